# Optimizing an MI355X kernel written in HIP

```python
import math
import jax
import jax.numpy as jnp
from jax import lax
import numpy as np

D_MODEL = 2048
BATCH = 1
SEQ = 8192
DEPTH = 2

F32 = jnp.float32
CHUNK = 64
Q_BLOCK = 128
FOX_HEADS = 6
FOX_HD = 128
FOX_W = FOX_HEADS * FOX_HD
LRU_W = 768
LRU_BLOCKS = 6
LRU_BW = LRU_W // LRU_BLOCKS
CONV_W = 4
LRU_C = 8.0
DIFF_HEADS = 4
DIFF_HD = 64
DIFF_VD = 2 * DIFF_HD
DIFF_W = DIFF_HEADS * DIFF_VD
ROT_DIM = DIFF_HD // 4
ROPE_THETA = 500000.0
D_MIX = FOX_W + LRU_W + DIFF_W
N_IN = 3 * FOX_W + FOX_HEADS + 2 * LRU_W + 3 * DIFF_W
N_GROUPS = 4
EXPERTS_PER_GROUP = 8
TOP_K = 2
D_FF_EXPERT = 512
ALPHA = (2.0 * DEPTH) ** 0.25
BETA = (8.0 * DEPTH) ** -0.25
LN_EPS = 1e-5

kernel_name = 'hybrid_fox_rglru_diffattn_hmoe_deepnorm'


def _layer_norm(x, g, b):
    xf = x.astype(F32)
    mu = jnp.mean(xf, -1, keepdims=True)
    xc = xf - mu
    var = jnp.mean(xc * xc, -1, keepdims=True)
    return (xc * lax.rsqrt(var + LN_EPS) * g.astype(F32) + b.astype(F32)).astype(x.dtype)


def _rms_norm(x, g):
    xf = x.astype(F32)
    return (xf * lax.rsqrt(jnp.mean(xf * xf, -1, keepdims=True) + LN_EPS) * g.astype(F32)).astype(x.dtype)


def _rope_tables(positions):
    half = ROT_DIM // 2
    inv_freq = ROPE_THETA ** (-jnp.arange(half, dtype=F32) * 2.0 / ROT_DIM)
    ang = positions.astype(F32)[..., None] * inv_freq
    return jnp.cos(ang)[:, :, None, :], jnp.sin(ang)[:, :, None, :]


def _apply_partial_rope(t, cos, sin):
    half = ROT_DIM // 2
    t1 = t[..., :half].astype(F32)
    t2 = t[..., half:ROT_DIM].astype(F32)
    rot = jnp.concatenate([t1 * cos - t2 * sin, t2 * cos + t1 * sin], -1).astype(t.dtype)
    return jnp.concatenate([rot, t[..., ROT_DIM:]], -1)


def _to_blocks(t):
    b, s = t.shape[:2]
    return jnp.moveaxis(t.reshape((b, s // Q_BLOCK, Q_BLOCK) + t.shape[2:]), 1, 0)


def _from_blocks(t):
    nb, b, q = t.shape[:3]
    return jnp.moveaxis(t, 0, 1).reshape((b, nb * q) + t.shape[3:])


def _forgetting_attention(q, k, v, log_f):
    s_len = q.shape[1]
    cum = jnp.moveaxis(jnp.cumsum(log_f, axis=1), -1, 1)
    k_pos = jnp.arange(s_len)
    q_pos = k_pos.reshape(-1, Q_BLOCK)
    cum_q = jnp.moveaxis(cum.reshape(cum.shape[0], cum.shape[1], -1, Q_BLOCK), 2, 0)
    scale = FOX_HD ** -0.5

    def block(args):
        qb, cq, pq = args
        logits = jnp.einsum('bqhd,bkhd->bhqk', qb, k, preferred_element_type=F32) * scale
        logits = logits + cq[..., None] - cum[:, :, None, :]
        logits = jnp.where(k_pos[None, :] <= pq[:, None], logits, -jnp.inf)
        p = jax.nn.softmax(logits, axis=-1)
        return jnp.einsum('bhqk,bkhd->bqhd', p.astype(v.dtype), v)

    return _from_blocks(lax.map(block, (_to_blocks(q), cum_q, q_pos)))


def _differential_attention(q, k, v, lam):
    s_len = q.shape[1]
    chunk = jnp.arange(s_len) // CHUNK
    chunk_q = chunk.reshape(-1, Q_BLOCK)
    scale = DIFF_HD ** -0.5

    def block(args):
        qb, cq = args
        logits = jnp.einsum('bqhmd,bkhmd->bhmqk', qb, k, preferred_element_type=F32) * scale
        logits = jnp.where(chunk[None, :] <= cq[:, None], logits, -jnp.inf)
        p = jax.nn.softmax(logits, axis=-1)
        w = p[:, :, 0] - lam * p[:, :, 1]
        return jnp.einsum('bhqk,bkhd->bqhd', w.astype(v.dtype), v)

    return _from_blocks(lax.map(block, (_to_blocks(q), chunk_q)))


def _causal_depthwise_conv(x, w, b):
    y = lax.conv_general_dilated(x, w[:, None, :], (1,), [(CONV_W - 1, 0)],
                                 dimension_numbers=('NWC', 'WIO', 'NWC'),
                                 feature_group_count=x.shape[-1])
    return y + b


def _rg_lru(x, w_a, b_a, w_i, b_i, lam):
    bsz, s_len, _ = x.shape
    xb = x.reshape(bsz, s_len, LRU_BLOCKS, LRU_BW)
    r = jax.nn.sigmoid((jnp.einsum('bsnc,ncd->bsnd', xb, w_a).reshape(bsz, s_len, LRU_W) + b_a).astype(F32))
    i = jax.nn.sigmoid((jnp.einsum('bsnc,ncd->bsnd', xb, w_i).reshape(bsz, s_len, LRU_W) + b_i).astype(F32))
    log_a = LRU_C * r * jax.nn.log_sigmoid(lam.astype(F32))
    a = jnp.exp(log_a)
    u = jnp.sqrt(-jnp.expm1(2.0 * log_a)) * (i * x.astype(F32))

    def combine(left, right):
        a_l, u_l = left
        a_r, u_r = right
        return a_l * a_r, a_r * u_l + u_r

    _, h = lax.associative_scan(combine, (a, u), axis=1)
    return h.astype(x.dtype)


def _hierarchical_moe(x, w_group, b_group, w_router, b_router, w_gate, w_up, w_down):
    bsz, s_len, d = x.shape
    t = x.reshape(-1, d)
    g_logits = jnp.matmul(t, w_group, preferred_element_type=F32) + b_group.astype(F32)
    g_prob = jax.nn.softmax(g_logits, axis=-1)
    g_onehot = jax.nn.one_hot(jnp.argmax(g_logits, axis=-1), N_GROUPS, dtype=F32)
    g_weight = jnp.sum(g_prob * g_onehot, -1, keepdims=True)
    e_logits = (jnp.matmul(t, w_router, preferred_element_type=F32) + b_router.astype(F32)
                ).reshape(-1, N_GROUPS, EXPERTS_PER_GROUP)
    e_logits = jnp.einsum('tg,tge->te', g_onehot, e_logits)
    e_prob = jax.nn.softmax(e_logits, axis=-1)
    top_w, top_i = lax.top_k(e_prob, TOP_K)
    top_w = top_w / jnp.sum(top_w, -1, keepdims=True)
    e_gate = jnp.einsum('tk,tke->te', top_w, jax.nn.one_hot(top_i, EXPERTS_PER_GROUP, dtype=F32))
    gate = g_onehot[:, :, None] * (g_weight * e_gate)[:, None, :]
    out = jnp.zeros((t.shape[0], d), F32)
    for g in range(N_GROUPS):
        hg = jnp.einsum('td,edf->tef', t, w_gate[g])
        hu = jnp.einsum('td,edf->tef', t, w_up[g])
        h = jax.nn.silu(hg) * hu * gate[:, g, :, None].astype(t.dtype)
        out = out + jnp.einsum('tef,efd->td', h, w_down[g], preferred_element_type=F32)
    return out.reshape(bsz, s_len, d).astype(x.dtype)


def _mixer(x, cos, sin, layer, w_in, b_f, conv_w, conv_b, w_a, b_a, w_i, b_i, lru_lambda,
           lam_q1, lam_k1, lam_q2, lam_k2, subln_g, w_o):
    bsz, s_len, _ = x.shape
    proj = x @ w_in
    sizes = (FOX_W, FOX_W, FOX_W, FOX_HEADS, LRU_W, LRU_W, DIFF_W, DIFF_W, DIFF_W)
    offs = [sum(sizes[:j + 1]) for j in range(len(sizes) - 1)]
    qa, ka, va, fa, xr, gr, qc, kc, vc = jnp.split(proj, offs, axis=-1)

    def heads(t, h):
        return t.reshape(bsz, s_len, h, -1)

    log_f = jax.nn.log_sigmoid(fa.astype(F32) + b_f.astype(F32))
    out_a = _forgetting_attention(heads(qa, FOX_HEADS), heads(ka, FOX_HEADS), heads(va, FOX_HEADS),
                                  log_f).reshape(bsz, s_len, FOX_W)
    xr = _causal_depthwise_conv(xr, conv_w, conv_b)
    out_b = jax.nn.gelu(gr, approximate=True) * _rg_lru(xr, w_a, b_a, w_i, b_i, lru_lambda)
    qc = _apply_partial_rope(heads(qc, 2 * DIFF_HEADS), cos, sin).reshape(bsz, s_len, DIFF_HEADS, 2, DIFF_HD)
    kc = _apply_partial_rope(heads(kc, 2 * DIFF_HEADS), cos, sin).reshape(bsz, s_len, DIFF_HEADS, 2, DIFF_HD)
    lam_init = 0.8 - 0.6 * math.exp(-0.3 * layer)
    lam = (jnp.exp(jnp.sum(lam_q1.astype(F32) * lam_k1.astype(F32)))
           - jnp.exp(jnp.sum(lam_q2.astype(F32) * lam_k2.astype(F32))) + lam_init)
    oc = _differential_attention(qc, kc, heads(vc, DIFF_HEADS), lam)
    out_c = (_rms_norm(oc, subln_g) * (1.0 - lam_init)).reshape(bsz, s_len, DIFF_W)
    return jnp.concatenate([out_a, out_b, out_c], axis=-1) @ w_o


def setup_inputs(seed: int = 0) -> dict:
    key = jax.random.key(seed)
    ks = jax.random.split(key, 32)

    def nrm(k, shape, scale):
        return jax.random.normal(k, shape, F32) * scale

    G, E = N_GROUPS, EXPERTS_PER_GROUP
    x = nrm(ks[0], (BATCH, SEQ, D_MODEL), 1.0)
    offset = jax.random.randint(ks[1], (BATCH, 1), 0, 64) * CHUNK
    positions = (offset + jnp.arange(SEQ)[None, :]).astype(jnp.int32)
    a_init = jax.random.uniform(ks[10], (DEPTH, LRU_W), F32, 0.9, 0.999) ** (1.0 / LRU_C)
    lru_lambda = jnp.log(a_init) - jnp.log1p(-a_init)
    return {
        'x': x,
        'positions': positions,
        'w_in': nrm(ks[2], (DEPTH, D_MODEL, N_IN), D_MODEL ** -0.5),
        'b_f': 1.0 + nrm(ks[3], (DEPTH, FOX_HEADS), 0.1),
        'conv_w': nrm(ks[4], (DEPTH, CONV_W, LRU_W), CONV_W ** -0.5),
        'conv_b': nrm(ks[5], (DEPTH, LRU_W), 0.02),
        'w_a': nrm(ks[6], (DEPTH, LRU_BLOCKS, LRU_BW, LRU_BW), LRU_BW ** -0.5),
        'b_a': nrm(ks[7], (DEPTH, LRU_W), 0.1),
        'w_i': nrm(ks[8], (DEPTH, LRU_BLOCKS, LRU_BW, LRU_BW), LRU_BW ** -0.5),
        'b_i': nrm(ks[9], (DEPTH, LRU_W), 0.1),
        'lru_lambda': lru_lambda,
        'lam_q1': nrm(ks[11], (DEPTH, DIFF_HD), 0.1),
        'lam_k1': nrm(ks[12], (DEPTH, DIFF_HD), 0.1),
        'lam_q2': nrm(ks[13], (DEPTH, DIFF_HD), 0.1),
        'lam_k2': nrm(ks[14], (DEPTH, DIFF_HD), 0.1),
        'subln_g': 1.0 + nrm(ks[15], (DEPTH, DIFF_VD), 0.02),
        'w_o': nrm(ks[16], (DEPTH, D_MIX, D_MODEL), BETA * D_MIX ** -0.5),
        'ln1_g': 1.0 + nrm(ks[17], (DEPTH, D_MODEL), 0.02),
        'ln1_b': nrm(ks[18], (DEPTH, D_MODEL), 0.02),
        'w_group': nrm(ks[19], (DEPTH, D_MODEL, G), D_MODEL ** -0.5),
        'b_group': nrm(ks[20], (DEPTH, G), 0.01),
        'w_router': nrm(ks[21], (DEPTH, D_MODEL, G * E), D_MODEL ** -0.5),
        'b_router': nrm(ks[22], (DEPTH, G * E), 0.01),
        'w_gate': nrm(ks[23], (DEPTH, G, E, D_MODEL, D_FF_EXPERT), D_MODEL ** -0.5),
        'w_up': nrm(ks[24], (DEPTH, G, E, D_MODEL, D_FF_EXPERT), D_MODEL ** -0.5),
        'w_down': nrm(ks[25], (DEPTH, G, E, D_FF_EXPERT, D_MODEL), BETA * D_FF_EXPERT ** -0.5),
        'ln2_g': 1.0 + nrm(ks[26], (DEPTH, D_MODEL), 0.02),
        'ln2_b': nrm(ks[27], (DEPTH, D_MODEL), 0.02),
    }


def reference(x, positions, w_in, b_f, conv_w, conv_b, w_a, b_a, w_i, b_i, lru_lambda,
              lam_q1, lam_k1, lam_q2, lam_k2, subln_g, w_o, ln1_g, ln1_b,
              w_group, b_group, w_router, b_router, w_gate, w_up, w_down, ln2_g, ln2_b):
    cos, sin = _rope_tables(positions)
    h = x
    for l in range(DEPTH):
        mix = _mixer(h, cos, sin, l, w_in[l], b_f[l], conv_w[l], conv_b[l], w_a[l], b_a[l],
                     w_i[l], b_i[l], lru_lambda[l], lam_q1[l], lam_k1[l], lam_q2[l], lam_k2[l],
                     subln_g[l], w_o[l])
        h = _layer_norm(ALPHA * h + mix, ln1_g[l], ln1_b[l])
        ffn = _hierarchical_moe(h, w_group[l], b_group[l], w_router[l], b_router[l],
                                w_gate[l], w_up[l], w_down[l])
        h = _layer_norm(ALPHA * h + ffn, ln2_g[l], ln2_b[l])
    return h
```

```cpp
#ifndef EMU
#include <hip/hip_runtime.h>
#include <cstdio>
#include <cstdint>
#include <cmath>
#endif

#ifndef SEQ
#define SEQ 8192
#endif
#ifndef N_LAUNCH_SPLIT
#define N_LAUNCH_SPLIT 0
#endif

constexpr int S = SEQ, D = 2048, DEPTH = 2;
constexpr int FOX_H = 6, FOX_HD = 128, FOX_W = 768;
constexpr int LRU_W = 768, LRU_BW = 128;
constexpr int DIFF_H = 4, DIFF_HD = 64, DIFF_VD = 128, DIFF_W = 512;
constexpr int N_IN = 5382;
constexpr int C_QA = 0, C_KA = 768, C_VA = 1536, C_FA = 2304, C_XR = 2310, C_GR = 3078, C_QC = 3846, C_KC = 4358, C_VC = 4870;
constexpr int NEXP = 32, DFF = 512;
constexpr float ALPHA = 1.41421356237309504880f;
constexpr float LN_EPS = 1e-5f;

enum { I_X = 0, I_POS, I_WIN, I_BF, I_CONVW, I_CONVB, I_WA, I_BA, I_WI, I_BI, I_LAM, I_LQ1, I_LK1, I_LQ2, I_LK2, I_SUBG, I_WO, I_LN1G, I_LN1B,
       I_WGRP, I_BGRP, I_WRT, I_BRT, I_WGATE, I_WUP, I_WDOWN, I_LN2G, I_LN2B, N_INPUTS };

constexpr size_t al256(size_t x) { return (x + 255) & ~(size_t)255; }
constexpr size_t CTL_BYTES = 65536;
constexpr size_t CTL_CNT_OFF = 32768;
constexpr size_t WS_PROJ = CTL_BYTES;
constexpr size_t WS_CUM = WS_PROJ + al256((size_t)S * N_IN * 4);
constexpr size_t WS_LOGF = WS_CUM + al256((size_t)6 * S * 4);
constexpr size_t WS_XC = WS_LOGF + al256((size_t)6 * S * 4);
constexpr size_t WS_LA = WS_XC + al256((size_t)S * LRU_W * 4);
constexpr size_t WS_LU = WS_LA + al256((size_t)S * LRU_W * 4);
constexpr size_t WS_CONCAT = WS_LU + al256((size_t)S * LRU_W * 4);
constexpr size_t WS_P1 = WS_CONCAT + al256((size_t)S * D * 4);
constexpr size_t WS_P2 = WS_P1 + al256((size_t)S * DIFF_W * 4);
constexpr size_t WS_Y1 = WS_P2 + al256((size_t)S * DIFF_W * 4);
constexpr size_t WS_H1 = WS_Y1 + al256((size_t)S * D * 4);
constexpr size_t WS_HB = WS_H1 + al256((size_t)S * D * 4);
constexpr size_t WS_LTOK = WS_HB + al256((size_t)S * D * 4);
constexpr size_t WS_LW = WS_LTOK + al256((size_t)NEXP * S * 4);
constexpr size_t WS_LSLOT = WS_LW + al256((size_t)NEXP * S * 4);
constexpr size_t WS_ACT = WS_LSLOT + al256((size_t)NEXP * S * 4);
constexpr size_t WS_CONTRIB = WS_ACT + al256((size_t)2 * S * DFF * 4);
constexpr size_t WS_END = WS_CONTRIB + al256((size_t)2 * S * D * 4);

constexpr int NTHREADS = 512;
constexpr int LDS_BYTES = 65536;

struct Params {
    const float* in[N_INPUTS];
    float* out;
    unsigned char* ws;
    float inv_freq[8];
    int lo, hi;
};

#ifndef EMU
#define LAS __attribute__((address_space(3)))
#define DYN_LDS(name) extern __shared__ __attribute__((aligned(16))) unsigned char name[]
#define SLEEP1() __builtin_amdgcn_s_sleep(1)
#define WAVE_SYNC() __builtin_amdgcn_wave_barrier()
#define OPAQUE(x) asm volatile("" : "+v"(x))
#define WAIT_VM0() asm volatile("s_waitcnt vmcnt(0)" ::: "memory")
#define WAIT_ALL0() __builtin_amdgcn_s_waitcnt(0)
#define FENCE_REL_AGENT() __builtin_amdgcn_fence(__ATOMIC_RELEASE, "agent")
#define FENCE_ACQ_AGENT() __builtin_amdgcn_fence(__ATOMIC_ACQUIRE, "agent")
__device__ __forceinline__ unsigned xb_ld(unsigned* p)              { return __hip_atomic_load(p, __ATOMIC_RELAXED, __HIP_MEMORY_SCOPE_AGENT); }
__device__ __forceinline__ unsigned xb_add(unsigned* p, unsigned v) { return __hip_atomic_fetch_add(p, v, __ATOMIC_RELAXED, __HIP_MEMORY_SCOPE_AGENT); }
__device__ __forceinline__ unsigned xb_xcc_id() { return (unsigned)__builtin_amdgcn_s_getreg((3 << 11) | 20) & 0xFu; }
__device__ __forceinline__ int atomic_add_int(int* p, int v) { return atomicAdd(p, v); }
#endif

#define XB_TMO      128
#define XB_XCNT(j)  (256  + 64 * (j))
#define XB_XSUB(j)  (1280 + 64 * (j))
#define XB_XGEN(j)  (2304 + 64 * (j))
#define XB_TOP      3328
#define XB_TOPGEN   3392
#define XCD_BAR_WORDS 3456
#define XB_SPIN_CAP (1u << 24)
#define XB_SPIN(cond, bar) do { unsigned _sp = 0; while (cond) { SLEEP1(); \
    if ((++_sp & 255u) == 0u) { if (xb_ld(&(bar)[XB_TMO])) break; if (_sp > XB_SPIN_CAP) { xb_add(&(bar)[XB_TMO], 1u); break; } } } } while (0)

struct XcdBarrier { unsigned* bar; unsigned x; volatile LAS unsigned* st; };

__device__ __forceinline__ XcdBarrier xcd_barrier_post(unsigned* bar, volatile LAS unsigned* st) {
    XcdBarrier b; b.bar = bar; b.x = xb_xcc_id(); b.st = st;
    if (threadIdx.x == 0) (void)xb_add(&bar[XB_XCNT(b.x)], 1u);
    return b;
}
__device__ __forceinline__ void xcd_barrier_complete(unsigned* bar, unsigned x, unsigned& nloc, unsigned& nx) {
    const unsigned G = gridDim.x;
    unsigned sum, cnt, mine, sp = 0u;
    for (;;) {
        sum = 0u; cnt = 0u; mine = 0u;
#pragma unroll
        for (unsigned j = 0; j < 16; ++j) { const unsigned c = xb_ld(&bar[XB_XCNT(j)]); sum += c; cnt += (c > 0u) ? 1u : 0u; mine = (j == x) ? c : mine; }
        if (sum == G) break;
        SLEEP1();
        if ((++sp & 255u) == 0u) { if (xb_ld(&bar[XB_TMO])) break; if (sp > XB_SPIN_CAP) { xb_add(&bar[XB_TMO], 1u); break; } }
    }
    nloc = mine > 0u ? mine : 1u; nx = cnt > 0u ? cnt : 1u;
}
__device__ __forceinline__ void xcd_barrier(const XcdBarrier& b) {
    WAIT_VM0();
    __syncthreads();
    if (threadIdx.x == 0) {
        unsigned* bar = b.bar;
        WAIT_ALL0();
        unsigned nloc = b.st[0], nx = b.st[1];
        if (nloc == 0u) { xcd_barrier_complete(bar, b.x, nloc, nx); b.st[0] = nloc; b.st[1] = nx; }
        const unsigned old = xb_add(&bar[XB_XSUB(b.x)], 1u);
        const unsigned gen = old / nloc;
        if (old + 1u == (gen + 1u) * nloc) {
            FENCE_REL_AGENT();
            WAIT_VM0();
            const unsigned og = xb_add(&bar[XB_TOP], 1u);
            const unsigned tg = og / nx;
            if (og + 1u == (tg + 1u) * nx) xb_add(&bar[XB_TOPGEN], 1u);
            else XB_SPIN(xb_ld(&bar[XB_TOPGEN]) == tg, bar);
            FENCE_ACQ_AGENT();
            xb_add(&bar[XB_XGEN(b.x)], 1u);
            WAIT_VM0();
        } else {
            XB_SPIN(xb_ld(&bar[XB_XGEN(b.x)]) == gen, bar);
            FENCE_ACQ_AGENT();
            WAIT_VM0();
        }
    }
    __syncthreads();
}

__device__ __forceinline__ float wave_sum(float v) {
#pragma unroll
    for (int o = 1; o < 64; o <<= 1) v += __shfl_xor(v, o);
    return v;
}
__device__ __forceinline__ float sigmoid_f(float x) { return 1.f / (1.f + expf(-x)); }
__device__ __forceinline__ float log_sigmoid_f(float x) { return fminf(x, 0.f) - log1pf(expf(-fabsf(x))); }
__device__ __forceinline__ float gelu_tanh_f(float x) { const float u = 0.7978845608028654f * (x + 0.044715f * x * x * x); return 0.5f * x * (1.f + tanhf(u)); }
__device__ __forceinline__ float silu_f(float x) { return x / (1.f + expf(-x)); }

template <class RowFn, class Epi>
__device__ __forceinline__ void gemm_naive_tile(const float* A, int lda, const RowFn& rowfn, const float* B, int ldb, int N, int K,
                                                int tm, int tn, float* lds, const Epi& epi, int tid) {
    float* As = lds;
    float* Bs = lds + 16 * 132;
    const int tx = tid & 31, ty = tid >> 5;
    float acc[8][4];
#pragma unroll
    for (int i = 0; i < 8; ++i)
#pragma unroll
        for (int j = 0; j < 4; ++j) acc[i][j] = 0.f;
    const int am = tid >> 2, ak = (tid & 3) * 4;
    const long arow = rowfn(tm + am);
    const int bk = tid >> 5, bn = (tid & 31) * 4;
    for (int k0 = 0; k0 < K; k0 += 16) {
        float av[4] = {0.f, 0.f, 0.f, 0.f}, bv[4];
        if (arow >= 0) {
#pragma unroll
            for (int j = 0; j < 4; ++j) av[j] = A[(size_t)arow * lda + k0 + ak + j];
        }
#pragma unroll
        for (int j = 0; j < 4; ++j) { const int n = tn + bn + j; bv[j] = (n < N) ? B[(size_t)(k0 + bk) * ldb + n] : 0.f; }
        __syncthreads();
#pragma unroll
        for (int j = 0; j < 4; ++j) { As[(ak + j) * 132 + am] = av[j]; Bs[bk * 132 + bn + j] = bv[j]; }
        __syncthreads();
#pragma unroll
        for (int k = 0; k < 16; ++k) {
            float a[8], b[4];
#pragma unroll
            for (int i = 0; i < 8; ++i) a[i] = As[k * 132 + ty * 8 + i];
#pragma unroll
            for (int j = 0; j < 4; ++j) b[j] = Bs[k * 132 + tx * 4 + j];
#pragma unroll
            for (int i = 0; i < 8; ++i)
#pragma unroll
                for (int j = 0; j < 4; ++j) acc[i][j] += a[i] * b[j];
        }
    }
#pragma unroll
    for (int i = 0; i < 8; ++i)
#pragma unroll
        for (int j = 0; j < 4; ++j) { const int m = tm + ty * 8 + i, n = tn + tx * 4 + j; if (n < N) epi(m, n, acc[i][j]); }
}

struct RowIdent { __device__ __forceinline__ long operator()(int m) const { return m; } };
struct RowGather { const int* tok; int cnt; __device__ __forceinline__ long operator()(int m) const { return m < cnt ? (long)tok[m] : -1L; } };
struct RowOff { int off, cnt; __device__ __forceinline__ long operator()(int m) const { return m < cnt ? (long)(off + m) : -1L; } };

struct EpiStore { float* C; int ldc; __device__ __forceinline__ void operator()(int m, int n, float v) const { C[(size_t)m * ldc + n] = v; } };
struct EpiResid { float* C; const float* R; int ldc; __device__ __forceinline__ void operator()(int m, int n, float v) const { C[(size_t)m * ldc + n] = ALPHA * R[(size_t)m * ldc + n] + v; } };
struct EpiGate { float* G; int off, cnt; __device__ __forceinline__ void operator()(int m, int n, float v) const { if (m < cnt) G[(size_t)(off + m) * DFF + n] = v; } };
struct EpiUp { float* G; const float* w; int off, cnt; __device__ __forceinline__ void operator()(int m, int n, float v) const {
    if (m < cnt) { const size_t i = (size_t)(off + m) * DFF + n; const float g = G[i]; G[i] = silu_f(g) * v * w[m]; } } };
struct EpiDown { float* contrib; const int* tok; const int* slot; int cnt; __device__ __forceinline__ void operator()(int m, int n, float v) const {
    if (m < cnt) contrib[((size_t)slot[m] * S + tok[m]) * D + n] = v; } };

template <int HD>
__device__ __forceinline__ void attn_naive_unit(const float* Q, int ldq, const float* Kp, int ldk, const float* V, int ldv,
                                                const float* cum, int mode, float scale, int qb, float* out, int ldo, float* lds, int tid) {
    constexpr int DQ = HD / 4;
    float* Ks = lds;
    float* Vs = lds + 32 * HD;
    float* Cs = Vs + 32 * 128;
    const int quarter = tid & 3, t = qb * 128 + (tid >> 2);
    float q[DQ];
#pragma unroll
    for (int d = 0; d < DQ; ++d) q[d] = Q[(size_t)t * ldq + quarter * DQ + d] * scale;
    float o[32];
#pragma unroll
    for (int d = 0; d < 32; ++d) o[d] = 0.f;
    float m = -INFINITY, lsum = 0.f;
    const float ct = cum ? cum[t] : 0.f;
    const int nkt = (qb * 128 + 128) / 32;
    const int tlimit = (mode == 0) ? t : ((t / 64) * 64 + 63);
    for (int kt = 0; kt < nkt; ++kt) {
        __syncthreads();
        for (int i = tid; i < 32 * HD; i += NTHREADS) { const int r = i / HD, c = i % HD; Ks[i] = Kp[(size_t)(kt * 32 + r) * ldk + c]; }
        for (int i = tid; i < 32 * 128; i += NTHREADS) { const int r = i / 128, c = i % 128; Vs[i] = V[(size_t)(kt * 32 + r) * ldv + c]; }
        if (tid < 32) Cs[tid] = cum ? cum[kt * 32 + tid] : 0.f;
        __syncthreads();
        const int s0 = kt * 32;
#pragma unroll 1
        for (int j = 0; j < 32; ++j) {
            float dot = 0.f;
#pragma unroll
            for (int d = 0; d < DQ; ++d) dot += q[d] * Ks[j * HD + quarter * DQ + d];
            dot += __shfl_xor(dot, 1);
            dot += __shfl_xor(dot, 2);
            if (s0 + j <= tlimit) {
                const float logit = dot + (ct - Cs[j]);
                const float mn = fmaxf(m, logit), corr = expf(m - mn), pr = expf(logit - mn);
                lsum = lsum * corr + pr;
#pragma unroll
                for (int d = 0; d < 32; ++d) o[d] = o[d] * corr + pr * Vs[j * 128 + quarter * 32 + d];
                m = mn;
            }
        }
    }
    const float inv = 1.f / lsum;
#pragma unroll
    for (int d = 0; d < 32; ++d) out[(size_t)t * ldo + quarter * 32 + d] = o[d] * inv;
}

#ifndef EMU
__global__ void __launch_bounds__(NTHREADS, 2)
#else
void
#endif
fwd_kernel(Params p) {
    DYN_LDS(lds_raw);
    float* ldsf = (float*)lds_raw;
    const int bid = blockIdx.x, G = gridDim.x;
    const int gthreads = G * NTHREADS, gwaves = G * (NTHREADS / 64);
#define PHASE_IDS() int tid = threadIdx.x; OPAQUE(tid); const int lane = tid & 63, wave = tid >> 6, gtid = bid * NTHREADS + tid, gwave = bid * (NTHREADS / 64) + wave; (void)lane; (void)wave; (void)gtid; (void)gwave

    unsigned char* ws = p.ws;
    volatile LAS unsigned* bst = (volatile LAS unsigned*)(lds_raw + LDS_BYTES - 16);
    if (threadIdx.x == 0) { bst[0] = 0u; bst[1] = 0u; bst[2] = 0u; bst[3] = 0u; }
    __syncthreads();
    XcdBarrier bar = xcd_barrier_post((unsigned*)ws, bst);

    float* proj = (float*)(ws + WS_PROJ);
    float* cumb = (float*)(ws + WS_CUM);
    float* logf_ = (float*)(ws + WS_LOGF);
    float* xcb = (float*)(ws + WS_XC);
    float* la = (float*)(ws + WS_LA);
    float* lu = (float*)(ws + WS_LU);
    float* concat = (float*)(ws + WS_CONCAT);
    float* P1 = (float*)(ws + WS_P1);
    float* P2 = (float*)(ws + WS_P2);
    float* y1 = (float*)(ws + WS_Y1);
    float* h1 = (float*)(ws + WS_H1);
    float* hb = (float*)(ws + WS_HB);
    int* ltok = (int*)(ws + WS_LTOK);
    float* lw = (float*)(ws + WS_LW);
    int* lslot = (int*)(ws + WS_LSLOT);
    float* act = (float*)(ws + WS_ACT);
    float* contrib = (float*)(ws + WS_CONTRIB);
    const int* positions = (const int*)p.in[I_POS];

    constexpr int NPH = 10;
    const int lo = p.lo, hi = p.hi;
#ifndef ONLY_PHASE
#define ONLY_PHASE -1
#endif
#define PH_IN(k) ((ONLY_PHASE < 0 || ((k) % NPH) == ONLY_PHASE) && lo <= (k) && (k) < hi)
#define PH_BAR(k) do { if ((k) + 1 < hi) xcd_barrier(bar); } while (0)

    for (int l = 0; l < DEPTH; ++l) {
        const int pb = l * NPH;
        const float* hin = (l == 0) ? p.in[I_X] : hb;
        float* hout = (l == DEPTH - 1) ? p.out : hb;
        const float* w_in = p.in[I_WIN] + (size_t)l * D * N_IN;
        int* cnt = (int*)(ws + CTL_CNT_OFF) + l * NEXP;

        if (PH_IN(pb + 0)) {
            PHASE_IDS();
            const int ntn = (N_IN + 127) / 128, ntm = S / 128;
            for (int t = bid; t < ntm * ntn; t += G)
                gemm_naive_tile(hin, D, RowIdent{}, w_in, N_IN, N_IN, D, (t / ntn) * 128, (t % ntn) * 128, ldsf, EpiStore{proj, N_IN}, tid);
            PH_BAR(pb + 0);
        }
        if (PH_IN(pb + 1)) {
            PHASE_IDS();
            for (int i = gtid; i < S * 16 * 8; i += gthreads) {
                const int d = i & 7, sh = (i >> 3) & 15, t = i >> 7;
                const int base = (sh < 8) ? (C_QC + sh * 64) : (C_KC + (sh - 8) * 64);
                const float ang = (float)positions[t] * p.inv_freq[d];
                const float c = cosf(ang), s = sinf(ang);
                float* r = proj + (size_t)t * N_IN + base;
                const float t1 = r[d], t2 = r[d + 8];
                r[d] = t1 * c - t2 * s; r[d + 8] = t2 * c + t1 * s;
            }
            for (int i = gtid; i < S * 6; i += gthreads) {
                const int h = i % 6, t = i / 6;
                logf_[h * S + t] = log_sigmoid_f(proj[(size_t)t * N_IN + C_FA + h] + p.in[I_BF][l * 6 + h]);
            }
            const float* cw = p.in[I_CONVW] + (size_t)l * 4 * LRU_W;
            const float* cb = p.in[I_CONVB] + (size_t)l * LRU_W;
            for (int i = gtid; i < S * LRU_W; i += gthreads) {
                const int c = i % LRU_W, t = i / LRU_W;
                float v = cb[c];
#pragma unroll
                for (int j = 0; j < 4; ++j) { const int tt = t - 3 + j; if (tt >= 0) v += cw[j * LRU_W + c] * proj[(size_t)tt * N_IN + C_XR + c]; }
                xcb[i] = v;
            }
            PH_BAR(pb + 1);
        }
        if (PH_IN(pb + 2)) {
            PHASE_IDS();
            const float* wa = p.in[I_WA] + (size_t)l * 6 * 128 * 128;
            const float* wi = p.in[I_WI] + (size_t)l * 6 * 128 * 128;
            for (int i = gtid; i < S * LRU_W; i += gthreads) {
                const int ch = i % LRU_W, t = i / LRU_W, n = ch >> 7, d = ch & 127;
                const float* xr = xcb + (size_t)t * LRU_W + n * 128;
                const float* wan = wa + (size_t)n * 128 * 128 + d;
                const float* win = wi + (size_t)n * 128 * 128 + d;
                float ra = 0.f, ri = 0.f;
                for (int c = 0; c < 128; ++c) { const float xv = xr[c]; ra += xv * wan[c * 128]; ri += xv * win[c * 128]; }
                const float r = sigmoid_f(ra + p.in[I_BA][l * LRU_W + ch]);
                const float ig = sigmoid_f(ri + p.in[I_BI][l * LRU_W + ch]);
                const float log_a = 8.0f * r * log_sigmoid_f(p.in[I_LAM][l * LRU_W + ch]);
                la[i] = expf(log_a);
                lu[i] = sqrtf(-expm1f(2.f * log_a)) * (ig * xr[d]);
            }
            if (bid == 0) {
                double* part = (double*)lds_raw;
                const int per = S / 64;
                double s = 0.0;
                if (wave < 6) { for (int i = 0; i < per; ++i) s += (double)logf_[wave * S + lane * per + i]; part[wave * 64 + lane] = s; }
                __syncthreads();
                if (wave < 6) {
                    double run = 0.0;
                    for (int j = 0; j < lane; ++j) run += part[wave * 64 + j];
                    for (int i = 0; i < per; ++i) { run += (double)logf_[wave * S + lane * per + i]; cumb[wave * S + lane * per + i] = (float)run; }
                }
                __syncthreads();
            }
            PH_BAR(pb + 2);
        }
        if (PH_IN(pb + 3)) {
            PHASE_IDS();
            for (int u = 0; u < LRU_W / 64; ++u) {
                if (((u + 1) % G) == bid && wave == 0) {
                    const int ch = u * 64 + lane;
                    float h = 0.f;
                    for (int t = 0; t < S; t += 8) {
                        float a8[8], u8[8], g8[8];
#pragma unroll
                        for (int i = 0; i < 8; ++i) { a8[i] = la[(size_t)(t + i) * LRU_W + ch]; u8[i] = lu[(size_t)(t + i) * LRU_W + ch]; g8[i] = proj[(size_t)(t + i) * N_IN + C_GR + ch]; }
#pragma unroll
                        for (int i = 0; i < 8; ++i) { h = a8[i] * h + u8[i]; concat[(size_t)(t + i) * D + FOX_W + ch] = gelu_tanh_f(g8[i]) * h; }
                    }
                }
            }
            const int nqb = S / 128, nunits = nqb * (FOX_H + 2 * DIFF_H);
            for (int u = bid; u < nunits; u += G) {
                const int qb = nqb - 1 - u / (FOX_H + 2 * DIFF_H), w = u % (FOX_H + 2 * DIFF_H);
                if (w < FOX_H) {
                    const int h = w;
                    attn_naive_unit<128>(proj + C_QA + h * 128, N_IN, proj + C_KA + h * 128, N_IN, proj + C_VA + h * 128, N_IN,
                                         cumb + (size_t)h * S, 0, 0.08838834764831845f, qb, concat + h * 128, D, ldsf, tid);
                } else {
                    const int h = (w - FOX_H) >> 1, mp = (w - FOX_H) & 1;
                    attn_naive_unit<64>(proj + C_QC + (h * 2 + mp) * 64, N_IN, proj + C_KC + (h * 2 + mp) * 64, N_IN, proj + C_VC + h * 128, N_IN,
                                        nullptr, 1, 0.125f, qb, (mp ? P2 : P1) + h * 128, DIFF_W, ldsf, tid);
                }
            }
            PH_BAR(pb + 3);
        }
        if (PH_IN(pb + 4)) {
            PHASE_IDS();
            const float lam_init = 0.8f - 0.6f * expf(-0.3f * (float)l);
            const float s1 = wave_sum(p.in[I_LQ1][l * 64 + lane] * p.in[I_LK1][l * 64 + lane]);
            const float s2 = wave_sum(p.in[I_LQ2][l * 64 + lane] * p.in[I_LK2][l * 64 + lane]);
            const float lam = expf(s1) - expf(s2) + lam_init;
            const float* sg = p.in[I_SUBG] + l * 128;
            for (int i = gwave; i < S * DIFF_H; i += gwaves) {
                const int h = i % DIFF_H, t = i / DIFF_H;
                const size_t o = (size_t)t * DIFF_W + h * 128;
                const float v0 = P1[o + lane] - lam * P2[o + lane], v1 = P1[o + 64 + lane] - lam * P2[o + 64 + lane];
                const float ms = wave_sum(v0 * v0 + v1 * v1) * (1.f / 128.f);
                const float rs = 1.f / sqrtf(ms + LN_EPS) * (1.f - lam_init);
                concat[(size_t)t * D + 1536 + h * 128 + lane] = v0 * rs * sg[lane];
                concat[(size_t)t * D + 1536 + h * 128 + 64 + lane] = v1 * rs * sg[64 + lane];
            }
            PH_BAR(pb + 4);
        }
        if (PH_IN(pb + 5)) {
            PHASE_IDS();
            const float* w_o = p.in[I_WO] + (size_t)l * D * D;
            const int ntn = D / 128, ntm = S / 128;
            for (int t = bid; t < ntm * ntn; t += G)
                gemm_naive_tile(concat, D, RowIdent{}, w_o, D, D, D, (t / ntn) * 128, (t % ntn) * 128, ldsf, EpiResid{y1, hin, D}, tid);
            PH_BAR(pb + 5);
        }
        if (PH_IN(pb + 6)) {
            PHASE_IDS();
            const float* g1 = p.in[I_LN1G] + (size_t)l * D; const float* b1 = p.in[I_LN1B] + (size_t)l * D;
            const float* wg = p.in[I_WGRP] + (size_t)l * D * 4; const float* bg = p.in[I_BGRP] + l * 4;
            const float* wr = p.in[I_WRT] + (size_t)l * D * 32; const float* br = p.in[I_BRT] + l * 32;
            for (int t = gwave; t < S; t += gwaves) {
                float v[32]; float s = 0.f;
#pragma unroll
                for (int j = 0; j < 32; ++j) { v[j] = y1[(size_t)t * D + j * 64 + lane]; s += v[j]; }
                const float mean = wave_sum(s) * (1.f / D);
                float s2 = 0.f;
#pragma unroll
                for (int j = 0; j < 32; ++j) { v[j] -= mean; s2 += v[j] * v[j]; }
                const float rstd = 1.f / sqrtf(wave_sum(s2) * (1.f / D) + LN_EPS);
#pragma unroll
                for (int j = 0; j < 32; ++j) { const int c = j * 64 + lane; v[j] = v[j] * rstd * g1[c] + b1[c]; h1[(size_t)t * D + c] = v[j]; }
                float* lg = ldsf + wave * 64;
                WAVE_SYNC();
#pragma unroll 1
                for (int o = 0; o < 36; ++o) {
                    const float* wcol = (o < 4) ? (wg + o) : (wr + (o - 4));
                    const int ldw = (o < 4) ? 4 : 32;
                    float a = 0.f;
#pragma unroll 4
                    for (int j = 0; j < 32; ++j) a += h1[(size_t)t * D + j * 64 + lane] * wcol[(size_t)(j * 64 + lane) * ldw];
                    a = wave_sum(a) + ((o < 4) ? bg[o] : br[o - 4]);
                    if (lane == 0) lg[o] = a;
                }
                WAVE_SYNC();
                float gl[4];
#pragma unroll
                for (int q = 0; q < 4; ++q) gl[q] = lg[q];
                int gi = 0; float gm = gl[0];
#pragma unroll
                for (int q = 1; q < 4; ++q) if (gl[q] > gm) { gm = gl[q]; gi = q; }
                float gs = 0.f;
#pragma unroll
                for (int q = 0; q < 4; ++q) gs += expf(gl[q] - gm);
                const float gweight = 1.f / gs;
                float el[8];
#pragma unroll
                for (int e = 0; e < 8; ++e) el[e] = lg[4 + gi * 8 + e];
                int e1 = 0; float m1 = el[0];
#pragma unroll
                for (int e = 1; e < 8; ++e) if (el[e] > m1) { m1 = el[e]; e1 = e; }
                int e2 = -1; float m2 = -INFINITY;
#pragma unroll
                for (int e = 0; e < 8; ++e) if (e != e1 && el[e] > m2) { m2 = el[e]; e2 = e; }
                const float p2 = expf(m2 - m1), w1 = 1.f / (1.f + p2), w2 = p2 / (1.f + p2);
                if (lane == 0) {
                    const int ge1 = gi * 8 + e1, ge2 = gi * 8 + e2;
                    const int pos1 = atomic_add_int(&cnt[ge1], 1);
                    ltok[ge1 * S + pos1] = t; lw[ge1 * S + pos1] = gweight * w1; lslot[ge1 * S + pos1] = 0;
                    const int pos2 = atomic_add_int(&cnt[ge2], 1);
                    ltok[ge2 * S + pos2] = t; lw[ge2 * S + pos2] = gweight * w2; lslot[ge2 * S + pos2] = 1;
                }
            }
            PH_BAR(pb + 6);
        }
        if (PH_IN(pb + 7)) {
            PHASE_IDS();
            int tile_id = 0, off = 0;
            for (int e = 0; e < NEXP; ++e) {
                const int c = cnt[e];
                const float* wgt = p.in[I_WGATE] + ((size_t)l * NEXP + e) * D * DFF;
                const float* wup = p.in[I_WUP] + ((size_t)l * NEXP + e) * D * DFF;
                const int ntm = (c + 127) / 128;
                for (int t = 0; t < ntm * 4; ++t, ++tile_id) {
                    if (tile_id % G != bid) continue;
                    const int tm = (t / 4) * 128, tn = (t % 4) * 128;
                    gemm_naive_tile(h1, D, RowGather{ltok + e * S, c}, wgt, DFF, DFF, D, tm, tn, ldsf, EpiGate{act, off, c}, tid);
                    gemm_naive_tile(h1, D, RowGather{ltok + e * S, c}, wup, DFF, DFF, D, tm, tn, ldsf, EpiUp{act, lw + e * S, off, c}, tid);
                }
                off += c;
            }
            PH_BAR(pb + 7);
        }
        if (PH_IN(pb + 8)) {
            PHASE_IDS();
            int tile_id = 0, off = 0;
            for (int e = 0; e < NEXP; ++e) {
                const int c = cnt[e];
                const float* wdn = p.in[I_WDOWN] + ((size_t)l * NEXP + e) * DFF * D;
                const int ntm = (c + 127) / 128;
                for (int t = 0; t < ntm * 16; ++t, ++tile_id) {
                    if (tile_id % G != bid) continue;
                    const int tm = (t / 16) * 128, tn = (t % 16) * 128;
                    gemm_naive_tile(act, DFF, RowOff{off, c}, wdn, D, D, DFF, tm, tn, ldsf, EpiDown{contrib, ltok + e * S, lslot + e * S, c}, tid);
                }
                off += c;
            }
            PH_BAR(pb + 8);
        }
        if (PH_IN(pb + 9)) {
            PHASE_IDS();
            const float* g2 = p.in[I_LN2G] + (size_t)l * D; const float* b2 = p.in[I_LN2B] + (size_t)l * D;
            for (int t = gwave; t < S; t += gwaves) {
                float v[32]; float s = 0.f;
#pragma unroll
                for (int j = 0; j < 32; ++j) { const size_t i = (size_t)t * D + j * 64 + lane; v[j] = ALPHA * h1[i] + contrib[i] + contrib[(size_t)S * D + i]; s += v[j]; }
                const float mean = wave_sum(s) * (1.f / D);
                float s2 = 0.f;
#pragma unroll
                for (int j = 0; j < 32; ++j) { v[j] -= mean; s2 += v[j] * v[j]; }
                const float rstd = 1.f / sqrtf(wave_sum(s2) * (1.f / D) + LN_EPS);
#pragma unroll
                for (int j = 0; j < 32; ++j) { const int c = j * 64 + lane; hout[(size_t)t * D + c] = v[j] * rstd * g2[c] + b2[c]; }
            }
            PH_BAR(pb + 9);
        }
    }
#undef PH_IN
#undef PH_BAR
}

#ifndef EMU
extern "C" void kernel_launch(void* const* d_in, const int* in_sizes, int n_in, void* d_out, int out_size, void* d_ws, size_t ws_size, hipStream_t stream) {
    static int grid = 0;
    if (grid == 0) {
        if (n_in != N_INPUTS || out_size != S * D || ws_size < WS_END) {
            fprintf(stderr, "kernel_launch: unexpected shapes: n_in %d out %d ws %zu (need %zu)\n", n_in, out_size, ws_size, (size_t)WS_END); grid = -1; return; }
        int dev = 0, cus = 0, per_cu = 0;
        if (hipGetDevice(&dev) != hipSuccess || hipDeviceGetAttribute(&cus, hipDeviceAttributeMultiprocessorCount, dev) != hipSuccess) { grid = -1; return; }
        if (hipFuncSetAttribute((const void*)fwd_kernel, hipFuncAttributeMaxDynamicSharedMemorySize, LDS_BYTES) != hipSuccess) { fprintf(stderr, "kernel_launch: hipFuncSetAttribute failed\n"); grid = -1; return; }
        if (hipOccupancyMaxActiveBlocksPerMultiprocessor(&per_cu, (const void*)fwd_kernel, NTHREADS, LDS_BYTES) != hipSuccess || per_cu < 1) {
            fprintf(stderr, "kernel_launch: occupancy query says %d blocks per CU\n", per_cu); (void)hipGetLastError(); grid = -1; return; }
        grid = cus;
    }
    if (grid < 0) return;
    (void)hipMemsetAsync(d_ws, 0, CTL_BYTES, stream);
    Params p{};
    for (int i = 0; i < N_INPUTS; ++i) p.in[i] = (const float*)d_in[i];
    p.out = (float*)d_out; p.ws = (unsigned char*)d_ws;
    for (int i = 0; i < 8; ++i) p.inv_freq[i] = (float)pow(500000.0, -(double)i * 2.0 / 16.0);
    const int nph = DEPTH * 10;
#if N_LAUNCH_SPLIT
    for (int k = 0; k < nph; ++k) { p.lo = k; p.hi = k + 1; hipLaunchKernelGGL(fwd_kernel, dim3(grid), dim3(NTHREADS), LDS_BYTES, stream, p); }
#else
    p.lo = 0; p.hi = nph;
    hipLaunchKernelGGL(fwd_kernel, dim3(grid), dim3(NTHREADS), LDS_BYTES, stream, p);
#endif
}
#endif
```

```cpp
#ifndef EMU
#include <hip/hip_runtime.h>
#include <cstdio>
#include <cstdint>
#include <cmath>
#endif

#ifndef SEQ
#define SEQ 8192
#endif
#ifndef N_LAUNCH_SPLIT
#define N_LAUNCH_SPLIT 0
#endif

constexpr int S = SEQ, D = 2048, DEPTH = 2;
constexpr int FOX_H = 6, FOX_W = 768;
constexpr int LRU_W = 768;
constexpr int DIFF_H = 4, DIFF_W = 512;
constexpr int N_IN = 5382, N_INP = 5376;
constexpr int C_FA = 2304;
constexpr int NEXP = 32, DFF = 512;
constexpr int NKT = S / 64;
constexpr float ALPHA = 1.41421356237309504880f;
constexpr float LN_EPS = 1e-5f;
constexpr float LOG2E = 1.4426950408889634f;
constexpr float QSCALE_A = 0.08838834764831845f * 1.4426950408889634f;
constexpr float QSCALE_C = 0.125f * 1.4426950408889634f;

enum { I_X = 0, I_POS, I_WIN, I_BF, I_CONVW, I_CONVB, I_WA, I_BA, I_WI, I_BI, I_LAM, I_LQ1, I_LK1, I_LQ2, I_LK2, I_SUBG, I_WO, I_LN1G, I_LN1B,
       I_WGRP, I_BGRP, I_WRT, I_BRT, I_WGATE, I_WUP, I_WDOWN, I_LN2G, I_LN2B, N_INPUTS };

typedef unsigned short bf16_t;
typedef short bf16x8 __attribute__((ext_vector_type(8)));
typedef float f32x4 __attribute__((ext_vector_type(4)));
typedef unsigned u32x4 __attribute__((ext_vector_type(4)));
typedef unsigned u32x2 __attribute__((ext_vector_type(2)));

constexpr size_t al256(size_t x) { return (x + 255) & ~(size_t)255; }
constexpr size_t CTL_BYTES = 65536;
constexpr size_t CTL_CNT_OFF = 32768;
constexpr size_t CTL_WORK_OFF = 36864;
constexpr size_t WB_WIN = CTL_BYTES;
constexpr size_t WB_WO = WB_WIN + al256((size_t)DEPTH * N_INP * D * 2);
constexpr size_t WB_WGU = WB_WO + al256((size_t)DEPTH * D * D * 2);
constexpr size_t WB_WD = WB_WGU + al256((size_t)DEPTH * NEXP * 1024 * D * 2);
constexpr size_t WB_WAI = WB_WD + al256((size_t)DEPTH * NEXP * D * DFF * 2);
constexpr size_t WF_FA = WB_WAI + al256((size_t)DEPTH * 6 * 256 * 128 * 2);
constexpr size_t WF_R36 = WF_FA + al256((size_t)DEPTH * 8 * D * 4);
constexpr size_t WF_ROPE = WF_R36 + al256((size_t)DEPTH * 40 * D * 4);
constexpr size_t A_XB = WF_ROPE + al256((size_t)S * 16 * 4);
constexpr size_t A_HB = A_XB + al256((size_t)S * D * 2);
constexpr size_t A_LOGF = A_HB + al256((size_t)S * D * 4);
constexpr size_t A_CUM = A_LOGF + al256((size_t)6 * S * 4);
constexpr size_t A_QA = A_CUM + al256((size_t)6 * S * 4);
constexpr size_t A_KA = A_QA + al256((size_t)FOX_H * S * 128 * 2);
constexpr size_t A_VAT = A_KA + al256((size_t)FOX_H * S * 128 * 2);
constexpr size_t A_XR = A_VAT + al256((size_t)FOX_H * S * 128 * 2);
constexpr size_t A_GR = A_XR + al256((size_t)S * LRU_W * 2);
constexpr size_t A_QC = A_GR + al256((size_t)S * LRU_W * 2);
constexpr size_t A_KC = A_QC + al256((size_t)DIFF_H * S * 128 * 2);
constexpr size_t A_VCT = A_KC + al256((size_t)DIFF_H * S * 128 * 2);
constexpr size_t A_HLOC = A_VCT + al256((size_t)DIFF_H * S * 128 * 2);
constexpr size_t A_PLOC = A_HLOC + al256((size_t)S * LRU_W * 4);
constexpr size_t A_SUMA = A_PLOC + al256((size_t)S * LRU_W * 4);
constexpr size_t A_SUMH = A_SUMA + al256((size_t)NKT * LRU_W * 4);
constexpr size_t A_CONCAT = A_SUMH + al256((size_t)NKT * LRU_W * 4);
constexpr size_t A_Y1 = A_CONCAT + al256((size_t)S * D * 2);
constexpr size_t A_H1 = A_Y1 + al256((size_t)S * D * 4);
constexpr size_t A_H1B = A_H1 + al256((size_t)S * D * 4);
constexpr size_t A_LTOK = A_H1B + al256((size_t)S * D * 2);
constexpr size_t A_LW = A_LTOK + al256((size_t)NEXP * S * 4);
constexpr size_t A_LSLOT = A_LW + al256((size_t)NEXP * S * 4);
constexpr size_t A_ACT = A_LSLOT + al256((size_t)NEXP * S * 4);
constexpr size_t A_CONTRIB = A_ACT + al256((size_t)(2 * S + 256) * DFF * 2);
constexpr size_t WS_END = A_CONTRIB + al256((size_t)2 * S * D * 4);

constexpr int NTHREADS = 512;
constexpr int LDS_MAIN = 131072;
constexpr int LDS_MISC = LDS_MAIN;
constexpr int LDS_BYTES = LDS_MAIN + 4096;

struct Params {
    const float* in[N_INPUTS];
    float* out;
    unsigned char* ws;
    float inv_freq[8];
    int lo, hi;
};

#ifndef EMU
#define LAS __attribute__((address_space(3)))
#define DYN_LDS(name) extern __shared__ __attribute__((aligned(16))) unsigned char name[]
#define SLEEP1() __builtin_amdgcn_s_sleep(1)
#define WAVE_SYNC() __builtin_amdgcn_wave_barrier()
#define OPAQUE(x) asm volatile("" : "+v"(x))
#define COMPILER_FENCE() asm volatile("" ::: "memory")
#define RFL(x) __builtin_amdgcn_readfirstlane(x)
__device__ __forceinline__ int lane_id_volatile() { int l; asm volatile("v_mbcnt_lo_u32_b32 %0, -1, 0\n\tv_mbcnt_hi_u32_b32 %0, -1, %0" : "=v"(l)); return l; }
#define LANE_ID() lane_id_volatile()
#define OPAQUE_S(x) asm volatile("" : "+s"(x))
#define WAIT_VM0() asm volatile("s_waitcnt vmcnt(0)" ::: "memory")
#define WAIT_ALL0() __builtin_amdgcn_s_waitcnt(0)
#define FENCE_REL_AGENT() __builtin_amdgcn_fence(__ATOMIC_RELEASE, "agent")
#define FENCE_ACQ_AGENT() __builtin_amdgcn_fence(__ATOMIC_ACQUIRE, "agent")
#define MFMA16(a, b, c) __builtin_amdgcn_mfma_f32_16x16x32_bf16(a, b, c, 0, 0, 0)
#define GLDS16(g, l) __builtin_amdgcn_global_load_lds((const unsigned*)(g), (unsigned*)(l), 16, 0, 0)
#define WAIT_V(n) asm volatile("s_waitcnt vmcnt(" #n ")" ::: "memory")
#define WAIT_L(n) asm volatile("s_waitcnt lgkmcnt(" #n ")" ::: "memory")
#define BAR() __builtin_amdgcn_s_barrier()
#define SCHED() __builtin_amdgcn_sched_barrier(0)
#define SETPRIO(n) __builtin_amdgcn_s_setprio(n)
#define FAST_EXP2(x) __builtin_amdgcn_exp2f(x)
#define FAST_LOG2(x) __builtin_amdgcn_logf(x)
#define FAST_RCP(x) __builtin_amdgcn_rcpf(x)
__device__ __forceinline__ unsigned xb_ld(unsigned* p)              { return __hip_atomic_load(p, __ATOMIC_RELAXED, __HIP_MEMORY_SCOPE_AGENT); }
__device__ __forceinline__ unsigned xb_add(unsigned* p, unsigned v) { return __hip_atomic_fetch_add(p, v, __ATOMIC_RELAXED, __HIP_MEMORY_SCOPE_AGENT); }
__device__ __forceinline__ unsigned xb_xcc_id() { return (unsigned)__builtin_amdgcn_s_getreg((3 << 11) | 20) & 0xFu; }
__device__ __forceinline__ int atomic_add_int(int* p, int v) { return atomicAdd(p, v); }
__device__ __forceinline__ unsigned pack2(float lo, float hi) { unsigned r; asm volatile("v_cvt_pk_bf16_f32 %0, %1, %2" : "=v"(r) : "v"(lo), "v"(hi)); return r; }
#else
#define MFMA16(a, b, c) emu_mfma_16x16x32_bf16(a, b, c)
#define GLDS16(g, l) emu_glds16((const void*)(g), (void*)(l))
#define WAIT_V(n) ((void)0)
#define WAIT_L(n) ((void)0)
#define BAR() __syncthreads()
#define SCHED() ((void)0)
#define SETPRIO(n) ((void)0)
#define FAST_EXP2(x) exp2f(x)
#define FAST_LOG2(x) log2f(x)
#define FAST_RCP(x) (1.f / (x))
static inline unsigned pack2(float lo, float hi) {
    unsigned a = __builtin_bit_cast(unsigned, lo), b = __builtin_bit_cast(unsigned, hi);
    a += 0x7fffu + ((a >> 16) & 1u); b += 0x7fffu + ((b >> 16) & 1u);
    return (a >> 16) | (b & 0xffff0000u);
}
#endif
__device__ __forceinline__ bf16_t f2bf(float f) { return (bf16_t)(pack2(f, 0.f) & 0xffffu); }
__device__ __forceinline__ float bf2f(bf16_t h) { return __builtin_bit_cast(float, (unsigned)h << 16); }

#define XB_TMO      128
#define XB_XCNT(j)  (256  + 64 * (j))
#define XB_XSUB(j)  (1280 + 64 * (j))
#define XB_XGEN(j)  (2304 + 64 * (j))
#define XB_TOP      3328
#define XB_TOPGEN   3392
#define XCD_BAR_WORDS 3456
#define XB_SPIN_CAP (1u << 22)
#define XB_SPIN(cond, bar) do { unsigned _sp = 0; while (cond) { SLEEP1(); \
    if ((++_sp & 255u) == 0u) { if (xb_ld(&(bar)[XB_TMO])) break; if (_sp > XB_SPIN_CAP) { xb_add(&(bar)[XB_TMO], 1u); break; } } } } while (0)

struct XcdBarrier { unsigned* bar; unsigned x; volatile LAS unsigned* st; };

__device__ __forceinline__ XcdBarrier xcd_barrier_post(unsigned* bar, volatile LAS unsigned* st) {
    XcdBarrier b; b.bar = bar; b.x = xb_xcc_id(); b.st = st;
    if (threadIdx.x == 0) (void)xb_add(&bar[XB_XCNT(b.x)], 1u);
    return b;
}
__device__ __forceinline__ void xcd_barrier_complete(unsigned* bar, unsigned x, unsigned& nloc, unsigned& nx) {
    const unsigned G = gridDim.x;
    unsigned sum, cnt, mine, sp = 0u;
    for (;;) {
        sum = 0u; cnt = 0u; mine = 0u;
#pragma unroll
        for (unsigned j = 0; j < 16; ++j) { const unsigned c = xb_ld(&bar[XB_XCNT(j)]); sum += c; cnt += (c > 0u) ? 1u : 0u; mine = (j == x) ? c : mine; }
        if (sum == G) break;
        SLEEP1();
        if ((++sp & 255u) == 0u) { if (xb_ld(&bar[XB_TMO])) break; if (sp > XB_SPIN_CAP) { xb_add(&bar[XB_TMO], 1u); break; } }
    }
    nloc = mine > 0u ? mine : 1u; nx = cnt > 0u ? cnt : 1u;
}
__device__ __forceinline__ void xcd_barrier(const XcdBarrier& b, bool leader) {
    WAIT_VM0();
    __syncthreads();
    if (leader) {
        unsigned* bar = b.bar;
        WAIT_ALL0();
        unsigned nloc = b.st[0], nx = b.st[1];
        if (nloc == 0u) { xcd_barrier_complete(bar, b.x, nloc, nx); b.st[0] = nloc; b.st[1] = nx; }
        const unsigned old = xb_add(&bar[XB_XSUB(b.x)], 1u);
        const unsigned gen = old / nloc;
        if (old + 1u == (gen + 1u) * nloc) {
            FENCE_REL_AGENT();
            WAIT_VM0();
            const unsigned og = xb_add(&bar[XB_TOP], 1u);
            const unsigned tg = og / nx;
            if (og + 1u == (tg + 1u) * nx) xb_add(&bar[XB_TOPGEN], 1u);
            else XB_SPIN(xb_ld(&bar[XB_TOPGEN]) == tg, bar);
            FENCE_ACQ_AGENT();
            xb_add(&bar[XB_XGEN(b.x)], 1u);
            WAIT_VM0();
        } else {
            XB_SPIN(xb_ld(&bar[XB_XGEN(b.x)]) == gen, bar);
            FENCE_ACQ_AGENT();
            WAIT_VM0();
        }
    }
    __syncthreads();
}

__device__ __forceinline__ float wave_sum(float v) {
#pragma unroll
    for (int o = 1; o < 64; o <<= 1) v += __shfl_xor(v, o);
    return v;
}
__device__ __forceinline__ float fexp(float x) { return FAST_EXP2(x * LOG2E); }
__device__ __forceinline__ float sigmoid_f(float x) { return FAST_RCP(1.f + fexp(-x)); }
__device__ __forceinline__ float log_sigmoid_f(float x) { return fminf(x, 0.f) - 0.6931471805599453f * FAST_LOG2(1.f + fexp(-fabsf(x))); }
__device__ __forceinline__ float gelu_tanh_f(float x) { const float u = 0.7978845608028654f * (x + 0.044715f * x * x * x); return x * FAST_RCP(1.f + fexp(-2.f * u)); }
__device__ __forceinline__ float silu_f(float x) { return x * FAST_RCP(1.f + fexp(-x)); }
__device__ __forceinline__ float neg_expm1_f(float x) {
    const float ser = -x * (1.f + x * (0.5f + x * (0.16666667f + x * (0.041666668f + x * (0.008333334f + x * 0.0013888889f)))));
    return (x > -0.35f) ? ser : (1.f - fexp(x));
}

struct RmIdent { __device__ __forceinline__ int operator()(int n) const { return n; } };
struct RmWin { __device__ __forceinline__ int operator()(int n) const { return n < C_FA ? n : (n < C_FA + 6 ? -1 : n - 6); } };
struct RmGu { int kind; __device__ __forceinline__ int operator()(int f) const { return (f >> 7) * 256 + ((f >> 6) & 1) * 128 + ((f >> 4) & 3) * 32 + kind * 16 + (f & 15); } };
struct RmOff { int off; __device__ __forceinline__ int operator()(int n) const { return n + off; } };

template <class RM>
__device__ __forceinline__ void convert_tile(const float* src, int ld, int K, int Nsrc, int k0, int n0, bf16_t* dst, const RM& rm, float* T, int tid) {
#pragma unroll
    for (int p = 0; p < 8; ++p) {
        const int kk = (tid >> 6) + 8 * p, nn = tid & 63, n = n0 + nn;
        T[kk * 65 + nn] = (n < Nsrc) ? src[(size_t)(k0 + kk) * ld + n] : 0.f;
    }
    __syncthreads();
    {
        const int nn = tid >> 3, kc = (tid & 7) * 8, n = n0 + nn;
        const int row = (n < Nsrc) ? rm(n) : -1;
        if (row >= 0) {
            u32x4 o;
            o.x = pack2(T[(kc + 0) * 65 + nn], T[(kc + 1) * 65 + nn]); o.y = pack2(T[(kc + 2) * 65 + nn], T[(kc + 3) * 65 + nn]);
            o.z = pack2(T[(kc + 4) * 65 + nn], T[(kc + 5) * 65 + nn]); o.w = pack2(T[(kc + 6) * 65 + nn], T[(kc + 7) * 65 + nn]);
            *(u32x4*)(dst + (size_t)row * K + k0 + kc) = o;
        }
    }
    __syncthreads();
}
template <class RM>
__device__ __forceinline__ void convert_mats(const float* src, size_t sstride, int nmat, int ld, int K, int Nsrc, bf16_t* dst, size_t dstride, const RM& rm,
                                             float* T, int tid, int bid, int G) {
    const int tk = K / 64, tn = (Nsrc + 63) / 64, per = tk * tn, total = nmat * per;
    for (int t = bid; t < total; t += G) {
        const int mi = t / per, r = t % per;
        convert_tile(src + (size_t)mi * sstride, ld, K, Nsrc, (r / tn) * 64, (r % tn) * 64, dst + (size_t)mi * dstride, rm, T, tid);
    }
}

constexpr int BK = 64, HTB = 128 * 64 * 2;
__device__ __forceinline__ int lds_byte(int r, int c) {
    const int st = (r >> 4) * 2 + (c >> 5), rr = r & 15, cc = c & 31, ob = rr * 64 + cc * 2;
    return st * 1024 + (ob ^ (((ob >> 9) & 1) << 5));
}
__device__ __forceinline__ void stage_rc(int b, int& R, int& C) {
    const int st = b / 1024, sb = b % 1024, swz = sb ^ (((sb >> 9) & 1) << 5);
    R = (st >> 1) * 16 + swz / 64; C = (st & 1) * 32 + (swz % 64) / 2;
}
template <bool GATHER>
__device__ __forceinline__ void gemm_tile(const bf16_t* A, int arow0, const unsigned (&aoff)[2][2], const bf16_t* Bt, int brow0, int K,
                                          unsigned char* shm, f32x4 (&acc)[2][2][4][2], int tid_in) {
    int tid = tid_in; OPAQUE(tid);
    unsigned toff; { int R0, C0; stage_rc(tid * 16, R0, C0); toff = (unsigned)(R0 * K + C0); }
#define SA(b, h) (shm + ((b) * 2 + (h)) * HTB)
#define SB(b, h) (shm + (4 + (b) * 2 + (h)) * HTB)
#define STAGE_B(P, h, kt) do { _Pragma("unroll") for (int _i = 0; _i < 2; ++_i) GLDS16(Bt + ((size_t)(brow0 + (h) * 128 + _i * 64) * K + (size_t)(kt) * BK) + toff, (P) + tid * 16 + _i * 8192); } while (0)
#define STAGE_A(P, h, kt) do { _Pragma("unroll") for (int _i = 0; _i < 2; ++_i) { \
    if (GATHER) GLDS16(A + (size_t)(kt) * BK + aoff[h][_i], (P) + tid * 16 + _i * 8192); \
    else GLDS16(A + ((size_t)(arow0 + (h) * 128 + _i * 64) * K + (size_t)(kt) * BK) + toff, (P) + tid * 16 + _i * 8192); } } while (0)
#define LDA(dst, b, h) _Pragma("unroll") for (int m = 0; m < 4; ++m) _Pragma("unroll") for (int k = 0; k < 2; ++k) \
    dst[m][k] = *reinterpret_cast<const bf16x8*>(SA(b, h) + lds_byte(wr * 64 + m * 16 + fr, k * 32 + fq * 8))
#define LDB(dst, b, h) _Pragma("unroll") for (int n = 0; n < 2; ++n) _Pragma("unroll") for (int k = 0; k < 2; ++k) \
    dst[n][k] = *reinterpret_cast<const bf16x8*>(SB(b, h) + lds_byte(wc * 32 + n * 16 + fr, k * 32 + fq * 8))
#define MMA(ai, bj, At, Bx) do { SETPRIO(1); \
    _Pragma("unroll") for (int m = 0; m < 4; ++m) _Pragma("unroll") for (int n = 0; n < 2; ++n) _Pragma("unroll") for (int k = 0; k < 2; ++k) \
      acc[ai][bj][m][n] = MFMA16(At[m][k], Bx[n][k], acc[ai][bj][m][n]); \
    SETPRIO(0); } while (0)
    int wid = tid >> 6, lane = tid & 63, wr = wid >> 2, wc = wid & 3, fr = lane & 15, fq = lane >> 4;
#pragma unroll
    for (int a = 0; a < 2; ++a)
#pragma unroll
        for (int b = 0; b < 2; ++b)
#pragma unroll
            for (int m = 0; m < 4; ++m)
#pragma unroll
                for (int n = 0; n < 2; ++n) acc[a][b][m][n] = (f32x4){0.f, 0.f, 0.f, 0.f};
    bf16x8 At[4][2], B0[2][2], B1[2][2];
    const int nt = K / BK;
    STAGE_B(SB(0, 0), 0, 0); STAGE_A(SA(0, 0), 0, 0);
    STAGE_B(SB(0, 1), 1, 0); STAGE_A(SA(0, 1), 1, 0);
    if (wr == 1) BAR();
    WAIT_V(4); BAR();
    STAGE_B(SB(1, 0), 0, 1); STAGE_A(SA(1, 0), 0, 1); STAGE_B(SB(1, 1), 1, 1);
    WAIT_V(6); BAR();
    for (int t = 0; t < nt - 2; t += 2) {
        LDB(B0, 0, 0); SCHED(); LDA(At, 0, 0); STAGE_A(SA(1, 1), 1, t + 1);
        WAIT_L(8); BAR(); WAIT_L(0); MMA(0, 0, At, B0); BAR(); SCHED();
        LDB(B1, 0, 1); STAGE_B(SB(0, 0), 0, t + 2);
        BAR(); WAIT_L(0); MMA(0, 1, At, B1); BAR();
        LDA(At, 0, 1); STAGE_A(SA(0, 0), 0, t + 2);
        BAR(); WAIT_L(0); MMA(1, 0, At, B0); BAR(); SCHED();
        STAGE_B(SB(0, 1), 1, t + 2);
        WAIT_V(6); BAR(); MMA(1, 1, At, B1); BAR();
        LDB(B0, 1, 0); SCHED(); LDA(At, 1, 0); STAGE_A(SA(0, 1), 1, t + 2);
        WAIT_L(8); BAR(); WAIT_L(0); MMA(0, 0, At, B0); BAR(); SCHED();
        LDB(B1, 1, 1); STAGE_B(SB(1, 0), 0, t + 3);
        BAR(); WAIT_L(0); MMA(0, 1, At, B1); BAR();
        LDA(At, 1, 1); STAGE_A(SA(1, 0), 0, t + 3);
        BAR(); WAIT_L(0); MMA(1, 0, At, B0); BAR(); SCHED();
        STAGE_B(SB(1, 1), 1, t + 3);
        WAIT_V(6); BAR(); MMA(1, 1, At, B1); BAR();
    }
    OPAQUE(tid); wid = tid >> 6; lane = tid & 63; wr = wid >> 2; wc = wid & 3; fr = lane & 15; fq = lane >> 4;
    { LDB(B0, 0, 0); WAIT_V(0); LDA(At, 0, 0); STAGE_A(SA(1, 1), 1, nt - 1);
      BAR(); WAIT_L(0); MMA(0, 0, At, B0); BAR();
      LDB(B1, 0, 1); BAR(); WAIT_L(0); MMA(0, 1, At, B1); BAR();
      LDA(At, 0, 1); WAIT_V(4); BAR(); WAIT_L(0); MMA(1, 0, At, B0); MMA(1, 1, At, B1); BAR(); }
    { LDB(B0, 1, 0); LDA(At, 1, 0); WAIT_V(2); BAR(); WAIT_L(0); MMA(0, 0, At, B0); BAR();
      LDB(B1, 1, 1); WAIT_V(0); BAR(); WAIT_L(0); MMA(0, 1, At, B1); BAR();
      LDA(At, 1, 1); BAR(); WAIT_L(0); MMA(1, 0, At, B0); MMA(1, 1, At, B1); BAR(); }
    if (wr == 0) BAR();
#undef SA
#undef SB
#undef STAGE_A
#undef STAGE_B
#undef LDA
#undef LDB
#undef MMA
}
__device__ __forceinline__ void stage_geom(int tid, int (&R)[2], int (&C)[2]) {
#pragma unroll
    for (int i = 0; i < 2; ++i) stage_rc(tid * 16 + i * 8192, R[i], C[i]);
}

constexpr int ATT_KBUF = 0, ATT_VBUF = 32768, ATT_CBUF = 65536;
template <int KIND>
__device__ __forceinline__ void attn_unit(const bf16_t* Q, const bf16_t* Kg, const bf16_t* VT, const float* cum2, int qb, bf16_t* concat, int ccol0,
                                          float lam, float osc, const float* subg, unsigned char* lds, int tid) {
    const int lane = tid & 63, wave = tid >> 6, r16 = lane & 15, q4 = lane >> 4;
    const int q0w = qb * 128 + wave * 16, myq = q0w + r16;
    const int ntiles = 2 * qb + 2;
    const int wlimit = (KIND == 0) ? ((q0w + 15) >> 6) : (q0w >> 6);
    constexpr int NMAP = (KIND == 0) ? 1 : 2, NKS = (KIND == 0) ? 4 : 2;
    bf16x8 qf[NMAP][NKS];
#pragma unroll
    for (int mp = 0; mp < NMAP; ++mp)
#pragma unroll
        for (int ks = 0; ks < NKS; ++ks) qf[mp][ks] = *(const bf16x8*)(Q + (size_t)myq * 128 + mp * 64 + ks * 32 + q4 * 8);
    const float cq = (KIND == 0) ? cum2[myq] : 0.f;
    f32x4 ot[NMAP][8];
    float mrun[NMAP], lsum[NMAP];
#pragma unroll
    for (int mp = 0; mp < NMAP; ++mp) { mrun[mp] = -INFINITY; lsum[mp] = 0.f;
#pragma unroll
        for (int mo = 0; mo < 8; ++mo) ot[mp][mo] = (f32x4){0.f, 0.f, 0.f, 0.f}; }
    u32x4 sk[2], sv[2]; float sc = 0.f;
    const u32x4* kg = (const u32x4*)Kg; const u32x4* vg = (const u32x4*)VT;
#pragma unroll
    for (int i = 0; i < 2; ++i) { sk[i] = kg[tid + i * 512]; sv[i] = vg[tid + i * 512]; }
    if (KIND == 0 && tid < 64) sc = cum2[tid];
    for (int kt = 0; kt < ntiles; ++kt) {
        unsigned char* kb = lds + ATT_KBUF + (kt & 1) * 16384;
        unsigned char* vb = lds + ATT_VBUF + (kt & 1) * 16384;
        float* cb = (float*)(lds + ATT_CBUF + (kt & 1) * 256);
#pragma unroll
        for (int i = 0; i < 2; ++i) {
            const int g = tid + i * 512;
            { const int row = g >> 4, c = g & 15; *(u32x4*)(kb + row * 256 + ((c ^ (row & 15)) << 4)) = sk[i]; }
            { const int d = g >> 3, c = g & 7; *(u32x4*)(vb + d * 128 + ((c ^ ((d >> 1) & 7)) << 4)) = sv[i]; }
        }
        if (KIND == 0 && tid < 64) cb[tid] = sc;
        __syncthreads();
        if (kt + 1 < ntiles) {
#pragma unroll
            for (int i = 0; i < 2; ++i) { sk[i] = kg[(size_t)(kt + 1) * 1024 + tid + i * 512]; sv[i] = vg[(size_t)(kt + 1) * 1024 + tid + i * 512]; }
            if (KIND == 0 && tid < 64) sc = cum2[(kt + 1) * 64 + tid];
        }
        if (kt <= wlimit) {
#pragma unroll
            for (int mp = 0; mp < NMAP; ++mp) {
                f32x4 st[4];
#pragma unroll
                for (int m = 0; m < 4; ++m) {
                    st[m] = (f32x4){0.f, 0.f, 0.f, 0.f};
#pragma unroll
                    for (int ks = 0; ks < NKS; ++ks) {
                        const int c = (KIND == 0 ? 0 : mp * 8) + ks * 4 + q4;
                        const bf16x8 kf = *(const bf16x8*)(kb + (m * 16 + r16) * 256 + ((c ^ r16) << 4));
                        st[m] = MFMA16(kf, qf[mp][ks], st[m]);
                    }
                }
                float mx = -INFINITY;
#pragma unroll
                for (int m = 0; m < 4; ++m) {
                    if (KIND == 0) {
                        const f32x4 ck = *(const f32x4*)(cb + m * 16 + 4 * q4);
#pragma unroll
                        for (int j = 0; j < 4; ++j) {
                            float y = st[m][j] + (cq - ck[j]);
                            if (kt * 64 + m * 16 + 4 * q4 + j > myq) y = -INFINITY;
                            st[m][j] = y;
                        }
                    }
#pragma unroll
                    for (int j = 0; j < 4; ++j) mx = fmaxf(mx, st[m][j]);
                }
                mx = fmaxf(mx, __shfl_xor(mx, 16));
                mx = fmaxf(mx, __shfl_xor(mx, 32));
                const float mnew = fmaxf(mrun[mp], mx);
                const float alpha = FAST_EXP2(mrun[mp] - mnew);
                mrun[mp] = mnew;
                float ps = 0.f;
#pragma unroll
                for (int m = 0; m < 4; ++m)
#pragma unroll
                    for (int j = 0; j < 4; ++j) { const float pv = FAST_EXP2(st[m][j] - mnew); st[m][j] = pv; ps += pv; }
                lsum[mp] = lsum[mp] * alpha + ps;
#pragma unroll
                for (int mo = 0; mo < 8; ++mo) ot[mp][mo] *= alpha;
#pragma unroll
                for (int kk = 0; kk < 2; ++kk) {
                    u32x4 pw;
                    pw.x = pack2(st[2 * kk][0], st[2 * kk][1]); pw.y = pack2(st[2 * kk][2], st[2 * kk][3]);
                    pw.z = pack2(st[2 * kk + 1][0], st[2 * kk + 1][1]); pw.w = pack2(st[2 * kk + 1][2], st[2 * kk + 1][3]);
                    const bf16x8 pf = __builtin_bit_cast(bf16x8, pw);
#pragma unroll
                    for (int mo = 0; mo < 8; ++mo) {
                        const int d = mo * 16 + r16, sw = (d >> 1) & 7;
                        const unsigned char* rowp = vb + d * 128 + (q4 & 1) * 8;
                        u32x4 vw;
                        const u32x2 lo = *(const u32x2*)(rowp + (((kk * 4 + (q4 >> 1)) ^ sw) << 4));
                        const u32x2 hi = *(const u32x2*)(rowp + (((kk * 4 + 2 + (q4 >> 1)) ^ sw) << 4));
                        vw.x = lo.x; vw.y = lo.y; vw.z = hi.x; vw.w = hi.y;
                        ot[mp][mo] = MFMA16(__builtin_bit_cast(bf16x8, vw), pf, ot[mp][mo]);
                    }
                }
            }
        }
    }
    float inv[NMAP];
#pragma unroll
    for (int mp = 0; mp < NMAP; ++mp) { float l = lsum[mp]; l += __shfl_xor(l, 16); l += __shfl_xor(l, 32); inv[mp] = 1.f / l; }
    if (KIND == 0) {
#pragma unroll
        for (int mo = 0; mo < 8; ++mo) {
            u32x2 o; o.x = pack2(ot[0][mo][0] * inv[0], ot[0][mo][1] * inv[0]); o.y = pack2(ot[0][mo][2] * inv[0], ot[0][mo][3] * inv[0]);
            *(u32x2*)(concat + (size_t)myq * D + ccol0 + mo * 16 + 4 * q4) = o;
        }
    } else {
        float ss = 0.f;
#pragma unroll
        for (int mo = 0; mo < 8; ++mo)
#pragma unroll
            for (int j = 0; j < 4; ++j) { const float v = ot[0][mo][j] * inv[0] - lam * (ot[NMAP - 1][mo][j] * inv[NMAP - 1]); ot[0][mo][j] = v; ss += v * v; }
        ss += __shfl_xor(ss, 16); ss += __shfl_xor(ss, 32);
        const float rs = osc / sqrtf(ss * (1.f / 128.f) + LN_EPS);
#pragma unroll
        for (int mo = 0; mo < 8; ++mo) {
            const f32x4 g = *(const f32x4*)(subg + mo * 16 + 4 * q4);
            u32x2 o; o.x = pack2(ot[0][mo][0] * rs * g[0], ot[0][mo][1] * rs * g[1]); o.y = pack2(ot[0][mo][2] * rs * g[2], ot[0][mo][3] * rs * g[3]);
            *(u32x2*)(concat + (size_t)myq * D + ccol0 + mo * 16 + 4 * q4) = o;
        }
    }
    __syncthreads();
}

__device__ __forceinline__ void lru_unit_a(int chunk, int grp, int l, const Params& p, const bf16_t* Xr, const bf16_t* WaiT, float* hloc, float* ploc, float* sumA, float* sumH,
                                           unsigned char* lds, int tid) {
    const int lane = tid & 63, wave = tid >> 6, r16 = lane & 15, q4 = lane >> 4;
    unsigned char* XCB = lds; float* XU = (float*)(lds + 16384); float* LA = (float*)(lds + 49152); float* ENDS = (float*)(lds + 81920);
    const int t0 = chunk * 64, ch0 = grp * 128;
    {
        const int c = tid & 127, tq = tid >> 7, ch = ch0 + c;
        const float* cw = p.in[I_CONVW] + (size_t)l * 4 * LRU_W + ch; const float cb = p.in[I_CONVB][(size_t)l * LRU_W + ch];
        const float w0 = cw[0], w1 = cw[LRU_W], w2 = cw[2 * LRU_W], w3 = cw[3 * LRU_W];
        const int ts = t0 + tq * 16;
        float x0 = (ts - 3 >= 0) ? bf2f(Xr[(size_t)(ts - 3) * LRU_W + ch]) : 0.f;
        float x1 = (ts - 2 >= 0) ? bf2f(Xr[(size_t)(ts - 2) * LRU_W + ch]) : 0.f;
        float x2 = (ts - 1 >= 0) ? bf2f(Xr[(size_t)(ts - 1) * LRU_W + ch]) : 0.f;
#pragma unroll
        for (int i = 0; i < 16; ++i) {
            const float x3 = bf2f(Xr[(size_t)(ts + i) * LRU_W + ch]);
            const float v = cb + w0 * x0 + w1 * x1 + w2 * x2 + w3 * x3;
            const int row = tq * 16 + i;
            XU[row * 128 + c] = v;
            *(bf16_t*)(XCB + row * 256 + (((c >> 3) ^ (row & 15)) << 4) + (c & 7) * 2) = f2bf(v);
            x0 = x1; x1 = x2; x2 = x3;
        }
    }
    __syncthreads();
    {
        bf16x8 bfr[2][4];
#pragma unroll
        for (int g = 0; g < 2; ++g)
#pragma unroll
            for (int ks = 0; ks < 4; ++ks) bfr[g][ks] = *(const bf16x8*)(WaiT + ((size_t)grp * 256 + g * 128 + wave * 16 + r16) * 128 + ks * 32 + q4 * 8);
        const int ch = ch0 + wave * 16 + r16;
        const float ba = p.in[I_BA][(size_t)l * LRU_W + ch], bi = p.in[I_BI][(size_t)l * LRU_W + ch];
        const float lsl = 8.0f * log_sigmoid_f(p.in[I_LAM][(size_t)l * LRU_W + ch]);
#pragma unroll
        for (int mt = 0; mt < 4; ++mt) {
            f32x4 ga = (f32x4){0.f, 0.f, 0.f, 0.f}, gi = (f32x4){0.f, 0.f, 0.f, 0.f};
#pragma unroll
            for (int ks = 0; ks < 4; ++ks) {
                const bf16x8 af = *(const bf16x8*)(XCB + (mt * 16 + r16) * 256 + (((ks * 4 + q4) ^ r16) << 4));
                ga = MFMA16(af, bfr[0][ks], ga); gi = MFMA16(af, bfr[1][ks], gi);
            }
#pragma unroll
            for (int j = 0; j < 4; ++j) {
                const int row = mt * 16 + 4 * q4 + j, idx = row * 128 + wave * 16 + r16;
                const float r = sigmoid_f(ga[j] + ba), ig = sigmoid_f(gi[j] + bi);
                const float log_a = lsl * r;
                LA[idx] = fexp(log_a);
                XU[idx] = sqrtf(neg_expm1_f(2.f * log_a)) * (ig * XU[idx]);
            }
        }
    }
    __syncthreads();
    {
        const int c = tid & 127, tq = tid >> 7, ch = ch0 + c;
        float h = 0.f, P = 1.f;
#pragma unroll
        for (int i = 0; i < 16; ++i) { const int idx = (tq * 16 + i) * 128 + c; const float a = LA[idx]; h = a * h + XU[idx]; P *= a; XU[idx] = h; LA[idx] = P; }
        ENDS[tq * 128 + c] = P; ENDS[512 + tq * 128 + c] = h;
        __syncthreads();
        float cin = 0.f, pin = 1.f;
        for (int s = 0; s < tq; ++s) { const float Ps = ENDS[s * 128 + c], hs = ENDS[512 + s * 128 + c]; cin = Ps * cin + hs; pin *= Ps; }
#pragma unroll
        for (int i = 0; i < 16; ++i) {
            const int idx = (tq * 16 + i) * 128 + c; const size_t gi = (size_t)(t0 + tq * 16 + i) * LRU_W + ch;
            const float Pl = LA[idx], hl = XU[idx];
            hloc[gi] = hl + Pl * cin; ploc[gi] = Pl * pin;
        }
        if (tq == 3) { const float Pl = LA[63 * 128 + c], hl = XU[63 * 128 + c]; sumA[(size_t)chunk * LRU_W + ch] = Pl * pin; sumH[(size_t)chunk * LRU_W + ch] = hl + Pl * cin; }
    }
    __syncthreads();
}

#define WinT ((bf16_t*)(wsl + WB_WIN))
#define WoT ((bf16_t*)(wsl + WB_WO))
#define WguT ((bf16_t*)(wsl + WB_WGU))
#define WdT ((bf16_t*)(wsl + WB_WD))
#define WaiT ((bf16_t*)(wsl + WB_WAI))
#define Wfa ((float*)(wsl + WF_FA))
#define Wr36 ((float*)(wsl + WF_R36))
#define ropecs ((float*)(wsl + WF_ROPE))
#define xb ((bf16_t*)(wsl + A_XB))
#define hb ((float*)(wsl + A_HB))
#define logf_ ((float*)(wsl + A_LOGF))
#define cum2 ((float*)(wsl + A_CUM))
#define Qa ((bf16_t*)(wsl + A_QA))
#define Ka ((bf16_t*)(wsl + A_KA))
#define VaT ((bf16_t*)(wsl + A_VAT))
#define Xr ((bf16_t*)(wsl + A_XR))
#define Gr ((bf16_t*)(wsl + A_GR))
#define Qc ((bf16_t*)(wsl + A_QC))
#define Kc ((bf16_t*)(wsl + A_KC))
#define VcT ((bf16_t*)(wsl + A_VCT))
#define hloc ((float*)(wsl + A_HLOC))
#define ploc ((float*)(wsl + A_PLOC))
#define sumA ((float*)(wsl + A_SUMA))
#define sumH ((float*)(wsl + A_SUMH))
#define concat ((bf16_t*)(wsl + A_CONCAT))
#define y1 ((float*)(wsl + A_Y1))
#define h1 ((float*)(wsl + A_H1))
#define h1b ((bf16_t*)(wsl + A_H1B))
#define ltok ((int*)(wsl + A_LTOK))
#define lw ((float*)(wsl + A_LW))
#define lslot ((int*)(wsl + A_LSLOT))
#define act ((bf16_t*)(wsl + A_ACT))
#define contrib ((float*)(wsl + A_CONTRIB))
#ifndef EMU
__global__ void __launch_bounds__(NTHREADS, 2)
#else
void
#endif
fwd_kernel(Params p) {
    DYN_LDS(lds_raw);
    float* ldsf = (float*)lds_raw;
    const int bid = blockIdx.x, G = gridDim.x;
    const int gthreads = G * NTHREADS, gwaves = G * (NTHREADS / 64);
    const int wave_s = RFL((int)threadIdx.x >> 6);
#define PHASE_IDS() unsigned char* wsl = ws; OPAQUE_S(wsl); int tid = wave_s * 64 + LANE_ID(); OPAQUE(tid); const int lane = tid & 63, wave = tid >> 6, gtid = bid * NTHREADS + tid, gwave = bid * (NTHREADS / 64) + wave; (void)lane; (void)wave; (void)gtid; (void)gwave

    unsigned char* ws = p.ws;
    volatile LAS unsigned* bst = (volatile LAS unsigned*)(lds_raw + LDS_MISC);
    unsigned* ubox = (unsigned*)(lds_raw + LDS_MISC + 16);
    if (threadIdx.x == 0) { bst[0] = 0u; bst[1] = 0u; bst[2] = 0u; bst[3] = 0u; }
    __syncthreads();
    XcdBarrier bar = xcd_barrier_post((unsigned*)ws, bst);

    const int* positions = (const int*)p.in[I_POS];

    constexpr int NPH = 8;
    const int lo = p.lo, hi = p.hi;
#ifdef ONLY_PHASE
#define PH_SEL(c) ((c) == ONLY_PHASE)
#else
#define PH_SEL(c) 1
#endif
#define PH_IN(k) (lo <= (k) && (k) < hi)
#define PH_BAR(k) do { if ((k) + 1 < hi) xcd_barrier(bar, wave_s == 0 && LANE_ID() == 0); } while (0)

    if (PH_SEL(-1) && PH_IN(0)) {
        PHASE_IDS();
        for (int l = 0; l < DEPTH; ++l) {
            convert_mats(p.in[I_WIN] + (size_t)l * D * N_IN, 0, 1, N_IN, D, N_IN, WinT + (size_t)l * N_INP * D, 0, RmWin{}, ldsf, tid, bid, G);
            convert_mats(p.in[I_WO] + (size_t)l * D * D, 0, 1, D, D, D, WoT + (size_t)l * D * D, 0, RmIdent{}, ldsf, tid, bid, G);
            convert_mats(p.in[I_WGATE] + (size_t)l * NEXP * D * DFF, (size_t)D * DFF, NEXP, DFF, D, DFF, WguT + (size_t)l * NEXP * 1024 * D, (size_t)1024 * D, RmGu{0}, ldsf, tid, bid, G);
            convert_mats(p.in[I_WUP] + (size_t)l * NEXP * D * DFF, (size_t)D * DFF, NEXP, DFF, D, DFF, WguT + (size_t)l * NEXP * 1024 * D, (size_t)1024 * D, RmGu{1}, ldsf, tid, bid, G);
            convert_mats(p.in[I_WDOWN] + (size_t)l * NEXP * DFF * D, (size_t)DFF * D, NEXP, D, DFF, D, WdT + (size_t)l * NEXP * D * DFF, (size_t)D * DFF, RmIdent{}, ldsf, tid, bid, G);
            convert_mats(p.in[I_WA] + (size_t)l * 6 * 128 * 128, (size_t)128 * 128, 6, 128, 128, 128, WaiT + (size_t)l * 6 * 256 * 128, (size_t)256 * 128, RmIdent{}, ldsf, tid, bid, G);
            convert_mats(p.in[I_WI] + (size_t)l * 6 * 128 * 128, (size_t)128 * 128, 6, 128, 128, 128, WaiT + (size_t)l * 6 * 256 * 128, (size_t)256 * 128, RmOff{128}, ldsf, tid, bid, G);
        }
        for (int i = gtid; i < DEPTH * 8 * D; i += gthreads) { const int k = i % D, h = (i / D) % 8, l = i / (8 * D);
            Wfa[i] = (h < 6) ? p.in[I_WIN][(size_t)l * D * N_IN + (size_t)k * N_IN + C_FA + h] : 0.f; }
        for (int i = gtid; i < DEPTH * 40 * D; i += gthreads) { const int k = i % D, o = (i / D) % 40, l = i / (40 * D);
            Wr36[i] = (o < 4) ? p.in[I_WGRP][((size_t)l * D + k) * 4 + o] : (o < 36 ? p.in[I_WRT][((size_t)l * D + k) * 32 + (o - 4)] : 0.f); }
        for (int i = gtid; i < S * 8; i += gthreads) { const int d = i & 7, t = i >> 3; const float ang = (float)positions[t] * p.inv_freq[d];
            ropecs[t * 16 + d] = cosf(ang); ropecs[t * 16 + 8 + d] = sinf(ang); }
        __syncthreads();
        for (int i = tid; i < 6 * D; i += NTHREADS) { const int k = i % D, h = i / D; ldsf[i] = p.in[I_WIN][(size_t)k * N_IN + C_FA + h]; }
        __syncthreads();
        for (int t = gwave; t < S; t += gwaves) {
            const float* xr = p.in[I_X] + (size_t)t * D;
            float fa[6] = {0.f, 0.f, 0.f, 0.f, 0.f, 0.f};
#pragma unroll
            for (int j = 0; j < 8; ++j) {
                const int c = j * 256 + lane * 4;
                const f32x4 v = *(const f32x4*)(xr + c);
                u32x2 o; o.x = pack2(v[0], v[1]); o.y = pack2(v[2], v[3]);
                *(u32x2*)(xb + (size_t)t * D + c) = o;
#pragma unroll
                for (int h = 0; h < 6; ++h) { const f32x4 w = *(const f32x4*)(ldsf + h * D + c); fa[h] += v[0] * w[0] + v[1] * w[1] + v[2] * w[2] + v[3] * w[3]; }
            }
#pragma unroll
            for (int h = 0; h < 6; ++h) { const float s = wave_sum(fa[h]); if (lane == 0) logf_[h * S + t] = log_sigmoid_f(s + p.in[I_BF][h]); }
        }
        PH_BAR(0);
    }

    for (int l = 0; l < DEPTH; ++l) {
        const int pb = 1 + l * NPH;
#define hin ((l == 0) ? p.in[I_X] : (const float*)hb)
#define hout ((l == DEPTH - 1) ? p.out : hb)
#define cnt ((int*)(wsl + CTL_CNT_OFF) + l * NEXP)
#define workctr ((int*)(wsl + CTL_WORK_OFF) + l * 64)

        if (PH_SEL(0) && PH_IN(pb + 0)) {
            PHASE_IDS();
            if (bid == 0) {
                double* part = (double*)lds_raw;
                const int per = S / 64;
                double s = 0.0;
                if (wave < 6) { for (int i = 0; i < per; ++i) s += (double)logf_[wave * S + lane * per + i]; part[wave * 64 + lane] = s; }
                __syncthreads();
                if (wave < 6) {
                    double run = 0.0;
                    for (int j = 0; j < lane; ++j) run += part[wave * 64 + j];
                    for (int i = 0; i < per; ++i) { run += (double)logf_[wave * S + lane * per + i]; cum2[wave * S + lane * per + i] = (float)(run * (double)LOG2E); }
                }
                __syncthreads();
            }
            const bf16_t* Bt = WinT + (size_t)l * N_INP * D;
            constexpr int ntn = N_INP / 256, ntm = S / 256;
            const unsigned nooff[2][2] = {{0u, 0u}, {0u, 0u}};
            for (int t = bid; t < ntm * ntn; t += G) {
                const int pm = t / ntn, pn = t % ntn;
                f32x4 acc[2][2][4][2];
                gemm_tile<false>(xb, pm * 256, nooff, Bt, pn * 256, D, lds_raw, acc, tid);
                int et = tid; OPAQUE(et); const int wr = et >> 8, wc = (et >> 6) & 3, fr = et & 15, fq = (et >> 4) & 3;
                if (pn < 6 || (pn >= 9 && pn < 19)) {
                    bf16_t* dst; float scale = 1.f; bool rope = false;
                    if (pn < 3) { dst = Qa; scale = QSCALE_A; } else if (pn < 6) { dst = Ka; } else if (pn < 12) { dst = Xr; } else if (pn < 15) { dst = Gr; }
                    else if (pn < 17) { dst = Qc; scale = QSCALE_C; rope = true; } else { dst = Kc; rope = true; }
                    const bool headmajor = (pn < 6) || (pn >= 15);
                    const int segpn = (pn < 3) ? pn : (pn < 6) ? pn - 3 : (pn < 12) ? pn - 9 : (pn < 15) ? pn - 12 : (pn < 17) ? pn - 15 : pn - 17;
#pragma unroll
                    for (int ai = 0; ai < 2; ++ai)
#pragma unroll
                        for (int m = 0; m < 4; ++m)
#pragma unroll
                            for (int bj = 0; bj < 2; ++bj)
#pragma unroll
                                for (int n = 0; n < 2; ++n) {
                                    const int dd = wc * 32 + n * 16 + fr;
#pragma unroll
                                    for (int j = 0; j < 4; ++j) {
                                        const int row = pm * 256 + ai * 128 + wr * 64 + m * 16 + fq * 4 + j;
                                        float v = acc[ai][bj][m][n][j];
                                        if (rope && n == 0 && (wc & 1) == 0) {
                                            const float pv = __shfl_xor(v, 8);
                                            const float cs = ropecs[row * 16 + (fr & 7)], sn = ropecs[row * 16 + 8 + (fr & 7)];
                                            v = (fr < 8) ? (v * cs - pv * sn) : (v * cs + pv * sn);
                                        }
                                        v *= scale;
                                        size_t idx;
                                        if (headmajor) idx = ((size_t)(segpn * 2 + bj) * S + row) * 128 + dd;
                                        else idx = (size_t)row * LRU_W + segpn * 256 + bj * 128 + dd;
                                        dst[idx] = f2bf(v);
                                    }
                                }
                } else {
                    bf16_t* dst = (pn < 9) ? VaT : VcT;
                    const int segpn = (pn < 9) ? pn - 6 : pn - 19;
#pragma unroll
                    for (int ai = 0; ai < 2; ++ai)
#pragma unroll
                        for (int m = 0; m < 4; ++m)
#pragma unroll
                            for (int bj = 0; bj < 2; ++bj)
#pragma unroll
                                for (int n = 0; n < 2; ++n) {
                                    const int dd = wc * 32 + n * 16 + fr;
                                    const int row = pm * 256 + ai * 128 + wr * 64 + m * 16 + fq * 4;
                                    const f32x4 a = acc[ai][bj][m][n];
                                    u32x2 o; o.x = pack2(a[0], a[1]); o.y = pack2(a[2], a[3]);
                                    *(u32x2*)(dst + (((size_t)(segpn * 2 + bj) * NKT + (row >> 6)) * 128 + dd) * 64 + (row & 63)) = o;
                                }
                }
            }
            PH_BAR(pb + 0);
        }

        if (PH_SEL(1) && PH_IN(pb + 1)) {
            PHASE_IDS();
            const float lam_init = (l == 0) ? 0.2f : 0.35550906759f;
            const float s1 = wave_sum(p.in[I_LQ1][l * 64 + lane] * p.in[I_LK1][l * 64 + lane]);
            const float s2 = wave_sum(p.in[I_LQ2][l * 64 + lane] * p.in[I_LK2][l * 64 + lane]);
            const float lam = fexp(s1) - fexp(s2) + lam_init;
            constexpr int NLRU = NKT * 6, NQB = S / 128;
#ifndef NO_LRU
            for (int u = bid; u < NLRU; u += G)
                lru_unit_a(u / 6, u % 6, l, p, Xr, WaiT + (size_t)l * 6 * 256 * 128, hloc, ploc, sumA, sumH, lds_raw, tid);
#endif
#ifndef NO_DIFF
            for (;;) {
                __syncthreads();
                if (tid == 0) *ubox = (unsigned)atomic_add_int(workctr, 1);
                __syncthreads();
                const int u = RFL((int)*ubox);
                if (u >= NQB * DIFF_H) break;
                const int qb = NQB - 1 - u / DIFF_H, h = u % DIFF_H;
                attn_unit<1>(Qc + (size_t)h * S * 128, Kc + (size_t)h * S * 128, VcT + (size_t)h * S * 128, nullptr, qb, concat, 1536 + h * 128,
                             lam, 1.f - lam_init, p.in[I_SUBG] + l * 128, lds_raw, tid);
            }
#endif
#ifndef NO_FOX
            for (;;) {
                __syncthreads();
                if (tid == 0) *ubox = (unsigned)atomic_add_int(workctr + 1, 1);
                __syncthreads();
                const int u = RFL((int)*ubox);
                if (u >= NQB * FOX_H) break;
                const int qb = NQB - 1 - u / FOX_H, h = u % FOX_H;
                attn_unit<0>(Qa + (size_t)h * S * 128, Ka + (size_t)h * S * 128, VaT + (size_t)h * S * 128, cum2 + (size_t)h * S, qb, concat, h * 128,
                             0.f, 0.f, nullptr, lds_raw, tid);
            }
#endif
            PH_BAR(pb + 1);
        }

        if (PH_SEL(2) && PH_IN(pb + 2)) {
            PHASE_IDS();
            for (int u = bid; u < NKT * 6; u += G) {
                const int chunk = u / 6, grp = u % 6, c = tid & 127, tq = tid >> 7, ch = grp * 128 + c;
                float cr = 0.f;
                for (int j = 0; j < chunk; ++j) cr = sumA[(size_t)j * LRU_W + ch] * cr + sumH[(size_t)j * LRU_W + ch];
#pragma unroll 4
                for (int i = 0; i < 16; ++i) {
                    const size_t gi = (size_t)(chunk * 64 + tq * 16 + i) * LRU_W + ch;
                    const float h = hloc[gi] + ploc[gi] * cr;
                    concat[(size_t)(chunk * 64 + tq * 16 + i) * D + FOX_W + ch] = f2bf(gelu_tanh_f(bf2f(Gr[gi])) * h);
                }
            }
            PH_BAR(pb + 2);
        }

        if (PH_SEL(3) && PH_IN(pb + 3)) {
            PHASE_IDS();
            const bf16_t* Bt = WoT + (size_t)l * D * D;
            constexpr int ntn = D / 256, ntm = S / 256;
            const unsigned nooff[2][2] = {{0u, 0u}, {0u, 0u}};
            for (int t = bid; t < ntm * ntn; t += G) {
                const int pm = t / ntn, pn = t % ntn;
                f32x4 acc[2][2][4][2];
                gemm_tile<false>(concat, pm * 256, nooff, Bt, pn * 256, D, lds_raw, acc, tid);
                int et = tid; OPAQUE(et); const int wr = et >> 8, wc = (et >> 6) & 3, fr = et & 15, fq = (et >> 4) & 3;
#pragma unroll
                for (int ai = 0; ai < 2; ++ai)
#pragma unroll
                    for (int m = 0; m < 4; ++m)
#pragma unroll
                        for (int j = 0; j < 4; ++j) {
                            const size_t rbase = (size_t)(pm * 256 + ai * 128 + wr * 64 + m * 16 + fq * 4 + j) * D + pn * 256 + wc * 32 + fr;
#pragma unroll
                            for (int bj = 0; bj < 2; ++bj)
#pragma unroll
                                for (int n = 0; n < 2; ++n) { const size_t i2 = rbase + bj * 128 + n * 16; y1[i2] = ALPHA * hin[i2] + acc[ai][bj][m][n][j]; }
                        }
            }
            PH_BAR(pb + 3);
        }

        if (PH_SEL(4) && PH_IN(pb + 4)) {
            PHASE_IDS();
            const float* g1 = p.in[I_LN1G] + (size_t)l * D; const float* b1 = p.in[I_LN1B] + (size_t)l * D;
            const float* bg = p.in[I_BGRP] + l * 4; const float* br = p.in[I_BRT] + l * 32;
            const float* W36 = Wr36 + (size_t)l * 40 * D;
            float* lg = (float*)(lds_raw + wave * 1024);
            for (int t4 = gwave; t4 < S / 4; t4 += gwaves) {
                f32x4 v[4][8];
#pragma unroll
                for (int tk = 0; tk < 4; ++tk) {
                    const int t = t4 * 4 + tk;
                    float s = 0.f;
#pragma unroll
                    for (int j = 0; j < 8; ++j) { v[tk][j] = *(const f32x4*)(y1 + (size_t)t * D + j * 256 + lane * 4); s += (v[tk][j][0] + v[tk][j][1]) + (v[tk][j][2] + v[tk][j][3]); }
                    const float mean = wave_sum(s) * (1.f / D);
                    float s2 = 0.f;
#pragma unroll
                    for (int j = 0; j < 8; ++j) { v[tk][j] -= mean; s2 += (v[tk][j][0] * v[tk][j][0] + v[tk][j][1] * v[tk][j][1]) + (v[tk][j][2] * v[tk][j][2] + v[tk][j][3] * v[tk][j][3]); }
                    const float rstd = 1.f / sqrtf(wave_sum(s2) * (1.f / D) + LN_EPS);
#pragma unroll
                    for (int j = 0; j < 8; ++j) {
                        const int c = j * 256 + lane * 4;
                        const f32x4 g = *(const f32x4*)(g1 + c), b = *(const f32x4*)(b1 + c);
                        v[tk][j] = v[tk][j] * rstd * g + b;
                        *(f32x4*)(h1 + (size_t)t * D + c) = v[tk][j];
                        u32x2 o; o.x = pack2(v[tk][j][0], v[tk][j][1]); o.y = pack2(v[tk][j][2], v[tk][j][3]);
                        *(u32x2*)(h1b + (size_t)t * D + c) = o;
                    }
                }
                WAVE_SYNC();
#pragma unroll 1
                for (int o = 0; o < 36; ++o) {
                    float a0 = 0.f, a1 = 0.f, a2 = 0.f, a3 = 0.f;
#pragma unroll
                    for (int j = 0; j < 8; ++j) {
                        const f32x4 w = *(const f32x4*)(W36 + (size_t)o * D + j * 256 + lane * 4);
                        a0 += (v[0][j][0] * w[0] + v[0][j][1] * w[1]) + (v[0][j][2] * w[2] + v[0][j][3] * w[3]);
                        a1 += (v[1][j][0] * w[0] + v[1][j][1] * w[1]) + (v[1][j][2] * w[2] + v[1][j][3] * w[3]);
                        a2 += (v[2][j][0] * w[0] + v[2][j][1] * w[1]) + (v[2][j][2] * w[2] + v[2][j][3] * w[3]);
                        a3 += (v[3][j][0] * w[0] + v[3][j][1] * w[1]) + (v[3][j][2] * w[2] + v[3][j][3] * w[3]);
                    }
                    a0 = wave_sum(a0); a1 = wave_sum(a1); a2 = wave_sum(a2); a3 = wave_sum(a3);
                    const float bias = (o < 4) ? bg[o] : br[o - 4];
                    if (lane == 0) { lg[0 * 40 + o] = a0 + bias; lg[1 * 40 + o] = a1 + bias; lg[2 * 40 + o] = a2 + bias; lg[3 * 40 + o] = a3 + bias; }
                }
                WAVE_SYNC();
                if (lane < 4) {
                    const int t = t4 * 4 + lane; const float* L = lg + lane * 40;
                    int gi = 0; float gm = L[0];
#pragma unroll
                    for (int q = 1; q < 4; ++q) if (L[q] > gm) { gm = L[q]; gi = q; }
                    float gs = 0.f;
#pragma unroll
                    for (int q = 0; q < 4; ++q) gs += fexp(L[q] - gm);
                    const float gweight = 1.f / gs;
                    const float* E = L + 4 + gi * 8;
                    int e1 = 0; float m1 = E[0];
#pragma unroll
                    for (int e = 1; e < 8; ++e) if (E[e] > m1) { m1 = E[e]; e1 = e; }
                    int e2 = -1; float m2 = -INFINITY;
#pragma unroll
                    for (int e = 0; e < 8; ++e) if (e != e1 && E[e] > m2) { m2 = E[e]; e2 = e; }
                    const float p2 = fexp(m2 - m1), w1 = 1.f / (1.f + p2), w2 = p2 / (1.f + p2);
                    const int ge1 = gi * 8 + e1, ge2 = gi * 8 + e2;
                    const int pos1 = atomic_add_int(&cnt[ge1], 1);
                    ltok[ge1 * S + pos1] = t; lw[ge1 * S + pos1] = gweight * w1; lslot[ge1 * S + pos1] = 0;
                    const int pos2 = atomic_add_int(&cnt[ge2], 1);
                    ltok[ge2 * S + pos2] = t; lw[ge2 * S + pos2] = gweight * w2; lslot[ge2 * S + pos2] = 1;
                }
                WAVE_SYNC();
            }
            PH_BAR(pb + 4);
        }

        if (PH_SEL(5) && PH_IN(pb + 5)) {
            PHASE_IDS();
            int tile_id = 0, off = 0;
            for (int e = 0; e < NEXP; ++e) {
                const int c = RFL(cnt[e]);
                const int ntm = (c + 255) / 256;
                const bf16_t* Bt = WguT + ((size_t)l * NEXP + e) * 1024 * D;
                for (int t = 0; t < ntm * 4; ++t, ++tile_id) {
                    if (tile_id % G != bid) continue;
                    const int m0 = (t >> 2) * 256, pn = t & 3;
                    unsigned aoff[2][2];
                    int st = tid; OPAQUE(st); int R[2], C[2]; stage_geom(st, R, C);
#pragma unroll
                    for (int h = 0; h < 2; ++h)
#pragma unroll
                        for (int i = 0; i < 2; ++i) {
                            const int r = m0 + h * 128 + R[i];
                            const int tok = ltok[e * S + (r < c ? r : m0)];
                            aoff[h][i] = (unsigned)(tok * D + C[i]);
                        }
                    f32x4 acc[2][2][4][2];
                    gemm_tile<true>(h1b, 0, aoff, Bt, pn * 256, D, lds_raw, acc, tid);
                    int et = tid; OPAQUE(et); const int wr = et >> 8, wc = (et >> 6) & 3, fr = et & 15, fq = (et >> 4) & 3;
#pragma unroll
                    for (int ai = 0; ai < 2; ++ai)
#pragma unroll
                        for (int m = 0; m < 4; ++m)
#pragma unroll
                            for (int j = 0; j < 4; ++j) {
                                const int gm = m0 + ai * 128 + wr * 64 + m * 16 + fq * 4 + j;
                                COMPILER_FENCE();
                                if (gm < c) {
                                    const float wgt = lw[e * S + gm];
#pragma unroll
                                    for (int bj = 0; bj < 2; ++bj) {
                                        const int f = pn * 128 + bj * 64 + wc * 16 + fr;
                                        act[(size_t)(off + gm) * DFF + f] = f2bf(silu_f(acc[ai][bj][m][0][j]) * acc[ai][bj][m][1][j] * wgt);
                                    }
                                }
                            }
                }
                off += c;
            }
            PH_BAR(pb + 5);
        }

        if (PH_SEL(6) && PH_IN(pb + 6)) {
            PHASE_IDS();
            const unsigned nooff[2][2] = {{0u, 0u}, {0u, 0u}};
            int tile_id = 0, off = 0;
            for (int e = 0; e < NEXP; ++e) {
                const int c = RFL(cnt[e]);
                const int ntm = (c + 255) / 256;
                const bf16_t* Bt = WdT + ((size_t)l * NEXP + e) * D * DFF;
                for (int t = 0; t < ntm * 8; ++t, ++tile_id) {
                    if (tile_id % G != bid) continue;
                    const int m0 = (t >> 3) * 256, pn = t & 7;
                    f32x4 acc[2][2][4][2];
                    gemm_tile<false>(act, off + m0, nooff, Bt, pn * 256, DFF, lds_raw, acc, tid);
                    int et = tid; OPAQUE(et); const int wr = et >> 8, wc = (et >> 6) & 3, fr = et & 15, fq = (et >> 4) & 3;
#pragma unroll
                    for (int ai = 0; ai < 2; ++ai)
#pragma unroll
                        for (int m = 0; m < 4; ++m)
#pragma unroll
                            for (int j = 0; j < 4; ++j) {
                                const int gm = m0 + ai * 128 + wr * 64 + m * 16 + fq * 4 + j;
                                COMPILER_FENCE();
                                if (gm < c) {
                                    float* dst = contrib + ((size_t)lslot[e * S + gm] * S + ltok[e * S + gm]) * D + pn * 256 + wc * 32 + fr;
#pragma unroll
                                    for (int bj = 0; bj < 2; ++bj)
#pragma unroll
                                        for (int n = 0; n < 2; ++n) dst[bj * 128 + n * 16] = acc[ai][bj][m][n][j];
                                }
                            }
                }
                off += c;
            }
            PH_BAR(pb + 6);
        }

        if (PH_SEL(7) && PH_IN(pb + 7)) {
            PHASE_IDS();
            const float* g2 = p.in[I_LN2G] + (size_t)l * D; const float* b2 = p.in[I_LN2B] + (size_t)l * D;
            const bool more = (l + 1 < DEPTH);
            const float* wf = Wfa + (size_t)(l + 1 < DEPTH ? l + 1 : l) * 8 * D;
            for (int t = gwave; t < S; t += gwaves) {
                f32x4 v[8]; float s = 0.f;
#pragma unroll
                for (int j = 0; j < 8; ++j) {
                    const size_t i = (size_t)t * D + j * 256 + lane * 4;
                    v[j] = ALPHA * *(const f32x4*)(h1 + i) + *(const f32x4*)(contrib + i) + *(const f32x4*)(contrib + (size_t)S * D + i);
                    s += (v[j][0] + v[j][1]) + (v[j][2] + v[j][3]);
                }
                const float mean = wave_sum(s) * (1.f / D);
                float s2 = 0.f;
#pragma unroll
                for (int j = 0; j < 8; ++j) { v[j] -= mean; s2 += (v[j][0] * v[j][0] + v[j][1] * v[j][1]) + (v[j][2] * v[j][2] + v[j][3] * v[j][3]); }
                const float rstd = 1.f / sqrtf(wave_sum(s2) * (1.f / D) + LN_EPS);
                float fa[6] = {0.f, 0.f, 0.f, 0.f, 0.f, 0.f};
#pragma unroll
                for (int j = 0; j < 8; ++j) {
                    const int c = j * 256 + lane * 4;
                    const f32x4 g = *(const f32x4*)(g2 + c), b = *(const f32x4*)(b2 + c);
                    v[j] = v[j] * rstd * g + b;
                    *(f32x4*)(hout + (size_t)t * D + c) = v[j];
                    COMPILER_FENCE();
                    if (more) {
                        u32x2 o; o.x = pack2(v[j][0], v[j][1]); o.y = pack2(v[j][2], v[j][3]);
                        *(u32x2*)(xb + (size_t)t * D + c) = o;
#pragma unroll
                        for (int h = 0; h < 6; ++h) { const f32x4 w = *(const f32x4*)(wf + h * D + c); fa[h] += (v[j][0] * w[0] + v[j][1] * w[1]) + (v[j][2] * w[2] + v[j][3] * w[3]); }
                    }
                }
                if (more) {
#pragma unroll
                    for (int h = 0; h < 6; ++h) { const float sm = wave_sum(fa[h]); if (lane == 0) logf_[h * S + t] = log_sigmoid_f(sm + p.in[I_BF][(l + 1) * 6 + h]); }
                }
            }
            PH_BAR(pb + 7);
        }
    }
#undef PH_IN
#undef PH_BAR
}

constexpr int N_PHASES = 1 + DEPTH * 8;
#ifndef EMU
extern "C" void kernel_launch(void* const* d_in, const int* in_sizes, int n_in, void* d_out, int out_size, void* d_ws, size_t ws_size, hipStream_t stream) {
    static int grid = 0;
    if (grid == 0) {
        if (n_in != N_INPUTS || out_size != S * D || ws_size < WS_END) {
            fprintf(stderr, "kernel_launch: unexpected shapes: n_in %d out %d ws %zu (need %zu)\n", n_in, out_size, ws_size, (size_t)WS_END); grid = -1; return; }
        int dev = 0, cus = 0, per_cu = 0;
        if (hipGetDevice(&dev) != hipSuccess || hipDeviceGetAttribute(&cus, hipDeviceAttributeMultiprocessorCount, dev) != hipSuccess) { grid = -1; return; }
        if (hipFuncSetAttribute((const void*)fwd_kernel, hipFuncAttributeMaxDynamicSharedMemorySize, LDS_BYTES) != hipSuccess) { fprintf(stderr, "kernel_launch: hipFuncSetAttribute failed\n"); grid = -1; return; }
        if (hipOccupancyMaxActiveBlocksPerMultiprocessor(&per_cu, (const void*)fwd_kernel, NTHREADS, LDS_BYTES) != hipSuccess || per_cu < 1) {
            fprintf(stderr, "kernel_launch: occupancy query says %d blocks per CU\n", per_cu); (void)hipGetLastError(); grid = -1; return; }
        grid = cus;
    }
    if (grid < 0) return;
    (void)hipMemsetAsync(d_ws, 0, CTL_BYTES, stream);
    Params p{};
    for (int i = 0; i < N_INPUTS; ++i) p.in[i] = (const float*)d_in[i];
    p.out = (float*)d_out; p.ws = (unsigned char*)d_ws;
    for (int i = 0; i < 8; ++i) p.inv_freq[i] = (float)pow(500000.0, -(double)i * 2.0 / 16.0);
#if N_LAUNCH_SPLIT
    for (int k = 0; k < N_PHASES; ++k) { p.lo = k; p.hi = k + 1; hipLaunchKernelGGL(fwd_kernel, dim3(grid), dim3(NTHREADS), LDS_BYTES, stream, p); }
#else
    p.lo = 0; p.hi = N_PHASES;
    hipLaunchKernelGGL(fwd_kernel, dim3(grid), dim3(NTHREADS), LDS_BYTES, stream, p);
#endif
}
#endif
```

```cpp
#ifndef EMU
#include <hip/hip_runtime.h>
#include <cstdio>
#include <cstdint>
#include <cmath>
#endif

#ifndef SEQ
#define SEQ 8192
#endif
#ifndef N_LAUNCH_SPLIT
#define N_LAUNCH_SPLIT 0
#endif
#ifndef REP_PHASE
#define REP_PHASE -2
#endif
#define PH_REPS(c) ((c) == REP_PHASE ? 2 : 1)
#ifndef REP_SUB
#define REP_SUB 0
#endif

constexpr int S = SEQ, D = 2048, DEPTH = 2;
constexpr int FOX_H = 6, FOX_W = 768;
constexpr int LRU_W = 768;
constexpr int DIFF_H = 4, DIFF_W = 512;
constexpr int N_IN = 5382, N_INP = 5376;
constexpr int C_FA = 2304;
constexpr int NEXP = 32, DFF = 512;
constexpr int NKT = S / 64;
#ifndef DCH
#define DCH 16
#endif
constexpr int NCH = (NKT + DCH - 1) / DCH;
constexpr size_t DPART_ROWS = (size_t)NCH * S - (size_t)(DCH * 64) * NCH * (NCH - 1) / 2;
constexpr float ALPHA = 1.41421356237309504880f;
constexpr float LN_EPS = 1e-5f;
constexpr float LOG2E = 1.4426950408889634f;
constexpr float QSCALE_A = 0.08838834764831845f * 1.4426950408889634f;
constexpr float QSCALE_C = 0.125f * 1.4426950408889634f;

enum { I_X = 0, I_POS, I_WIN, I_BF, I_CONVW, I_CONVB, I_WA, I_BA, I_WI, I_BI, I_LAM, I_LQ1, I_LK1, I_LQ2, I_LK2, I_SUBG, I_WO, I_LN1G, I_LN1B,
       I_WGRP, I_BGRP, I_WRT, I_BRT, I_WGATE, I_WUP, I_WDOWN, I_LN2G, I_LN2B, N_INPUTS };

typedef unsigned short bf16_t;
typedef short bf16x8 __attribute__((ext_vector_type(8)));
typedef float f32x4 __attribute__((ext_vector_type(4)));
typedef unsigned u32x4 __attribute__((ext_vector_type(4)));
typedef unsigned u32x2 __attribute__((ext_vector_type(2)));

constexpr size_t al256(size_t x) { return (x + 255) & ~(size_t)255; }
constexpr size_t CTL_BYTES = 65536;
constexpr size_t CTL_CNT_OFF = 32768;
constexpr size_t CTL_WORK_OFF = 36864;
constexpr size_t WB_WIN = CTL_BYTES;
constexpr size_t WB_WO = WB_WIN + al256((size_t)DEPTH * N_INP * D * 2);
constexpr size_t WB_WGU = WB_WO + al256((size_t)DEPTH * D * D * 2);
constexpr size_t WB_WD = WB_WGU + al256((size_t)DEPTH * NEXP * 1024 * D * 2);
constexpr size_t WB_WAI = WB_WD + al256((size_t)DEPTH * NEXP * D * DFF * 2);
constexpr size_t WF_FA = WB_WAI + al256((size_t)DEPTH * 6 * 256 * 128 * 2);
constexpr size_t WF_R36 = WF_FA + al256((size_t)DEPTH * 8 * D * 4);
constexpr size_t WF_ROPE = WF_R36 + al256((size_t)DEPTH * 2 * 48 * D * 2);
constexpr size_t A_XB = WF_ROPE + al256((size_t)S * 16 * 4);
constexpr size_t A_HB = A_XB + al256((size_t)S * D * 2);
constexpr size_t A_LOGF = A_HB + al256((size_t)S * D * 4);
constexpr size_t A_CUM = A_LOGF + al256((size_t)6 * S * 4);
constexpr size_t A_KMAX = A_CUM + al256((size_t)6 * S * 4);
constexpr size_t A_CNTB = A_KMAX + al256((size_t)6 * NKT * 4);
constexpr size_t A_QA = A_CNTB + al256((size_t)1024 * 32 * 4);
constexpr size_t A_KA = A_QA + al256((size_t)FOX_H * S * 128 * 2);
constexpr size_t A_VAT = A_KA + al256((size_t)FOX_H * S * 128 * 2);
constexpr size_t A_XR = A_VAT + al256((size_t)FOX_H * S * 128 * 2);
constexpr size_t A_GR = A_XR + al256((size_t)S * LRU_W * 2);
constexpr size_t A_QC = A_GR + al256((size_t)S * LRU_W * 2);
constexpr size_t A_KC = A_QC + al256((size_t)DIFF_H * S * 128 * 2);
constexpr size_t A_VCT = A_KC + al256((size_t)DIFF_H * S * 128 * 2);
constexpr size_t A_HLOC = A_VCT + al256((size_t)DIFF_H * S * 128 * 2);
constexpr size_t A_PLOC = A_HLOC + al256((size_t)S * LRU_W * 4);
constexpr size_t A_SUMA = A_PLOC + al256((size_t)S * LRU_W * 4);
constexpr size_t A_SUMH = A_SUMA + al256((size_t)NKT * LRU_W * 4);
constexpr size_t A_CONCAT = A_SUMH + al256((size_t)NKT * LRU_W * 4);
constexpr size_t A_Y1 = A_CONCAT + al256((size_t)S * D * 2);
constexpr size_t A_H1 = A_Y1 + al256((size_t)S * D * 4);
constexpr size_t A_H1B = A_H1 + al256((size_t)S * D * 4);
constexpr size_t A_LTOK = A_H1B + al256((size_t)S * D * 2);
constexpr size_t A_LW = A_LTOK + al256((size_t)NEXP * S * 4);
constexpr size_t A_LSLOT = A_LW + al256((size_t)NEXP * S * 4);
constexpr size_t A_ACT = A_LSLOT + al256((size_t)NEXP * S * 4);
constexpr size_t A_CONTRIB = A_ACT + al256((size_t)(2 * S + 256) * DFF * 2);
constexpr size_t WS_END = A_CONTRIB + al256((size_t)2 * S * D * 4);
constexpr size_t A_DPO = A_Y1;
constexpr size_t A_DPML = A_DPO + al256((size_t)8 * DPART_ROWS * 128 * 2);
static_assert(A_DPML + (size_t)8 * DPART_ROWS * 2 * 4 <= A_H1B, "differential partials must fit inside the y1 + h1 region");

constexpr int NTHREADS = 512;
constexpr int LDS_MAIN = 131072;
constexpr int LDS_MISC = LDS_MAIN;
constexpr int LDS_BYTES = LDS_MAIN + 8192;
constexpr int M_LCNT = 64, M_CTOT = 256, M_COFF = 384, M_PRE = 512, M_RTOK = 2048, M_RW = 3072, M_RSLOT = 4096;

struct Params {
    const float* in[N_INPUTS];
    float* out;
    unsigned char* ws;
    float inv_freq[8];
    int lo, hi;
};

#ifndef EMU
#define LAS __attribute__((address_space(3)))
#define DYN_LDS(name) extern __shared__ __attribute__((aligned(16))) unsigned char name[]
#define SLEEP1() __builtin_amdgcn_s_sleep(1)
#define WAVE_SYNC() __builtin_amdgcn_wave_barrier()
#define OPAQUE(x) asm volatile("" : "+v"(x))
#define COMPILER_FENCE() asm volatile("" ::: "memory")
#define RFL(x) __builtin_amdgcn_readfirstlane(x)
#define RDLANE(v, l) __builtin_bit_cast(float, __builtin_amdgcn_readlane(__builtin_bit_cast(int, v), l))
__device__ __forceinline__ int lane_id_volatile() { int l; asm volatile("v_mbcnt_lo_u32_b32 %0, -1, 0\n\tv_mbcnt_hi_u32_b32 %0, -1, %0" : "=v"(l)); return l; }
#define LANE_ID() lane_id_volatile()
#define OPAQUE_S(x) asm volatile("" : "+s"(x))
#define WAIT_VM0() asm volatile("s_waitcnt vmcnt(0)" ::: "memory")
#define WAIT_ALL0() __builtin_amdgcn_s_waitcnt(0)
#define FENCE_REL_AGENT() __builtin_amdgcn_fence(__ATOMIC_RELEASE, "agent")
#define FENCE_ACQ_AGENT() __builtin_amdgcn_fence(__ATOMIC_ACQUIRE, "agent")
#define MFMA16(a, b, c) __builtin_amdgcn_mfma_f32_16x16x32_bf16(a, b, c, 0, 0, 0)
#define GLDS16(g, l) __builtin_amdgcn_global_load_lds((const unsigned*)(g), (unsigned*)(l), 16, 0, 0)
#define WAIT_V(n) asm volatile("s_waitcnt vmcnt(" #n ")" ::: "memory")
#define WAIT_L(n) asm volatile("s_waitcnt lgkmcnt(" #n ")" ::: "memory")
#define BAR() __builtin_amdgcn_s_barrier()
#define SCHED() __builtin_amdgcn_sched_barrier(0)
#define SETPRIO(n) __builtin_amdgcn_s_setprio(n)
#define FAST_EXP2(x) __builtin_amdgcn_exp2f(x)
template <int M> __device__ __forceinline__ float shx_impl(float v, int lane) {
    if (M < 32) return __builtin_bit_cast(float, __builtin_amdgcn_ds_swizzle(__builtin_bit_cast(int, v), (M << 10) | 0x1f));
    return __builtin_bit_cast(float, __builtin_amdgcn_ds_bpermute((lane ^ 32) << 2, __builtin_bit_cast(int, v)));
}
#define SHX(v, M) shx_impl<M>(v, lane)
#define FAST_LOG2(x) __builtin_amdgcn_logf(x)
#define FAST_RCP(x) __builtin_amdgcn_rcpf(x)
__device__ __forceinline__ unsigned xb_ld(unsigned* p)              { return __hip_atomic_load(p, __ATOMIC_RELAXED, __HIP_MEMORY_SCOPE_AGENT); }
__device__ __forceinline__ unsigned xb_add(unsigned* p, unsigned v) { return __hip_atomic_fetch_add(p, v, __ATOMIC_RELAXED, __HIP_MEMORY_SCOPE_AGENT); }
__device__ __forceinline__ unsigned xb_xcc_id() { return (unsigned)__builtin_amdgcn_s_getreg((3 << 11) | 20) & 0xFu; }
__device__ __forceinline__ int atomic_add_int(int* p, int v) { return atomicAdd(p, v); }
__device__ __forceinline__ void atomic_min_int(int* p, int v) { atomicMin(p, v); }
__device__ __forceinline__ unsigned pack2(float lo, float hi) { unsigned r; asm volatile("v_cvt_pk_bf16_f32 %0, %1, %2" : "=v"(r) : "v"(lo), "v"(hi)); return r; }
#else
#define MFMA16(a, b, c) emu_mfma_16x16x32_bf16(a, b, c)
#define GLDS16(g, l) emu_glds16((const void*)(g), (void*)(l))
#define WAIT_V(n) ((void)0)
#define WAIT_L(n) ((void)0)
#define BAR() __syncthreads()
#define SCHED() ((void)0)
#define SETPRIO(n) ((void)0)
#define FAST_EXP2(x) exp2f(x)
#define SHX(v, M) __shfl_xor(v, M)
#define FAST_LOG2(x) log2f(x)
#define FAST_RCP(x) (1.f / (x))
static inline unsigned pack2(float lo, float hi) {
    unsigned a = __builtin_bit_cast(unsigned, lo), b = __builtin_bit_cast(unsigned, hi);
    a += 0x7fffu + ((a >> 16) & 1u); b += 0x7fffu + ((b >> 16) & 1u);
    return (a >> 16) | (b & 0xffff0000u);
}
#endif
__device__ __forceinline__ bf16_t f2bf(float f) { return (bf16_t)(pack2(f, 0.f) & 0xffffu); }
__device__ __forceinline__ float bf2f(bf16_t h) { return __builtin_bit_cast(float, (unsigned)h << 16); }

#define XB_TMO      128
#define XB_XCNT(j)  (256  + 64 * (j))
#define XB_XSUB(j)  (1280 + 64 * (j))
#define XB_XGEN(j)  (2304 + 64 * (j))
#define XB_TOP      3328
#define XB_TOPGEN   3392
#define XCD_BAR_WORDS 3456
#define XB_SPIN_CAP (1u << 22)
#define XB_SPIN(cond, bar) do { unsigned _sp = 0; while (cond) { SLEEP1(); \
    if ((++_sp & 255u) == 0u) { if (xb_ld(&(bar)[XB_TMO])) break; if (_sp > XB_SPIN_CAP) { xb_add(&(bar)[XB_TMO], 1u); break; } } } } while (0)

struct XcdBarrier { unsigned* bar; unsigned x; volatile LAS unsigned* st; };

__device__ __forceinline__ XcdBarrier xcd_barrier_post(unsigned* bar, volatile LAS unsigned* st) {
    XcdBarrier b; b.bar = bar; b.x = xb_xcc_id(); b.st = st;
    if (threadIdx.x == 0) (void)xb_add(&bar[XB_XCNT(b.x)], 1u);
    return b;
}
__device__ __forceinline__ void xcd_barrier_complete(unsigned* bar, unsigned x, unsigned& nloc, unsigned& nx) {
    const unsigned G = gridDim.x;
    unsigned sum, cnt, mine, sp = 0u;
    for (;;) {
        sum = 0u; cnt = 0u; mine = 0u;
#pragma unroll
        for (unsigned j = 0; j < 16; ++j) { const unsigned c = xb_ld(&bar[XB_XCNT(j)]); sum += c; cnt += (c > 0u) ? 1u : 0u; mine = (j == x) ? c : mine; }
        if (sum == G) break;
        SLEEP1();
        if ((++sp & 255u) == 0u) { if (xb_ld(&bar[XB_TMO])) break; if (sp > XB_SPIN_CAP) { xb_add(&bar[XB_TMO], 1u); break; } }
    }
    nloc = mine > 0u ? mine : 1u; nx = cnt > 0u ? cnt : 1u;
}
__device__ __forceinline__ void xcd_barrier(const XcdBarrier& b, bool leader) {
    WAIT_VM0();
    __syncthreads();
    if (leader) {
        unsigned* bar = b.bar;
        WAIT_ALL0();
        unsigned nloc = b.st[0], nx = b.st[1];
        if (nloc == 0u) { xcd_barrier_complete(bar, b.x, nloc, nx); b.st[0] = nloc; b.st[1] = nx; }
        const unsigned old = xb_add(&bar[XB_XSUB(b.x)], 1u);
        const unsigned gen = old / nloc;
        if (old + 1u == (gen + 1u) * nloc) {
            FENCE_REL_AGENT();
            WAIT_VM0();
            const unsigned og = xb_add(&bar[XB_TOP], 1u);
            const unsigned tg = og / nx;
            if (og + 1u == (tg + 1u) * nx) xb_add(&bar[XB_TOPGEN], 1u);
            else XB_SPIN(xb_ld(&bar[XB_TOPGEN]) == tg, bar);
            FENCE_ACQ_AGENT();
            xb_add(&bar[XB_XGEN(b.x)], 1u);
            WAIT_VM0();
        } else {
            XB_SPIN(xb_ld(&bar[XB_XGEN(b.x)]) == gen, bar);
            FENCE_ACQ_AGENT();
            WAIT_VM0();
        }
    }
    __syncthreads();
}

__device__ __forceinline__ float wave_sum_l(float v, int lane) {
    v += SHX(v, 1); v += SHX(v, 2); v += SHX(v, 4); v += SHX(v, 8); v += SHX(v, 16); v += SHX(v, 32);
    return v;
}
#define wave_sum(v) wave_sum_l(v, lane)
__device__ __forceinline__ float fexp(float x) { return FAST_EXP2(x * LOG2E); }
__device__ __forceinline__ float sigmoid_f(float x) { return FAST_RCP(1.f + fexp(-x)); }
__device__ __forceinline__ float log_sigmoid_f(float x) { return fminf(x, 0.f) - 0.6931471805599453f * FAST_LOG2(1.f + fexp(-fabsf(x))); }
__device__ __forceinline__ float gelu_tanh_f(float x) { const float u = 0.7978845608028654f * (x + 0.044715f * x * x * x); return x * FAST_RCP(1.f + fexp(-2.f * u)); }
__device__ __forceinline__ float silu_f(float x) { return x * FAST_RCP(1.f + fexp(-x)); }
__device__ __forceinline__ float neg_expm1_f(float x) {
    const float ser = -x * (1.f + x * (0.5f + x * (0.16666667f + x * (0.041666668f + x * (0.008333334f + x * 0.0013888889f)))));
    return (x > -0.35f) ? ser : (1.f - fexp(x));
}

struct RmIdent { __device__ __forceinline__ int operator()(int n) const { return n; } };
struct RmWin { __device__ __forceinline__ int operator()(int n) const { return n < C_FA ? n : (n < C_FA + 6 ? -1 : n - 6); } };
struct RmGu { int kind; __device__ __forceinline__ int operator()(int f) const { return (f >> 7) * 256 + ((f >> 6) & 1) * 128 + ((f >> 4) & 3) * 32 + kind * 16 + (f & 15); } };
struct RmOff { int off; __device__ __forceinline__ int operator()(int n) const { return n + off; } };

template <class RM>
__device__ __forceinline__ void convert_tile(const float* src, int ld, int K, int Nsrc, int k0, int n0, bf16_t* dst, const RM& rm, float* T, int tid) {
#pragma unroll
    for (int p = 0; p < 8; ++p) {
        const int kk = (tid >> 6) + 8 * p, nn = tid & 63, n = n0 + nn;
        T[kk * 65 + nn] = (n < Nsrc) ? src[(size_t)(k0 + kk) * ld + n] : 0.f;
    }
    __syncthreads();
    {
        const int nn = tid >> 3, kc = (tid & 7) * 8, n = n0 + nn;
        const int row = (n < Nsrc) ? rm(n) : -1;
        if (row >= 0) {
            u32x4 o;
            o.x = pack2(T[(kc + 0) * 65 + nn], T[(kc + 1) * 65 + nn]); o.y = pack2(T[(kc + 2) * 65 + nn], T[(kc + 3) * 65 + nn]);
            o.z = pack2(T[(kc + 4) * 65 + nn], T[(kc + 5) * 65 + nn]); o.w = pack2(T[(kc + 6) * 65 + nn], T[(kc + 7) * 65 + nn]);
            *(u32x4*)(dst + (size_t)row * K + k0 + kc) = o;
        }
    }
    __syncthreads();
}
template <class RM>
__device__ __forceinline__ void convert_mats(const float* src, size_t sstride, int nmat, int ld, int K, int Nsrc, bf16_t* dst, size_t dstride, const RM& rm,
                                             float* T, int tid, int bid, int G) {
    const int tk = K / 64, tn = (Nsrc + 63) / 64, per = tk * tn, total = nmat * per;
    for (int t = bid; t < total; t += G) {
        const int mi = t / per, r = t % per;
        convert_tile(src + (size_t)mi * sstride, ld, K, Nsrc, (r / tn) * 64, (r % tn) * 64, dst + (size_t)mi * dstride, rm, T, tid);
    }
}

constexpr int BK = 64, HTB = 128 * 64 * 2;
__device__ __forceinline__ int lds_byte(int r, int c) {
    const int st = (r >> 4) * 2 + (c >> 5), rr = r & 15, cc = c & 31, ob = rr * 64 + cc * 2;
    return st * 1024 + (ob ^ (((ob >> 9) & 1) << 5));
}
__device__ __forceinline__ void stage_rc(int b, int& R, int& C) {
    const int st = b / 1024, sb = b % 1024, swz = sb ^ (((sb >> 9) & 1) << 5);
    R = (st >> 1) * 16 + swz / 64; C = (st & 1) * 32 + (swz % 64) / 2;
}
template <bool GATHER>
__device__ __forceinline__ void gemm_tile(const bf16_t* A, int arow0, const unsigned (&aoff)[2][2], const bf16_t* Bt, int brow0, int K,
                                          unsigned char* shm, f32x4 (&acc)[2][2][4][2], int tid_in) {
    int tid = tid_in; OPAQUE(tid);
    unsigned toff; { int R0, C0; stage_rc(tid * 16, R0, C0); toff = (unsigned)(R0 * K + C0); }
#define SA(b, h) (shm + ((b) * 2 + (h)) * HTB)
#define SB(b, h) (shm + (4 + (b) * 2 + (h)) * HTB)
#define STAGE_B(P, h, kt) do { _Pragma("unroll") for (int _i = 0; _i < 2; ++_i) GLDS16(Bt + ((size_t)(brow0 + (h) * 128 + _i * 64) * K + (size_t)(kt) * BK) + toff, (P) + tid * 16 + _i * 8192); } while (0)
#define STAGE_A(P, h, kt) do { _Pragma("unroll") for (int _i = 0; _i < 2; ++_i) { \
    if (GATHER) GLDS16(A + (size_t)(kt) * BK + aoff[h][_i], (P) + tid * 16 + _i * 8192); \
    else GLDS16(A + ((size_t)(arow0 + (h) * 128 + _i * 64) * K + (size_t)(kt) * BK) + toff, (P) + tid * 16 + _i * 8192); } } while (0)
#define LDA(dst, b, h) _Pragma("unroll") for (int m = 0; m < 4; ++m) _Pragma("unroll") for (int k = 0; k < 2; ++k) \
    dst[m][k] = *reinterpret_cast<const bf16x8*>(SA(b, h) + lds_byte(wr * 64 + m * 16 + fr, k * 32 + fq * 8))
#define LDB(dst, b, h) _Pragma("unroll") for (int n = 0; n < 2; ++n) _Pragma("unroll") for (int k = 0; k < 2; ++k) \
    dst[n][k] = *reinterpret_cast<const bf16x8*>(SB(b, h) + lds_byte(wc * 32 + n * 16 + fr, k * 32 + fq * 8))
#define MMA(ai, bj, At, Bx) do { SETPRIO(1); \
    _Pragma("unroll") for (int m = 0; m < 4; ++m) _Pragma("unroll") for (int n = 0; n < 2; ++n) _Pragma("unroll") for (int k = 0; k < 2; ++k) \
      acc[ai][bj][m][n] = MFMA16(At[m][k], Bx[n][k], acc[ai][bj][m][n]); \
    SETPRIO(0); } while (0)
    int wid = tid >> 6, lane = tid & 63, wr = wid >> 2, wc = wid & 3, fr = lane & 15, fq = lane >> 4;
#pragma unroll
    for (int a = 0; a < 2; ++a)
#pragma unroll
        for (int b = 0; b < 2; ++b)
#pragma unroll
            for (int m = 0; m < 4; ++m)
#pragma unroll
                for (int n = 0; n < 2; ++n) acc[a][b][m][n] = (f32x4){0.f, 0.f, 0.f, 0.f};
    bf16x8 At[4][2], B0[2][2], B1[2][2];
    const int nt = K / BK;
    STAGE_B(SB(0, 0), 0, 0); STAGE_A(SA(0, 0), 0, 0);
    STAGE_B(SB(0, 1), 1, 0); STAGE_A(SA(0, 1), 1, 0);
    if (wr == 1) BAR();
    WAIT_V(4); BAR();
    STAGE_B(SB(1, 0), 0, 1); STAGE_A(SA(1, 0), 0, 1); STAGE_B(SB(1, 1), 1, 1);
    WAIT_V(6); BAR();
    for (int t = 0; t < nt - 2; t += 2) {
        LDB(B0, 0, 0); SCHED(); LDA(At, 0, 0); STAGE_A(SA(1, 1), 1, t + 1);
        WAIT_L(8); BAR(); WAIT_L(0); MMA(0, 0, At, B0); BAR(); SCHED();
        LDB(B1, 0, 1); STAGE_B(SB(0, 0), 0, t + 2);
        BAR(); WAIT_L(0); MMA(0, 1, At, B1); BAR();
        LDA(At, 0, 1); STAGE_A(SA(0, 0), 0, t + 2);
        BAR(); WAIT_L(0); MMA(1, 0, At, B0); BAR(); SCHED();
        STAGE_B(SB(0, 1), 1, t + 2);
        WAIT_V(6); BAR(); MMA(1, 1, At, B1); BAR();
        LDB(B0, 1, 0); SCHED(); LDA(At, 1, 0); STAGE_A(SA(0, 1), 1, t + 2);
        WAIT_L(8); BAR(); WAIT_L(0); MMA(0, 0, At, B0); BAR(); SCHED();
        LDB(B1, 1, 1); STAGE_B(SB(1, 0), 0, t + 3);
        BAR(); WAIT_L(0); MMA(0, 1, At, B1); BAR();
        LDA(At, 1, 1); STAGE_A(SA(1, 0), 0, t + 3);
        BAR(); WAIT_L(0); MMA(1, 0, At, B0); BAR(); SCHED();
        STAGE_B(SB(1, 1), 1, t + 3);
        WAIT_V(6); BAR(); MMA(1, 1, At, B1); BAR();
    }
    OPAQUE(tid); wid = tid >> 6; lane = tid & 63; wr = wid >> 2; wc = wid & 3; fr = lane & 15; fq = lane >> 4;
    { LDB(B0, 0, 0); WAIT_V(0); LDA(At, 0, 0); STAGE_A(SA(1, 1), 1, nt - 1);
      BAR(); WAIT_L(0); MMA(0, 0, At, B0); BAR();
      LDB(B1, 0, 1); BAR(); WAIT_L(0); MMA(0, 1, At, B1); BAR();
      LDA(At, 0, 1); WAIT_V(4); BAR(); WAIT_L(0); MMA(1, 0, At, B0); MMA(1, 1, At, B1); BAR(); }
    { LDB(B0, 1, 0); LDA(At, 1, 0); WAIT_V(2); BAR(); WAIT_L(0); MMA(0, 0, At, B0); BAR();
      LDB(B1, 1, 1); WAIT_V(0); BAR(); WAIT_L(0); MMA(0, 1, At, B1); BAR();
      LDA(At, 1, 1); BAR(); WAIT_L(0); MMA(1, 0, At, B0); MMA(1, 1, At, B1); BAR(); }
    if (wr == 0) BAR();
#undef SA
#undef SB
#undef STAGE_A
#undef STAGE_B
#undef LDA
#undef LDB
#undef MMA
}
__device__ __forceinline__ void stage_geom(int tid, int (&R)[2], int (&C)[2]) {
#pragma unroll
    for (int i = 0; i < 2; ++i) stage_rc(tid * 16 + i * 8192, R[i], C[i]);
}

constexpr int ATT_KBUF = 0, ATT_VBUF = 32768, ATT_CBUF = 65536;
template <int KIND>
__device__ __forceinline__ void attn_unit(const bf16_t* Q, const bf16_t* Kg, const bf16_t* VT, const float* cum2, const float* kmx, int qb, bf16_t* concat, int ccol0,
                                          float lam, float osc, const float* subg, unsigned char* lds, int tid) {
    const int lane = tid & 63, wave = tid >> 6, r16 = lane & 15, q4 = lane >> 4;
    const int q0w = qb * 128 + wave * 16, myq = q0w + r16;
    const int ntiles = 2 * qb + 2;
    const int wlimit = (KIND == 0) ? ((q0w + 15) >> 6) : (q0w >> 6);
    constexpr int NMAP = (KIND == 0) ? 1 : 2, NKS = (KIND == 0) ? 4 : 2;
    bf16x8 qf[NMAP][NKS];
#pragma unroll
    for (int mp = 0; mp < NMAP; ++mp)
#pragma unroll
        for (int ks = 0; ks < NKS; ++ks) qf[mp][ks] = *(const bf16x8*)(Q + (size_t)myq * 128 + mp * 64 + ks * 32 + q4 * 8);
    const float cq = (KIND == 0) ? cum2[myq] : 0.f;
    int kt0 = 0;
    if (KIND == 0) {
        float* wmax = (float*)(lds + ATT_CBUF + 512); int* kst = (int*)(lds + ATT_CBUF + 576);
        float qs = 0.f;
#pragma unroll
        for (int ks = 0; ks < NKS; ++ks)
#pragma unroll
            for (int j = 0; j < 8; ++j) { const float v = bf2f((bf16_t)qf[0][ks][j]); qs += v * v; }
        qs += SHX(qs, 16); qs += SHX(qs, 32);
        qs = fmaxf(qs, SHX(qs, 1)); qs = fmaxf(qs, SHX(qs, 2)); qs = fmaxf(qs, SHX(qs, 4)); qs = fmaxf(qs, SHX(qs, 8));
        if (lane == 0) wmax[wave] = qs;
        if (tid == 0) *kst = 2 * qb;
        __syncthreads();
        float qm = wmax[0];
#pragma unroll
        for (int w = 1; w < 8; ++w) qm = fmaxf(qm, wmax[w]);
        qm = sqrtf(qm) * 1.01f;
        const float kd = sqrtf(fmaxf(kmx[2 * qb], kmx[2 * qb + 1])) * 1.01f;
        if (tid < 2 * qb) {
            const float bias = cum2[qb * 128] - cum2[tid * 64 + 63];
            const bool skip = bias + qm * (sqrtf(kmx[tid]) * 1.01f + kd) < -40.f;
            if (!skip) atomic_min_int(kst, tid);
        }
        __syncthreads();
        kt0 = RFL(*kst);
    }
    f32x4 ot[NMAP][8];
    float mrun[NMAP], lsum[NMAP];
#pragma unroll
    for (int mp = 0; mp < NMAP; ++mp) { mrun[mp] = -INFINITY; lsum[mp] = 0.f;
#pragma unroll
        for (int mo = 0; mo < 8; ++mo) ot[mp][mo] = (f32x4){0.f, 0.f, 0.f, 0.f}; }
    u32x4 sk[2], sv[2]; float sc = 0.f;
    const u32x4* kg = (const u32x4*)Kg; const u32x4* vg = (const u32x4*)VT;
#pragma unroll
    for (int i = 0; i < 2; ++i) { sk[i] = kg[(size_t)kt0 * 1024 + tid + i * 512]; sv[i] = vg[(size_t)kt0 * 1024 + tid + i * 512]; }
    if (KIND == 0 && tid < 64) sc = cum2[kt0 * 64 + tid];
    for (int kt = kt0; kt < ntiles; ++kt) {
        unsigned char* kb = lds + ATT_KBUF + (kt & 1) * 16384;
        unsigned char* vb = lds + ATT_VBUF + (kt & 1) * 16384;
        float* cb = (float*)(lds + ATT_CBUF + (kt & 1) * 256);
#pragma unroll
        for (int i = 0; i < 2; ++i) {
            const int g = tid + i * 512;
            { const int row = g >> 4, c = g & 15; *(u32x4*)(kb + row * 256 + ((c ^ (row & 15)) << 4)) = sk[i]; }
            { const int d = g >> 3, c = g & 7; *(u32x4*)(vb + d * 128 + ((c ^ ((d >> 1) & 7)) << 4)) = sv[i]; }
        }
        if (KIND == 0 && tid < 64) cb[tid] = sc;
        __syncthreads();
        if (kt + 1 < ntiles) {
#pragma unroll
            for (int i = 0; i < 2; ++i) { sk[i] = kg[(size_t)(kt + 1) * 1024 + tid + i * 512]; sv[i] = vg[(size_t)(kt + 1) * 1024 + tid + i * 512]; }
            if (KIND == 0 && tid < 64) sc = cum2[(kt + 1) * 64 + tid];
        }
        if (kt <= wlimit) {
#pragma unroll
            for (int mp = 0; mp < NMAP; ++mp) {
                f32x4 st[4];
#pragma unroll
                for (int m = 0; m < 4; ++m) {
                    st[m] = (f32x4){0.f, 0.f, 0.f, 0.f};
#pragma unroll
                    for (int ks = 0; ks < NKS; ++ks) {
                        const int c = (KIND == 0 ? 0 : mp * 8) + ks * 4 + q4;
                        const bf16x8 kf = *(const bf16x8*)(kb + (m * 16 + r16) * 256 + ((c ^ r16) << 4));
                        st[m] = MFMA16(kf, qf[mp][ks], st[m]);
                    }
                }
                float mx = -INFINITY;
#pragma unroll
                for (int m = 0; m < 4; ++m) {
                    if (KIND == 0) {
                        const f32x4 ck = *(const f32x4*)(cb + m * 16 + 4 * q4);
#pragma unroll
                        for (int j = 0; j < 4; ++j) {
                            float y = st[m][j] + (cq - ck[j]);
                            if (kt * 64 + m * 16 + 4 * q4 + j > myq) y = -INFINITY;
                            st[m][j] = y;
                        }
                    }
#pragma unroll
                    for (int j = 0; j < 4; ++j) mx = fmaxf(mx, st[m][j]);
                }
                mx = fmaxf(mx, SHX(mx, 16));
                mx = fmaxf(mx, SHX(mx, 32));
                const float mnew = fmaxf(mrun[mp], mx);
                const float alpha = FAST_EXP2(mrun[mp] - mnew);
                mrun[mp] = mnew;
                float ps = 0.f;
#pragma unroll
                for (int m = 0; m < 4; ++m)
#pragma unroll
                    for (int j = 0; j < 4; ++j) { const float pv = FAST_EXP2(st[m][j] - mnew); st[m][j] = pv; ps += pv; }
                lsum[mp] = lsum[mp] * alpha + ps;
#pragma unroll
                for (int mo = 0; mo < 8; ++mo) ot[mp][mo] *= alpha;
#pragma unroll
                for (int kk = 0; kk < 2; ++kk) {
                    u32x4 pw;
                    pw.x = pack2(st[2 * kk][0], st[2 * kk][1]); pw.y = pack2(st[2 * kk][2], st[2 * kk][3]);
                    pw.z = pack2(st[2 * kk + 1][0], st[2 * kk + 1][1]); pw.w = pack2(st[2 * kk + 1][2], st[2 * kk + 1][3]);
                    const bf16x8 pf = __builtin_bit_cast(bf16x8, pw);
#pragma unroll
                    for (int mo = 0; mo < 8; ++mo) {
                        const int d = mo * 16 + r16, sw = (d >> 1) & 7;
                        const unsigned char* rowp = vb + d * 128 + (q4 & 1) * 8;
                        u32x4 vw;
                        const u32x2 lo = *(const u32x2*)(rowp + (((kk * 4 + (q4 >> 1)) ^ sw) << 4));
                        const u32x2 hi = *(const u32x2*)(rowp + (((kk * 4 + 2 + (q4 >> 1)) ^ sw) << 4));
                        vw.x = lo.x; vw.y = lo.y; vw.z = hi.x; vw.w = hi.y;
                        ot[mp][mo] = MFMA16(__builtin_bit_cast(bf16x8, vw), pf, ot[mp][mo]);
                    }
                }
            }
        }
    }
    float inv[NMAP];
#pragma unroll
    for (int mp = 0; mp < NMAP; ++mp) { float l = lsum[mp]; l += SHX(l, 16); l += SHX(l, 32); inv[mp] = 1.f / l; }
    if (KIND == 0) {
#pragma unroll
        for (int mo = 0; mo < 8; ++mo) {
            u32x2 o; o.x = pack2(ot[0][mo][0] * inv[0], ot[0][mo][1] * inv[0]); o.y = pack2(ot[0][mo][2] * inv[0], ot[0][mo][3] * inv[0]);
            *(u32x2*)(concat + (size_t)myq * D + ccol0 + mo * 16 + 4 * q4) = o;
        }
    } else {
        float ss = 0.f;
#pragma unroll
        for (int mo = 0; mo < 8; ++mo)
#pragma unroll
            for (int j = 0; j < 4; ++j) { const float v = ot[0][mo][j] * inv[0] - lam * (ot[NMAP - 1][mo][j] * inv[NMAP - 1]); ot[0][mo][j] = v; ss += v * v; }
        ss += SHX(ss, 16); ss += SHX(ss, 32);
        const float rs = osc / sqrtf(ss * (1.f / 128.f) + LN_EPS);
#pragma unroll
        for (int mo = 0; mo < 8; ++mo) {
            const f32x4 g = *(const f32x4*)(subg + mo * 16 + 4 * q4);
            u32x2 o; o.x = pack2(ot[0][mo][0] * rs * g[0], ot[0][mo][1] * rs * g[1]); o.y = pack2(ot[0][mo][2] * rs * g[2], ot[0][mo][3] * rs * g[3]);
            *(u32x2*)(concat + (size_t)myq * D + ccol0 + mo * 16 + 4 * q4) = o;
        }
    }
    __syncthreads();
}

__device__ __forceinline__ int dpart_row(int c, int q) { return c * (S - DCH * 64) - (DCH * 32) * c * (c - 1) + q; }
__device__ __forceinline__ void attn_dmap_unit(const bf16_t* Qh, const bf16_t* Kh, const bf16_t* VTh, int mp, int qb, int t0, int t1,
                                               bf16_t* Op, float* ML, int c, unsigned char* lds, int tid) {
    const int lane = tid & 63, wave = tid >> 6, r16 = lane & 15, q4 = lane >> 4;
    const int q0w = qb * 256 + wave * 32;
    const int wlimit = q0w >> 6;
    bf16x8 qf[2][2];
#pragma unroll
    for (int n = 0; n < 2; ++n)
#pragma unroll
        for (int ks = 0; ks < 2; ++ks) qf[n][ks] = *(const bf16x8*)(Qh + (size_t)(q0w + n * 16 + r16) * 128 + mp * 64 + ks * 32 + q4 * 8);
    f32x4 ot[8][2];
    float mrun[2] = {-INFINITY, -INFINITY}, lsum[2] = {0.f, 0.f};
#pragma unroll
    for (int mo = 0; mo < 8; ++mo) { ot[mo][0] = (f32x4){0.f, 0.f, 0.f, 0.f}; ot[mo][1] = (f32x4){0.f, 0.f, 0.f, 0.f}; }
    u32x4 sk, sv[2];
    const u32x4* kg = (const u32x4*)Kh; const u32x4* vg = (const u32x4*)VTh;
    const int krow = tid >> 3, kc8 = tid & 7;
    sk = kg[(size_t)t0 * 1024 + krow * 16 + mp * 8 + kc8];
#pragma unroll
    for (int i = 0; i < 2; ++i) sv[i] = vg[(size_t)t0 * 1024 + tid + i * 512];
    for (int kt = t0; kt < t1; ++kt) {
        unsigned char* kb = lds + (kt & 1) * 8192;
        unsigned char* vb = lds + 16384 + (kt & 1) * 16384;
        *(u32x4*)(kb + krow * 128 + ((kc8 ^ ((krow >> 1) & 7)) << 4)) = sk;
#pragma unroll
        for (int i = 0; i < 2; ++i) { const int g = tid + i * 512, d = g >> 3, cc = g & 7; *(u32x4*)(vb + d * 128 + ((cc ^ ((d >> 1) & 7)) << 4)) = sv[i]; }
        __syncthreads();
        if (kt + 1 < t1) {
            sk = kg[(size_t)(kt + 1) * 1024 + krow * 16 + mp * 8 + kc8];
#pragma unroll
            for (int i = 0; i < 2; ++i) sv[i] = vg[(size_t)(kt + 1) * 1024 + tid + i * 512];
        }
        if (kt <= wlimit) {
            f32x4 st[4][2];
#pragma unroll
            for (int m = 0; m < 4; ++m) {
                st[m][0] = (f32x4){0.f, 0.f, 0.f, 0.f}; st[m][1] = (f32x4){0.f, 0.f, 0.f, 0.f};
#pragma unroll
                for (int ks = 0; ks < 2; ++ks) {
                    const bf16x8 kf = *(const bf16x8*)(kb + (m * 16 + r16) * 128 + (((ks * 4 + q4) ^ ((r16 >> 1) & 7)) << 4));
                    st[m][0] = MFMA16(kf, qf[0][ks], st[m][0]);
                    st[m][1] = MFMA16(kf, qf[1][ks], st[m][1]);
                }
            }
            float alpha[2];
#pragma unroll
            for (int n = 0; n < 2; ++n) {
                float mx = -INFINITY;
#pragma unroll
                for (int m = 0; m < 4; ++m)
#pragma unroll
                    for (int j = 0; j < 4; ++j) mx = fmaxf(mx, st[m][n][j]);
                mx = fmaxf(mx, SHX(mx, 16));
                mx = fmaxf(mx, SHX(mx, 32));
                const float mnew = fmaxf(mrun[n], mx);
                alpha[n] = FAST_EXP2(mrun[n] - mnew);
                mrun[n] = mnew;
                float ps = 0.f;
#pragma unroll
                for (int m = 0; m < 4; ++m)
#pragma unroll
                    for (int j = 0; j < 4; ++j) { const float pv = FAST_EXP2(st[m][n][j] - mnew); st[m][n][j] = pv; ps += pv; }
                lsum[n] = lsum[n] * alpha[n] + ps;
            }
#pragma unroll
            for (int mo = 0; mo < 8; ++mo) { ot[mo][0] *= alpha[0]; ot[mo][1] *= alpha[1]; }
#pragma unroll
            for (int kk = 0; kk < 2; ++kk) {
                bf16x8 pf[2];
#pragma unroll
                for (int n = 0; n < 2; ++n) {
                    u32x4 pw;
                    pw.x = pack2(st[2 * kk][n][0], st[2 * kk][n][1]); pw.y = pack2(st[2 * kk][n][2], st[2 * kk][n][3]);
                    pw.z = pack2(st[2 * kk + 1][n][0], st[2 * kk + 1][n][1]); pw.w = pack2(st[2 * kk + 1][n][2], st[2 * kk + 1][n][3]);
                    pf[n] = __builtin_bit_cast(bf16x8, pw);
                }
#pragma unroll
                for (int mo = 0; mo < 8; ++mo) {
                    const int d = mo * 16 + r16, sw = (d >> 1) & 7;
                    const unsigned char* rowp = vb + d * 128 + (q4 & 1) * 8;
                    u32x4 vw;
                    const u32x2 lo = *(const u32x2*)(rowp + (((kk * 4 + (q4 >> 1)) ^ sw) << 4));
                    const u32x2 hi = *(const u32x2*)(rowp + (((kk * 4 + 2 + (q4 >> 1)) ^ sw) << 4));
                    vw.x = lo.x; vw.y = lo.y; vw.z = hi.x; vw.w = hi.y;
                    const bf16x8 vf = __builtin_bit_cast(bf16x8, vw);
                    ot[mo][0] = MFMA16(vf, pf[0], ot[mo][0]);
                    ot[mo][1] = MFMA16(vf, pf[1], ot[mo][1]);
                }
            }
        }
    }
    if (q0w >= DCH * 64 * c)
#pragma unroll
    for (int n = 0; n < 2; ++n) {
        float l = lsum[n]; l += SHX(l, 16); l += SHX(l, 32);
        const int row = dpart_row(c, q0w + n * 16 + r16);
#pragma unroll
        for (int mo = 0; mo < 8; ++mo) {
            u32x2 o; o.x = pack2(ot[mo][n][0], ot[mo][n][1]); o.y = pack2(ot[mo][n][2], ot[mo][n][3]);
            *(u32x2*)(Op + (size_t)(row * 128 + mo * 16 + 4 * q4)) = o;
        }
        if (q4 == 0) { ML[row * 2] = mrun[n]; ML[row * 2 + 1] = l; }
    }
    __syncthreads();
}

__device__ __forceinline__ void lru_unit_a(int chunk, int grp, int l, const Params& p, const bf16_t* Xr, const bf16_t* WaiT, float* hloc, float* ploc, float* sumA, float* sumH,
                                           unsigned char* lds, int tid) {
    const int lane = tid & 63, wave = tid >> 6, r16 = lane & 15, q4 = lane >> 4;
    unsigned char* XCB = lds; float* XU = (float*)(lds + 16384); float* LA = (float*)(lds + 49152); float* ENDS = (float*)(lds + 81920);
    const int t0 = chunk * 64, ch0 = grp * 128;
    {
        const int c = tid & 127, tq = tid >> 7, ch = ch0 + c;
        const float* cw = p.in[I_CONVW] + (size_t)l * 4 * LRU_W + ch; const float cb = p.in[I_CONVB][(size_t)l * LRU_W + ch];
        const float w0 = cw[0], w1 = cw[LRU_W], w2 = cw[2 * LRU_W], w3 = cw[3 * LRU_W];
        const int ts = t0 + tq * 16;
        float x0 = (ts - 3 >= 0) ? bf2f(Xr[(size_t)(ts - 3) * LRU_W + ch]) : 0.f;
        float x1 = (ts - 2 >= 0) ? bf2f(Xr[(size_t)(ts - 2) * LRU_W + ch]) : 0.f;
        float x2 = (ts - 1 >= 0) ? bf2f(Xr[(size_t)(ts - 1) * LRU_W + ch]) : 0.f;
#pragma unroll
        for (int i = 0; i < 16; ++i) {
            const float x3 = bf2f(Xr[(size_t)(ts + i) * LRU_W + ch]);
            const float v = cb + w0 * x0 + w1 * x1 + w2 * x2 + w3 * x3;
            const int row = tq * 16 + i;
            XU[row * 128 + c] = v;
            *(bf16_t*)(XCB + row * 256 + (((c >> 3) ^ (row & 15)) << 4) + (c & 7) * 2) = f2bf(v);
            x0 = x1; x1 = x2; x2 = x3;
        }
    }
    __syncthreads();
    {
        bf16x8 bfr[2][4];
#pragma unroll
        for (int g = 0; g < 2; ++g)
#pragma unroll
            for (int ks = 0; ks < 4; ++ks) bfr[g][ks] = *(const bf16x8*)(WaiT + ((size_t)grp * 256 + g * 128 + wave * 16 + r16) * 128 + ks * 32 + q4 * 8);
        const int ch = ch0 + wave * 16 + r16;
        const float ba = p.in[I_BA][(size_t)l * LRU_W + ch], bi = p.in[I_BI][(size_t)l * LRU_W + ch];
        const float lsl = 8.0f * log_sigmoid_f(p.in[I_LAM][(size_t)l * LRU_W + ch]);
#pragma unroll
        for (int mt = 0; mt < 4; ++mt) {
            f32x4 ga = (f32x4){0.f, 0.f, 0.f, 0.f}, gi = (f32x4){0.f, 0.f, 0.f, 0.f};
#pragma unroll
            for (int ks = 0; ks < 4; ++ks) {
                const bf16x8 af = *(const bf16x8*)(XCB + (mt * 16 + r16) * 256 + (((ks * 4 + q4) ^ r16) << 4));
                ga = MFMA16(af, bfr[0][ks], ga); gi = MFMA16(af, bfr[1][ks], gi);
            }
#pragma unroll
            for (int j = 0; j < 4; ++j) {
                const int row = mt * 16 + 4 * q4 + j, idx = row * 128 + wave * 16 + r16;
                const float r = sigmoid_f(ga[j] + ba), ig = sigmoid_f(gi[j] + bi);
                const float log_a = lsl * r;
                LA[idx] = fexp(log_a);
                XU[idx] = sqrtf(neg_expm1_f(2.f * log_a)) * (ig * XU[idx]);
            }
        }
    }
    __syncthreads();
    {
        const int c = tid & 127, tq = tid >> 7, ch = ch0 + c;
        float h = 0.f, P = 1.f;
#pragma unroll
        for (int i = 0; i < 16; ++i) { const int idx = (tq * 16 + i) * 128 + c; const float a = LA[idx]; h = a * h + XU[idx]; P *= a; XU[idx] = h; LA[idx] = P; }
        ENDS[tq * 128 + c] = P; ENDS[512 + tq * 128 + c] = h;
        __syncthreads();
        float cin = 0.f, pin = 1.f;
        for (int s = 0; s < tq; ++s) { const float Ps = ENDS[s * 128 + c], hs = ENDS[512 + s * 128 + c]; cin = Ps * cin + hs; pin *= Ps; }
#pragma unroll
        for (int i = 0; i < 16; ++i) {
            const int idx = (tq * 16 + i) * 128 + c; const size_t gi = (size_t)(t0 + tq * 16 + i) * LRU_W + ch;
            const float Pl = LA[idx], hl = XU[idx];
            hloc[gi] = hl + Pl * cin; ploc[gi] = Pl * pin;
        }
        if (tq == 3) { const float Pl = LA[63 * 128 + c], hl = XU[63 * 128 + c]; sumA[(size_t)chunk * LRU_W + ch] = Pl * pin; sumH[(size_t)chunk * LRU_W + ch] = hl + Pl * cin; }
    }
    __syncthreads();
}

__device__ __forceinline__ void moe_totals(const int* cntb_, int G, unsigned char* lds, int tid) {
    int* tmp = (int*)lds; int* ctot = (int*)(lds + LDS_MISC + M_CTOT); int* coff = (int*)(lds + LDS_MISC + M_COFF);
    int sm = 0;
    for (int b = tid >> 5; b < G; b += 16) sm += cntb_[b * 32 + (tid & 31)];
    tmp[tid] = sm;
    __syncthreads();
    if (tid < 32) { int c = 0; for (int q = 0; q < 16; ++q) c += tmp[q * 32 + tid]; ctot[tid] = c; }
    __syncthreads();
    if (tid == 0) { int o = 0; for (int e = 0; e < 32; ++e) { coff[e] = o; o += ctot[e]; } coff[32] = o; }
    __syncthreads();
}
__device__ __forceinline__ void moe_rowtable(const int* cntb_, const int* ltok_, const float* lw_, const int* lslot_, int e, int m0, int G, int segcap, unsigned char* lds, int tid) {
    int* sA = (int*)lds; int* rtok = (int*)(lds + LDS_MISC + M_RTOK); float* rw = (float*)(lds + LDS_MISC + M_RW); int* rslot = (int*)(lds + LDS_MISC + M_RSLOT);
    const int v = (tid < G) ? cntb_[tid * 32 + e] : 0;
    sA[tid] = v;
    if (tid < 256) { rtok[tid] = 0; rw[tid] = 0.f; rslot[tid] = 0; }
    __syncthreads();
    for (int d = 1; d < NTHREADS; d <<= 1) { int x = sA[tid]; if (tid >= d) x += sA[tid - d]; __syncthreads(); sA[tid] = x; __syncthreads(); }
    const int base = sA[tid] - v;
    for (int i = 0; i < v; ++i) {
        const int g = base + i - m0;
        if (g >= 0 && g < 256) { const int idx = (e * G + tid) * segcap + i; rtok[g] = ltok_[idx]; rw[g] = lw_[idx]; rslot[g] = lslot_[idx]; }
    }
    __syncthreads();
}

#define kmax2 ((float*)(wsl + A_KMAX))
#define dpo ((bf16_t*)(wsl + A_DPO))
#define dpml ((float*)(wsl + A_DPML))
#define cntb ((int*)(wsl + A_CNTB))
#define WinT ((bf16_t*)(wsl + WB_WIN))
#define WoT ((bf16_t*)(wsl + WB_WO))
#define WguT ((bf16_t*)(wsl + WB_WGU))
#define WdT ((bf16_t*)(wsl + WB_WD))
#define WaiT ((bf16_t*)(wsl + WB_WAI))
#define Wfa ((float*)(wsl + WF_FA))
#define W36b ((bf16_t*)(wsl + WF_R36))
#define ropecs ((float*)(wsl + WF_ROPE))
#define xb ((bf16_t*)(wsl + A_XB))
#define hb ((float*)(wsl + A_HB))
#define logf_ ((float*)(wsl + A_LOGF))
#define cum2 ((float*)(wsl + A_CUM))
#define Qa ((bf16_t*)(wsl + A_QA))
#define Ka ((bf16_t*)(wsl + A_KA))
#define VaT ((bf16_t*)(wsl + A_VAT))
#define Xr ((bf16_t*)(wsl + A_XR))
#define Gr ((bf16_t*)(wsl + A_GR))
#define Qc ((bf16_t*)(wsl + A_QC))
#define Kc ((bf16_t*)(wsl + A_KC))
#define VcT ((bf16_t*)(wsl + A_VCT))
#define hloc ((float*)(wsl + A_HLOC))
#define ploc ((float*)(wsl + A_PLOC))
#define sumA ((float*)(wsl + A_SUMA))
#define sumH ((float*)(wsl + A_SUMH))
#define concat ((bf16_t*)(wsl + A_CONCAT))
#define y1 ((float*)(wsl + A_Y1))
#define h1 ((float*)(wsl + A_H1))
#define h1b ((bf16_t*)(wsl + A_H1B))
#define ltok ((int*)(wsl + A_LTOK))
#define lw ((float*)(wsl + A_LW))
#define lslot ((int*)(wsl + A_LSLOT))
#define act ((bf16_t*)(wsl + A_ACT))
#define contrib ((float*)(wsl + A_CONTRIB))
#ifndef EMU
__global__ void __launch_bounds__(NTHREADS, 2)
#else
void
#endif
fwd_kernel(Params p) {
    DYN_LDS(lds_raw);
    float* ldsf = (float*)lds_raw;
    const int bid = blockIdx.x, G = gridDim.x;
    const int gthreads = G * NTHREADS, gwaves = G * (NTHREADS / 64);
    const int wave_s = RFL((int)threadIdx.x >> 6);
#define PHASE_IDS() unsigned char* wsl = ws; OPAQUE_S(wsl); int tid = wave_s * 64 + LANE_ID(); OPAQUE(tid); const int lane = tid & 63, wave = tid >> 6, gtid = bid * NTHREADS + tid, gwave = bid * (NTHREADS / 64) + wave; (void)lane; (void)wave; (void)gtid; (void)gwave

    unsigned char* ws = p.ws;
    volatile LAS unsigned* bst = (volatile LAS unsigned*)(lds_raw + LDS_MISC);
    unsigned* ubox = (unsigned*)(lds_raw + LDS_MISC + 16);
    if (threadIdx.x == 0) { bst[0] = 0u; bst[1] = 0u; bst[2] = 0u; bst[3] = 0u; }
    __syncthreads();
    XcdBarrier bar = xcd_barrier_post((unsigned*)ws, bst);

    const int* positions = (const int*)p.in[I_POS];

    constexpr int NPH = 8;
    const int lo = p.lo, hi = p.hi;
#ifdef ONLY_PHASE
#define PH_SEL(c) ((c) == ONLY_PHASE)
#else
#define PH_SEL(c) 1
#endif
#define PH_IN(k) (lo <= (k) && (k) < hi)
#define PH_BAR(k) do { if ((k) + 1 < hi) xcd_barrier(bar, wave_s == 0 && LANE_ID() == 0); } while (0)

    if (PH_SEL(-1) && PH_IN(0)) for (int rep = 0; rep < PH_REPS(-1); ++rep) {
        PHASE_IDS();
        for (int l = 0; l < DEPTH; ++l) {
            convert_mats(p.in[I_WIN] + (size_t)l * D * N_IN, 0, 1, N_IN, D, N_IN, WinT + (size_t)l * N_INP * D, 0, RmWin{}, ldsf, tid, bid, G);
            convert_mats(p.in[I_WO] + (size_t)l * D * D, 0, 1, D, D, D, WoT + (size_t)l * D * D, 0, RmIdent{}, ldsf, tid, bid, G);
            convert_mats(p.in[I_WGATE] + (size_t)l * NEXP * D * DFF, (size_t)D * DFF, NEXP, DFF, D, DFF, WguT + (size_t)l * NEXP * 1024 * D, (size_t)1024 * D, RmGu{0}, ldsf, tid, bid, G);
            convert_mats(p.in[I_WUP] + (size_t)l * NEXP * D * DFF, (size_t)D * DFF, NEXP, DFF, D, DFF, WguT + (size_t)l * NEXP * 1024 * D, (size_t)1024 * D, RmGu{1}, ldsf, tid, bid, G);
            convert_mats(p.in[I_WDOWN] + (size_t)l * NEXP * DFF * D, (size_t)DFF * D, NEXP, D, DFF, D, WdT + (size_t)l * NEXP * D * DFF, (size_t)D * DFF, RmIdent{}, ldsf, tid, bid, G);
            convert_mats(p.in[I_WA] + (size_t)l * 6 * 128 * 128, (size_t)128 * 128, 6, 128, 128, 128, WaiT + (size_t)l * 6 * 256 * 128, (size_t)256 * 128, RmIdent{}, ldsf, tid, bid, G);
            convert_mats(p.in[I_WI] + (size_t)l * 6 * 128 * 128, (size_t)128 * 128, 6, 128, 128, 128, WaiT + (size_t)l * 6 * 256 * 128, (size_t)256 * 128, RmOff{128}, ldsf, tid, bid, G);
        }
        for (int i = gtid; i < DEPTH * 8 * D; i += gthreads) { const int k = i % D, h = (i / D) % 8, l = i / (8 * D);
            Wfa[i] = (h < 6) ? p.in[I_WIN][(size_t)l * D * N_IN + (size_t)k * N_IN + C_FA + h] : 0.f; }
        for (int i = gtid; i < DEPTH * 48 * D; i += gthreads) { const int k = i % D, o = (i / D) % 48, l = i / (48 * D);
            const float w = (o < 4) ? p.in[I_WGRP][((size_t)l * D + k) * 4 + o] : (o < 36 ? p.in[I_WRT][((size_t)l * D + k) * 32 + (o - 4)] : 0.f);
            const bf16_t hi = f2bf(w);
            W36b[((size_t)l * 2 + 0) * 48 * D + (size_t)o * D + k] = hi; W36b[((size_t)l * 2 + 1) * 48 * D + (size_t)o * D + k] = f2bf(w - bf2f(hi)); }
        for (int i = gtid; i < S * 8; i += gthreads) { const int d = i & 7, t = i >> 3; const float ang = (float)positions[t] * p.inv_freq[d];
            ropecs[t * 16 + d] = cosf(ang); ropecs[t * 16 + 8 + d] = sinf(ang); }
        __syncthreads();
        for (int i = tid; i < 6 * D; i += NTHREADS) { const int k = i % D, h = i / D; ldsf[i] = p.in[I_WIN][(size_t)k * N_IN + C_FA + h]; }
        __syncthreads();
        for (int t = gwave; t < S; t += gwaves) {
            const float* xr = p.in[I_X] + (size_t)t * D;
            float fa[6] = {0.f, 0.f, 0.f, 0.f, 0.f, 0.f};
#pragma unroll
            for (int j = 0; j < 8; ++j) {
                const int c = j * 256 + lane * 4;
                const f32x4 v = *(const f32x4*)(xr + c);
                u32x2 o; o.x = pack2(v[0], v[1]); o.y = pack2(v[2], v[3]);
                *(u32x2*)(xb + (size_t)t * D + c) = o;
#pragma unroll
                for (int h = 0; h < 6; ++h) { const f32x4 w = *(const f32x4*)(ldsf + h * D + c); fa[h] += v[0] * w[0] + v[1] * w[1] + v[2] * w[2] + v[3] * w[3]; }
            }
#pragma unroll
            for (int h = 0; h < 6; ++h) { const float s = wave_sum(fa[h]); if (lane == 0) logf_[h * S + t] = log_sigmoid_f(s + p.in[I_BF][h]); }
        }
        PH_BAR(0);
    }

    for (int l = 0; l < DEPTH; ++l) {
        const int pb = 1 + l * NPH;
#define hin ((l == 0) ? p.in[I_X] : (const float*)hb)
#define hout ((l == DEPTH - 1) ? p.out : hb)
#define workctr ((int*)(wsl + CTL_WORK_OFF) + l * 64)

        if (PH_SEL(0) && PH_IN(pb + 0)) for (int rep = 0; rep < PH_REPS(0); ++rep) {
            PHASE_IDS();
            if (bid == 0) {
                double* part = (double*)lds_raw;
                const int per = S / 64;
                double s = 0.0;
                if (wave < 6) { for (int i = 0; i < per; ++i) s += (double)logf_[wave * S + lane * per + i]; part[wave * 64 + lane] = s; }
                __syncthreads();
                if (wave < 6) {
                    double run = 0.0;
                    for (int j = 0; j < lane; ++j) run += part[wave * 64 + j];
                    for (int i = 0; i < per; ++i) { run += (double)logf_[wave * S + lane * per + i]; cum2[wave * S + lane * per + i] = (float)(run * (double)LOG2E); }
                }
                __syncthreads();
            }
            const bf16_t* Bt = WinT + (size_t)l * N_INP * D;
            constexpr int ntn = N_INP / 256, ntm = S / 256;
            const unsigned nooff[2][2] = {{0u, 0u}, {0u, 0u}};
            for (int t = bid; t < ntm * ntn; t += G) {
                const int pm = t / ntn, pn = t % ntn;
                f32x4 acc[2][2][4][2];
                gemm_tile<false>(xb, pm * 256, nooff, Bt, pn * 256, D, lds_raw, acc, tid);
                int et = tid; OPAQUE(et); const int wr = et >> 8, wc = (et >> 6) & 3, fr = et & 15, fq = (et >> 4) & 3;
                if (pn < 6 || (pn >= 9 && pn < 19)) {
                    bf16_t* dst; float scale = 1.f; bool rope = false;
                    if (pn < 3) { dst = Qa; scale = QSCALE_A; } else if (pn < 6) { dst = Ka; } else if (pn < 12) { dst = Xr; } else if (pn < 15) { dst = Gr; }
                    else if (pn < 17) { dst = Qc; scale = QSCALE_C; rope = true; } else { dst = Kc; rope = true; }
                    const bool headmajor = (pn < 6) || (pn >= 15);
                    const int segpn = (pn < 3) ? pn : (pn < 6) ? pn - 3 : (pn < 12) ? pn - 9 : (pn < 15) ? pn - 12 : (pn < 17) ? pn - 15 : pn - 17;
#pragma unroll
                    for (int ai = 0; ai < 2; ++ai)
#pragma unroll
                        for (int m = 0; m < 4; ++m)
#pragma unroll
                            for (int bj = 0; bj < 2; ++bj)
#pragma unroll
                                for (int n = 0; n < 2; ++n) {
                                    const int dd = wc * 32 + n * 16 + fr;
#pragma unroll
                                    for (int j = 0; j < 4; ++j) {
                                        const int row = pm * 256 + ai * 128 + wr * 64 + m * 16 + fq * 4 + j;
                                        float v = acc[ai][bj][m][n][j];
                                        if (rope && n == 0 && (wc & 1) == 0) {
                                            const float pv = SHX(v, 8);
                                            const float cs = ropecs[row * 16 + (fr & 7)], sn = ropecs[row * 16 + 8 + (fr & 7)];
                                            v = (fr < 8) ? (v * cs - pv * sn) : (v * cs + pv * sn);
                                        }
                                        v *= scale;
                                        size_t idx;
                                        if (headmajor) idx = ((size_t)(segpn * 2 + bj) * S + row) * 128 + dd;
                                        else idx = (size_t)row * LRU_W + segpn * 256 + bj * 128 + dd;
                                        dst[idx] = f2bf(v);
                                    }
                                }
                    if (pn >= 3 && pn < 6) {
                        float* part = ldsf;
#pragma unroll
                        for (int ai = 0; ai < 2; ++ai)
#pragma unroll
                            for (int m = 0; m < 4; ++m)
#pragma unroll
                                for (int bj = 0; bj < 2; ++bj)
#pragma unroll
                                    for (int j = 0; j < 4; ++j) {
                                        float ss = acc[ai][bj][m][0][j] * acc[ai][bj][m][0][j] + acc[ai][bj][m][1][j] * acc[ai][bj][m][1][j];
                                        ss += SHX(ss, 1); ss += SHX(ss, 2); ss += SHX(ss, 4); ss += SHX(ss, 8);
                                        if (fr == 0) part[(wc * 2 + bj) * 256 + ai * 128 + wr * 64 + m * 16 + fq * 4 + j] = ss;
                                    }
                        __syncthreads();
                        {
                            const int bj = et >> 8, row = et & 255;
                            float v = part[(0 * 2 + bj) * 256 + row] + part[(1 * 2 + bj) * 256 + row] + part[(2 * 2 + bj) * 256 + row] + part[(3 * 2 + bj) * 256 + row];
                            v = fmaxf(v, SHX(v, 1)); v = fmaxf(v, SHX(v, 2)); v = fmaxf(v, SHX(v, 4)); v = fmaxf(v, SHX(v, 8)); v = fmaxf(v, SHX(v, 16)); v = fmaxf(v, SHX(v, 32));
                            if ((et & 63) == 0) kmax2[((pn - 3) * 2 + bj) * NKT + pm * 4 + ((et >> 6) & 3)] = v;
                        }
                        __syncthreads();
                    }
                } else {
                    bf16_t* dst = (pn < 9) ? VaT : VcT;
                    const int segpn = (pn < 9) ? pn - 6 : pn - 19;
#pragma unroll
                    for (int ai = 0; ai < 2; ++ai)
#pragma unroll
                        for (int m = 0; m < 4; ++m)
#pragma unroll
                            for (int bj = 0; bj < 2; ++bj)
#pragma unroll
                                for (int n = 0; n < 2; ++n) {
                                    const int dd = wc * 32 + n * 16 + fr;
                                    const int row = pm * 256 + ai * 128 + wr * 64 + m * 16 + fq * 4;
                                    const f32x4 a = acc[ai][bj][m][n];
                                    u32x2 o; o.x = pack2(a[0], a[1]); o.y = pack2(a[2], a[3]);
                                    *(u32x2*)(dst + (((size_t)(segpn * 2 + bj) * NKT + (row >> 6)) * 128 + dd) * 64 + (row & 63)) = o;
                                }
                }
            }
            PH_BAR(pb + 0);
        }

        if (PH_SEL(1) && PH_IN(pb + 1)) for (int rep = 0; rep < PH_REPS(1); ++rep) {
            PHASE_IDS();
            const float lam_init = (l == 0) ? 0.2f : 0.35550906759f;
            const float s1 = wave_sum(p.in[I_LQ1][l * 64 + lane] * p.in[I_LK1][l * 64 + lane]);
            const float s2 = wave_sum(p.in[I_LQ2][l * 64 + lane] * p.in[I_LK2][l * 64 + lane]);
            const float lam = fexp(s1) - fexp(s2) + lam_init;
            constexpr int NLRU = NKT * 6, NQB = S / 128;
#ifndef NO_LRU
            for (int r2 = 0; r2 < (REP_SUB == 1 ? 2 : 1); ++r2)
            for (int u = bid; u < NLRU; u += G)
                lru_unit_a(u / 6, u % 6, l, p, Xr, WaiT + (size_t)l * 6 * 256 * 128, hloc, ploc, sumA, sumH, lds_raw, tid);
#endif
#ifndef NO_DIFF
            {
                constexpr int NQB2 = S / 256;
                int total = 0;
                for (int q = 0; q < NQB2; ++q) total += ((4 * q + 4 + DCH - 1) / DCH) * 8;
                for (int r2 = 0; r2 < (REP_SUB == 2 ? 2 : 1); ++r2)
                for (;;) {
                    __syncthreads();
                    if (tid == 0) *ubox = (unsigned)atomic_add_int(workctr + 2 * rep + 4 * r2, 1);
                    __syncthreads();
                    int u = RFL((int)*ubox);
                    if (u >= total) break;
                    int qb = NQB2 - 1;
                    for (;; --qb) { const int nu = ((4 * qb + 4 + DCH - 1) / DCH) * 8; if (u < nu) break; u -= nu; }
                    const int c = u >> 3, h = (u >> 1) & 3, mp = u & 1;
                    const int t0 = c * DCH, t1 = (t0 + DCH < 4 * qb + 4) ? t0 + DCH : 4 * qb + 4;
                    attn_dmap_unit(Qc + (size_t)h * S * 128, Kc + (size_t)h * S * 128, VcT + (size_t)h * S * 128, mp, qb, t0, t1,
                                   dpo + (size_t)(h * 2 + mp) * DPART_ROWS * 128, dpml + (size_t)(h * 2 + mp) * DPART_ROWS * 2, c, lds_raw, tid);
                }
            }
#endif
#ifndef NO_FOX
            for (int r2 = 0; r2 < (REP_SUB == 3 ? 2 : 1); ++r2)
            for (;;) {
                __syncthreads();
                if (tid == 0) *ubox = (unsigned)atomic_add_int(workctr + 2 * rep + 1 + 4 * r2, 1);
                __syncthreads();
                const int u = RFL((int)*ubox);
                if (u >= NQB * FOX_H) break;
                const int qb = NQB - 1 - u / FOX_H, h = u % FOX_H;
                attn_unit<0>(Qa + (size_t)h * S * 128, Ka + (size_t)h * S * 128, VaT + (size_t)h * S * 128, cum2 + (size_t)h * S, kmax2 + h * NKT, qb, concat, h * 128,
                             0.f, 0.f, nullptr, lds_raw, tid);
            }
#endif
            PH_BAR(pb + 1);
        }

        if (PH_SEL(2) && PH_IN(pb + 2)) for (int rep = 0; rep < PH_REPS(2); ++rep) {
            PHASE_IDS();
            for (int u = bid; u < NKT * 6; u += G) {
                const int chunk = u / 6, grp = u % 6, c = tid & 127, tq = tid >> 7, ch = grp * 128 + c;
                float cr = 0.f;
                {
                    int j = 0;
                    for (; j + 8 <= chunk; j += 8) {
                        float a8[8], h8[8];
#pragma unroll
                        for (int q = 0; q < 8; ++q) { a8[q] = sumA[(size_t)(j + q) * LRU_W + ch]; h8[q] = sumH[(size_t)(j + q) * LRU_W + ch]; }
#pragma unroll
                        for (int q = 0; q < 8; ++q) cr = a8[q] * cr + h8[q];
                    }
                    for (; j < chunk; ++j) cr = sumA[(size_t)j * LRU_W + ch] * cr + sumH[(size_t)j * LRU_W + ch];
                }
#pragma unroll 4
                for (int i = 0; i < 16; ++i) {
                    const size_t gi = (size_t)(chunk * 64 + tq * 16 + i) * LRU_W + ch;
                    const float h = hloc[gi] + ploc[gi] * cr;
                    concat[(size_t)(chunk * 64 + tq * 16 + i) * D + FOX_W + ch] = f2bf(gelu_tanh_f(bf2f(Gr[gi])) * h);
                }
            }
            {
                const float lam_init = (l == 0) ? 0.2f : 0.35550906759f;
                const float s1 = wave_sum(p.in[I_LQ1][l * 64 + lane] * p.in[I_LK1][l * 64 + lane]);
                const float s2 = wave_sum(p.in[I_LQ2][l * 64 + lane] * p.in[I_LK2][l * 64 + lane]);
                const float lam = fexp(s1) - fexp(s2) + lam_init;
                const float* sg = p.in[I_SUBG] + l * 128;
                const float g0 = sg[2 * lane], g1 = sg[2 * lane + 1];
                static_assert(NCH <= 8, "the merge below keeps one (map, chunk) pair per lane: 2 x 8 lanes");
                for (int idx = gwave; idx < S * DIFF_H; idx += gwaves) {
                    const int h = idx & 3, q = idx >> 2, nch = (q >> 6) / DCH + 1;
                    float mv = -INFINITY, lv = 0.f;
                    { const int c = lane & 7, mp = (lane >> 3) & 1;
                      if (lane < 16 && c < nch) { const float* ML = dpml + ((size_t)(h * 2 + mp) * DPART_ROWS + dpart_row(c, q)) * 2; mv = ML[0]; lv = ML[1]; } }
                    float Mx = mv; Mx = fmaxf(Mx, SHX(Mx, 1)); Mx = fmaxf(Mx, SHX(Mx, 2)); Mx = fmaxf(Mx, SHX(Mx, 4));
                    const float wv = (mv == -INFINITY) ? 0.f : FAST_EXP2(mv - Mx);
                    float Lp = lv * wv; Lp += SHX(Lp, 1); Lp += SHX(Lp, 2); Lp += SHX(Lp, 4);
                    float om[2][2];
#pragma unroll
                    for (int mp = 0; mp < 2; ++mp) {
                        const unsigned* OP = (const unsigned*)(dpo + (size_t)(h * 2 + mp) * DPART_ROWS * 128);
                        unsigned pk[NCH];
#pragma unroll
                        for (int c = 0; c < NCH; ++c) pk[c] = (c < nch) ? OP[(size_t)dpart_row(c, q) * 64 + lane] : 0u;
                        float o0 = 0.f, o1 = 0.f;
#pragma unroll
                        for (int c = 0; c < NCH; ++c) { const float w = RDLANE(wv, mp * 8 + c); o0 += bf2f((bf16_t)(pk[c] & 0xffffu)) * w; o1 += bf2f((bf16_t)(pk[c] >> 16)) * w; }
                        const float il = 1.f / RDLANE(Lp, mp * 8);
                        om[mp][0] = o0 * il; om[mp][1] = o1 * il;
                    }
                    const float v0 = om[0][0] - lam * om[1][0], v1 = om[0][1] - lam * om[1][1];
                    const float ss = wave_sum(v0 * v0 + v1 * v1);
                    const float rs = (1.f - lam_init) / sqrtf(ss * (1.f / 128.f) + LN_EPS);
                    *(unsigned*)(concat + (size_t)q * D + 1536 + h * 128 + 2 * lane) = pack2(v0 * rs * g0, v1 * rs * g1);
                }
            }
            PH_BAR(pb + 2);
        }

        if (PH_SEL(3) && PH_IN(pb + 3)) for (int rep = 0; rep < PH_REPS(3); ++rep) {
            PHASE_IDS();
            const bf16_t* Bt = WoT + (size_t)l * D * D;
            constexpr int ntn = D / 256, ntm = S / 256;
            const unsigned nooff[2][2] = {{0u, 0u}, {0u, 0u}};
            for (int t = bid; t < ntm * ntn; t += G) {
                const int pm = t / ntn, pn = t % ntn;
                f32x4 acc[2][2][4][2];
                gemm_tile<false>(concat, pm * 256, nooff, Bt, pn * 256, D, lds_raw, acc, tid);
                int et = tid; OPAQUE(et); const int wr = et >> 8, wc = (et >> 6) & 3, fr = et & 15, fq = (et >> 4) & 3;
#pragma unroll
                for (int ai = 0; ai < 2; ++ai)
#pragma unroll
                    for (int m = 0; m < 4; ++m)
#pragma unroll
                        for (int j = 0; j < 4; ++j) {
                            const size_t rbase = (size_t)(pm * 256 + ai * 128 + wr * 64 + m * 16 + fq * 4 + j) * D + pn * 256 + wc * 32 + fr;
#pragma unroll
                            for (int bj = 0; bj < 2; ++bj)
#pragma unroll
                                for (int n = 0; n < 2; ++n) { const size_t i2 = rbase + bj * 128 + n * 16; y1[i2] = ALPHA * hin[i2] + acc[ai][bj][m][n][j]; }
                        }
            }
            PH_BAR(pb + 3);
        }

        if (PH_SEL(4) && PH_IN(pb + 4)) for (int rep = 0; rep < PH_REPS(4); ++rep) {
            PHASE_IDS();
            const float* g1 = p.in[I_LN1G] + (size_t)l * D; const float* b1 = p.in[I_LN1B] + (size_t)l * D;
            const float* bg = p.in[I_BGRP] + l * 4; const float* br = p.in[I_BRT] + l * 32;
            const bf16_t* Wb = W36b + (size_t)l * 2 * 48 * D;
            int* lcnt = (int*)(lds_raw + LDS_MISC + M_LCNT);
            const int segcap = ((S / 16 + G - 1) / G) * 16;
            const int r16 = lane & 15, q4 = lane >> 4;
            if (tid < 32) lcnt[tid] = 0;
            __syncthreads();
            for (int bi = bid; bi < S / 16; bi += G) {
#pragma unroll 1
                for (int tk = 0; tk < 2; ++tk) {
                    const int r = wave * 2 + tk, t = bi * 16 + r;
                    f32x4 v[8]; float s = 0.f;
#pragma unroll
                    for (int j = 0; j < 8; ++j) { v[j] = *(const f32x4*)(y1 + (size_t)t * D + j * 256 + lane * 4); s += (v[j][0] + v[j][1]) + (v[j][2] + v[j][3]); }
                    const float mean = wave_sum(s) * (1.f / D);
                    float s2 = 0.f;
#pragma unroll
                    for (int j = 0; j < 8; ++j) { v[j] -= mean; s2 += (v[j][0] * v[j][0] + v[j][1] * v[j][1]) + (v[j][2] * v[j][2] + v[j][3] * v[j][3]); }
                    const float rstd = 1.f / sqrtf(wave_sum(s2) * (1.f / D) + LN_EPS);
#pragma unroll
                    for (int j = 0; j < 8; ++j) {
                        const int c = j * 256 + lane * 4;
                        const f32x4 g = *(const f32x4*)(g1 + c), b = *(const f32x4*)(b1 + c);
                        v[j] = v[j] * rstd * g + b;
                        *(f32x4*)(h1 + (size_t)t * D + c) = v[j];
                        u32x2 o; o.x = pack2(v[j][0], v[j][1]); o.y = pack2(v[j][2], v[j][3]);
                        *(u32x2*)(h1b + (size_t)t * D + c) = o;
                        u32x2 lo2;
                        lo2.x = pack2(v[j][0] - bf2f((bf16_t)(o.x & 0xffffu)), v[j][1] - bf2f((bf16_t)(o.x >> 16)));
                        lo2.y = pack2(v[j][2] - bf2f((bf16_t)(o.y & 0xffffu)), v[j][3] - bf2f((bf16_t)(o.y >> 16)));
                        const int la = r * 4096 + (((j * 32 + (lane >> 1)) ^ r) << 4) + (lane & 1) * 8;
                        *(u32x2*)(lds_raw + la) = o; *(u32x2*)(lds_raw + 65536 + la) = lo2;
                    }
                }
                __syncthreads();
                f32x4 ac[3];
#pragma unroll
                for (int nt = 0; nt < 3; ++nt) ac[nt] = (f32x4){0.f, 0.f, 0.f, 0.f};
#pragma unroll 2
                for (int ks = 0; ks < 8; ++ks) {
                    const int kk = wave * 8 + ks;
                    const int la = r16 * 4096 + (((kk * 4 + q4) ^ r16) << 4);
                    const bf16x8 ah = *(const bf16x8*)(lds_raw + la), al = *(const bf16x8*)(lds_raw + 65536 + la);
#pragma unroll
                    for (int nt = 0; nt < 3; ++nt) {
                        const bf16x8 bh = *(const bf16x8*)(Wb + (size_t)(nt * 16 + r16) * D + kk * 32 + q4 * 8);
                        const bf16x8 bl = *(const bf16x8*)(Wb + (size_t)48 * D + (size_t)(nt * 16 + r16) * D + kk * 32 + q4 * 8);
                        ac[nt] = MFMA16(ah, bh, ac[nt]); ac[nt] = MFMA16(al, bh, ac[nt]); ac[nt] = MFMA16(ah, bl, ac[nt]);
                    }
                }
                __syncthreads();
                float* red = ldsf;
#pragma unroll
                for (int nt = 0; nt < 3; ++nt)
#pragma unroll
                    for (int j = 0; j < 4; ++j) red[(wave * 16 + q4 * 4 + j) * 48 + nt * 16 + r16] = ac[nt][j];
                __syncthreads();
                float* lgt = ldsf + 8 * 16 * 48;
                if (tid < 256) {
                    const int tkn = tid >> 4, o3 = (tid & 15) * 3;
#pragma unroll
                    for (int q = 0; q < 3; ++q) { float a = 0.f;
#pragma unroll
                        for (int w = 0; w < 8; ++w) a += red[(w * 16 + tkn) * 48 + o3 + q];
                        lgt[tkn * 48 + o3 + q] = a; }
                }
                __syncthreads();
                if (tid < 16) {
                    const int t = bi * 16 + tid; const float* L = lgt + tid * 48;
                    float gl[4];
#pragma unroll
                    for (int q = 0; q < 4; ++q) gl[q] = L[q] + bg[q];
                    int gi = 0; float gm = gl[0];
#pragma unroll
                    for (int q = 1; q < 4; ++q) if (gl[q] > gm) { gm = gl[q]; gi = q; }
                    float gs = 0.f;
#pragma unroll
                    for (int q = 0; q < 4; ++q) gs += fexp(gl[q] - gm);
                    const float gweight = 1.f / gs;
                    float E[8];
#pragma unroll
                    for (int e = 0; e < 8; ++e) E[e] = L[4 + gi * 8 + e] + br[gi * 8 + e];
                    int e1 = 0; float m1 = E[0];
#pragma unroll
                    for (int e = 1; e < 8; ++e) if (E[e] > m1) { m1 = E[e]; e1 = e; }
                    int e2 = -1; float m2 = -INFINITY;
#pragma unroll
                    for (int e = 0; e < 8; ++e) if (e != e1 && E[e] > m2) { m2 = E[e]; e2 = e; }
                    const float p2 = fexp(m2 - m1), w1 = 1.f / (1.f + p2), w2 = p2 / (1.f + p2);
                    const int ge1 = gi * 8 + e1, ge2 = gi * 8 + e2;
                    const int i1 = (ge1 * G + bid) * segcap + atomic_add_int(&lcnt[ge1], 1);
                    ltok[i1] = t; lw[i1] = gweight * w1; lslot[i1] = 0;
                    const int i2 = (ge2 * G + bid) * segcap + atomic_add_int(&lcnt[ge2], 1);
                    ltok[i2] = t; lw[i2] = gweight * w2; lslot[i2] = 1;
                }
                __syncthreads();
            }
            if (tid < 32) cntb[bid * 32 + tid] = lcnt[tid];
            PH_BAR(pb + 4);
        }

        if (PH_SEL(5) && PH_IN(pb + 5)) for (int rep = 0; rep < PH_REPS(5); ++rep) {
            PHASE_IDS();
            const int segcap = ((S / 16 + G - 1) / G) * 16;
            moe_totals(cntb, G, lds_raw, tid);
            const int* ctot = (const int*)(lds_raw + LDS_MISC + M_CTOT); const int* coff = (const int*)(lds_raw + LDS_MISC + M_COFF);
            const int* rtok = (const int*)(lds_raw + LDS_MISC + M_RTOK); const float* rw = (const float*)(lds_raw + LDS_MISC + M_RW);
            int tile_id = 0;
            for (int e = 0; e < NEXP; ++e) {
                const int c = RFL(ctot[e]), off = RFL(coff[e]);
                const int ntm = (c + 255) / 256;
                const bf16_t* Bt = WguT + ((size_t)l * NEXP + e) * 1024 * D;
                for (int t = 0; t < ntm * 4; ++t, ++tile_id) {
                    if (tile_id % G != bid) continue;
                    const int m0 = (t >> 2) * 256, pn = t & 3;
                    moe_rowtable(cntb, ltok, lw, lslot, e, m0, G, segcap, lds_raw, tid);
                    unsigned aoff[2][2];
                    int st = tid; OPAQUE(st); int R[2], C[2]; stage_geom(st, R, C);
#pragma unroll
                    for (int h = 0; h < 2; ++h)
#pragma unroll
                        for (int i = 0; i < 2; ++i) aoff[h][i] = (unsigned)(rtok[h * 128 + R[i]] * D + C[i]);
                    f32x4 acc[2][2][4][2];
                    gemm_tile<true>(h1b, 0, aoff, Bt, pn * 256, D, lds_raw, acc, tid);
                    int et = tid; OPAQUE(et); const int wr = et >> 8, wc = (et >> 6) & 3, fr = et & 15, fq = (et >> 4) & 3;
#pragma unroll
                    for (int ai = 0; ai < 2; ++ai)
#pragma unroll
                        for (int m = 0; m < 4; ++m)
#pragma unroll
                            for (int j = 0; j < 4; ++j) {
                                const int r = ai * 128 + wr * 64 + m * 16 + fq * 4 + j, gm = m0 + r;
                                COMPILER_FENCE();
                                if (gm < c) {
                                    const float wgt = rw[r];
#pragma unroll
                                    for (int bj = 0; bj < 2; ++bj) {
                                        const int f = pn * 128 + bj * 64 + wc * 16 + fr;
                                        act[(size_t)(off + gm) * DFF + f] = f2bf(silu_f(acc[ai][bj][m][0][j]) * acc[ai][bj][m][1][j] * wgt);
                                    }
                                }
                            }
                    __syncthreads();
                }
            }
            PH_BAR(pb + 5);
        }

        if (PH_SEL(6) && PH_IN(pb + 6)) for (int rep = 0; rep < PH_REPS(6); ++rep) {
            PHASE_IDS();
            const unsigned nooff[2][2] = {{0u, 0u}, {0u, 0u}};
            const int segcap = ((S / 16 + G - 1) / G) * 16;
            moe_totals(cntb, G, lds_raw, tid);
            const int* ctot = (const int*)(lds_raw + LDS_MISC + M_CTOT); const int* coff = (const int*)(lds_raw + LDS_MISC + M_COFF);
            const int* rtok = (const int*)(lds_raw + LDS_MISC + M_RTOK); const int* rslot = (const int*)(lds_raw + LDS_MISC + M_RSLOT);
            int tile_id = 0;
            for (int e = 0; e < NEXP; ++e) {
                const int c = RFL(ctot[e]), off = RFL(coff[e]);
                const int ntm = (c + 255) / 256;
                const bf16_t* Bt = WdT + ((size_t)l * NEXP + e) * D * DFF;
                for (int t = 0; t < ntm * 8; ++t, ++tile_id) {
                    if (tile_id % G != bid) continue;
                    const int m0 = (t >> 3) * 256, pn = t & 7;
                    moe_rowtable(cntb, ltok, lw, lslot, e, m0, G, segcap, lds_raw, tid);
                    f32x4 acc[2][2][4][2];
                    gemm_tile<false>(act, off + m0, nooff, Bt, pn * 256, DFF, lds_raw, acc, tid);
                    int et = tid; OPAQUE(et); const int wr = et >> 8, wc = (et >> 6) & 3, fr = et & 15, fq = (et >> 4) & 3;
#pragma unroll
                    for (int ai = 0; ai < 2; ++ai)
#pragma unroll
                        for (int m = 0; m < 4; ++m)
#pragma unroll
                            for (int j = 0; j < 4; ++j) {
                                const int r = ai * 128 + wr * 64 + m * 16 + fq * 4 + j, gm = m0 + r;
                                COMPILER_FENCE();
                                if (gm < c) {
                                    float* dst = contrib + ((size_t)rslot[r] * S + rtok[r]) * D + pn * 256 + wc * 32 + fr;
#pragma unroll
                                    for (int bj = 0; bj < 2; ++bj)
#pragma unroll
                                        for (int n = 0; n < 2; ++n) dst[bj * 128 + n * 16] = acc[ai][bj][m][n][j];
                                }
                            }
                    __syncthreads();
                }
            }
            PH_BAR(pb + 6);
        }

        if (PH_SEL(7) && PH_IN(pb + 7)) for (int rep = 0; rep < PH_REPS(7); ++rep) {
            PHASE_IDS();
            const float* g2 = p.in[I_LN2G] + (size_t)l * D; const float* b2 = p.in[I_LN2B] + (size_t)l * D;
            const bool more = (l + 1 < DEPTH);
            const float* wf = Wfa + (size_t)(l + 1 < DEPTH ? l + 1 : l) * 8 * D;
            for (int t = gwave; t < S; t += gwaves) {
                f32x4 v[8]; float s = 0.f;
#pragma unroll
                for (int j = 0; j < 8; ++j) {
                    const size_t i = (size_t)t * D + j * 256 + lane * 4;
                    v[j] = ALPHA * *(const f32x4*)(h1 + i) + *(const f32x4*)(contrib + i) + *(const f32x4*)(contrib + (size_t)S * D + i);
                    s += (v[j][0] + v[j][1]) + (v[j][2] + v[j][3]);
                }
                const float mean = wave_sum(s) * (1.f / D);
                float s2 = 0.f;
#pragma unroll
                for (int j = 0; j < 8; ++j) { v[j] -= mean; s2 += (v[j][0] * v[j][0] + v[j][1] * v[j][1]) + (v[j][2] * v[j][2] + v[j][3] * v[j][3]); }
                const float rstd = 1.f / sqrtf(wave_sum(s2) * (1.f / D) + LN_EPS);
                float fa[6] = {0.f, 0.f, 0.f, 0.f, 0.f, 0.f};
#pragma unroll
                for (int j = 0; j < 8; ++j) {
                    const int c = j * 256 + lane * 4;
                    const f32x4 g = *(const f32x4*)(g2 + c), b = *(const f32x4*)(b2 + c);
                    v[j] = v[j] * rstd * g + b;
                    *(f32x4*)(hout + (size_t)t * D + c) = v[j];
                    COMPILER_FENCE();
                    if (more) {
                        u32x2 o; o.x = pack2(v[j][0], v[j][1]); o.y = pack2(v[j][2], v[j][3]);
                        *(u32x2*)(xb + (size_t)t * D + c) = o;
#pragma unroll
                        for (int h = 0; h < 6; ++h) { const f32x4 w = *(const f32x4*)(wf + h * D + c); fa[h] += (v[j][0] * w[0] + v[j][1] * w[1]) + (v[j][2] * w[2] + v[j][3] * w[3]); }
                    }
                }
                if (more) {
#pragma unroll
                    for (int h = 0; h < 6; ++h) { const float sm = wave_sum(fa[h]); if (lane == 0) logf_[h * S + t] = log_sigmoid_f(sm + p.in[I_BF][(l + 1) * 6 + h]); }
                }
            }
            PH_BAR(pb + 7);
        }
    }
#undef PH_IN
#undef PH_BAR
}

constexpr int N_PHASES = 1 + DEPTH * 8;
#ifndef EMU
extern "C" void kernel_launch(void* const* d_in, const int* in_sizes, int n_in, void* d_out, int out_size, void* d_ws, size_t ws_size, hipStream_t stream) {
    static int grid = 0;
    if (grid == 0) {
        if (n_in != N_INPUTS || out_size != S * D || ws_size < WS_END) {
            fprintf(stderr, "kernel_launch: unexpected shapes: n_in %d out %d ws %zu (need %zu)\n", n_in, out_size, ws_size, (size_t)WS_END); grid = -1; return; }
        int dev = 0, cus = 0, per_cu = 0;
        if (hipGetDevice(&dev) != hipSuccess || hipDeviceGetAttribute(&cus, hipDeviceAttributeMultiprocessorCount, dev) != hipSuccess) { grid = -1; return; }
        if (hipFuncSetAttribute((const void*)fwd_kernel, hipFuncAttributeMaxDynamicSharedMemorySize, LDS_BYTES) != hipSuccess) { fprintf(stderr, "kernel_launch: hipFuncSetAttribute failed\n"); grid = -1; return; }
        if (hipOccupancyMaxActiveBlocksPerMultiprocessor(&per_cu, (const void*)fwd_kernel, NTHREADS, LDS_BYTES) != hipSuccess || per_cu < 1) {
            fprintf(stderr, "kernel_launch: occupancy query says %d blocks per CU\n", per_cu); (void)hipGetLastError(); grid = -1; return; }
        grid = cus;
    }
    if (grid < 0) return;
    (void)hipMemsetAsync(d_ws, 0, CTL_BYTES, stream);
    Params p{};
    for (int i = 0; i < N_INPUTS; ++i) p.in[i] = (const float*)d_in[i];
    p.out = (float*)d_out; p.ws = (unsigned char*)d_ws;
    for (int i = 0; i < 8; ++i) p.inv_freq[i] = (float)pow(500000.0, -(double)i * 2.0 / 16.0);
#if N_LAUNCH_SPLIT
    for (int k = 0; k < N_PHASES; ++k) { p.lo = k; p.hi = k + 1; hipLaunchKernelGGL(fwd_kernel, dim3(grid), dim3(NTHREADS), LDS_BYTES, stream, p); }
#else
    p.lo = 0; p.hi = N_PHASES;
    hipLaunchKernelGGL(fwd_kernel, dim3(grid), dim3(NTHREADS), LDS_BYTES, stream, p);
#endif
}
#endif
```

```cpp
#ifndef EMU
#include <hip/hip_runtime.h>
#include <cstdio>
#include <cstdint>
#include <cmath>
#endif

#ifndef SEQ
#define SEQ 8192
#endif
#ifndef N_LAUNCH_SPLIT
#define N_LAUNCH_SPLIT 0
#endif
#ifndef REP_PHASE
#define REP_PHASE -2
#endif
#define PH_REPS(c) ((c) == REP_PHASE ? 2 : 1)
#ifndef REP_SUB
#define REP_SUB 0
#endif

constexpr int S = SEQ, D = 2048, DEPTH = 2;
constexpr int FOX_H = 6, FOX_W = 768;
constexpr int LRU_W = 768;
constexpr int DIFF_H = 4, DIFF_W = 512;
constexpr int N_IN = 5382, N_INP = 5376;
constexpr int C_FA = 2304;
constexpr int NEXP = 32, DFF = 512;
constexpr int NKT = S / 64;
#ifndef DCH
#define DCH 16
#endif
constexpr int NCH = (NKT + DCH - 1) / DCH;
constexpr size_t DPART_ROWS = (size_t)NCH * S - (size_t)(DCH * 64) * NCH * (NCH - 1) / 2;
constexpr float ALPHA = 1.41421356237309504880f;
constexpr float LN_EPS = 1e-5f;
constexpr float LOG2E = 1.4426950408889634f;
constexpr float QSCALE_A = 0.08838834764831845f * 1.4426950408889634f;
constexpr float QSCALE_C = 0.125f * 1.4426950408889634f;

enum { I_X = 0, I_POS, I_WIN, I_BF, I_CONVW, I_CONVB, I_WA, I_BA, I_WI, I_BI, I_LAM, I_LQ1, I_LK1, I_LQ2, I_LK2, I_SUBG, I_WO, I_LN1G, I_LN1B,
       I_WGRP, I_BGRP, I_WRT, I_BRT, I_WGATE, I_WUP, I_WDOWN, I_LN2G, I_LN2B, N_INPUTS };

typedef unsigned short bf16_t;
typedef short bf16x8 __attribute__((ext_vector_type(8)));
typedef float f32x4 __attribute__((ext_vector_type(4)));
typedef unsigned u32x4 __attribute__((ext_vector_type(4)));
typedef unsigned u32x2 __attribute__((ext_vector_type(2)));

constexpr size_t al256(size_t x) { return (x + 255) & ~(size_t)255; }
constexpr size_t CTL_BYTES = 65536;
constexpr size_t CTL_CNT_OFF = 32768;
constexpr size_t CTL_WORK_OFF = 36864;
constexpr size_t CTL_DONE_OFF = 40960;
constexpr size_t WB_WIN = CTL_BYTES;
constexpr size_t WB_WO = WB_WIN + al256((size_t)DEPTH * N_INP * D * 2);
constexpr size_t WB_WGU = WB_WO + al256((size_t)DEPTH * D * D * 2);
constexpr size_t WB_WD = WB_WGU + al256((size_t)DEPTH * NEXP * 1024 * D * 2);
constexpr size_t WB_WAI = WB_WD + al256((size_t)DEPTH * NEXP * D * DFF * 2);
constexpr size_t WF_FA = WB_WAI + al256((size_t)DEPTH * 6 * 256 * 128 * 2);
constexpr size_t WF_R36 = WF_FA + al256((size_t)DEPTH * 8 * D * 4);
constexpr size_t WF_ROPE = WF_R36 + al256((size_t)DEPTH * 2 * 48 * D * 2);
constexpr size_t A_XB = WF_ROPE + al256((size_t)S * 16 * 4);
constexpr size_t A_HB = A_XB + al256((size_t)S * D * 2);
constexpr size_t A_LOGF = A_HB + al256((size_t)S * D * 4);
constexpr size_t A_CUM = A_LOGF + al256((size_t)6 * S * 4);
constexpr size_t A_KMAX = A_CUM + al256((size_t)6 * S * 4);
constexpr size_t A_CNTB = A_KMAX + al256((size_t)6 * NKT * 4);
constexpr size_t A_QA = A_CNTB + al256((size_t)1024 * 32 * 4);
constexpr size_t A_KA = A_QA + al256((size_t)FOX_H * S * 128 * 2);
constexpr size_t A_VAT = A_KA + al256((size_t)FOX_H * S * 128 * 2);
constexpr size_t A_XR = A_VAT + al256((size_t)FOX_H * S * 128 * 2);
constexpr size_t A_GR = A_XR + al256((size_t)S * LRU_W * 2);
constexpr size_t A_QC = A_GR + al256((size_t)S * LRU_W * 2);
constexpr size_t A_KC = A_QC + al256((size_t)DIFF_H * S * 128 * 2);
constexpr size_t A_VCT = A_KC + al256((size_t)DIFF_H * S * 128 * 2);
constexpr size_t A_HLOC = A_VCT + al256((size_t)DIFF_H * S * 128 * 2);
constexpr size_t A_PLOC = A_HLOC + al256((size_t)S * LRU_W * 4);
constexpr size_t A_SUMA = A_PLOC + al256((size_t)S * LRU_W * 4);
constexpr size_t A_SUMH = A_SUMA + al256((size_t)NKT * LRU_W * 4);
constexpr size_t A_CONCAT = A_SUMH + al256((size_t)NKT * LRU_W * 4);
constexpr size_t A_Y1 = A_CONCAT + al256((size_t)S * D * 2);
constexpr size_t A_H1 = A_Y1 + al256((size_t)S * D * 4);
constexpr size_t A_H1B = A_H1 + al256((size_t)S * D * 4);
constexpr size_t A_LTOK = A_H1B + al256((size_t)S * D * 2);
constexpr size_t A_LW = A_LTOK + al256((size_t)NEXP * S * 4);
constexpr size_t A_LSLOT = A_LW + al256((size_t)NEXP * S * 4);
constexpr size_t A_ACT = A_LSLOT + al256((size_t)NEXP * S * 4);
constexpr size_t A_CONTRIB = A_ACT + al256((size_t)(2 * S + 256) * DFF * 2);
constexpr size_t WS_END = A_CONTRIB + al256((size_t)2 * S * D * 4);
constexpr size_t A_DPO = A_Y1;
constexpr size_t A_DPML = A_DPO + al256((size_t)8 * DPART_ROWS * 128 * 2);
static_assert(A_DPML + (size_t)8 * DPART_ROWS * 2 * 4 <= A_H1B, "differential partials must fit inside the y1 + h1 region");

constexpr int NTHREADS = 512;
constexpr int LDS_MAIN = 131072 + 4096;
constexpr int LDS_MISC = LDS_MAIN;
constexpr int LDS_BYTES = LDS_MAIN + 8192 + 16640;
constexpr int M_PRE16 = 8192;
constexpr int M_LCNT = 64, M_CTOT = 256, M_COFF = 384, M_PRE = 512, M_RTOK = 2048, M_RW = 3072, M_RSLOT = 4096;

struct Params {
    const float* in[N_INPUTS];
    float* out;
    unsigned char* ws;
    float inv_freq[8];
    int lo, hi;
};

#ifndef EMU
#define LAS __attribute__((address_space(3)))
#define DYN_LDS(name) extern __shared__ __attribute__((aligned(16))) unsigned char name[]
#define SLEEP1() __builtin_amdgcn_s_sleep(1)
#define WAVE_SYNC() __builtin_amdgcn_wave_barrier()
#define OPAQUE(x) asm volatile("" : "+v"(x))
#define COMPILER_FENCE() asm volatile("" ::: "memory")
#define RFL(x) __builtin_amdgcn_readfirstlane(x)
#define RDLANE(v, l) __builtin_bit_cast(float, __builtin_amdgcn_readlane(__builtin_bit_cast(int, v), l))
__device__ __forceinline__ int lane_id_volatile() { int l; asm volatile("v_mbcnt_lo_u32_b32 %0, -1, 0\n\tv_mbcnt_hi_u32_b32 %0, -1, %0" : "=v"(l)); return l; }
#define LANE_ID() lane_id_volatile()
#define OPAQUE_S(x) asm volatile("" : "+s"(x))
#define WAIT_VM0() asm volatile("s_waitcnt vmcnt(0)" ::: "memory")
#define WAIT_ALL0() __builtin_amdgcn_s_waitcnt(0)
#define FENCE_REL_AGENT() __builtin_amdgcn_fence(__ATOMIC_RELEASE, "agent")
#define FENCE_ACQ_AGENT() __builtin_amdgcn_fence(__ATOMIC_ACQUIRE, "agent")
#define MFMA16(a, b, c) __builtin_amdgcn_mfma_f32_16x16x32_bf16(a, b, c, 0, 0, 0)
#define GLDS16(g, l) __builtin_amdgcn_global_load_lds((const unsigned*)(g), (unsigned*)(l), 16, 0, 0)
#define WAIT_V(n) asm volatile("s_waitcnt vmcnt(" #n ")" ::: "memory")
#define WAIT_L(n) asm volatile("s_waitcnt lgkmcnt(" #n ")" ::: "memory")
#define BAR() __builtin_amdgcn_s_barrier()
#define SCHED() __builtin_amdgcn_sched_barrier(0)
#define SETPRIO(n) __builtin_amdgcn_s_setprio(n)
#define FAST_EXP2(x) __builtin_amdgcn_exp2f(x)
template <int M> __device__ __forceinline__ float shx_impl(float v, int lane) {
    if (M < 32) return __builtin_bit_cast(float, __builtin_amdgcn_ds_swizzle(__builtin_bit_cast(int, v), (M << 10) | 0x1f));
    return __builtin_bit_cast(float, __builtin_amdgcn_ds_bpermute((lane ^ 32) << 2, __builtin_bit_cast(int, v)));
}
#define SHX(v, M) shx_impl<M>(v, lane)
#define FAST_LOG2(x) __builtin_amdgcn_logf(x)
#define FAST_RCP(x) __builtin_amdgcn_rcpf(x)
__device__ __forceinline__ unsigned xb_ld(unsigned* p)              { return __hip_atomic_load(p, __ATOMIC_RELAXED, __HIP_MEMORY_SCOPE_AGENT); }
__device__ __forceinline__ unsigned xb_add(unsigned* p, unsigned v) { return __hip_atomic_fetch_add(p, v, __ATOMIC_RELAXED, __HIP_MEMORY_SCOPE_AGENT); }
__device__ __forceinline__ unsigned xb_xcc_id() { return (unsigned)__builtin_amdgcn_s_getreg((3 << 11) | 20) & 0xFu; }
__device__ __forceinline__ int atomic_add_int(int* p, int v) { return atomicAdd(p, v); }
__device__ __forceinline__ void atomic_min_int(int* p, int v) { atomicMin(p, v); }
__device__ __forceinline__ unsigned pack2(float lo, float hi) { unsigned r; asm volatile("v_cvt_pk_bf16_f32 %0, %1, %2" : "=v"(r) : "v"(lo), "v"(hi)); return r; }
#else
#define MFMA16(a, b, c) emu_mfma_16x16x32_bf16(a, b, c)
#define GLDS16(g, l) emu_glds16((const void*)(g), (void*)(l))
#define WAIT_V(n) ((void)0)
#define WAIT_L(n) ((void)0)
#define BAR() __syncthreads()
#define SCHED() ((void)0)
#define SETPRIO(n) ((void)0)
#define FAST_EXP2(x) exp2f(x)
#define SHX(v, M) __shfl_xor(v, M)
#define FAST_LOG2(x) log2f(x)
#define FAST_RCP(x) (1.f / (x))
static inline unsigned pack2(float lo, float hi) {
    unsigned a = __builtin_bit_cast(unsigned, lo), b = __builtin_bit_cast(unsigned, hi);
    a += 0x7fffu + ((a >> 16) & 1u); b += 0x7fffu + ((b >> 16) & 1u);
    return (a >> 16) | (b & 0xffff0000u);
}
#endif
__device__ __forceinline__ bf16_t f2bf(float f) { return (bf16_t)(pack2(f, 0.f) & 0xffffu); }
__device__ __forceinline__ float bf2f(bf16_t h) { return __builtin_bit_cast(float, (unsigned)h << 16); }

#define XB_TMO      128
#define XB_XCNT(j)  (256  + 64 * (j))
#define XB_XSUB(j)  (1280 + 64 * (j))
#define XB_XGEN(j)  (2304 + 64 * (j))
#define XB_TOP      3328
#define XB_TOPGEN   3392
#define XCD_BAR_WORDS 3456
#define XB_SPIN_CAP (1u << 22)
#define XB_SPIN(cond, bar) do { unsigned _sp = 0; while (cond) { SLEEP1(); \
    if ((++_sp & 255u) == 0u) { if (xb_ld(&(bar)[XB_TMO])) break; if (_sp > XB_SPIN_CAP) { xb_add(&(bar)[XB_TMO], 1u); break; } } } } while (0)

struct XcdBarrier { unsigned* bar; unsigned x; volatile LAS unsigned* st; };

__device__ __forceinline__ XcdBarrier xcd_barrier_post(unsigned* bar, volatile LAS unsigned* st) {
    XcdBarrier b; b.bar = bar; b.x = xb_xcc_id(); b.st = st;
    if (threadIdx.x == 0) (void)xb_add(&bar[XB_XCNT(b.x)], 1u);
    return b;
}
__device__ __forceinline__ void xcd_barrier_complete(unsigned* bar, unsigned x, unsigned& nloc, unsigned& nx) {
    const unsigned G = gridDim.x;
    unsigned sum, cnt, mine, sp = 0u;
    for (;;) {
        sum = 0u; cnt = 0u; mine = 0u;
#pragma unroll
        for (unsigned j = 0; j < 16; ++j) { const unsigned c = xb_ld(&bar[XB_XCNT(j)]); sum += c; cnt += (c > 0u) ? 1u : 0u; mine = (j == x) ? c : mine; }
        if (sum == G) break;
        SLEEP1();
        if ((++sp & 255u) == 0u) { if (xb_ld(&bar[XB_TMO])) break; if (sp > XB_SPIN_CAP) { xb_add(&bar[XB_TMO], 1u); break; } }
    }
    nloc = mine > 0u ? mine : 1u; nx = cnt > 0u ? cnt : 1u;
}
__device__ __forceinline__ void xcd_barrier(const XcdBarrier& b, bool leader) {
    WAIT_VM0();
    __syncthreads();
    if (leader) {
        unsigned* bar = b.bar;
        WAIT_ALL0();
        unsigned nloc = b.st[0], nx = b.st[1];
        if (nloc == 0u) { xcd_barrier_complete(bar, b.x, nloc, nx); b.st[0] = nloc; b.st[1] = nx; }
        const unsigned old = xb_add(&bar[XB_XSUB(b.x)], 1u);
        const unsigned gen = old / nloc;
        if (old + 1u == (gen + 1u) * nloc) {
            FENCE_REL_AGENT();
            WAIT_VM0();
            const unsigned og = xb_add(&bar[XB_TOP], 1u);
            const unsigned tg = og / nx;
            if (og + 1u == (tg + 1u) * nx) xb_add(&bar[XB_TOPGEN], 1u);
            else XB_SPIN(xb_ld(&bar[XB_TOPGEN]) == tg, bar);
            FENCE_ACQ_AGENT();
            xb_add(&bar[XB_XGEN(b.x)], 1u);
            WAIT_VM0();
        } else {
            XB_SPIN(xb_ld(&bar[XB_XGEN(b.x)]) == gen, bar);
            FENCE_ACQ_AGENT();
            WAIT_VM0();
        }
    }
    __syncthreads();
}

__device__ __forceinline__ float wave_sum_l(float v, int lane) {
    v += SHX(v, 1); v += SHX(v, 2); v += SHX(v, 4); v += SHX(v, 8); v += SHX(v, 16); v += SHX(v, 32);
    return v;
}
#define wave_sum(v) wave_sum_l(v, lane)
__device__ __forceinline__ float fexp(float x) { return FAST_EXP2(x * LOG2E); }
__device__ __forceinline__ float sigmoid_f(float x) { return FAST_RCP(1.f + fexp(-x)); }
__device__ __forceinline__ float log_sigmoid_f(float x) { return fminf(x, 0.f) - 0.6931471805599453f * FAST_LOG2(1.f + fexp(-fabsf(x))); }
__device__ __forceinline__ float gelu_tanh_f(float x) { const float u = 0.7978845608028654f * (x + 0.044715f * x * x * x); return x * FAST_RCP(1.f + fexp(-2.f * u)); }
__device__ __forceinline__ float silu_f(float x) { return x * FAST_RCP(1.f + fexp(-x)); }
__device__ __forceinline__ float neg_expm1_f(float x) {
    const float ser = -x * (1.f + x * (0.5f + x * (0.16666667f + x * (0.041666668f + x * (0.008333334f + x * 0.0013888889f)))));
    return (x > -0.35f) ? ser : (1.f - fexp(x));
}

struct RmIdent { __device__ __forceinline__ int operator()(int n) const { return n; } };
struct RmWin { __device__ __forceinline__ int operator()(int n) const { return n < C_FA ? n : (n < C_FA + 6 ? -1 : n - 6); } };
struct RmGu { int kind; __device__ __forceinline__ int operator()(int f) const { return (f >> 7) * 256 + ((f >> 6) & 1) * 128 + ((f >> 4) & 3) * 32 + kind * 16 + (f & 15); } };
struct RmOff { int off; __device__ __forceinline__ int operator()(int n) const { return n + off; } };

template <class RM>
__device__ __forceinline__ void convert_tile(const float* src, int ld, int K, int Nsrc, int k0, int n0, bf16_t* dst, const RM& rm, float* T, int tid) {
    {
        const int nn = tid & 255, kh = (tid >> 8) * 32, n = n0 + nn;
        const float* sp = src + (size_t)(k0 + kh) * ld + n;
        float v[32];
#pragma unroll
        for (int i = 0; i < 32; ++i) v[i] = (n < Nsrc) ? sp[(size_t)i * ld] : 0.f;
#pragma unroll
        for (int i = 0; i < 32; ++i) T[(kh + i) * 257 + nn] = v[i];
    }
    __syncthreads();
#pragma unroll
    for (int q = 0; q < 4; ++q) {
        const int nn = q * 64 + (tid >> 3), kc = (tid & 7) * 8, n = n0 + nn;
        const int row = (n < Nsrc) ? rm(n) : -1;
        if (row >= 0) {
            u32x4 o;
            o.x = pack2(T[(kc + 0) * 257 + nn], T[(kc + 1) * 257 + nn]); o.y = pack2(T[(kc + 2) * 257 + nn], T[(kc + 3) * 257 + nn]);
            o.z = pack2(T[(kc + 4) * 257 + nn], T[(kc + 5) * 257 + nn]); o.w = pack2(T[(kc + 6) * 257 + nn], T[(kc + 7) * 257 + nn]);
            *(u32x4*)(dst + (size_t)row * K + k0 + kc) = o;
        }
    }
    __syncthreads();
}
template <class RM>
__device__ __forceinline__ void convert_mats(const float* src, size_t sstride, int nmat, int ld, int K, int Nsrc, bf16_t* dst, size_t dstride, const RM& rm,
                                             float* T, int tid, int bid, int G) {
    const int tk = K / 64, tn = (Nsrc + 255) / 256, per = tk * tn, total = nmat * per;
    for (int t = bid; t < total; t += G) {
        const int mi = t / per, r = t % per;
        convert_tile(src + (size_t)mi * sstride, ld, K, Nsrc, (r / tn) * 64, (r % tn) * 256, dst + (size_t)mi * dstride, rm, T, tid);
    }
}

constexpr int BK = 64, HTB = 128 * 64 * 2;
__device__ __forceinline__ int lds_byte(int r, int c) {
    const int st = (r >> 4) * 2 + (c >> 5), rr = r & 15, cc = c & 31, ob = rr * 64 + cc * 2;
    return st * 1024 + (ob ^ (((ob >> 9) & 1) << 5));
}
__device__ __forceinline__ void stage_rc(int b, int& R, int& C) {
    const int st = b / 1024, sb = b % 1024, swz = sb ^ (((sb >> 9) & 1) << 5);
    R = (st >> 1) * 16 + swz / 64; C = (st & 1) * 32 + (swz % 64) / 2;
}
template <bool GATHER>
__device__ __forceinline__ void gemm_tile(const bf16_t* A, int arow0, const unsigned (&aoff)[2][2], const bf16_t* Bt, int brow0, int K,
                                          unsigned char* shm, f32x4 (&acc)[2][2][4][2], int tid_in) {
    int tid = tid_in; OPAQUE(tid);
    unsigned toff; { int R0, C0; stage_rc(tid * 16, R0, C0); toff = (unsigned)(R0 * K + C0); }
#define SA(b, h) (shm + ((b) * 2 + (h)) * HTB)
#define SB(b, h) (shm + (4 + (b) * 2 + (h)) * HTB)
#define STAGE_B(P, h, kt) do { _Pragma("unroll") for (int _i = 0; _i < 2; ++_i) GLDS16(Bt + ((size_t)(brow0 + (h) * 128 + _i * 64) * K + (size_t)(kt) * BK) + toff, (P) + tid * 16 + _i * 8192); } while (0)
#define STAGE_A(P, h, kt) do { _Pragma("unroll") for (int _i = 0; _i < 2; ++_i) { \
    if (GATHER) GLDS16(A + (size_t)(kt) * BK + aoff[h][_i], (P) + tid * 16 + _i * 8192); \
    else GLDS16(A + ((size_t)(arow0 + (h) * 128 + _i * 64) * K + (size_t)(kt) * BK) + toff, (P) + tid * 16 + _i * 8192); } } while (0)
#define LDA(dst, b, h) _Pragma("unroll") for (int m = 0; m < 4; ++m) _Pragma("unroll") for (int k = 0; k < 2; ++k) \
    dst[m][k] = *reinterpret_cast<const bf16x8*>(SA(b, h) + lds_byte(wr * 64 + m * 16 + fr, k * 32 + fq * 8))
#define LDB(dst, b, h) _Pragma("unroll") for (int n = 0; n < 2; ++n) _Pragma("unroll") for (int k = 0; k < 2; ++k) \
    dst[n][k] = *reinterpret_cast<const bf16x8*>(SB(b, h) + lds_byte(wc * 32 + n * 16 + fr, k * 32 + fq * 8))
#define MMA(ai, bj, At, Bx) do { SETPRIO(1); \
    _Pragma("unroll") for (int m = 0; m < 4; ++m) _Pragma("unroll") for (int n = 0; n < 2; ++n) _Pragma("unroll") for (int k = 0; k < 2; ++k) \
      acc[ai][bj][m][n] = MFMA16(At[m][k], Bx[n][k], acc[ai][bj][m][n]); \
    SETPRIO(0); } while (0)
    int wid = tid >> 6, lane = tid & 63, wr = wid >> 2, wc = wid & 3, fr = lane & 15, fq = lane >> 4;
#pragma unroll
    for (int a = 0; a < 2; ++a)
#pragma unroll
        for (int b = 0; b < 2; ++b)
#pragma unroll
            for (int m = 0; m < 4; ++m)
#pragma unroll
                for (int n = 0; n < 2; ++n) acc[a][b][m][n] = (f32x4){0.f, 0.f, 0.f, 0.f};
    bf16x8 At[4][2], B0[2][2], B1[2][2];
    const int nt = K / BK;
    STAGE_B(SB(0, 0), 0, 0); STAGE_A(SA(0, 0), 0, 0);
    STAGE_B(SB(0, 1), 1, 0); STAGE_A(SA(0, 1), 1, 0);
    if (wr == 1) BAR();
    WAIT_V(4); BAR();
    STAGE_B(SB(1, 0), 0, 1); STAGE_A(SA(1, 0), 0, 1); STAGE_B(SB(1, 1), 1, 1);
    WAIT_V(6); BAR();
    for (int t = 0; t < nt - 2; t += 2) {
        LDB(B0, 0, 0); SCHED(); LDA(At, 0, 0); STAGE_A(SA(1, 1), 1, t + 1);
        WAIT_L(8); BAR(); WAIT_L(0); MMA(0, 0, At, B0); BAR(); SCHED();
        LDB(B1, 0, 1); STAGE_B(SB(0, 0), 0, t + 2);
        BAR(); WAIT_L(0); MMA(0, 1, At, B1); BAR();
        LDA(At, 0, 1); STAGE_A(SA(0, 0), 0, t + 2);
        BAR(); WAIT_L(0); MMA(1, 0, At, B0); BAR(); SCHED();
        STAGE_B(SB(0, 1), 1, t + 2);
        WAIT_V(6); BAR(); MMA(1, 1, At, B1); BAR();
        LDB(B0, 1, 0); SCHED(); LDA(At, 1, 0); STAGE_A(SA(0, 1), 1, t + 2);
        WAIT_L(8); BAR(); WAIT_L(0); MMA(0, 0, At, B0); BAR(); SCHED();
        LDB(B1, 1, 1); STAGE_B(SB(1, 0), 0, t + 3);
        BAR(); WAIT_L(0); MMA(0, 1, At, B1); BAR();
        LDA(At, 1, 1); STAGE_A(SA(1, 0), 0, t + 3);
        BAR(); WAIT_L(0); MMA(1, 0, At, B0); BAR(); SCHED();
        STAGE_B(SB(1, 1), 1, t + 3);
        WAIT_V(6); BAR(); MMA(1, 1, At, B1); BAR();
    }
    OPAQUE(tid); wid = tid >> 6; lane = tid & 63; wr = wid >> 2; wc = wid & 3; fr = lane & 15; fq = lane >> 4;
    { LDB(B0, 0, 0); WAIT_V(0); LDA(At, 0, 0); STAGE_A(SA(1, 1), 1, nt - 1);
      BAR(); WAIT_L(0); MMA(0, 0, At, B0); BAR();
      LDB(B1, 0, 1); BAR(); WAIT_L(0); MMA(0, 1, At, B1); BAR();
      LDA(At, 0, 1); WAIT_V(4); BAR(); WAIT_L(0); MMA(1, 0, At, B0); MMA(1, 1, At, B1); BAR(); }
    { LDB(B0, 1, 0); LDA(At, 1, 0); WAIT_V(2); BAR(); WAIT_L(0); MMA(0, 0, At, B0); BAR();
      LDB(B1, 1, 1); WAIT_V(0); BAR(); WAIT_L(0); MMA(0, 1, At, B1); BAR();
      LDA(At, 1, 1); BAR(); WAIT_L(0); MMA(1, 0, At, B0); MMA(1, 1, At, B1); BAR(); }
    if (wr == 0) BAR();
#undef SA
#undef SB
#undef STAGE_A
#undef STAGE_B
#undef LDA
#undef LDB
#undef MMA
}
__device__ __forceinline__ void stage_geom(int tid, int (&R)[2], int (&C)[2]) {
#pragma unroll
    for (int i = 0; i < 2; ++i) stage_rc(tid * 16 + i * 8192, R[i], C[i]);
}

constexpr int ATT_KBUF = 0, ATT_VBUF = 32768, ATT_CBUF = 65536;
template <int KIND>
__device__ __forceinline__ void attn_unit(const bf16_t* Q, const bf16_t* Kg, const bf16_t* VT, const float* cum2, const float* kmx, int qb, bf16_t* concat, int ccol0,
                                          float lam, float osc, const float* subg, unsigned char* lds, int tid) {
    const int lane = tid & 63, wave = tid >> 6, r16 = lane & 15, q4 = lane >> 4;
    const int q0w = qb * 128 + wave * 16, myq = q0w + r16;
    const int ntiles = 2 * qb + 2;
    const int wlimit = (KIND == 0) ? ((q0w + 15) >> 6) : (q0w >> 6);
    constexpr int NMAP = (KIND == 0) ? 1 : 2, NKS = (KIND == 0) ? 4 : 2;
    bf16x8 qf[NMAP][NKS];
#pragma unroll
    for (int mp = 0; mp < NMAP; ++mp)
#pragma unroll
        for (int ks = 0; ks < NKS; ++ks) qf[mp][ks] = *(const bf16x8*)(Q + (size_t)myq * 128 + mp * 64 + ks * 32 + q4 * 8);
    const float cq = (KIND == 0) ? cum2[myq] : 0.f;
    int kt0 = 0;
    if (KIND == 0) {
        float* wmax = (float*)(lds + ATT_CBUF + 512); int* kst = (int*)(lds + ATT_CBUF + 576);
        float qs = 0.f;
#pragma unroll
        for (int ks = 0; ks < NKS; ++ks)
#pragma unroll
            for (int j = 0; j < 8; ++j) { const float v = bf2f((bf16_t)qf[0][ks][j]); qs += v * v; }
        qs += SHX(qs, 16); qs += SHX(qs, 32);
        qs = fmaxf(qs, SHX(qs, 1)); qs = fmaxf(qs, SHX(qs, 2)); qs = fmaxf(qs, SHX(qs, 4)); qs = fmaxf(qs, SHX(qs, 8));
        if (lane == 0) wmax[wave] = qs;
        if (tid == 0) *kst = 2 * qb;
        __syncthreads();
        float qm = wmax[0];
#pragma unroll
        for (int w = 1; w < 8; ++w) qm = fmaxf(qm, wmax[w]);
        qm = sqrtf(qm) * 1.01f;
        const float kd = sqrtf(fmaxf(kmx[2 * qb], kmx[2 * qb + 1])) * 1.01f;
        if (tid < 2 * qb) {
            const float bias = cum2[qb * 128] - cum2[tid * 64 + 63];
            const bool skip = bias + qm * (sqrtf(kmx[tid]) * 1.01f + kd) < -40.f;
            if (!skip) atomic_min_int(kst, tid);
        }
        __syncthreads();
        kt0 = RFL(*kst);
    }
    f32x4 ot[NMAP][8];
    float mrun[NMAP], lsum[NMAP];
#pragma unroll
    for (int mp = 0; mp < NMAP; ++mp) { mrun[mp] = -INFINITY; lsum[mp] = 0.f;
#pragma unroll
        for (int mo = 0; mo < 8; ++mo) ot[mp][mo] = (f32x4){0.f, 0.f, 0.f, 0.f}; }
    u32x4 sk[2], sv[2]; float sc = 0.f;
    const u32x4* kg = (const u32x4*)Kg; const u32x4* vg = (const u32x4*)VT;
#pragma unroll
    for (int i = 0; i < 2; ++i) { sk[i] = kg[(size_t)kt0 * 1024 + tid + i * 512]; sv[i] = vg[(size_t)kt0 * 1024 + tid + i * 512]; }
    if (KIND == 0 && tid < 64) sc = cum2[kt0 * 64 + tid];
    for (int kt = kt0; kt < ntiles; ++kt) {
        unsigned char* kb = lds + ATT_KBUF + (kt & 1) * 16384;
        unsigned char* vb = lds + ATT_VBUF + (kt & 1) * 16384;
        float* cb = (float*)(lds + ATT_CBUF + (kt & 1) * 256);
#pragma unroll
        for (int i = 0; i < 2; ++i) {
            const int g = tid + i * 512;
            { const int row = g >> 4, c = g & 15; *(u32x4*)(kb + row * 256 + ((c ^ (row & 15)) << 4)) = sk[i]; }
            { const int d = g >> 3, c = g & 7; *(u32x4*)(vb + d * 128 + ((c ^ ((d >> 1) & 7)) << 4)) = sv[i]; }
        }
        if (KIND == 0 && tid < 64) cb[tid] = sc;
        __syncthreads();
        if (kt + 1 < ntiles) {
#pragma unroll
            for (int i = 0; i < 2; ++i) { sk[i] = kg[(size_t)(kt + 1) * 1024 + tid + i * 512]; sv[i] = vg[(size_t)(kt + 1) * 1024 + tid + i * 512]; }
            if (KIND == 0 && tid < 64) sc = cum2[(kt + 1) * 64 + tid];
        }
        if (kt <= wlimit) {
#pragma unroll
            for (int mp = 0; mp < NMAP; ++mp) {
                f32x4 st[4];
#pragma unroll
                for (int m = 0; m < 4; ++m) {
                    st[m] = (f32x4){0.f, 0.f, 0.f, 0.f};
#pragma unroll
                    for (int ks = 0; ks < NKS; ++ks) {
                        const int c = (KIND == 0 ? 0 : mp * 8) + ks * 4 + q4;
                        const bf16x8 kf = *(const bf16x8*)(kb + (m * 16 + r16) * 256 + ((c ^ r16) << 4));
                        st[m] = MFMA16(kf, qf[mp][ks], st[m]);
                    }
                }
                float mx = -INFINITY;
#pragma unroll
                for (int m = 0; m < 4; ++m) {
                    if (KIND == 0) {
                        const f32x4 ck = *(const f32x4*)(cb + m * 16 + 4 * q4);
#pragma unroll
                        for (int j = 0; j < 4; ++j) {
                            float y = st[m][j] + (cq - ck[j]);
                            if (kt * 64 + m * 16 + 4 * q4 + j > myq) y = -INFINITY;
                            st[m][j] = y;
                        }
                    }
#pragma unroll
                    for (int j = 0; j < 4; ++j) mx = fmaxf(mx, st[m][j]);
                }
                mx = fmaxf(mx, SHX(mx, 16));
                mx = fmaxf(mx, SHX(mx, 32));
                const float mnew = fmaxf(mrun[mp], mx);
                const float alpha = FAST_EXP2(mrun[mp] - mnew);
                mrun[mp] = mnew;
                float ps = 0.f;
#pragma unroll
                for (int m = 0; m < 4; ++m)
#pragma unroll
                    for (int j = 0; j < 4; ++j) { const float pv = FAST_EXP2(st[m][j] - mnew); st[m][j] = pv; ps += pv; }
                lsum[mp] = lsum[mp] * alpha + ps;
#pragma unroll
                for (int mo = 0; mo < 8; ++mo) ot[mp][mo] *= alpha;
#pragma unroll
                for (int kk = 0; kk < 2; ++kk) {
                    u32x4 pw;
                    pw.x = pack2(st[2 * kk][0], st[2 * kk][1]); pw.y = pack2(st[2 * kk][2], st[2 * kk][3]);
                    pw.z = pack2(st[2 * kk + 1][0], st[2 * kk + 1][1]); pw.w = pack2(st[2 * kk + 1][2], st[2 * kk + 1][3]);
                    const bf16x8 pf = __builtin_bit_cast(bf16x8, pw);
#pragma unroll
                    for (int mo = 0; mo < 8; ++mo) {
                        const int d = mo * 16 + r16, sw = (d >> 1) & 7;
                        const unsigned char* rowp = vb + d * 128 + (q4 & 1) * 8;
                        u32x4 vw;
                        const u32x2 lo = *(const u32x2*)(rowp + (((kk * 4 + (q4 >> 1)) ^ sw) << 4));
                        const u32x2 hi = *(const u32x2*)(rowp + (((kk * 4 + 2 + (q4 >> 1)) ^ sw) << 4));
                        vw.x = lo.x; vw.y = lo.y; vw.z = hi.x; vw.w = hi.y;
                        ot[mp][mo] = MFMA16(__builtin_bit_cast(bf16x8, vw), pf, ot[mp][mo]);
                    }
                }
            }
        }
    }
    float inv[NMAP];
#pragma unroll
    for (int mp = 0; mp < NMAP; ++mp) { float l = lsum[mp]; l += SHX(l, 16); l += SHX(l, 32); inv[mp] = 1.f / l; }
    if (KIND == 0) {
#pragma unroll
        for (int mo = 0; mo < 8; ++mo) {
            u32x2 o; o.x = pack2(ot[0][mo][0] * inv[0], ot[0][mo][1] * inv[0]); o.y = pack2(ot[0][mo][2] * inv[0], ot[0][mo][3] * inv[0]);
            *(u32x2*)(concat + (size_t)myq * D + ccol0 + mo * 16 + 4 * q4) = o;
        }
    } else {
        float ss = 0.f;
#pragma unroll
        for (int mo = 0; mo < 8; ++mo)
#pragma unroll
            for (int j = 0; j < 4; ++j) { const float v = ot[0][mo][j] * inv[0] - lam * (ot[NMAP - 1][mo][j] * inv[NMAP - 1]); ot[0][mo][j] = v; ss += v * v; }
        ss += SHX(ss, 16); ss += SHX(ss, 32);
        const float rs = osc / sqrtf(ss * (1.f / 128.f) + LN_EPS);
#pragma unroll
        for (int mo = 0; mo < 8; ++mo) {
            const f32x4 g = *(const f32x4*)(subg + mo * 16 + 4 * q4);
            u32x2 o; o.x = pack2(ot[0][mo][0] * rs * g[0], ot[0][mo][1] * rs * g[1]); o.y = pack2(ot[0][mo][2] * rs * g[2], ot[0][mo][3] * rs * g[3]);
            *(u32x2*)(concat + (size_t)myq * D + ccol0 + mo * 16 + 4 * q4) = o;
        }
    }
    __syncthreads();
}

__device__ __forceinline__ int dpart_row(int c, int q) { return c * (S - DCH * 64) - (DCH * 32) * c * (c - 1) + q; }
__device__ __forceinline__ void attn_dmap_unit(const bf16_t* Qh, const bf16_t* Kh, const bf16_t* VTh, int mp, int qb, int t0, int t1,
                                               bf16_t* Op, float* ML, int c, unsigned char* lds, int tid) {
    const int lane = tid & 63, wave = tid >> 6, r16 = lane & 15, q4 = lane >> 4;
    const int q0w = qb * 256 + wave * 32;
    const int wlimit = q0w >> 6;
    bf16x8 qf[2][2];
#pragma unroll
    for (int n = 0; n < 2; ++n)
#pragma unroll
        for (int ks = 0; ks < 2; ++ks) qf[n][ks] = *(const bf16x8*)(Qh + (size_t)(q0w + n * 16 + r16) * 128 + mp * 64 + ks * 32 + q4 * 8);
    f32x4 ot[8][2];
    float mrun[2] = {-INFINITY, -INFINITY}, lsum[2] = {0.f, 0.f};
#pragma unroll
    for (int mo = 0; mo < 8; ++mo) { ot[mo][0] = (f32x4){0.f, 0.f, 0.f, 0.f}; ot[mo][1] = (f32x4){0.f, 0.f, 0.f, 0.f}; }
    u32x4 sk, sv[2];
    const u32x4* kg = (const u32x4*)Kh; const u32x4* vg = (const u32x4*)VTh;
    const int krow = tid >> 3, kc8 = tid & 7;
    sk = kg[(size_t)t0 * 1024 + krow * 16 + mp * 8 + kc8];
#pragma unroll
    for (int i = 0; i < 2; ++i) sv[i] = vg[(size_t)t0 * 1024 + tid + i * 512];
    for (int kt = t0; kt < t1; ++kt) {
        unsigned char* kb = lds + (kt & 1) * 8192;
        unsigned char* vb = lds + 16384 + (kt & 1) * 16384;
        *(u32x4*)(kb + krow * 128 + ((kc8 ^ ((krow >> 1) & 7)) << 4)) = sk;
#pragma unroll
        for (int i = 0; i < 2; ++i) { const int g = tid + i * 512, d = g >> 3, cc = g & 7; *(u32x4*)(vb + d * 128 + ((cc ^ ((d >> 1) & 7)) << 4)) = sv[i]; }
        __syncthreads();
        if (kt + 1 < t1) {
            sk = kg[(size_t)(kt + 1) * 1024 + krow * 16 + mp * 8 + kc8];
#pragma unroll
            for (int i = 0; i < 2; ++i) sv[i] = vg[(size_t)(kt + 1) * 1024 + tid + i * 512];
        }
        if (kt <= wlimit) {
            f32x4 st[4][2];
#pragma unroll
            for (int m = 0; m < 4; ++m) {
                st[m][0] = (f32x4){0.f, 0.f, 0.f, 0.f}; st[m][1] = (f32x4){0.f, 0.f, 0.f, 0.f};
#pragma unroll
                for (int ks = 0; ks < 2; ++ks) {
                    const bf16x8 kf = *(const bf16x8*)(kb + (m * 16 + r16) * 128 + (((ks * 4 + q4) ^ ((r16 >> 1) & 7)) << 4));
                    st[m][0] = MFMA16(kf, qf[0][ks], st[m][0]);
                    st[m][1] = MFMA16(kf, qf[1][ks], st[m][1]);
                }
            }
            float alpha[2];
#pragma unroll
            for (int n = 0; n < 2; ++n) {
                float mx = -INFINITY;
#pragma unroll
                for (int m = 0; m < 4; ++m)
#pragma unroll
                    for (int j = 0; j < 4; ++j) mx = fmaxf(mx, st[m][n][j]);
                mx = fmaxf(mx, SHX(mx, 16));
                mx = fmaxf(mx, SHX(mx, 32));
                const float mnew = fmaxf(mrun[n], mx);
                alpha[n] = FAST_EXP2(mrun[n] - mnew);
                mrun[n] = mnew;
                float ps = 0.f;
#pragma unroll
                for (int m = 0; m < 4; ++m)
#pragma unroll
                    for (int j = 0; j < 4; ++j) { const float pv = FAST_EXP2(st[m][n][j] - mnew); st[m][n][j] = pv; ps += pv; }
                lsum[n] = lsum[n] * alpha[n] + ps;
            }
#pragma unroll
            for (int mo = 0; mo < 8; ++mo) { ot[mo][0] *= alpha[0]; ot[mo][1] *= alpha[1]; }
#pragma unroll
            for (int kk = 0; kk < 2; ++kk) {
                bf16x8 pf[2];
#pragma unroll
                for (int n = 0; n < 2; ++n) {
                    u32x4 pw;
                    pw.x = pack2(st[2 * kk][n][0], st[2 * kk][n][1]); pw.y = pack2(st[2 * kk][n][2], st[2 * kk][n][3]);
                    pw.z = pack2(st[2 * kk + 1][n][0], st[2 * kk + 1][n][1]); pw.w = pack2(st[2 * kk + 1][n][2], st[2 * kk + 1][n][3]);
                    pf[n] = __builtin_bit_cast(bf16x8, pw);
                }
#pragma unroll
                for (int mo = 0; mo < 8; ++mo) {
                    const int d = mo * 16 + r16, sw = (d >> 1) & 7;
                    const unsigned char* rowp = vb + d * 128 + (q4 & 1) * 8;
                    u32x4 vw;
                    const u32x2 lo = *(const u32x2*)(rowp + (((kk * 4 + (q4 >> 1)) ^ sw) << 4));
                    const u32x2 hi = *(const u32x2*)(rowp + (((kk * 4 + 2 + (q4 >> 1)) ^ sw) << 4));
                    vw.x = lo.x; vw.y = lo.y; vw.z = hi.x; vw.w = hi.y;
                    const bf16x8 vf = __builtin_bit_cast(bf16x8, vw);
                    ot[mo][0] = MFMA16(vf, pf[0], ot[mo][0]);
                    ot[mo][1] = MFMA16(vf, pf[1], ot[mo][1]);
                }
            }
        }
    }
    if (q0w >= DCH * 64 * c)
#pragma unroll
    for (int n = 0; n < 2; ++n) {
        float l = lsum[n]; l += SHX(l, 16); l += SHX(l, 32);
        const int row = dpart_row(c, q0w + n * 16 + r16);
#pragma unroll
        for (int mo = 0; mo < 8; ++mo) {
            u32x2 o; o.x = pack2(ot[mo][n][0], ot[mo][n][1]); o.y = pack2(ot[mo][n][2], ot[mo][n][3]);
            *(u32x2*)(Op + (size_t)(row * 128 + mo * 16 + 4 * q4)) = o;
        }
        if (q4 == 0) { ML[row * 2] = mrun[n]; ML[row * 2 + 1] = l; }
    }
    __syncthreads();
}

__device__ __forceinline__ void lru_unit_a(int chunk, int grp, int l, const Params& p, const bf16_t* Xr, const bf16_t* WaiT, float* hloc, float* ploc, float* sumA, float* sumH,
                                           unsigned char* lds, int tid) {
    const int lane = tid & 63, wave = tid >> 6, r16 = lane & 15, q4 = lane >> 4;
    unsigned char* XCB = lds; float* XU = (float*)(lds + 16384); float* LA = (float*)(lds + 49152); float* ENDS = (float*)(lds + 81920);
    const int t0 = chunk * 64, ch0 = grp * 128;
    {
        const int c = tid & 127, tq = tid >> 7, ch = ch0 + c;
        const float* cw = p.in[I_CONVW] + (size_t)l * 4 * LRU_W + ch; const float cb = p.in[I_CONVB][(size_t)l * LRU_W + ch];
        const float w0 = cw[0], w1 = cw[LRU_W], w2 = cw[2 * LRU_W], w3 = cw[3 * LRU_W];
        const int ts = t0 + tq * 16;
        float x0 = (ts - 3 >= 0) ? bf2f(Xr[(size_t)(ts - 3) * LRU_W + ch]) : 0.f;
        float x1 = (ts - 2 >= 0) ? bf2f(Xr[(size_t)(ts - 2) * LRU_W + ch]) : 0.f;
        float x2 = (ts - 1 >= 0) ? bf2f(Xr[(size_t)(ts - 1) * LRU_W + ch]) : 0.f;
#pragma unroll
        for (int i = 0; i < 16; ++i) {
            const float x3 = bf2f(Xr[(size_t)(ts + i) * LRU_W + ch]);
            const float v = cb + w0 * x0 + w1 * x1 + w2 * x2 + w3 * x3;
            const int row = tq * 16 + i;
            XU[row * 128 + c] = v;
            *(bf16_t*)(XCB + row * 256 + (((c >> 3) ^ (row & 15)) << 4) + (c & 7) * 2) = f2bf(v);
            x0 = x1; x1 = x2; x2 = x3;
        }
    }
    __syncthreads();
    {
        bf16x8 bfr[2][4];
#pragma unroll
        for (int g = 0; g < 2; ++g)
#pragma unroll
            for (int ks = 0; ks < 4; ++ks) bfr[g][ks] = *(const bf16x8*)(WaiT + ((size_t)grp * 256 + g * 128 + wave * 16 + r16) * 128 + ks * 32 + q4 * 8);
        const int ch = ch0 + wave * 16 + r16;
        const float ba = p.in[I_BA][(size_t)l * LRU_W + ch], bi = p.in[I_BI][(size_t)l * LRU_W + ch];
        const float lsl = 8.0f * log_sigmoid_f(p.in[I_LAM][(size_t)l * LRU_W + ch]);
#pragma unroll
        for (int mt = 0; mt < 4; ++mt) {
            f32x4 ga = (f32x4){0.f, 0.f, 0.f, 0.f}, gi = (f32x4){0.f, 0.f, 0.f, 0.f};
#pragma unroll
            for (int ks = 0; ks < 4; ++ks) {
                const bf16x8 af = *(const bf16x8*)(XCB + (mt * 16 + r16) * 256 + (((ks * 4 + q4) ^ r16) << 4));
                ga = MFMA16(af, bfr[0][ks], ga); gi = MFMA16(af, bfr[1][ks], gi);
            }
#pragma unroll
            for (int j = 0; j < 4; ++j) {
                const int row = mt * 16 + 4 * q4 + j, idx = row * 128 + wave * 16 + r16;
                const float r = sigmoid_f(ga[j] + ba), ig = sigmoid_f(gi[j] + bi);
                const float log_a = lsl * r;
                LA[idx] = fexp(log_a);
                XU[idx] = sqrtf(neg_expm1_f(2.f * log_a)) * (ig * XU[idx]);
            }
        }
    }
    __syncthreads();
    {
        const int c = tid & 127, tq = tid >> 7, ch = ch0 + c;
        float h = 0.f, P = 1.f;
#pragma unroll
        for (int i = 0; i < 16; ++i) { const int idx = (tq * 16 + i) * 128 + c; const float a = LA[idx]; h = a * h + XU[idx]; P *= a; XU[idx] = h; LA[idx] = P; }
        ENDS[tq * 128 + c] = P; ENDS[512 + tq * 128 + c] = h;
        __syncthreads();
        float cin = 0.f, pin = 1.f;
        for (int s = 0; s < tq; ++s) { const float Ps = ENDS[s * 128 + c], hs = ENDS[512 + s * 128 + c]; cin = Ps * cin + hs; pin *= Ps; }
#pragma unroll
        for (int i = 0; i < 16; ++i) {
            const int idx = (tq * 16 + i) * 128 + c; const size_t gi = (size_t)(t0 + tq * 16 + i) * LRU_W + ch;
            const float Pl = LA[idx], hl = XU[idx];
            hloc[gi] = hl + Pl * cin; ploc[gi] = Pl * pin;
        }
        if (tq == 3) { const float Pl = LA[63 * 128 + c], hl = XU[63 * 128 + c]; sumA[(size_t)chunk * LRU_W + ch] = Pl * pin; sumH[(size_t)chunk * LRU_W + ch] = hl + Pl * cin; }
    }
    __syncthreads();
}

__device__ __forceinline__ void moe_prefix(const int* cntb_, int G, unsigned char* lds, int tid) {
    int* tmp = (int*)lds; int* ctot = (int*)(lds + LDS_MISC + M_CTOT); int* coff = (int*)(lds + LDS_MISC + M_COFF);
    unsigned short* pre16 = (unsigned short*)(lds + LDS_MISC + M_PRE16);
    const int e = tid & 31, part = tid >> 5, PB = (G + 15) / 16;
    int sm = 0;
    for (int i = 0; i < PB; ++i) { const int b = part * PB + i; if (b < G) sm += cntb_[b * 32 + e]; }
    tmp[part * 32 + e] = sm;
    __syncthreads();
    int run = 0;
    for (int q = 0; q < part; ++q) run += tmp[q * 32 + e];
    for (int i = 0; i < PB; ++i) { const int b = part * PB + i; if (b < G) { pre16[e * 257 + b] = (unsigned short)run; run += cntb_[b * 32 + e]; } }
    if (part == 15) { ctot[e] = run; pre16[e * 257 + G] = (unsigned short)run; }
    __syncthreads();
    if (tid == 0) { int o = 0; for (int q = 0; q < 32; ++q) { coff[q] = o; o += ctot[q]; } coff[32] = o; }
    __syncthreads();
}
__device__ __forceinline__ void moe_rowtable(const int* ltok_, const float* lw_, const int* lslot_, int e, int m0, int G, int segcap, unsigned char* lds, int tid_in) {
    int tid = tid_in; OPAQUE(tid);
    const unsigned short* pre16 = (const unsigned short*)(lds + LDS_MISC + M_PRE16);
    int* rtok = (int*)(lds + LDS_MISC + M_RTOK); float* rw = (float*)(lds + LDS_MISC + M_RW); int* rslot = (int*)(lds + LDS_MISC + M_RSLOT);
    if (tid < 256) { rtok[tid] = 0; rw[tid] = 0.f; rslot[tid] = 0; }
    __syncthreads();
    if (tid < G) {
        const int base = pre16[e * 257 + tid], v = pre16[e * 257 + tid + 1] - base;
        for (int i = 0; i < v; ++i) {
            const int g = base + i - m0;
            if (g >= 0 && g < 256) { const int idx = (e * G + tid) * segcap + i; rtok[g] = ltok_[idx]; rw[g] = lw_[idx]; rslot[g] = lslot_[idx]; }
        }
    }
    __syncthreads();
}
#define kmax2 ((float*)(wsl + A_KMAX))
#define dpo ((bf16_t*)(wsl + A_DPO))
#define dpml ((float*)(wsl + A_DPML))
#define cntb ((int*)(wsl + A_CNTB))
#define WinT ((bf16_t*)(wsl + WB_WIN))
#define WoT ((bf16_t*)(wsl + WB_WO))
#define WguT ((bf16_t*)(wsl + WB_WGU))
#define WdT ((bf16_t*)(wsl + WB_WD))
#define WaiT ((bf16_t*)(wsl + WB_WAI))
#define Wfa ((float*)(wsl + WF_FA))
#define W36b ((bf16_t*)(wsl + WF_R36))
#define ropecs ((float*)(wsl + WF_ROPE))
#define xb ((bf16_t*)(wsl + A_XB))
#define hb ((float*)(wsl + A_HB))
#define logf_ ((float*)(wsl + A_LOGF))
#define cum2 ((float*)(wsl + A_CUM))
#define Qa ((bf16_t*)(wsl + A_QA))
#define Ka ((bf16_t*)(wsl + A_KA))
#define VaT ((bf16_t*)(wsl + A_VAT))
#define Xr ((bf16_t*)(wsl + A_XR))
#define Gr ((bf16_t*)(wsl + A_GR))
#define Qc ((bf16_t*)(wsl + A_QC))
#define Kc ((bf16_t*)(wsl + A_KC))
#define VcT ((bf16_t*)(wsl + A_VCT))
#define hloc ((float*)(wsl + A_HLOC))
#define ploc ((float*)(wsl + A_PLOC))
#define sumA ((float*)(wsl + A_SUMA))
#define sumH ((float*)(wsl + A_SUMH))
#define concat ((bf16_t*)(wsl + A_CONCAT))
#define y1 ((float*)(wsl + A_Y1))
#define h1 ((float*)(wsl + A_H1))
#define h1b ((bf16_t*)(wsl + A_H1B))
#define ltok ((int*)(wsl + A_LTOK))
#define lw ((float*)(wsl + A_LW))
#define lslot ((int*)(wsl + A_LSLOT))
#define act ((bf16_t*)(wsl + A_ACT))
#define contrib ((bf16_t*)(wsl + A_CONTRIB))
#ifndef EMU
__global__ void __launch_bounds__(NTHREADS, 2)
#else
void
#endif
fwd_kernel(Params p) {
    DYN_LDS(lds_raw);
    float* ldsf = (float*)lds_raw;
    const int bid = blockIdx.x, G = gridDim.x;
    const int gthreads = G * NTHREADS, gwaves = G * (NTHREADS / 64);
    const int wave_s = RFL((int)threadIdx.x >> 6);
#define PHASE_IDS() unsigned char* wsl = ws; OPAQUE_S(wsl); int tid = wave_s * 64 + LANE_ID(); OPAQUE(tid); const int lane = tid & 63, wave = tid >> 6, gtid = bid * NTHREADS + tid, gwave = bid * (NTHREADS / 64) + wave; (void)lane; (void)wave; (void)gtid; (void)gwave

    unsigned char* ws = p.ws;
    volatile LAS unsigned* bst = (volatile LAS unsigned*)(lds_raw + LDS_MISC);
    unsigned* ubox = (unsigned*)(lds_raw + LDS_MISC + 16);
    if (threadIdx.x == 0) { bst[0] = 0u; bst[1] = 0u; bst[2] = 0u; bst[3] = 0u; }
    __syncthreads();
    XcdBarrier bar = xcd_barrier_post((unsigned*)ws, bst);

    const int* positions = (const int*)p.in[I_POS];

    constexpr int NPH = 8;
    const int lo = p.lo, hi = p.hi;
#ifdef ONLY_PHASE
#define PH_SEL(c) ((c) == ONLY_PHASE)
#else
#define PH_SEL(c) 1
#endif
#define PH_IN(k) (lo <= (k) && (k) < hi)
#define PH_BAR(k) do { if ((k) + 1 < hi) xcd_barrier(bar, wave_s == 0 && LANE_ID() == 0); } while (0)

    if (PH_SEL(-1) && PH_IN(0)) for (int rep = 0; rep < PH_REPS(-1); ++rep) {
        PHASE_IDS();
        for (int l = 0; l < DEPTH; ++l) {
            convert_mats(p.in[I_WIN] + (size_t)l * D * N_IN, 0, 1, N_IN, D, N_IN, WinT + (size_t)l * N_INP * D, 0, RmWin{}, ldsf, tid, bid, G);
            convert_mats(p.in[I_WO] + (size_t)l * D * D, 0, 1, D, D, D, WoT + (size_t)l * D * D, 0, RmIdent{}, ldsf, tid, bid, G);
            convert_mats(p.in[I_WGATE] + (size_t)l * NEXP * D * DFF, (size_t)D * DFF, NEXP, DFF, D, DFF, WguT + (size_t)l * NEXP * 1024 * D, (size_t)1024 * D, RmGu{0}, ldsf, tid, bid, G);
            convert_mats(p.in[I_WUP] + (size_t)l * NEXP * D * DFF, (size_t)D * DFF, NEXP, DFF, D, DFF, WguT + (size_t)l * NEXP * 1024 * D, (size_t)1024 * D, RmGu{1}, ldsf, tid, bid, G);
            convert_mats(p.in[I_WDOWN] + (size_t)l * NEXP * DFF * D, (size_t)DFF * D, NEXP, D, DFF, D, WdT + (size_t)l * NEXP * D * DFF, (size_t)D * DFF, RmIdent{}, ldsf, tid, bid, G);
            convert_mats(p.in[I_WA] + (size_t)l * 6 * 128 * 128, (size_t)128 * 128, 6, 128, 128, 128, WaiT + (size_t)l * 6 * 256 * 128, (size_t)256 * 128, RmIdent{}, ldsf, tid, bid, G);
            convert_mats(p.in[I_WI] + (size_t)l * 6 * 128 * 128, (size_t)128 * 128, 6, 128, 128, 128, WaiT + (size_t)l * 6 * 256 * 128, (size_t)256 * 128, RmOff{128}, ldsf, tid, bid, G);
        }
        for (int i = gtid; i < DEPTH * 8 * D; i += gthreads) { const int k = i % D, h = (i / D) % 8, l = i / (8 * D);
            Wfa[i] = (h < 6) ? p.in[I_WIN][(size_t)l * D * N_IN + (size_t)k * N_IN + C_FA + h] : 0.f; }
        for (int i = gtid; i < DEPTH * 48 * D; i += gthreads) { const int k = i % D, o = (i / D) % 48, l = i / (48 * D);
            const float w = (o < 4) ? p.in[I_WGRP][((size_t)l * D + k) * 4 + o] : (o < 36 ? p.in[I_WRT][((size_t)l * D + k) * 32 + (o - 4)] : 0.f);
            const bf16_t hi = f2bf(w);
            W36b[((size_t)l * 2 + 0) * 48 * D + (size_t)o * D + k] = hi; W36b[((size_t)l * 2 + 1) * 48 * D + (size_t)o * D + k] = f2bf(w - bf2f(hi)); }
        for (int i = gtid; i < S * 8; i += gthreads) { const int d = i & 7, t = i >> 3; const float ang = (float)positions[t] * p.inv_freq[d];
            ropecs[t * 16 + d] = cosf(ang); ropecs[t * 16 + 8 + d] = sinf(ang); }
        __syncthreads();
        for (int i = tid; i < 6 * D; i += NTHREADS) { const int k = i % D, h = i / D; ldsf[i] = p.in[I_WIN][(size_t)k * N_IN + C_FA + h]; }
        __syncthreads();
        for (int t = gwave; t < S; t += gwaves) {
            const float* xr = p.in[I_X] + (size_t)t * D;
            float fa[6] = {0.f, 0.f, 0.f, 0.f, 0.f, 0.f};
#pragma unroll
            for (int j = 0; j < 8; ++j) {
                const int c = j * 256 + lane * 4;
                const f32x4 v = *(const f32x4*)(xr + c);
                u32x2 o; o.x = pack2(v[0], v[1]); o.y = pack2(v[2], v[3]);
                *(u32x2*)(xb + (size_t)t * D + c) = o;
#pragma unroll
                for (int h = 0; h < 6; ++h) { const f32x4 w = *(const f32x4*)(ldsf + h * D + c); fa[h] += v[0] * w[0] + v[1] * w[1] + v[2] * w[2] + v[3] * w[3]; }
            }
#pragma unroll
            for (int h = 0; h < 6; ++h) { const float s = wave_sum(fa[h]); if (lane == 0) logf_[h * S + t] = log_sigmoid_f(s + p.in[I_BF][h]); }
        }
        PH_BAR(0);
    }

    for (int l = 0; l < DEPTH; ++l) {
        const int pb = 1 + l * NPH;
#define hin ((l == 0) ? p.in[I_X] : (const float*)hb)
#define hout ((l == DEPTH - 1) ? p.out : hb)
#define workctr ((int*)(wsl + CTL_WORK_OFF) + l * 64)

        if (PH_SEL(0) && PH_IN(pb + 0)) for (int rep = 0; rep < PH_REPS(0); ++rep) {
            PHASE_IDS();
            if (bid == 0) {
                double* part = (double*)lds_raw;
                const int per = S / 64;
                double s = 0.0;
                if (wave < 6) { for (int i = 0; i < per; ++i) s += (double)logf_[wave * S + lane * per + i]; part[wave * 64 + lane] = s; }
                __syncthreads();
                if (wave < 6) {
                    double run = 0.0;
                    for (int j = 0; j < lane; ++j) run += part[wave * 64 + j];
                    for (int i = 0; i < per; ++i) { run += (double)logf_[wave * S + lane * per + i]; cum2[wave * S + lane * per + i] = (float)(run * (double)LOG2E); }
                }
                __syncthreads();
            }
            const bf16_t* Bt = WinT + (size_t)l * N_INP * D;
            constexpr int ntn = N_INP / 256, ntm = S / 256;
            const unsigned nooff[2][2] = {{0u, 0u}, {0u, 0u}};
            for (int t = bid; t < ntm * ntn; t += G) {
                const int pm = t / ntn, pn = t % ntn;
                f32x4 acc[2][2][4][2];
                gemm_tile<false>(xb, pm * 256, nooff, Bt, pn * 256, D, lds_raw, acc, tid);
                int et = tid; OPAQUE(et); const int wr = et >> 8, wc = (et >> 6) & 3, fr = et & 15, fq = (et >> 4) & 3;
                if (pn < 6 || (pn >= 9 && pn < 19)) {
                    bf16_t* dst; float scale = 1.f; bool rope = false;
                    if (pn < 3) { dst = Qa; scale = QSCALE_A; } else if (pn < 6) { dst = Ka; } else if (pn < 12) { dst = Xr; } else if (pn < 15) { dst = Gr; }
                    else if (pn < 17) { dst = Qc; scale = QSCALE_C; rope = true; } else { dst = Kc; rope = true; }
                    const bool headmajor = (pn < 6) || (pn >= 15);
                    const int segpn = (pn < 3) ? pn : (pn < 6) ? pn - 3 : (pn < 12) ? pn - 9 : (pn < 15) ? pn - 12 : (pn < 17) ? pn - 15 : pn - 17;
#pragma unroll
                    for (int ai = 0; ai < 2; ++ai)
#pragma unroll
                        for (int m = 0; m < 4; ++m)
#pragma unroll
                            for (int bj = 0; bj < 2; ++bj)
#pragma unroll
                                for (int n = 0; n < 2; ++n) {
                                    const int dd = wc * 32 + n * 16 + fr;
#pragma unroll
                                    for (int j = 0; j < 4; ++j) {
                                        const int row = pm * 256 + ai * 128 + wr * 64 + m * 16 + fq * 4 + j;
                                        float v = acc[ai][bj][m][n][j];
                                        if (rope && n == 0 && (wc & 1) == 0) {
                                            const float pv = SHX(v, 8);
                                            const float cs = ropecs[row * 16 + (fr & 7)], sn = ropecs[row * 16 + 8 + (fr & 7)];
                                            v = (fr < 8) ? (v * cs - pv * sn) : (v * cs + pv * sn);
                                        }
                                        v *= scale;
                                        *(bf16_t*)(lds_raw + (ai * 128 + wr * 64 + m * 16 + fq * 4 + j) * 528 + (bj * 128 + dd) * 2) = f2bf(v);
                                    }
                                }
                    __syncthreads();
#pragma unroll 4
                    for (int i = 0; i < 16; ++i) {
                        const int idx = et + i * 512, lrow = idx >> 5, ch = idx & 31, row = pm * 256 + lrow;
                        const u32x4 val = *(const u32x4*)(lds_raw + lrow * 528 + ch * 16);
                        size_t gi;
                        if (headmajor) gi = ((size_t)(segpn * 2 + (ch >> 4)) * S + row) * 128 + (ch & 15) * 8;
                        else gi = (size_t)row * LRU_W + segpn * 256 + ch * 8;
                        *(u32x4*)(dst + gi) = val;
                    }
                    __syncthreads();
                    if (pn >= 3 && pn < 6) {
                        float* part = ldsf;
#pragma unroll
                        for (int ai = 0; ai < 2; ++ai)
#pragma unroll
                            for (int m = 0; m < 4; ++m)
#pragma unroll
                                for (int bj = 0; bj < 2; ++bj)
#pragma unroll
                                    for (int j = 0; j < 4; ++j) {
                                        float ss = acc[ai][bj][m][0][j] * acc[ai][bj][m][0][j] + acc[ai][bj][m][1][j] * acc[ai][bj][m][1][j];
                                        ss += SHX(ss, 1); ss += SHX(ss, 2); ss += SHX(ss, 4); ss += SHX(ss, 8);
                                        if (fr == 0) part[(wc * 2 + bj) * 256 + ai * 128 + wr * 64 + m * 16 + fq * 4 + j] = ss;
                                    }
                        __syncthreads();
                        {
                            const int bj = et >> 8, row = et & 255;
                            float v = part[(0 * 2 + bj) * 256 + row] + part[(1 * 2 + bj) * 256 + row] + part[(2 * 2 + bj) * 256 + row] + part[(3 * 2 + bj) * 256 + row];
                            v = fmaxf(v, SHX(v, 1)); v = fmaxf(v, SHX(v, 2)); v = fmaxf(v, SHX(v, 4)); v = fmaxf(v, SHX(v, 8)); v = fmaxf(v, SHX(v, 16)); v = fmaxf(v, SHX(v, 32));
                            if ((et & 63) == 0) kmax2[((pn - 3) * 2 + bj) * NKT + pm * 4 + ((et >> 6) & 3)] = v;
                        }
                        __syncthreads();
                    }
                } else {
                    bf16_t* dst = (pn < 9) ? VaT : VcT;
                    const int segpn = (pn < 9) ? pn - 6 : pn - 19;
#pragma unroll
                    for (int ai = 0; ai < 2; ++ai)
#pragma unroll
                        for (int m = 0; m < 4; ++m)
#pragma unroll
                            for (int bj = 0; bj < 2; ++bj)
#pragma unroll
                                for (int n = 0; n < 2; ++n) {
                                    const int dd = wc * 32 + n * 16 + fr;
                                    const int row = pm * 256 + ai * 128 + wr * 64 + m * 16 + fq * 4;
                                    const f32x4 a = acc[ai][bj][m][n];
                                    u32x2 o; o.x = pack2(a[0], a[1]); o.y = pack2(a[2], a[3]);
                                    *(u32x2*)(dst + (((size_t)(segpn * 2 + bj) * NKT + (row >> 6)) * 128 + dd) * 64 + (row & 63)) = o;
                                }
                }
            }
            PH_BAR(pb + 0);
        }

        if (PH_SEL(1) && PH_IN(pb + 1)) for (int rep = 0; rep < PH_REPS(1); ++rep) {
            PHASE_IDS();
            const float lam_init = (l == 0) ? 0.2f : 0.35550906759f;
            const float s1 = wave_sum(p.in[I_LQ1][l * 64 + lane] * p.in[I_LK1][l * 64 + lane]);
            const float s2 = wave_sum(p.in[I_LQ2][l * 64 + lane] * p.in[I_LK2][l * 64 + lane]);
            const float lam = fexp(s1) - fexp(s2) + lam_init;
            constexpr int NLRU = NKT * 6, NQB = S / 128;
#ifndef NO_LRU
            for (int r2 = 0; r2 < (REP_SUB == 1 ? 2 : 1); ++r2)
            for (int u = bid; u < NLRU; u += G)
                lru_unit_a(u / 6, u % 6, l, p, Xr, WaiT + (size_t)l * 6 * 256 * 128, hloc, ploc, sumA, sumH, lds_raw, tid);
#endif
#ifndef NO_DIFF
            {
                constexpr int NQB2 = S / 256;
                int total = 0;
                for (int q = 0; q < NQB2; ++q) total += ((4 * q + 4 + DCH - 1) / DCH) * 8;
                for (int r2 = 0; r2 < (REP_SUB == 2 ? 2 : 1); ++r2)
                for (;;) {
                    __syncthreads();
                    if (tid == 0) *ubox = (unsigned)atomic_add_int(workctr + 2 * rep + 4 * r2, 1);
                    __syncthreads();
                    int u = RFL((int)*ubox);
                    if (u >= total) break;
                    int qb = NQB2 - 1;
                    for (;; --qb) { const int nu = ((4 * qb + 4 + DCH - 1) / DCH) * 8; if (u < nu) break; u -= nu; }
                    const int c = u >> 3, h = (u >> 1) & 3, mp = u & 1;
                    const int t0 = c * DCH, t1 = (t0 + DCH < 4 * qb + 4) ? t0 + DCH : 4 * qb + 4;
                    attn_dmap_unit(Qc + (size_t)h * S * 128, Kc + (size_t)h * S * 128, VcT + (size_t)h * S * 128, mp, qb, t0, t1,
                                   dpo + (size_t)(h * 2 + mp) * DPART_ROWS * 128, dpml + (size_t)(h * 2 + mp) * DPART_ROWS * 2, c, lds_raw, tid);
                }
            }
#endif
#ifndef NO_FOX
            for (int r2 = 0; r2 < (REP_SUB == 3 ? 2 : 1); ++r2)
            for (;;) {
                __syncthreads();
                if (tid == 0) *ubox = (unsigned)atomic_add_int(workctr + 2 * rep + 1 + 4 * r2, 1);
                __syncthreads();
                const int u = RFL((int)*ubox);
                if (u >= NQB * FOX_H) break;
                const int qb = NQB - 1 - u / FOX_H, h = u % FOX_H;
                attn_unit<0>(Qa + (size_t)h * S * 128, Ka + (size_t)h * S * 128, VaT + (size_t)h * S * 128, cum2 + (size_t)h * S, kmax2 + h * NKT, qb, concat, h * 128,
                             0.f, 0.f, nullptr, lds_raw, tid);
            }
#endif
            PH_BAR(pb + 1);
        }

        if (PH_SEL(2) && PH_IN(pb + 2)) for (int rep = 0; rep < PH_REPS(2); ++rep) {
            PHASE_IDS();
            for (int u = bid; u < NKT * 6; u += G) {
                const int chunk = u / 6, grp = u % 6, c = tid & 127, tq = tid >> 7, ch = grp * 128 + c;
                float cr = 0.f;
                {
                    int j = 0;
                    for (; j + 8 <= chunk; j += 8) {
                        float a8[8], h8[8];
#pragma unroll
                        for (int q = 0; q < 8; ++q) { a8[q] = sumA[(size_t)(j + q) * LRU_W + ch]; h8[q] = sumH[(size_t)(j + q) * LRU_W + ch]; }
#pragma unroll
                        for (int q = 0; q < 8; ++q) cr = a8[q] * cr + h8[q];
                    }
                    for (; j < chunk; ++j) cr = sumA[(size_t)j * LRU_W + ch] * cr + sumH[(size_t)j * LRU_W + ch];
                }
#pragma unroll 4
                for (int i = 0; i < 16; ++i) {
                    const size_t gi = (size_t)(chunk * 64 + tq * 16 + i) * LRU_W + ch;
                    const float h = hloc[gi] + ploc[gi] * cr;
                    concat[(size_t)(chunk * 64 + tq * 16 + i) * D + FOX_W + ch] = f2bf(gelu_tanh_f(bf2f(Gr[gi])) * h);
                }
            }
            {
                const float lam_init = (l == 0) ? 0.2f : 0.35550906759f;
                const float s1 = wave_sum(p.in[I_LQ1][l * 64 + lane] * p.in[I_LK1][l * 64 + lane]);
                const float s2 = wave_sum(p.in[I_LQ2][l * 64 + lane] * p.in[I_LK2][l * 64 + lane]);
                const float lam = fexp(s1) - fexp(s2) + lam_init;
                const float* sg = p.in[I_SUBG] + l * 128;
                const float g0 = sg[2 * lane], g1 = sg[2 * lane + 1];
                static_assert(NCH <= 8, "the merge below keeps one (map, chunk) pair per lane: 2 x 8 lanes");
                for (int idx = gwave; idx < S * DIFF_H; idx += gwaves) {
                    const int h = idx & 3, q = idx >> 2, nch = (q >> 6) / DCH + 1;
                    float mv = -INFINITY, lv = 0.f;
                    { const int c = lane & 7, mp = (lane >> 3) & 1;
                      if (lane < 16 && c < nch) { const float* ML = dpml + ((size_t)(h * 2 + mp) * DPART_ROWS + dpart_row(c, q)) * 2; mv = ML[0]; lv = ML[1]; } }
                    float Mx = mv; Mx = fmaxf(Mx, SHX(Mx, 1)); Mx = fmaxf(Mx, SHX(Mx, 2)); Mx = fmaxf(Mx, SHX(Mx, 4));
                    const float wv = (mv == -INFINITY) ? 0.f : FAST_EXP2(mv - Mx);
                    float Lp = lv * wv; Lp += SHX(Lp, 1); Lp += SHX(Lp, 2); Lp += SHX(Lp, 4);
                    float om[2][2];
#pragma unroll
                    for (int mp = 0; mp < 2; ++mp) {
                        const unsigned* OP = (const unsigned*)(dpo + (size_t)(h * 2 + mp) * DPART_ROWS * 128);
                        unsigned pk[NCH];
#pragma unroll
                        for (int c = 0; c < NCH; ++c) pk[c] = (c < nch) ? OP[(size_t)dpart_row(c, q) * 64 + lane] : 0u;
                        float o0 = 0.f, o1 = 0.f;
#pragma unroll
                        for (int c = 0; c < NCH; ++c) { const float w = RDLANE(wv, mp * 8 + c); o0 += bf2f((bf16_t)(pk[c] & 0xffffu)) * w; o1 += bf2f((bf16_t)(pk[c] >> 16)) * w; }
                        const float il = 1.f / RDLANE(Lp, mp * 8);
                        om[mp][0] = o0 * il; om[mp][1] = o1 * il;
                    }
                    const float v0 = om[0][0] - lam * om[1][0], v1 = om[0][1] - lam * om[1][1];
                    const float ss = wave_sum(v0 * v0 + v1 * v1);
                    const float rs = (1.f - lam_init) / sqrtf(ss * (1.f / 128.f) + LN_EPS);
                    *(unsigned*)(concat + (size_t)q * D + 1536 + h * 128 + 2 * lane) = pack2(v0 * rs * g0, v1 * rs * g1);
                }
            }
            PH_BAR(pb + 2);
        }

        if (PH_SEL(3) && PH_IN(pb + 3)) for (int rep = 0; rep < PH_REPS(3); ++rep) {
            PHASE_IDS();
            const bf16_t* Bt = WoT + (size_t)l * D * D;
            constexpr int ntn = D / 256, ntm = S / 256;
            const unsigned nooff[2][2] = {{0u, 0u}, {0u, 0u}};
            for (int t = bid; t < ntm * ntn; t += G) {
                const int pm = t / ntn, pn = t % ntn;
                f32x4 acc[2][2][4][2];
                gemm_tile<false>(concat, pm * 256, nooff, Bt, pn * 256, D, lds_raw, acc, tid);
                int et = tid; OPAQUE(et); const int wr = et >> 8, wc = (et >> 6) & 3, fr = et & 15, fq = (et >> 4) & 3;
#pragma unroll
                for (int ai = 0; ai < 2; ++ai) {
#pragma unroll
                    for (int m = 0; m < 4; ++m)
#pragma unroll
                        for (int bj = 0; bj < 2; ++bj)
#pragma unroll
                            for (int n = 0; n < 2; ++n)
#pragma unroll
                                for (int j = 0; j < 4; ++j)
                                    *(float*)(lds_raw + (wr * 64 + m * 16 + fq * 4 + j) * 1040 + (bj * 128 + wc * 32 + n * 16 + fr) * 4) = acc[ai][bj][m][n][j];
                    __syncthreads();
#pragma unroll 4
                    for (int i = 0; i < 16; ++i) {
                        const int idx = et + i * 512, lrow = idx >> 6, c4 = idx & 63;
                        const size_t gi = (size_t)(pm * 256 + ai * 128 + lrow) * D + pn * 256 + c4 * 4;
                        const f32x4 v = *(const f32x4*)(lds_raw + lrow * 1040 + c4 * 16);
                        *(f32x4*)(y1 + gi) = ALPHA * *(const f32x4*)(hin + gi) + v;
                    }
                    __syncthreads();
                }
            }
            PH_BAR(pb + 3);
        }

        if (PH_SEL(4) && PH_IN(pb + 4)) for (int rep = 0; rep < PH_REPS(4); ++rep) {
            PHASE_IDS();
            const float* g1 = p.in[I_LN1G] + (size_t)l * D; const float* b1 = p.in[I_LN1B] + (size_t)l * D;
            const float* bg = p.in[I_BGRP] + l * 4; const float* br = p.in[I_BRT] + l * 32;
            const bf16_t* Wb = W36b + (size_t)l * 2 * 48 * D;
            int* lcnt = (int*)(lds_raw + LDS_MISC + M_LCNT);
            const int segcap = ((S / 16 + G - 1) / G) * 16;
            const int r16 = lane & 15, q4 = lane >> 4;
            if (tid < 32) lcnt[tid] = 0;
            __syncthreads();
            for (int bi = bid; bi < S / 16; bi += G) {
#pragma unroll 1
                for (int tk = 0; tk < 2; ++tk) {
                    const int r = wave * 2 + tk, t = bi * 16 + r;
                    f32x4 v[8]; float s = 0.f;
#pragma unroll
                    for (int j = 0; j < 8; ++j) { v[j] = *(const f32x4*)(y1 + (size_t)t * D + j * 256 + lane * 4); s += (v[j][0] + v[j][1]) + (v[j][2] + v[j][3]); }
                    const float mean = wave_sum(s) * (1.f / D);
                    float s2 = 0.f;
#pragma unroll
                    for (int j = 0; j < 8; ++j) { v[j] -= mean; s2 += (v[j][0] * v[j][0] + v[j][1] * v[j][1]) + (v[j][2] * v[j][2] + v[j][3] * v[j][3]); }
                    const float rstd = 1.f / sqrtf(wave_sum(s2) * (1.f / D) + LN_EPS);
#pragma unroll
                    for (int j = 0; j < 8; ++j) {
                        const int c = j * 256 + lane * 4;
                        const f32x4 g = *(const f32x4*)(g1 + c), b = *(const f32x4*)(b1 + c);
                        v[j] = v[j] * rstd * g + b;
                        *(f32x4*)(h1 + (size_t)t * D + c) = v[j];
                        u32x2 o; o.x = pack2(v[j][0], v[j][1]); o.y = pack2(v[j][2], v[j][3]);
                        *(u32x2*)(h1b + (size_t)t * D + c) = o;
                        u32x2 lo2;
                        lo2.x = pack2(v[j][0] - bf2f((bf16_t)(o.x & 0xffffu)), v[j][1] - bf2f((bf16_t)(o.x >> 16)));
                        lo2.y = pack2(v[j][2] - bf2f((bf16_t)(o.y & 0xffffu)), v[j][3] - bf2f((bf16_t)(o.y >> 16)));
                        const int la = r * 4096 + (((j * 32 + (lane >> 1)) ^ r) << 4) + (lane & 1) * 8;
                        *(u32x2*)(lds_raw + la) = o; *(u32x2*)(lds_raw + 65536 + la) = lo2;
                    }
                }
                __syncthreads();
                f32x4 ac[3];
#pragma unroll
                for (int nt = 0; nt < 3; ++nt) ac[nt] = (f32x4){0.f, 0.f, 0.f, 0.f};
#pragma unroll 2
                for (int ks = 0; ks < 8; ++ks) {
                    const int kk = wave * 8 + ks;
                    const int la = r16 * 4096 + (((kk * 4 + q4) ^ r16) << 4);
                    const bf16x8 ah = *(const bf16x8*)(lds_raw + la), al = *(const bf16x8*)(lds_raw + 65536 + la);
#pragma unroll
                    for (int nt = 0; nt < 3; ++nt) {
                        const bf16x8 bh = *(const bf16x8*)(Wb + (size_t)(nt * 16 + r16) * D + kk * 32 + q4 * 8);
                        const bf16x8 bl = *(const bf16x8*)(Wb + (size_t)48 * D + (size_t)(nt * 16 + r16) * D + kk * 32 + q4 * 8);
                        ac[nt] = MFMA16(ah, bh, ac[nt]); ac[nt] = MFMA16(al, bh, ac[nt]); ac[nt] = MFMA16(ah, bl, ac[nt]);
                    }
                }
                __syncthreads();
                float* red = ldsf;
#pragma unroll
                for (int nt = 0; nt < 3; ++nt)
#pragma unroll
                    for (int j = 0; j < 4; ++j) red[(wave * 16 + q4 * 4 + j) * 48 + nt * 16 + r16] = ac[nt][j];
                __syncthreads();
                float* lgt = ldsf + 8 * 16 * 48;
                if (tid < 256) {
                    const int tkn = tid >> 4, o3 = (tid & 15) * 3;
#pragma unroll
                    for (int q = 0; q < 3; ++q) { float a = 0.f;
#pragma unroll
                        for (int w = 0; w < 8; ++w) a += red[(w * 16 + tkn) * 48 + o3 + q];
                        lgt[tkn * 48 + o3 + q] = a; }
                }
                __syncthreads();
                if (tid < 16) {
                    const int t = bi * 16 + tid; const float* L = lgt + tid * 48;
                    float gl[4];
#pragma unroll
                    for (int q = 0; q < 4; ++q) gl[q] = L[q] + bg[q];
                    int gi = 0; float gm = gl[0];
#pragma unroll
                    for (int q = 1; q < 4; ++q) if (gl[q] > gm) { gm = gl[q]; gi = q; }
                    float gs = 0.f;
#pragma unroll
                    for (int q = 0; q < 4; ++q) gs += fexp(gl[q] - gm);
                    const float gweight = 1.f / gs;
                    float E[8];
#pragma unroll
                    for (int e = 0; e < 8; ++e) E[e] = L[4 + gi * 8 + e] + br[gi * 8 + e];
                    int e1 = 0; float m1 = E[0];
#pragma unroll
                    for (int e = 1; e < 8; ++e) if (E[e] > m1) { m1 = E[e]; e1 = e; }
                    int e2 = -1; float m2 = -INFINITY;
#pragma unroll
                    for (int e = 0; e < 8; ++e) if (e != e1 && E[e] > m2) { m2 = E[e]; e2 = e; }
                    const float p2 = fexp(m2 - m1), w1 = 1.f / (1.f + p2), w2 = p2 / (1.f + p2);
                    const int ge1 = gi * 8 + e1, ge2 = gi * 8 + e2;
                    const int i1 = (ge1 * G + bid) * segcap + atomic_add_int(&lcnt[ge1], 1);
                    ltok[i1] = t; lw[i1] = gweight * w1; lslot[i1] = 0;
                    const int i2 = (ge2 * G + bid) * segcap + atomic_add_int(&lcnt[ge2], 1);
                    ltok[i2] = t; lw[i2] = gweight * w2; lslot[i2] = 1;
                }
                __syncthreads();
            }
            if (tid < 32) cntb[bid * 32 + tid] = lcnt[tid];
            PH_BAR(pb + 4);
        }

        if (PH_SEL(5) && PH_IN(pb + 5)) {
            PHASE_IDS();
            const unsigned nooff[2][2] = {{0u, 0u}, {0u, 0u}};
            const int segcap = ((S / 16 + G - 1) / G) * 16;
            moe_prefix(cntb, G, lds_raw, tid);
            const int* ctot = (const int*)(lds_raw + LDS_MISC + M_CTOT); const int* coff = (const int*)(lds_raw + LDS_MISC + M_COFF);
            const int* rtok = (const int*)(lds_raw + LDS_MISC + M_RTOK); const float* rw = (const float*)(lds_raw + LDS_MISC + M_RW);
            const int* rslot = (const int*)(lds_raw + LDS_MISC + M_RSLOT);
            unsigned* done = (unsigned*)(wsl + CTL_DONE_OFF) + l * 1024;
            int nmt = 0;
            for (int e = 0; e < NEXP; ++e) nmt += (ctot[e] + 255) / 256;
            nmt = RFL(nmt);
            for (;;) {
                __syncthreads();
                if (tid == 0) *ubox = (unsigned)atomic_add_int(workctr + 8, 1);
                __syncthreads();
                int u = RFL((int)*ubox);
                if (u >= nmt * 12) break;
                const bool down = (u >= nmt * 4);
                const int per = down ? 8 : 4;
                if (down) u -= nmt * 4;
                int e = 0;
                for (;; ++e) { const int nt = ((RFL(ctot[e]) + 255) / 256) * per; if (u < nt) break; u -= nt; }
                const int c = RFL(ctot[e]), off = RFL(coff[e]);
                const int mt = u / per, pn = u % per, m0 = mt * 256;
                moe_rowtable(ltok, lw, lslot, e, m0, G, segcap, lds_raw, tid);
                f32x4 acc[2][2][4][2];
                if (!down) {
                    const bf16_t* Bt = WguT + ((size_t)l * NEXP + e) * 1024 * D;
                    unsigned aoff[2][2];
                    int st = tid; OPAQUE(st); int R[2], C[2]; stage_geom(st, R, C);
#pragma unroll
                    for (int h = 0; h < 2; ++h)
#pragma unroll
                        for (int i = 0; i < 2; ++i) aoff[h][i] = (unsigned)(rtok[h * 128 + R[i]] * D + C[i]);
                    gemm_tile<true>(h1b, 0, aoff, Bt, pn * 256, D, lds_raw, acc, tid);
                    int et = tid; OPAQUE(et); const int wr = et >> 8, wc = (et >> 6) & 3, fr = et & 15, fq = (et >> 4) & 3;
#pragma unroll
                    for (int ai = 0; ai < 2; ++ai)
#pragma unroll
                        for (int m = 0; m < 4; ++m)
#pragma unroll
                            for (int j = 0; j < 4; ++j) {
                                const int r = ai * 128 + wr * 64 + m * 16 + fq * 4 + j;
                                const float wgt = rw[r];
#pragma unroll
                                for (int bj = 0; bj < 2; ++bj)
                                    *(bf16_t*)(lds_raw + r * 272 + (bj * 64 + wc * 16 + fr) * 2) = f2bf(silu_f(acc[ai][bj][m][0][j]) * acc[ai][bj][m][1][j] * wgt);
                            }
                    __syncthreads();
#pragma unroll 4
                    for (int i = 0; i < 8; ++i) {
                        const int idx = et + i * 512, r = idx >> 4, ch = idx & 15;
                        if (m0 + r < c) *(u32x4*)(act + (size_t)(off + m0 + r) * DFF + pn * 128 + ch * 8) = *(const u32x4*)(lds_raw + r * 272 + ch * 16);
                    }
                    WAIT_VM0();
                    __syncthreads();
                    if (et == 0) { FENCE_REL_AGENT(); WAIT_VM0(); (void)xb_add(&done[e * 32 + mt], 1u); }
                } else {
                    const bf16_t* Bt = WdT + ((size_t)l * NEXP + e) * D * DFF;
                    if (tid == 0) {
                        unsigned* bw = (unsigned*)wsl;
                        XB_SPIN(xb_ld(&done[e * 32 + mt]) < 4u, bw);
                        FENCE_ACQ_AGENT();
                        WAIT_VM0();
                    }
                    __syncthreads();
                    gemm_tile<false>(act, off + m0, nooff, Bt, pn * 256, DFF, lds_raw, acc, tid);
                    int et = tid; OPAQUE(et); const int wr = et >> 8, wc = (et >> 6) & 3, fr = et & 15, fq = (et >> 4) & 3;
#pragma unroll
                    for (int ai = 0; ai < 2; ++ai)
#pragma unroll
                        for (int m = 0; m < 4; ++m)
#pragma unroll
                            for (int bj = 0; bj < 2; ++bj)
#pragma unroll
                                for (int n = 0; n < 2; ++n)
#pragma unroll
                                    for (int j = 0; j < 4; ++j)
                                        *(bf16_t*)(lds_raw + (ai * 128 + wr * 64 + m * 16 + fq * 4 + j) * 528 + (bj * 128 + wc * 32 + n * 16 + fr) * 2) = f2bf(acc[ai][bj][m][n][j]);
                    __syncthreads();
#pragma unroll 4
                    for (int i = 0; i < 16; ++i) {
                        const int idx = et + i * 512, r = idx >> 5, ch = idx & 31;
                        if (m0 + r < c) *(u32x4*)(contrib + ((size_t)rslot[r] * S + rtok[r]) * D + pn * 256 + ch * 8) = *(const u32x4*)(lds_raw + r * 528 + ch * 16);
                    }
                }
            }
            PH_BAR(pb + 5);
        }

        if (PH_SEL(7) && PH_IN(pb + 7)) for (int rep = 0; rep < PH_REPS(7); ++rep) {
            PHASE_IDS();
            const float* g2 = p.in[I_LN2G] + (size_t)l * D; const float* b2 = p.in[I_LN2B] + (size_t)l * D;
            const bool more = (l + 1 < DEPTH);
            const float* wf = Wfa + (size_t)(l + 1 < DEPTH ? l + 1 : l) * 8 * D;
            for (int t = gwave; t < S; t += gwaves) {
                f32x4 v[8]; float s = 0.f;
#pragma unroll
                for (int j = 0; j < 8; ++j) {
                    const size_t i = (size_t)t * D + j * 256 + lane * 4;
                    const u32x2 c0 = *(const u32x2*)(contrib + i), c1 = *(const u32x2*)(contrib + (size_t)S * D + i);
                    const f32x4 cs = (f32x4){bf2f((bf16_t)(c0.x & 0xffffu)) + bf2f((bf16_t)(c1.x & 0xffffu)), bf2f((bf16_t)(c0.x >> 16)) + bf2f((bf16_t)(c1.x >> 16)),
                                             bf2f((bf16_t)(c0.y & 0xffffu)) + bf2f((bf16_t)(c1.y & 0xffffu)), bf2f((bf16_t)(c0.y >> 16)) + bf2f((bf16_t)(c1.y >> 16))};
                    v[j] = ALPHA * *(const f32x4*)(h1 + i) + cs;
                    s += (v[j][0] + v[j][1]) + (v[j][2] + v[j][3]);
                }
                const float mean = wave_sum(s) * (1.f / D);
                float s2 = 0.f;
#pragma unroll
                for (int j = 0; j < 8; ++j) { v[j] -= mean; s2 += (v[j][0] * v[j][0] + v[j][1] * v[j][1]) + (v[j][2] * v[j][2] + v[j][3] * v[j][3]); }
                const float rstd = 1.f / sqrtf(wave_sum(s2) * (1.f / D) + LN_EPS);
                float fa[6] = {0.f, 0.f, 0.f, 0.f, 0.f, 0.f};
#pragma unroll
                for (int j = 0; j < 8; ++j) {
                    const int c = j * 256 + lane * 4;
                    const f32x4 g = *(const f32x4*)(g2 + c), b = *(const f32x4*)(b2 + c);
                    v[j] = v[j] * rstd * g + b;
                    *(f32x4*)(hout + (size_t)t * D + c) = v[j];
                    COMPILER_FENCE();
                    if (more) {
                        u32x2 o; o.x = pack2(v[j][0], v[j][1]); o.y = pack2(v[j][2], v[j][3]);
                        *(u32x2*)(xb + (size_t)t * D + c) = o;
#pragma unroll
                        for (int h = 0; h < 6; ++h) { const f32x4 w = *(const f32x4*)(wf + h * D + c); fa[h] += (v[j][0] * w[0] + v[j][1] * w[1]) + (v[j][2] * w[2] + v[j][3] * w[3]); }
                    }
                }
                if (more) {
#pragma unroll
                    for (int h = 0; h < 6; ++h) { const float sm = wave_sum(fa[h]); if (lane == 0) logf_[h * S + t] = log_sigmoid_f(sm + p.in[I_BF][(l + 1) * 6 + h]); }
                }
            }
            PH_BAR(pb + 7);
        }
    }
#undef PH_IN
#undef PH_BAR
}

constexpr int N_PHASES = 1 + DEPTH * 8;
#ifndef EMU
extern "C" void kernel_launch(void* const* d_in, const int* in_sizes, int n_in, void* d_out, int out_size, void* d_ws, size_t ws_size, hipStream_t stream) {
    static int grid = 0;
    if (grid == 0) {
        if (n_in != N_INPUTS || out_size != S * D || ws_size < WS_END) {
            fprintf(stderr, "kernel_launch: unexpected shapes: n_in %d out %d ws %zu (need %zu)\n", n_in, out_size, ws_size, (size_t)WS_END); grid = -1; return; }
        int dev = 0, cus = 0, per_cu = 0;
        if (hipGetDevice(&dev) != hipSuccess || hipDeviceGetAttribute(&cus, hipDeviceAttributeMultiprocessorCount, dev) != hipSuccess) { grid = -1; return; }
        if (hipFuncSetAttribute((const void*)fwd_kernel, hipFuncAttributeMaxDynamicSharedMemorySize, LDS_BYTES) != hipSuccess) { fprintf(stderr, "kernel_launch: hipFuncSetAttribute failed\n"); grid = -1; return; }
        if (hipOccupancyMaxActiveBlocksPerMultiprocessor(&per_cu, (const void*)fwd_kernel, NTHREADS, LDS_BYTES) != hipSuccess || per_cu < 1) {
            fprintf(stderr, "kernel_launch: occupancy query says %d blocks per CU\n", per_cu); (void)hipGetLastError(); grid = -1; return; }
        grid = cus;
    }
    if (grid < 0) return;
    (void)hipMemsetAsync(d_ws, 0, CTL_BYTES, stream);
    Params p{};
    for (int i = 0; i < N_INPUTS; ++i) p.in[i] = (const float*)d_in[i];
    p.out = (float*)d_out; p.ws = (unsigned char*)d_ws;
    for (int i = 0; i < 8; ++i) p.inv_freq[i] = (float)pow(500000.0, -(double)i * 2.0 / 16.0);
#if N_LAUNCH_SPLIT
    for (int k = 0; k < N_PHASES; ++k) { p.lo = k; p.hi = k + 1; hipLaunchKernelGGL(fwd_kernel, dim3(grid), dim3(NTHREADS), LDS_BYTES, stream, p); }
#else
    p.lo = 0; p.hi = N_PHASES;
    hipLaunchKernelGGL(fwd_kernel, dim3(grid), dim3(NTHREADS), LDS_BYTES, stream, p);
#endif
}
#endif
```

```cpp
#ifndef EMU
#include <hip/hip_runtime.h>
#include <cstdio>
#include <cstdint>
#include <cmath>
#endif

#ifndef SEQ
#define SEQ 8192
#endif
#ifndef N_LAUNCH_SPLIT
#define N_LAUNCH_SPLIT 0
#endif
#ifndef REP_PHASE
#define REP_PHASE -2
#endif
#define PH_REPS(c) ((c) == REP_PHASE ? 2 : 1)
#ifndef REP_SUB
#define REP_SUB 0
#endif

constexpr int S = SEQ, D = 2048, DEPTH = 2;
constexpr int FOX_H = 6, FOX_W = 768;
constexpr int LRU_W = 768;
constexpr int DIFF_H = 4, DIFF_W = 512;
constexpr int N_IN = 5382, N_INP = 5376;
constexpr int C_FA = 2304;
constexpr int NEXP = 32, DFF = 512;
constexpr int NKT = S / 64;
#ifndef DCH
#define DCH 16
#endif
constexpr int NCH = (NKT + DCH - 1) / DCH;
constexpr size_t DPART_ROWS = (size_t)NCH * S - (size_t)(DCH * 64) * NCH * (NCH - 1) / 2;
constexpr float ALPHA = 1.41421356237309504880f;
constexpr float LN_EPS = 1e-5f;
constexpr float LOG2E = 1.4426950408889634f;
constexpr float QSCALE_A = 0.08838834764831845f * 1.4426950408889634f;
constexpr float QSCALE_C = 0.125f * 1.4426950408889634f;

enum { I_X = 0, I_POS, I_WIN, I_BF, I_CONVW, I_CONVB, I_WA, I_BA, I_WI, I_BI, I_LAM, I_LQ1, I_LK1, I_LQ2, I_LK2, I_SUBG, I_WO, I_LN1G, I_LN1B,
       I_WGRP, I_BGRP, I_WRT, I_BRT, I_WGATE, I_WUP, I_WDOWN, I_LN2G, I_LN2B, N_INPUTS };

typedef unsigned short bf16_t;
typedef short bf16x8 __attribute__((ext_vector_type(8)));
typedef float f32x4 __attribute__((ext_vector_type(4)));
typedef unsigned u32x4 __attribute__((ext_vector_type(4)));
typedef unsigned u32x2 __attribute__((ext_vector_type(2)));

constexpr size_t al256(size_t x) { return (x + 255) & ~(size_t)255; }
constexpr size_t CTL_BYTES = 65536;
constexpr size_t CTL_CNT_OFF = 32768;
constexpr size_t CTL_WORK_OFF = 36864;
constexpr size_t CTL_CLS_OFF = 49152;
constexpr size_t CTL_DONE_OFF = 40960;
constexpr size_t WB_WIN = CTL_BYTES;
constexpr size_t WB_WO = WB_WIN + al256((size_t)DEPTH * N_INP * D * 2);
constexpr size_t WB_WGU = WB_WO + al256((size_t)DEPTH * D * D * 2);
constexpr size_t WB_WD = WB_WGU + al256((size_t)DEPTH * NEXP * 1024 * D * 2);
constexpr size_t WB_WAI = WB_WD + al256((size_t)DEPTH * NEXP * D * DFF * 2);
constexpr size_t WF_FA = WB_WAI + al256((size_t)DEPTH * 6 * 256 * 128 * 2);
constexpr size_t WF_R36 = WF_FA + al256((size_t)DEPTH * 8 * D * 4);
constexpr size_t WF_ROPE = WF_R36 + al256((size_t)DEPTH * 2 * 48 * D * 2);
constexpr size_t A_XB = WF_ROPE + al256((size_t)S * 16 * 4);
constexpr size_t A_HB = A_XB + al256((size_t)S * D * 2);
constexpr size_t A_LOGF = A_HB + al256((size_t)S * D * 4);
constexpr size_t A_CUM = A_LOGF + al256((size_t)6 * S * 4);
constexpr size_t A_KMAX = A_CUM + al256((size_t)6 * S * 4);
constexpr size_t A_CNTB = A_KMAX + al256((size_t)6 * NKT * 4);
constexpr size_t A_QA = A_CNTB + al256((size_t)1024 * 32 * 4);
constexpr size_t A_KA = A_QA + al256((size_t)FOX_H * S * 128 * 2);
constexpr size_t A_VAT = A_KA + al256((size_t)FOX_H * S * 128 * 2);
constexpr size_t A_XR = A_VAT + al256((size_t)FOX_H * S * 128 * 2);
constexpr size_t A_GR = A_XR + al256((size_t)S * LRU_W * 2);
constexpr size_t A_QC = A_GR + al256((size_t)S * LRU_W * 2);
constexpr size_t A_KC = A_QC + al256((size_t)DIFF_H * S * 128 * 2);
constexpr size_t A_VCT = A_KC + al256((size_t)DIFF_H * S * 128 * 2);
constexpr size_t A_HLOC = A_VCT + al256((size_t)DIFF_H * S * 128 * 2);
constexpr size_t A_PLOC = A_HLOC + al256((size_t)S * LRU_W * 4);
constexpr size_t A_SUMA = A_PLOC + al256((size_t)S * LRU_W * 4);
constexpr size_t A_SUMH = A_SUMA + al256((size_t)NKT * LRU_W * 4);
constexpr size_t A_CONCAT = A_SUMH + al256((size_t)NKT * LRU_W * 4);
constexpr size_t A_Y1 = A_CONCAT + al256((size_t)S * D * 2);
constexpr size_t A_H1 = A_Y1 + al256((size_t)S * D * 4);
constexpr size_t A_H1B = A_H1 + al256((size_t)S * D * 4);
constexpr size_t A_LTOK = A_H1B + al256((size_t)S * D * 2);
constexpr size_t A_LW = A_LTOK + al256((size_t)NEXP * S * 4);
constexpr size_t A_LSLOT = A_LW + al256((size_t)NEXP * S * 4);
constexpr size_t A_ACT = A_LSLOT + al256((size_t)NEXP * S * 4);
constexpr size_t A_CONTRIB = A_ACT + al256((size_t)(2 * S + 256) * DFF * 2);
constexpr size_t WS_END = A_CONTRIB + al256((size_t)2 * S * D * 4);
constexpr size_t A_DPO = A_Y1;
constexpr size_t A_DPML = A_DPO + al256((size_t)8 * DPART_ROWS * 128 * 2);
static_assert(A_DPML + (size_t)8 * DPART_ROWS * 2 * 4 <= A_H1B, "differential partials must fit inside the y1 + h1 region");

constexpr int NTHREADS = 512;
constexpr int LDS_MAIN = 131072 + 4096;
constexpr int LDS_MISC = LDS_MAIN;
constexpr int LDS_BYTES = LDS_MAIN + 8192 + 16640;
constexpr int M_PRE16 = 8192;
constexpr int M_LCNT = 64, M_CTOT = 256, M_COFF = 384, M_PRE = 512, M_RTOK = 2048, M_RW = 3072, M_RSLOT = 4096;

struct Params {
    const float* in[N_INPUTS];
    float* out;
    unsigned char* ws;
    float inv_freq[8];
    int lo, hi;
};

#ifndef EMU
#define LAS __attribute__((address_space(3)))
#define DYN_LDS(name) extern __shared__ __attribute__((aligned(16))) unsigned char name[]
#define SLEEP1() __builtin_amdgcn_s_sleep(1)
#define WAVE_SYNC() __builtin_amdgcn_wave_barrier()
#define OPAQUE(x) asm volatile("" : "+v"(x))
#define COMPILER_FENCE() asm volatile("" ::: "memory")
#define RFL(x) __builtin_amdgcn_readfirstlane(x)
#define ANY_LANE(p) (__builtin_amdgcn_ballot_w64(p) != 0ull)
#define RDLANE(v, l) __builtin_bit_cast(float, __builtin_amdgcn_readlane(__builtin_bit_cast(int, v), l))
__device__ __forceinline__ int lane_id_volatile() { int l; asm volatile("v_mbcnt_lo_u32_b32 %0, -1, 0\n\tv_mbcnt_hi_u32_b32 %0, -1, %0" : "=v"(l)); return l; }
#define LANE_ID() lane_id_volatile()
#define OPAQUE_S(x) asm volatile("" : "+s"(x))
#define WAIT_VM0() asm volatile("s_waitcnt vmcnt(0)" ::: "memory")
#define WAIT_ALL0() __builtin_amdgcn_s_waitcnt(0)
#define FENCE_REL_AGENT() __builtin_amdgcn_fence(__ATOMIC_RELEASE, "agent")
#define FENCE_ACQ_AGENT() __builtin_amdgcn_fence(__ATOMIC_ACQUIRE, "agent")
#define MFMA16(a, b, c) __builtin_amdgcn_mfma_f32_16x16x32_bf16(a, b, c, 0, 0, 0)
#define GLDS16(g, l) __builtin_amdgcn_global_load_lds((const unsigned*)(g), (unsigned*)(l), 16, 0, 0)
#define WAIT_V(n) asm volatile("s_waitcnt vmcnt(" #n ")" ::: "memory")
#define WAIT_L(n) asm volatile("s_waitcnt lgkmcnt(" #n ")" ::: "memory")
#define BAR() __builtin_amdgcn_s_barrier()
#define SCHED() __builtin_amdgcn_sched_barrier(0)
#define SETPRIO(n) __builtin_amdgcn_s_setprio(n)
#define FAST_EXP2(x) __builtin_amdgcn_exp2f(x)
template <int M> __device__ __forceinline__ float shx_impl(float v, int lane) {
    if (M < 32) return __builtin_bit_cast(float, __builtin_amdgcn_ds_swizzle(__builtin_bit_cast(int, v), (M << 10) | 0x1f));
    return __builtin_bit_cast(float, __builtin_amdgcn_ds_bpermute((lane ^ 32) << 2, __builtin_bit_cast(int, v)));
}
#define SHX(v, M) shx_impl<M>(v, lane)
#define FAST_LOG2(x) __builtin_amdgcn_logf(x)
#define FAST_RCP(x) __builtin_amdgcn_rcpf(x)
__device__ __forceinline__ unsigned xb_ld(unsigned* p)              { return __hip_atomic_load(p, __ATOMIC_RELAXED, __HIP_MEMORY_SCOPE_AGENT); }
__device__ __forceinline__ unsigned xb_add(unsigned* p, unsigned v) { return __hip_atomic_fetch_add(p, v, __ATOMIC_RELAXED, __HIP_MEMORY_SCOPE_AGENT); }
__device__ __forceinline__ unsigned xb_xcc_id() { return (unsigned)__builtin_amdgcn_s_getreg((3 << 11) | 20) & 0xFu; }
__device__ __forceinline__ int atomic_add_int(int* p, int v) { return atomicAdd(p, v); }
__device__ __forceinline__ void atomic_min_int(int* p, int v) { atomicMin(p, v); }
__device__ __forceinline__ unsigned pack2(float lo, float hi) { unsigned r; asm volatile("v_cvt_pk_bf16_f32 %0, %1, %2" : "=v"(r) : "v"(lo), "v"(hi)); return r; }
#else
#define MFMA16(a, b, c) emu_mfma_16x16x32_bf16(a, b, c)
#define GLDS16(g, l) emu_glds16((const void*)(g), (void*)(l))
#define WAIT_V(n) ((void)0)
#define WAIT_L(n) ((void)0)
#define BAR() __syncthreads()
#define SCHED() ((void)0)
#define SETPRIO(n) ((void)0)
#define FAST_EXP2(x) exp2f(x)
#define SHX(v, M) __shfl_xor(v, M)
#define FAST_LOG2(x) log2f(x)
#define FAST_RCP(x) (1.f / (x))
static inline unsigned pack2(float lo, float hi) {
    unsigned a = __builtin_bit_cast(unsigned, lo), b = __builtin_bit_cast(unsigned, hi);
    a += 0x7fffu + ((a >> 16) & 1u); b += 0x7fffu + ((b >> 16) & 1u);
    return (a >> 16) | (b & 0xffff0000u);
}
#endif
__device__ __forceinline__ bf16_t f2bf(float f) { return (bf16_t)(pack2(f, 0.f) & 0xffffu); }
__device__ __forceinline__ float bf2f(bf16_t h) { return __builtin_bit_cast(float, (unsigned)h << 16); }

#define XB_TMO      128
#define XB_XCNT(j)  (256  + 64 * (j))
#define XB_XSUB(j)  (1280 + 64 * (j))
#define XB_XGEN(j)  (2304 + 64 * (j))
#define XB_TOP      3328
#define XB_TOPGEN   3392
#define XCD_BAR_WORDS 3456
#define XB_SPIN_CAP (1u << 22)
#define XB_SPIN(cond, bar) do { unsigned _sp = 0; while (cond) { SLEEP1(); \
    if ((++_sp & 255u) == 0u) { if (xb_ld(&(bar)[XB_TMO])) break; if (_sp > XB_SPIN_CAP) { xb_add(&(bar)[XB_TMO], 1u); break; } } } } while (0)

struct XcdBarrier { unsigned* bar; unsigned x; volatile LAS unsigned* st; };

__device__ __forceinline__ XcdBarrier xcd_barrier_post(unsigned* bar, volatile LAS unsigned* st) {
    XcdBarrier b; b.bar = bar; b.x = xb_xcc_id(); b.st = st;
    if (threadIdx.x == 0) (void)xb_add(&bar[XB_XCNT(b.x)], 1u);
    return b;
}
__device__ __forceinline__ void xcd_barrier_complete(unsigned* bar, unsigned x, unsigned& nloc, unsigned& nx) {
    const unsigned G = gridDim.x;
    unsigned sum, cnt, mine, sp = 0u;
    for (;;) {
        sum = 0u; cnt = 0u; mine = 0u;
#pragma unroll
        for (unsigned j = 0; j < 16; ++j) { const unsigned c = xb_ld(&bar[XB_XCNT(j)]); sum += c; cnt += (c > 0u) ? 1u : 0u; mine = (j == x) ? c : mine; }
        if (sum == G) break;
        SLEEP1();
        if ((++sp & 255u) == 0u) { if (xb_ld(&bar[XB_TMO])) break; if (sp > XB_SPIN_CAP) { xb_add(&bar[XB_TMO], 1u); break; } }
    }
    nloc = mine > 0u ? mine : 1u; nx = cnt > 0u ? cnt : 1u;
}
__device__ __forceinline__ void xcd_barrier(const XcdBarrier& b, bool leader) {
    WAIT_VM0();
    __syncthreads();
    if (leader) {
        unsigned* bar = b.bar;
        WAIT_ALL0();
        unsigned nloc = b.st[0], nx = b.st[1];
        if (nloc == 0u) { xcd_barrier_complete(bar, b.x, nloc, nx); b.st[0] = nloc; b.st[1] = nx; }
        const unsigned old = xb_add(&bar[XB_XSUB(b.x)], 1u);
        const unsigned gen = old / nloc;
        if (old + 1u == (gen + 1u) * nloc) {
            FENCE_REL_AGENT();
            WAIT_VM0();
            const unsigned og = xb_add(&bar[XB_TOP], 1u);
            const unsigned tg = og / nx;
            if (og + 1u == (tg + 1u) * nx) xb_add(&bar[XB_TOPGEN], 1u);
            else XB_SPIN(xb_ld(&bar[XB_TOPGEN]) == tg, bar);
            FENCE_ACQ_AGENT();
            xb_add(&bar[XB_XGEN(b.x)], 1u);
            WAIT_VM0();
        } else {
            XB_SPIN(xb_ld(&bar[XB_XGEN(b.x)]) == gen, bar);
            FENCE_ACQ_AGENT();
            WAIT_VM0();
        }
    }
    __syncthreads();
}

__device__ __forceinline__ float wave_sum_l(float v, int lane) {
    v += SHX(v, 1); v += SHX(v, 2); v += SHX(v, 4); v += SHX(v, 8); v += SHX(v, 16); v += SHX(v, 32);
    return v;
}
#define wave_sum(v) wave_sum_l(v, lane)
__device__ __forceinline__ float fexp(float x) { return FAST_EXP2(x * LOG2E); }
__device__ __forceinline__ float sigmoid_f(float x) { return FAST_RCP(1.f + fexp(-x)); }
__device__ __forceinline__ float log_sigmoid_f(float x) { return fminf(x, 0.f) - 0.6931471805599453f * FAST_LOG2(1.f + fexp(-fabsf(x))); }
__device__ __forceinline__ float gelu_tanh_f(float x) { const float u = 0.7978845608028654f * (x + 0.044715f * x * x * x); return x * FAST_RCP(1.f + fexp(-2.f * u)); }
__device__ __forceinline__ float silu_f(float x) { return x * FAST_RCP(1.f + fexp(-x)); }
__device__ __forceinline__ float neg_expm1_f(float x) {
    const float ser = -x * (1.f + x * (0.5f + x * (0.16666667f + x * (0.041666668f + x * (0.008333334f + x * 0.0013888889f)))));
    return (x > -0.35f) ? ser : (1.f - fexp(x));
}

struct RmIdent { __device__ __forceinline__ int operator()(int n) const { return n; } };
struct RmWin { __device__ __forceinline__ int operator()(int n) const { return n < C_FA ? n : (n < C_FA + 6 ? -1 : n - 6); } };
struct RmGu { int kind; __device__ __forceinline__ int operator()(int f) const { return (f >> 7) * 256 + ((f >> 6) & 1) * 128 + ((f >> 4) & 3) * 32 + kind * 16 + (f & 15); } };
struct RmOff { int off; __device__ __forceinline__ int operator()(int n) const { return n + off; } };

template <class RM>
__device__ __forceinline__ void convert_tile(const float* src, int ld, int K, int Nsrc, int k0, int n0, bf16_t* dst, const RM& rm, float* T, int tid) {
    {
        const int nn = tid & 255, kh = (tid >> 8) * 32, n = n0 + nn;
        const float* sp = src + (size_t)(k0 + kh) * ld + n;
        float v[32];
#pragma unroll
        for (int i = 0; i < 32; ++i) v[i] = (n < Nsrc) ? sp[(size_t)i * ld] : 0.f;
#pragma unroll
        for (int i = 0; i < 32; ++i) T[(kh + i) * 257 + nn] = v[i];
    }
    __syncthreads();
#pragma unroll
    for (int q = 0; q < 4; ++q) {
        const int nn = q * 64 + (tid >> 3), kc = (tid & 7) * 8, n = n0 + nn;
        const int row = (n < Nsrc) ? rm(n) : -1;
        if (row >= 0) {
            u32x4 o;
            o.x = pack2(T[(kc + 0) * 257 + nn], T[(kc + 1) * 257 + nn]); o.y = pack2(T[(kc + 2) * 257 + nn], T[(kc + 3) * 257 + nn]);
            o.z = pack2(T[(kc + 4) * 257 + nn], T[(kc + 5) * 257 + nn]); o.w = pack2(T[(kc + 6) * 257 + nn], T[(kc + 7) * 257 + nn]);
            *(u32x4*)(dst + (size_t)row * K + k0 + kc) = o;
        }
    }
    __syncthreads();
}
template <class RM>
__device__ __forceinline__ void convert_mats(const float* src, size_t sstride, int nmat, int ld, int K, int Nsrc, bf16_t* dst, size_t dstride, const RM& rm,
                                             float* T, int tid, int bid, int G) {
    const int tk = K / 64, tn = (Nsrc + 255) / 256, per = tk * tn, total = nmat * per;
    for (int t = bid; t < total; t += G) {
        const int mi = t / per, r = t % per;
        convert_tile(src + (size_t)mi * sstride, ld, K, Nsrc, (r / tn) * 64, (r % tn) * 256, dst + (size_t)mi * dstride, rm, T, tid);
    }
}

constexpr int NCONV = DEPTH * 768;
__device__ __forceinline__ void moe_conv_chunk(const Params& p, int cid, bf16_t* WguT_, bf16_t* WdT_, float* T, int tid) {
    const int l = cid / 768, r = cid % 768, kind = r >> 8, t0 = (r & 255) * 8;
    for (int t = t0; t < t0 + 8; ++t) {
        const int mi = t >> 6, rr = t & 63;
        if (kind < 2) {
            const float* src = p.in[kind == 0 ? I_WGATE : I_WUP] + ((size_t)l * NEXP + mi) * D * DFF;
            convert_tile(src, DFF, D, DFF, (rr >> 1) * 64, (rr & 1) * 256, WguT_ + ((size_t)l * NEXP + mi) * 1024 * D, RmGu{kind}, T, tid);
        } else {
            const float* src = p.in[I_WDOWN] + ((size_t)l * NEXP + mi) * DFF * D;
            convert_tile(src, D, DFF, D, (rr >> 3) * 64, (rr & 7) * 256, WdT_ + ((size_t)l * NEXP + mi) * D * DFF, RmIdent{}, T, tid);
        }
    }
}

constexpr int BK = 64, HTB = 128 * 64 * 2;
__device__ __forceinline__ int lds_byte(int r, int c) {
    const int st = (r >> 4) * 2 + (c >> 5), rr = r & 15, cc = c & 31, ob = rr * 64 + cc * 2;
    return st * 1024 + (ob ^ (((ob >> 9) & 1) << 5));
}
__device__ __forceinline__ void stage_rc(int b, int& R, int& C) {
    const int st = b / 1024, sb = b % 1024, swz = sb ^ (((sb >> 9) & 1) << 5);
    R = (st >> 1) * 16 + swz / 64; C = (st & 1) * 32 + (swz % 64) / 2;
}
template <bool GATHER>
__device__ __forceinline__ void gemm_tile(const bf16_t* A, int arow0, const unsigned (&aoff)[2][2], const bf16_t* Bt, int brow0, int K,
                                          unsigned char* shm, f32x4 (&acc)[2][2][4][2], int tid_in) {
    int tid = tid_in; OPAQUE(tid);
    unsigned toff; { int R0, C0; stage_rc(tid * 16, R0, C0); toff = (unsigned)(R0 * K + C0); }
#define SA(b, h) (shm + ((b) * 2 + (h)) * HTB)
#define SB(b, h) (shm + (4 + (b) * 2 + (h)) * HTB)
#define STAGE_B(P, h, kt) do { _Pragma("unroll") for (int _i = 0; _i < 2; ++_i) GLDS16(Bt + ((size_t)(brow0 + (h) * 128 + _i * 64) * K + (size_t)(kt) * BK) + toff, (P) + tid * 16 + _i * 8192); } while (0)
#define STAGE_A(P, h, kt) do { _Pragma("unroll") for (int _i = 0; _i < 2; ++_i) { \
    if (GATHER) GLDS16(A + (size_t)(kt) * BK + aoff[h][_i], (P) + tid * 16 + _i * 8192); \
    else GLDS16(A + ((size_t)(arow0 + (h) * 128 + _i * 64) * K + (size_t)(kt) * BK) + toff, (P) + tid * 16 + _i * 8192); } } while (0)
#define LDA(dst, b, h) _Pragma("unroll") for (int m = 0; m < 4; ++m) _Pragma("unroll") for (int k = 0; k < 2; ++k) \
    dst[m][k] = *reinterpret_cast<const bf16x8*>(SA(b, h) + lds_byte(wr * 64 + m * 16 + fr, k * 32 + fq * 8))
#define LDB(dst, b, h) _Pragma("unroll") for (int n = 0; n < 2; ++n) _Pragma("unroll") for (int k = 0; k < 2; ++k) \
    dst[n][k] = *reinterpret_cast<const bf16x8*>(SB(b, h) + lds_byte(wc * 32 + n * 16 + fr, k * 32 + fq * 8))
#define MMA(ai, bj, At, Bx) do { SETPRIO(1); \
    _Pragma("unroll") for (int m = 0; m < 4; ++m) _Pragma("unroll") for (int n = 0; n < 2; ++n) _Pragma("unroll") for (int k = 0; k < 2; ++k) \
      acc[ai][bj][m][n] = MFMA16(At[m][k], Bx[n][k], acc[ai][bj][m][n]); \
    SETPRIO(0); } while (0)
    int wid = tid >> 6, lane = tid & 63, wr = wid >> 2, wc = wid & 3, fr = lane & 15, fq = lane >> 4;
#pragma unroll
    for (int a = 0; a < 2; ++a)
#pragma unroll
        for (int b = 0; b < 2; ++b)
#pragma unroll
            for (int m = 0; m < 4; ++m)
#pragma unroll
                for (int n = 0; n < 2; ++n) acc[a][b][m][n] = (f32x4){0.f, 0.f, 0.f, 0.f};
    bf16x8 At[4][2], B0[2][2], B1[2][2];
    const int nt = K / BK;
    STAGE_B(SB(0, 0), 0, 0); STAGE_A(SA(0, 0), 0, 0);
    STAGE_B(SB(0, 1), 1, 0); STAGE_A(SA(0, 1), 1, 0);
    if (wr == 1) BAR();
    WAIT_V(4); BAR();
    STAGE_B(SB(1, 0), 0, 1); STAGE_A(SA(1, 0), 0, 1); STAGE_B(SB(1, 1), 1, 1);
    WAIT_V(6); BAR();
    for (int t = 0; t < nt - 2; t += 2) {
        LDB(B0, 0, 0); SCHED(); LDA(At, 0, 0); STAGE_A(SA(1, 1), 1, t + 1);
        WAIT_L(8); BAR(); WAIT_L(0); MMA(0, 0, At, B0); BAR(); SCHED();
        LDB(B1, 0, 1); STAGE_B(SB(0, 0), 0, t + 2);
        BAR(); WAIT_L(0); MMA(0, 1, At, B1); BAR();
        LDA(At, 0, 1); STAGE_A(SA(0, 0), 0, t + 2);
        BAR(); WAIT_L(0); MMA(1, 0, At, B0); BAR(); SCHED();
        STAGE_B(SB(0, 1), 1, t + 2);
        WAIT_V(6); BAR(); MMA(1, 1, At, B1); BAR();
        LDB(B0, 1, 0); SCHED(); LDA(At, 1, 0); STAGE_A(SA(0, 1), 1, t + 2);
        WAIT_L(8); BAR(); WAIT_L(0); MMA(0, 0, At, B0); BAR(); SCHED();
        LDB(B1, 1, 1); STAGE_B(SB(1, 0), 0, t + 3);
        BAR(); WAIT_L(0); MMA(0, 1, At, B1); BAR();
        LDA(At, 1, 1); STAGE_A(SA(1, 0), 0, t + 3);
        BAR(); WAIT_L(0); MMA(1, 0, At, B0); BAR(); SCHED();
        STAGE_B(SB(1, 1), 1, t + 3);
        WAIT_V(6); BAR(); MMA(1, 1, At, B1); BAR();
    }
    OPAQUE(tid); wid = tid >> 6; lane = tid & 63; wr = wid >> 2; wc = wid & 3; fr = lane & 15; fq = lane >> 4;
    { LDB(B0, 0, 0); WAIT_V(0); LDA(At, 0, 0); STAGE_A(SA(1, 1), 1, nt - 1);
      BAR(); WAIT_L(0); MMA(0, 0, At, B0); BAR();
      LDB(B1, 0, 1); BAR(); WAIT_L(0); MMA(0, 1, At, B1); BAR();
      LDA(At, 0, 1); WAIT_V(4); BAR(); WAIT_L(0); MMA(1, 0, At, B0); MMA(1, 1, At, B1); BAR(); }
    { LDB(B0, 1, 0); LDA(At, 1, 0); WAIT_V(2); BAR(); WAIT_L(0); MMA(0, 0, At, B0); BAR();
      LDB(B1, 1, 1); WAIT_V(0); BAR(); WAIT_L(0); MMA(0, 1, At, B1); BAR();
      LDA(At, 1, 1); BAR(); WAIT_L(0); MMA(1, 0, At, B0); MMA(1, 1, At, B1); BAR(); }
    if (wr == 0) BAR();
#undef SA
#undef SB
#undef STAGE_A
#undef STAGE_B
#undef LDA
#undef LDB
#undef MMA
}
__device__ __forceinline__ void stage_geom(int tid, int (&R)[2], int (&C)[2]) {
#pragma unroll
    for (int i = 0; i < 2; ++i) stage_rc(tid * 16 + i * 8192, R[i], C[i]);
}

constexpr int ATT_KBUF = 0, ATT_VBUF = 32768, ATT_CBUF = 65536;
template <int KIND>
__device__ __forceinline__ void attn_unit(const bf16_t* Q, const bf16_t* Kg, const bf16_t* VT, const float* cum2, const float* kmx, int qb, bf16_t* concat, int ccol0,
                                          float lam, float osc, const float* subg, unsigned char* lds, int tid) {
    const int lane = tid & 63, wave = tid >> 6, r16 = lane & 15, q4 = lane >> 4;
    const int q0w = qb * 128 + wave * 16, myq = q0w + r16;
    const int ntiles = 2 * qb + 2;
    const int wlimit = (KIND == 0) ? ((q0w + 15) >> 6) : (q0w >> 6);
    constexpr int NMAP = (KIND == 0) ? 1 : 2, NKS = (KIND == 0) ? 4 : 2;
    bf16x8 qf[NMAP][NKS];
#pragma unroll
    for (int mp = 0; mp < NMAP; ++mp)
#pragma unroll
        for (int ks = 0; ks < NKS; ++ks) qf[mp][ks] = *(const bf16x8*)(Q + (size_t)myq * 128 + mp * 64 + ks * 32 + q4 * 8);
    const float cq = (KIND == 0) ? cum2[myq] : 0.f;
    int kt0 = 0;
    if (KIND == 0) {
        float* wmax = (float*)(lds + ATT_CBUF + 512); int* kst = (int*)(lds + ATT_CBUF + 576);
        float qs = 0.f;
#pragma unroll
        for (int ks = 0; ks < NKS; ++ks)
#pragma unroll
            for (int j = 0; j < 8; ++j) { const float v = bf2f((bf16_t)qf[0][ks][j]); qs += v * v; }
        qs += SHX(qs, 16); qs += SHX(qs, 32);
        qs = fmaxf(qs, SHX(qs, 1)); qs = fmaxf(qs, SHX(qs, 2)); qs = fmaxf(qs, SHX(qs, 4)); qs = fmaxf(qs, SHX(qs, 8));
        if (lane == 0) wmax[wave] = qs;
        if (tid == 0) *kst = 2 * qb;
        __syncthreads();
        float qm = wmax[0];
#pragma unroll
        for (int w = 1; w < 8; ++w) qm = fmaxf(qm, wmax[w]);
        qm = sqrtf(qm) * 1.01f;
        const float kd = sqrtf(fmaxf(kmx[2 * qb], kmx[2 * qb + 1])) * 1.01f;
        if (tid < 2 * qb) {
            const float bias = cum2[qb * 128] - cum2[tid * 64 + 63];
            const bool skip = bias + qm * (sqrtf(kmx[tid]) * 1.01f + kd) < -40.f;
            if (!skip) atomic_min_int(kst, tid);
        }
        __syncthreads();
        kt0 = RFL(*kst);
    }
    f32x4 ot[NMAP][8];
    float mrun[NMAP], lsum[NMAP];
#pragma unroll
    for (int mp = 0; mp < NMAP; ++mp) { mrun[mp] = -INFINITY; lsum[mp] = 0.f;
#pragma unroll
        for (int mo = 0; mo < 8; ++mo) ot[mp][mo] = (f32x4){0.f, 0.f, 0.f, 0.f}; }
    u32x4 sk[2], sv[2]; float sc = 0.f;
    const u32x4* kg = (const u32x4*)Kg; const u32x4* vg = (const u32x4*)VT;
#pragma unroll
    for (int i = 0; i < 2; ++i) { sk[i] = kg[(size_t)kt0 * 1024 + tid + i * 512]; sv[i] = vg[(size_t)kt0 * 1024 + tid + i * 512]; }
    if (KIND == 0 && tid < 64) sc = cum2[kt0 * 64 + tid];
    for (int kt = kt0; kt < ntiles; ++kt) {
        unsigned char* kb = lds + ATT_KBUF + (kt & 1) * 16384;
        unsigned char* vb = lds + ATT_VBUF + (kt & 1) * 16384;
        float* cb = (float*)(lds + ATT_CBUF + (kt & 1) * 256);
#pragma unroll
        for (int i = 0; i < 2; ++i) {
            const int g = tid + i * 512;
            { const int row = g >> 4, c = g & 15; *(u32x4*)(kb + row * 256 + ((c ^ (row & 15)) << 4)) = sk[i]; }
            { const int d = g >> 3, c = g & 7; *(u32x4*)(vb + d * 128 + ((c ^ ((d >> 1) & 7)) << 4)) = sv[i]; }
        }
        if (KIND == 0 && tid < 64) cb[tid] = sc;
        __syncthreads();
        if (kt + 1 < ntiles) {
#pragma unroll
            for (int i = 0; i < 2; ++i) { sk[i] = kg[(size_t)(kt + 1) * 1024 + tid + i * 512]; sv[i] = vg[(size_t)(kt + 1) * 1024 + tid + i * 512]; }
            if (KIND == 0 && tid < 64) sc = cum2[(kt + 1) * 64 + tid];
        }
        if (kt <= wlimit) {
#pragma unroll
            for (int mp = 0; mp < NMAP; ++mp) {
                bf16x8 kf[4][NKS], vfa[8];
#pragma unroll
                for (int m = 0; m < 4; ++m)
#pragma unroll
                    for (int ks = 0; ks < NKS; ++ks) { const int c = (KIND == 0 ? 0 : mp * 8) + ks * 4 + q4; kf[m][ks] = *(const bf16x8*)(kb + (m * 16 + r16) * 256 + ((c ^ r16) << 4)); }
#pragma unroll
                for (int mo = 0; mo < 8; ++mo) { const int d = mo * 16 + r16; vfa[mo] = *(const bf16x8*)(vb + d * 128 + (((0 * 4 + q4) ^ ((d >> 1) & 7)) << 4)); }
                SCHED();
                f32x4 st[4];
#pragma unroll
                for (int m = 0; m < 4; ++m) st[m] = (f32x4){0.f, 0.f, 0.f, 0.f};
#pragma unroll
                for (int ks = 0; ks < NKS; ++ks)
#pragma unroll
                    for (int m = 0; m < 4; ++m) st[m] = MFMA16(kf[m][ks], qf[mp][ks], st[m]);
                SCHED();
                float mx = -INFINITY;
#pragma unroll
                for (int m = 0; m < 4; ++m) {
                    if (KIND == 0) {
                        const f32x4 ck = *(const f32x4*)(cb + m * 16 + 4 * q4);
#pragma unroll
                        for (int j = 0; j < 4; ++j) {
                            float y = st[m][j] + (cq - ck[j]);
                            if (kt * 64 + m * 16 + 4 * q4 + j > myq) y = -INFINITY;
                            st[m][j] = y;
                        }
                    }
#pragma unroll
                    for (int j = 0; j < 4; ++j) mx = fmaxf(mx, st[m][j]);
                }
                mx = fmaxf(mx, SHX(mx, 16));
                mx = fmaxf(mx, SHX(mx, 32));
                const float mnew = fmaxf(mrun[mp], mx);
                const float alpha = FAST_EXP2(mrun[mp] - mnew);
                mrun[mp] = mnew;
                float ps = 0.f;
#pragma unroll
                for (int m = 0; m < 4; ++m)
#pragma unroll
                    for (int j = 0; j < 4; ++j) { const float pv = FAST_EXP2(st[m][j] - mnew); st[m][j] = pv; ps += pv; }
                lsum[mp] = lsum[mp] * alpha + ps;
#pragma unroll
                for (int mo = 0; mo < 8; ++mo) ot[mp][mo] *= alpha;
                bf16x8 pf[2];
#pragma unroll
                for (int kk = 0; kk < 2; ++kk) {
                    u32x4 pw;
                    pw.x = pack2(st[2 * kk][0], st[2 * kk][1]); pw.y = pack2(st[2 * kk][2], st[2 * kk][3]);
                    pw.z = pack2(st[2 * kk + 1][0], st[2 * kk + 1][1]); pw.w = pack2(st[2 * kk + 1][2], st[2 * kk + 1][3]);
                    pf[kk] = __builtin_bit_cast(bf16x8, pw);
                }
                bf16x8 vfb[8];
#pragma unroll
                for (int mo = 0; mo < 8; ++mo) { const int d = mo * 16 + r16; vfb[mo] = *(const bf16x8*)(vb + d * 128 + (((1 * 4 + q4) ^ ((d >> 1) & 7)) << 4)); }
                SCHED();
#pragma unroll
                for (int mo = 0; mo < 8; ++mo) ot[mp][mo] = MFMA16(vfa[mo], pf[0], ot[mp][mo]);
                SCHED();
#pragma unroll
                for (int mo = 0; mo < 8; ++mo) ot[mp][mo] = MFMA16(vfb[mo], pf[1], ot[mp][mo]);
            }
        }
    }
    float inv[NMAP];
#pragma unroll
    for (int mp = 0; mp < NMAP; ++mp) { float l = lsum[mp]; l += SHX(l, 16); l += SHX(l, 32); inv[mp] = 1.f / l; }
    if (KIND == 0) {
#pragma unroll
        for (int mo = 0; mo < 8; ++mo) {
            u32x2 o; o.x = pack2(ot[0][mo][0] * inv[0], ot[0][mo][1] * inv[0]); o.y = pack2(ot[0][mo][2] * inv[0], ot[0][mo][3] * inv[0]);
            *(u32x2*)(concat + (size_t)myq * D + ccol0 + mo * 16 + 4 * q4) = o;
        }
    } else {
        float ss = 0.f;
#pragma unroll
        for (int mo = 0; mo < 8; ++mo)
#pragma unroll
            for (int j = 0; j < 4; ++j) { const float v = ot[0][mo][j] * inv[0] - lam * (ot[NMAP - 1][mo][j] * inv[NMAP - 1]); ot[0][mo][j] = v; ss += v * v; }
        ss += SHX(ss, 16); ss += SHX(ss, 32);
        const float rs = osc / sqrtf(ss * (1.f / 128.f) + LN_EPS);
#pragma unroll
        for (int mo = 0; mo < 8; ++mo) {
            const f32x4 g = *(const f32x4*)(subg + mo * 16 + 4 * q4);
            u32x2 o; o.x = pack2(ot[0][mo][0] * rs * g[0], ot[0][mo][1] * rs * g[1]); o.y = pack2(ot[0][mo][2] * rs * g[2], ot[0][mo][3] * rs * g[3]);
            *(u32x2*)(concat + (size_t)myq * D + ccol0 + mo * 16 + 4 * q4) = o;
        }
    }
    __syncthreads();
}

__device__ __forceinline__ int dpart_row(int c, int q) { return c * (S - DCH * 64) - (DCH * 32) * c * (c - 1) + q; }
__device__ __forceinline__ void attn_dmap_unit(const bf16_t* Qh, const bf16_t* Kh, const bf16_t* VTh, int mp, int qb, int t0, int t1,
                                               bf16_t* Op, float* ML, int c, unsigned char* lds, int tid) {
    const int lane = tid & 63, wave = tid >> 6, r16 = lane & 15, q4 = lane >> 4;
    const int q0w = qb * 256 + wave * 32;
    const int wlimit = q0w >> 6;
    bf16x8 qf[2][2];
#pragma unroll
    for (int n = 0; n < 2; ++n)
#pragma unroll
        for (int ks = 0; ks < 2; ++ks) qf[n][ks] = *(const bf16x8*)(Qh + (size_t)(q0w + n * 16 + r16) * 128 + mp * 64 + ks * 32 + q4 * 8);
    f32x4 ot[8][2];
    float mrun[2] = {-INFINITY, -INFINITY}, lsum[2] = {0.f, 0.f};
#pragma unroll
    for (int mo = 0; mo < 8; ++mo) { ot[mo][0] = (f32x4){0.f, 0.f, 0.f, 0.f}; ot[mo][1] = (f32x4){0.f, 0.f, 0.f, 0.f}; }
    u32x4 sk, sv[2];
    const u32x4* kg = (const u32x4*)Kh; const u32x4* vg = (const u32x4*)VTh;
    const int krow = tid >> 3, kc8 = tid & 7;
    sk = kg[(size_t)t0 * 1024 + krow * 16 + mp * 8 + kc8];
#pragma unroll
    for (int i = 0; i < 2; ++i) sv[i] = vg[(size_t)t0 * 1024 + tid + i * 512];
    for (int kt = t0; kt < t1; ++kt) {
        unsigned char* kb = lds + (kt & 1) * 8192;
        unsigned char* vb = lds + 16384 + (kt & 1) * 16384;
        *(u32x4*)(kb + krow * 128 + ((kc8 ^ ((krow >> 1) & 7)) << 4)) = sk;
#pragma unroll
        for (int i = 0; i < 2; ++i) { const int g = tid + i * 512, d = g >> 3, cc = g & 7; *(u32x4*)(vb + d * 128 + ((cc ^ ((d >> 1) & 7)) << 4)) = sv[i]; }
        __syncthreads();
        if (kt + 1 < t1) {
            sk = kg[(size_t)(kt + 1) * 1024 + krow * 16 + mp * 8 + kc8];
#pragma unroll
            for (int i = 0; i < 2; ++i) sv[i] = vg[(size_t)(kt + 1) * 1024 + tid + i * 512];
        }
        if (kt <= wlimit) {
            bf16x8 kf[4][2], vfa[8];
#pragma unroll
            for (int m = 0; m < 4; ++m)
#pragma unroll
                for (int ks = 0; ks < 2; ++ks) kf[m][ks] = *(const bf16x8*)(kb + (m * 16 + r16) * 128 + (((ks * 4 + q4) ^ ((r16 >> 1) & 7)) << 4));
#pragma unroll
            for (int mo = 0; mo < 8; ++mo) { const int d = mo * 16 + r16; vfa[mo] = *(const bf16x8*)(vb + d * 128 + (((0 * 4 + q4) ^ ((d >> 1) & 7)) << 4)); }
            SCHED();
            f32x4 st[4][2];
#pragma unroll
            for (int m = 0; m < 4; ++m) { st[m][0] = (f32x4){0.f, 0.f, 0.f, 0.f}; st[m][1] = (f32x4){0.f, 0.f, 0.f, 0.f}; }
#pragma unroll
            for (int ks = 0; ks < 2; ++ks)
#pragma unroll
                for (int m = 0; m < 4; ++m) { st[m][0] = MFMA16(kf[m][ks], qf[0][ks], st[m][0]); st[m][1] = MFMA16(kf[m][ks], qf[1][ks], st[m][1]); }
            SCHED();
            float alpha[2];
#pragma unroll
            for (int n = 0; n < 2; ++n) {
                float mx = -INFINITY;
#pragma unroll
                for (int m = 0; m < 4; ++m)
#pragma unroll
                    for (int j = 0; j < 4; ++j) mx = fmaxf(mx, st[m][n][j]);
                mx = fmaxf(mx, SHX(mx, 16));
                mx = fmaxf(mx, SHX(mx, 32));
                const float mnew = fmaxf(mrun[n], mx);
                alpha[n] = FAST_EXP2(mrun[n] - mnew);
                mrun[n] = mnew;
                float ps = 0.f;
#pragma unroll
                for (int m = 0; m < 4; ++m)
#pragma unroll
                    for (int j = 0; j < 4; ++j) { const float pv = FAST_EXP2(st[m][n][j] - mnew); st[m][n][j] = pv; ps += pv; }
                lsum[n] = lsum[n] * alpha[n] + ps;
            }
            if (ANY_LANE(alpha[0] != 1.f)) {
#pragma unroll
                for (int mo = 0; mo < 8; ++mo) ot[mo][0] *= alpha[0];
            }
            if (ANY_LANE(alpha[1] != 1.f)) {
#pragma unroll
                for (int mo = 0; mo < 8; ++mo) ot[mo][1] *= alpha[1];
            }
            bf16x8 pf[2][2];
#pragma unroll
            for (int kk = 0; kk < 2; ++kk)
#pragma unroll
                for (int n = 0; n < 2; ++n) {
                    u32x4 pw;
                    pw.x = pack2(st[2 * kk][n][0], st[2 * kk][n][1]); pw.y = pack2(st[2 * kk][n][2], st[2 * kk][n][3]);
                    pw.z = pack2(st[2 * kk + 1][n][0], st[2 * kk + 1][n][1]); pw.w = pack2(st[2 * kk + 1][n][2], st[2 * kk + 1][n][3]);
                    pf[kk][n] = __builtin_bit_cast(bf16x8, pw);
                }
            bf16x8 vfb[8];
#pragma unroll
            for (int mo = 0; mo < 8; ++mo) { const int d = mo * 16 + r16; vfb[mo] = *(const bf16x8*)(vb + d * 128 + (((1 * 4 + q4) ^ ((d >> 1) & 7)) << 4)); }
            SCHED();
#pragma unroll
            for (int mo = 0; mo < 8; ++mo) { ot[mo][0] = MFMA16(vfa[mo], pf[0][0], ot[mo][0]); ot[mo][1] = MFMA16(vfa[mo], pf[0][1], ot[mo][1]); }
            SCHED();
#pragma unroll
            for (int mo = 0; mo < 8; ++mo) { ot[mo][0] = MFMA16(vfb[mo], pf[1][0], ot[mo][0]); ot[mo][1] = MFMA16(vfb[mo], pf[1][1], ot[mo][1]); }
        }
    }
    if (q0w >= DCH * 64 * c)
#pragma unroll
    for (int n = 0; n < 2; ++n) {
        float l = lsum[n]; l += SHX(l, 16); l += SHX(l, 32);
        const int row = dpart_row(c, q0w + n * 16 + r16);
#pragma unroll
        for (int mo = 0; mo < 8; ++mo) {
            u32x2 o; o.x = pack2(ot[mo][n][0], ot[mo][n][1]); o.y = pack2(ot[mo][n][2], ot[mo][n][3]);
            *(u32x2*)(Op + (size_t)(row * 128 + mo * 16 + 4 * q4)) = o;
        }
        if (q4 == 0) { ML[row * 2] = mrun[n]; ML[row * 2 + 1] = l; }
    }
    __syncthreads();
}

__device__ __forceinline__ void lru_unit_a(int chunk, int grp, int l, const Params& p, const bf16_t* Xr, const bf16_t* WaiT, float* hloc, float* ploc, float* sumA, float* sumH,
                                           unsigned char* lds, int tid) {
    const int lane = tid & 63, wave = tid >> 6, r16 = lane & 15, q4 = lane >> 4;
    unsigned char* XCB = lds; float* XU = (float*)(lds + 16384); float* LA = (float*)(lds + 49152); float* ENDS = (float*)(lds + 81920);
    const int t0 = chunk * 64, ch0 = grp * 128;
    {
        const int c = tid & 127, tq = tid >> 7, ch = ch0 + c;
        const float* cw = p.in[I_CONVW] + (size_t)l * 4 * LRU_W + ch; const float cb = p.in[I_CONVB][(size_t)l * LRU_W + ch];
        const float w0 = cw[0], w1 = cw[LRU_W], w2 = cw[2 * LRU_W], w3 = cw[3 * LRU_W];
        const int ts = t0 + tq * 16;
        float x0 = (ts - 3 >= 0) ? bf2f(Xr[(size_t)(ts - 3) * LRU_W + ch]) : 0.f;
        float x1 = (ts - 2 >= 0) ? bf2f(Xr[(size_t)(ts - 2) * LRU_W + ch]) : 0.f;
        float x2 = (ts - 1 >= 0) ? bf2f(Xr[(size_t)(ts - 1) * LRU_W + ch]) : 0.f;
#pragma unroll
        for (int i = 0; i < 16; ++i) {
            const float x3 = bf2f(Xr[(size_t)(ts + i) * LRU_W + ch]);
            const float v = cb + w0 * x0 + w1 * x1 + w2 * x2 + w3 * x3;
            const int row = tq * 16 + i;
            XU[row * 128 + c] = v;
            *(bf16_t*)(XCB + row * 256 + (((c >> 3) ^ (row & 15)) << 4) + (c & 7) * 2) = f2bf(v);
            x0 = x1; x1 = x2; x2 = x3;
        }
    }
    __syncthreads();
    {
        bf16x8 bfr[2][4];
#pragma unroll
        for (int g = 0; g < 2; ++g)
#pragma unroll
            for (int ks = 0; ks < 4; ++ks) bfr[g][ks] = *(const bf16x8*)(WaiT + ((size_t)grp * 256 + g * 128 + wave * 16 + r16) * 128 + ks * 32 + q4 * 8);
        const int ch = ch0 + wave * 16 + r16;
        const float ba = p.in[I_BA][(size_t)l * LRU_W + ch], bi = p.in[I_BI][(size_t)l * LRU_W + ch];
        const float lsl = 8.0f * log_sigmoid_f(p.in[I_LAM][(size_t)l * LRU_W + ch]);
#pragma unroll
        for (int mt = 0; mt < 4; ++mt) {
            f32x4 ga = (f32x4){0.f, 0.f, 0.f, 0.f}, gi = (f32x4){0.f, 0.f, 0.f, 0.f};
#pragma unroll
            for (int ks = 0; ks < 4; ++ks) {
                const bf16x8 af = *(const bf16x8*)(XCB + (mt * 16 + r16) * 256 + (((ks * 4 + q4) ^ r16) << 4));
                ga = MFMA16(af, bfr[0][ks], ga); gi = MFMA16(af, bfr[1][ks], gi);
            }
#pragma unroll
            for (int j = 0; j < 4; ++j) {
                const int row = mt * 16 + 4 * q4 + j, idx = row * 128 + wave * 16 + r16;
                const float r = sigmoid_f(ga[j] + ba), ig = sigmoid_f(gi[j] + bi);
                const float log_a = lsl * r;
                LA[idx] = fexp(log_a);
                XU[idx] = sqrtf(neg_expm1_f(2.f * log_a)) * (ig * XU[idx]);
            }
        }
    }
    __syncthreads();
    {
        const int c = tid & 127, tq = tid >> 7, ch = ch0 + c;
        float h = 0.f, P = 1.f;
#pragma unroll
        for (int i = 0; i < 16; ++i) { const int idx = (tq * 16 + i) * 128 + c; const float a = LA[idx]; h = a * h + XU[idx]; P *= a; XU[idx] = h; LA[idx] = P; }
        ENDS[tq * 128 + c] = P; ENDS[512 + tq * 128 + c] = h;
        __syncthreads();
        float cin = 0.f, pin = 1.f;
        for (int s = 0; s < tq; ++s) { const float Ps = ENDS[s * 128 + c], hs = ENDS[512 + s * 128 + c]; cin = Ps * cin + hs; pin *= Ps; }
#pragma unroll
        for (int i = 0; i < 16; ++i) {
            const int idx = (tq * 16 + i) * 128 + c; const size_t gi = (size_t)(t0 + tq * 16 + i) * LRU_W + ch;
            const float Pl = LA[idx], hl = XU[idx];
            hloc[gi] = hl + Pl * cin; ploc[gi] = Pl * pin;
        }
        if (tq == 3) { const float Pl = LA[63 * 128 + c], hl = XU[63 * 128 + c]; sumA[(size_t)chunk * LRU_W + ch] = Pl * pin; sumH[(size_t)chunk * LRU_W + ch] = hl + Pl * cin; }
    }
    __syncthreads();
}

__device__ __forceinline__ void moe_prefix(const int* cntb_, int G, unsigned char* lds, int tid) {
    int* tmp = (int*)lds; int* ctot = (int*)(lds + LDS_MISC + M_CTOT); int* coff = (int*)(lds + LDS_MISC + M_COFF);
    unsigned short* pre16 = (unsigned short*)(lds + LDS_MISC + M_PRE16);
    const int e = tid & 31, part = tid >> 5, PB = (G + 15) / 16;
    int sm = 0;
    for (int i = 0; i < PB; ++i) { const int b = part * PB + i; if (b < G) sm += cntb_[b * 32 + e]; }
    tmp[part * 32 + e] = sm;
    __syncthreads();
    int run = 0;
    for (int q = 0; q < part; ++q) run += tmp[q * 32 + e];
    for (int i = 0; i < PB; ++i) { const int b = part * PB + i; if (b < G) { pre16[e * 257 + b] = (unsigned short)run; run += cntb_[b * 32 + e]; } }
    if (part == 15) { ctot[e] = run; pre16[e * 257 + G] = (unsigned short)run; }
    __syncthreads();
    if (tid == 0) { int o = 0; for (int q = 0; q < 32; ++q) { coff[q] = o; o += ctot[q]; } coff[32] = o; }
    __syncthreads();
}
__device__ __forceinline__ void moe_rowtable(const int* ltok_, const float* lw_, const int* lslot_, int e, int m0, int G, int segcap, unsigned char* lds, int tid_in) {
    int tid = tid_in; OPAQUE(tid);
    const unsigned short* pre16 = (const unsigned short*)(lds + LDS_MISC + M_PRE16);
    int* rtok = (int*)(lds + LDS_MISC + M_RTOK); float* rw = (float*)(lds + LDS_MISC + M_RW); int* rslot = (int*)(lds + LDS_MISC + M_RSLOT);
    if (tid < 256) { rtok[tid] = 0; rw[tid] = 0.f; rslot[tid] = 0; }
    __syncthreads();
    if (tid < G) {
        const int base = pre16[e * 257 + tid], v = pre16[e * 257 + tid + 1] - base;
        for (int i = 0; i < v; ++i) {
            const int g = base + i - m0;
            if (g >= 0 && g < 256) { const int idx = (e * G + tid) * segcap + i; rtok[g] = ltok_[idx]; rw[g] = lw_[idx]; rslot[g] = lslot_[idx]; }
        }
    }
    __syncthreads();
}
#define kmax2 ((float*)(wsl + A_KMAX))
#define dpo ((bf16_t*)(wsl + A_DPO))
#define dpml ((float*)(wsl + A_DPML))
#define cntb ((int*)(wsl + A_CNTB))
#define WinT ((bf16_t*)(wsl + WB_WIN))
#define WoT ((bf16_t*)(wsl + WB_WO))
#define WguT ((bf16_t*)(wsl + WB_WGU))
#define WdT ((bf16_t*)(wsl + WB_WD))
#define WaiT ((bf16_t*)(wsl + WB_WAI))
#define Wfa ((float*)(wsl + WF_FA))
#define W36b ((bf16_t*)(wsl + WF_R36))
#define ropecs ((float*)(wsl + WF_ROPE))
#define xb ((bf16_t*)(wsl + A_XB))
#define hb ((float*)(wsl + A_HB))
#define logf_ ((float*)(wsl + A_LOGF))
#define cum2 ((float*)(wsl + A_CUM))
#define Qa ((bf16_t*)(wsl + A_QA))
#define Ka ((bf16_t*)(wsl + A_KA))
#define VaT ((bf16_t*)(wsl + A_VAT))
#define Xr ((bf16_t*)(wsl + A_XR))
#define Gr ((bf16_t*)(wsl + A_GR))
#define Qc ((bf16_t*)(wsl + A_QC))
#define Kc ((bf16_t*)(wsl + A_KC))
#define VcT ((bf16_t*)(wsl + A_VCT))
#define hloc ((float*)(wsl + A_HLOC))
#define ploc ((float*)(wsl + A_PLOC))
#define sumA ((float*)(wsl + A_SUMA))
#define sumH ((float*)(wsl + A_SUMH))
#define concat ((bf16_t*)(wsl + A_CONCAT))
#define y1 ((float*)(wsl + A_Y1))
#define h1 ((float*)(wsl + A_H1))
#define h1b ((bf16_t*)(wsl + A_H1B))
#define ltok ((int*)(wsl + A_LTOK))
#define lw ((float*)(wsl + A_LW))
#define lslot ((int*)(wsl + A_LSLOT))
#define act ((bf16_t*)(wsl + A_ACT))
#define contrib ((bf16_t*)(wsl + A_CONTRIB))
#ifndef EMU
__global__ void __launch_bounds__(NTHREADS, 2)
#else
void
#endif
fwd_kernel(Params p) {
    DYN_LDS(lds_raw);
    float* ldsf = (float*)lds_raw;
    const int bid = blockIdx.x, G = gridDim.x;
    const int gthreads = G * NTHREADS, gwaves = G * (NTHREADS / 64);
    const int wave_s = RFL((int)threadIdx.x >> 6);
#define PHASE_IDS() unsigned char* wsl = ws; OPAQUE_S(wsl); int tid = wave_s * 64 + LANE_ID(); OPAQUE(tid); const int lane = tid & 63, wave = tid >> 6, gtid = bid * NTHREADS + tid, gwave = bid * (NTHREADS / 64) + wave; (void)lane; (void)wave; (void)gtid; (void)gwave

    unsigned char* ws = p.ws;
    volatile LAS unsigned* bst = (volatile LAS unsigned*)(lds_raw + LDS_MISC);
    unsigned* ubox = (unsigned*)(lds_raw + LDS_MISC + 16);
    if (threadIdx.x == 0) { bst[0] = 0u; bst[1] = 0u; bst[2] = 0u; bst[3] = 0u; }
    __syncthreads();
    XcdBarrier bar = xcd_barrier_post((unsigned*)ws, bst);

    const int* positions = (const int*)p.in[I_POS];

    constexpr int NPH = 8;
    const int lo = p.lo, hi = p.hi;
#ifdef ONLY_PHASE
#define PH_SEL(c) ((c) == ONLY_PHASE)
#else
#define PH_SEL(c) 1
#endif
#define PH_IN(k) (lo <= (k) && (k) < hi)
#define PH_BAR(k) do { if ((k) + 1 < hi) xcd_barrier(bar, wave_s == 0 && LANE_ID() == 0); } while (0)

    if (PH_SEL(-1) && PH_IN(0)) for (int rep = 0; rep < PH_REPS(-1); ++rep) {
        PHASE_IDS();
        for (int l = 0; l < DEPTH; ++l) {
            convert_mats(p.in[I_WIN] + (size_t)l * D * N_IN, 0, 1, N_IN, D, N_IN, WinT + (size_t)l * N_INP * D, 0, RmWin{}, ldsf, tid, bid, G);
            convert_mats(p.in[I_WO] + (size_t)l * D * D, 0, 1, D, D, D, WoT + (size_t)l * D * D, 0, RmIdent{}, ldsf, tid, bid, G);
            convert_mats(p.in[I_WA] + (size_t)l * 6 * 128 * 128, (size_t)128 * 128, 6, 128, 128, 128, WaiT + (size_t)l * 6 * 256 * 128, (size_t)256 * 128, RmIdent{}, ldsf, tid, bid, G);
            convert_mats(p.in[I_WI] + (size_t)l * 6 * 128 * 128, (size_t)128 * 128, 6, 128, 128, 128, WaiT + (size_t)l * 6 * 256 * 128, (size_t)256 * 128, RmOff{128}, ldsf, tid, bid, G);
        }
        for (int i = gtid; i < DEPTH * 8 * D; i += gthreads) { const int k = i % D, h = (i / D) % 8, l = i / (8 * D);
            Wfa[i] = (h < 6) ? p.in[I_WIN][(size_t)l * D * N_IN + (size_t)k * N_IN + C_FA + h] : 0.f; }
        for (int i = gtid; i < DEPTH * 48 * D; i += gthreads) { const int k = i % D, o = (i / D) % 48, l = i / (48 * D);
            const float w = (o < 4) ? p.in[I_WGRP][((size_t)l * D + k) * 4 + o] : (o < 36 ? p.in[I_WRT][((size_t)l * D + k) * 32 + (o - 4)] : 0.f);
            const bf16_t hi = f2bf(w);
            W36b[((size_t)l * 2 + 0) * 48 * D + (size_t)o * D + k] = hi; W36b[((size_t)l * 2 + 1) * 48 * D + (size_t)o * D + k] = f2bf(w - bf2f(hi)); }
        for (int i = gtid; i < S * 8; i += gthreads) { const int d = i & 7, t = i >> 3; const float ang = (float)positions[t] * p.inv_freq[d];
            ropecs[t * 16 + d] = cosf(ang); ropecs[t * 16 + 8 + d] = sinf(ang); }
        __syncthreads();
        for (int i = tid; i < 6 * D; i += NTHREADS) { const int k = i % D, h = i / D; ldsf[i] = p.in[I_WIN][(size_t)k * N_IN + C_FA + h]; }
        __syncthreads();
        for (int t = gwave; t < S; t += gwaves) {
            const float* xr = p.in[I_X] + (size_t)t * D;
            float fa[6] = {0.f, 0.f, 0.f, 0.f, 0.f, 0.f};
#pragma unroll
            for (int j = 0; j < 8; ++j) {
                const int c = j * 256 + lane * 4;
                const f32x4 v = *(const f32x4*)(xr + c);
                u32x2 o; o.x = pack2(v[0], v[1]); o.y = pack2(v[2], v[3]);
                *(u32x2*)(xb + (size_t)t * D + c) = o;
#pragma unroll
                for (int h = 0; h < 6; ++h) { const f32x4 w = *(const f32x4*)(ldsf + h * D + c); fa[h] += v[0] * w[0] + v[1] * w[1] + v[2] * w[2] + v[3] * w[3]; }
            }
#pragma unroll
            for (int h = 0; h < 6; ++h) { const float s = wave_sum(fa[h]); if (lane == 0) logf_[h * S + t] = log_sigmoid_f(s + p.in[I_BF][h]); }
        }
        PH_BAR(0);
    }

    for (int l = 0; l < DEPTH; ++l) {
        const int pb = 1 + l * NPH;
#define hin ((l == 0) ? p.in[I_X] : (const float*)hb)
#define hout ((l == DEPTH - 1) ? p.out : hb)
#define workctr ((int*)(wsl + CTL_WORK_OFF) + l * 64)

        if (PH_SEL(0) && PH_IN(pb + 0)) {
            PHASE_IDS();
            int bz = bid; OPAQUE_S(bz);
            if (bz == 0) {
                double* part = (double*)lds_raw;
                const int per = S / 64;
                double s = 0.0;
                if (wave < 6) { for (int i = 0; i < per; ++i) s += (double)logf_[wave * S + lane * per + i]; part[wave * 64 + lane] = s; }
                __syncthreads();
                if (wave < 6) {
                    double run = 0.0;
                    for (int j = 0; j < lane; ++j) run += part[wave * 64 + j];
                    for (int i = 0; i < per; ++i) { run += (double)logf_[wave * S + lane * per + i]; cum2[wave * S + lane * per + i] = (float)(run * (double)LOG2E); }
                }
                __syncthreads();
            }
            bool conv_more = (l == 0);
#define CONV_ONE() do { if (conv_more) { __syncthreads(); if (tid == 0) *ubox = (unsigned)atomic_add_int((int*)(wsl + CTL_WORK_OFF) + 62, 1); __syncthreads(); \
                const int cid_ = RFL((int)*ubox); if (cid_ < NCONV) moe_conv_chunk(p, cid_, WguT, WdT, ldsf, tid); else conv_more = false; } } while (0)
            unsigned* cls = (unsigned*)(wsl + CTL_CLS_OFF) + l * 256;
            if (bz == 0) { WAIT_VM0(); __syncthreads(); if (tid == 0) { FENCE_REL_AGENT(); WAIT_VM0(); (void)xb_add(&cls[192], 1u); } }
            const bf16_t* Bt = WinT + (size_t)l * N_INP * D;
            constexpr int ntm = S / 256;
            const unsigned nooff[2][2] = {{0u, 0u}, {0u, 0u}};
            for (int i = 0; i < (bid & 3); ++i) CONV_ONE();
            for (;;) {
                __syncthreads();
                if (tid == 0) *ubox = (unsigned)atomic_add_int(workctr + 9, 1);
                __syncthreads();
                int t = RFL((int)*ubox);
                if (t >= ntm * 21) break;
                int pm, pn, kcls;
                if (t < ntm * 6) { pm = t / 6; pn = 15 + t % 6; kcls = 0; }
                else if (t < ntm * 12) { t -= ntm * 6; pm = t / 6; pn = 9 + t % 6; kcls = 1; }
                else { t -= ntm * 12; pm = t / 9; pn = t % 9; kcls = 2; }
                f32x4 acc[2][2][4][2];
                gemm_tile<false>(xb, pm * 256, nooff, Bt, pn * 256, D, lds_raw, acc, tid);
                int et = tid; OPAQUE(et); const int wr = et >> 8, wc = (et >> 6) & 3, fr = et & 15, fq = (et >> 4) & 3;
                if (pn < 6 || (pn >= 9 && pn < 19)) {
                    bf16_t* dst; float scale = 1.f; bool rope = false;
                    if (pn < 3) { dst = Qa; scale = QSCALE_A; } else if (pn < 6) { dst = Ka; } else if (pn < 12) { dst = Xr; } else if (pn < 15) { dst = Gr; }
                    else if (pn < 17) { dst = Qc; scale = QSCALE_C; rope = true; } else { dst = Kc; rope = true; }
                    const bool headmajor = (pn < 6) || (pn >= 15);
                    const int segpn = (pn < 3) ? pn : (pn < 6) ? pn - 3 : (pn < 12) ? pn - 9 : (pn < 15) ? pn - 12 : (pn < 17) ? pn - 15 : pn - 17;
#pragma unroll
                    for (int ai = 0; ai < 2; ++ai)
#pragma unroll
                        for (int m = 0; m < 4; ++m)
#pragma unroll
                            for (int bj = 0; bj < 2; ++bj)
#pragma unroll
                                for (int n = 0; n < 2; ++n) {
                                    const int dd = wc * 32 + n * 16 + fr;
#pragma unroll
                                    for (int j = 0; j < 4; ++j) {
                                        const int row = pm * 256 + ai * 128 + wr * 64 + m * 16 + fq * 4 + j;
                                        float v = acc[ai][bj][m][n][j];
                                        if (rope && n == 0 && (wc & 1) == 0) {
                                            const float pv = SHX(v, 8);
                                            const float cs = ropecs[row * 16 + (fr & 7)], sn = ropecs[row * 16 + 8 + (fr & 7)];
                                            v = (fr < 8) ? (v * cs - pv * sn) : (v * cs + pv * sn);
                                        }
                                        v *= scale;
                                        *(bf16_t*)(lds_raw + (ai * 128 + wr * 64 + m * 16 + fq * 4 + j) * 528 + (bj * 128 + dd) * 2) = f2bf(v);
                                    }
                                }
                    __syncthreads();
#pragma unroll 4
                    for (int i = 0; i < 16; ++i) {
                        const int idx = et + i * 512, lrow = idx >> 5, ch = idx & 31, row = pm * 256 + lrow;
                        const u32x4 val = *(const u32x4*)(lds_raw + lrow * 528 + ch * 16);
                        size_t gi;
                        if (headmajor) gi = ((size_t)(segpn * 2 + (ch >> 4)) * S + row) * 128 + (ch & 15) * 8;
                        else gi = (size_t)row * LRU_W + segpn * 256 + ch * 8;
                        *(u32x4*)(dst + gi) = val;
                    }
                    __syncthreads();
                    if (pn >= 3 && pn < 6) {
                        float* part = ldsf;
#pragma unroll
                        for (int ai = 0; ai < 2; ++ai)
#pragma unroll
                            for (int m = 0; m < 4; ++m)
#pragma unroll
                                for (int bj = 0; bj < 2; ++bj)
#pragma unroll
                                    for (int j = 0; j < 4; ++j) {
                                        float ss = acc[ai][bj][m][0][j] * acc[ai][bj][m][0][j] + acc[ai][bj][m][1][j] * acc[ai][bj][m][1][j];
                                        ss += SHX(ss, 1); ss += SHX(ss, 2); ss += SHX(ss, 4); ss += SHX(ss, 8);
                                        if (fr == 0) part[(wc * 2 + bj) * 256 + ai * 128 + wr * 64 + m * 16 + fq * 4 + j] = ss;
                                    }
                        __syncthreads();
                        {
                            const int bj = et >> 8, row = et & 255;
                            float v = part[(0 * 2 + bj) * 256 + row] + part[(1 * 2 + bj) * 256 + row] + part[(2 * 2 + bj) * 256 + row] + part[(3 * 2 + bj) * 256 + row];
                            v = fmaxf(v, SHX(v, 1)); v = fmaxf(v, SHX(v, 2)); v = fmaxf(v, SHX(v, 4)); v = fmaxf(v, SHX(v, 8)); v = fmaxf(v, SHX(v, 16)); v = fmaxf(v, SHX(v, 32));
                            if ((et & 63) == 0) kmax2[((pn - 3) * 2 + bj) * NKT + pm * 4 + ((et >> 6) & 3)] = v;
                        }
                        __syncthreads();
                    }
                } else {
                    bf16_t* dst = (pn < 9) ? VaT : VcT;
                    const int segpn = (pn < 9) ? pn - 6 : pn - 19;
#pragma unroll
                    for (int ai = 0; ai < 2; ++ai)
#pragma unroll
                        for (int m = 0; m < 4; ++m)
#pragma unroll
                            for (int bj = 0; bj < 2; ++bj)
#pragma unroll
                                for (int n = 0; n < 2; ++n) {
                                    const int dd = wc * 32 + n * 16 + fr;
                                    const int row = pm * 256 + ai * 128 + wr * 64 + m * 16 + fq * 4;
                                    const f32x4 a = acc[ai][bj][m][n];
                                    u32x2 o; o.x = pack2(a[0], a[1]); o.y = pack2(a[2], a[3]);
                                    const int s6 = row & 63, pos = (s6 & 32) + ((s6 >> 2) & 3) * 8 + ((s6 >> 4) & 1) * 4;
                                    *(u32x2*)(dst + (((size_t)(segpn * 2 + bj) * NKT + (row >> 6)) * 128 + dd) * 64 + pos) = o;
                                }
                }
                WAIT_VM0();
                __syncthreads();
                if (et == 0) { FENCE_REL_AGENT(); WAIT_VM0(); (void)xb_add(&cls[kcls * 64], 1u); }
                CONV_ONE();
            }
        }

        if (PH_SEL(1) && PH_IN(pb + 1)) {
            PHASE_IDS();
            const float lam_init = (l == 0) ? 0.2f : 0.35550906759f;
            const float s1 = wave_sum(p.in[I_LQ1][l * 64 + lane] * p.in[I_LK1][l * 64 + lane]);
            const float s2 = wave_sum(p.in[I_LQ2][l * 64 + lane] * p.in[I_LK2][l * 64 + lane]);
            const float lam = fexp(s1) - fexp(s2) + lam_init;
            constexpr int NLRU = NKT * 6, NQB = S / 128;
            bool conv_more = (l == 0);
            unsigned* cls = (unsigned*)(wsl + CTL_CLS_OFF) + l * 256;
            unsigned* bw = (unsigned*)wsl;
#define WAIT_CLASS(k, n) do { __syncthreads(); if (tid == 0) { XB_SPIN(xb_ld(&cls[(k) * 64]) < (unsigned)(n), bw); FENCE_ACQ_AGENT(); WAIT_VM0(); } __syncthreads(); } while (0)
#ifndef NO_LRU
            WAIT_CLASS(1, (S / 256) * 6);
            for (;;) {
                __syncthreads();
                if (tid == 0) *ubox = (unsigned)atomic_add_int(workctr + 10, 1);
                __syncthreads();
                const int u = RFL((int)*ubox);
                if (u >= NLRU) break;
                lru_unit_a(u / 6, u % 6, l, p, Xr, WaiT + (size_t)l * 6 * 256 * 128, hloc, ploc, sumA, sumH, lds_raw, tid);
            }
#endif
#ifndef NO_DIFF
            {
                constexpr int NQB2 = S / 256;
                int total = 0;
                for (int q = 0; q < NQB2; ++q) total += ((4 * q + 4 + DCH - 1) / DCH) * 8;
                WAIT_CLASS(0, (S / 256) * 6);
                for (;;) {
                    __syncthreads();
                    if (tid == 0) *ubox = (unsigned)atomic_add_int(workctr, 1);
                    __syncthreads();
                    int u = RFL((int)*ubox);
                    if (u >= total) break;
                    int qb = NQB2 - 1;
                    for (;; --qb) { const int nu = ((4 * qb + 4 + DCH - 1) / DCH) * 8; if (u < nu) break; u -= nu; }
                    const int c = u >> 3, h = (u >> 1) & 3, mp = u & 1;
                    const int t0 = c * DCH, t1 = (t0 + DCH < 4 * qb + 4) ? t0 + DCH : 4 * qb + 4;
                    attn_dmap_unit(Qc + (size_t)h * S * 128, Kc + (size_t)h * S * 128, VcT + (size_t)h * S * 128, mp, qb, t0, t1,
                                   dpo + (size_t)(h * 2 + mp) * DPART_ROWS * 128, dpml + (size_t)(h * 2 + mp) * DPART_ROWS * 2, c, lds_raw, tid);
                    CONV_ONE();
                }
            }
#endif
#ifndef NO_FOX
            WAIT_CLASS(2, (S / 256) * 9);
            WAIT_CLASS(3, 1);
            for (;;) {
                __syncthreads();
                if (tid == 0) *ubox = (unsigned)atomic_add_int(workctr + 1, 1);
                __syncthreads();
                const int u = RFL((int)*ubox);
                if (u >= NQB * FOX_H) break;
                const int qb = NQB - 1 - u / FOX_H, h = u % FOX_H;
                attn_unit<0>(Qa + (size_t)h * S * 128, Ka + (size_t)h * S * 128, VaT + (size_t)h * S * 128, cum2 + (size_t)h * S, kmax2 + h * NKT, qb, concat, h * 128,
                             0.f, 0.f, nullptr, lds_raw, tid);
            }
#endif
            while (conv_more) CONV_ONE();
            PH_BAR(pb + 1);
        }

        if (PH_SEL(2) && PH_IN(pb + 2)) for (int rep = 0; rep < PH_REPS(2); ++rep) {
            PHASE_IDS();
            for (int u = bid; u < NKT * 6; u += G) {
                const int chunk = u / 6, grp = u % 6, c = tid & 127, tq = tid >> 7, ch = grp * 128 + c;
                float cr = 0.f;
                {
                    int j = 0;
                    for (; j + 8 <= chunk; j += 8) {
                        float a8[8], h8[8];
#pragma unroll
                        for (int q = 0; q < 8; ++q) { a8[q] = sumA[(size_t)(j + q) * LRU_W + ch]; h8[q] = sumH[(size_t)(j + q) * LRU_W + ch]; }
#pragma unroll
                        for (int q = 0; q < 8; ++q) cr = a8[q] * cr + h8[q];
                    }
                    for (; j < chunk; ++j) cr = sumA[(size_t)j * LRU_W + ch] * cr + sumH[(size_t)j * LRU_W + ch];
                }
#pragma unroll 4
                for (int i = 0; i < 16; ++i) {
                    const size_t gi = (size_t)(chunk * 64 + tq * 16 + i) * LRU_W + ch;
                    const float h = hloc[gi] + ploc[gi] * cr;
                    concat[(size_t)(chunk * 64 + tq * 16 + i) * D + FOX_W + ch] = f2bf(gelu_tanh_f(bf2f(Gr[gi])) * h);
                }
            }
            {
                const float lam_init = (l == 0) ? 0.2f : 0.35550906759f;
                const float s1 = wave_sum(p.in[I_LQ1][l * 64 + lane] * p.in[I_LK1][l * 64 + lane]);
                const float s2 = wave_sum(p.in[I_LQ2][l * 64 + lane] * p.in[I_LK2][l * 64 + lane]);
                const float lam = fexp(s1) - fexp(s2) + lam_init;
                const float* sg = p.in[I_SUBG] + l * 128;
                const float g0 = sg[2 * lane], g1 = sg[2 * lane + 1];
                static_assert(NCH <= 8, "the merge below keeps one (map, chunk) pair per lane: 2 x 8 lanes");
                for (int idx = gwave; idx < S * DIFF_H; idx += gwaves) {
                    const int h = idx & 3, q = idx >> 2, nch = (q >> 6) / DCH + 1;
                    float mv = -INFINITY, lv = 0.f;
                    { const int c = lane & 7, mp = (lane >> 3) & 1;
                      if (lane < 16 && c < nch) { const float* ML = dpml + ((size_t)(h * 2 + mp) * DPART_ROWS + dpart_row(c, q)) * 2; mv = ML[0]; lv = ML[1]; } }
                    float Mx = mv; Mx = fmaxf(Mx, SHX(Mx, 1)); Mx = fmaxf(Mx, SHX(Mx, 2)); Mx = fmaxf(Mx, SHX(Mx, 4));
                    const float wv = (mv == -INFINITY) ? 0.f : FAST_EXP2(mv - Mx);
                    float Lp = lv * wv; Lp += SHX(Lp, 1); Lp += SHX(Lp, 2); Lp += SHX(Lp, 4);
                    float om[2][2];
#pragma unroll
                    for (int mp = 0; mp < 2; ++mp) {
                        const unsigned* OP = (const unsigned*)(dpo + (size_t)(h * 2 + mp) * DPART_ROWS * 128);
                        unsigned pk[NCH];
#pragma unroll
                        for (int c = 0; c < NCH; ++c) pk[c] = (c < nch) ? OP[(size_t)dpart_row(c, q) * 64 + lane] : 0u;
                        float o0 = 0.f, o1 = 0.f;
#pragma unroll
                        for (int c = 0; c < NCH; ++c) { const float w = RDLANE(wv, mp * 8 + c); o0 += bf2f((bf16_t)(pk[c] & 0xffffu)) * w; o1 += bf2f((bf16_t)(pk[c] >> 16)) * w; }
                        const float il = 1.f / RDLANE(Lp, mp * 8);
                        om[mp][0] = o0 * il; om[mp][1] = o1 * il;
                    }
                    const float v0 = om[0][0] - lam * om[1][0], v1 = om[0][1] - lam * om[1][1];
                    const float ss = wave_sum(v0 * v0 + v1 * v1);
                    const float rs = (1.f - lam_init) / sqrtf(ss * (1.f / 128.f) + LN_EPS);
                    *(unsigned*)(concat + (size_t)q * D + 1536 + h * 128 + 2 * lane) = pack2(v0 * rs * g0, v1 * rs * g1);
                }
            }
            PH_BAR(pb + 2);
        }

        if (PH_SEL(3) && PH_IN(pb + 3)) for (int rep = 0; rep < PH_REPS(3); ++rep) {
            PHASE_IDS();
            const bf16_t* Bt = WoT + (size_t)l * D * D;
            constexpr int ntn = D / 256, ntm = S / 256;
            const unsigned nooff[2][2] = {{0u, 0u}, {0u, 0u}};
            for (int t = bid; t < ntm * ntn; t += G) {
                const int pm = t / ntn, pn = t % ntn;
                f32x4 acc[2][2][4][2];
                gemm_tile<false>(concat, pm * 256, nooff, Bt, pn * 256, D, lds_raw, acc, tid);
                int et = tid; OPAQUE(et); const int wr = et >> 8, wc = (et >> 6) & 3, fr = et & 15, fq = (et >> 4) & 3;
#pragma unroll
                for (int ai = 0; ai < 2; ++ai) {
#pragma unroll
                    for (int m = 0; m < 4; ++m)
#pragma unroll
                        for (int bj = 0; bj < 2; ++bj)
#pragma unroll
                            for (int n = 0; n < 2; ++n)
#pragma unroll
                                for (int j = 0; j < 4; ++j)
                                    *(float*)(lds_raw + (wr * 64 + m * 16 + fq * 4 + j) * 1040 + (bj * 128 + wc * 32 + n * 16 + fr) * 4) = acc[ai][bj][m][n][j];
                    __syncthreads();
#pragma unroll 4
                    for (int i = 0; i < 16; ++i) {
                        const int idx = et + i * 512, lrow = idx >> 6, c4 = idx & 63;
                        const size_t gi = (size_t)(pm * 256 + ai * 128 + lrow) * D + pn * 256 + c4 * 4;
                        const f32x4 v = *(const f32x4*)(lds_raw + lrow * 1040 + c4 * 16);
                        *(f32x4*)(y1 + gi) = ALPHA * *(const f32x4*)(hin + gi) + v;
                    }
                    __syncthreads();
                }
            }
            PH_BAR(pb + 3);
        }

        if (PH_SEL(4) && PH_IN(pb + 4)) for (int rep = 0; rep < PH_REPS(4); ++rep) {
            PHASE_IDS();
            const float* g1 = p.in[I_LN1G] + (size_t)l * D; const float* b1 = p.in[I_LN1B] + (size_t)l * D;
            const float* bg = p.in[I_BGRP] + l * 4; const float* br = p.in[I_BRT] + l * 32;
            const bf16_t* Wb = W36b + (size_t)l * 2 * 48 * D;
            int* lcnt = (int*)(lds_raw + LDS_MISC + M_LCNT);
            const int segcap = ((S / 16 + G - 1) / G) * 16;
            const int r16 = lane & 15, q4 = lane >> 4;
            if (tid < 32) lcnt[tid] = 0;
            __syncthreads();
            for (int bi = bid; bi < S / 16; bi += G) {
#pragma unroll 1
                for (int tk = 0; tk < 2; ++tk) {
                    const int r = wave * 2 + tk, t = bi * 16 + r;
                    f32x4 v[8]; float s = 0.f;
#pragma unroll
                    for (int j = 0; j < 8; ++j) { v[j] = *(const f32x4*)(y1 + (size_t)t * D + j * 256 + lane * 4); s += (v[j][0] + v[j][1]) + (v[j][2] + v[j][3]); }
                    const float mean = wave_sum(s) * (1.f / D);
                    float s2 = 0.f;
#pragma unroll
                    for (int j = 0; j < 8; ++j) { v[j] -= mean; s2 += (v[j][0] * v[j][0] + v[j][1] * v[j][1]) + (v[j][2] * v[j][2] + v[j][3] * v[j][3]); }
                    const float rstd = 1.f / sqrtf(wave_sum(s2) * (1.f / D) + LN_EPS);
#pragma unroll
                    for (int j = 0; j < 8; ++j) {
                        const int c = j * 256 + lane * 4;
                        const f32x4 g = *(const f32x4*)(g1 + c), b = *(const f32x4*)(b1 + c);
                        v[j] = v[j] * rstd * g + b;
                        *(f32x4*)(h1 + (size_t)t * D + c) = v[j];
                        u32x2 o; o.x = pack2(v[j][0], v[j][1]); o.y = pack2(v[j][2], v[j][3]);
                        *(u32x2*)(h1b + (size_t)t * D + c) = o;
                        u32x2 lo2;
                        lo2.x = pack2(v[j][0] - bf2f((bf16_t)(o.x & 0xffffu)), v[j][1] - bf2f((bf16_t)(o.x >> 16)));
                        lo2.y = pack2(v[j][2] - bf2f((bf16_t)(o.y & 0xffffu)), v[j][3] - bf2f((bf16_t)(o.y >> 16)));
                        const int la = r * 4096 + (((j * 32 + (lane >> 1)) ^ r) << 4) + (lane & 1) * 8;
                        *(u32x2*)(lds_raw + la) = o; *(u32x2*)(lds_raw + 65536 + la) = lo2;
                    }
                }
                __syncthreads();
                f32x4 ac[3];
#pragma unroll
                for (int nt = 0; nt < 3; ++nt) ac[nt] = (f32x4){0.f, 0.f, 0.f, 0.f};
#pragma unroll 2
                for (int ks = 0; ks < 8; ++ks) {
                    const int kk = wave * 8 + ks;
                    const int la = r16 * 4096 + (((kk * 4 + q4) ^ r16) << 4);
                    const bf16x8 ah = *(const bf16x8*)(lds_raw + la), al = *(const bf16x8*)(lds_raw + 65536 + la);
#pragma unroll
                    for (int nt = 0; nt < 3; ++nt) {
                        const bf16x8 bh = *(const bf16x8*)(Wb + (size_t)(nt * 16 + r16) * D + kk * 32 + q4 * 8);
                        const bf16x8 bl = *(const bf16x8*)(Wb + (size_t)48 * D + (size_t)(nt * 16 + r16) * D + kk * 32 + q4 * 8);
                        ac[nt] = MFMA16(ah, bh, ac[nt]); ac[nt] = MFMA16(al, bh, ac[nt]); ac[nt] = MFMA16(ah, bl, ac[nt]);
                    }
                }
                __syncthreads();
                float* red = ldsf;
#pragma unroll
                for (int nt = 0; nt < 3; ++nt)
#pragma unroll
                    for (int j = 0; j < 4; ++j) red[(wave * 16 + q4 * 4 + j) * 48 + nt * 16 + r16] = ac[nt][j];
                __syncthreads();
                float* lgt = ldsf + 8 * 16 * 48;
                if (tid < 256) {
                    const int tkn = tid >> 4, o3 = (tid & 15) * 3;
#pragma unroll
                    for (int q = 0; q < 3; ++q) { float a = 0.f;
#pragma unroll
                        for (int w = 0; w < 8; ++w) a += red[(w * 16 + tkn) * 48 + o3 + q];
                        lgt[tkn * 48 + o3 + q] = a; }
                }
                __syncthreads();
                if (tid < 16) {
                    const int t = bi * 16 + tid; const float* L = lgt + tid * 48;
                    float gl[4];
#pragma unroll
                    for (int q = 0; q < 4; ++q) gl[q] = L[q] + bg[q];
                    int gi = 0; float gm = gl[0];
#pragma unroll
                    for (int q = 1; q < 4; ++q) if (gl[q] > gm) { gm = gl[q]; gi = q; }
                    float gs = 0.f;
#pragma unroll
                    for (int q = 0; q < 4; ++q) gs += fexp(gl[q] - gm);
                    const float gweight = 1.f / gs;
                    float E[8];
#pragma unroll
                    for (int e = 0; e < 8; ++e) E[e] = L[4 + gi * 8 + e] + br[gi * 8 + e];
                    int e1 = 0; float m1 = E[0];
#pragma unroll
                    for (int e = 1; e < 8; ++e) if (E[e] > m1) { m1 = E[e]; e1 = e; }
                    int e2 = -1; float m2 = -INFINITY;
#pragma unroll
                    for (int e = 0; e < 8; ++e) if (e != e1 && E[e] > m2) { m2 = E[e]; e2 = e; }
                    const float p2 = fexp(m2 - m1), w1 = 1.f / (1.f + p2), w2 = p2 / (1.f + p2);
                    const int ge1 = gi * 8 + e1, ge2 = gi * 8 + e2;
                    const int i1 = (ge1 * G + bid) * segcap + atomic_add_int(&lcnt[ge1], 1);
                    ltok[i1] = t; lw[i1] = gweight * w1; lslot[i1] = 0;
                    const int i2 = (ge2 * G + bid) * segcap + atomic_add_int(&lcnt[ge2], 1);
                    ltok[i2] = t; lw[i2] = gweight * w2; lslot[i2] = 1;
                }
                __syncthreads();
            }
            if (tid < 32) cntb[bid * 32 + tid] = lcnt[tid];
            PH_BAR(pb + 4);
        }

        if (PH_SEL(5) && PH_IN(pb + 5)) {
            PHASE_IDS();
            const unsigned nooff[2][2] = {{0u, 0u}, {0u, 0u}};
            const int segcap = ((S / 16 + G - 1) / G) * 16;
            moe_prefix(cntb, G, lds_raw, tid);
            const int* ctot = (const int*)(lds_raw + LDS_MISC + M_CTOT); const int* coff = (const int*)(lds_raw + LDS_MISC + M_COFF);
            const int* rtok = (const int*)(lds_raw + LDS_MISC + M_RTOK); const float* rw = (const float*)(lds_raw + LDS_MISC + M_RW);
            const int* rslot = (const int*)(lds_raw + LDS_MISC + M_RSLOT);
            unsigned* done = (unsigned*)(wsl + CTL_DONE_OFF) + l * 1024;
            int nmt = 0;
            for (int e = 0; e < NEXP; ++e) nmt += (ctot[e] + 255) / 256;
            nmt = RFL(nmt);
            for (;;) {
                __syncthreads();
                if (tid == 0) *ubox = (unsigned)atomic_add_int(workctr + 8, 1);
                __syncthreads();
                int u = RFL((int)*ubox);
                if (u >= nmt * 12) break;
                const bool down = (u >= nmt * 4);
                const int per = down ? 8 : 4;
                if (down) u -= nmt * 4;
                int e = 0;
                for (;; ++e) { const int nt = ((RFL(ctot[e]) + 255) / 256) * per; if (u < nt) break; u -= nt; }
                const int c = RFL(ctot[e]), off = RFL(coff[e]);
                const int mt = u / per, pn = u % per, m0 = mt * 256;
                moe_rowtable(ltok, lw, lslot, e, m0, G, segcap, lds_raw, tid);
                f32x4 acc[2][2][4][2];
                if (!down) {
                    const bf16_t* Bt = WguT + ((size_t)l * NEXP + e) * 1024 * D;
                    unsigned aoff[2][2];
                    int st = tid; OPAQUE(st); int R[2], C[2]; stage_geom(st, R, C);
#pragma unroll
                    for (int h = 0; h < 2; ++h)
#pragma unroll
                        for (int i = 0; i < 2; ++i) aoff[h][i] = (unsigned)(rtok[h * 128 + R[i]] * D + C[i]);
                    gemm_tile<true>(h1b, 0, aoff, Bt, pn * 256, D, lds_raw, acc, tid);
                    int et = tid; OPAQUE(et); const int wr = et >> 8, wc = (et >> 6) & 3, fr = et & 15, fq = (et >> 4) & 3;
#pragma unroll
                    for (int ai = 0; ai < 2; ++ai)
#pragma unroll
                        for (int m = 0; m < 4; ++m)
#pragma unroll
                            for (int j = 0; j < 4; ++j) {
                                const int r = ai * 128 + wr * 64 + m * 16 + fq * 4 + j;
                                const float wgt = rw[r];
#pragma unroll
                                for (int bj = 0; bj < 2; ++bj)
                                    *(bf16_t*)(lds_raw + r * 272 + (bj * 64 + wc * 16 + fr) * 2) = f2bf(silu_f(acc[ai][bj][m][0][j]) * acc[ai][bj][m][1][j] * wgt);
                            }
                    __syncthreads();
#pragma unroll 4
                    for (int i = 0; i < 8; ++i) {
                        const int idx = et + i * 512, r = idx >> 4, ch = idx & 15;
                        if (m0 + r < c) *(u32x4*)(act + (size_t)(off + m0 + r) * DFF + pn * 128 + ch * 8) = *(const u32x4*)(lds_raw + r * 272 + ch * 16);
                    }
                    WAIT_VM0();
                    __syncthreads();
                    if (et == 0) { FENCE_REL_AGENT(); WAIT_VM0(); (void)xb_add(&done[e * 32 + mt], 1u); }
                } else {
                    const bf16_t* Bt = WdT + ((size_t)l * NEXP + e) * D * DFF;
                    if (tid == 0) {
                        unsigned* bw = (unsigned*)wsl;
                        XB_SPIN(xb_ld(&done[e * 32 + mt]) < 4u, bw);
                        FENCE_ACQ_AGENT();
                        WAIT_VM0();
                    }
                    __syncthreads();
                    gemm_tile<false>(act, off + m0, nooff, Bt, pn * 256, DFF, lds_raw, acc, tid);
                    int et = tid; OPAQUE(et); const int wr = et >> 8, wc = (et >> 6) & 3, fr = et & 15, fq = (et >> 4) & 3;
#pragma unroll
                    for (int ai = 0; ai < 2; ++ai)
#pragma unroll
                        for (int m = 0; m < 4; ++m)
#pragma unroll
                            for (int bj = 0; bj < 2; ++bj)
#pragma unroll
                                for (int n = 0; n < 2; ++n)
#pragma unroll
                                    for (int j = 0; j < 4; ++j)
                                        *(bf16_t*)(lds_raw + (ai * 128 + wr * 64 + m * 16 + fq * 4 + j) * 528 + (bj * 128 + wc * 32 + n * 16 + fr) * 2) = f2bf(acc[ai][bj][m][n][j]);
                    __syncthreads();
#pragma unroll 4
                    for (int i = 0; i < 16; ++i) {
                        const int idx = et + i * 512, r = idx >> 5, ch = idx & 31;
                        if (m0 + r < c) *(u32x4*)(contrib + ((size_t)rslot[r] * S + rtok[r]) * D + pn * 256 + ch * 8) = *(const u32x4*)(lds_raw + r * 528 + ch * 16);
                    }
                }
            }
            PH_BAR(pb + 5);
        }

        if (PH_SEL(7) && PH_IN(pb + 7)) for (int rep = 0; rep < PH_REPS(7); ++rep) {
            PHASE_IDS();
            const float* g2 = p.in[I_LN2G] + (size_t)l * D; const float* b2 = p.in[I_LN2B] + (size_t)l * D;
            const bool more = (l + 1 < DEPTH);
            const float* wf = Wfa + (size_t)(l + 1 < DEPTH ? l + 1 : l) * 8 * D;
            for (int t = gwave; t < S; t += gwaves) {
                f32x4 v[8]; float s = 0.f;
#pragma unroll
                for (int j = 0; j < 8; ++j) {
                    const size_t i = (size_t)t * D + j * 256 + lane * 4;
                    const u32x2 c0 = *(const u32x2*)(contrib + i), c1 = *(const u32x2*)(contrib + (size_t)S * D + i);
                    const f32x4 cs = (f32x4){bf2f((bf16_t)(c0.x & 0xffffu)) + bf2f((bf16_t)(c1.x & 0xffffu)), bf2f((bf16_t)(c0.x >> 16)) + bf2f((bf16_t)(c1.x >> 16)),
                                             bf2f((bf16_t)(c0.y & 0xffffu)) + bf2f((bf16_t)(c1.y & 0xffffu)), bf2f((bf16_t)(c0.y >> 16)) + bf2f((bf16_t)(c1.y >> 16))};
                    v[j] = ALPHA * *(const f32x4*)(h1 + i) + cs;
                    s += (v[j][0] + v[j][1]) + (v[j][2] + v[j][3]);
                }
                const float mean = wave_sum(s) * (1.f / D);
                float s2 = 0.f;
#pragma unroll
                for (int j = 0; j < 8; ++j) { v[j] -= mean; s2 += (v[j][0] * v[j][0] + v[j][1] * v[j][1]) + (v[j][2] * v[j][2] + v[j][3] * v[j][3]); }
                const float rstd = 1.f / sqrtf(wave_sum(s2) * (1.f / D) + LN_EPS);
                float fa[6] = {0.f, 0.f, 0.f, 0.f, 0.f, 0.f};
#pragma unroll
                for (int j = 0; j < 8; ++j) {
                    const int c = j * 256 + lane * 4;
                    const f32x4 g = *(const f32x4*)(g2 + c), b = *(const f32x4*)(b2 + c);
                    v[j] = v[j] * rstd * g + b;
                    *(f32x4*)(hout + (size_t)t * D + c) = v[j];
                    COMPILER_FENCE();
                    if (more) {
                        u32x2 o; o.x = pack2(v[j][0], v[j][1]); o.y = pack2(v[j][2], v[j][3]);
                        *(u32x2*)(xb + (size_t)t * D + c) = o;
#pragma unroll
                        for (int h = 0; h < 6; ++h) { const f32x4 w = *(const f32x4*)(wf + h * D + c); fa[h] += (v[j][0] * w[0] + v[j][1] * w[1]) + (v[j][2] * w[2] + v[j][3] * w[3]); }
                    }
                }
                if (more) {
#pragma unroll
                    for (int h = 0; h < 6; ++h) { const float sm = wave_sum(fa[h]); if (lane == 0) logf_[h * S + t] = log_sigmoid_f(sm + p.in[I_BF][(l + 1) * 6 + h]); }
                }
            }
            PH_BAR(pb + 7);
        }
    }
#undef PH_IN
#undef PH_BAR
}

constexpr int N_PHASES = 1 + DEPTH * 8;
#ifndef EMU
extern "C" void kernel_launch(void* const* d_in, const int* in_sizes, int n_in, void* d_out, int out_size, void* d_ws, size_t ws_size, hipStream_t stream) {
    static int grid = 0;
    if (grid == 0) {
        if (n_in != N_INPUTS || out_size != S * D || ws_size < WS_END) {
            fprintf(stderr, "kernel_launch: unexpected shapes: n_in %d out %d ws %zu (need %zu)\n", n_in, out_size, ws_size, (size_t)WS_END); grid = -1; return; }
        int dev = 0, cus = 0, per_cu = 0;
        if (hipGetDevice(&dev) != hipSuccess || hipDeviceGetAttribute(&cus, hipDeviceAttributeMultiprocessorCount, dev) != hipSuccess) { grid = -1; return; }
        if (hipFuncSetAttribute((const void*)fwd_kernel, hipFuncAttributeMaxDynamicSharedMemorySize, LDS_BYTES) != hipSuccess) { fprintf(stderr, "kernel_launch: hipFuncSetAttribute failed\n"); grid = -1; return; }
        if (hipOccupancyMaxActiveBlocksPerMultiprocessor(&per_cu, (const void*)fwd_kernel, NTHREADS, LDS_BYTES) != hipSuccess || per_cu < 1) {
            fprintf(stderr, "kernel_launch: occupancy query says %d blocks per CU\n", per_cu); (void)hipGetLastError(); grid = -1; return; }
        grid = cus;
    }
    if (grid < 0) return;
    (void)hipMemsetAsync(d_ws, 0, CTL_BYTES, stream);
    Params p{};
    for (int i = 0; i < N_INPUTS; ++i) p.in[i] = (const float*)d_in[i];
    p.out = (float*)d_out; p.ws = (unsigned char*)d_ws;
    for (int i = 0; i < 8; ++i) p.inv_freq[i] = (float)pow(500000.0, -(double)i * 2.0 / 16.0);
#if N_LAUNCH_SPLIT
    for (int k = 0; k < N_PHASES; ++k) { p.lo = k; p.hi = k + 1; hipLaunchKernelGGL(fwd_kernel, dim3(grid), dim3(NTHREADS), LDS_BYTES, stream, p); }
#else
    p.lo = 0; p.hi = N_PHASES;
    hipLaunchKernelGGL(fwd_kernel, dim3(grid), dim3(NTHREADS), LDS_BYTES, stream, p);
#endif
}
#endif
```

```cpp
#ifndef EMU
#include <hip/hip_runtime.h>
#include <cstdio>
#include <cstdint>
#include <cmath>
#endif

#ifndef SEQ
#define SEQ 8192
#endif
#ifndef N_LAUNCH_SPLIT
#define N_LAUNCH_SPLIT 0
#endif
#ifndef REP_PHASE
#define REP_PHASE -2
#endif
#define PH_REPS(c) ((c) == REP_PHASE ? 2 : 1)
#ifndef REP_SUB
#define REP_SUB 0
#endif

constexpr int S = SEQ, D = 2048, DEPTH = 2;
constexpr int FOX_H = 6, FOX_W = 768;
constexpr int LRU_W = 768;
constexpr int DIFF_H = 4, DIFF_W = 512;
constexpr int N_IN = 5382, N_INP = 5376;
constexpr int C_FA = 2304;
constexpr int NEXP = 32, DFF = 512;
constexpr int NKT = S / 64;
#ifndef DCH
#define DCH 16
#endif
constexpr int NCH = (NKT + DCH - 1) / DCH;
constexpr size_t DPART_ROWS = (size_t)NCH * S - (size_t)(DCH * 64) * NCH * (NCH - 1) / 2;
constexpr float ALPHA = 1.41421356237309504880f;
constexpr float LN_EPS = 1e-5f;
constexpr float LOG2E = 1.4426950408889634f;
constexpr float QSCALE_A = 0.08838834764831845f * 1.4426950408889634f;
constexpr float QSCALE_C = 0.125f * 1.4426950408889634f;

enum { I_X = 0, I_POS, I_WIN, I_BF, I_CONVW, I_CONVB, I_WA, I_BA, I_WI, I_BI, I_LAM, I_LQ1, I_LK1, I_LQ2, I_LK2, I_SUBG, I_WO, I_LN1G, I_LN1B,
       I_WGRP, I_BGRP, I_WRT, I_BRT, I_WGATE, I_WUP, I_WDOWN, I_LN2G, I_LN2B, N_INPUTS };

typedef unsigned short bf16_t;
typedef short bf16x8 __attribute__((ext_vector_type(8)));
typedef float f32x4 __attribute__((ext_vector_type(4)));
typedef unsigned u32x4 __attribute__((ext_vector_type(4)));
typedef unsigned u32x2 __attribute__((ext_vector_type(2)));

constexpr size_t al256(size_t x) { return (x + 255) & ~(size_t)255; }
constexpr size_t CTL_BYTES = 65536;
constexpr size_t CTL_CNT_OFF = 32768;
constexpr size_t CTL_WORK_OFF = 36864;
constexpr size_t CTL_CLS_OFF = 49152;
constexpr size_t CTL_DONE_OFF = 40960;
constexpr size_t WB_WIN = CTL_BYTES;
constexpr size_t WB_WO = WB_WIN + al256((size_t)DEPTH * N_INP * D * 2);
constexpr size_t WB_WGU = WB_WO + al256((size_t)DEPTH * D * D * 2);
constexpr size_t WB_WD = WB_WGU + al256((size_t)DEPTH * NEXP * 1024 * D * 2);
constexpr size_t WB_WAI = WB_WD + al256((size_t)DEPTH * NEXP * D * DFF * 2);
constexpr size_t WF_FA = WB_WAI + al256((size_t)DEPTH * 6 * 256 * 128 * 2);
constexpr size_t WF_R36 = WF_FA + al256((size_t)DEPTH * 8 * D * 4);
constexpr size_t WF_ROPE = WF_R36 + al256((size_t)DEPTH * 2 * 48 * D * 2);
constexpr size_t A_XB = WF_ROPE + al256((size_t)S * 16 * 4);
constexpr size_t A_HB = A_XB + al256((size_t)S * D * 2);
constexpr size_t A_LOGF = A_HB + al256((size_t)S * D * 4);
constexpr size_t A_CUM = A_LOGF + al256((size_t)6 * S * 4);
constexpr size_t A_KMAX = A_CUM + al256((size_t)6 * S * 4);
constexpr size_t A_CNTB = A_KMAX + al256((size_t)6 * NKT * 4);
constexpr size_t A_QA = A_CNTB + al256((size_t)1024 * 32 * 4);
constexpr size_t A_KA = A_QA + al256((size_t)FOX_H * S * 128 * 2);
constexpr size_t A_VAT = A_KA + al256((size_t)FOX_H * S * 128 * 2);
constexpr size_t A_XR = A_VAT + al256((size_t)FOX_H * S * 128 * 2);
constexpr size_t A_GR = A_XR + al256((size_t)S * LRU_W * 2);
constexpr size_t A_QC = A_GR + al256((size_t)S * LRU_W * 2);
constexpr size_t A_KC = A_QC + al256((size_t)DIFF_H * S * 128 * 2);
constexpr size_t A_VCT = A_KC + al256((size_t)DIFF_H * S * 128 * 2);
constexpr size_t A_HLOC = A_VCT + al256((size_t)DIFF_H * S * 128 * 2);
constexpr size_t A_PLOC = A_HLOC + al256((size_t)S * LRU_W * 4);
constexpr size_t A_SUMA = A_PLOC + al256((size_t)S * LRU_W * 4);
constexpr size_t A_SUMH = A_SUMA + al256((size_t)NKT * LRU_W * 4);
constexpr size_t A_CONCAT = A_SUMH + al256((size_t)NKT * LRU_W * 4);
constexpr size_t A_Y1 = A_CONCAT + al256((size_t)S * D * 2);
constexpr size_t A_H1 = A_Y1 + al256((size_t)S * D * 4);
constexpr size_t A_H1B = A_H1 + al256((size_t)S * D * 4);
constexpr size_t A_LTOK = A_H1B + al256((size_t)S * D * 2);
constexpr size_t A_LW = A_LTOK + al256((size_t)NEXP * S * 4);
constexpr size_t A_LSLOT = A_LW + al256((size_t)NEXP * S * 4);
constexpr size_t A_ACT = A_LSLOT + al256((size_t)NEXP * S * 4);
constexpr size_t A_CONTRIB = A_ACT + al256((size_t)(2 * S + 256) * DFF * 2);
constexpr size_t WS_END = A_CONTRIB + al256((size_t)2 * S * D * 4);
constexpr size_t A_DPO = A_Y1;
constexpr size_t A_DPML = A_DPO + al256((size_t)8 * DPART_ROWS * 128 * 2);
static_assert(A_DPML + (size_t)8 * DPART_ROWS * 2 * 4 <= A_H1B, "differential partials must fit inside the y1 + h1 region");

constexpr int NTHREADS = 512;
constexpr int LDS_MAIN = 131072 + 4096;
constexpr int LDS_MISC = LDS_MAIN;
constexpr int LDS_BYTES = LDS_MAIN + 8192 + 16640;
constexpr int M_PRE16 = 8192;
constexpr int M_LCNT = 64, M_CTOT = 256, M_COFF = 384, M_PRE = 512, M_RTOK = 2048, M_RW = 3072, M_RSLOT = 4096;

struct Params {
    const float* in[N_INPUTS];
    float* out;
    unsigned char* ws;
    float inv_freq[8];
    int lo, hi;
};

#ifndef EMU
#define LAS __attribute__((address_space(3)))
#define DYN_LDS(name) extern __shared__ __attribute__((aligned(16))) unsigned char name[]
#define SLEEP1() __builtin_amdgcn_s_sleep(1)
#define WAVE_SYNC() __builtin_amdgcn_wave_barrier()
#define OPAQUE(x) asm volatile("" : "+v"(x))
#define COMPILER_FENCE() asm volatile("" ::: "memory")
#define RFL(x) __builtin_amdgcn_readfirstlane(x)
#define ANY_LANE(p) (__builtin_amdgcn_ballot_w64(p) != 0ull)
#define RDLANE(v, l) __builtin_bit_cast(float, __builtin_amdgcn_readlane(__builtin_bit_cast(int, v), l))
__device__ __forceinline__ int lane_id_volatile() { int l; asm volatile("v_mbcnt_lo_u32_b32 %0, -1, 0\n\tv_mbcnt_hi_u32_b32 %0, -1, %0" : "=v"(l)); return l; }
#define LANE_ID() lane_id_volatile()
#define OPAQUE_S(x) asm volatile("" : "+s"(x))
#define WAIT_VM0() asm volatile("s_waitcnt vmcnt(0)" ::: "memory")
#define WAIT_ALL0() __builtin_amdgcn_s_waitcnt(0)
#define FENCE_REL_AGENT() __builtin_amdgcn_fence(__ATOMIC_RELEASE, "agent")
#define FENCE_ACQ_AGENT() __builtin_amdgcn_fence(__ATOMIC_ACQUIRE, "agent")
#define MFMA16(a, b, c) __builtin_amdgcn_mfma_f32_16x16x32_bf16(a, b, c, 0, 0, 0)
#define GLDS16(g, l) __builtin_amdgcn_global_load_lds((const unsigned*)(g), (unsigned*)(l), 16, 0, 0)
#define WAIT_V(n) asm volatile("s_waitcnt vmcnt(" #n ")" ::: "memory")
#define WAIT_L(n) asm volatile("s_waitcnt lgkmcnt(" #n ")" ::: "memory")
#define BAR() __builtin_amdgcn_s_barrier()
#define SCHED() __builtin_amdgcn_sched_barrier(0)
#define SETPRIO(n) __builtin_amdgcn_s_setprio(n)
#define FAST_EXP2(x) __builtin_amdgcn_exp2f(x)
template <int M> __device__ __forceinline__ float shx_impl(float v, int lane) {
    if (M < 32) return __builtin_bit_cast(float, __builtin_amdgcn_ds_swizzle(__builtin_bit_cast(int, v), (M << 10) | 0x1f));
    return __builtin_bit_cast(float, __builtin_amdgcn_ds_bpermute((lane ^ 32) << 2, __builtin_bit_cast(int, v)));
}
#define SHX(v, M) shx_impl<M>(v, lane)
#define FAST_LOG2(x) __builtin_amdgcn_logf(x)
#define FAST_RCP(x) __builtin_amdgcn_rcpf(x)
__device__ __forceinline__ unsigned xb_ld(unsigned* p)              { return __hip_atomic_load(p, __ATOMIC_RELAXED, __HIP_MEMORY_SCOPE_AGENT); }
__device__ __forceinline__ unsigned xb_add(unsigned* p, unsigned v) { return __hip_atomic_fetch_add(p, v, __ATOMIC_RELAXED, __HIP_MEMORY_SCOPE_AGENT); }
__device__ __forceinline__ unsigned xb_xcc_id() { return (unsigned)__builtin_amdgcn_s_getreg((3 << 11) | 20) & 0xFu; }
__device__ __forceinline__ int atomic_add_int(int* p, int v) { return atomicAdd(p, v); }
__device__ __forceinline__ void atomic_min_int(int* p, int v) { atomicMin(p, v); }
__device__ __forceinline__ unsigned pack2(float lo, float hi) { unsigned r; asm volatile("v_cvt_pk_bf16_f32 %0, %1, %2" : "=v"(r) : "v"(lo), "v"(hi)); return r; }
#else
#define MFMA16(a, b, c) emu_mfma_16x16x32_bf16(a, b, c)
#define GLDS16(g, l) emu_glds16((const void*)(g), (void*)(l))
#define WAIT_V(n) ((void)0)
#define WAIT_L(n) ((void)0)
#define BAR() __syncthreads()
#define SCHED() ((void)0)
#define SETPRIO(n) ((void)0)
#define FAST_EXP2(x) exp2f(x)
#define SHX(v, M) __shfl_xor(v, M)
#define FAST_LOG2(x) log2f(x)
#define FAST_RCP(x) (1.f / (x))
static inline unsigned pack2(float lo, float hi) {
    unsigned a = __builtin_bit_cast(unsigned, lo), b = __builtin_bit_cast(unsigned, hi);
    a += 0x7fffu + ((a >> 16) & 1u); b += 0x7fffu + ((b >> 16) & 1u);
    return (a >> 16) | (b & 0xffff0000u);
}
#endif
__device__ __forceinline__ bf16_t f2bf(float f) { return (bf16_t)(pack2(f, 0.f) & 0xffffu); }
__device__ __forceinline__ float bf2f(bf16_t h) { return __builtin_bit_cast(float, (unsigned)h << 16); }

#define XB_TMO      128
#define XB_XCNT(j)  (256  + 64 * (j))
#define XB_XSUB(j)  (1280 + 64 * (j))
#define XB_XGEN(j)  (2304 + 64 * (j))
#define XB_TOP      3328
#define XB_TOPGEN   3392
#define XCD_BAR_WORDS 3456
#define XB_SPIN_CAP (1u << 22)
#define XB_SPIN(cond, bar) do { unsigned _sp = 0; while (cond) { SLEEP1(); \
    if ((++_sp & 255u) == 0u) { if (xb_ld(&(bar)[XB_TMO])) break; if (_sp > XB_SPIN_CAP) { xb_add(&(bar)[XB_TMO], 1u); break; } } } } while (0)

struct XcdBarrier { unsigned* bar; unsigned x; volatile LAS unsigned* st; };

__device__ __forceinline__ XcdBarrier xcd_barrier_post(unsigned* bar, volatile LAS unsigned* st) {
    XcdBarrier b; b.bar = bar; b.x = xb_xcc_id(); b.st = st;
    if (threadIdx.x == 0) (void)xb_add(&bar[XB_XCNT(b.x)], 1u);
    return b;
}
__device__ __forceinline__ void xcd_barrier_complete(unsigned* bar, unsigned x, unsigned& nloc, unsigned& nx) {
    const unsigned G = gridDim.x;
    unsigned sum, cnt, mine, sp = 0u;
    for (;;) {
        sum = 0u; cnt = 0u; mine = 0u;
#pragma unroll
        for (unsigned j = 0; j < 16; ++j) { const unsigned c = xb_ld(&bar[XB_XCNT(j)]); sum += c; cnt += (c > 0u) ? 1u : 0u; mine = (j == x) ? c : mine; }
        if (sum == G) break;
        SLEEP1();
        if ((++sp & 255u) == 0u) { if (xb_ld(&bar[XB_TMO])) break; if (sp > XB_SPIN_CAP) { xb_add(&bar[XB_TMO], 1u); break; } }
    }
    nloc = mine > 0u ? mine : 1u; nx = cnt > 0u ? cnt : 1u;
}
__device__ __forceinline__ void xcd_barrier(const XcdBarrier& b, bool leader) {
    WAIT_VM0();
    __syncthreads();
    if (leader) {
        unsigned* bar = b.bar;
        WAIT_ALL0();
        unsigned nloc = b.st[0], nx = b.st[1];
        if (nloc == 0u) { xcd_barrier_complete(bar, b.x, nloc, nx); b.st[0] = nloc; b.st[1] = nx; }
        const unsigned old = xb_add(&bar[XB_XSUB(b.x)], 1u);
        const unsigned gen = old / nloc;
        if (old + 1u == (gen + 1u) * nloc) {
            FENCE_REL_AGENT();
            WAIT_VM0();
            const unsigned og = xb_add(&bar[XB_TOP], 1u);
            const unsigned tg = og / nx;
            if (og + 1u == (tg + 1u) * nx) xb_add(&bar[XB_TOPGEN], 1u);
            else XB_SPIN(xb_ld(&bar[XB_TOPGEN]) == tg, bar);
            FENCE_ACQ_AGENT();
            xb_add(&bar[XB_XGEN(b.x)], 1u);
            WAIT_VM0();
        } else {
            XB_SPIN(xb_ld(&bar[XB_XGEN(b.x)]) == gen, bar);
            FENCE_ACQ_AGENT();
            WAIT_VM0();
        }
    }
    __syncthreads();
}

__device__ __forceinline__ float wave_sum_l(float v, int lane) {
    v += SHX(v, 1); v += SHX(v, 2); v += SHX(v, 4); v += SHX(v, 8); v += SHX(v, 16); v += SHX(v, 32);
    return v;
}
#define wave_sum(v) wave_sum_l(v, lane)
__device__ __forceinline__ float fexp(float x) { return FAST_EXP2(x * LOG2E); }
__device__ __forceinline__ float sigmoid_f(float x) { return FAST_RCP(1.f + fexp(-x)); }
__device__ __forceinline__ float log_sigmoid_f(float x) { return fminf(x, 0.f) - 0.6931471805599453f * FAST_LOG2(1.f + fexp(-fabsf(x))); }
__device__ __forceinline__ float gelu_tanh_f(float x) { const float u = 0.7978845608028654f * (x + 0.044715f * x * x * x); return x * FAST_RCP(1.f + fexp(-2.f * u)); }
__device__ __forceinline__ float silu_f(float x) { return x * FAST_RCP(1.f + fexp(-x)); }
__device__ __forceinline__ float neg_expm1_f(float x) {
    const float ser = -x * (1.f + x * (0.5f + x * (0.16666667f + x * (0.041666668f + x * (0.008333334f + x * 0.0013888889f)))));
    return (x > -0.35f) ? ser : (1.f - fexp(x));
}

struct RmIdent { __device__ __forceinline__ int operator()(int n) const { return n; } };
struct RmWin { __device__ __forceinline__ int operator()(int n) const { return n < C_FA ? n : (n < C_FA + 6 ? -1 : n - 6); } };
struct RmGu { int kind; __device__ __forceinline__ int operator()(int f) const { return (f >> 7) * 256 + ((f >> 6) & 1) * 128 + ((f >> 4) & 3) * 32 + kind * 16 + (f & 15); } };
struct RmOff { int off; __device__ __forceinline__ int operator()(int n) const { return n + off; } };

template <class RM>
__device__ __forceinline__ void convert_tile(const float* src, int ld, int K, int Nsrc, int k0, int n0, bf16_t* dst, const RM& rm, float* T, int tid) {
    {
        const int nn = tid & 255, kh = (tid >> 8) * 32, n = n0 + nn;
        const float* sp = src + (size_t)(k0 + kh) * ld + n;
        float v[32];
#pragma unroll
        for (int i = 0; i < 32; ++i) v[i] = (n < Nsrc) ? sp[(size_t)i * ld] : 0.f;
#pragma unroll
        for (int i = 0; i < 32; ++i) T[(kh + i) * 257 + nn] = v[i];
    }
    __syncthreads();
#pragma unroll
    for (int q = 0; q < 4; ++q) {
        const int nn = q * 64 + (tid >> 3), kc = (tid & 7) * 8, n = n0 + nn;
        const int row = (n < Nsrc) ? rm(n) : -1;
        if (row >= 0) {
            u32x4 o;
            o.x = pack2(T[(kc + 0) * 257 + nn], T[(kc + 1) * 257 + nn]); o.y = pack2(T[(kc + 2) * 257 + nn], T[(kc + 3) * 257 + nn]);
            o.z = pack2(T[(kc + 4) * 257 + nn], T[(kc + 5) * 257 + nn]); o.w = pack2(T[(kc + 6) * 257 + nn], T[(kc + 7) * 257 + nn]);
            *(u32x4*)(dst + (size_t)row * K + k0 + kc) = o;
        }
    }
    __syncthreads();
}
template <class RM>
__device__ __forceinline__ void convert_mats(const float* src, size_t sstride, int nmat, int ld, int K, int Nsrc, bf16_t* dst, size_t dstride, const RM& rm,
                                             float* T, int tid, int bid, int G) {
    const int tk = K / 64, tn = (Nsrc + 255) / 256, per = tk * tn, total = nmat * per;
    for (int t = bid; t < total; t += G) {
        const int mi = t / per, r = t % per;
        convert_tile(src + (size_t)mi * sstride, ld, K, Nsrc, (r / tn) * 64, (r % tn) * 256, dst + (size_t)mi * dstride, rm, T, tid);
    }
}

constexpr int NCONV = DEPTH * 768;
__device__ __forceinline__ void moe_conv_chunk(const Params& p, int cid, bf16_t* WguT_, bf16_t* WdT_, float* T, int tid) {
    const int l = cid / 768, r = cid % 768, kind = r >> 8, t0 = (r & 255) * 8;
    for (int t = t0; t < t0 + 8; ++t) {
        const int mi = t >> 6, rr = t & 63;
        if (kind < 2) {
            const float* src = p.in[kind == 0 ? I_WGATE : I_WUP] + ((size_t)l * NEXP + mi) * D * DFF;
            convert_tile(src, DFF, D, DFF, (rr >> 1) * 64, (rr & 1) * 256, WguT_ + ((size_t)l * NEXP + mi) * 1024 * D, RmGu{kind}, T, tid);
        } else {
            const float* src = p.in[I_WDOWN] + ((size_t)l * NEXP + mi) * DFF * D;
            convert_tile(src, D, DFF, D, (rr >> 3) * 64, (rr & 7) * 256, WdT_ + ((size_t)l * NEXP + mi) * D * DFF, RmIdent{}, T, tid);
        }
    }
}

constexpr int BK = 64, HTB = 128 * 64 * 2;
__device__ __forceinline__ int lds_byte(int r, int c) {
    const int st = (r >> 4) * 2 + (c >> 5), rr = r & 15, cc = c & 31, ob = rr * 64 + cc * 2;
    return st * 1024 + (ob ^ (((ob >> 9) & 1) << 5));
}
__device__ __forceinline__ void stage_rc(int b, int& R, int& C) {
    const int st = b / 1024, sb = b % 1024, swz = sb ^ (((sb >> 9) & 1) << 5);
    R = (st >> 1) * 16 + swz / 64; C = (st & 1) * 32 + (swz % 64) / 2;
}
template <bool GATHER>
__device__ __forceinline__ void gemm_tile(const bf16_t* A, int arow0, const unsigned (&aoff)[2][2], const bf16_t* Bt, int brow0, int K,
                                          unsigned char* shm, f32x4 (&acc)[2][2][4][2], int tid_in) {
    int tid = tid_in; OPAQUE(tid);
    unsigned toff; { int R0, C0; stage_rc(tid * 16, R0, C0); toff = (unsigned)(R0 * K + C0); }
#define SA(b, h) (shm + ((b) * 2 + (h)) * HTB)
#define SB(b, h) (shm + (4 + (b) * 2 + (h)) * HTB)
#define STAGE_B(P, h, kt) do { _Pragma("unroll") for (int _i = 0; _i < 2; ++_i) GLDS16(Bt + ((size_t)(brow0 + (h) * 128 + _i * 64) * K + (size_t)(kt) * BK) + toff, (P) + tid * 16 + _i * 8192); } while (0)
#define STAGE_A(P, h, kt) do { _Pragma("unroll") for (int _i = 0; _i < 2; ++_i) { \
    if (GATHER) GLDS16(A + (size_t)(kt) * BK + aoff[h][_i], (P) + tid * 16 + _i * 8192); \
    else GLDS16(A + ((size_t)(arow0 + (h) * 128 + _i * 64) * K + (size_t)(kt) * BK) + toff, (P) + tid * 16 + _i * 8192); } } while (0)
#define LDA(dst, b, h) _Pragma("unroll") for (int m = 0; m < 4; ++m) _Pragma("unroll") for (int k = 0; k < 2; ++k) \
    dst[m][k] = *reinterpret_cast<const bf16x8*>(SA(b, h) + lds_byte(wr * 64 + m * 16 + fr, k * 32 + fq * 8))
#define LDB(dst, b, h) _Pragma("unroll") for (int n = 0; n < 2; ++n) _Pragma("unroll") for (int k = 0; k < 2; ++k) \
    dst[n][k] = *reinterpret_cast<const bf16x8*>(SB(b, h) + lds_byte(wc * 32 + n * 16 + fr, k * 32 + fq * 8))
#define MMA(ai, bj, At, Bx) do { SETPRIO(1); \
    _Pragma("unroll") for (int m = 0; m < 4; ++m) _Pragma("unroll") for (int n = 0; n < 2; ++n) _Pragma("unroll") for (int k = 0; k < 2; ++k) \
      acc[ai][bj][m][n] = MFMA16(At[m][k], Bx[n][k], acc[ai][bj][m][n]); \
    SETPRIO(0); } while (0)
    int wid = tid >> 6, lane = tid & 63, wr = wid >> 2, wc = wid & 3, fr = lane & 15, fq = lane >> 4;
#pragma unroll
    for (int a = 0; a < 2; ++a)
#pragma unroll
        for (int b = 0; b < 2; ++b)
#pragma unroll
            for (int m = 0; m < 4; ++m)
#pragma unroll
                for (int n = 0; n < 2; ++n) acc[a][b][m][n] = (f32x4){0.f, 0.f, 0.f, 0.f};
    bf16x8 At[4][2], B0[2][2], B1[2][2];
    const int nt = K / BK;
    STAGE_B(SB(0, 0), 0, 0); STAGE_A(SA(0, 0), 0, 0);
    STAGE_B(SB(0, 1), 1, 0); STAGE_A(SA(0, 1), 1, 0);
    if (wr == 1) BAR();
    WAIT_V(4); BAR();
    STAGE_B(SB(1, 0), 0, 1); STAGE_A(SA(1, 0), 0, 1); STAGE_B(SB(1, 1), 1, 1);
    WAIT_V(6); BAR();
    for (int t = 0; t < nt - 2; t += 2) {
        LDB(B0, 0, 0); SCHED(); LDA(At, 0, 0); STAGE_A(SA(1, 1), 1, t + 1);
        WAIT_L(8); BAR(); WAIT_L(0); MMA(0, 0, At, B0); BAR(); SCHED();
        LDB(B1, 0, 1); STAGE_B(SB(0, 0), 0, t + 2);
        BAR(); WAIT_L(0); MMA(0, 1, At, B1); BAR();
        LDA(At, 0, 1); STAGE_A(SA(0, 0), 0, t + 2);
        BAR(); WAIT_L(0); MMA(1, 0, At, B0); BAR(); SCHED();
        STAGE_B(SB(0, 1), 1, t + 2);
        WAIT_V(6); BAR(); MMA(1, 1, At, B1); BAR();
        LDB(B0, 1, 0); SCHED(); LDA(At, 1, 0); STAGE_A(SA(0, 1), 1, t + 2);
        WAIT_L(8); BAR(); WAIT_L(0); MMA(0, 0, At, B0); BAR(); SCHED();
        LDB(B1, 1, 1); STAGE_B(SB(1, 0), 0, t + 3);
        BAR(); WAIT_L(0); MMA(0, 1, At, B1); BAR();
        LDA(At, 1, 1); STAGE_A(SA(1, 0), 0, t + 3);
        BAR(); WAIT_L(0); MMA(1, 0, At, B0); BAR(); SCHED();
        STAGE_B(SB(1, 1), 1, t + 3);
        WAIT_V(6); BAR(); MMA(1, 1, At, B1); BAR();
    }
    OPAQUE(tid); wid = tid >> 6; lane = tid & 63; wr = wid >> 2; wc = wid & 3; fr = lane & 15; fq = lane >> 4;
    { LDB(B0, 0, 0); WAIT_V(0); LDA(At, 0, 0); STAGE_A(SA(1, 1), 1, nt - 1);
      BAR(); WAIT_L(0); MMA(0, 0, At, B0); BAR();
      LDB(B1, 0, 1); BAR(); WAIT_L(0); MMA(0, 1, At, B1); BAR();
      LDA(At, 0, 1); WAIT_V(4); BAR(); WAIT_L(0); MMA(1, 0, At, B0); MMA(1, 1, At, B1); BAR(); }
    { LDB(B0, 1, 0); LDA(At, 1, 0); WAIT_V(2); BAR(); WAIT_L(0); MMA(0, 0, At, B0); BAR();
      LDB(B1, 1, 1); WAIT_V(0); BAR(); WAIT_L(0); MMA(0, 1, At, B1); BAR();
      LDA(At, 1, 1); BAR(); WAIT_L(0); MMA(1, 0, At, B0); MMA(1, 1, At, B1); BAR(); }
    if (wr == 0) BAR();
#undef SA
#undef SB
#undef STAGE_A
#undef STAGE_B
#undef LDA
#undef LDB
#undef MMA
}
__device__ __forceinline__ void stage_geom(int tid, int (&R)[2], int (&C)[2]) {
#pragma unroll
    for (int i = 0; i < 2; ++i) stage_rc(tid * 16 + i * 8192, R[i], C[i]);
}

constexpr int ATT_KBUF = 0, ATT_VBUF = 32768, ATT_CBUF = 65536;
template <int KIND>
__device__ __forceinline__ void attn_unit(const bf16_t* Q, const bf16_t* Kg, const bf16_t* VT, const float* cum2, const float* kmx, int qb, bf16_t* concat, int ccol0,
                                          float lam, float osc, const float* subg, unsigned char* lds, int tid) {
    const int lane = tid & 63, wave = tid >> 6, r16 = lane & 15, q4 = lane >> 4;
    const int q0w = qb * 128 + wave * 16, myq = q0w + r16;
    const int ntiles = 2 * qb + 2;
    const int wlimit = (KIND == 0) ? ((q0w + 15) >> 6) : (q0w >> 6);
    constexpr int NMAP = (KIND == 0) ? 1 : 2, NKS = (KIND == 0) ? 4 : 2;
    bf16x8 qf[NMAP][NKS];
#pragma unroll
    for (int mp = 0; mp < NMAP; ++mp)
#pragma unroll
        for (int ks = 0; ks < NKS; ++ks) qf[mp][ks] = *(const bf16x8*)(Q + (size_t)myq * 128 + mp * 64 + ks * 32 + q4 * 8);
    const float cq = (KIND == 0) ? cum2[myq] : 0.f;
    int kt0 = 0;
    if (KIND == 0) {
        float* wmax = (float*)(lds + ATT_CBUF + 512); int* kst = (int*)(lds + ATT_CBUF + 576);
        float qs = 0.f;
#pragma unroll
        for (int ks = 0; ks < NKS; ++ks)
#pragma unroll
            for (int j = 0; j < 8; ++j) { const float v = bf2f((bf16_t)qf[0][ks][j]); qs += v * v; }
        qs += SHX(qs, 16); qs += SHX(qs, 32);
        qs = fmaxf(qs, SHX(qs, 1)); qs = fmaxf(qs, SHX(qs, 2)); qs = fmaxf(qs, SHX(qs, 4)); qs = fmaxf(qs, SHX(qs, 8));
        if (lane == 0) wmax[wave] = qs;
        if (tid == 0) *kst = 2 * qb;
        __syncthreads();
        float qm = wmax[0];
#pragma unroll
        for (int w = 1; w < 8; ++w) qm = fmaxf(qm, wmax[w]);
        qm = sqrtf(qm) * 1.01f;
        const float kd = sqrtf(fmaxf(kmx[2 * qb], kmx[2 * qb + 1])) * 1.01f;
        if (tid < 2 * qb) {
            const float bias = cum2[qb * 128] - cum2[tid * 64 + 63];
            const bool skip = bias + qm * (sqrtf(kmx[tid]) * 1.01f + kd) < -40.f;
            if (!skip) atomic_min_int(kst, tid);
        }
        __syncthreads();
        kt0 = RFL(*kst);
    }
    f32x4 ot[NMAP][8];
    float mrun[NMAP], lsum[NMAP];
#pragma unroll
    for (int mp = 0; mp < NMAP; ++mp) { mrun[mp] = -INFINITY; lsum[mp] = 0.f;
#pragma unroll
        for (int mo = 0; mo < 8; ++mo) ot[mp][mo] = (f32x4){0.f, 0.f, 0.f, 0.f}; }
    u32x4 sk[2], sv[2]; float sc = 0.f;
    const u32x4* kg = (const u32x4*)Kg; const u32x4* vg = (const u32x4*)VT;
#pragma unroll
    for (int i = 0; i < 2; ++i) { sk[i] = kg[(size_t)kt0 * 1024 + tid + i * 512]; sv[i] = vg[(size_t)kt0 * 1024 + tid + i * 512]; }
    if (KIND == 0 && tid < 64) sc = cum2[kt0 * 64 + tid];
    for (int kt = kt0; kt < ntiles; ++kt) {
        unsigned char* kb = lds + ATT_KBUF + (kt & 1) * 16384;
        unsigned char* vb = lds + ATT_VBUF + (kt & 1) * 16384;
        float* cb = (float*)(lds + ATT_CBUF + (kt & 1) * 256);
#pragma unroll
        for (int i = 0; i < 2; ++i) {
            const int g = tid + i * 512;
            { const int row = g >> 4, c = g & 15; *(u32x4*)(kb + row * 256 + ((c ^ (row & 15)) << 4)) = sk[i]; }
            { const int d = g >> 3, c = g & 7; *(u32x4*)(vb + d * 128 + ((c ^ ((d >> 1) & 7)) << 4)) = sv[i]; }
        }
        if (KIND == 0 && tid < 64) cb[tid] = sc;
        __syncthreads();
        if (kt + 1 < ntiles) {
#pragma unroll
            for (int i = 0; i < 2; ++i) { sk[i] = kg[(size_t)(kt + 1) * 1024 + tid + i * 512]; sv[i] = vg[(size_t)(kt + 1) * 1024 + tid + i * 512]; }
            if (KIND == 0 && tid < 64) sc = cum2[(kt + 1) * 64 + tid];
        }
        if (kt <= wlimit) {
#pragma unroll
            for (int mp = 0; mp < NMAP; ++mp) {
                bf16x8 kf[4][NKS], vfa[8];
#pragma unroll
                for (int m = 0; m < 4; ++m)
#pragma unroll
                    for (int ks = 0; ks < NKS; ++ks) { const int c = (KIND == 0 ? 0 : mp * 8) + ks * 4 + q4; kf[m][ks] = *(const bf16x8*)(kb + (m * 16 + r16) * 256 + ((c ^ r16) << 4)); }
#pragma unroll
                for (int mo = 0; mo < 8; ++mo) { const int d = mo * 16 + r16; vfa[mo] = *(const bf16x8*)(vb + d * 128 + (((0 * 4 + q4) ^ ((d >> 1) & 7)) << 4)); }
                SCHED();
                f32x4 st[4];
#pragma unroll
                for (int m = 0; m < 4; ++m) st[m] = (f32x4){0.f, 0.f, 0.f, 0.f};
#pragma unroll
                for (int ks = 0; ks < NKS; ++ks)
#pragma unroll
                    for (int m = 0; m < 4; ++m) st[m] = MFMA16(kf[m][ks], qf[mp][ks], st[m]);
                SCHED();
                float mx = -INFINITY;
#pragma unroll
                for (int m = 0; m < 4; ++m) {
                    if (KIND == 0) {
                        const f32x4 ck = *(const f32x4*)(cb + m * 16 + 4 * q4);
#pragma unroll
                        for (int j = 0; j < 4; ++j) {
                            float y = st[m][j] + (cq - ck[j]);
                            if (kt * 64 + m * 16 + 4 * q4 + j > myq) y = -INFINITY;
                            st[m][j] = y;
                        }
                    }
#pragma unroll
                    for (int j = 0; j < 4; ++j) mx = fmaxf(mx, st[m][j]);
                }
                mx = fmaxf(mx, SHX(mx, 16));
                mx = fmaxf(mx, SHX(mx, 32));
                const float mnew = fmaxf(mrun[mp], mx);
                const float alpha = FAST_EXP2(mrun[mp] - mnew);
                mrun[mp] = mnew;
                float ps = 0.f;
#pragma unroll
                for (int m = 0; m < 4; ++m)
#pragma unroll
                    for (int j = 0; j < 4; ++j) { const float pv = FAST_EXP2(st[m][j] - mnew); st[m][j] = pv; ps += pv; }
                lsum[mp] = lsum[mp] * alpha + ps;
#pragma unroll
                for (int mo = 0; mo < 8; ++mo) ot[mp][mo] *= alpha;
                bf16x8 pf[2];
#pragma unroll
                for (int kk = 0; kk < 2; ++kk) {
                    u32x4 pw;
                    pw.x = pack2(st[2 * kk][0], st[2 * kk][1]); pw.y = pack2(st[2 * kk][2], st[2 * kk][3]);
                    pw.z = pack2(st[2 * kk + 1][0], st[2 * kk + 1][1]); pw.w = pack2(st[2 * kk + 1][2], st[2 * kk + 1][3]);
                    pf[kk] = __builtin_bit_cast(bf16x8, pw);
                }
                bf16x8 vfb[8];
#pragma unroll
                for (int mo = 0; mo < 8; ++mo) { const int d = mo * 16 + r16; vfb[mo] = *(const bf16x8*)(vb + d * 128 + (((1 * 4 + q4) ^ ((d >> 1) & 7)) << 4)); }
                SCHED();
#pragma unroll
                for (int mo = 0; mo < 8; ++mo) ot[mp][mo] = MFMA16(vfa[mo], pf[0], ot[mp][mo]);
                SCHED();
#pragma unroll
                for (int mo = 0; mo < 8; ++mo) ot[mp][mo] = MFMA16(vfb[mo], pf[1], ot[mp][mo]);
            }
        }
    }
    float inv[NMAP];
#pragma unroll
    for (int mp = 0; mp < NMAP; ++mp) { float l = lsum[mp]; l += SHX(l, 16); l += SHX(l, 32); inv[mp] = 1.f / l; }
    if (KIND == 0) {
#pragma unroll
        for (int mo = 0; mo < 8; ++mo) {
            u32x2 o; o.x = pack2(ot[0][mo][0] * inv[0], ot[0][mo][1] * inv[0]); o.y = pack2(ot[0][mo][2] * inv[0], ot[0][mo][3] * inv[0]);
            *(u32x2*)(concat + (size_t)myq * D + ccol0 + mo * 16 + 4 * q4) = o;
        }
    } else {
        float ss = 0.f;
#pragma unroll
        for (int mo = 0; mo < 8; ++mo)
#pragma unroll
            for (int j = 0; j < 4; ++j) { const float v = ot[0][mo][j] * inv[0] - lam * (ot[NMAP - 1][mo][j] * inv[NMAP - 1]); ot[0][mo][j] = v; ss += v * v; }
        ss += SHX(ss, 16); ss += SHX(ss, 32);
        const float rs = osc / sqrtf(ss * (1.f / 128.f) + LN_EPS);
#pragma unroll
        for (int mo = 0; mo < 8; ++mo) {
            const f32x4 g = *(const f32x4*)(subg + mo * 16 + 4 * q4);
            u32x2 o; o.x = pack2(ot[0][mo][0] * rs * g[0], ot[0][mo][1] * rs * g[1]); o.y = pack2(ot[0][mo][2] * rs * g[2], ot[0][mo][3] * rs * g[3]);
            *(u32x2*)(concat + (size_t)myq * D + ccol0 + mo * 16 + 4 * q4) = o;
        }
    }
    __syncthreads();
}

__device__ __forceinline__ int dpart_row(int c, int q) { return c * (S - DCH * 64) - (DCH * 32) * c * (c - 1) + q; }
__device__ __forceinline__ void attn_dmap_unit(const bf16_t* Qh, const bf16_t* Kh, const bf16_t* VTh, int mp, int qb, int t0, int t1,
                                               bf16_t* Op, float* ML, int c, unsigned char* lds, int tid) {
    const int lane = tid & 63, wave = tid >> 6, r16 = lane & 15, q4 = lane >> 4;
    const int q0w = qb * 256 + wave * 32;
    const int wlimit = q0w >> 6;
    bf16x8 qf[2][2];
#pragma unroll
    for (int n = 0; n < 2; ++n)
#pragma unroll
        for (int ks = 0; ks < 2; ++ks) qf[n][ks] = *(const bf16x8*)(Qh + (size_t)(q0w + n * 16 + r16) * 128 + mp * 64 + ks * 32 + q4 * 8);
    f32x4 ot[8][2];
    float mrun[2] = {-INFINITY, -INFINITY}, lsum[2] = {0.f, 0.f};
#pragma unroll
    for (int mo = 0; mo < 8; ++mo) { ot[mo][0] = (f32x4){0.f, 0.f, 0.f, 0.f}; ot[mo][1] = (f32x4){0.f, 0.f, 0.f, 0.f}; }
    u32x4 sk, sv[2];
    const u32x4* kg = (const u32x4*)Kh; const u32x4* vg = (const u32x4*)VTh;
    const int krow = tid >> 3, kc8 = tid & 7;
    sk = kg[(size_t)t0 * 1024 + krow * 16 + mp * 8 + kc8];
#pragma unroll
    for (int i = 0; i < 2; ++i) sv[i] = vg[(size_t)t0 * 1024 + tid + i * 512];
    for (int kt = t0; kt < t1; ++kt) {
        unsigned char* kb = lds + (kt & 1) * 8192;
        unsigned char* vb = lds + 16384 + (kt & 1) * 16384;
        *(u32x4*)(kb + krow * 128 + ((kc8 ^ ((krow >> 1) & 7)) << 4)) = sk;
#pragma unroll
        for (int i = 0; i < 2; ++i) { const int g = tid + i * 512, d = g >> 3, cc = g & 7; *(u32x4*)(vb + d * 128 + ((cc ^ ((d >> 1) & 7)) << 4)) = sv[i]; }
        __syncthreads();
        if (kt + 1 < t1) {
            sk = kg[(size_t)(kt + 1) * 1024 + krow * 16 + mp * 8 + kc8];
#pragma unroll
            for (int i = 0; i < 2; ++i) sv[i] = vg[(size_t)(kt + 1) * 1024 + tid + i * 512];
        }
        if (kt <= wlimit) {
            bf16x8 kf[4][2], vfa[8];
#pragma unroll
            for (int m = 0; m < 4; ++m)
#pragma unroll
                for (int ks = 0; ks < 2; ++ks) kf[m][ks] = *(const bf16x8*)(kb + (m * 16 + r16) * 128 + (((ks * 4 + q4) ^ ((r16 >> 1) & 7)) << 4));
#pragma unroll
            for (int mo = 0; mo < 8; ++mo) { const int d = mo * 16 + r16; vfa[mo] = *(const bf16x8*)(vb + d * 128 + (((0 * 4 + q4) ^ ((d >> 1) & 7)) << 4)); }
            SCHED();
            f32x4 st[4][2];
#pragma unroll
            for (int m = 0; m < 4; ++m) { st[m][0] = (f32x4){0.f, 0.f, 0.f, 0.f}; st[m][1] = (f32x4){0.f, 0.f, 0.f, 0.f}; }
#pragma unroll
            for (int ks = 0; ks < 2; ++ks)
#pragma unroll
                for (int m = 0; m < 4; ++m) { st[m][0] = MFMA16(kf[m][ks], qf[0][ks], st[m][0]); st[m][1] = MFMA16(kf[m][ks], qf[1][ks], st[m][1]); }
            SCHED();
            float alpha[2];
#pragma unroll
            for (int n = 0; n < 2; ++n) {
                float mx = -INFINITY;
#pragma unroll
                for (int m = 0; m < 4; ++m)
#pragma unroll
                    for (int j = 0; j < 4; ++j) mx = fmaxf(mx, st[m][n][j]);
                mx = fmaxf(mx, SHX(mx, 16));
                mx = fmaxf(mx, SHX(mx, 32));
                const float mnew = fmaxf(mrun[n], mx);
                alpha[n] = FAST_EXP2(mrun[n] - mnew);
                mrun[n] = mnew;
                float ps = 0.f;
#pragma unroll
                for (int m = 0; m < 4; ++m)
#pragma unroll
                    for (int j = 0; j < 4; ++j) { const float pv = FAST_EXP2(st[m][n][j] - mnew); st[m][n][j] = pv; ps += pv; }
                lsum[n] = lsum[n] * alpha[n] + ps;
            }
            if (ANY_LANE(alpha[0] != 1.f)) {
#pragma unroll
                for (int mo = 0; mo < 8; ++mo) ot[mo][0] *= alpha[0];
            }
            if (ANY_LANE(alpha[1] != 1.f)) {
#pragma unroll
                for (int mo = 0; mo < 8; ++mo) ot[mo][1] *= alpha[1];
            }
            bf16x8 pf[2][2];
#pragma unroll
            for (int kk = 0; kk < 2; ++kk)
#pragma unroll
                for (int n = 0; n < 2; ++n) {
                    u32x4 pw;
                    pw.x = pack2(st[2 * kk][n][0], st[2 * kk][n][1]); pw.y = pack2(st[2 * kk][n][2], st[2 * kk][n][3]);
                    pw.z = pack2(st[2 * kk + 1][n][0], st[2 * kk + 1][n][1]); pw.w = pack2(st[2 * kk + 1][n][2], st[2 * kk + 1][n][3]);
                    pf[kk][n] = __builtin_bit_cast(bf16x8, pw);
                }
            bf16x8 vfb[8];
#pragma unroll
            for (int mo = 0; mo < 8; ++mo) { const int d = mo * 16 + r16; vfb[mo] = *(const bf16x8*)(vb + d * 128 + (((1 * 4 + q4) ^ ((d >> 1) & 7)) << 4)); }
            SCHED();
#pragma unroll
            for (int mo = 0; mo < 8; ++mo) { ot[mo][0] = MFMA16(vfa[mo], pf[0][0], ot[mo][0]); ot[mo][1] = MFMA16(vfa[mo], pf[0][1], ot[mo][1]); }
            SCHED();
#pragma unroll
            for (int mo = 0; mo < 8; ++mo) { ot[mo][0] = MFMA16(vfb[mo], pf[1][0], ot[mo][0]); ot[mo][1] = MFMA16(vfb[mo], pf[1][1], ot[mo][1]); }
        }
    }
    if (q0w >= DCH * 64 * c)
#pragma unroll
    for (int n = 0; n < 2; ++n) {
        float l = lsum[n]; l += SHX(l, 16); l += SHX(l, 32);
        const int row = dpart_row(c, q0w + n * 16 + r16);
#pragma unroll
        for (int mo = 0; mo < 8; ++mo) {
            u32x2 o; o.x = pack2(ot[mo][n][0], ot[mo][n][1]); o.y = pack2(ot[mo][n][2], ot[mo][n][3]);
            *(u32x2*)(Op + (size_t)(row * 128 + mo * 16 + 4 * q4)) = o;
        }
        if (q4 == 0) { ML[row * 2] = mrun[n]; ML[row * 2 + 1] = l; }
    }
    __syncthreads();
}

__device__ __forceinline__ void lru_unit_a(int chunk, int grp, int l, const Params& p, const bf16_t* Xr, const bf16_t* WaiT, float* hloc, float* ploc, float* sumA, float* sumH,
                                           unsigned char* lds, int tid) {
    const int lane = tid & 63, wave = tid >> 6, r16 = lane & 15, q4 = lane >> 4;
    unsigned char* XCB = lds; float* XU = (float*)(lds + 16384); float* LA = (float*)(lds + 49152); float* ENDS = (float*)(lds + 81920);
    const int t0 = chunk * 64, ch0 = grp * 128;
    {
        const int c = tid & 127, tq = tid >> 7, ch = ch0 + c;
        const float* cw = p.in[I_CONVW] + (size_t)l * 4 * LRU_W + ch; const float cb = p.in[I_CONVB][(size_t)l * LRU_W + ch];
        const float w0 = cw[0], w1 = cw[LRU_W], w2 = cw[2 * LRU_W], w3 = cw[3 * LRU_W];
        const int ts = t0 + tq * 16;
        float x0 = (ts - 3 >= 0) ? bf2f(Xr[(size_t)(ts - 3) * LRU_W + ch]) : 0.f;
        float x1 = (ts - 2 >= 0) ? bf2f(Xr[(size_t)(ts - 2) * LRU_W + ch]) : 0.f;
        float x2 = (ts - 1 >= 0) ? bf2f(Xr[(size_t)(ts - 1) * LRU_W + ch]) : 0.f;
#pragma unroll
        for (int i = 0; i < 16; ++i) {
            const float x3 = bf2f(Xr[(size_t)(ts + i) * LRU_W + ch]);
            const float v = cb + w0 * x0 + w1 * x1 + w2 * x2 + w3 * x3;
            const int row = tq * 16 + i;
            XU[row * 128 + c] = v;
            *(bf16_t*)(XCB + row * 256 + (((c >> 3) ^ (row & 15)) << 4) + (c & 7) * 2) = f2bf(v);
            x0 = x1; x1 = x2; x2 = x3;
        }
    }
    __syncthreads();
    {
        bf16x8 bfr[2][4];
#pragma unroll
        for (int g = 0; g < 2; ++g)
#pragma unroll
            for (int ks = 0; ks < 4; ++ks) bfr[g][ks] = *(const bf16x8*)(WaiT + ((size_t)grp * 256 + g * 128 + wave * 16 + r16) * 128 + ks * 32 + q4 * 8);
        const int ch = ch0 + wave * 16 + r16;
        const float ba = p.in[I_BA][(size_t)l * LRU_W + ch], bi = p.in[I_BI][(size_t)l * LRU_W + ch];
        const float lsl = 8.0f * log_sigmoid_f(p.in[I_LAM][(size_t)l * LRU_W + ch]);
#pragma unroll
        for (int mt = 0; mt < 4; ++mt) {
            f32x4 ga = (f32x4){0.f, 0.f, 0.f, 0.f}, gi = (f32x4){0.f, 0.f, 0.f, 0.f};
#pragma unroll
            for (int ks = 0; ks < 4; ++ks) {
                const bf16x8 af = *(const bf16x8*)(XCB + (mt * 16 + r16) * 256 + (((ks * 4 + q4) ^ r16) << 4));
                ga = MFMA16(af, bfr[0][ks], ga); gi = MFMA16(af, bfr[1][ks], gi);
            }
#pragma unroll
            for (int j = 0; j < 4; ++j) {
                const int row = mt * 16 + 4 * q4 + j, idx = row * 128 + wave * 16 + r16;
                const float r = sigmoid_f(ga[j] + ba), ig = sigmoid_f(gi[j] + bi);
                const float log_a = lsl * r;
                LA[idx] = fexp(log_a);
                XU[idx] = sqrtf(neg_expm1_f(2.f * log_a)) * (ig * XU[idx]);
            }
        }
    }
    __syncthreads();
    {
        const int c = tid & 127, tq = tid >> 7, ch = ch0 + c;
        float h = 0.f, P = 1.f;
#pragma unroll
        for (int i = 0; i < 16; ++i) { const int idx = (tq * 16 + i) * 128 + c; const float a = LA[idx]; h = a * h + XU[idx]; P *= a; XU[idx] = h; LA[idx] = P; }
        ENDS[tq * 128 + c] = P; ENDS[512 + tq * 128 + c] = h;
        __syncthreads();
        float cin = 0.f, pin = 1.f;
        for (int s = 0; s < tq; ++s) { const float Ps = ENDS[s * 128 + c], hs = ENDS[512 + s * 128 + c]; cin = Ps * cin + hs; pin *= Ps; }
#pragma unroll
        for (int i = 0; i < 16; ++i) {
            const int idx = (tq * 16 + i) * 128 + c; const size_t gi = (size_t)(t0 + tq * 16 + i) * LRU_W + ch;
            const float Pl = LA[idx], hl = XU[idx];
            hloc[gi] = hl + Pl * cin; ploc[gi] = Pl * pin;
        }
        if (tq == 3) { const float Pl = LA[63 * 128 + c], hl = XU[63 * 128 + c]; sumA[(size_t)chunk * LRU_W + ch] = Pl * pin; sumH[(size_t)chunk * LRU_W + ch] = hl + Pl * cin; }
    }
    __syncthreads();
}

__device__ __forceinline__ void moe_prefix(const int* cntb_, int G, unsigned char* lds, int tid) {
    int* tmp = (int*)lds; int* ctot = (int*)(lds + LDS_MISC + M_CTOT); int* coff = (int*)(lds + LDS_MISC + M_COFF);
    unsigned short* pre16 = (unsigned short*)(lds + LDS_MISC + M_PRE16);
    const int e = tid & 31, part = tid >> 5, PB = (G + 15) / 16;
    int sm = 0;
    for (int i = 0; i < PB; ++i) { const int b = part * PB + i; if (b < G) sm += cntb_[b * 32 + e]; }
    tmp[part * 32 + e] = sm;
    __syncthreads();
    int run = 0;
    for (int q = 0; q < part; ++q) run += tmp[q * 32 + e];
    for (int i = 0; i < PB; ++i) { const int b = part * PB + i; if (b < G) { pre16[e * 257 + b] = (unsigned short)run; run += cntb_[b * 32 + e]; } }
    if (part == 15) { ctot[e] = run; pre16[e * 257 + G] = (unsigned short)run; }
    __syncthreads();
    if (tid == 0) { int o = 0; for (int q = 0; q < 32; ++q) { coff[q] = o; o += ctot[q]; } coff[32] = o; }
    __syncthreads();
}
__device__ __forceinline__ void moe_rowtable(const int* ltok_, const float* lw_, const int* lslot_, int e, int m0, int c_e, int G, int segcap, unsigned char* lds, int tid_in) {
    int tid = tid_in; OPAQUE(tid);
    const unsigned short* pre = (const unsigned short*)(lds + LDS_MISC + M_PRE16) + e * 257;
    int* rtok = (int*)(lds + LDS_MISC + M_RTOK); float* rw = (float*)(lds + LDS_MISC + M_RW); int* rslot = (int*)(lds + LDS_MISC + M_RSLOT);
    if (tid < 256) {
        const int g = m0 + tid;
        int tk = 0, sl = 0; float w = 0.f;
        if (g < c_e) {
            int lo = 0, hi = G;
            while (hi - lo > 1) { const int mid = (lo + hi) >> 1; if ((int)pre[mid] <= g) lo = mid; else hi = mid; }
            const int idx = (e * G + lo) * segcap + (g - (int)pre[lo]);
            tk = ltok_[idx]; w = lw_[idx]; sl = lslot_[idx];
        }
        rtok[tid] = tk; rw[tid] = w; rslot[tid] = sl;
    }
    __syncthreads();
}
#define kmax2 ((float*)(wsl + A_KMAX))
#define dpo ((bf16_t*)(wsl + A_DPO))
#define dpml ((float*)(wsl + A_DPML))
#define cntb ((int*)(wsl + A_CNTB))
#define WinT ((bf16_t*)(wsl + WB_WIN))
#define WoT ((bf16_t*)(wsl + WB_WO))
#define WguT ((bf16_t*)(wsl + WB_WGU))
#define WdT ((bf16_t*)(wsl + WB_WD))
#define WaiT ((bf16_t*)(wsl + WB_WAI))
#define Wfa ((float*)(wsl + WF_FA))
#define W36b ((bf16_t*)(wsl + WF_R36))
#define ropecs ((float*)(wsl + WF_ROPE))
#define xb ((bf16_t*)(wsl + A_XB))
#define hb ((float*)(wsl + A_HB))
#define logf_ ((float*)(wsl + A_LOGF))
#define cum2 ((float*)(wsl + A_CUM))
#define Qa ((bf16_t*)(wsl + A_QA))
#define Ka ((bf16_t*)(wsl + A_KA))
#define VaT ((bf16_t*)(wsl + A_VAT))
#define Xr ((bf16_t*)(wsl + A_XR))
#define Gr ((bf16_t*)(wsl + A_GR))
#define Qc ((bf16_t*)(wsl + A_QC))
#define Kc ((bf16_t*)(wsl + A_KC))
#define VcT ((bf16_t*)(wsl + A_VCT))
#define hloc ((float*)(wsl + A_HLOC))
#define ploc ((float*)(wsl + A_PLOC))
#define sumA ((float*)(wsl + A_SUMA))
#define sumH ((float*)(wsl + A_SUMH))
#define concat ((bf16_t*)(wsl + A_CONCAT))
#define y1 ((float*)(wsl + A_Y1))
#define h1 ((float*)(wsl + A_H1))
#define h1b ((bf16_t*)(wsl + A_H1B))
#define ltok ((int*)(wsl + A_LTOK))
#define lw ((float*)(wsl + A_LW))
#define lslot ((int*)(wsl + A_LSLOT))
#define act ((bf16_t*)(wsl + A_ACT))
#define contrib ((bf16_t*)(wsl + A_CONTRIB))
#ifndef EMU
__global__ void __launch_bounds__(NTHREADS, 2)
#else
void
#endif
fwd_kernel(Params p) {
    DYN_LDS(lds_raw);
    float* ldsf = (float*)lds_raw;
    const int bid = blockIdx.x, G = gridDim.x;
    const int gthreads = G * NTHREADS, gwaves = G * (NTHREADS / 64);
    const int wave_s = RFL((int)threadIdx.x >> 6);
#define PHASE_IDS() unsigned char* wsl = ws; OPAQUE_S(wsl); int tid = wave_s * 64 + LANE_ID(); OPAQUE(tid); const int lane = tid & 63, wave = tid >> 6, gtid = bid * NTHREADS + tid, gwave = bid * (NTHREADS / 64) + wave; (void)lane; (void)wave; (void)gtid; (void)gwave

    unsigned char* ws = p.ws;
    volatile LAS unsigned* bst = (volatile LAS unsigned*)(lds_raw + LDS_MISC);
    unsigned* ubox = (unsigned*)(lds_raw + LDS_MISC + 16);
    if (threadIdx.x == 0) { bst[0] = 0u; bst[1] = 0u; bst[2] = 0u; bst[3] = 0u; }
    __syncthreads();
    XcdBarrier bar = xcd_barrier_post((unsigned*)ws, bst);

    const int* positions = (const int*)p.in[I_POS];

    constexpr int NPH = 8;
    const int lo = p.lo, hi = p.hi;
#ifdef ONLY_PHASE
#define PH_SEL(c) ((c) == ONLY_PHASE)
#else
#define PH_SEL(c) 1
#endif
#define PH_IN(k) (lo <= (k) && (k) < hi)
#define PH_BAR(k) do { if ((k) + 1 < hi) xcd_barrier(bar, wave_s == 0 && LANE_ID() == 0); } while (0)

    if (PH_SEL(-1) && PH_IN(0)) for (int rep = 0; rep < PH_REPS(-1); ++rep) {
        PHASE_IDS();
        for (int l = 0; l < DEPTH; ++l) {
            convert_mats(p.in[I_WIN] + (size_t)l * D * N_IN, 0, 1, N_IN, D, N_IN, WinT + (size_t)l * N_INP * D, 0, RmWin{}, ldsf, tid, bid, G);
            convert_mats(p.in[I_WO] + (size_t)l * D * D, 0, 1, D, D, D, WoT + (size_t)l * D * D, 0, RmIdent{}, ldsf, tid, bid, G);
            convert_mats(p.in[I_WA] + (size_t)l * 6 * 128 * 128, (size_t)128 * 128, 6, 128, 128, 128, WaiT + (size_t)l * 6 * 256 * 128, (size_t)256 * 128, RmIdent{}, ldsf, tid, bid, G);
            convert_mats(p.in[I_WI] + (size_t)l * 6 * 128 * 128, (size_t)128 * 128, 6, 128, 128, 128, WaiT + (size_t)l * 6 * 256 * 128, (size_t)256 * 128, RmOff{128}, ldsf, tid, bid, G);
        }
        for (int i = gtid; i < DEPTH * 8 * D; i += gthreads) { const int k = i % D, h = (i / D) % 8, l = i / (8 * D);
            Wfa[i] = (h < 6) ? p.in[I_WIN][(size_t)l * D * N_IN + (size_t)k * N_IN + C_FA + h] : 0.f; }
        for (int i = gtid; i < DEPTH * 48 * D; i += gthreads) { const int k = i % D, o = (i / D) % 48, l = i / (48 * D);
            const float w = (o < 4) ? p.in[I_WGRP][((size_t)l * D + k) * 4 + o] : (o < 36 ? p.in[I_WRT][((size_t)l * D + k) * 32 + (o - 4)] : 0.f);
            const bf16_t hi = f2bf(w);
            W36b[((size_t)l * 2 + 0) * 48 * D + (size_t)o * D + k] = hi; W36b[((size_t)l * 2 + 1) * 48 * D + (size_t)o * D + k] = f2bf(w - bf2f(hi)); }
        for (int i = gtid; i < S * 8; i += gthreads) { const int d = i & 7, t = i >> 3; const float ang = (float)positions[t] * p.inv_freq[d];
            ropecs[t * 16 + d] = cosf(ang); ropecs[t * 16 + 8 + d] = sinf(ang); }
        __syncthreads();
        for (int i = tid; i < 6 * D; i += NTHREADS) { const int k = i % D, h = i / D; ldsf[i] = p.in[I_WIN][(size_t)k * N_IN + C_FA + h]; }
        __syncthreads();
        for (int t0 = gwave * 2; t0 < S; t0 += gwaves * 2) {
            f32x4 v[2][8];
#pragma unroll
            for (int tk = 0; tk < 2; ++tk)
#pragma unroll
                for (int j = 0; j < 8; ++j) v[tk][j] = *(const f32x4*)(p.in[I_X] + (size_t)(t0 + tk) * D + j * 256 + lane * 4);
#pragma unroll
            for (int tk = 0; tk < 2; ++tk) {
                const int t = t0 + tk;
                float fa[6] = {0.f, 0.f, 0.f, 0.f, 0.f, 0.f};
#pragma unroll
                for (int j = 0; j < 8; ++j) {
                    const int c = j * 256 + lane * 4;
                    u32x2 o; o.x = pack2(v[tk][j][0], v[tk][j][1]); o.y = pack2(v[tk][j][2], v[tk][j][3]);
                    *(u32x2*)(xb + (size_t)t * D + c) = o;
#pragma unroll
                    for (int h = 0; h < 6; ++h) { const f32x4 w = *(const f32x4*)(ldsf + h * D + c); fa[h] += v[tk][j][0] * w[0] + v[tk][j][1] * w[1] + v[tk][j][2] * w[2] + v[tk][j][3] * w[3]; }
                    COMPILER_FENCE();
                }
#pragma unroll
                for (int h = 0; h < 6; ++h) { const float sm = wave_sum(fa[h]); if (lane == 0) logf_[h * S + t] = log_sigmoid_f(sm + p.in[I_BF][h]); }
            }
        }
        PH_BAR(0);
    }

    for (int l = 0; l < DEPTH; ++l) {
        const int pb = 1 + l * NPH;
#define hin ((l == 0) ? p.in[I_X] : (const float*)hb)
#define hout ((l == DEPTH - 1) ? p.out : hb)
#define workctr ((int*)(wsl + CTL_WORK_OFF) + l * 64)

        if (PH_SEL(0) && PH_IN(pb + 0)) {
            PHASE_IDS();
            int bz = bid; OPAQUE_S(bz);
            if (bz == 0) {
                double* part = (double*)lds_raw;
                const int per = S / 64;
                double s = 0.0;
                if (wave < 6) { for (int i = 0; i < per; ++i) s += (double)logf_[wave * S + lane * per + i]; part[wave * 64 + lane] = s; }
                __syncthreads();
                if (wave < 6) {
                    double run = 0.0;
                    for (int j = 0; j < lane; ++j) run += part[wave * 64 + j];
                    for (int i = 0; i < per; ++i) { run += (double)logf_[wave * S + lane * per + i]; cum2[wave * S + lane * per + i] = (float)(run * (double)LOG2E); }
                }
                __syncthreads();
            }
            bool conv_more = (l == 0);
#define CONV_ONE() do { if (conv_more) { __syncthreads(); if (tid == 0) *ubox = (unsigned)atomic_add_int((int*)(wsl + CTL_WORK_OFF) + 62, 1); __syncthreads(); \
                const int cid_ = RFL((int)*ubox); if (cid_ < NCONV) moe_conv_chunk(p, cid_, WguT, WdT, ldsf, tid); else conv_more = false; } } while (0)
            unsigned* cls = (unsigned*)(wsl + CTL_CLS_OFF) + l * 256;
            if (bz == 0) { WAIT_VM0(); __syncthreads(); if (tid == 0) { FENCE_REL_AGENT(); WAIT_VM0(); (void)xb_add(&cls[192], 1u); } }
            const bf16_t* Bt = WinT + (size_t)l * N_INP * D;
            constexpr int ntm = S / 256;
            const unsigned nooff[2][2] = {{0u, 0u}, {0u, 0u}};
            for (int i = 0; i < (bid & 3); ++i) CONV_ONE();
            for (;;) {
                __syncthreads();
                if (tid == 0) *ubox = (unsigned)atomic_add_int(workctr + 9, 1);
                __syncthreads();
                int t = RFL((int)*ubox);
                if (t >= ntm * 21) break;
                int pm, pn, kcls;
                if (t < ntm * 6) { pm = t / 6; pn = 15 + t % 6; kcls = 0; }
                else if (t < ntm * 12) { t -= ntm * 6; pm = t / 6; pn = 9 + t % 6; kcls = 1; }
                else { t -= ntm * 12; pm = t / 9; pn = t % 9; kcls = 2; }
                f32x4 acc[2][2][4][2];
                gemm_tile<false>(xb, pm * 256, nooff, Bt, pn * 256, D, lds_raw, acc, tid);
                int et = tid; OPAQUE(et); const int wr = et >> 8, wc = (et >> 6) & 3, fr = et & 15, fq = (et >> 4) & 3;
                if (pn < 6 || (pn >= 9 && pn < 19)) {
                    bf16_t* dst; float scale = 1.f; bool rope = false;
                    if (pn < 3) { dst = Qa; scale = QSCALE_A; } else if (pn < 6) { dst = Ka; } else if (pn < 12) { dst = Xr; } else if (pn < 15) { dst = Gr; }
                    else if (pn < 17) { dst = Qc; scale = QSCALE_C; rope = true; } else { dst = Kc; rope = true; }
                    const bool headmajor = (pn < 6) || (pn >= 15);
                    const int segpn = (pn < 3) ? pn : (pn < 6) ? pn - 3 : (pn < 12) ? pn - 9 : (pn < 15) ? pn - 12 : (pn < 17) ? pn - 15 : pn - 17;
#pragma unroll
                    for (int ai = 0; ai < 2; ++ai)
#pragma unroll
                        for (int m = 0; m < 4; ++m)
#pragma unroll
                            for (int bj = 0; bj < 2; ++bj)
#pragma unroll
                                for (int n = 0; n < 2; ++n) {
                                    const int dd = wc * 32 + n * 16 + fr;
#pragma unroll
                                    for (int j = 0; j < 4; ++j) {
                                        const int row = pm * 256 + ai * 128 + wr * 64 + m * 16 + fq * 4 + j;
                                        float v = acc[ai][bj][m][n][j];
                                        if (rope && n == 0 && (wc & 1) == 0) {
                                            const float pv = SHX(v, 8);
                                            const float cs = ropecs[row * 16 + (fr & 7)], sn = ropecs[row * 16 + 8 + (fr & 7)];
                                            v = (fr < 8) ? (v * cs - pv * sn) : (v * cs + pv * sn);
                                        }
                                        v *= scale;
                                        *(bf16_t*)(lds_raw + (ai * 128 + wr * 64 + m * 16 + fq * 4 + j) * 528 + (bj * 128 + dd) * 2) = f2bf(v);
                                    }
                                }
                    __syncthreads();
#pragma unroll 4
                    for (int i = 0; i < 16; ++i) {
                        const int idx = et + i * 512, lrow = idx >> 5, ch = idx & 31, row = pm * 256 + lrow;
                        const u32x4 val = *(const u32x4*)(lds_raw + lrow * 528 + ch * 16);
                        size_t gi;
                        if (headmajor) gi = ((size_t)(segpn * 2 + (ch >> 4)) * S + row) * 128 + (ch & 15) * 8;
                        else gi = (size_t)row * LRU_W + segpn * 256 + ch * 8;
                        *(u32x4*)(dst + gi) = val;
                    }
                    __syncthreads();
                    if (pn >= 3 && pn < 6) {
                        float* part = ldsf;
#pragma unroll
                        for (int ai = 0; ai < 2; ++ai)
#pragma unroll
                            for (int m = 0; m < 4; ++m)
#pragma unroll
                                for (int bj = 0; bj < 2; ++bj)
#pragma unroll
                                    for (int j = 0; j < 4; ++j) {
                                        float ss = acc[ai][bj][m][0][j] * acc[ai][bj][m][0][j] + acc[ai][bj][m][1][j] * acc[ai][bj][m][1][j];
                                        ss += SHX(ss, 1); ss += SHX(ss, 2); ss += SHX(ss, 4); ss += SHX(ss, 8);
                                        if (fr == 0) part[(wc * 2 + bj) * 256 + ai * 128 + wr * 64 + m * 16 + fq * 4 + j] = ss;
                                    }
                        __syncthreads();
                        {
                            const int bj = et >> 8, row = et & 255;
                            float v = part[(0 * 2 + bj) * 256 + row] + part[(1 * 2 + bj) * 256 + row] + part[(2 * 2 + bj) * 256 + row] + part[(3 * 2 + bj) * 256 + row];
                            v = fmaxf(v, SHX(v, 1)); v = fmaxf(v, SHX(v, 2)); v = fmaxf(v, SHX(v, 4)); v = fmaxf(v, SHX(v, 8)); v = fmaxf(v, SHX(v, 16)); v = fmaxf(v, SHX(v, 32));
                            if ((et & 63) == 0) kmax2[((pn - 3) * 2 + bj) * NKT + pm * 4 + ((et >> 6) & 3)] = v;
                        }
                        __syncthreads();
                    }
                } else {
                    bf16_t* dst = (pn < 9) ? VaT : VcT;
                    const int segpn = (pn < 9) ? pn - 6 : pn - 19;
#pragma unroll
                    for (int ai = 0; ai < 2; ++ai)
#pragma unroll
                        for (int m = 0; m < 4; ++m)
#pragma unroll
                            for (int bj = 0; bj < 2; ++bj)
#pragma unroll
                                for (int n = 0; n < 2; ++n) {
                                    const int dd = wc * 32 + n * 16 + fr;
                                    const int row = pm * 256 + ai * 128 + wr * 64 + m * 16 + fq * 4;
                                    const f32x4 a = acc[ai][bj][m][n];
                                    u32x2 o; o.x = pack2(a[0], a[1]); o.y = pack2(a[2], a[3]);
                                    const int s6 = row & 63, pos = (s6 & 32) + ((s6 >> 2) & 3) * 8 + ((s6 >> 4) & 1) * 4;
                                    *(u32x2*)(dst + (((size_t)(segpn * 2 + bj) * NKT + (row >> 6)) * 128 + dd) * 64 + pos) = o;
                                }
                }
                WAIT_VM0();
                __syncthreads();
                if (et == 0) { FENCE_REL_AGENT(); WAIT_VM0(); (void)xb_add(&cls[kcls * 64], 1u); }
                CONV_ONE();
            }
        }

        if (PH_SEL(1) && PH_IN(pb + 1)) {
            PHASE_IDS();
            const float lam_init = (l == 0) ? 0.2f : 0.35550906759f;
            const float s1 = wave_sum(p.in[I_LQ1][l * 64 + lane] * p.in[I_LK1][l * 64 + lane]);
            const float s2 = wave_sum(p.in[I_LQ2][l * 64 + lane] * p.in[I_LK2][l * 64 + lane]);
            const float lam = fexp(s1) - fexp(s2) + lam_init;
            constexpr int NLRU = NKT * 6, NQB = S / 128;
            bool conv_more = (l == 0);
            unsigned* cls = (unsigned*)(wsl + CTL_CLS_OFF) + l * 256;
            unsigned* bw = (unsigned*)wsl;
#define WAIT_CLASS(k, n) do { __syncthreads(); if (tid == 0) { XB_SPIN(xb_ld(&cls[(k) * 64]) < (unsigned)(n), bw); FENCE_ACQ_AGENT(); WAIT_VM0(); } __syncthreads(); } while (0)
#ifndef NO_LRU
            WAIT_CLASS(1, (S / 256) * 6);
            for (;;) {
                __syncthreads();
                if (tid == 0) *ubox = (unsigned)atomic_add_int(workctr + 10, 1);
                __syncthreads();
                const int u = RFL((int)*ubox);
                if (u >= NLRU) break;
                lru_unit_a(u / 6, u % 6, l, p, Xr, WaiT + (size_t)l * 6 * 256 * 128, hloc, ploc, sumA, sumH, lds_raw, tid);
            }
#endif
#ifndef NO_DIFF
            {
                constexpr int NQB2 = S / 256;
                int total = 0;
                for (int q = 0; q < NQB2; ++q) total += ((4 * q + 4 + DCH - 1) / DCH) * 8;
                WAIT_CLASS(0, (S / 256) * 6);
                for (;;) {
                    __syncthreads();
                    if (tid == 0) *ubox = (unsigned)atomic_add_int(workctr, 1);
                    __syncthreads();
                    int u = RFL((int)*ubox);
                    if (u >= total) break;
                    int qb = NQB2 - 1;
                    for (;; --qb) { const int nu = ((4 * qb + 4 + DCH - 1) / DCH) * 8; if (u < nu) break; u -= nu; }
                    const int c = u >> 3, h = (u >> 1) & 3, mp = u & 1;
                    const int t0 = c * DCH, t1 = (t0 + DCH < 4 * qb + 4) ? t0 + DCH : 4 * qb + 4;
                    attn_dmap_unit(Qc + (size_t)h * S * 128, Kc + (size_t)h * S * 128, VcT + (size_t)h * S * 128, mp, qb, t0, t1,
                                   dpo + (size_t)(h * 2 + mp) * DPART_ROWS * 128, dpml + (size_t)(h * 2 + mp) * DPART_ROWS * 2, c, lds_raw, tid);
                    CONV_ONE();
                }
            }
#endif
#ifndef NO_FOX
            WAIT_CLASS(2, (S / 256) * 9);
            WAIT_CLASS(3, 1);
            for (;;) {
                __syncthreads();
                if (tid == 0) *ubox = (unsigned)atomic_add_int(workctr + 1, 1);
                __syncthreads();
                const int u = RFL((int)*ubox);
                if (u >= NQB * FOX_H) break;
                const int qb = NQB - 1 - u / FOX_H, h = u % FOX_H;
                attn_unit<0>(Qa + (size_t)h * S * 128, Ka + (size_t)h * S * 128, VaT + (size_t)h * S * 128, cum2 + (size_t)h * S, kmax2 + h * NKT, qb, concat, h * 128,
                             0.f, 0.f, nullptr, lds_raw, tid);
            }
#endif
            while (conv_more) CONV_ONE();
            PH_BAR(pb + 1);
        }

        if (PH_SEL(2) && PH_IN(pb + 2)) for (int rep = 0; rep < PH_REPS(2); ++rep) {
            PHASE_IDS();
            for (int u = bid; u < NKT * 6; u += G) {
                const int chunk = u / 6, grp = u % 6, c = tid & 127, tq = tid >> 7, ch = grp * 128 + c;
                float cr = 0.f;
                {
                    int j = 0;
                    for (; j + 16 <= chunk; j += 16) {
                        float a8[16], h8[16];
#pragma unroll
                        for (int q = 0; q < 16; ++q) { a8[q] = sumA[(size_t)(j + q) * LRU_W + ch]; h8[q] = sumH[(size_t)(j + q) * LRU_W + ch]; }
#pragma unroll
                        for (int q = 0; q < 16; ++q) cr = a8[q] * cr + h8[q];
                    }
                    for (; j < chunk; ++j) cr = sumA[(size_t)j * LRU_W + ch] * cr + sumH[(size_t)j * LRU_W + ch];
                }
                float hl[16], pl[16]; bf16_t gg[16];
#pragma unroll
                for (int i = 0; i < 16; ++i) { const size_t gi = (size_t)(chunk * 64 + tq * 16 + i) * LRU_W + ch; hl[i] = hloc[gi]; pl[i] = ploc[gi]; gg[i] = Gr[gi]; }
#pragma unroll
                for (int i = 0; i < 16; ++i)
                    concat[(size_t)(chunk * 64 + tq * 16 + i) * D + FOX_W + ch] = f2bf(gelu_tanh_f(bf2f(gg[i])) * (hl[i] + pl[i] * cr));
            }
            {
                const float lam_init = (l == 0) ? 0.2f : 0.35550906759f;
                const float s1 = wave_sum(p.in[I_LQ1][l * 64 + lane] * p.in[I_LK1][l * 64 + lane]);
                const float s2 = wave_sum(p.in[I_LQ2][l * 64 + lane] * p.in[I_LK2][l * 64 + lane]);
                const float lam = fexp(s1) - fexp(s2) + lam_init;
                const float* sg = p.in[I_SUBG] + l * 128;
                const float g0 = sg[2 * lane], g1 = sg[2 * lane + 1];
                static_assert(NCH <= 8, "the merge below keeps one (map, chunk) pair per lane: 2 x 8 lanes");
                for (int q = gwave; q < S; q += gwaves) {
                    const int nch = (q >> 6) / DCH + 1;
                    float mv = -INFINITY, lv = 0.f;
                    { const int c = lane & 7, hm = lane >> 3;
                      if (c < nch) { const float* ML = dpml + ((size_t)hm * DPART_ROWS + dpart_row(c, q)) * 2; mv = ML[0]; lv = ML[1]; } }
                    unsigned pk[4][2][NCH];
#pragma unroll
                    for (int h = 0; h < 4; ++h)
#pragma unroll
                        for (int mp = 0; mp < 2; ++mp) {
                            const unsigned* OP = (const unsigned*)(dpo + (size_t)(h * 2 + mp) * DPART_ROWS * 128);
#pragma unroll
                            for (int c = 0; c < NCH; ++c) pk[h][mp][c] = (c < nch) ? OP[(size_t)dpart_row(c, q) * 64 + lane] : 0u;
                        }
                    float Mx = mv; Mx = fmaxf(Mx, SHX(Mx, 1)); Mx = fmaxf(Mx, SHX(Mx, 2)); Mx = fmaxf(Mx, SHX(Mx, 4));
                    const float wv = (mv == -INFINITY) ? 0.f : FAST_EXP2(mv - Mx);
                    float Lp = lv * wv; Lp += SHX(Lp, 1); Lp += SHX(Lp, 2); Lp += SHX(Lp, 4);
#pragma unroll
                    for (int h = 0; h < 4; ++h) {
                        float om[2][2];
#pragma unroll
                        for (int mp = 0; mp < 2; ++mp) {
                            float o0 = 0.f, o1 = 0.f;
#pragma unroll
                            for (int c = 0; c < NCH; ++c) { const float w = RDLANE(wv, (h * 2 + mp) * 8 + c); o0 += bf2f((bf16_t)(pk[h][mp][c] & 0xffffu)) * w; o1 += bf2f((bf16_t)(pk[h][mp][c] >> 16)) * w; }
                            const float il = 1.f / RDLANE(Lp, (h * 2 + mp) * 8);
                            om[mp][0] = o0 * il; om[mp][1] = o1 * il;
                        }
                        const float v0 = om[0][0] - lam * om[1][0], v1 = om[0][1] - lam * om[1][1];
                        const float ss = wave_sum(v0 * v0 + v1 * v1);
                        const float rs = (1.f - lam_init) / sqrtf(ss * (1.f / 128.f) + LN_EPS);
                        *(unsigned*)(concat + (size_t)q * D + 1536 + h * 128 + 2 * lane) = pack2(v0 * rs * g0, v1 * rs * g1);
                    }
                }
            }
            PH_BAR(pb + 2);
        }

        if (PH_SEL(3) && PH_IN(pb + 3)) for (int rep = 0; rep < PH_REPS(3); ++rep) {
            PHASE_IDS();
            const bf16_t* Bt = WoT + (size_t)l * D * D;
            constexpr int ntn = D / 256, ntm = S / 256;
            const unsigned nooff[2][2] = {{0u, 0u}, {0u, 0u}};
            for (int t0 = bid; t0 < ntm * ntn; t0 += G) {
                int t = t0;
                if (G == 256 && ntm * ntn == 256) { const int x = t0 & 7, j = t0 >> 3; t = (x * 4 + (j >> 3)) * ntn + (j & 7); }
                const int pm = t / ntn, pn = t % ntn;
                f32x4 acc[2][2][4][2];
                gemm_tile<false>(concat, pm * 256, nooff, Bt, pn * 256, D, lds_raw, acc, tid);
                int et = tid; OPAQUE(et); const int wr = et >> 8, wc = (et >> 6) & 3, fr = et & 15, fq = (et >> 4) & 3;
#pragma unroll
                for (int ai = 0; ai < 2; ++ai) {
#pragma unroll
                    for (int m = 0; m < 4; ++m)
#pragma unroll
                        for (int bj = 0; bj < 2; ++bj)
#pragma unroll
                            for (int n = 0; n < 2; ++n)
#pragma unroll
                                for (int j = 0; j < 4; ++j)
                                    *(float*)(lds_raw + (wr * 64 + m * 16 + fq * 4 + j) * 1040 + (bj * 128 + wc * 32 + n * 16 + fr) * 4) = acc[ai][bj][m][n][j];
                    __syncthreads();
#pragma unroll 4
                    for (int i = 0; i < 16; ++i) {
                        const int idx = et + i * 512, lrow = idx >> 6, c4 = idx & 63;
                        const size_t gi = (size_t)(pm * 256 + ai * 128 + lrow) * D + pn * 256 + c4 * 4;
                        const f32x4 v = *(const f32x4*)(lds_raw + lrow * 1040 + c4 * 16);
                        *(f32x4*)(y1 + gi) = ALPHA * *(const f32x4*)(hin + gi) + v;
                    }
                    __syncthreads();
                }
            }
            PH_BAR(pb + 3);
        }

        if (PH_SEL(4) && PH_IN(pb + 4)) for (int rep = 0; rep < PH_REPS(4); ++rep) {
            PHASE_IDS();
            const float* g1 = p.in[I_LN1G] + (size_t)l * D; const float* b1 = p.in[I_LN1B] + (size_t)l * D;
            const float* bg = p.in[I_BGRP] + l * 4; const float* br = p.in[I_BRT] + l * 32;
            const bf16_t* Wb = W36b + (size_t)l * 2 * 48 * D;
            int* lcnt = (int*)(lds_raw + LDS_MISC + M_LCNT);
            const int segcap = ((S / 16 + G - 1) / G) * 16;
            const int r16 = lane & 15, q4 = lane >> 4;
            if (tid < 32) lcnt[tid] = 0;
            __syncthreads();
            for (int bi = bid; bi < S / 16; bi += G) {
#pragma unroll 1
                for (int tk = 0; tk < 2; ++tk) {
                    const int r = wave * 2 + tk, t = bi * 16 + r;
                    f32x4 v[8]; float s = 0.f;
#pragma unroll
                    for (int j = 0; j < 8; ++j) { v[j] = *(const f32x4*)(y1 + (size_t)t * D + j * 256 + lane * 4); s += (v[j][0] + v[j][1]) + (v[j][2] + v[j][3]); }
                    const float mean = wave_sum(s) * (1.f / D);
                    float s2 = 0.f;
#pragma unroll
                    for (int j = 0; j < 8; ++j) { v[j] -= mean; s2 += (v[j][0] * v[j][0] + v[j][1] * v[j][1]) + (v[j][2] * v[j][2] + v[j][3] * v[j][3]); }
                    const float rstd = 1.f / sqrtf(wave_sum(s2) * (1.f / D) + LN_EPS);
#pragma unroll
                    for (int j = 0; j < 8; ++j) {
                        const int c = j * 256 + lane * 4;
                        const f32x4 g = *(const f32x4*)(g1 + c), b = *(const f32x4*)(b1 + c);
                        v[j] = v[j] * rstd * g + b;
                        *(f32x4*)(h1 + (size_t)t * D + c) = v[j];
                        u32x2 o; o.x = pack2(v[j][0], v[j][1]); o.y = pack2(v[j][2], v[j][3]);
                        *(u32x2*)(h1b + (size_t)t * D + c) = o;
                        u32x2 lo2;
                        lo2.x = pack2(v[j][0] - bf2f((bf16_t)(o.x & 0xffffu)), v[j][1] - bf2f((bf16_t)(o.x >> 16)));
                        lo2.y = pack2(v[j][2] - bf2f((bf16_t)(o.y & 0xffffu)), v[j][3] - bf2f((bf16_t)(o.y >> 16)));
                        const int la = r * 4096 + (((j * 32 + (lane >> 1)) ^ r) << 4) + (lane & 1) * 8;
                        *(u32x2*)(lds_raw + la) = o; *(u32x2*)(lds_raw + 65536 + la) = lo2;
                    }
                }
                __syncthreads();
                f32x4 ac[3];
#pragma unroll
                for (int nt = 0; nt < 3; ++nt) ac[nt] = (f32x4){0.f, 0.f, 0.f, 0.f};
#pragma unroll 2
                for (int ks = 0; ks < 8; ++ks) {
                    const int kk = wave * 8 + ks;
                    const int la = r16 * 4096 + (((kk * 4 + q4) ^ r16) << 4);
                    const bf16x8 ah = *(const bf16x8*)(lds_raw + la), al = *(const bf16x8*)(lds_raw + 65536 + la);
#pragma unroll
                    for (int nt = 0; nt < 3; ++nt) {
                        const bf16x8 bh = *(const bf16x8*)(Wb + (size_t)(nt * 16 + r16) * D + kk * 32 + q4 * 8);
                        const bf16x8 bl = *(const bf16x8*)(Wb + (size_t)48 * D + (size_t)(nt * 16 + r16) * D + kk * 32 + q4 * 8);
                        ac[nt] = MFMA16(ah, bh, ac[nt]); ac[nt] = MFMA16(al, bh, ac[nt]); ac[nt] = MFMA16(ah, bl, ac[nt]);
                    }
                }
                __syncthreads();
                float* red = ldsf;
#pragma unroll
                for (int nt = 0; nt < 3; ++nt)
#pragma unroll
                    for (int j = 0; j < 4; ++j) red[(wave * 16 + q4 * 4 + j) * 48 + nt * 16 + r16] = ac[nt][j];
                __syncthreads();
                float* lgt = ldsf + 8 * 16 * 48;
                if (tid < 256) {
                    const int tkn = tid >> 4, o3 = (tid & 15) * 3;
#pragma unroll
                    for (int q = 0; q < 3; ++q) { float a = 0.f;
#pragma unroll
                        for (int w = 0; w < 8; ++w) a += red[(w * 16 + tkn) * 48 + o3 + q];
                        lgt[tkn * 48 + o3 + q] = a; }
                }
                __syncthreads();
                if (tid < 16) {
                    const int t = bi * 16 + tid; const float* L = lgt + tid * 48;
                    float gl[4];
#pragma unroll
                    for (int q = 0; q < 4; ++q) gl[q] = L[q] + bg[q];
                    int gi = 0; float gm = gl[0];
#pragma unroll
                    for (int q = 1; q < 4; ++q) if (gl[q] > gm) { gm = gl[q]; gi = q; }
                    float gs = 0.f;
#pragma unroll
                    for (int q = 0; q < 4; ++q) gs += fexp(gl[q] - gm);
                    const float gweight = 1.f / gs;
                    float E[8];
#pragma unroll
                    for (int e = 0; e < 8; ++e) E[e] = L[4 + gi * 8 + e] + br[gi * 8 + e];
                    int e1 = 0; float m1 = E[0];
#pragma unroll
                    for (int e = 1; e < 8; ++e) if (E[e] > m1) { m1 = E[e]; e1 = e; }
                    int e2 = -1; float m2 = -INFINITY;
#pragma unroll
                    for (int e = 0; e < 8; ++e) if (e != e1 && E[e] > m2) { m2 = E[e]; e2 = e; }
                    const float p2 = fexp(m2 - m1), w1 = 1.f / (1.f + p2), w2 = p2 / (1.f + p2);
                    const int ge1 = gi * 8 + e1, ge2 = gi * 8 + e2;
                    const int i1 = (ge1 * G + bid) * segcap + atomic_add_int(&lcnt[ge1], 1);
                    ltok[i1] = t; lw[i1] = gweight * w1; lslot[i1] = 0;
                    const int i2 = (ge2 * G + bid) * segcap + atomic_add_int(&lcnt[ge2], 1);
                    ltok[i2] = t; lw[i2] = gweight * w2; lslot[i2] = 1;
                }
                __syncthreads();
            }
            if (tid < 32) cntb[bid * 32 + tid] = lcnt[tid];
            PH_BAR(pb + 4);
        }

        if (PH_SEL(5) && PH_IN(pb + 5)) {
            PHASE_IDS();
            const unsigned nooff[2][2] = {{0u, 0u}, {0u, 0u}};
            const int segcap = ((S / 16 + G - 1) / G) * 16;
            moe_prefix(cntb, G, lds_raw, tid);
            const int* ctot = (const int*)(lds_raw + LDS_MISC + M_CTOT); const int* coff = (const int*)(lds_raw + LDS_MISC + M_COFF);
            const int* rtok = (const int*)(lds_raw + LDS_MISC + M_RTOK); const float* rw = (const float*)(lds_raw + LDS_MISC + M_RW);
            const int* rslot = (const int*)(lds_raw + LDS_MISC + M_RSLOT);
            unsigned* done = (unsigned*)(wsl + CTL_DONE_OFF) + l * 1024;
            int nmt = 0;
            for (int e = 0; e < NEXP; ++e) nmt += (ctot[e] + 255) / 256;
            nmt = RFL(nmt);
            for (;;) {
                __syncthreads();
                if (tid == 0) *ubox = (unsigned)atomic_add_int(workctr + 8, 1);
                __syncthreads();
                int u = RFL((int)*ubox);
                if (u >= nmt * 12) break;
                const bool down = (u >= nmt * 4);
                const int per = down ? 8 : 4;
                if (down) u -= nmt * 4;
                int e = 0;
                for (;; ++e) { const int nt = ((RFL(ctot[e]) + 255) / 256) * per; if (u < nt) break; u -= nt; }
                const int c = RFL(ctot[e]), off = RFL(coff[e]);
                const int mt = u / per, pn = u % per, m0 = mt * 256;
                moe_rowtable(ltok, lw, lslot, e, m0, c, G, segcap, lds_raw, tid);
                f32x4 acc[2][2][4][2];
                if (!down) {
                    const bf16_t* Bt = WguT + ((size_t)l * NEXP + e) * 1024 * D;
                    unsigned aoff[2][2];
                    int st = tid; OPAQUE(st); int R[2], C[2]; stage_geom(st, R, C);
#pragma unroll
                    for (int h = 0; h < 2; ++h)
#pragma unroll
                        for (int i = 0; i < 2; ++i) aoff[h][i] = (unsigned)(rtok[h * 128 + R[i]] * D + C[i]);
                    gemm_tile<true>(h1b, 0, aoff, Bt, pn * 256, D, lds_raw, acc, tid);
                    int et = tid; OPAQUE(et); const int wr = et >> 8, wc = (et >> 6) & 3, fr = et & 15, fq = (et >> 4) & 3;
#pragma unroll
                    for (int ai = 0; ai < 2; ++ai)
#pragma unroll
                        for (int m = 0; m < 4; ++m)
#pragma unroll
                            for (int j = 0; j < 4; ++j) {
                                const int r = ai * 128 + wr * 64 + m * 16 + fq * 4 + j;
                                const float wgt = rw[r];
#pragma unroll
                                for (int bj = 0; bj < 2; ++bj)
                                    *(bf16_t*)(lds_raw + r * 272 + (bj * 64 + wc * 16 + fr) * 2) = f2bf(silu_f(acc[ai][bj][m][0][j]) * acc[ai][bj][m][1][j] * wgt);
                            }
                    __syncthreads();
#pragma unroll 4
                    for (int i = 0; i < 8; ++i) {
                        const int idx = et + i * 512, r = idx >> 4, ch = idx & 15;
                        if (m0 + r < c) *(u32x4*)(act + (size_t)(off + m0 + r) * DFF + pn * 128 + ch * 8) = *(const u32x4*)(lds_raw + r * 272 + ch * 16);
                    }
                    WAIT_VM0();
                    __syncthreads();
                    if (et == 0) { FENCE_REL_AGENT(); WAIT_VM0(); (void)xb_add(&done[e * 32 + mt], 1u); }
                } else {
                    const bf16_t* Bt = WdT + ((size_t)l * NEXP + e) * D * DFF;
                    if (tid == 0) {
                        unsigned* bw = (unsigned*)wsl;
                        XB_SPIN(xb_ld(&done[e * 32 + mt]) < 4u, bw);
                        FENCE_ACQ_AGENT();
                        WAIT_VM0();
                    }
                    __syncthreads();
                    gemm_tile<false>(act, off + m0, nooff, Bt, pn * 256, DFF, lds_raw, acc, tid);
                    int et = tid; OPAQUE(et); const int wr = et >> 8, wc = (et >> 6) & 3, fr = et & 15, fq = (et >> 4) & 3;
#pragma unroll
                    for (int ai = 0; ai < 2; ++ai)
#pragma unroll
                        for (int m = 0; m < 4; ++m)
#pragma unroll
                            for (int bj = 0; bj < 2; ++bj)
#pragma unroll
                                for (int n = 0; n < 2; ++n)
#pragma unroll
                                    for (int j = 0; j < 4; ++j)
                                        *(bf16_t*)(lds_raw + (ai * 128 + wr * 64 + m * 16 + fq * 4 + j) * 528 + (bj * 128 + wc * 32 + n * 16 + fr) * 2) = f2bf(acc[ai][bj][m][n][j]);
                    __syncthreads();
#pragma unroll 4
                    for (int i = 0; i < 16; ++i) {
                        const int idx = et + i * 512, r = idx >> 5, ch = idx & 31;
                        if (m0 + r < c) *(u32x4*)(contrib + ((size_t)rslot[r] * S + rtok[r]) * D + pn * 256 + ch * 8) = *(const u32x4*)(lds_raw + r * 528 + ch * 16);
                    }
                }
            }
            PH_BAR(pb + 5);
        }

        if (PH_SEL(7) && PH_IN(pb + 7)) for (int rep = 0; rep < PH_REPS(7); ++rep) {
            PHASE_IDS();
            const float* g2 = p.in[I_LN2G] + (size_t)l * D; const float* b2 = p.in[I_LN2B] + (size_t)l * D;
            const bool more = (l + 1 < DEPTH);
            f32x4 gq[8], bq[8];
#pragma unroll
            for (int j = 0; j < 8; ++j) { gq[j] = *(const f32x4*)(g2 + j * 256 + lane * 4); bq[j] = *(const f32x4*)(b2 + j * 256 + lane * 4); }
            if (more) {
                const float* wf = Wfa + (size_t)(l + 1) * 8 * D;
                __syncthreads();
                for (int i = tid; i < 6 * D / 4; i += NTHREADS) *(f32x4*)(ldsf + i * 4) = *(const f32x4*)(wf + i * 4);
                __syncthreads();
            }
            for (int t = gwave; t < S; t += gwaves) {
                f32x4 v[8]; float s = 0.f;
#pragma unroll
                for (int j = 0; j < 8; ++j) {
                    const size_t i = (size_t)t * D + j * 256 + lane * 4;
                    const u32x2 c0 = *(const u32x2*)(contrib + i), c1 = *(const u32x2*)(contrib + (size_t)S * D + i);
                    const f32x4 cs = (f32x4){bf2f((bf16_t)(c0.x & 0xffffu)) + bf2f((bf16_t)(c1.x & 0xffffu)), bf2f((bf16_t)(c0.x >> 16)) + bf2f((bf16_t)(c1.x >> 16)),
                                             bf2f((bf16_t)(c0.y & 0xffffu)) + bf2f((bf16_t)(c1.y & 0xffffu)), bf2f((bf16_t)(c0.y >> 16)) + bf2f((bf16_t)(c1.y >> 16))};
                    v[j] = ALPHA * *(const f32x4*)(h1 + i) + cs;
                    s += (v[j][0] + v[j][1]) + (v[j][2] + v[j][3]);
                }
                const float mean = wave_sum(s) * (1.f / D);
                float s2 = 0.f;
#pragma unroll
                for (int j = 0; j < 8; ++j) { v[j] -= mean; s2 += (v[j][0] * v[j][0] + v[j][1] * v[j][1]) + (v[j][2] * v[j][2] + v[j][3] * v[j][3]); }
                const float rstd = 1.f / sqrtf(wave_sum(s2) * (1.f / D) + LN_EPS);
                float fa[6] = {0.f, 0.f, 0.f, 0.f, 0.f, 0.f};
#pragma unroll
                for (int j = 0; j < 8; ++j) {
                    const int c = j * 256 + lane * 4;
                    v[j] = v[j] * rstd * gq[j] + bq[j];
                    *(f32x4*)(hout + (size_t)t * D + c) = v[j];
                    COMPILER_FENCE();
                    if (more) {
                        u32x2 o; o.x = pack2(v[j][0], v[j][1]); o.y = pack2(v[j][2], v[j][3]);
                        *(u32x2*)(xb + (size_t)t * D + c) = o;
#pragma unroll
                        for (int h = 0; h < 6; ++h) { const f32x4 w = *(const f32x4*)(ldsf + h * D + c); fa[h] += (v[j][0] * w[0] + v[j][1] * w[1]) + (v[j][2] * w[2] + v[j][3] * w[3]); }
                    }
                }
                if (more) {
#pragma unroll
                    for (int h = 0; h < 6; ++h) { const float sm = wave_sum(fa[h]); if (lane == 0) logf_[h * S + t] = log_sigmoid_f(sm + p.in[I_BF][(l + 1) * 6 + h]); }
                }
            }
            PH_BAR(pb + 7);
        }
    }
#undef PH_IN
#undef PH_BAR
}

constexpr int N_PHASES = 1 + DEPTH * 8;
#ifndef EMU
extern "C" void kernel_launch(void* const* d_in, const int* in_sizes, int n_in, void* d_out, int out_size, void* d_ws, size_t ws_size, hipStream_t stream) {
    static int grid = 0;
    if (grid == 0) {
        if (n_in != N_INPUTS || out_size != S * D || ws_size < WS_END) {
            fprintf(stderr, "kernel_launch: unexpected shapes: n_in %d out %d ws %zu (need %zu)\n", n_in, out_size, ws_size, (size_t)WS_END); grid = -1; return; }
        int dev = 0, cus = 0, per_cu = 0;
        if (hipGetDevice(&dev) != hipSuccess || hipDeviceGetAttribute(&cus, hipDeviceAttributeMultiprocessorCount, dev) != hipSuccess) { grid = -1; return; }
        if (hipFuncSetAttribute((const void*)fwd_kernel, hipFuncAttributeMaxDynamicSharedMemorySize, LDS_BYTES) != hipSuccess) { fprintf(stderr, "kernel_launch: hipFuncSetAttribute failed\n"); grid = -1; return; }
        if (hipOccupancyMaxActiveBlocksPerMultiprocessor(&per_cu, (const void*)fwd_kernel, NTHREADS, LDS_BYTES) != hipSuccess || per_cu < 1) {
            fprintf(stderr, "kernel_launch: occupancy query says %d blocks per CU\n", per_cu); (void)hipGetLastError(); grid = -1; return; }
        grid = cus;
    }
    if (grid < 0) return;
    (void)hipMemsetAsync(d_ws, 0, CTL_BYTES, stream);
    Params p{};
    for (int i = 0; i < N_INPUTS; ++i) p.in[i] = (const float*)d_in[i];
    p.out = (float*)d_out; p.ws = (unsigned char*)d_ws;
    for (int i = 0; i < 8; ++i) p.inv_freq[i] = (float)pow(500000.0, -(double)i * 2.0 / 16.0);
#if N_LAUNCH_SPLIT
    for (int k = 0; k < N_PHASES; ++k) { p.lo = k; p.hi = k + 1; hipLaunchKernelGGL(fwd_kernel, dim3(grid), dim3(NTHREADS), LDS_BYTES, stream, p); }
#else
    p.lo = 0; p.hi = N_PHASES;
    hipLaunchKernelGGL(fwd_kernel, dim3(grid), dim3(NTHREADS), LDS_BYTES, stream, p);
#endif
}
#endif
```

```cpp
#ifndef EMU
#include <hip/hip_runtime.h>
#include <cstdio>
#include <cstdint>
#include <cmath>
#endif

#ifndef SEQ
#define SEQ 8192
#endif
#ifndef N_LAUNCH_SPLIT
#define N_LAUNCH_SPLIT 0
#endif
#ifndef REP_PHASE
#define REP_PHASE -2
#endif
#define PH_REPS(c) ((c) == REP_PHASE ? 2 : 1)
#ifndef REP_SUB
#define REP_SUB 0
#endif

constexpr int S = SEQ, D = 2048, DEPTH = 2;
constexpr int FOX_H = 6, FOX_W = 768;
constexpr int LRU_W = 768;
constexpr int DIFF_H = 4, DIFF_W = 512;
constexpr int N_IN = 5382, N_INP = 5376;
constexpr int C_FA = 2304;
constexpr int NEXP = 32, DFF = 512;
constexpr int NKT = S / 64;
#ifndef DCH
#define DCH 16
#endif
constexpr int NCH = (NKT + DCH - 1) / DCH;
constexpr size_t DPART_ROWS = (size_t)NCH * S - (size_t)(DCH * 64) * NCH * (NCH - 1) / 2;
constexpr float ALPHA = 1.41421356237309504880f;
constexpr float LN_EPS = 1e-5f;
constexpr float LOG2E = 1.4426950408889634f;
constexpr float QSCALE_A = 0.08838834764831845f * 1.4426950408889634f;
constexpr float QSCALE_C = 0.125f * 1.4426950408889634f;

enum { I_X = 0, I_POS, I_WIN, I_BF, I_CONVW, I_CONVB, I_WA, I_BA, I_WI, I_BI, I_LAM, I_LQ1, I_LK1, I_LQ2, I_LK2, I_SUBG, I_WO, I_LN1G, I_LN1B,
       I_WGRP, I_BGRP, I_WRT, I_BRT, I_WGATE, I_WUP, I_WDOWN, I_LN2G, I_LN2B, N_INPUTS };

typedef unsigned short bf16_t;
typedef short bf16x8 __attribute__((ext_vector_type(8)));
typedef float f32x4 __attribute__((ext_vector_type(4)));
typedef unsigned u32x4 __attribute__((ext_vector_type(4)));
typedef unsigned u32x2 __attribute__((ext_vector_type(2)));

constexpr size_t al256(size_t x) { return (x + 255) & ~(size_t)255; }
constexpr size_t CTL_BYTES = 65536;
constexpr size_t CTL_CNT_OFF = 32768;
constexpr size_t CTL_WORK_OFF = 36864;
constexpr size_t CTL_QK2_OFF = 57344;
constexpr size_t CTL_CLS_OFF = 49152;
constexpr size_t CTL_DONE_OFF = 40960;
constexpr size_t WB_WIN = CTL_BYTES;
constexpr size_t WB_WO = WB_WIN + al256((size_t)DEPTH * N_INP * D * 2);
constexpr size_t WB_WGU = WB_WO + al256((size_t)DEPTH * D * D * 2);
constexpr size_t WB_WD = WB_WGU + al256((size_t)DEPTH * NEXP * 1024 * D * 2);
constexpr size_t WB_WAI = WB_WD + al256((size_t)DEPTH * NEXP * D * DFF * 2);
constexpr size_t WF_FA = WB_WAI + al256((size_t)DEPTH * 6 * 256 * 128 * 2);
constexpr size_t WF_R36 = WF_FA + al256((size_t)DEPTH * 8 * D * 4);
constexpr size_t WF_ROPE = WF_R36 + al256((size_t)DEPTH * 2 * 48 * D * 2);
constexpr size_t A_XB = WF_ROPE + al256((size_t)S * 16 * 4);
constexpr size_t A_HB = A_XB + al256((size_t)S * D * 2);
constexpr size_t A_LOGF = A_HB + al256((size_t)S * D * 4);
constexpr size_t A_CUM = A_LOGF + al256((size_t)6 * S * 4);
constexpr size_t A_KMAX = A_CUM + al256((size_t)6 * S * 4);
constexpr size_t A_CNTB = A_KMAX + al256((size_t)6 * NKT * 4);
constexpr size_t A_QA = A_CNTB + al256((size_t)1024 * 32 * 4);
constexpr size_t A_KA = A_QA + al256((size_t)FOX_H * S * 128 * 2);
constexpr size_t A_VAT = A_KA + al256((size_t)FOX_H * S * 128 * 2);
constexpr size_t A_XR = A_VAT + al256((size_t)FOX_H * S * 128 * 2);
constexpr size_t A_GR = A_XR + al256((size_t)S * LRU_W * 2);
constexpr size_t A_QC = A_GR + al256((size_t)S * LRU_W * 2);
constexpr size_t A_KC = A_QC + al256((size_t)DIFF_H * S * 128 * 2);
constexpr size_t A_VCT = A_KC + al256((size_t)DIFF_H * S * 128 * 2);
constexpr size_t A_HLOC = A_VCT + al256((size_t)DIFF_H * S * 128 * 2);
constexpr size_t A_PLOC = A_HLOC + al256((size_t)S * LRU_W * 4);
constexpr size_t A_SUMA = A_PLOC + al256((size_t)S * LRU_W * 4);
constexpr size_t A_SUMH = A_SUMA + al256((size_t)NKT * LRU_W * 4);
constexpr size_t A_CONCAT = A_SUMH + al256((size_t)NKT * LRU_W * 4);
constexpr size_t A_Y1 = A_CONCAT + al256((size_t)S * D * 2);
constexpr size_t A_H1 = A_Y1 + al256((size_t)S * D * 4);
constexpr size_t A_H1B = A_H1 + al256((size_t)S * D * 4);
constexpr size_t A_LTOK = A_H1B + al256((size_t)S * D * 2);
constexpr size_t A_LW = A_LTOK + al256((size_t)NEXP * S * 4);
constexpr size_t A_LSLOT = A_LW + al256((size_t)NEXP * S * 4);
constexpr size_t A_ACT = A_LSLOT + al256((size_t)NEXP * S * 4);
constexpr size_t A_CONTRIB = A_ACT + al256((size_t)(2 * S + 256) * DFF * 2);
constexpr size_t WS_END = A_CONTRIB + al256((size_t)2 * S * D * 4);
constexpr size_t A_DPO = A_Y1;
constexpr size_t A_DPML = A_DPO + al256((size_t)8 * DPART_ROWS * 128 * 2);
static_assert(A_DPML + (size_t)8 * DPART_ROWS * 2 * 4 <= A_H1B, "differential partials must fit inside the y1 + h1 region");

constexpr int NTHREADS = 512;
constexpr int LDS_MAIN = 131072 + 4096;
constexpr int LDS_MISC = LDS_MAIN;
constexpr int LDS_BYTES = LDS_MAIN + 8192 + 16640;
constexpr int M_PRE16 = 8192;
constexpr int M_LCNT = 64, M_CTOT = 256, M_COFF = 384, M_PRE = 512, M_RTOK = 2048, M_RW = 3072, M_RSLOT = 4096;

struct Params {
    const float* in[N_INPUTS];
    float* out;
    unsigned char* ws;
    float inv_freq[8];
    int lo, hi;
};

#ifndef EMU
#define LAS __attribute__((address_space(3)))
#define DYN_LDS(name) extern __shared__ __attribute__((aligned(16))) unsigned char name[]
#define SLEEP1() __builtin_amdgcn_s_sleep(1)
#define WAVE_SYNC() __builtin_amdgcn_wave_barrier()
#define OPAQUE(x) asm volatile("" : "+v"(x))
#define COMPILER_FENCE() asm volatile("" ::: "memory")
#define RFL(x) __builtin_amdgcn_readfirstlane(x)
#define RFL_F(x) __builtin_bit_cast(float, __builtin_amdgcn_readfirstlane(__builtin_bit_cast(int, x)))
#define ANY_LANE(p) (__builtin_amdgcn_ballot_w64(p) != 0ull)
#define RDLANE(v, l) __builtin_bit_cast(float, __builtin_amdgcn_readlane(__builtin_bit_cast(int, v), l))
__device__ __forceinline__ int lane_id_volatile() { int l; asm volatile("v_mbcnt_lo_u32_b32 %0, -1, 0\n\tv_mbcnt_hi_u32_b32 %0, -1, %0" : "=v"(l)); return l; }
#define LANE_ID() lane_id_volatile()
#define OPAQUE_S(x) asm volatile("" : "+s"(x))
#define WAIT_VM0() asm volatile("s_waitcnt vmcnt(0)" ::: "memory")
#define WAIT_ALL0() __builtin_amdgcn_s_waitcnt(0)
#define FENCE_REL_AGENT() __builtin_amdgcn_fence(__ATOMIC_RELEASE, "agent")
#define FENCE_ACQ_AGENT() __builtin_amdgcn_fence(__ATOMIC_ACQUIRE, "agent")
#define MFMA16(a, b, c) __builtin_amdgcn_mfma_f32_16x16x32_bf16(a, b, c, 0, 0, 0)
#define GLDS16(g, l) __builtin_amdgcn_global_load_lds((const unsigned*)(g), (unsigned*)(l), 16, 0, 0)
#define WAIT_V(n) asm volatile("s_waitcnt vmcnt(" #n ")" ::: "memory")
#define WAIT_L(n) asm volatile("s_waitcnt lgkmcnt(" #n ")" ::: "memory")
#define BAR() __builtin_amdgcn_s_barrier()
#define SCHED() __builtin_amdgcn_sched_barrier(0)
#define SETPRIO(n) __builtin_amdgcn_s_setprio(n)
#define FAST_EXP2(x) __builtin_amdgcn_exp2f(x)
template <int M> __device__ __forceinline__ float shx_impl(float v, int lane) {
    if (M < 32) return __builtin_bit_cast(float, __builtin_amdgcn_ds_swizzle(__builtin_bit_cast(int, v), (M << 10) | 0x1f));
    return __builtin_bit_cast(float, __builtin_amdgcn_ds_bpermute((lane ^ 32) << 2, __builtin_bit_cast(int, v)));
}
#define SHX(v, M) shx_impl<M>(v, lane)
#define FAST_LOG2(x) __builtin_amdgcn_logf(x)
#define FAST_RCP(x) __builtin_amdgcn_rcpf(x)
__device__ __forceinline__ unsigned xb_ld(unsigned* p)              { return __hip_atomic_load(p, __ATOMIC_RELAXED, __HIP_MEMORY_SCOPE_AGENT); }
__device__ __forceinline__ unsigned xb_add(unsigned* p, unsigned v) { return __hip_atomic_fetch_add(p, v, __ATOMIC_RELAXED, __HIP_MEMORY_SCOPE_AGENT); }
__device__ __forceinline__ unsigned xb_xcc_id() { return (unsigned)__builtin_amdgcn_s_getreg((3 << 11) | 20) & 0xFu; }
__device__ __forceinline__ int atomic_add_int(int* p, int v) { return atomicAdd(p, v); }
__device__ __forceinline__ void atomic_min_int(int* p, int v) { atomicMin(p, v); }
__device__ __forceinline__ void atomic_max_u32(unsigned* p, unsigned v) { atomicMax(p, v); }
__device__ __forceinline__ unsigned pack2(float lo, float hi) { unsigned r; asm volatile("v_cvt_pk_bf16_f32 %0, %1, %2" : "=v"(r) : "v"(lo), "v"(hi)); return r; }
#else
#define MFMA16(a, b, c) emu_mfma_16x16x32_bf16(a, b, c)
#define GLDS16(g, l) emu_glds16((const void*)(g), (void*)(l))
#define WAIT_V(n) ((void)0)
#define WAIT_L(n) ((void)0)
#define BAR() __syncthreads()
#define SCHED() ((void)0)
#define SETPRIO(n) ((void)0)
#define FAST_EXP2(x) exp2f(x)
#define SHX(v, M) __shfl_xor(v, M)
#define FAST_LOG2(x) log2f(x)
#define FAST_RCP(x) (1.f / (x))
static inline unsigned pack2(float lo, float hi) {
    unsigned a = __builtin_bit_cast(unsigned, lo), b = __builtin_bit_cast(unsigned, hi);
    a += 0x7fffu + ((a >> 16) & 1u); b += 0x7fffu + ((b >> 16) & 1u);
    return (a >> 16) | (b & 0xffff0000u);
}
#endif
__device__ __forceinline__ bf16_t f2bf(float f) { return (bf16_t)(pack2(f, 0.f) & 0xffffu); }
__device__ __forceinline__ float bf2f(bf16_t h) { return __builtin_bit_cast(float, (unsigned)h << 16); }

#define XB_TMO      128
#define XB_XCNT(j)  (256  + 64 * (j))
#define XB_XSUB(j)  (1280 + 64 * (j))
#define XB_XGEN(j)  (2304 + 64 * (j))
#define XB_TOP      3328
#define XB_TOPGEN   3392
#define XCD_BAR_WORDS 3456
#define XB_SPIN_CAP (1u << 22)
#define XB_SPIN(cond, bar) do { unsigned _sp = 0; while (cond) { SLEEP1(); \
    if ((++_sp & 255u) == 0u) { if (xb_ld(&(bar)[XB_TMO])) break; if (_sp > XB_SPIN_CAP) { xb_add(&(bar)[XB_TMO], 1u); break; } } } } while (0)

struct XcdBarrier { unsigned* bar; unsigned x; volatile LAS unsigned* st; };

__device__ __forceinline__ XcdBarrier xcd_barrier_post(unsigned* bar, volatile LAS unsigned* st) {
    XcdBarrier b; b.bar = bar; b.x = xb_xcc_id(); b.st = st;
    if (threadIdx.x == 0) (void)xb_add(&bar[XB_XCNT(b.x)], 1u);
    return b;
}
__device__ __forceinline__ void xcd_barrier_complete(unsigned* bar, unsigned x, unsigned& nloc, unsigned& nx) {
    const unsigned G = gridDim.x;
    unsigned sum, cnt, mine, sp = 0u;
    for (;;) {
        sum = 0u; cnt = 0u; mine = 0u;
#pragma unroll
        for (unsigned j = 0; j < 16; ++j) { const unsigned c = xb_ld(&bar[XB_XCNT(j)]); sum += c; cnt += (c > 0u) ? 1u : 0u; mine = (j == x) ? c : mine; }
        if (sum == G) break;
        SLEEP1();
        if ((++sp & 255u) == 0u) { if (xb_ld(&bar[XB_TMO])) break; if (sp > XB_SPIN_CAP) { xb_add(&bar[XB_TMO], 1u); break; } }
    }
    nloc = mine > 0u ? mine : 1u; nx = cnt > 0u ? cnt : 1u;
}
__device__ __forceinline__ void xcd_barrier(const XcdBarrier& b, bool leader) {
    WAIT_VM0();
    __syncthreads();
    if (leader) {
        unsigned* bar = b.bar;
        WAIT_ALL0();
        unsigned nloc = b.st[0], nx = b.st[1];
        if (nloc == 0u) { xcd_barrier_complete(bar, b.x, nloc, nx); b.st[0] = nloc; b.st[1] = nx; }
        const unsigned old = xb_add(&bar[XB_XSUB(b.x)], 1u);
        const unsigned gen = old / nloc;
        if (old + 1u == (gen + 1u) * nloc) {
            FENCE_REL_AGENT();
            WAIT_VM0();
            const unsigned og = xb_add(&bar[XB_TOP], 1u);
            const unsigned tg = og / nx;
            if (og + 1u == (tg + 1u) * nx) xb_add(&bar[XB_TOPGEN], 1u);
            else XB_SPIN(xb_ld(&bar[XB_TOPGEN]) == tg, bar);
            FENCE_ACQ_AGENT();
            xb_add(&bar[XB_XGEN(b.x)], 1u);
            WAIT_VM0();
        } else {
            XB_SPIN(xb_ld(&bar[XB_XGEN(b.x)]) == gen, bar);
            FENCE_ACQ_AGENT();
            WAIT_VM0();
        }
    }
    __syncthreads();
}

__device__ __forceinline__ float wave_sum_l(float v, int lane) {
    v += SHX(v, 1); v += SHX(v, 2); v += SHX(v, 4); v += SHX(v, 8); v += SHX(v, 16); v += SHX(v, 32);
    return v;
}
#define wave_sum(v) wave_sum_l(v, lane)
__device__ __forceinline__ float fexp(float x) { return FAST_EXP2(x * LOG2E); }
__device__ __forceinline__ float sigmoid_f(float x) { return FAST_RCP(1.f + fexp(-x)); }
__device__ __forceinline__ float log_sigmoid_f(float x) { return fminf(x, 0.f) - 0.6931471805599453f * FAST_LOG2(1.f + fexp(-fabsf(x))); }
__device__ __forceinline__ float gelu_tanh_f(float x) { const float u = 0.7978845608028654f * (x + 0.044715f * x * x * x); return x * FAST_RCP(1.f + fexp(-2.f * u)); }
__device__ __forceinline__ float silu_f(float x) { return x * FAST_RCP(1.f + fexp(-x)); }
__device__ __forceinline__ float neg_expm1_f(float x) {
    const float ser = -x * (1.f + x * (0.5f + x * (0.16666667f + x * (0.041666668f + x * (0.008333334f + x * 0.0013888889f)))));
    return (x > -0.35f) ? ser : (1.f - fexp(x));
}

struct RmIdent { __device__ __forceinline__ int operator()(int n) const { return n; } };
struct RmWin { __device__ __forceinline__ int operator()(int n) const { return n < C_FA ? n : (n < C_FA + 6 ? -1 : n - 6); } };
struct RmGu { int kind; __device__ __forceinline__ int operator()(int f) const { return (f >> 7) * 256 + ((f >> 6) & 1) * 128 + ((f >> 4) & 3) * 32 + kind * 16 + (f & 15); } };
struct RmOff { int off; __device__ __forceinline__ int operator()(int n) const { return n + off; } };

template <class RM>
__device__ __forceinline__ void convert_tile(const float* src, int ld, int K, int Nsrc, int k0, int n0, bf16_t* dst, const RM& rm, float* T, int tid) {
    {
        const int nn = tid & 255, kh = (tid >> 8) * 32, n = n0 + nn;
        const float* sp = src + (size_t)(k0 + kh) * ld + n;
        float v[32];
#pragma unroll
        for (int i = 0; i < 32; ++i) v[i] = (n < Nsrc) ? sp[(size_t)i * ld] : 0.f;
#pragma unroll
        for (int i = 0; i < 32; ++i) T[(kh + i) * 257 + nn] = v[i];
    }
    __syncthreads();
#pragma unroll
    for (int q = 0; q < 4; ++q) {
        const int nn = q * 64 + (tid >> 3), kc = (tid & 7) * 8, n = n0 + nn;
        const int row = (n < Nsrc) ? rm(n) : -1;
        if (row >= 0) {
            u32x4 o;
            o.x = pack2(T[(kc + 0) * 257 + nn], T[(kc + 1) * 257 + nn]); o.y = pack2(T[(kc + 2) * 257 + nn], T[(kc + 3) * 257 + nn]);
            o.z = pack2(T[(kc + 4) * 257 + nn], T[(kc + 5) * 257 + nn]); o.w = pack2(T[(kc + 6) * 257 + nn], T[(kc + 7) * 257 + nn]);
            *(u32x4*)(dst + (size_t)row * K + k0 + kc) = o;
        }
    }
    __syncthreads();
}
template <class RM>
__device__ __forceinline__ void convert_mats(const float* src, size_t sstride, int nmat, int ld, int K, int Nsrc, bf16_t* dst, size_t dstride, const RM& rm,
                                             float* T, int tid, int bid, int G) {
    const int tk = K / 64, tn = (Nsrc + 255) / 256, per = tk * tn, total = nmat * per;
    for (int t = bid; t < total; t += G) {
        const int mi = t / per, r = t % per;
        convert_tile(src + (size_t)mi * sstride, ld, K, Nsrc, (r / tn) * 64, (r % tn) * 256, dst + (size_t)mi * dstride, rm, T, tid);
    }
}

constexpr int NCONV = DEPTH * 768;
__device__ __forceinline__ void moe_conv_chunk(const Params& p, int cid, bf16_t* WguT_, bf16_t* WdT_, float* T, int tid) {
    const int l = cid / 768, r = cid % 768, kind = r >> 8, t0 = (r & 255) * 8;
    for (int t = t0; t < t0 + 8; ++t) {
        const int mi = t >> 6, rr = t & 63;
        if (kind < 2) {
            const float* src = p.in[kind == 0 ? I_WGATE : I_WUP] + ((size_t)l * NEXP + mi) * D * DFF;
            convert_tile(src, DFF, D, DFF, (rr >> 1) * 64, (rr & 1) * 256, WguT_ + ((size_t)l * NEXP + mi) * 1024 * D, RmGu{kind}, T, tid);
        } else {
            const float* src = p.in[I_WDOWN] + ((size_t)l * NEXP + mi) * DFF * D;
            convert_tile(src, D, DFF, D, (rr >> 3) * 64, (rr & 7) * 256, WdT_ + ((size_t)l * NEXP + mi) * D * DFF, RmIdent{}, T, tid);
        }
    }
}

constexpr int BK = 64, HTB = 128 * 64 * 2;
__device__ __forceinline__ int lds_byte(int r, int c) {
    const int st = (r >> 4) * 2 + (c >> 5), rr = r & 15, cc = c & 31, ob = rr * 64 + cc * 2;
    return st * 1024 + (ob ^ (((ob >> 9) & 1) << 5));
}
__device__ __forceinline__ void stage_rc(int b, int& R, int& C) {
    const int st = b / 1024, sb = b % 1024, swz = sb ^ (((sb >> 9) & 1) << 5);
    R = (st >> 1) * 16 + swz / 64; C = (st & 1) * 32 + (swz % 64) / 2;
}
template <bool GATHER>
__device__ __forceinline__ void gemm_tile(const bf16_t* A, int arow0, const unsigned (&aoff)[2][2], const bf16_t* Bt, int brow0, int K,
                                          unsigned char* shm, f32x4 (&acc)[2][2][4][2], int tid_in) {
    int tid = tid_in; OPAQUE(tid);
    unsigned toff; { int R0, C0; stage_rc(tid * 16, R0, C0); toff = (unsigned)(R0 * K + C0); }
#define SA(b, h) (shm + ((b) * 2 + (h)) * HTB)
#define SB(b, h) (shm + (4 + (b) * 2 + (h)) * HTB)
#define STAGE_B(P, h, kt) do { _Pragma("unroll") for (int _i = 0; _i < 2; ++_i) GLDS16(Bt + ((size_t)(brow0 + (h) * 128 + _i * 64) * K + (size_t)(kt) * BK) + toff, (P) + tid * 16 + _i * 8192); } while (0)
#define STAGE_A(P, h, kt) do { _Pragma("unroll") for (int _i = 0; _i < 2; ++_i) { \
    if (GATHER) GLDS16(A + (size_t)(kt) * BK + aoff[h][_i], (P) + tid * 16 + _i * 8192); \
    else GLDS16(A + ((size_t)(arow0 + (h) * 128 + _i * 64) * K + (size_t)(kt) * BK) + toff, (P) + tid * 16 + _i * 8192); } } while (0)
#define LDA(dst, b, h) _Pragma("unroll") for (int m = 0; m < 4; ++m) _Pragma("unroll") for (int k = 0; k < 2; ++k) \
    dst[m][k] = *reinterpret_cast<const bf16x8*>(SA(b, h) + lds_byte(wr * 64 + m * 16 + fr, k * 32 + fq * 8))
#define LDB(dst, b, h) _Pragma("unroll") for (int n = 0; n < 2; ++n) _Pragma("unroll") for (int k = 0; k < 2; ++k) \
    dst[n][k] = *reinterpret_cast<const bf16x8*>(SB(b, h) + lds_byte(wc * 32 + n * 16 + fr, k * 32 + fq * 8))
#define MMA(ai, bj, At, Bx) do { SETPRIO(1); \
    _Pragma("unroll") for (int m = 0; m < 4; ++m) _Pragma("unroll") for (int n = 0; n < 2; ++n) _Pragma("unroll") for (int k = 0; k < 2; ++k) \
      acc[ai][bj][m][n] = MFMA16(At[m][k], Bx[n][k], acc[ai][bj][m][n]); \
    SETPRIO(0); } while (0)
    int wid = tid >> 6, lane = tid & 63, wr = wid >> 2, wc = wid & 3, fr = lane & 15, fq = lane >> 4;
#pragma unroll
    for (int a = 0; a < 2; ++a)
#pragma unroll
        for (int b = 0; b < 2; ++b)
#pragma unroll
            for (int m = 0; m < 4; ++m)
#pragma unroll
                for (int n = 0; n < 2; ++n) acc[a][b][m][n] = (f32x4){0.f, 0.f, 0.f, 0.f};
    bf16x8 At[4][2], B0[2][2], B1[2][2];
    const int nt = K / BK;
    STAGE_B(SB(0, 0), 0, 0); STAGE_A(SA(0, 0), 0, 0);
    STAGE_B(SB(0, 1), 1, 0); STAGE_A(SA(0, 1), 1, 0);
    if (wr == 1) BAR();
    WAIT_V(4); BAR();
    STAGE_B(SB(1, 0), 0, 1); STAGE_A(SA(1, 0), 0, 1); STAGE_B(SB(1, 1), 1, 1);
    WAIT_V(6); BAR();
    for (int t = 0; t < nt - 2; t += 2) {
        LDB(B0, 0, 0); SCHED(); LDA(At, 0, 0); STAGE_A(SA(1, 1), 1, t + 1);
        WAIT_L(8); BAR(); WAIT_L(0); MMA(0, 0, At, B0); BAR(); SCHED();
        LDB(B1, 0, 1); STAGE_B(SB(0, 0), 0, t + 2);
        BAR(); WAIT_L(0); MMA(0, 1, At, B1); BAR();
        LDA(At, 0, 1); STAGE_A(SA(0, 0), 0, t + 2);
        BAR(); WAIT_L(0); MMA(1, 0, At, B0); BAR(); SCHED();
        STAGE_B(SB(0, 1), 1, t + 2);
        WAIT_V(6); BAR(); MMA(1, 1, At, B1); BAR();
        LDB(B0, 1, 0); SCHED(); LDA(At, 1, 0); STAGE_A(SA(0, 1), 1, t + 2);
        WAIT_L(8); BAR(); WAIT_L(0); MMA(0, 0, At, B0); BAR(); SCHED();
        LDB(B1, 1, 1); STAGE_B(SB(1, 0), 0, t + 3);
        BAR(); WAIT_L(0); MMA(0, 1, At, B1); BAR();
        LDA(At, 1, 1); STAGE_A(SA(1, 0), 0, t + 3);
        BAR(); WAIT_L(0); MMA(1, 0, At, B0); BAR(); SCHED();
        STAGE_B(SB(1, 1), 1, t + 3);
        WAIT_V(6); BAR(); MMA(1, 1, At, B1); BAR();
    }
    OPAQUE(tid); wid = tid >> 6; lane = tid & 63; wr = wid >> 2; wc = wid & 3; fr = lane & 15; fq = lane >> 4;
    { LDB(B0, 0, 0); WAIT_V(0); LDA(At, 0, 0); STAGE_A(SA(1, 1), 1, nt - 1);
      BAR(); WAIT_L(0); MMA(0, 0, At, B0); BAR();
      LDB(B1, 0, 1); BAR(); WAIT_L(0); MMA(0, 1, At, B1); BAR();
      LDA(At, 0, 1); WAIT_V(4); BAR(); WAIT_L(0); MMA(1, 0, At, B0); MMA(1, 1, At, B1); BAR(); }
    { LDB(B0, 1, 0); LDA(At, 1, 0); WAIT_V(2); BAR(); WAIT_L(0); MMA(0, 0, At, B0); BAR();
      LDB(B1, 1, 1); WAIT_V(0); BAR(); WAIT_L(0); MMA(0, 1, At, B1); BAR();
      LDA(At, 1, 1); BAR(); WAIT_L(0); MMA(1, 0, At, B0); MMA(1, 1, At, B1); BAR(); }
    if (wr == 0) BAR();
#undef SA
#undef SB
#undef STAGE_A
#undef STAGE_B
#undef LDA
#undef LDB
#undef MMA
}
__device__ __forceinline__ void stage_geom(int tid, int (&R)[2], int (&C)[2]) {
#pragma unroll
    for (int i = 0; i < 2; ++i) stage_rc(tid * 16 + i * 8192, R[i], C[i]);
}

constexpr int ATT_KBUF = 0, ATT_VBUF = 32768, ATT_CBUF = 65536;
template <int KIND>
__device__ __forceinline__ void attn_unit(const bf16_t* Q, const bf16_t* Kg, const bf16_t* VT, const float* cum2, const float* kmx, int qb, bf16_t* concat, int ccol0,
                                          float lam, float osc, const float* subg, unsigned char* lds, int tid) {
    const int lane = tid & 63, wave = tid >> 6, r16 = lane & 15, q4 = lane >> 4;
    const int q0w = qb * 128 + wave * 16, myq = q0w + r16;
    const int ntiles = 2 * qb + 2;
    const int wlimit = (KIND == 0) ? ((q0w + 15) >> 6) : (q0w >> 6);
    constexpr int NMAP = (KIND == 0) ? 1 : 2, NKS = (KIND == 0) ? 4 : 2;
    bf16x8 qf[NMAP][NKS];
#pragma unroll
    for (int mp = 0; mp < NMAP; ++mp)
#pragma unroll
        for (int ks = 0; ks < NKS; ++ks) qf[mp][ks] = *(const bf16x8*)(Q + (size_t)myq * 128 + mp * 64 + ks * 32 + q4 * 8);
    const float cq = (KIND == 0) ? cum2[myq] : 0.f;
    int kt0 = 0;
    if (KIND == 0) {
        float* wmax = (float*)(lds + ATT_CBUF + 512); int* kst = (int*)(lds + ATT_CBUF + 576);
        float qs = 0.f;
#pragma unroll
        for (int ks = 0; ks < NKS; ++ks)
#pragma unroll
            for (int j = 0; j < 8; ++j) { const float v = bf2f((bf16_t)qf[0][ks][j]); qs += v * v; }
        qs += SHX(qs, 16); qs += SHX(qs, 32);
        qs = fmaxf(qs, SHX(qs, 1)); qs = fmaxf(qs, SHX(qs, 2)); qs = fmaxf(qs, SHX(qs, 4)); qs = fmaxf(qs, SHX(qs, 8));
        if (lane == 0) wmax[wave] = qs;
        if (tid == 0) *kst = 2 * qb;
        __syncthreads();
        float qm = wmax[0];
#pragma unroll
        for (int w = 1; w < 8; ++w) qm = fmaxf(qm, wmax[w]);
        qm = sqrtf(qm) * 1.01f;
        const float kd = sqrtf(fmaxf(kmx[2 * qb], kmx[2 * qb + 1])) * 1.01f;
        if (tid < 2 * qb) {
            const float bias = cum2[qb * 128] - cum2[tid * 64 + 63];
            const bool skip = bias + qm * (sqrtf(kmx[tid]) * 1.01f + kd) < -40.f;
            if (!skip) atomic_min_int(kst, tid);
        }
        __syncthreads();
        kt0 = RFL(*kst);
    }
    f32x4 ot[NMAP][8];
    float mrun[NMAP], lsum[NMAP];
#pragma unroll
    for (int mp = 0; mp < NMAP; ++mp) { mrun[mp] = -INFINITY; lsum[mp] = 0.f;
#pragma unroll
        for (int mo = 0; mo < 8; ++mo) ot[mp][mo] = (f32x4){0.f, 0.f, 0.f, 0.f}; }
    u32x4 sk[2], sv[2]; float sc = 0.f;
    const u32x4* kg = (const u32x4*)Kg; const u32x4* vg = (const u32x4*)VT;
#pragma unroll
    for (int i = 0; i < 2; ++i) { sk[i] = kg[(size_t)kt0 * 1024 + tid + i * 512]; sv[i] = vg[(size_t)kt0 * 1024 + tid + i * 512]; }
    if (KIND == 0 && tid < 64) sc = cum2[kt0 * 64 + tid];
    for (int kt = kt0; kt < ntiles; ++kt) {
        unsigned char* kb = lds + ATT_KBUF + (kt & 1) * 16384;
        unsigned char* vb = lds + ATT_VBUF + (kt & 1) * 16384;
        float* cb = (float*)(lds + ATT_CBUF + (kt & 1) * 256);
#pragma unroll
        for (int i = 0; i < 2; ++i) {
            const int g = tid + i * 512;
            { const int row = g >> 4, c = g & 15; *(u32x4*)(kb + row * 256 + ((c ^ (row & 15)) << 4)) = sk[i]; }
            { const int d = g >> 3, c = g & 7; *(u32x4*)(vb + d * 128 + ((c ^ ((d >> 1) & 7)) << 4)) = sv[i]; }
        }
        if (KIND == 0 && tid < 64) cb[tid] = sc;
        __syncthreads();
        if (kt + 1 < ntiles) {
#pragma unroll
            for (int i = 0; i < 2; ++i) { sk[i] = kg[(size_t)(kt + 1) * 1024 + tid + i * 512]; sv[i] = vg[(size_t)(kt + 1) * 1024 + tid + i * 512]; }
            if (KIND == 0 && tid < 64) sc = cum2[(kt + 1) * 64 + tid];
        }
        if (kt <= wlimit) {
#pragma unroll
            for (int mp = 0; mp < NMAP; ++mp) {
                bf16x8 kf[4][NKS], vfa[8];
#pragma unroll
                for (int m = 0; m < 4; ++m)
#pragma unroll
                    for (int ks = 0; ks < NKS; ++ks) { const int c = (KIND == 0 ? 0 : mp * 8) + ks * 4 + q4; kf[m][ks] = *(const bf16x8*)(kb + (m * 16 + r16) * 256 + ((c ^ r16) << 4)); }
#pragma unroll
                for (int mo = 0; mo < 8; ++mo) { const int d = mo * 16 + r16; vfa[mo] = *(const bf16x8*)(vb + d * 128 + (((0 * 4 + q4) ^ ((d >> 1) & 7)) << 4)); }
                SCHED();
                f32x4 st[4];
#pragma unroll
                for (int m = 0; m < 4; ++m) st[m] = (f32x4){0.f, 0.f, 0.f, 0.f};
#pragma unroll
                for (int ks = 0; ks < NKS; ++ks)
#pragma unroll
                    for (int m = 0; m < 4; ++m) st[m] = MFMA16(kf[m][ks], qf[mp][ks], st[m]);
                SCHED();
                float mx = -INFINITY;
#pragma unroll
                for (int m = 0; m < 4; ++m) {
                    if (KIND == 0) {
                        const f32x4 ck = *(const f32x4*)(cb + m * 16 + 4 * q4);
#pragma unroll
                        for (int j = 0; j < 4; ++j) {
                            float y = st[m][j] + (cq - ck[j]);
                            if (kt * 64 + m * 16 + 4 * q4 + j > myq) y = -INFINITY;
                            st[m][j] = y;
                        }
                    }
#pragma unroll
                    for (int j = 0; j < 4; ++j) mx = fmaxf(mx, st[m][j]);
                }
                mx = fmaxf(mx, SHX(mx, 16));
                mx = fmaxf(mx, SHX(mx, 32));
                const float mnew = fmaxf(mrun[mp], mx);
                const float alpha = FAST_EXP2(mrun[mp] - mnew);
                mrun[mp] = mnew;
                float ps = 0.f;
#pragma unroll
                for (int m = 0; m < 4; ++m)
#pragma unroll
                    for (int j = 0; j < 4; ++j) { const float pv = FAST_EXP2(st[m][j] - mnew); st[m][j] = pv; ps += pv; }
                lsum[mp] = lsum[mp] * alpha + ps;
#pragma unroll
                for (int mo = 0; mo < 8; ++mo) ot[mp][mo] *= alpha;
                bf16x8 pf[2];
#pragma unroll
                for (int kk = 0; kk < 2; ++kk) {
                    u32x4 pw;
                    pw.x = pack2(st[2 * kk][0], st[2 * kk][1]); pw.y = pack2(st[2 * kk][2], st[2 * kk][3]);
                    pw.z = pack2(st[2 * kk + 1][0], st[2 * kk + 1][1]); pw.w = pack2(st[2 * kk + 1][2], st[2 * kk + 1][3]);
                    pf[kk] = __builtin_bit_cast(bf16x8, pw);
                }
                bf16x8 vfb[8];
#pragma unroll
                for (int mo = 0; mo < 8; ++mo) { const int d = mo * 16 + r16; vfb[mo] = *(const bf16x8*)(vb + d * 128 + (((1 * 4 + q4) ^ ((d >> 1) & 7)) << 4)); }
                SCHED();
#pragma unroll
                for (int mo = 0; mo < 8; ++mo) ot[mp][mo] = MFMA16(vfa[mo], pf[0], ot[mp][mo]);
                SCHED();
#pragma unroll
                for (int mo = 0; mo < 8; ++mo) ot[mp][mo] = MFMA16(vfb[mo], pf[1], ot[mp][mo]);
            }
        }
    }
    float inv[NMAP];
#pragma unroll
    for (int mp = 0; mp < NMAP; ++mp) { float l = lsum[mp]; l += SHX(l, 16); l += SHX(l, 32); inv[mp] = 1.f / l; }
    if (KIND == 0) {
#pragma unroll
        for (int mo = 0; mo < 8; ++mo) {
            u32x2 o; o.x = pack2(ot[0][mo][0] * inv[0], ot[0][mo][1] * inv[0]); o.y = pack2(ot[0][mo][2] * inv[0], ot[0][mo][3] * inv[0]);
            *(u32x2*)(concat + (size_t)myq * D + ccol0 + mo * 16 + 4 * q4) = o;
        }
    } else {
        float ss = 0.f;
#pragma unroll
        for (int mo = 0; mo < 8; ++mo)
#pragma unroll
            for (int j = 0; j < 4; ++j) { const float v = ot[0][mo][j] * inv[0] - lam * (ot[NMAP - 1][mo][j] * inv[NMAP - 1]); ot[0][mo][j] = v; ss += v * v; }
        ss += SHX(ss, 16); ss += SHX(ss, 32);
        const float rs = osc / sqrtf(ss * (1.f / 128.f) + LN_EPS);
#pragma unroll
        for (int mo = 0; mo < 8; ++mo) {
            const f32x4 g = *(const f32x4*)(subg + mo * 16 + 4 * q4);
            u32x2 o; o.x = pack2(ot[0][mo][0] * rs * g[0], ot[0][mo][1] * rs * g[1]); o.y = pack2(ot[0][mo][2] * rs * g[2], ot[0][mo][3] * rs * g[3]);
            *(u32x2*)(concat + (size_t)myq * D + ccol0 + mo * 16 + 4 * q4) = o;
        }
    }
    __syncthreads();
}

__device__ __forceinline__ int dpart_row(int c, int q) { return c * (S - DCH * 64) - (DCH * 32) * c * (c - 1) + q; }
__device__ __forceinline__ void attn_dmap_unit(const bf16_t* Qh, const bf16_t* Kh, const bf16_t* VTh, int mp, int qb, int t0, int t1,
                                               bf16_t* Op, float* ML, int c, float bnd, unsigned char* lds, int tid) {
    const bool fixedref = (bnd <= 60.f);
    const int lane = tid & 63, wave = tid >> 6, r16 = lane & 15, q4 = lane >> 4;
    const int q0w = qb * 256 + wave * 32;
    const int wlimit = q0w >> 6;
    bf16x8 qf[2][2];
#pragma unroll
    for (int n = 0; n < 2; ++n)
#pragma unroll
        for (int ks = 0; ks < 2; ++ks) qf[n][ks] = *(const bf16x8*)(Qh + (size_t)(q0w + n * 16 + r16) * 128 + mp * 64 + ks * 32 + q4 * 8);
    f32x4 ot[8][2];
    float mrun[2] = {-INFINITY, -INFINITY}, lsum[2] = {0.f, 0.f};
    if (fixedref) { mrun[0] = bnd; mrun[1] = bnd; }
    const float stinit = fixedref ? -bnd : 0.f;
#pragma unroll
    for (int mo = 0; mo < 8; ++mo) { ot[mo][0] = (f32x4){0.f, 0.f, 0.f, 0.f}; ot[mo][1] = (f32x4){0.f, 0.f, 0.f, 0.f}; }
    u32x4 sk, sv[2];
    const u32x4* kg = (const u32x4*)Kh; const u32x4* vg = (const u32x4*)VTh;
    const int krow = tid >> 3, kc8 = tid & 7;
    sk = kg[(size_t)t0 * 1024 + krow * 16 + mp * 8 + kc8];
#pragma unroll
    for (int i = 0; i < 2; ++i) sv[i] = vg[(size_t)t0 * 1024 + tid + i * 512];
    for (int kt = t0; kt < t1; ++kt) {
        unsigned char* kb = lds + (kt & 1) * 8192;
        unsigned char* vb = lds + 16384 + (kt & 1) * 16384;
        *(u32x4*)(kb + krow * 128 + ((kc8 ^ ((krow >> 1) & 7)) << 4)) = sk;
#pragma unroll
        for (int i = 0; i < 2; ++i) { const int g = tid + i * 512, d = g >> 3, cc = g & 7; *(u32x4*)(vb + d * 128 + ((cc ^ ((d >> 1) & 7)) << 4)) = sv[i]; }
        __syncthreads();
        if (kt + 1 < t1) {
            sk = kg[(size_t)(kt + 1) * 1024 + krow * 16 + mp * 8 + kc8];
#pragma unroll
            for (int i = 0; i < 2; ++i) sv[i] = vg[(size_t)(kt + 1) * 1024 + tid + i * 512];
        }
        if (kt <= wlimit) {
            bf16x8 kf[4][2], vfa[8];
#pragma unroll
            for (int m = 0; m < 4; ++m)
#pragma unroll
                for (int ks = 0; ks < 2; ++ks) kf[m][ks] = *(const bf16x8*)(kb + (m * 16 + r16) * 128 + (((ks * 4 + q4) ^ ((r16 >> 1) & 7)) << 4));
#pragma unroll
            for (int mo = 0; mo < 8; ++mo) { const int d = mo * 16 + r16; vfa[mo] = *(const bf16x8*)(vb + d * 128 + (((0 * 4 + q4) ^ ((d >> 1) & 7)) << 4)); }
            SCHED();
            f32x4 st[4][2];
#pragma unroll
            for (int m = 0; m < 4; ++m) { st[m][0] = (f32x4){stinit, stinit, stinit, stinit}; st[m][1] = (f32x4){stinit, stinit, stinit, stinit}; }
            SETPRIO(1);
#pragma unroll
            for (int ks = 0; ks < 2; ++ks)
#pragma unroll
                for (int m = 0; m < 4; ++m) { st[m][0] = MFMA16(kf[m][ks], qf[0][ks], st[m][0]); st[m][1] = MFMA16(kf[m][ks], qf[1][ks], st[m][1]); }
            SETPRIO(0);
            SCHED();
            float alpha[2] = {1.f, 1.f};
            if (fixedref) {
#pragma unroll
                for (int n = 0; n < 2; ++n) {
                    float ps = 0.f;
#pragma unroll
                    for (int m = 0; m < 4; ++m)
#pragma unroll
                        for (int j = 0; j < 4; ++j) { const float pv = FAST_EXP2(st[m][n][j]); st[m][n][j] = pv; ps += pv; }
                    lsum[n] += ps;
                }
            } else
#pragma unroll
            for (int n = 0; n < 2; ++n) {
                float mx = -INFINITY;
#pragma unroll
                for (int m = 0; m < 4; ++m)
#pragma unroll
                    for (int j = 0; j < 4; ++j) mx = fmaxf(mx, st[m][n][j]);
                mx = fmaxf(mx, SHX(mx, 16));
                mx = fmaxf(mx, SHX(mx, 32));
                const float mnew = fmaxf(mrun[n], mx);
                alpha[n] = FAST_EXP2(mrun[n] - mnew);
                mrun[n] = mnew;
                float ps = 0.f;
#pragma unroll
                for (int m = 0; m < 4; ++m)
#pragma unroll
                    for (int j = 0; j < 4; ++j) { const float pv = FAST_EXP2(st[m][n][j] - mnew); st[m][n][j] = pv; ps += pv; }
                lsum[n] = lsum[n] * alpha[n] + ps;
            }
            if (ANY_LANE(alpha[0] != 1.f)) {
#pragma unroll
                for (int mo = 0; mo < 8; ++mo) ot[mo][0] *= alpha[0];
            }
            if (ANY_LANE(alpha[1] != 1.f)) {
#pragma unroll
                for (int mo = 0; mo < 8; ++mo) ot[mo][1] *= alpha[1];
            }
            bf16x8 pf[2][2];
#pragma unroll
            for (int kk = 0; kk < 2; ++kk)
#pragma unroll
                for (int n = 0; n < 2; ++n) {
                    u32x4 pw;
                    pw.x = pack2(st[2 * kk][n][0], st[2 * kk][n][1]); pw.y = pack2(st[2 * kk][n][2], st[2 * kk][n][3]);
                    pw.z = pack2(st[2 * kk + 1][n][0], st[2 * kk + 1][n][1]); pw.w = pack2(st[2 * kk + 1][n][2], st[2 * kk + 1][n][3]);
                    pf[kk][n] = __builtin_bit_cast(bf16x8, pw);
                }
            bf16x8 vfb[8];
#pragma unroll
            for (int mo = 0; mo < 8; ++mo) { const int d = mo * 16 + r16; vfb[mo] = *(const bf16x8*)(vb + d * 128 + (((1 * 4 + q4) ^ ((d >> 1) & 7)) << 4)); }
            SCHED();
            SETPRIO(1);
#pragma unroll
            for (int mo = 0; mo < 8; ++mo) { ot[mo][0] = MFMA16(vfa[mo], pf[0][0], ot[mo][0]); ot[mo][1] = MFMA16(vfa[mo], pf[0][1], ot[mo][1]); }
            SCHED();
#pragma unroll
            for (int mo = 0; mo < 8; ++mo) { ot[mo][0] = MFMA16(vfb[mo], pf[1][0], ot[mo][0]); ot[mo][1] = MFMA16(vfb[mo], pf[1][1], ot[mo][1]); }
            SETPRIO(0);
        }
    }
    if (q0w >= DCH * 64 * c)
#pragma unroll
    for (int n = 0; n < 2; ++n) {
        float l = lsum[n]; l += SHX(l, 16); l += SHX(l, 32);
        const int row = dpart_row(c, q0w + n * 16 + r16);
#pragma unroll
        for (int mo = 0; mo < 8; ++mo) {
            u32x2 o; o.x = pack2(ot[mo][n][0], ot[mo][n][1]); o.y = pack2(ot[mo][n][2], ot[mo][n][3]);
            *(u32x2*)(Op + (size_t)(row * 128 + mo * 16 + 4 * q4)) = o;
        }
        if (q4 == 0) { ML[row * 2] = mrun[n]; ML[row * 2 + 1] = l; }
    }
    __syncthreads();
}

__device__ __forceinline__ void lru_unit_a(int chunk, int grp, int l, const Params& p, const bf16_t* Xr, const bf16_t* WaiT, float* hloc, float* ploc, float* sumA, float* sumH,
                                           unsigned char* lds, int tid) {
    const int lane = tid & 63, wave = tid >> 6, r16 = lane & 15, q4 = lane >> 4;
    unsigned char* XCB = lds; float* XU = (float*)(lds + 16384); float* LA = (float*)(lds + 49152); float* ENDS = (float*)(lds + 81920);
    const int t0 = chunk * 64, ch0 = grp * 128;
    {
        const int c = tid & 127, tq = tid >> 7, ch = ch0 + c;
        const float* cw = p.in[I_CONVW] + (size_t)l * 4 * LRU_W + ch; const float cb = p.in[I_CONVB][(size_t)l * LRU_W + ch];
        const float w0 = cw[0], w1 = cw[LRU_W], w2 = cw[2 * LRU_W], w3 = cw[3 * LRU_W];
        const int ts = t0 + tq * 16;
        float x0 = (ts - 3 >= 0) ? bf2f(Xr[(size_t)(ts - 3) * LRU_W + ch]) : 0.f;
        float x1 = (ts - 2 >= 0) ? bf2f(Xr[(size_t)(ts - 2) * LRU_W + ch]) : 0.f;
        float x2 = (ts - 1 >= 0) ? bf2f(Xr[(size_t)(ts - 1) * LRU_W + ch]) : 0.f;
#pragma unroll
        for (int i = 0; i < 16; ++i) {
            const float x3 = bf2f(Xr[(size_t)(ts + i) * LRU_W + ch]);
            const float v = cb + w0 * x0 + w1 * x1 + w2 * x2 + w3 * x3;
            const int row = tq * 16 + i;
            XU[row * 128 + c] = v;
            *(bf16_t*)(XCB + row * 256 + (((c >> 3) ^ (row & 15)) << 4) + (c & 7) * 2) = f2bf(v);
            x0 = x1; x1 = x2; x2 = x3;
        }
    }
    __syncthreads();
    {
        bf16x8 bfr[2][4];
#pragma unroll
        for (int g = 0; g < 2; ++g)
#pragma unroll
            for (int ks = 0; ks < 4; ++ks) bfr[g][ks] = *(const bf16x8*)(WaiT + ((size_t)grp * 256 + g * 128 + wave * 16 + r16) * 128 + ks * 32 + q4 * 8);
        const int ch = ch0 + wave * 16 + r16;
        const float ba = p.in[I_BA][(size_t)l * LRU_W + ch], bi = p.in[I_BI][(size_t)l * LRU_W + ch];
        const float lsl = 8.0f * log_sigmoid_f(p.in[I_LAM][(size_t)l * LRU_W + ch]);
#pragma unroll
        for (int mt = 0; mt < 4; ++mt) {
            f32x4 ga = (f32x4){0.f, 0.f, 0.f, 0.f}, gi = (f32x4){0.f, 0.f, 0.f, 0.f};
#pragma unroll
            for (int ks = 0; ks < 4; ++ks) {
                const bf16x8 af = *(const bf16x8*)(XCB + (mt * 16 + r16) * 256 + (((ks * 4 + q4) ^ r16) << 4));
                ga = MFMA16(af, bfr[0][ks], ga); gi = MFMA16(af, bfr[1][ks], gi);
            }
#pragma unroll
            for (int j = 0; j < 4; ++j) {
                const int row = mt * 16 + 4 * q4 + j, idx = row * 128 + wave * 16 + r16;
                const float r = sigmoid_f(ga[j] + ba), ig = sigmoid_f(gi[j] + bi);
                const float log_a = lsl * r;
                LA[idx] = fexp(log_a);
                XU[idx] = sqrtf(neg_expm1_f(2.f * log_a)) * (ig * XU[idx]);
            }
        }
    }
    __syncthreads();
    {
        const int c = tid & 127, tq = tid >> 7, ch = ch0 + c;
        float h = 0.f, P = 1.f;
#pragma unroll
        for (int i = 0; i < 16; ++i) { const int idx = (tq * 16 + i) * 128 + c; const float a = LA[idx]; h = a * h + XU[idx]; P *= a; XU[idx] = h; LA[idx] = P; }
        ENDS[tq * 128 + c] = P; ENDS[512 + tq * 128 + c] = h;
        __syncthreads();
        float cin = 0.f, pin = 1.f;
        for (int s = 0; s < tq; ++s) { const float Ps = ENDS[s * 128 + c], hs = ENDS[512 + s * 128 + c]; cin = Ps * cin + hs; pin *= Ps; }
#pragma unroll
        for (int i = 0; i < 16; ++i) {
            const int idx = (tq * 16 + i) * 128 + c; const size_t gi = (size_t)(t0 + tq * 16 + i) * LRU_W + ch;
            const float Pl = LA[idx], hl = XU[idx];
            ((unsigned*)hloc)[gi] = pack2(hl + Pl * cin, Pl * pin);
        }
        if (tq == 3) { const float Pl = LA[63 * 128 + c], hl = XU[63 * 128 + c]; sumA[(size_t)chunk * LRU_W + ch] = Pl * pin; sumH[(size_t)chunk * LRU_W + ch] = hl + Pl * cin; }
    }
    __syncthreads();
}

__device__ __forceinline__ void moe_prefix(const int* cntb_, int G, unsigned char* lds, int tid) {
    int* tmp = (int*)lds; int* ctot = (int*)(lds + LDS_MISC + M_CTOT); int* coff = (int*)(lds + LDS_MISC + M_COFF);
    unsigned short* pre16 = (unsigned short*)(lds + LDS_MISC + M_PRE16);
    const int e = tid & 31, part = tid >> 5, PB = (G + 15) / 16;
    int sm = 0;
    for (int i = 0; i < PB; ++i) { const int b = part * PB + i; if (b < G) sm += cntb_[b * 32 + e]; }
    tmp[part * 32 + e] = sm;
    __syncthreads();
    int run = 0;
    for (int q = 0; q < part; ++q) run += tmp[q * 32 + e];
    for (int i = 0; i < PB; ++i) { const int b = part * PB + i; if (b < G) { pre16[e * 257 + b] = (unsigned short)run; run += cntb_[b * 32 + e]; } }
    if (part == 15) { ctot[e] = run; pre16[e * 257 + G] = (unsigned short)run; }
    __syncthreads();
    if (tid == 0) { int o = 0; for (int q = 0; q < 32; ++q) { coff[q] = o; o += ctot[q]; } coff[32] = o; }
    __syncthreads();
}
__device__ __forceinline__ void moe_rowtable(const int* ltok_, const float* lw_, const int* lslot_, int e, int m0, int c_e, int G, int segcap, unsigned char* lds, int tid_in) {
    int tid = tid_in; OPAQUE(tid);
    const unsigned short* pre = (const unsigned short*)(lds + LDS_MISC + M_PRE16) + e * 257;
    int* rtok = (int*)(lds + LDS_MISC + M_RTOK); float* rw = (float*)(lds + LDS_MISC + M_RW); int* rslot = (int*)(lds + LDS_MISC + M_RSLOT);
    if (tid < 256) {
        const int g = m0 + tid;
        int tk = 0, sl = 0; float w = 0.f;
        if (g < c_e) {
            int lo = 0, hi = G;
            while (hi - lo > 1) { const int mid = (lo + hi) >> 1; if ((int)pre[mid] <= g) lo = mid; else hi = mid; }
            const int idx = (e * G + lo) * segcap + (g - (int)pre[lo]);
            tk = ltok_[idx]; w = lw_[idx]; sl = lslot_[idx];
        }
        rtok[tid] = tk; rw[tid] = w; rslot[tid] = sl;
    }
    __syncthreads();
}
#define kmax2 ((float*)(wsl + A_KMAX))
#define dpo ((bf16_t*)(wsl + A_DPO))
#define dpml ((float*)(wsl + A_DPML))
#define cntb ((int*)(wsl + A_CNTB))
#define WinT ((bf16_t*)(wsl + WB_WIN))
#define WoT ((bf16_t*)(wsl + WB_WO))
#define WguT ((bf16_t*)(wsl + WB_WGU))
#define WdT ((bf16_t*)(wsl + WB_WD))
#define WaiT ((bf16_t*)(wsl + WB_WAI))
#define Wfa ((float*)(wsl + WF_FA))
#define W36b ((bf16_t*)(wsl + WF_R36))
#define ropecs ((float*)(wsl + WF_ROPE))
#define xb ((bf16_t*)(wsl + A_XB))
#define hb ((float*)(wsl + A_HB))
#define logf_ ((float*)(wsl + A_LOGF))
#define cum2 ((float*)(wsl + A_CUM))
#define Qa ((bf16_t*)(wsl + A_QA))
#define Ka ((bf16_t*)(wsl + A_KA))
#define VaT ((bf16_t*)(wsl + A_VAT))
#define Xr ((bf16_t*)(wsl + A_XR))
#define Gr ((bf16_t*)(wsl + A_GR))
#define Qc ((bf16_t*)(wsl + A_QC))
#define Kc ((bf16_t*)(wsl + A_KC))
#define VcT ((bf16_t*)(wsl + A_VCT))
#define hloc ((float*)(wsl + A_HLOC))
#define ploc ((float*)(wsl + A_PLOC))
#define sumA ((float*)(wsl + A_SUMA))
#define sumH ((float*)(wsl + A_SUMH))
#define concat ((bf16_t*)(wsl + A_CONCAT))
#define y1 ((float*)(wsl + A_Y1))
#define h1 ((float*)(wsl + A_H1))
#define lnstat ((float*)(wsl + A_H1 + (size_t)32 * 1024 * 1024))
#define h1b ((bf16_t*)(wsl + A_H1B))
#define ltok ((int*)(wsl + A_LTOK))
#define lw ((float*)(wsl + A_LW))
#define lslot ((int*)(wsl + A_LSLOT))
#define act ((bf16_t*)(wsl + A_ACT))
#define contrib ((bf16_t*)(wsl + A_CONTRIB))
#ifndef EMU
__global__ void __launch_bounds__(NTHREADS, 2)
#else
void
#endif
fwd_kernel(Params p) {
    DYN_LDS(lds_raw);
    float* ldsf = (float*)lds_raw;
    const int bid = blockIdx.x, G = gridDim.x;
    const int gthreads = G * NTHREADS, gwaves = G * (NTHREADS / 64);
    const int wave_s = RFL((int)threadIdx.x >> 6);
#define PHASE_IDS() unsigned char* wsl = ws; OPAQUE_S(wsl); int tid = wave_s * 64 + LANE_ID(); OPAQUE(tid); const int lane = tid & 63, wave = tid >> 6, gtid = bid * NTHREADS + tid, gwave = bid * (NTHREADS / 64) + wave; (void)lane; (void)wave; (void)gtid; (void)gwave

    unsigned char* ws = p.ws;
    volatile LAS unsigned* bst = (volatile LAS unsigned*)(lds_raw + LDS_MISC);
    unsigned* ubox = (unsigned*)(lds_raw + LDS_MISC + 16);
    if (threadIdx.x == 0) { bst[0] = 0u; bst[1] = 0u; bst[2] = 0u; bst[3] = 0u; }
    __syncthreads();
    XcdBarrier bar = xcd_barrier_post((unsigned*)ws, bst);

    const int* positions = (const int*)p.in[I_POS];

    constexpr int NPH = 8;
    const int lo = p.lo, hi = p.hi;
#ifdef ONLY_PHASE
#define PH_SEL(c) ((c) == ONLY_PHASE)
#else
#define PH_SEL(c) 1
#endif
#define PH_IN(k) (lo <= (k) && (k) < hi)
#define PH_BAR(k) do { if ((k) + 1 < hi) xcd_barrier(bar, wave_s == 0 && LANE_ID() == 0); } while (0)

    if (PH_SEL(-1) && PH_IN(0)) for (int rep = 0; rep < PH_REPS(-1); ++rep) {
        PHASE_IDS();
        for (int l = 0; l < DEPTH; ++l) {
            convert_mats(p.in[I_WIN] + (size_t)l * D * N_IN, 0, 1, N_IN, D, N_IN, WinT + (size_t)l * N_INP * D, 0, RmWin{}, ldsf, tid, bid, G);
            convert_mats(p.in[I_WO] + (size_t)l * D * D, 0, 1, D, D, D, WoT + (size_t)l * D * D, 0, RmIdent{}, ldsf, tid, bid, G);
            convert_mats(p.in[I_WA] + (size_t)l * 6 * 128 * 128, (size_t)128 * 128, 6, 128, 128, 128, WaiT + (size_t)l * 6 * 256 * 128, (size_t)256 * 128, RmIdent{}, ldsf, tid, bid, G);
            convert_mats(p.in[I_WI] + (size_t)l * 6 * 128 * 128, (size_t)128 * 128, 6, 128, 128, 128, WaiT + (size_t)l * 6 * 256 * 128, (size_t)256 * 128, RmOff{128}, ldsf, tid, bid, G);
        }
        for (int i = gtid; i < DEPTH * 8 * D; i += gthreads) { const int k = i % D, h = (i / D) % 8, l = i / (8 * D);
            Wfa[i] = (h < 6) ? p.in[I_WIN][(size_t)l * D * N_IN + (size_t)k * N_IN + C_FA + h] : 0.f; }
        for (int i = gtid; i < DEPTH * 48 * D; i += gthreads) { const int k = i % D, o = (i / D) % 48, l = i / (48 * D);
            const float w = (o < 4) ? p.in[I_WGRP][((size_t)l * D + k) * 4 + o] : (o < 36 ? p.in[I_WRT][((size_t)l * D + k) * 32 + (o - 4)] : 0.f);
            const bf16_t hi = f2bf(w);
            W36b[((size_t)l * 2 + 0) * 48 * D + (size_t)o * D + k] = hi; W36b[((size_t)l * 2 + 1) * 48 * D + (size_t)o * D + k] = f2bf(w - bf2f(hi)); }
        for (int i = gtid; i < S * 8; i += gthreads) { const int d = i & 7, t = i >> 3; const float ang = (float)positions[t] * p.inv_freq[d];
            ropecs[t * 16 + d] = cosf(ang); ropecs[t * 16 + 8 + d] = sinf(ang); }
        __syncthreads();
        for (int i = tid; i < 6 * D; i += NTHREADS) { const int k = i % D, h = i / D; ldsf[i] = p.in[I_WIN][(size_t)k * N_IN + C_FA + h]; }
        __syncthreads();
        for (int t0 = gwave * 2; t0 < S; t0 += gwaves * 2) {
            f32x4 v[2][8];
#pragma unroll
            for (int tk = 0; tk < 2; ++tk)
#pragma unroll
                for (int j = 0; j < 8; ++j) v[tk][j] = *(const f32x4*)(p.in[I_X] + (size_t)(t0 + tk) * D + j * 256 + lane * 4);
#pragma unroll
            for (int tk = 0; tk < 2; ++tk) {
                const int t = t0 + tk;
                float fa[6] = {0.f, 0.f, 0.f, 0.f, 0.f, 0.f};
#pragma unroll
                for (int j = 0; j < 8; ++j) {
                    const int c = j * 256 + lane * 4;
                    u32x2 o; o.x = pack2(v[tk][j][0], v[tk][j][1]); o.y = pack2(v[tk][j][2], v[tk][j][3]);
                    *(u32x2*)(xb + (size_t)t * D + c) = o;
#pragma unroll
                    for (int h = 0; h < 6; ++h) { const f32x4 w = *(const f32x4*)(ldsf + h * D + c); fa[h] += v[tk][j][0] * w[0] + v[tk][j][1] * w[1] + v[tk][j][2] * w[2] + v[tk][j][3] * w[3]; }
                    COMPILER_FENCE();
                }
#pragma unroll
                for (int h = 0; h < 6; ++h) { const float sm = wave_sum(fa[h]); if (lane == 0) logf_[h * S + t] = log_sigmoid_f(sm + p.in[I_BF][h]); }
            }
        }
        PH_BAR(0);
    }

    for (int l = 0; l < DEPTH; ++l) {
        const int pb = 1 + l * NPH;
#define hin ((l == 0) ? p.in[I_X] : (const float*)hb)
#define hout ((l == DEPTH - 1) ? p.out : hb)
#define workctr ((int*)(wsl + CTL_WORK_OFF) + l * 64)

        if (PH_SEL(0) && PH_IN(pb + 0)) {
            PHASE_IDS();
            int bz = bid; OPAQUE_S(bz);
            if (bz == 0) {
                double* part = (double*)lds_raw;
                const int per = S / 64;
                double s = 0.0;
                if (wave < 6) { for (int i = 0; i < per; ++i) s += (double)logf_[wave * S + lane * per + i]; part[wave * 64 + lane] = s; }
                __syncthreads();
                if (wave < 6) {
                    double run = 0.0;
                    for (int j = 0; j < lane; ++j) run += part[wave * 64 + j];
                    for (int i = 0; i < per; ++i) { run += (double)logf_[wave * S + lane * per + i]; cum2[wave * S + lane * per + i] = (float)(run * (double)LOG2E); }
                }
                __syncthreads();
            }
            bool conv_more = (l == 0);
#define CONV_ONE() do { if (conv_more) { __syncthreads(); if (tid == 0) *ubox = (unsigned)atomic_add_int((int*)(wsl + CTL_WORK_OFF) + 62, 1); __syncthreads(); \
                const int cid_ = RFL((int)*ubox); if (cid_ < NCONV) moe_conv_chunk(p, cid_, WguT, WdT, ldsf, tid); else conv_more = false; } } while (0)
            unsigned* cls = (unsigned*)(wsl + CTL_CLS_OFF) + l * 256;
            if (bz == 0) { WAIT_VM0(); __syncthreads(); if (tid == 0) { FENCE_REL_AGENT(); WAIT_VM0(); (void)xb_add(&cls[192], 1u); } }
            const bf16_t* Bt = WinT + (size_t)l * N_INP * D;
            constexpr int ntm = S / 256;
            const unsigned nooff[2][2] = {{0u, 0u}, {0u, 0u}};
            for (int i = 0; i < (bid & 3); ++i) CONV_ONE();
            for (;;) {
                __syncthreads();
                if (tid == 0) *ubox = (unsigned)atomic_add_int(workctr + 9, 1);
                __syncthreads();
                int t = RFL((int)*ubox);
                if (t >= ntm * 21) break;
                int pm, pn, kcls;
                if (t < ntm * 6) { pm = t / 6; pn = 15 + t % 6; kcls = 0; }
                else if (t < ntm * 12) { t -= ntm * 6; pm = t / 6; pn = 9 + t % 6; kcls = 1; }
                else { t -= ntm * 12; pm = t / 9; pn = t % 9; kcls = 2; }
                f32x4 acc[2][2][4][2];
                gemm_tile<false>(xb, pm * 256, nooff, Bt, pn * 256, D, lds_raw, acc, tid);
                int et = tid; OPAQUE(et); const int wr = et >> 8, wc = (et >> 6) & 3, fr = et & 15, fq = (et >> 4) & 3;
                if (pn < 6 || (pn >= 9 && pn < 19)) {
                    bf16_t* dst; float scale = 1.f; bool rope = false;
                    if (pn < 3) { dst = Qa; scale = QSCALE_A; } else if (pn < 6) { dst = Ka; } else if (pn < 12) { dst = Xr; } else if (pn < 15) { dst = Gr; }
                    else if (pn < 17) { dst = Qc; scale = QSCALE_C; rope = true; } else { dst = Kc; rope = true; }
                    const bool headmajor = (pn < 6) || (pn >= 15);
                    const int segpn = (pn < 3) ? pn : (pn < 6) ? pn - 3 : (pn < 12) ? pn - 9 : (pn < 15) ? pn - 12 : (pn < 17) ? pn - 15 : pn - 17;
#pragma unroll
                    for (int ai = 0; ai < 2; ++ai)
#pragma unroll
                        for (int m = 0; m < 4; ++m)
#pragma unroll
                            for (int bj = 0; bj < 2; ++bj)
#pragma unroll
                                for (int n = 0; n < 2; ++n) {
                                    const int dd = wc * 32 + n * 16 + fr;
#pragma unroll
                                    for (int j = 0; j < 4; ++j) {
                                        const int row = pm * 256 + ai * 128 + wr * 64 + m * 16 + fq * 4 + j;
                                        float v = acc[ai][bj][m][n][j];
                                        if (rope && n == 0 && (wc & 1) == 0) {
                                            const float pv = SHX(v, 8);
                                            const float cs = ropecs[row * 16 + (fr & 7)], sn = ropecs[row * 16 + 8 + (fr & 7)];
                                            v = (fr < 8) ? (v * cs - pv * sn) : (v * cs + pv * sn);
                                        }
                                        v *= scale;
                                        *(bf16_t*)(lds_raw + (ai * 128 + wr * 64 + m * 16 + fq * 4 + j) * 528 + (bj * 128 + dd) * 2) = f2bf(v);
                                    }
                                }
                    __syncthreads();
#pragma unroll 4
                    for (int i = 0; i < 16; ++i) {
                        const int idx = et + i * 512, lrow = idx >> 5, ch = idx & 31, row = pm * 256 + lrow;
                        const u32x4 val = *(const u32x4*)(lds_raw + lrow * 528 + ch * 16);
                        size_t gi;
                        if (headmajor) gi = ((size_t)(segpn * 2 + (ch >> 4)) * S + row) * 128 + (ch & 15) * 8;
                        else gi = (size_t)row * LRU_W + segpn * 256 + ch * 8;
                        *(u32x4*)(dst + gi) = val;
                    }
                    __syncthreads();
                    if (pn >= 15) {
                        float* part = ldsf;
#pragma unroll
                        for (int ai = 0; ai < 2; ++ai)
#pragma unroll
                            for (int m = 0; m < 4; ++m)
#pragma unroll
                                for (int bj = 0; bj < 2; ++bj)
#pragma unroll
                                    for (int j = 0; j < 4; ++j) {
                                        float ss = acc[ai][bj][m][0][j] * acc[ai][bj][m][0][j] + acc[ai][bj][m][1][j] * acc[ai][bj][m][1][j];
                                        ss += SHX(ss, 1); ss += SHX(ss, 2); ss += SHX(ss, 4); ss += SHX(ss, 8);
                                        if (fr == 0) part[(wc * 2 + bj) * 256 + ai * 128 + wr * 64 + m * 16 + fq * 4 + j] = ss;
                                    }
                        __syncthreads();
                        {
                            const int bj = et >> 8, row = et & 255;
                            float v0 = part[(0 * 2 + bj) * 256 + row] + part[(1 * 2 + bj) * 256 + row], v1 = part[(2 * 2 + bj) * 256 + row] + part[(3 * 2 + bj) * 256 + row];
                            v0 = fmaxf(v0, SHX(v0, 1)); v0 = fmaxf(v0, SHX(v0, 2)); v0 = fmaxf(v0, SHX(v0, 4)); v0 = fmaxf(v0, SHX(v0, 8)); v0 = fmaxf(v0, SHX(v0, 16)); v0 = fmaxf(v0, SHX(v0, 32));
                            v1 = fmaxf(v1, SHX(v1, 1)); v1 = fmaxf(v1, SHX(v1, 2)); v1 = fmaxf(v1, SHX(v1, 4)); v1 = fmaxf(v1, SHX(v1, 8)); v1 = fmaxf(v1, SHX(v1, 16)); v1 = fmaxf(v1, SHX(v1, 32));
                            if ((et & 63) == 0) {
                                unsigned* q2p = (unsigned*)(wsl + CTL_QK2_OFF) + l * 16 + (pn >= 17 ? 8 : 0) + (segpn * 2 + bj) * 2;
                                atomic_max_u32(q2p, __builtin_bit_cast(unsigned, v0)); atomic_max_u32(q2p + 1, __builtin_bit_cast(unsigned, v1));
                            }
                        }
                        __syncthreads();
                    }
                    if (pn >= 3 && pn < 6) {
                        float* part = ldsf;
#pragma unroll
                        for (int ai = 0; ai < 2; ++ai)
#pragma unroll
                            for (int m = 0; m < 4; ++m)
#pragma unroll
                                for (int bj = 0; bj < 2; ++bj)
#pragma unroll
                                    for (int j = 0; j < 4; ++j) {
                                        float ss = acc[ai][bj][m][0][j] * acc[ai][bj][m][0][j] + acc[ai][bj][m][1][j] * acc[ai][bj][m][1][j];
                                        ss += SHX(ss, 1); ss += SHX(ss, 2); ss += SHX(ss, 4); ss += SHX(ss, 8);
                                        if (fr == 0) part[(wc * 2 + bj) * 256 + ai * 128 + wr * 64 + m * 16 + fq * 4 + j] = ss;
                                    }
                        __syncthreads();
                        {
                            const int bj = et >> 8, row = et & 255;
                            float v = part[(0 * 2 + bj) * 256 + row] + part[(1 * 2 + bj) * 256 + row] + part[(2 * 2 + bj) * 256 + row] + part[(3 * 2 + bj) * 256 + row];
                            v = fmaxf(v, SHX(v, 1)); v = fmaxf(v, SHX(v, 2)); v = fmaxf(v, SHX(v, 4)); v = fmaxf(v, SHX(v, 8)); v = fmaxf(v, SHX(v, 16)); v = fmaxf(v, SHX(v, 32));
                            if ((et & 63) == 0) kmax2[((pn - 3) * 2 + bj) * NKT + pm * 4 + ((et >> 6) & 3)] = v;
                        }
                        __syncthreads();
                    }
                } else {
                    bf16_t* dst = (pn < 9) ? VaT : VcT;
                    const int segpn = (pn < 9) ? pn - 6 : pn - 19;
#pragma unroll
                    for (int ai = 0; ai < 2; ++ai)
#pragma unroll
                        for (int m = 0; m < 4; ++m)
#pragma unroll
                            for (int bj = 0; bj < 2; ++bj)
#pragma unroll
                                for (int n = 0; n < 2; ++n) {
                                    const int dd = wc * 32 + n * 16 + fr;
                                    const int row = pm * 256 + ai * 128 + wr * 64 + m * 16 + fq * 4;
                                    const f32x4 a = acc[ai][bj][m][n];
                                    u32x2 o; o.x = pack2(a[0], a[1]); o.y = pack2(a[2], a[3]);
                                    const int s6 = row & 63, pos = (s6 & 32) + ((s6 >> 2) & 3) * 8 + ((s6 >> 4) & 1) * 4;
                                    *(u32x2*)(dst + (((size_t)(segpn * 2 + bj) * NKT + (row >> 6)) * 128 + dd) * 64 + pos) = o;
                                }
                }
                WAIT_VM0();
                __syncthreads();
                if (et == 0) { FENCE_REL_AGENT(); WAIT_VM0(); (void)xb_add(&cls[kcls * 64], 1u); }
                CONV_ONE();
            }
        }

        if (PH_SEL(1) && PH_IN(pb + 1)) {
            PHASE_IDS();
            const float lam_init = (l == 0) ? 0.2f : 0.35550906759f;
            const float s1 = wave_sum(p.in[I_LQ1][l * 64 + lane] * p.in[I_LK1][l * 64 + lane]);
            const float s2 = wave_sum(p.in[I_LQ2][l * 64 + lane] * p.in[I_LK2][l * 64 + lane]);
            const float lam = fexp(s1) - fexp(s2) + lam_init;
            constexpr int NLRU = NKT * 6, NQB = S / 128;
            bool conv_more = (l == 0);
            unsigned* cls = (unsigned*)(wsl + CTL_CLS_OFF) + l * 256;
            unsigned* bw = (unsigned*)wsl;
#define WAIT_CLASS(k, n) do { __syncthreads(); if (tid == 0) { XB_SPIN(xb_ld(&cls[(k) * 64]) < (unsigned)(n), bw); FENCE_ACQ_AGENT(); WAIT_VM0(); } __syncthreads(); } while (0)
#ifndef NO_LRU
            WAIT_CLASS(1, (S / 256) * 6);
            for (;;) {
                __syncthreads();
                if (tid == 0) *ubox = (unsigned)atomic_add_int(workctr + 10, 1);
                __syncthreads();
                const int u = RFL((int)*ubox);
                if (u >= NLRU) break;
                lru_unit_a(u / 6, u % 6, l, p, Xr, WaiT + (size_t)l * 6 * 256 * 128, hloc, ploc, sumA, sumH, lds_raw, tid);
            }
#endif
#ifndef NO_DIFF
            {
                constexpr int NQB2 = S / 256;
                int total = 0;
                for (int q = 0; q < NQB2; ++q) total += ((4 * q + 4 + DCH - 1) / DCH) * 8;
                WAIT_CLASS(0, (S / 256) * 6);
                for (;;) {
                    __syncthreads();
                    if (tid == 0) *ubox = (unsigned)atomic_add_int(workctr, 1);
                    __syncthreads();
                    int u = RFL((int)*ubox);
                    if (u >= total) break;
                    int qb = NQB2 - 1;
                    for (;; --qb) { const int nu = ((4 * qb + 4 + DCH - 1) / DCH) * 8; if (u < nu) break; u -= nu; }
                    const int c = u >> 3, h = (u >> 1) & 3, mp = u & 1;
                    const int t0 = c * DCH, t1 = (t0 + DCH < 4 * qb + 4) ? t0 + DCH : 4 * qb + 4;
                    const unsigned* q2p = (const unsigned*)(wsl + CTL_QK2_OFF) + l * 16;
                    const float bnd = sqrtf(__builtin_bit_cast(float, q2p[h * 2 + mp]) * __builtin_bit_cast(float, q2p[8 + h * 2 + mp])) * (QSCALE_C * 1.02f) + 0.01f;
                    attn_dmap_unit(Qc + (size_t)h * S * 128, Kc + (size_t)h * S * 128, VcT + (size_t)h * S * 128, mp, qb, t0, t1,
                                   dpo + (size_t)(h * 2 + mp) * DPART_ROWS * 128, dpml + (size_t)(h * 2 + mp) * DPART_ROWS * 2, c, RFL_F(bnd), lds_raw, tid);
                    CONV_ONE();
                }
            }
#endif
#ifndef NO_FOX
            WAIT_CLASS(2, (S / 256) * 9);
            WAIT_CLASS(3, 1);
            for (;;) {
                __syncthreads();
                if (tid == 0) *ubox = (unsigned)atomic_add_int(workctr + 1, 1);
                __syncthreads();
                const int u = RFL((int)*ubox);
                if (u >= NQB * FOX_H) break;
                const int qb = NQB - 1 - u / FOX_H, h = u % FOX_H;
                attn_unit<0>(Qa + (size_t)h * S * 128, Ka + (size_t)h * S * 128, VaT + (size_t)h * S * 128, cum2 + (size_t)h * S, kmax2 + h * NKT, qb, concat, h * 128,
                             0.f, 0.f, nullptr, lds_raw, tid);
            }
#endif
            while (conv_more) CONV_ONE();
            PH_BAR(pb + 1);
        }

        if (PH_SEL(2) && PH_IN(pb + 2)) for (int rep = 0; rep < PH_REPS(2); ++rep) {
            PHASE_IDS();
            for (int u = bid; u < NKT * 6; u += G) {
                const int chunk = u / 6, grp = u % 6, c = tid & 127, tq = tid >> 7, ch = grp * 128 + c;
                float cr = 0.f;
                {
                    int j = 0;
                    for (; j + 16 <= chunk; j += 16) {
                        float a8[16], h8[16];
#pragma unroll
                        for (int q = 0; q < 16; ++q) { a8[q] = sumA[(size_t)(j + q) * LRU_W + ch]; h8[q] = sumH[(size_t)(j + q) * LRU_W + ch]; }
#pragma unroll
                        for (int q = 0; q < 16; ++q) cr = a8[q] * cr + h8[q];
                    }
                    for (; j < chunk; ++j) cr = sumA[(size_t)j * LRU_W + ch] * cr + sumH[(size_t)j * LRU_W + ch];
                }
                float hl[16], pl[16]; bf16_t gg[16];
#pragma unroll
                for (int i = 0; i < 16; ++i) { const size_t gi = (size_t)(chunk * 64 + tq * 16 + i) * LRU_W + ch; const unsigned hp = ((const unsigned*)hloc)[gi]; hl[i] = bf2f((bf16_t)(hp & 0xffffu)); pl[i] = bf2f((bf16_t)(hp >> 16)); gg[i] = Gr[gi]; }
#pragma unroll
                for (int i = 0; i < 16; ++i)
                    concat[(size_t)(chunk * 64 + tq * 16 + i) * D + FOX_W + ch] = f2bf(gelu_tanh_f(bf2f(gg[i])) * (hl[i] + pl[i] * cr));
            }
            {
                const float lam_init = (l == 0) ? 0.2f : 0.35550906759f;
                const float s1 = wave_sum(p.in[I_LQ1][l * 64 + lane] * p.in[I_LK1][l * 64 + lane]);
                const float s2 = wave_sum(p.in[I_LQ2][l * 64 + lane] * p.in[I_LK2][l * 64 + lane]);
                const float lam = fexp(s1) - fexp(s2) + lam_init;
                const float* sg = p.in[I_SUBG] + l * 128;
                const float g0 = sg[2 * lane], g1 = sg[2 * lane + 1];
                static_assert(NCH <= 8, "the merge below keeps one (map, chunk) pair per lane: 2 x 8 lanes");
                for (int q = gwave; q < S; q += gwaves) {
                    const int nch = (q >> 6) / DCH + 1;
                    float mv = -INFINITY, lv = 0.f;
                    { const int c = lane & 7, hm = lane >> 3;
                      if (c < nch) { const float* ML = dpml + ((size_t)hm * DPART_ROWS + dpart_row(c, q)) * 2; mv = ML[0]; lv = ML[1]; } }
                    unsigned pk[4][2][NCH];
#pragma unroll
                    for (int h = 0; h < 4; ++h)
#pragma unroll
                        for (int mp = 0; mp < 2; ++mp) {
                            const unsigned* OP = (const unsigned*)(dpo + (size_t)(h * 2 + mp) * DPART_ROWS * 128);
#pragma unroll
                            for (int c = 0; c < NCH; ++c) pk[h][mp][c] = (c < nch) ? OP[(size_t)dpart_row(c, q) * 64 + lane] : 0u;
                        }
                    float Mx = mv; Mx = fmaxf(Mx, SHX(Mx, 1)); Mx = fmaxf(Mx, SHX(Mx, 2)); Mx = fmaxf(Mx, SHX(Mx, 4));
                    const float wv = (mv == -INFINITY) ? 0.f : FAST_EXP2(mv - Mx);
                    float Lp = lv * wv; Lp += SHX(Lp, 1); Lp += SHX(Lp, 2); Lp += SHX(Lp, 4);
#pragma unroll
                    for (int h = 0; h < 4; ++h) {
                        float om[2][2];
#pragma unroll
                        for (int mp = 0; mp < 2; ++mp) {
                            float o0 = 0.f, o1 = 0.f;
#pragma unroll
                            for (int c = 0; c < NCH; ++c) { const float w = RDLANE(wv, (h * 2 + mp) * 8 + c); o0 += bf2f((bf16_t)(pk[h][mp][c] & 0xffffu)) * w; o1 += bf2f((bf16_t)(pk[h][mp][c] >> 16)) * w; }
                            const float il = 1.f / RDLANE(Lp, (h * 2 + mp) * 8);
                            om[mp][0] = o0 * il; om[mp][1] = o1 * il;
                        }
                        const float v0 = om[0][0] - lam * om[1][0], v1 = om[0][1] - lam * om[1][1];
                        const float ss = wave_sum(v0 * v0 + v1 * v1);
                        const float rs = (1.f - lam_init) / sqrtf(ss * (1.f / 128.f) + LN_EPS);
                        *(unsigned*)(concat + (size_t)q * D + 1536 + h * 128 + 2 * lane) = pack2(v0 * rs * g0, v1 * rs * g1);
                    }
                }
            }
            PH_BAR(pb + 2);
        }

        if (PH_SEL(3) && PH_IN(pb + 3)) for (int rep = 0; rep < PH_REPS(3); ++rep) {
            PHASE_IDS();
            const bf16_t* Bt = WoT + (size_t)l * D * D;
            constexpr int ntn = D / 256, ntm = S / 256;
            const unsigned nooff[2][2] = {{0u, 0u}, {0u, 0u}};
            for (int t0 = bid; t0 < ntm * ntn; t0 += G) {
                int t = t0;
                if (G == 256 && ntm * ntn == 256) { const int x = t0 & 7, j = t0 >> 3; t = (x * 4 + (j >> 3)) * ntn + (j & 7); }
                const int pm = t / ntn, pn = t % ntn;
                f32x4 acc[2][2][4][2];
                gemm_tile<false>(concat, pm * 256, nooff, Bt, pn * 256, D, lds_raw, acc, tid);
                int et = tid; OPAQUE(et); const int wr = et >> 8, wc = (et >> 6) & 3, fr = et & 15, fq = (et >> 4) & 3;
#pragma unroll
                for (int ai = 0; ai < 2; ++ai) {
#pragma unroll
                    for (int m = 0; m < 4; ++m)
#pragma unroll
                        for (int bj = 0; bj < 2; ++bj)
#pragma unroll
                            for (int n = 0; n < 2; ++n)
#pragma unroll
                                for (int j = 0; j < 4; ++j)
                                    *(float*)(lds_raw + (wr * 64 + m * 16 + fq * 4 + j) * 1040 + (bj * 128 + wc * 32 + n * 16 + fr) * 4) = acc[ai][bj][m][n][j];
                    __syncthreads();
#pragma unroll 4
                    for (int i = 0; i < 16; ++i) {
                        const int idx = et + i * 512, lrow = idx >> 6, c4 = idx & 63;
                        const size_t gi = (size_t)(pm * 256 + ai * 128 + lrow) * D + pn * 256 + c4 * 4;
                        const f32x4 v = *(const f32x4*)(lds_raw + lrow * 1040 + c4 * 16);
                        *(f32x4*)(y1 + gi) = ALPHA * *(const f32x4*)(hin + gi) + v;
                    }
                    __syncthreads();
                }
            }
            PH_BAR(pb + 3);
        }

        if (PH_SEL(4) && PH_IN(pb + 4)) for (int rep = 0; rep < PH_REPS(4); ++rep) {
            PHASE_IDS();
            const float* g1 = p.in[I_LN1G] + (size_t)l * D; const float* b1 = p.in[I_LN1B] + (size_t)l * D;
            const float* bg = p.in[I_BGRP] + l * 4; const float* br = p.in[I_BRT] + l * 32;
            const bf16_t* Wb = W36b + (size_t)l * 2 * 48 * D;
            int* lcnt = (int*)(lds_raw + LDS_MISC + M_LCNT);
            const int segcap = ((S / 16 + G - 1) / G) * 16;
            const int r16 = lane & 15, q4 = lane >> 4;
            if (tid < 32) lcnt[tid] = 0;
            f32x4 gq[8], bq[8];
#pragma unroll
            for (int j = 0; j < 8; ++j) { gq[j] = *(const f32x4*)(g1 + j * 256 + lane * 4); bq[j] = *(const f32x4*)(b1 + j * 256 + lane * 4); }
            __syncthreads();
            for (int bi = bid; bi < S / 16; bi += G) {
                f32x4 v2[2][8];
#pragma unroll
                for (int tk = 0; tk < 2; ++tk)
#pragma unroll
                    for (int j = 0; j < 8; ++j) v2[tk][j] = *(const f32x4*)(y1 + (size_t)(bi * 16 + wave * 2 + tk) * D + j * 256 + lane * 4);
#pragma unroll
                for (int tk = 0; tk < 2; ++tk) {
                    const int r = wave * 2 + tk, t = bi * 16 + r;
                    float s = 0.f;
#pragma unroll
                    for (int j = 0; j < 8; ++j) s += (v2[tk][j][0] + v2[tk][j][1]) + (v2[tk][j][2] + v2[tk][j][3]);
                    const float mean = wave_sum(s) * (1.f / D);
                    float s2 = 0.f;
#pragma unroll
                    for (int j = 0; j < 8; ++j) { v2[tk][j] -= mean; s2 += (v2[tk][j][0] * v2[tk][j][0] + v2[tk][j][1] * v2[tk][j][1]) + (v2[tk][j][2] * v2[tk][j][2] + v2[tk][j][3] * v2[tk][j][3]); }
                    const float rstd = 1.f / sqrtf(wave_sum(s2) * (1.f / D) + LN_EPS);
                    if (lane == 0) { lnstat[2 * t] = mean; lnstat[2 * t + 1] = rstd; }
#pragma unroll
                    for (int j = 0; j < 8; ++j) {
                        const int c = j * 256 + lane * 4;
                        const f32x4 hv = v2[tk][j] * rstd * gq[j] + bq[j];
                        u32x2 o; o.x = pack2(hv[0], hv[1]); o.y = pack2(hv[2], hv[3]);
                        *(u32x2*)(h1b + (size_t)t * D + c) = o;
                        u32x2 lo2;
                        lo2.x = pack2(hv[0] - bf2f((bf16_t)(o.x & 0xffffu)), hv[1] - bf2f((bf16_t)(o.x >> 16)));
                        lo2.y = pack2(hv[2] - bf2f((bf16_t)(o.y & 0xffffu)), hv[3] - bf2f((bf16_t)(o.y >> 16)));
                        const int la = r * 4096 + (((j * 32 + (lane >> 1)) ^ r) << 4) + (lane & 1) * 8;
                        *(u32x2*)(lds_raw + la) = o; *(u32x2*)(lds_raw + 65536 + la) = lo2;
                    }
                }
                __syncthreads();
                f32x4 ac[3];
#pragma unroll
                for (int nt = 0; nt < 3; ++nt) ac[nt] = (f32x4){0.f, 0.f, 0.f, 0.f};
#pragma unroll 4
                for (int ks = 0; ks < 8; ++ks) {
                    const int kk = wave * 8 + ks;
                    const int la = r16 * 4096 + (((kk * 4 + q4) ^ r16) << 4);
                    const bf16x8 ah = *(const bf16x8*)(lds_raw + la), al = *(const bf16x8*)(lds_raw + 65536 + la);
#pragma unroll
                    for (int nt = 0; nt < 3; ++nt) {
                        const bf16x8 bh = *(const bf16x8*)(Wb + (size_t)(nt * 16 + r16) * D + kk * 32 + q4 * 8);
                        const bf16x8 bl = *(const bf16x8*)(Wb + (size_t)48 * D + (size_t)(nt * 16 + r16) * D + kk * 32 + q4 * 8);
                        ac[nt] = MFMA16(ah, bh, ac[nt]); ac[nt] = MFMA16(al, bh, ac[nt]); ac[nt] = MFMA16(ah, bl, ac[nt]);
                    }
                }
                __syncthreads();
                float* red = ldsf;
#pragma unroll
                for (int nt = 0; nt < 3; ++nt)
#pragma unroll
                    for (int j = 0; j < 4; ++j) red[(wave * 16 + q4 * 4 + j) * 48 + nt * 16 + r16] = ac[nt][j];
                __syncthreads();
                float* lgt = ldsf + 8 * 16 * 48;
                if (tid < 256) {
                    const int tkn = tid >> 4, o3 = (tid & 15) * 3;
#pragma unroll
                    for (int q = 0; q < 3; ++q) { float a = 0.f;
#pragma unroll
                        for (int w = 0; w < 8; ++w) a += red[(w * 16 + tkn) * 48 + o3 + q];
                        lgt[tkn * 48 + o3 + q] = a; }
                }
                __syncthreads();
                if (tid < 16) {
                    const int t = bi * 16 + tid; const float* L = lgt + tid * 48;
                    float gl[4];
#pragma unroll
                    for (int q = 0; q < 4; ++q) gl[q] = L[q] + bg[q];
                    int gi = 0; float gm = gl[0];
#pragma unroll
                    for (int q = 1; q < 4; ++q) if (gl[q] > gm) { gm = gl[q]; gi = q; }
                    float gs = 0.f;
#pragma unroll
                    for (int q = 0; q < 4; ++q) gs += fexp(gl[q] - gm);
                    const float gweight = 1.f / gs;
                    float E[8];
#pragma unroll
                    for (int e = 0; e < 8; ++e) E[e] = L[4 + gi * 8 + e] + br[gi * 8 + e];
                    int e1 = 0; float m1 = E[0];
#pragma unroll
                    for (int e = 1; e < 8; ++e) if (E[e] > m1) { m1 = E[e]; e1 = e; }
                    int e2 = -1; float m2 = -INFINITY;
#pragma unroll
                    for (int e = 0; e < 8; ++e) if (e != e1 && E[e] > m2) { m2 = E[e]; e2 = e; }
                    const float p2 = fexp(m2 - m1), w1 = 1.f / (1.f + p2), w2 = p2 / (1.f + p2);
                    const int ge1 = gi * 8 + e1, ge2 = gi * 8 + e2;
                    const int i1 = (ge1 * G + bid) * segcap + atomic_add_int(&lcnt[ge1], 1);
                    ltok[i1] = t; lw[i1] = gweight * w1; lslot[i1] = 0;
                    const int i2 = (ge2 * G + bid) * segcap + atomic_add_int(&lcnt[ge2], 1);
                    ltok[i2] = t; lw[i2] = gweight * w2; lslot[i2] = 1;
                }
                __syncthreads();
            }
            if (tid < 32) cntb[bid * 32 + tid] = lcnt[tid];
            PH_BAR(pb + 4);
        }

        if (PH_SEL(5) && PH_IN(pb + 5)) {
            PHASE_IDS();
            const unsigned nooff[2][2] = {{0u, 0u}, {0u, 0u}};
            const int segcap = ((S / 16 + G - 1) / G) * 16;
            moe_prefix(cntb, G, lds_raw, tid);
            const int* ctot = (const int*)(lds_raw + LDS_MISC + M_CTOT); const int* coff = (const int*)(lds_raw + LDS_MISC + M_COFF);
            const int* rtok = (const int*)(lds_raw + LDS_MISC + M_RTOK); const float* rw = (const float*)(lds_raw + LDS_MISC + M_RW);
            const int* rslot = (const int*)(lds_raw + LDS_MISC + M_RSLOT);
            unsigned* done = (unsigned*)(wsl + CTL_DONE_OFF) + l * 1024;
            int nmt = 0;
            for (int e = 0; e < NEXP; ++e) nmt += (ctot[e] + 255) / 256;
            nmt = RFL(nmt);
            for (;;) {
                __syncthreads();
                if (tid == 0) *ubox = (unsigned)atomic_add_int(workctr + 8, 1);
                __syncthreads();
                int u = RFL((int)*ubox);
                if (u >= nmt * 12) break;
                const bool down = (u >= nmt * 4);
                const int per = down ? 8 : 4;
                if (down) u -= nmt * 4;
                int e = 0;
                for (;; ++e) { const int nt = ((RFL(ctot[e]) + 255) / 256) * per; if (u < nt) break; u -= nt; }
                const int c = RFL(ctot[e]), off = RFL(coff[e]);
                const int mt = u / per, pn = u % per, m0 = mt * 256;
                moe_rowtable(ltok, lw, lslot, e, m0, c, G, segcap, lds_raw, tid);
                f32x4 acc[2][2][4][2];
                if (!down) {
                    const bf16_t* Bt = WguT + ((size_t)l * NEXP + e) * 1024 * D;
                    unsigned aoff[2][2];
                    int st = tid; OPAQUE(st); int R[2], C[2]; stage_geom(st, R, C);
#pragma unroll
                    for (int h = 0; h < 2; ++h)
#pragma unroll
                        for (int i = 0; i < 2; ++i) aoff[h][i] = (unsigned)(rtok[h * 128 + R[i]] * D + C[i]);
                    gemm_tile<true>(h1b, 0, aoff, Bt, pn * 256, D, lds_raw, acc, tid);
                    int et = tid; OPAQUE(et); const int wr = et >> 8, wc = (et >> 6) & 3, fr = et & 15, fq = (et >> 4) & 3;
#pragma unroll
                    for (int ai = 0; ai < 2; ++ai)
#pragma unroll
                        for (int m = 0; m < 4; ++m)
#pragma unroll
                            for (int j = 0; j < 4; ++j) {
                                const int r = ai * 128 + wr * 64 + m * 16 + fq * 4 + j;
                                const float wgt = rw[r];
#pragma unroll
                                for (int bj = 0; bj < 2; ++bj)
                                    *(bf16_t*)(lds_raw + r * 272 + (bj * 64 + wc * 16 + fr) * 2) = f2bf(silu_f(acc[ai][bj][m][0][j]) * acc[ai][bj][m][1][j] * wgt);
                            }
                    __syncthreads();
#pragma unroll 4
                    for (int i = 0; i < 8; ++i) {
                        const int idx = et + i * 512, r = idx >> 4, ch = idx & 15;
                        if (m0 + r < c) *(u32x4*)(act + (size_t)(off + m0 + r) * DFF + pn * 128 + ch * 8) = *(const u32x4*)(lds_raw + r * 272 + ch * 16);
                    }
                    WAIT_VM0();
                    __syncthreads();
                    if (et == 0) { FENCE_REL_AGENT(); WAIT_VM0(); (void)xb_add(&done[e * 32 + mt], 1u); }
                } else {
                    const bf16_t* Bt = WdT + ((size_t)l * NEXP + e) * D * DFF;
                    if (tid == 0) {
                        unsigned* bw = (unsigned*)wsl;
                        XB_SPIN(xb_ld(&done[e * 32 + mt]) < 4u, bw);
                        FENCE_ACQ_AGENT();
                        WAIT_VM0();
                    }
                    __syncthreads();
                    gemm_tile<false>(act, off + m0, nooff, Bt, pn * 256, DFF, lds_raw, acc, tid);
                    int et = tid; OPAQUE(et); const int wr = et >> 8, wc = (et >> 6) & 3, fr = et & 15, fq = (et >> 4) & 3;
#pragma unroll
                    for (int ai = 0; ai < 2; ++ai)
#pragma unroll
                        for (int m = 0; m < 4; ++m)
#pragma unroll
                            for (int bj = 0; bj < 2; ++bj)
#pragma unroll
                                for (int n = 0; n < 2; ++n)
#pragma unroll
                                    for (int j = 0; j < 4; ++j)
                                        *(bf16_t*)(lds_raw + (ai * 128 + wr * 64 + m * 16 + fq * 4 + j) * 528 + (bj * 128 + wc * 32 + n * 16 + fr) * 2) = f2bf(acc[ai][bj][m][n][j]);
                    __syncthreads();
#pragma unroll 4
                    for (int i = 0; i < 16; ++i) {
                        const int idx = et + i * 512, r = idx >> 5, ch = idx & 31;
                        if (m0 + r < c) *(u32x4*)(contrib + ((size_t)rslot[r] * S + rtok[r]) * D + pn * 256 + ch * 8) = *(const u32x4*)(lds_raw + r * 528 + ch * 16);
                    }
                }
            }
            PH_BAR(pb + 5);
        }

        if (PH_SEL(7) && PH_IN(pb + 7)) for (int rep = 0; rep < PH_REPS(7); ++rep) {
            PHASE_IDS();
            const float* g2 = p.in[I_LN2G] + (size_t)l * D; const float* b2 = p.in[I_LN2B] + (size_t)l * D;
            const bool more = (l + 1 < DEPTH);
            f32x4 gq[8], bq[8], g1q[8], b1q[8];
#pragma unroll
            for (int j = 0; j < 8; ++j) { gq[j] = *(const f32x4*)(g2 + j * 256 + lane * 4); bq[j] = *(const f32x4*)(b2 + j * 256 + lane * 4);
                g1q[j] = *(const f32x4*)(p.in[I_LN1G] + (size_t)l * D + j * 256 + lane * 4); b1q[j] = *(const f32x4*)(p.in[I_LN1B] + (size_t)l * D + j * 256 + lane * 4); }
            if (more) {
                const float* wf = Wfa + (size_t)(l + 1) * 8 * D;
                __syncthreads();
                for (int i = tid; i < 6 * D / 4; i += NTHREADS) *(f32x4*)(ldsf + i * 4) = *(const f32x4*)(wf + i * 4);
                __syncthreads();
            }
            for (int t = gwave; t < S; t += gwaves) {
                f32x4 v[8]; float s = 0.f;
                const float mean1 = lnstat[2 * t], rstd1 = lnstat[2 * t + 1];
#pragma unroll
                for (int j = 0; j < 8; ++j) {
                    const size_t i = (size_t)t * D + j * 256 + lane * 4;
                    const u32x2 c0 = *(const u32x2*)(contrib + i), c1 = *(const u32x2*)(contrib + (size_t)S * D + i);
                    const f32x4 cs = (f32x4){bf2f((bf16_t)(c0.x & 0xffffu)) + bf2f((bf16_t)(c1.x & 0xffffu)), bf2f((bf16_t)(c0.x >> 16)) + bf2f((bf16_t)(c1.x >> 16)),
                                             bf2f((bf16_t)(c0.y & 0xffffu)) + bf2f((bf16_t)(c1.y & 0xffffu)), bf2f((bf16_t)(c0.y >> 16)) + bf2f((bf16_t)(c1.y >> 16))};
                    v[j] = ALPHA * ((*(const f32x4*)(y1 + i) - mean1) * rstd1 * g1q[j] + b1q[j]) + cs;
                    s += (v[j][0] + v[j][1]) + (v[j][2] + v[j][3]);
                }
                const float mean = wave_sum(s) * (1.f / D);
                float s2 = 0.f;
#pragma unroll
                for (int j = 0; j < 8; ++j) { v[j] -= mean; s2 += (v[j][0] * v[j][0] + v[j][1] * v[j][1]) + (v[j][2] * v[j][2] + v[j][3] * v[j][3]); }
                const float rstd = 1.f / sqrtf(wave_sum(s2) * (1.f / D) + LN_EPS);
                float fa[6] = {0.f, 0.f, 0.f, 0.f, 0.f, 0.f};
#pragma unroll
                for (int j = 0; j < 8; ++j) {
                    const int c = j * 256 + lane * 4;
                    v[j] = v[j] * rstd * gq[j] + bq[j];
                    *(f32x4*)(hout + (size_t)t * D + c) = v[j];
                    COMPILER_FENCE();
                    if (more) {
                        u32x2 o; o.x = pack2(v[j][0], v[j][1]); o.y = pack2(v[j][2], v[j][3]);
                        *(u32x2*)(xb + (size_t)t * D + c) = o;
#pragma unroll
                        for (int h = 0; h < 6; ++h) { const f32x4 w = *(const f32x4*)(ldsf + h * D + c); fa[h] += (v[j][0] * w[0] + v[j][1] * w[1]) + (v[j][2] * w[2] + v[j][3] * w[3]); }
                    }
                }
                if (more) {
#pragma unroll
                    for (int h = 0; h < 6; ++h) { const float sm = wave_sum(fa[h]); if (lane == 0) logf_[h * S + t] = log_sigmoid_f(sm + p.in[I_BF][(l + 1) * 6 + h]); }
                }
            }
            PH_BAR(pb + 7);
        }
    }
#undef PH_IN
#undef PH_BAR
}

constexpr int N_PHASES = 1 + DEPTH * 8;
#ifndef EMU
extern "C" void kernel_launch(void* const* d_in, const int* in_sizes, int n_in, void* d_out, int out_size, void* d_ws, size_t ws_size, hipStream_t stream) {
    static int grid = 0;
    if (grid == 0) {
        if (n_in != N_INPUTS || out_size != S * D || ws_size < WS_END) {
            fprintf(stderr, "kernel_launch: unexpected shapes: n_in %d out %d ws %zu (need %zu)\n", n_in, out_size, ws_size, (size_t)WS_END); grid = -1; return; }
        int dev = 0, cus = 0, per_cu = 0;
        if (hipGetDevice(&dev) != hipSuccess || hipDeviceGetAttribute(&cus, hipDeviceAttributeMultiprocessorCount, dev) != hipSuccess) { grid = -1; return; }
        if (hipFuncSetAttribute((const void*)fwd_kernel, hipFuncAttributeMaxDynamicSharedMemorySize, LDS_BYTES) != hipSuccess) { fprintf(stderr, "kernel_launch: hipFuncSetAttribute failed\n"); grid = -1; return; }
        if (hipOccupancyMaxActiveBlocksPerMultiprocessor(&per_cu, (const void*)fwd_kernel, NTHREADS, LDS_BYTES) != hipSuccess || per_cu < 1) {
            fprintf(stderr, "kernel_launch: occupancy query says %d blocks per CU\n", per_cu); (void)hipGetLastError(); grid = -1; return; }
        grid = cus;
    }
    if (grid < 0) return;
    (void)hipMemsetAsync(d_ws, 0, CTL_BYTES, stream);
    Params p{};
    for (int i = 0; i < N_INPUTS; ++i) p.in[i] = (const float*)d_in[i];
    p.out = (float*)d_out; p.ws = (unsigned char*)d_ws;
    for (int i = 0; i < 8; ++i) p.inv_freq[i] = (float)pow(500000.0, -(double)i * 2.0 / 16.0);
#if N_LAUNCH_SPLIT
    for (int k = 0; k < N_PHASES; ++k) { p.lo = k; p.hi = k + 1; hipLaunchKernelGGL(fwd_kernel, dim3(grid), dim3(NTHREADS), LDS_BYTES, stream, p); }
#else
    p.lo = 0; p.hi = N_PHASES;
    hipLaunchKernelGGL(fwd_kernel, dim3(grid), dim3(NTHREADS), LDS_BYTES, stream, p);
#endif
}
#endif
```

```cpp
#ifndef EMU
#include <hip/hip_runtime.h>
#include <cstdio>
#include <cstdint>
#include <cmath>
#endif

#ifndef SEQ
#define SEQ 8192
#endif
#ifndef N_LAUNCH_SPLIT
#define N_LAUNCH_SPLIT 0
#endif
#ifndef REP_PHASE
#define REP_PHASE -2
#endif
#define PH_REPS(c) ((c) == REP_PHASE ? 2 : 1)
#ifndef REP_SUB
#define REP_SUB 0
#endif

constexpr int S = SEQ, D = 2048, DEPTH = 2;
constexpr int FOX_H = 6, FOX_W = 768;
constexpr int LRU_W = 768;
constexpr int DIFF_H = 4, DIFF_W = 512;
constexpr int N_IN = 5382, N_INP = 5376;
constexpr int C_FA = 2304;
constexpr int NEXP = 32, DFF = 512;
constexpr int NKT = S / 64;
#ifndef DCH
#define DCH 32
#endif
constexpr int NCH = (NKT + DCH - 1) / DCH;
constexpr size_t DPART_ROWS = (size_t)NCH * S - (size_t)(DCH * 64) * NCH * (NCH - 1) / 2;
constexpr float ALPHA = 1.41421356237309504880f;
constexpr float LN_EPS = 1e-5f;
constexpr float LOG2E = 1.4426950408889634f;
constexpr float QSCALE_A = 0.08838834764831845f * 1.4426950408889634f;
constexpr float QSCALE_C = 0.125f * 1.4426950408889634f;

enum { I_X = 0, I_POS, I_WIN, I_BF, I_CONVW, I_CONVB, I_WA, I_BA, I_WI, I_BI, I_LAM, I_LQ1, I_LK1, I_LQ2, I_LK2, I_SUBG, I_WO, I_LN1G, I_LN1B,
       I_WGRP, I_BGRP, I_WRT, I_BRT, I_WGATE, I_WUP, I_WDOWN, I_LN2G, I_LN2B, N_INPUTS };

typedef unsigned short bf16_t;
typedef short bf16x8 __attribute__((ext_vector_type(8)));
typedef float f32x4 __attribute__((ext_vector_type(4)));
typedef unsigned u32x4 __attribute__((ext_vector_type(4)));
typedef unsigned u32x2 __attribute__((ext_vector_type(2)));

constexpr size_t al256(size_t x) { return (x + 255) & ~(size_t)255; }
constexpr size_t CTL_BYTES = 65536;
constexpr size_t CTL_CNT_OFF = 32768;
constexpr size_t CTL_WORK_OFF = 36864;
constexpr size_t CTL_QK2_OFF = 57344;
constexpr size_t CTL_CLS_OFF = 49152;
constexpr size_t CTL_DONE_OFF = 40960;
constexpr size_t WB_WIN = CTL_BYTES;
constexpr size_t WB_WO = WB_WIN + al256((size_t)DEPTH * N_INP * D * 2);
constexpr size_t WB_WGU = WB_WO + al256((size_t)DEPTH * D * D * 2);
constexpr size_t WB_WD = WB_WGU + al256((size_t)DEPTH * NEXP * 1024 * D * 2);
constexpr size_t WB_WAI = WB_WD + al256((size_t)DEPTH * NEXP * D * DFF * 2);
constexpr size_t WF_FA = WB_WAI + al256((size_t)DEPTH * 6 * 256 * 128 * 2);
constexpr size_t WF_R36 = WF_FA + al256((size_t)DEPTH * 8 * D * 4);
constexpr size_t WF_ROPE = WF_R36 + al256((size_t)DEPTH * 2 * 48 * D * 2);
constexpr size_t A_XB = WF_ROPE + al256((size_t)S * 16 * 4);
constexpr size_t A_HB = A_XB + al256((size_t)S * D * 2);
constexpr size_t A_LOGF = A_HB + al256((size_t)S * D * 4);
constexpr size_t A_CUM = A_LOGF + al256((size_t)6 * S * 4);
constexpr size_t A_KMAX = A_CUM + al256((size_t)6 * S * 4);
constexpr size_t A_CNTB = A_KMAX + al256((size_t)6 * NKT * 4);
constexpr size_t A_QA = A_CNTB + al256((size_t)1024 * 32 * 4);
constexpr size_t A_KA = A_QA + al256((size_t)FOX_H * S * 128 * 2);
constexpr size_t A_VAT = A_KA + al256((size_t)FOX_H * S * 128 * 2);
constexpr size_t A_XR = A_VAT + al256((size_t)FOX_H * S * 128 * 2);
constexpr size_t A_GR = A_XR + al256((size_t)S * LRU_W * 2);
constexpr size_t A_QC = A_GR + al256((size_t)S * LRU_W * 2);
constexpr size_t A_KC = A_QC + al256((size_t)DIFF_H * S * 128 * 2);
constexpr size_t A_VCT = A_KC + al256((size_t)DIFF_H * S * 128 * 2);
constexpr size_t A_HLOC = A_VCT + al256((size_t)DIFF_H * S * 128 * 2);
constexpr size_t A_PLOC = A_HLOC + al256((size_t)S * LRU_W * 4);
constexpr size_t A_SUMA = A_PLOC + al256((size_t)S * LRU_W * 4);
constexpr size_t A_SUMH = A_SUMA + al256((size_t)NKT * LRU_W * 4);
constexpr size_t A_CONCAT = A_SUMH + al256((size_t)NKT * LRU_W * 4);
constexpr size_t A_Y1 = A_CONCAT + al256((size_t)S * D * 2);
constexpr size_t A_H1 = A_Y1 + al256((size_t)S * D * 4);
constexpr size_t A_H1B = A_H1 + al256((size_t)S * D * 4);
constexpr size_t A_LTOK = A_H1B + al256((size_t)S * D * 2);
constexpr size_t A_LW = A_LTOK + al256((size_t)NEXP * S * 4);
constexpr size_t A_LSLOT = A_LW + al256((size_t)NEXP * S * 4);
constexpr size_t A_ACT = A_LSLOT + al256((size_t)NEXP * S * 4);
constexpr size_t A_CONTRIB = A_ACT + al256((size_t)(2 * S + 256) * DFF * 2);
constexpr size_t WS_END = A_CONTRIB + al256((size_t)2 * S * D * 4);
constexpr size_t A_DPO = A_Y1;
constexpr size_t A_DPML = A_DPO + al256((size_t)8 * DPART_ROWS * 128 * 2);
static_assert(A_DPML + (size_t)8 * DPART_ROWS * 2 * 4 <= A_H1B, "differential partials must fit inside the y1 + h1 region");

constexpr int NTHREADS = 512;
constexpr int LDS_MAIN = 131072 + 4096;
constexpr int LDS_MISC = LDS_MAIN;
constexpr int LDS_BYTES = LDS_MAIN + 8192 + 16640;
constexpr int M_PRE16 = 8192;
constexpr int M_LCNT = 64, M_CTOT = 256, M_COFF = 384, M_PRE = 512, M_RTOK = 2048, M_RW = 3072, M_RSLOT = 4096;

struct Params {
    const float* in[N_INPUTS];
    float* out;
    unsigned char* ws;
    float inv_freq[8];
    int lo, hi;
};

#ifndef EMU
#define LAS __attribute__((address_space(3)))
#define DYN_LDS(name) extern __shared__ __attribute__((aligned(16))) unsigned char name[]
#define SLEEP1() __builtin_amdgcn_s_sleep(1)
#define WAVE_SYNC() __builtin_amdgcn_wave_barrier()
#define OPAQUE(x) asm volatile("" : "+v"(x))
#define COMPILER_FENCE() asm volatile("" ::: "memory")
#define RFL(x) __builtin_amdgcn_readfirstlane(x)
#define RFL_F(x) __builtin_bit_cast(float, __builtin_amdgcn_readfirstlane(__builtin_bit_cast(int, x)))
#define ANY_LANE(p) (__builtin_amdgcn_ballot_w64(p) != 0ull)
#define RDLANE(v, l) __builtin_bit_cast(float, __builtin_amdgcn_readlane(__builtin_bit_cast(int, v), l))
__device__ __forceinline__ int lane_id_volatile() { int l; asm volatile("v_mbcnt_lo_u32_b32 %0, -1, 0\n\tv_mbcnt_hi_u32_b32 %0, -1, %0" : "=v"(l)); return l; }
#define LANE_ID() lane_id_volatile()
#define OPAQUE_S(x) asm volatile("" : "+s"(x))
#define WAIT_VM0() asm volatile("s_waitcnt vmcnt(0)" ::: "memory")
#define WAIT_ALL0() __builtin_amdgcn_s_waitcnt(0)
#define FENCE_REL_AGENT() __builtin_amdgcn_fence(__ATOMIC_RELEASE, "agent")
#define FENCE_ACQ_AGENT() __builtin_amdgcn_fence(__ATOMIC_ACQUIRE, "agent")
#define MFMA16(a, b, c) __builtin_amdgcn_mfma_f32_16x16x32_bf16(a, b, c, 0, 0, 0)
#define GLDS16(g, l) __builtin_amdgcn_global_load_lds((const unsigned*)(g), (unsigned*)(l), 16, 0, 0)
#define WAIT_V(n) asm volatile("s_waitcnt vmcnt(" #n ")" ::: "memory")
#define WAIT_L(n) asm volatile("s_waitcnt lgkmcnt(" #n ")" ::: "memory")
#define BAR() __builtin_amdgcn_s_barrier()
#define SCHED() __builtin_amdgcn_sched_barrier(0)
#define SETPRIO(n) __builtin_amdgcn_s_setprio(n)
#define FAST_EXP2(x) __builtin_amdgcn_exp2f(x)
template <int M> __device__ __forceinline__ float shx_impl(float v, int lane) {
    if (M < 32) return __builtin_bit_cast(float, __builtin_amdgcn_ds_swizzle(__builtin_bit_cast(int, v), (M << 10) | 0x1f));
    return __builtin_bit_cast(float, __builtin_amdgcn_ds_bpermute((lane ^ 32) << 2, __builtin_bit_cast(int, v)));
}
#define SHX(v, M) shx_impl<M>(v, lane)
#define FAST_LOG2(x) __builtin_amdgcn_logf(x)
#define FAST_RCP(x) __builtin_amdgcn_rcpf(x)
__device__ __forceinline__ unsigned xb_ld(unsigned* p)              { return __hip_atomic_load(p, __ATOMIC_RELAXED, __HIP_MEMORY_SCOPE_AGENT); }
__device__ __forceinline__ unsigned xb_add(unsigned* p, unsigned v) { return __hip_atomic_fetch_add(p, v, __ATOMIC_RELAXED, __HIP_MEMORY_SCOPE_AGENT); }
__device__ __forceinline__ unsigned xb_xcc_id() { return (unsigned)__builtin_amdgcn_s_getreg((3 << 11) | 20) & 0xFu; }
__device__ __forceinline__ int atomic_add_int(int* p, int v) { return atomicAdd(p, v); }
__device__ __forceinline__ void atomic_min_int(int* p, int v) { atomicMin(p, v); }
__device__ __forceinline__ void atomic_max_u32(unsigned* p, unsigned v) { atomicMax(p, v); }
__device__ __forceinline__ unsigned pack2(float lo, float hi) { unsigned r; asm volatile("v_cvt_pk_bf16_f32 %0, %1, %2" : "=v"(r) : "v"(lo), "v"(hi)); return r; }
#else
#define MFMA16(a, b, c) emu_mfma_16x16x32_bf16(a, b, c)
#define GLDS16(g, l) emu_glds16((const void*)(g), (void*)(l))
#define WAIT_V(n) ((void)0)
#define WAIT_L(n) ((void)0)
#define BAR() __syncthreads()
#define SCHED() ((void)0)
#define SETPRIO(n) ((void)0)
#define FAST_EXP2(x) exp2f(x)
#define SHX(v, M) __shfl_xor(v, M)
#define FAST_LOG2(x) log2f(x)
#define FAST_RCP(x) (1.f / (x))
static inline unsigned pack2(float lo, float hi) {
    unsigned a = __builtin_bit_cast(unsigned, lo), b = __builtin_bit_cast(unsigned, hi);
    a += 0x7fffu + ((a >> 16) & 1u); b += 0x7fffu + ((b >> 16) & 1u);
    return (a >> 16) | (b & 0xffff0000u);
}
#endif
__device__ __forceinline__ bf16_t f2bf(float f) { return (bf16_t)(pack2(f, 0.f) & 0xffffu); }
__device__ __forceinline__ float bf2f(bf16_t h) { return __builtin_bit_cast(float, (unsigned)h << 16); }

#define XB_TMO      128
#define XB_XCNT(j)  (256  + 64 * (j))
#define XB_XSUB(j)  (1280 + 64 * (j))
#define XB_XGEN(j)  (2304 + 64 * (j))
#define XB_TOP      3328
#define XB_TOPGEN   3392
#define XCD_BAR_WORDS 3456
#define XB_SPIN_CAP (1u << 22)
#define XB_SPIN(cond, bar) do { unsigned _sp = 0; while (cond) { SLEEP1(); \
    if ((++_sp & 255u) == 0u) { if (xb_ld(&(bar)[XB_TMO])) break; if (_sp > XB_SPIN_CAP) { xb_add(&(bar)[XB_TMO], 1u); break; } } } } while (0)

struct XcdBarrier { unsigned* bar; unsigned x; volatile LAS unsigned* st; };

__device__ __forceinline__ XcdBarrier xcd_barrier_post(unsigned* bar, volatile LAS unsigned* st) {
    XcdBarrier b; b.bar = bar; b.x = xb_xcc_id(); b.st = st;
    if (threadIdx.x == 0) (void)xb_add(&bar[XB_XCNT(b.x)], 1u);
    return b;
}
__device__ __forceinline__ void xcd_barrier_complete(unsigned* bar, unsigned x, unsigned& nloc, unsigned& nx) {
    const unsigned G = gridDim.x;
    unsigned sum, cnt, mine, sp = 0u;
    for (;;) {
        sum = 0u; cnt = 0u; mine = 0u;
#pragma unroll
        for (unsigned j = 0; j < 16; ++j) { const unsigned c = xb_ld(&bar[XB_XCNT(j)]); sum += c; cnt += (c > 0u) ? 1u : 0u; mine = (j == x) ? c : mine; }
        if (sum == G) break;
        SLEEP1();
        if ((++sp & 255u) == 0u) { if (xb_ld(&bar[XB_TMO])) break; if (sp > XB_SPIN_CAP) { xb_add(&bar[XB_TMO], 1u); break; } }
    }
    nloc = mine > 0u ? mine : 1u; nx = cnt > 0u ? cnt : 1u;
}
__device__ __forceinline__ void xcd_barrier(const XcdBarrier& b, bool leader) {
    WAIT_VM0();
    __syncthreads();
    if (leader) {
        unsigned* bar = b.bar;
        WAIT_ALL0();
        unsigned nloc = b.st[0], nx = b.st[1];
        if (nloc == 0u) { xcd_barrier_complete(bar, b.x, nloc, nx); b.st[0] = nloc; b.st[1] = nx; }
        const unsigned old = xb_add(&bar[XB_XSUB(b.x)], 1u);
        const unsigned gen = old / nloc;
        if (old + 1u == (gen + 1u) * nloc) {
            FENCE_REL_AGENT();
            WAIT_VM0();
            const unsigned og = xb_add(&bar[XB_TOP], 1u);
            const unsigned tg = og / nx;
            if (og + 1u == (tg + 1u) * nx) xb_add(&bar[XB_TOPGEN], 1u);
            else XB_SPIN(xb_ld(&bar[XB_TOPGEN]) == tg, bar);
            FENCE_ACQ_AGENT();
            xb_add(&bar[XB_XGEN(b.x)], 1u);
            WAIT_VM0();
        } else {
            XB_SPIN(xb_ld(&bar[XB_XGEN(b.x)]) == gen, bar);
            FENCE_ACQ_AGENT();
            WAIT_VM0();
        }
    }
    __syncthreads();
}

__device__ __forceinline__ float wave_sum_l(float v, int lane) {
    v += SHX(v, 1); v += SHX(v, 2); v += SHX(v, 4); v += SHX(v, 8); v += SHX(v, 16); v += SHX(v, 32);
    return v;
}
#define wave_sum(v) wave_sum_l(v, lane)
__device__ __forceinline__ float fexp(float x) { return FAST_EXP2(x * LOG2E); }
__device__ __forceinline__ float sigmoid_f(float x) { return FAST_RCP(1.f + fexp(-x)); }
__device__ __forceinline__ float log_sigmoid_f(float x) { return fminf(x, 0.f) - 0.6931471805599453f * FAST_LOG2(1.f + fexp(-fabsf(x))); }
__device__ __forceinline__ float gelu_tanh_f(float x) { const float u = 0.7978845608028654f * (x + 0.044715f * x * x * x); return x * FAST_RCP(1.f + fexp(-2.f * u)); }
__device__ __forceinline__ float silu_f(float x) { return x * FAST_RCP(1.f + fexp(-x)); }
__device__ __forceinline__ float neg_expm1_f(float x) {
    const float ser = -x * (1.f + x * (0.5f + x * (0.16666667f + x * (0.041666668f + x * (0.008333334f + x * 0.0013888889f)))));
    return (x > -0.35f) ? ser : (1.f - fexp(x));
}

struct RmIdent { __device__ __forceinline__ int operator()(int n) const { return n; } };
struct RmWin { __device__ __forceinline__ int operator()(int n) const { return n < C_FA ? n : (n < C_FA + 6 ? -1 : n - 6); } };
struct RmGu { int kind; __device__ __forceinline__ int operator()(int f) const { return (f >> 7) * 256 + ((f >> 6) & 1) * 128 + ((f >> 4) & 3) * 32 + kind * 16 + (f & 15); } };
struct RmOff { int off; __device__ __forceinline__ int operator()(int n) const { return n + off; } };

template <class RM>
__device__ __forceinline__ void convert_tile(const float* src, int ld, int K, int Nsrc, int k0, int n0, bf16_t* dst, const RM& rm, float* T, int tid) {
    {
        const int nn = tid & 255, kh = (tid >> 8) * 32, n = n0 + nn;
        const float* sp = src + (size_t)(k0 + kh) * ld + n;
        float v[32];
#pragma unroll
        for (int i = 0; i < 32; ++i) v[i] = (n < Nsrc) ? sp[(size_t)i * ld] : 0.f;
#pragma unroll
        for (int i = 0; i < 32; ++i) T[(kh + i) * 257 + nn] = v[i];
    }
    __syncthreads();
#pragma unroll
    for (int q = 0; q < 4; ++q) {
        const int nn = q * 64 + (tid >> 3), kc = (tid & 7) * 8, n = n0 + nn;
        const int row = (n < Nsrc) ? rm(n) : -1;
        if (row >= 0) {
            u32x4 o;
            o.x = pack2(T[(kc + 0) * 257 + nn], T[(kc + 1) * 257 + nn]); o.y = pack2(T[(kc + 2) * 257 + nn], T[(kc + 3) * 257 + nn]);
            o.z = pack2(T[(kc + 4) * 257 + nn], T[(kc + 5) * 257 + nn]); o.w = pack2(T[(kc + 6) * 257 + nn], T[(kc + 7) * 257 + nn]);
            *(u32x4*)(dst + (size_t)row * K + k0 + kc) = o;
        }
    }
    __syncthreads();
}
template <class RM>
__device__ __forceinline__ void convert_mats(const float* src, size_t sstride, int nmat, int ld, int K, int Nsrc, bf16_t* dst, size_t dstride, const RM& rm,
                                             float* T, int tid, int bid, int G) {
    const int tk = K / 64, tn = (Nsrc + 255) / 256, per = tk * tn, total = nmat * per;
    for (int t = bid; t < total; t += G) {
        const int mi = t / per, r = t % per;
        convert_tile(src + (size_t)mi * sstride, ld, K, Nsrc, (r / tn) * 64, (r % tn) * 256, dst + (size_t)mi * dstride, rm, T, tid);
    }
}

constexpr int NCONV = DEPTH * 768;
__device__ __forceinline__ void moe_conv_chunk(const Params& p, int cid, bf16_t* WguT_, bf16_t* WdT_, float* T, int tid) {
    const int l = cid / 768, r = cid % 768, kind = r >> 8, t0 = (r & 255) * 8;
    for (int t = t0; t < t0 + 8; ++t) {
        const int mi = t >> 6, rr = t & 63;
        if (kind < 2) {
            const float* src = p.in[kind == 0 ? I_WGATE : I_WUP] + ((size_t)l * NEXP + mi) * D * DFF;
            convert_tile(src, DFF, D, DFF, (rr >> 1) * 64, (rr & 1) * 256, WguT_ + ((size_t)l * NEXP + mi) * 1024 * D, RmGu{kind}, T, tid);
        } else {
            const float* src = p.in[I_WDOWN] + ((size_t)l * NEXP + mi) * DFF * D;
            convert_tile(src, D, DFF, D, (rr >> 3) * 64, (rr & 7) * 256, WdT_ + ((size_t)l * NEXP + mi) * D * DFF, RmIdent{}, T, tid);
        }
    }
}

constexpr int BK = 64, HTB = 128 * 64 * 2;
__device__ __forceinline__ int lds_byte(int r, int c) {
    const int st = (r >> 4) * 2 + (c >> 5), rr = r & 15, cc = c & 31, ob = rr * 64 + cc * 2;
    return st * 1024 + (ob ^ (((ob >> 9) & 1) << 5));
}
__device__ __forceinline__ void stage_rc(int b, int& R, int& C) {
    const int st = b / 1024, sb = b % 1024, swz = sb ^ (((sb >> 9) & 1) << 5);
    R = (st >> 1) * 16 + swz / 64; C = (st & 1) * 32 + (swz % 64) / 2;
}
template <bool GATHER>
__device__ __forceinline__ void gemm_tile(const bf16_t* A, int arow0, const unsigned (&aoff)[2][2], const bf16_t* Bt, int brow0, int K,
                                          unsigned char* shm, f32x4 (&acc)[2][2][4][2], int tid_in) {
    int tid = tid_in; OPAQUE(tid);
    unsigned toff; { int R0, C0; stage_rc(tid * 16, R0, C0); toff = (unsigned)(R0 * K + C0); }
#define SA(b, h) (shm + ((b) * 2 + (h)) * HTB)
#define SB(b, h) (shm + (4 + (b) * 2 + (h)) * HTB)
#define STAGE_B(P, h, kt) do { _Pragma("unroll") for (int _i = 0; _i < 2; ++_i) GLDS16(Bt + ((size_t)(brow0 + (h) * 128 + _i * 64) * K + (size_t)(kt) * BK) + toff, (P) + tid * 16 + _i * 8192); } while (0)
#define STAGE_A(P, h, kt) do { _Pragma("unroll") for (int _i = 0; _i < 2; ++_i) { \
    if (GATHER) GLDS16(A + (size_t)(kt) * BK + aoff[h][_i], (P) + tid * 16 + _i * 8192); \
    else GLDS16(A + ((size_t)(arow0 + (h) * 128 + _i * 64) * K + (size_t)(kt) * BK) + toff, (P) + tid * 16 + _i * 8192); } } while (0)
#define LDA(dst, b, h) _Pragma("unroll") for (int m = 0; m < 4; ++m) _Pragma("unroll") for (int k = 0; k < 2; ++k) \
    dst[m][k] = *reinterpret_cast<const bf16x8*>(SA(b, h) + lds_byte(wr * 64 + m * 16 + fr, k * 32 + fq * 8))
#define LDB(dst, b, h) _Pragma("unroll") for (int n = 0; n < 2; ++n) _Pragma("unroll") for (int k = 0; k < 2; ++k) \
    dst[n][k] = *reinterpret_cast<const bf16x8*>(SB(b, h) + lds_byte(wc * 32 + n * 16 + fr, k * 32 + fq * 8))
#define MMA(ai, bj, At, Bx) do { SETPRIO(1); \
    _Pragma("unroll") for (int m = 0; m < 4; ++m) _Pragma("unroll") for (int n = 0; n < 2; ++n) _Pragma("unroll") for (int k = 0; k < 2; ++k) \
      acc[ai][bj][m][n] = MFMA16(At[m][k], Bx[n][k], acc[ai][bj][m][n]); \
    SETPRIO(0); } while (0)
    int wid = tid >> 6, lane = tid & 63, wr = wid >> 2, wc = wid & 3, fr = lane & 15, fq = lane >> 4;
#pragma unroll
    for (int a = 0; a < 2; ++a)
#pragma unroll
        for (int b = 0; b < 2; ++b)
#pragma unroll
            for (int m = 0; m < 4; ++m)
#pragma unroll
                for (int n = 0; n < 2; ++n) acc[a][b][m][n] = (f32x4){0.f, 0.f, 0.f, 0.f};
    bf16x8 At[4][2], B0[2][2], B1[2][2];
    const int nt = K / BK;
    STAGE_B(SB(0, 0), 0, 0); STAGE_A(SA(0, 0), 0, 0);
    STAGE_B(SB(0, 1), 1, 0); STAGE_A(SA(0, 1), 1, 0);
    if (wr == 1) BAR();
    WAIT_V(4); BAR();
    STAGE_B(SB(1, 0), 0, 1); STAGE_A(SA(1, 0), 0, 1); STAGE_B(SB(1, 1), 1, 1);
    WAIT_V(6); BAR();
    for (int t = 0; t < nt - 2; t += 2) {
        LDB(B0, 0, 0); SCHED(); LDA(At, 0, 0); STAGE_A(SA(1, 1), 1, t + 1);
        WAIT_L(8); BAR(); WAIT_L(0); MMA(0, 0, At, B0); BAR(); SCHED();
        LDB(B1, 0, 1); STAGE_B(SB(0, 0), 0, t + 2);
        BAR(); WAIT_L(0); MMA(0, 1, At, B1); BAR();
        LDA(At, 0, 1); STAGE_A(SA(0, 0), 0, t + 2);
        BAR(); WAIT_L(0); MMA(1, 0, At, B0); BAR(); SCHED();
        STAGE_B(SB(0, 1), 1, t + 2);
        WAIT_V(6); BAR(); MMA(1, 1, At, B1); BAR();
        LDB(B0, 1, 0); SCHED(); LDA(At, 1, 0); STAGE_A(SA(0, 1), 1, t + 2);
        WAIT_L(8); BAR(); WAIT_L(0); MMA(0, 0, At, B0); BAR(); SCHED();
        LDB(B1, 1, 1); STAGE_B(SB(1, 0), 0, t + 3);
        BAR(); WAIT_L(0); MMA(0, 1, At, B1); BAR();
        LDA(At, 1, 1); STAGE_A(SA(1, 0), 0, t + 3);
        BAR(); WAIT_L(0); MMA(1, 0, At, B0); BAR(); SCHED();
        STAGE_B(SB(1, 1), 1, t + 3);
        WAIT_V(6); BAR(); MMA(1, 1, At, B1); BAR();
    }
    OPAQUE(tid); wid = tid >> 6; lane = tid & 63; wr = wid >> 2; wc = wid & 3; fr = lane & 15; fq = lane >> 4;
    { LDB(B0, 0, 0); WAIT_V(0); LDA(At, 0, 0); STAGE_A(SA(1, 1), 1, nt - 1);
      BAR(); WAIT_L(0); MMA(0, 0, At, B0); BAR();
      LDB(B1, 0, 1); BAR(); WAIT_L(0); MMA(0, 1, At, B1); BAR();
      LDA(At, 0, 1); WAIT_V(4); BAR(); WAIT_L(0); MMA(1, 0, At, B0); MMA(1, 1, At, B1); BAR(); }
    { LDB(B0, 1, 0); LDA(At, 1, 0); WAIT_V(2); BAR(); WAIT_L(0); MMA(0, 0, At, B0); BAR();
      LDB(B1, 1, 1); WAIT_V(0); BAR(); WAIT_L(0); MMA(0, 1, At, B1); BAR();
      LDA(At, 1, 1); BAR(); WAIT_L(0); MMA(1, 0, At, B0); MMA(1, 1, At, B1); BAR(); }
    if (wr == 0) BAR();
#undef SA
#undef SB
#undef STAGE_A
#undef STAGE_B
#undef LDA
#undef LDB
#undef MMA
}
__device__ __forceinline__ void stage_geom(int tid, int (&R)[2], int (&C)[2]) {
#pragma unroll
    for (int i = 0; i < 2; ++i) stage_rc(tid * 16 + i * 8192, R[i], C[i]);
}

constexpr int ATT_KBUF = 0, ATT_VBUF = 32768, ATT_CBUF = 65536;
template <int KIND>
__device__ __forceinline__ void attn_unit(const bf16_t* Q, const bf16_t* Kg, const bf16_t* VT, const float* cum2, const float* kmx, int qb, bf16_t* concat, int ccol0,
                                          float lam, float osc, const float* subg, unsigned char* lds, int tid) {
    const int lane = tid & 63, wave = tid >> 6, r16 = lane & 15, q4 = lane >> 4;
    const int q0w = qb * 128 + wave * 16, myq = q0w + r16;
    const int ntiles = 2 * qb + 2;
    const int wlimit = (KIND == 0) ? ((q0w + 15) >> 6) : (q0w >> 6);
    constexpr int NMAP = (KIND == 0) ? 1 : 2, NKS = (KIND == 0) ? 4 : 2;
    bf16x8 qf[NMAP][NKS];
#pragma unroll
    for (int mp = 0; mp < NMAP; ++mp)
#pragma unroll
        for (int ks = 0; ks < NKS; ++ks) qf[mp][ks] = *(const bf16x8*)(Q + (size_t)myq * 128 + mp * 64 + ks * 32 + q4 * 8);
    const float cq = (KIND == 0) ? cum2[myq] : 0.f;
    int kt0 = 0;
    if (KIND == 0) {
        float* wmax = (float*)(lds + ATT_CBUF + 512); int* kst = (int*)(lds + ATT_CBUF + 576);
        float qs = 0.f;
#pragma unroll
        for (int ks = 0; ks < NKS; ++ks)
#pragma unroll
            for (int j = 0; j < 8; ++j) { const float v = bf2f((bf16_t)qf[0][ks][j]); qs += v * v; }
        qs += SHX(qs, 16); qs += SHX(qs, 32);
        qs = fmaxf(qs, SHX(qs, 1)); qs = fmaxf(qs, SHX(qs, 2)); qs = fmaxf(qs, SHX(qs, 4)); qs = fmaxf(qs, SHX(qs, 8));
        if (lane == 0) wmax[wave] = qs;
        if (tid == 0) *kst = 2 * qb;
        __syncthreads();
        float qm = wmax[0];
#pragma unroll
        for (int w = 1; w < 8; ++w) qm = fmaxf(qm, wmax[w]);
        qm = sqrtf(qm) * 1.01f;
        const float kd = sqrtf(fmaxf(kmx[2 * qb], kmx[2 * qb + 1])) * 1.01f;
        if (tid < 2 * qb) {
            const float bias = cum2[qb * 128] - cum2[tid * 64 + 63];
            const bool skip = bias + qm * (sqrtf(kmx[tid]) * 1.01f + kd) < -40.f;
            if (!skip) atomic_min_int(kst, tid);
        }
        __syncthreads();
        kt0 = RFL(*kst);
    }
    f32x4 ot[NMAP][8];
    float mrun[NMAP], lsum[NMAP];
#pragma unroll
    for (int mp = 0; mp < NMAP; ++mp) { mrun[mp] = -INFINITY; lsum[mp] = 0.f;
#pragma unroll
        for (int mo = 0; mo < 8; ++mo) ot[mp][mo] = (f32x4){0.f, 0.f, 0.f, 0.f}; }
    u32x4 sk[2], sv[2]; float sc = 0.f;
    const u32x4* kg = (const u32x4*)Kg; const u32x4* vg = (const u32x4*)VT;
#pragma unroll
    for (int i = 0; i < 2; ++i) { sk[i] = kg[(size_t)kt0 * 1024 + tid + i * 512]; sv[i] = vg[(size_t)kt0 * 1024 + tid + i * 512]; }
    if (KIND == 0 && tid < 64) sc = cum2[kt0 * 64 + tid];
    for (int kt = kt0; kt < ntiles; ++kt) {
        unsigned char* kb = lds + ATT_KBUF + (kt & 1) * 16384;
        unsigned char* vb = lds + ATT_VBUF + (kt & 1) * 16384;
        float* cb = (float*)(lds + ATT_CBUF + (kt & 1) * 256);
#pragma unroll
        for (int i = 0; i < 2; ++i) {
            const int g = tid + i * 512;
            { const int row = g >> 4, c = g & 15; *(u32x4*)(kb + row * 256 + ((c ^ (row & 15)) << 4)) = sk[i]; }
            { const int d = g >> 3, c = g & 7; *(u32x4*)(vb + d * 128 + ((c ^ ((d >> 1) & 7)) << 4)) = sv[i]; }
        }
        if (KIND == 0 && tid < 64) cb[tid] = sc;
        __syncthreads();
        if (kt + 1 < ntiles) {
#pragma unroll
            for (int i = 0; i < 2; ++i) { sk[i] = kg[(size_t)(kt + 1) * 1024 + tid + i * 512]; sv[i] = vg[(size_t)(kt + 1) * 1024 + tid + i * 512]; }
            if (KIND == 0 && tid < 64) sc = cum2[(kt + 1) * 64 + tid];
        }
        if (kt <= wlimit) {
#pragma unroll
            for (int mp = 0; mp < NMAP; ++mp) {
                bf16x8 kf[4][NKS], vfa[8];
#pragma unroll
                for (int m = 0; m < 4; ++m)
#pragma unroll
                    for (int ks = 0; ks < NKS; ++ks) { const int c = (KIND == 0 ? 0 : mp * 8) + ks * 4 + q4; kf[m][ks] = *(const bf16x8*)(kb + (m * 16 + r16) * 256 + ((c ^ r16) << 4)); }
#pragma unroll
                for (int mo = 0; mo < 8; ++mo) { const int d = mo * 16 + r16; vfa[mo] = *(const bf16x8*)(vb + d * 128 + (((0 * 4 + q4) ^ ((d >> 1) & 7)) << 4)); }
                SCHED();
                f32x4 st[4];
#pragma unroll
                for (int m = 0; m < 4; ++m) st[m] = (f32x4){0.f, 0.f, 0.f, 0.f};
#pragma unroll
                for (int ks = 0; ks < NKS; ++ks)
#pragma unroll
                    for (int m = 0; m < 4; ++m) st[m] = MFMA16(kf[m][ks], qf[mp][ks], st[m]);
                SCHED();
                float mx = -INFINITY;
#pragma unroll
                for (int m = 0; m < 4; ++m) {
                    if (KIND == 0) {
                        const f32x4 ck = *(const f32x4*)(cb + m * 16 + 4 * q4);
#pragma unroll
                        for (int j = 0; j < 4; ++j) {
                            float y = st[m][j] + (cq - ck[j]);
                            if (kt * 64 + m * 16 + 4 * q4 + j > myq) y = -INFINITY;
                            st[m][j] = y;
                        }
                    }
#pragma unroll
                    for (int j = 0; j < 4; ++j) mx = fmaxf(mx, st[m][j]);
                }
                mx = fmaxf(mx, SHX(mx, 16));
                mx = fmaxf(mx, SHX(mx, 32));
                const float mnew = fmaxf(mrun[mp], mx);
                const float alpha = FAST_EXP2(mrun[mp] - mnew);
                mrun[mp] = mnew;
                float ps = 0.f;
#pragma unroll
                for (int m = 0; m < 4; ++m)
#pragma unroll
                    for (int j = 0; j < 4; ++j) { const float pv = FAST_EXP2(st[m][j] - mnew); st[m][j] = pv; ps += pv; }
                lsum[mp] = lsum[mp] * alpha + ps;
#pragma unroll
                for (int mo = 0; mo < 8; ++mo) ot[mp][mo] *= alpha;
                bf16x8 pf[2];
#pragma unroll
                for (int kk = 0; kk < 2; ++kk) {
                    u32x4 pw;
                    pw.x = pack2(st[2 * kk][0], st[2 * kk][1]); pw.y = pack2(st[2 * kk][2], st[2 * kk][3]);
                    pw.z = pack2(st[2 * kk + 1][0], st[2 * kk + 1][1]); pw.w = pack2(st[2 * kk + 1][2], st[2 * kk + 1][3]);
                    pf[kk] = __builtin_bit_cast(bf16x8, pw);
                }
                bf16x8 vfb[8];
#pragma unroll
                for (int mo = 0; mo < 8; ++mo) { const int d = mo * 16 + r16; vfb[mo] = *(const bf16x8*)(vb + d * 128 + (((1 * 4 + q4) ^ ((d >> 1) & 7)) << 4)); }
                SCHED();
#pragma unroll
                for (int mo = 0; mo < 8; ++mo) ot[mp][mo] = MFMA16(vfa[mo], pf[0], ot[mp][mo]);
                SCHED();
#pragma unroll
                for (int mo = 0; mo < 8; ++mo) ot[mp][mo] = MFMA16(vfb[mo], pf[1], ot[mp][mo]);
            }
        }
    }
    float inv[NMAP];
#pragma unroll
    for (int mp = 0; mp < NMAP; ++mp) { float l = lsum[mp]; l += SHX(l, 16); l += SHX(l, 32); inv[mp] = 1.f / l; }
    if (KIND == 0) {
#pragma unroll
        for (int mo = 0; mo < 8; ++mo) {
            u32x2 o; o.x = pack2(ot[0][mo][0] * inv[0], ot[0][mo][1] * inv[0]); o.y = pack2(ot[0][mo][2] * inv[0], ot[0][mo][3] * inv[0]);
            *(u32x2*)(concat + (size_t)myq * D + ccol0 + mo * 16 + 4 * q4) = o;
        }
    } else {
        float ss = 0.f;
#pragma unroll
        for (int mo = 0; mo < 8; ++mo)
#pragma unroll
            for (int j = 0; j < 4; ++j) { const float v = ot[0][mo][j] * inv[0] - lam * (ot[NMAP - 1][mo][j] * inv[NMAP - 1]); ot[0][mo][j] = v; ss += v * v; }
        ss += SHX(ss, 16); ss += SHX(ss, 32);
        const float rs = osc / sqrtf(ss * (1.f / 128.f) + LN_EPS);
#pragma unroll
        for (int mo = 0; mo < 8; ++mo) {
            const f32x4 g = *(const f32x4*)(subg + mo * 16 + 4 * q4);
            u32x2 o; o.x = pack2(ot[0][mo][0] * rs * g[0], ot[0][mo][1] * rs * g[1]); o.y = pack2(ot[0][mo][2] * rs * g[2], ot[0][mo][3] * rs * g[3]);
            *(u32x2*)(concat + (size_t)myq * D + ccol0 + mo * 16 + 4 * q4) = o;
        }
    }
    __syncthreads();
}

__device__ __forceinline__ int dpart_row(int c, int q) { return c * (S - DCH * 64) - (DCH * 32) * c * (c - 1) + q; }
__device__ __forceinline__ void attn_dmap_unit(const bf16_t* Qh, const bf16_t* Kh, const bf16_t* VTh, int mp, int qb, int t0, int t1,
                                               bf16_t* Op, float* ML, int c, float bnd, unsigned char* lds, int tid) {
    const bool fixedref = (bnd <= 60.f);
    const int lane = tid & 63, wave = tid >> 6, r16 = lane & 15, q4 = lane >> 4;
    const int q0w = qb * 256 + wave * 32;
    const int wlimit = q0w >> 6;
    bf16x8 qf[2][2];
#pragma unroll
    for (int n = 0; n < 2; ++n)
#pragma unroll
        for (int ks = 0; ks < 2; ++ks) qf[n][ks] = *(const bf16x8*)(Qh + (size_t)(q0w + n * 16 + r16) * 128 + mp * 64 + ks * 32 + q4 * 8);
    f32x4 ot[8][2];
    float mrun[2] = {-INFINITY, -INFINITY}, lsum[2] = {0.f, 0.f};
    if (fixedref) { mrun[0] = bnd; mrun[1] = bnd; }
    const float stinit = fixedref ? -bnd : 0.f;
#pragma unroll
    for (int mo = 0; mo < 8; ++mo) { ot[mo][0] = (f32x4){0.f, 0.f, 0.f, 0.f}; ot[mo][1] = (f32x4){0.f, 0.f, 0.f, 0.f}; }
    u32x4 sk, sv[2];
    const u32x4* kg = (const u32x4*)Kh; const u32x4* vg = (const u32x4*)VTh;
    const int krow = tid >> 3, kc8 = tid & 7;
    sk = kg[(size_t)t0 * 1024 + krow * 16 + mp * 8 + kc8];
#pragma unroll
    for (int i = 0; i < 2; ++i) sv[i] = vg[(size_t)t0 * 1024 + tid + i * 512];
    for (int kt = t0; kt < t1; ++kt) {
        unsigned char* kb = lds + (kt & 1) * 8192;
        unsigned char* vb = lds + 16384 + (kt & 1) * 16384;
        *(u32x4*)(kb + krow * 128 + ((kc8 ^ ((krow >> 1) & 7)) << 4)) = sk;
#pragma unroll
        for (int i = 0; i < 2; ++i) { const int g = tid + i * 512, d = g >> 3, cc = g & 7; *(u32x4*)(vb + d * 128 + ((cc ^ ((d >> 1) & 7)) << 4)) = sv[i]; }
        __syncthreads();
        if (kt + 1 < t1) {
            sk = kg[(size_t)(kt + 1) * 1024 + krow * 16 + mp * 8 + kc8];
#pragma unroll
            for (int i = 0; i < 2; ++i) sv[i] = vg[(size_t)(kt + 1) * 1024 + tid + i * 512];
        }
        if (kt <= wlimit) {
            bf16x8 kf[4][2], vfa[8];
#pragma unroll
            for (int m = 0; m < 4; ++m)
#pragma unroll
                for (int ks = 0; ks < 2; ++ks) kf[m][ks] = *(const bf16x8*)(kb + (m * 16 + r16) * 128 + (((ks * 4 + q4) ^ ((r16 >> 1) & 7)) << 4));
#pragma unroll
            for (int mo = 0; mo < 8; ++mo) { const int d = mo * 16 + r16; vfa[mo] = *(const bf16x8*)(vb + d * 128 + (((0 * 4 + q4) ^ ((d >> 1) & 7)) << 4)); }
            SCHED();
            f32x4 st[4][2];
#pragma unroll
            for (int m = 0; m < 4; ++m) { st[m][0] = (f32x4){stinit, stinit, stinit, stinit}; st[m][1] = (f32x4){stinit, stinit, stinit, stinit}; }
            SETPRIO(1);
#pragma unroll
            for (int ks = 0; ks < 2; ++ks)
#pragma unroll
                for (int m = 0; m < 4; ++m) { st[m][0] = MFMA16(kf[m][ks], qf[0][ks], st[m][0]); st[m][1] = MFMA16(kf[m][ks], qf[1][ks], st[m][1]); }
            SETPRIO(0);
            SCHED();
            float alpha[2] = {1.f, 1.f};
            if (fixedref) {
#pragma unroll
                for (int n = 0; n < 2; ++n) {
                    float ps = 0.f;
#pragma unroll
                    for (int m = 0; m < 4; ++m)
#pragma unroll
                        for (int j = 0; j < 4; ++j) { const float pv = FAST_EXP2(st[m][n][j]); st[m][n][j] = pv; ps += pv; }
                    lsum[n] += ps;
                }
            } else
#pragma unroll
            for (int n = 0; n < 2; ++n) {
                float mx = -INFINITY;
#pragma unroll
                for (int m = 0; m < 4; ++m)
#pragma unroll
                    for (int j = 0; j < 4; ++j) mx = fmaxf(mx, st[m][n][j]);
                mx = fmaxf(mx, SHX(mx, 16));
                mx = fmaxf(mx, SHX(mx, 32));
                const float mnew = fmaxf(mrun[n], mx);
                alpha[n] = FAST_EXP2(mrun[n] - mnew);
                mrun[n] = mnew;
                float ps = 0.f;
#pragma unroll
                for (int m = 0; m < 4; ++m)
#pragma unroll
                    for (int j = 0; j < 4; ++j) { const float pv = FAST_EXP2(st[m][n][j] - mnew); st[m][n][j] = pv; ps += pv; }
                lsum[n] = lsum[n] * alpha[n] + ps;
            }
            if (ANY_LANE(alpha[0] != 1.f)) {
#pragma unroll
                for (int mo = 0; mo < 8; ++mo) ot[mo][0] *= alpha[0];
            }
            if (ANY_LANE(alpha[1] != 1.f)) {
#pragma unroll
                for (int mo = 0; mo < 8; ++mo) ot[mo][1] *= alpha[1];
            }
            bf16x8 pf[2][2];
#pragma unroll
            for (int kk = 0; kk < 2; ++kk)
#pragma unroll
                for (int n = 0; n < 2; ++n) {
                    u32x4 pw;
                    pw.x = pack2(st[2 * kk][n][0], st[2 * kk][n][1]); pw.y = pack2(st[2 * kk][n][2], st[2 * kk][n][3]);
                    pw.z = pack2(st[2 * kk + 1][n][0], st[2 * kk + 1][n][1]); pw.w = pack2(st[2 * kk + 1][n][2], st[2 * kk + 1][n][3]);
                    pf[kk][n] = __builtin_bit_cast(bf16x8, pw);
                }
            bf16x8 vfb[8];
#pragma unroll
            for (int mo = 0; mo < 8; ++mo) { const int d = mo * 16 + r16; vfb[mo] = *(const bf16x8*)(vb + d * 128 + (((1 * 4 + q4) ^ ((d >> 1) & 7)) << 4)); }
            SCHED();
            SETPRIO(1);
#pragma unroll
            for (int mo = 0; mo < 8; ++mo) { ot[mo][0] = MFMA16(vfa[mo], pf[0][0], ot[mo][0]); ot[mo][1] = MFMA16(vfa[mo], pf[0][1], ot[mo][1]); }
            SCHED();
#pragma unroll
            for (int mo = 0; mo < 8; ++mo) { ot[mo][0] = MFMA16(vfb[mo], pf[1][0], ot[mo][0]); ot[mo][1] = MFMA16(vfb[mo], pf[1][1], ot[mo][1]); }
            SETPRIO(0);
        }
    }
    if (q0w >= DCH * 64 * c)
#pragma unroll
    for (int n = 0; n < 2; ++n) {
        float l = lsum[n]; l += SHX(l, 16); l += SHX(l, 32);
        const int row = dpart_row(c, q0w + n * 16 + r16);
#pragma unroll
        for (int mo = 0; mo < 8; ++mo) {
            u32x2 o; o.x = pack2(ot[mo][n][0], ot[mo][n][1]); o.y = pack2(ot[mo][n][2], ot[mo][n][3]);
            *(u32x2*)(Op + (size_t)(row * 128 + mo * 16 + 4 * q4)) = o;
        }
        if (q4 == 0) { ML[row * 2] = mrun[n]; ML[row * 2 + 1] = l; }
    }
    __syncthreads();
}

__device__ __forceinline__ void lru_unit_a(int chunk, int grp, int l, const Params& p, const bf16_t* Xr, const bf16_t* WaiT, float* hloc, float* ploc, float* sumA, float* sumH,
                                           unsigned char* lds, int tid) {
    const int lane = tid & 63, wave = tid >> 6, r16 = lane & 15, q4 = lane >> 4;
    unsigned char* XCB = lds; float* XU = (float*)(lds + 16384); float* LA = (float*)(lds + 49152); float* ENDS = (float*)(lds + 81920);
    const int t0 = chunk * 64, ch0 = grp * 128;
    bf16x8 bfr[2][4];
#pragma unroll
    for (int g = 0; g < 2; ++g)
#pragma unroll
        for (int ks = 0; ks < 4; ++ks) bfr[g][ks] = *(const bf16x8*)(WaiT + ((size_t)grp * 256 + g * 128 + wave * 16 + r16) * 128 + ks * 32 + q4 * 8);
    const int chg = ch0 + wave * 16 + r16;
    const float ba = p.in[I_BA][(size_t)l * LRU_W + chg], bi = p.in[I_BI][(size_t)l * LRU_W + chg];
    const float lam_raw = p.in[I_LAM][(size_t)l * LRU_W + chg];
    {
        const int c = tid & 127, tq = tid >> 7, ch = ch0 + c;
        const float* cw = p.in[I_CONVW] + (size_t)l * 4 * LRU_W + ch; const float cb = p.in[I_CONVB][(size_t)l * LRU_W + ch];
        const float w0 = cw[0], w1 = cw[LRU_W], w2 = cw[2 * LRU_W], w3 = cw[3 * LRU_W];
        const int ts = t0 + tq * 16;
        float x0 = (ts - 3 >= 0) ? bf2f(Xr[(size_t)(ts - 3) * LRU_W + ch]) : 0.f;
        float x1 = (ts - 2 >= 0) ? bf2f(Xr[(size_t)(ts - 2) * LRU_W + ch]) : 0.f;
        float x2 = (ts - 1 >= 0) ? bf2f(Xr[(size_t)(ts - 1) * LRU_W + ch]) : 0.f;
#pragma unroll
        for (int i = 0; i < 16; ++i) {
            const float x3 = bf2f(Xr[(size_t)(ts + i) * LRU_W + ch]);
            const float v = cb + w0 * x0 + w1 * x1 + w2 * x2 + w3 * x3;
            const int row = tq * 16 + i;
            XU[row * 128 + c] = v;
            *(bf16_t*)(XCB + row * 256 + (((c >> 3) ^ (row & 15)) << 4) + (c & 7) * 2) = f2bf(v);
            x0 = x1; x1 = x2; x2 = x3;
        }
    }
    __syncthreads();
    {
        const float lsl = 8.0f * log_sigmoid_f(lam_raw);
#pragma unroll
        for (int mt = 0; mt < 4; ++mt) {
            f32x4 ga = (f32x4){0.f, 0.f, 0.f, 0.f}, gi = (f32x4){0.f, 0.f, 0.f, 0.f};
#pragma unroll
            for (int ks = 0; ks < 4; ++ks) {
                const bf16x8 af = *(const bf16x8*)(XCB + (mt * 16 + r16) * 256 + (((ks * 4 + q4) ^ r16) << 4));
                ga = MFMA16(af, bfr[0][ks], ga); gi = MFMA16(af, bfr[1][ks], gi);
            }
#pragma unroll
            for (int j = 0; j < 4; ++j) {
                const int row = mt * 16 + 4 * q4 + j, idx = row * 128 + wave * 16 + r16;
                const float r = sigmoid_f(ga[j] + ba), ig = sigmoid_f(gi[j] + bi);
                const float log_a = lsl * r;
                LA[idx] = fexp(log_a);
                XU[idx] = sqrtf(neg_expm1_f(2.f * log_a)) * (ig * XU[idx]);
            }
        }
    }
    __syncthreads();
    {
        const int c = tid & 127, tq = tid >> 7, ch = ch0 + c;
        float h = 0.f, P = 1.f;
#pragma unroll
        for (int i = 0; i < 16; ++i) { const int idx = (tq * 16 + i) * 128 + c; const float a = LA[idx]; h = a * h + XU[idx]; P *= a; XU[idx] = h; LA[idx] = P; }
        ENDS[tq * 128 + c] = P; ENDS[512 + tq * 128 + c] = h;
        __syncthreads();
        float cin = 0.f, pin = 1.f;
        for (int s = 0; s < tq; ++s) { const float Ps = ENDS[s * 128 + c], hs = ENDS[512 + s * 128 + c]; cin = Ps * cin + hs; pin *= Ps; }
#pragma unroll
        for (int i = 0; i < 16; ++i) {
            const int idx = (tq * 16 + i) * 128 + c; const size_t gi = (size_t)(t0 + tq * 16 + i) * LRU_W + ch;
            const float Pl = LA[idx], hl = XU[idx];
            ((unsigned*)hloc)[gi] = pack2(hl + Pl * cin, Pl * pin);
        }
        if (tq == 3) { const float Pl = LA[63 * 128 + c], hl = XU[63 * 128 + c]; sumA[(size_t)chunk * LRU_W + ch] = Pl * pin; sumH[(size_t)chunk * LRU_W + ch] = hl + Pl * cin; }
    }
    __syncthreads();
}

__device__ __forceinline__ void moe_prefix(const int* cntb_, int G, unsigned char* lds, int tid) {
    int* tmp = (int*)lds; int* ctot = (int*)(lds + LDS_MISC + M_CTOT); int* coff = (int*)(lds + LDS_MISC + M_COFF);
    unsigned short* pre16 = (unsigned short*)(lds + LDS_MISC + M_PRE16);
    const int e = tid & 31, part = tid >> 5, PB = (G + 15) / 16;
    int sm = 0;
    for (int i = 0; i < PB; ++i) { const int b = part * PB + i; if (b < G) sm += cntb_[b * 32 + e]; }
    tmp[part * 32 + e] = sm;
    __syncthreads();
    int run = 0;
    for (int q = 0; q < part; ++q) run += tmp[q * 32 + e];
    for (int i = 0; i < PB; ++i) { const int b = part * PB + i; if (b < G) { pre16[e * 257 + b] = (unsigned short)run; run += cntb_[b * 32 + e]; } }
    if (part == 15) { ctot[e] = run; pre16[e * 257 + G] = (unsigned short)run; }
    __syncthreads();
    if (tid == 0) { int o = 0; for (int q = 0; q < 32; ++q) { coff[q] = o; o += ctot[q]; } coff[32] = o; }
    __syncthreads();
}
__device__ __forceinline__ void moe_rowtable(const int* ltok_, const float* lw_, const int* lslot_, int e, int m0, int c_e, int G, int segcap, unsigned char* lds, int tid_in) {
    int tid = tid_in; OPAQUE(tid);
    const unsigned short* pre = (const unsigned short*)(lds + LDS_MISC + M_PRE16) + e * 257;
    int* rtok = (int*)(lds + LDS_MISC + M_RTOK); float* rw = (float*)(lds + LDS_MISC + M_RW); int* rslot = (int*)(lds + LDS_MISC + M_RSLOT);
    if (tid < 256) {
        const int g = m0 + tid;
        int tk = 0, sl = 0; float w = 0.f;
        if (g < c_e) {
            int lo = 0, hi = G;
            while (hi - lo > 1) { const int mid = (lo + hi) >> 1; if ((int)pre[mid] <= g) lo = mid; else hi = mid; }
            const int idx = (e * G + lo) * segcap + (g - (int)pre[lo]);
            tk = ltok_[idx]; w = lw_[idx]; sl = lslot_[idx];
        }
        rtok[tid] = tk; rw[tid] = w; rslot[tid] = sl;
    }
    __syncthreads();
}
#define kmax2 ((float*)(wsl + A_KMAX))
#define dpo ((bf16_t*)(wsl + A_DPO))
#define dpml ((float*)(wsl + A_DPML))
#define cntb ((int*)(wsl + A_CNTB))
#define WinT ((bf16_t*)(wsl + WB_WIN))
#define WoT ((bf16_t*)(wsl + WB_WO))
#define WguT ((bf16_t*)(wsl + WB_WGU))
#define WdT ((bf16_t*)(wsl + WB_WD))
#define WaiT ((bf16_t*)(wsl + WB_WAI))
#define Wfa ((float*)(wsl + WF_FA))
#define W36b ((bf16_t*)(wsl + WF_R36))
#define ropecs ((float*)(wsl + WF_ROPE))
#define xb ((bf16_t*)(wsl + A_XB))
#define hb ((float*)(wsl + A_HB))
#define logf_ ((float*)(wsl + A_LOGF))
#define cum2 ((float*)(wsl + A_CUM))
#define Qa ((bf16_t*)(wsl + A_QA))
#define Ka ((bf16_t*)(wsl + A_KA))
#define VaT ((bf16_t*)(wsl + A_VAT))
#define Xr ((bf16_t*)(wsl + A_XR))
#define Gr ((bf16_t*)(wsl + A_GR))
#define Qc ((bf16_t*)(wsl + A_QC))
#define Kc ((bf16_t*)(wsl + A_KC))
#define VcT ((bf16_t*)(wsl + A_VCT))
#define hloc ((float*)(wsl + A_HLOC))
#define ploc ((float*)(wsl + A_PLOC))
#define sumA ((float*)(wsl + A_SUMA))
#define sumH ((float*)(wsl + A_SUMH))
#define concat ((bf16_t*)(wsl + A_CONCAT))
#define y1 ((float*)(wsl + A_Y1))
#define h1 ((float*)(wsl + A_H1))
#define lnstat ((float*)(wsl + A_H1 + (size_t)32 * 1024 * 1024))
#define h1b ((bf16_t*)(wsl + A_H1B))
#define ltok ((int*)(wsl + A_LTOK))
#define lw ((float*)(wsl + A_LW))
#define lslot ((int*)(wsl + A_LSLOT))
#define act ((bf16_t*)(wsl + A_ACT))
#define contrib ((bf16_t*)(wsl + A_CONTRIB))
#ifndef EMU
__global__ void __launch_bounds__(NTHREADS, 2)
#else
void
#endif
fwd_kernel(Params p) {
    DYN_LDS(lds_raw);
    float* ldsf = (float*)lds_raw;
    const int bid = blockIdx.x, G = gridDim.x;
    const int gthreads = G * NTHREADS, gwaves = G * (NTHREADS / 64);
    const int wave_s = RFL((int)threadIdx.x >> 6);
#define PHASE_IDS() unsigned char* wsl = ws; OPAQUE_S(wsl); int tid = wave_s * 64 + LANE_ID(); OPAQUE(tid); const int lane = tid & 63, wave = tid >> 6, gtid = bid * NTHREADS + tid, gwave = bid * (NTHREADS / 64) + wave; (void)lane; (void)wave; (void)gtid; (void)gwave

    unsigned char* ws = p.ws;
    volatile LAS unsigned* bst = (volatile LAS unsigned*)(lds_raw + LDS_MISC);
    unsigned* ubox = (unsigned*)(lds_raw + LDS_MISC + 16);
    if (threadIdx.x == 0) { bst[0] = 0u; bst[1] = 0u; bst[2] = 0u; bst[3] = 0u; }
    __syncthreads();
    XcdBarrier bar = xcd_barrier_post((unsigned*)ws, bst);

    const int* positions = (const int*)p.in[I_POS];

    constexpr int NPH = 8;
    const int lo = p.lo, hi = p.hi;
#ifdef ONLY_PHASE
#define PH_SEL(c) ((c) == ONLY_PHASE)
#else
#define PH_SEL(c) 1
#endif
#define PH_IN(k) (lo <= (k) && (k) < hi)
#define PH_BAR(k) do { if ((k) + 1 < hi) xcd_barrier(bar, wave_s == 0 && LANE_ID() == 0); } while (0)

    if (PH_SEL(-1) && PH_IN(0)) for (int rep = 0; rep < PH_REPS(-1); ++rep) {
        PHASE_IDS();
        for (int l = 0; l < DEPTH; ++l) {
            convert_mats(p.in[I_WIN] + (size_t)l * D * N_IN, 0, 1, N_IN, D, N_IN, WinT + (size_t)l * N_INP * D, 0, RmWin{}, ldsf, tid, bid, G);
            convert_mats(p.in[I_WO] + (size_t)l * D * D, 0, 1, D, D, D, WoT + (size_t)l * D * D, 0, RmIdent{}, ldsf, tid, bid, G);
            convert_mats(p.in[I_WA] + (size_t)l * 6 * 128 * 128, (size_t)128 * 128, 6, 128, 128, 128, WaiT + (size_t)l * 6 * 256 * 128, (size_t)256 * 128, RmIdent{}, ldsf, tid, bid, G);
            convert_mats(p.in[I_WI] + (size_t)l * 6 * 128 * 128, (size_t)128 * 128, 6, 128, 128, 128, WaiT + (size_t)l * 6 * 256 * 128, (size_t)256 * 128, RmOff{128}, ldsf, tid, bid, G);
        }
        for (int i = gtid; i < DEPTH * 8 * D; i += gthreads) { const int k = i % D, h = (i / D) % 8, l = i / (8 * D);
            Wfa[i] = (h < 6) ? p.in[I_WIN][(size_t)l * D * N_IN + (size_t)k * N_IN + C_FA + h] : 0.f; }
        for (int i = gtid; i < DEPTH * 48 * D; i += gthreads) { const int k = i % D, o = (i / D) % 48, l = i / (48 * D);
            const float w = (o < 4) ? p.in[I_WGRP][((size_t)l * D + k) * 4 + o] : (o < 36 ? p.in[I_WRT][((size_t)l * D + k) * 32 + (o - 4)] : 0.f);
            const bf16_t hi = f2bf(w);
            W36b[((size_t)l * 2 + 0) * 48 * D + (size_t)o * D + k] = hi; W36b[((size_t)l * 2 + 1) * 48 * D + (size_t)o * D + k] = f2bf(w - bf2f(hi)); }
        for (int i = gtid; i < S * 8; i += gthreads) { const int d = i & 7, t = i >> 3; const float ang = (float)positions[t] * p.inv_freq[d];
            ropecs[t * 16 + d] = cosf(ang); ropecs[t * 16 + 8 + d] = sinf(ang); }
        __syncthreads();
        for (int i = tid; i < 6 * D; i += NTHREADS) { const int k = i % D, h = i / D; ldsf[i] = p.in[I_WIN][(size_t)k * N_IN + C_FA + h]; }
        __syncthreads();
        for (int t0 = gwave * 2; t0 < S; t0 += gwaves * 2) {
            f32x4 v[2][8];
#pragma unroll
            for (int tk = 0; tk < 2; ++tk)
#pragma unroll
                for (int j = 0; j < 8; ++j) v[tk][j] = *(const f32x4*)(p.in[I_X] + (size_t)(t0 + tk) * D + j * 256 + lane * 4);
#pragma unroll
            for (int tk = 0; tk < 2; ++tk) {
                const int t = t0 + tk;
                float fa[6] = {0.f, 0.f, 0.f, 0.f, 0.f, 0.f};
#pragma unroll
                for (int j = 0; j < 8; ++j) {
                    const int c = j * 256 + lane * 4;
                    u32x2 o; o.x = pack2(v[tk][j][0], v[tk][j][1]); o.y = pack2(v[tk][j][2], v[tk][j][3]);
                    *(u32x2*)(xb + (size_t)t * D + c) = o;
#pragma unroll
                    for (int h = 0; h < 6; ++h) { const f32x4 w = *(const f32x4*)(ldsf + h * D + c); fa[h] += v[tk][j][0] * w[0] + v[tk][j][1] * w[1] + v[tk][j][2] * w[2] + v[tk][j][3] * w[3]; }
                    COMPILER_FENCE();
                }
#pragma unroll
                for (int h = 0; h < 6; ++h) { const float sm = wave_sum(fa[h]); if (lane == 0) logf_[h * S + t] = log_sigmoid_f(sm + p.in[I_BF][h]); }
            }
        }
        PH_BAR(0);
    }

    for (int l = 0; l < DEPTH; ++l) {
        const int pb = 1 + l * NPH;
#define hin ((l == 0) ? p.in[I_X] : (const float*)hb)
#define hout ((l == DEPTH - 1) ? p.out : hb)
#define workctr ((int*)(wsl + CTL_WORK_OFF) + l * 64)

        if (PH_SEL(0) && PH_IN(pb + 0)) {
            PHASE_IDS();
            int bz = bid; OPAQUE_S(bz);
            if (bz == 0) {
                double* part = (double*)lds_raw;
                const int per = S / 64;
                double s = 0.0;
                if (wave < 6) { for (int i = 0; i < per; ++i) s += (double)logf_[wave * S + lane * per + i]; part[wave * 64 + lane] = s; }
                __syncthreads();
                if (wave < 6) {
                    double run = 0.0;
                    for (int j = 0; j < lane; ++j) run += part[wave * 64 + j];
                    for (int i = 0; i < per; ++i) { run += (double)logf_[wave * S + lane * per + i]; cum2[wave * S + lane * per + i] = (float)(run * (double)LOG2E); }
                }
                __syncthreads();
            }
            bool conv_more = (l == 0);
#define CONV_ONE() do { if (conv_more) { __syncthreads(); if (tid == 0) *ubox = (unsigned)atomic_add_int((int*)(wsl + CTL_WORK_OFF) + 62, 1); __syncthreads(); \
                const int cid_ = RFL((int)*ubox); if (cid_ < NCONV) moe_conv_chunk(p, cid_, WguT, WdT, ldsf, tid); else conv_more = false; } } while (0)
            unsigned* cls = (unsigned*)(wsl + CTL_CLS_OFF) + l * 256;
            if (bz == 0) { WAIT_VM0(); __syncthreads(); if (tid == 0) { FENCE_REL_AGENT(); WAIT_VM0(); (void)xb_add(&cls[192], 1u); } }
            const bf16_t* Bt = WinT + (size_t)l * N_INP * D;
            constexpr int ntm = S / 256;
            const unsigned nooff[2][2] = {{0u, 0u}, {0u, 0u}};
            for (int i = 0; i < (bid & 3); ++i) CONV_ONE();
            for (;;) {
                __syncthreads();
                if (tid == 0) *ubox = (unsigned)atomic_add_int(workctr + 9, 1);
                __syncthreads();
                int t = RFL((int)*ubox);
                if (t >= ntm * 21) break;
                int pm, pn, kcls;
                if (t < ntm * 6) { pm = t / 6; pn = 15 + t % 6; kcls = 0; }
                else if (t < ntm * 12) { t -= ntm * 6; pm = t / 6; pn = 9 + t % 6; kcls = 1; }
                else { t -= ntm * 12; pm = t / 9; pn = t % 9; kcls = 2; }
                f32x4 acc[2][2][4][2];
                gemm_tile<false>(xb, pm * 256, nooff, Bt, pn * 256, D, lds_raw, acc, tid);
                int et = tid; OPAQUE(et); const int wr = et >> 8, wc = (et >> 6) & 3, fr = et & 15, fq = (et >> 4) & 3;
                if (pn < 6 || (pn >= 9 && pn < 19)) {
                    bf16_t* dst; float scale = 1.f; bool rope = false;
                    if (pn < 3) { dst = Qa; scale = QSCALE_A; } else if (pn < 6) { dst = Ka; } else if (pn < 12) { dst = Xr; } else if (pn < 15) { dst = Gr; }
                    else if (pn < 17) { dst = Qc; scale = QSCALE_C; rope = true; } else { dst = Kc; rope = true; }
                    const bool headmajor = (pn < 6) || (pn >= 15);
                    const int segpn = (pn < 3) ? pn : (pn < 6) ? pn - 3 : (pn < 12) ? pn - 9 : (pn < 15) ? pn - 12 : (pn < 17) ? pn - 15 : pn - 17;
#pragma unroll
                    for (int ai = 0; ai < 2; ++ai)
#pragma unroll
                        for (int m = 0; m < 4; ++m)
#pragma unroll
                            for (int bj = 0; bj < 2; ++bj)
#pragma unroll
                                for (int n = 0; n < 2; ++n) {
                                    const int dd = wc * 32 + n * 16 + fr;
#pragma unroll
                                    for (int j = 0; j < 4; ++j) {
                                        const int row = pm * 256 + ai * 128 + wr * 64 + m * 16 + fq * 4 + j;
                                        float v = acc[ai][bj][m][n][j];
                                        if (rope && n == 0 && (wc & 1) == 0) {
                                            const float pv = SHX(v, 8);
                                            const float cs = ropecs[row * 16 + (fr & 7)], sn = ropecs[row * 16 + 8 + (fr & 7)];
                                            v = (fr < 8) ? (v * cs - pv * sn) : (v * cs + pv * sn);
                                        }
                                        v *= scale;
                                        *(bf16_t*)(lds_raw + (ai * 128 + wr * 64 + m * 16 + fq * 4 + j) * 528 + (bj * 128 + dd) * 2) = f2bf(v);
                                    }
                                }
                    __syncthreads();
#pragma unroll 4
                    for (int i = 0; i < 16; ++i) {
                        const int idx = et + i * 512, lrow = idx >> 5, ch = idx & 31, row = pm * 256 + lrow;
                        const u32x4 val = *(const u32x4*)(lds_raw + lrow * 528 + ch * 16);
                        size_t gi;
                        if (headmajor) gi = ((size_t)(segpn * 2 + (ch >> 4)) * S + row) * 128 + (ch & 15) * 8;
                        else gi = (size_t)row * LRU_W + segpn * 256 + ch * 8;
                        *(u32x4*)(dst + gi) = val;
                    }
                    __syncthreads();
                    if (pn >= 15) {
                        float* part = ldsf;
#pragma unroll
                        for (int ai = 0; ai < 2; ++ai)
#pragma unroll
                            for (int m = 0; m < 4; ++m)
#pragma unroll
                                for (int bj = 0; bj < 2; ++bj)
#pragma unroll
                                    for (int j = 0; j < 4; ++j) {
                                        float ss = acc[ai][bj][m][0][j] * acc[ai][bj][m][0][j] + acc[ai][bj][m][1][j] * acc[ai][bj][m][1][j];
                                        ss += SHX(ss, 1); ss += SHX(ss, 2); ss += SHX(ss, 4); ss += SHX(ss, 8);
                                        if (fr == 0) part[(wc * 2 + bj) * 256 + ai * 128 + wr * 64 + m * 16 + fq * 4 + j] = ss;
                                    }
                        __syncthreads();
                        {
                            const int bj = et >> 8, row = et & 255;
                            float v0 = part[(0 * 2 + bj) * 256 + row] + part[(1 * 2 + bj) * 256 + row], v1 = part[(2 * 2 + bj) * 256 + row] + part[(3 * 2 + bj) * 256 + row];
                            v0 = fmaxf(v0, SHX(v0, 1)); v0 = fmaxf(v0, SHX(v0, 2)); v0 = fmaxf(v0, SHX(v0, 4)); v0 = fmaxf(v0, SHX(v0, 8)); v0 = fmaxf(v0, SHX(v0, 16)); v0 = fmaxf(v0, SHX(v0, 32));
                            v1 = fmaxf(v1, SHX(v1, 1)); v1 = fmaxf(v1, SHX(v1, 2)); v1 = fmaxf(v1, SHX(v1, 4)); v1 = fmaxf(v1, SHX(v1, 8)); v1 = fmaxf(v1, SHX(v1, 16)); v1 = fmaxf(v1, SHX(v1, 32));
                            if ((et & 63) == 0) {
                                unsigned* q2p = (unsigned*)(wsl + CTL_QK2_OFF) + l * 16 + (pn >= 17 ? 8 : 0) + (segpn * 2 + bj) * 2;
                                atomic_max_u32(q2p, __builtin_bit_cast(unsigned, v0)); atomic_max_u32(q2p + 1, __builtin_bit_cast(unsigned, v1));
                            }
                        }
                        __syncthreads();
                    }
                    if (pn >= 3 && pn < 6) {
                        float* part = ldsf;
#pragma unroll
                        for (int ai = 0; ai < 2; ++ai)
#pragma unroll
                            for (int m = 0; m < 4; ++m)
#pragma unroll
                                for (int bj = 0; bj < 2; ++bj)
#pragma unroll
                                    for (int j = 0; j < 4; ++j) {
                                        float ss = acc[ai][bj][m][0][j] * acc[ai][bj][m][0][j] + acc[ai][bj][m][1][j] * acc[ai][bj][m][1][j];
                                        ss += SHX(ss, 1); ss += SHX(ss, 2); ss += SHX(ss, 4); ss += SHX(ss, 8);
                                        if (fr == 0) part[(wc * 2 + bj) * 256 + ai * 128 + wr * 64 + m * 16 + fq * 4 + j] = ss;
                                    }
                        __syncthreads();
                        {
                            const int bj = et >> 8, row = et & 255;
                            float v = part[(0 * 2 + bj) * 256 + row] + part[(1 * 2 + bj) * 256 + row] + part[(2 * 2 + bj) * 256 + row] + part[(3 * 2 + bj) * 256 + row];
                            v = fmaxf(v, SHX(v, 1)); v = fmaxf(v, SHX(v, 2)); v = fmaxf(v, SHX(v, 4)); v = fmaxf(v, SHX(v, 8)); v = fmaxf(v, SHX(v, 16)); v = fmaxf(v, SHX(v, 32));
                            if ((et & 63) == 0) kmax2[((pn - 3) * 2 + bj) * NKT + pm * 4 + ((et >> 6) & 3)] = v;
                        }
                        __syncthreads();
                    }
                } else {
                    bf16_t* dst = (pn < 9) ? VaT : VcT;
                    const int segpn = (pn < 9) ? pn - 6 : pn - 19;
#pragma unroll
                    for (int ai = 0; ai < 2; ++ai)
#pragma unroll
                        for (int m = 0; m < 4; ++m)
#pragma unroll
                            for (int bj = 0; bj < 2; ++bj)
#pragma unroll
                                for (int n = 0; n < 2; ++n) {
                                    const int dd = wc * 32 + n * 16 + fr;
                                    const int row = pm * 256 + ai * 128 + wr * 64 + m * 16 + fq * 4;
                                    const f32x4 a = acc[ai][bj][m][n];
                                    u32x2 o; o.x = pack2(a[0], a[1]); o.y = pack2(a[2], a[3]);
                                    const int s6 = row & 63, pos = (s6 & 32) + ((s6 >> 2) & 3) * 8 + ((s6 >> 4) & 1) * 4;
                                    *(u32x2*)(dst + (((size_t)(segpn * 2 + bj) * NKT + (row >> 6)) * 128 + dd) * 64 + pos) = o;
                                }
                }
                WAIT_VM0();
                __syncthreads();
                if (et == 0) { FENCE_REL_AGENT(); WAIT_VM0(); (void)xb_add(&cls[kcls * 64], 1u); }
                CONV_ONE();
            }
        }

        if (PH_SEL(1) && PH_IN(pb + 1)) {
            PHASE_IDS();
            const float lam_init = (l == 0) ? 0.2f : 0.35550906759f;
            const float s1 = wave_sum(p.in[I_LQ1][l * 64 + lane] * p.in[I_LK1][l * 64 + lane]);
            const float s2 = wave_sum(p.in[I_LQ2][l * 64 + lane] * p.in[I_LK2][l * 64 + lane]);
            const float lam = fexp(s1) - fexp(s2) + lam_init;
            constexpr int NLRU = NKT * 6, NQB = S / 128;
            bool conv_more = (l == 0);
            unsigned* cls = (unsigned*)(wsl + CTL_CLS_OFF) + l * 256;
            unsigned* bw = (unsigned*)wsl;
#define WAIT_CLASS(k, n) do { __syncthreads(); if (tid == 0) { XB_SPIN(xb_ld(&cls[(k) * 64]) < (unsigned)(n), bw); FENCE_ACQ_AGENT(); WAIT_VM0(); } __syncthreads(); } while (0)
#ifndef NO_DIFF
            {
                constexpr int NQB2 = S / 256;
                int total = 0;
                for (int q = 0; q < NQB2; ++q) total += ((4 * q + 4 + DCH - 1) / DCH) * 8;
                WAIT_CLASS(0, (S / 256) * 6);
                for (;;) {
                    __syncthreads();
                    if (tid == 0) *ubox = (unsigned)atomic_add_int(workctr, 1);
                    __syncthreads();
                    int u = RFL((int)*ubox);
                    if (u >= total) break;
                    int qb = NQB2 - 1;
                    for (;; --qb) { const int nu = ((4 * qb + 4 + DCH - 1) / DCH) * 8; if (u < nu) break; u -= nu; }
                    const int c = u >> 3, h = (u >> 1) & 3, mp = u & 1;
                    const int t0 = c * DCH, t1 = (t0 + DCH < 4 * qb + 4) ? t0 + DCH : 4 * qb + 4;
                    const unsigned* q2p = (const unsigned*)(wsl + CTL_QK2_OFF) + l * 16;
                    const float bnd = sqrtf(__builtin_bit_cast(float, q2p[h * 2 + mp]) * __builtin_bit_cast(float, q2p[8 + h * 2 + mp])) * (QSCALE_C * 1.02f) + 0.01f;
                    attn_dmap_unit(Qc + (size_t)h * S * 128, Kc + (size_t)h * S * 128, VcT + (size_t)h * S * 128, mp, qb, t0, t1,
                                   dpo + (size_t)(h * 2 + mp) * DPART_ROWS * 128, dpml + (size_t)(h * 2 + mp) * DPART_ROWS * 2, c, RFL_F(bnd), lds_raw, tid);
                    CONV_ONE();
                }
            }
#endif
#ifndef NO_LRU
            WAIT_CLASS(1, (S / 256) * 6);
            for (;;) {
                __syncthreads();
                if (tid == 0) *ubox = (unsigned)atomic_add_int(workctr + 10, 1);
                __syncthreads();
                const int u = RFL((int)*ubox);
                if (u >= NLRU) break;
                lru_unit_a(u / 6, u % 6, l, p, Xr, WaiT + (size_t)l * 6 * 256 * 128, hloc, ploc, sumA, sumH, lds_raw, tid);
            }
#endif
#ifndef NO_FOX
            WAIT_CLASS(2, (S / 256) * 9);
            WAIT_CLASS(3, 1);
            for (;;) {
                __syncthreads();
                if (tid == 0) *ubox = (unsigned)atomic_add_int(workctr + 1, 1);
                __syncthreads();
                const int u = RFL((int)*ubox);
                if (u >= NQB * FOX_H) break;
                const int qb = NQB - 1 - u / FOX_H, h = u % FOX_H;
                attn_unit<0>(Qa + (size_t)h * S * 128, Ka + (size_t)h * S * 128, VaT + (size_t)h * S * 128, cum2 + (size_t)h * S, kmax2 + h * NKT, qb, concat, h * 128,
                             0.f, 0.f, nullptr, lds_raw, tid);
            }
#endif
            while (conv_more) CONV_ONE();
            PH_BAR(pb + 1);
        }

        if (PH_SEL(2) && PH_IN(pb + 2)) for (int rep = 0; rep < PH_REPS(2); ++rep) {
            PHASE_IDS();
            for (int u = bid; u < NKT * 6; u += G) {
                const int chunk = u / 6, grp = u % 6, c = tid & 127, tq = tid >> 7, ch = grp * 128 + c;
                float cr = 0.f;
                {
                    int j = 0;
                    for (; j + 16 <= chunk; j += 16) {
                        float a8[16], h8[16];
#pragma unroll
                        for (int q = 0; q < 16; ++q) { a8[q] = sumA[(size_t)(j + q) * LRU_W + ch]; h8[q] = sumH[(size_t)(j + q) * LRU_W + ch]; }
#pragma unroll
                        for (int q = 0; q < 16; ++q) cr = a8[q] * cr + h8[q];
                    }
                    for (; j < chunk; ++j) cr = sumA[(size_t)j * LRU_W + ch] * cr + sumH[(size_t)j * LRU_W + ch];
                }
                float hl[16], pl[16]; bf16_t gg[16];
#pragma unroll
                for (int i = 0; i < 16; ++i) { const size_t gi = (size_t)(chunk * 64 + tq * 16 + i) * LRU_W + ch; const unsigned hp = ((const unsigned*)hloc)[gi]; hl[i] = bf2f((bf16_t)(hp & 0xffffu)); pl[i] = bf2f((bf16_t)(hp >> 16)); gg[i] = Gr[gi]; }
#pragma unroll
                for (int i = 0; i < 16; ++i)
                    concat[(size_t)(chunk * 64 + tq * 16 + i) * D + FOX_W + ch] = f2bf(gelu_tanh_f(bf2f(gg[i])) * (hl[i] + pl[i] * cr));
            }
            {
                const float lam_init = (l == 0) ? 0.2f : 0.35550906759f;
                const float s1 = wave_sum(p.in[I_LQ1][l * 64 + lane] * p.in[I_LK1][l * 64 + lane]);
                const float s2 = wave_sum(p.in[I_LQ2][l * 64 + lane] * p.in[I_LK2][l * 64 + lane]);
                const float lam = fexp(s1) - fexp(s2) + lam_init;
                const float* sg = p.in[I_SUBG] + l * 128;
                const float g0 = sg[2 * lane], g1 = sg[2 * lane + 1];
                static_assert(NCH <= 8, "the merge below keeps one (map, chunk) pair per lane: 2 x 8 lanes");
                for (int q = gwave; q < S; q += gwaves) {
                    const int nch = (q >> 6) / DCH + 1;
                    float mv = -INFINITY, lv = 0.f;
                    { const int c = lane & 7, hm = lane >> 3;
                      if (c < nch) { const float* ML = dpml + ((size_t)hm * DPART_ROWS + dpart_row(c, q)) * 2; mv = ML[0]; lv = ML[1]; } }
                    unsigned pk[4][2][NCH];
#pragma unroll
                    for (int h = 0; h < 4; ++h)
#pragma unroll
                        for (int mp = 0; mp < 2; ++mp) {
                            const unsigned* OP = (const unsigned*)(dpo + (size_t)(h * 2 + mp) * DPART_ROWS * 128);
#pragma unroll
                            for (int c = 0; c < NCH; ++c) pk[h][mp][c] = (c < nch) ? OP[(size_t)dpart_row(c, q) * 64 + lane] : 0u;
                        }
                    float Mx = mv; Mx = fmaxf(Mx, SHX(Mx, 1)); Mx = fmaxf(Mx, SHX(Mx, 2)); Mx = fmaxf(Mx, SHX(Mx, 4));
                    const float wv = (mv == -INFINITY) ? 0.f : FAST_EXP2(mv - Mx);
                    float Lp = lv * wv; Lp += SHX(Lp, 1); Lp += SHX(Lp, 2); Lp += SHX(Lp, 4);
#pragma unroll
                    for (int h = 0; h < 4; ++h) {
                        float om[2][2];
#pragma unroll
                        for (int mp = 0; mp < 2; ++mp) {
                            float o0 = 0.f, o1 = 0.f;
#pragma unroll
                            for (int c = 0; c < NCH; ++c) { const float w = RDLANE(wv, (h * 2 + mp) * 8 + c); o0 += bf2f((bf16_t)(pk[h][mp][c] & 0xffffu)) * w; o1 += bf2f((bf16_t)(pk[h][mp][c] >> 16)) * w; }
                            const float il = 1.f / RDLANE(Lp, (h * 2 + mp) * 8);
                            om[mp][0] = o0 * il; om[mp][1] = o1 * il;
                        }
                        const float v0 = om[0][0] - lam * om[1][0], v1 = om[0][1] - lam * om[1][1];
                        const float ss = wave_sum(v0 * v0 + v1 * v1);
                        const float rs = (1.f - lam_init) / sqrtf(ss * (1.f / 128.f) + LN_EPS);
                        *(unsigned*)(concat + (size_t)q * D + 1536 + h * 128 + 2 * lane) = pack2(v0 * rs * g0, v1 * rs * g1);
                    }
                }
            }
            PH_BAR(pb + 2);
        }

        if (PH_SEL(3) && PH_IN(pb + 3)) for (int rep = 0; rep < PH_REPS(3); ++rep) {
            PHASE_IDS();
            const bf16_t* Bt = WoT + (size_t)l * D * D;
            constexpr int ntn = D / 256, ntm = S / 256;
            const unsigned nooff[2][2] = {{0u, 0u}, {0u, 0u}};
            for (int t0 = bid; t0 < ntm * ntn; t0 += G) {
                int t = t0;
                if (G == 256 && ntm * ntn == 256) { const int x = t0 & 7, j = t0 >> 3; t = (x * 4 + (j >> 3)) * ntn + (j & 7); }
                const int pm = t / ntn, pn = t % ntn;
                f32x4 acc[2][2][4][2];
                gemm_tile<false>(concat, pm * 256, nooff, Bt, pn * 256, D, lds_raw, acc, tid);
                int et = tid; OPAQUE(et); const int wr = et >> 8, wc = (et >> 6) & 3, fr = et & 15, fq = (et >> 4) & 3;
#pragma unroll
                for (int ai = 0; ai < 2; ++ai) {
#pragma unroll
                    for (int m = 0; m < 4; ++m)
#pragma unroll
                        for (int bj = 0; bj < 2; ++bj)
#pragma unroll
                            for (int n = 0; n < 2; ++n)
#pragma unroll
                                for (int j = 0; j < 4; ++j)
                                    *(float*)(lds_raw + (wr * 64 + m * 16 + fq * 4 + j) * 1040 + (bj * 128 + wc * 32 + n * 16 + fr) * 4) = acc[ai][bj][m][n][j];
                    __syncthreads();
#pragma unroll 4
                    for (int i = 0; i < 16; ++i) {
                        const int idx = et + i * 512, lrow = idx >> 6, c4 = idx & 63;
                        const size_t gi = (size_t)(pm * 256 + ai * 128 + lrow) * D + pn * 256 + c4 * 4;
                        const f32x4 v = *(const f32x4*)(lds_raw + lrow * 1040 + c4 * 16);
                        *(f32x4*)(y1 + gi) = ALPHA * *(const f32x4*)(hin + gi) + v;
                    }
                    __syncthreads();
                }
            }
            PH_BAR(pb + 3);
        }

        if (PH_SEL(4) && PH_IN(pb + 4)) for (int rep = 0; rep < PH_REPS(4); ++rep) {
            PHASE_IDS();
            const float* g1 = p.in[I_LN1G] + (size_t)l * D; const float* b1 = p.in[I_LN1B] + (size_t)l * D;
            const float* bg = p.in[I_BGRP] + l * 4; const float* br = p.in[I_BRT] + l * 32;
            const bf16_t* Wb = W36b + (size_t)l * 2 * 48 * D;
            int* lcnt = (int*)(lds_raw + LDS_MISC + M_LCNT);
            const int segcap = ((S / 16 + G - 1) / G) * 16;
            const int r16 = lane & 15, q4 = lane >> 4;
            if (tid < 32) lcnt[tid] = 0;
            f32x4 gq[8], bq[8];
#pragma unroll
            for (int j = 0; j < 8; ++j) { gq[j] = *(const f32x4*)(g1 + j * 256 + lane * 4); bq[j] = *(const f32x4*)(b1 + j * 256 + lane * 4); }
            __syncthreads();
            for (int bi = bid; bi < S / 16; bi += G) {
                f32x4 v2[2][8];
#pragma unroll
                for (int tk = 0; tk < 2; ++tk)
#pragma unroll
                    for (int j = 0; j < 8; ++j) v2[tk][j] = *(const f32x4*)(y1 + (size_t)(bi * 16 + wave * 2 + tk) * D + j * 256 + lane * 4);
#pragma unroll
                for (int tk = 0; tk < 2; ++tk) {
                    const int r = wave * 2 + tk, t = bi * 16 + r;
                    float s = 0.f;
#pragma unroll
                    for (int j = 0; j < 8; ++j) s += (v2[tk][j][0] + v2[tk][j][1]) + (v2[tk][j][2] + v2[tk][j][3]);
                    const float mean = wave_sum(s) * (1.f / D);
                    float s2 = 0.f;
#pragma unroll
                    for (int j = 0; j < 8; ++j) { v2[tk][j] -= mean; s2 += (v2[tk][j][0] * v2[tk][j][0] + v2[tk][j][1] * v2[tk][j][1]) + (v2[tk][j][2] * v2[tk][j][2] + v2[tk][j][3] * v2[tk][j][3]); }
                    const float rstd = 1.f / sqrtf(wave_sum(s2) * (1.f / D) + LN_EPS);
                    if (lane == 0) { lnstat[2 * t] = mean; lnstat[2 * t + 1] = rstd; }
#pragma unroll
                    for (int j = 0; j < 8; ++j) {
                        const int c = j * 256 + lane * 4;
                        const f32x4 hv = v2[tk][j] * rstd * gq[j] + bq[j];
                        u32x2 o; o.x = pack2(hv[0], hv[1]); o.y = pack2(hv[2], hv[3]);
                        *(u32x2*)(h1b + (size_t)t * D + c) = o;
                        u32x2 lo2;
                        lo2.x = pack2(hv[0] - bf2f((bf16_t)(o.x & 0xffffu)), hv[1] - bf2f((bf16_t)(o.x >> 16)));
                        lo2.y = pack2(hv[2] - bf2f((bf16_t)(o.y & 0xffffu)), hv[3] - bf2f((bf16_t)(o.y >> 16)));
                        const int la = r * 4096 + (((j * 32 + (lane >> 1)) ^ r) << 4) + (lane & 1) * 8;
                        *(u32x2*)(lds_raw + la) = o; *(u32x2*)(lds_raw + 65536 + la) = lo2;
                    }
                }
                __syncthreads();
                f32x4 ac[3];
#pragma unroll
                for (int nt = 0; nt < 3; ++nt) ac[nt] = (f32x4){0.f, 0.f, 0.f, 0.f};
#pragma unroll 4
                for (int ks = 0; ks < 8; ++ks) {
                    const int kk = wave * 8 + ks;
                    const int la = r16 * 4096 + (((kk * 4 + q4) ^ r16) << 4);
                    const bf16x8 ah = *(const bf16x8*)(lds_raw + la), al = *(const bf16x8*)(lds_raw + 65536 + la);
#pragma unroll
                    for (int nt = 0; nt < 3; ++nt) {
                        const bf16x8 bh = *(const bf16x8*)(Wb + (size_t)(nt * 16 + r16) * D + kk * 32 + q4 * 8);
                        const bf16x8 bl = *(const bf16x8*)(Wb + (size_t)48 * D + (size_t)(nt * 16 + r16) * D + kk * 32 + q4 * 8);
                        ac[nt] = MFMA16(ah, bh, ac[nt]); ac[nt] = MFMA16(al, bh, ac[nt]); ac[nt] = MFMA16(ah, bl, ac[nt]);
                    }
                }
                __syncthreads();
                float* red = ldsf;
#pragma unroll
                for (int nt = 0; nt < 3; ++nt)
#pragma unroll
                    for (int j = 0; j < 4; ++j) red[(wave * 16 + q4 * 4 + j) * 48 + nt * 16 + r16] = ac[nt][j];
                __syncthreads();
                float* lgt = ldsf + 8 * 16 * 48;
                if (tid < 256) {
                    const int tkn = tid >> 4, o3 = (tid & 15) * 3;
#pragma unroll
                    for (int q = 0; q < 3; ++q) { float a = 0.f;
#pragma unroll
                        for (int w = 0; w < 8; ++w) a += red[(w * 16 + tkn) * 48 + o3 + q];
                        lgt[tkn * 48 + o3 + q] = a; }
                }
                __syncthreads();
                if (tid < 16) {
                    const int t = bi * 16 + tid; const float* L = lgt + tid * 48;
                    float gl[4];
#pragma unroll
                    for (int q = 0; q < 4; ++q) gl[q] = L[q] + bg[q];
                    int gi = 0; float gm = gl[0];
#pragma unroll
                    for (int q = 1; q < 4; ++q) if (gl[q] > gm) { gm = gl[q]; gi = q; }
                    float gs = 0.f;
#pragma unroll
                    for (int q = 0; q < 4; ++q) gs += fexp(gl[q] - gm);
                    const float gweight = 1.f / gs;
                    float E[8];
#pragma unroll
                    for (int e = 0; e < 8; ++e) E[e] = L[4 + gi * 8 + e] + br[gi * 8 + e];
                    int e1 = 0; float m1 = E[0];
#pragma unroll
                    for (int e = 1; e < 8; ++e) if (E[e] > m1) { m1 = E[e]; e1 = e; }
                    int e2 = -1; float m2 = -INFINITY;
#pragma unroll
                    for (int e = 0; e < 8; ++e) if (e != e1 && E[e] > m2) { m2 = E[e]; e2 = e; }
                    const float p2 = fexp(m2 - m1), w1 = 1.f / (1.f + p2), w2 = p2 / (1.f + p2);
                    const int ge1 = gi * 8 + e1, ge2 = gi * 8 + e2;
                    const int i1 = (ge1 * G + bid) * segcap + atomic_add_int(&lcnt[ge1], 1);
                    ltok[i1] = t; lw[i1] = gweight * w1; lslot[i1] = 0;
                    const int i2 = (ge2 * G + bid) * segcap + atomic_add_int(&lcnt[ge2], 1);
                    ltok[i2] = t; lw[i2] = gweight * w2; lslot[i2] = 1;
                }
                __syncthreads();
            }
            if (tid < 32) cntb[bid * 32 + tid] = lcnt[tid];
            PH_BAR(pb + 4);
        }

        if (PH_SEL(5) && PH_IN(pb + 5)) {
            PHASE_IDS();
            const unsigned nooff[2][2] = {{0u, 0u}, {0u, 0u}};
            const int segcap = ((S / 16 + G - 1) / G) * 16;
            moe_prefix(cntb, G, lds_raw, tid);
            const int* ctot = (const int*)(lds_raw + LDS_MISC + M_CTOT); const int* coff = (const int*)(lds_raw + LDS_MISC + M_COFF);
            const int* rtok = (const int*)(lds_raw + LDS_MISC + M_RTOK); const float* rw = (const float*)(lds_raw + LDS_MISC + M_RW);
            const int* rslot = (const int*)(lds_raw + LDS_MISC + M_RSLOT);
            unsigned* done = (unsigned*)(wsl + CTL_DONE_OFF) + l * 1024;
            int nmt = 0;
            for (int e = 0; e < NEXP; ++e) nmt += (ctot[e] + 255) / 256;
            nmt = RFL(nmt);
            for (;;) {
                __syncthreads();
                if (tid == 0) *ubox = (unsigned)atomic_add_int(workctr + 8, 1);
                __syncthreads();
                int u = RFL((int)*ubox);
                if (u >= nmt * 12) break;
                const bool down = (u >= nmt * 4);
                const int per = down ? 8 : 4;
                if (down) u -= nmt * 4;
                int e = 0;
                for (;; ++e) { const int nt = ((RFL(ctot[e]) + 255) / 256) * per; if (u < nt) break; u -= nt; }
                const int c = RFL(ctot[e]), off = RFL(coff[e]);
                const int mt = u / per, pn = u % per, m0 = mt * 256;
                moe_rowtable(ltok, lw, lslot, e, m0, c, G, segcap, lds_raw, tid);
                f32x4 acc[2][2][4][2];
                if (!down) {
                    const bf16_t* Bt = WguT + ((size_t)l * NEXP + e) * 1024 * D;
                    unsigned aoff[2][2];
                    int st = tid; OPAQUE(st); int R[2], C[2]; stage_geom(st, R, C);
#pragma unroll
                    for (int h = 0; h < 2; ++h)
#pragma unroll
                        for (int i = 0; i < 2; ++i) aoff[h][i] = (unsigned)(rtok[h * 128 + R[i]] * D + C[i]);
                    gemm_tile<true>(h1b, 0, aoff, Bt, pn * 256, D, lds_raw, acc, tid);
                    int et = tid; OPAQUE(et); const int wr = et >> 8, wc = (et >> 6) & 3, fr = et & 15, fq = (et >> 4) & 3;
#pragma unroll
                    for (int ai = 0; ai < 2; ++ai)
#pragma unroll
                        for (int m = 0; m < 4; ++m)
#pragma unroll
                            for (int j = 0; j < 4; ++j) {
                                const int r = ai * 128 + wr * 64 + m * 16 + fq * 4 + j;
                                const float wgt = rw[r];
#pragma unroll
                                for (int bj = 0; bj < 2; ++bj)
                                    *(bf16_t*)(lds_raw + r * 272 + (bj * 64 + wc * 16 + fr) * 2) = f2bf(silu_f(acc[ai][bj][m][0][j]) * acc[ai][bj][m][1][j] * wgt);
                            }
                    __syncthreads();
#pragma unroll 4
                    for (int i = 0; i < 8; ++i) {
                        const int idx = et + i * 512, r = idx >> 4, ch = idx & 15;
                        if (m0 + r < c) *(u32x4*)(act + (size_t)(off + m0 + r) * DFF + pn * 128 + ch * 8) = *(const u32x4*)(lds_raw + r * 272 + ch * 16);
                    }
                    WAIT_VM0();
                    __syncthreads();
                    if (et == 0) { FENCE_REL_AGENT(); WAIT_VM0(); (void)xb_add(&done[e * 32 + mt], 1u); }
                } else {
                    const bf16_t* Bt = WdT + ((size_t)l * NEXP + e) * D * DFF;
                    if (tid == 0) {
                        unsigned* bw = (unsigned*)wsl;
                        XB_SPIN(xb_ld(&done[e * 32 + mt]) < 4u, bw);
                        FENCE_ACQ_AGENT();
                        WAIT_VM0();
                    }
                    __syncthreads();
                    gemm_tile<false>(act, off + m0, nooff, Bt, pn * 256, DFF, lds_raw, acc, tid);
                    int et = tid; OPAQUE(et); const int wr = et >> 8, wc = (et >> 6) & 3, fr = et & 15, fq = (et >> 4) & 3;
#pragma unroll
                    for (int ai = 0; ai < 2; ++ai)
#pragma unroll
                        for (int m = 0; m < 4; ++m)
#pragma unroll
                            for (int bj = 0; bj < 2; ++bj)
#pragma unroll
                                for (int n = 0; n < 2; ++n)
#pragma unroll
                                    for (int j = 0; j < 4; ++j)
                                        *(bf16_t*)(lds_raw + (ai * 128 + wr * 64 + m * 16 + fq * 4 + j) * 528 + (bj * 128 + wc * 32 + n * 16 + fr) * 2) = f2bf(acc[ai][bj][m][n][j]);
                    __syncthreads();
#pragma unroll 4
                    for (int i = 0; i < 16; ++i) {
                        const int idx = et + i * 512, r = idx >> 5, ch = idx & 31;
                        if (m0 + r < c) *(u32x4*)(contrib + ((size_t)rslot[r] * S + rtok[r]) * D + pn * 256 + ch * 8) = *(const u32x4*)(lds_raw + r * 528 + ch * 16);
                    }
                }
            }
            PH_BAR(pb + 5);
        }

        if (PH_SEL(7) && PH_IN(pb + 7)) for (int rep = 0; rep < PH_REPS(7); ++rep) {
            PHASE_IDS();
            const float* g2 = p.in[I_LN2G] + (size_t)l * D; const float* b2 = p.in[I_LN2B] + (size_t)l * D;
            const bool more = (l + 1 < DEPTH);
            f32x4 gq[8], bq[8], g1q[8], b1q[8];
#pragma unroll
            for (int j = 0; j < 8; ++j) { gq[j] = *(const f32x4*)(g2 + j * 256 + lane * 4); bq[j] = *(const f32x4*)(b2 + j * 256 + lane * 4);
                g1q[j] = *(const f32x4*)(p.in[I_LN1G] + (size_t)l * D + j * 256 + lane * 4); b1q[j] = *(const f32x4*)(p.in[I_LN1B] + (size_t)l * D + j * 256 + lane * 4); }
            if (more) {
                const float* wf = Wfa + (size_t)(l + 1) * 8 * D;
                __syncthreads();
                for (int i = tid; i < 6 * D / 4; i += NTHREADS) *(f32x4*)(ldsf + i * 4) = *(const f32x4*)(wf + i * 4);
                __syncthreads();
            }
            for (int t = gwave; t < S; t += gwaves) {
                f32x4 v[8]; float s = 0.f;
                const float mean1 = lnstat[2 * t], rstd1 = lnstat[2 * t + 1];
#pragma unroll
                for (int j = 0; j < 8; ++j) {
                    const size_t i = (size_t)t * D + j * 256 + lane * 4;
                    const u32x2 c0 = *(const u32x2*)(contrib + i), c1 = *(const u32x2*)(contrib + (size_t)S * D + i);
                    const f32x4 cs = (f32x4){bf2f((bf16_t)(c0.x & 0xffffu)) + bf2f((bf16_t)(c1.x & 0xffffu)), bf2f((bf16_t)(c0.x >> 16)) + bf2f((bf16_t)(c1.x >> 16)),
                                             bf2f((bf16_t)(c0.y & 0xffffu)) + bf2f((bf16_t)(c1.y & 0xffffu)), bf2f((bf16_t)(c0.y >> 16)) + bf2f((bf16_t)(c1.y >> 16))};
                    v[j] = ALPHA * ((*(const f32x4*)(y1 + i) - mean1) * rstd1 * g1q[j] + b1q[j]) + cs;
                    s += (v[j][0] + v[j][1]) + (v[j][2] + v[j][3]);
                }
                const float mean = wave_sum(s) * (1.f / D);
                float s2 = 0.f;
#pragma unroll
                for (int j = 0; j < 8; ++j) { v[j] -= mean; s2 += (v[j][0] * v[j][0] + v[j][1] * v[j][1]) + (v[j][2] * v[j][2] + v[j][3] * v[j][3]); }
                const float rstd = 1.f / sqrtf(wave_sum(s2) * (1.f / D) + LN_EPS);
                float fa[6] = {0.f, 0.f, 0.f, 0.f, 0.f, 0.f};
#pragma unroll
                for (int j = 0; j < 8; ++j) {
                    const int c = j * 256 + lane * 4;
                    v[j] = v[j] * rstd * gq[j] + bq[j];
                    *(f32x4*)(hout + (size_t)t * D + c) = v[j];
                    COMPILER_FENCE();
                    if (more) {
                        u32x2 o; o.x = pack2(v[j][0], v[j][1]); o.y = pack2(v[j][2], v[j][3]);
                        *(u32x2*)(xb + (size_t)t * D + c) = o;
#pragma unroll
                        for (int h = 0; h < 6; ++h) { const f32x4 w = *(const f32x4*)(ldsf + h * D + c); fa[h] += (v[j][0] * w[0] + v[j][1] * w[1]) + (v[j][2] * w[2] + v[j][3] * w[3]); }
                    }
                }
                if (more) {
#pragma unroll
                    for (int h = 0; h < 6; ++h) { const float sm = wave_sum(fa[h]); if (lane == 0) logf_[h * S + t] = log_sigmoid_f(sm + p.in[I_BF][(l + 1) * 6 + h]); }
                }
            }
            PH_BAR(pb + 7);
        }
    }
#undef PH_IN
#undef PH_BAR
}

constexpr int N_PHASES = 1 + DEPTH * 8;
#ifndef EMU
extern "C" void kernel_launch(void* const* d_in, const int* in_sizes, int n_in, void* d_out, int out_size, void* d_ws, size_t ws_size, hipStream_t stream) {
    static int grid = 0;
    if (grid == 0) {
        if (n_in != N_INPUTS || out_size != S * D || ws_size < WS_END) {
            fprintf(stderr, "kernel_launch: unexpected shapes: n_in %d out %d ws %zu (need %zu)\n", n_in, out_size, ws_size, (size_t)WS_END); grid = -1; return; }
        int dev = 0, cus = 0, per_cu = 0;
        if (hipGetDevice(&dev) != hipSuccess || hipDeviceGetAttribute(&cus, hipDeviceAttributeMultiprocessorCount, dev) != hipSuccess) { grid = -1; return; }
        if (hipFuncSetAttribute((const void*)fwd_kernel, hipFuncAttributeMaxDynamicSharedMemorySize, LDS_BYTES) != hipSuccess) { fprintf(stderr, "kernel_launch: hipFuncSetAttribute failed\n"); grid = -1; return; }
        if (hipOccupancyMaxActiveBlocksPerMultiprocessor(&per_cu, (const void*)fwd_kernel, NTHREADS, LDS_BYTES) != hipSuccess || per_cu < 1) {
            fprintf(stderr, "kernel_launch: occupancy query says %d blocks per CU\n", per_cu); (void)hipGetLastError(); grid = -1; return; }
        grid = cus;
    }
    if (grid < 0) return;
    (void)hipMemsetAsync(d_ws, 0, CTL_BYTES, stream);
    Params p{};
    for (int i = 0; i < N_INPUTS; ++i) p.in[i] = (const float*)d_in[i];
    p.out = (float*)d_out; p.ws = (unsigned char*)d_ws;
    for (int i = 0; i < 8; ++i) p.inv_freq[i] = (float)pow(500000.0, -(double)i * 2.0 / 16.0);
#if N_LAUNCH_SPLIT
    for (int k = 0; k < N_PHASES; ++k) { p.lo = k; p.hi = k + 1; hipLaunchKernelGGL(fwd_kernel, dim3(grid), dim3(NTHREADS), LDS_BYTES, stream, p); }
#else
    p.lo = 0; p.hi = N_PHASES;
    hipLaunchKernelGGL(fwd_kernel, dim3(grid), dim3(NTHREADS), LDS_BYTES, stream, p);
#endif
}
#endif
```

```cpp
#ifndef EMU
#include <hip/hip_runtime.h>
#include <cstdio>
#include <cstdint>
#include <cmath>
#endif

#ifndef SEQ
#define SEQ 8192
#endif
#ifndef N_LAUNCH_SPLIT
#define N_LAUNCH_SPLIT 0
#endif
#ifndef REP_PHASE
#define REP_PHASE -2
#endif
#define PH_REPS(c) ((c) == REP_PHASE ? 2 : 1)
#ifndef REP_SUB
#define REP_SUB 0
#endif

constexpr int S = SEQ, D = 2048, DEPTH = 2;
constexpr int FOX_H = 6, FOX_W = 768;
constexpr int LRU_W = 768;
constexpr int DIFF_H = 4, DIFF_W = 512;
constexpr int N_IN = 5382, N_INP = 5376;
constexpr int C_FA = 2304;
constexpr int NEXP = 32, DFF = 512;
constexpr int NKT = S / 64;
#ifndef DCH
#define DCH 32
#endif
constexpr int NCH = (NKT + DCH - 1) / DCH;
constexpr size_t DPART_ROWS = (size_t)NCH * S - (size_t)(DCH * 64) * NCH * (NCH - 1) / 2;
constexpr float ALPHA = 1.41421356237309504880f;
constexpr float LN_EPS = 1e-5f;
constexpr float LOG2E = 1.4426950408889634f;
constexpr float QSCALE_A = 0.08838834764831845f * 1.4426950408889634f;
constexpr float QSCALE_C = 0.125f * 1.4426950408889634f;

enum { I_X = 0, I_POS, I_WIN, I_BF, I_CONVW, I_CONVB, I_WA, I_BA, I_WI, I_BI, I_LAM, I_LQ1, I_LK1, I_LQ2, I_LK2, I_SUBG, I_WO, I_LN1G, I_LN1B,
       I_WGRP, I_BGRP, I_WRT, I_BRT, I_WGATE, I_WUP, I_WDOWN, I_LN2G, I_LN2B, N_INPUTS };

typedef unsigned short bf16_t;
typedef short bf16x8 __attribute__((ext_vector_type(8)));
typedef float f32x4 __attribute__((ext_vector_type(4)));
typedef unsigned u32x4 __attribute__((ext_vector_type(4)));
typedef unsigned u32x2 __attribute__((ext_vector_type(2)));

constexpr size_t al256(size_t x) { return (x + 255) & ~(size_t)255; }
constexpr size_t CTL_BYTES = 65536;
constexpr size_t CTL_CNT_OFF = 32768;
constexpr size_t CTL_WORK_OFF = 36864;
constexpr size_t CTL_QK2_OFF = 57344;
constexpr size_t CTL_CLS_OFF = 49152;
constexpr size_t CTL_DONE_OFF = 40960;
constexpr size_t WB_WIN = CTL_BYTES;
constexpr size_t WB_WO = WB_WIN + al256((size_t)DEPTH * N_INP * D * 2);
constexpr size_t WB_WGU = WB_WO + al256((size_t)DEPTH * D * D * 2);
constexpr size_t WB_WD = WB_WGU + al256((size_t)DEPTH * NEXP * 1024 * D * 2);
constexpr size_t WB_WAI = WB_WD + al256((size_t)DEPTH * NEXP * D * DFF * 2);
constexpr size_t WF_FA = WB_WAI + al256((size_t)DEPTH * 6 * 256 * 128 * 2);
constexpr size_t WF_R36 = WF_FA + al256((size_t)DEPTH * 8 * D * 4);
constexpr size_t WF_ROPE = WF_R36 + al256((size_t)DEPTH * 2 * 48 * D * 2);
constexpr size_t A_XB = WF_ROPE + al256((size_t)S * 16 * 4);
constexpr size_t A_HB = A_XB + al256((size_t)S * D * 2);
constexpr size_t A_LOGF = A_HB + al256((size_t)S * D * 4);
constexpr size_t A_CUM = A_LOGF + al256((size_t)6 * S * 4);
constexpr size_t A_KMAX = A_CUM + al256((size_t)6 * S * 4);
constexpr size_t A_CNTB = A_KMAX + al256((size_t)6 * NKT * 4);
constexpr size_t A_QA = A_CNTB + al256((size_t)1024 * 32 * 4);
constexpr size_t A_KA = A_QA + al256((size_t)FOX_H * S * 128 * 2);
constexpr size_t A_VAT = A_KA + al256((size_t)FOX_H * S * 128 * 2);
constexpr size_t A_XR = A_VAT + al256((size_t)FOX_H * S * 128 * 2);
constexpr size_t A_GR = A_XR + al256((size_t)S * LRU_W * 2);
constexpr size_t A_QC = A_GR + al256((size_t)S * LRU_W * 2);
constexpr size_t A_KC = A_QC + al256((size_t)DIFF_H * S * 128 * 2);
constexpr size_t A_VCT = A_KC + al256((size_t)DIFF_H * S * 128 * 2);
constexpr size_t A_HLOC = A_VCT + al256((size_t)DIFF_H * S * 128 * 2);
constexpr size_t A_PLOC = A_HLOC + al256((size_t)S * LRU_W * 4);
constexpr size_t A_SUMA = A_PLOC + al256((size_t)S * LRU_W * 4);
constexpr size_t A_SUMH = A_SUMA + al256((size_t)NKT * LRU_W * 4);
constexpr size_t A_CONCAT = A_SUMH + al256((size_t)NKT * LRU_W * 4);
constexpr size_t A_Y1 = A_CONCAT + al256((size_t)S * D * 2);
constexpr size_t A_H1 = A_Y1 + al256((size_t)S * D * 4);
constexpr size_t A_H1B = A_H1 + al256((size_t)S * D * 4);
constexpr size_t A_LTOK = A_H1B + al256((size_t)S * D * 2);
constexpr size_t A_LW = A_LTOK + al256((size_t)NEXP * S * 4);
constexpr size_t A_LSLOT = A_LW + al256((size_t)NEXP * S * 4);
constexpr size_t A_ACT = A_LSLOT + al256((size_t)NEXP * S * 4);
constexpr size_t A_CONTRIB = A_ACT + al256((size_t)(2 * S + 256) * DFF * 2);
constexpr size_t WS_END = A_CONTRIB + al256((size_t)2 * S * D * 4);
constexpr size_t A_DPO = A_Y1;
constexpr size_t A_DPML = A_DPO + al256((size_t)8 * DPART_ROWS * 128 * 2);
static_assert(A_DPML + (size_t)8 * DPART_ROWS * 2 * 4 <= A_H1B, "differential partials must fit inside the y1 + h1 region");

constexpr int NTHREADS = 512;
constexpr int LDS_MAIN = 131072 + 4096;
constexpr int LDS_MISC = LDS_MAIN;
constexpr int LDS_BYTES = LDS_MAIN + 8192 + 16640;
constexpr int M_PRE16 = 8192;
constexpr int M_LCNT = 64, M_CTOT = 256, M_COFF = 384, M_PRE = 512, M_RTOK = 2048, M_RW = 3072, M_RSLOT = 4096;

struct Params {
    const float* in[N_INPUTS];
    float* out;
    unsigned char* ws;
    float inv_freq[8];
    int lo, hi;
};

#ifndef EMU
#define LAS __attribute__((address_space(3)))
#define DYN_LDS(name) extern __shared__ __attribute__((aligned(16))) unsigned char name[]
#define SLEEP1() __builtin_amdgcn_s_sleep(1)
#define WAVE_SYNC() __builtin_amdgcn_wave_barrier()
#define OPAQUE(x) asm volatile("" : "+v"(x))
#define COMPILER_FENCE() asm volatile("" ::: "memory")
#define RFL(x) __builtin_amdgcn_readfirstlane(x)
#define RFL_F(x) __builtin_bit_cast(float, __builtin_amdgcn_readfirstlane(__builtin_bit_cast(int, x)))
#define ANY_LANE(p) (__builtin_amdgcn_ballot_w64(p) != 0ull)
#define RDLANE(v, l) __builtin_bit_cast(float, __builtin_amdgcn_readlane(__builtin_bit_cast(int, v), l))
__device__ __forceinline__ int lane_id_volatile() { int l; asm volatile("v_mbcnt_lo_u32_b32 %0, -1, 0\n\tv_mbcnt_hi_u32_b32 %0, -1, %0" : "=v"(l)); return l; }
#define LANE_ID() lane_id_volatile()
#define OPAQUE_S(x) asm volatile("" : "+s"(x))
#define WAIT_VM0() asm volatile("s_waitcnt vmcnt(0)" ::: "memory")
#define WAIT_ALL0() __builtin_amdgcn_s_waitcnt(0)
#define FENCE_REL_AGENT() __builtin_amdgcn_fence(__ATOMIC_RELEASE, "agent")
#define FENCE_ACQ_AGENT() __builtin_amdgcn_fence(__ATOMIC_ACQUIRE, "agent")
#define MFMA16(a, b, c) __builtin_amdgcn_mfma_f32_16x16x32_bf16(a, b, c, 0, 0, 0)
#define GLDS16(g, l) __builtin_amdgcn_global_load_lds((const unsigned*)(g), (unsigned*)(l), 16, 0, 0)
#define WAIT_V(n) asm volatile("s_waitcnt vmcnt(" #n ")" ::: "memory")
#define WAIT_L(n) asm volatile("s_waitcnt lgkmcnt(" #n ")" ::: "memory")
#define BAR() __builtin_amdgcn_s_barrier()
#define SCHED() __builtin_amdgcn_sched_barrier(0)
#define SETPRIO(n) __builtin_amdgcn_s_setprio(n)
#define FAST_EXP2(x) __builtin_amdgcn_exp2f(x)
template <int M> __device__ __forceinline__ float shx_impl(float v, int lane) {
    if (M < 32) return __builtin_bit_cast(float, __builtin_amdgcn_ds_swizzle(__builtin_bit_cast(int, v), (M << 10) | 0x1f));
    return __builtin_bit_cast(float, __builtin_amdgcn_ds_bpermute((lane ^ 32) << 2, __builtin_bit_cast(int, v)));
}
#define SHX(v, M) shx_impl<M>(v, lane)
template <int CTRL> __device__ __forceinline__ float dppx(float x) { return __builtin_bit_cast(float, __builtin_amdgcn_mov_dpp(__builtin_bit_cast(int, x), CTRL, 0xf, 0xf, true)); }
#define DPP_X1(x) dppx<0xB1>(x)
#define DPP_X2(x) dppx<0x4E>(x)
#define DPP_X7(x) dppx<0x141>(x)
#define DPP_X8(x) dppx<0x128>(x)
#define xrow16_max(x) xrow16_max_l(x, lane)
#define xrow16_sum(x) xrow16_sum_l(x, lane)
__device__ __forceinline__ float xrow16_max_l(float x, int lane) { x = fmaxf(x, shx_impl<16>(x, lane)); return fmaxf(x, shx_impl<32>(x, lane)); }
__device__ __forceinline__ float xrow16_sum_l(float x, int lane) { x = x + shx_impl<16>(x, lane); return x + shx_impl<32>(x, lane); }
#define FAST_LOG2(x) __builtin_amdgcn_logf(x)
#define FAST_RCP(x) __builtin_amdgcn_rcpf(x)
__device__ __forceinline__ unsigned xb_ld(unsigned* p)              { return __hip_atomic_load(p, __ATOMIC_RELAXED, __HIP_MEMORY_SCOPE_AGENT); }
__device__ __forceinline__ unsigned xb_add(unsigned* p, unsigned v) { return __hip_atomic_fetch_add(p, v, __ATOMIC_RELAXED, __HIP_MEMORY_SCOPE_AGENT); }
__device__ __forceinline__ unsigned xb_xcc_id() { return (unsigned)__builtin_amdgcn_s_getreg((3 << 11) | 20) & 0xFu; }
__device__ __forceinline__ int atomic_add_int(int* p, int v) { return atomicAdd(p, v); }
__device__ __forceinline__ void atomic_min_int(int* p, int v) { atomicMin(p, v); }
__device__ __forceinline__ void atomic_max_u32(unsigned* p, unsigned v) { atomicMax(p, v); }
__device__ __forceinline__ unsigned pack2(float lo, float hi) { unsigned r; asm volatile("v_cvt_pk_bf16_f32 %0, %1, %2" : "=v"(r) : "v"(lo), "v"(hi)); return r; }
#else
#define MFMA16(a, b, c) emu_mfma_16x16x32_bf16(a, b, c)
#define GLDS16(g, l) emu_glds16((const void*)(g), (void*)(l))
#define WAIT_V(n) ((void)0)
#define WAIT_L(n) ((void)0)
#define BAR() __syncthreads()
#define SCHED() ((void)0)
#define SETPRIO(n) ((void)0)
#define FAST_EXP2(x) exp2f(x)
#define SHX(v, M) __shfl_xor(v, M)
#define DPP_X1(x) __shfl_xor(x, 1)
#define DPP_X2(x) __shfl_xor(x, 2)
#define DPP_X7(x) __shfl_xor(x, 7)
#define DPP_X8(x) __shfl_xor(x, 8)
static inline float xrow16_max(float x) { x = fmaxf(x, __shfl_xor(x, 16)); return fmaxf(x, __shfl_xor(x, 32)); }
static inline float xrow16_sum(float x) { x = x + __shfl_xor(x, 16); return x + __shfl_xor(x, 32); }
#define FAST_LOG2(x) log2f(x)
#define FAST_RCP(x) (1.f / (x))
static inline unsigned pack2(float lo, float hi) {
    unsigned a = __builtin_bit_cast(unsigned, lo), b = __builtin_bit_cast(unsigned, hi);
    a += 0x7fffu + ((a >> 16) & 1u); b += 0x7fffu + ((b >> 16) & 1u);
    return (a >> 16) | (b & 0xffff0000u);
}
#endif
__device__ __forceinline__ bf16_t f2bf(float f) { return (bf16_t)(pack2(f, 0.f) & 0xffffu); }
__device__ __forceinline__ float bf2f(bf16_t h) { return __builtin_bit_cast(float, (unsigned)h << 16); }

#define XB_TMO      128
#define XB_XCNT(j)  (256  + 64 * (j))
#define XB_XSUB(j)  (1280 + 64 * (j))
#define XB_XGEN(j)  (2304 + 64 * (j))
#define XB_TOP      3328
#define XB_TOPGEN   3392
#define XCD_BAR_WORDS 3456
#define XB_SPIN_CAP (1u << 22)
#define XB_SPIN(cond, bar) do { unsigned _sp = 0; while (cond) { SLEEP1(); \
    if ((++_sp & 255u) == 0u) { if (xb_ld(&(bar)[XB_TMO])) break; if (_sp > XB_SPIN_CAP) { xb_add(&(bar)[XB_TMO], 1u); break; } } } } while (0)

struct XcdBarrier { unsigned* bar; unsigned x; volatile LAS unsigned* st; };

__device__ __forceinline__ XcdBarrier xcd_barrier_post(unsigned* bar, volatile LAS unsigned* st) {
    XcdBarrier b; b.bar = bar; b.x = xb_xcc_id(); b.st = st;
    if (threadIdx.x == 0) (void)xb_add(&bar[XB_XCNT(b.x)], 1u);
    return b;
}
__device__ __forceinline__ void xcd_barrier_complete(unsigned* bar, unsigned x, unsigned& nloc, unsigned& nx) {
    const unsigned G = gridDim.x;
    unsigned sum, cnt, mine, sp = 0u;
    for (;;) {
        sum = 0u; cnt = 0u; mine = 0u;
#pragma unroll
        for (unsigned j = 0; j < 16; ++j) { const unsigned c = xb_ld(&bar[XB_XCNT(j)]); sum += c; cnt += (c > 0u) ? 1u : 0u; mine = (j == x) ? c : mine; }
        if (sum == G) break;
        SLEEP1();
        if ((++sp & 255u) == 0u) { if (xb_ld(&bar[XB_TMO])) break; if (sp > XB_SPIN_CAP) { xb_add(&bar[XB_TMO], 1u); break; } }
    }
    nloc = mine > 0u ? mine : 1u; nx = cnt > 0u ? cnt : 1u;
}
__device__ __forceinline__ void xcd_barrier(const XcdBarrier& b, bool leader) {
    WAIT_VM0();
    __syncthreads();
    if (leader) {
        unsigned* bar = b.bar;
        WAIT_ALL0();
        unsigned nloc = b.st[0], nx = b.st[1];
        if (nloc == 0u) { xcd_barrier_complete(bar, b.x, nloc, nx); b.st[0] = nloc; b.st[1] = nx; }
        const unsigned old = xb_add(&bar[XB_XSUB(b.x)], 1u);
        const unsigned gen = old / nloc;
        if (old + 1u == (gen + 1u) * nloc) {
            FENCE_REL_AGENT();
            WAIT_VM0();
            const unsigned og = xb_add(&bar[XB_TOP], 1u);
            const unsigned tg = og / nx;
            if (og + 1u == (tg + 1u) * nx) xb_add(&bar[XB_TOPGEN], 1u);
            else XB_SPIN(xb_ld(&bar[XB_TOPGEN]) == tg, bar);
            FENCE_ACQ_AGENT();
            xb_add(&bar[XB_XGEN(b.x)], 1u);
            WAIT_VM0();
        } else {
            XB_SPIN(xb_ld(&bar[XB_XGEN(b.x)]) == gen, bar);
            FENCE_ACQ_AGENT();
            WAIT_VM0();
        }
    }
    __syncthreads();
}

__device__ __forceinline__ float wave_sum_l(float v, int lane) {
    (void)lane;
    v += DPP_X1(v); v += DPP_X2(v); v += DPP_X7(v); v += DPP_X8(v);
    return xrow16_sum(v);
}
#define wave_sum(v) wave_sum_l(v, lane)
__device__ __forceinline__ float fexp(float x) { return FAST_EXP2(x * LOG2E); }
__device__ __forceinline__ float sigmoid_f(float x) { return FAST_RCP(1.f + fexp(-x)); }
__device__ __forceinline__ float log_sigmoid_f(float x) { return fminf(x, 0.f) - 0.6931471805599453f * FAST_LOG2(1.f + fexp(-fabsf(x))); }
__device__ __forceinline__ float gelu_tanh_f(float x) { const float u = 0.7978845608028654f * (x + 0.044715f * x * x * x); return x * FAST_RCP(1.f + fexp(-2.f * u)); }
__device__ __forceinline__ float silu_f(float x) { return x * FAST_RCP(1.f + fexp(-x)); }
__device__ __forceinline__ float neg_expm1_f(float x) {
    const float ser = -x * (1.f + x * (0.5f + x * (0.16666667f + x * (0.041666668f + x * (0.008333334f + x * 0.0013888889f)))));
    return (x > -0.35f) ? ser : (1.f - fexp(x));
}

struct RmIdent { __device__ __forceinline__ int operator()(int n) const { return n; } };
struct RmWin { __device__ __forceinline__ int operator()(int n) const { return n < C_FA ? n : (n < C_FA + 6 ? -1 : n - 6); } };
struct RmGu { int kind; __device__ __forceinline__ int operator()(int f) const { return (f >> 7) * 256 + ((f >> 6) & 1) * 128 + ((f >> 4) & 3) * 32 + kind * 16 + (f & 15); } };
struct RmOff { int off; __device__ __forceinline__ int operator()(int n) const { return n + off; } };

template <class RM>
__device__ __forceinline__ void convert_tile(const float* src, int ld, int K, int Nsrc, int k0, int n0, bf16_t* dst, const RM& rm, float* T, int tid) {
    {
        const int nn = tid & 255, kh = (tid >> 8) * 32, n = n0 + nn;
        const float* sp = src + (size_t)(k0 + kh) * ld + n;
        float v[32];
#pragma unroll
        for (int i = 0; i < 32; ++i) v[i] = (n < Nsrc) ? sp[(size_t)i * ld] : 0.f;
#pragma unroll
        for (int i = 0; i < 32; ++i) T[(kh + i) * 257 + nn] = v[i];
    }
    __syncthreads();
#pragma unroll
    for (int q = 0; q < 4; ++q) {
        const int nn = q * 64 + (tid >> 3), kc = (tid & 7) * 8, n = n0 + nn;
        const int row = (n < Nsrc) ? rm(n) : -1;
        if (row >= 0) {
            u32x4 o;
            o.x = pack2(T[(kc + 0) * 257 + nn], T[(kc + 1) * 257 + nn]); o.y = pack2(T[(kc + 2) * 257 + nn], T[(kc + 3) * 257 + nn]);
            o.z = pack2(T[(kc + 4) * 257 + nn], T[(kc + 5) * 257 + nn]); o.w = pack2(T[(kc + 6) * 257 + nn], T[(kc + 7) * 257 + nn]);
            *(u32x4*)(dst + (size_t)row * K + k0 + kc) = o;
        }
    }
    __syncthreads();
}
template <class RM>
__device__ __forceinline__ void convert_mats(const float* src, size_t sstride, int nmat, int ld, int K, int Nsrc, bf16_t* dst, size_t dstride, const RM& rm,
                                             float* T, int tid, int bid, int G) {
    const int tk = K / 64, tn = (Nsrc + 255) / 256, per = tk * tn, total = nmat * per;
    for (int t = bid; t < total; t += G) {
        const int mi = t / per, r = t % per;
        convert_tile(src + (size_t)mi * sstride, ld, K, Nsrc, (r / tn) * 64, (r % tn) * 256, dst + (size_t)mi * dstride, rm, T, tid);
    }
}

constexpr int NCONV = DEPTH * 768;
__device__ __forceinline__ void moe_conv_chunk(const Params& p, int cid, bf16_t* WguT_, bf16_t* WdT_, float* T, int tid) {
    const int l = cid / 768, r = cid % 768, kind = r >> 8, t0 = (r & 255) * 8;
    for (int t = t0; t < t0 + 8; ++t) {
        const int mi = t >> 6, rr = t & 63;
        if (kind < 2) {
            const float* src = p.in[kind == 0 ? I_WGATE : I_WUP] + ((size_t)l * NEXP + mi) * D * DFF;
            convert_tile(src, DFF, D, DFF, (rr >> 1) * 64, (rr & 1) * 256, WguT_ + ((size_t)l * NEXP + mi) * 1024 * D, RmGu{kind}, T, tid);
        } else {
            const float* src = p.in[I_WDOWN] + ((size_t)l * NEXP + mi) * DFF * D;
            convert_tile(src, D, DFF, D, (rr >> 3) * 64, (rr & 7) * 256, WdT_ + ((size_t)l * NEXP + mi) * D * DFF, RmIdent{}, T, tid);
        }
    }
}

constexpr int BK = 64, HTB = 128 * 64 * 2;
__device__ __forceinline__ int lds_byte(int r, int c) {
    const int st = (r >> 4) * 2 + (c >> 5), rr = r & 15, cc = c & 31, ob = rr * 64 + cc * 2;
    return st * 1024 + (ob ^ (((ob >> 9) & 1) << 5));
}
__device__ __forceinline__ void stage_rc(int b, int& R, int& C) {
    const int st = b / 1024, sb = b % 1024, swz = sb ^ (((sb >> 9) & 1) << 5);
    R = (st >> 1) * 16 + swz / 64; C = (st & 1) * 32 + (swz % 64) / 2;
}
template <bool GATHER>
__device__ __forceinline__ void gemm_tile(const bf16_t* A, int arow0, const unsigned (&aoff)[2][2], const bf16_t* Bt, int brow0, int K,
                                          unsigned char* shm, f32x4 (&acc)[2][2][4][2], int tid_in) {
    int tid = tid_in; OPAQUE(tid);
    unsigned toff; { int R0, C0; stage_rc(tid * 16, R0, C0); toff = (unsigned)(R0 * K + C0); }
#define SA(b, h) (shm + ((b) * 2 + (h)) * HTB)
#define SB(b, h) (shm + (4 + (b) * 2 + (h)) * HTB)
#define STAGE_B(P, h, kt) do { _Pragma("unroll") for (int _i = 0; _i < 2; ++_i) GLDS16(Bt + ((size_t)(brow0 + (h) * 128 + _i * 64) * K + (size_t)(kt) * BK) + toff, (P) + tid * 16 + _i * 8192); } while (0)
#define STAGE_A(P, h, kt) do { _Pragma("unroll") for (int _i = 0; _i < 2; ++_i) { \
    if (GATHER) GLDS16(A + (size_t)(kt) * BK + aoff[h][_i], (P) + tid * 16 + _i * 8192); \
    else GLDS16(A + ((size_t)(arow0 + (h) * 128 + _i * 64) * K + (size_t)(kt) * BK) + toff, (P) + tid * 16 + _i * 8192); } } while (0)
#define LDA(dst, b, h) _Pragma("unroll") for (int m = 0; m < 4; ++m) _Pragma("unroll") for (int k = 0; k < 2; ++k) \
    dst[m][k] = *reinterpret_cast<const bf16x8*>(SA(b, h) + lds_byte(wr * 64 + m * 16 + fr, k * 32 + fq * 8))
#define LDB(dst, b, h) _Pragma("unroll") for (int n = 0; n < 2; ++n) _Pragma("unroll") for (int k = 0; k < 2; ++k) \
    dst[n][k] = *reinterpret_cast<const bf16x8*>(SB(b, h) + lds_byte(wc * 32 + n * 16 + fr, k * 32 + fq * 8))
#define MMA(ai, bj, At, Bx) do { SETPRIO(1); \
    _Pragma("unroll") for (int m = 0; m < 4; ++m) _Pragma("unroll") for (int n = 0; n < 2; ++n) _Pragma("unroll") for (int k = 0; k < 2; ++k) \
      acc[ai][bj][m][n] = MFMA16(At[m][k], Bx[n][k], acc[ai][bj][m][n]); \
    SETPRIO(0); } while (0)
    int wid = tid >> 6, lane = tid & 63, wr = wid >> 2, wc = wid & 3, fr = lane & 15, fq = lane >> 4;
#pragma unroll
    for (int a = 0; a < 2; ++a)
#pragma unroll
        for (int b = 0; b < 2; ++b)
#pragma unroll
            for (int m = 0; m < 4; ++m)
#pragma unroll
                for (int n = 0; n < 2; ++n) acc[a][b][m][n] = (f32x4){0.f, 0.f, 0.f, 0.f};
    bf16x8 At[4][2], B0[2][2], B1[2][2];
    const int nt = K / BK;
    STAGE_B(SB(0, 0), 0, 0); STAGE_A(SA(0, 0), 0, 0);
    STAGE_B(SB(0, 1), 1, 0); STAGE_A(SA(0, 1), 1, 0);
    if (wr == 1) BAR();
    WAIT_V(4); BAR();
    STAGE_B(SB(1, 0), 0, 1); STAGE_A(SA(1, 0), 0, 1); STAGE_B(SB(1, 1), 1, 1);
    WAIT_V(6); BAR();
    for (int t = 0; t < nt - 2; t += 2) {
        LDB(B0, 0, 0); SCHED(); LDA(At, 0, 0); STAGE_A(SA(1, 1), 1, t + 1);
        WAIT_L(8); BAR(); WAIT_L(0); MMA(0, 0, At, B0); BAR(); SCHED();
        LDB(B1, 0, 1); STAGE_B(SB(0, 0), 0, t + 2);
        BAR(); WAIT_L(0); MMA(0, 1, At, B1); BAR();
        LDA(At, 0, 1); STAGE_A(SA(0, 0), 0, t + 2);
        BAR(); WAIT_L(0); MMA(1, 0, At, B0); BAR(); SCHED();
        STAGE_B(SB(0, 1), 1, t + 2);
        WAIT_V(6); BAR(); MMA(1, 1, At, B1); BAR();
        LDB(B0, 1, 0); SCHED(); LDA(At, 1, 0); STAGE_A(SA(0, 1), 1, t + 2);
        WAIT_L(8); BAR(); WAIT_L(0); MMA(0, 0, At, B0); BAR(); SCHED();
        LDB(B1, 1, 1); STAGE_B(SB(1, 0), 0, t + 3);
        BAR(); WAIT_L(0); MMA(0, 1, At, B1); BAR();
        LDA(At, 1, 1); STAGE_A(SA(1, 0), 0, t + 3);
        BAR(); WAIT_L(0); MMA(1, 0, At, B0); BAR(); SCHED();
        STAGE_B(SB(1, 1), 1, t + 3);
        WAIT_V(6); BAR(); MMA(1, 1, At, B1); BAR();
    }
    OPAQUE(tid); wid = tid >> 6; lane = tid & 63; wr = wid >> 2; wc = wid & 3; fr = lane & 15; fq = lane >> 4;
    { LDB(B0, 0, 0); WAIT_V(0); LDA(At, 0, 0); STAGE_A(SA(1, 1), 1, nt - 1);
      BAR(); WAIT_L(0); MMA(0, 0, At, B0); BAR();
      LDB(B1, 0, 1); BAR(); WAIT_L(0); MMA(0, 1, At, B1); BAR();
      LDA(At, 0, 1); WAIT_V(4); BAR(); WAIT_L(0); MMA(1, 0, At, B0); MMA(1, 1, At, B1); BAR(); }
    { LDB(B0, 1, 0); LDA(At, 1, 0); WAIT_V(2); BAR(); WAIT_L(0); MMA(0, 0, At, B0); BAR();
      LDB(B1, 1, 1); WAIT_V(0); BAR(); WAIT_L(0); MMA(0, 1, At, B1); BAR();
      LDA(At, 1, 1); BAR(); WAIT_L(0); MMA(1, 0, At, B0); MMA(1, 1, At, B1); BAR(); }
    if (wr == 0) BAR();
#undef SA
#undef SB
#undef STAGE_A
#undef STAGE_B
#undef LDA
#undef LDB
#undef MMA
}
__device__ __forceinline__ void stage_geom(int tid, int (&R)[2], int (&C)[2]) {
#pragma unroll
    for (int i = 0; i < 2; ++i) stage_rc(tid * 16 + i * 8192, R[i], C[i]);
}

constexpr int ATT_KBUF = 0, ATT_VBUF = 32768, ATT_CBUF = 65536;
template <int KIND>
__device__ __forceinline__ void attn_unit(const bf16_t* Q, const bf16_t* Kg, const bf16_t* VT, const float* cum2, const float* kmx, int qb, bf16_t* concat, int ccol0,
                                          float lam, float osc, const float* subg, unsigned char* lds, int tid) {
    const int lane = tid & 63, wave = tid >> 6, r16 = lane & 15, q4 = lane >> 4;
    const int q0w = qb * 128 + wave * 16, myq = q0w + r16;
    const int ntiles = 2 * qb + 2;
    const int wlimit = (KIND == 0) ? ((q0w + 15) >> 6) : (q0w >> 6);
    constexpr int NMAP = (KIND == 0) ? 1 : 2, NKS = (KIND == 0) ? 4 : 2;
    bf16x8 qf[NMAP][NKS];
#pragma unroll
    for (int mp = 0; mp < NMAP; ++mp)
#pragma unroll
        for (int ks = 0; ks < NKS; ++ks) qf[mp][ks] = *(const bf16x8*)(Q + (size_t)myq * 128 + mp * 64 + ks * 32 + q4 * 8);
    const float cq = (KIND == 0) ? cum2[myq] : 0.f;
    int kt0 = 0;
    if (KIND == 0) {
        float* wmax = (float*)(lds + ATT_CBUF + 512); int* kst = (int*)(lds + ATT_CBUF + 576);
        float qs = 0.f;
#pragma unroll
        for (int ks = 0; ks < NKS; ++ks)
#pragma unroll
            for (int j = 0; j < 8; ++j) { const float v = bf2f((bf16_t)qf[0][ks][j]); qs += v * v; }
        qs = xrow16_sum(qs);
        qs = fmaxf(qs, SHX(qs, 1)); qs = fmaxf(qs, SHX(qs, 2)); qs = fmaxf(qs, SHX(qs, 4)); qs = fmaxf(qs, SHX(qs, 8));
        if (lane == 0) wmax[wave] = qs;
        if (tid == 0) *kst = 2 * qb;
        __syncthreads();
        float qm = wmax[0];
#pragma unroll
        for (int w = 1; w < 8; ++w) qm = fmaxf(qm, wmax[w]);
        qm = sqrtf(qm) * 1.01f;
        const float kd = sqrtf(fmaxf(kmx[2 * qb], kmx[2 * qb + 1])) * 1.01f;
        if (tid < 2 * qb) {
            const float bias = cum2[qb * 128] - cum2[tid * 64 + 63];
            const bool skip = bias + qm * (sqrtf(kmx[tid]) * 1.01f + kd) < -40.f;
            if (!skip) atomic_min_int(kst, tid);
        }
        __syncthreads();
        kt0 = RFL(*kst);
    }
    f32x4 ot[NMAP][8];
    float mrun[NMAP], lsum[NMAP];
#pragma unroll
    for (int mp = 0; mp < NMAP; ++mp) { mrun[mp] = -INFINITY; lsum[mp] = 0.f;
#pragma unroll
        for (int mo = 0; mo < 8; ++mo) ot[mp][mo] = (f32x4){0.f, 0.f, 0.f, 0.f}; }
    u32x4 sk[2], sv[2]; float sc = 0.f;
    const u32x4* kg = (const u32x4*)Kg; const u32x4* vg = (const u32x4*)VT;
#pragma unroll
    for (int i = 0; i < 2; ++i) { sk[i] = kg[(size_t)kt0 * 1024 + tid + i * 512]; sv[i] = vg[(size_t)kt0 * 1024 + tid + i * 512]; }
    if (KIND == 0 && tid < 64) sc = cum2[kt0 * 64 + tid];
    for (int kt = kt0; kt < ntiles; ++kt) {
        unsigned char* kb = lds + ATT_KBUF + (kt & 1) * 16384;
        unsigned char* vb = lds + ATT_VBUF + (kt & 1) * 16384;
        float* cb = (float*)(lds + ATT_CBUF + (kt & 1) * 256);
#pragma unroll
        for (int i = 0; i < 2; ++i) {
            const int g = tid + i * 512;
            { const int row = g >> 4, c = g & 15; *(u32x4*)(kb + row * 256 + ((c ^ (row & 15)) << 4)) = sk[i]; }
            { const int d = g >> 3, c = g & 7; *(u32x4*)(vb + d * 128 + ((c ^ ((d >> 1) & 7)) << 4)) = sv[i]; }
        }
        if (KIND == 0 && tid < 64) cb[tid] = sc;
        __syncthreads();
        if (kt + 1 < ntiles) {
#pragma unroll
            for (int i = 0; i < 2; ++i) { sk[i] = kg[(size_t)(kt + 1) * 1024 + tid + i * 512]; sv[i] = vg[(size_t)(kt + 1) * 1024 + tid + i * 512]; }
            if (KIND == 0 && tid < 64) sc = cum2[(kt + 1) * 64 + tid];
        }
        if (kt <= wlimit) {
#pragma unroll
            for (int mp = 0; mp < NMAP; ++mp) {
                bf16x8 kf[4][NKS], vfa[8];
#pragma unroll
                for (int m = 0; m < 4; ++m)
#pragma unroll
                    for (int ks = 0; ks < NKS; ++ks) { const int c = (KIND == 0 ? 0 : mp * 8) + ks * 4 + q4; kf[m][ks] = *(const bf16x8*)(kb + (m * 16 + r16) * 256 + ((c ^ r16) << 4)); }
#pragma unroll
                for (int mo = 0; mo < 8; ++mo) { const int d = mo * 16 + r16; vfa[mo] = *(const bf16x8*)(vb + d * 128 + (((0 * 4 + q4) ^ ((d >> 1) & 7)) << 4)); }
                SCHED();
                f32x4 st[4];
#pragma unroll
                for (int m = 0; m < 4; ++m) st[m] = (f32x4){0.f, 0.f, 0.f, 0.f};
#pragma unroll
                for (int ks = 0; ks < NKS; ++ks)
#pragma unroll
                    for (int m = 0; m < 4; ++m) st[m] = MFMA16(kf[m][ks], qf[mp][ks], st[m]);
                SCHED();
                float mx = -INFINITY;
#pragma unroll
                for (int m = 0; m < 4; ++m) {
                    if (KIND == 0) {
                        const f32x4 ck = *(const f32x4*)(cb + m * 16 + 4 * q4);
#pragma unroll
                        for (int j = 0; j < 4; ++j) {
                            float y = st[m][j] + (cq - ck[j]);
                            if (kt * 64 + m * 16 + 4 * q4 + j > myq) y = -INFINITY;
                            st[m][j] = y;
                        }
                    }
#pragma unroll
                    for (int j = 0; j < 4; ++j) mx = fmaxf(mx, st[m][j]);
                }
                mx = xrow16_max(mx);
                const float mnew = fmaxf(mrun[mp], mx);
                const float alpha = FAST_EXP2(mrun[mp] - mnew);
                mrun[mp] = mnew;
                float ps = 0.f;
#pragma unroll
                for (int m = 0; m < 4; ++m)
#pragma unroll
                    for (int j = 0; j < 4; ++j) { const float pv = FAST_EXP2(st[m][j] - mnew); st[m][j] = pv; ps += pv; }
                lsum[mp] = lsum[mp] * alpha + ps;
#pragma unroll
                for (int mo = 0; mo < 8; ++mo) ot[mp][mo] *= alpha;
                bf16x8 pf[2];
#pragma unroll
                for (int kk = 0; kk < 2; ++kk) {
                    u32x4 pw;
                    pw.x = pack2(st[2 * kk][0], st[2 * kk][1]); pw.y = pack2(st[2 * kk][2], st[2 * kk][3]);
                    pw.z = pack2(st[2 * kk + 1][0], st[2 * kk + 1][1]); pw.w = pack2(st[2 * kk + 1][2], st[2 * kk + 1][3]);
                    pf[kk] = __builtin_bit_cast(bf16x8, pw);
                }
                bf16x8 vfb[8];
#pragma unroll
                for (int mo = 0; mo < 8; ++mo) { const int d = mo * 16 + r16; vfb[mo] = *(const bf16x8*)(vb + d * 128 + (((1 * 4 + q4) ^ ((d >> 1) & 7)) << 4)); }
                SCHED();
#pragma unroll
                for (int mo = 0; mo < 8; ++mo) ot[mp][mo] = MFMA16(vfa[mo], pf[0], ot[mp][mo]);
                SCHED();
#pragma unroll
                for (int mo = 0; mo < 8; ++mo) ot[mp][mo] = MFMA16(vfb[mo], pf[1], ot[mp][mo]);
            }
        }
    }
    float inv[NMAP];
#pragma unroll
    for (int mp = 0; mp < NMAP; ++mp) { float l = lsum[mp]; l = xrow16_sum(l); inv[mp] = 1.f / l; }
    if (KIND == 0) {
#pragma unroll
        for (int mo = 0; mo < 8; ++mo) {
            u32x2 o; o.x = pack2(ot[0][mo][0] * inv[0], ot[0][mo][1] * inv[0]); o.y = pack2(ot[0][mo][2] * inv[0], ot[0][mo][3] * inv[0]);
            *(u32x2*)(concat + (size_t)myq * D + ccol0 + mo * 16 + 4 * q4) = o;
        }
    } else {
        float ss = 0.f;
#pragma unroll
        for (int mo = 0; mo < 8; ++mo)
#pragma unroll
            for (int j = 0; j < 4; ++j) { const float v = ot[0][mo][j] * inv[0] - lam * (ot[NMAP - 1][mo][j] * inv[NMAP - 1]); ot[0][mo][j] = v; ss += v * v; }
        ss = xrow16_sum(ss);
        const float rs = osc / sqrtf(ss * (1.f / 128.f) + LN_EPS);
#pragma unroll
        for (int mo = 0; mo < 8; ++mo) {
            const f32x4 g = *(const f32x4*)(subg + mo * 16 + 4 * q4);
            u32x2 o; o.x = pack2(ot[0][mo][0] * rs * g[0], ot[0][mo][1] * rs * g[1]); o.y = pack2(ot[0][mo][2] * rs * g[2], ot[0][mo][3] * rs * g[3]);
            *(u32x2*)(concat + (size_t)myq * D + ccol0 + mo * 16 + 4 * q4) = o;
        }
    }
    __syncthreads();
}

__device__ __forceinline__ int dpart_row(int c, int q) { return c * (S - DCH * 64) - (DCH * 32) * c * (c - 1) + q; }
__device__ __forceinline__ void attn_dmap_unit(const bf16_t* Qh, const bf16_t* Kh, const bf16_t* VTh, int mp, int qb, int t0, int t1,
                                               bf16_t* Op, float* ML, int c, float bnd, unsigned char* lds, int tid) {
    const bool fixedref = (bnd <= 60.f);
    const int lane = tid & 63, wave = tid >> 6, r16 = lane & 15, q4 = lane >> 4;
    const int q0w = qb * 256 + wave * 32;
    const int wlimit = q0w >> 6;
    bf16x8 qf[2][2];
#pragma unroll
    for (int n = 0; n < 2; ++n)
#pragma unroll
        for (int ks = 0; ks < 2; ++ks) qf[n][ks] = *(const bf16x8*)(Qh + (size_t)(q0w + n * 16 + r16) * 128 + mp * 64 + ks * 32 + q4 * 8);
    f32x4 ot[8][2];
    float mrun[2] = {-INFINITY, -INFINITY}, lsum[2] = {0.f, 0.f};
    if (fixedref) { mrun[0] = bnd; mrun[1] = bnd; }
    const float stinit = fixedref ? -bnd : 0.f;
#pragma unroll
    for (int mo = 0; mo < 8; ++mo) { ot[mo][0] = (f32x4){0.f, 0.f, 0.f, 0.f}; ot[mo][1] = (f32x4){0.f, 0.f, 0.f, 0.f}; }
    u32x4 sk, sv[2];
    const u32x4* kg = (const u32x4*)Kh; const u32x4* vg = (const u32x4*)VTh;
    const int krow = tid >> 3, kc8 = tid & 7;
    sk = kg[(size_t)t0 * 1024 + krow * 16 + mp * 8 + kc8];
#pragma unroll
    for (int i = 0; i < 2; ++i) sv[i] = vg[(size_t)t0 * 1024 + tid + i * 512];
    for (int kt = t0; kt < t1; ++kt) {
        unsigned char* kb = lds + (kt & 1) * 8192;
        unsigned char* vb = lds + 16384 + (kt & 1) * 16384;
        *(u32x4*)(kb + krow * 128 + ((kc8 ^ ((krow >> 1) & 7)) << 4)) = sk;
#pragma unroll
        for (int i = 0; i < 2; ++i) { const int g = tid + i * 512, d = g >> 3, cc = g & 7; *(u32x4*)(vb + d * 128 + ((cc ^ ((d >> 1) & 7)) << 4)) = sv[i]; }
        __syncthreads();
        if (kt + 1 < t1) {
            sk = kg[(size_t)(kt + 1) * 1024 + krow * 16 + mp * 8 + kc8];
#pragma unroll
            for (int i = 0; i < 2; ++i) sv[i] = vg[(size_t)(kt + 1) * 1024 + tid + i * 512];
        }
        if (kt <= wlimit) {
            bf16x8 kf[4][2], vfa[8];
#pragma unroll
            for (int m = 0; m < 4; ++m)
#pragma unroll
                for (int ks = 0; ks < 2; ++ks) kf[m][ks] = *(const bf16x8*)(kb + (m * 16 + r16) * 128 + (((ks * 4 + q4) ^ ((r16 >> 1) & 7)) << 4));
#pragma unroll
            for (int mo = 0; mo < 8; ++mo) { const int d = mo * 16 + r16; vfa[mo] = *(const bf16x8*)(vb + d * 128 + (((0 * 4 + q4) ^ ((d >> 1) & 7)) << 4)); }
            SCHED();
            f32x4 st[4][2];
#pragma unroll
            for (int m = 0; m < 4; ++m) { st[m][0] = (f32x4){stinit, stinit, stinit, stinit}; st[m][1] = (f32x4){stinit, stinit, stinit, stinit}; }
            SETPRIO(1);
#pragma unroll
            for (int ks = 0; ks < 2; ++ks)
#pragma unroll
                for (int m = 0; m < 4; ++m) { st[m][0] = MFMA16(kf[m][ks], qf[0][ks], st[m][0]); st[m][1] = MFMA16(kf[m][ks], qf[1][ks], st[m][1]); }
            SETPRIO(0);
            SCHED();
            float alpha[2] = {1.f, 1.f};
            if (fixedref) {
#pragma unroll
                for (int n = 0; n < 2; ++n) {
                    float ps = 0.f;
#pragma unroll
                    for (int m = 0; m < 4; ++m)
#pragma unroll
                        for (int j = 0; j < 4; ++j) { const float pv = FAST_EXP2(st[m][n][j]); st[m][n][j] = pv; ps += pv; }
                    lsum[n] += ps;
                }
            } else
#pragma unroll
            for (int n = 0; n < 2; ++n) {
                float mx = -INFINITY;
#pragma unroll
                for (int m = 0; m < 4; ++m)
#pragma unroll
                    for (int j = 0; j < 4; ++j) mx = fmaxf(mx, st[m][n][j]);
                mx = xrow16_max(mx);
                const float mnew = fmaxf(mrun[n], mx);
                alpha[n] = FAST_EXP2(mrun[n] - mnew);
                mrun[n] = mnew;
                float ps = 0.f;
#pragma unroll
                for (int m = 0; m < 4; ++m)
#pragma unroll
                    for (int j = 0; j < 4; ++j) { const float pv = FAST_EXP2(st[m][n][j] - mnew); st[m][n][j] = pv; ps += pv; }
                lsum[n] = lsum[n] * alpha[n] + ps;
            }
            if (ANY_LANE(alpha[0] != 1.f)) {
#pragma unroll
                for (int mo = 0; mo < 8; ++mo) ot[mo][0] *= alpha[0];
            }
            if (ANY_LANE(alpha[1] != 1.f)) {
#pragma unroll
                for (int mo = 0; mo < 8; ++mo) ot[mo][1] *= alpha[1];
            }
            bf16x8 pf[2][2];
#pragma unroll
            for (int kk = 0; kk < 2; ++kk)
#pragma unroll
                for (int n = 0; n < 2; ++n) {
                    u32x4 pw;
                    pw.x = pack2(st[2 * kk][n][0], st[2 * kk][n][1]); pw.y = pack2(st[2 * kk][n][2], st[2 * kk][n][3]);
                    pw.z = pack2(st[2 * kk + 1][n][0], st[2 * kk + 1][n][1]); pw.w = pack2(st[2 * kk + 1][n][2], st[2 * kk + 1][n][3]);
                    pf[kk][n] = __builtin_bit_cast(bf16x8, pw);
                }
            bf16x8 vfb[8];
#pragma unroll
            for (int mo = 0; mo < 8; ++mo) { const int d = mo * 16 + r16; vfb[mo] = *(const bf16x8*)(vb + d * 128 + (((1 * 4 + q4) ^ ((d >> 1) & 7)) << 4)); }
            SCHED();
            SETPRIO(1);
#pragma unroll
            for (int mo = 0; mo < 8; ++mo) { ot[mo][0] = MFMA16(vfa[mo], pf[0][0], ot[mo][0]); ot[mo][1] = MFMA16(vfa[mo], pf[0][1], ot[mo][1]); }
            SCHED();
#pragma unroll
            for (int mo = 0; mo < 8; ++mo) { ot[mo][0] = MFMA16(vfb[mo], pf[1][0], ot[mo][0]); ot[mo][1] = MFMA16(vfb[mo], pf[1][1], ot[mo][1]); }
            SETPRIO(0);
        }
    }
    if (q0w >= DCH * 64 * c)
#pragma unroll
    for (int n = 0; n < 2; ++n) {
        float l = lsum[n]; l = xrow16_sum(l);
        const int row = dpart_row(c, q0w + n * 16 + r16);
#pragma unroll
        for (int mo = 0; mo < 8; ++mo) {
            u32x2 o; o.x = pack2(ot[mo][n][0], ot[mo][n][1]); o.y = pack2(ot[mo][n][2], ot[mo][n][3]);
            *(u32x2*)(Op + (size_t)(row * 128 + mo * 16 + 4 * q4)) = o;
        }
        if (q4 == 0) { ML[row * 2] = mrun[n]; ML[row * 2 + 1] = l; }
    }
    __syncthreads();
}

__device__ __forceinline__ void lru_unit_a(int chunk, int grp, int l, const Params& p, const bf16_t* Xr, const bf16_t* WaiT, float* hloc, float* ploc, float* sumA, float* sumH,
                                           unsigned char* lds, int tid) {
    const int lane = tid & 63, wave = tid >> 6, r16 = lane & 15, q4 = lane >> 4;
    unsigned char* XCB = lds; float* XU = (float*)(lds + 16384); float* LA = (float*)(lds + 49152); float* ENDS = (float*)(lds + 81920);
    const int t0 = chunk * 64, ch0 = grp * 128;
    bf16x8 bfr[2][4];
#pragma unroll
    for (int g = 0; g < 2; ++g)
#pragma unroll
        for (int ks = 0; ks < 4; ++ks) bfr[g][ks] = *(const bf16x8*)(WaiT + ((size_t)grp * 256 + g * 128 + wave * 16 + r16) * 128 + ks * 32 + q4 * 8);
    const int chg = ch0 + wave * 16 + r16;
    const float ba = p.in[I_BA][(size_t)l * LRU_W + chg], bi = p.in[I_BI][(size_t)l * LRU_W + chg];
    const float lam_raw = p.in[I_LAM][(size_t)l * LRU_W + chg];
    {
        const int c = tid & 127, tq = tid >> 7, ch = ch0 + c;
        const float* cw = p.in[I_CONVW] + (size_t)l * 4 * LRU_W + ch; const float cb = p.in[I_CONVB][(size_t)l * LRU_W + ch];
        const float w0 = cw[0], w1 = cw[LRU_W], w2 = cw[2 * LRU_W], w3 = cw[3 * LRU_W];
        const int ts = t0 + tq * 16;
        float x0 = (ts - 3 >= 0) ? bf2f(Xr[(size_t)(ts - 3) * LRU_W + ch]) : 0.f;
        float x1 = (ts - 2 >= 0) ? bf2f(Xr[(size_t)(ts - 2) * LRU_W + ch]) : 0.f;
        float x2 = (ts - 1 >= 0) ? bf2f(Xr[(size_t)(ts - 1) * LRU_W + ch]) : 0.f;
#pragma unroll
        for (int i = 0; i < 16; ++i) {
            const float x3 = bf2f(Xr[(size_t)(ts + i) * LRU_W + ch]);
            const float v = cb + w0 * x0 + w1 * x1 + w2 * x2 + w3 * x3;
            const int row = tq * 16 + i;
            XU[row * 128 + c] = v;
            *(bf16_t*)(XCB + row * 256 + (((c >> 3) ^ (row & 15)) << 4) + (c & 7) * 2) = f2bf(v);
            x0 = x1; x1 = x2; x2 = x3;
        }
    }
    __syncthreads();
    {
        const float lsl = 8.0f * log_sigmoid_f(lam_raw);
#pragma unroll
        for (int mt = 0; mt < 4; ++mt) {
            f32x4 ga = (f32x4){0.f, 0.f, 0.f, 0.f}, gi = (f32x4){0.f, 0.f, 0.f, 0.f};
#pragma unroll
            for (int ks = 0; ks < 4; ++ks) {
                const bf16x8 af = *(const bf16x8*)(XCB + (mt * 16 + r16) * 256 + (((ks * 4 + q4) ^ r16) << 4));
                ga = MFMA16(af, bfr[0][ks], ga); gi = MFMA16(af, bfr[1][ks], gi);
            }
#pragma unroll
            for (int j = 0; j < 4; ++j) {
                const int row = mt * 16 + 4 * q4 + j, idx = row * 128 + wave * 16 + r16;
                const float r = sigmoid_f(ga[j] + ba), ig = sigmoid_f(gi[j] + bi);
                const float log_a = lsl * r;
                LA[idx] = fexp(log_a);
                XU[idx] = sqrtf(neg_expm1_f(2.f * log_a)) * (ig * XU[idx]);
            }
        }
    }
    __syncthreads();
    {
        const int c = tid & 127, tq = tid >> 7, ch = ch0 + c;
        float h = 0.f, P = 1.f;
#pragma unroll
        for (int i = 0; i < 16; ++i) { const int idx = (tq * 16 + i) * 128 + c; const float a = LA[idx]; h = a * h + XU[idx]; P *= a; XU[idx] = h; LA[idx] = P; }
        ENDS[tq * 128 + c] = P; ENDS[512 + tq * 128 + c] = h;
        __syncthreads();
        float cin = 0.f, pin = 1.f;
        for (int s = 0; s < tq; ++s) { const float Ps = ENDS[s * 128 + c], hs = ENDS[512 + s * 128 + c]; cin = Ps * cin + hs; pin *= Ps; }
#pragma unroll
        for (int i = 0; i < 16; ++i) {
            const int idx = (tq * 16 + i) * 128 + c; const size_t gi = (size_t)(t0 + tq * 16 + i) * LRU_W + ch;
            const float Pl = LA[idx], hl = XU[idx];
            ((unsigned*)hloc)[gi] = pack2(hl + Pl * cin, Pl * pin);
        }
        if (tq == 3) { const float Pl = LA[63 * 128 + c], hl = XU[63 * 128 + c]; sumA[(size_t)chunk * LRU_W + ch] = Pl * pin; sumH[(size_t)chunk * LRU_W + ch] = hl + Pl * cin; }
    }
    __syncthreads();
}

__device__ __forceinline__ void moe_prefix(const int* cntb_, int G, unsigned char* lds, int tid) {
    int* tmp = (int*)lds; int* ctot = (int*)(lds + LDS_MISC + M_CTOT); int* coff = (int*)(lds + LDS_MISC + M_COFF);
    unsigned short* pre16 = (unsigned short*)(lds + LDS_MISC + M_PRE16);
    const int e = tid & 31, part = tid >> 5, PB = (G + 15) / 16;
    int sm = 0;
    for (int i = 0; i < PB; ++i) { const int b = part * PB + i; if (b < G) sm += cntb_[b * 32 + e]; }
    tmp[part * 32 + e] = sm;
    __syncthreads();
    int run = 0;
    for (int q = 0; q < part; ++q) run += tmp[q * 32 + e];
    for (int i = 0; i < PB; ++i) { const int b = part * PB + i; if (b < G) { pre16[e * 257 + b] = (unsigned short)run; run += cntb_[b * 32 + e]; } }
    if (part == 15) { ctot[e] = run; pre16[e * 257 + G] = (unsigned short)run; }
    __syncthreads();
    if (tid == 0) { int o = 0; for (int q = 0; q < 32; ++q) { coff[q] = o; o += ctot[q]; } coff[32] = o; }
    __syncthreads();
}
__device__ __forceinline__ void moe_rowtable(const int* ltok_, const float* lw_, const int* lslot_, int e, int m0, int c_e, int G, int segcap, unsigned char* lds, int tid_in) {
    int tid = tid_in; OPAQUE(tid);
    const unsigned short* pre = (const unsigned short*)(lds + LDS_MISC + M_PRE16) + e * 257;
    int* rtok = (int*)(lds + LDS_MISC + M_RTOK); float* rw = (float*)(lds + LDS_MISC + M_RW); int* rslot = (int*)(lds + LDS_MISC + M_RSLOT);
    if (tid < 256) {
        const int g = m0 + tid;
        int tk = 0, sl = 0; float w = 0.f;
        if (g < c_e) {
            int lo = 0, hi = G;
            while (hi - lo > 1) { const int mid = (lo + hi) >> 1; if ((int)pre[mid] <= g) lo = mid; else hi = mid; }
            const int idx = (e * G + lo) * segcap + (g - (int)pre[lo]);
            tk = ltok_[idx]; w = lw_[idx]; sl = lslot_[idx];
        }
        rtok[tid] = tk; rw[tid] = w; rslot[tid] = sl;
    }
    __syncthreads();
}
#define kmax2 ((float*)(wsl + A_KMAX))
#define dpo ((bf16_t*)(wsl + A_DPO))
#define dpml ((float*)(wsl + A_DPML))
#define cntb ((int*)(wsl + A_CNTB))
#define WinT ((bf16_t*)(wsl + WB_WIN))
#define WoT ((bf16_t*)(wsl + WB_WO))
#define WguT ((bf16_t*)(wsl + WB_WGU))
#define WdT ((bf16_t*)(wsl + WB_WD))
#define WaiT ((bf16_t*)(wsl + WB_WAI))
#define Wfa ((float*)(wsl + WF_FA))
#define W36b ((bf16_t*)(wsl + WF_R36))
#define ropecs ((float*)(wsl + WF_ROPE))
#define xb ((bf16_t*)(wsl + A_XB))
#define hb ((float*)(wsl + A_HB))
#define logf_ ((float*)(wsl + A_LOGF))
#define cum2 ((float*)(wsl + A_CUM))
#define Qa ((bf16_t*)(wsl + A_QA))
#define Ka ((bf16_t*)(wsl + A_KA))
#define VaT ((bf16_t*)(wsl + A_VAT))
#define Xr ((bf16_t*)(wsl + A_XR))
#define Gr ((bf16_t*)(wsl + A_GR))
#define Qc ((bf16_t*)(wsl + A_QC))
#define Kc ((bf16_t*)(wsl + A_KC))
#define VcT ((bf16_t*)(wsl + A_VCT))
#define hloc ((float*)(wsl + A_HLOC))
#define ploc ((float*)(wsl + A_PLOC))
#define sumA ((float*)(wsl + A_SUMA))
#define sumH ((float*)(wsl + A_SUMH))
#define concat ((bf16_t*)(wsl + A_CONCAT))
#define y1 ((float*)(wsl + A_Y1))
#define h1 ((float*)(wsl + A_H1))
#define lnstat ((float*)(wsl + A_H1 + (size_t)32 * 1024 * 1024))
#define h1b ((bf16_t*)(wsl + A_H1B))
#define ltok ((int*)(wsl + A_LTOK))
#define lw ((float*)(wsl + A_LW))
#define lslot ((int*)(wsl + A_LSLOT))
#define act ((bf16_t*)(wsl + A_ACT))
#define contrib ((bf16_t*)(wsl + A_CONTRIB))
#ifndef EMU
__global__ void __launch_bounds__(NTHREADS, 2)
#else
void
#endif
fwd_kernel(Params p) {
    DYN_LDS(lds_raw);
    float* ldsf = (float*)lds_raw;
    const int bid = blockIdx.x, G = gridDim.x;
    const int gthreads = G * NTHREADS, gwaves = G * (NTHREADS / 64);
    const int wave_s = RFL((int)threadIdx.x >> 6);
#define PHASE_IDS() unsigned char* wsl = ws; OPAQUE_S(wsl); int tid = wave_s * 64 + LANE_ID(); OPAQUE(tid); const int lane = tid & 63, wave = tid >> 6, gtid = bid * NTHREADS + tid, gwave = bid * (NTHREADS / 64) + wave; (void)lane; (void)wave; (void)gtid; (void)gwave

    unsigned char* ws = p.ws;
    volatile LAS unsigned* bst = (volatile LAS unsigned*)(lds_raw + LDS_MISC);
    unsigned* ubox = (unsigned*)(lds_raw + LDS_MISC + 16);
    if (threadIdx.x == 0) { bst[0] = 0u; bst[1] = 0u; bst[2] = 0u; bst[3] = 0u; }
    __syncthreads();
    XcdBarrier bar = xcd_barrier_post((unsigned*)ws, bst);

    const int* positions = (const int*)p.in[I_POS];

    constexpr int NPH = 8;
    const int lo = p.lo, hi = p.hi;
#ifdef ONLY_PHASE
#define PH_SEL(c) ((c) == ONLY_PHASE)
#else
#define PH_SEL(c) 1
#endif
#define PH_IN(k) (lo <= (k) && (k) < hi)
#define PH_BAR(k) do { if ((k) + 1 < hi) xcd_barrier(bar, wave_s == 0 && LANE_ID() == 0); } while (0)

    if (PH_SEL(-1) && PH_IN(0)) for (int rep = 0; rep < PH_REPS(-1); ++rep) {
        PHASE_IDS();
        for (int l = 0; l < DEPTH; ++l) {
            convert_mats(p.in[I_WIN] + (size_t)l * D * N_IN, 0, 1, N_IN, D, N_IN, WinT + (size_t)l * N_INP * D, 0, RmWin{}, ldsf, tid, bid, G);
            convert_mats(p.in[I_WO] + (size_t)l * D * D, 0, 1, D, D, D, WoT + (size_t)l * D * D, 0, RmIdent{}, ldsf, tid, bid, G);
            convert_mats(p.in[I_WA] + (size_t)l * 6 * 128 * 128, (size_t)128 * 128, 6, 128, 128, 128, WaiT + (size_t)l * 6 * 256 * 128, (size_t)256 * 128, RmIdent{}, ldsf, tid, bid, G);
            convert_mats(p.in[I_WI] + (size_t)l * 6 * 128 * 128, (size_t)128 * 128, 6, 128, 128, 128, WaiT + (size_t)l * 6 * 256 * 128, (size_t)256 * 128, RmOff{128}, ldsf, tid, bid, G);
        }
        for (int i = gtid; i < DEPTH * 8 * D; i += gthreads) { const int k = i % D, h = (i / D) % 8, l = i / (8 * D);
            Wfa[i] = (h < 6) ? p.in[I_WIN][(size_t)l * D * N_IN + (size_t)k * N_IN + C_FA + h] : 0.f; }
        for (int i = gtid; i < DEPTH * 48 * D; i += gthreads) { const int k = i % D, o = (i / D) % 48, l = i / (48 * D);
            const float w = (o < 4) ? p.in[I_WGRP][((size_t)l * D + k) * 4 + o] : (o < 36 ? p.in[I_WRT][((size_t)l * D + k) * 32 + (o - 4)] : 0.f);
            const bf16_t hi = f2bf(w);
            W36b[((size_t)l * 2 + 0) * 48 * D + (size_t)o * D + k] = hi; W36b[((size_t)l * 2 + 1) * 48 * D + (size_t)o * D + k] = f2bf(w - bf2f(hi)); }
        for (int i = gtid; i < S * 8; i += gthreads) { const int d = i & 7, t = i >> 3; const float ang = (float)positions[t] * p.inv_freq[d];
            ropecs[t * 16 + d] = cosf(ang); ropecs[t * 16 + 8 + d] = sinf(ang); }
        __syncthreads();
        for (int i = tid; i < 6 * D; i += NTHREADS) { const int k = i % D, h = i / D; ldsf[i] = p.in[I_WIN][(size_t)k * N_IN + C_FA + h]; }
        __syncthreads();
        for (int t0 = gwave * 2; t0 < S; t0 += gwaves * 2) {
            f32x4 v[2][8];
#pragma unroll
            for (int tk = 0; tk < 2; ++tk)
#pragma unroll
                for (int j = 0; j < 8; ++j) v[tk][j] = *(const f32x4*)(p.in[I_X] + (size_t)(t0 + tk) * D + j * 256 + lane * 4);
#pragma unroll
            for (int tk = 0; tk < 2; ++tk) {
                const int t = t0 + tk;
                float fa[6] = {0.f, 0.f, 0.f, 0.f, 0.f, 0.f};
#pragma unroll
                for (int j = 0; j < 8; ++j) {
                    const int c = j * 256 + lane * 4;
                    u32x2 o; o.x = pack2(v[tk][j][0], v[tk][j][1]); o.y = pack2(v[tk][j][2], v[tk][j][3]);
                    *(u32x2*)(xb + (size_t)t * D + c) = o;
#pragma unroll
                    for (int h = 0; h < 6; ++h) { const f32x4 w = *(const f32x4*)(ldsf + h * D + c); fa[h] += v[tk][j][0] * w[0] + v[tk][j][1] * w[1] + v[tk][j][2] * w[2] + v[tk][j][3] * w[3]; }
                    COMPILER_FENCE();
                }
#pragma unroll
                for (int h = 0; h < 6; ++h) { const float sm = wave_sum(fa[h]); if (lane == 0) logf_[h * S + t] = log_sigmoid_f(sm + p.in[I_BF][h]); }
            }
        }
        PH_BAR(0);
    }

    for (int l = 0; l < DEPTH; ++l) {
        const int pb = 1 + l * NPH;
#define hin ((l == 0) ? p.in[I_X] : (const float*)hb)
#define hout ((l == DEPTH - 1) ? p.out : hb)
#define workctr ((int*)(wsl + CTL_WORK_OFF) + l * 64)

        if (PH_SEL(0) && PH_IN(pb + 0)) {
            PHASE_IDS();
            int bz = bid; OPAQUE_S(bz);
            if (bz == 0) {
                double* part = (double*)lds_raw;
                const int per = S / 64;
                double s = 0.0;
                if (wave < 6) { for (int i = 0; i < per; ++i) s += (double)logf_[wave * S + lane * per + i]; part[wave * 64 + lane] = s; }
                __syncthreads();
                if (wave < 6) {
                    double run = 0.0;
                    for (int j = 0; j < lane; ++j) run += part[wave * 64 + j];
                    for (int i = 0; i < per; ++i) { run += (double)logf_[wave * S + lane * per + i]; cum2[wave * S + lane * per + i] = (float)(run * (double)LOG2E); }
                }
                __syncthreads();
            }
            bool conv_more = (l == 0);
#define CONV_ONE() do { if (conv_more) { __syncthreads(); if (tid == 0) *ubox = (unsigned)atomic_add_int((int*)(wsl + CTL_WORK_OFF) + 62, 1); __syncthreads(); \
                const int cid_ = RFL((int)*ubox); if (cid_ < NCONV) moe_conv_chunk(p, cid_, WguT, WdT, ldsf, tid); else conv_more = false; } } while (0)
            unsigned* cls = (unsigned*)(wsl + CTL_CLS_OFF) + l * 256;
            if (bz == 0) { WAIT_VM0(); __syncthreads(); if (tid == 0) { FENCE_REL_AGENT(); WAIT_VM0(); (void)xb_add(&cls[192], 1u); } }
            const bf16_t* Bt = WinT + (size_t)l * N_INP * D;
            constexpr int ntm = S / 256;
            const unsigned nooff[2][2] = {{0u, 0u}, {0u, 0u}};
            for (int i = 0; i < (bid & 3); ++i) CONV_ONE();
            for (;;) {
                __syncthreads();
                if (tid == 0) *ubox = (unsigned)atomic_add_int(workctr + 9, 1);
                __syncthreads();
                int t = RFL((int)*ubox);
                if (t >= ntm * 21) break;
                int pm, pn, kcls;
                if (t < ntm * 6) { pm = t / 6; pn = 15 + t % 6; kcls = 0; }
                else if (t < ntm * 12) { t -= ntm * 6; pm = t / 6; pn = 9 + t % 6; kcls = 1; }
                else { t -= ntm * 12; pm = t / 9; pn = t % 9; kcls = 2; }
                f32x4 acc[2][2][4][2];
                gemm_tile<false>(xb, pm * 256, nooff, Bt, pn * 256, D, lds_raw, acc, tid);
                int et = tid; OPAQUE(et); const int wr = et >> 8, wc = (et >> 6) & 3, fr = et & 15, fq = (et >> 4) & 3;
                if (pn < 6 || (pn >= 9 && pn < 19)) {
                    bf16_t* dst; float scale = 1.f; bool rope = false;
                    if (pn < 3) { dst = Qa; scale = QSCALE_A; } else if (pn < 6) { dst = Ka; } else if (pn < 12) { dst = Xr; } else if (pn < 15) { dst = Gr; }
                    else if (pn < 17) { dst = Qc; scale = QSCALE_C; rope = true; } else { dst = Kc; rope = true; }
                    const bool headmajor = (pn < 6) || (pn >= 15);
                    const int segpn = (pn < 3) ? pn : (pn < 6) ? pn - 3 : (pn < 12) ? pn - 9 : (pn < 15) ? pn - 12 : (pn < 17) ? pn - 15 : pn - 17;
#pragma unroll
                    for (int ai = 0; ai < 2; ++ai)
#pragma unroll
                        for (int m = 0; m < 4; ++m)
#pragma unroll
                            for (int bj = 0; bj < 2; ++bj)
#pragma unroll
                                for (int n = 0; n < 2; ++n) {
                                    const int dd = wc * 32 + n * 16 + fr;
#pragma unroll
                                    for (int j = 0; j < 4; ++j) {
                                        const int row = pm * 256 + ai * 128 + wr * 64 + m * 16 + fq * 4 + j;
                                        float v = acc[ai][bj][m][n][j];
                                        if (rope && n == 0 && (wc & 1) == 0) {
                                            const float pv = SHX(v, 8);
                                            const float cs = ropecs[row * 16 + (fr & 7)], sn = ropecs[row * 16 + 8 + (fr & 7)];
                                            v = (fr < 8) ? (v * cs - pv * sn) : (v * cs + pv * sn);
                                        }
                                        v *= scale;
                                        *(bf16_t*)(lds_raw + (ai * 128 + wr * 64 + m * 16 + fq * 4 + j) * 528 + (bj * 128 + dd) * 2) = f2bf(v);
                                    }
                                }
                    __syncthreads();
#pragma unroll 4
                    for (int i = 0; i < 16; ++i) {
                        const int idx = et + i * 512, lrow = idx >> 5, ch = idx & 31, row = pm * 256 + lrow;
                        const u32x4 val = *(const u32x4*)(lds_raw + lrow * 528 + ch * 16);
                        size_t gi;
                        if (headmajor) gi = ((size_t)(segpn * 2 + (ch >> 4)) * S + row) * 128 + (ch & 15) * 8;
                        else gi = (size_t)row * LRU_W + segpn * 256 + ch * 8;
                        *(u32x4*)(dst + gi) = val;
                    }
                    __syncthreads();
                    if (pn >= 15) {
                        float* part = ldsf;
#pragma unroll
                        for (int ai = 0; ai < 2; ++ai)
#pragma unroll
                            for (int m = 0; m < 4; ++m)
#pragma unroll
                                for (int bj = 0; bj < 2; ++bj)
#pragma unroll
                                    for (int j = 0; j < 4; ++j) {
                                        float ss = acc[ai][bj][m][0][j] * acc[ai][bj][m][0][j] + acc[ai][bj][m][1][j] * acc[ai][bj][m][1][j];
                                        ss += SHX(ss, 1); ss += SHX(ss, 2); ss += SHX(ss, 4); ss += SHX(ss, 8);
                                        if (fr == 0) part[(wc * 2 + bj) * 256 + ai * 128 + wr * 64 + m * 16 + fq * 4 + j] = ss;
                                    }
                        __syncthreads();
                        {
                            const int bj = et >> 8, row = et & 255;
                            float v0 = part[(0 * 2 + bj) * 256 + row] + part[(1 * 2 + bj) * 256 + row], v1 = part[(2 * 2 + bj) * 256 + row] + part[(3 * 2 + bj) * 256 + row];
                            v0 = fmaxf(v0, SHX(v0, 1)); v0 = fmaxf(v0, SHX(v0, 2)); v0 = fmaxf(v0, SHX(v0, 4)); v0 = fmaxf(v0, SHX(v0, 8)); v0 = xrow16_max(v0);
                            v1 = fmaxf(v1, SHX(v1, 1)); v1 = fmaxf(v1, SHX(v1, 2)); v1 = fmaxf(v1, SHX(v1, 4)); v1 = fmaxf(v1, SHX(v1, 8)); v1 = xrow16_max(v1);
                            if ((et & 63) == 0) {
                                unsigned* q2p = (unsigned*)(wsl + CTL_QK2_OFF) + l * 16 + (pn >= 17 ? 8 : 0) + (segpn * 2 + bj) * 2;
                                atomic_max_u32(q2p, __builtin_bit_cast(unsigned, v0)); atomic_max_u32(q2p + 1, __builtin_bit_cast(unsigned, v1));
                            }
                        }
                        __syncthreads();
                    }
                    if (pn >= 3 && pn < 6) {
                        float* part = ldsf;
#pragma unroll
                        for (int ai = 0; ai < 2; ++ai)
#pragma unroll
                            for (int m = 0; m < 4; ++m)
#pragma unroll
                                for (int bj = 0; bj < 2; ++bj)
#pragma unroll
                                    for (int j = 0; j < 4; ++j) {
                                        float ss = acc[ai][bj][m][0][j] * acc[ai][bj][m][0][j] + acc[ai][bj][m][1][j] * acc[ai][bj][m][1][j];
                                        ss += SHX(ss, 1); ss += SHX(ss, 2); ss += SHX(ss, 4); ss += SHX(ss, 8);
                                        if (fr == 0) part[(wc * 2 + bj) * 256 + ai * 128 + wr * 64 + m * 16 + fq * 4 + j] = ss;
                                    }
                        __syncthreads();
                        {
                            const int bj = et >> 8, row = et & 255;
                            float v = part[(0 * 2 + bj) * 256 + row] + part[(1 * 2 + bj) * 256 + row] + part[(2 * 2 + bj) * 256 + row] + part[(3 * 2 + bj) * 256 + row];
                            v = fmaxf(v, SHX(v, 1)); v = fmaxf(v, SHX(v, 2)); v = fmaxf(v, SHX(v, 4)); v = fmaxf(v, SHX(v, 8)); v = xrow16_max(v);
                            if ((et & 63) == 0) kmax2[((pn - 3) * 2 + bj) * NKT + pm * 4 + ((et >> 6) & 3)] = v;
                        }
                        __syncthreads();
                    }
                } else {
                    bf16_t* dst = (pn < 9) ? VaT : VcT;
                    const int segpn = (pn < 9) ? pn - 6 : pn - 19;
#pragma unroll
                    for (int ai = 0; ai < 2; ++ai)
#pragma unroll
                        for (int m = 0; m < 4; ++m)
#pragma unroll
                            for (int bj = 0; bj < 2; ++bj)
#pragma unroll
                                for (int n = 0; n < 2; ++n) {
                                    const int dd = wc * 32 + n * 16 + fr;
                                    const int row = pm * 256 + ai * 128 + wr * 64 + m * 16 + fq * 4;
                                    const f32x4 a = acc[ai][bj][m][n];
                                    u32x2 o; o.x = pack2(a[0], a[1]); o.y = pack2(a[2], a[3]);
                                    const int s6 = row & 63, pos = (s6 & 32) + ((s6 >> 2) & 3) * 8 + ((s6 >> 4) & 1) * 4;
                                    *(u32x2*)(dst + (((size_t)(segpn * 2 + bj) * NKT + (row >> 6)) * 128 + dd) * 64 + pos) = o;
                                }
                }
                WAIT_VM0();
                __syncthreads();
                if (et == 0) { FENCE_REL_AGENT(); WAIT_VM0(); (void)xb_add(&cls[kcls * 64], 1u); }
                CONV_ONE();
            }
        }

        if (PH_SEL(1) && PH_IN(pb + 1)) {
            PHASE_IDS();
            const float lam_init = (l == 0) ? 0.2f : 0.35550906759f;
            const float s1 = wave_sum(p.in[I_LQ1][l * 64 + lane] * p.in[I_LK1][l * 64 + lane]);
            const float s2 = wave_sum(p.in[I_LQ2][l * 64 + lane] * p.in[I_LK2][l * 64 + lane]);
            const float lam = fexp(s1) - fexp(s2) + lam_init;
            constexpr int NLRU = NKT * 6, NQB = S / 128;
            bool conv_more = (l == 0);
            unsigned* cls = (unsigned*)(wsl + CTL_CLS_OFF) + l * 256;
            unsigned* bw = (unsigned*)wsl;
#define WAIT_CLASS(k, n) do { __syncthreads(); if (tid == 0) { XB_SPIN(xb_ld(&cls[(k) * 64]) < (unsigned)(n), bw); FENCE_ACQ_AGENT(); WAIT_VM0(); } __syncthreads(); } while (0)
#ifndef NO_DIFF
            {
                constexpr int NQB2 = S / 256;
                int total = 0;
                for (int q = 0; q < NQB2; ++q) total += ((4 * q + 4 + DCH - 1) / DCH) * 8;
                WAIT_CLASS(0, (S / 256) * 6);
                for (;;) {
                    __syncthreads();
                    if (tid == 0) *ubox = (unsigned)atomic_add_int(workctr, 1);
                    __syncthreads();
                    int u = RFL((int)*ubox);
                    if (u >= total) break;
                    int qb = NQB2 - 1;
                    for (;; --qb) { const int nu = ((4 * qb + 4 + DCH - 1) / DCH) * 8; if (u < nu) break; u -= nu; }
                    const int c = u >> 3, h = (u >> 1) & 3, mp = u & 1;
                    const int t0 = c * DCH, t1 = (t0 + DCH < 4 * qb + 4) ? t0 + DCH : 4 * qb + 4;
                    const unsigned* q2p = (const unsigned*)(wsl + CTL_QK2_OFF) + l * 16;
                    const float bnd = sqrtf(__builtin_bit_cast(float, q2p[h * 2 + mp]) * __builtin_bit_cast(float, q2p[8 + h * 2 + mp])) * (QSCALE_C * 1.02f) + 0.01f;
                    attn_dmap_unit(Qc + (size_t)h * S * 128, Kc + (size_t)h * S * 128, VcT + (size_t)h * S * 128, mp, qb, t0, t1,
                                   dpo + (size_t)(h * 2 + mp) * DPART_ROWS * 128, dpml + (size_t)(h * 2 + mp) * DPART_ROWS * 2, c, RFL_F(bnd), lds_raw, tid);
                    CONV_ONE();
                }
            }
#endif
#ifndef NO_LRU
            WAIT_CLASS(1, (S / 256) * 6);
            for (;;) {
                __syncthreads();
                if (tid == 0) *ubox = (unsigned)atomic_add_int(workctr + 10, 1);
                __syncthreads();
                const int u = RFL((int)*ubox);
                if (u >= NLRU) break;
                lru_unit_a(u / 6, u % 6, l, p, Xr, WaiT + (size_t)l * 6 * 256 * 128, hloc, ploc, sumA, sumH, lds_raw, tid);
            }
#endif
#ifndef NO_FOX
            WAIT_CLASS(2, (S / 256) * 9);
            WAIT_CLASS(3, 1);
            for (;;) {
                __syncthreads();
                if (tid == 0) *ubox = (unsigned)atomic_add_int(workctr + 1, 1);
                __syncthreads();
                const int u = RFL((int)*ubox);
                if (u >= NQB * FOX_H) break;
                const int qb = NQB - 1 - u / FOX_H, h = u % FOX_H;
                attn_unit<0>(Qa + (size_t)h * S * 128, Ka + (size_t)h * S * 128, VaT + (size_t)h * S * 128, cum2 + (size_t)h * S, kmax2 + h * NKT, qb, concat, h * 128,
                             0.f, 0.f, nullptr, lds_raw, tid);
            }
#endif
            while (conv_more) CONV_ONE();
            PH_BAR(pb + 1);
        }

        if (PH_SEL(2) && PH_IN(pb + 2)) for (int rep = 0; rep < PH_REPS(2); ++rep) {
            PHASE_IDS();
            for (int u = bid; u < NKT * 6; u += G) {
                const int chunk = u / 6, grp = u % 6, c = tid & 127, tq = tid >> 7, ch = grp * 128 + c;
                float cr = 0.f;
                {
                    int j = 0;
                    for (; j + 16 <= chunk; j += 16) {
                        float a8[16], h8[16];
#pragma unroll
                        for (int q = 0; q < 16; ++q) { a8[q] = sumA[(size_t)(j + q) * LRU_W + ch]; h8[q] = sumH[(size_t)(j + q) * LRU_W + ch]; }
#pragma unroll
                        for (int q = 0; q < 16; ++q) cr = a8[q] * cr + h8[q];
                    }
                    for (; j < chunk; ++j) cr = sumA[(size_t)j * LRU_W + ch] * cr + sumH[(size_t)j * LRU_W + ch];
                }
                float hl[16], pl[16]; bf16_t gg[16];
#pragma unroll
                for (int i = 0; i < 16; ++i) { const size_t gi = (size_t)(chunk * 64 + tq * 16 + i) * LRU_W + ch; const unsigned hp = ((const unsigned*)hloc)[gi]; hl[i] = bf2f((bf16_t)(hp & 0xffffu)); pl[i] = bf2f((bf16_t)(hp >> 16)); gg[i] = Gr[gi]; }
#pragma unroll
                for (int i = 0; i < 16; ++i)
                    concat[(size_t)(chunk * 64 + tq * 16 + i) * D + FOX_W + ch] = f2bf(gelu_tanh_f(bf2f(gg[i])) * (hl[i] + pl[i] * cr));
            }
            {
                const float lam_init = (l == 0) ? 0.2f : 0.35550906759f;
                const float s1 = wave_sum(p.in[I_LQ1][l * 64 + lane] * p.in[I_LK1][l * 64 + lane]);
                const float s2 = wave_sum(p.in[I_LQ2][l * 64 + lane] * p.in[I_LK2][l * 64 + lane]);
                const float lam = fexp(s1) - fexp(s2) + lam_init;
                const float* sg = p.in[I_SUBG] + l * 128;
                const float g0 = sg[2 * lane], g1 = sg[2 * lane + 1];
                static_assert(NCH <= 8, "the merge below keeps one (map, chunk) pair per lane: 2 x 8 lanes");
                for (int q = gwave; q < S; q += gwaves) {
                    const int nch = (q >> 6) / DCH + 1;
                    float mv = -INFINITY, lv = 0.f;
                    { const int c = lane & 7, hm = lane >> 3;
                      if (c < nch) { const float* ML = dpml + ((size_t)hm * DPART_ROWS + dpart_row(c, q)) * 2; mv = ML[0]; lv = ML[1]; } }
                    unsigned pk[4][2][NCH];
#pragma unroll
                    for (int h = 0; h < 4; ++h)
#pragma unroll
                        for (int mp = 0; mp < 2; ++mp) {
                            const unsigned* OP = (const unsigned*)(dpo + (size_t)(h * 2 + mp) * DPART_ROWS * 128);
#pragma unroll
                            for (int c = 0; c < NCH; ++c) pk[h][mp][c] = (c < nch) ? OP[(size_t)dpart_row(c, q) * 64 + lane] : 0u;
                        }
                    float Mx = mv; Mx = fmaxf(Mx, DPP_X1(Mx)); Mx = fmaxf(Mx, DPP_X2(Mx)); Mx = fmaxf(Mx, DPP_X7(Mx));
                    const float wv = (mv == -INFINITY) ? 0.f : FAST_EXP2(mv - Mx);
                    float Lp = lv * wv; Lp += DPP_X1(Lp); Lp += DPP_X2(Lp); Lp += DPP_X7(Lp);
#pragma unroll
                    for (int h = 0; h < 4; ++h) {
                        float om[2][2];
#pragma unroll
                        for (int mp = 0; mp < 2; ++mp) {
                            float o0 = 0.f, o1 = 0.f;
#pragma unroll
                            for (int c = 0; c < NCH; ++c) { const float w = RDLANE(wv, (h * 2 + mp) * 8 + c); o0 += bf2f((bf16_t)(pk[h][mp][c] & 0xffffu)) * w; o1 += bf2f((bf16_t)(pk[h][mp][c] >> 16)) * w; }
                            const float il = 1.f / RDLANE(Lp, (h * 2 + mp) * 8);
                            om[mp][0] = o0 * il; om[mp][1] = o1 * il;
                        }
                        const float v0 = om[0][0] - lam * om[1][0], v1 = om[0][1] - lam * om[1][1];
                        const float ss = wave_sum(v0 * v0 + v1 * v1);
                        const float rs = (1.f - lam_init) / sqrtf(ss * (1.f / 128.f) + LN_EPS);
                        *(unsigned*)(concat + (size_t)q * D + 1536 + h * 128 + 2 * lane) = pack2(v0 * rs * g0, v1 * rs * g1);
                    }
                }
            }
            PH_BAR(pb + 2);
        }

        if (PH_SEL(3) && PH_IN(pb + 3)) for (int rep = 0; rep < PH_REPS(3); ++rep) {
            PHASE_IDS();
            const bf16_t* Bt = WoT + (size_t)l * D * D;
            constexpr int ntn = D / 256, ntm = S / 256;
            const unsigned nooff[2][2] = {{0u, 0u}, {0u, 0u}};
            for (int t0 = bid; t0 < ntm * ntn; t0 += G) {
                int t = t0;
                if (G == 256 && ntm * ntn == 256) { const int x = t0 & 7, j = t0 >> 3; t = (x * 4 + (j >> 3)) * ntn + (j & 7); }
                const int pm = t / ntn, pn = t % ntn;
                f32x4 acc[2][2][4][2];
                gemm_tile<false>(concat, pm * 256, nooff, Bt, pn * 256, D, lds_raw, acc, tid);
                int et = tid; OPAQUE(et); const int wr = et >> 8, wc = (et >> 6) & 3, fr = et & 15, fq = (et >> 4) & 3;
#pragma unroll
                for (int ai = 0; ai < 2; ++ai) {
#pragma unroll
                    for (int m = 0; m < 4; ++m)
#pragma unroll
                        for (int bj = 0; bj < 2; ++bj)
#pragma unroll
                            for (int n = 0; n < 2; ++n)
#pragma unroll
                                for (int j = 0; j < 4; ++j)
                                    *(float*)(lds_raw + (wr * 64 + m * 16 + fq * 4 + j) * 1040 + (bj * 128 + wc * 32 + n * 16 + fr) * 4) = acc[ai][bj][m][n][j];
                    __syncthreads();
#pragma unroll 4
                    for (int i = 0; i < 16; ++i) {
                        const int idx = et + i * 512, lrow = idx >> 6, c4 = idx & 63;
                        const size_t gi = (size_t)(pm * 256 + ai * 128 + lrow) * D + pn * 256 + c4 * 4;
                        const f32x4 v = *(const f32x4*)(lds_raw + lrow * 1040 + c4 * 16);
                        *(f32x4*)(y1 + gi) = ALPHA * *(const f32x4*)(hin + gi) + v;
                    }
                    __syncthreads();
                }
            }
            PH_BAR(pb + 3);
        }

        if (PH_SEL(4) && PH_IN(pb + 4)) for (int rep = 0; rep < PH_REPS(4); ++rep) {
            PHASE_IDS();
            const float* g1 = p.in[I_LN1G] + (size_t)l * D; const float* b1 = p.in[I_LN1B] + (size_t)l * D;
            const float* bg = p.in[I_BGRP] + l * 4; const float* br = p.in[I_BRT] + l * 32;
            const bf16_t* Wb = W36b + (size_t)l * 2 * 48 * D;
            int* lcnt = (int*)(lds_raw + LDS_MISC + M_LCNT);
            const int segcap = ((S / 16 + G - 1) / G) * 16;
            const int r16 = lane & 15, q4 = lane >> 4;
            if (tid < 32) lcnt[tid] = 0;
            f32x4 gq[8], bq[8];
#pragma unroll
            for (int j = 0; j < 8; ++j) { gq[j] = *(const f32x4*)(g1 + j * 256 + lane * 4); bq[j] = *(const f32x4*)(b1 + j * 256 + lane * 4); }
            __syncthreads();
            for (int bi = bid; bi < S / 16; bi += G) {
                f32x4 v2[2][8];
#pragma unroll
                for (int tk = 0; tk < 2; ++tk)
#pragma unroll
                    for (int j = 0; j < 8; ++j) v2[tk][j] = *(const f32x4*)(y1 + (size_t)(bi * 16 + wave * 2 + tk) * D + j * 256 + lane * 4);
#pragma unroll
                for (int tk = 0; tk < 2; ++tk) {
                    const int r = wave * 2 + tk, t = bi * 16 + r;
                    float s = 0.f;
#pragma unroll
                    for (int j = 0; j < 8; ++j) s += (v2[tk][j][0] + v2[tk][j][1]) + (v2[tk][j][2] + v2[tk][j][3]);
                    const float mean = wave_sum(s) * (1.f / D);
                    float s2 = 0.f;
#pragma unroll
                    for (int j = 0; j < 8; ++j) { v2[tk][j] -= mean; s2 += (v2[tk][j][0] * v2[tk][j][0] + v2[tk][j][1] * v2[tk][j][1]) + (v2[tk][j][2] * v2[tk][j][2] + v2[tk][j][3] * v2[tk][j][3]); }
                    const float rstd = 1.f / sqrtf(wave_sum(s2) * (1.f / D) + LN_EPS);
                    if (lane == 0) { lnstat[2 * t] = mean; lnstat[2 * t + 1] = rstd; }
#pragma unroll
                    for (int j = 0; j < 8; ++j) {
                        const int c = j * 256 + lane * 4;
                        const f32x4 hv = v2[tk][j] * rstd * gq[j] + bq[j];
                        u32x2 o; o.x = pack2(hv[0], hv[1]); o.y = pack2(hv[2], hv[3]);
                        *(u32x2*)(h1b + (size_t)t * D + c) = o;
                        u32x2 lo2;
                        lo2.x = pack2(hv[0] - bf2f((bf16_t)(o.x & 0xffffu)), hv[1] - bf2f((bf16_t)(o.x >> 16)));
                        lo2.y = pack2(hv[2] - bf2f((bf16_t)(o.y & 0xffffu)), hv[3] - bf2f((bf16_t)(o.y >> 16)));
                        const int la = r * 4096 + (((j * 32 + (lane >> 1)) ^ r) << 4) + (lane & 1) * 8;
                        *(u32x2*)(lds_raw + la) = o; *(u32x2*)(lds_raw + 65536 + la) = lo2;
                    }
                }
                __syncthreads();
                f32x4 ac[3];
#pragma unroll
                for (int nt = 0; nt < 3; ++nt) ac[nt] = (f32x4){0.f, 0.f, 0.f, 0.f};
#pragma unroll 4
                for (int ks = 0; ks < 8; ++ks) {
                    const int kk = wave * 8 + ks;
                    const int la = r16 * 4096 + (((kk * 4 + q4) ^ r16) << 4);
                    const bf16x8 ah = *(const bf16x8*)(lds_raw + la), al = *(const bf16x8*)(lds_raw + 65536 + la);
#pragma unroll
                    for (int nt = 0; nt < 3; ++nt) {
                        const bf16x8 bh = *(const bf16x8*)(Wb + (size_t)(nt * 16 + r16) * D + kk * 32 + q4 * 8);
                        const bf16x8 bl = *(const bf16x8*)(Wb + (size_t)48 * D + (size_t)(nt * 16 + r16) * D + kk * 32 + q4 * 8);
                        ac[nt] = MFMA16(ah, bh, ac[nt]); ac[nt] = MFMA16(al, bh, ac[nt]); ac[nt] = MFMA16(ah, bl, ac[nt]);
                    }
                }
                __syncthreads();
                float* red = ldsf;
#pragma unroll
                for (int nt = 0; nt < 3; ++nt)
#pragma unroll
                    for (int j = 0; j < 4; ++j) red[(wave * 16 + q4 * 4 + j) * 48 + nt * 16 + r16] = ac[nt][j];
                __syncthreads();
                float* lgt = ldsf + 8 * 16 * 48;
                if (tid < 256) {
                    const int tkn = tid >> 4, o3 = (tid & 15) * 3;
#pragma unroll
                    for (int q = 0; q < 3; ++q) { float a = 0.f;
#pragma unroll
                        for (int w = 0; w < 8; ++w) a += red[(w * 16 + tkn) * 48 + o3 + q];
                        lgt[tkn * 48 + o3 + q] = a; }
                }
                __syncthreads();
                if (tid < 16) {
                    const int t = bi * 16 + tid; const float* L = lgt + tid * 48;
                    float gl[4];
#pragma unroll
                    for (int q = 0; q < 4; ++q) gl[q] = L[q] + bg[q];
                    int gi = 0; float gm = gl[0];
#pragma unroll
                    for (int q = 1; q < 4; ++q) if (gl[q] > gm) { gm = gl[q]; gi = q; }
                    float gs = 0.f;
#pragma unroll
                    for (int q = 0; q < 4; ++q) gs += fexp(gl[q] - gm);
                    const float gweight = 1.f / gs;
                    float E[8];
#pragma unroll
                    for (int e = 0; e < 8; ++e) E[e] = L[4 + gi * 8 + e] + br[gi * 8 + e];
                    int e1 = 0; float m1 = E[0];
#pragma unroll
                    for (int e = 1; e < 8; ++e) if (E[e] > m1) { m1 = E[e]; e1 = e; }
                    int e2 = -1; float m2 = -INFINITY;
#pragma unroll
                    for (int e = 0; e < 8; ++e) if (e != e1 && E[e] > m2) { m2 = E[e]; e2 = e; }
                    const float p2 = fexp(m2 - m1), w1 = 1.f / (1.f + p2), w2 = p2 / (1.f + p2);
                    const int ge1 = gi * 8 + e1, ge2 = gi * 8 + e2;
                    const int i1 = (ge1 * G + bid) * segcap + atomic_add_int(&lcnt[ge1], 1);
                    ltok[i1] = t; lw[i1] = gweight * w1; lslot[i1] = 0;
                    const int i2 = (ge2 * G + bid) * segcap + atomic_add_int(&lcnt[ge2], 1);
                    ltok[i2] = t; lw[i2] = gweight * w2; lslot[i2] = 1;
                }
                __syncthreads();
            }
            if (tid < 32) cntb[bid * 32 + tid] = lcnt[tid];
            PH_BAR(pb + 4);
        }

        if (PH_SEL(5) && PH_IN(pb + 5)) {
            PHASE_IDS();
            const unsigned nooff[2][2] = {{0u, 0u}, {0u, 0u}};
            const int segcap = ((S / 16 + G - 1) / G) * 16;
            moe_prefix(cntb, G, lds_raw, tid);
            const int* ctot = (const int*)(lds_raw + LDS_MISC + M_CTOT); const int* coff = (const int*)(lds_raw + LDS_MISC + M_COFF);
            const int* rtok = (const int*)(lds_raw + LDS_MISC + M_RTOK); const float* rw = (const float*)(lds_raw + LDS_MISC + M_RW);
            const int* rslot = (const int*)(lds_raw + LDS_MISC + M_RSLOT);
            unsigned* done = (unsigned*)(wsl + CTL_DONE_OFF) + l * 1024;
            int nmt = 0;
            for (int e = 0; e < NEXP; ++e) nmt += (ctot[e] + 255) / 256;
            nmt = RFL(nmt);
            for (;;) {
                __syncthreads();
                if (tid == 0) *ubox = (unsigned)atomic_add_int(workctr + 8, 1);
                __syncthreads();
                int u = RFL((int)*ubox);
                if (u >= nmt * 12) break;
                const bool down = (u >= nmt * 4);
                const int per = down ? 8 : 4;
                if (down) u -= nmt * 4;
                int e = 0;
                for (;; ++e) { const int nt = ((RFL(ctot[e]) + 255) / 256) * per; if (u < nt) break; u -= nt; }
                const int c = RFL(ctot[e]), off = RFL(coff[e]);
                const int mt = u / per, pn = u % per, m0 = mt * 256;
                moe_rowtable(ltok, lw, lslot, e, m0, c, G, segcap, lds_raw, tid);
                f32x4 acc[2][2][4][2];
                if (!down) {
                    const bf16_t* Bt = WguT + ((size_t)l * NEXP + e) * 1024 * D;
                    unsigned aoff[2][2];
                    int st = tid; OPAQUE(st); int R[2], C[2]; stage_geom(st, R, C);
#pragma unroll
                    for (int h = 0; h < 2; ++h)
#pragma unroll
                        for (int i = 0; i < 2; ++i) aoff[h][i] = (unsigned)(rtok[h * 128 + R[i]] * D + C[i]);
                    gemm_tile<true>(h1b, 0, aoff, Bt, pn * 256, D, lds_raw, acc, tid);
                    int et = tid; OPAQUE(et); const int wr = et >> 8, wc = (et >> 6) & 3, fr = et & 15, fq = (et >> 4) & 3;
#pragma unroll
                    for (int ai = 0; ai < 2; ++ai)
#pragma unroll
                        for (int m = 0; m < 4; ++m)
#pragma unroll
                            for (int j = 0; j < 4; ++j) {
                                const int r = ai * 128 + wr * 64 + m * 16 + fq * 4 + j;
                                const float wgt = rw[r];
#pragma unroll
                                for (int bj = 0; bj < 2; ++bj)
                                    *(bf16_t*)(lds_raw + r * 272 + (bj * 64 + wc * 16 + fr) * 2) = f2bf(silu_f(acc[ai][bj][m][0][j]) * acc[ai][bj][m][1][j] * wgt);
                            }
                    __syncthreads();
#pragma unroll 4
                    for (int i = 0; i < 8; ++i) {
                        const int idx = et + i * 512, r = idx >> 4, ch = idx & 15;
                        if (m0 + r < c) *(u32x4*)(act + (size_t)(off + m0 + r) * DFF + pn * 128 + ch * 8) = *(const u32x4*)(lds_raw + r * 272 + ch * 16);
                    }
                    WAIT_VM0();
                    __syncthreads();
                    if (et == 0) { FENCE_REL_AGENT(); WAIT_VM0(); (void)xb_add(&done[e * 32 + mt], 1u); }
                } else {
                    const bf16_t* Bt = WdT + ((size_t)l * NEXP + e) * D * DFF;
                    if (tid == 0) {
                        unsigned* bw = (unsigned*)wsl;
                        XB_SPIN(xb_ld(&done[e * 32 + mt]) < 4u, bw);
                        FENCE_ACQ_AGENT();
                        WAIT_VM0();
                    }
                    __syncthreads();
                    gemm_tile<false>(act, off + m0, nooff, Bt, pn * 256, DFF, lds_raw, acc, tid);
                    int et = tid; OPAQUE(et); const int wr = et >> 8, wc = (et >> 6) & 3, fr = et & 15, fq = (et >> 4) & 3;
#pragma unroll
                    for (int ai = 0; ai < 2; ++ai)
#pragma unroll
                        for (int m = 0; m < 4; ++m)
#pragma unroll
                            for (int bj = 0; bj < 2; ++bj)
#pragma unroll
                                for (int n = 0; n < 2; ++n)
#pragma unroll
                                    for (int j = 0; j < 4; ++j)
                                        *(bf16_t*)(lds_raw + (ai * 128 + wr * 64 + m * 16 + fq * 4 + j) * 528 + (bj * 128 + wc * 32 + n * 16 + fr) * 2) = f2bf(acc[ai][bj][m][n][j]);
                    __syncthreads();
#pragma unroll 4
                    for (int i = 0; i < 16; ++i) {
                        const int idx = et + i * 512, r = idx >> 5, ch = idx & 31;
                        if (m0 + r < c) *(u32x4*)(contrib + ((size_t)rslot[r] * S + rtok[r]) * D + pn * 256 + ch * 8) = *(const u32x4*)(lds_raw + r * 528 + ch * 16);
                    }
                }
            }
            PH_BAR(pb + 5);
        }

        if (PH_SEL(7) && PH_IN(pb + 7)) for (int rep = 0; rep < PH_REPS(7); ++rep) {
            PHASE_IDS();
            const float* g2 = p.in[I_LN2G] + (size_t)l * D; const float* b2 = p.in[I_LN2B] + (size_t)l * D;
            const bool more = (l + 1 < DEPTH);
            f32x4 gq[8], bq[8], g1q[8], b1q[8];
#pragma unroll
            for (int j = 0; j < 8; ++j) { gq[j] = *(const f32x4*)(g2 + j * 256 + lane * 4); bq[j] = *(const f32x4*)(b2 + j * 256 + lane * 4);
                g1q[j] = *(const f32x4*)(p.in[I_LN1G] + (size_t)l * D + j * 256 + lane * 4); b1q[j] = *(const f32x4*)(p.in[I_LN1B] + (size_t)l * D + j * 256 + lane * 4); }
            if (more) {
                const float* wf = Wfa + (size_t)(l + 1) * 8 * D;
                __syncthreads();
                for (int i = tid; i < 6 * D / 4; i += NTHREADS) *(f32x4*)(ldsf + i * 4) = *(const f32x4*)(wf + i * 4);
                __syncthreads();
            }
            for (int t = gwave; t < S; t += gwaves) {
                f32x4 v[8]; float s = 0.f;
                const float mean1 = lnstat[2 * t], rstd1 = lnstat[2 * t + 1];
#pragma unroll
                for (int j = 0; j < 8; ++j) {
                    const size_t i = (size_t)t * D + j * 256 + lane * 4;
                    const u32x2 c0 = *(const u32x2*)(contrib + i), c1 = *(const u32x2*)(contrib + (size_t)S * D + i);
                    const f32x4 cs = (f32x4){bf2f((bf16_t)(c0.x & 0xffffu)) + bf2f((bf16_t)(c1.x & 0xffffu)), bf2f((bf16_t)(c0.x >> 16)) + bf2f((bf16_t)(c1.x >> 16)),
                                             bf2f((bf16_t)(c0.y & 0xffffu)) + bf2f((bf16_t)(c1.y & 0xffffu)), bf2f((bf16_t)(c0.y >> 16)) + bf2f((bf16_t)(c1.y >> 16))};
                    v[j] = ALPHA * ((*(const f32x4*)(y1 + i) - mean1) * rstd1 * g1q[j] + b1q[j]) + cs;
                    s += (v[j][0] + v[j][1]) + (v[j][2] + v[j][3]);
                }
                const float mean = wave_sum(s) * (1.f / D);
                float s2 = 0.f;
#pragma unroll
                for (int j = 0; j < 8; ++j) { v[j] -= mean; s2 += (v[j][0] * v[j][0] + v[j][1] * v[j][1]) + (v[j][2] * v[j][2] + v[j][3] * v[j][3]); }
                const float rstd = 1.f / sqrtf(wave_sum(s2) * (1.f / D) + LN_EPS);
                float fa[6] = {0.f, 0.f, 0.f, 0.f, 0.f, 0.f};
#pragma unroll
                for (int j = 0; j < 8; ++j) {
                    const int c = j * 256 + lane * 4;
                    v[j] = v[j] * rstd * gq[j] + bq[j];
                    *(f32x4*)(hout + (size_t)t * D + c) = v[j];
                    COMPILER_FENCE();
                    if (more) {
                        u32x2 o; o.x = pack2(v[j][0], v[j][1]); o.y = pack2(v[j][2], v[j][3]);
                        *(u32x2*)(xb + (size_t)t * D + c) = o;
#pragma unroll
                        for (int h = 0; h < 6; ++h) { const f32x4 w = *(const f32x4*)(ldsf + h * D + c); fa[h] += (v[j][0] * w[0] + v[j][1] * w[1]) + (v[j][2] * w[2] + v[j][3] * w[3]); }
                    }
                }
                if (more) {
#pragma unroll
                    for (int h = 0; h < 6; ++h) { const float sm = wave_sum(fa[h]); if (lane == 0) logf_[h * S + t] = log_sigmoid_f(sm + p.in[I_BF][(l + 1) * 6 + h]); }
                }
            }
            PH_BAR(pb + 7);
        }
    }
#undef PH_IN
#undef PH_BAR
}

constexpr int N_PHASES = 1 + DEPTH * 8;
#ifndef EMU
extern "C" void kernel_launch(void* const* d_in, const int* in_sizes, int n_in, void* d_out, int out_size, void* d_ws, size_t ws_size, hipStream_t stream) {
    static int grid = 0;
    if (grid == 0) {
        if (n_in != N_INPUTS || out_size != S * D || ws_size < WS_END) {
            fprintf(stderr, "kernel_launch: unexpected shapes: n_in %d out %d ws %zu (need %zu)\n", n_in, out_size, ws_size, (size_t)WS_END); grid = -1; return; }
        int dev = 0, cus = 0, per_cu = 0;
        if (hipGetDevice(&dev) != hipSuccess || hipDeviceGetAttribute(&cus, hipDeviceAttributeMultiprocessorCount, dev) != hipSuccess) { grid = -1; return; }
        if (hipFuncSetAttribute((const void*)fwd_kernel, hipFuncAttributeMaxDynamicSharedMemorySize, LDS_BYTES) != hipSuccess) { fprintf(stderr, "kernel_launch: hipFuncSetAttribute failed\n"); grid = -1; return; }
        if (hipOccupancyMaxActiveBlocksPerMultiprocessor(&per_cu, (const void*)fwd_kernel, NTHREADS, LDS_BYTES) != hipSuccess || per_cu < 1) {
            fprintf(stderr, "kernel_launch: occupancy query says %d blocks per CU\n", per_cu); (void)hipGetLastError(); grid = -1; return; }
        grid = cus;
    }
    if (grid < 0) return;
    (void)hipMemsetAsync(d_ws, 0, CTL_BYTES, stream);
    Params p{};
    for (int i = 0; i < N_INPUTS; ++i) p.in[i] = (const float*)d_in[i];
    p.out = (float*)d_out; p.ws = (unsigned char*)d_ws;
    for (int i = 0; i < 8; ++i) p.inv_freq[i] = (float)pow(500000.0, -(double)i * 2.0 / 16.0);
#if N_LAUNCH_SPLIT
    for (int k = 0; k < N_PHASES; ++k) { p.lo = k; p.hi = k + 1; hipLaunchKernelGGL(fwd_kernel, dim3(grid), dim3(NTHREADS), LDS_BYTES, stream, p); }
#else
    p.lo = 0; p.hi = N_PHASES;
    hipLaunchKernelGGL(fwd_kernel, dim3(grid), dim3(NTHREADS), LDS_BYTES, stream, p);
#endif
}
#endif
```

```cpp
#ifndef EMU
#include <hip/hip_runtime.h>
#include <cstdio>
#include <cstdint>
#include <cmath>
#endif

#ifndef SEQ
#define SEQ 8192
#endif
#ifndef N_LAUNCH_SPLIT
#define N_LAUNCH_SPLIT 0
#endif
#ifndef REP_PHASE
#define REP_PHASE -2
#endif
#define PH_REPS(c) ((c) == REP_PHASE ? 2 : 1)
#ifndef REP_SUB
#define REP_SUB 0
#endif

constexpr int S = SEQ, D = 2048, DEPTH = 2;
constexpr int FOX_H = 6, FOX_W = 768;
constexpr int LRU_W = 768;
constexpr int DIFF_H = 4, DIFF_W = 512;
constexpr int N_IN = 5382, N_INP = 5376;
constexpr int C_FA = 2304;
constexpr int NEXP = 32, DFF = 512;
constexpr int NKT = S / 64;
#ifndef DCH
#define DCH 32
#endif
constexpr int NCH = (NKT + DCH - 1) / DCH;
constexpr size_t DPART_ROWS = (size_t)NCH * S - (size_t)(DCH * 64) * NCH * (NCH - 1) / 2;
constexpr float ALPHA = 1.41421356237309504880f;
constexpr float LN_EPS = 1e-5f;
constexpr float LOG2E = 1.4426950408889634f;
constexpr float QSCALE_A = 0.08838834764831845f * 1.4426950408889634f;
constexpr float QSCALE_C = 0.125f * 1.4426950408889634f;

enum { I_X = 0, I_POS, I_WIN, I_BF, I_CONVW, I_CONVB, I_WA, I_BA, I_WI, I_BI, I_LAM, I_LQ1, I_LK1, I_LQ2, I_LK2, I_SUBG, I_WO, I_LN1G, I_LN1B,
       I_WGRP, I_BGRP, I_WRT, I_BRT, I_WGATE, I_WUP, I_WDOWN, I_LN2G, I_LN2B, N_INPUTS };

typedef unsigned short bf16_t;
typedef short bf16x8 __attribute__((ext_vector_type(8)));
typedef float f32x4 __attribute__((ext_vector_type(4)));
typedef unsigned u32x4 __attribute__((ext_vector_type(4)));
typedef unsigned u32x2 __attribute__((ext_vector_type(2)));

constexpr size_t al256(size_t x) { return (x + 255) & ~(size_t)255; }
constexpr size_t CTL_BYTES = 65536;
constexpr size_t CTL_CNT_OFF = 32768;
constexpr size_t CTL_WORK_OFF = 36864;
constexpr size_t CTL_QK2_OFF = 57344;
constexpr size_t CTL_CLS_OFF = 49152;
constexpr size_t CTL_DONE_OFF = 40960;
constexpr size_t WB_WIN = CTL_BYTES;
constexpr size_t WB_WO = WB_WIN + al256((size_t)DEPTH * N_INP * D * 2);
constexpr size_t WB_WGU = WB_WO + al256((size_t)DEPTH * D * D * 2);
constexpr size_t WB_WD = WB_WGU + al256((size_t)DEPTH * NEXP * 1024 * D * 2);
constexpr size_t WB_WAI = WB_WD + al256((size_t)DEPTH * NEXP * D * DFF * 2);
constexpr size_t WF_FA = WB_WAI + al256((size_t)DEPTH * 6 * 256 * 128 * 2);
constexpr size_t WF_R36 = WF_FA + al256((size_t)DEPTH * 8 * D * 4);
constexpr size_t WF_ROPE = WF_R36 + al256((size_t)DEPTH * 2 * 48 * D * 2);
constexpr size_t A_XB = WF_ROPE + al256((size_t)S * 16 * 4);
constexpr size_t A_HB = A_XB + al256((size_t)S * D * 2);
constexpr size_t A_LOGF = A_HB + al256((size_t)S * D * 4);
constexpr size_t A_CUM = A_LOGF + al256((size_t)6 * S * 4);
constexpr size_t A_KMAX = A_CUM + al256((size_t)6 * S * 4);
constexpr size_t A_CNTB = A_KMAX + al256((size_t)6 * NKT * 4);
constexpr size_t A_QA = A_CNTB + al256((size_t)1024 * 32 * 4);
constexpr size_t A_KA = A_QA + al256((size_t)FOX_H * S * 128 * 2);
constexpr size_t A_VAT = A_KA + al256((size_t)FOX_H * S * 128 * 2);
constexpr size_t A_XR = A_VAT + al256((size_t)FOX_H * S * 128 * 2);
constexpr size_t A_GR = A_XR + al256((size_t)S * LRU_W * 2);
constexpr size_t A_QC = A_GR + al256((size_t)S * LRU_W * 2);
constexpr size_t A_KC = A_QC + al256((size_t)DIFF_H * S * 128 * 2);
constexpr size_t A_VCT = A_KC + al256((size_t)DIFF_H * S * 128 * 2);
constexpr size_t A_HLOC = A_VCT + al256((size_t)DIFF_H * S * 128 * 2);
constexpr size_t A_PLOC = A_HLOC + al256((size_t)S * LRU_W * 4);
constexpr size_t A_SUMA = A_PLOC + al256((size_t)S * LRU_W * 4);
constexpr size_t A_SUMH = A_SUMA + al256((size_t)NKT * LRU_W * 4);
constexpr size_t A_CONCAT = A_SUMH + al256((size_t)NKT * LRU_W * 4);
constexpr size_t A_Y1 = A_CONCAT + al256((size_t)S * D * 2);
constexpr size_t A_H1 = A_Y1 + al256((size_t)S * D * 4);
constexpr size_t A_H1B = A_H1 + al256((size_t)S * D * 4);
constexpr size_t A_LTOK = A_H1B + al256((size_t)S * D * 2);
constexpr size_t A_LW = A_LTOK + al256((size_t)NEXP * S * 4);
constexpr size_t A_LSLOT = A_LW + al256((size_t)NEXP * S * 4);
constexpr size_t A_ACT = A_LSLOT + al256((size_t)NEXP * S * 4);
constexpr size_t A_CONTRIB = A_ACT + al256((size_t)(2 * S + 256) * DFF * 2);
constexpr size_t WS_END = A_CONTRIB + al256((size_t)2 * S * D * 4);
constexpr size_t A_DPO = A_Y1;
constexpr size_t A_DPML = A_DPO + al256((size_t)8 * DPART_ROWS * 128 * 2);
static_assert(A_DPML + (size_t)8 * DPART_ROWS * 2 * 4 <= A_H1B, "differential partials must fit inside the y1 + h1 region");

constexpr int NTHREADS = 512;
constexpr int LDS_MAIN = 131072 + 4096;
constexpr int LDS_MISC = LDS_MAIN;
constexpr int LDS_BYTES = LDS_MAIN + 8192 + 16640;
constexpr int M_PRE16 = 8192;
constexpr int M_LCNT = 64, M_CTOT = 256, M_COFF = 384, M_PRE = 512, M_RTOK = 2048, M_RW = 3072, M_RSLOT = 4096;

struct Params {
    const float* in[N_INPUTS];
    float* out;
    unsigned char* ws;
    float inv_freq[8];
    int lo, hi;
};

#ifndef EMU
#define LAS __attribute__((address_space(3)))
#define DYN_LDS(name) extern __shared__ __attribute__((aligned(16))) unsigned char name[]
#define SLEEP1() __builtin_amdgcn_s_sleep(1)
#define WAVE_SYNC() __builtin_amdgcn_wave_barrier()
#define OPAQUE(x) asm volatile("" : "+v"(x))
#define COMPILER_FENCE() asm volatile("" ::: "memory")
#define RFL(x) __builtin_amdgcn_readfirstlane(x)
#define RFL_F(x) __builtin_bit_cast(float, __builtin_amdgcn_readfirstlane(__builtin_bit_cast(int, x)))
#define ANY_LANE(p) (__builtin_amdgcn_ballot_w64(p) != 0ull)
#define RDLANE(v, l) __builtin_bit_cast(float, __builtin_amdgcn_readlane(__builtin_bit_cast(int, v), l))
__device__ __forceinline__ int lane_id_volatile() { int l; asm volatile("v_mbcnt_lo_u32_b32 %0, -1, 0\n\tv_mbcnt_hi_u32_b32 %0, -1, %0" : "=v"(l)); return l; }
#define LANE_ID() lane_id_volatile()
#define OPAQUE_S(x) asm volatile("" : "+s"(x))
#define WAIT_VM0() asm volatile("s_waitcnt vmcnt(0)" ::: "memory")
#define WAIT_ALL0() __builtin_amdgcn_s_waitcnt(0)
#define FENCE_REL_AGENT() __builtin_amdgcn_fence(__ATOMIC_RELEASE, "agent")
#define FENCE_ACQ_AGENT() __builtin_amdgcn_fence(__ATOMIC_ACQUIRE, "agent")
#define MFMA16(a, b, c) __builtin_amdgcn_mfma_f32_16x16x32_bf16(a, b, c, 0, 0, 0)
#define GLDS16(g, l) __builtin_amdgcn_global_load_lds((const unsigned*)(g), (unsigned*)(l), 16, 0, 0)
#define WAIT_V(n) asm volatile("s_waitcnt vmcnt(" #n ")" ::: "memory")
#define WAIT_L(n) asm volatile("s_waitcnt lgkmcnt(" #n ")" ::: "memory")
#define BAR() __builtin_amdgcn_s_barrier()
#define SCHED() __builtin_amdgcn_sched_barrier(0)
#define SETPRIO(n) __builtin_amdgcn_s_setprio(n)
#define FAST_EXP2(x) __builtin_amdgcn_exp2f(x)
template <int M> __device__ __forceinline__ float shx_impl(float v, int lane) {
    if (M < 32) return __builtin_bit_cast(float, __builtin_amdgcn_ds_swizzle(__builtin_bit_cast(int, v), (M << 10) | 0x1f));
    return __builtin_bit_cast(float, __builtin_amdgcn_ds_bpermute((lane ^ 32) << 2, __builtin_bit_cast(int, v)));
}
#define SHX(v, M) shx_impl<M>(v, lane)
template <int CTRL> __device__ __forceinline__ float dppx(float x) { return __builtin_bit_cast(float, __builtin_amdgcn_mov_dpp(__builtin_bit_cast(int, x), CTRL, 0xf, 0xf, true)); }
#define DPP_X1(x) dppx<0xB1>(x)
#define DPP_X2(x) dppx<0x4E>(x)
#define DPP_X7(x) dppx<0x141>(x)
#define DPP_X8(x) dppx<0x128>(x)
#define xrow16_max(x) xrow16_max_l(x, lane)
#define xrow16_sum(x) xrow16_sum_l(x, lane)
__device__ __forceinline__ float xrow16_max_l(float x, int lane) { x = fmaxf(x, shx_impl<16>(x, lane)); return fmaxf(x, shx_impl<32>(x, lane)); }
__device__ __forceinline__ float xrow16_sum_l(float x, int lane) { x = x + shx_impl<16>(x, lane); return x + shx_impl<32>(x, lane); }
#define FAST_LOG2(x) __builtin_amdgcn_logf(x)
#define FAST_RCP(x) __builtin_amdgcn_rcpf(x)
__device__ __forceinline__ unsigned xb_ld(unsigned* p)              { return __hip_atomic_load(p, __ATOMIC_RELAXED, __HIP_MEMORY_SCOPE_AGENT); }
__device__ __forceinline__ unsigned xb_add(unsigned* p, unsigned v) { return __hip_atomic_fetch_add(p, v, __ATOMIC_RELAXED, __HIP_MEMORY_SCOPE_AGENT); }
__device__ __forceinline__ unsigned xb_xcc_id() { return (unsigned)__builtin_amdgcn_s_getreg((3 << 11) | 20) & 0xFu; }
__device__ __forceinline__ int atomic_add_int(int* p, int v) { return atomicAdd(p, v); }
__device__ __forceinline__ void atomic_min_int(int* p, int v) { atomicMin(p, v); }
__device__ __forceinline__ void atomic_max_u32(unsigned* p, unsigned v) { atomicMax(p, v); }
__device__ __forceinline__ unsigned pack2(float lo, float hi) { unsigned r; asm volatile("v_cvt_pk_bf16_f32 %0, %1, %2" : "=v"(r) : "v"(lo), "v"(hi)); return r; }
#else
#define MFMA16(a, b, c) emu_mfma_16x16x32_bf16(a, b, c)
#define GLDS16(g, l) emu_glds16((const void*)(g), (void*)(l))
#define WAIT_V(n) ((void)0)
#define WAIT_L(n) ((void)0)
#define BAR() __syncthreads()
#define SCHED() ((void)0)
#define SETPRIO(n) ((void)0)
#define FAST_EXP2(x) exp2f(x)
#define SHX(v, M) __shfl_xor(v, M)
#define DPP_X1(x) __shfl_xor(x, 1)
#define DPP_X2(x) __shfl_xor(x, 2)
#define DPP_X7(x) __shfl_xor(x, 7)
#define DPP_X8(x) __shfl_xor(x, 8)
static inline float xrow16_max(float x) { x = fmaxf(x, __shfl_xor(x, 16)); return fmaxf(x, __shfl_xor(x, 32)); }
static inline float xrow16_sum(float x) { x = x + __shfl_xor(x, 16); return x + __shfl_xor(x, 32); }
#define FAST_LOG2(x) log2f(x)
#define FAST_RCP(x) (1.f / (x))
static inline unsigned pack2(float lo, float hi) {
    unsigned a = __builtin_bit_cast(unsigned, lo), b = __builtin_bit_cast(unsigned, hi);
    a += 0x7fffu + ((a >> 16) & 1u); b += 0x7fffu + ((b >> 16) & 1u);
    return (a >> 16) | (b & 0xffff0000u);
}
#endif
__device__ __forceinline__ bf16_t f2bf(float f) { return (bf16_t)(pack2(f, 0.f) & 0xffffu); }
__device__ __forceinline__ float bf2f(bf16_t h) { return __builtin_bit_cast(float, (unsigned)h << 16); }

#define XB_TMO      128
#define XB_XCNT(j)  (256  + 64 * (j))
#define XB_XSUB(j)  (1280 + 64 * (j))
#define XB_XGEN(j)  (2304 + 64 * (j))
#define XB_TOP      3328
#define XB_TOPGEN   3392
#define XCD_BAR_WORDS 3456
#define XB_SPIN_CAP (1u << 22)
#define XB_SPIN(cond, bar) do { unsigned _sp = 0; while (cond) { SLEEP1(); \
    if ((++_sp & 255u) == 0u) { if (xb_ld(&(bar)[XB_TMO])) break; if (_sp > XB_SPIN_CAP) { xb_add(&(bar)[XB_TMO], 1u); break; } } } } while (0)

struct XcdBarrier { unsigned* bar; unsigned x; volatile LAS unsigned* st; };

__device__ __forceinline__ XcdBarrier xcd_barrier_post(unsigned* bar, volatile LAS unsigned* st) {
    XcdBarrier b; b.bar = bar; b.x = xb_xcc_id(); b.st = st;
    if (threadIdx.x == 0) (void)xb_add(&bar[XB_XCNT(b.x)], 1u);
    return b;
}
__device__ __forceinline__ void xcd_barrier_complete(unsigned* bar, unsigned x, unsigned& nloc, unsigned& nx) {
    const unsigned G = gridDim.x;
    unsigned sum, cnt, mine, sp = 0u;
    for (;;) {
        sum = 0u; cnt = 0u; mine = 0u;
#pragma unroll
        for (unsigned j = 0; j < 16; ++j) { const unsigned c = xb_ld(&bar[XB_XCNT(j)]); sum += c; cnt += (c > 0u) ? 1u : 0u; mine = (j == x) ? c : mine; }
        if (sum == G) break;
        SLEEP1();
        if ((++sp & 255u) == 0u) { if (xb_ld(&bar[XB_TMO])) break; if (sp > XB_SPIN_CAP) { xb_add(&bar[XB_TMO], 1u); break; } }
    }
    nloc = mine > 0u ? mine : 1u; nx = cnt > 0u ? cnt : 1u;
}
__device__ __forceinline__ void xcd_barrier(const XcdBarrier& b, bool leader) {
    WAIT_VM0();
    __syncthreads();
    if (leader) {
        unsigned* bar = b.bar;
        WAIT_ALL0();
        unsigned nloc = b.st[0], nx = b.st[1];
        if (nloc == 0u) { xcd_barrier_complete(bar, b.x, nloc, nx); b.st[0] = nloc; b.st[1] = nx; }
        const unsigned old = xb_add(&bar[XB_XSUB(b.x)], 1u);
        const unsigned gen = old / nloc;
        if (old + 1u == (gen + 1u) * nloc) {
            FENCE_REL_AGENT();
            WAIT_VM0();
            const unsigned og = xb_add(&bar[XB_TOP], 1u);
            const unsigned tg = og / nx;
            if (og + 1u == (tg + 1u) * nx) xb_add(&bar[XB_TOPGEN], 1u);
            else XB_SPIN(xb_ld(&bar[XB_TOPGEN]) == tg, bar);
            FENCE_ACQ_AGENT();
            xb_add(&bar[XB_XGEN(b.x)], 1u);
            WAIT_VM0();
        } else {
            XB_SPIN(xb_ld(&bar[XB_XGEN(b.x)]) == gen, bar);
            FENCE_ACQ_AGENT();
            WAIT_VM0();
        }
    }
    __syncthreads();
}

__device__ __forceinline__ float wave_sum_l(float v, int lane) {
    (void)lane;
    v += DPP_X1(v); v += DPP_X2(v); v += DPP_X7(v); v += DPP_X8(v);
    return xrow16_sum(v);
}
#define wave_sum(v) wave_sum_l(v, lane)
__device__ __forceinline__ float fexp(float x) { return FAST_EXP2(x * LOG2E); }
__device__ __forceinline__ float sigmoid_f(float x) { return FAST_RCP(1.f + fexp(-x)); }
__device__ __forceinline__ float log_sigmoid_f(float x) { return fminf(x, 0.f) - 0.6931471805599453f * FAST_LOG2(1.f + fexp(-fabsf(x))); }
__device__ __forceinline__ float gelu_tanh_f(float x) { const float u = 0.7978845608028654f * (x + 0.044715f * x * x * x); return x * FAST_RCP(1.f + fexp(-2.f * u)); }
__device__ __forceinline__ float silu_f(float x) { return x * FAST_RCP(1.f + fexp(-x)); }
__device__ __forceinline__ float neg_expm1_f(float x) {
    const float ser = -x * (1.f + x * (0.5f + x * (0.16666667f + x * (0.041666668f + x * (0.008333334f + x * 0.0013888889f)))));
    return (x > -0.35f) ? ser : (1.f - fexp(x));
}

struct RmIdent { __device__ __forceinline__ int operator()(int n) const { return n; } };
struct RmWin { __device__ __forceinline__ int operator()(int n) const { return n < C_FA ? n : (n < C_FA + 6 ? -1 : n - 6); } };
struct RmGu { int kind; __device__ __forceinline__ int operator()(int f) const { return (f >> 7) * 256 + ((f >> 6) & 1) * 128 + ((f >> 4) & 3) * 32 + kind * 16 + (f & 15); } };
struct RmOff { int off; __device__ __forceinline__ int operator()(int n) const { return n + off; } };

template <class RM>
__device__ __forceinline__ void convert_tile(const float* src, int ld, int K, int Nsrc, int k0, int n0, bf16_t* dst, const RM& rm, float* T, int tid) {
    {
        const int nn = tid & 255, kh = (tid >> 8) * 32, n = n0 + nn;
        const float* sp = src + (size_t)(k0 + kh) * ld + n;
        float v[32];
#pragma unroll
        for (int i = 0; i < 32; ++i) v[i] = (n < Nsrc) ? sp[(size_t)i * ld] : 0.f;
#pragma unroll
        for (int i = 0; i < 32; ++i) T[(kh + i) * 257 + nn] = v[i];
    }
    __syncthreads();
#pragma unroll
    for (int q = 0; q < 4; ++q) {
        const int nn = q * 64 + (tid >> 3), kc = (tid & 7) * 8, n = n0 + nn;
        const int row = (n < Nsrc) ? rm(n) : -1;
        if (row >= 0) {
            u32x4 o;
            o.x = pack2(T[(kc + 0) * 257 + nn], T[(kc + 1) * 257 + nn]); o.y = pack2(T[(kc + 2) * 257 + nn], T[(kc + 3) * 257 + nn]);
            o.z = pack2(T[(kc + 4) * 257 + nn], T[(kc + 5) * 257 + nn]); o.w = pack2(T[(kc + 6) * 257 + nn], T[(kc + 7) * 257 + nn]);
            *(u32x4*)(dst + (size_t)row * K + k0 + kc) = o;
        }
    }
    __syncthreads();
}
template <class RM>
__device__ __forceinline__ void convert_tile_v4(const float* src, int ld, int K, int k0, int n0, bf16_t* dst, const RM& rm, float* T, int tid_in) {
    int tid = tid_in; OPAQUE(tid);
    {
        const int w = tid >> 6, l4 = (tid & 63) * 4;
        const float* sp = src + (size_t)(k0 + w * 8) * ld + n0 + l4;
        f32x4 v[8];
#pragma unroll
        for (int i = 0; i < 8; ++i) v[i] = *(const f32x4*)(sp + (size_t)i * ld);
#pragma unroll
        for (int i = 0; i < 8; ++i) { float* tp = T + (w * 8 + i) * 257 + l4; tp[0] = v[i][0]; tp[1] = v[i][1]; tp[2] = v[i][2]; tp[3] = v[i][3]; }
    }
    __syncthreads();
#pragma unroll
    for (int q = 0; q < 4; ++q) {
        const int nn = q * 64 + (tid >> 3), kc = (tid & 7) * 8, n = n0 + nn;
        const int row = rm(n);
        u32x4 o;
        o.x = pack2(T[(kc + 0) * 257 + nn], T[(kc + 1) * 257 + nn]); o.y = pack2(T[(kc + 2) * 257 + nn], T[(kc + 3) * 257 + nn]);
        o.z = pack2(T[(kc + 4) * 257 + nn], T[(kc + 5) * 257 + nn]); o.w = pack2(T[(kc + 6) * 257 + nn], T[(kc + 7) * 257 + nn]);
        *(u32x4*)(dst + (size_t)row * K + k0 + kc) = o;
    }
    __syncthreads();
}
template <class RM>
__device__ __forceinline__ void convert_mats(const float* src, size_t sstride, int nmat, int ld, int K, int Nsrc, bf16_t* dst, size_t dstride, const RM& rm,
                                             float* T, int tid, int bid, int G) {
    const int tk = K / 64, tn = (Nsrc + 255) / 256, per = tk * tn, total = nmat * per;
    for (int t = bid; t < total; t += G) {
        const int mi = t / per, r = t % per;
        convert_tile(src + (size_t)mi * sstride, ld, K, Nsrc, (r / tn) * 64, (r % tn) * 256, dst + (size_t)mi * dstride, rm, T, tid);
    }
}

constexpr int NCONV = DEPTH * 768;
__device__ __forceinline__ void moe_conv_chunk(const Params& p, int cid, bf16_t* WguT_, bf16_t* WdT_, float* T, int tid) {
    const int l = cid / 768, r = cid % 768, kind = r >> 8, t0 = (r & 255) * 8;
    for (int t = t0; t < t0 + 8; ++t) {
        const int mi = t >> 6, rr = t & 63;
        if (kind < 2) {
            const float* src = p.in[kind == 0 ? I_WGATE : I_WUP] + ((size_t)l * NEXP + mi) * D * DFF;
            convert_tile_v4(src, DFF, D, (rr >> 1) * 64, (rr & 1) * 256, WguT_ + ((size_t)l * NEXP + mi) * 1024 * D, RmGu{kind}, T, tid);
        } else {
            const float* src = p.in[I_WDOWN] + ((size_t)l * NEXP + mi) * DFF * D;
            convert_tile_v4(src, D, DFF, (rr >> 3) * 64, (rr & 7) * 256, WdT_ + ((size_t)l * NEXP + mi) * D * DFF, RmIdent{}, T, tid);
        }
    }
}

constexpr int BK = 64, HTB = 128 * 64 * 2;
__device__ __forceinline__ int lds_byte(int r, int c) {
    const int st = (r >> 4) * 2 + (c >> 5), rr = r & 15, cc = c & 31, ob = rr * 64 + cc * 2;
    return st * 1024 + (ob ^ (((ob >> 9) & 1) << 5));
}
__device__ __forceinline__ void stage_rc(int b, int& R, int& C) {
    const int st = b / 1024, sb = b % 1024, swz = sb ^ (((sb >> 9) & 1) << 5);
    R = (st >> 1) * 16 + swz / 64; C = (st & 1) * 32 + (swz % 64) / 2;
}
template <bool GATHER>
__device__ __forceinline__ void gemm_tile(const bf16_t* A, int arow0, const unsigned (&aoff)[2][2], const bf16_t* Bt, int brow0, int K,
                                          unsigned char* shm, f32x4 (&acc)[2][2][4][2], int tid_in) {
    int tid = tid_in; OPAQUE(tid);
    unsigned toff; { int R0, C0; stage_rc(tid * 16, R0, C0); toff = (unsigned)(R0 * K + C0); }
#define SA(b, h) (shm + ((b) * 2 + (h)) * HTB)
#define SB(b, h) (shm + (4 + (b) * 2 + (h)) * HTB)
#define STAGE_B(P, h, kt) do { _Pragma("unroll") for (int _i = 0; _i < 2; ++_i) GLDS16(Bt + ((size_t)(brow0 + (h) * 128 + _i * 64) * K + (size_t)(kt) * BK) + toff, (P) + tid * 16 + _i * 8192); } while (0)
#define STAGE_A(P, h, kt) do { _Pragma("unroll") for (int _i = 0; _i < 2; ++_i) { \
    if (GATHER) GLDS16(A + (size_t)(kt) * BK + aoff[h][_i], (P) + tid * 16 + _i * 8192); \
    else GLDS16(A + ((size_t)(arow0 + (h) * 128 + _i * 64) * K + (size_t)(kt) * BK) + toff, (P) + tid * 16 + _i * 8192); } } while (0)
#define LDA(dst, b, h) _Pragma("unroll") for (int m = 0; m < 4; ++m) _Pragma("unroll") for (int k = 0; k < 2; ++k) \
    dst[m][k] = *reinterpret_cast<const bf16x8*>(SA(b, h) + lds_byte(wr * 64 + m * 16 + fr, k * 32 + fq * 8))
#define LDB(dst, b, h) _Pragma("unroll") for (int n = 0; n < 2; ++n) _Pragma("unroll") for (int k = 0; k < 2; ++k) \
    dst[n][k] = *reinterpret_cast<const bf16x8*>(SB(b, h) + lds_byte(wc * 32 + n * 16 + fr, k * 32 + fq * 8))
#define MMA(ai, bj, At, Bx) do { SETPRIO(1); \
    _Pragma("unroll") for (int m = 0; m < 4; ++m) _Pragma("unroll") for (int n = 0; n < 2; ++n) _Pragma("unroll") for (int k = 0; k < 2; ++k) \
      acc[ai][bj][m][n] = MFMA16(At[m][k], Bx[n][k], acc[ai][bj][m][n]); \
    SETPRIO(0); } while (0)
    int wid = tid >> 6, lane = tid & 63, wr = wid >> 2, wc = wid & 3, fr = lane & 15, fq = lane >> 4;
#pragma unroll
    for (int a = 0; a < 2; ++a)
#pragma unroll
        for (int b = 0; b < 2; ++b)
#pragma unroll
            for (int m = 0; m < 4; ++m)
#pragma unroll
                for (int n = 0; n < 2; ++n) acc[a][b][m][n] = (f32x4){0.f, 0.f, 0.f, 0.f};
    bf16x8 At[4][2], B0[2][2], B1[2][2];
    const int nt = K / BK;
    STAGE_B(SB(0, 0), 0, 0); STAGE_A(SA(0, 0), 0, 0);
    STAGE_B(SB(0, 1), 1, 0); STAGE_A(SA(0, 1), 1, 0);
    if (wr == 1) BAR();
    WAIT_V(4); BAR();
    STAGE_B(SB(1, 0), 0, 1); STAGE_A(SA(1, 0), 0, 1); STAGE_B(SB(1, 1), 1, 1);
    WAIT_V(6); BAR();
    for (int t = 0; t < nt - 2; t += 2) {
        LDB(B0, 0, 0); SCHED(); LDA(At, 0, 0); STAGE_A(SA(1, 1), 1, t + 1);
        WAIT_L(8); BAR(); WAIT_L(0); MMA(0, 0, At, B0); BAR(); SCHED();
        LDB(B1, 0, 1); STAGE_B(SB(0, 0), 0, t + 2);
        BAR(); WAIT_L(0); MMA(0, 1, At, B1); BAR();
        LDA(At, 0, 1); STAGE_A(SA(0, 0), 0, t + 2);
        BAR(); WAIT_L(0); MMA(1, 0, At, B0); BAR(); SCHED();
        STAGE_B(SB(0, 1), 1, t + 2);
        WAIT_V(6); BAR(); MMA(1, 1, At, B1); BAR();
        LDB(B0, 1, 0); SCHED(); LDA(At, 1, 0); STAGE_A(SA(0, 1), 1, t + 2);
        WAIT_L(8); BAR(); WAIT_L(0); MMA(0, 0, At, B0); BAR(); SCHED();
        LDB(B1, 1, 1); STAGE_B(SB(1, 0), 0, t + 3);
        BAR(); WAIT_L(0); MMA(0, 1, At, B1); BAR();
        LDA(At, 1, 1); STAGE_A(SA(1, 0), 0, t + 3);
        BAR(); WAIT_L(0); MMA(1, 0, At, B0); BAR(); SCHED();
        STAGE_B(SB(1, 1), 1, t + 3);
        WAIT_V(6); BAR(); MMA(1, 1, At, B1); BAR();
    }
    OPAQUE(tid); wid = tid >> 6; lane = tid & 63; wr = wid >> 2; wc = wid & 3; fr = lane & 15; fq = lane >> 4;
    { LDB(B0, 0, 0); WAIT_V(0); LDA(At, 0, 0); STAGE_A(SA(1, 1), 1, nt - 1);
      BAR(); WAIT_L(0); MMA(0, 0, At, B0); BAR();
      LDB(B1, 0, 1); BAR(); WAIT_L(0); MMA(0, 1, At, B1); BAR();
      LDA(At, 0, 1); WAIT_V(4); BAR(); WAIT_L(0); MMA(1, 0, At, B0); MMA(1, 1, At, B1); BAR(); }
    { LDB(B0, 1, 0); LDA(At, 1, 0); WAIT_V(2); BAR(); WAIT_L(0); MMA(0, 0, At, B0); BAR();
      LDB(B1, 1, 1); WAIT_V(0); BAR(); WAIT_L(0); MMA(0, 1, At, B1); BAR();
      LDA(At, 1, 1); BAR(); WAIT_L(0); MMA(1, 0, At, B0); MMA(1, 1, At, B1); BAR(); }
    if (wr == 0) BAR();
#undef SA
#undef SB
#undef STAGE_A
#undef STAGE_B
#undef LDA
#undef LDB
#undef MMA
}
__device__ __forceinline__ void stage_geom(int tid, int (&R)[2], int (&C)[2]) {
#pragma unroll
    for (int i = 0; i < 2; ++i) stage_rc(tid * 16 + i * 8192, R[i], C[i]);
}

constexpr int ATT_KBUF = 0, ATT_VBUF = 32768, ATT_CBUF = 65536;
template <int KIND>
__device__ __forceinline__ void attn_unit(const bf16_t* Q, const bf16_t* Kg, const bf16_t* VT, const float* cum2, const float* kmx, int qb, bf16_t* concat, int ccol0,
                                          float lam, float osc, const float* subg, unsigned char* lds, int tid) {
    const int lane = tid & 63, wave = tid >> 6, r16 = lane & 15, q4 = lane >> 4;
    const int q0w = qb * 128 + wave * 16, myq = q0w + r16;
    const int ntiles = 2 * qb + 2;
    const int wlimit = (KIND == 0) ? ((q0w + 15) >> 6) : (q0w >> 6);
    constexpr int NMAP = (KIND == 0) ? 1 : 2, NKS = (KIND == 0) ? 4 : 2;
    bf16x8 qf[NMAP][NKS];
#pragma unroll
    for (int mp = 0; mp < NMAP; ++mp)
#pragma unroll
        for (int ks = 0; ks < NKS; ++ks) qf[mp][ks] = *(const bf16x8*)(Q + (size_t)myq * 128 + mp * 64 + ks * 32 + q4 * 8);
    const float cq = (KIND == 0) ? cum2[myq] : 0.f;
    int kt0 = 0;
    if (KIND == 0) {
        float* wmax = (float*)(lds + ATT_CBUF + 512); int* kst = (int*)(lds + ATT_CBUF + 576);
        float qs = 0.f;
#pragma unroll
        for (int ks = 0; ks < NKS; ++ks)
#pragma unroll
            for (int j = 0; j < 8; ++j) { const float v = bf2f((bf16_t)qf[0][ks][j]); qs += v * v; }
        qs = xrow16_sum(qs);
        qs = fmaxf(qs, SHX(qs, 1)); qs = fmaxf(qs, SHX(qs, 2)); qs = fmaxf(qs, SHX(qs, 4)); qs = fmaxf(qs, SHX(qs, 8));
        if (lane == 0) wmax[wave] = qs;
        if (tid == 0) *kst = 2 * qb;
        __syncthreads();
        float qm = wmax[0];
#pragma unroll
        for (int w = 1; w < 8; ++w) qm = fmaxf(qm, wmax[w]);
        qm = sqrtf(qm) * 1.01f;
        const float kd = sqrtf(fmaxf(kmx[2 * qb], kmx[2 * qb + 1])) * 1.01f;
        if (tid < 2 * qb) {
            const float bias = cum2[qb * 128] - cum2[tid * 64 + 63];
            const bool skip = bias + qm * (sqrtf(kmx[tid]) * 1.01f + kd) < -40.f;
            if (!skip) atomic_min_int(kst, tid);
        }
        __syncthreads();
        kt0 = RFL(*kst);
    }
    f32x4 ot[NMAP][8];
    float mrun[NMAP], lsum[NMAP];
#pragma unroll
    for (int mp = 0; mp < NMAP; ++mp) { mrun[mp] = -INFINITY; lsum[mp] = 0.f;
#pragma unroll
        for (int mo = 0; mo < 8; ++mo) ot[mp][mo] = (f32x4){0.f, 0.f, 0.f, 0.f}; }
    u32x4 sk[2], sv[2]; float sc = 0.f;
    const u32x4* kg = (const u32x4*)Kg; const u32x4* vg = (const u32x4*)VT;
#pragma unroll
    for (int i = 0; i < 2; ++i) { sk[i] = kg[(size_t)kt0 * 1024 + tid + i * 512]; sv[i] = vg[(size_t)kt0 * 1024 + tid + i * 512]; }
    if (KIND == 0 && tid < 64) sc = cum2[kt0 * 64 + tid];
    for (int kt = kt0; kt < ntiles; ++kt) {
        unsigned char* kb = lds + ATT_KBUF + (kt & 1) * 16384;
        unsigned char* vb = lds + ATT_VBUF + (kt & 1) * 16384;
        float* cb = (float*)(lds + ATT_CBUF + (kt & 1) * 256);
#pragma unroll
        for (int i = 0; i < 2; ++i) {
            const int g = tid + i * 512;
            { const int row = g >> 4, c = g & 15; *(u32x4*)(kb + row * 256 + ((c ^ (row & 15)) << 4)) = sk[i]; }
            { const int d = g >> 3, c = g & 7; *(u32x4*)(vb + d * 128 + ((c ^ ((d >> 1) & 7)) << 4)) = sv[i]; }
        }
        if (KIND == 0 && tid < 64) cb[tid] = sc;
        __syncthreads();
        if (kt + 1 < ntiles) {
#pragma unroll
            for (int i = 0; i < 2; ++i) { sk[i] = kg[(size_t)(kt + 1) * 1024 + tid + i * 512]; sv[i] = vg[(size_t)(kt + 1) * 1024 + tid + i * 512]; }
            if (KIND == 0 && tid < 64) sc = cum2[(kt + 1) * 64 + tid];
        }
        if (kt <= wlimit) {
#pragma unroll
            for (int mp = 0; mp < NMAP; ++mp) {
                bf16x8 kf[4][NKS], vfa[8];
#pragma unroll
                for (int m = 0; m < 4; ++m)
#pragma unroll
                    for (int ks = 0; ks < NKS; ++ks) { const int c = (KIND == 0 ? 0 : mp * 8) + ks * 4 + q4; kf[m][ks] = *(const bf16x8*)(kb + (m * 16 + r16) * 256 + ((c ^ r16) << 4)); }
#pragma unroll
                for (int mo = 0; mo < 8; ++mo) { const int d = mo * 16 + r16; vfa[mo] = *(const bf16x8*)(vb + d * 128 + (((0 * 4 + q4) ^ ((d >> 1) & 7)) << 4)); }
                SCHED();
                f32x4 st[4];
#pragma unroll
                for (int m = 0; m < 4; ++m) st[m] = (f32x4){0.f, 0.f, 0.f, 0.f};
#pragma unroll
                for (int ks = 0; ks < NKS; ++ks)
#pragma unroll
                    for (int m = 0; m < 4; ++m) st[m] = MFMA16(kf[m][ks], qf[mp][ks], st[m]);
                SCHED();
                float mx = -INFINITY;
#pragma unroll
                for (int m = 0; m < 4; ++m) {
                    if (KIND == 0) {
                        const f32x4 ck = *(const f32x4*)(cb + m * 16 + 4 * q4);
#pragma unroll
                        for (int j = 0; j < 4; ++j) {
                            float y = st[m][j] + (cq - ck[j]);
                            if (kt * 64 + m * 16 + 4 * q4 + j > myq) y = -INFINITY;
                            st[m][j] = y;
                        }
                    }
#pragma unroll
                    for (int j = 0; j < 4; ++j) mx = fmaxf(mx, st[m][j]);
                }
                mx = xrow16_max(mx);
                const float mnew = fmaxf(mrun[mp], mx);
                const float alpha = FAST_EXP2(mrun[mp] - mnew);
                mrun[mp] = mnew;
                float ps = 0.f;
#pragma unroll
                for (int m = 0; m < 4; ++m)
#pragma unroll
                    for (int j = 0; j < 4; ++j) { const float pv = FAST_EXP2(st[m][j] - mnew); st[m][j] = pv; ps += pv; }
                lsum[mp] = lsum[mp] * alpha + ps;
#pragma unroll
                for (int mo = 0; mo < 8; ++mo) ot[mp][mo] *= alpha;
                bf16x8 pf[2];
#pragma unroll
                for (int kk = 0; kk < 2; ++kk) {
                    u32x4 pw;
                    pw.x = pack2(st[2 * kk][0], st[2 * kk][1]); pw.y = pack2(st[2 * kk][2], st[2 * kk][3]);
                    pw.z = pack2(st[2 * kk + 1][0], st[2 * kk + 1][1]); pw.w = pack2(st[2 * kk + 1][2], st[2 * kk + 1][3]);
                    pf[kk] = __builtin_bit_cast(bf16x8, pw);
                }
                bf16x8 vfb[8];
#pragma unroll
                for (int mo = 0; mo < 8; ++mo) { const int d = mo * 16 + r16; vfb[mo] = *(const bf16x8*)(vb + d * 128 + (((1 * 4 + q4) ^ ((d >> 1) & 7)) << 4)); }
                SCHED();
#pragma unroll
                for (int mo = 0; mo < 8; ++mo) ot[mp][mo] = MFMA16(vfa[mo], pf[0], ot[mp][mo]);
                SCHED();
#pragma unroll
                for (int mo = 0; mo < 8; ++mo) ot[mp][mo] = MFMA16(vfb[mo], pf[1], ot[mp][mo]);
            }
        }
    }
    float inv[NMAP];
#pragma unroll
    for (int mp = 0; mp < NMAP; ++mp) { float l = lsum[mp]; l = xrow16_sum(l); inv[mp] = 1.f / l; }
    if (KIND == 0) {
#pragma unroll
        for (int mo = 0; mo < 8; ++mo) {
            u32x2 o; o.x = pack2(ot[0][mo][0] * inv[0], ot[0][mo][1] * inv[0]); o.y = pack2(ot[0][mo][2] * inv[0], ot[0][mo][3] * inv[0]);
            *(u32x2*)(concat + (size_t)myq * D + ccol0 + mo * 16 + 4 * q4) = o;
        }
    } else {
        float ss = 0.f;
#pragma unroll
        for (int mo = 0; mo < 8; ++mo)
#pragma unroll
            for (int j = 0; j < 4; ++j) { const float v = ot[0][mo][j] * inv[0] - lam * (ot[NMAP - 1][mo][j] * inv[NMAP - 1]); ot[0][mo][j] = v; ss += v * v; }
        ss = xrow16_sum(ss);
        const float rs = osc / sqrtf(ss * (1.f / 128.f) + LN_EPS);
#pragma unroll
        for (int mo = 0; mo < 8; ++mo) {
            const f32x4 g = *(const f32x4*)(subg + mo * 16 + 4 * q4);
            u32x2 o; o.x = pack2(ot[0][mo][0] * rs * g[0], ot[0][mo][1] * rs * g[1]); o.y = pack2(ot[0][mo][2] * rs * g[2], ot[0][mo][3] * rs * g[3]);
            *(u32x2*)(concat + (size_t)myq * D + ccol0 + mo * 16 + 4 * q4) = o;
        }
    }
    __syncthreads();
}

__device__ __forceinline__ int dpart_row(int c, int q) { return c * (S - DCH * 64) - (DCH * 32) * c * (c - 1) + q; }
__device__ __forceinline__ void attn_dmap_unit(const bf16_t* Qh, const bf16_t* Kh, const bf16_t* VTh, int mp, int qb, int t0, int t1,
                                               bf16_t* Op, float* ML, int c, float bnd, unsigned char* lds, int tid) {
    const bool fixedref = (bnd <= 60.f);
    const int lane = tid & 63, wave = tid >> 6, r16 = lane & 15, q4 = lane >> 4;
    const int q0w = qb * 256 + wave * 32;
    const int wlimit = q0w >> 6;
    bf16x8 qf[2][2];
#pragma unroll
    for (int n = 0; n < 2; ++n)
#pragma unroll
        for (int ks = 0; ks < 2; ++ks) qf[n][ks] = *(const bf16x8*)(Qh + (size_t)(q0w + n * 16 + r16) * 128 + mp * 64 + ks * 32 + q4 * 8);
    f32x4 ot[8][2];
    float mrun[2] = {-INFINITY, -INFINITY}, lsum[2] = {0.f, 0.f};
    if (fixedref) { mrun[0] = bnd; mrun[1] = bnd; }
    const float stinit = fixedref ? -bnd : 0.f;
#pragma unroll
    for (int mo = 0; mo < 8; ++mo) { ot[mo][0] = (f32x4){0.f, 0.f, 0.f, 0.f}; ot[mo][1] = (f32x4){0.f, 0.f, 0.f, 0.f}; }
    u32x4 sk, sv[2];
    const u32x4* kg = (const u32x4*)Kh; const u32x4* vg = (const u32x4*)VTh;
    const int krow = tid >> 3, kc8 = tid & 7;
    sk = kg[(size_t)t0 * 1024 + krow * 16 + mp * 8 + kc8];
#pragma unroll
    for (int i = 0; i < 2; ++i) sv[i] = vg[(size_t)t0 * 1024 + tid + i * 512];
    for (int kt = t0; kt < t1; ++kt) {
        unsigned char* kb = lds + (kt & 1) * 8192;
        unsigned char* vb = lds + 16384 + (kt & 1) * 16384;
        *(u32x4*)(kb + krow * 128 + ((kc8 ^ ((krow >> 1) & 7)) << 4)) = sk;
#pragma unroll
        for (int i = 0; i < 2; ++i) { const int g = tid + i * 512, d = g >> 3, cc = g & 7; *(u32x4*)(vb + d * 128 + ((cc ^ ((d >> 1) & 7)) << 4)) = sv[i]; }
        __syncthreads();
        if (kt + 1 < t1) {
            sk = kg[(size_t)(kt + 1) * 1024 + krow * 16 + mp * 8 + kc8];
#pragma unroll
            for (int i = 0; i < 2; ++i) sv[i] = vg[(size_t)(kt + 1) * 1024 + tid + i * 512];
        }
        if (kt <= wlimit) {
            bf16x8 kf[4][2], vfa[8];
#pragma unroll
            for (int m = 0; m < 4; ++m)
#pragma unroll
                for (int ks = 0; ks < 2; ++ks) kf[m][ks] = *(const bf16x8*)(kb + (m * 16 + r16) * 128 + (((ks * 4 + q4) ^ ((r16 >> 1) & 7)) << 4));
#pragma unroll
            for (int mo = 0; mo < 8; ++mo) { const int d = mo * 16 + r16; vfa[mo] = *(const bf16x8*)(vb + d * 128 + (((0 * 4 + q4) ^ ((d >> 1) & 7)) << 4)); }
            SCHED();
            f32x4 st[4][2];
#pragma unroll
            for (int m = 0; m < 4; ++m) { st[m][0] = (f32x4){stinit, stinit, stinit, stinit}; st[m][1] = (f32x4){stinit, stinit, stinit, stinit}; }
            SETPRIO(1);
#pragma unroll
            for (int ks = 0; ks < 2; ++ks)
#pragma unroll
                for (int m = 0; m < 4; ++m) { st[m][0] = MFMA16(kf[m][ks], qf[0][ks], st[m][0]); st[m][1] = MFMA16(kf[m][ks], qf[1][ks], st[m][1]); }
            SETPRIO(0);
            SCHED();
            float alpha[2] = {1.f, 1.f};
            if (fixedref) {
#pragma unroll
                for (int n = 0; n < 2; ++n) {
                    float ps = 0.f;
#pragma unroll
                    for (int m = 0; m < 4; ++m)
#pragma unroll
                        for (int j = 0; j < 4; ++j) { const float pv = FAST_EXP2(st[m][n][j]); st[m][n][j] = pv; ps += pv; }
                    lsum[n] += ps;
                }
            } else
#pragma unroll
            for (int n = 0; n < 2; ++n) {
                float mx = -INFINITY;
#pragma unroll
                for (int m = 0; m < 4; ++m)
#pragma unroll
                    for (int j = 0; j < 4; ++j) mx = fmaxf(mx, st[m][n][j]);
                mx = xrow16_max(mx);
                const float mnew = fmaxf(mrun[n], mx);
                alpha[n] = FAST_EXP2(mrun[n] - mnew);
                mrun[n] = mnew;
                float ps = 0.f;
#pragma unroll
                for (int m = 0; m < 4; ++m)
#pragma unroll
                    for (int j = 0; j < 4; ++j) { const float pv = FAST_EXP2(st[m][n][j] - mnew); st[m][n][j] = pv; ps += pv; }
                lsum[n] = lsum[n] * alpha[n] + ps;
            }
            if (ANY_LANE(alpha[0] != 1.f)) {
#pragma unroll
                for (int mo = 0; mo < 8; ++mo) ot[mo][0] *= alpha[0];
            }
            if (ANY_LANE(alpha[1] != 1.f)) {
#pragma unroll
                for (int mo = 0; mo < 8; ++mo) ot[mo][1] *= alpha[1];
            }
            bf16x8 pf[2][2];
#pragma unroll
            for (int kk = 0; kk < 2; ++kk)
#pragma unroll
                for (int n = 0; n < 2; ++n) {
                    u32x4 pw;
                    pw.x = pack2(st[2 * kk][n][0], st[2 * kk][n][1]); pw.y = pack2(st[2 * kk][n][2], st[2 * kk][n][3]);
                    pw.z = pack2(st[2 * kk + 1][n][0], st[2 * kk + 1][n][1]); pw.w = pack2(st[2 * kk + 1][n][2], st[2 * kk + 1][n][3]);
                    pf[kk][n] = __builtin_bit_cast(bf16x8, pw);
                }
            bf16x8 vfb[8];
#pragma unroll
            for (int mo = 0; mo < 8; ++mo) { const int d = mo * 16 + r16; vfb[mo] = *(const bf16x8*)(vb + d * 128 + (((1 * 4 + q4) ^ ((d >> 1) & 7)) << 4)); }
            SCHED();
            SETPRIO(1);
#pragma unroll
            for (int mo = 0; mo < 8; ++mo) { ot[mo][0] = MFMA16(vfa[mo], pf[0][0], ot[mo][0]); ot[mo][1] = MFMA16(vfa[mo], pf[0][1], ot[mo][1]); }
            SCHED();
#pragma unroll
            for (int mo = 0; mo < 8; ++mo) { ot[mo][0] = MFMA16(vfb[mo], pf[1][0], ot[mo][0]); ot[mo][1] = MFMA16(vfb[mo], pf[1][1], ot[mo][1]); }
            SETPRIO(0);
        }
    }
    if (q0w >= DCH * 64 * c)
#pragma unroll
    for (int n = 0; n < 2; ++n) {
        float l = lsum[n]; l = xrow16_sum(l);
        const int row = dpart_row(c, q0w + n * 16 + r16);
#pragma unroll
        for (int mo = 0; mo < 8; ++mo) {
            u32x2 o; o.x = pack2(ot[mo][n][0], ot[mo][n][1]); o.y = pack2(ot[mo][n][2], ot[mo][n][3]);
            *(u32x2*)(Op + (size_t)(row * 128 + mo * 16 + 4 * q4)) = o;
        }
        if (q4 == 0) { ML[row * 2] = mrun[n]; ML[row * 2 + 1] = l; }
    }
    __syncthreads();
}

__device__ __forceinline__ void lru_unit_a(int chunk, int grp, int l, const Params& p, const bf16_t* Xr, const bf16_t* WaiT, float* hloc, float* ploc, float* sumA, float* sumH,
                                           unsigned char* lds, int tid) {
    const int lane = tid & 63, wave = tid >> 6, r16 = lane & 15, q4 = lane >> 4;
    unsigned char* XCB = lds; float* XU = (float*)(lds + 16384); float* LA = (float*)(lds + 49152); float* ENDS = (float*)(lds + 81920);
    const int t0 = chunk * 64, ch0 = grp * 128;
    bf16x8 bfr[2][4];
#pragma unroll
    for (int g = 0; g < 2; ++g)
#pragma unroll
        for (int ks = 0; ks < 4; ++ks) bfr[g][ks] = *(const bf16x8*)(WaiT + ((size_t)grp * 256 + g * 128 + wave * 16 + r16) * 128 + ks * 32 + q4 * 8);
    const int chg = ch0 + wave * 16 + r16;
    const float ba = p.in[I_BA][(size_t)l * LRU_W + chg], bi = p.in[I_BI][(size_t)l * LRU_W + chg];
    const float lam_raw = p.in[I_LAM][(size_t)l * LRU_W + chg];
    {
        const int c = tid & 127, tq = tid >> 7, ch = ch0 + c;
        const float* cw = p.in[I_CONVW] + (size_t)l * 4 * LRU_W + ch; const float cb = p.in[I_CONVB][(size_t)l * LRU_W + ch];
        const float w0 = cw[0], w1 = cw[LRU_W], w2 = cw[2 * LRU_W], w3 = cw[3 * LRU_W];
        const int ts = t0 + tq * 16;
        float x0 = (ts - 3 >= 0) ? bf2f(Xr[(size_t)(ts - 3) * LRU_W + ch]) : 0.f;
        float x1 = (ts - 2 >= 0) ? bf2f(Xr[(size_t)(ts - 2) * LRU_W + ch]) : 0.f;
        float x2 = (ts - 1 >= 0) ? bf2f(Xr[(size_t)(ts - 1) * LRU_W + ch]) : 0.f;
#pragma unroll
        for (int i = 0; i < 16; ++i) {
            const float x3 = bf2f(Xr[(size_t)(ts + i) * LRU_W + ch]);
            const float v = cb + w0 * x0 + w1 * x1 + w2 * x2 + w3 * x3;
            const int row = tq * 16 + i;
            XU[row * 128 + c] = v;
            *(bf16_t*)(XCB + row * 256 + (((c >> 3) ^ (row & 15)) << 4) + (c & 7) * 2) = f2bf(v);
            x0 = x1; x1 = x2; x2 = x3;
        }
    }
    __syncthreads();
    {
        const float lsl = 8.0f * log_sigmoid_f(lam_raw);
#pragma unroll
        for (int mt = 0; mt < 4; ++mt) {
            f32x4 ga = (f32x4){0.f, 0.f, 0.f, 0.f}, gi = (f32x4){0.f, 0.f, 0.f, 0.f};
#pragma unroll
            for (int ks = 0; ks < 4; ++ks) {
                const bf16x8 af = *(const bf16x8*)(XCB + (mt * 16 + r16) * 256 + (((ks * 4 + q4) ^ r16) << 4));
                ga = MFMA16(af, bfr[0][ks], ga); gi = MFMA16(af, bfr[1][ks], gi);
            }
#pragma unroll
            for (int j = 0; j < 4; ++j) {
                const int row = mt * 16 + 4 * q4 + j, idx = row * 128 + wave * 16 + r16;
                const float r = sigmoid_f(ga[j] + ba), ig = sigmoid_f(gi[j] + bi);
                const float log_a = lsl * r;
                LA[idx] = fexp(log_a);
                XU[idx] = sqrtf(neg_expm1_f(2.f * log_a)) * (ig * XU[idx]);
            }
        }
    }
    __syncthreads();
    {
        const int c = tid & 127, tq = tid >> 7, ch = ch0 + c;
        float h = 0.f, P = 1.f;
#pragma unroll
        for (int i = 0; i < 16; ++i) { const int idx = (tq * 16 + i) * 128 + c; const float a = LA[idx]; h = a * h + XU[idx]; P *= a; XU[idx] = h; LA[idx] = P; }
        ENDS[tq * 128 + c] = P; ENDS[512 + tq * 128 + c] = h;
        __syncthreads();
        float cin = 0.f, pin = 1.f;
        for (int s = 0; s < tq; ++s) { const float Ps = ENDS[s * 128 + c], hs = ENDS[512 + s * 128 + c]; cin = Ps * cin + hs; pin *= Ps; }
#pragma unroll
        for (int i = 0; i < 16; ++i) {
            const int idx = (tq * 16 + i) * 128 + c; const size_t gi = (size_t)(t0 + tq * 16 + i) * LRU_W + ch;
            const float Pl = LA[idx], hl = XU[idx];
            ((unsigned*)hloc)[gi] = pack2(hl + Pl * cin, Pl * pin);
        }
        if (tq == 3) { const float Pl = LA[63 * 128 + c], hl = XU[63 * 128 + c]; sumA[(size_t)chunk * LRU_W + ch] = Pl * pin; sumH[(size_t)chunk * LRU_W + ch] = hl + Pl * cin; }
    }
    __syncthreads();
}

__device__ __forceinline__ void moe_prefix(const int* cntb_, int G, unsigned char* lds, int tid) {
    int* tmp = (int*)lds; int* ctot = (int*)(lds + LDS_MISC + M_CTOT); int* coff = (int*)(lds + LDS_MISC + M_COFF);
    unsigned short* pre16 = (unsigned short*)(lds + LDS_MISC + M_PRE16);
    const int e = tid & 31, part = tid >> 5, PB = (G + 15) / 16;
    int sm = 0;
    for (int i = 0; i < PB; ++i) { const int b = part * PB + i; if (b < G) sm += cntb_[b * 32 + e]; }
    tmp[part * 32 + e] = sm;
    __syncthreads();
    int run = 0;
    for (int q = 0; q < part; ++q) run += tmp[q * 32 + e];
    for (int i = 0; i < PB; ++i) { const int b = part * PB + i; if (b < G) { pre16[e * 257 + b] = (unsigned short)run; run += cntb_[b * 32 + e]; } }
    if (part == 15) { ctot[e] = run; pre16[e * 257 + G] = (unsigned short)run; }
    __syncthreads();
    if (tid == 0) { int o = 0; for (int q = 0; q < 32; ++q) { coff[q] = o; o += ctot[q]; } coff[32] = o; }
    __syncthreads();
}
__device__ __forceinline__ void moe_rowtable(const int* ltok_, const float* lw_, const int* lslot_, int e, int m0, int c_e, int G, int segcap, unsigned char* lds, int tid_in) {
    int tid = tid_in; OPAQUE(tid);
    const unsigned short* pre = (const unsigned short*)(lds + LDS_MISC + M_PRE16) + e * 257;
    int* rtok = (int*)(lds + LDS_MISC + M_RTOK); float* rw = (float*)(lds + LDS_MISC + M_RW); int* rslot = (int*)(lds + LDS_MISC + M_RSLOT);
    if (tid < 256) {
        const int g = m0 + tid;
        int tk = 0, sl = 0; float w = 0.f;
        if (g < c_e) {
            int lo = 0, hi = G;
            while (hi - lo > 1) { const int mid = (lo + hi) >> 1; if ((int)pre[mid] <= g) lo = mid; else hi = mid; }
            const int idx = (e * G + lo) * segcap + (g - (int)pre[lo]);
            tk = ltok_[idx]; w = lw_[idx]; sl = lslot_[idx];
        }
        rtok[tid] = tk; rw[tid] = w; rslot[tid] = sl;
    }
    __syncthreads();
}
#define kmax2 ((float*)(wsl + A_KMAX))
#define dpo ((bf16_t*)(wsl + A_DPO))
#define dpml ((float*)(wsl + A_DPML))
#define cntb ((int*)(wsl + A_CNTB))
#define WinT ((bf16_t*)(wsl + WB_WIN))
#define WoT ((bf16_t*)(wsl + WB_WO))
#define WguT ((bf16_t*)(wsl + WB_WGU))
#define WdT ((bf16_t*)(wsl + WB_WD))
#define WaiT ((bf16_t*)(wsl + WB_WAI))
#define Wfa ((float*)(wsl + WF_FA))
#define W36b ((bf16_t*)(wsl + WF_R36))
#define ropecs ((float*)(wsl + WF_ROPE))
#define xb ((bf16_t*)(wsl + A_XB))
#define hb ((float*)(wsl + A_HB))
#define logf_ ((float*)(wsl + A_LOGF))
#define cum2 ((float*)(wsl + A_CUM))
#define Qa ((bf16_t*)(wsl + A_QA))
#define Ka ((bf16_t*)(wsl + A_KA))
#define VaT ((bf16_t*)(wsl + A_VAT))
#define Xr ((bf16_t*)(wsl + A_XR))
#define Gr ((bf16_t*)(wsl + A_GR))
#define Qc ((bf16_t*)(wsl + A_QC))
#define Kc ((bf16_t*)(wsl + A_KC))
#define VcT ((bf16_t*)(wsl + A_VCT))
#define hloc ((float*)(wsl + A_HLOC))
#define ploc ((float*)(wsl + A_PLOC))
#define sumA ((float*)(wsl + A_SUMA))
#define sumH ((float*)(wsl + A_SUMH))
#define concat ((bf16_t*)(wsl + A_CONCAT))
#define y1 ((float*)(wsl + A_Y1))
#define h1 ((float*)(wsl + A_H1))
#define lnstat ((float*)(wsl + A_H1 + (size_t)32 * 1024 * 1024))
#define h1b ((bf16_t*)(wsl + A_H1B))
#define ltok ((int*)(wsl + A_LTOK))
#define lw ((float*)(wsl + A_LW))
#define lslot ((int*)(wsl + A_LSLOT))
#define act ((bf16_t*)(wsl + A_ACT))
#define contrib ((bf16_t*)(wsl + A_CONTRIB))
#ifndef EMU
__global__ void __launch_bounds__(NTHREADS, 2)
#else
void
#endif
fwd_kernel(Params p) {
    DYN_LDS(lds_raw);
    float* ldsf = (float*)lds_raw;
    const int bid = blockIdx.x, G = gridDim.x;
    const int gthreads = G * NTHREADS, gwaves = G * (NTHREADS / 64);
    const int wave_s = RFL((int)threadIdx.x >> 6);
#define PHASE_IDS() unsigned char* wsl = ws; OPAQUE_S(wsl); int tid = wave_s * 64 + LANE_ID(); OPAQUE(tid); const int lane = tid & 63, wave = tid >> 6, gtid = bid * NTHREADS + tid, gwave = bid * (NTHREADS / 64) + wave; (void)lane; (void)wave; (void)gtid; (void)gwave

    unsigned char* ws = p.ws;
    volatile LAS unsigned* bst = (volatile LAS unsigned*)(lds_raw + LDS_MISC);
    unsigned* ubox = (unsigned*)(lds_raw + LDS_MISC + 16);
    if (threadIdx.x == 0) { bst[0] = 0u; bst[1] = 0u; bst[2] = 0u; bst[3] = 0u; }
    __syncthreads();
    XcdBarrier bar = xcd_barrier_post((unsigned*)ws, bst);

    const int* positions = (const int*)p.in[I_POS];

    constexpr int NPH = 8;
    const int lo = p.lo, hi = p.hi;
#ifdef ONLY_PHASE
#define PH_SEL(c) ((c) == ONLY_PHASE)
#else
#define PH_SEL(c) 1
#endif
#define PH_IN(k) (lo <= (k) && (k) < hi)
#define PH_BAR(k) do { if ((k) + 1 < hi) xcd_barrier(bar, wave_s == 0 && LANE_ID() == 0); } while (0)

    if (PH_SEL(-1) && PH_IN(0)) for (int rep = 0; rep < PH_REPS(-1); ++rep) {
        PHASE_IDS();
        for (int l = 0; l < DEPTH; ++l) {
            convert_mats(p.in[I_WIN] + (size_t)l * D * N_IN, 0, 1, N_IN, D, N_IN, WinT + (size_t)l * N_INP * D, 0, RmWin{}, ldsf, tid, bid, G);
            for (int t = bid; t < (D / 64) * (D / 256); t += G)
                convert_tile_v4(p.in[I_WO] + (size_t)l * D * D, D, D, (t / (D / 256)) * 64, (t % (D / 256)) * 256, WoT + (size_t)l * D * D, RmIdent{}, ldsf, tid);
            convert_mats(p.in[I_WA] + (size_t)l * 6 * 128 * 128, (size_t)128 * 128, 6, 128, 128, 128, WaiT + (size_t)l * 6 * 256 * 128, (size_t)256 * 128, RmIdent{}, ldsf, tid, bid, G);
            convert_mats(p.in[I_WI] + (size_t)l * 6 * 128 * 128, (size_t)128 * 128, 6, 128, 128, 128, WaiT + (size_t)l * 6 * 256 * 128, (size_t)256 * 128, RmOff{128}, ldsf, tid, bid, G);
        }
        for (int i = gtid; i < DEPTH * 8 * D; i += gthreads) { const int k = i % D, h = (i / D) % 8, l = i / (8 * D);
            Wfa[i] = (h < 6) ? p.in[I_WIN][(size_t)l * D * N_IN + (size_t)k * N_IN + C_FA + h] : 0.f; }
        for (int i = gtid; i < DEPTH * 48 * D; i += gthreads) { const int k = i % D, o = (i / D) % 48, l = i / (48 * D);
            const float w = (o < 4) ? p.in[I_WGRP][((size_t)l * D + k) * 4 + o] : (o < 36 ? p.in[I_WRT][((size_t)l * D + k) * 32 + (o - 4)] : 0.f);
            const bf16_t hi = f2bf(w);
            W36b[((size_t)l * 2 + 0) * 48 * D + (size_t)o * D + k] = hi; W36b[((size_t)l * 2 + 1) * 48 * D + (size_t)o * D + k] = f2bf(w - bf2f(hi)); }
        for (int i = gtid; i < S * 8; i += gthreads) { const int d = i & 7, t = i >> 3; const float ang = (float)positions[t] * p.inv_freq[d];
            ropecs[t * 16 + d] = cosf(ang); ropecs[t * 16 + 8 + d] = sinf(ang); }
        __syncthreads();
        for (int i = tid; i < 6 * D; i += NTHREADS) { const int k = i % D, h = i / D; ldsf[i] = p.in[I_WIN][(size_t)k * N_IN + C_FA + h]; }
        __syncthreads();
        for (int t0 = gwave * 2; t0 < S; t0 += gwaves * 2) {
            f32x4 v[2][8];
#pragma unroll
            for (int tk = 0; tk < 2; ++tk)
#pragma unroll
                for (int j = 0; j < 8; ++j) v[tk][j] = *(const f32x4*)(p.in[I_X] + (size_t)(t0 + tk) * D + j * 256 + lane * 4);
#pragma unroll
            for (int tk = 0; tk < 2; ++tk) {
                const int t = t0 + tk;
                float fa[6] = {0.f, 0.f, 0.f, 0.f, 0.f, 0.f};
#pragma unroll
                for (int j = 0; j < 8; ++j) {
                    const int c = j * 256 + lane * 4;
                    u32x2 o; o.x = pack2(v[tk][j][0], v[tk][j][1]); o.y = pack2(v[tk][j][2], v[tk][j][3]);
                    *(u32x2*)(xb + (size_t)t * D + c) = o;
#pragma unroll
                    for (int h = 0; h < 6; ++h) { const f32x4 w = *(const f32x4*)(ldsf + h * D + c); fa[h] += v[tk][j][0] * w[0] + v[tk][j][1] * w[1] + v[tk][j][2] * w[2] + v[tk][j][3] * w[3]; }
                    COMPILER_FENCE();
                }
#pragma unroll
                for (int h = 0; h < 6; ++h) { const float sm = wave_sum(fa[h]); if (lane == 0) logf_[h * S + t] = log_sigmoid_f(sm + p.in[I_BF][h]); }
            }
        }
        PH_BAR(0);
    }

    for (int l = 0; l < DEPTH; ++l) {
        const int pb = 1 + l * NPH;
#define hin ((l == 0) ? p.in[I_X] : (const float*)hb)
#define hout ((l == DEPTH - 1) ? p.out : hb)
#define workctr ((int*)(wsl + CTL_WORK_OFF) + l * 64)

        if (PH_SEL(0) && PH_IN(pb + 0)) {
            PHASE_IDS();
            int bz = bid; OPAQUE_S(bz);
            if (bz == 0) {
                double* part = (double*)lds_raw;
                const int per = S / 64;
                double s = 0.0;
                if (wave < 6) { for (int i = 0; i < per; ++i) s += (double)logf_[wave * S + lane * per + i]; part[wave * 64 + lane] = s; }
                __syncthreads();
                if (wave < 6) {
                    double run = 0.0;
                    for (int j = 0; j < lane; ++j) run += part[wave * 64 + j];
                    for (int i = 0; i < per; ++i) { run += (double)logf_[wave * S + lane * per + i]; cum2[wave * S + lane * per + i] = (float)(run * (double)LOG2E); }
                }
                __syncthreads();
            }
            bool conv_more = (l == 0);
#define CONV_ONE() do { if (conv_more) { __syncthreads(); if (tid == 0) *ubox = (unsigned)atomic_add_int((int*)(wsl + CTL_WORK_OFF) + 62, 1); __syncthreads(); \
                const int cid_ = RFL((int)*ubox); if (cid_ < NCONV) moe_conv_chunk(p, cid_, WguT, WdT, ldsf, tid); else conv_more = false; } } while (0)
            unsigned* cls = (unsigned*)(wsl + CTL_CLS_OFF) + l * 256;
            if (bz == 0) { WAIT_VM0(); __syncthreads(); if (tid == 0) { FENCE_REL_AGENT(); WAIT_VM0(); (void)xb_add(&cls[192], 1u); } }
            const bf16_t* Bt = WinT + (size_t)l * N_INP * D;
            constexpr int ntm = S / 256;
            const unsigned nooff[2][2] = {{0u, 0u}, {0u, 0u}};
            for (int i = 0; i < (bid & 3); ++i) CONV_ONE();
            for (;;) {
                __syncthreads();
                if (tid == 0) *ubox = (unsigned)atomic_add_int(workctr + 9, 1);
                __syncthreads();
                int t = RFL((int)*ubox);
                if (t >= ntm * 21) break;
                int pm, pn, kcls;
                if (t < ntm * 6) { pm = t / 6; pn = 15 + t % 6; kcls = 0; }
                else if (t < ntm * 12) { t -= ntm * 6; pm = t / 6; pn = 9 + t % 6; kcls = 1; }
                else { t -= ntm * 12; pm = t / 9; pn = t % 9; kcls = 2; }
                f32x4 acc[2][2][4][2];
                gemm_tile<false>(xb, pm * 256, nooff, Bt, pn * 256, D, lds_raw, acc, tid);
                int et = tid; OPAQUE(et); const int wr = et >> 8, wc = (et >> 6) & 3, fr = et & 15, fq = (et >> 4) & 3;
                if (pn < 6 || (pn >= 9 && pn < 19)) {
                    bf16_t* dst; float scale = 1.f; bool rope = false;
                    if (pn < 3) { dst = Qa; scale = QSCALE_A; } else if (pn < 6) { dst = Ka; } else if (pn < 12) { dst = Xr; } else if (pn < 15) { dst = Gr; }
                    else if (pn < 17) { dst = Qc; scale = QSCALE_C; rope = true; } else { dst = Kc; rope = true; }
                    const bool headmajor = (pn < 6) || (pn >= 15);
                    const int segpn = (pn < 3) ? pn : (pn < 6) ? pn - 3 : (pn < 12) ? pn - 9 : (pn < 15) ? pn - 12 : (pn < 17) ? pn - 15 : pn - 17;
#pragma unroll
                    for (int ai = 0; ai < 2; ++ai)
#pragma unroll
                        for (int m = 0; m < 4; ++m)
#pragma unroll
                            for (int bj = 0; bj < 2; ++bj)
#pragma unroll
                                for (int n = 0; n < 2; ++n) {
                                    const int dd = wc * 32 + n * 16 + fr;
#pragma unroll
                                    for (int j = 0; j < 4; ++j) {
                                        const int row = pm * 256 + ai * 128 + wr * 64 + m * 16 + fq * 4 + j;
                                        float v = acc[ai][bj][m][n][j];
                                        if (rope && n == 0 && (wc & 1) == 0) {
                                            const float pv = SHX(v, 8);
                                            const float cs = ropecs[row * 16 + (fr & 7)], sn = ropecs[row * 16 + 8 + (fr & 7)];
                                            v = (fr < 8) ? (v * cs - pv * sn) : (v * cs + pv * sn);
                                        }
                                        v *= scale;
                                        *(bf16_t*)(lds_raw + (ai * 128 + wr * 64 + m * 16 + fq * 4 + j) * 528 + (bj * 128 + dd) * 2) = f2bf(v);
                                    }
                                }
                    __syncthreads();
#pragma unroll 4
                    for (int i = 0; i < 16; ++i) {
                        const int idx = et + i * 512, lrow = idx >> 5, ch = idx & 31, row = pm * 256 + lrow;
                        const u32x4 val = *(const u32x4*)(lds_raw + lrow * 528 + ch * 16);
                        size_t gi;
                        if (headmajor) gi = ((size_t)(segpn * 2 + (ch >> 4)) * S + row) * 128 + (ch & 15) * 8;
                        else gi = (size_t)row * LRU_W + segpn * 256 + ch * 8;
                        *(u32x4*)(dst + gi) = val;
                    }
                    __syncthreads();
                    if (pn >= 15) {
                        float* part = ldsf;
#pragma unroll
                        for (int ai = 0; ai < 2; ++ai)
#pragma unroll
                            for (int m = 0; m < 4; ++m)
#pragma unroll
                                for (int bj = 0; bj < 2; ++bj)
#pragma unroll
                                    for (int j = 0; j < 4; ++j) {
                                        float ss = acc[ai][bj][m][0][j] * acc[ai][bj][m][0][j] + acc[ai][bj][m][1][j] * acc[ai][bj][m][1][j];
                                        ss += SHX(ss, 1); ss += SHX(ss, 2); ss += SHX(ss, 4); ss += SHX(ss, 8);
                                        if (fr == 0) part[(wc * 2 + bj) * 256 + ai * 128 + wr * 64 + m * 16 + fq * 4 + j] = ss;
                                    }
                        __syncthreads();
                        {
                            const int bj = et >> 8, row = et & 255;
                            float v0 = part[(0 * 2 + bj) * 256 + row] + part[(1 * 2 + bj) * 256 + row], v1 = part[(2 * 2 + bj) * 256 + row] + part[(3 * 2 + bj) * 256 + row];
                            v0 = fmaxf(v0, SHX(v0, 1)); v0 = fmaxf(v0, SHX(v0, 2)); v0 = fmaxf(v0, SHX(v0, 4)); v0 = fmaxf(v0, SHX(v0, 8)); v0 = xrow16_max(v0);
                            v1 = fmaxf(v1, SHX(v1, 1)); v1 = fmaxf(v1, SHX(v1, 2)); v1 = fmaxf(v1, SHX(v1, 4)); v1 = fmaxf(v1, SHX(v1, 8)); v1 = xrow16_max(v1);
                            if ((et & 63) == 0) {
                                unsigned* q2p = (unsigned*)(wsl + CTL_QK2_OFF) + l * 16 + (pn >= 17 ? 8 : 0) + (segpn * 2 + bj) * 2;
                                atomic_max_u32(q2p, __builtin_bit_cast(unsigned, v0)); atomic_max_u32(q2p + 1, __builtin_bit_cast(unsigned, v1));
                            }
                        }
                        __syncthreads();
                    }
                    if (pn >= 3 && pn < 6) {
                        float* part = ldsf;
#pragma unroll
                        for (int ai = 0; ai < 2; ++ai)
#pragma unroll
                            for (int m = 0; m < 4; ++m)
#pragma unroll
                                for (int bj = 0; bj < 2; ++bj)
#pragma unroll
                                    for (int j = 0; j < 4; ++j) {
                                        float ss = acc[ai][bj][m][0][j] * acc[ai][bj][m][0][j] + acc[ai][bj][m][1][j] * acc[ai][bj][m][1][j];
                                        ss += SHX(ss, 1); ss += SHX(ss, 2); ss += SHX(ss, 4); ss += SHX(ss, 8);
                                        if (fr == 0) part[(wc * 2 + bj) * 256 + ai * 128 + wr * 64 + m * 16 + fq * 4 + j] = ss;
                                    }
                        __syncthreads();
                        {
                            const int bj = et >> 8, row = et & 255;
                            float v = part[(0 * 2 + bj) * 256 + row] + part[(1 * 2 + bj) * 256 + row] + part[(2 * 2 + bj) * 256 + row] + part[(3 * 2 + bj) * 256 + row];
                            v = fmaxf(v, SHX(v, 1)); v = fmaxf(v, SHX(v, 2)); v = fmaxf(v, SHX(v, 4)); v = fmaxf(v, SHX(v, 8)); v = xrow16_max(v);
                            if ((et & 63) == 0) kmax2[((pn - 3) * 2 + bj) * NKT + pm * 4 + ((et >> 6) & 3)] = v;
                        }
                        __syncthreads();
                    }
                } else {
                    bf16_t* dst = (pn < 9) ? VaT : VcT;
                    const int segpn = (pn < 9) ? pn - 6 : pn - 19;
#pragma unroll
                    for (int ai = 0; ai < 2; ++ai)
#pragma unroll
                        for (int m = 0; m < 4; ++m)
#pragma unroll
                            for (int bj = 0; bj < 2; ++bj)
#pragma unroll
                                for (int n = 0; n < 2; ++n) {
                                    const int dd = wc * 32 + n * 16 + fr;
                                    const int row = pm * 256 + ai * 128 + wr * 64 + m * 16 + fq * 4;
                                    const f32x4 a = acc[ai][bj][m][n];
                                    u32x2 o; o.x = pack2(a[0], a[1]); o.y = pack2(a[2], a[3]);
                                    const int s6 = row & 63, pos = (s6 & 32) + ((s6 >> 2) & 3) * 8 + ((s6 >> 4) & 1) * 4;
                                    *(u32x2*)(dst + (((size_t)(segpn * 2 + bj) * NKT + (row >> 6)) * 128 + dd) * 64 + pos) = o;
                                }
                }
                WAIT_VM0();
                __syncthreads();
                if (et == 0) { FENCE_REL_AGENT(); WAIT_VM0(); (void)xb_add(&cls[kcls * 64], 1u); }
                CONV_ONE();
            }
        }

        if (PH_SEL(1) && PH_IN(pb + 1)) {
            PHASE_IDS();
            const float lam_init = (l == 0) ? 0.2f : 0.35550906759f;
            const float s1 = wave_sum(p.in[I_LQ1][l * 64 + lane] * p.in[I_LK1][l * 64 + lane]);
            const float s2 = wave_sum(p.in[I_LQ2][l * 64 + lane] * p.in[I_LK2][l * 64 + lane]);
            const float lam = fexp(s1) - fexp(s2) + lam_init;
            constexpr int NLRU = NKT * 6, NQB = S / 128;
            bool conv_more = (l == 0);
            unsigned* cls = (unsigned*)(wsl + CTL_CLS_OFF) + l * 256;
            unsigned* bw = (unsigned*)wsl;
#define WAIT_CLASS(k, n) do { __syncthreads(); if (tid == 0) { XB_SPIN(xb_ld(&cls[(k) * 64]) < (unsigned)(n), bw); FENCE_ACQ_AGENT(); WAIT_VM0(); } __syncthreads(); } while (0)
#ifndef NO_DIFF
            {
                constexpr int NQB2 = S / 256;
                int total = 0;
                for (int q = 0; q < NQB2; ++q) total += ((4 * q + 4 + DCH - 1) / DCH) * 8;
                WAIT_CLASS(0, (S / 256) * 6);
                for (;;) {
                    __syncthreads();
                    if (tid == 0) *ubox = (unsigned)atomic_add_int(workctr, 1);
                    __syncthreads();
                    int u = RFL((int)*ubox);
                    if (u >= total) break;
                    int qb = NQB2 - 1;
                    for (;; --qb) { const int nu = ((4 * qb + 4 + DCH - 1) / DCH) * 8; if (u < nu) break; u -= nu; }
                    const int c = u >> 3, h = (u >> 1) & 3, mp = u & 1;
                    const int t0 = c * DCH, t1 = (t0 + DCH < 4 * qb + 4) ? t0 + DCH : 4 * qb + 4;
                    const unsigned* q2p = (const unsigned*)(wsl + CTL_QK2_OFF) + l * 16;
                    const float bnd = sqrtf(__builtin_bit_cast(float, q2p[h * 2 + mp]) * __builtin_bit_cast(float, q2p[8 + h * 2 + mp])) * (QSCALE_C * 1.02f) + 0.01f;
                    attn_dmap_unit(Qc + (size_t)h * S * 128, Kc + (size_t)h * S * 128, VcT + (size_t)h * S * 128, mp, qb, t0, t1,
                                   dpo + (size_t)(h * 2 + mp) * DPART_ROWS * 128, dpml + (size_t)(h * 2 + mp) * DPART_ROWS * 2, c, RFL_F(bnd), lds_raw, tid);
                    CONV_ONE();
                }
            }
#endif
#ifndef NO_LRU
            WAIT_CLASS(1, (S / 256) * 6);
            for (;;) {
                __syncthreads();
                if (tid == 0) *ubox = (unsigned)atomic_add_int(workctr + 10, 1);
                __syncthreads();
                const int u = RFL((int)*ubox);
                if (u >= NLRU) break;
                lru_unit_a(u / 6, u % 6, l, p, Xr, WaiT + (size_t)l * 6 * 256 * 128, hloc, ploc, sumA, sumH, lds_raw, tid);
            }
#endif
#ifndef NO_FOX
            WAIT_CLASS(2, (S / 256) * 9);
            WAIT_CLASS(3, 1);
            for (;;) {
                __syncthreads();
                if (tid == 0) *ubox = (unsigned)atomic_add_int(workctr + 1, 1);
                __syncthreads();
                const int u = RFL((int)*ubox);
                if (u >= NQB * FOX_H) break;
                const int qb = NQB - 1 - u / FOX_H, h = u % FOX_H;
                attn_unit<0>(Qa + (size_t)h * S * 128, Ka + (size_t)h * S * 128, VaT + (size_t)h * S * 128, cum2 + (size_t)h * S, kmax2 + h * NKT, qb, concat, h * 128,
                             0.f, 0.f, nullptr, lds_raw, tid);
            }
#endif
            while (conv_more) CONV_ONE();
            PH_BAR(pb + 1);
        }

        if (PH_SEL(2) && PH_IN(pb + 2)) for (int rep = 0; rep < PH_REPS(2); ++rep) {
            PHASE_IDS();
            for (int u = bid; u < NKT * 6; u += G) {
                const int chunk = u / 6, grp = u % 6, c = tid & 127, tq = tid >> 7, ch = grp * 128 + c;
                float cr = 0.f;
                {
                    int j = 0;
                    for (; j + 16 <= chunk; j += 16) {
                        float a8[16], h8[16];
#pragma unroll
                        for (int q = 0; q < 16; ++q) { a8[q] = sumA[(size_t)(j + q) * LRU_W + ch]; h8[q] = sumH[(size_t)(j + q) * LRU_W + ch]; }
#pragma unroll
                        for (int q = 0; q < 16; ++q) cr = a8[q] * cr + h8[q];
                    }
                    for (; j < chunk; ++j) cr = sumA[(size_t)j * LRU_W + ch] * cr + sumH[(size_t)j * LRU_W + ch];
                }
                float hl[16], pl[16]; bf16_t gg[16];
#pragma unroll
                for (int i = 0; i < 16; ++i) { const size_t gi = (size_t)(chunk * 64 + tq * 16 + i) * LRU_W + ch; const unsigned hp = ((const unsigned*)hloc)[gi]; hl[i] = bf2f((bf16_t)(hp & 0xffffu)); pl[i] = bf2f((bf16_t)(hp >> 16)); gg[i] = Gr[gi]; }
#pragma unroll
                for (int i = 0; i < 16; ++i)
                    concat[(size_t)(chunk * 64 + tq * 16 + i) * D + FOX_W + ch] = f2bf(gelu_tanh_f(bf2f(gg[i])) * (hl[i] + pl[i] * cr));
            }
            {
                const float lam_init = (l == 0) ? 0.2f : 0.35550906759f;
                const float s1 = wave_sum(p.in[I_LQ1][l * 64 + lane] * p.in[I_LK1][l * 64 + lane]);
                const float s2 = wave_sum(p.in[I_LQ2][l * 64 + lane] * p.in[I_LK2][l * 64 + lane]);
                const float lam = fexp(s1) - fexp(s2) + lam_init;
                const float* sg = p.in[I_SUBG] + l * 128;
                const float g0 = sg[2 * lane], g1 = sg[2 * lane + 1];
                static_assert(NCH <= 8, "the merge below keeps one (map, chunk) pair per lane: 2 x 8 lanes");
                for (int q = gwave; q < S; q += gwaves) {
                    const int nch = (q >> 6) / DCH + 1;
                    float mv = -INFINITY, lv = 0.f;
                    { const int c = lane & 7, hm = lane >> 3;
                      if (c < nch) { const float* ML = dpml + ((size_t)hm * DPART_ROWS + dpart_row(c, q)) * 2; mv = ML[0]; lv = ML[1]; } }
                    unsigned pk[4][2][NCH];
#pragma unroll
                    for (int h = 0; h < 4; ++h)
#pragma unroll
                        for (int mp = 0; mp < 2; ++mp) {
                            const unsigned* OP = (const unsigned*)(dpo + (size_t)(h * 2 + mp) * DPART_ROWS * 128);
#pragma unroll
                            for (int c = 0; c < NCH; ++c) pk[h][mp][c] = (c < nch) ? OP[(size_t)dpart_row(c, q) * 64 + lane] : 0u;
                        }
                    float Mx = mv; Mx = fmaxf(Mx, DPP_X1(Mx)); Mx = fmaxf(Mx, DPP_X2(Mx)); Mx = fmaxf(Mx, DPP_X7(Mx));
                    const float wv = (mv == -INFINITY) ? 0.f : FAST_EXP2(mv - Mx);
                    float Lp = lv * wv; Lp += DPP_X1(Lp); Lp += DPP_X2(Lp); Lp += DPP_X7(Lp);
#pragma unroll
                    for (int h = 0; h < 4; ++h) {
                        float om[2][2];
#pragma unroll
                        for (int mp = 0; mp < 2; ++mp) {
                            float o0 = 0.f, o1 = 0.f;
#pragma unroll
                            for (int c = 0; c < NCH; ++c) { const float w = RDLANE(wv, (h * 2 + mp) * 8 + c); o0 += bf2f((bf16_t)(pk[h][mp][c] & 0xffffu)) * w; o1 += bf2f((bf16_t)(pk[h][mp][c] >> 16)) * w; }
                            const float il = 1.f / RDLANE(Lp, (h * 2 + mp) * 8);
                            om[mp][0] = o0 * il; om[mp][1] = o1 * il;
                        }
                        const float v0 = om[0][0] - lam * om[1][0], v1 = om[0][1] - lam * om[1][1];
                        const float ss = wave_sum(v0 * v0 + v1 * v1);
                        const float rs = (1.f - lam_init) / sqrtf(ss * (1.f / 128.f) + LN_EPS);
                        *(unsigned*)(concat + (size_t)q * D + 1536 + h * 128 + 2 * lane) = pack2(v0 * rs * g0, v1 * rs * g1);
                    }
                }
            }
            PH_BAR(pb + 2);
        }

        if (PH_SEL(3) && PH_IN(pb + 3)) for (int rep = 0; rep < PH_REPS(3); ++rep) {
            PHASE_IDS();
            const bf16_t* Bt = WoT + (size_t)l * D * D;
            constexpr int ntn = D / 256, ntm = S / 256;
            const unsigned nooff[2][2] = {{0u, 0u}, {0u, 0u}};
            for (int t0 = bid; t0 < ntm * ntn; t0 += G) {
                int t = t0;
                if (G == 256 && ntm * ntn == 256) { const int x = t0 & 7, j = t0 >> 3; t = (x * 4 + (j >> 3)) * ntn + (j & 7); }
                const int pm = t / ntn, pn = t % ntn;
                f32x4 acc[2][2][4][2];
                gemm_tile<false>(concat, pm * 256, nooff, Bt, pn * 256, D, lds_raw, acc, tid);
                int et = tid; OPAQUE(et); const int wr = et >> 8, wc = (et >> 6) & 3, fr = et & 15, fq = (et >> 4) & 3;
#pragma unroll
                for (int ai = 0; ai < 2; ++ai) {
#pragma unroll
                    for (int m = 0; m < 4; ++m)
#pragma unroll
                        for (int bj = 0; bj < 2; ++bj)
#pragma unroll
                            for (int n = 0; n < 2; ++n)
#pragma unroll
                                for (int j = 0; j < 4; ++j)
                                    *(float*)(lds_raw + (wr * 64 + m * 16 + fq * 4 + j) * 1040 + (bj * 128 + wc * 32 + n * 16 + fr) * 4) = acc[ai][bj][m][n][j];
                    __syncthreads();
#pragma unroll 4
                    for (int i = 0; i < 16; ++i) {
                        const int idx = et + i * 512, lrow = idx >> 6, c4 = idx & 63;
                        const size_t gi = (size_t)(pm * 256 + ai * 128 + lrow) * D + pn * 256 + c4 * 4;
                        const f32x4 v = *(const f32x4*)(lds_raw + lrow * 1040 + c4 * 16);
                        *(f32x4*)(y1 + gi) = ALPHA * *(const f32x4*)(hin + gi) + v;
                    }
                    __syncthreads();
                }
            }
            PH_BAR(pb + 3);
        }

        if (PH_SEL(4) && PH_IN(pb + 4)) for (int rep = 0; rep < PH_REPS(4); ++rep) {
            PHASE_IDS();
            const float* g1 = p.in[I_LN1G] + (size_t)l * D; const float* b1 = p.in[I_LN1B] + (size_t)l * D;
            const float* bg = p.in[I_BGRP] + l * 4; const float* br = p.in[I_BRT] + l * 32;
            const bf16_t* Wb = W36b + (size_t)l * 2 * 48 * D;
            int* lcnt = (int*)(lds_raw + LDS_MISC + M_LCNT);
            const int segcap = ((S / 16 + G - 1) / G) * 16;
            const int r16 = lane & 15, q4 = lane >> 4;
            if (tid < 32) lcnt[tid] = 0;
            f32x4 gq[8], bq[8];
#pragma unroll
            for (int j = 0; j < 8; ++j) { gq[j] = *(const f32x4*)(g1 + j * 256 + lane * 4); bq[j] = *(const f32x4*)(b1 + j * 256 + lane * 4); }
            __syncthreads();
            for (int bi = bid; bi < S / 16; bi += G) {
                f32x4 v2[2][8];
#pragma unroll
                for (int tk = 0; tk < 2; ++tk)
#pragma unroll
                    for (int j = 0; j < 8; ++j) v2[tk][j] = *(const f32x4*)(y1 + (size_t)(bi * 16 + wave * 2 + tk) * D + j * 256 + lane * 4);
#pragma unroll
                for (int tk = 0; tk < 2; ++tk) {
                    const int r = wave * 2 + tk, t = bi * 16 + r;
                    float s = 0.f;
#pragma unroll
                    for (int j = 0; j < 8; ++j) s += (v2[tk][j][0] + v2[tk][j][1]) + (v2[tk][j][2] + v2[tk][j][3]);
                    const float mean = wave_sum(s) * (1.f / D);
                    float s2 = 0.f;
#pragma unroll
                    for (int j = 0; j < 8; ++j) { v2[tk][j] -= mean; s2 += (v2[tk][j][0] * v2[tk][j][0] + v2[tk][j][1] * v2[tk][j][1]) + (v2[tk][j][2] * v2[tk][j][2] + v2[tk][j][3] * v2[tk][j][3]); }
                    const float rstd = 1.f / sqrtf(wave_sum(s2) * (1.f / D) + LN_EPS);
                    if (lane == 0) { lnstat[2 * t] = mean; lnstat[2 * t + 1] = rstd; }
#pragma unroll
                    for (int j = 0; j < 8; ++j) {
                        const int c = j * 256 + lane * 4;
                        const f32x4 hv = v2[tk][j] * rstd * gq[j] + bq[j];
                        u32x2 o; o.x = pack2(hv[0], hv[1]); o.y = pack2(hv[2], hv[3]);
                        *(u32x2*)(h1b + (size_t)t * D + c) = o;
                        u32x2 lo2;
                        lo2.x = pack2(hv[0] - bf2f((bf16_t)(o.x & 0xffffu)), hv[1] - bf2f((bf16_t)(o.x >> 16)));
                        lo2.y = pack2(hv[2] - bf2f((bf16_t)(o.y & 0xffffu)), hv[3] - bf2f((bf16_t)(o.y >> 16)));
                        const int la = r * 4096 + (((j * 32 + (lane >> 1)) ^ r) << 4) + (lane & 1) * 8;
                        *(u32x2*)(lds_raw + la) = o; *(u32x2*)(lds_raw + 65536 + la) = lo2;
                    }
                }
                __syncthreads();
                f32x4 ac[3];
#pragma unroll
                for (int nt = 0; nt < 3; ++nt) ac[nt] = (f32x4){0.f, 0.f, 0.f, 0.f};
#pragma unroll 4
                for (int ks = 0; ks < 8; ++ks) {
                    const int kk = wave * 8 + ks;
                    const int la = r16 * 4096 + (((kk * 4 + q4) ^ r16) << 4);
                    const bf16x8 ah = *(const bf16x8*)(lds_raw + la), al = *(const bf16x8*)(lds_raw + 65536 + la);
#pragma unroll
                    for (int nt = 0; nt < 3; ++nt) {
                        const bf16x8 bh = *(const bf16x8*)(Wb + (size_t)(nt * 16 + r16) * D + kk * 32 + q4 * 8);
                        const bf16x8 bl = *(const bf16x8*)(Wb + (size_t)48 * D + (size_t)(nt * 16 + r16) * D + kk * 32 + q4 * 8);
                        ac[nt] = MFMA16(ah, bh, ac[nt]); ac[nt] = MFMA16(al, bh, ac[nt]); ac[nt] = MFMA16(ah, bl, ac[nt]);
                    }
                }
                __syncthreads();
                float* red = ldsf;
#pragma unroll
                for (int nt = 0; nt < 3; ++nt)
#pragma unroll
                    for (int j = 0; j < 4; ++j) red[(wave * 16 + q4 * 4 + j) * 48 + nt * 16 + r16] = ac[nt][j];
                __syncthreads();
                float* lgt = ldsf + 8 * 16 * 48;
                if (tid < 256) {
                    const int tkn = tid >> 4, o3 = (tid & 15) * 3;
#pragma unroll
                    for (int q = 0; q < 3; ++q) { float a = 0.f;
#pragma unroll
                        for (int w = 0; w < 8; ++w) a += red[(w * 16 + tkn) * 48 + o3 + q];
                        lgt[tkn * 48 + o3 + q] = a; }
                }
                __syncthreads();
                if (tid < 16) {
                    const int t = bi * 16 + tid; const float* L = lgt + tid * 48;
                    float gl[4];
#pragma unroll
                    for (int q = 0; q < 4; ++q) gl[q] = L[q] + bg[q];
                    int gi = 0; float gm = gl[0];
#pragma unroll
                    for (int q = 1; q < 4; ++q) if (gl[q] > gm) { gm = gl[q]; gi = q; }
                    float gs = 0.f;
#pragma unroll
                    for (int q = 0; q < 4; ++q) gs += fexp(gl[q] - gm);
                    const float gweight = 1.f / gs;
                    float E[8];
#pragma unroll
                    for (int e = 0; e < 8; ++e) E[e] = L[4 + gi * 8 + e] + br[gi * 8 + e];
                    int e1 = 0; float m1 = E[0];
#pragma unroll
                    for (int e = 1; e < 8; ++e) if (E[e] > m1) { m1 = E[e]; e1 = e; }
                    int e2 = -1; float m2 = -INFINITY;
#pragma unroll
                    for (int e = 0; e < 8; ++e) if (e != e1 && E[e] > m2) { m2 = E[e]; e2 = e; }
                    const float p2 = fexp(m2 - m1), w1 = 1.f / (1.f + p2), w2 = p2 / (1.f + p2);
                    const int ge1 = gi * 8 + e1, ge2 = gi * 8 + e2;
                    const int i1 = (ge1 * G + bid) * segcap + atomic_add_int(&lcnt[ge1], 1);
                    ltok[i1] = t; lw[i1] = gweight * w1; lslot[i1] = 0;
                    const int i2 = (ge2 * G + bid) * segcap + atomic_add_int(&lcnt[ge2], 1);
                    ltok[i2] = t; lw[i2] = gweight * w2; lslot[i2] = 1;
                }
                __syncthreads();
            }
            if (tid < 32) cntb[bid * 32 + tid] = lcnt[tid];
            PH_BAR(pb + 4);
        }

        if (PH_SEL(5) && PH_IN(pb + 5)) {
            PHASE_IDS();
            const unsigned nooff[2][2] = {{0u, 0u}, {0u, 0u}};
            const int segcap = ((S / 16 + G - 1) / G) * 16;
            moe_prefix(cntb, G, lds_raw, tid);
            const int* ctot = (const int*)(lds_raw + LDS_MISC + M_CTOT); const int* coff = (const int*)(lds_raw + LDS_MISC + M_COFF);
            const int* rtok = (const int*)(lds_raw + LDS_MISC + M_RTOK); const float* rw = (const float*)(lds_raw + LDS_MISC + M_RW);
            const int* rslot = (const int*)(lds_raw + LDS_MISC + M_RSLOT);
            unsigned* done = (unsigned*)(wsl + CTL_DONE_OFF) + l * 1024;
            int nmt = 0;
            for (int e = 0; e < NEXP; ++e) nmt += (ctot[e] + 255) / 256;
            nmt = RFL(nmt);
            for (;;) {
                __syncthreads();
                if (tid == 0) *ubox = (unsigned)atomic_add_int(workctr + 8, 1);
                __syncthreads();
                int u = RFL((int)*ubox);
                if (u >= nmt * 12) break;
                const bool down = (u >= nmt * 4);
                const int per = down ? 8 : 4;
                if (down) u -= nmt * 4;
                int e = 0;
                for (;; ++e) { const int nt = ((RFL(ctot[e]) + 255) / 256) * per; if (u < nt) break; u -= nt; }
                const int c = RFL(ctot[e]), off = RFL(coff[e]);
                const int mt = u / per, pn = u % per, m0 = mt * 256;
                moe_rowtable(ltok, lw, lslot, e, m0, c, G, segcap, lds_raw, tid);
                f32x4 acc[2][2][4][2];
                if (!down) {
                    const bf16_t* Bt = WguT + ((size_t)l * NEXP + e) * 1024 * D;
                    unsigned aoff[2][2];
                    int st = tid; OPAQUE(st); int R[2], C[2]; stage_geom(st, R, C);
#pragma unroll
                    for (int h = 0; h < 2; ++h)
#pragma unroll
                        for (int i = 0; i < 2; ++i) aoff[h][i] = (unsigned)(rtok[h * 128 + R[i]] * D + C[i]);
                    gemm_tile<true>(h1b, 0, aoff, Bt, pn * 256, D, lds_raw, acc, tid);
                    int et = tid; OPAQUE(et); const int wr = et >> 8, wc = (et >> 6) & 3, fr = et & 15, fq = (et >> 4) & 3;
#pragma unroll
                    for (int ai = 0; ai < 2; ++ai)
#pragma unroll
                        for (int m = 0; m < 4; ++m)
#pragma unroll
                            for (int j = 0; j < 4; ++j) {
                                const int r = ai * 128 + wr * 64 + m * 16 + fq * 4 + j;
                                const float wgt = rw[r];
#pragma unroll
                                for (int bj = 0; bj < 2; ++bj)
                                    *(bf16_t*)(lds_raw + r * 272 + (bj * 64 + wc * 16 + fr) * 2) = f2bf(silu_f(acc[ai][bj][m][0][j]) * acc[ai][bj][m][1][j] * wgt);
                            }
                    __syncthreads();
#pragma unroll 4
                    for (int i = 0; i < 8; ++i) {
                        const int idx = et + i * 512, r = idx >> 4, ch = idx & 15;
                        if (m0 + r < c) *(u32x4*)(act + (size_t)(off + m0 + r) * DFF + pn * 128 + ch * 8) = *(const u32x4*)(lds_raw + r * 272 + ch * 16);
                    }
                    WAIT_VM0();
                    __syncthreads();
                    if (et == 0) { FENCE_REL_AGENT(); WAIT_VM0(); (void)xb_add(&done[e * 32 + mt], 1u); }
                } else {
                    const bf16_t* Bt = WdT + ((size_t)l * NEXP + e) * D * DFF;
                    if (tid == 0) {
                        unsigned* bw = (unsigned*)wsl;
                        XB_SPIN(xb_ld(&done[e * 32 + mt]) < 4u, bw);
                        FENCE_ACQ_AGENT();
                        WAIT_VM0();
                    }
                    __syncthreads();
                    gemm_tile<false>(act, off + m0, nooff, Bt, pn * 256, DFF, lds_raw, acc, tid);
                    int et = tid; OPAQUE(et); const int wr = et >> 8, wc = (et >> 6) & 3, fr = et & 15, fq = (et >> 4) & 3;
#pragma unroll
                    for (int ai = 0; ai < 2; ++ai)
#pragma unroll
                        for (int m = 0; m < 4; ++m)
#pragma unroll
                            for (int bj = 0; bj < 2; ++bj)
#pragma unroll
                                for (int n = 0; n < 2; ++n)
#pragma unroll
                                    for (int j = 0; j < 4; ++j)
                                        *(bf16_t*)(lds_raw + (ai * 128 + wr * 64 + m * 16 + fq * 4 + j) * 528 + (bj * 128 + wc * 32 + n * 16 + fr) * 2) = f2bf(acc[ai][bj][m][n][j]);
                    __syncthreads();
#pragma unroll 4
                    for (int i = 0; i < 16; ++i) {
                        const int idx = et + i * 512, r = idx >> 5, ch = idx & 31;
                        if (m0 + r < c) *(u32x4*)(contrib + ((size_t)rslot[r] * S + rtok[r]) * D + pn * 256 + ch * 8) = *(const u32x4*)(lds_raw + r * 528 + ch * 16);
                    }
                }
            }
            PH_BAR(pb + 5);
        }

        if (PH_SEL(7) && PH_IN(pb + 7)) for (int rep = 0; rep < PH_REPS(7); ++rep) {
            PHASE_IDS();
            const float* g2 = p.in[I_LN2G] + (size_t)l * D; const float* b2 = p.in[I_LN2B] + (size_t)l * D;
            const bool more = (l + 1 < DEPTH);
            f32x4 gq[8], bq[8], g1q[8], b1q[8];
#pragma unroll
            for (int j = 0; j < 8; ++j) { gq[j] = *(const f32x4*)(g2 + j * 256 + lane * 4); bq[j] = *(const f32x4*)(b2 + j * 256 + lane * 4);
                g1q[j] = *(const f32x4*)(p.in[I_LN1G] + (size_t)l * D + j * 256 + lane * 4); b1q[j] = *(const f32x4*)(p.in[I_LN1B] + (size_t)l * D + j * 256 + lane * 4); }
            if (more) {
                const float* wf = Wfa + (size_t)(l + 1) * 8 * D;
                __syncthreads();
                for (int i = tid; i < 6 * D / 4; i += NTHREADS) *(f32x4*)(ldsf + i * 4) = *(const f32x4*)(wf + i * 4);
                __syncthreads();
            }
            for (int t = gwave; t < S; t += gwaves) {
                f32x4 v[8]; float s = 0.f;
                const float mean1 = lnstat[2 * t], rstd1 = lnstat[2 * t + 1];
#pragma unroll
                for (int j = 0; j < 8; ++j) {
                    const size_t i = (size_t)t * D + j * 256 + lane * 4;
                    const u32x2 c0 = *(const u32x2*)(contrib + i), c1 = *(const u32x2*)(contrib + (size_t)S * D + i);
                    const f32x4 cs = (f32x4){bf2f((bf16_t)(c0.x & 0xffffu)) + bf2f((bf16_t)(c1.x & 0xffffu)), bf2f((bf16_t)(c0.x >> 16)) + bf2f((bf16_t)(c1.x >> 16)),
                                             bf2f((bf16_t)(c0.y & 0xffffu)) + bf2f((bf16_t)(c1.y & 0xffffu)), bf2f((bf16_t)(c0.y >> 16)) + bf2f((bf16_t)(c1.y >> 16))};
                    v[j] = ALPHA * ((*(const f32x4*)(y1 + i) - mean1) * rstd1 * g1q[j] + b1q[j]) + cs;
                    s += (v[j][0] + v[j][1]) + (v[j][2] + v[j][3]);
                }
                const float mean = wave_sum(s) * (1.f / D);
                float s2 = 0.f;
#pragma unroll
                for (int j = 0; j < 8; ++j) { v[j] -= mean; s2 += (v[j][0] * v[j][0] + v[j][1] * v[j][1]) + (v[j][2] * v[j][2] + v[j][3] * v[j][3]); }
                const float rstd = 1.f / sqrtf(wave_sum(s2) * (1.f / D) + LN_EPS);
                float fa[6] = {0.f, 0.f, 0.f, 0.f, 0.f, 0.f};
#pragma unroll
                for (int j = 0; j < 8; ++j) {
                    const int c = j * 256 + lane * 4;
                    v[j] = v[j] * rstd * gq[j] + bq[j];
                    *(f32x4*)(hout + (size_t)t * D + c) = v[j];
                    COMPILER_FENCE();
                    if (more) {
                        u32x2 o; o.x = pack2(v[j][0], v[j][1]); o.y = pack2(v[j][2], v[j][3]);
                        *(u32x2*)(xb + (size_t)t * D + c) = o;
#pragma unroll
                        for (int h = 0; h < 6; ++h) { const f32x4 w = *(const f32x4*)(ldsf + h * D + c); fa[h] += (v[j][0] * w[0] + v[j][1] * w[1]) + (v[j][2] * w[2] + v[j][3] * w[3]); }
                    }
                }
                if (more) {
#pragma unroll
                    for (int h = 0; h < 6; ++h) { const float sm = wave_sum(fa[h]); if (lane == 0) logf_[h * S + t] = log_sigmoid_f(sm + p.in[I_BF][(l + 1) * 6 + h]); }
                }
            }
            PH_BAR(pb + 7);
        }
    }
#undef PH_IN
#undef PH_BAR
}

constexpr int N_PHASES = 1 + DEPTH * 8;
#ifndef EMU
extern "C" void kernel_launch(void* const* d_in, const int* in_sizes, int n_in, void* d_out, int out_size, void* d_ws, size_t ws_size, hipStream_t stream) {
    static int grid = 0;
    if (grid == 0) {
        if (n_in != N_INPUTS || out_size != S * D || ws_size < WS_END) {
            fprintf(stderr, "kernel_launch: unexpected shapes: n_in %d out %d ws %zu (need %zu)\n", n_in, out_size, ws_size, (size_t)WS_END); grid = -1; return; }
        int dev = 0, cus = 0, per_cu = 0;
        if (hipGetDevice(&dev) != hipSuccess || hipDeviceGetAttribute(&cus, hipDeviceAttributeMultiprocessorCount, dev) != hipSuccess) { grid = -1; return; }
        if (hipFuncSetAttribute((const void*)fwd_kernel, hipFuncAttributeMaxDynamicSharedMemorySize, LDS_BYTES) != hipSuccess) { fprintf(stderr, "kernel_launch: hipFuncSetAttribute failed\n"); grid = -1; return; }
        if (hipOccupancyMaxActiveBlocksPerMultiprocessor(&per_cu, (const void*)fwd_kernel, NTHREADS, LDS_BYTES) != hipSuccess || per_cu < 1) {
            fprintf(stderr, "kernel_launch: occupancy query says %d blocks per CU\n", per_cu); (void)hipGetLastError(); grid = -1; return; }
        grid = cus;
    }
    if (grid < 0) return;
    (void)hipMemsetAsync(d_ws, 0, CTL_BYTES, stream);
    Params p{};
    for (int i = 0; i < N_INPUTS; ++i) p.in[i] = (const float*)d_in[i];
    p.out = (float*)d_out; p.ws = (unsigned char*)d_ws;
    for (int i = 0; i < 8; ++i) p.inv_freq[i] = (float)pow(500000.0, -(double)i * 2.0 / 16.0);
#if N_LAUNCH_SPLIT
    for (int k = 0; k < N_PHASES; ++k) { p.lo = k; p.hi = k + 1; hipLaunchKernelGGL(fwd_kernel, dim3(grid), dim3(NTHREADS), LDS_BYTES, stream, p); }
#else
    p.lo = 0; p.hi = N_PHASES;
    hipLaunchKernelGGL(fwd_kernel, dim3(grid), dim3(NTHREADS), LDS_BYTES, stream, p);
#endif
}
#endif
```

```cpp
#ifndef EMU
#include <hip/hip_runtime.h>
#include <cstdio>
#include <cstdint>
#include <cmath>
#endif

#ifndef SEQ
#define SEQ 8192
#endif
#ifndef N_LAUNCH_SPLIT
#define N_LAUNCH_SPLIT 0
#endif
#ifndef REP_PHASE
#define REP_PHASE -2
#endif
#define PH_REPS(c) ((c) == REP_PHASE ? 2 : 1)
#ifndef REP_SUB
#define REP_SUB 0
#endif

constexpr int S = SEQ, D = 2048, DEPTH = 2;
constexpr int FOX_H = 6, FOX_W = 768;
constexpr int LRU_W = 768;
constexpr int DIFF_H = 4, DIFF_W = 512;
constexpr int N_IN = 5382, N_INP = 5376;
constexpr int C_FA = 2304;
constexpr int NEXP = 32, DFF = 512;
constexpr int NKT = S / 64;
#ifndef DCH
#define DCH 32
#endif
constexpr int NCH = (NKT + DCH - 1) / DCH;
constexpr size_t DPART_ROWS = (size_t)NCH * S - (size_t)(DCH * 64) * NCH * (NCH - 1) / 2;
constexpr float ALPHA = 1.41421356237309504880f;
constexpr float LN_EPS = 1e-5f;
constexpr float LOG2E = 1.4426950408889634f;
constexpr float QSCALE_A = 0.08838834764831845f * 1.4426950408889634f;
constexpr float QSCALE_C = 0.125f * 1.4426950408889634f;

enum { I_X = 0, I_POS, I_WIN, I_BF, I_CONVW, I_CONVB, I_WA, I_BA, I_WI, I_BI, I_LAM, I_LQ1, I_LK1, I_LQ2, I_LK2, I_SUBG, I_WO, I_LN1G, I_LN1B,
       I_WGRP, I_BGRP, I_WRT, I_BRT, I_WGATE, I_WUP, I_WDOWN, I_LN2G, I_LN2B, N_INPUTS };

typedef unsigned short bf16_t;
typedef short bf16x8 __attribute__((ext_vector_type(8)));
typedef float f32x4 __attribute__((ext_vector_type(4)));
typedef unsigned u32x4 __attribute__((ext_vector_type(4)));
typedef unsigned u32x2 __attribute__((ext_vector_type(2)));

constexpr size_t al256(size_t x) { return (x + 255) & ~(size_t)255; }
constexpr size_t CTL_BYTES = 65536;
constexpr size_t CTL_CNT_OFF = 32768;
constexpr size_t CTL_WORK_OFF = 36864;
constexpr size_t CTL_QK2_OFF = 57344;
constexpr size_t CTL_CLS_OFF = 49152;
constexpr size_t CTL_PAN_OFF = 16384;
constexpr size_t CTL_DONE_OFF = 40960;
constexpr size_t WB_WIN = CTL_BYTES;
constexpr size_t WB_WO = WB_WIN + al256((size_t)DEPTH * N_INP * D * 2);
constexpr size_t WB_WGU = WB_WO + al256((size_t)DEPTH * D * D * 2);
constexpr size_t WB_WD = WB_WGU + al256((size_t)DEPTH * NEXP * 1024 * D * 2);
constexpr size_t WB_WAI = WB_WD + al256((size_t)DEPTH * NEXP * D * DFF * 2);
constexpr size_t WF_FA = WB_WAI + al256((size_t)DEPTH * 6 * 256 * 128 * 2);
constexpr size_t WF_R36 = WF_FA + al256((size_t)DEPTH * 8 * D * 4);
constexpr size_t WF_ROPE = WF_R36 + al256((size_t)DEPTH * 2 * 48 * D * 2);
constexpr size_t A_XB = WF_ROPE + al256((size_t)S * 16 * 4);
constexpr size_t A_HB = A_XB + al256((size_t)S * D * 2);
constexpr size_t A_LOGF = A_HB + al256((size_t)S * D * 4);
constexpr size_t A_CUM = A_LOGF + al256((size_t)6 * S * 4);
constexpr size_t A_KMAX = A_CUM + al256((size_t)6 * S * 4);
constexpr size_t A_CNTB = A_KMAX + al256((size_t)6 * NKT * 4);
constexpr size_t A_QA = A_CNTB + al256((size_t)1024 * 32 * 4);
constexpr size_t A_KA = A_QA + al256((size_t)FOX_H * S * 128 * 2);
constexpr size_t A_VAT = A_KA + al256((size_t)FOX_H * S * 128 * 2);
constexpr size_t A_XR = A_VAT + al256((size_t)FOX_H * S * 128 * 2);
constexpr size_t A_GR = A_XR + al256((size_t)S * LRU_W * 2);
constexpr size_t A_QC = A_GR + al256((size_t)S * LRU_W * 2);
constexpr size_t A_KC = A_QC + al256((size_t)DIFF_H * S * 128 * 2);
constexpr size_t A_VCT = A_KC + al256((size_t)DIFF_H * S * 128 * 2);
constexpr size_t A_HLOC = A_VCT + al256((size_t)DIFF_H * S * 128 * 2);
constexpr size_t A_PLOC = A_HLOC + al256((size_t)S * LRU_W * 4);
constexpr size_t A_SUMA = A_PLOC + al256((size_t)S * LRU_W * 4);
constexpr size_t A_SUMH = A_SUMA + al256((size_t)NKT * LRU_W * 4);
constexpr size_t A_CONCAT = A_SUMH + al256((size_t)NKT * LRU_W * 4);
constexpr size_t A_Y1 = A_CONCAT + al256((size_t)S * D * 2);
constexpr size_t A_H1 = A_Y1 + al256((size_t)S * D * 4);
constexpr size_t A_H1B = A_H1 + al256((size_t)S * D * 4);
constexpr size_t A_LTOK = A_H1B + al256((size_t)S * D * 2);
constexpr size_t A_LW = A_LTOK + al256((size_t)NEXP * S * 4);
constexpr size_t A_LSLOT = A_LW + al256((size_t)NEXP * S * 4);
constexpr size_t A_ACT = A_LSLOT + al256((size_t)NEXP * S * 4);
constexpr size_t A_CONTRIB = A_ACT + al256((size_t)(2 * S + 256) * DFF * 2);
constexpr size_t WS_END = A_CONTRIB + al256((size_t)2 * S * D * 4);
constexpr size_t A_DPO = A_Y1;
constexpr size_t A_DPML = A_DPO + al256((size_t)8 * DPART_ROWS * 128 * 2);
static_assert(A_DPML + (size_t)8 * DPART_ROWS * 2 * 4 <= A_H1B, "differential partials must fit inside the y1 + h1 region");

constexpr size_t A_XBUF = A_H1 + al256((size_t)S * D * 2);
constexpr size_t A_PART = A_XBUF + al256((size_t)S * 8 * 8);
static_assert(A_PART + (size_t)8 * S * 48 * 4 <= A_H1B, "exchange buffers must fit inside the h1 region");
constexpr int NTHREADS = 512;
constexpr int LDS_MAIN = 131072 + 4096;
constexpr int LDS_MISC = LDS_MAIN;
constexpr int LDS_BYTES = LDS_MAIN + 8192 + 16640;
constexpr int M_PRE16 = 8192;
constexpr int M_LCNT = 64, M_CTOT = 256, M_COFF = 384, M_PRE = 512, M_RTOK = 2048, M_RW = 3072, M_RSLOT = 4096;

struct Params {
    const float* in[N_INPUTS];
    float* out;
    unsigned char* ws;
    float inv_freq[8];
    int lo, hi;
};

#ifndef EMU
#define LAS __attribute__((address_space(3)))
#define GAS __attribute__((address_space(1)))
#define DYN_LDS(name) extern __shared__ __attribute__((aligned(16))) unsigned char name[]
#define SLEEP1() __builtin_amdgcn_s_sleep(1)
#define WAVE_SYNC() __builtin_amdgcn_wave_barrier()
#define OPAQUE(x) asm volatile("" : "+v"(x))
#define COMPILER_FENCE() asm volatile("" ::: "memory")
#define RFL(x) __builtin_amdgcn_readfirstlane(x)
#define RFL_F(x) __builtin_bit_cast(float, __builtin_amdgcn_readfirstlane(__builtin_bit_cast(int, x)))
#define ANY_LANE(p) (__builtin_amdgcn_ballot_w64(p) != 0ull)
#define RDLANE(v, l) __builtin_bit_cast(float, __builtin_amdgcn_readlane(__builtin_bit_cast(int, v), l))
__device__ __forceinline__ int lane_id_volatile() { int l; asm volatile("v_mbcnt_lo_u32_b32 %0, -1, 0\n\tv_mbcnt_hi_u32_b32 %0, -1, %0" : "=v"(l)); return l; }
#define LANE_ID() lane_id_volatile()
#define OPAQUE_S(x) asm volatile("" : "+s"(x))
#define WAIT_VM0() asm volatile("s_waitcnt vmcnt(0)" ::: "memory")
#define WAIT_ALL0() __builtin_amdgcn_s_waitcnt(0)
#define FENCE_REL_AGENT() __builtin_amdgcn_fence(__ATOMIC_RELEASE, "agent")
#define FENCE_ACQ_AGENT() __builtin_amdgcn_fence(__ATOMIC_ACQUIRE, "agent")
#define MFMA16(a, b, c) __builtin_amdgcn_mfma_f32_16x16x32_bf16(a, b, c, 0, 0, 0)
#define GLDS16(g, l) __builtin_amdgcn_global_load_lds((const unsigned*)(g), (unsigned*)(l), 16, 0, 0)
#define WAIT_V(n) asm volatile("s_waitcnt vmcnt(" #n ")" ::: "memory")
#define WAIT_L(n) asm volatile("s_waitcnt lgkmcnt(" #n ")" ::: "memory")
#define BAR() __builtin_amdgcn_s_barrier()
#define SCHED() __builtin_amdgcn_sched_barrier(0)
#define SETPRIO(n) __builtin_amdgcn_s_setprio(n)
#define FAST_EXP2(x) __builtin_amdgcn_exp2f(x)
template <int M> __device__ __forceinline__ float shx_impl(float v, int lane) {
    if (M < 32) return __builtin_bit_cast(float, __builtin_amdgcn_ds_swizzle(__builtin_bit_cast(int, v), (M << 10) | 0x1f));
    return __builtin_bit_cast(float, __builtin_amdgcn_ds_bpermute((lane ^ 32) << 2, __builtin_bit_cast(int, v)));
}
#define SHX(v, M) shx_impl<M>(v, lane)
template <int CTRL> __device__ __forceinline__ float dppx(float x) { return __builtin_bit_cast(float, __builtin_amdgcn_mov_dpp(__builtin_bit_cast(int, x), CTRL, 0xf, 0xf, true)); }
#define DPP_X1(x) dppx<0xB1>(x)
#define DPP_X2(x) dppx<0x4E>(x)
#define DPP_X7(x) dppx<0x141>(x)
#define DPP_X8(x) dppx<0x128>(x)
#define xrow16_max(x) xrow16_max_l(x, lane)
#define xrow16_sum(x) xrow16_sum_l(x, lane)
__device__ __forceinline__ float xrow16_max_l(float x, int lane) { x = fmaxf(x, shx_impl<16>(x, lane)); return fmaxf(x, shx_impl<32>(x, lane)); }
__device__ __forceinline__ float xrow16_sum_l(float x, int lane) { x = x + shx_impl<16>(x, lane); return x + shx_impl<32>(x, lane); }
#define FAST_LOG2(x) __builtin_amdgcn_logf(x)
#define FAST_RCP(x) __builtin_amdgcn_rcpf(x)
__device__ __forceinline__ unsigned xb_ld(unsigned* p)              { return __hip_atomic_load(p, __ATOMIC_RELAXED, __HIP_MEMORY_SCOPE_AGENT); }
__device__ __forceinline__ unsigned xb_add(unsigned* p, unsigned v) { return __hip_atomic_fetch_add(p, v, __ATOMIC_RELAXED, __HIP_MEMORY_SCOPE_AGENT); }
__device__ __forceinline__ void xst64(unsigned long long* p, unsigned long long v) { __hip_atomic_store(p, v, __ATOMIC_RELAXED, __HIP_MEMORY_SCOPE_AGENT); }
__device__ __forceinline__ unsigned long long xld64(unsigned long long* p) { return __hip_atomic_load(p, __ATOMIC_RELAXED, __HIP_MEMORY_SCOPE_AGENT); }
__device__ __forceinline__ void xst32(unsigned* p, unsigned v) { __hip_atomic_store(p, v, __ATOMIC_RELAXED, __HIP_MEMORY_SCOPE_AGENT); }
__device__ __forceinline__ unsigned xb_xcc_id() { return (unsigned)__builtin_amdgcn_s_getreg((3 << 11) | 20) & 0xFu; }
__device__ __forceinline__ int atomic_add_int(int* p, int v) { return atomicAdd(p, v); }
__device__ __forceinline__ void atomic_min_int(int* p, int v) { atomicMin(p, v); }
__device__ __forceinline__ void atomic_max_u32(unsigned* p, unsigned v) { atomicMax(p, v); }
__device__ __forceinline__ unsigned pack2(float lo, float hi) { unsigned r; asm volatile("v_cvt_pk_bf16_f32 %0, %1, %2" : "=v"(r) : "v"(lo), "v"(hi)); return r; }
#else
#define MFMA16(a, b, c) emu_mfma_16x16x32_bf16(a, b, c)
#define GLDS16(g, l) emu_glds16((const void*)(g), (void*)(l))
#define WAIT_V(n) ((void)0)
#define WAIT_L(n) ((void)0)
#define BAR() __syncthreads()
#define SCHED() ((void)0)
#define SETPRIO(n) ((void)0)
#define FAST_EXP2(x) exp2f(x)
#define SHX(v, M) __shfl_xor(v, M)
#define DPP_X1(x) __shfl_xor(x, 1)
#define DPP_X2(x) __shfl_xor(x, 2)
#define DPP_X7(x) __shfl_xor(x, 7)
#define DPP_X8(x) __shfl_xor(x, 8)
static inline float xrow16_max(float x) { x = fmaxf(x, __shfl_xor(x, 16)); return fmaxf(x, __shfl_xor(x, 32)); }
static inline float xrow16_sum(float x) { x = x + __shfl_xor(x, 16); return x + __shfl_xor(x, 32); }
#define FAST_LOG2(x) log2f(x)
#define FAST_RCP(x) (1.f / (x))
static inline unsigned pack2(float lo, float hi) {
    unsigned a = __builtin_bit_cast(unsigned, lo), b = __builtin_bit_cast(unsigned, hi);
    a += 0x7fffu + ((a >> 16) & 1u); b += 0x7fffu + ((b >> 16) & 1u);
    return (a >> 16) | (b & 0xffff0000u);
}
#endif
__device__ __forceinline__ bf16_t f2bf(float f) { return (bf16_t)(pack2(f, 0.f) & 0xffffu); }
__device__ __forceinline__ float bf2f(bf16_t h) { return __builtin_bit_cast(float, (unsigned)h << 16); }

#define XB_TMO      128
#define XB_XCNT(j)  (256  + 64 * (j))
#define XB_XSUB(j)  (1280 + 64 * (j))
#define XB_XGEN(j)  (2304 + 64 * (j))
#define XB_TOP      3328
#define XB_TOPGEN   3392
#define XCD_BAR_WORDS 3456
#define XB_SPIN_CAP (1u << 22)
#define XB_SPIN(cond, bar) do { unsigned _sp = 0; while (cond) { SLEEP1(); \
    if ((++_sp & 255u) == 0u) { if (xb_ld(&(bar)[XB_TMO])) break; if (_sp > XB_SPIN_CAP) { xb_add(&(bar)[XB_TMO], 1u); break; } } } } while (0)

struct XcdBarrier { unsigned* bar; unsigned x; volatile LAS unsigned* st; };

__device__ __forceinline__ XcdBarrier xcd_barrier_post(unsigned* bar, volatile LAS unsigned* st) {
    XcdBarrier b; b.bar = bar; b.x = xb_xcc_id(); b.st = st;
    if (threadIdx.x == 0) (void)xb_add(&bar[XB_XCNT(b.x)], 1u);
    return b;
}
__device__ __forceinline__ void xcd_barrier_complete(unsigned* bar, unsigned x, unsigned& nloc, unsigned& nx) {
    const unsigned G = gridDim.x;
    unsigned sum, cnt, mine, sp = 0u;
    for (;;) {
        sum = 0u; cnt = 0u; mine = 0u;
#pragma unroll
        for (unsigned j = 0; j < 16; ++j) { const unsigned c = xb_ld(&bar[XB_XCNT(j)]); sum += c; cnt += (c > 0u) ? 1u : 0u; mine = (j == x) ? c : mine; }
        if (sum == G) break;
        SLEEP1();
        if ((++sp & 255u) == 0u) { if (xb_ld(&bar[XB_TMO])) break; if (sp > XB_SPIN_CAP) { xb_add(&bar[XB_TMO], 1u); break; } }
    }
    nloc = mine > 0u ? mine : 1u; nx = cnt > 0u ? cnt : 1u;
}
__device__ __forceinline__ void xcd_barrier(const XcdBarrier& b, bool leader) {
    WAIT_VM0();
    __syncthreads();
    if (leader) {
        unsigned* bar = b.bar;
        WAIT_ALL0();
        unsigned nloc = b.st[0], nx = b.st[1];
        if (nloc == 0u) { xcd_barrier_complete(bar, b.x, nloc, nx); b.st[0] = nloc; b.st[1] = nx; }
        const unsigned old = xb_add(&bar[XB_XSUB(b.x)], 1u);
        const unsigned gen = old / nloc;
        if (old + 1u == (gen + 1u) * nloc) {
            FENCE_REL_AGENT();
            WAIT_VM0();
            const unsigned og = xb_add(&bar[XB_TOP], 1u);
            const unsigned tg = og / nx;
            if (og + 1u == (tg + 1u) * nx) xb_add(&bar[XB_TOPGEN], 1u);
            else XB_SPIN(xb_ld(&bar[XB_TOPGEN]) == tg, bar);
            FENCE_ACQ_AGENT();
            xb_add(&bar[XB_XGEN(b.x)], 1u);
            WAIT_VM0();
        } else {
            XB_SPIN(xb_ld(&bar[XB_XGEN(b.x)]) == gen, bar);
            FENCE_ACQ_AGENT();
            WAIT_VM0();
        }
    }
    __syncthreads();
}

__device__ __forceinline__ f32x4 mul_s4(f32x4 a, float s) {
#ifdef EMU
    return a * s;
#else
    f32x4 o;
#pragma unroll
    for (int c = 0; c < 4; ++c) { float r, x = a[c]; asm volatile("v_mul_f32_e32 %0, %1, %2" : "=v"(r) : "v"(x), "v"(s)); o[c] = r; }
    return o;
#endif
}
__device__ __forceinline__ float wave_sum_l(float v, int lane) {
    (void)lane;
    v += DPP_X1(v); v += DPP_X2(v); v += DPP_X7(v); v += DPP_X8(v);
    return xrow16_sum(v);
}
#define wave_sum(v) wave_sum_l(v, lane)
__device__ __forceinline__ float fexp(float x) { return FAST_EXP2(x * LOG2E); }
__device__ __forceinline__ float sigmoid_f(float x) { return FAST_RCP(1.f + fexp(-x)); }
__device__ __forceinline__ float log_sigmoid_f(float x) { return fminf(x, 0.f) - 0.6931471805599453f * FAST_LOG2(1.f + fexp(-fabsf(x))); }
__device__ __forceinline__ float gelu_tanh_f(float x) { const float u = 0.7978845608028654f * (x + 0.044715f * x * x * x); return x * FAST_RCP(1.f + fexp(-2.f * u)); }
__device__ __forceinline__ float silu_f(float x) { return x * FAST_RCP(1.f + fexp(-x)); }
__device__ __forceinline__ float neg_expm1_f(float x) {
    const float ser = -x * (1.f + x * (0.5f + x * (0.16666667f + x * (0.041666668f + x * (0.008333334f + x * 0.0013888889f)))));
    return (x > -0.35f) ? ser : (1.f - fexp(x));
}

struct RmIdent { __device__ __forceinline__ int operator()(int n) const { return n; } };
struct RmWin { __device__ __forceinline__ int operator()(int n) const { return n < C_FA ? n : (n < C_FA + 6 ? -1 : n - 6); } };
struct RmGu { int kind; __device__ __forceinline__ int operator()(int f) const { return (f >> 7) * 256 + ((f >> 6) & 1) * 128 + ((f >> 4) & 3) * 32 + kind * 16 + (f & 15); } };
struct RmOff { int off; __device__ __forceinline__ int operator()(int n) const { return n + off; } };

template <class RM>
__device__ __forceinline__ void convert_tile(const float* src, int ld, int K, int Nsrc, int k0, int n0, bf16_t* dst, const RM& rm, float* T, int tid) {
    {
        const int nn = tid & 255, kh = (tid >> 8) * 32, n = n0 + nn;
        const float* sp = src + (size_t)(k0 + kh) * ld + n;
        float v[32];
#pragma unroll
        for (int i = 0; i < 32; ++i) v[i] = (n < Nsrc) ? sp[(size_t)i * ld] : 0.f;
#pragma unroll
        for (int i = 0; i < 32; ++i) T[(kh + i) * 257 + nn] = v[i];
    }
    __syncthreads();
#pragma unroll
    for (int q = 0; q < 4; ++q) {
        const int nn = q * 64 + (tid >> 3), kc = (tid & 7) * 8, n = n0 + nn;
        const int row = (n < Nsrc) ? rm(n) : -1;
        if (row >= 0) {
            u32x4 o;
            o.x = pack2(T[(kc + 0) * 257 + nn], T[(kc + 1) * 257 + nn]); o.y = pack2(T[(kc + 2) * 257 + nn], T[(kc + 3) * 257 + nn]);
            o.z = pack2(T[(kc + 4) * 257 + nn], T[(kc + 5) * 257 + nn]); o.w = pack2(T[(kc + 6) * 257 + nn], T[(kc + 7) * 257 + nn]);
            *(u32x4*)(dst + (size_t)row * K + k0 + kc) = o;
        }
    }
    __syncthreads();
}
template <class RM>
__device__ __forceinline__ void convert_tile_v4(const float* src, int ld, int K, int k0, int n0, bf16_t* dst, const RM& rm, float* T, int tid_in) {
    int tid = tid_in; OPAQUE(tid);
    {
        const int w = tid >> 6, l4 = (tid & 63) * 4;
        const float* sp = src + (size_t)(k0 + w * 8) * ld + n0 + l4;
        f32x4 v[8];
#pragma unroll
        for (int i = 0; i < 8; ++i) v[i] = *(const f32x4*)(sp + (size_t)i * ld);
#pragma unroll
        for (int i = 0; i < 8; ++i) { float* tp = T + (w * 8 + i) * 257 + l4; tp[0] = v[i][0]; tp[1] = v[i][1]; tp[2] = v[i][2]; tp[3] = v[i][3]; }
    }
    __syncthreads();
#pragma unroll
    for (int q = 0; q < 4; ++q) {
        const int nn = q * 64 + (tid >> 3), kc = (tid & 7) * 8, n = n0 + nn;
        const int row = rm(n);
        u32x4 o;
        o.x = pack2(T[(kc + 0) * 257 + nn], T[(kc + 1) * 257 + nn]); o.y = pack2(T[(kc + 2) * 257 + nn], T[(kc + 3) * 257 + nn]);
        o.z = pack2(T[(kc + 4) * 257 + nn], T[(kc + 5) * 257 + nn]); o.w = pack2(T[(kc + 6) * 257 + nn], T[(kc + 7) * 257 + nn]);
        *(u32x4*)(dst + (size_t)row * K + k0 + kc) = o;
    }
    __syncthreads();
}
template <class RM>
__device__ __forceinline__ void convert_mats(const float* src, size_t sstride, int nmat, int ld, int K, int Nsrc, bf16_t* dst, size_t dstride, const RM& rm,
                                             float* T, int tid, int bid, int G) {
    const int tk = K / 64, tn = (Nsrc + 255) / 256, per = tk * tn, total = nmat * per;
    for (int t = bid; t < total; t += G) {
        const int mi = t / per, r = t % per;
        convert_tile(src + (size_t)mi * sstride, ld, K, Nsrc, (r / tn) * 64, (r % tn) * 256, dst + (size_t)mi * dstride, rm, T, tid);
    }
}

constexpr int NCONV = DEPTH * 768;
__device__ __forceinline__ void moe_conv_chunk(const Params& p, int cid, bf16_t* WguT_, bf16_t* WdT_, float* T, int tid) {
    const int l = cid / 768, r = cid % 768, kind = r >> 8, t0 = (r & 255) * 8;
    for (int t = t0; t < t0 + 8; ++t) {
        const int mi = t >> 6, rr = t & 63;
        if (kind < 2) {
            const float* src = p.in[kind == 0 ? I_WGATE : I_WUP] + ((size_t)l * NEXP + mi) * D * DFF;
            convert_tile_v4(src, DFF, D, (rr >> 1) * 64, (rr & 1) * 256, WguT_ + ((size_t)l * NEXP + mi) * 1024 * D, RmGu{kind}, T, tid);
        } else {
            const float* src = p.in[I_WDOWN] + ((size_t)l * NEXP + mi) * DFF * D;
            convert_tile_v4(src, D, DFF, (rr >> 3) * 64, (rr & 7) * 256, WdT_ + ((size_t)l * NEXP + mi) * D * DFF, RmIdent{}, T, tid);
        }
    }
}

constexpr int BK = 64, HTB = 128 * 64 * 2;
__device__ __forceinline__ int lds_byte(int r, int c) {
    const int st = (r >> 4) * 2 + (c >> 5), rr = r & 15, cc = c & 31, ob = rr * 64 + cc * 2;
    return st * 1024 + (ob ^ (((ob >> 9) & 1) << 5));
}
__device__ __forceinline__ void stage_rc(int b, int& R, int& C) {
    const int st = b / 1024, sb = b % 1024, swz = sb ^ (((sb >> 9) & 1) << 5);
    R = (st >> 1) * 16 + swz / 64; C = (st & 1) * 32 + (swz % 64) / 2;
}
template <bool GATHER>
__device__ __forceinline__ void gemm_tile(const bf16_t* A, int arow0, const unsigned (&aoff)[2][2], const bf16_t* Bt, int brow0, int K,
                                          unsigned char* shm, f32x4 (&acc)[2][2][4][2], int tid_in) {
    int tid = tid_in; OPAQUE(tid);
    unsigned toff; { int R0, C0; stage_rc(tid * 16, R0, C0); toff = (unsigned)(R0 * K + C0); }
#define SA(b, h) (shm + ((b) * 2 + (h)) * HTB)
#define SB(b, h) (shm + (4 + (b) * 2 + (h)) * HTB)
#define STAGE_B(P, h, kt) do { _Pragma("unroll") for (int _i = 0; _i < 2; ++_i) GLDS16(Bt + ((size_t)(brow0 + (h) * 128 + _i * 64) * K + (size_t)(kt) * BK) + toff, (P) + tid * 16 + _i * 8192); } while (0)
#define STAGE_A(P, h, kt) do { _Pragma("unroll") for (int _i = 0; _i < 2; ++_i) { \
    if (GATHER) GLDS16(A + (size_t)(kt) * BK + aoff[h][_i], (P) + tid * 16 + _i * 8192); \
    else GLDS16(A + ((size_t)(arow0 + (h) * 128 + _i * 64) * K + (size_t)(kt) * BK) + toff, (P) + tid * 16 + _i * 8192); } } while (0)
#define LDA(dst, b, h) _Pragma("unroll") for (int m = 0; m < 4; ++m) _Pragma("unroll") for (int k = 0; k < 2; ++k) \
    dst[m][k] = *reinterpret_cast<const bf16x8*>(SA(b, h) + lds_byte(wr * 64 + m * 16 + fr, k * 32 + fq * 8))
#define LDB(dst, b, h) _Pragma("unroll") for (int n = 0; n < 2; ++n) _Pragma("unroll") for (int k = 0; k < 2; ++k) \
    dst[n][k] = *reinterpret_cast<const bf16x8*>(SB(b, h) + lds_byte(wc * 32 + n * 16 + fr, k * 32 + fq * 8))
#define MMA(ai, bj, At, Bx) do { SETPRIO(1); \
    _Pragma("unroll") for (int m = 0; m < 4; ++m) _Pragma("unroll") for (int n = 0; n < 2; ++n) _Pragma("unroll") for (int k = 0; k < 2; ++k) \
      acc[ai][bj][m][n] = MFMA16(At[m][k], Bx[n][k], acc[ai][bj][m][n]); \
    SETPRIO(0); } while (0)
    int wid = tid >> 6, lane = tid & 63, wr = wid >> 2, wc = wid & 3, fr = lane & 15, fq = lane >> 4;
#pragma unroll
    for (int a = 0; a < 2; ++a)
#pragma unroll
        for (int b = 0; b < 2; ++b)
#pragma unroll
            for (int m = 0; m < 4; ++m)
#pragma unroll
                for (int n = 0; n < 2; ++n) acc[a][b][m][n] = (f32x4){0.f, 0.f, 0.f, 0.f};
    bf16x8 At[4][2], B0[2][2], B1[2][2];
    const int nt = K / BK;
    STAGE_B(SB(0, 0), 0, 0); STAGE_A(SA(0, 0), 0, 0);
    STAGE_B(SB(0, 1), 1, 0); STAGE_A(SA(0, 1), 1, 0);
    if (wr == 1) BAR();
    WAIT_V(4); BAR();
    STAGE_B(SB(1, 0), 0, 1); STAGE_A(SA(1, 0), 0, 1); STAGE_B(SB(1, 1), 1, 1);
    WAIT_V(6); BAR();
    for (int t = 0; t < nt - 2; t += 2) {
        LDB(B0, 0, 0); SCHED(); LDA(At, 0, 0); STAGE_A(SA(1, 1), 1, t + 1);
        WAIT_L(8); BAR(); WAIT_L(0); MMA(0, 0, At, B0); BAR(); SCHED();
        LDB(B1, 0, 1); STAGE_B(SB(0, 0), 0, t + 2);
        BAR(); WAIT_L(0); MMA(0, 1, At, B1); BAR();
        LDA(At, 0, 1); STAGE_A(SA(0, 0), 0, t + 2);
        BAR(); WAIT_L(0); MMA(1, 0, At, B0); BAR(); SCHED();
        STAGE_B(SB(0, 1), 1, t + 2);
        WAIT_V(6); BAR(); MMA(1, 1, At, B1); BAR();
        LDB(B0, 1, 0); SCHED(); LDA(At, 1, 0); STAGE_A(SA(0, 1), 1, t + 2);
        WAIT_L(8); BAR(); WAIT_L(0); MMA(0, 0, At, B0); BAR(); SCHED();
        LDB(B1, 1, 1); STAGE_B(SB(1, 0), 0, t + 3);
        BAR(); WAIT_L(0); MMA(0, 1, At, B1); BAR();
        LDA(At, 1, 1); STAGE_A(SA(1, 0), 0, t + 3);
        BAR(); WAIT_L(0); MMA(1, 0, At, B0); BAR(); SCHED();
        STAGE_B(SB(1, 1), 1, t + 3);
        WAIT_V(6); BAR(); MMA(1, 1, At, B1); BAR();
    }
    OPAQUE(tid); wid = tid >> 6; lane = tid & 63; wr = wid >> 2; wc = wid & 3; fr = lane & 15; fq = lane >> 4;
    { LDB(B0, 0, 0); WAIT_V(0); LDA(At, 0, 0); STAGE_A(SA(1, 1), 1, nt - 1);
      BAR(); WAIT_L(0); MMA(0, 0, At, B0); BAR();
      LDB(B1, 0, 1); BAR(); WAIT_L(0); MMA(0, 1, At, B1); BAR();
      LDA(At, 0, 1); WAIT_V(4); BAR(); WAIT_L(0); MMA(1, 0, At, B0); MMA(1, 1, At, B1); BAR(); }
    { LDB(B0, 1, 0); LDA(At, 1, 0); WAIT_V(2); BAR(); WAIT_L(0); MMA(0, 0, At, B0); BAR();
      LDB(B1, 1, 1); WAIT_V(0); BAR(); WAIT_L(0); MMA(0, 1, At, B1); BAR();
      LDA(At, 1, 1); BAR(); WAIT_L(0); MMA(1, 0, At, B0); MMA(1, 1, At, B1); BAR(); }
    if (wr == 0) BAR();
#undef SA
#undef SB
#undef STAGE_A
#undef STAGE_B
#undef LDA
#undef LDB
#undef MMA
}
__device__ __forceinline__ void stage_geom(int tid, int (&R)[2], int (&C)[2]) {
#pragma unroll
    for (int i = 0; i < 2; ++i) stage_rc(tid * 16 + i * 8192, R[i], C[i]);
}

constexpr int ATT_KBUF = 0, ATT_VBUF = 32768, ATT_CBUF = 65536;
template <int KIND>
__device__ __forceinline__ void attn_unit(const bf16_t* Q, const bf16_t* Kg, const bf16_t* VT, const float* cum2, const float* kmx, int qb, bf16_t* concat, int ccol0,
                                          float lam, float osc, const float* subg, unsigned char* lds, int tid) {
    const int lane = tid & 63, wave = tid >> 6, r16 = lane & 15, q4 = lane >> 4;
    const int q0w = qb * 128 + wave * 16, myq = q0w + r16;
    const int ntiles = 2 * qb + 2;
    const int wlimit = (KIND == 0) ? ((q0w + 15) >> 6) : (q0w >> 6);
    constexpr int NMAP = (KIND == 0) ? 1 : 2, NKS = (KIND == 0) ? 4 : 2;
    bf16x8 qf[NMAP][NKS];
#pragma unroll
    for (int mp = 0; mp < NMAP; ++mp)
#pragma unroll
        for (int ks = 0; ks < NKS; ++ks) qf[mp][ks] = *(const bf16x8*)(Q + (size_t)myq * 128 + mp * 64 + ks * 32 + q4 * 8);
    const float cq = (KIND == 0) ? cum2[myq] : 0.f;
    int kt0 = 0;
    if (KIND == 0) {
        float* wmax = (float*)(lds + ATT_CBUF + 512); int* kst = (int*)(lds + ATT_CBUF + 576);
        float qs = 0.f;
#pragma unroll
        for (int ks = 0; ks < NKS; ++ks)
#pragma unroll
            for (int j = 0; j < 8; ++j) { const float v = bf2f((bf16_t)qf[0][ks][j]); qs += v * v; }
        qs = xrow16_sum(qs);
        qs = fmaxf(qs, SHX(qs, 1)); qs = fmaxf(qs, SHX(qs, 2)); qs = fmaxf(qs, SHX(qs, 4)); qs = fmaxf(qs, SHX(qs, 8));
        if (lane == 0) wmax[wave] = qs;
        if (tid == 0) *kst = 2 * qb;
        __syncthreads();
        float qm = wmax[0];
#pragma unroll
        for (int w = 1; w < 8; ++w) qm = fmaxf(qm, wmax[w]);
        qm = sqrtf(qm) * 1.01f;
        const float kd = sqrtf(fmaxf(kmx[2 * qb], kmx[2 * qb + 1])) * 1.01f;
        if (tid < 2 * qb) {
            const float bias = cum2[qb * 128] - cum2[tid * 64 + 63];
            const bool skip = bias + qm * (sqrtf(kmx[tid]) * 1.01f + kd) < -40.f;
            if (!skip) atomic_min_int(kst, tid);
        }
        __syncthreads();
        kt0 = RFL(*kst);
    }
    f32x4 ot[NMAP][8];
    float mrun[NMAP], lsum[NMAP];
#pragma unroll
    for (int mp = 0; mp < NMAP; ++mp) { mrun[mp] = -INFINITY; lsum[mp] = 0.f;
#pragma unroll
        for (int mo = 0; mo < 8; ++mo) ot[mp][mo] = (f32x4){0.f, 0.f, 0.f, 0.f}; }
    u32x4 sk[2], sv[2]; float sc = 0.f;
    const u32x4* kg = (const u32x4*)Kg; const u32x4* vg = (const u32x4*)VT;
#pragma unroll
    for (int i = 0; i < 2; ++i) { sk[i] = kg[(size_t)kt0 * 1024 + tid + i * 512]; sv[i] = vg[(size_t)kt0 * 1024 + tid + i * 512]; }
    if (KIND == 0 && tid < 64) sc = cum2[kt0 * 64 + tid];
    for (int kt = kt0; kt < ntiles; ++kt) {
        unsigned char* kb = lds + ATT_KBUF + (kt & 1) * 16384;
        unsigned char* vb = lds + ATT_VBUF + (kt & 1) * 16384;
        float* cb = (float*)(lds + ATT_CBUF + (kt & 1) * 256);
#pragma unroll
        for (int i = 0; i < 2; ++i) {
            const int g = tid + i * 512;
            { const int row = g >> 4, c = g & 15; *(u32x4*)(kb + row * 256 + ((c ^ (row & 15)) << 4)) = sk[i]; }
            { const int d = g >> 3, c = g & 7; *(u32x4*)(vb + d * 128 + ((c ^ ((d >> 1) & 7)) << 4)) = sv[i]; }
        }
        if (KIND == 0 && tid < 64) cb[tid] = sc;
        __syncthreads();
        if (kt + 1 < ntiles) {
#pragma unroll
            for (int i = 0; i < 2; ++i) { sk[i] = kg[(size_t)(kt + 1) * 1024 + tid + i * 512]; sv[i] = vg[(size_t)(kt + 1) * 1024 + tid + i * 512]; }
            if (KIND == 0 && tid < 64) sc = cum2[(kt + 1) * 64 + tid];
        }
        if (kt <= wlimit) {
#pragma unroll
            for (int mp = 0; mp < NMAP; ++mp) {
                bf16x8 kf[4][NKS], vfa[8];
#pragma unroll
                for (int m = 0; m < 4; ++m)
#pragma unroll
                    for (int ks = 0; ks < NKS; ++ks) { const int c = (KIND == 0 ? 0 : mp * 8) + ks * 4 + q4; kf[m][ks] = *(const bf16x8*)(kb + (m * 16 + r16) * 256 + ((c ^ r16) << 4)); }
#pragma unroll
                for (int mo = 0; mo < 8; ++mo) { const int d = mo * 16 + r16; vfa[mo] = *(const bf16x8*)(vb + d * 128 + (((0 * 4 + q4) ^ ((d >> 1) & 7)) << 4)); }
                SCHED();
                f32x4 st[4];
#pragma unroll
                for (int m = 0; m < 4; ++m) st[m] = (f32x4){0.f, 0.f, 0.f, 0.f};
#pragma unroll
                for (int ks = 0; ks < NKS; ++ks)
#pragma unroll
                    for (int m = 0; m < 4; ++m) st[m] = MFMA16(kf[m][ks], qf[mp][ks], st[m]);
                SCHED();
                float mx = -INFINITY;
#pragma unroll
                for (int m = 0; m < 4; ++m) {
                    if (KIND == 0) {
                        const f32x4 ck = *(const f32x4*)(cb + m * 16 + 4 * q4);
#pragma unroll
                        for (int j = 0; j < 4; ++j) {
                            float y = st[m][j] + (cq - ck[j]);
                            if (kt * 64 + m * 16 + 4 * q4 + j > myq) y = -INFINITY;
                            st[m][j] = y;
                        }
                    }
#pragma unroll
                    for (int j = 0; j < 4; ++j) mx = fmaxf(mx, st[m][j]);
                }
                mx = xrow16_max(mx);
                const float mnew = fmaxf(mrun[mp], mx);
                const float alpha = FAST_EXP2(mrun[mp] - mnew);
                mrun[mp] = mnew;
                float ps = 0.f;
#pragma unroll
                for (int m = 0; m < 4; ++m)
#pragma unroll
                    for (int j = 0; j < 4; ++j) { const float pv = FAST_EXP2(st[m][j] - mnew); st[m][j] = pv; ps += pv; }
                lsum[mp] = lsum[mp] * alpha + ps;
#pragma unroll
                for (int mo = 0; mo < 8; ++mo) ot[mp][mo] *= alpha;
                bf16x8 pf[2];
#pragma unroll
                for (int kk = 0; kk < 2; ++kk) {
                    u32x4 pw;
                    pw.x = pack2(st[2 * kk][0], st[2 * kk][1]); pw.y = pack2(st[2 * kk][2], st[2 * kk][3]);
                    pw.z = pack2(st[2 * kk + 1][0], st[2 * kk + 1][1]); pw.w = pack2(st[2 * kk + 1][2], st[2 * kk + 1][3]);
                    pf[kk] = __builtin_bit_cast(bf16x8, pw);
                }
                bf16x8 vfb[8];
#pragma unroll
                for (int mo = 0; mo < 8; ++mo) { const int d = mo * 16 + r16; vfb[mo] = *(const bf16x8*)(vb + d * 128 + (((1 * 4 + q4) ^ ((d >> 1) & 7)) << 4)); }
                SCHED();
#pragma unroll
                for (int mo = 0; mo < 8; ++mo) ot[mp][mo] = MFMA16(vfa[mo], pf[0], ot[mp][mo]);
                SCHED();
#pragma unroll
                for (int mo = 0; mo < 8; ++mo) ot[mp][mo] = MFMA16(vfb[mo], pf[1], ot[mp][mo]);
            }
        }
    }
    float inv[NMAP];
#pragma unroll
    for (int mp = 0; mp < NMAP; ++mp) { float l = lsum[mp]; l = xrow16_sum(l); inv[mp] = 1.f / l; }
    if (KIND == 0) {
#pragma unroll
        for (int mo = 0; mo < 8; ++mo) {
            u32x2 o; o.x = pack2(ot[0][mo][0] * inv[0], ot[0][mo][1] * inv[0]); o.y = pack2(ot[0][mo][2] * inv[0], ot[0][mo][3] * inv[0]);
            *(u32x2*)(concat + (size_t)myq * D + ccol0 + mo * 16 + 4 * q4) = o;
        }
    } else {
        float ss = 0.f;
#pragma unroll
        for (int mo = 0; mo < 8; ++mo)
#pragma unroll
            for (int j = 0; j < 4; ++j) { const float v = ot[0][mo][j] * inv[0] - lam * (ot[NMAP - 1][mo][j] * inv[NMAP - 1]); ot[0][mo][j] = v; ss += v * v; }
        ss = xrow16_sum(ss);
        const float rs = osc / sqrtf(ss * (1.f / 128.f) + LN_EPS);
#pragma unroll
        for (int mo = 0; mo < 8; ++mo) {
            const f32x4 g = *(const f32x4*)(subg + mo * 16 + 4 * q4);
            u32x2 o; o.x = pack2(ot[0][mo][0] * rs * g[0], ot[0][mo][1] * rs * g[1]); o.y = pack2(ot[0][mo][2] * rs * g[2], ot[0][mo][3] * rs * g[3]);
            *(u32x2*)(concat + (size_t)myq * D + ccol0 + mo * 16 + 4 * q4) = o;
        }
    }
    __syncthreads();
}

__device__ __forceinline__ int dpart_row(int c, int q) { return c * (S - DCH * 64) - (DCH * 32) * c * (c - 1) + q; }
__device__ __forceinline__ void attn_dmap_unit(const bf16_t* Qh, const bf16_t* Kh, const bf16_t* VTh, int mp, int qb, int t0, int t1,
                                               bf16_t* Op, float* ML, int c, float bnd, unsigned char* lds, int tid) {
    const bool fixedref = (bnd <= 60.f);
    const int lane = tid & 63, wave = tid >> 6, r16 = lane & 15, q4 = lane >> 4;
    const int q0w = qb * 256 + wave * 32;
    const int wlimit = q0w >> 6;
    bf16x8 qf[2][2];
#pragma unroll
    for (int n = 0; n < 2; ++n)
#pragma unroll
        for (int ks = 0; ks < 2; ++ks) qf[n][ks] = *(const bf16x8*)(Qh + (size_t)(q0w + n * 16 + r16) * 128 + mp * 64 + ks * 32 + q4 * 8);
    f32x4 ot[8][2];
    float mrun[2] = {-INFINITY, -INFINITY}, lsum[2] = {0.f, 0.f};
    if (fixedref) { mrun[0] = bnd; mrun[1] = bnd; }
    const float stinit = fixedref ? -bnd : 0.f;
#pragma unroll
    for (int mo = 0; mo < 8; ++mo) { ot[mo][0] = (f32x4){0.f, 0.f, 0.f, 0.f}; ot[mo][1] = (f32x4){0.f, 0.f, 0.f, 0.f}; }
    u32x4 sk, sv[2];
    const u32x4* kg = (const u32x4*)Kh; const u32x4* vg = (const u32x4*)VTh;
    const int krow = tid >> 3, kc8 = tid & 7;
    sk = kg[(size_t)t0 * 1024 + krow * 16 + mp * 8 + kc8];
#pragma unroll
    for (int i = 0; i < 2; ++i) sv[i] = vg[(size_t)t0 * 1024 + tid + i * 512];
    for (int kt = t0; kt < t1; ++kt) {
        unsigned char* kb = lds + (kt & 1) * 8192;
        unsigned char* vb = lds + 16384 + (kt & 1) * 16384;
        *(u32x4*)(kb + krow * 128 + ((kc8 ^ ((krow >> 1) & 7)) << 4)) = sk;
#pragma unroll
        for (int i = 0; i < 2; ++i) { const int g = tid + i * 512, d = g >> 3, cc = g & 7; *(u32x4*)(vb + d * 128 + ((cc ^ ((d >> 1) & 7)) << 4)) = sv[i]; }
        __syncthreads();
        if (kt + 1 < t1) {
            sk = kg[(size_t)(kt + 1) * 1024 + krow * 16 + mp * 8 + kc8];
#pragma unroll
            for (int i = 0; i < 2; ++i) sv[i] = vg[(size_t)(kt + 1) * 1024 + tid + i * 512];
        }
        if (kt <= wlimit) {
            bf16x8 kf[4][2], vfa[8];
#pragma unroll
            for (int m = 0; m < 4; ++m)
#pragma unroll
                for (int ks = 0; ks < 2; ++ks) kf[m][ks] = *(const bf16x8*)(kb + (m * 16 + r16) * 128 + (((ks * 4 + q4) ^ ((r16 >> 1) & 7)) << 4));
#pragma unroll
            for (int mo = 0; mo < 8; ++mo) { const int d = mo * 16 + r16; vfa[mo] = *(const bf16x8*)(vb + d * 128 + (((0 * 4 + q4) ^ ((d >> 1) & 7)) << 4)); }
            SCHED();
            f32x4 st[4][2];
#pragma unroll
            for (int m = 0; m < 4; ++m) { st[m][0] = (f32x4){stinit, stinit, stinit, stinit}; st[m][1] = (f32x4){stinit, stinit, stinit, stinit}; }
            SETPRIO(1);
#pragma unroll
            for (int ks = 0; ks < 2; ++ks)
#pragma unroll
                for (int m = 0; m < 4; ++m) { st[m][0] = MFMA16(kf[m][ks], qf[0][ks], st[m][0]); st[m][1] = MFMA16(kf[m][ks], qf[1][ks], st[m][1]); }
            SETPRIO(0);
            SCHED();
            float alpha[2] = {1.f, 1.f};
            if (fixedref) {
#pragma unroll
                for (int n = 0; n < 2; ++n) {
                    float ps = 0.f;
#pragma unroll
                    for (int m = 0; m < 4; ++m)
#pragma unroll
                        for (int j = 0; j < 4; ++j) { const float pv = FAST_EXP2(st[m][n][j]); st[m][n][j] = pv; ps += pv; }
                    lsum[n] += ps;
                }
            } else
#pragma unroll
            for (int n = 0; n < 2; ++n) {
                float mx = -INFINITY;
#pragma unroll
                for (int m = 0; m < 4; ++m)
#pragma unroll
                    for (int j = 0; j < 4; ++j) mx = fmaxf(mx, st[m][n][j]);
                mx = xrow16_max(mx);
                const float mnew = fmaxf(mrun[n], mx);
                alpha[n] = FAST_EXP2(mrun[n] - mnew);
                mrun[n] = mnew;
                float ps = 0.f;
#pragma unroll
                for (int m = 0; m < 4; ++m)
#pragma unroll
                    for (int j = 0; j < 4; ++j) { const float pv = FAST_EXP2(st[m][n][j] - mnew); st[m][n][j] = pv; ps += pv; }
                lsum[n] = lsum[n] * alpha[n] + ps;
            }
            if (ANY_LANE(alpha[0] != 1.f)) {
#pragma unroll
                for (int mo = 0; mo < 8; ++mo) ot[mo][0] *= alpha[0];
            }
            if (ANY_LANE(alpha[1] != 1.f)) {
#pragma unroll
                for (int mo = 0; mo < 8; ++mo) ot[mo][1] *= alpha[1];
            }
            bf16x8 pf[2][2];
#pragma unroll
            for (int kk = 0; kk < 2; ++kk)
#pragma unroll
                for (int n = 0; n < 2; ++n) {
                    u32x4 pw;
                    pw.x = pack2(st[2 * kk][n][0], st[2 * kk][n][1]); pw.y = pack2(st[2 * kk][n][2], st[2 * kk][n][3]);
                    pw.z = pack2(st[2 * kk + 1][n][0], st[2 * kk + 1][n][1]); pw.w = pack2(st[2 * kk + 1][n][2], st[2 * kk + 1][n][3]);
                    pf[kk][n] = __builtin_bit_cast(bf16x8, pw);
                }
            bf16x8 vfb[8];
#pragma unroll
            for (int mo = 0; mo < 8; ++mo) { const int d = mo * 16 + r16; vfb[mo] = *(const bf16x8*)(vb + d * 128 + (((1 * 4 + q4) ^ ((d >> 1) & 7)) << 4)); }
            SCHED();
            SETPRIO(1);
#pragma unroll
            for (int mo = 0; mo < 8; ++mo) { ot[mo][0] = MFMA16(vfa[mo], pf[0][0], ot[mo][0]); ot[mo][1] = MFMA16(vfa[mo], pf[0][1], ot[mo][1]); }
            SCHED();
#pragma unroll
            for (int mo = 0; mo < 8; ++mo) { ot[mo][0] = MFMA16(vfb[mo], pf[1][0], ot[mo][0]); ot[mo][1] = MFMA16(vfb[mo], pf[1][1], ot[mo][1]); }
            SETPRIO(0);
        }
    }
    if (q0w >= DCH * 64 * c)
#pragma unroll
    for (int n = 0; n < 2; ++n) {
        float l = lsum[n]; l = xrow16_sum(l);
        const int row = dpart_row(c, q0w + n * 16 + r16);
#pragma unroll
        for (int mo = 0; mo < 8; ++mo) {
            u32x2 o; o.x = pack2(ot[mo][n][0], ot[mo][n][1]); o.y = pack2(ot[mo][n][2], ot[mo][n][3]);
            *(u32x2*)(Op + (size_t)(row * 128 + mo * 16 + 4 * q4)) = o;
        }
        if (q4 == 0) { ML[row * 2] = mrun[n]; ML[row * 2 + 1] = l; }
    }
    __syncthreads();
}

__device__ __forceinline__ void lru_unit_a(int chunk, int grp, int l, const Params& p, const bf16_t* Xr, const bf16_t* WaiT, float* hloc, float* ploc, float* sumA, float* sumH,
                                           unsigned char* lds, int tid) {
    const int lane = tid & 63, wave = tid >> 6, r16 = lane & 15, q4 = lane >> 4;
    unsigned char* XCB = lds; float* XU = (float*)(lds + 16384); float* LA = (float*)(lds + 49152); float* ENDS = (float*)(lds + 81920);
    const int t0 = chunk * 64, ch0 = grp * 128;
    bf16x8 bfr[2][4];
#pragma unroll
    for (int g = 0; g < 2; ++g)
#pragma unroll
        for (int ks = 0; ks < 4; ++ks) bfr[g][ks] = *(const bf16x8*)(WaiT + ((size_t)grp * 256 + g * 128 + wave * 16 + r16) * 128 + ks * 32 + q4 * 8);
    const int chg = ch0 + wave * 16 + r16;
    const float ba = p.in[I_BA][(size_t)l * LRU_W + chg], bi = p.in[I_BI][(size_t)l * LRU_W + chg];
    const float lam_raw = p.in[I_LAM][(size_t)l * LRU_W + chg];
    {
        const int c = tid & 127, tq = tid >> 7, ch = ch0 + c;
        const float* cw = p.in[I_CONVW] + (size_t)l * 4 * LRU_W + ch; const float cb = p.in[I_CONVB][(size_t)l * LRU_W + ch];
        const float w0 = cw[0], w1 = cw[LRU_W], w2 = cw[2 * LRU_W], w3 = cw[3 * LRU_W];
        const int ts = t0 + tq * 16;
        float x0 = (ts - 3 >= 0) ? bf2f(Xr[(size_t)(ts - 3) * LRU_W + ch]) : 0.f;
        float x1 = (ts - 2 >= 0) ? bf2f(Xr[(size_t)(ts - 2) * LRU_W + ch]) : 0.f;
        float x2 = (ts - 1 >= 0) ? bf2f(Xr[(size_t)(ts - 1) * LRU_W + ch]) : 0.f;
#pragma unroll
        for (int i = 0; i < 16; ++i) {
            const float x3 = bf2f(Xr[(size_t)(ts + i) * LRU_W + ch]);
            const float v = cb + w0 * x0 + w1 * x1 + w2 * x2 + w3 * x3;
            const int row = tq * 16 + i;
            XU[row * 128 + c] = v;
            *(bf16_t*)(XCB + row * 256 + (((c >> 3) ^ (row & 15)) << 4) + (c & 7) * 2) = f2bf(v);
            x0 = x1; x1 = x2; x2 = x3;
        }
    }
    __syncthreads();
    {
        const float lsl = 8.0f * log_sigmoid_f(lam_raw);
#pragma unroll
        for (int mt = 0; mt < 4; ++mt) {
            f32x4 ga = (f32x4){0.f, 0.f, 0.f, 0.f}, gi = (f32x4){0.f, 0.f, 0.f, 0.f};
#pragma unroll
            for (int ks = 0; ks < 4; ++ks) {
                const bf16x8 af = *(const bf16x8*)(XCB + (mt * 16 + r16) * 256 + (((ks * 4 + q4) ^ r16) << 4));
                ga = MFMA16(af, bfr[0][ks], ga); gi = MFMA16(af, bfr[1][ks], gi);
            }
#pragma unroll
            for (int j = 0; j < 4; ++j) {
                const int row = mt * 16 + 4 * q4 + j, idx = row * 128 + wave * 16 + r16;
                const float r = sigmoid_f(ga[j] + ba), ig = sigmoid_f(gi[j] + bi);
                const float log_a = lsl * r;
                LA[idx] = fexp(log_a);
                XU[idx] = sqrtf(neg_expm1_f(2.f * log_a)) * (ig * XU[idx]);
            }
        }
    }
    __syncthreads();
    {
        const int c = tid & 127, tq = tid >> 7, ch = ch0 + c;
        float h = 0.f, P = 1.f;
#pragma unroll
        for (int i = 0; i < 16; ++i) { const int idx = (tq * 16 + i) * 128 + c; const float a = LA[idx]; h = a * h + XU[idx]; P *= a; XU[idx] = h; LA[idx] = P; }
        ENDS[tq * 128 + c] = P; ENDS[512 + tq * 128 + c] = h;
        __syncthreads();
        float cin = 0.f, pin = 1.f;
        for (int s = 0; s < tq; ++s) { const float Ps = ENDS[s * 128 + c], hs = ENDS[512 + s * 128 + c]; cin = Ps * cin + hs; pin *= Ps; }
#pragma unroll
        for (int i = 0; i < 16; ++i) {
            const int idx = (tq * 16 + i) * 128 + c; const size_t gi = (size_t)(t0 + tq * 16 + i) * LRU_W + ch;
            const float Pl = LA[idx], hl = XU[idx];
            ((unsigned*)hloc)[gi] = pack2(hl + Pl * cin, Pl * pin);
        }
        if (tq == 3) { const float Pl = LA[63 * 128 + c], hl = XU[63 * 128 + c]; sumA[(size_t)chunk * LRU_W + ch] = Pl * pin; sumH[(size_t)chunk * LRU_W + ch] = hl + Pl * cin; }
    }
    __syncthreads();
}

__device__ __forceinline__ void moe_prefix(const int* cntb_, int G, unsigned char* lds, int tid) {
    int* tmp = (int*)lds; int* ctot = (int*)(lds + LDS_MISC + M_CTOT); int* coff = (int*)(lds + LDS_MISC + M_COFF);
    unsigned short* pre16 = (unsigned short*)(lds + LDS_MISC + M_PRE16);
    const int e = tid & 31, part = tid >> 5, PB = (G + 15) / 16;
    int sm = 0;
    for (int i = 0; i < PB; ++i) { const int b = part * PB + i; if (b < G) sm += cntb_[b * 32 + e]; }
    tmp[part * 32 + e] = sm;
    __syncthreads();
    int run = 0;
    for (int q = 0; q < part; ++q) run += tmp[q * 32 + e];
    for (int i = 0; i < PB; ++i) { const int b = part * PB + i; if (b < G) { pre16[e * 257 + b] = (unsigned short)run; run += cntb_[b * 32 + e]; } }
    if (part == 15) { ctot[e] = run; pre16[e * 257 + G] = (unsigned short)run; }
    __syncthreads();
    if (tid == 0) { int o = 0; for (int q = 0; q < 32; ++q) { coff[q] = o; o += ctot[q]; } coff[32] = o; }
    __syncthreads();
}
__device__ __forceinline__ void moe_rowtable(const int* ltok_, const float* lw_, const int* lslot_, int e, int m0, int c_e, int G, int segcap, unsigned char* lds, int tid_in) {
    int tid = tid_in; OPAQUE(tid);
    const unsigned short* pre = (const unsigned short*)(lds + LDS_MISC + M_PRE16) + e * 257;
    int* rtok = (int*)(lds + LDS_MISC + M_RTOK); float* rw = (float*)(lds + LDS_MISC + M_RW); int* rslot = (int*)(lds + LDS_MISC + M_RSLOT);
    if (tid < 256) {
        const int g = m0 + tid;
        int tk = 0, sl = 0; float w = 0.f;
        if (g < c_e) {
            int lo = 0, hi = G;
            while (hi - lo > 1) { const int mid = (lo + hi) >> 1; if ((int)pre[mid] <= g) lo = mid; else hi = mid; }
            const int idx = (e * G + lo) * segcap + (g - (int)pre[lo]);
            tk = ltok_[idx]; w = lw_[idx]; sl = lslot_[idx];
        }
        rtok[tid] = tk; rw[tid] = w; rslot[tid] = sl;
    }
    __syncthreads();
}
#define kmax2 ((float*)(wsl + A_KMAX))
#define dpo ((bf16_t*)(wsl + A_DPO))
#define dpml ((float*)(wsl + A_DPML))
#define cntb ((int*)(wsl + A_CNTB))
#define WinT ((bf16_t*)(wsl + WB_WIN))
#define WoT ((bf16_t*)(wsl + WB_WO))
#define WguT ((bf16_t*)(wsl + WB_WGU))
#define WdT ((bf16_t*)(wsl + WB_WD))
#define WaiT ((bf16_t*)(wsl + WB_WAI))
#define Wfa ((float*)(wsl + WF_FA))
#define W36b ((bf16_t*)(wsl + WF_R36))
#define ropecs ((float*)(wsl + WF_ROPE))
#define xb ((bf16_t*)(wsl + A_XB))
#define hb ((float*)(wsl + A_HB))
#define logf_ ((float*)(wsl + A_LOGF))
#define cum2 ((float*)(wsl + A_CUM))
#define Qa ((bf16_t*)(wsl + A_QA))
#define Ka ((bf16_t*)(wsl + A_KA))
#define VaT ((bf16_t*)(wsl + A_VAT))
#define Xr ((bf16_t*)(wsl + A_XR))
#define Gr ((bf16_t*)(wsl + A_GR))
#define Qc ((bf16_t*)(wsl + A_QC))
#define Kc ((bf16_t*)(wsl + A_KC))
#define VcT ((bf16_t*)(wsl + A_VCT))
#define hloc ((float*)(wsl + A_HLOC))
#define ploc ((float*)(wsl + A_PLOC))
#define sumA ((float*)(wsl + A_SUMA))
#define sumH ((float*)(wsl + A_SUMH))
#define concat ((bf16_t*)(wsl + A_CONCAT))
#define y1 ((float*)(wsl + A_Y1))
#define h1 ((float*)(wsl + A_H1))
#define h1b ((bf16_t*)(wsl + A_H1B))
#define ltok ((int*)(wsl + A_LTOK))
#define lw ((float*)(wsl + A_LW))
#define lslot ((int*)(wsl + A_LSLOT))
#define act ((bf16_t*)(wsl + A_ACT))
#define contrib ((bf16_t*)(wsl + A_CONTRIB))
#ifndef EMU
__global__ void __launch_bounds__(NTHREADS, 2)
#else
void
#endif
fwd_kernel(Params p) {
    DYN_LDS(lds_raw);
    float* ldsf = (float*)lds_raw;
    const int bid = blockIdx.x, G = gridDim.x;
    const int gthreads = G * NTHREADS, gwaves = G * (NTHREADS / 64);
    const int wave_s = RFL((int)threadIdx.x >> 6);
#define PHASE_IDS() unsigned char* wsl = ws; OPAQUE_S(wsl); int tid = wave_s * 64 + LANE_ID(); OPAQUE(tid); const int lane = tid & 63, wave = tid >> 6, gtid = bid * NTHREADS + tid, gwave = bid * (NTHREADS / 64) + wave; (void)lane; (void)wave; (void)gtid; (void)gwave

    unsigned char* ws = p.ws;
    volatile LAS unsigned* bst = (volatile LAS unsigned*)(lds_raw + LDS_MISC);
    unsigned* ubox = (unsigned*)(lds_raw + LDS_MISC + 16);
    if (threadIdx.x == 0) { bst[0] = 0u; bst[1] = 0u; bst[2] = 0u; bst[3] = 0u; }
    __syncthreads();
    XcdBarrier bar = xcd_barrier_post((unsigned*)ws, bst);

    const int* positions = (const int*)p.in[I_POS];

    constexpr int NPH = 8;
    const int lo = p.lo, hi = p.hi;
#ifdef ONLY_PHASE
#define PH_SEL(c) ((c) == ONLY_PHASE)
#else
#define PH_SEL(c) 1
#endif
#define PH_IN(k) (lo <= (k) && (k) < hi)
#define PH_BAR(k) do { if ((k) + 1 < hi) xcd_barrier(bar, wave_s == 0 && LANE_ID() == 0); } while (0)

    if (PH_SEL(-1) && PH_IN(0)) for (int rep = 0; rep < PH_REPS(-1); ++rep) {
        PHASE_IDS();
        for (int l = 0; l < DEPTH; ++l) {
            convert_mats(p.in[I_WIN] + (size_t)l * D * N_IN, 0, 1, N_IN, D, N_IN, WinT + (size_t)l * N_INP * D, 0, RmWin{}, ldsf, tid, bid, G);
            for (int t = bid; t < (D / 64) * (D / 256); t += G)
                convert_tile_v4(p.in[I_WO] + (size_t)l * D * D, D, D, (t / (D / 256)) * 64, (t % (D / 256)) * 256, WoT + (size_t)l * D * D, RmIdent{}, ldsf, tid);
            convert_mats(p.in[I_WA] + (size_t)l * 6 * 128 * 128, (size_t)128 * 128, 6, 128, 128, 128, WaiT + (size_t)l * 6 * 256 * 128, (size_t)256 * 128, RmIdent{}, ldsf, tid, bid, G);
            convert_mats(p.in[I_WI] + (size_t)l * 6 * 128 * 128, (size_t)128 * 128, 6, 128, 128, 128, WaiT + (size_t)l * 6 * 256 * 128, (size_t)256 * 128, RmOff{128}, ldsf, tid, bid, G);
        }
        for (int i = gtid; i < DEPTH * 8 * D; i += gthreads) { const int k = i % D, h = (i / D) % 8, l = i / (8 * D);
            Wfa[i] = (h < 6) ? p.in[I_WIN][(size_t)l * D * N_IN + (size_t)k * N_IN + C_FA + h] : 0.f; }
        for (int i = gtid; i < DEPTH * 48 * D; i += gthreads) { const int k = i % D, o = (i / D) % 48, l = i / (48 * D);
            const float w = (o < 4) ? p.in[I_WGRP][((size_t)l * D + k) * 4 + o] : (o < 36 ? p.in[I_WRT][((size_t)l * D + k) * 32 + (o - 4)] : 0.f);
            const bf16_t hi = f2bf(w);
            W36b[((size_t)l * 2 + 0) * 48 * D + (size_t)o * D + k] = hi; W36b[((size_t)l * 2 + 1) * 48 * D + (size_t)o * D + k] = f2bf(w - bf2f(hi)); }
        for (int i = gtid; i < S * 8; i += gthreads) { const int d = i & 7, t = i >> 3; const float ang = (float)positions[t] * p.inv_freq[d];
            ropecs[t * 16 + d] = cosf(ang); ropecs[t * 16 + 8 + d] = sinf(ang); }
        __syncthreads();
        for (int i = tid; i < 6 * D; i += NTHREADS) { const int k = i % D, h = i / D; ldsf[i] = p.in[I_WIN][(size_t)k * N_IN + C_FA + h]; }
        __syncthreads();
        for (int t0 = gwave * 2; t0 < S; t0 += gwaves * 2) {
            f32x4 v[2][8];
#pragma unroll
            for (int tk = 0; tk < 2; ++tk)
#pragma unroll
                for (int j = 0; j < 8; ++j) v[tk][j] = *(const f32x4*)(p.in[I_X] + (size_t)(t0 + tk) * D + j * 256 + lane * 4);
#pragma unroll
            for (int tk = 0; tk < 2; ++tk) {
                const int t = t0 + tk;
                float fa[6] = {0.f, 0.f, 0.f, 0.f, 0.f, 0.f};
#pragma unroll
                for (int j = 0; j < 8; ++j) {
                    const int c = j * 256 + lane * 4;
                    u32x2 o; o.x = pack2(v[tk][j][0], v[tk][j][1]); o.y = pack2(v[tk][j][2], v[tk][j][3]);
                    *(u32x2*)(xb + (size_t)t * D + c) = o;
#pragma unroll
                    for (int h = 0; h < 6; ++h) { const f32x4 w = *(const f32x4*)(ldsf + h * D + c); fa[h] += v[tk][j][0] * w[0] + v[tk][j][1] * w[1] + v[tk][j][2] * w[2] + v[tk][j][3] * w[3]; }
                    COMPILER_FENCE();
                }
#pragma unroll
                for (int h = 0; h < 6; ++h) { const float sm = wave_sum(fa[h]); if (lane == 0) logf_[h * S + t] = log_sigmoid_f(sm + p.in[I_BF][h]); }
            }
        }
        PH_BAR(0);
    }

    for (int l = 0; l < DEPTH; ++l) {
        const int pb = 1 + l * NPH;
#define hin ((l == 0) ? p.in[I_X] : (const float*)hb)
#define hout ((l == DEPTH - 1) ? p.out : hb)
#define workctr ((int*)(wsl + CTL_WORK_OFF) + l * 64)

        if (PH_SEL(0) && PH_IN(pb + 0)) {
            PHASE_IDS();
            int bz = RFL(bid); OPAQUE_S(bz);
            if (bz == 0) {
                double* part = (double*)lds_raw;
                const int per = S / 64;
                double s = 0.0;
                if (wave < 6) { for (int i = 0; i < per; ++i) s += (double)logf_[wave * S + lane * per + i]; part[wave * 64 + lane] = s; }
                __syncthreads();
                if (wave < 6) {
                    double run = 0.0;
                    for (int j = 0; j < lane; ++j) run += part[wave * 64 + j];
                    for (int i = 0; i < per; ++i) { run += (double)logf_[wave * S + lane * per + i]; cum2[wave * S + lane * per + i] = (float)(run * (double)LOG2E); }
                }
                __syncthreads();
            }
            bool conv_more = (l == 0);
#define CONV_ONE() do { if (conv_more) { __syncthreads(); if (tid == 0) *ubox = (unsigned)atomic_add_int((int*)(wsl + CTL_WORK_OFF) + 62, 1); __syncthreads(); \
                const int cid_ = RFL((int)*ubox); if (cid_ < NCONV) moe_conv_chunk(p, cid_, WguT, WdT, ldsf, tid); else conv_more = false; } } while (0)
            unsigned* cls = (unsigned*)(wsl + CTL_CLS_OFF) + l * 256;
            if (bz == 0) { WAIT_VM0(); __syncthreads(); if (tid == 0) { FENCE_REL_AGENT(); WAIT_VM0(); (void)xb_add(&cls[192], 1u); } }
            const bf16_t* Bt = WinT + (size_t)l * N_INP * D;
            constexpr int ntm = S / 256;
            const unsigned nooff[2][2] = {{0u, 0u}, {0u, 0u}};
            for (int i = 0; i < (bid & 3); ++i) CONV_ONE();
            for (;;) {
                __syncthreads();
                if (tid == 0) *ubox = (unsigned)atomic_add_int(workctr + 9, 1);
                __syncthreads();
                int t = RFL((int)*ubox);
                if (t >= ntm * 21) break;
                int pm, pn, kcls;
                if (t < ntm * 6) { pm = t / 6; pn = 15 + t % 6; kcls = 0; }
                else if (t < ntm * 12) { t -= ntm * 6; pm = t / 6; pn = 9 + t % 6; kcls = 1; }
                else { t -= ntm * 12; pm = t / 9; pn = t % 9; kcls = 2; }
                f32x4 acc[2][2][4][2];
                gemm_tile<false>(xb, pm * 256, nooff, Bt, pn * 256, D, lds_raw, acc, tid);
                int et = tid; OPAQUE(et); const int wr = et >> 8, wc = (et >> 6) & 3, fr = et & 15, fq = (et >> 4) & 3;
                if (pn < 6 || (pn >= 9 && pn < 19)) {
                    bf16_t* dst; float scale = 1.f; bool rope = false;
                    if (pn < 3) { dst = Qa; scale = QSCALE_A; } else if (pn < 6) { dst = Ka; } else if (pn < 12) { dst = Xr; } else if (pn < 15) { dst = Gr; }
                    else if (pn < 17) { dst = Qc; scale = QSCALE_C; rope = true; } else { dst = Kc; rope = true; }
                    const bool headmajor = (pn < 6) || (pn >= 15);
                    const int segpn = (pn < 3) ? pn : (pn < 6) ? pn - 3 : (pn < 12) ? pn - 9 : (pn < 15) ? pn - 12 : (pn < 17) ? pn - 15 : pn - 17;
#pragma unroll
                    for (int ai = 0; ai < 2; ++ai)
#pragma unroll
                        for (int m = 0; m < 4; ++m)
#pragma unroll
                            for (int bj = 0; bj < 2; ++bj)
#pragma unroll
                                for (int n = 0; n < 2; ++n) {
                                    const int dd = wc * 32 + n * 16 + fr;
#pragma unroll
                                    for (int j = 0; j < 4; ++j) {
                                        const int row = pm * 256 + ai * 128 + wr * 64 + m * 16 + fq * 4 + j;
                                        float v = acc[ai][bj][m][n][j];
                                        if (rope && n == 0 && (wc & 1) == 0) {
                                            const float pv = SHX(v, 8);
                                            const float cs = ropecs[row * 16 + (fr & 7)], sn = ropecs[row * 16 + 8 + (fr & 7)];
                                            v = (fr < 8) ? (v * cs - pv * sn) : (v * cs + pv * sn);
                                        }
                                        v *= scale;
                                        *(bf16_t*)(lds_raw + (ai * 128 + wr * 64 + m * 16 + fq * 4 + j) * 528 + (bj * 128 + dd) * 2) = f2bf(v);
                                    }
                                }
                    __syncthreads();
#pragma unroll 4
                    for (int i = 0; i < 16; ++i) {
                        const int idx = et + i * 512, lrow = idx >> 5, ch = idx & 31, row = pm * 256 + lrow;
                        const u32x4 val = *(const u32x4*)(lds_raw + lrow * 528 + ch * 16);
                        size_t gi;
                        if (headmajor) gi = ((size_t)(segpn * 2 + (ch >> 4)) * S + row) * 128 + (ch & 15) * 8;
                        else gi = (size_t)row * LRU_W + segpn * 256 + ch * 8;
                        *(u32x4*)(dst + gi) = val;
                    }
                    __syncthreads();
                    if (pn >= 15) {
                        float* part = ldsf;
#pragma unroll
                        for (int ai = 0; ai < 2; ++ai)
#pragma unroll
                            for (int m = 0; m < 4; ++m)
#pragma unroll
                                for (int bj = 0; bj < 2; ++bj)
#pragma unroll
                                    for (int j = 0; j < 4; ++j) {
                                        float ss = acc[ai][bj][m][0][j] * acc[ai][bj][m][0][j] + acc[ai][bj][m][1][j] * acc[ai][bj][m][1][j];
                                        ss += SHX(ss, 1); ss += SHX(ss, 2); ss += SHX(ss, 4); ss += SHX(ss, 8);
                                        if (fr == 0) part[(wc * 2 + bj) * 256 + ai * 128 + wr * 64 + m * 16 + fq * 4 + j] = ss;
                                    }
                        __syncthreads();
                        {
                            const int bj = et >> 8, row = et & 255;
                            float v0 = part[(0 * 2 + bj) * 256 + row] + part[(1 * 2 + bj) * 256 + row], v1 = part[(2 * 2 + bj) * 256 + row] + part[(3 * 2 + bj) * 256 + row];
                            v0 = fmaxf(v0, SHX(v0, 1)); v0 = fmaxf(v0, SHX(v0, 2)); v0 = fmaxf(v0, SHX(v0, 4)); v0 = fmaxf(v0, SHX(v0, 8)); v0 = xrow16_max(v0);
                            v1 = fmaxf(v1, SHX(v1, 1)); v1 = fmaxf(v1, SHX(v1, 2)); v1 = fmaxf(v1, SHX(v1, 4)); v1 = fmaxf(v1, SHX(v1, 8)); v1 = xrow16_max(v1);
                            if ((et & 63) == 0) {
                                unsigned* q2p = (unsigned*)(wsl + CTL_QK2_OFF) + l * 16 + (pn >= 17 ? 8 : 0) + (segpn * 2 + bj) * 2;
                                atomic_max_u32(q2p, __builtin_bit_cast(unsigned, v0)); atomic_max_u32(q2p + 1, __builtin_bit_cast(unsigned, v1));
                            }
                        }
                        __syncthreads();
                    }
                    if (pn >= 3 && pn < 6) {
                        float* part = ldsf;
#pragma unroll
                        for (int ai = 0; ai < 2; ++ai)
#pragma unroll
                            for (int m = 0; m < 4; ++m)
#pragma unroll
                                for (int bj = 0; bj < 2; ++bj)
#pragma unroll
                                    for (int j = 0; j < 4; ++j) {
                                        float ss = acc[ai][bj][m][0][j] * acc[ai][bj][m][0][j] + acc[ai][bj][m][1][j] * acc[ai][bj][m][1][j];
                                        ss += SHX(ss, 1); ss += SHX(ss, 2); ss += SHX(ss, 4); ss += SHX(ss, 8);
                                        if (fr == 0) part[(wc * 2 + bj) * 256 + ai * 128 + wr * 64 + m * 16 + fq * 4 + j] = ss;
                                    }
                        __syncthreads();
                        {
                            const int bj = et >> 8, row = et & 255;
                            float v = part[(0 * 2 + bj) * 256 + row] + part[(1 * 2 + bj) * 256 + row] + part[(2 * 2 + bj) * 256 + row] + part[(3 * 2 + bj) * 256 + row];
                            v = fmaxf(v, SHX(v, 1)); v = fmaxf(v, SHX(v, 2)); v = fmaxf(v, SHX(v, 4)); v = fmaxf(v, SHX(v, 8)); v = xrow16_max(v);
                            if ((et & 63) == 0) kmax2[((pn - 3) * 2 + bj) * NKT + pm * 4 + ((et >> 6) & 3)] = v;
                        }
                        __syncthreads();
                    }
                } else {
                    bf16_t* dst = (pn < 9) ? VaT : VcT;
                    const int segpn = (pn < 9) ? pn - 6 : pn - 19;
#pragma unroll
                    for (int ai = 0; ai < 2; ++ai)
#pragma unroll
                        for (int m = 0; m < 4; ++m)
#pragma unroll
                            for (int bj = 0; bj < 2; ++bj)
#pragma unroll
                                for (int n = 0; n < 2; ++n) {
                                    const int dd = wc * 32 + n * 16 + fr;
                                    const int row = pm * 256 + ai * 128 + wr * 64 + m * 16 + fq * 4;
                                    const f32x4 a = acc[ai][bj][m][n];
                                    u32x2 o; o.x = pack2(a[0], a[1]); o.y = pack2(a[2], a[3]);
                                    const int s6 = row & 63, pos = (s6 & 32) + ((s6 >> 2) & 3) * 8 + ((s6 >> 4) & 1) * 4;
                                    *(u32x2*)(dst + (((size_t)(segpn * 2 + bj) * NKT + (row >> 6)) * 128 + dd) * 64 + pos) = o;
                                }
                }
                WAIT_VM0();
                __syncthreads();
                if (et == 0) { FENCE_REL_AGENT(); WAIT_VM0(); (void)xb_add(&cls[kcls * 64], 1u); }
                CONV_ONE();
            }
        }

        if (PH_SEL(1) && PH_IN(pb + 1)) {
            PHASE_IDS();
            const float lam_init = (l == 0) ? 0.2f : 0.35550906759f;
            const float s1 = wave_sum(p.in[I_LQ1][l * 64 + lane] * p.in[I_LK1][l * 64 + lane]);
            const float s2 = wave_sum(p.in[I_LQ2][l * 64 + lane] * p.in[I_LK2][l * 64 + lane]);
            const float lam = fexp(s1) - fexp(s2) + lam_init;
            constexpr int NLRU = NKT * 6, NQB = S / 128;
            bool conv_more = (l == 0);
            unsigned* cls = (unsigned*)(wsl + CTL_CLS_OFF) + l * 256;
            unsigned* bw = (unsigned*)wsl;
#define WAIT_CLASS(k, n) do { __syncthreads(); if (tid == 0) { XB_SPIN(xb_ld(&cls[(k) * 64]) < (unsigned)(n), bw); FENCE_ACQ_AGENT(); WAIT_VM0(); } __syncthreads(); } while (0)
#ifndef NO_DIFF
            {
                constexpr int NQB2 = S / 256;
                int total = 0;
                for (int q = 0; q < NQB2; ++q) total += ((4 * q + 4 + DCH - 1) / DCH) * 8;
                WAIT_CLASS(0, (S / 256) * 6);
                for (;;) {
                    __syncthreads();
                    if (tid == 0) *ubox = (unsigned)atomic_add_int(workctr, 1);
                    __syncthreads();
                    int u = RFL((int)*ubox);
                    if (u >= total) break;
                    int qb = NQB2 - 1;
                    for (;; --qb) { const int nu = ((4 * qb + 4 + DCH - 1) / DCH) * 8; if (u < nu) break; u -= nu; }
                    const int c = u >> 3, h = (u >> 1) & 3, mp = u & 1;
                    const int t0 = c * DCH, t1 = (t0 + DCH < 4 * qb + 4) ? t0 + DCH : 4 * qb + 4;
                    const unsigned* q2p = (const unsigned*)(wsl + CTL_QK2_OFF) + l * 16;
                    const float bnd = sqrtf(__builtin_bit_cast(float, q2p[h * 2 + mp]) * __builtin_bit_cast(float, q2p[8 + h * 2 + mp])) * (QSCALE_C * 1.02f) + 0.01f;
                    attn_dmap_unit(Qc + (size_t)h * S * 128, Kc + (size_t)h * S * 128, VcT + (size_t)h * S * 128, mp, qb, t0, t1,
                                   dpo + (size_t)(h * 2 + mp) * DPART_ROWS * 128, dpml + (size_t)(h * 2 + mp) * DPART_ROWS * 2, c, RFL_F(bnd), lds_raw, tid);
                    CONV_ONE();
                }
            }
#endif
#ifndef NO_LRU
            WAIT_CLASS(1, (S / 256) * 6);
            for (;;) {
                __syncthreads();
                if (tid == 0) *ubox = (unsigned)atomic_add_int(workctr + 10, 1);
                __syncthreads();
                const int u = RFL((int)*ubox);
                if (u >= NLRU) break;
                lru_unit_a(u / 6, u % 6, l, p, Xr, WaiT + (size_t)l * 6 * 256 * 128, hloc, ploc, sumA, sumH, lds_raw, tid);
            }
#endif
#ifndef NO_FOX
            WAIT_CLASS(2, (S / 256) * 9);
            WAIT_CLASS(3, 1);
            for (;;) {
                __syncthreads();
                if (tid == 0) *ubox = (unsigned)atomic_add_int(workctr + 1, 1);
                __syncthreads();
                const int u = RFL((int)*ubox);
                if (u >= NQB * FOX_H) break;
                const int qb = NQB - 1 - u / FOX_H, h = u % FOX_H;
                attn_unit<0>(Qa + (size_t)h * S * 128, Ka + (size_t)h * S * 128, VaT + (size_t)h * S * 128, cum2 + (size_t)h * S, kmax2 + h * NKT, qb, concat, h * 128,
                             0.f, 0.f, nullptr, lds_raw, tid);
            }
#endif
            while (conv_more) CONV_ONE();
            PH_BAR(pb + 1);
        }

        if (PH_SEL(2) && PH_IN(pb + 2)) for (int rep = 0; rep < PH_REPS(2); ++rep) {
            PHASE_IDS();
            for (int u = bid; u < NKT * 6; u += G) {
                const int chunk = u / 6, grp = u % 6, c = tid & 127, tq = tid >> 7, ch = grp * 128 + c;
                float cr = 0.f;
                {
                    int j = 0;
                    for (; j + 16 <= chunk; j += 16) {
                        float a8[16], h8[16];
#pragma unroll
                        for (int q = 0; q < 16; ++q) { a8[q] = sumA[(size_t)(j + q) * LRU_W + ch]; h8[q] = sumH[(size_t)(j + q) * LRU_W + ch]; }
#pragma unroll
                        for (int q = 0; q < 16; ++q) cr = a8[q] * cr + h8[q];
                    }
                    for (; j < chunk; ++j) cr = sumA[(size_t)j * LRU_W + ch] * cr + sumH[(size_t)j * LRU_W + ch];
                }
                float hl[16], pl[16]; bf16_t gg[16];
#pragma unroll
                for (int i = 0; i < 16; ++i) { const size_t gi = (size_t)(chunk * 64 + tq * 16 + i) * LRU_W + ch; const unsigned hp = ((const unsigned*)hloc)[gi]; hl[i] = bf2f((bf16_t)(hp & 0xffffu)); pl[i] = bf2f((bf16_t)(hp >> 16)); gg[i] = Gr[gi]; }
#pragma unroll
                for (int i = 0; i < 16; ++i)
                    concat[(size_t)(chunk * 64 + tq * 16 + i) * D + FOX_W + ch] = f2bf(gelu_tanh_f(bf2f(gg[i])) * (hl[i] + pl[i] * cr));
            }
            {
                const float lam_init = (l == 0) ? 0.2f : 0.35550906759f;
                const float s1 = wave_sum(p.in[I_LQ1][l * 64 + lane] * p.in[I_LK1][l * 64 + lane]);
                const float s2 = wave_sum(p.in[I_LQ2][l * 64 + lane] * p.in[I_LK2][l * 64 + lane]);
                const float lam = fexp(s1) - fexp(s2) + lam_init;
                const float* sg = p.in[I_SUBG] + l * 128;
                const float g0 = sg[2 * lane], g1 = sg[2 * lane + 1];
                static_assert(NCH <= 8, "the merge below keeps one (map, chunk) pair per lane: 2 x 8 lanes");
                for (int q = gwave; q < S; q += gwaves) {
                    const int nch = (q >> 6) / DCH + 1;
                    float mv = -INFINITY, lv = 0.f;
                    { const int c = lane & 7, hm = lane >> 3;
                      if (c < nch) { const float* ML = dpml + ((size_t)hm * DPART_ROWS + dpart_row(c, q)) * 2; mv = ML[0]; lv = ML[1]; } }
                    unsigned pk[4][2][NCH];
#pragma unroll
                    for (int h = 0; h < 4; ++h)
#pragma unroll
                        for (int mp = 0; mp < 2; ++mp) {
                            const unsigned* OP = (const unsigned*)(dpo + (size_t)(h * 2 + mp) * DPART_ROWS * 128);
#pragma unroll
                            for (int c = 0; c < NCH; ++c) pk[h][mp][c] = (c < nch) ? OP[(size_t)dpart_row(c, q) * 64 + lane] : 0u;
                        }
                    float Mx = mv; Mx = fmaxf(Mx, DPP_X1(Mx)); Mx = fmaxf(Mx, DPP_X2(Mx)); Mx = fmaxf(Mx, DPP_X7(Mx));
                    const float wv = (mv == -INFINITY) ? 0.f : FAST_EXP2(mv - Mx);
                    float Lp = lv * wv; Lp += DPP_X1(Lp); Lp += DPP_X2(Lp); Lp += DPP_X7(Lp);
#pragma unroll
                    for (int h = 0; h < 4; ++h) {
                        float om[2][2];
#pragma unroll
                        for (int mp = 0; mp < 2; ++mp) {
                            float o0 = 0.f, o1 = 0.f;
#pragma unroll
                            for (int c = 0; c < NCH; ++c) { const float w = RDLANE(wv, (h * 2 + mp) * 8 + c); o0 += bf2f((bf16_t)(pk[h][mp][c] & 0xffffu)) * w; o1 += bf2f((bf16_t)(pk[h][mp][c] >> 16)) * w; }
                            const float il = 1.f / RDLANE(Lp, (h * 2 + mp) * 8);
                            om[mp][0] = o0 * il; om[mp][1] = o1 * il;
                        }
                        const float v0 = om[0][0] - lam * om[1][0], v1 = om[0][1] - lam * om[1][1];
                        const float ss = wave_sum(v0 * v0 + v1 * v1);
                        const float rs = (1.f - lam_init) / sqrtf(ss * (1.f / 128.f) + LN_EPS);
                        *(unsigned*)(concat + (size_t)q * D + 1536 + h * 128 + 2 * lane) = pack2(v0 * rs * g0, v1 * rs * g1);
                    }
                }
            }
            PH_BAR(pb + 2);
        }

        if (PH_SEL(3) && PH_IN(pb + 3)) {
            PHASE_IDS();
            const bf16_t* Bt = WoT + (size_t)l * D * D;
            constexpr int ntn = D / 256, ntm = S / 256;
            static_assert(ntn == 8, "the panel exchange is written for 8 column tiles");
            const unsigned nooff[2][2] = {{0u, 0u}, {0u, 0u}};
            const float* g1 = p.in[I_LN1G] + (size_t)l * D; const float* b1 = p.in[I_LN1B] + (size_t)l * D;
            const float* bg = p.in[I_BGRP] + l * 4; const float* br = p.in[I_BRT] + l * 32;
            const bf16_t* Wb = W36b + (size_t)l * 2 * 48 * D;
            int* lcnt = (int*)(lds_raw + LDS_MISC + M_LCNT);
            const int segcap = ((ntm * ntn + G - 1) / G) * 32;
            unsigned* pcnt = (unsigned*)(wsl + CTL_PAN_OFF) + l * 1024;
            unsigned long long* xbuf = (unsigned long long*)(wsl + A_XBUF);
            unsigned* part = (unsigned*)(wsl + A_PART);
            LAS float* Stab = (LAS float*)(lds_raw + LDS_MISC + M_RTOK);
            float* lgt = (float*)(lds_raw + LDS_MISC + 4096);
            if (tid < 32) lcnt[tid] = 0;
            __syncthreads();
            for (int t0 = bid; t0 < ntm * ntn; t0 += G) {
                int t = t0;
                if (G == 256 && ntm * ntn == 256) { const int x = t0 & 7, j = t0 >> 3; t = (x * 4 + (j >> 3)) * ntn + (j & 7); }
                const int pm = t / ntn, pn = t % ntn;
                f32x4 v[2][16];
                {
                    f32x4 acc[2][2][4][2];
                    gemm_tile<false>(concat, pm * 256, nooff, Bt, pn * 256, D, lds_raw, acc, tid);
                    int et = tid; OPAQUE(et); const int wr = et >> 8, wc = (et >> 6) & 3, fr = et & 15, fq = (et >> 4) & 3;
#pragma unroll
                    for (int ai = 0; ai < 2; ++ai) {
#pragma unroll
                        for (int m = 0; m < 4; ++m)
#pragma unroll
                            for (int bj = 0; bj < 2; ++bj)
#pragma unroll
                                for (int n = 0; n < 2; ++n)
#pragma unroll
                                    for (int j = 0; j < 4; ++j)
                                        *(float*)(lds_raw + (wr * 64 + m * 16 + fq * 4 + j) * 1040 + (bj * 128 + wc * 32 + n * 16 + fr) * 4) = acc[ai][bj][m][n][j];
                        __syncthreads();
#pragma unroll
                        for (int i = 0; i < 16; ++i) {
                            const int lrow = i * 8 + (et >> 6), c4 = et & 63;
                            const size_t gi = (size_t)(pm * 256 + ai * 128 + lrow) * D + pn * 256 + c4 * 4;
                            v[ai][i] = *(const GAS f32x4*)(hin + gi);
                        }
#pragma unroll
                        for (int i = 0; i < 16; ++i) {
                            const int lrow = i * 8 + (et >> 6), c4 = et & 63;
                            v[ai][i] = ALPHA * v[ai][i] + *(const f32x4*)(lds_raw + lrow * 1040 + c4 * 16);
                        }
                        __syncthreads();
                    }
                }
                int et2 = tid; OPAQUE(et2); const int el = et2 & 63, ew = wave_s, er16 = et2 & 15, eq4 = (et2 >> 4) & 3;
                float my_mt = 0.f, my_m2 = 0.f;
#pragma unroll
                for (int ai = 0; ai < 2; ++ai)
#pragma unroll
                    for (int i = 0; i < 16; ++i) {
                        const f32x4 x = v[ai][i];
                        const float mt = wave_sum((x[0] + x[1]) + (x[2] + x[3])) * (1.f / 256.f);
                        const f32x4 d = x - mt;
                        const float m2 = wave_sum((d[0] * d[0] + d[1] * d[1]) + (d[2] * d[2] + d[3] * d[3]));
                        if (el == ai * 16 + i) { my_mt = mt; my_m2 = m2; }
                        COMPILER_FENCE();
                    }
                unsigned* bw = (unsigned*)wsl;
                if (el < 32) {
                    const int grow = (el >> 4) * 128 + (el & 15) * 8 + ew;
                    xst64(&xbuf[(size_t)(pm * 256 + grow) * 8 + pn], ((unsigned long long)__builtin_bit_cast(unsigned, my_m2) << 32) | __builtin_bit_cast(unsigned, my_mt));
                }
                WAIT_VM0();
                __syncthreads();
                if (et2 == 0) { (void)xb_add(&pcnt[pm * 16], 1u); XB_SPIN(xb_ld(&pcnt[pm * 16]) < 8u, bw); FENCE_ACQ_AGENT(); }
                __syncthreads();
                unsigned long long wk[4];
#pragma unroll
                for (int k = 0; k < 4; ++k) {
                    const int r = k * 8 + (el >> 3), grow = (r >> 4) * 128 + (r & 15) * 8 + ew;
                    wk[k] = xld64(&xbuf[(size_t)(pm * 256 + grow) * 8 + (el & 7)]);
                }
#pragma unroll
                for (int k = 0; k < 4; ++k) {
                    const int r = k * 8 + (el >> 3);
                    const unsigned long long w = wk[k];
                    const float mt = __builtin_bit_cast(float, (unsigned)w), m2 = __builtin_bit_cast(float, (unsigned)(w >> 32));
#if defined(DIAG) && DIAG == 10
                    const float mean = __builtin_bit_cast(float, __builtin_amdgcn_ds_bpermute(r << 2, __builtin_bit_cast(int, my_mt))) + 0.f * mt;
                    const float rstd = 1.f / sqrtf(__builtin_bit_cast(float, __builtin_amdgcn_ds_bpermute(r << 2, __builtin_bit_cast(int, my_m2))) * (1.f / 256.f) + LN_EPS) + 0.f * m2;
#else
                    float ms = mt; ms += DPP_X1(ms); ms += DPP_X2(ms); ms += DPP_X7(ms);
                    const float mean = ms * 0.125f, dm = mt - mean;
                    float q = m2 + 256.f * dm * dm; q += DPP_X1(q); q += DPP_X2(q); q += DPP_X7(q);
                    const float rstd = 1.f / sqrtf(q * (1.f / D) + LN_EPS);
#endif
                    if ((el & 7) == 0) { Stab[(ew * 32 + r) * 2] = mean; Stab[(ew * 32 + r) * 2 + 1] = rstd; }
                }
                WAVE_SYNC();
                const f32x4 gv = *(const f32x4*)(g1 + pn * 256 + el * 4), bv = *(const f32x4*)(b1 + pn * 256 + el * 4);
                LAS unsigned char* wt = (LAS unsigned char*)lds_raw + ew * 16384;
#pragma unroll
                for (int ai = 0; ai < 2; ++ai) {
#pragma unroll
                    for (int i = 0; i < 16; ++i) {
                        const float mean = Stab[(ew * 32 + ai * 16 + i) * 2], rstd = Stab[(ew * 32 + ai * 16 + i) * 2 + 1];
                        const f32x4 hv = mul_s4(v[ai][i] - mean, rstd) * gv + bv;
                        const size_t gi = (size_t)(pm * 256 + ai * 128 + i * 8 + ew) * D + pn * 256 + el * 4;
#if defined(DIAG) && DIAG == 4
                        *(f32x4*)(y1 + gi) = v[ai][i];
#elif defined(DIAG) && DIAG == 12
                        *(f32x4*)(y1 + gi) = v[ai][i] * 0.5f + 1.f;
#elif defined(DIAG) && DIAG == 13
                        *(f32x4*)(y1 + gi) = v[ai][i] - mean;
#elif defined(DIAG) && DIAG == 14
                        *(f32x4*)(y1 + gi) = v[ai][i] * rstd;
#elif defined(DIAG) && DIAG == 22
                        { f32x4 oo; const f32x4 aa = v[ai][i];
#pragma unroll
                          for (int c_ = 0; c_ < 4; ++c_) { float o_, a_ = aa[c_]; asm volatile("v_mul_f32_e32 %0, %1, %2" : "=v"(o_) : "v"(a_), "v"(rstd)); oo[c_] = o_; }
                          *(f32x4*)(y1 + gi) = oo; }
#elif defined(DIAG) && DIAG == 20
                        *(f32x4*)(y1 + gi) = (ew == 0) ? v[ai][i] * rstd : v[ai][i];
#elif defined(DIAG) && DIAG == 21
                        *(f32x4*)(y1 + gi) = (ew != 0) ? v[ai][i] * rstd : v[ai][i];
#elif defined(DIAG) && DIAG == 6
                        *(f32x4*)(y1 + gi) = gv + bv;
#elif defined(DIAG) && (DIAG == 7 || DIAG == 10)
                        *(f32x4*)(y1 + gi) = (v[ai][i] - mean) * rstd;
#elif defined(DIAG) && DIAG == 5
                        *(f32x4*)(y1 + gi) = (f32x4){mean, rstd, mean, rstd};
#else
                        *(f32x4*)(y1 + gi) = hv;
#endif
                        u32x2 o; o.x = pack2(hv[0], hv[1]); o.y = pack2(hv[2], hv[3]);
                        *(u32x2*)(h1b + gi) = o;
                        u32x2 lo2;
                        lo2.x = pack2(hv[0] - bf2f((bf16_t)(o.x & 0xffffu)), hv[1] - bf2f((bf16_t)(o.x >> 16)));
                        lo2.y = pack2(hv[2] - bf2f((bf16_t)(o.y & 0xffffu)), hv[3] - bf2f((bf16_t)(o.y >> 16)));
                        const int la = i * 512 + (((el >> 1) ^ i) << 4) + (el & 1) * 8;
                        *(LAS u32x2*)(wt + la) = o; *(LAS u32x2*)(wt + 8192 + la) = lo2;
                        COMPILER_FENCE();
                    }
                    WAVE_SYNC();
                    f32x4 ac[3];
#pragma unroll
                    for (int nt = 0; nt < 3; ++nt) ac[nt] = (f32x4){0.f, 0.f, 0.f, 0.f};
#pragma unroll 2
                    for (int ks = 0; ks < 8; ++ks) {
                        const int la = er16 * 512 + (((ks * 4 + eq4) ^ er16) << 4);
                        const bf16x8 ah = *(const LAS bf16x8*)(wt + la), al = *(const LAS bf16x8*)(wt + 8192 + la);
#pragma unroll
                        for (int nt = 0; nt < 3; ++nt) {
                            const bf16x8 bh = *(const bf16x8*)(Wb + (size_t)(nt * 16 + er16) * D + pn * 256 + ks * 32 + eq4 * 8);
                            const bf16x8 bl = *(const bf16x8*)(Wb + (size_t)48 * D + (size_t)(nt * 16 + er16) * D + pn * 256 + ks * 32 + eq4 * 8);
                            ac[nt] = MFMA16(ah, bh, ac[nt]); ac[nt] = MFMA16(al, bh, ac[nt]); ac[nt] = MFMA16(ah, bl, ac[nt]);
                        }
                        COMPILER_FENCE();
                    }
#pragma unroll
                    for (int nt = 0; nt < 3; ++nt)
#pragma unroll
                        for (int j = 0; j < 4; ++j) {
                            const float cv = ac[nt][j];
                            xst32(&part[((size_t)pn * S + pm * 256 + ai * 128 + (eq4 * 4 + j) * 8 + ew) * 48 + nt * 16 + er16], __builtin_bit_cast(unsigned, cv));
                        }
                    WAVE_SYNC();
                }
                WAIT_VM0();
                __syncthreads();
                if (et2 == 0) { (void)xb_add(&pcnt[512 + pm * 16], 1u); XB_SPIN(xb_ld(&pcnt[512 + pm * 16]) < 8u, bw); FENCE_ACQ_AGENT(); }
                __syncthreads();
                int rt = tid; OPAQUE(rt);
#pragma unroll
                for (int k = 0; k < 3; ++k) {
                    const int idx = rt + k * 512, tk = idx / 48, n = idx - tk * 48;
                    unsigned pq[8];
#pragma unroll
                    for (int q = 0; q < 8; ++q) pq[q] = xb_ld(&part[((size_t)q * S + pm * 256 + pn * 32 + tk) * 48 + n]);
                    float a = 0.f;
#pragma unroll
                    for (int q = 0; q < 8; ++q) a += __builtin_bit_cast(float, pq[q]);
                    lgt[idx] = a;
                }
                __syncthreads();
                if (rt < 32) {
                    const int t = pm * 256 + pn * 32 + rt; const float* L = lgt + rt * 48;
                    float gl[4];
#pragma unroll
                    for (int q = 0; q < 4; ++q) gl[q] = L[q] + bg[q];
                    int gi = 0; float gm = gl[0];
#pragma unroll
                    for (int q = 1; q < 4; ++q) if (gl[q] > gm) { gm = gl[q]; gi = q; }
                    float gs = 0.f;
#pragma unroll
                    for (int q = 0; q < 4; ++q) gs += fexp(gl[q] - gm);
                    const float gweight = 1.f / gs;
                    float E[8];
#pragma unroll
                    for (int e = 0; e < 8; ++e) E[e] = L[4 + gi * 8 + e] + br[gi * 8 + e];
                    int e1 = 0; float m1 = E[0];
#pragma unroll
                    for (int e = 1; e < 8; ++e) if (E[e] > m1) { m1 = E[e]; e1 = e; }
                    int e2 = -1; float m2 = -INFINITY;
#pragma unroll
                    for (int e = 0; e < 8; ++e) if (e != e1 && E[e] > m2) { m2 = E[e]; e2 = e; }
                    const float p2 = fexp(m2 - m1), w1 = 1.f / (1.f + p2), w2 = p2 / (1.f + p2);
                    const int ge1 = gi * 8 + e1, ge2 = gi * 8 + e2;
                    const int i1 = (ge1 * G + bid) * segcap + atomic_add_int(&lcnt[ge1], 1);
                    ltok[i1] = t; lw[i1] = gweight * w1; lslot[i1] = 0;
                    const int i2 = (ge2 * G + bid) * segcap + atomic_add_int(&lcnt[ge2], 1);
                    ltok[i2] = t; lw[i2] = gweight * w2; lslot[i2] = 1;
#ifdef DIAG
                    { float* dbg = (float*)(wsl + A_CONTRIB); dbg[t * 4 + 0] = (float)ge1; dbg[t * 4 + 1] = (float)ge2; dbg[t * 4 + 2] = gweight * w1; dbg[t * 4 + 3] = gweight * w2; }
#endif
                }
                __syncthreads();
            }
            { int ft = tid; OPAQUE(ft); if (ft < 32) cntb[bid * 32 + ft] = lcnt[ft]; }
            PH_BAR(pb + 3);
#ifdef DIAG
            if (l == DIAG_LAYER) {
                const float* dbg = (const float*)(wsl + A_CONTRIB);
                for (size_t i = gtid; i < (size_t)S * D / 4; i += gthreads) {
                    const size_t row = i / (D / 4); const int c4 = (int)(i % (D / 4));
                    f32x4 x = (f32x4){0.f, 0.f, 0.f, 0.f};
                    if (DIAG == 1 || DIAG >= 4) x = *(const f32x4*)(y1 + i * 4);
                    if (DIAG == 2 && c4 == 0) x = *(const f32x4*)(dbg + row * 4);
                    if (DIAG == 3) { const u32x2 hbv = *(const u32x2*)(h1b + i * 4); x = (f32x4){bf2f((bf16_t)(hbv.x & 0xffffu)), bf2f((bf16_t)(hbv.x >> 16)), bf2f((bf16_t)(hbv.y & 0xffffu)), bf2f((bf16_t)(hbv.y >> 16))}; }
                    *(f32x4*)(p.out + i * 4) = x;
                }
                return;
            }
#endif
        }

        if (PH_SEL(5) && PH_IN(pb + 5)) {
            PHASE_IDS();
            const unsigned nooff[2][2] = {{0u, 0u}, {0u, 0u}};
            const int segcap = ((S / 256 * (D / 256) + G - 1) / G) * 32;
            moe_prefix(cntb, G, lds_raw, tid);
            const int* ctot = (const int*)(lds_raw + LDS_MISC + M_CTOT); const int* coff = (const int*)(lds_raw + LDS_MISC + M_COFF);
            const int* rtok = (const int*)(lds_raw + LDS_MISC + M_RTOK); const float* rw = (const float*)(lds_raw + LDS_MISC + M_RW);
            const int* rslot = (const int*)(lds_raw + LDS_MISC + M_RSLOT);
            unsigned* done = (unsigned*)(wsl + CTL_DONE_OFF) + l * 1024;
            int nmt = 0;
            for (int e = 0; e < NEXP; ++e) nmt += (ctot[e] + 255) / 256;
            nmt = RFL(nmt);
            for (;;) {
                __syncthreads();
                if (tid == 0) *ubox = (unsigned)atomic_add_int(workctr + 8, 1);
                __syncthreads();
                int u = RFL((int)*ubox);
                if (u >= nmt * 12) break;
                const bool down = (u >= nmt * 4);
                const int per = down ? 8 : 4;
                if (down) u -= nmt * 4;
                int e = 0;
                for (;; ++e) { const int nt = ((RFL(ctot[e]) + 255) / 256) * per; if (u < nt) break; u -= nt; }
                const int c = RFL(ctot[e]), off = RFL(coff[e]);
                const int mt = u / per, pn = u % per, m0 = mt * 256;
                moe_rowtable(ltok, lw, lslot, e, m0, c, G, segcap, lds_raw, tid);
                f32x4 acc[2][2][4][2];
                if (!down) {
                    const bf16_t* Bt = WguT + ((size_t)l * NEXP + e) * 1024 * D;
                    unsigned aoff[2][2];
                    int st = tid; OPAQUE(st); int R[2], C[2]; stage_geom(st, R, C);
#pragma unroll
                    for (int h = 0; h < 2; ++h)
#pragma unroll
                        for (int i = 0; i < 2; ++i) aoff[h][i] = (unsigned)(rtok[h * 128 + R[i]] * D + C[i]);
                    gemm_tile<true>(h1b, 0, aoff, Bt, pn * 256, D, lds_raw, acc, tid);
                    int et = tid; OPAQUE(et); const int wr = et >> 8, wc = (et >> 6) & 3, fr = et & 15, fq = (et >> 4) & 3;
#pragma unroll
                    for (int ai = 0; ai < 2; ++ai)
#pragma unroll
                        for (int m = 0; m < 4; ++m)
#pragma unroll
                            for (int j = 0; j < 4; ++j) {
                                const int r = ai * 128 + wr * 64 + m * 16 + fq * 4 + j;
                                const float wgt = rw[r];
#pragma unroll
                                for (int bj = 0; bj < 2; ++bj)
                                    *(bf16_t*)(lds_raw + r * 272 + (bj * 64 + wc * 16 + fr) * 2) = f2bf(silu_f(acc[ai][bj][m][0][j]) * acc[ai][bj][m][1][j] * wgt);
                            }
                    __syncthreads();
#pragma unroll 4
                    for (int i = 0; i < 8; ++i) {
                        const int idx = et + i * 512, r = idx >> 4, ch = idx & 15;
                        if (m0 + r < c) *(u32x4*)(act + (size_t)(off + m0 + r) * DFF + pn * 128 + ch * 8) = *(const u32x4*)(lds_raw + r * 272 + ch * 16);
                    }
                    WAIT_VM0();
                    __syncthreads();
                    if (et == 0) { FENCE_REL_AGENT(); WAIT_VM0(); (void)xb_add(&done[e * 32 + mt], 1u); }
                } else {
                    const bf16_t* Bt = WdT + ((size_t)l * NEXP + e) * D * DFF;
                    if (tid == 0) {
                        unsigned* bw = (unsigned*)wsl;
                        XB_SPIN(xb_ld(&done[e * 32 + mt]) < 4u, bw);
                        FENCE_ACQ_AGENT();
                        WAIT_VM0();
                    }
                    __syncthreads();
                    gemm_tile<false>(act, off + m0, nooff, Bt, pn * 256, DFF, lds_raw, acc, tid);
                    int et = tid; OPAQUE(et); const int wr = et >> 8, wc = (et >> 6) & 3, fr = et & 15, fq = (et >> 4) & 3;
#pragma unroll
                    for (int ai = 0; ai < 2; ++ai)
#pragma unroll
                        for (int m = 0; m < 4; ++m)
#pragma unroll
                            for (int bj = 0; bj < 2; ++bj)
#pragma unroll
                                for (int n = 0; n < 2; ++n)
#pragma unroll
                                    for (int j = 0; j < 4; ++j)
                                        *(bf16_t*)(lds_raw + (ai * 128 + wr * 64 + m * 16 + fq * 4 + j) * 528 + (bj * 128 + wc * 32 + n * 16 + fr) * 2) = f2bf(acc[ai][bj][m][n][j]);
                    __syncthreads();
#pragma unroll 4
                    for (int i = 0; i < 16; ++i) {
                        const int idx = et + i * 512, r = idx >> 5, ch = idx & 31;
                        if (m0 + r < c) *(u32x4*)(contrib + ((size_t)rslot[r] * S + rtok[r]) * D + pn * 256 + ch * 8) = *(const u32x4*)(lds_raw + r * 528 + ch * 16);
                    }
                }
            }
            PH_BAR(pb + 5);
        }

        if (PH_SEL(7) && PH_IN(pb + 7)) for (int rep = 0; rep < PH_REPS(7); ++rep) {
            PHASE_IDS();
            const float* g2 = p.in[I_LN2G] + (size_t)l * D; const float* b2 = p.in[I_LN2B] + (size_t)l * D;
            const bool more = (l + 1 < DEPTH);
            f32x4 gq[8], bq[8];
#pragma unroll
            for (int j = 0; j < 8; ++j) { gq[j] = *(const f32x4*)(g2 + j * 256 + lane * 4); bq[j] = *(const f32x4*)(b2 + j * 256 + lane * 4); }
            if (more) {
                const float* wf = Wfa + (size_t)(l + 1) * 8 * D;
                __syncthreads();
                for (int i = tid; i < 6 * D / 4; i += NTHREADS) *(f32x4*)(ldsf + i * 4) = *(const f32x4*)(wf + i * 4);
                __syncthreads();
            }
            for (int t = gwave; t < S; t += gwaves) {
                f32x4 v[8]; float s = 0.f;
#pragma unroll
                for (int j = 0; j < 8; ++j) {
                    const size_t i = (size_t)t * D + j * 256 + lane * 4;
                    const u32x2 c0 = *(const u32x2*)(contrib + i), c1 = *(const u32x2*)(contrib + (size_t)S * D + i);
                    const f32x4 cs = (f32x4){bf2f((bf16_t)(c0.x & 0xffffu)) + bf2f((bf16_t)(c1.x & 0xffffu)), bf2f((bf16_t)(c0.x >> 16)) + bf2f((bf16_t)(c1.x >> 16)),
                                             bf2f((bf16_t)(c0.y & 0xffffu)) + bf2f((bf16_t)(c1.y & 0xffffu)), bf2f((bf16_t)(c0.y >> 16)) + bf2f((bf16_t)(c1.y >> 16))};
                    v[j] = ALPHA * *(const f32x4*)(y1 + i) + cs;
                    s += (v[j][0] + v[j][1]) + (v[j][2] + v[j][3]);
                }
                const float mean = wave_sum(s) * (1.f / D);
                float s2 = 0.f;
#pragma unroll
                for (int j = 0; j < 8; ++j) { v[j] -= mean; s2 += (v[j][0] * v[j][0] + v[j][1] * v[j][1]) + (v[j][2] * v[j][2] + v[j][3] * v[j][3]); }
                const float rstd = 1.f / sqrtf(wave_sum(s2) * (1.f / D) + LN_EPS);
                float fa[6] = {0.f, 0.f, 0.f, 0.f, 0.f, 0.f};
#pragma unroll
                for (int j = 0; j < 8; ++j) {
                    const int c = j * 256 + lane * 4;
                    v[j] = v[j] * rstd * gq[j] + bq[j];
                    *(f32x4*)(hout + (size_t)t * D + c) = v[j];
                    COMPILER_FENCE();
                    if (more) {
                        u32x2 o; o.x = pack2(v[j][0], v[j][1]); o.y = pack2(v[j][2], v[j][3]);
                        *(u32x2*)(xb + (size_t)t * D + c) = o;
#pragma unroll
                        for (int h = 0; h < 6; ++h) { const f32x4 w = *(const f32x4*)(ldsf + h * D + c); fa[h] += (v[j][0] * w[0] + v[j][1] * w[1]) + (v[j][2] * w[2] + v[j][3] * w[3]); }
                    }
                }
                if (more) {
#pragma unroll
                    for (int h = 0; h < 6; ++h) { const float sm = wave_sum(fa[h]); if (lane == 0) logf_[h * S + t] = log_sigmoid_f(sm + p.in[I_BF][(l + 1) * 6 + h]); }
                }
            }
            PH_BAR(pb + 7);
        }
    }
#undef PH_IN
#undef PH_BAR
}

constexpr int N_PHASES = 1 + DEPTH * 8;
#ifndef EMU
extern "C" void kernel_launch(void* const* d_in, const int* in_sizes, int n_in, void* d_out, int out_size, void* d_ws, size_t ws_size, hipStream_t stream) {
    static int grid = 0;
    if (grid == 0) {
        if (n_in != N_INPUTS || out_size != S * D || ws_size < WS_END) {
            fprintf(stderr, "kernel_launch: unexpected shapes: n_in %d out %d ws %zu (need %zu)\n", n_in, out_size, ws_size, (size_t)WS_END); grid = -1; return; }
        int dev = 0, cus = 0, per_cu = 0;
        if (hipGetDevice(&dev) != hipSuccess || hipDeviceGetAttribute(&cus, hipDeviceAttributeMultiprocessorCount, dev) != hipSuccess) { grid = -1; return; }
        if (hipFuncSetAttribute((const void*)fwd_kernel, hipFuncAttributeMaxDynamicSharedMemorySize, LDS_BYTES) != hipSuccess) { fprintf(stderr, "kernel_launch: hipFuncSetAttribute failed\n"); grid = -1; return; }
        if (hipOccupancyMaxActiveBlocksPerMultiprocessor(&per_cu, (const void*)fwd_kernel, NTHREADS, LDS_BYTES) != hipSuccess || per_cu < 1) {
            fprintf(stderr, "kernel_launch: occupancy query says %d blocks per CU\n", per_cu); (void)hipGetLastError(); grid = -1; return; }
        grid = cus;
    }
    if (grid < 0) return;
    (void)hipMemsetAsync(d_ws, 0, CTL_BYTES, stream);
    Params p{};
    for (int i = 0; i < N_INPUTS; ++i) p.in[i] = (const float*)d_in[i];
    p.out = (float*)d_out; p.ws = (unsigned char*)d_ws;
    for (int i = 0; i < 8; ++i) p.inv_freq[i] = (float)pow(500000.0, -(double)i * 2.0 / 16.0);
#if N_LAUNCH_SPLIT
    for (int k = 0; k < N_PHASES; ++k) { p.lo = k; p.hi = k + 1; hipLaunchKernelGGL(fwd_kernel, dim3(grid), dim3(NTHREADS), LDS_BYTES, stream, p); }
#else
    p.lo = 0; p.hi = N_PHASES;
    hipLaunchKernelGGL(fwd_kernel, dim3(grid), dim3(NTHREADS), LDS_BYTES, stream, p);
#endif
}
#endif
```

```cpp
#ifndef EMU
#include <hip/hip_runtime.h>
#include <cstdio>
#include <cstdint>
#include <cmath>
#endif

#ifndef SEQ
#define SEQ 8192
#endif
#ifndef N_LAUNCH_SPLIT
#define N_LAUNCH_SPLIT 0
#endif
#ifndef REP_PHASE
#define REP_PHASE -2
#endif
#define PH_REPS(c) ((c) == REP_PHASE ? 2 : 1)
#ifndef REP_SUB
#define REP_SUB 0
#endif

constexpr int S = SEQ, D = 2048, DEPTH = 2;
constexpr int FOX_H = 6, FOX_W = 768;
constexpr int LRU_W = 768;
constexpr int DIFF_H = 4, DIFF_W = 512;
constexpr int N_IN = 5382, N_INP = 5376;
constexpr int C_FA = 2304;
constexpr int NEXP = 32, DFF = 512;
constexpr int NKT = S / 64;
#ifndef DCH
#ifndef REP_ROUTER
#define REP_ROUTER 1
#endif
#define DCH 32
#endif
constexpr int NCH = (NKT + DCH - 1) / DCH;
constexpr size_t DPART_ROWS = (size_t)NCH * S - (size_t)(DCH * 64) * NCH * (NCH - 1) / 2;
constexpr float ALPHA = 1.41421356237309504880f;
constexpr float LN_EPS = 1e-5f;
constexpr float LOG2E = 1.4426950408889634f;
constexpr float QSCALE_A = 0.08838834764831845f * 1.4426950408889634f;
constexpr float QSCALE_C = 0.125f * 1.4426950408889634f;

enum { I_X = 0, I_POS, I_WIN, I_BF, I_CONVW, I_CONVB, I_WA, I_BA, I_WI, I_BI, I_LAM, I_LQ1, I_LK1, I_LQ2, I_LK2, I_SUBG, I_WO, I_LN1G, I_LN1B,
       I_WGRP, I_BGRP, I_WRT, I_BRT, I_WGATE, I_WUP, I_WDOWN, I_LN2G, I_LN2B, N_INPUTS };

typedef unsigned short bf16_t;
typedef short bf16x8 __attribute__((ext_vector_type(8)));
typedef float f32x4 __attribute__((ext_vector_type(4)));
typedef unsigned u32x4 __attribute__((ext_vector_type(4)));
typedef unsigned u32x2 __attribute__((ext_vector_type(2)));

constexpr size_t al256(size_t x) { return (x + 255) & ~(size_t)255; }
constexpr size_t CTL_BYTES = 65536;
constexpr size_t CTL_CNT_OFF = 32768;
constexpr size_t CTL_WORK_OFF = 36864;
constexpr size_t CTL_QK2_OFF = 57344;
constexpr size_t CTL_CLS_OFF = 49152;
constexpr size_t CTL_PAN_OFF = 16384;
constexpr size_t CTL_DONE_OFF = 40960;
constexpr size_t WB_WIN = CTL_BYTES;
constexpr size_t WB_WO = WB_WIN + al256((size_t)DEPTH * N_INP * D * 2);
constexpr size_t WB_WGU = WB_WO + al256((size_t)DEPTH * D * D * 2);
constexpr size_t WB_WD = WB_WGU + al256((size_t)DEPTH * NEXP * 1024 * D * 2);
constexpr size_t WB_WAI = WB_WD + al256((size_t)DEPTH * NEXP * D * DFF * 2);
constexpr size_t WF_FA = WB_WAI + al256((size_t)DEPTH * 6 * 256 * 128 * 2);
constexpr size_t WF_R36 = WF_FA + al256((size_t)DEPTH * 8 * D * 4);
constexpr size_t WF_ROPE = WF_R36 + al256((size_t)DEPTH * 2 * 48 * D * 2);
constexpr size_t A_XB = WF_ROPE + al256((size_t)S * 16 * 4);
constexpr size_t A_HB = A_XB + al256((size_t)S * D * 2);
constexpr size_t A_LOGF = A_HB + al256((size_t)S * D * 4);
constexpr size_t A_CUM = A_LOGF + al256((size_t)6 * S * 4);
constexpr size_t A_KMAX = A_CUM + al256((size_t)6 * S * 4);
constexpr size_t A_CNTB = A_KMAX + al256((size_t)6 * NKT * 4);
constexpr size_t A_QA = A_CNTB + al256((size_t)1024 * 32 * 4);
constexpr size_t A_KA = A_QA + al256((size_t)FOX_H * S * 128 * 2);
constexpr size_t A_VAT = A_KA + al256((size_t)FOX_H * S * 128 * 2);
constexpr size_t A_XR = A_VAT + al256((size_t)FOX_H * S * 128 * 2);
constexpr size_t A_GR = A_XR + al256((size_t)S * LRU_W * 2);
constexpr size_t A_QC = A_GR + al256((size_t)S * LRU_W * 2);
constexpr size_t A_KC = A_QC + al256((size_t)DIFF_H * S * 128 * 2);
constexpr size_t A_VCT = A_KC + al256((size_t)DIFF_H * S * 128 * 2);
constexpr size_t A_HLOC = A_VCT + al256((size_t)DIFF_H * S * 128 * 2);
constexpr size_t A_PLOC = A_HLOC + al256((size_t)S * LRU_W * 4);
constexpr size_t A_SUMA = A_PLOC + al256((size_t)S * LRU_W * 4);
constexpr size_t A_SUMH = A_SUMA + al256((size_t)NKT * LRU_W * 4);
constexpr size_t A_CONCAT = A_SUMH + al256((size_t)NKT * LRU_W * 4);
constexpr size_t A_Y1 = A_CONCAT + al256((size_t)S * D * 2);
constexpr size_t A_H1 = A_Y1 + al256((size_t)S * D * 4);
constexpr size_t A_H1B = A_H1 + al256((size_t)S * D * 4);
constexpr size_t A_LTOK = A_H1B + al256((size_t)S * D * 2);
constexpr size_t A_LW = A_LTOK + al256((size_t)NEXP * S * 4);
constexpr size_t A_LSLOT = A_LW + al256((size_t)NEXP * S * 4);
constexpr size_t A_ACT = A_LSLOT + al256((size_t)NEXP * S * 4);
constexpr size_t A_CONTRIB = A_ACT + al256((size_t)(2 * S + 256) * DFF * 2);
constexpr size_t WS_END = A_CONTRIB + al256((size_t)2 * S * D * 4);
constexpr size_t A_DPO = A_Y1;
constexpr size_t A_DPML = A_DPO + al256((size_t)8 * DPART_ROWS * 128 * 2);
static_assert(A_DPML + (size_t)8 * DPART_ROWS * 2 * 4 <= A_H1B, "differential partials must fit inside the y1 + h1 region");

constexpr size_t A_XBUF = A_H1 + al256((size_t)S * D * 2);
constexpr size_t A_PART = A_XBUF + al256((size_t)S * 8 * 8);
static_assert(A_PART + (size_t)8 * S * 48 * 4 <= A_H1B, "exchange buffers must fit inside the h1 region");
constexpr int NTHREADS = 512;
constexpr int LDS_MAIN = 131072 + 4096;
constexpr int LDS_MISC = LDS_MAIN;
constexpr int LDS_BYTES = LDS_MAIN + 8192 + 16640;
constexpr int M_PRE16 = 8192;
constexpr int M_LCNT = 64, M_CTOT = 256, M_COFF = 384, M_PRE = 512, M_RTOK = 2048, M_RW = 3072, M_RSLOT = 4096;

struct Params {
    const float* in[N_INPUTS];
    float* out;
    unsigned char* ws;
    float inv_freq[8];
    int lo, hi;
};

#ifndef EMU
#define LAS __attribute__((address_space(3)))
#define GAS __attribute__((address_space(1)))
#define DYN_LDS(name) extern __shared__ __attribute__((aligned(16))) unsigned char name[]
#define SLEEP1() __builtin_amdgcn_s_sleep(1)
#define WAVE_SYNC() __builtin_amdgcn_wave_barrier()
#define OPAQUE(x) asm volatile("" : "+v"(x))
#define COMPILER_FENCE() asm volatile("" ::: "memory")
#define RFL(x) __builtin_amdgcn_readfirstlane(x)
#define RFL_F(x) __builtin_bit_cast(float, __builtin_amdgcn_readfirstlane(__builtin_bit_cast(int, x)))
#define ANY_LANE(p) (__builtin_amdgcn_ballot_w64(p) != 0ull)
#define RDLANE(v, l) __builtin_bit_cast(float, __builtin_amdgcn_readlane(__builtin_bit_cast(int, v), l))
__device__ __forceinline__ int lane_id_volatile() { int l; asm volatile("v_mbcnt_lo_u32_b32 %0, -1, 0\n\tv_mbcnt_hi_u32_b32 %0, -1, %0" : "=v"(l)); return l; }
#define LANE_ID() lane_id_volatile()
#define OPAQUE_S(x) asm volatile("" : "+s"(x))
#define WAIT_VM0() asm volatile("s_waitcnt vmcnt(0)" ::: "memory")
#define WAIT_ALL0() __builtin_amdgcn_s_waitcnt(0)
#define FENCE_REL_AGENT() __builtin_amdgcn_fence(__ATOMIC_RELEASE, "agent")
#define FENCE_ACQ_AGENT() __builtin_amdgcn_fence(__ATOMIC_ACQUIRE, "agent")
#define MFMA16(a, b, c) __builtin_amdgcn_mfma_f32_16x16x32_bf16(a, b, c, 0, 0, 0)
#define GLDS16(g, l) __builtin_amdgcn_global_load_lds((const unsigned*)(g), (unsigned*)(l), 16, 0, 0)
#define WAIT_V(n) asm volatile("s_waitcnt vmcnt(" #n ")" ::: "memory")
#define WAIT_L(n) asm volatile("s_waitcnt lgkmcnt(" #n ")" ::: "memory")
#define BAR() __builtin_amdgcn_s_barrier()
#define SCHED() __builtin_amdgcn_sched_barrier(0)
#define SETPRIO(n) __builtin_amdgcn_s_setprio(n)
#define FAST_EXP2(x) __builtin_amdgcn_exp2f(x)
template <int M> __device__ __forceinline__ float shx_impl(float v, int lane) {
    if (M < 32) return __builtin_bit_cast(float, __builtin_amdgcn_ds_swizzle(__builtin_bit_cast(int, v), (M << 10) | 0x1f));
    return __builtin_bit_cast(float, __builtin_amdgcn_ds_bpermute((lane ^ 32) << 2, __builtin_bit_cast(int, v)));
}
#define SHX(v, M) shx_impl<M>(v, lane)
template <int CTRL> __device__ __forceinline__ float dppx(float x) { return __builtin_bit_cast(float, __builtin_amdgcn_mov_dpp(__builtin_bit_cast(int, x), CTRL, 0xf, 0xf, true)); }
#define DPP_X1(x) dppx<0xB1>(x)
#define DPP_X2(x) dppx<0x4E>(x)
#define DPP_X7(x) dppx<0x141>(x)
#define DPP_X8(x) dppx<0x128>(x)
#define xrow16_max(x) xrow16_max_l(x, lane)
#define xrow16_sum(x) xrow16_sum_l(x, lane)
__device__ __forceinline__ float xrow16_max_l(float x, int lane) { x = fmaxf(x, shx_impl<16>(x, lane)); return fmaxf(x, shx_impl<32>(x, lane)); }
__device__ __forceinline__ float xrow16_sum_l(float x, int lane) { x = x + shx_impl<16>(x, lane); return x + shx_impl<32>(x, lane); }
#define FAST_LOG2(x) __builtin_amdgcn_logf(x)
#define FAST_RCP(x) __builtin_amdgcn_rcpf(x)
__device__ __forceinline__ unsigned xb_ld(unsigned* p)              { return __hip_atomic_load(p, __ATOMIC_RELAXED, __HIP_MEMORY_SCOPE_AGENT); }
__device__ __forceinline__ unsigned xb_add(unsigned* p, unsigned v) { return __hip_atomic_fetch_add(p, v, __ATOMIC_RELAXED, __HIP_MEMORY_SCOPE_AGENT); }
__device__ __forceinline__ void xst64(unsigned long long* p, unsigned long long v) { __hip_atomic_store(p, v, __ATOMIC_RELAXED, __HIP_MEMORY_SCOPE_AGENT); }
__device__ __forceinline__ unsigned long long xld64(unsigned long long* p) { return __hip_atomic_load(p, __ATOMIC_RELAXED, __HIP_MEMORY_SCOPE_AGENT); }
__device__ __forceinline__ void xst32(unsigned* p, unsigned v) { __hip_atomic_store(p, v, __ATOMIC_RELAXED, __HIP_MEMORY_SCOPE_AGENT); }
__device__ __forceinline__ unsigned xb_xcc_id() { return (unsigned)__builtin_amdgcn_s_getreg((3 << 11) | 20) & 0xFu; }
__device__ __forceinline__ int atomic_add_int(int* p, int v) { return atomicAdd(p, v); }
__device__ __forceinline__ void atomic_min_int(int* p, int v) { atomicMin(p, v); }
__device__ __forceinline__ void atomic_max_u32(unsigned* p, unsigned v) { atomicMax(p, v); }
__device__ __forceinline__ unsigned pack2(float lo, float hi) { unsigned r; asm volatile("v_cvt_pk_bf16_f32 %0, %1, %2" : "=v"(r) : "v"(lo), "v"(hi)); return r; }
#else
#define MFMA16(a, b, c) emu_mfma_16x16x32_bf16(a, b, c)
#define GLDS16(g, l) emu_glds16((const void*)(g), (void*)(l))
#define WAIT_V(n) ((void)0)
#define WAIT_L(n) ((void)0)
#define BAR() __syncthreads()
#define SCHED() ((void)0)
#define SETPRIO(n) ((void)0)
#define FAST_EXP2(x) exp2f(x)
#define SHX(v, M) __shfl_xor(v, M)
#define DPP_X1(x) __shfl_xor(x, 1)
#define DPP_X2(x) __shfl_xor(x, 2)
#define DPP_X7(x) __shfl_xor(x, 7)
#define DPP_X8(x) __shfl_xor(x, 8)
static inline float xrow16_max(float x) { x = fmaxf(x, __shfl_xor(x, 16)); return fmaxf(x, __shfl_xor(x, 32)); }
static inline float xrow16_sum(float x) { x = x + __shfl_xor(x, 16); return x + __shfl_xor(x, 32); }
#define FAST_LOG2(x) log2f(x)
#define FAST_RCP(x) (1.f / (x))
static inline unsigned pack2(float lo, float hi) {
    unsigned a = __builtin_bit_cast(unsigned, lo), b = __builtin_bit_cast(unsigned, hi);
    a += 0x7fffu + ((a >> 16) & 1u); b += 0x7fffu + ((b >> 16) & 1u);
    return (a >> 16) | (b & 0xffff0000u);
}
#endif
__device__ __forceinline__ bf16_t f2bf(float f) { return (bf16_t)(pack2(f, 0.f) & 0xffffu); }
__device__ __forceinline__ float bf2f(bf16_t h) { return __builtin_bit_cast(float, (unsigned)h << 16); }

#define XB_TMO      128
#define XB_XCNT(j)  (256  + 64 * (j))
#define XB_XSUB(j)  (1280 + 64 * (j))
#define XB_XGEN(j)  (2304 + 64 * (j))
#define XB_TOP      3328
#define XB_TOPGEN   3392
#define XCD_BAR_WORDS 3456
#define XB_SPIN_CAP (1u << 22)
#define XB_SPIN(cond, bar) do { unsigned _sp = 0; while (cond) { SLEEP1(); \
    if ((++_sp & 255u) == 0u) { if (xb_ld(&(bar)[XB_TMO])) break; if (_sp > XB_SPIN_CAP) { xb_add(&(bar)[XB_TMO], 1u); break; } } } } while (0)

struct XcdBarrier { unsigned* bar; unsigned x; volatile LAS unsigned* st; };

__device__ __forceinline__ XcdBarrier xcd_barrier_post(unsigned* bar, volatile LAS unsigned* st) {
    XcdBarrier b; b.bar = bar; b.x = xb_xcc_id(); b.st = st;
    if (threadIdx.x == 0) (void)xb_add(&bar[XB_XCNT(b.x)], 1u);
    return b;
}
__device__ __forceinline__ void xcd_barrier_complete(unsigned* bar, unsigned x, unsigned& nloc, unsigned& nx) {
    const unsigned G = gridDim.x;
    unsigned sum, cnt, mine, sp = 0u;
    for (;;) {
        sum = 0u; cnt = 0u; mine = 0u;
#pragma unroll
        for (unsigned j = 0; j < 16; ++j) { const unsigned c = xb_ld(&bar[XB_XCNT(j)]); sum += c; cnt += (c > 0u) ? 1u : 0u; mine = (j == x) ? c : mine; }
        if (sum == G) break;
        SLEEP1();
        if ((++sp & 255u) == 0u) { if (xb_ld(&bar[XB_TMO])) break; if (sp > XB_SPIN_CAP) { xb_add(&bar[XB_TMO], 1u); break; } }
    }
    nloc = mine > 0u ? mine : 1u; nx = cnt > 0u ? cnt : 1u;
}
__device__ __forceinline__ void xcd_barrier(const XcdBarrier& b, bool leader) {
    WAIT_VM0();
    __syncthreads();
    if (leader) {
        unsigned* bar = b.bar;
        WAIT_ALL0();
        unsigned nloc = b.st[0], nx = b.st[1];
        if (nloc == 0u) { xcd_barrier_complete(bar, b.x, nloc, nx); b.st[0] = nloc; b.st[1] = nx; }
        const unsigned old = xb_add(&bar[XB_XSUB(b.x)], 1u);
        const unsigned gen = old / nloc;
        if (old + 1u == (gen + 1u) * nloc) {
            FENCE_REL_AGENT();
            WAIT_VM0();
            const unsigned og = xb_add(&bar[XB_TOP], 1u);
            const unsigned tg = og / nx;
            if (og + 1u == (tg + 1u) * nx) xb_add(&bar[XB_TOPGEN], 1u);
            else XB_SPIN(xb_ld(&bar[XB_TOPGEN]) == tg, bar);
            FENCE_ACQ_AGENT();
            xb_add(&bar[XB_XGEN(b.x)], 1u);
            WAIT_VM0();
        } else {
            XB_SPIN(xb_ld(&bar[XB_XGEN(b.x)]) == gen, bar);
            FENCE_ACQ_AGENT();
            WAIT_VM0();
        }
    }
    __syncthreads();
}

__device__ __forceinline__ f32x4 mul_s4(f32x4 a, float s) {
#ifdef EMU
    return a * s;
#else
    f32x4 o;
#pragma unroll
    for (int c = 0; c < 4; ++c) { float r, x = a[c]; asm volatile("v_mul_f32_e32 %0, %1, %2" : "=v"(r) : "v"(x), "v"(s)); o[c] = r; }
    return o;
#endif
}
__device__ __forceinline__ float wave_sum_l(float v, int lane) {
    (void)lane;
    v += DPP_X1(v); v += DPP_X2(v); v += DPP_X7(v); v += DPP_X8(v);
    return xrow16_sum(v);
}
#define wave_sum(v) wave_sum_l(v, lane)
__device__ __forceinline__ float fexp(float x) { return FAST_EXP2(x * LOG2E); }
__device__ __forceinline__ float sigmoid_f(float x) { return FAST_RCP(1.f + fexp(-x)); }
__device__ __forceinline__ float log_sigmoid_f(float x) { return fminf(x, 0.f) - 0.6931471805599453f * FAST_LOG2(1.f + fexp(-fabsf(x))); }
__device__ __forceinline__ float gelu_tanh_f(float x) { const float u = 0.7978845608028654f * (x + 0.044715f * x * x * x); return x * FAST_RCP(1.f + fexp(-2.f * u)); }
__device__ __forceinline__ float silu_f(float x) { return x * FAST_RCP(1.f + fexp(-x)); }
__device__ __forceinline__ float neg_expm1_f(float x) {
    const float ser = -x * (1.f + x * (0.5f + x * (0.16666667f + x * (0.041666668f + x * (0.008333334f + x * 0.0013888889f)))));
    return (x > -0.35f) ? ser : (1.f - fexp(x));
}

struct RmIdent { __device__ __forceinline__ int operator()(int n) const { return n; } };
struct RmWin { __device__ __forceinline__ int operator()(int n) const { return n < C_FA ? n : (n < C_FA + 6 ? -1 : n - 6); } };
struct RmGu { int kind; __device__ __forceinline__ int operator()(int f) const { return (f >> 7) * 256 + ((f >> 6) & 1) * 128 + ((f >> 4) & 3) * 32 + kind * 16 + (f & 15); } };
struct RmOff { int off; __device__ __forceinline__ int operator()(int n) const { return n + off; } };

template <class RM>
__device__ __forceinline__ void convert_tile(const float* src, int ld, int K, int Nsrc, int k0, int n0, bf16_t* dst, const RM& rm, float* T, int tid) {
    {
        const int nn = tid & 255, kh = (tid >> 8) * 32, n = n0 + nn;
        const float* sp = src + (size_t)(k0 + kh) * ld + n;
        float v[32];
#pragma unroll
        for (int i = 0; i < 32; ++i) v[i] = (n < Nsrc) ? sp[(size_t)i * ld] : 0.f;
#pragma unroll
        for (int i = 0; i < 32; ++i) T[(kh + i) * 257 + nn] = v[i];
    }
    __syncthreads();
#pragma unroll
    for (int q = 0; q < 4; ++q) {
        const int nn = q * 64 + (tid >> 3), kc = (tid & 7) * 8, n = n0 + nn;
        const int row = (n < Nsrc) ? rm(n) : -1;
        if (row >= 0) {
            u32x4 o;
            o.x = pack2(T[(kc + 0) * 257 + nn], T[(kc + 1) * 257 + nn]); o.y = pack2(T[(kc + 2) * 257 + nn], T[(kc + 3) * 257 + nn]);
            o.z = pack2(T[(kc + 4) * 257 + nn], T[(kc + 5) * 257 + nn]); o.w = pack2(T[(kc + 6) * 257 + nn], T[(kc + 7) * 257 + nn]);
            *(u32x4*)(dst + (size_t)row * K + k0 + kc) = o;
        }
    }
    __syncthreads();
}
template <class RM>
__device__ __forceinline__ void convert_tile_v4(const float* src, int ld, int K, int k0, int n0, bf16_t* dst, const RM& rm, float* T, int tid_in) {
    int tid = tid_in; OPAQUE(tid);
    {
        const int w = tid >> 6, l4 = (tid & 63) * 4;
        const float* sp = src + (size_t)(k0 + w * 8) * ld + n0 + l4;
        f32x4 v[8];
#pragma unroll
        for (int i = 0; i < 8; ++i) v[i] = *(const f32x4*)(sp + (size_t)i * ld);
#pragma unroll
        for (int i = 0; i < 8; ++i) { float* tp = T + (w * 8 + i) * 257 + l4; tp[0] = v[i][0]; tp[1] = v[i][1]; tp[2] = v[i][2]; tp[3] = v[i][3]; }
    }
    __syncthreads();
#pragma unroll
    for (int q = 0; q < 4; ++q) {
        const int nn = q * 64 + (tid >> 3), kc = (tid & 7) * 8, n = n0 + nn;
        const int row = rm(n);
        u32x4 o;
        o.x = pack2(T[(kc + 0) * 257 + nn], T[(kc + 1) * 257 + nn]); o.y = pack2(T[(kc + 2) * 257 + nn], T[(kc + 3) * 257 + nn]);
        o.z = pack2(T[(kc + 4) * 257 + nn], T[(kc + 5) * 257 + nn]); o.w = pack2(T[(kc + 6) * 257 + nn], T[(kc + 7) * 257 + nn]);
        *(u32x4*)(dst + (size_t)row * K + k0 + kc) = o;
    }
    __syncthreads();
}
template <class RM>
__device__ __forceinline__ void convert_mats(const float* src, size_t sstride, int nmat, int ld, int K, int Nsrc, bf16_t* dst, size_t dstride, const RM& rm,
                                             float* T, int tid, int bid, int G) {
    const int tk = K / 64, tn = (Nsrc + 255) / 256, per = tk * tn, total = nmat * per;
    for (int t = bid; t < total; t += G) {
        const int mi = t / per, r = t % per;
        convert_tile(src + (size_t)mi * sstride, ld, K, Nsrc, (r / tn) * 64, (r % tn) * 256, dst + (size_t)mi * dstride, rm, T, tid);
    }
}

constexpr int NCONV = DEPTH * 768;
__device__ __forceinline__ void moe_conv_chunk(const Params& p, int cid, bf16_t* WguT_, bf16_t* WdT_, float* T, int tid) {
    const int l = cid / 768, r = cid % 768, kind = r >> 8, t0 = (r & 255) * 8;
    for (int t = t0; t < t0 + 8; ++t) {
        const int mi = t >> 6, rr = t & 63;
        if (kind < 2) {
            const float* src = p.in[kind == 0 ? I_WGATE : I_WUP] + ((size_t)l * NEXP + mi) * D * DFF;
            convert_tile_v4(src, DFF, D, (rr >> 1) * 64, (rr & 1) * 256, WguT_ + ((size_t)l * NEXP + mi) * 1024 * D, RmGu{kind}, T, tid);
        } else {
            const float* src = p.in[I_WDOWN] + ((size_t)l * NEXP + mi) * DFF * D;
            convert_tile_v4(src, D, DFF, (rr >> 3) * 64, (rr & 7) * 256, WdT_ + ((size_t)l * NEXP + mi) * D * DFF, RmIdent{}, T, tid);
        }
    }
}

constexpr int BK = 64, HTB = 128 * 64 * 2;
__device__ __forceinline__ int lds_byte(int r, int c) {
    const int st = (r >> 4) * 2 + (c >> 5), rr = r & 15, cc = c & 31, ob = rr * 64 + cc * 2;
    return st * 1024 + (ob ^ (((ob >> 9) & 1) << 5));
}
__device__ __forceinline__ void stage_rc(int b, int& R, int& C) {
    const int st = b / 1024, sb = b % 1024, swz = sb ^ (((sb >> 9) & 1) << 5);
    R = (st >> 1) * 16 + swz / 64; C = (st & 1) * 32 + (swz % 64) / 2;
}
template <bool GATHER>
__device__ __forceinline__ void gemm_tile(const bf16_t* A, int arow0, const unsigned (&aoff)[2][2], const bf16_t* Bt, int brow0, int K,
                                          unsigned char* shm, f32x4 (&acc)[2][2][4][2], int tid_in) {
    int tid = tid_in; OPAQUE(tid);
    unsigned toff; { int R0, C0; stage_rc(tid * 16, R0, C0); toff = (unsigned)(R0 * K + C0); }
#define SA(b, h) (shm + ((b) * 2 + (h)) * HTB)
#define SB(b, h) (shm + (4 + (b) * 2 + (h)) * HTB)
#define STAGE_B(P, h, kt) do { _Pragma("unroll") for (int _i = 0; _i < 2; ++_i) GLDS16(Bt + ((size_t)(brow0 + (h) * 128 + _i * 64) * K + (size_t)(kt) * BK) + toff, (P) + tid * 16 + _i * 8192); } while (0)
#define STAGE_A(P, h, kt) do { _Pragma("unroll") for (int _i = 0; _i < 2; ++_i) { \
    if (GATHER) GLDS16(A + (size_t)(kt) * BK + aoff[h][_i], (P) + tid * 16 + _i * 8192); \
    else GLDS16(A + ((size_t)(arow0 + (h) * 128 + _i * 64) * K + (size_t)(kt) * BK) + toff, (P) + tid * 16 + _i * 8192); } } while (0)
#define LDA(dst, b, h) _Pragma("unroll") for (int m = 0; m < 4; ++m) _Pragma("unroll") for (int k = 0; k < 2; ++k) \
    dst[m][k] = *reinterpret_cast<const bf16x8*>(SA(b, h) + lds_byte(wr * 64 + m * 16 + fr, k * 32 + fq * 8))
#define LDB(dst, b, h) _Pragma("unroll") for (int n = 0; n < 2; ++n) _Pragma("unroll") for (int k = 0; k < 2; ++k) \
    dst[n][k] = *reinterpret_cast<const bf16x8*>(SB(b, h) + lds_byte(wc * 32 + n * 16 + fr, k * 32 + fq * 8))
#define MMA(ai, bj, At, Bx) do { SETPRIO(1); \
    _Pragma("unroll") for (int m = 0; m < 4; ++m) _Pragma("unroll") for (int n = 0; n < 2; ++n) _Pragma("unroll") for (int k = 0; k < 2; ++k) \
      acc[ai][bj][m][n] = MFMA16(At[m][k], Bx[n][k], acc[ai][bj][m][n]); \
    SETPRIO(0); } while (0)
    int wid = tid >> 6, lane = tid & 63, wr = wid >> 2, wc = wid & 3, fr = lane & 15, fq = lane >> 4;
#pragma unroll
    for (int a = 0; a < 2; ++a)
#pragma unroll
        for (int b = 0; b < 2; ++b)
#pragma unroll
            for (int m = 0; m < 4; ++m)
#pragma unroll
                for (int n = 0; n < 2; ++n) acc[a][b][m][n] = (f32x4){0.f, 0.f, 0.f, 0.f};
    bf16x8 At[4][2], B0[2][2], B1[2][2];
    const int nt = K / BK;
    STAGE_B(SB(0, 0), 0, 0); STAGE_A(SA(0, 0), 0, 0);
    STAGE_B(SB(0, 1), 1, 0); STAGE_A(SA(0, 1), 1, 0);
    if (wr == 1) BAR();
    WAIT_V(4); BAR();
    STAGE_B(SB(1, 0), 0, 1); STAGE_A(SA(1, 0), 0, 1); STAGE_B(SB(1, 1), 1, 1);
    WAIT_V(6); BAR();
    for (int t = 0; t < nt - 2; t += 2) {
        LDB(B0, 0, 0); SCHED(); LDA(At, 0, 0); STAGE_A(SA(1, 1), 1, t + 1);
        WAIT_L(8); BAR(); WAIT_L(0); MMA(0, 0, At, B0); BAR(); SCHED();
        LDB(B1, 0, 1); STAGE_B(SB(0, 0), 0, t + 2);
        BAR(); WAIT_L(0); MMA(0, 1, At, B1); BAR();
        LDA(At, 0, 1); STAGE_A(SA(0, 0), 0, t + 2);
        BAR(); WAIT_L(0); MMA(1, 0, At, B0); BAR(); SCHED();
        STAGE_B(SB(0, 1), 1, t + 2);
        WAIT_V(6); BAR(); MMA(1, 1, At, B1); BAR();
        LDB(B0, 1, 0); SCHED(); LDA(At, 1, 0); STAGE_A(SA(0, 1), 1, t + 2);
        WAIT_L(8); BAR(); WAIT_L(0); MMA(0, 0, At, B0); BAR(); SCHED();
        LDB(B1, 1, 1); STAGE_B(SB(1, 0), 0, t + 3);
        BAR(); WAIT_L(0); MMA(0, 1, At, B1); BAR();
        LDA(At, 1, 1); STAGE_A(SA(1, 0), 0, t + 3);
        BAR(); WAIT_L(0); MMA(1, 0, At, B0); BAR(); SCHED();
        STAGE_B(SB(1, 1), 1, t + 3);
        WAIT_V(6); BAR(); MMA(1, 1, At, B1); BAR();
    }
    OPAQUE(tid); wid = tid >> 6; lane = tid & 63; wr = wid >> 2; wc = wid & 3; fr = lane & 15; fq = lane >> 4;
    { LDB(B0, 0, 0); WAIT_V(0); LDA(At, 0, 0); STAGE_A(SA(1, 1), 1, nt - 1);
      BAR(); WAIT_L(0); MMA(0, 0, At, B0); BAR();
      LDB(B1, 0, 1); BAR(); WAIT_L(0); MMA(0, 1, At, B1); BAR();
      LDA(At, 0, 1); WAIT_V(4); BAR(); WAIT_L(0); MMA(1, 0, At, B0); MMA(1, 1, At, B1); BAR(); }
    { LDB(B0, 1, 0); LDA(At, 1, 0); WAIT_V(2); BAR(); WAIT_L(0); MMA(0, 0, At, B0); BAR();
      LDB(B1, 1, 1); WAIT_V(0); BAR(); WAIT_L(0); MMA(0, 1, At, B1); BAR();
      LDA(At, 1, 1); BAR(); WAIT_L(0); MMA(1, 0, At, B0); MMA(1, 1, At, B1); BAR(); }
    if (wr == 0) BAR();
#undef SA
#undef SB
#undef STAGE_A
#undef STAGE_B
#undef LDA
#undef LDB
#undef MMA
}
__device__ __forceinline__ void stage_geom(int tid, int (&R)[2], int (&C)[2]) {
#pragma unroll
    for (int i = 0; i < 2; ++i) stage_rc(tid * 16 + i * 8192, R[i], C[i]);
}

constexpr int ATT_KBUF = 0, ATT_VBUF = 32768, ATT_CBUF = 65536;
template <int KIND>
__device__ __forceinline__ void attn_unit(const bf16_t* Q, const bf16_t* Kg, const bf16_t* VT, const float* cum2, const float* kmx, int qb, bf16_t* concat, int ccol0,
                                          float lam, float osc, const float* subg, unsigned char* lds, int tid) {
    const int lane = tid & 63, wave = tid >> 6, r16 = lane & 15, q4 = lane >> 4;
    const int q0w = qb * 128 + wave * 16, myq = q0w + r16;
    const int ntiles = 2 * qb + 2;
    const int wlimit = (KIND == 0) ? ((q0w + 15) >> 6) : (q0w >> 6);
    constexpr int NMAP = (KIND == 0) ? 1 : 2, NKS = (KIND == 0) ? 4 : 2;
    bf16x8 qf[NMAP][NKS];
#pragma unroll
    for (int mp = 0; mp < NMAP; ++mp)
#pragma unroll
        for (int ks = 0; ks < NKS; ++ks) qf[mp][ks] = *(const bf16x8*)(Q + (size_t)myq * 128 + mp * 64 + ks * 32 + q4 * 8);
    const float cq = (KIND == 0) ? cum2[myq] : 0.f;
    int kt0 = 0;
    if (KIND == 0) {
        float* wmax = (float*)(lds + ATT_CBUF + 512); int* kst = (int*)(lds + ATT_CBUF + 576);
        float qs = 0.f;
#pragma unroll
        for (int ks = 0; ks < NKS; ++ks)
#pragma unroll
            for (int j = 0; j < 8; ++j) { const float v = bf2f((bf16_t)qf[0][ks][j]); qs += v * v; }
        qs = xrow16_sum(qs);
        qs = fmaxf(qs, SHX(qs, 1)); qs = fmaxf(qs, SHX(qs, 2)); qs = fmaxf(qs, SHX(qs, 4)); qs = fmaxf(qs, SHX(qs, 8));
        if (lane == 0) wmax[wave] = qs;
        if (tid == 0) *kst = 2 * qb;
        __syncthreads();
        float qm = wmax[0];
#pragma unroll
        for (int w = 1; w < 8; ++w) qm = fmaxf(qm, wmax[w]);
        qm = sqrtf(qm) * 1.01f;
        const float kd = sqrtf(fmaxf(kmx[2 * qb], kmx[2 * qb + 1])) * 1.01f;
        if (tid < 2 * qb) {
            const float bias = cum2[qb * 128] - cum2[tid * 64 + 63];
            const bool skip = bias + qm * (sqrtf(kmx[tid]) * 1.01f + kd) < -40.f;
            if (!skip) atomic_min_int(kst, tid);
        }
        __syncthreads();
        kt0 = RFL(*kst);
    }
    f32x4 ot[NMAP][8];
    float mrun[NMAP], lsum[NMAP];
#pragma unroll
    for (int mp = 0; mp < NMAP; ++mp) { mrun[mp] = -INFINITY; lsum[mp] = 0.f;
#pragma unroll
        for (int mo = 0; mo < 8; ++mo) ot[mp][mo] = (f32x4){0.f, 0.f, 0.f, 0.f}; }
    u32x4 sk[2], sv[2]; float sc = 0.f;
    const u32x4* kg = (const u32x4*)Kg; const u32x4* vg = (const u32x4*)VT;
#pragma unroll
    for (int i = 0; i < 2; ++i) { sk[i] = kg[(size_t)kt0 * 1024 + tid + i * 512]; sv[i] = vg[(size_t)kt0 * 1024 + tid + i * 512]; }
    if (KIND == 0 && tid < 64) sc = cum2[kt0 * 64 + tid];
    for (int kt = kt0; kt < ntiles; ++kt) {
        unsigned char* kb = lds + ATT_KBUF + (kt & 1) * 16384;
        unsigned char* vb = lds + ATT_VBUF + (kt & 1) * 16384;
        float* cb = (float*)(lds + ATT_CBUF + (kt & 1) * 256);
#pragma unroll
        for (int i = 0; i < 2; ++i) {
            const int g = tid + i * 512;
            { const int row = g >> 4, c = g & 15; *(u32x4*)(kb + row * 256 + ((c ^ (row & 15)) << 4)) = sk[i]; }
            { const int d = g >> 3, c = g & 7; *(u32x4*)(vb + d * 128 + ((c ^ ((d >> 1) & 7)) << 4)) = sv[i]; }
        }
        if (KIND == 0 && tid < 64) cb[tid] = sc;
        __syncthreads();
        if (kt + 1 < ntiles) {
#pragma unroll
            for (int i = 0; i < 2; ++i) { sk[i] = kg[(size_t)(kt + 1) * 1024 + tid + i * 512]; sv[i] = vg[(size_t)(kt + 1) * 1024 + tid + i * 512]; }
            if (KIND == 0 && tid < 64) sc = cum2[(kt + 1) * 64 + tid];
        }
        if (kt <= wlimit) {
#pragma unroll
            for (int mp = 0; mp < NMAP; ++mp) {
                bf16x8 kf[4][NKS], vfa[8];
#pragma unroll
                for (int m = 0; m < 4; ++m)
#pragma unroll
                    for (int ks = 0; ks < NKS; ++ks) { const int c = (KIND == 0 ? 0 : mp * 8) + ks * 4 + q4; kf[m][ks] = *(const bf16x8*)(kb + (m * 16 + r16) * 256 + ((c ^ r16) << 4)); }
#pragma unroll
                for (int mo = 0; mo < 8; ++mo) { const int d = mo * 16 + r16; vfa[mo] = *(const bf16x8*)(vb + d * 128 + (((0 * 4 + q4) ^ ((d >> 1) & 7)) << 4)); }
                SCHED();
                f32x4 st[4];
#pragma unroll
                for (int m = 0; m < 4; ++m) st[m] = (f32x4){0.f, 0.f, 0.f, 0.f};
#pragma unroll
                for (int ks = 0; ks < NKS; ++ks)
#pragma unroll
                    for (int m = 0; m < 4; ++m) st[m] = MFMA16(kf[m][ks], qf[mp][ks], st[m]);
                SCHED();
                float mx = -INFINITY;
#pragma unroll
                for (int m = 0; m < 4; ++m) {
                    if (KIND == 0) {
                        const f32x4 ck = *(const f32x4*)(cb + m * 16 + 4 * q4);
#pragma unroll
                        for (int j = 0; j < 4; ++j) {
                            float y = st[m][j] + (cq - ck[j]);
                            if (kt * 64 + m * 16 + 4 * q4 + j > myq) y = -INFINITY;
                            st[m][j] = y;
                        }
                    }
#pragma unroll
                    for (int j = 0; j < 4; ++j) mx = fmaxf(mx, st[m][j]);
                }
                mx = xrow16_max(mx);
                const float mnew = fmaxf(mrun[mp], mx);
                const float alpha = FAST_EXP2(mrun[mp] - mnew);
                mrun[mp] = mnew;
                float ps = 0.f;
#pragma unroll
                for (int m = 0; m < 4; ++m)
#pragma unroll
                    for (int j = 0; j < 4; ++j) { const float pv = FAST_EXP2(st[m][j] - mnew); st[m][j] = pv; ps += pv; }
                lsum[mp] = lsum[mp] * alpha + ps;
#pragma unroll
                for (int mo = 0; mo < 8; ++mo) ot[mp][mo] *= alpha;
                bf16x8 pf[2];
#pragma unroll
                for (int kk = 0; kk < 2; ++kk) {
                    u32x4 pw;
                    pw.x = pack2(st[2 * kk][0], st[2 * kk][1]); pw.y = pack2(st[2 * kk][2], st[2 * kk][3]);
                    pw.z = pack2(st[2 * kk + 1][0], st[2 * kk + 1][1]); pw.w = pack2(st[2 * kk + 1][2], st[2 * kk + 1][3]);
                    pf[kk] = __builtin_bit_cast(bf16x8, pw);
                }
                bf16x8 vfb[8];
#pragma unroll
                for (int mo = 0; mo < 8; ++mo) { const int d = mo * 16 + r16; vfb[mo] = *(const bf16x8*)(vb + d * 128 + (((1 * 4 + q4) ^ ((d >> 1) & 7)) << 4)); }
                SCHED();
#pragma unroll
                for (int mo = 0; mo < 8; ++mo) ot[mp][mo] = MFMA16(vfa[mo], pf[0], ot[mp][mo]);
                SCHED();
#pragma unroll
                for (int mo = 0; mo < 8; ++mo) ot[mp][mo] = MFMA16(vfb[mo], pf[1], ot[mp][mo]);
            }
        }
    }
    float inv[NMAP];
#pragma unroll
    for (int mp = 0; mp < NMAP; ++mp) { float l = lsum[mp]; l = xrow16_sum(l); inv[mp] = 1.f / l; }
    if (KIND == 0) {
#pragma unroll
        for (int mo = 0; mo < 8; ++mo) {
            u32x2 o; o.x = pack2(ot[0][mo][0] * inv[0], ot[0][mo][1] * inv[0]); o.y = pack2(ot[0][mo][2] * inv[0], ot[0][mo][3] * inv[0]);
            *(u32x2*)(concat + (size_t)myq * D + ccol0 + mo * 16 + 4 * q4) = o;
        }
    } else {
        float ss = 0.f;
#pragma unroll
        for (int mo = 0; mo < 8; ++mo)
#pragma unroll
            for (int j = 0; j < 4; ++j) { const float v = ot[0][mo][j] * inv[0] - lam * (ot[NMAP - 1][mo][j] * inv[NMAP - 1]); ot[0][mo][j] = v; ss += v * v; }
        ss = xrow16_sum(ss);
        const float rs = osc / sqrtf(ss * (1.f / 128.f) + LN_EPS);
#pragma unroll
        for (int mo = 0; mo < 8; ++mo) {
            const f32x4 g = *(const f32x4*)(subg + mo * 16 + 4 * q4);
            u32x2 o; o.x = pack2(ot[0][mo][0] * rs * g[0], ot[0][mo][1] * rs * g[1]); o.y = pack2(ot[0][mo][2] * rs * g[2], ot[0][mo][3] * rs * g[3]);
            *(u32x2*)(concat + (size_t)myq * D + ccol0 + mo * 16 + 4 * q4) = o;
        }
    }
    __syncthreads();
}

__device__ __forceinline__ int dpart_row(int c, int q) { return c * (S - DCH * 64) - (DCH * 32) * c * (c - 1) + q; }
__device__ __forceinline__ void attn_dmap_unit(const bf16_t* Qh, const bf16_t* Kh, const bf16_t* VTh, int mp, int qb, int t0, int t1,
                                               bf16_t* Op, float* ML, int c, float bnd, unsigned char* lds, int tid) {
    const bool fixedref = (bnd <= 60.f);
    const int lane = tid & 63, wave = tid >> 6, r16 = lane & 15, q4 = lane >> 4;
    const int q0w = qb * 256 + wave * 32;
    const int wlimit = q0w >> 6;
    bf16x8 qf[2][2];
#pragma unroll
    for (int n = 0; n < 2; ++n)
#pragma unroll
        for (int ks = 0; ks < 2; ++ks) qf[n][ks] = *(const bf16x8*)(Qh + (size_t)(q0w + n * 16 + r16) * 128 + mp * 64 + ks * 32 + q4 * 8);
    f32x4 ot[8][2];
    float mrun[2] = {-INFINITY, -INFINITY}, lsum[2] = {0.f, 0.f};
    if (fixedref) { mrun[0] = bnd; mrun[1] = bnd; }
    const float stinit = fixedref ? -bnd : 0.f;
#pragma unroll
    for (int mo = 0; mo < 8; ++mo) { ot[mo][0] = (f32x4){0.f, 0.f, 0.f, 0.f}; ot[mo][1] = (f32x4){0.f, 0.f, 0.f, 0.f}; }
    u32x4 sk, sv[2];
    const u32x4* kg = (const u32x4*)Kh; const u32x4* vg = (const u32x4*)VTh;
    const int krow = tid >> 3, kc8 = tid & 7;
    sk = kg[(size_t)t0 * 1024 + krow * 16 + mp * 8 + kc8];
#pragma unroll
    for (int i = 0; i < 2; ++i) sv[i] = vg[(size_t)t0 * 1024 + tid + i * 512];
    for (int kt = t0; kt < t1; ++kt) {
        unsigned char* kb = lds + (kt & 1) * 8192;
        unsigned char* vb = lds + 16384 + (kt & 1) * 16384;
        *(u32x4*)(kb + krow * 128 + ((kc8 ^ ((krow >> 1) & 7)) << 4)) = sk;
#pragma unroll
        for (int i = 0; i < 2; ++i) { const int g = tid + i * 512, d = g >> 3, cc = g & 7; *(u32x4*)(vb + d * 128 + ((cc ^ ((d >> 1) & 7)) << 4)) = sv[i]; }
        __syncthreads();
        if (kt + 1 < t1) {
            sk = kg[(size_t)(kt + 1) * 1024 + krow * 16 + mp * 8 + kc8];
#pragma unroll
            for (int i = 0; i < 2; ++i) sv[i] = vg[(size_t)(kt + 1) * 1024 + tid + i * 512];
        }
        if (kt <= wlimit) {
            bf16x8 kf[4][2], vfa[8];
#pragma unroll
            for (int m = 0; m < 4; ++m)
#pragma unroll
                for (int ks = 0; ks < 2; ++ks) kf[m][ks] = *(const bf16x8*)(kb + (m * 16 + r16) * 128 + (((ks * 4 + q4) ^ ((r16 >> 1) & 7)) << 4));
#pragma unroll
            for (int mo = 0; mo < 8; ++mo) { const int d = mo * 16 + r16; vfa[mo] = *(const bf16x8*)(vb + d * 128 + (((0 * 4 + q4) ^ ((d >> 1) & 7)) << 4)); }
            SCHED();
            f32x4 st[4][2];
#pragma unroll
            for (int m = 0; m < 4; ++m) { st[m][0] = (f32x4){stinit, stinit, stinit, stinit}; st[m][1] = (f32x4){stinit, stinit, stinit, stinit}; }
            SETPRIO(1);
#pragma unroll
            for (int ks = 0; ks < 2; ++ks)
#pragma unroll
                for (int m = 0; m < 4; ++m) { st[m][0] = MFMA16(kf[m][ks], qf[0][ks], st[m][0]); st[m][1] = MFMA16(kf[m][ks], qf[1][ks], st[m][1]); }
            SETPRIO(0);
            SCHED();
            float alpha[2] = {1.f, 1.f};
            if (fixedref) {
#pragma unroll
                for (int n = 0; n < 2; ++n) {
                    float ps = 0.f;
#pragma unroll
                    for (int m = 0; m < 4; ++m)
#pragma unroll
                        for (int j = 0; j < 4; ++j) { const float pv = FAST_EXP2(st[m][n][j]); st[m][n][j] = pv; ps += pv; }
                    lsum[n] += ps;
                }
            } else
#pragma unroll
            for (int n = 0; n < 2; ++n) {
                float mx = -INFINITY;
#pragma unroll
                for (int m = 0; m < 4; ++m)
#pragma unroll
                    for (int j = 0; j < 4; ++j) mx = fmaxf(mx, st[m][n][j]);
                mx = xrow16_max(mx);
                const float mnew = fmaxf(mrun[n], mx);
                alpha[n] = FAST_EXP2(mrun[n] - mnew);
                mrun[n] = mnew;
                float ps = 0.f;
#pragma unroll
                for (int m = 0; m < 4; ++m)
#pragma unroll
                    for (int j = 0; j < 4; ++j) { const float pv = FAST_EXP2(st[m][n][j] - mnew); st[m][n][j] = pv; ps += pv; }
                lsum[n] = lsum[n] * alpha[n] + ps;
            }
            if (ANY_LANE(alpha[0] != 1.f)) {
#pragma unroll
                for (int mo = 0; mo < 8; ++mo) ot[mo][0] *= alpha[0];
            }
            if (ANY_LANE(alpha[1] != 1.f)) {
#pragma unroll
                for (int mo = 0; mo < 8; ++mo) ot[mo][1] *= alpha[1];
            }
            bf16x8 pf[2][2];
#pragma unroll
            for (int kk = 0; kk < 2; ++kk)
#pragma unroll
                for (int n = 0; n < 2; ++n) {
                    u32x4 pw;
                    pw.x = pack2(st[2 * kk][n][0], st[2 * kk][n][1]); pw.y = pack2(st[2 * kk][n][2], st[2 * kk][n][3]);
                    pw.z = pack2(st[2 * kk + 1][n][0], st[2 * kk + 1][n][1]); pw.w = pack2(st[2 * kk + 1][n][2], st[2 * kk + 1][n][3]);
                    pf[kk][n] = __builtin_bit_cast(bf16x8, pw);
                }
            bf16x8 vfb[8];
#pragma unroll
            for (int mo = 0; mo < 8; ++mo) { const int d = mo * 16 + r16; vfb[mo] = *(const bf16x8*)(vb + d * 128 + (((1 * 4 + q4) ^ ((d >> 1) & 7)) << 4)); }
            SCHED();
            SETPRIO(1);
#pragma unroll
            for (int mo = 0; mo < 8; ++mo) { ot[mo][0] = MFMA16(vfa[mo], pf[0][0], ot[mo][0]); ot[mo][1] = MFMA16(vfa[mo], pf[0][1], ot[mo][1]); }
            SCHED();
#pragma unroll
            for (int mo = 0; mo < 8; ++mo) { ot[mo][0] = MFMA16(vfb[mo], pf[1][0], ot[mo][0]); ot[mo][1] = MFMA16(vfb[mo], pf[1][1], ot[mo][1]); }
            SETPRIO(0);
        }
    }
    if (q0w >= DCH * 64 * c)
#pragma unroll
    for (int n = 0; n < 2; ++n) {
        float l = lsum[n]; l = xrow16_sum(l);
        const int row = dpart_row(c, q0w + n * 16 + r16);
#pragma unroll
        for (int mo = 0; mo < 8; ++mo) {
            u32x2 o; o.x = pack2(ot[mo][n][0], ot[mo][n][1]); o.y = pack2(ot[mo][n][2], ot[mo][n][3]);
            *(u32x2*)(Op + (size_t)(row * 128 + mo * 16 + 4 * q4)) = o;
        }
        if (q4 == 0) { ML[row * 2] = mrun[n]; ML[row * 2 + 1] = l; }
    }
    __syncthreads();
}

__device__ __forceinline__ void lru_unit_a(int chunk, int grp, int l, const Params& p, const bf16_t* Xr, const bf16_t* WaiT, float* hloc, float* ploc, float* sumA, float* sumH,
                                           unsigned char* lds, int tid) {
    const int lane = tid & 63, wave = tid >> 6, r16 = lane & 15, q4 = lane >> 4;
    unsigned char* XCB = lds; float* XU = (float*)(lds + 16384); float* LA = (float*)(lds + 49152); float* ENDS = (float*)(lds + 81920);
    const int t0 = chunk * 64, ch0 = grp * 128;
    bf16x8 bfr[2][4];
#pragma unroll
    for (int g = 0; g < 2; ++g)
#pragma unroll
        for (int ks = 0; ks < 4; ++ks) bfr[g][ks] = *(const bf16x8*)(WaiT + ((size_t)grp * 256 + g * 128 + wave * 16 + r16) * 128 + ks * 32 + q4 * 8);
    const int chg = ch0 + wave * 16 + r16;
    const float ba = p.in[I_BA][(size_t)l * LRU_W + chg], bi = p.in[I_BI][(size_t)l * LRU_W + chg];
    const float lam_raw = p.in[I_LAM][(size_t)l * LRU_W + chg];
    {
        const int c = tid & 127, tq = tid >> 7, ch = ch0 + c;
        const float* cw = p.in[I_CONVW] + (size_t)l * 4 * LRU_W + ch; const float cb = p.in[I_CONVB][(size_t)l * LRU_W + ch];
        const float w0 = cw[0], w1 = cw[LRU_W], w2 = cw[2 * LRU_W], w3 = cw[3 * LRU_W];
        const int ts = t0 + tq * 16;
        float x0 = (ts - 3 >= 0) ? bf2f(Xr[(size_t)(ts - 3) * LRU_W + ch]) : 0.f;
        float x1 = (ts - 2 >= 0) ? bf2f(Xr[(size_t)(ts - 2) * LRU_W + ch]) : 0.f;
        float x2 = (ts - 1 >= 0) ? bf2f(Xr[(size_t)(ts - 1) * LRU_W + ch]) : 0.f;
#pragma unroll
        for (int i = 0; i < 16; ++i) {
            const float x3 = bf2f(Xr[(size_t)(ts + i) * LRU_W + ch]);
            const float v = cb + w0 * x0 + w1 * x1 + w2 * x2 + w3 * x3;
            const int row = tq * 16 + i;
            XU[row * 128 + c] = v;
            *(bf16_t*)(XCB + row * 256 + (((c >> 3) ^ (row & 15)) << 4) + (c & 7) * 2) = f2bf(v);
            x0 = x1; x1 = x2; x2 = x3;
        }
    }
    __syncthreads();
    {
        const float lsl = 8.0f * log_sigmoid_f(lam_raw);
#pragma unroll
        for (int mt = 0; mt < 4; ++mt) {
            f32x4 ga = (f32x4){0.f, 0.f, 0.f, 0.f}, gi = (f32x4){0.f, 0.f, 0.f, 0.f};
#pragma unroll
            for (int ks = 0; ks < 4; ++ks) {
                const bf16x8 af = *(const bf16x8*)(XCB + (mt * 16 + r16) * 256 + (((ks * 4 + q4) ^ r16) << 4));
                ga = MFMA16(af, bfr[0][ks], ga); gi = MFMA16(af, bfr[1][ks], gi);
            }
#pragma unroll
            for (int j = 0; j < 4; ++j) {
                const int row = mt * 16 + 4 * q4 + j, idx = row * 128 + wave * 16 + r16;
                const float r = sigmoid_f(ga[j] + ba), ig = sigmoid_f(gi[j] + bi);
                const float log_a = lsl * r;
                LA[idx] = fexp(log_a);
                XU[idx] = sqrtf(neg_expm1_f(2.f * log_a)) * (ig * XU[idx]);
            }
        }
    }
    __syncthreads();
    {
        const int c = tid & 127, tq = tid >> 7, ch = ch0 + c;
        float h = 0.f, P = 1.f;
#pragma unroll
        for (int i = 0; i < 16; ++i) { const int idx = (tq * 16 + i) * 128 + c; const float a = LA[idx]; h = a * h + XU[idx]; P *= a; XU[idx] = h; LA[idx] = P; }
        ENDS[tq * 128 + c] = P; ENDS[512 + tq * 128 + c] = h;
        __syncthreads();
        float cin = 0.f, pin = 1.f;
        for (int s = 0; s < tq; ++s) { const float Ps = ENDS[s * 128 + c], hs = ENDS[512 + s * 128 + c]; cin = Ps * cin + hs; pin *= Ps; }
#pragma unroll
        for (int i = 0; i < 16; ++i) {
            const int idx = (tq * 16 + i) * 128 + c; const size_t gi = (size_t)(t0 + tq * 16 + i) * LRU_W + ch;
            const float Pl = LA[idx], hl = XU[idx];
            ((unsigned*)hloc)[gi] = pack2(hl + Pl * cin, Pl * pin);
        }
        if (tq == 3) { const float Pl = LA[63 * 128 + c], hl = XU[63 * 128 + c]; sumA[(size_t)chunk * LRU_W + ch] = Pl * pin; sumH[(size_t)chunk * LRU_W + ch] = hl + Pl * cin; }
    }
    __syncthreads();
}

__device__ __forceinline__ void moe_prefix(const int* cntb_, int G, unsigned char* lds, int tid) {
    int* tmp = (int*)lds; int* ctot = (int*)(lds + LDS_MISC + M_CTOT); int* coff = (int*)(lds + LDS_MISC + M_COFF);
    unsigned short* pre16 = (unsigned short*)(lds + LDS_MISC + M_PRE16);
    const int e = tid & 31, part = tid >> 5, PB = (G + 15) / 16;
    int sm = 0;
    for (int i = 0; i < PB; ++i) { const int b = part * PB + i; if (b < G) sm += cntb_[b * 32 + e]; }
    tmp[part * 32 + e] = sm;
    __syncthreads();
    int run = 0;
    for (int q = 0; q < part; ++q) run += tmp[q * 32 + e];
    for (int i = 0; i < PB; ++i) { const int b = part * PB + i; if (b < G) { pre16[e * 257 + b] = (unsigned short)run; run += cntb_[b * 32 + e]; } }
    if (part == 15) { ctot[e] = run; pre16[e * 257 + G] = (unsigned short)run; }
    __syncthreads();
    if (tid == 0) { int o = 0; for (int q = 0; q < 32; ++q) { coff[q] = o; o += ctot[q]; } coff[32] = o; }
    __syncthreads();
}
__device__ __forceinline__ void moe_rowtable(const int* ltok_, const float* lw_, const int* lslot_, int e, int m0, int c_e, int G, int segcap, unsigned char* lds, int tid_in) {
    int tid = tid_in; OPAQUE(tid);
    const unsigned short* pre = (const unsigned short*)(lds + LDS_MISC + M_PRE16) + e * 257;
    int* rtok = (int*)(lds + LDS_MISC + M_RTOK); float* rw = (float*)(lds + LDS_MISC + M_RW); int* rslot = (int*)(lds + LDS_MISC + M_RSLOT);
    if (tid < 256) {
        const int g = m0 + tid;
        int tk = 0, sl = 0; float w = 0.f;
        if (g < c_e) {
            int lo = 0, hi = G;
            while (hi - lo > 1) { const int mid = (lo + hi) >> 1; if ((int)pre[mid] <= g) lo = mid; else hi = mid; }
            const int idx = (e * G + lo) * segcap + (g - (int)pre[lo]);
            tk = ltok_[idx]; w = lw_[idx]; sl = lslot_[idx];
        }
        rtok[tid] = tk; rw[tid] = w; rslot[tid] = sl;
    }
    __syncthreads();
}
#define kmax2 ((float*)(wsl + A_KMAX))
#define dpo ((bf16_t*)(wsl + A_DPO))
#define dpml ((float*)(wsl + A_DPML))
#define cntb ((int*)(wsl + A_CNTB))
#define WinT ((bf16_t*)(wsl + WB_WIN))
#define WoT ((bf16_t*)(wsl + WB_WO))
#define WguT ((bf16_t*)(wsl + WB_WGU))
#define WdT ((bf16_t*)(wsl + WB_WD))
#define WaiT ((bf16_t*)(wsl + WB_WAI))
#define Wfa ((float*)(wsl + WF_FA))
#define W36b ((bf16_t*)(wsl + WF_R36))
#define ropecs ((float*)(wsl + WF_ROPE))
#define xb ((bf16_t*)(wsl + A_XB))
#define hb ((float*)(wsl + A_HB))
#define logf_ ((float*)(wsl + A_LOGF))
#define cum2 ((float*)(wsl + A_CUM))
#define Qa ((bf16_t*)(wsl + A_QA))
#define Ka ((bf16_t*)(wsl + A_KA))
#define VaT ((bf16_t*)(wsl + A_VAT))
#define Xr ((bf16_t*)(wsl + A_XR))
#define Gr ((bf16_t*)(wsl + A_GR))
#define Qc ((bf16_t*)(wsl + A_QC))
#define Kc ((bf16_t*)(wsl + A_KC))
#define VcT ((bf16_t*)(wsl + A_VCT))
#define hloc ((float*)(wsl + A_HLOC))
#define ploc ((float*)(wsl + A_PLOC))
#define sumA ((float*)(wsl + A_SUMA))
#define sumH ((float*)(wsl + A_SUMH))
#define concat ((bf16_t*)(wsl + A_CONCAT))
#define y1 ((float*)(wsl + A_Y1))
#define h1 ((float*)(wsl + A_H1))
#define h1b ((bf16_t*)(wsl + A_H1B))
#define ltok ((int*)(wsl + A_LTOK))
#define lw ((float*)(wsl + A_LW))
#define lslot ((int*)(wsl + A_LSLOT))
#define act ((bf16_t*)(wsl + A_ACT))
#define contrib ((bf16_t*)(wsl + A_CONTRIB))
#ifndef EMU
__global__ void __launch_bounds__(NTHREADS, 2)
#else
void
#endif
fwd_kernel(Params p) {
    DYN_LDS(lds_raw);
    float* ldsf = (float*)lds_raw;
    const int bid = blockIdx.x, G = gridDim.x;
    const int gthreads = G * NTHREADS, gwaves = G * (NTHREADS / 64);
    const int wave_s = RFL((int)threadIdx.x >> 6);
#define PHASE_IDS() unsigned char* wsl = ws; OPAQUE_S(wsl); int tid = wave_s * 64 + LANE_ID(); OPAQUE(tid); const int lane = tid & 63, wave = tid >> 6, gtid = bid * NTHREADS + tid, gwave = bid * (NTHREADS / 64) + wave; (void)lane; (void)wave; (void)gtid; (void)gwave

    unsigned char* ws = p.ws;
    volatile LAS unsigned* bst = (volatile LAS unsigned*)(lds_raw + LDS_MISC);
    unsigned* ubox = (unsigned*)(lds_raw + LDS_MISC + 16);
    if (threadIdx.x == 0) { bst[0] = 0u; bst[1] = 0u; bst[2] = 0u; bst[3] = 0u; }
    __syncthreads();
    XcdBarrier bar = xcd_barrier_post((unsigned*)ws, bst);

    const int* positions = (const int*)p.in[I_POS];

    constexpr int NPH = 8;
    const int lo = p.lo, hi = p.hi;
#ifdef ONLY_PHASE
#define PH_SEL(c) ((c) == ONLY_PHASE)
#else
#define PH_SEL(c) 1
#endif
#define PH_IN(k) (lo <= (k) && (k) < hi)
#define PH_BAR(k) do { if ((k) + 1 < hi) xcd_barrier(bar, wave_s == 0 && LANE_ID() == 0); } while (0)

    if (PH_SEL(-1) && PH_IN(0)) for (int rep = 0; rep < PH_REPS(-1); ++rep) {
        PHASE_IDS();
        for (int l = 0; l < DEPTH; ++l) {
            convert_mats(p.in[I_WIN] + (size_t)l * D * N_IN, 0, 1, N_IN, D, N_IN, WinT + (size_t)l * N_INP * D, 0, RmWin{}, ldsf, tid, bid, G);
            for (int t = bid; t < (D / 64) * (D / 256); t += G)
                convert_tile_v4(p.in[I_WO] + (size_t)l * D * D, D, D, (t / (D / 256)) * 64, (t % (D / 256)) * 256, WoT + (size_t)l * D * D, RmIdent{}, ldsf, tid);
            convert_mats(p.in[I_WA] + (size_t)l * 6 * 128 * 128, (size_t)128 * 128, 6, 128, 128, 128, WaiT + (size_t)l * 6 * 256 * 128, (size_t)256 * 128, RmIdent{}, ldsf, tid, bid, G);
            convert_mats(p.in[I_WI] + (size_t)l * 6 * 128 * 128, (size_t)128 * 128, 6, 128, 128, 128, WaiT + (size_t)l * 6 * 256 * 128, (size_t)256 * 128, RmOff{128}, ldsf, tid, bid, G);
        }
        for (int i = gtid; i < DEPTH * 8 * D; i += gthreads) { const int k = i % D, h = (i / D) % 8, l = i / (8 * D);
            Wfa[i] = (h < 6) ? p.in[I_WIN][(size_t)l * D * N_IN + (size_t)k * N_IN + C_FA + h] : 0.f; }
        for (int i = gtid; i < DEPTH * 48 * D; i += gthreads) { const int k = i % D, o = (i / D) % 48, l = i / (48 * D);
            const float w = (o < 4) ? p.in[I_WGRP][((size_t)l * D + k) * 4 + o] : (o < 36 ? p.in[I_WRT][((size_t)l * D + k) * 32 + (o - 4)] : 0.f);
            const bf16_t hi = f2bf(w);
            W36b[((size_t)l * 2 + 0) * 48 * D + (size_t)o * D + k] = hi; W36b[((size_t)l * 2 + 1) * 48 * D + (size_t)o * D + k] = f2bf(w - bf2f(hi)); }
        for (int i = gtid; i < S * 8; i += gthreads) { const int d = i & 7, t = i >> 3; const float ang = (float)positions[t] * p.inv_freq[d];
            ropecs[t * 16 + d] = cosf(ang); ropecs[t * 16 + 8 + d] = sinf(ang); }
        __syncthreads();
        for (int i = tid; i < 6 * D; i += NTHREADS) { const int k = i % D, h = i / D; ldsf[i] = p.in[I_WIN][(size_t)k * N_IN + C_FA + h]; }
        __syncthreads();
        for (int t0 = gwave * 2; t0 < S; t0 += gwaves * 2) {
            f32x4 v[2][8];
#pragma unroll
            for (int tk = 0; tk < 2; ++tk)
#pragma unroll
                for (int j = 0; j < 8; ++j) v[tk][j] = *(const f32x4*)(p.in[I_X] + (size_t)(t0 + tk) * D + j * 256 + lane * 4);
#pragma unroll
            for (int tk = 0; tk < 2; ++tk) {
                const int t = t0 + tk;
                float fa[6] = {0.f, 0.f, 0.f, 0.f, 0.f, 0.f};
#pragma unroll
                for (int j = 0; j < 8; ++j) {
                    const int c = j * 256 + lane * 4;
                    u32x2 o; o.x = pack2(v[tk][j][0], v[tk][j][1]); o.y = pack2(v[tk][j][2], v[tk][j][3]);
                    *(u32x2*)(xb + (size_t)t * D + c) = o;
#pragma unroll
                    for (int h = 0; h < 6; ++h) { const f32x4 w = *(const f32x4*)(ldsf + h * D + c); fa[h] += v[tk][j][0] * w[0] + v[tk][j][1] * w[1] + v[tk][j][2] * w[2] + v[tk][j][3] * w[3]; }
                    COMPILER_FENCE();
                }
#pragma unroll
                for (int h = 0; h < 6; ++h) { const float sm = wave_sum(fa[h]); if (lane == 0) logf_[h * S + t] = log_sigmoid_f(sm + p.in[I_BF][h]); }
            }
        }
        PH_BAR(0);
    }

    for (int l = 0; l < DEPTH; ++l) {
        const int pb = 1 + l * NPH;
#define hin ((l == 0) ? p.in[I_X] : (const float*)hb)
#define hout ((l == DEPTH - 1) ? p.out : hb)
#define workctr ((int*)(wsl + CTL_WORK_OFF) + l * 64)

        if (PH_SEL(0) && PH_IN(pb + 0)) {
            PHASE_IDS();
            int bz = RFL(bid); OPAQUE_S(bz);
            if (bz == 0) {
                double* part = (double*)lds_raw;
                const int per = S / 64;
                double s = 0.0;
                if (wave < 6) { for (int i = 0; i < per; ++i) s += (double)logf_[wave * S + lane * per + i]; part[wave * 64 + lane] = s; }
                __syncthreads();
                if (wave < 6) {
                    double run = 0.0;
                    for (int j = 0; j < lane; ++j) run += part[wave * 64 + j];
                    for (int i = 0; i < per; ++i) { run += (double)logf_[wave * S + lane * per + i]; cum2[wave * S + lane * per + i] = (float)(run * (double)LOG2E); }
                }
                __syncthreads();
            }
            bool conv_more = (l == 0);
#define CONV_ONE() do { if (conv_more) { __syncthreads(); if (tid == 0) *ubox = (unsigned)atomic_add_int((int*)(wsl + CTL_WORK_OFF) + 62, 1); __syncthreads(); \
                const int cid_ = RFL((int)*ubox); if (cid_ < NCONV) moe_conv_chunk(p, cid_, WguT, WdT, ldsf, tid); else conv_more = false; } } while (0)
            unsigned* cls = (unsigned*)(wsl + CTL_CLS_OFF) + l * 256;
            if (bz == 0) { WAIT_VM0(); __syncthreads(); if (tid == 0) { FENCE_REL_AGENT(); WAIT_VM0(); (void)xb_add(&cls[192], 1u); } }
            const bf16_t* Bt = WinT + (size_t)l * N_INP * D;
            constexpr int ntm = S / 256;
            const unsigned nooff[2][2] = {{0u, 0u}, {0u, 0u}};
            for (int i = 0; i < (bid & 3); ++i) CONV_ONE();
            for (;;) {
                __syncthreads();
                if (tid == 0) *ubox = (unsigned)atomic_add_int(workctr + 9, 1);
                __syncthreads();
                int t = RFL((int)*ubox);
                if (t >= ntm * 21) break;
                int pm, pn, kcls;
                if (t < ntm * 6) { pm = t / 6; pn = 15 + t % 6; kcls = 0; }
                else if (t < ntm * 12) { t -= ntm * 6; pm = t / 6; pn = 9 + t % 6; kcls = 1; }
                else { t -= ntm * 12; pm = t / 9; pn = t % 9; kcls = 2; }
                f32x4 acc[2][2][4][2];
                gemm_tile<false>(xb, pm * 256, nooff, Bt, pn * 256, D, lds_raw, acc, tid);
                int et = tid; OPAQUE(et); const int wr = et >> 8, wc = (et >> 6) & 3, fr = et & 15, fq = (et >> 4) & 3;
                if (pn < 6 || (pn >= 9 && pn < 19)) {
                    bf16_t* dst; float scale = 1.f; bool rope = false;
                    if (pn < 3) { dst = Qa; scale = QSCALE_A; } else if (pn < 6) { dst = Ka; } else if (pn < 12) { dst = Xr; } else if (pn < 15) { dst = Gr; }
                    else if (pn < 17) { dst = Qc; scale = QSCALE_C; rope = true; } else { dst = Kc; rope = true; }
                    const bool headmajor = (pn < 6) || (pn >= 15);
                    const int segpn = (pn < 3) ? pn : (pn < 6) ? pn - 3 : (pn < 12) ? pn - 9 : (pn < 15) ? pn - 12 : (pn < 17) ? pn - 15 : pn - 17;
#pragma unroll
                    for (int ai = 0; ai < 2; ++ai)
#pragma unroll
                        for (int m = 0; m < 4; ++m)
#pragma unroll
                            for (int bj = 0; bj < 2; ++bj)
#pragma unroll
                                for (int n = 0; n < 2; ++n) {
                                    const int dd = wc * 32 + n * 16 + fr;
#pragma unroll
                                    for (int j = 0; j < 4; ++j) {
                                        const int row = pm * 256 + ai * 128 + wr * 64 + m * 16 + fq * 4 + j;
                                        float v = acc[ai][bj][m][n][j];
                                        if (rope && n == 0 && (wc & 1) == 0) {
                                            const float pv = SHX(v, 8);
                                            const float cs = ropecs[row * 16 + (fr & 7)], sn = ropecs[row * 16 + 8 + (fr & 7)];
                                            v = (fr < 8) ? (v * cs - pv * sn) : (v * cs + pv * sn);
                                        }
                                        v *= scale;
                                        *(bf16_t*)(lds_raw + (ai * 128 + wr * 64 + m * 16 + fq * 4 + j) * 528 + (bj * 128 + dd) * 2) = f2bf(v);
                                    }
                                }
                    __syncthreads();
#pragma unroll 4
                    for (int i = 0; i < 16; ++i) {
                        const int idx = et + i * 512, lrow = idx >> 5, ch = idx & 31, row = pm * 256 + lrow;
                        const u32x4 val = *(const u32x4*)(lds_raw + lrow * 528 + ch * 16);
                        size_t gi;
                        if (headmajor) gi = ((size_t)(segpn * 2 + (ch >> 4)) * S + row) * 128 + (ch & 15) * 8;
                        else gi = (size_t)row * LRU_W + segpn * 256 + ch * 8;
                        *(u32x4*)(dst + gi) = val;
                    }
                    __syncthreads();
                    if (pn >= 15) {
                        float* part = ldsf;
#pragma unroll
                        for (int ai = 0; ai < 2; ++ai)
#pragma unroll
                            for (int m = 0; m < 4; ++m)
#pragma unroll
                                for (int bj = 0; bj < 2; ++bj)
#pragma unroll
                                    for (int j = 0; j < 4; ++j) {
                                        float ss = acc[ai][bj][m][0][j] * acc[ai][bj][m][0][j] + acc[ai][bj][m][1][j] * acc[ai][bj][m][1][j];
                                        ss += SHX(ss, 1); ss += SHX(ss, 2); ss += SHX(ss, 4); ss += SHX(ss, 8);
                                        if (fr == 0) part[(wc * 2 + bj) * 256 + ai * 128 + wr * 64 + m * 16 + fq * 4 + j] = ss;
                                    }
                        __syncthreads();
                        {
                            const int bj = et >> 8, row = et & 255;
                            float v0 = part[(0 * 2 + bj) * 256 + row] + part[(1 * 2 + bj) * 256 + row], v1 = part[(2 * 2 + bj) * 256 + row] + part[(3 * 2 + bj) * 256 + row];
                            v0 = fmaxf(v0, SHX(v0, 1)); v0 = fmaxf(v0, SHX(v0, 2)); v0 = fmaxf(v0, SHX(v0, 4)); v0 = fmaxf(v0, SHX(v0, 8)); v0 = xrow16_max(v0);
                            v1 = fmaxf(v1, SHX(v1, 1)); v1 = fmaxf(v1, SHX(v1, 2)); v1 = fmaxf(v1, SHX(v1, 4)); v1 = fmaxf(v1, SHX(v1, 8)); v1 = xrow16_max(v1);
                            if ((et & 63) == 0) {
                                unsigned* q2p = (unsigned*)(wsl + CTL_QK2_OFF) + l * 16 + (pn >= 17 ? 8 : 0) + (segpn * 2 + bj) * 2;
                                atomic_max_u32(q2p, __builtin_bit_cast(unsigned, v0)); atomic_max_u32(q2p + 1, __builtin_bit_cast(unsigned, v1));
                            }
                        }
                        __syncthreads();
                    }
                    if (pn >= 3 && pn < 6) {
                        float* part = ldsf;
#pragma unroll
                        for (int ai = 0; ai < 2; ++ai)
#pragma unroll
                            for (int m = 0; m < 4; ++m)
#pragma unroll
                                for (int bj = 0; bj < 2; ++bj)
#pragma unroll
                                    for (int j = 0; j < 4; ++j) {
                                        float ss = acc[ai][bj][m][0][j] * acc[ai][bj][m][0][j] + acc[ai][bj][m][1][j] * acc[ai][bj][m][1][j];
                                        ss += SHX(ss, 1); ss += SHX(ss, 2); ss += SHX(ss, 4); ss += SHX(ss, 8);
                                        if (fr == 0) part[(wc * 2 + bj) * 256 + ai * 128 + wr * 64 + m * 16 + fq * 4 + j] = ss;
                                    }
                        __syncthreads();
                        {
                            const int bj = et >> 8, row = et & 255;
                            float v = part[(0 * 2 + bj) * 256 + row] + part[(1 * 2 + bj) * 256 + row] + part[(2 * 2 + bj) * 256 + row] + part[(3 * 2 + bj) * 256 + row];
                            v = fmaxf(v, SHX(v, 1)); v = fmaxf(v, SHX(v, 2)); v = fmaxf(v, SHX(v, 4)); v = fmaxf(v, SHX(v, 8)); v = xrow16_max(v);
                            if ((et & 63) == 0) kmax2[((pn - 3) * 2 + bj) * NKT + pm * 4 + ((et >> 6) & 3)] = v;
                        }
                        __syncthreads();
                    }
                } else {
                    bf16_t* dst = (pn < 9) ? VaT : VcT;
                    const int segpn = (pn < 9) ? pn - 6 : pn - 19;
#pragma unroll
                    for (int ai = 0; ai < 2; ++ai)
#pragma unroll
                        for (int m = 0; m < 4; ++m)
#pragma unroll
                            for (int bj = 0; bj < 2; ++bj)
#pragma unroll
                                for (int n = 0; n < 2; ++n) {
                                    const int dd = wc * 32 + n * 16 + fr;
                                    const int row = pm * 256 + ai * 128 + wr * 64 + m * 16 + fq * 4;
                                    const f32x4 a = acc[ai][bj][m][n];
                                    u32x2 o; o.x = pack2(a[0], a[1]); o.y = pack2(a[2], a[3]);
                                    const int s6 = row & 63, pos = (s6 & 32) + ((s6 >> 2) & 3) * 8 + ((s6 >> 4) & 1) * 4;
                                    *(u32x2*)(dst + (((size_t)(segpn * 2 + bj) * NKT + (row >> 6)) * 128 + dd) * 64 + pos) = o;
                                }
                }
                WAIT_VM0();
                __syncthreads();
                if (et == 0) { FENCE_REL_AGENT(); WAIT_VM0(); (void)xb_add(&cls[kcls * 64], 1u); }
                CONV_ONE();
            }
        }

        if (PH_SEL(1) && PH_IN(pb + 1)) {
            PHASE_IDS();
            const float lam_init = (l == 0) ? 0.2f : 0.35550906759f;
            const float s1 = wave_sum(p.in[I_LQ1][l * 64 + lane] * p.in[I_LK1][l * 64 + lane]);
            const float s2 = wave_sum(p.in[I_LQ2][l * 64 + lane] * p.in[I_LK2][l * 64 + lane]);
            const float lam = fexp(s1) - fexp(s2) + lam_init;
            constexpr int NLRU = NKT * 6, NQB = S / 128;
            bool conv_more = (l == 0);
            unsigned* cls = (unsigned*)(wsl + CTL_CLS_OFF) + l * 256;
            unsigned* bw = (unsigned*)wsl;
#define WAIT_CLASS(k, n) do { __syncthreads(); if (tid == 0) { XB_SPIN(xb_ld(&cls[(k) * 64]) < (unsigned)(n), bw); FENCE_ACQ_AGENT(); WAIT_VM0(); } __syncthreads(); } while (0)
#ifndef NO_DIFF
            {
                constexpr int NQB2 = S / 256;
                int total = 0;
                for (int q = 0; q < NQB2; ++q) total += ((4 * q + 4 + DCH - 1) / DCH) * 8;
                WAIT_CLASS(0, (S / 256) * 6);
                for (;;) {
                    __syncthreads();
                    if (tid == 0) *ubox = (unsigned)atomic_add_int(workctr, 1);
                    __syncthreads();
                    int u = RFL((int)*ubox);
                    if (u >= total) break;
                    int qb = NQB2 - 1;
                    for (;; --qb) { const int nu = ((4 * qb + 4 + DCH - 1) / DCH) * 8; if (u < nu) break; u -= nu; }
                    const int c = u >> 3, h = (u >> 1) & 3, mp = u & 1;
                    const int t0 = c * DCH, t1 = (t0 + DCH < 4 * qb + 4) ? t0 + DCH : 4 * qb + 4;
                    const unsigned* q2p = (const unsigned*)(wsl + CTL_QK2_OFF) + l * 16;
                    const float bnd = sqrtf(__builtin_bit_cast(float, q2p[h * 2 + mp]) * __builtin_bit_cast(float, q2p[8 + h * 2 + mp])) * (QSCALE_C * 1.02f) + 0.01f;
                    attn_dmap_unit(Qc + (size_t)h * S * 128, Kc + (size_t)h * S * 128, VcT + (size_t)h * S * 128, mp, qb, t0, t1,
                                   dpo + (size_t)(h * 2 + mp) * DPART_ROWS * 128, dpml + (size_t)(h * 2 + mp) * DPART_ROWS * 2, c, RFL_F(bnd), lds_raw, tid);
                    CONV_ONE();
                }
            }
#endif
#ifndef NO_LRU
            WAIT_CLASS(1, (S / 256) * 6);
            for (;;) {
                __syncthreads();
                if (tid == 0) *ubox = (unsigned)atomic_add_int(workctr + 10, 1);
                __syncthreads();
                const int u = RFL((int)*ubox);
                if (u >= NLRU) break;
                lru_unit_a(u / 6, u % 6, l, p, Xr, WaiT + (size_t)l * 6 * 256 * 128, hloc, ploc, sumA, sumH, lds_raw, tid);
            }
#endif
#ifndef NO_FOX
            WAIT_CLASS(2, (S / 256) * 9);
            WAIT_CLASS(3, 1);
            for (;;) {
                __syncthreads();
                if (tid == 0) *ubox = (unsigned)atomic_add_int(workctr + 1, 1);
                __syncthreads();
                const int u = RFL((int)*ubox);
                if (u >= NQB * FOX_H) break;
                const int qb = NQB - 1 - u / FOX_H, h = u % FOX_H;
                attn_unit<0>(Qa + (size_t)h * S * 128, Ka + (size_t)h * S * 128, VaT + (size_t)h * S * 128, cum2 + (size_t)h * S, kmax2 + h * NKT, qb, concat, h * 128,
                             0.f, 0.f, nullptr, lds_raw, tid);
            }
#endif
            while (conv_more) CONV_ONE();
            PH_BAR(pb + 1);
        }

        if (PH_SEL(2) && PH_IN(pb + 2)) for (int rep = 0; rep < PH_REPS(2); ++rep) {
            PHASE_IDS();
            for (int u = bid; u < NKT * 6; u += G) {
                const int chunk = u / 6, grp = u % 6, c = tid & 127, tq = tid >> 7, ch = grp * 128 + c;
                float cr = 0.f;
                {
                    int j = 0;
                    for (; j + 16 <= chunk; j += 16) {
                        float a8[16], h8[16];
#pragma unroll
                        for (int q = 0; q < 16; ++q) { a8[q] = sumA[(size_t)(j + q) * LRU_W + ch]; h8[q] = sumH[(size_t)(j + q) * LRU_W + ch]; }
#pragma unroll
                        for (int q = 0; q < 16; ++q) cr = a8[q] * cr + h8[q];
                    }
                    for (; j < chunk; ++j) cr = sumA[(size_t)j * LRU_W + ch] * cr + sumH[(size_t)j * LRU_W + ch];
                }
                float hl[16], pl[16]; bf16_t gg[16];
#pragma unroll
                for (int i = 0; i < 16; ++i) { const size_t gi = (size_t)(chunk * 64 + tq * 16 + i) * LRU_W + ch; const unsigned hp = ((const unsigned*)hloc)[gi]; hl[i] = bf2f((bf16_t)(hp & 0xffffu)); pl[i] = bf2f((bf16_t)(hp >> 16)); gg[i] = Gr[gi]; }
#pragma unroll
                for (int i = 0; i < 16; ++i)
                    concat[(size_t)(chunk * 64 + tq * 16 + i) * D + FOX_W + ch] = f2bf(gelu_tanh_f(bf2f(gg[i])) * (hl[i] + pl[i] * cr));
            }
            {
                const float lam_init = (l == 0) ? 0.2f : 0.35550906759f;
                const float s1 = wave_sum(p.in[I_LQ1][l * 64 + lane] * p.in[I_LK1][l * 64 + lane]);
                const float s2 = wave_sum(p.in[I_LQ2][l * 64 + lane] * p.in[I_LK2][l * 64 + lane]);
                const float lam = fexp(s1) - fexp(s2) + lam_init;
                const float* sg = p.in[I_SUBG] + l * 128;
                const float g0 = sg[2 * lane], g1 = sg[2 * lane + 1];
                static_assert(NCH <= 8, "the merge below keeps one (map, chunk) pair per lane: 2 x 8 lanes");
                for (int q = gwave; q < S; q += gwaves) {
                    const int nch = (q >> 6) / DCH + 1;
                    float mv = -INFINITY, lv = 0.f;
                    { const int c = lane & 7, hm = lane >> 3;
                      if (c < nch) { const float* ML = dpml + ((size_t)hm * DPART_ROWS + dpart_row(c, q)) * 2; mv = ML[0]; lv = ML[1]; } }
                    unsigned pk[4][2][NCH];
#pragma unroll
                    for (int h = 0; h < 4; ++h)
#pragma unroll
                        for (int mp = 0; mp < 2; ++mp) {
                            const unsigned* OP = (const unsigned*)(dpo + (size_t)(h * 2 + mp) * DPART_ROWS * 128);
#pragma unroll
                            for (int c = 0; c < NCH; ++c) pk[h][mp][c] = (c < nch) ? OP[(size_t)dpart_row(c, q) * 64 + lane] : 0u;
                        }
                    float Mx = mv; Mx = fmaxf(Mx, DPP_X1(Mx)); Mx = fmaxf(Mx, DPP_X2(Mx)); Mx = fmaxf(Mx, DPP_X7(Mx));
                    const float wv = (mv == -INFINITY) ? 0.f : FAST_EXP2(mv - Mx);
                    float Lp = lv * wv; Lp += DPP_X1(Lp); Lp += DPP_X2(Lp); Lp += DPP_X7(Lp);
#pragma unroll
                    for (int h = 0; h < 4; ++h) {
                        float om[2][2];
#pragma unroll
                        for (int mp = 0; mp < 2; ++mp) {
                            float o0 = 0.f, o1 = 0.f;
#pragma unroll
                            for (int c = 0; c < NCH; ++c) { const float w = RDLANE(wv, (h * 2 + mp) * 8 + c); o0 += bf2f((bf16_t)(pk[h][mp][c] & 0xffffu)) * w; o1 += bf2f((bf16_t)(pk[h][mp][c] >> 16)) * w; }
                            const float il = 1.f / RDLANE(Lp, (h * 2 + mp) * 8);
                            om[mp][0] = o0 * il; om[mp][1] = o1 * il;
                        }
                        const float v0 = om[0][0] - lam * om[1][0], v1 = om[0][1] - lam * om[1][1];
                        const float ss = wave_sum(v0 * v0 + v1 * v1);
                        const float rs = (1.f - lam_init) / sqrtf(ss * (1.f / 128.f) + LN_EPS);
                        *(unsigned*)(concat + (size_t)q * D + 1536 + h * 128 + 2 * lane) = pack2(v0 * rs * g0, v1 * rs * g1);
                    }
                }
            }
            PH_BAR(pb + 2);
        }

        if (PH_SEL(3) && PH_IN(pb + 3)) {
            PHASE_IDS();
            const bf16_t* Bt = WoT + (size_t)l * D * D;
            constexpr int ntn = D / 256, ntm = S / 256;
            static_assert(ntn == 8, "the panel exchange is written for 8 column tiles");
            const unsigned nooff[2][2] = {{0u, 0u}, {0u, 0u}};
            const float* g1 = p.in[I_LN1G] + (size_t)l * D; const float* b1 = p.in[I_LN1B] + (size_t)l * D;
            const float* bg = p.in[I_BGRP] + l * 4; const float* br = p.in[I_BRT] + l * 32;
            const bf16_t* Wb = W36b + (size_t)l * 2 * 48 * D;
            int* lcnt = (int*)(lds_raw + LDS_MISC + M_LCNT);
            const int segcap = ((ntm * ntn + G - 1) / G) * 32;
            unsigned* pcnt = (unsigned*)(wsl + CTL_PAN_OFF) + l * 1024;
            unsigned long long* xbuf = (unsigned long long*)(wsl + A_XBUF);
            unsigned* part = (unsigned*)(wsl + A_PART);
            LAS float* Stab = (LAS float*)(lds_raw + LDS_MISC + M_RTOK);
            float* lgt = (float*)(lds_raw + LDS_MISC + 4096);
            if (tid < 32) lcnt[tid] = 0;
            __syncthreads();
            for (int t0 = bid; t0 < ntm * ntn; t0 += G) {
                int t = t0;
                if (G == 256 && ntm * ntn == 256) { const int x = t0 & 7, j = t0 >> 3; t = (x * 4 + (j >> 3)) * ntn + (j & 7); }
                const int pm = t / ntn, pn = t % ntn;
                f32x4 v[2][16];
                {
                    f32x4 acc[2][2][4][2];
                    gemm_tile<false>(concat, pm * 256, nooff, Bt, pn * 256, D, lds_raw, acc, tid);
                    int et = tid; OPAQUE(et); const int wr = et >> 8, wc = (et >> 6) & 3, fr = et & 15, fq = (et >> 4) & 3;
#pragma unroll
                    for (int ai = 0; ai < 2; ++ai) {
#pragma unroll
                        for (int m = 0; m < 4; ++m)
#pragma unroll
                            for (int bj = 0; bj < 2; ++bj)
#pragma unroll
                                for (int n = 0; n < 2; ++n)
#pragma unroll
                                    for (int j = 0; j < 4; ++j)
                                        *(float*)(lds_raw + (wr * 64 + m * 16 + fq * 4 + j) * 1040 + (bj * 128 + wc * 32 + n * 16 + fr) * 4) = acc[ai][bj][m][n][j];
                        __syncthreads();
#pragma unroll
                        for (int i = 0; i < 16; ++i) {
                            const int lrow = i * 8 + (et >> 6), c4 = et & 63;
                            const size_t gi = (size_t)(pm * 256 + ai * 128 + lrow) * D + pn * 256 + c4 * 4;
                            v[ai][i] = *(const GAS f32x4*)(hin + gi);
                        }
#pragma unroll
                        for (int i = 0; i < 16; ++i) {
                            const int lrow = i * 8 + (et >> 6), c4 = et & 63;
                            v[ai][i] = ALPHA * v[ai][i] + *(const f32x4*)(lds_raw + lrow * 1040 + c4 * 16);
                        }
                        __syncthreads();
                    }
                }
                int et2 = tid; OPAQUE(et2); const int el = et2 & 63, ew = wave_s, er16 = et2 & 15, eq4 = (et2 >> 4) & 3;
#pragma unroll
                for (int q = 0; q < 6; ++q) {
                    const int seg = ew * 6 + q, n2 = seg * 2 + (el >> 5), p5 = el & 31;
                    GLDS16(Wb + (size_t)n2 * D + pn * 256 + ((p5 ^ (n2 & 15)) << 3), lds_raw + 65536 + seg * 1024 + el * 16);
                }
                float my_mt = 0.f, my_m2 = 0.f;
#pragma unroll
                for (int ai = 0; ai < 2; ++ai)
#pragma unroll
                    for (int i4 = 0; i4 < 16; i4 += 4) {
                        float mt4[4], m24[4];
#pragma unroll
                        for (int u = 0; u < 4; ++u) { const f32x4 x = v[ai][i4 + u]; mt4[u] = wave_sum((x[0] + x[1]) + (x[2] + x[3])) * (1.f / 256.f); }
#pragma unroll
                        for (int u = 0; u < 4; ++u) { const f32x4 d = v[ai][i4 + u] - mt4[u]; m24[u] = wave_sum((d[0] * d[0] + d[1] * d[1]) + (d[2] * d[2] + d[3] * d[3])); }
#pragma unroll
                        for (int u = 0; u < 4; ++u) if (el == ai * 16 + i4 + u) { my_mt = mt4[u]; my_m2 = m24[u]; }
                        COMPILER_FENCE();
                    }
                unsigned* bw = (unsigned*)wsl;
                if (el < 32) {
                    const int grow = (el >> 4) * 128 + (el & 15) * 8 + ew;
                    xst64(&xbuf[(size_t)(pm * 256 + grow) * 8 + pn], ((unsigned long long)__builtin_bit_cast(unsigned, my_m2) << 32) | __builtin_bit_cast(unsigned, my_mt));
                }
                WAIT_VM0();
                __syncthreads();
                if (et2 == 0) { (void)xb_add(&pcnt[pm * 16], 1u); XB_SPIN(xb_ld(&pcnt[pm * 16]) < 8u, bw); FENCE_ACQ_AGENT(); }
                __syncthreads();
                unsigned long long wk[4];
#pragma unroll
                for (int k = 0; k < 4; ++k) {
                    const int r = k * 8 + (el >> 3), grow = (r >> 4) * 128 + (r & 15) * 8 + ew;
                    wk[k] = xld64(&xbuf[(size_t)(pm * 256 + grow) * 8 + (el & 7)]);
                }
#pragma unroll
                for (int k = 0; k < 4; ++k) {
                    const int r = k * 8 + (el >> 3);
                    const unsigned long long w = wk[k];
                    const float mt = __builtin_bit_cast(float, (unsigned)w), m2 = __builtin_bit_cast(float, (unsigned)(w >> 32));
                    float ms = mt; ms += DPP_X1(ms); ms += DPP_X2(ms); ms += DPP_X7(ms);
                    const float mean = ms * 0.125f, dm = mt - mean;
                    float q = m2 + 256.f * dm * dm; q += DPP_X1(q); q += DPP_X2(q); q += DPP_X7(q);
                    const float rstd = 1.f / sqrtf(q * (1.f / D) + LN_EPS);
                    if ((el & 7) == 0) { Stab[(ew * 32 + r) * 2] = mean; Stab[(ew * 32 + r) * 2 + 1] = rstd; }
                }
                WAVE_SYNC();
                const f32x4 gv = *(const f32x4*)(g1 + pn * 256 + el * 4), bv = *(const f32x4*)(b1 + pn * 256 + el * 4);
                LAS unsigned char* wt = (LAS unsigned char*)lds_raw + ew * 8192;
                const LAS unsigned char* wbl = (const LAS unsigned char*)lds_raw + 65536;
#pragma unroll
                for (int ai = 0; ai < 2; ++ai) {
                    u32x2 lokeep[16];
#pragma unroll
                    for (int i = 0; i < 16; ++i) {
                        const float mean = Stab[(ew * 32 + ai * 16 + i) * 2], rstd = Stab[(ew * 32 + ai * 16 + i) * 2 + 1];
                        const f32x4 hv = mul_s4(v[ai][i] - mean, rstd) * gv + bv;
                        const size_t gi = (size_t)(pm * 256 + ai * 128 + i * 8 + ew) * D + pn * 256 + el * 4;
                        *(f32x4*)(y1 + gi) = hv;
                        u32x2 o; o.x = pack2(hv[0], hv[1]); o.y = pack2(hv[2], hv[3]);
                        *(u32x2*)(h1b + gi) = o;
                        lokeep[i].x = pack2(hv[0] - bf2f((bf16_t)(o.x & 0xffffu)), hv[1] - bf2f((bf16_t)(o.x >> 16)));
                        lokeep[i].y = pack2(hv[2] - bf2f((bf16_t)(o.y & 0xffffu)), hv[3] - bf2f((bf16_t)(o.y >> 16)));
                        *(LAS u32x2*)(wt + i * 512 + (((el >> 1) ^ i) << 4) + (el & 1) * 8) = o;
                        COMPILER_FENCE();
                    }
                    WAVE_SYNC();
                    f32x4 ac[3];
#pragma unroll
                    for (int nt = 0; nt < 3; ++nt) ac[nt] = (f32x4){0.f, 0.f, 0.f, 0.f};
#pragma unroll 2
                    for (int ks = 0; ks < 8; ++ks) {
                        const int co = ((ks * 4 + eq4) ^ er16) << 4;
                        const bf16x8 ah = *(const LAS bf16x8*)(wt + er16 * 512 + co);
#pragma unroll
                        for (int nt = 0; nt < 3; ++nt) {
                            const bf16x8 bh = *(const LAS bf16x8*)(wbl + (nt * 16 + er16) * 512 + co);
                            const bf16x8 bl = *(const LAS bf16x8*)(wbl + (48 + nt * 16 + er16) * 512 + co);
                            ac[nt] = MFMA16(ah, bh, ac[nt]); ac[nt] = MFMA16(ah, bl, ac[nt]);
                        }
                    }
                    WAVE_SYNC();
#pragma unroll
                    for (int i = 0; i < 16; ++i) *(LAS u32x2*)(wt + i * 512 + (((el >> 1) ^ i) << 4) + (el & 1) * 8) = lokeep[i];
                    WAVE_SYNC();
#pragma unroll 2
                    for (int ks = 0; ks < 8; ++ks) {
                        const int co = ((ks * 4 + eq4) ^ er16) << 4;
                        const bf16x8 al = *(const LAS bf16x8*)(wt + er16 * 512 + co);
#pragma unroll
                        for (int nt = 0; nt < 3; ++nt) {
                            const bf16x8 bh = *(const LAS bf16x8*)(wbl + (nt * 16 + er16) * 512 + co);
                            ac[nt] = MFMA16(al, bh, ac[nt]);
                        }
                    }
#pragma unroll
                    for (int nt = 0; nt < 3; ++nt)
#pragma unroll
                        for (int j = 0; j < 4; ++j) {
                            const float cv = ac[nt][j];
                            xst32(&part[((size_t)pn * S + pm * 256 + ai * 128 + (eq4 * 4 + j) * 8 + ew) * 48 + nt * 16 + er16], __builtin_bit_cast(unsigned, cv));
                        }
                    WAVE_SYNC();
                }
                WAIT_VM0();
                __syncthreads();
                if (et2 == 0) { (void)xb_add(&pcnt[512 + pm * 16], 1u); XB_SPIN(xb_ld(&pcnt[512 + pm * 16]) < 8u, bw); FENCE_ACQ_AGENT(); }
                __syncthreads();
                int rt = tid; OPAQUE(rt);
#pragma unroll
                for (int k = 0; k < 3; ++k) {
                    const int idx = rt + k * 512, tk = idx / 48, n = idx - tk * 48;
                    unsigned pq[8];
#pragma unroll
                    for (int q = 0; q < 8; ++q) pq[q] = xb_ld(&part[((size_t)q * S + pm * 256 + pn * 32 + tk) * 48 + n]);
                    float a = 0.f;
#pragma unroll
                    for (int q = 0; q < 8; ++q) a += __builtin_bit_cast(float, pq[q]);
                    lgt[idx] = a;
                }
                __syncthreads();
                if (rt < 32) {
                    const int t = pm * 256 + pn * 32 + rt; const float* L = lgt + rt * 48;
                    float gl[4];
#pragma unroll
                    for (int q = 0; q < 4; ++q) gl[q] = L[q] + bg[q];
                    int gi = 0; float gm = gl[0];
#pragma unroll
                    for (int q = 1; q < 4; ++q) if (gl[q] > gm) { gm = gl[q]; gi = q; }
                    float gs = 0.f;
#pragma unroll
                    for (int q = 0; q < 4; ++q) gs += fexp(gl[q] - gm);
                    const float gweight = 1.f / gs;
                    float E[8];
#pragma unroll
                    for (int e = 0; e < 8; ++e) E[e] = L[4 + gi * 8 + e] + br[gi * 8 + e];
                    int e1 = 0; float m1 = E[0];
#pragma unroll
                    for (int e = 1; e < 8; ++e) if (E[e] > m1) { m1 = E[e]; e1 = e; }
                    int e2 = -1; float m2 = -INFINITY;
#pragma unroll
                    for (int e = 0; e < 8; ++e) if (e != e1 && E[e] > m2) { m2 = E[e]; e2 = e; }
                    const float p2 = fexp(m2 - m1), w1 = 1.f / (1.f + p2), w2 = p2 / (1.f + p2);
                    const int ge1 = gi * 8 + e1, ge2 = gi * 8 + e2;
                    const int i1 = (ge1 * G + bid) * segcap + atomic_add_int(&lcnt[ge1], 1);
                    ltok[i1] = t; lw[i1] = gweight * w1; lslot[i1] = 0;
                    const int i2 = (ge2 * G + bid) * segcap + atomic_add_int(&lcnt[ge2], 1);
                    ltok[i2] = t; lw[i2] = gweight * w2; lslot[i2] = 1;
                }
                __syncthreads();
            }
            { int ft = tid; OPAQUE(ft); if (ft < 32) cntb[bid * 32 + ft] = lcnt[ft]; }
            PH_BAR(pb + 3);
        }

        if (PH_SEL(5) && PH_IN(pb + 5)) {
            PHASE_IDS();
            const unsigned nooff[2][2] = {{0u, 0u}, {0u, 0u}};
            const int segcap = ((S / 256 * (D / 256) + G - 1) / G) * 32;
            moe_prefix(cntb, G, lds_raw, tid);
            const int* ctot = (const int*)(lds_raw + LDS_MISC + M_CTOT); const int* coff = (const int*)(lds_raw + LDS_MISC + M_COFF);
            const int* rtok = (const int*)(lds_raw + LDS_MISC + M_RTOK); const float* rw = (const float*)(lds_raw + LDS_MISC + M_RW);
            const int* rslot = (const int*)(lds_raw + LDS_MISC + M_RSLOT);
            unsigned* done = (unsigned*)(wsl + CTL_DONE_OFF) + l * 1024;
            int nmt = 0;
            for (int e = 0; e < NEXP; ++e) nmt += (ctot[e] + 255) / 256;
            nmt = RFL(nmt);
            for (;;) {
                __syncthreads();
                if (tid == 0) *ubox = (unsigned)atomic_add_int(workctr + 8, 1);
                __syncthreads();
                int u = RFL((int)*ubox);
                if (u >= nmt * 12) break;
                const bool down = (u >= nmt * 4);
                const int per = down ? 8 : 4;
                if (down) u -= nmt * 4;
                int e = 0;
                for (;; ++e) { const int nt = ((RFL(ctot[e]) + 255) / 256) * per; if (u < nt) break; u -= nt; }
                const int c = RFL(ctot[e]), off = RFL(coff[e]);
                const int mt = u / per, pn = u % per, m0 = mt * 256;
                moe_rowtable(ltok, lw, lslot, e, m0, c, G, segcap, lds_raw, tid);
                f32x4 acc[2][2][4][2];
                if (!down) {
                    const bf16_t* Bt = WguT + ((size_t)l * NEXP + e) * 1024 * D;
                    unsigned aoff[2][2];
                    int st = tid; OPAQUE(st); int R[2], C[2]; stage_geom(st, R, C);
#pragma unroll
                    for (int h = 0; h < 2; ++h)
#pragma unroll
                        for (int i = 0; i < 2; ++i) aoff[h][i] = (unsigned)(rtok[h * 128 + R[i]] * D + C[i]);
                    gemm_tile<true>(h1b, 0, aoff, Bt, pn * 256, D, lds_raw, acc, tid);
                    int et = tid; OPAQUE(et); const int wr = et >> 8, wc = (et >> 6) & 3, fr = et & 15, fq = (et >> 4) & 3;
#pragma unroll
                    for (int ai = 0; ai < 2; ++ai)
#pragma unroll
                        for (int m = 0; m < 4; ++m)
#pragma unroll
                            for (int j = 0; j < 4; ++j) {
                                const int r = ai * 128 + wr * 64 + m * 16 + fq * 4 + j;
                                const float wgt = rw[r];
#pragma unroll
                                for (int bj = 0; bj < 2; ++bj)
                                    *(bf16_t*)(lds_raw + r * 272 + (bj * 64 + wc * 16 + fr) * 2) = f2bf(silu_f(acc[ai][bj][m][0][j]) * acc[ai][bj][m][1][j] * wgt);
                            }
                    __syncthreads();
#pragma unroll 4
                    for (int i = 0; i < 8; ++i) {
                        const int idx = et + i * 512, r = idx >> 4, ch = idx & 15;
                        if (m0 + r < c) *(u32x4*)(act + (size_t)(off + m0 + r) * DFF + pn * 128 + ch * 8) = *(const u32x4*)(lds_raw + r * 272 + ch * 16);
                    }
                    WAIT_VM0();
                    __syncthreads();
                    if (et == 0) { FENCE_REL_AGENT(); WAIT_VM0(); (void)xb_add(&done[e * 32 + mt], 1u); }
                } else {
                    const bf16_t* Bt = WdT + ((size_t)l * NEXP + e) * D * DFF;
                    if (tid == 0) {
                        unsigned* bw = (unsigned*)wsl;
                        XB_SPIN(xb_ld(&done[e * 32 + mt]) < 4u, bw);
                        FENCE_ACQ_AGENT();
                        WAIT_VM0();
                    }
                    __syncthreads();
                    gemm_tile<false>(act, off + m0, nooff, Bt, pn * 256, DFF, lds_raw, acc, tid);
                    int et = tid; OPAQUE(et); const int wr = et >> 8, wc = (et >> 6) & 3, fr = et & 15, fq = (et >> 4) & 3;
#pragma unroll
                    for (int ai = 0; ai < 2; ++ai)
#pragma unroll
                        for (int m = 0; m < 4; ++m)
#pragma unroll
                            for (int bj = 0; bj < 2; ++bj)
#pragma unroll
                                for (int n = 0; n < 2; ++n)
#pragma unroll
                                    for (int j = 0; j < 4; ++j)
                                        *(bf16_t*)(lds_raw + (ai * 128 + wr * 64 + m * 16 + fq * 4 + j) * 528 + (bj * 128 + wc * 32 + n * 16 + fr) * 2) = f2bf(acc[ai][bj][m][n][j]);
                    __syncthreads();
#pragma unroll 4
                    for (int i = 0; i < 16; ++i) {
                        const int idx = et + i * 512, r = idx >> 5, ch = idx & 31;
                        if (m0 + r < c) *(u32x4*)(contrib + ((size_t)rslot[r] * S + rtok[r]) * D + pn * 256 + ch * 8) = *(const u32x4*)(lds_raw + r * 528 + ch * 16);
                    }
                }
            }
            PH_BAR(pb + 5);
        }

        if (PH_SEL(7) && PH_IN(pb + 7)) for (int rep = 0; rep < PH_REPS(7); ++rep) {
            PHASE_IDS();
            const float* g2 = p.in[I_LN2G] + (size_t)l * D; const float* b2 = p.in[I_LN2B] + (size_t)l * D;
            const bool more = (l + 1 < DEPTH);
            f32x4 gq[8], bq[8];
#pragma unroll
            for (int j = 0; j < 8; ++j) { gq[j] = *(const f32x4*)(g2 + j * 256 + lane * 4); bq[j] = *(const f32x4*)(b2 + j * 256 + lane * 4); }
            if (more) {
                const float* wf = Wfa + (size_t)(l + 1) * 8 * D;
                __syncthreads();
                for (int i = tid; i < 6 * D / 4; i += NTHREADS) *(f32x4*)(ldsf + i * 4) = *(const f32x4*)(wf + i * 4);
                __syncthreads();
            }
            for (int t = gwave; t < S; t += gwaves) {
                f32x4 v[8]; float s = 0.f;
#pragma unroll
                for (int j = 0; j < 8; ++j) {
                    const size_t i = (size_t)t * D + j * 256 + lane * 4;
                    const u32x2 c0 = *(const u32x2*)(contrib + i), c1 = *(const u32x2*)(contrib + (size_t)S * D + i);
                    const f32x4 cs = (f32x4){bf2f((bf16_t)(c0.x & 0xffffu)) + bf2f((bf16_t)(c1.x & 0xffffu)), bf2f((bf16_t)(c0.x >> 16)) + bf2f((bf16_t)(c1.x >> 16)),
                                             bf2f((bf16_t)(c0.y & 0xffffu)) + bf2f((bf16_t)(c1.y & 0xffffu)), bf2f((bf16_t)(c0.y >> 16)) + bf2f((bf16_t)(c1.y >> 16))};
                    v[j] = ALPHA * *(const f32x4*)(y1 + i) + cs;
                    s += (v[j][0] + v[j][1]) + (v[j][2] + v[j][3]);
                }
                const float mean = wave_sum(s) * (1.f / D);
                float s2 = 0.f;
#pragma unroll
                for (int j = 0; j < 8; ++j) { v[j] -= mean; s2 += (v[j][0] * v[j][0] + v[j][1] * v[j][1]) + (v[j][2] * v[j][2] + v[j][3] * v[j][3]); }
                const float rstd = 1.f / sqrtf(wave_sum(s2) * (1.f / D) + LN_EPS);
                float fa[6] = {0.f, 0.f, 0.f, 0.f, 0.f, 0.f};
#pragma unroll
                for (int j = 0; j < 8; ++j) {
                    const int c = j * 256 + lane * 4;
                    v[j] = v[j] * rstd * gq[j] + bq[j];
                    *(f32x4*)(hout + (size_t)t * D + c) = v[j];
                    COMPILER_FENCE();
                    if (more) {
                        u32x2 o; o.x = pack2(v[j][0], v[j][1]); o.y = pack2(v[j][2], v[j][3]);
                        *(u32x2*)(xb + (size_t)t * D + c) = o;
#pragma unroll
                        for (int h = 0; h < 6; ++h) { const f32x4 w = *(const f32x4*)(ldsf + h * D + c); fa[h] += (v[j][0] * w[0] + v[j][1] * w[1]) + (v[j][2] * w[2] + v[j][3] * w[3]); }
                    }
                }
                if (more) {
#pragma unroll
                    for (int h = 0; h < 6; ++h) { const float sm = wave_sum(fa[h]); if (lane == 0) logf_[h * S + t] = log_sigmoid_f(sm + p.in[I_BF][(l + 1) * 6 + h]); }
                }
            }
            PH_BAR(pb + 7);
        }
    }
#undef PH_IN
#undef PH_BAR
}

constexpr int N_PHASES = 1 + DEPTH * 8;
#ifndef EMU
extern "C" void kernel_launch(void* const* d_in, const int* in_sizes, int n_in, void* d_out, int out_size, void* d_ws, size_t ws_size, hipStream_t stream) {
    static int grid = 0;
    if (grid == 0) {
        if (n_in != N_INPUTS || out_size != S * D || ws_size < WS_END) {
            fprintf(stderr, "kernel_launch: unexpected shapes: n_in %d out %d ws %zu (need %zu)\n", n_in, out_size, ws_size, (size_t)WS_END); grid = -1; return; }
        int dev = 0, cus = 0, per_cu = 0;
        if (hipGetDevice(&dev) != hipSuccess || hipDeviceGetAttribute(&cus, hipDeviceAttributeMultiprocessorCount, dev) != hipSuccess) { grid = -1; return; }
        if (hipFuncSetAttribute((const void*)fwd_kernel, hipFuncAttributeMaxDynamicSharedMemorySize, LDS_BYTES) != hipSuccess) { fprintf(stderr, "kernel_launch: hipFuncSetAttribute failed\n"); grid = -1; return; }
        if (hipOccupancyMaxActiveBlocksPerMultiprocessor(&per_cu, (const void*)fwd_kernel, NTHREADS, LDS_BYTES) != hipSuccess || per_cu < 1) {
            fprintf(stderr, "kernel_launch: occupancy query says %d blocks per CU\n", per_cu); (void)hipGetLastError(); grid = -1; return; }
        grid = cus;
    }
    if (grid < 0) return;
    (void)hipMemsetAsync(d_ws, 0, CTL_BYTES, stream);
    Params p{};
    for (int i = 0; i < N_INPUTS; ++i) p.in[i] = (const float*)d_in[i];
    p.out = (float*)d_out; p.ws = (unsigned char*)d_ws;
    for (int i = 0; i < 8; ++i) p.inv_freq[i] = (float)pow(500000.0, -(double)i * 2.0 / 16.0);
#if N_LAUNCH_SPLIT
    for (int k = 0; k < N_PHASES; ++k) { p.lo = k; p.hi = k + 1; hipLaunchKernelGGL(fwd_kernel, dim3(grid), dim3(NTHREADS), LDS_BYTES, stream, p); }
#else
    p.lo = 0; p.hi = N_PHASES;
    hipLaunchKernelGGL(fwd_kernel, dim3(grid), dim3(NTHREADS), LDS_BYTES, stream, p);
#endif
}
#endif
```

```cpp
#ifndef EMU
#include <hip/hip_runtime.h>
#include <cstdio>
#include <cstdint>
#include <cmath>
#endif

#ifndef SEQ
#define SEQ 8192
#endif
#ifndef N_LAUNCH_SPLIT
#define N_LAUNCH_SPLIT 0
#endif
#ifndef REP_PHASE
#define REP_PHASE -2
#endif
#define PH_REPS(c) ((c) == REP_PHASE ? 2 : 1)
#ifndef REP_SUB
#define REP_SUB 0
#endif

constexpr int S = SEQ, D = 2048, DEPTH = 2;
constexpr int FOX_H = 6, FOX_W = 768;
constexpr int LRU_W = 768;
constexpr int DIFF_H = 4, DIFF_W = 512;
constexpr int N_IN = 5382, N_INP = 5376;
constexpr int C_FA = 2304;
constexpr int NEXP = 32, DFF = 512;
constexpr int NKT = S / 64;
#ifndef DCH
#ifndef REP_ROUTER
#define REP_ROUTER 1
#endif
#ifndef REP_STORES
#define REP_STORES 1
#endif
#ifndef REP_STATS
#define REP_STATS 1
#endif
#define DCH 32
#endif
constexpr int NCH = (NKT + DCH - 1) / DCH;
constexpr size_t DPART_ROWS = (size_t)NCH * S - (size_t)(DCH * 64) * NCH * (NCH - 1) / 2;
constexpr float ALPHA = 1.41421356237309504880f;
constexpr float LN_EPS = 1e-5f;
constexpr float LOG2E = 1.4426950408889634f;
constexpr float QSCALE_A = 0.08838834764831845f * 1.4426950408889634f;
constexpr float QSCALE_C = 0.125f * 1.4426950408889634f;

enum { I_X = 0, I_POS, I_WIN, I_BF, I_CONVW, I_CONVB, I_WA, I_BA, I_WI, I_BI, I_LAM, I_LQ1, I_LK1, I_LQ2, I_LK2, I_SUBG, I_WO, I_LN1G, I_LN1B,
       I_WGRP, I_BGRP, I_WRT, I_BRT, I_WGATE, I_WUP, I_WDOWN, I_LN2G, I_LN2B, N_INPUTS };

typedef unsigned short bf16_t;
typedef short bf16x8 __attribute__((ext_vector_type(8)));
typedef float f32x4 __attribute__((ext_vector_type(4)));
typedef unsigned u32x4 __attribute__((ext_vector_type(4)));
typedef unsigned u32x2 __attribute__((ext_vector_type(2)));

constexpr size_t al256(size_t x) { return (x + 255) & ~(size_t)255; }
constexpr size_t CTL_BYTES = 65536;
constexpr size_t CTL_CNT_OFF = 32768;
constexpr size_t CTL_WORK_OFF = 36864;
constexpr size_t CTL_QK2_OFF = 57344;
constexpr size_t CTL_CLS_OFF = 49152;
constexpr size_t CTL_PAN_OFF = 16384;
constexpr size_t CTL_DONE_OFF = 40960;
constexpr size_t WB_WIN = CTL_BYTES;
constexpr size_t WB_WO = WB_WIN + al256((size_t)DEPTH * N_INP * D * 2);
constexpr size_t WB_WGU = WB_WO + al256((size_t)DEPTH * D * D * 2);
constexpr size_t WB_WD = WB_WGU + al256((size_t)DEPTH * NEXP * 1024 * D * 2);
constexpr size_t WB_WAI = WB_WD + al256((size_t)DEPTH * NEXP * D * DFF * 2);
constexpr size_t WF_FA = WB_WAI + al256((size_t)DEPTH * 6 * 256 * 128 * 2);
constexpr size_t WF_R36 = WF_FA + al256((size_t)DEPTH * 8 * D * 4);
constexpr size_t WF_ROPE = WF_R36 + al256((size_t)DEPTH * 2 * 48 * D * 2);
constexpr size_t A_XB = WF_ROPE + al256((size_t)S * 16 * 4);
constexpr size_t A_HB = A_XB + al256((size_t)S * D * 2);
constexpr size_t A_LOGF = A_HB + al256((size_t)S * D * 4);
constexpr size_t A_CUM = A_LOGF + al256((size_t)6 * S * 4);
constexpr size_t A_KMAX = A_CUM + al256((size_t)6 * S * 4);
constexpr size_t A_CNTB = A_KMAX + al256((size_t)6 * NKT * 4);
constexpr size_t A_QA = A_CNTB + al256((size_t)1024 * 32 * 4);
constexpr size_t A_KA = A_QA + al256((size_t)FOX_H * S * 128 * 2);
constexpr size_t A_VAT = A_KA + al256((size_t)FOX_H * S * 128 * 2);
constexpr size_t A_XR = A_VAT + al256((size_t)FOX_H * S * 128 * 2);
constexpr size_t A_GR = A_XR + al256((size_t)S * LRU_W * 2);
constexpr size_t A_QC = A_GR + al256((size_t)S * LRU_W * 2);
constexpr size_t A_KC = A_QC + al256((size_t)DIFF_H * S * 128 * 2);
constexpr size_t A_VCT = A_KC + al256((size_t)DIFF_H * S * 128 * 2);
constexpr size_t A_HLOC = A_VCT + al256((size_t)DIFF_H * S * 128 * 2);
constexpr size_t A_PLOC = A_HLOC + al256((size_t)S * LRU_W * 4);
constexpr size_t A_SUMA = A_PLOC + al256((size_t)S * LRU_W * 4);
constexpr size_t A_SUMH = A_SUMA + al256((size_t)NKT * LRU_W * 4);
constexpr size_t A_CONCAT = A_SUMH + al256((size_t)NKT * LRU_W * 4);
constexpr size_t A_Y1 = A_CONCAT + al256((size_t)S * D * 2);
constexpr size_t A_H1 = A_Y1 + al256((size_t)S * D * 4);
constexpr size_t A_H1B = A_H1 + al256((size_t)S * D * 4);
constexpr size_t A_LTOK = A_H1B + al256((size_t)S * D * 2);
constexpr size_t A_LW = A_LTOK + al256((size_t)NEXP * S * 4);
constexpr size_t A_LSLOT = A_LW + al256((size_t)NEXP * S * 4);
constexpr size_t A_ACT = A_LSLOT + al256((size_t)NEXP * S * 4);
constexpr size_t A_CONTRIB = A_ACT + al256((size_t)(2 * S + 256) * DFF * 2);
constexpr size_t WS_END = A_CONTRIB + al256((size_t)2 * S * D * 4);
constexpr size_t A_DPO = A_Y1;
constexpr size_t A_DPML = A_DPO + al256((size_t)8 * DPART_ROWS * 128 * 2);
static_assert(A_DPML + (size_t)8 * DPART_ROWS * 2 * 4 <= A_H1B, "differential partials must fit inside the y1 + h1 region");

constexpr size_t A_XBUF = A_H1 + al256((size_t)S * D * 2);
constexpr size_t A_PART = A_XBUF + al256((size_t)S * 8 * 8);
static_assert(A_PART + (size_t)8 * S * 48 * 4 <= A_H1B, "exchange buffers must fit inside the h1 region");
constexpr int NTHREADS = 512;
constexpr int LDS_MAIN = 131072 + 4096;
constexpr int LDS_MISC = LDS_MAIN;
constexpr int LDS_BYTES = LDS_MAIN + 8192 + 16640;
constexpr int M_PRE16 = 8192;
constexpr int M_LCNT = 64, M_CTOT = 256, M_COFF = 384, M_PRE = 512, M_RTOK = 2048, M_RW = 3072, M_RSLOT = 4096;

struct Params {
    const float* in[N_INPUTS];
    float* out;
    unsigned char* ws;
    float inv_freq[8];
    int lo, hi;
};

#ifndef EMU
#define LAS __attribute__((address_space(3)))
#define GAS __attribute__((address_space(1)))
#define DYN_LDS(name) extern __shared__ __attribute__((aligned(16))) unsigned char name[]
#define SLEEP1() __builtin_amdgcn_s_sleep(1)
#define WAVE_SYNC() __builtin_amdgcn_wave_barrier()
#define OPAQUE(x) asm volatile("" : "+v"(x))
#define COMPILER_FENCE() asm volatile("" ::: "memory")
#define RFL(x) __builtin_amdgcn_readfirstlane(x)
#define RFL_F(x) __builtin_bit_cast(float, __builtin_amdgcn_readfirstlane(__builtin_bit_cast(int, x)))
#define ANY_LANE(p) (__builtin_amdgcn_ballot_w64(p) != 0ull)
#define RDLANE(v, l) __builtin_bit_cast(float, __builtin_amdgcn_readlane(__builtin_bit_cast(int, v), l))
__device__ __forceinline__ int lane_id_volatile() { int l; asm volatile("v_mbcnt_lo_u32_b32 %0, -1, 0\n\tv_mbcnt_hi_u32_b32 %0, -1, %0" : "=v"(l)); return l; }
#define LANE_ID() lane_id_volatile()
#define OPAQUE_S(x) asm volatile("" : "+s"(x))
#define WAIT_VM0() asm volatile("s_waitcnt vmcnt(0)" ::: "memory")
#define WAIT_ALL0() __builtin_amdgcn_s_waitcnt(0)
#define FENCE_REL_AGENT() __builtin_amdgcn_fence(__ATOMIC_RELEASE, "agent")
#define FENCE_ACQ_AGENT() __builtin_amdgcn_fence(__ATOMIC_ACQUIRE, "agent")
#define MFMA16(a, b, c) __builtin_amdgcn_mfma_f32_16x16x32_bf16(a, b, c, 0, 0, 0)
#define GLDS16(g, l) __builtin_amdgcn_global_load_lds((const unsigned*)(g), (unsigned*)(l), 16, 0, 0)
#define WAIT_V(n) asm volatile("s_waitcnt vmcnt(" #n ")" ::: "memory")
#define WAIT_L(n) asm volatile("s_waitcnt lgkmcnt(" #n ")" ::: "memory")
#define BAR() __builtin_amdgcn_s_barrier()
#define SCHED() __builtin_amdgcn_sched_barrier(0)
#define SETPRIO(n) __builtin_amdgcn_s_setprio(n)
#define FAST_EXP2(x) __builtin_amdgcn_exp2f(x)
template <int M> __device__ __forceinline__ float shx_impl(float v, int lane) {
    if (M < 32) return __builtin_bit_cast(float, __builtin_amdgcn_ds_swizzle(__builtin_bit_cast(int, v), (M << 10) | 0x1f));
    return __builtin_bit_cast(float, __builtin_amdgcn_ds_bpermute((lane ^ 32) << 2, __builtin_bit_cast(int, v)));
}
#define SHX(v, M) shx_impl<M>(v, lane)
template <int CTRL> __device__ __forceinline__ float dppx(float x) { return __builtin_bit_cast(float, __builtin_amdgcn_mov_dpp(__builtin_bit_cast(int, x), CTRL, 0xf, 0xf, true)); }
#define DPP_X1(x) dppx<0xB1>(x)
#define DPP_X2(x) dppx<0x4E>(x)
#define DPP_X7(x) dppx<0x141>(x)
#define DPP_X8(x) dppx<0x128>(x)
#define xrow16_max(x) xrow16_max_l(x, lane)
#define xrow16_sum(x) xrow16_sum_l(x, lane)
__device__ __forceinline__ float xrow16_max_l(float x, int lane) { x = fmaxf(x, shx_impl<16>(x, lane)); return fmaxf(x, shx_impl<32>(x, lane)); }
__device__ __forceinline__ float xrow16_sum_l(float x, int lane) { x = x + shx_impl<16>(x, lane); return x + shx_impl<32>(x, lane); }
#define FAST_LOG2(x) __builtin_amdgcn_logf(x)
#define FAST_RCP(x) __builtin_amdgcn_rcpf(x)
__device__ __forceinline__ unsigned xb_ld(unsigned* p)              { return __hip_atomic_load(p, __ATOMIC_RELAXED, __HIP_MEMORY_SCOPE_AGENT); }
__device__ __forceinline__ unsigned xb_add(unsigned* p, unsigned v) { return __hip_atomic_fetch_add(p, v, __ATOMIC_RELAXED, __HIP_MEMORY_SCOPE_AGENT); }
__device__ __forceinline__ void xst64(unsigned long long* p, unsigned long long v) { __hip_atomic_store(p, v, __ATOMIC_RELAXED, __HIP_MEMORY_SCOPE_AGENT); }
__device__ __forceinline__ unsigned long long xld64(unsigned long long* p) { return __hip_atomic_load(p, __ATOMIC_RELAXED, __HIP_MEMORY_SCOPE_AGENT); }
__device__ __forceinline__ void xst32(unsigned* p, unsigned v) { __hip_atomic_store(p, v, __ATOMIC_RELAXED, __HIP_MEMORY_SCOPE_AGENT); }
__device__ __forceinline__ unsigned xb_xcc_id() { return (unsigned)__builtin_amdgcn_s_getreg((3 << 11) | 20) & 0xFu; }
__device__ __forceinline__ int atomic_add_int(int* p, int v) { return atomicAdd(p, v); }
__device__ __forceinline__ void atomic_min_int(int* p, int v) { atomicMin(p, v); }
__device__ __forceinline__ void atomic_max_u32(unsigned* p, unsigned v) { atomicMax(p, v); }
__device__ __forceinline__ unsigned pack2(float lo, float hi) { unsigned r; asm volatile("v_cvt_pk_bf16_f32 %0, %1, %2" : "=v"(r) : "v"(lo), "v"(hi)); return r; }
#else
#define MFMA16(a, b, c) emu_mfma_16x16x32_bf16(a, b, c)
#define GLDS16(g, l) emu_glds16((const void*)(g), (void*)(l))
#define WAIT_V(n) ((void)0)
#define WAIT_L(n) ((void)0)
#define BAR() __syncthreads()
#define SCHED() ((void)0)
#define SETPRIO(n) ((void)0)
#define FAST_EXP2(x) exp2f(x)
#define SHX(v, M) __shfl_xor(v, M)
#define DPP_X1(x) __shfl_xor(x, 1)
#define DPP_X2(x) __shfl_xor(x, 2)
#define DPP_X7(x) __shfl_xor(x, 7)
#define DPP_X8(x) __shfl_xor(x, 8)
static inline float xrow16_max(float x) { x = fmaxf(x, __shfl_xor(x, 16)); return fmaxf(x, __shfl_xor(x, 32)); }
static inline float xrow16_sum(float x) { x = x + __shfl_xor(x, 16); return x + __shfl_xor(x, 32); }
#define FAST_LOG2(x) log2f(x)
#define FAST_RCP(x) (1.f / (x))
static inline unsigned pack2(float lo, float hi) {
    unsigned a = __builtin_bit_cast(unsigned, lo), b = __builtin_bit_cast(unsigned, hi);
    a += 0x7fffu + ((a >> 16) & 1u); b += 0x7fffu + ((b >> 16) & 1u);
    return (a >> 16) | (b & 0xffff0000u);
}
#endif
__device__ __forceinline__ bf16_t f2bf(float f) { return (bf16_t)(pack2(f, 0.f) & 0xffffu); }
__device__ __forceinline__ float bf2f(bf16_t h) { return __builtin_bit_cast(float, (unsigned)h << 16); }

#define XB_TMO      128
#define XB_XCNT(j)  (256  + 64 * (j))
#define XB_XSUB(j)  (1280 + 64 * (j))
#define XB_XGEN(j)  (2304 + 64 * (j))
#define XB_TOP      3328
#define XB_TOPGEN   3392
#define XCD_BAR_WORDS 3456
#define XB_SPIN_CAP (1u << 22)
#define XB_SPIN(cond, bar) do { unsigned _sp = 0; while (cond) { SLEEP1(); \
    if ((++_sp & 255u) == 0u) { if (xb_ld(&(bar)[XB_TMO])) break; if (_sp > XB_SPIN_CAP) { xb_add(&(bar)[XB_TMO], 1u); break; } } } } while (0)

struct XcdBarrier { unsigned* bar; unsigned x; volatile LAS unsigned* st; };

__device__ __forceinline__ XcdBarrier xcd_barrier_post(unsigned* bar, volatile LAS unsigned* st) {
    XcdBarrier b; b.bar = bar; b.x = xb_xcc_id(); b.st = st;
    if (threadIdx.x == 0) (void)xb_add(&bar[XB_XCNT(b.x)], 1u);
    return b;
}
__device__ __forceinline__ void xcd_barrier_complete(unsigned* bar, unsigned x, unsigned& nloc, unsigned& nx) {
    const unsigned G = gridDim.x;
    unsigned sum, cnt, mine, sp = 0u;
    for (;;) {
        sum = 0u; cnt = 0u; mine = 0u;
#pragma unroll
        for (unsigned j = 0; j < 16; ++j) { const unsigned c = xb_ld(&bar[XB_XCNT(j)]); sum += c; cnt += (c > 0u) ? 1u : 0u; mine = (j == x) ? c : mine; }
        if (sum == G) break;
        SLEEP1();
        if ((++sp & 255u) == 0u) { if (xb_ld(&bar[XB_TMO])) break; if (sp > XB_SPIN_CAP) { xb_add(&bar[XB_TMO], 1u); break; } }
    }
    nloc = mine > 0u ? mine : 1u; nx = cnt > 0u ? cnt : 1u;
}
__device__ __forceinline__ void xcd_barrier(const XcdBarrier& b, bool leader) {
    WAIT_VM0();
    __syncthreads();
    if (leader) {
        unsigned* bar = b.bar;
        WAIT_ALL0();
        unsigned nloc = b.st[0], nx = b.st[1];
        if (nloc == 0u) { xcd_barrier_complete(bar, b.x, nloc, nx); b.st[0] = nloc; b.st[1] = nx; }
        const unsigned old = xb_add(&bar[XB_XSUB(b.x)], 1u);
        const unsigned gen = old / nloc;
        if (old + 1u == (gen + 1u) * nloc) {
            FENCE_REL_AGENT();
            WAIT_VM0();
            const unsigned og = xb_add(&bar[XB_TOP], 1u);
            const unsigned tg = og / nx;
            if (og + 1u == (tg + 1u) * nx) xb_add(&bar[XB_TOPGEN], 1u);
            else XB_SPIN(xb_ld(&bar[XB_TOPGEN]) == tg, bar);
            FENCE_ACQ_AGENT();
            xb_add(&bar[XB_XGEN(b.x)], 1u);
            WAIT_VM0();
        } else {
            XB_SPIN(xb_ld(&bar[XB_XGEN(b.x)]) == gen, bar);
            FENCE_ACQ_AGENT();
            WAIT_VM0();
        }
    }
    __syncthreads();
}

__device__ __forceinline__ f32x4 mul_s4(f32x4 a, float s) {
#ifdef EMU
    return a * s;
#else
    f32x4 o;
#pragma unroll
    for (int c = 0; c < 4; ++c) { float r, x = a[c]; asm volatile("v_mul_f32_e32 %0, %1, %2" : "=v"(r) : "v"(x), "v"(s)); o[c] = r; }
    return o;
#endif
}
__device__ __forceinline__ float wave_sum_l(float v, int lane) {
    (void)lane;
    v += DPP_X1(v); v += DPP_X2(v); v += DPP_X7(v); v += DPP_X8(v);
    return xrow16_sum(v);
}
#define wave_sum(v) wave_sum_l(v, lane)
__device__ __forceinline__ float fexp(float x) { return FAST_EXP2(x * LOG2E); }
__device__ __forceinline__ float sigmoid_f(float x) { return FAST_RCP(1.f + fexp(-x)); }
__device__ __forceinline__ float log_sigmoid_f(float x) { return fminf(x, 0.f) - 0.6931471805599453f * FAST_LOG2(1.f + fexp(-fabsf(x))); }
__device__ __forceinline__ float gelu_tanh_f(float x) { const float u = 0.7978845608028654f * (x + 0.044715f * x * x * x); return x * FAST_RCP(1.f + fexp(-2.f * u)); }
__device__ __forceinline__ float silu_f(float x) { return x * FAST_RCP(1.f + fexp(-x)); }
__device__ __forceinline__ float neg_expm1_f(float x) {
    const float ser = -x * (1.f + x * (0.5f + x * (0.16666667f + x * (0.041666668f + x * (0.008333334f + x * 0.0013888889f)))));
    return (x > -0.35f) ? ser : (1.f - fexp(x));
}

struct RmIdent { __device__ __forceinline__ int operator()(int n) const { return n; } };
struct RmWin { __device__ __forceinline__ int operator()(int n) const { return n < C_FA ? n : (n < C_FA + 6 ? -1 : n - 6); } };
struct RmGu { int kind; __device__ __forceinline__ int operator()(int f) const { return (f >> 7) * 256 + ((f >> 6) & 1) * 128 + ((f >> 4) & 3) * 32 + kind * 16 + (f & 15); } };
struct RmOff { int off; __device__ __forceinline__ int operator()(int n) const { return n + off; } };

template <class RM>
__device__ __forceinline__ void convert_tile(const float* src, int ld, int K, int Nsrc, int k0, int n0, bf16_t* dst, const RM& rm, float* T, int tid) {
    {
        const int nn = tid & 255, kh = (tid >> 8) * 32, n = n0 + nn;
        const float* sp = src + (size_t)(k0 + kh) * ld + n;
        float v[32];
#pragma unroll
        for (int i = 0; i < 32; ++i) v[i] = (n < Nsrc) ? sp[(size_t)i * ld] : 0.f;
#pragma unroll
        for (int i = 0; i < 32; ++i) T[(kh + i) * 257 + nn] = v[i];
    }
    __syncthreads();
#pragma unroll
    for (int q = 0; q < 4; ++q) {
        const int nn = q * 64 + (tid >> 3), kc = (tid & 7) * 8, n = n0 + nn;
        const int row = (n < Nsrc) ? rm(n) : -1;
        if (row >= 0) {
            u32x4 o;
            o.x = pack2(T[(kc + 0) * 257 + nn], T[(kc + 1) * 257 + nn]); o.y = pack2(T[(kc + 2) * 257 + nn], T[(kc + 3) * 257 + nn]);
            o.z = pack2(T[(kc + 4) * 257 + nn], T[(kc + 5) * 257 + nn]); o.w = pack2(T[(kc + 6) * 257 + nn], T[(kc + 7) * 257 + nn]);
            *(u32x4*)(dst + (size_t)row * K + k0 + kc) = o;
        }
    }
    __syncthreads();
}
template <class RM>
__device__ __forceinline__ void convert_tile_v4(const float* src, int ld, int K, int k0, int n0, bf16_t* dst, const RM& rm, float* T, int tid_in) {
    int tid = tid_in; OPAQUE(tid);
    {
        const int w = tid >> 6, l4 = (tid & 63) * 4;
        const float* sp = src + (size_t)(k0 + w * 8) * ld + n0 + l4;
        f32x4 v[8];
#pragma unroll
        for (int i = 0; i < 8; ++i) v[i] = *(const f32x4*)(sp + (size_t)i * ld);
#pragma unroll
        for (int i = 0; i < 8; ++i) { float* tp = T + (w * 8 + i) * 257 + l4; tp[0] = v[i][0]; tp[1] = v[i][1]; tp[2] = v[i][2]; tp[3] = v[i][3]; }
    }
    __syncthreads();
#pragma unroll
    for (int q = 0; q < 4; ++q) {
        const int nn = q * 64 + (tid >> 3), kc = (tid & 7) * 8, n = n0 + nn;
        const int row = rm(n);
        u32x4 o;
        o.x = pack2(T[(kc + 0) * 257 + nn], T[(kc + 1) * 257 + nn]); o.y = pack2(T[(kc + 2) * 257 + nn], T[(kc + 3) * 257 + nn]);
        o.z = pack2(T[(kc + 4) * 257 + nn], T[(kc + 5) * 257 + nn]); o.w = pack2(T[(kc + 6) * 257 + nn], T[(kc + 7) * 257 + nn]);
        *(u32x4*)(dst + (size_t)row * K + k0 + kc) = o;
    }
    __syncthreads();
}
template <class RM>
__device__ __forceinline__ void convert_mats(const float* src, size_t sstride, int nmat, int ld, int K, int Nsrc, bf16_t* dst, size_t dstride, const RM& rm,
                                             float* T, int tid, int bid, int G) {
    const int tk = K / 64, tn = (Nsrc + 255) / 256, per = tk * tn, total = nmat * per;
    for (int t = bid; t < total; t += G) {
        const int mi = t / per, r = t % per;
        convert_tile(src + (size_t)mi * sstride, ld, K, Nsrc, (r / tn) * 64, (r % tn) * 256, dst + (size_t)mi * dstride, rm, T, tid);
    }
}

constexpr int NCONV = DEPTH * 768;
__device__ __forceinline__ void moe_conv_chunk(const Params& p, int cid, bf16_t* WguT_, bf16_t* WdT_, float* T, int tid) {
    const int l = cid / 768, r = cid % 768, kind = r >> 8, t0 = (r & 255) * 8;
    for (int t = t0; t < t0 + 8; ++t) {
        const int mi = t >> 6, rr = t & 63;
        if (kind < 2) {
            const float* src = p.in[kind == 0 ? I_WGATE : I_WUP] + ((size_t)l * NEXP + mi) * D * DFF;
            convert_tile_v4(src, DFF, D, (rr >> 1) * 64, (rr & 1) * 256, WguT_ + ((size_t)l * NEXP + mi) * 1024 * D, RmGu{kind}, T, tid);
        } else {
            const float* src = p.in[I_WDOWN] + ((size_t)l * NEXP + mi) * DFF * D;
            convert_tile_v4(src, D, DFF, (rr >> 3) * 64, (rr & 7) * 256, WdT_ + ((size_t)l * NEXP + mi) * D * DFF, RmIdent{}, T, tid);
        }
    }
}

constexpr int BK = 64, HTB = 128 * 64 * 2;
__device__ __forceinline__ int lds_byte(int r, int c) {
    const int st = (r >> 4) * 2 + (c >> 5), rr = r & 15, cc = c & 31, ob = rr * 64 + cc * 2;
    return st * 1024 + (ob ^ (((ob >> 9) & 1) << 5));
}
__device__ __forceinline__ void stage_rc(int b, int& R, int& C) {
    const int st = b / 1024, sb = b % 1024, swz = sb ^ (((sb >> 9) & 1) << 5);
    R = (st >> 1) * 16 + swz / 64; C = (st & 1) * 32 + (swz % 64) / 2;
}
template <bool GATHER>
__device__ __forceinline__ void gemm_tile(const bf16_t* A, int arow0, const unsigned (&aoff)[2][2], const bf16_t* Bt, int brow0, int K,
                                          unsigned char* shm, f32x4 (&acc)[2][2][4][2], int tid_in) {
    int tid = tid_in; OPAQUE(tid);
    unsigned toff; { int R0, C0; stage_rc(tid * 16, R0, C0); toff = (unsigned)(R0 * K + C0); }
#define SA(b, h) (shm + ((b) * 2 + (h)) * HTB)
#define SB(b, h) (shm + (4 + (b) * 2 + (h)) * HTB)
#define STAGE_B(P, h, kt) do { _Pragma("unroll") for (int _i = 0; _i < 2; ++_i) GLDS16(Bt + ((size_t)(brow0 + (h) * 128 + _i * 64) * K + (size_t)(kt) * BK) + toff, (P) + tid * 16 + _i * 8192); } while (0)
#define STAGE_A(P, h, kt) do { _Pragma("unroll") for (int _i = 0; _i < 2; ++_i) { \
    if (GATHER) GLDS16(A + (size_t)(kt) * BK + aoff[h][_i], (P) + tid * 16 + _i * 8192); \
    else GLDS16(A + ((size_t)(arow0 + (h) * 128 + _i * 64) * K + (size_t)(kt) * BK) + toff, (P) + tid * 16 + _i * 8192); } } while (0)
#define LDA(dst, b, h) _Pragma("unroll") for (int m = 0; m < 4; ++m) _Pragma("unroll") for (int k = 0; k < 2; ++k) \
    dst[m][k] = *reinterpret_cast<const bf16x8*>(SA(b, h) + lds_byte(wr * 64 + m * 16 + fr, k * 32 + fq * 8))
#define LDB(dst, b, h) _Pragma("unroll") for (int n = 0; n < 2; ++n) _Pragma("unroll") for (int k = 0; k < 2; ++k) \
    dst[n][k] = *reinterpret_cast<const bf16x8*>(SB(b, h) + lds_byte(wc * 32 + n * 16 + fr, k * 32 + fq * 8))
#define MMA(ai, bj, At, Bx) do { SETPRIO(1); \
    _Pragma("unroll") for (int m = 0; m < 4; ++m) _Pragma("unroll") for (int n = 0; n < 2; ++n) _Pragma("unroll") for (int k = 0; k < 2; ++k) \
      acc[ai][bj][m][n] = MFMA16(At[m][k], Bx[n][k], acc[ai][bj][m][n]); \
    SETPRIO(0); } while (0)
    int wid = tid >> 6, lane = tid & 63, wr = wid >> 2, wc = wid & 3, fr = lane & 15, fq = lane >> 4;
#pragma unroll
    for (int a = 0; a < 2; ++a)
#pragma unroll
        for (int b = 0; b < 2; ++b)
#pragma unroll
            for (int m = 0; m < 4; ++m)
#pragma unroll
                for (int n = 0; n < 2; ++n) acc[a][b][m][n] = (f32x4){0.f, 0.f, 0.f, 0.f};
    bf16x8 At[4][2], B0[2][2], B1[2][2];
    const int nt = K / BK;
    STAGE_B(SB(0, 0), 0, 0); STAGE_A(SA(0, 0), 0, 0);
    STAGE_B(SB(0, 1), 1, 0); STAGE_A(SA(0, 1), 1, 0);
    if (wr == 1) BAR();
    WAIT_V(4); BAR();
    STAGE_B(SB(1, 0), 0, 1); STAGE_A(SA(1, 0), 0, 1); STAGE_B(SB(1, 1), 1, 1);
    WAIT_V(6); BAR();
    for (int t = 0; t < nt - 2; t += 2) {
        LDB(B0, 0, 0); SCHED(); LDA(At, 0, 0); STAGE_A(SA(1, 1), 1, t + 1);
        WAIT_L(8); BAR(); WAIT_L(0); MMA(0, 0, At, B0); BAR(); SCHED();
        LDB(B1, 0, 1); STAGE_B(SB(0, 0), 0, t + 2);
        BAR(); WAIT_L(0); MMA(0, 1, At, B1); BAR();
        LDA(At, 0, 1); STAGE_A(SA(0, 0), 0, t + 2);
        BAR(); WAIT_L(0); MMA(1, 0, At, B0); BAR(); SCHED();
        STAGE_B(SB(0, 1), 1, t + 2);
        WAIT_V(6); BAR(); MMA(1, 1, At, B1); BAR();
        LDB(B0, 1, 0); SCHED(); LDA(At, 1, 0); STAGE_A(SA(0, 1), 1, t + 2);
        WAIT_L(8); BAR(); WAIT_L(0); MMA(0, 0, At, B0); BAR(); SCHED();
        LDB(B1, 1, 1); STAGE_B(SB(1, 0), 0, t + 3);
        BAR(); WAIT_L(0); MMA(0, 1, At, B1); BAR();
        LDA(At, 1, 1); STAGE_A(SA(1, 0), 0, t + 3);
        BAR(); WAIT_L(0); MMA(1, 0, At, B0); BAR(); SCHED();
        STAGE_B(SB(1, 1), 1, t + 3);
        WAIT_V(6); BAR(); MMA(1, 1, At, B1); BAR();
    }
    OPAQUE(tid); wid = tid >> 6; lane = tid & 63; wr = wid >> 2; wc = wid & 3; fr = lane & 15; fq = lane >> 4;
    { LDB(B0, 0, 0); WAIT_V(0); LDA(At, 0, 0); STAGE_A(SA(1, 1), 1, nt - 1);
      BAR(); WAIT_L(0); MMA(0, 0, At, B0); BAR();
      LDB(B1, 0, 1); BAR(); WAIT_L(0); MMA(0, 1, At, B1); BAR();
      LDA(At, 0, 1); WAIT_V(4); BAR(); WAIT_L(0); MMA(1, 0, At, B0); MMA(1, 1, At, B1); BAR(); }
    { LDB(B0, 1, 0); LDA(At, 1, 0); WAIT_V(2); BAR(); WAIT_L(0); MMA(0, 0, At, B0); BAR();
      LDB(B1, 1, 1); WAIT_V(0); BAR(); WAIT_L(0); MMA(0, 1, At, B1); BAR();
      LDA(At, 1, 1); BAR(); WAIT_L(0); MMA(1, 0, At, B0); MMA(1, 1, At, B1); BAR(); }
    if (wr == 0) BAR();
#undef SA
#undef SB
#undef STAGE_A
#undef STAGE_B
#undef LDA
#undef LDB
#undef MMA
}
__device__ __forceinline__ void stage_geom(int tid, int (&R)[2], int (&C)[2]) {
#pragma unroll
    for (int i = 0; i < 2; ++i) stage_rc(tid * 16 + i * 8192, R[i], C[i]);
}

constexpr int ATT_KBUF = 0, ATT_VBUF = 32768, ATT_CBUF = 65536;
template <int KIND>
__device__ __forceinline__ void attn_unit(const bf16_t* Q, const bf16_t* Kg, const bf16_t* VT, const float* cum2, const float* kmx, int qb, bf16_t* concat, int ccol0,
                                          float lam, float osc, const float* subg, unsigned char* lds, int tid) {
    const int lane = tid & 63, wave = tid >> 6, r16 = lane & 15, q4 = lane >> 4;
    const int q0w = qb * 128 + wave * 16, myq = q0w + r16;
    const int ntiles = 2 * qb + 2;
    const int wlimit = (KIND == 0) ? ((q0w + 15) >> 6) : (q0w >> 6);
    constexpr int NMAP = (KIND == 0) ? 1 : 2, NKS = (KIND == 0) ? 4 : 2;
    bf16x8 qf[NMAP][NKS];
#pragma unroll
    for (int mp = 0; mp < NMAP; ++mp)
#pragma unroll
        for (int ks = 0; ks < NKS; ++ks) qf[mp][ks] = *(const bf16x8*)(Q + (size_t)myq * 128 + mp * 64 + ks * 32 + q4 * 8);
    const float cq = (KIND == 0) ? cum2[myq] : 0.f;
    int kt0 = 0;
    if (KIND == 0) {
        float* wmax = (float*)(lds + ATT_CBUF + 512); int* kst = (int*)(lds + ATT_CBUF + 576);
        float qs = 0.f;
#pragma unroll
        for (int ks = 0; ks < NKS; ++ks)
#pragma unroll
            for (int j = 0; j < 8; ++j) { const float v = bf2f((bf16_t)qf[0][ks][j]); qs += v * v; }
        qs = xrow16_sum(qs);
        qs = fmaxf(qs, SHX(qs, 1)); qs = fmaxf(qs, SHX(qs, 2)); qs = fmaxf(qs, SHX(qs, 4)); qs = fmaxf(qs, SHX(qs, 8));
        if (lane == 0) wmax[wave] = qs;
        if (tid == 0) *kst = 2 * qb;
        __syncthreads();
        float qm = wmax[0];
#pragma unroll
        for (int w = 1; w < 8; ++w) qm = fmaxf(qm, wmax[w]);
        qm = sqrtf(qm) * 1.01f;
        const float kd = sqrtf(fmaxf(kmx[2 * qb], kmx[2 * qb + 1])) * 1.01f;
        if (tid < 2 * qb) {
            const float bias = cum2[qb * 128] - cum2[tid * 64 + 63];
            const bool skip = bias + qm * (sqrtf(kmx[tid]) * 1.01f + kd) < -40.f;
            if (!skip) atomic_min_int(kst, tid);
        }
        __syncthreads();
        kt0 = RFL(*kst);
    }
    f32x4 ot[NMAP][8];
    float mrun[NMAP], lsum[NMAP];
#pragma unroll
    for (int mp = 0; mp < NMAP; ++mp) { mrun[mp] = -INFINITY; lsum[mp] = 0.f;
#pragma unroll
        for (int mo = 0; mo < 8; ++mo) ot[mp][mo] = (f32x4){0.f, 0.f, 0.f, 0.f}; }
    u32x4 sk[2], sv[2]; float sc = 0.f;
    const u32x4* kg = (const u32x4*)Kg; const u32x4* vg = (const u32x4*)VT;
#pragma unroll
    for (int i = 0; i < 2; ++i) { sk[i] = kg[(size_t)kt0 * 1024 + tid + i * 512]; sv[i] = vg[(size_t)kt0 * 1024 + tid + i * 512]; }
    if (KIND == 0 && tid < 64) sc = cum2[kt0 * 64 + tid];
    for (int kt = kt0; kt < ntiles; ++kt) {
        unsigned char* kb = lds + ATT_KBUF + (kt & 1) * 16384;
        unsigned char* vb = lds + ATT_VBUF + (kt & 1) * 16384;
        float* cb = (float*)(lds + ATT_CBUF + (kt & 1) * 256);
#pragma unroll
        for (int i = 0; i < 2; ++i) {
            const int g = tid + i * 512;
            { const int row = g >> 4, c = g & 15; *(u32x4*)(kb + row * 256 + ((c ^ (row & 15)) << 4)) = sk[i]; }
            { const int d = g >> 3, c = g & 7; *(u32x4*)(vb + d * 128 + ((c ^ ((d >> 1) & 7)) << 4)) = sv[i]; }
        }
        if (KIND == 0 && tid < 64) cb[tid] = sc;
        __syncthreads();
        if (kt + 1 < ntiles) {
#pragma unroll
            for (int i = 0; i < 2; ++i) { sk[i] = kg[(size_t)(kt + 1) * 1024 + tid + i * 512]; sv[i] = vg[(size_t)(kt + 1) * 1024 + tid + i * 512]; }
            if (KIND == 0 && tid < 64) sc = cum2[(kt + 1) * 64 + tid];
        }
        if (kt <= wlimit) {
#pragma unroll
            for (int mp = 0; mp < NMAP; ++mp) {
                bf16x8 kf[4][NKS], vfa[8];
#pragma unroll
                for (int m = 0; m < 4; ++m)
#pragma unroll
                    for (int ks = 0; ks < NKS; ++ks) { const int c = (KIND == 0 ? 0 : mp * 8) + ks * 4 + q4; kf[m][ks] = *(const bf16x8*)(kb + (m * 16 + r16) * 256 + ((c ^ r16) << 4)); }
#pragma unroll
                for (int mo = 0; mo < 8; ++mo) { const int d = mo * 16 + r16; vfa[mo] = *(const bf16x8*)(vb + d * 128 + (((0 * 4 + q4) ^ ((d >> 1) & 7)) << 4)); }
                SCHED();
                f32x4 st[4];
#pragma unroll
                for (int m = 0; m < 4; ++m) st[m] = (f32x4){0.f, 0.f, 0.f, 0.f};
#pragma unroll
                for (int ks = 0; ks < NKS; ++ks)
#pragma unroll
                    for (int m = 0; m < 4; ++m) st[m] = MFMA16(kf[m][ks], qf[mp][ks], st[m]);
                SCHED();
                float mx = -INFINITY;
#pragma unroll
                for (int m = 0; m < 4; ++m) {
                    if (KIND == 0) {
                        const f32x4 ck = *(const f32x4*)(cb + m * 16 + 4 * q4);
#pragma unroll
                        for (int j = 0; j < 4; ++j) {
                            float y = st[m][j] + (cq - ck[j]);
                            if (kt * 64 + m * 16 + 4 * q4 + j > myq) y = -INFINITY;
                            st[m][j] = y;
                        }
                    }
#pragma unroll
                    for (int j = 0; j < 4; ++j) mx = fmaxf(mx, st[m][j]);
                }
                mx = xrow16_max(mx);
                const float mnew = fmaxf(mrun[mp], mx);
                const float alpha = FAST_EXP2(mrun[mp] - mnew);
                mrun[mp] = mnew;
                float ps = 0.f;
#pragma unroll
                for (int m = 0; m < 4; ++m)
#pragma unroll
                    for (int j = 0; j < 4; ++j) { const float pv = FAST_EXP2(st[m][j] - mnew); st[m][j] = pv; ps += pv; }
                lsum[mp] = lsum[mp] * alpha + ps;
#pragma unroll
                for (int mo = 0; mo < 8; ++mo) ot[mp][mo] *= alpha;
                bf16x8 pf[2];
#pragma unroll
                for (int kk = 0; kk < 2; ++kk) {
                    u32x4 pw;
                    pw.x = pack2(st[2 * kk][0], st[2 * kk][1]); pw.y = pack2(st[2 * kk][2], st[2 * kk][3]);
                    pw.z = pack2(st[2 * kk + 1][0], st[2 * kk + 1][1]); pw.w = pack2(st[2 * kk + 1][2], st[2 * kk + 1][3]);
                    pf[kk] = __builtin_bit_cast(bf16x8, pw);
                }
                bf16x8 vfb[8];
#pragma unroll
                for (int mo = 0; mo < 8; ++mo) { const int d = mo * 16 + r16; vfb[mo] = *(const bf16x8*)(vb + d * 128 + (((1 * 4 + q4) ^ ((d >> 1) & 7)) << 4)); }
                SCHED();
#pragma unroll
                for (int mo = 0; mo < 8; ++mo) ot[mp][mo] = MFMA16(vfa[mo], pf[0], ot[mp][mo]);
                SCHED();
#pragma unroll
                for (int mo = 0; mo < 8; ++mo) ot[mp][mo] = MFMA16(vfb[mo], pf[1], ot[mp][mo]);
            }
        }
    }
    float inv[NMAP];
#pragma unroll
    for (int mp = 0; mp < NMAP; ++mp) { float l = lsum[mp]; l = xrow16_sum(l); inv[mp] = 1.f / l; }
    if (KIND == 0) {
#pragma unroll
        for (int mo = 0; mo < 8; ++mo) {
            u32x2 o; o.x = pack2(ot[0][mo][0] * inv[0], ot[0][mo][1] * inv[0]); o.y = pack2(ot[0][mo][2] * inv[0], ot[0][mo][3] * inv[0]);
            *(u32x2*)(concat + (size_t)myq * D + ccol0 + mo * 16 + 4 * q4) = o;
        }
    } else {
        float ss = 0.f;
#pragma unroll
        for (int mo = 0; mo < 8; ++mo)
#pragma unroll
            for (int j = 0; j < 4; ++j) { const float v = ot[0][mo][j] * inv[0] - lam * (ot[NMAP - 1][mo][j] * inv[NMAP - 1]); ot[0][mo][j] = v; ss += v * v; }
        ss = xrow16_sum(ss);
        const float rs = osc / sqrtf(ss * (1.f / 128.f) + LN_EPS);
#pragma unroll
        for (int mo = 0; mo < 8; ++mo) {
            const f32x4 g = *(const f32x4*)(subg + mo * 16 + 4 * q4);
            u32x2 o; o.x = pack2(ot[0][mo][0] * rs * g[0], ot[0][mo][1] * rs * g[1]); o.y = pack2(ot[0][mo][2] * rs * g[2], ot[0][mo][3] * rs * g[3]);
            *(u32x2*)(concat + (size_t)myq * D + ccol0 + mo * 16 + 4 * q4) = o;
        }
    }
    __syncthreads();
}

__device__ __forceinline__ int dpart_row(int c, int q) { return c * (S - DCH * 64) - (DCH * 32) * c * (c - 1) + q; }
__device__ __forceinline__ void attn_dmap_unit(const bf16_t* Qh, const bf16_t* Kh, const bf16_t* VTh, int mp, int qb, int t0, int t1,
                                               bf16_t* Op, float* ML, int c, float bnd, unsigned char* lds, int tid) {
    const bool fixedref = (bnd <= 60.f);
    const int lane = tid & 63, wave = tid >> 6, r16 = lane & 15, q4 = lane >> 4;
    const int q0w = qb * 256 + wave * 32;
    const int wlimit = q0w >> 6;
    bf16x8 qf[2][2];
#pragma unroll
    for (int n = 0; n < 2; ++n)
#pragma unroll
        for (int ks = 0; ks < 2; ++ks) qf[n][ks] = *(const bf16x8*)(Qh + (size_t)(q0w + n * 16 + r16) * 128 + mp * 64 + ks * 32 + q4 * 8);
    f32x4 ot[8][2];
    float mrun[2] = {-INFINITY, -INFINITY}, lsum[2] = {0.f, 0.f};
    if (fixedref) { mrun[0] = bnd; mrun[1] = bnd; }
    const float stinit = fixedref ? -bnd : 0.f;
#pragma unroll
    for (int mo = 0; mo < 8; ++mo) { ot[mo][0] = (f32x4){0.f, 0.f, 0.f, 0.f}; ot[mo][1] = (f32x4){0.f, 0.f, 0.f, 0.f}; }
    u32x4 sk, sv[2];
    const u32x4* kg = (const u32x4*)Kh; const u32x4* vg = (const u32x4*)VTh;
    const int krow = tid >> 3, kc8 = tid & 7;
    sk = kg[(size_t)t0 * 1024 + krow * 16 + mp * 8 + kc8];
#pragma unroll
    for (int i = 0; i < 2; ++i) sv[i] = vg[(size_t)t0 * 1024 + tid + i * 512];
    for (int kt = t0; kt < t1; ++kt) {
        unsigned char* kb = lds + (kt & 1) * 8192;
        unsigned char* vb = lds + 16384 + (kt & 1) * 16384;
        *(u32x4*)(kb + krow * 128 + ((kc8 ^ ((krow >> 1) & 7)) << 4)) = sk;
#pragma unroll
        for (int i = 0; i < 2; ++i) { const int g = tid + i * 512, d = g >> 3, cc = g & 7; *(u32x4*)(vb + d * 128 + ((cc ^ ((d >> 1) & 7)) << 4)) = sv[i]; }
        __syncthreads();
        if (kt + 1 < t1) {
            sk = kg[(size_t)(kt + 1) * 1024 + krow * 16 + mp * 8 + kc8];
#pragma unroll
            for (int i = 0; i < 2; ++i) sv[i] = vg[(size_t)(kt + 1) * 1024 + tid + i * 512];
        }
        if (kt <= wlimit) {
            bf16x8 kf[4][2], vfa[8];
#pragma unroll
            for (int m = 0; m < 4; ++m)
#pragma unroll
                for (int ks = 0; ks < 2; ++ks) kf[m][ks] = *(const bf16x8*)(kb + (m * 16 + r16) * 128 + (((ks * 4 + q4) ^ ((r16 >> 1) & 7)) << 4));
#pragma unroll
            for (int mo = 0; mo < 8; ++mo) { const int d = mo * 16 + r16; vfa[mo] = *(const bf16x8*)(vb + d * 128 + (((0 * 4 + q4) ^ ((d >> 1) & 7)) << 4)); }
            SCHED();
            f32x4 st[4][2];
#pragma unroll
            for (int m = 0; m < 4; ++m) { st[m][0] = (f32x4){stinit, stinit, stinit, stinit}; st[m][1] = (f32x4){stinit, stinit, stinit, stinit}; }
            SETPRIO(1);
#pragma unroll
            for (int ks = 0; ks < 2; ++ks)
#pragma unroll
                for (int m = 0; m < 4; ++m) { st[m][0] = MFMA16(kf[m][ks], qf[0][ks], st[m][0]); st[m][1] = MFMA16(kf[m][ks], qf[1][ks], st[m][1]); }
            SETPRIO(0);
            SCHED();
            float alpha[2] = {1.f, 1.f};
            if (fixedref) {
#pragma unroll
                for (int n = 0; n < 2; ++n) {
                    float ps = 0.f;
#pragma unroll
                    for (int m = 0; m < 4; ++m)
#pragma unroll
                        for (int j = 0; j < 4; ++j) { const float pv = FAST_EXP2(st[m][n][j]); st[m][n][j] = pv; ps += pv; }
                    lsum[n] += ps;
                }
            } else
#pragma unroll
            for (int n = 0; n < 2; ++n) {
                float mx = -INFINITY;
#pragma unroll
                for (int m = 0; m < 4; ++m)
#pragma unroll
                    for (int j = 0; j < 4; ++j) mx = fmaxf(mx, st[m][n][j]);
                mx = xrow16_max(mx);
                const float mnew = fmaxf(mrun[n], mx);
                alpha[n] = FAST_EXP2(mrun[n] - mnew);
                mrun[n] = mnew;
                float ps = 0.f;
#pragma unroll
                for (int m = 0; m < 4; ++m)
#pragma unroll
                    for (int j = 0; j < 4; ++j) { const float pv = FAST_EXP2(st[m][n][j] - mnew); st[m][n][j] = pv; ps += pv; }
                lsum[n] = lsum[n] * alpha[n] + ps;
            }
            if (ANY_LANE(alpha[0] != 1.f)) {
#pragma unroll
                for (int mo = 0; mo < 8; ++mo) ot[mo][0] *= alpha[0];
            }
            if (ANY_LANE(alpha[1] != 1.f)) {
#pragma unroll
                for (int mo = 0; mo < 8; ++mo) ot[mo][1] *= alpha[1];
            }
            bf16x8 pf[2][2];
#pragma unroll
            for (int kk = 0; kk < 2; ++kk)
#pragma unroll
                for (int n = 0; n < 2; ++n) {
                    u32x4 pw;
                    pw.x = pack2(st[2 * kk][n][0], st[2 * kk][n][1]); pw.y = pack2(st[2 * kk][n][2], st[2 * kk][n][3]);
                    pw.z = pack2(st[2 * kk + 1][n][0], st[2 * kk + 1][n][1]); pw.w = pack2(st[2 * kk + 1][n][2], st[2 * kk + 1][n][3]);
                    pf[kk][n] = __builtin_bit_cast(bf16x8, pw);
                }
            bf16x8 vfb[8];
#pragma unroll
            for (int mo = 0; mo < 8; ++mo) { const int d = mo * 16 + r16; vfb[mo] = *(const bf16x8*)(vb + d * 128 + (((1 * 4 + q4) ^ ((d >> 1) & 7)) << 4)); }
            SCHED();
            SETPRIO(1);
#pragma unroll
            for (int mo = 0; mo < 8; ++mo) { ot[mo][0] = MFMA16(vfa[mo], pf[0][0], ot[mo][0]); ot[mo][1] = MFMA16(vfa[mo], pf[0][1], ot[mo][1]); }
            SCHED();
#pragma unroll
            for (int mo = 0; mo < 8; ++mo) { ot[mo][0] = MFMA16(vfb[mo], pf[1][0], ot[mo][0]); ot[mo][1] = MFMA16(vfb[mo], pf[1][1], ot[mo][1]); }
            SETPRIO(0);
        }
    }
    if (q0w >= DCH * 64 * c)
#pragma unroll
    for (int n = 0; n < 2; ++n) {
        float l = lsum[n]; l = xrow16_sum(l);
        const int row = dpart_row(c, q0w + n * 16 + r16);
#pragma unroll
        for (int mo = 0; mo < 8; ++mo) {
            u32x2 o; o.x = pack2(ot[mo][n][0], ot[mo][n][1]); o.y = pack2(ot[mo][n][2], ot[mo][n][3]);
            *(u32x2*)(Op + (size_t)(row * 128 + mo * 16 + 4 * q4)) = o;
        }
        if (q4 == 0) { ML[row * 2] = mrun[n]; ML[row * 2 + 1] = l; }
    }
    __syncthreads();
}

__device__ __forceinline__ void lru_unit_a(int chunk, int grp, int l, const Params& p, const bf16_t* Xr, const bf16_t* WaiT, float* hloc, float* ploc, float* sumA, float* sumH,
                                           unsigned char* lds, int tid) {
    const int lane = tid & 63, wave = tid >> 6, r16 = lane & 15, q4 = lane >> 4;
    unsigned char* XCB = lds; float* XU = (float*)(lds + 16384); float* LA = (float*)(lds + 49152); float* ENDS = (float*)(lds + 81920);
    const int t0 = chunk * 64, ch0 = grp * 128;
    bf16x8 bfr[2][4];
#pragma unroll
    for (int g = 0; g < 2; ++g)
#pragma unroll
        for (int ks = 0; ks < 4; ++ks) bfr[g][ks] = *(const bf16x8*)(WaiT + ((size_t)grp * 256 + g * 128 + wave * 16 + r16) * 128 + ks * 32 + q4 * 8);
    const int chg = ch0 + wave * 16 + r16;
    const float ba = p.in[I_BA][(size_t)l * LRU_W + chg], bi = p.in[I_BI][(size_t)l * LRU_W + chg];
    const float lam_raw = p.in[I_LAM][(size_t)l * LRU_W + chg];
    {
        const int c = tid & 127, tq = tid >> 7, ch = ch0 + c;
        const float* cw = p.in[I_CONVW] + (size_t)l * 4 * LRU_W + ch; const float cb = p.in[I_CONVB][(size_t)l * LRU_W + ch];
        const float w0 = cw[0], w1 = cw[LRU_W], w2 = cw[2 * LRU_W], w3 = cw[3 * LRU_W];
        const int ts = t0 + tq * 16;
        float x0 = (ts - 3 >= 0) ? bf2f(Xr[(size_t)(ts - 3) * LRU_W + ch]) : 0.f;
        float x1 = (ts - 2 >= 0) ? bf2f(Xr[(size_t)(ts - 2) * LRU_W + ch]) : 0.f;
        float x2 = (ts - 1 >= 0) ? bf2f(Xr[(size_t)(ts - 1) * LRU_W + ch]) : 0.f;
#pragma unroll
        for (int i = 0; i < 16; ++i) {
            const float x3 = bf2f(Xr[(size_t)(ts + i) * LRU_W + ch]);
            const float v = cb + w0 * x0 + w1 * x1 + w2 * x2 + w3 * x3;
            const int row = tq * 16 + i;
            XU[row * 128 + c] = v;
            *(bf16_t*)(XCB + row * 256 + (((c >> 3) ^ (row & 15)) << 4) + (c & 7) * 2) = f2bf(v);
            x0 = x1; x1 = x2; x2 = x3;
        }
    }
    __syncthreads();
    {
        const float lsl = 8.0f * log_sigmoid_f(lam_raw);
#pragma unroll
        for (int mt = 0; mt < 4; ++mt) {
            f32x4 ga = (f32x4){0.f, 0.f, 0.f, 0.f}, gi = (f32x4){0.f, 0.f, 0.f, 0.f};
#pragma unroll
            for (int ks = 0; ks < 4; ++ks) {
                const bf16x8 af = *(const bf16x8*)(XCB + (mt * 16 + r16) * 256 + (((ks * 4 + q4) ^ r16) << 4));
                ga = MFMA16(af, bfr[0][ks], ga); gi = MFMA16(af, bfr[1][ks], gi);
            }
#pragma unroll
            for (int j = 0; j < 4; ++j) {
                const int row = mt * 16 + 4 * q4 + j, idx = row * 128 + wave * 16 + r16;
                const float r = sigmoid_f(ga[j] + ba), ig = sigmoid_f(gi[j] + bi);
                const float log_a = lsl * r;
                LA[idx] = fexp(log_a);
                XU[idx] = sqrtf(neg_expm1_f(2.f * log_a)) * (ig * XU[idx]);
            }
        }
    }
    __syncthreads();
    {
        const int c = tid & 127, tq = tid >> 7, ch = ch0 + c;
        float h = 0.f, P = 1.f;
#pragma unroll
        for (int i = 0; i < 16; ++i) { const int idx = (tq * 16 + i) * 128 + c; const float a = LA[idx]; h = a * h + XU[idx]; P *= a; XU[idx] = h; LA[idx] = P; }
        ENDS[tq * 128 + c] = P; ENDS[512 + tq * 128 + c] = h;
        __syncthreads();
        float cin = 0.f, pin = 1.f;
        for (int s = 0; s < tq; ++s) { const float Ps = ENDS[s * 128 + c], hs = ENDS[512 + s * 128 + c]; cin = Ps * cin + hs; pin *= Ps; }
#pragma unroll
        for (int i = 0; i < 16; ++i) {
            const int idx = (tq * 16 + i) * 128 + c; const size_t gi = (size_t)(t0 + tq * 16 + i) * LRU_W + ch;
            const float Pl = LA[idx], hl = XU[idx];
            ((unsigned*)hloc)[gi] = pack2(hl + Pl * cin, Pl * pin);
        }
        if (tq == 3) { const float Pl = LA[63 * 128 + c], hl = XU[63 * 128 + c]; sumA[(size_t)chunk * LRU_W + ch] = Pl * pin; sumH[(size_t)chunk * LRU_W + ch] = hl + Pl * cin; }
    }
    __syncthreads();
}

__device__ __forceinline__ void moe_prefix(const int* cntb_, int G, unsigned char* lds, int tid) {
    int* tmp = (int*)lds; int* ctot = (int*)(lds + LDS_MISC + M_CTOT); int* coff = (int*)(lds + LDS_MISC + M_COFF);
    unsigned short* pre16 = (unsigned short*)(lds + LDS_MISC + M_PRE16);
    const int e = tid & 31, part = tid >> 5, PB = (G + 15) / 16;
    int sm = 0;
    for (int i = 0; i < PB; ++i) { const int b = part * PB + i; if (b < G) sm += cntb_[b * 32 + e]; }
    tmp[part * 32 + e] = sm;
    __syncthreads();
    int run = 0;
    for (int q = 0; q < part; ++q) run += tmp[q * 32 + e];
    for (int i = 0; i < PB; ++i) { const int b = part * PB + i; if (b < G) { pre16[e * 257 + b] = (unsigned short)run; run += cntb_[b * 32 + e]; } }
    if (part == 15) { ctot[e] = run; pre16[e * 257 + G] = (unsigned short)run; }
    __syncthreads();
    if (tid == 0) { int o = 0; for (int q = 0; q < 32; ++q) { coff[q] = o; o += ctot[q]; } coff[32] = o; }
    __syncthreads();
}
__device__ __forceinline__ void moe_rowtable(const int* ltok_, const float* lw_, const int* lslot_, int e, int m0, int c_e, int G, int segcap, unsigned char* lds, int tid_in) {
    int tid = tid_in; OPAQUE(tid);
    const unsigned short* pre = (const unsigned short*)(lds + LDS_MISC + M_PRE16) + e * 257;
    int* rtok = (int*)(lds + LDS_MISC + M_RTOK); float* rw = (float*)(lds + LDS_MISC + M_RW); int* rslot = (int*)(lds + LDS_MISC + M_RSLOT);
    if (tid < 256) {
        const int g = m0 + tid;
        int tk = 0, sl = 0; float w = 0.f;
        if (g < c_e) {
            int lo = 0, hi = G;
            while (hi - lo > 1) { const int mid = (lo + hi) >> 1; if ((int)pre[mid] <= g) lo = mid; else hi = mid; }
            const int idx = (e * G + lo) * segcap + (g - (int)pre[lo]);
            tk = ltok_[idx]; w = lw_[idx]; sl = lslot_[idx];
        }
        rtok[tid] = tk; rw[tid] = w; rslot[tid] = sl;
    }
    __syncthreads();
}
#define kmax2 ((float*)(wsl + A_KMAX))
#define dpo ((bf16_t*)(wsl + A_DPO))
#define dpml ((float*)(wsl + A_DPML))
#define cntb ((int*)(wsl + A_CNTB))
#define WinT ((bf16_t*)(wsl + WB_WIN))
#define WoT ((bf16_t*)(wsl + WB_WO))
#define WguT ((bf16_t*)(wsl + WB_WGU))
#define WdT ((bf16_t*)(wsl + WB_WD))
#define WaiT ((bf16_t*)(wsl + WB_WAI))
#define Wfa ((float*)(wsl + WF_FA))
#define W36b ((bf16_t*)(wsl + WF_R36))
#define ropecs ((float*)(wsl + WF_ROPE))
#define xb ((bf16_t*)(wsl + A_XB))
#define hb ((float*)(wsl + A_HB))
#define logf_ ((float*)(wsl + A_LOGF))
#define cum2 ((float*)(wsl + A_CUM))
#define Qa ((bf16_t*)(wsl + A_QA))
#define Ka ((bf16_t*)(wsl + A_KA))
#define VaT ((bf16_t*)(wsl + A_VAT))
#define Xr ((bf16_t*)(wsl + A_XR))
#define Gr ((bf16_t*)(wsl + A_GR))
#define Qc ((bf16_t*)(wsl + A_QC))
#define Kc ((bf16_t*)(wsl + A_KC))
#define VcT ((bf16_t*)(wsl + A_VCT))
#define hloc ((float*)(wsl + A_HLOC))
#define ploc ((float*)(wsl + A_PLOC))
#define sumA ((float*)(wsl + A_SUMA))
#define sumH ((float*)(wsl + A_SUMH))
#define concat ((bf16_t*)(wsl + A_CONCAT))
#define y1 ((float*)(wsl + A_Y1))
#define h1 ((float*)(wsl + A_H1))
#define h1b ((bf16_t*)(wsl + A_H1B))
#define ltok ((int*)(wsl + A_LTOK))
#define lw ((float*)(wsl + A_LW))
#define lslot ((int*)(wsl + A_LSLOT))
#define act ((bf16_t*)(wsl + A_ACT))
#define contrib ((bf16_t*)(wsl + A_CONTRIB))
#ifndef EMU
__global__ void __launch_bounds__(NTHREADS, 2)
#else
void
#endif
fwd_kernel(Params p) {
    DYN_LDS(lds_raw);
    float* ldsf = (float*)lds_raw;
    const int bid = blockIdx.x, G = gridDim.x;
    const int gthreads = G * NTHREADS, gwaves = G * (NTHREADS / 64);
    const int wave_s = RFL((int)threadIdx.x >> 6);
#define PHASE_IDS() unsigned char* wsl = ws; OPAQUE_S(wsl); int tid = wave_s * 64 + LANE_ID(); OPAQUE(tid); const int lane = tid & 63, wave = tid >> 6, gtid = bid * NTHREADS + tid, gwave = bid * (NTHREADS / 64) + wave; (void)lane; (void)wave; (void)gtid; (void)gwave

    unsigned char* ws = p.ws;
    volatile LAS unsigned* bst = (volatile LAS unsigned*)(lds_raw + LDS_MISC);
    unsigned* ubox = (unsigned*)(lds_raw + LDS_MISC + 16);
    if (threadIdx.x == 0) { bst[0] = 0u; bst[1] = 0u; bst[2] = 0u; bst[3] = 0u; }
    __syncthreads();
    XcdBarrier bar = xcd_barrier_post((unsigned*)ws, bst);

    const int* positions = (const int*)p.in[I_POS];

    constexpr int NPH = 8;
    const int lo = p.lo, hi = p.hi;
#ifdef ONLY_PHASE
#define PH_SEL(c) ((c) == ONLY_PHASE)
#else
#define PH_SEL(c) 1
#endif
#define PH_IN(k) (lo <= (k) && (k) < hi)
#define PH_BAR(k) do { if ((k) + 1 < hi) xcd_barrier(bar, wave_s == 0 && LANE_ID() == 0); } while (0)

    if (PH_SEL(-1) && PH_IN(0)) for (int rep = 0; rep < PH_REPS(-1); ++rep) {
        PHASE_IDS();
        for (int l = 0; l < DEPTH; ++l) {
            convert_mats(p.in[I_WIN] + (size_t)l * D * N_IN, 0, 1, N_IN, D, N_IN, WinT + (size_t)l * N_INP * D, 0, RmWin{}, ldsf, tid, bid, G);
            for (int t = bid; t < (D / 64) * (D / 256); t += G)
                convert_tile_v4(p.in[I_WO] + (size_t)l * D * D, D, D, (t / (D / 256)) * 64, (t % (D / 256)) * 256, WoT + (size_t)l * D * D, RmIdent{}, ldsf, tid);
            convert_mats(p.in[I_WA] + (size_t)l * 6 * 128 * 128, (size_t)128 * 128, 6, 128, 128, 128, WaiT + (size_t)l * 6 * 256 * 128, (size_t)256 * 128, RmIdent{}, ldsf, tid, bid, G);
            convert_mats(p.in[I_WI] + (size_t)l * 6 * 128 * 128, (size_t)128 * 128, 6, 128, 128, 128, WaiT + (size_t)l * 6 * 256 * 128, (size_t)256 * 128, RmOff{128}, ldsf, tid, bid, G);
        }
        for (int i = gtid; i < DEPTH * 8 * D; i += gthreads) { const int k = i % D, h = (i / D) % 8, l = i / (8 * D);
            Wfa[i] = (h < 6) ? p.in[I_WIN][(size_t)l * D * N_IN + (size_t)k * N_IN + C_FA + h] : 0.f; }
        for (int i = gtid; i < DEPTH * 48 * D; i += gthreads) { const int k = i % D, o = (i / D) % 48, l = i / (48 * D);
            const float w = (o < 4) ? p.in[I_WGRP][((size_t)l * D + k) * 4 + o] : (o < 36 ? p.in[I_WRT][((size_t)l * D + k) * 32 + (o - 4)] : 0.f);
            const bf16_t hi = f2bf(w);
            W36b[((size_t)l * 2 + 0) * 48 * D + (size_t)o * D + k] = hi; W36b[((size_t)l * 2 + 1) * 48 * D + (size_t)o * D + k] = f2bf(w - bf2f(hi)); }
        for (int i = gtid; i < S * 8; i += gthreads) { const int d = i & 7, t = i >> 3; const float ang = (float)positions[t] * p.inv_freq[d];
            ropecs[t * 16 + d] = cosf(ang); ropecs[t * 16 + 8 + d] = sinf(ang); }
        __syncthreads();
        for (int i = tid; i < 6 * D; i += NTHREADS) { const int k = i % D, h = i / D; ldsf[i] = p.in[I_WIN][(size_t)k * N_IN + C_FA + h]; }
        __syncthreads();
        for (int t0 = gwave * 2; t0 < S; t0 += gwaves * 2) {
            f32x4 v[2][8];
#pragma unroll
            for (int tk = 0; tk < 2; ++tk)
#pragma unroll
                for (int j = 0; j < 8; ++j) v[tk][j] = *(const f32x4*)(p.in[I_X] + (size_t)(t0 + tk) * D + j * 256 + lane * 4);
#pragma unroll
            for (int tk = 0; tk < 2; ++tk) {
                const int t = t0 + tk;
                float fa[6] = {0.f, 0.f, 0.f, 0.f, 0.f, 0.f};
#pragma unroll
                for (int j = 0; j < 8; ++j) {
                    const int c = j * 256 + lane * 4;
                    u32x2 o; o.x = pack2(v[tk][j][0], v[tk][j][1]); o.y = pack2(v[tk][j][2], v[tk][j][3]);
                    *(u32x2*)(xb + (size_t)t * D + c) = o;
#pragma unroll
                    for (int h = 0; h < 6; ++h) { const f32x4 w = *(const f32x4*)(ldsf + h * D + c); fa[h] += v[tk][j][0] * w[0] + v[tk][j][1] * w[1] + v[tk][j][2] * w[2] + v[tk][j][3] * w[3]; }
                    COMPILER_FENCE();
                }
#pragma unroll
                for (int h = 0; h < 6; ++h) { const float sm = wave_sum(fa[h]); if (lane == 0) logf_[h * S + t] = log_sigmoid_f(sm + p.in[I_BF][h]); }
            }
        }
        PH_BAR(0);
    }

    for (int l = 0; l < DEPTH; ++l) {
        const int pb = 1 + l * NPH;
#define hin ((l == 0) ? p.in[I_X] : (const float*)hb)
#define hout ((l == DEPTH - 1) ? p.out : hb)
#define workctr ((int*)(wsl + CTL_WORK_OFF) + l * 64)

        if (PH_SEL(0) && PH_IN(pb + 0)) {
            PHASE_IDS();
            int bz = RFL(bid); OPAQUE_S(bz);
            if (bz == 0) {
                double* part = (double*)lds_raw;
                const int per = S / 64;
                double s = 0.0;
                if (wave < 6) { for (int i = 0; i < per; ++i) s += (double)logf_[wave * S + lane * per + i]; part[wave * 64 + lane] = s; }
                __syncthreads();
                if (wave < 6) {
                    double run = 0.0;
                    for (int j = 0; j < lane; ++j) run += part[wave * 64 + j];
                    for (int i = 0; i < per; ++i) { run += (double)logf_[wave * S + lane * per + i]; cum2[wave * S + lane * per + i] = (float)(run * (double)LOG2E); }
                }
                __syncthreads();
            }
            bool conv_more = (l == 0);
#define CONV_ONE() do { if (conv_more) { __syncthreads(); if (tid == 0) *ubox = (unsigned)atomic_add_int((int*)(wsl + CTL_WORK_OFF) + 62, 1); __syncthreads(); \
                const int cid_ = RFL((int)*ubox); if (cid_ < NCONV) moe_conv_chunk(p, cid_, WguT, WdT, ldsf, tid); else conv_more = false; } } while (0)
            unsigned* cls = (unsigned*)(wsl + CTL_CLS_OFF) + l * 256;
            if (bz == 0) { WAIT_VM0(); __syncthreads(); if (tid == 0) { FENCE_REL_AGENT(); WAIT_VM0(); (void)xb_add(&cls[192], 1u); } }
            const bf16_t* Bt = WinT + (size_t)l * N_INP * D;
            constexpr int ntm = S / 256;
            const unsigned nooff[2][2] = {{0u, 0u}, {0u, 0u}};
            for (int i = 0; i < (bid & 3); ++i) CONV_ONE();
            for (;;) {
                __syncthreads();
                if (tid == 0) *ubox = (unsigned)atomic_add_int(workctr + 9, 1);
                __syncthreads();
                int t = RFL((int)*ubox);
                if (t >= ntm * 21) break;
                int pm, pn, kcls;
                if (t < ntm * 6) { pm = t / 6; pn = 15 + t % 6; kcls = 0; }
                else if (t < ntm * 12) { t -= ntm * 6; pm = t / 6; pn = 9 + t % 6; kcls = 1; }
                else { t -= ntm * 12; pm = t / 9; pn = t % 9; kcls = 2; }
                f32x4 acc[2][2][4][2];
                gemm_tile<false>(xb, pm * 256, nooff, Bt, pn * 256, D, lds_raw, acc, tid);
                int et = tid; OPAQUE(et); const int wr = et >> 8, wc = (et >> 6) & 3, fr = et & 15, fq = (et >> 4) & 3;
                if (pn < 6 || (pn >= 9 && pn < 19)) {
                    bf16_t* dst; float scale = 1.f; bool rope = false;
                    if (pn < 3) { dst = Qa; scale = QSCALE_A; } else if (pn < 6) { dst = Ka; } else if (pn < 12) { dst = Xr; } else if (pn < 15) { dst = Gr; }
                    else if (pn < 17) { dst = Qc; scale = QSCALE_C; rope = true; } else { dst = Kc; rope = true; }
                    const bool headmajor = (pn < 6) || (pn >= 15);
                    const int segpn = (pn < 3) ? pn : (pn < 6) ? pn - 3 : (pn < 12) ? pn - 9 : (pn < 15) ? pn - 12 : (pn < 17) ? pn - 15 : pn - 17;
#pragma unroll
                    for (int ai = 0; ai < 2; ++ai)
#pragma unroll
                        for (int m = 0; m < 4; ++m)
#pragma unroll
                            for (int bj = 0; bj < 2; ++bj)
#pragma unroll
                                for (int n = 0; n < 2; ++n) {
                                    const int dd = wc * 32 + n * 16 + fr;
#pragma unroll
                                    for (int j = 0; j < 4; ++j) {
                                        const int row = pm * 256 + ai * 128 + wr * 64 + m * 16 + fq * 4 + j;
                                        float v = acc[ai][bj][m][n][j];
                                        if (rope && n == 0 && (wc & 1) == 0) {
                                            const float pv = SHX(v, 8);
                                            const float cs = ropecs[row * 16 + (fr & 7)], sn = ropecs[row * 16 + 8 + (fr & 7)];
                                            v = (fr < 8) ? (v * cs - pv * sn) : (v * cs + pv * sn);
                                        }
                                        v *= scale;
                                        *(bf16_t*)(lds_raw + (ai * 128 + wr * 64 + m * 16 + fq * 4 + j) * 528 + (bj * 128 + dd) * 2) = f2bf(v);
                                    }
                                }
                    __syncthreads();
#pragma unroll 4
                    for (int i = 0; i < 16; ++i) {
                        const int idx = et + i * 512, lrow = idx >> 5, ch = idx & 31, row = pm * 256 + lrow;
                        const u32x4 val = *(const u32x4*)(lds_raw + lrow * 528 + ch * 16);
                        size_t gi;
                        if (headmajor) gi = ((size_t)(segpn * 2 + (ch >> 4)) * S + row) * 128 + (ch & 15) * 8;
                        else gi = (size_t)row * LRU_W + segpn * 256 + ch * 8;
                        *(u32x4*)(dst + gi) = val;
                    }
                    __syncthreads();
                    if (pn >= 15) {
                        float* part = ldsf;
#pragma unroll
                        for (int ai = 0; ai < 2; ++ai)
#pragma unroll
                            for (int m = 0; m < 4; ++m)
#pragma unroll
                                for (int bj = 0; bj < 2; ++bj)
#pragma unroll
                                    for (int j = 0; j < 4; ++j) {
                                        float ss = acc[ai][bj][m][0][j] * acc[ai][bj][m][0][j] + acc[ai][bj][m][1][j] * acc[ai][bj][m][1][j];
                                        ss += SHX(ss, 1); ss += SHX(ss, 2); ss += SHX(ss, 4); ss += SHX(ss, 8);
                                        if (fr == 0) part[(wc * 2 + bj) * 256 + ai * 128 + wr * 64 + m * 16 + fq * 4 + j] = ss;
                                    }
                        __syncthreads();
                        {
                            const int bj = et >> 8, row = et & 255;
                            float v0 = part[(0 * 2 + bj) * 256 + row] + part[(1 * 2 + bj) * 256 + row], v1 = part[(2 * 2 + bj) * 256 + row] + part[(3 * 2 + bj) * 256 + row];
                            v0 = fmaxf(v0, SHX(v0, 1)); v0 = fmaxf(v0, SHX(v0, 2)); v0 = fmaxf(v0, SHX(v0, 4)); v0 = fmaxf(v0, SHX(v0, 8)); v0 = xrow16_max(v0);
                            v1 = fmaxf(v1, SHX(v1, 1)); v1 = fmaxf(v1, SHX(v1, 2)); v1 = fmaxf(v1, SHX(v1, 4)); v1 = fmaxf(v1, SHX(v1, 8)); v1 = xrow16_max(v1);
                            if ((et & 63) == 0) {
                                unsigned* q2p = (unsigned*)(wsl + CTL_QK2_OFF) + l * 16 + (pn >= 17 ? 8 : 0) + (segpn * 2 + bj) * 2;
                                atomic_max_u32(q2p, __builtin_bit_cast(unsigned, v0)); atomic_max_u32(q2p + 1, __builtin_bit_cast(unsigned, v1));
                            }
                        }
                        __syncthreads();
                    }
                    if (pn >= 3 && pn < 6) {
                        float* part = ldsf;
#pragma unroll
                        for (int ai = 0; ai < 2; ++ai)
#pragma unroll
                            for (int m = 0; m < 4; ++m)
#pragma unroll
                                for (int bj = 0; bj < 2; ++bj)
#pragma unroll
                                    for (int j = 0; j < 4; ++j) {
                                        float ss = acc[ai][bj][m][0][j] * acc[ai][bj][m][0][j] + acc[ai][bj][m][1][j] * acc[ai][bj][m][1][j];
                                        ss += SHX(ss, 1); ss += SHX(ss, 2); ss += SHX(ss, 4); ss += SHX(ss, 8);
                                        if (fr == 0) part[(wc * 2 + bj) * 256 + ai * 128 + wr * 64 + m * 16 + fq * 4 + j] = ss;
                                    }
                        __syncthreads();
                        {
                            const int bj = et >> 8, row = et & 255;
                            float v = part[(0 * 2 + bj) * 256 + row] + part[(1 * 2 + bj) * 256 + row] + part[(2 * 2 + bj) * 256 + row] + part[(3 * 2 + bj) * 256 + row];
                            v = fmaxf(v, SHX(v, 1)); v = fmaxf(v, SHX(v, 2)); v = fmaxf(v, SHX(v, 4)); v = fmaxf(v, SHX(v, 8)); v = xrow16_max(v);
                            if ((et & 63) == 0) kmax2[((pn - 3) * 2 + bj) * NKT + pm * 4 + ((et >> 6) & 3)] = v;
                        }
                        __syncthreads();
                    }
                } else {
                    bf16_t* dst = (pn < 9) ? VaT : VcT;
                    const int segpn = (pn < 9) ? pn - 6 : pn - 19;
#pragma unroll
                    for (int ai = 0; ai < 2; ++ai)
#pragma unroll
                        for (int m = 0; m < 4; ++m)
#pragma unroll
                            for (int bj = 0; bj < 2; ++bj)
#pragma unroll
                                for (int n = 0; n < 2; ++n) {
                                    const int dd = wc * 32 + n * 16 + fr;
                                    const int row = pm * 256 + ai * 128 + wr * 64 + m * 16 + fq * 4;
                                    const f32x4 a = acc[ai][bj][m][n];
                                    u32x2 o; o.x = pack2(a[0], a[1]); o.y = pack2(a[2], a[3]);
                                    const int s6 = row & 63, pos = (s6 & 32) + ((s6 >> 2) & 3) * 8 + ((s6 >> 4) & 1) * 4;
                                    *(u32x2*)(dst + (((size_t)(segpn * 2 + bj) * NKT + (row >> 6)) * 128 + dd) * 64 + pos) = o;
                                }
                }
                WAIT_VM0();
                __syncthreads();
                if (et == 0) { FENCE_REL_AGENT(); WAIT_VM0(); (void)xb_add(&cls[kcls * 64], 1u); }
                CONV_ONE();
            }
        }

        if (PH_SEL(1) && PH_IN(pb + 1)) {
            PHASE_IDS();
            const float lam_init = (l == 0) ? 0.2f : 0.35550906759f;
            const float s1 = wave_sum(p.in[I_LQ1][l * 64 + lane] * p.in[I_LK1][l * 64 + lane]);
            const float s2 = wave_sum(p.in[I_LQ2][l * 64 + lane] * p.in[I_LK2][l * 64 + lane]);
            const float lam = fexp(s1) - fexp(s2) + lam_init;
            constexpr int NLRU = NKT * 6, NQB = S / 128;
            bool conv_more = (l == 0);
            unsigned* cls = (unsigned*)(wsl + CTL_CLS_OFF) + l * 256;
            unsigned* bw = (unsigned*)wsl;
#define WAIT_CLASS(k, n) do { __syncthreads(); if (tid == 0) { XB_SPIN(xb_ld(&cls[(k) * 64]) < (unsigned)(n), bw); FENCE_ACQ_AGENT(); WAIT_VM0(); } __syncthreads(); } while (0)
#ifndef NO_DIFF
            {
                constexpr int NQB2 = S / 256;
                int total = 0;
                for (int q = 0; q < NQB2; ++q) total += ((4 * q + 4 + DCH - 1) / DCH) * 8;
                WAIT_CLASS(0, (S / 256) * 6);
                for (;;) {
                    __syncthreads();
                    if (tid == 0) *ubox = (unsigned)atomic_add_int(workctr, 1);
                    __syncthreads();
                    int u = RFL((int)*ubox);
                    if (u >= total) break;
                    int qb = NQB2 - 1;
                    for (;; --qb) { const int nu = ((4 * qb + 4 + DCH - 1) / DCH) * 8; if (u < nu) break; u -= nu; }
                    const int c = u >> 3, h = (u >> 1) & 3, mp = u & 1;
                    const int t0 = c * DCH, t1 = (t0 + DCH < 4 * qb + 4) ? t0 + DCH : 4 * qb + 4;
                    const unsigned* q2p = (const unsigned*)(wsl + CTL_QK2_OFF) + l * 16;
                    const float bnd = sqrtf(__builtin_bit_cast(float, q2p[h * 2 + mp]) * __builtin_bit_cast(float, q2p[8 + h * 2 + mp])) * (QSCALE_C * 1.02f) + 0.01f;
                    attn_dmap_unit(Qc + (size_t)h * S * 128, Kc + (size_t)h * S * 128, VcT + (size_t)h * S * 128, mp, qb, t0, t1,
                                   dpo + (size_t)(h * 2 + mp) * DPART_ROWS * 128, dpml + (size_t)(h * 2 + mp) * DPART_ROWS * 2, c, RFL_F(bnd), lds_raw, tid);
                    CONV_ONE();
                }
            }
#endif
#ifndef NO_LRU
            WAIT_CLASS(1, (S / 256) * 6);
            for (;;) {
                __syncthreads();
                if (tid == 0) *ubox = (unsigned)atomic_add_int(workctr + 10, 1);
                __syncthreads();
                const int u = RFL((int)*ubox);
                if (u >= NLRU) break;
                lru_unit_a(u / 6, u % 6, l, p, Xr, WaiT + (size_t)l * 6 * 256 * 128, hloc, ploc, sumA, sumH, lds_raw, tid);
            }
#endif
#ifndef NO_FOX
            WAIT_CLASS(2, (S / 256) * 9);
            WAIT_CLASS(3, 1);
            for (;;) {
                __syncthreads();
                if (tid == 0) *ubox = (unsigned)atomic_add_int(workctr + 1, 1);
                __syncthreads();
                const int u = RFL((int)*ubox);
                if (u >= NQB * FOX_H) break;
                const int qb = NQB - 1 - u / FOX_H, h = u % FOX_H;
                attn_unit<0>(Qa + (size_t)h * S * 128, Ka + (size_t)h * S * 128, VaT + (size_t)h * S * 128, cum2 + (size_t)h * S, kmax2 + h * NKT, qb, concat, h * 128,
                             0.f, 0.f, nullptr, lds_raw, tid);
            }
#endif
            while (conv_more) CONV_ONE();
            PH_BAR(pb + 1);
        }

        if (PH_SEL(2) && PH_IN(pb + 2)) for (int rep = 0; rep < PH_REPS(2); ++rep) {
            PHASE_IDS();
            for (int u = bid; u < NKT * 6; u += G) {
                const int chunk = u / 6, grp = u % 6, c = tid & 127, tq = tid >> 7, ch = grp * 128 + c;
                float cr = 0.f;
                {
                    int j = 0;
                    for (; j + 16 <= chunk; j += 16) {
                        float a8[16], h8[16];
#pragma unroll
                        for (int q = 0; q < 16; ++q) { a8[q] = sumA[(size_t)(j + q) * LRU_W + ch]; h8[q] = sumH[(size_t)(j + q) * LRU_W + ch]; }
#pragma unroll
                        for (int q = 0; q < 16; ++q) cr = a8[q] * cr + h8[q];
                    }
                    for (; j < chunk; ++j) cr = sumA[(size_t)j * LRU_W + ch] * cr + sumH[(size_t)j * LRU_W + ch];
                }
                float hl[16], pl[16]; bf16_t gg[16];
#pragma unroll
                for (int i = 0; i < 16; ++i) { const size_t gi = (size_t)(chunk * 64 + tq * 16 + i) * LRU_W + ch; const unsigned hp = ((const unsigned*)hloc)[gi]; hl[i] = bf2f((bf16_t)(hp & 0xffffu)); pl[i] = bf2f((bf16_t)(hp >> 16)); gg[i] = Gr[gi]; }
#pragma unroll
                for (int i = 0; i < 16; ++i)
                    concat[(size_t)(chunk * 64 + tq * 16 + i) * D + FOX_W + ch] = f2bf(gelu_tanh_f(bf2f(gg[i])) * (hl[i] + pl[i] * cr));
            }
            {
                const float lam_init = (l == 0) ? 0.2f : 0.35550906759f;
                const float s1 = wave_sum(p.in[I_LQ1][l * 64 + lane] * p.in[I_LK1][l * 64 + lane]);
                const float s2 = wave_sum(p.in[I_LQ2][l * 64 + lane] * p.in[I_LK2][l * 64 + lane]);
                const float lam = fexp(s1) - fexp(s2) + lam_init;
                const float* sg = p.in[I_SUBG] + l * 128;
                const float g0 = sg[2 * lane], g1 = sg[2 * lane + 1];
                static_assert(NCH <= 8, "the merge below keeps one (map, chunk) pair per lane: 2 x 8 lanes");
                for (int q = gwave; q < S; q += gwaves) {
                    const int nch = (q >> 6) / DCH + 1;
                    float mv = -INFINITY, lv = 0.f;
                    { const int c = lane & 7, hm = lane >> 3;
                      if (c < nch) { const float* ML = dpml + ((size_t)hm * DPART_ROWS + dpart_row(c, q)) * 2; mv = ML[0]; lv = ML[1]; } }
                    unsigned pk[4][2][NCH];
#pragma unroll
                    for (int h = 0; h < 4; ++h)
#pragma unroll
                        for (int mp = 0; mp < 2; ++mp) {
                            const unsigned* OP = (const unsigned*)(dpo + (size_t)(h * 2 + mp) * DPART_ROWS * 128);
#pragma unroll
                            for (int c = 0; c < NCH; ++c) pk[h][mp][c] = (c < nch) ? OP[(size_t)dpart_row(c, q) * 64 + lane] : 0u;
                        }
                    float Mx = mv; Mx = fmaxf(Mx, DPP_X1(Mx)); Mx = fmaxf(Mx, DPP_X2(Mx)); Mx = fmaxf(Mx, DPP_X7(Mx));
                    const float wv = (mv == -INFINITY) ? 0.f : FAST_EXP2(mv - Mx);
                    float Lp = lv * wv; Lp += DPP_X1(Lp); Lp += DPP_X2(Lp); Lp += DPP_X7(Lp);
#pragma unroll
                    for (int h = 0; h < 4; ++h) {
                        float om[2][2];
#pragma unroll
                        for (int mp = 0; mp < 2; ++mp) {
                            float o0 = 0.f, o1 = 0.f;
#pragma unroll
                            for (int c = 0; c < NCH; ++c) { const float w = RDLANE(wv, (h * 2 + mp) * 8 + c); o0 += bf2f((bf16_t)(pk[h][mp][c] & 0xffffu)) * w; o1 += bf2f((bf16_t)(pk[h][mp][c] >> 16)) * w; }
                            const float il = 1.f / RDLANE(Lp, (h * 2 + mp) * 8);
                            om[mp][0] = o0 * il; om[mp][1] = o1 * il;
                        }
                        const float v0 = om[0][0] - lam * om[1][0], v1 = om[0][1] - lam * om[1][1];
                        const float ss = wave_sum(v0 * v0 + v1 * v1);
                        const float rs = (1.f - lam_init) / sqrtf(ss * (1.f / 128.f) + LN_EPS);
                        *(unsigned*)(concat + (size_t)q * D + 1536 + h * 128 + 2 * lane) = pack2(v0 * rs * g0, v1 * rs * g1);
                    }
                }
            }
            PH_BAR(pb + 2);
        }

        if (PH_SEL(3) && PH_IN(pb + 3)) {
            PHASE_IDS();
            const bf16_t* Bt = WoT + (size_t)l * D * D;
            constexpr int ntn = D / 256, ntm = S / 256;
            static_assert(ntn == 8, "the panel exchange is written for 8 column tiles");
            const unsigned nooff[2][2] = {{0u, 0u}, {0u, 0u}};
            const float* g1 = p.in[I_LN1G] + (size_t)l * D; const float* b1 = p.in[I_LN1B] + (size_t)l * D;
            const float* bg = p.in[I_BGRP] + l * 4; const float* br = p.in[I_BRT] + l * 32;
            const bf16_t* Wb = W36b + (size_t)l * 2 * 48 * D;
            int* lcnt = (int*)(lds_raw + LDS_MISC + M_LCNT);
            const int segcap = ((ntm * ntn + G - 1) / G) * 32;
            unsigned* pcnt = (unsigned*)(wsl + CTL_PAN_OFF) + l * 1024;
            unsigned long long* xbuf = (unsigned long long*)(wsl + A_XBUF);
            unsigned* part = (unsigned*)(wsl + A_PART);
            LAS float* Stab = (LAS float*)(lds_raw + LDS_MISC + M_RTOK);
            float* lgt = (float*)(lds_raw + LDS_MISC + 4096);
            if (tid < 32) lcnt[tid] = 0;
            __syncthreads();
            for (int t0 = bid; t0 < ntm * ntn; t0 += G) {
                int t = t0;
                if (G == 256 && ntm * ntn == 256) { const int x = t0 & 7, j = t0 >> 3; t = (x * 4 + (j >> 3)) * ntn + (j & 7); }
                const int pm = t / ntn, pn = t % ntn;
                f32x4 v[2][16];
                {
                    f32x4 acc[2][2][4][2];
                    gemm_tile<false>(concat, pm * 256, nooff, Bt, pn * 256, D, lds_raw, acc, tid);
                    int et = tid; OPAQUE(et); const int wr = et >> 8, wc = (et >> 6) & 3, fr = et & 15, fq = (et >> 4) & 3;
#pragma unroll
                    for (int ai = 0; ai < 2; ++ai) {
#pragma unroll
                        for (int m = 0; m < 4; ++m)
#pragma unroll
                            for (int bj = 0; bj < 2; ++bj)
#pragma unroll
                                for (int n = 0; n < 2; ++n)
#pragma unroll
                                    for (int j = 0; j < 4; ++j)
                                        *(float*)(lds_raw + (wr * 64 + m * 16 + fq * 4 + j) * 1040 + (bj * 128 + wc * 32 + n * 16 + fr) * 4) = acc[ai][bj][m][n][j];
                        __syncthreads();
#pragma unroll
                        for (int i = 0; i < 16; ++i) {
                            const int lrow = i * 8 + (et >> 6), c4 = et & 63;
                            const size_t gi = (size_t)(pm * 256 + ai * 128 + lrow) * D + pn * 256 + c4 * 4;
                            v[ai][i] = *(const GAS f32x4*)(hin + gi);
                        }
#pragma unroll
                        for (int i = 0; i < 16; ++i) {
                            const int lrow = i * 8 + (et >> 6), c4 = et & 63;
                            v[ai][i] = ALPHA * v[ai][i] + *(const f32x4*)(lds_raw + lrow * 1040 + c4 * 16);
                        }
                        __syncthreads();
                    }
                }
                int et2 = tid; OPAQUE(et2); const int el = et2 & 63, ew = wave_s, er16 = et2 & 15, eq4 = (et2 >> 4) & 3;
#pragma unroll
                for (int q = 0; q < 6; ++q) {
                    const int seg = ew * 6 + q, n2 = seg * 2 + (el >> 5), p5 = el & 31;
                    GLDS16(Wb + (size_t)n2 * D + pn * 256 + ((p5 ^ (n2 & 15)) << 3), lds_raw + 65536 + seg * 1024 + el * 16);
                }
                float my_mt = 0.f, my_m2 = 0.f;
                for (int trep = 0; trep < REP_STATS; ++trep)
#pragma unroll
                for (int ai = 0; ai < 2; ++ai)
#pragma unroll
                    for (int i4 = 0; i4 < 16; i4 += 4) {
                        float mt4[4], m24[4];
#pragma unroll
                        for (int u = 0; u < 4; ++u) { const f32x4 x = v[ai][i4 + u]; mt4[u] = wave_sum((x[0] + x[1]) + (x[2] + x[3])) * (1.f / 256.f); }
#pragma unroll
                        for (int u = 0; u < 4; ++u) { const f32x4 d = v[ai][i4 + u] - mt4[u]; m24[u] = wave_sum((d[0] * d[0] + d[1] * d[1]) + (d[2] * d[2] + d[3] * d[3])); }
#pragma unroll
                        for (int u = 0; u < 4; ++u) if (el == ai * 16 + i4 + u) { my_mt = mt4[u]; my_m2 = m24[u]; }
                        COMPILER_FENCE();
                    }
                unsigned* bw = (unsigned*)wsl;
                if (el < 32) {
                    const int grow = (el >> 4) * 128 + (el & 15) * 8 + ew;
                    xst64(&xbuf[(size_t)(pm * 256 + grow) * 8 + pn], ((unsigned long long)__builtin_bit_cast(unsigned, my_m2) << 32) | __builtin_bit_cast(unsigned, my_mt));
                }
                WAIT_VM0();
                __syncthreads();
                if (et2 == 0) { (void)xb_add(&pcnt[pm * 16], 1u); XB_SPIN(xb_ld(&pcnt[pm * 16]) < 8u, bw); FENCE_ACQ_AGENT(); }
                __syncthreads();
                unsigned long long wk[4];
#pragma unroll
                for (int k = 0; k < 4; ++k) {
                    const int r = k * 8 + (el >> 3), grow = (r >> 4) * 128 + (r & 15) * 8 + ew;
                    wk[k] = xld64(&xbuf[(size_t)(pm * 256 + grow) * 8 + (el & 7)]);
                }
#pragma unroll
                for (int k = 0; k < 4; ++k) {
                    const int r = k * 8 + (el >> 3);
                    const unsigned long long w = wk[k];
                    const float mt = __builtin_bit_cast(float, (unsigned)w), m2 = __builtin_bit_cast(float, (unsigned)(w >> 32));
                    float ms = mt; ms += DPP_X1(ms); ms += DPP_X2(ms); ms += DPP_X7(ms);
                    const float mean = ms * 0.125f, dm = mt - mean;
                    float q = m2 + 256.f * dm * dm; q += DPP_X1(q); q += DPP_X2(q); q += DPP_X7(q);
                    const float rstd = 1.f / sqrtf(q * (1.f / D) + LN_EPS);
                    if ((el & 7) == 0) { Stab[(ew * 32 + r) * 2] = mean; Stab[(ew * 32 + r) * 2 + 1] = rstd; }
                }
                WAVE_SYNC();
                const f32x4 gv = *(const f32x4*)(g1 + pn * 256 + el * 4), bv = *(const f32x4*)(b1 + pn * 256 + el * 4);
                LAS unsigned char* wt = (LAS unsigned char*)lds_raw + ew * 8192;
                const LAS unsigned char* wbl = (const LAS unsigned char*)lds_raw + 65536;
                for (int rrep = 0; rrep < REP_ROUTER; ++rrep)
#pragma unroll
                for (int ai = 0; ai < 2; ++ai) {
                    u32x2 lokeep[16];
#pragma unroll
                    for (int i = 0; i < 16; ++i) {
                        const float mean = Stab[(ew * 32 + ai * 16 + i) * 2], rstd = Stab[(ew * 32 + ai * 16 + i) * 2 + 1];
                        const f32x4 hv = mul_s4(v[ai][i] - mean, rstd) * gv + bv;
                        u32x2 o; o.x = pack2(hv[0], hv[1]); o.y = pack2(hv[2], hv[3]);
                        lokeep[i].x = pack2(hv[0] - bf2f((bf16_t)(o.x & 0xffffu)), hv[1] - bf2f((bf16_t)(o.x >> 16)));
                        lokeep[i].y = pack2(hv[2] - bf2f((bf16_t)(o.y & 0xffffu)), hv[3] - bf2f((bf16_t)(o.y >> 16)));
                        *(LAS u32x2*)(wt + i * 512 + (((el >> 1) ^ i) << 4) + (el & 1) * 8) = o;
                        COMPILER_FENCE();
                    }
                    WAVE_SYNC();
                    f32x4 ac[3];
#pragma unroll
                    for (int nt = 0; nt < 3; ++nt) ac[nt] = (f32x4){0.f, 0.f, 0.f, 0.f};
#pragma unroll 2
                    for (int ks = 0; ks < 8; ++ks) {
                        const int co = ((ks * 4 + eq4) ^ er16) << 4;
                        const bf16x8 ah = *(const LAS bf16x8*)(wt + er16 * 512 + co);
#pragma unroll
                        for (int nt = 0; nt < 3; ++nt) {
                            const bf16x8 bh = *(const LAS bf16x8*)(wbl + (nt * 16 + er16) * 512 + co);
                            const bf16x8 bl = *(const LAS bf16x8*)(wbl + (48 + nt * 16 + er16) * 512 + co);
                            ac[nt] = MFMA16(ah, bh, ac[nt]); ac[nt] = MFMA16(ah, bl, ac[nt]);
                        }
                    }
                    WAVE_SYNC();
#pragma unroll
                    for (int i = 0; i < 16; ++i) *(LAS u32x2*)(wt + i * 512 + (((el >> 1) ^ i) << 4) + (el & 1) * 8) = lokeep[i];
                    WAVE_SYNC();
#pragma unroll 2
                    for (int ks = 0; ks < 8; ++ks) {
                        const int co = ((ks * 4 + eq4) ^ er16) << 4;
                        const bf16x8 al = *(const LAS bf16x8*)(wt + er16 * 512 + co);
#pragma unroll
                        for (int nt = 0; nt < 3; ++nt) {
                            const bf16x8 bh = *(const LAS bf16x8*)(wbl + (nt * 16 + er16) * 512 + co);
                            ac[nt] = MFMA16(al, bh, ac[nt]);
                        }
                    }
#pragma unroll
                    for (int nt = 0; nt < 3; ++nt)
#pragma unroll
                        for (int j = 0; j < 4; ++j) {
                            const float cv = ac[nt][j];
                            xst32(&part[((size_t)pn * S + pm * 256 + ai * 128 + (eq4 * 4 + j) * 8 + ew) * 48 + nt * 16 + er16], __builtin_bit_cast(unsigned, cv));
                        }
                    WAVE_SYNC();
                }
                WAIT_VM0();
                __syncthreads();
                if (et2 == 0) (void)xb_add(&pcnt[512 + pm * 16], 1u);
                for (int srep = 0; srep < REP_STORES; ++srep)
#pragma unroll
                for (int ai = 0; ai < 2; ++ai)
#pragma unroll
                    for (int i = 0; i < 16; ++i) {
                        const float mean = Stab[(ew * 32 + ai * 16 + i) * 2], rstd = Stab[(ew * 32 + ai * 16 + i) * 2 + 1];
                        const f32x4 hv = mul_s4(v[ai][i] - mean, rstd) * gv + bv;
                        const size_t gi = (size_t)(pm * 256 + ai * 128 + i * 8 + ew) * D + pn * 256 + el * 4;
                        u32x2 o; o.x = pack2(hv[0], hv[1]); o.y = pack2(hv[2], hv[3]);
                        *(u32x2*)(h1b + gi) = o;
                        COMPILER_FENCE();
                    }
                if (et2 == 0) { XB_SPIN(xb_ld(&pcnt[512 + pm * 16]) < 8u, bw); FENCE_ACQ_AGENT(); }
                __syncthreads();
                int rt = tid; OPAQUE(rt);
#pragma unroll
                for (int k = 0; k < 3; ++k) {
                    const int idx = rt + k * 512, tk = idx / 48, n = idx - tk * 48;
                    unsigned pq[8];
#pragma unroll
                    for (int q = 0; q < 8; ++q) pq[q] = xb_ld(&part[((size_t)q * S + pm * 256 + pn * 32 + tk) * 48 + n]);
                    float a = 0.f;
#pragma unroll
                    for (int q = 0; q < 8; ++q) a += __builtin_bit_cast(float, pq[q]);
                    lgt[idx] = a;
                }
                __syncthreads();
                if (rt < 32) {
                    const int t = pm * 256 + pn * 32 + rt; const float* L = lgt + rt * 48;
                    float gl[4];
#pragma unroll
                    for (int q = 0; q < 4; ++q) gl[q] = L[q] + bg[q];
                    int gi = 0; float gm = gl[0];
#pragma unroll
                    for (int q = 1; q < 4; ++q) if (gl[q] > gm) { gm = gl[q]; gi = q; }
                    float gs = 0.f;
#pragma unroll
                    for (int q = 0; q < 4; ++q) gs += fexp(gl[q] - gm);
                    const float gweight = 1.f / gs;
                    float E[8];
#pragma unroll
                    for (int e = 0; e < 8; ++e) E[e] = L[4 + gi * 8 + e] + br[gi * 8 + e];
                    int e1 = 0; float m1 = E[0];
#pragma unroll
                    for (int e = 1; e < 8; ++e) if (E[e] > m1) { m1 = E[e]; e1 = e; }
                    int e2 = -1; float m2 = -INFINITY;
#pragma unroll
                    for (int e = 0; e < 8; ++e) if (e != e1 && E[e] > m2) { m2 = E[e]; e2 = e; }
                    const float p2 = fexp(m2 - m1), w1 = 1.f / (1.f + p2), w2 = p2 / (1.f + p2);
                    const int ge1 = gi * 8 + e1, ge2 = gi * 8 + e2;
                    const int i1 = (ge1 * G + bid) * segcap + atomic_add_int(&lcnt[ge1], 1);
                    ltok[i1] = t; lw[i1] = gweight * w1; lslot[i1] = 0;
                    const int i2 = (ge2 * G + bid) * segcap + atomic_add_int(&lcnt[ge2], 1);
                    ltok[i2] = t; lw[i2] = gweight * w2; lslot[i2] = 1;
                }
                __syncthreads();
            }
            { int ft = tid; OPAQUE(ft); if (ft < 32) cntb[bid * 32 + ft] = lcnt[ft]; }
            PH_BAR(pb + 3);
        }

        if (PH_SEL(5) && PH_IN(pb + 5)) {
            PHASE_IDS();
            const unsigned nooff[2][2] = {{0u, 0u}, {0u, 0u}};
            const int segcap = ((S / 256 * (D / 256) + G - 1) / G) * 32;
            moe_prefix(cntb, G, lds_raw, tid);
            const int* ctot = (const int*)(lds_raw + LDS_MISC + M_CTOT); const int* coff = (const int*)(lds_raw + LDS_MISC + M_COFF);
            const int* rtok = (const int*)(lds_raw + LDS_MISC + M_RTOK); const float* rw = (const float*)(lds_raw + LDS_MISC + M_RW);
            const int* rslot = (const int*)(lds_raw + LDS_MISC + M_RSLOT);
            unsigned* done = (unsigned*)(wsl + CTL_DONE_OFF) + l * 1024;
            int nmt = 0;
            for (int e = 0; e < NEXP; ++e) nmt += (ctot[e] + 255) / 256;
            nmt = RFL(nmt);
            for (;;) {
                __syncthreads();
                if (tid == 0) *ubox = (unsigned)atomic_add_int(workctr + 8, 1);
                __syncthreads();
                int u = RFL((int)*ubox);
                if (u >= nmt * 12) break;
                const bool down = (u >= nmt * 4);
                const int per = down ? 8 : 4;
                if (down) u -= nmt * 4;
                int e = 0;
                for (;; ++e) { const int nt = ((RFL(ctot[e]) + 255) / 256) * per; if (u < nt) break; u -= nt; }
                const int c = RFL(ctot[e]), off = RFL(coff[e]);
                const int mt = u / per, pn = u % per, m0 = mt * 256;
                moe_rowtable(ltok, lw, lslot, e, m0, c, G, segcap, lds_raw, tid);
                f32x4 acc[2][2][4][2];
                if (!down) {
                    const bf16_t* Bt = WguT + ((size_t)l * NEXP + e) * 1024 * D;
                    unsigned aoff[2][2];
                    int st = tid; OPAQUE(st); int R[2], C[2]; stage_geom(st, R, C);
#pragma unroll
                    for (int h = 0; h < 2; ++h)
#pragma unroll
                        for (int i = 0; i < 2; ++i) aoff[h][i] = (unsigned)(rtok[h * 128 + R[i]] * D + C[i]);
                    gemm_tile<true>(h1b, 0, aoff, Bt, pn * 256, D, lds_raw, acc, tid);
                    int et = tid; OPAQUE(et); const int wr = et >> 8, wc = (et >> 6) & 3, fr = et & 15, fq = (et >> 4) & 3;
#pragma unroll
                    for (int ai = 0; ai < 2; ++ai)
#pragma unroll
                        for (int m = 0; m < 4; ++m)
#pragma unroll
                            for (int j = 0; j < 4; ++j) {
                                const int r = ai * 128 + wr * 64 + m * 16 + fq * 4 + j;
                                const float wgt = rw[r];
#pragma unroll
                                for (int bj = 0; bj < 2; ++bj)
                                    *(bf16_t*)(lds_raw + r * 272 + (bj * 64 + wc * 16 + fr) * 2) = f2bf(silu_f(acc[ai][bj][m][0][j]) * acc[ai][bj][m][1][j] * wgt);
                            }
                    __syncthreads();
#pragma unroll 4
                    for (int i = 0; i < 8; ++i) {
                        const int idx = et + i * 512, r = idx >> 4, ch = idx & 15;
                        if (m0 + r < c) *(u32x4*)(act + (size_t)(off + m0 + r) * DFF + pn * 128 + ch * 8) = *(const u32x4*)(lds_raw + r * 272 + ch * 16);
                    }
                    WAIT_VM0();
                    __syncthreads();
                    if (et == 0) { FENCE_REL_AGENT(); WAIT_VM0(); (void)xb_add(&done[e * 32 + mt], 1u); }
                } else {
                    const bf16_t* Bt = WdT + ((size_t)l * NEXP + e) * D * DFF;
                    if (tid == 0) {
                        unsigned* bw = (unsigned*)wsl;
                        XB_SPIN(xb_ld(&done[e * 32 + mt]) < 4u, bw);
                        FENCE_ACQ_AGENT();
                        WAIT_VM0();
                    }
                    __syncthreads();
                    gemm_tile<false>(act, off + m0, nooff, Bt, pn * 256, DFF, lds_raw, acc, tid);
                    int et = tid; OPAQUE(et); const int wr = et >> 8, wc = (et >> 6) & 3, fr = et & 15, fq = (et >> 4) & 3;
#pragma unroll
                    for (int ai = 0; ai < 2; ++ai)
#pragma unroll
                        for (int m = 0; m < 4; ++m)
#pragma unroll
                            for (int bj = 0; bj < 2; ++bj)
#pragma unroll
                                for (int n = 0; n < 2; ++n)
#pragma unroll
                                    for (int j = 0; j < 4; ++j)
                                        *(bf16_t*)(lds_raw + (ai * 128 + wr * 64 + m * 16 + fq * 4 + j) * 528 + (bj * 128 + wc * 32 + n * 16 + fr) * 2) = f2bf(acc[ai][bj][m][n][j]);
                    __syncthreads();
#pragma unroll 4
                    for (int i = 0; i < 16; ++i) {
                        const int idx = et + i * 512, r = idx >> 5, ch = idx & 31;
                        if (m0 + r < c) *(u32x4*)(contrib + ((size_t)rslot[r] * S + rtok[r]) * D + pn * 256 + ch * 8) = *(const u32x4*)(lds_raw + r * 528 + ch * 16);
                    }
                }
            }
            PH_BAR(pb + 5);
        }

        if (PH_SEL(7) && PH_IN(pb + 7)) for (int rep = 0; rep < PH_REPS(7); ++rep) {
            PHASE_IDS();
            const float* g2 = p.in[I_LN2G] + (size_t)l * D; const float* b2 = p.in[I_LN2B] + (size_t)l * D;
            const bool more = (l + 1 < DEPTH);
            f32x4 gq[8], bq[8];
#pragma unroll
            for (int j = 0; j < 8; ++j) { gq[j] = *(const f32x4*)(g2 + j * 256 + lane * 4); bq[j] = *(const f32x4*)(b2 + j * 256 + lane * 4); }
            if (more) {
                const float* wf = Wfa + (size_t)(l + 1) * 8 * D;
                __syncthreads();
                for (int i = tid; i < 6 * D / 4; i += NTHREADS) *(f32x4*)(ldsf + i * 4) = *(const f32x4*)(wf + i * 4);
                __syncthreads();
            }
            for (int t = gwave; t < S; t += gwaves) {
                f32x4 v[8]; float s = 0.f;
#pragma unroll
                for (int j = 0; j < 8; ++j) {
                    const size_t i = (size_t)t * D + j * 256 + lane * 4;
                    const u32x2 c0 = *(const u32x2*)(contrib + i), c1 = *(const u32x2*)(contrib + (size_t)S * D + i);
                    const f32x4 cs = (f32x4){bf2f((bf16_t)(c0.x & 0xffffu)) + bf2f((bf16_t)(c1.x & 0xffffu)), bf2f((bf16_t)(c0.x >> 16)) + bf2f((bf16_t)(c1.x >> 16)),
                                             bf2f((bf16_t)(c0.y & 0xffffu)) + bf2f((bf16_t)(c1.y & 0xffffu)), bf2f((bf16_t)(c0.y >> 16)) + bf2f((bf16_t)(c1.y >> 16))};
                    const u32x2 hq = *(const u32x2*)(h1b + i);
                    v[j] = ALPHA * (f32x4){bf2f((bf16_t)(hq.x & 0xffffu)), bf2f((bf16_t)(hq.x >> 16)), bf2f((bf16_t)(hq.y & 0xffffu)), bf2f((bf16_t)(hq.y >> 16))} + cs;
                    s += (v[j][0] + v[j][1]) + (v[j][2] + v[j][3]);
                }
                const float mean = wave_sum(s) * (1.f / D);
                float s2 = 0.f;
#pragma unroll
                for (int j = 0; j < 8; ++j) { v[j] -= mean; s2 += (v[j][0] * v[j][0] + v[j][1] * v[j][1]) + (v[j][2] * v[j][2] + v[j][3] * v[j][3]); }
                const float rstd = 1.f / sqrtf(wave_sum(s2) * (1.f / D) + LN_EPS);
                float fa[6] = {0.f, 0.f, 0.f, 0.f, 0.f, 0.f};
#pragma unroll
                for (int j = 0; j < 8; ++j) {
                    const int c = j * 256 + lane * 4;
                    v[j] = v[j] * rstd * gq[j] + bq[j];
                    *(f32x4*)(hout + (size_t)t * D + c) = v[j];
                    COMPILER_FENCE();
                    if (more) {
                        u32x2 o; o.x = pack2(v[j][0], v[j][1]); o.y = pack2(v[j][2], v[j][3]);
                        *(u32x2*)(xb + (size_t)t * D + c) = o;
#pragma unroll
                        for (int h = 0; h < 6; ++h) { const f32x4 w = *(const f32x4*)(ldsf + h * D + c); fa[h] += (v[j][0] * w[0] + v[j][1] * w[1]) + (v[j][2] * w[2] + v[j][3] * w[3]); }
                    }
                }
                if (more) {
#pragma unroll
                    for (int h = 0; h < 6; ++h) { const float sm = wave_sum(fa[h]); if (lane == 0) logf_[h * S + t] = log_sigmoid_f(sm + p.in[I_BF][(l + 1) * 6 + h]); }
                }
            }
            PH_BAR(pb + 7);
        }
    }
#undef PH_IN
#undef PH_BAR
}

constexpr int N_PHASES = 1 + DEPTH * 8;
#ifndef EMU
extern "C" void kernel_launch(void* const* d_in, const int* in_sizes, int n_in, void* d_out, int out_size, void* d_ws, size_t ws_size, hipStream_t stream) {
    static int grid = 0;
    if (grid == 0) {
        if (n_in != N_INPUTS || out_size != S * D || ws_size < WS_END) {
            fprintf(stderr, "kernel_launch: unexpected shapes: n_in %d out %d ws %zu (need %zu)\n", n_in, out_size, ws_size, (size_t)WS_END); grid = -1; return; }
        int dev = 0, cus = 0, per_cu = 0;
        if (hipGetDevice(&dev) != hipSuccess || hipDeviceGetAttribute(&cus, hipDeviceAttributeMultiprocessorCount, dev) != hipSuccess) { grid = -1; return; }
        if (hipFuncSetAttribute((const void*)fwd_kernel, hipFuncAttributeMaxDynamicSharedMemorySize, LDS_BYTES) != hipSuccess) { fprintf(stderr, "kernel_launch: hipFuncSetAttribute failed\n"); grid = -1; return; }
        if (hipOccupancyMaxActiveBlocksPerMultiprocessor(&per_cu, (const void*)fwd_kernel, NTHREADS, LDS_BYTES) != hipSuccess || per_cu < 1) {
            fprintf(stderr, "kernel_launch: occupancy query says %d blocks per CU\n", per_cu); (void)hipGetLastError(); grid = -1; return; }
        grid = cus;
    }
    if (grid < 0) return;
    (void)hipMemsetAsync(d_ws, 0, CTL_BYTES, stream);
    Params p{};
    for (int i = 0; i < N_INPUTS; ++i) p.in[i] = (const float*)d_in[i];
    p.out = (float*)d_out; p.ws = (unsigned char*)d_ws;
    for (int i = 0; i < 8; ++i) p.inv_freq[i] = (float)pow(500000.0, -(double)i * 2.0 / 16.0);
#if N_LAUNCH_SPLIT
    for (int k = 0; k < N_PHASES; ++k) { p.lo = k; p.hi = k + 1; hipLaunchKernelGGL(fwd_kernel, dim3(grid), dim3(NTHREADS), LDS_BYTES, stream, p); }
#else
    p.lo = 0; p.hi = N_PHASES;
    hipLaunchKernelGGL(fwd_kernel, dim3(grid), dim3(NTHREADS), LDS_BYTES, stream, p);
#endif
}
#endif
```

```cpp
#ifndef EMU
#include <hip/hip_runtime.h>
#include <cstdio>
#include <cstdint>
#include <cmath>
#endif

#ifndef SEQ
#define SEQ 8192
#endif
#ifndef N_LAUNCH_SPLIT
#define N_LAUNCH_SPLIT 0
#endif
#ifndef REP_PHASE
#define REP_PHASE -2
#endif
#define PH_REPS(c) ((c) == REP_PHASE ? 2 : 1)
#ifndef REP_SUB
#define REP_SUB 0
#endif

constexpr int S = SEQ, D = 2048, DEPTH = 2;
constexpr int FOX_H = 6, FOX_W = 768;
constexpr int LRU_W = 768;
constexpr int DIFF_H = 4, DIFF_W = 512;
constexpr int N_IN = 5382, N_INP = 5376;
constexpr int C_FA = 2304;
constexpr int NEXP = 32, DFF = 512;
constexpr int NKT = S / 64;
#ifndef DCH
#ifndef REP_ROUTER
#define REP_ROUTER 1
#endif
#ifndef REP_STORES
#define REP_STORES 1
#endif
#ifndef REP_STATS
#define REP_STATS 1
#endif
#define DCH 32
#endif
constexpr int NCH = (NKT + DCH - 1) / DCH;
constexpr size_t DPART_ROWS = (size_t)NCH * S - (size_t)(DCH * 64) * NCH * (NCH - 1) / 2;
constexpr float ALPHA = 1.41421356237309504880f;
constexpr float LN_EPS = 1e-5f;
constexpr float LOG2E = 1.4426950408889634f;
constexpr float QSCALE_A = 0.08838834764831845f * 1.4426950408889634f;
constexpr float QSCALE_C = 0.125f * 1.4426950408889634f;

enum { I_X = 0, I_POS, I_WIN, I_BF, I_CONVW, I_CONVB, I_WA, I_BA, I_WI, I_BI, I_LAM, I_LQ1, I_LK1, I_LQ2, I_LK2, I_SUBG, I_WO, I_LN1G, I_LN1B,
       I_WGRP, I_BGRP, I_WRT, I_BRT, I_WGATE, I_WUP, I_WDOWN, I_LN2G, I_LN2B, N_INPUTS };

typedef unsigned short bf16_t;
typedef short bf16x8 __attribute__((ext_vector_type(8)));
typedef float f32x4 __attribute__((ext_vector_type(4)));
typedef unsigned u32x4 __attribute__((ext_vector_type(4)));
typedef unsigned u32x2 __attribute__((ext_vector_type(2)));

constexpr size_t al256(size_t x) { return (x + 255) & ~(size_t)255; }
constexpr size_t CTL_BYTES = 65536;
constexpr size_t CTL_CNT_OFF = 32768;
constexpr size_t CTL_WORK_OFF = 36864;
constexpr size_t CTL_QK2_OFF = 57344;
constexpr size_t CTL_CLS_OFF = 49152;
constexpr size_t CTL_PAN_OFF = 16384;
constexpr size_t CTL_MQ_OFF = 24576;
constexpr size_t CTL_DONE_OFF = 40960;
constexpr size_t WB_WIN = CTL_BYTES;
constexpr size_t WB_WO = WB_WIN + al256((size_t)DEPTH * N_INP * D * 2);
constexpr size_t WB_WGU = WB_WO + al256((size_t)DEPTH * D * D * 2);
constexpr size_t WB_WD = WB_WGU + al256((size_t)DEPTH * NEXP * 1024 * D * 2);
constexpr size_t WB_WAI = WB_WD + al256((size_t)DEPTH * NEXP * D * DFF * 2);
constexpr size_t WF_FA = WB_WAI + al256((size_t)DEPTH * 6 * 256 * 128 * 2);
constexpr size_t WF_R36 = WF_FA + al256((size_t)DEPTH * 8 * D * 4);
constexpr size_t WF_ROPE = WF_R36 + al256((size_t)DEPTH * 2 * 48 * D * 2);
constexpr size_t A_XB = WF_ROPE + al256((size_t)S * 16 * 4);
constexpr size_t A_HB = A_XB + al256((size_t)S * D * 2);
constexpr size_t A_LOGF = A_HB + al256((size_t)S * D * 4);
constexpr size_t A_CUM = A_LOGF + al256((size_t)6 * S * 4);
constexpr size_t A_KMAX = A_CUM + al256((size_t)6 * S * 4);
constexpr size_t A_CNTB = A_KMAX + al256((size_t)6 * NKT * 4);
constexpr size_t A_QA = A_CNTB + al256((size_t)1024 * 32 * 4);
constexpr size_t A_KA = A_QA + al256((size_t)FOX_H * S * 128 * 2);
constexpr size_t A_VAT = A_KA + al256((size_t)FOX_H * S * 128 * 2);
constexpr size_t A_XR = A_VAT + al256((size_t)FOX_H * S * 128 * 2);
constexpr size_t A_GR = A_XR + al256((size_t)S * LRU_W * 2);
constexpr size_t A_QC = A_GR + al256((size_t)S * LRU_W * 2);
constexpr size_t A_KC = A_QC + al256((size_t)DIFF_H * S * 128 * 2);
constexpr size_t A_VCT = A_KC + al256((size_t)DIFF_H * S * 128 * 2);
constexpr size_t A_HLOC = A_VCT + al256((size_t)DIFF_H * S * 128 * 2);
constexpr size_t A_PLOC = A_HLOC + al256((size_t)S * LRU_W * 4);
constexpr size_t A_SUMA = A_PLOC + al256((size_t)S * LRU_W * 4);
constexpr size_t A_SUMH = A_SUMA + al256((size_t)NKT * LRU_W * 4);
constexpr size_t A_CONCAT = A_SUMH + al256((size_t)NKT * LRU_W * 4);
constexpr size_t A_Y1 = A_CONCAT + al256((size_t)S * D * 2);
constexpr size_t A_H1 = A_Y1 + al256((size_t)S * D * 4);
constexpr size_t A_H1B = A_H1 + al256((size_t)S * D * 4);
constexpr size_t A_LTOK = A_H1B + al256((size_t)S * D * 2);
constexpr size_t A_LW = A_LTOK + al256((size_t)NEXP * S * 4);
constexpr size_t A_LSLOT = A_LW + al256((size_t)NEXP * S * 4);
constexpr size_t A_ACT = A_LSLOT + al256((size_t)NEXP * S * 4);
constexpr size_t A_CONTRIB = A_ACT + al256((size_t)(2 * S + 256) * DFF * 2);
constexpr size_t WS_END = A_CONTRIB + al256((size_t)2 * S * D * 4);
constexpr size_t A_DPO = A_Y1;
constexpr size_t A_DPML = A_DPO + al256((size_t)8 * DPART_ROWS * 128 * 2);
static_assert(A_DPML + (size_t)8 * DPART_ROWS * 2 * 4 <= A_H1B, "differential partials must fit inside the y1 + h1 region");

constexpr size_t A_XBUF = A_H1 + al256((size_t)S * D * 2);
constexpr size_t A_PART = A_XBUF + al256((size_t)S * 8 * 8);
static_assert(A_PART + (size_t)8 * S * 48 * 4 <= A_H1B, "exchange buffers must fit inside the h1 region");
constexpr int NTHREADS = 512;
constexpr int LDS_MAIN = 131072 + 4096;
constexpr int LDS_MISC = LDS_MAIN;
constexpr int LDS_BYTES = LDS_MAIN + 8192 + 16640;
constexpr int M_PRE16 = 8192;
constexpr int M_LCNT = 64, M_CTOT = 256, M_COFF = 384, M_PRE = 512, M_RTOK = 2048, M_RW = 3072, M_RSLOT = 4096;

struct Params {
    const float* in[N_INPUTS];
    float* out;
    unsigned char* ws;
    float inv_freq[8];
    int lo, hi;
};

#ifndef EMU
#define LAS __attribute__((address_space(3)))
#define GAS __attribute__((address_space(1)))
#define DYN_LDS(name) extern __shared__ __attribute__((aligned(16))) unsigned char name[]
#define SLEEP1() __builtin_amdgcn_s_sleep(1)
#define WAVE_SYNC() __builtin_amdgcn_wave_barrier()
#define OPAQUE(x) asm volatile("" : "+v"(x))
#define COMPILER_FENCE() asm volatile("" ::: "memory")
#define RFL(x) __builtin_amdgcn_readfirstlane(x)
#define RFL_F(x) __builtin_bit_cast(float, __builtin_amdgcn_readfirstlane(__builtin_bit_cast(int, x)))
#define ANY_LANE(p) (__builtin_amdgcn_ballot_w64(p) != 0ull)
#define RDLANE(v, l) __builtin_bit_cast(float, __builtin_amdgcn_readlane(__builtin_bit_cast(int, v), l))
__device__ __forceinline__ int lane_id_volatile() { int l; asm volatile("v_mbcnt_lo_u32_b32 %0, -1, 0\n\tv_mbcnt_hi_u32_b32 %0, -1, %0" : "=v"(l)); return l; }
#define LANE_ID() lane_id_volatile()
#define OPAQUE_S(x) asm volatile("" : "+s"(x))
#define WAIT_VM0() asm volatile("s_waitcnt vmcnt(0)" ::: "memory")
#define WAIT_ALL0() __builtin_amdgcn_s_waitcnt(0)
#define FENCE_REL_AGENT() __builtin_amdgcn_fence(__ATOMIC_RELEASE, "agent")
#define FENCE_ACQ_AGENT() __builtin_amdgcn_fence(__ATOMIC_ACQUIRE, "agent")
#define MFMA16(a, b, c) __builtin_amdgcn_mfma_f32_16x16x32_bf16(a, b, c, 0, 0, 0)
#define GLDS16(g, l) __builtin_amdgcn_global_load_lds((const unsigned*)(g), (unsigned*)(l), 16, 0, 0)
#define WAIT_V(n) asm volatile("s_waitcnt vmcnt(" #n ")" ::: "memory")
#define WAIT_L(n) asm volatile("s_waitcnt lgkmcnt(" #n ")" ::: "memory")
#define BAR() __builtin_amdgcn_s_barrier()
#define SCHED() __builtin_amdgcn_sched_barrier(0)
#define SETPRIO(n) __builtin_amdgcn_s_setprio(n)
#define FAST_EXP2(x) __builtin_amdgcn_exp2f(x)
template <int M> __device__ __forceinline__ float shx_impl(float v, int lane) {
    if (M < 32) return __builtin_bit_cast(float, __builtin_amdgcn_ds_swizzle(__builtin_bit_cast(int, v), (M << 10) | 0x1f));
    return __builtin_bit_cast(float, __builtin_amdgcn_ds_bpermute((lane ^ 32) << 2, __builtin_bit_cast(int, v)));
}
#define SHX(v, M) shx_impl<M>(v, lane)
template <int CTRL> __device__ __forceinline__ float dppx(float x) { return __builtin_bit_cast(float, __builtin_amdgcn_mov_dpp(__builtin_bit_cast(int, x), CTRL, 0xf, 0xf, true)); }
#define DPP_X1(x) dppx<0xB1>(x)
#define DPP_X2(x) dppx<0x4E>(x)
#define DPP_X7(x) dppx<0x141>(x)
#define DPP_X8(x) dppx<0x128>(x)
#define xrow16_max(x) xrow16_max_l(x, lane)
#define xrow16_sum(x) xrow16_sum_l(x, lane)
__device__ __forceinline__ float xrow16_max_l(float x, int lane) { x = fmaxf(x, shx_impl<16>(x, lane)); return fmaxf(x, shx_impl<32>(x, lane)); }
__device__ __forceinline__ float xrow16_sum_l(float x, int lane) { x = x + shx_impl<16>(x, lane); return x + shx_impl<32>(x, lane); }
#define FAST_LOG2(x) __builtin_amdgcn_logf(x)
#define FAST_RCP(x) __builtin_amdgcn_rcpf(x)
__device__ __forceinline__ unsigned xb_ld(unsigned* p)              { return __hip_atomic_load(p, __ATOMIC_RELAXED, __HIP_MEMORY_SCOPE_AGENT); }
__device__ __forceinline__ unsigned xb_add(unsigned* p, unsigned v) { return __hip_atomic_fetch_add(p, v, __ATOMIC_RELAXED, __HIP_MEMORY_SCOPE_AGENT); }
__device__ __forceinline__ void xst64(unsigned long long* p, unsigned long long v) { __hip_atomic_store(p, v, __ATOMIC_RELAXED, __HIP_MEMORY_SCOPE_AGENT); }
__device__ __forceinline__ unsigned long long xld64(unsigned long long* p) { return __hip_atomic_load(p, __ATOMIC_RELAXED, __HIP_MEMORY_SCOPE_AGENT); }
__device__ __forceinline__ void xst32(unsigned* p, unsigned v) { __hip_atomic_store(p, v, __ATOMIC_RELAXED, __HIP_MEMORY_SCOPE_AGENT); }
__device__ __forceinline__ unsigned xb_xcc_id() { return (unsigned)__builtin_amdgcn_s_getreg((3 << 11) | 20) & 0xFu; }
__device__ __forceinline__ int atomic_add_int(int* p, int v) { return atomicAdd(p, v); }
__device__ __forceinline__ void atomic_min_int(int* p, int v) { atomicMin(p, v); }
__device__ __forceinline__ void atomic_max_u32(unsigned* p, unsigned v) { atomicMax(p, v); }
__device__ __forceinline__ unsigned pack2(float lo, float hi) { unsigned r; asm volatile("v_cvt_pk_bf16_f32 %0, %1, %2" : "=v"(r) : "v"(lo), "v"(hi)); return r; }
#else
#define MFMA16(a, b, c) emu_mfma_16x16x32_bf16(a, b, c)
#define GLDS16(g, l) emu_glds16((const void*)(g), (void*)(l))
#define WAIT_V(n) ((void)0)
#define WAIT_L(n) ((void)0)
#define BAR() __syncthreads()
#define SCHED() ((void)0)
#define SETPRIO(n) ((void)0)
#define FAST_EXP2(x) exp2f(x)
#define SHX(v, M) __shfl_xor(v, M)
#define DPP_X1(x) __shfl_xor(x, 1)
#define DPP_X2(x) __shfl_xor(x, 2)
#define DPP_X7(x) __shfl_xor(x, 7)
#define DPP_X8(x) __shfl_xor(x, 8)
static inline float xrow16_max(float x) { x = fmaxf(x, __shfl_xor(x, 16)); return fmaxf(x, __shfl_xor(x, 32)); }
static inline float xrow16_sum(float x) { x = x + __shfl_xor(x, 16); return x + __shfl_xor(x, 32); }
#define FAST_LOG2(x) log2f(x)
#define FAST_RCP(x) (1.f / (x))
static inline unsigned pack2(float lo, float hi) {
    unsigned a = __builtin_bit_cast(unsigned, lo), b = __builtin_bit_cast(unsigned, hi);
    a += 0x7fffu + ((a >> 16) & 1u); b += 0x7fffu + ((b >> 16) & 1u);
    return (a >> 16) | (b & 0xffff0000u);
}
#endif
__device__ __forceinline__ bf16_t f2bf(float f) { return (bf16_t)(pack2(f, 0.f) & 0xffffu); }
__device__ __forceinline__ float bf2f(bf16_t h) { return __builtin_bit_cast(float, (unsigned)h << 16); }

#define XB_TMO      128
#define XB_XCNT(j)  (256  + 64 * (j))
#define XB_XSUB(j)  (1280 + 64 * (j))
#define XB_XGEN(j)  (2304 + 64 * (j))
#define XB_TOP      3328
#define XB_TOPGEN   3392
#define XCD_BAR_WORDS 3456
#define XB_SPIN_CAP (1u << 22)
#define XB_SPIN(cond, bar) do { unsigned _sp = 0; while (cond) { SLEEP1(); \
    if ((++_sp & 255u) == 0u) { if (xb_ld(&(bar)[XB_TMO])) break; if (_sp > XB_SPIN_CAP) { xb_add(&(bar)[XB_TMO], 1u); break; } } } } while (0)

struct XcdBarrier { unsigned* bar; unsigned x; volatile LAS unsigned* st; };

__device__ __forceinline__ XcdBarrier xcd_barrier_post(unsigned* bar, volatile LAS unsigned* st) {
    XcdBarrier b; b.bar = bar; b.x = xb_xcc_id(); b.st = st;
    if (threadIdx.x == 0) (void)xb_add(&bar[XB_XCNT(b.x)], 1u);
    return b;
}
__device__ __forceinline__ void xcd_barrier_complete(unsigned* bar, unsigned x, unsigned& nloc, unsigned& nx) {
    const unsigned G = gridDim.x;
    unsigned sum, cnt, mine, sp = 0u;
    for (;;) {
        sum = 0u; cnt = 0u; mine = 0u;
#pragma unroll
        for (unsigned j = 0; j < 16; ++j) { const unsigned c = xb_ld(&bar[XB_XCNT(j)]); sum += c; cnt += (c > 0u) ? 1u : 0u; mine = (j == x) ? c : mine; }
        if (sum == G) break;
        SLEEP1();
        if ((++sp & 255u) == 0u) { if (xb_ld(&bar[XB_TMO])) break; if (sp > XB_SPIN_CAP) { xb_add(&bar[XB_TMO], 1u); break; } }
    }
    nloc = mine > 0u ? mine : 1u; nx = cnt > 0u ? cnt : 1u;
}
__device__ __forceinline__ void xcd_barrier(const XcdBarrier& b, bool leader) {
    WAIT_VM0();
    __syncthreads();
    if (leader) {
        unsigned* bar = b.bar;
        WAIT_ALL0();
        unsigned nloc = b.st[0], nx = b.st[1];
        if (nloc == 0u) { xcd_barrier_complete(bar, b.x, nloc, nx); b.st[0] = nloc; b.st[1] = nx; }
        const unsigned old = xb_add(&bar[XB_XSUB(b.x)], 1u);
        const unsigned gen = old / nloc;
        if (old + 1u == (gen + 1u) * nloc) {
            FENCE_REL_AGENT();
            WAIT_VM0();
            const unsigned og = xb_add(&bar[XB_TOP], 1u);
            const unsigned tg = og / nx;
            if (og + 1u == (tg + 1u) * nx) xb_add(&bar[XB_TOPGEN], 1u);
            else XB_SPIN(xb_ld(&bar[XB_TOPGEN]) == tg, bar);
            FENCE_ACQ_AGENT();
            xb_add(&bar[XB_XGEN(b.x)], 1u);
            WAIT_VM0();
        } else {
            XB_SPIN(xb_ld(&bar[XB_XGEN(b.x)]) == gen, bar);
            FENCE_ACQ_AGENT();
            WAIT_VM0();
        }
    }
    __syncthreads();
}

__device__ __forceinline__ f32x4 mul_s4(f32x4 a, float s) {
#ifdef EMU
    return a * s;
#else
    f32x4 o;
#pragma unroll
    for (int c = 0; c < 4; ++c) { float r, x = a[c]; asm volatile("v_mul_f32_e32 %0, %1, %2" : "=v"(r) : "v"(x), "v"(s)); o[c] = r; }
    return o;
#endif
}
__device__ __forceinline__ float wave_sum_l(float v, int lane) {
    (void)lane;
    v += DPP_X1(v); v += DPP_X2(v); v += DPP_X7(v); v += DPP_X8(v);
    return xrow16_sum(v);
}
#define wave_sum(v) wave_sum_l(v, lane)
__device__ __forceinline__ float fexp(float x) { return FAST_EXP2(x * LOG2E); }
__device__ __forceinline__ float sigmoid_f(float x) { return FAST_RCP(1.f + fexp(-x)); }
__device__ __forceinline__ float log_sigmoid_f(float x) { return fminf(x, 0.f) - 0.6931471805599453f * FAST_LOG2(1.f + fexp(-fabsf(x))); }
__device__ __forceinline__ float gelu_tanh_f(float x) { const float u = 0.7978845608028654f * (x + 0.044715f * x * x * x); return x * FAST_RCP(1.f + fexp(-2.f * u)); }
__device__ __forceinline__ float silu_f(float x) { return x * FAST_RCP(1.f + fexp(-x)); }
__device__ __forceinline__ float neg_expm1_f(float x) {
    const float ser = -x * (1.f + x * (0.5f + x * (0.16666667f + x * (0.041666668f + x * (0.008333334f + x * 0.0013888889f)))));
    return (x > -0.35f) ? ser : (1.f - fexp(x));
}

struct RmIdent { __device__ __forceinline__ int operator()(int n) const { return n; } };
struct RmWin { __device__ __forceinline__ int operator()(int n) const { return n < C_FA ? n : (n < C_FA + 6 ? -1 : n - 6); } };
struct RmGu { int kind; __device__ __forceinline__ int operator()(int f) const { return (f >> 7) * 256 + ((f >> 6) & 1) * 128 + ((f >> 4) & 3) * 32 + kind * 16 + (f & 15); } };
struct RmOff { int off; __device__ __forceinline__ int operator()(int n) const { return n + off; } };

template <class RM>
__device__ __forceinline__ void convert_tile(const float* src, int ld, int K, int Nsrc, int k0, int n0, bf16_t* dst, const RM& rm, float* T, int tid) {
    {
        const int nn = tid & 255, kh = (tid >> 8) * 32, n = n0 + nn;
        const float* sp = src + (size_t)(k0 + kh) * ld + n;
        float v[32];
#pragma unroll
        for (int i = 0; i < 32; ++i) v[i] = (n < Nsrc) ? sp[(size_t)i * ld] : 0.f;
#pragma unroll
        for (int i = 0; i < 32; ++i) T[(kh + i) * 257 + nn] = v[i];
    }
    __syncthreads();
#pragma unroll
    for (int q = 0; q < 4; ++q) {
        const int nn = q * 64 + (tid >> 3), kc = (tid & 7) * 8, n = n0 + nn;
        const int row = (n < Nsrc) ? rm(n) : -1;
        if (row >= 0) {
            u32x4 o;
            o.x = pack2(T[(kc + 0) * 257 + nn], T[(kc + 1) * 257 + nn]); o.y = pack2(T[(kc + 2) * 257 + nn], T[(kc + 3) * 257 + nn]);
            o.z = pack2(T[(kc + 4) * 257 + nn], T[(kc + 5) * 257 + nn]); o.w = pack2(T[(kc + 6) * 257 + nn], T[(kc + 7) * 257 + nn]);
            *(u32x4*)(dst + (size_t)row * K + k0 + kc) = o;
        }
    }
    __syncthreads();
}
template <class RM>
__device__ __forceinline__ void convert_tile_v4(const float* src, int ld, int K, int k0, int n0, bf16_t* dst, const RM& rm, float* T, int tid_in) {
    int tid = tid_in; OPAQUE(tid);
    {
        const int w = tid >> 6, l4 = (tid & 63) * 4;
        const float* sp = src + (size_t)(k0 + w * 8) * ld + n0 + l4;
        f32x4 v[8];
#pragma unroll
        for (int i = 0; i < 8; ++i) v[i] = *(const f32x4*)(sp + (size_t)i * ld);
#pragma unroll
        for (int i = 0; i < 8; ++i) { float* tp = T + (w * 8 + i) * 257 + l4; tp[0] = v[i][0]; tp[1] = v[i][1]; tp[2] = v[i][2]; tp[3] = v[i][3]; }
    }
    __syncthreads();
#pragma unroll
    for (int q = 0; q < 4; ++q) {
        const int nn = q * 64 + (tid >> 3), kc = (tid & 7) * 8, n = n0 + nn;
        const int row = rm(n);
        u32x4 o;
        o.x = pack2(T[(kc + 0) * 257 + nn], T[(kc + 1) * 257 + nn]); o.y = pack2(T[(kc + 2) * 257 + nn], T[(kc + 3) * 257 + nn]);
        o.z = pack2(T[(kc + 4) * 257 + nn], T[(kc + 5) * 257 + nn]); o.w = pack2(T[(kc + 6) * 257 + nn], T[(kc + 7) * 257 + nn]);
        *(u32x4*)(dst + (size_t)row * K + k0 + kc) = o;
    }
    __syncthreads();
}
template <class RM>
__device__ __forceinline__ void convert_mats(const float* src, size_t sstride, int nmat, int ld, int K, int Nsrc, bf16_t* dst, size_t dstride, const RM& rm,
                                             float* T, int tid, int bid, int G) {
    const int tk = K / 64, tn = (Nsrc + 255) / 256, per = tk * tn, total = nmat * per;
    for (int t = bid; t < total; t += G) {
        const int mi = t / per, r = t % per;
        convert_tile(src + (size_t)mi * sstride, ld, K, Nsrc, (r / tn) * 64, (r % tn) * 256, dst + (size_t)mi * dstride, rm, T, tid);
    }
}

constexpr int NCONV = DEPTH * 768;
__device__ __forceinline__ void moe_conv_chunk(const Params& p, int cid, bf16_t* WguT_, bf16_t* WdT_, float* T, int tid) {
    const int l = cid / 768, r = cid % 768, kind = r >> 8, t0 = (r & 255) * 8;
    for (int t = t0; t < t0 + 8; ++t) {
        const int mi = t >> 6, rr = t & 63;
        if (kind < 2) {
            const float* src = p.in[kind == 0 ? I_WGATE : I_WUP] + ((size_t)l * NEXP + mi) * D * DFF;
            convert_tile_v4(src, DFF, D, (rr >> 1) * 64, (rr & 1) * 256, WguT_ + ((size_t)l * NEXP + mi) * 1024 * D, RmGu{kind}, T, tid);
        } else {
            const float* src = p.in[I_WDOWN] + ((size_t)l * NEXP + mi) * DFF * D;
            convert_tile_v4(src, D, DFF, (rr >> 3) * 64, (rr & 7) * 256, WdT_ + ((size_t)l * NEXP + mi) * D * DFF, RmIdent{}, T, tid);
        }
    }
}

constexpr int BK = 64, HTB = 128 * 64 * 2;
__device__ __forceinline__ int lds_byte(int r, int c) {
    const int st = (r >> 4) * 2 + (c >> 5), rr = r & 15, cc = c & 31, ob = rr * 64 + cc * 2;
    return st * 1024 + (ob ^ (((ob >> 9) & 1) << 5));
}
__device__ __forceinline__ void stage_rc(int b, int& R, int& C) {
    const int st = b / 1024, sb = b % 1024, swz = sb ^ (((sb >> 9) & 1) << 5);
    R = (st >> 1) * 16 + swz / 64; C = (st & 1) * 32 + (swz % 64) / 2;
}
template <bool GATHER>
__device__ __forceinline__ void gemm_tile(const bf16_t* A, int arow0, const unsigned (&aoff)[2][2], const bf16_t* Bt, int brow0, int K,
                                          unsigned char* shm, f32x4 (&acc)[2][2][4][2], int tid_in) {
    int tid = tid_in; OPAQUE(tid);
    unsigned toff; { int R0, C0; stage_rc(tid * 16, R0, C0); toff = (unsigned)(R0 * K + C0); }
#define SA(b, h) (shm + ((b) * 2 + (h)) * HTB)
#define SB(b, h) (shm + (4 + (b) * 2 + (h)) * HTB)
#define STAGE_B(P, h, kt) do { _Pragma("unroll") for (int _i = 0; _i < 2; ++_i) GLDS16(Bt + ((size_t)(brow0 + (h) * 128 + _i * 64) * K + (size_t)(kt) * BK) + toff, (P) + tid * 16 + _i * 8192); } while (0)
#define STAGE_A(P, h, kt) do { _Pragma("unroll") for (int _i = 0; _i < 2; ++_i) { \
    if (GATHER) GLDS16(A + (size_t)(kt) * BK + aoff[h][_i], (P) + tid * 16 + _i * 8192); \
    else GLDS16(A + ((size_t)(arow0 + (h) * 128 + _i * 64) * K + (size_t)(kt) * BK) + toff, (P) + tid * 16 + _i * 8192); } } while (0)
#define LDA(dst, b, h) _Pragma("unroll") for (int m = 0; m < 4; ++m) _Pragma("unroll") for (int k = 0; k < 2; ++k) \
    dst[m][k] = *reinterpret_cast<const bf16x8*>(SA(b, h) + lds_byte(wr * 64 + m * 16 + fr, k * 32 + fq * 8))
#define LDB(dst, b, h) _Pragma("unroll") for (int n = 0; n < 2; ++n) _Pragma("unroll") for (int k = 0; k < 2; ++k) \
    dst[n][k] = *reinterpret_cast<const bf16x8*>(SB(b, h) + lds_byte(wc * 32 + n * 16 + fr, k * 32 + fq * 8))
#define MMA(ai, bj, At, Bx) do { SETPRIO(1); \
    _Pragma("unroll") for (int m = 0; m < 4; ++m) _Pragma("unroll") for (int n = 0; n < 2; ++n) _Pragma("unroll") for (int k = 0; k < 2; ++k) \
      acc[ai][bj][m][n] = MFMA16(At[m][k], Bx[n][k], acc[ai][bj][m][n]); \
    SETPRIO(0); } while (0)
    int wid = tid >> 6, lane = tid & 63, wr = wid >> 2, wc = wid & 3, fr = lane & 15, fq = lane >> 4;
#pragma unroll
    for (int a = 0; a < 2; ++a)
#pragma unroll
        for (int b = 0; b < 2; ++b)
#pragma unroll
            for (int m = 0; m < 4; ++m)
#pragma unroll
                for (int n = 0; n < 2; ++n) acc[a][b][m][n] = (f32x4){0.f, 0.f, 0.f, 0.f};
    bf16x8 At[4][2], B0[2][2], B1[2][2];
    const int nt = K / BK;
    STAGE_B(SB(0, 0), 0, 0); STAGE_A(SA(0, 0), 0, 0);
    STAGE_B(SB(0, 1), 1, 0); STAGE_A(SA(0, 1), 1, 0);
    if (wr == 1) BAR();
    WAIT_V(4); BAR();
    STAGE_B(SB(1, 0), 0, 1); STAGE_A(SA(1, 0), 0, 1); STAGE_B(SB(1, 1), 1, 1);
    WAIT_V(6); BAR();
    for (int t = 0; t < nt - 2; t += 2) {
        LDB(B0, 0, 0); SCHED(); LDA(At, 0, 0); STAGE_A(SA(1, 1), 1, t + 1);
        WAIT_L(8); BAR(); WAIT_L(0); MMA(0, 0, At, B0); BAR(); SCHED();
        LDB(B1, 0, 1); STAGE_B(SB(0, 0), 0, t + 2);
        BAR(); WAIT_L(0); MMA(0, 1, At, B1); BAR();
        LDA(At, 0, 1); STAGE_A(SA(0, 0), 0, t + 2);
        BAR(); WAIT_L(0); MMA(1, 0, At, B0); BAR(); SCHED();
        STAGE_B(SB(0, 1), 1, t + 2);
        WAIT_V(6); BAR(); MMA(1, 1, At, B1); BAR();
        LDB(B0, 1, 0); SCHED(); LDA(At, 1, 0); STAGE_A(SA(0, 1), 1, t + 2);
        WAIT_L(8); BAR(); WAIT_L(0); MMA(0, 0, At, B0); BAR(); SCHED();
        LDB(B1, 1, 1); STAGE_B(SB(1, 0), 0, t + 3);
        BAR(); WAIT_L(0); MMA(0, 1, At, B1); BAR();
        LDA(At, 1, 1); STAGE_A(SA(1, 0), 0, t + 3);
        BAR(); WAIT_L(0); MMA(1, 0, At, B0); BAR(); SCHED();
        STAGE_B(SB(1, 1), 1, t + 3);
        WAIT_V(6); BAR(); MMA(1, 1, At, B1); BAR();
    }
    OPAQUE(tid); wid = tid >> 6; lane = tid & 63; wr = wid >> 2; wc = wid & 3; fr = lane & 15; fq = lane >> 4;
    { LDB(B0, 0, 0); WAIT_V(0); LDA(At, 0, 0); STAGE_A(SA(1, 1), 1, nt - 1);
      BAR(); WAIT_L(0); MMA(0, 0, At, B0); BAR();
      LDB(B1, 0, 1); BAR(); WAIT_L(0); MMA(0, 1, At, B1); BAR();
      LDA(At, 0, 1); WAIT_V(4); BAR(); WAIT_L(0); MMA(1, 0, At, B0); MMA(1, 1, At, B1); BAR(); }
    { LDB(B0, 1, 0); LDA(At, 1, 0); WAIT_V(2); BAR(); WAIT_L(0); MMA(0, 0, At, B0); BAR();
      LDB(B1, 1, 1); WAIT_V(0); BAR(); WAIT_L(0); MMA(0, 1, At, B1); BAR();
      LDA(At, 1, 1); BAR(); WAIT_L(0); MMA(1, 0, At, B0); MMA(1, 1, At, B1); BAR(); }
    if (wr == 0) BAR();
#undef SA
#undef SB
#undef STAGE_A
#undef STAGE_B
#undef LDA
#undef LDB
#undef MMA
}
__device__ __forceinline__ void stage_geom(int tid, int (&R)[2], int (&C)[2]) {
#pragma unroll
    for (int i = 0; i < 2; ++i) stage_rc(tid * 16 + i * 8192, R[i], C[i]);
}

constexpr int ATT_KBUF = 0, ATT_VBUF = 32768, ATT_CBUF = 65536;
template <int KIND>
__device__ __forceinline__ void attn_unit(const bf16_t* Q, const bf16_t* Kg, const bf16_t* VT, const float* cum2, const float* kmx, int qb, bf16_t* concat, int ccol0,
                                          float lam, float osc, const float* subg, unsigned char* lds, int tid) {
    const int lane = tid & 63, wave = tid >> 6, r16 = lane & 15, q4 = lane >> 4;
    const int q0w = qb * 128 + wave * 16, myq = q0w + r16;
    const int ntiles = 2 * qb + 2;
    const int wlimit = (KIND == 0) ? ((q0w + 15) >> 6) : (q0w >> 6);
    constexpr int NMAP = (KIND == 0) ? 1 : 2, NKS = (KIND == 0) ? 4 : 2;
    bf16x8 qf[NMAP][NKS];
#pragma unroll
    for (int mp = 0; mp < NMAP; ++mp)
#pragma unroll
        for (int ks = 0; ks < NKS; ++ks) qf[mp][ks] = *(const bf16x8*)(Q + (size_t)myq * 128 + mp * 64 + ks * 32 + q4 * 8);
    const float cq = (KIND == 0) ? cum2[myq] : 0.f;
    int kt0 = 0;
    if (KIND == 0) {
        float* wmax = (float*)(lds + ATT_CBUF + 512); int* kst = (int*)(lds + ATT_CBUF + 576);
        float qs = 0.f;
#pragma unroll
        for (int ks = 0; ks < NKS; ++ks)
#pragma unroll
            for (int j = 0; j < 8; ++j) { const float v = bf2f((bf16_t)qf[0][ks][j]); qs += v * v; }
        qs = xrow16_sum(qs);
        qs = fmaxf(qs, SHX(qs, 1)); qs = fmaxf(qs, SHX(qs, 2)); qs = fmaxf(qs, SHX(qs, 4)); qs = fmaxf(qs, SHX(qs, 8));
        if (lane == 0) wmax[wave] = qs;
        if (tid == 0) *kst = 2 * qb;
        __syncthreads();
        float qm = wmax[0];
#pragma unroll
        for (int w = 1; w < 8; ++w) qm = fmaxf(qm, wmax[w]);
        qm = sqrtf(qm) * 1.01f;
        const float kd = sqrtf(fmaxf(kmx[2 * qb], kmx[2 * qb + 1])) * 1.01f;
        if (tid < 2 * qb) {
            const float bias = cum2[qb * 128] - cum2[tid * 64 + 63];
            const bool skip = bias + qm * (sqrtf(kmx[tid]) * 1.01f + kd) < -40.f;
            if (!skip) atomic_min_int(kst, tid);
        }
        __syncthreads();
        kt0 = RFL(*kst);
    }
    f32x4 ot[NMAP][8];
    float mrun[NMAP], lsum[NMAP];
#pragma unroll
    for (int mp = 0; mp < NMAP; ++mp) { mrun[mp] = -INFINITY; lsum[mp] = 0.f;
#pragma unroll
        for (int mo = 0; mo < 8; ++mo) ot[mp][mo] = (f32x4){0.f, 0.f, 0.f, 0.f}; }
    u32x4 sk[2], sv[2]; float sc = 0.f;
    const u32x4* kg = (const u32x4*)Kg; const u32x4* vg = (const u32x4*)VT;
#pragma unroll
    for (int i = 0; i < 2; ++i) { sk[i] = kg[(size_t)kt0 * 1024 + tid + i * 512]; sv[i] = vg[(size_t)kt0 * 1024 + tid + i * 512]; }
    if (KIND == 0 && tid < 64) sc = cum2[kt0 * 64 + tid];
    for (int kt = kt0; kt < ntiles; ++kt) {
        unsigned char* kb = lds + ATT_KBUF + (kt & 1) * 16384;
        unsigned char* vb = lds + ATT_VBUF + (kt & 1) * 16384;
        float* cb = (float*)(lds + ATT_CBUF + (kt & 1) * 256);
#pragma unroll
        for (int i = 0; i < 2; ++i) {
            const int g = tid + i * 512;
            { const int row = g >> 4, c = g & 15; *(u32x4*)(kb + row * 256 + ((c ^ (row & 15)) << 4)) = sk[i]; }
            { const int d = g >> 3, c = g & 7; *(u32x4*)(vb + d * 128 + ((c ^ ((d >> 1) & 7)) << 4)) = sv[i]; }
        }
        if (KIND == 0 && tid < 64) cb[tid] = sc;
        __syncthreads();
        if (kt + 1 < ntiles) {
#pragma unroll
            for (int i = 0; i < 2; ++i) { sk[i] = kg[(size_t)(kt + 1) * 1024 + tid + i * 512]; sv[i] = vg[(size_t)(kt + 1) * 1024 + tid + i * 512]; }
            if (KIND == 0 && tid < 64) sc = cum2[(kt + 1) * 64 + tid];
        }
        if (kt <= wlimit) {
#pragma unroll
            for (int mp = 0; mp < NMAP; ++mp) {
                bf16x8 kf[4][NKS], vfa[8];
#pragma unroll
                for (int m = 0; m < 4; ++m)
#pragma unroll
                    for (int ks = 0; ks < NKS; ++ks) { const int c = (KIND == 0 ? 0 : mp * 8) + ks * 4 + q4; kf[m][ks] = *(const bf16x8*)(kb + (m * 16 + r16) * 256 + ((c ^ r16) << 4)); }
#pragma unroll
                for (int mo = 0; mo < 8; ++mo) { const int d = mo * 16 + r16; vfa[mo] = *(const bf16x8*)(vb + d * 128 + (((0 * 4 + q4) ^ ((d >> 1) & 7)) << 4)); }
                SCHED();
                f32x4 st[4];
#pragma unroll
                for (int m = 0; m < 4; ++m) st[m] = (f32x4){0.f, 0.f, 0.f, 0.f};
#pragma unroll
                for (int ks = 0; ks < NKS; ++ks)
#pragma unroll
                    for (int m = 0; m < 4; ++m) st[m] = MFMA16(kf[m][ks], qf[mp][ks], st[m]);
                SCHED();
                float mx = -INFINITY;
#pragma unroll
                for (int m = 0; m < 4; ++m) {
                    if (KIND == 0) {
                        const f32x4 ck = *(const f32x4*)(cb + m * 16 + 4 * q4);
#pragma unroll
                        for (int j = 0; j < 4; ++j) {
                            float y = st[m][j] + (cq - ck[j]);
                            if (kt * 64 + m * 16 + 4 * q4 + j > myq) y = -INFINITY;
                            st[m][j] = y;
                        }
                    }
#pragma unroll
                    for (int j = 0; j < 4; ++j) mx = fmaxf(mx, st[m][j]);
                }
                mx = xrow16_max(mx);
                const float mnew = fmaxf(mrun[mp], mx);
                const float alpha = FAST_EXP2(mrun[mp] - mnew);
                mrun[mp] = mnew;
                float ps = 0.f;
#pragma unroll
                for (int m = 0; m < 4; ++m)
#pragma unroll
                    for (int j = 0; j < 4; ++j) { const float pv = FAST_EXP2(st[m][j] - mnew); st[m][j] = pv; ps += pv; }
                lsum[mp] = lsum[mp] * alpha + ps;
#pragma unroll
                for (int mo = 0; mo < 8; ++mo) ot[mp][mo] *= alpha;
                bf16x8 pf[2];
#pragma unroll
                for (int kk = 0; kk < 2; ++kk) {
                    u32x4 pw;
                    pw.x = pack2(st[2 * kk][0], st[2 * kk][1]); pw.y = pack2(st[2 * kk][2], st[2 * kk][3]);
                    pw.z = pack2(st[2 * kk + 1][0], st[2 * kk + 1][1]); pw.w = pack2(st[2 * kk + 1][2], st[2 * kk + 1][3]);
                    pf[kk] = __builtin_bit_cast(bf16x8, pw);
                }
                bf16x8 vfb[8];
#pragma unroll
                for (int mo = 0; mo < 8; ++mo) { const int d = mo * 16 + r16; vfb[mo] = *(const bf16x8*)(vb + d * 128 + (((1 * 4 + q4) ^ ((d >> 1) & 7)) << 4)); }
                SCHED();
#pragma unroll
                for (int mo = 0; mo < 8; ++mo) ot[mp][mo] = MFMA16(vfa[mo], pf[0], ot[mp][mo]);
                SCHED();
#pragma unroll
                for (int mo = 0; mo < 8; ++mo) ot[mp][mo] = MFMA16(vfb[mo], pf[1], ot[mp][mo]);
            }
        }
    }
    float inv[NMAP];
#pragma unroll
    for (int mp = 0; mp < NMAP; ++mp) { float l = lsum[mp]; l = xrow16_sum(l); inv[mp] = 1.f / l; }
    if (KIND == 0) {
#pragma unroll
        for (int mo = 0; mo < 8; ++mo) {
            u32x2 o; o.x = pack2(ot[0][mo][0] * inv[0], ot[0][mo][1] * inv[0]); o.y = pack2(ot[0][mo][2] * inv[0], ot[0][mo][3] * inv[0]);
            *(u32x2*)(concat + (size_t)myq * D + ccol0 + mo * 16 + 4 * q4) = o;
        }
    } else {
        float ss = 0.f;
#pragma unroll
        for (int mo = 0; mo < 8; ++mo)
#pragma unroll
            for (int j = 0; j < 4; ++j) { const float v = ot[0][mo][j] * inv[0] - lam * (ot[NMAP - 1][mo][j] * inv[NMAP - 1]); ot[0][mo][j] = v; ss += v * v; }
        ss = xrow16_sum(ss);
        const float rs = osc / sqrtf(ss * (1.f / 128.f) + LN_EPS);
#pragma unroll
        for (int mo = 0; mo < 8; ++mo) {
            const f32x4 g = *(const f32x4*)(subg + mo * 16 + 4 * q4);
            u32x2 o; o.x = pack2(ot[0][mo][0] * rs * g[0], ot[0][mo][1] * rs * g[1]); o.y = pack2(ot[0][mo][2] * rs * g[2], ot[0][mo][3] * rs * g[3]);
            *(u32x2*)(concat + (size_t)myq * D + ccol0 + mo * 16 + 4 * q4) = o;
        }
    }
    __syncthreads();
}

__device__ __forceinline__ int dpart_row(int c, int q) { return c * (S - DCH * 64) - (DCH * 32) * c * (c - 1) + q; }
__device__ __forceinline__ void attn_dmap_unit(const bf16_t* Qh, const bf16_t* Kh, const bf16_t* VTh, int mp, int qb, int t0, int t1,
                                               bf16_t* Op, float* ML, int c, float bnd, unsigned char* lds, int tid) {
    const bool fixedref = (bnd <= 60.f);
    const int lane = tid & 63, wave = tid >> 6, r16 = lane & 15, q4 = lane >> 4;
    const int q0w = qb * 256 + wave * 32;
    const int wlimit = q0w >> 6;
    bf16x8 qf[2][2];
#pragma unroll
    for (int n = 0; n < 2; ++n)
#pragma unroll
        for (int ks = 0; ks < 2; ++ks) qf[n][ks] = *(const bf16x8*)(Qh + (size_t)(q0w + n * 16 + r16) * 128 + mp * 64 + ks * 32 + q4 * 8);
    f32x4 ot[8][2];
    float mrun[2] = {-INFINITY, -INFINITY}, lsum[2] = {0.f, 0.f};
    if (fixedref) { mrun[0] = bnd; mrun[1] = bnd; }
    const float stinit = fixedref ? -bnd : 0.f;
#pragma unroll
    for (int mo = 0; mo < 8; ++mo) { ot[mo][0] = (f32x4){0.f, 0.f, 0.f, 0.f}; ot[mo][1] = (f32x4){0.f, 0.f, 0.f, 0.f}; }
    u32x4 sk, sv[2];
    const u32x4* kg = (const u32x4*)Kh; const u32x4* vg = (const u32x4*)VTh;
    const int krow = tid >> 3, kc8 = tid & 7;
    sk = kg[(size_t)t0 * 1024 + krow * 16 + mp * 8 + kc8];
#pragma unroll
    for (int i = 0; i < 2; ++i) sv[i] = vg[(size_t)t0 * 1024 + tid + i * 512];
    for (int kt = t0; kt < t1; ++kt) {
        unsigned char* kb = lds + (kt & 1) * 8192;
        unsigned char* vb = lds + 16384 + (kt & 1) * 16384;
        *(u32x4*)(kb + krow * 128 + ((kc8 ^ ((krow >> 1) & 7)) << 4)) = sk;
#pragma unroll
        for (int i = 0; i < 2; ++i) { const int g = tid + i * 512, d = g >> 3, cc = g & 7; *(u32x4*)(vb + d * 128 + ((cc ^ ((d >> 1) & 7)) << 4)) = sv[i]; }
        __syncthreads();
        if (kt + 1 < t1) {
            sk = kg[(size_t)(kt + 1) * 1024 + krow * 16 + mp * 8 + kc8];
#pragma unroll
            for (int i = 0; i < 2; ++i) sv[i] = vg[(size_t)(kt + 1) * 1024 + tid + i * 512];
        }
        if (kt <= wlimit) {
            bf16x8 kf[4][2], vfa[8];
#pragma unroll
            for (int m = 0; m < 4; ++m)
#pragma unroll
                for (int ks = 0; ks < 2; ++ks) kf[m][ks] = *(const bf16x8*)(kb + (m * 16 + r16) * 128 + (((ks * 4 + q4) ^ ((r16 >> 1) & 7)) << 4));
#pragma unroll
            for (int mo = 0; mo < 8; ++mo) { const int d = mo * 16 + r16; vfa[mo] = *(const bf16x8*)(vb + d * 128 + (((0 * 4 + q4) ^ ((d >> 1) & 7)) << 4)); }
            SCHED();
            f32x4 st[4][2];
#pragma unroll
            for (int m = 0; m < 4; ++m) { st[m][0] = (f32x4){stinit, stinit, stinit, stinit}; st[m][1] = (f32x4){stinit, stinit, stinit, stinit}; }
            SETPRIO(1);
#pragma unroll
            for (int ks = 0; ks < 2; ++ks)
#pragma unroll
                for (int m = 0; m < 4; ++m) { st[m][0] = MFMA16(kf[m][ks], qf[0][ks], st[m][0]); st[m][1] = MFMA16(kf[m][ks], qf[1][ks], st[m][1]); }
            SETPRIO(0);
            SCHED();
            float alpha[2] = {1.f, 1.f};
            if (fixedref) {
#pragma unroll
                for (int n = 0; n < 2; ++n) {
                    float ps = 0.f;
#pragma unroll
                    for (int m = 0; m < 4; ++m)
#pragma unroll
                        for (int j = 0; j < 4; ++j) { const float pv = FAST_EXP2(st[m][n][j]); st[m][n][j] = pv; ps += pv; }
                    lsum[n] += ps;
                }
            } else
#pragma unroll
            for (int n = 0; n < 2; ++n) {
                float mx = -INFINITY;
#pragma unroll
                for (int m = 0; m < 4; ++m)
#pragma unroll
                    for (int j = 0; j < 4; ++j) mx = fmaxf(mx, st[m][n][j]);
                mx = xrow16_max(mx);
                const float mnew = fmaxf(mrun[n], mx);
                alpha[n] = FAST_EXP2(mrun[n] - mnew);
                mrun[n] = mnew;
                float ps = 0.f;
#pragma unroll
                for (int m = 0; m < 4; ++m)
#pragma unroll
                    for (int j = 0; j < 4; ++j) { const float pv = FAST_EXP2(st[m][n][j] - mnew); st[m][n][j] = pv; ps += pv; }
                lsum[n] = lsum[n] * alpha[n] + ps;
            }
            if (ANY_LANE(alpha[0] != 1.f)) {
#pragma unroll
                for (int mo = 0; mo < 8; ++mo) ot[mo][0] *= alpha[0];
            }
            if (ANY_LANE(alpha[1] != 1.f)) {
#pragma unroll
                for (int mo = 0; mo < 8; ++mo) ot[mo][1] *= alpha[1];
            }
            bf16x8 pf[2][2];
#pragma unroll
            for (int kk = 0; kk < 2; ++kk)
#pragma unroll
                for (int n = 0; n < 2; ++n) {
                    u32x4 pw;
                    pw.x = pack2(st[2 * kk][n][0], st[2 * kk][n][1]); pw.y = pack2(st[2 * kk][n][2], st[2 * kk][n][3]);
                    pw.z = pack2(st[2 * kk + 1][n][0], st[2 * kk + 1][n][1]); pw.w = pack2(st[2 * kk + 1][n][2], st[2 * kk + 1][n][3]);
                    pf[kk][n] = __builtin_bit_cast(bf16x8, pw);
                }
            bf16x8 vfb[8];
#pragma unroll
            for (int mo = 0; mo < 8; ++mo) { const int d = mo * 16 + r16; vfb[mo] = *(const bf16x8*)(vb + d * 128 + (((1 * 4 + q4) ^ ((d >> 1) & 7)) << 4)); }
            SCHED();
            SETPRIO(1);
#pragma unroll
            for (int mo = 0; mo < 8; ++mo) { ot[mo][0] = MFMA16(vfa[mo], pf[0][0], ot[mo][0]); ot[mo][1] = MFMA16(vfa[mo], pf[0][1], ot[mo][1]); }
            SCHED();
#pragma unroll
            for (int mo = 0; mo < 8; ++mo) { ot[mo][0] = MFMA16(vfb[mo], pf[1][0], ot[mo][0]); ot[mo][1] = MFMA16(vfb[mo], pf[1][1], ot[mo][1]); }
            SETPRIO(0);
        }
    }
    if (q0w >= DCH * 64 * c)
#pragma unroll
    for (int n = 0; n < 2; ++n) {
        float l = lsum[n]; l = xrow16_sum(l);
        const int row = dpart_row(c, q0w + n * 16 + r16);
#pragma unroll
        for (int mo = 0; mo < 8; ++mo) {
            u32x2 o; o.x = pack2(ot[mo][n][0], ot[mo][n][1]); o.y = pack2(ot[mo][n][2], ot[mo][n][3]);
            *(u32x2*)(Op + (size_t)(row * 128 + mo * 16 + 4 * q4)) = o;
        }
        if (q4 == 0) { ML[row * 2] = mrun[n]; ML[row * 2 + 1] = l; }
    }
    __syncthreads();
}

__device__ __forceinline__ void lru_unit_a(int chunk, int grp, int l, const Params& p, const bf16_t* Xr, const bf16_t* WaiT, float* hloc, float* ploc, float* sumA, float* sumH,
                                           unsigned char* lds, int tid) {
    const int lane = tid & 63, wave = tid >> 6, r16 = lane & 15, q4 = lane >> 4;
    unsigned char* XCB = lds; float* XU = (float*)(lds + 16384); float* LA = (float*)(lds + 49152); float* ENDS = (float*)(lds + 81920);
    const int t0 = chunk * 64, ch0 = grp * 128;
    bf16x8 bfr[2][4];
#pragma unroll
    for (int g = 0; g < 2; ++g)
#pragma unroll
        for (int ks = 0; ks < 4; ++ks) bfr[g][ks] = *(const bf16x8*)(WaiT + ((size_t)grp * 256 + g * 128 + wave * 16 + r16) * 128 + ks * 32 + q4 * 8);
    const int chg = ch0 + wave * 16 + r16;
    const float ba = p.in[I_BA][(size_t)l * LRU_W + chg], bi = p.in[I_BI][(size_t)l * LRU_W + chg];
    const float lam_raw = p.in[I_LAM][(size_t)l * LRU_W + chg];
    {
        const int c = tid & 127, tq = tid >> 7, ch = ch0 + c;
        const float* cw = p.in[I_CONVW] + (size_t)l * 4 * LRU_W + ch; const float cb = p.in[I_CONVB][(size_t)l * LRU_W + ch];
        const float w0 = cw[0], w1 = cw[LRU_W], w2 = cw[2 * LRU_W], w3 = cw[3 * LRU_W];
        const int ts = t0 + tq * 16;
        float x0 = (ts - 3 >= 0) ? bf2f(Xr[(size_t)(ts - 3) * LRU_W + ch]) : 0.f;
        float x1 = (ts - 2 >= 0) ? bf2f(Xr[(size_t)(ts - 2) * LRU_W + ch]) : 0.f;
        float x2 = (ts - 1 >= 0) ? bf2f(Xr[(size_t)(ts - 1) * LRU_W + ch]) : 0.f;
#pragma unroll
        for (int i = 0; i < 16; ++i) {
            const float x3 = bf2f(Xr[(size_t)(ts + i) * LRU_W + ch]);
            const float v = cb + w0 * x0 + w1 * x1 + w2 * x2 + w3 * x3;
            const int row = tq * 16 + i;
            XU[row * 128 + c] = v;
            *(bf16_t*)(XCB + row * 256 + (((c >> 3) ^ (row & 15)) << 4) + (c & 7) * 2) = f2bf(v);
            x0 = x1; x1 = x2; x2 = x3;
        }
    }
    __syncthreads();
    {
        const float lsl = 8.0f * log_sigmoid_f(lam_raw);
#pragma unroll
        for (int mt = 0; mt < 4; ++mt) {
            f32x4 ga = (f32x4){0.f, 0.f, 0.f, 0.f}, gi = (f32x4){0.f, 0.f, 0.f, 0.f};
#pragma unroll
            for (int ks = 0; ks < 4; ++ks) {
                const bf16x8 af = *(const bf16x8*)(XCB + (mt * 16 + r16) * 256 + (((ks * 4 + q4) ^ r16) << 4));
                ga = MFMA16(af, bfr[0][ks], ga); gi = MFMA16(af, bfr[1][ks], gi);
            }
#pragma unroll
            for (int j = 0; j < 4; ++j) {
                const int row = mt * 16 + 4 * q4 + j, idx = row * 128 + wave * 16 + r16;
                const float r = sigmoid_f(ga[j] + ba), ig = sigmoid_f(gi[j] + bi);
                const float log_a = lsl * r;
                LA[idx] = fexp(log_a);
                XU[idx] = sqrtf(neg_expm1_f(2.f * log_a)) * (ig * XU[idx]);
            }
        }
    }
    __syncthreads();
    {
        const int c = tid & 127, tq = tid >> 7, ch = ch0 + c;
        float h = 0.f, P = 1.f;
#pragma unroll
        for (int i = 0; i < 16; ++i) { const int idx = (tq * 16 + i) * 128 + c; const float a = LA[idx]; h = a * h + XU[idx]; P *= a; XU[idx] = h; LA[idx] = P; }
        ENDS[tq * 128 + c] = P; ENDS[512 + tq * 128 + c] = h;
        __syncthreads();
        float cin = 0.f, pin = 1.f;
        for (int s = 0; s < tq; ++s) { const float Ps = ENDS[s * 128 + c], hs = ENDS[512 + s * 128 + c]; cin = Ps * cin + hs; pin *= Ps; }
#pragma unroll
        for (int i = 0; i < 16; ++i) {
            const int idx = (tq * 16 + i) * 128 + c; const size_t gi = (size_t)(t0 + tq * 16 + i) * LRU_W + ch;
            const float Pl = LA[idx], hl = XU[idx];
            ((unsigned*)hloc)[gi] = pack2(hl + Pl * cin, Pl * pin);
        }
        if (tq == 3) { const float Pl = LA[63 * 128 + c], hl = XU[63 * 128 + c]; sumA[(size_t)chunk * LRU_W + ch] = Pl * pin; sumH[(size_t)chunk * LRU_W + ch] = hl + Pl * cin; }
    }
    __syncthreads();
}

__device__ __forceinline__ void moe_prefix(const int* cntb_, int G, unsigned char* lds, int tid) {
    int* tmp = (int*)lds; int* ctot = (int*)(lds + LDS_MISC + M_CTOT); int* coff = (int*)(lds + LDS_MISC + M_COFF);
    unsigned short* pre16 = (unsigned short*)(lds + LDS_MISC + M_PRE16);
    const int e = tid & 31, part = tid >> 5, PB = (G + 15) / 16;
    int sm = 0;
    for (int i = 0; i < PB; ++i) { const int b = part * PB + i; if (b < G) sm += cntb_[b * 32 + e]; }
    tmp[part * 32 + e] = sm;
    __syncthreads();
    int run = 0;
    for (int q = 0; q < part; ++q) run += tmp[q * 32 + e];
    for (int i = 0; i < PB; ++i) { const int b = part * PB + i; if (b < G) { pre16[e * 257 + b] = (unsigned short)run; run += cntb_[b * 32 + e]; } }
    if (part == 15) { ctot[e] = run; pre16[e * 257 + G] = (unsigned short)run; }
    __syncthreads();
    if (tid == 0) { int o = 0; for (int q = 0; q < 32; ++q) { coff[q] = o; o += ctot[q]; } coff[32] = o; }
    __syncthreads();
}
__device__ __forceinline__ void moe_rowtable(const int* ltok_, const float* lw_, const int* lslot_, int e, int m0, int c_e, int G, int segcap, unsigned char* lds, int tid_in) {
    int tid = tid_in; OPAQUE(tid);
    const unsigned short* pre = (const unsigned short*)(lds + LDS_MISC + M_PRE16) + e * 257;
    int* rtok = (int*)(lds + LDS_MISC + M_RTOK); float* rw = (float*)(lds + LDS_MISC + M_RW); int* rslot = (int*)(lds + LDS_MISC + M_RSLOT);
    if (tid < 256) {
        const int g = m0 + tid;
        int tk = 0, sl = 0; float w = 0.f;
        if (g < c_e) {
            int lo = 0, hi = G;
            while (hi - lo > 1) { const int mid = (lo + hi) >> 1; if ((int)pre[mid] <= g) lo = mid; else hi = mid; }
            const int idx = (e * G + lo) * segcap + (g - (int)pre[lo]);
            tk = ltok_[idx]; w = lw_[idx]; sl = lslot_[idx];
        }
        rtok[tid] = tk; rw[tid] = w; rslot[tid] = sl;
    }
    __syncthreads();
}
#define kmax2 ((float*)(wsl + A_KMAX))
#define dpo ((bf16_t*)(wsl + A_DPO))
#define dpml ((float*)(wsl + A_DPML))
#define cntb ((int*)(wsl + A_CNTB))
#define WinT ((bf16_t*)(wsl + WB_WIN))
#define WoT ((bf16_t*)(wsl + WB_WO))
#define WguT ((bf16_t*)(wsl + WB_WGU))
#define WdT ((bf16_t*)(wsl + WB_WD))
#define WaiT ((bf16_t*)(wsl + WB_WAI))
#define Wfa ((float*)(wsl + WF_FA))
#define W36b ((bf16_t*)(wsl + WF_R36))
#define ropecs ((float*)(wsl + WF_ROPE))
#define xb ((bf16_t*)(wsl + A_XB))
#define hb ((float*)(wsl + A_HB))
#define logf_ ((float*)(wsl + A_LOGF))
#define cum2 ((float*)(wsl + A_CUM))
#define Qa ((bf16_t*)(wsl + A_QA))
#define Ka ((bf16_t*)(wsl + A_KA))
#define VaT ((bf16_t*)(wsl + A_VAT))
#define Xr ((bf16_t*)(wsl + A_XR))
#define Gr ((bf16_t*)(wsl + A_GR))
#define Qc ((bf16_t*)(wsl + A_QC))
#define Kc ((bf16_t*)(wsl + A_KC))
#define VcT ((bf16_t*)(wsl + A_VCT))
#define hloc ((float*)(wsl + A_HLOC))
#define ploc ((float*)(wsl + A_PLOC))
#define sumA ((float*)(wsl + A_SUMA))
#define sumH ((float*)(wsl + A_SUMH))
#define concat ((bf16_t*)(wsl + A_CONCAT))
#define y1 ((float*)(wsl + A_Y1))
#define h1 ((float*)(wsl + A_H1))
#define h1b ((bf16_t*)(wsl + A_H1B))
#define ltok ((int*)(wsl + A_LTOK))
#define lw ((float*)(wsl + A_LW))
#define lslot ((int*)(wsl + A_LSLOT))
#define act ((bf16_t*)(wsl + A_ACT))
#define contrib ((bf16_t*)(wsl + A_CONTRIB))
#ifndef EMU
__global__ void __launch_bounds__(NTHREADS, 2)
#else
void
#endif
fwd_kernel(Params p) {
    DYN_LDS(lds_raw);
    float* ldsf = (float*)lds_raw;
    const int bid = blockIdx.x, G = gridDim.x;
    const int gthreads = G * NTHREADS, gwaves = G * (NTHREADS / 64);
    const int wave_s = RFL((int)threadIdx.x >> 6);
#define PHASE_IDS() unsigned char* wsl = ws; OPAQUE_S(wsl); int tid = wave_s * 64 + LANE_ID(); OPAQUE(tid); const int lane = tid & 63, wave = tid >> 6, gtid = bid * NTHREADS + tid, gwave = bid * (NTHREADS / 64) + wave; (void)lane; (void)wave; (void)gtid; (void)gwave

    unsigned char* ws = p.ws;
    volatile LAS unsigned* bst = (volatile LAS unsigned*)(lds_raw + LDS_MISC);
    unsigned* ubox = (unsigned*)(lds_raw + LDS_MISC + 16);
    if (threadIdx.x == 0) { bst[0] = 0u; bst[1] = 0u; bst[2] = 0u; bst[3] = 0u; }
    __syncthreads();
    XcdBarrier bar = xcd_barrier_post((unsigned*)ws, bst);

    const int* positions = (const int*)p.in[I_POS];

    constexpr int NPH = 8;
    const int lo = p.lo, hi = p.hi;
#ifdef ONLY_PHASE
#define PH_SEL(c) ((c) == ONLY_PHASE)
#else
#define PH_SEL(c) 1
#endif
#define PH_IN(k) (lo <= (k) && (k) < hi)
#define PH_BAR(k) do { if ((k) + 1 < hi) xcd_barrier(bar, wave_s == 0 && LANE_ID() == 0); } while (0)

    if (PH_SEL(-1) && PH_IN(0)) for (int rep = 0; rep < PH_REPS(-1); ++rep) {
        PHASE_IDS();
        for (int l = 0; l < DEPTH; ++l) {
            convert_mats(p.in[I_WIN] + (size_t)l * D * N_IN, 0, 1, N_IN, D, N_IN, WinT + (size_t)l * N_INP * D, 0, RmWin{}, ldsf, tid, bid, G);
            for (int t = bid; t < (D / 64) * (D / 256); t += G)
                convert_tile_v4(p.in[I_WO] + (size_t)l * D * D, D, D, (t / (D / 256)) * 64, (t % (D / 256)) * 256, WoT + (size_t)l * D * D, RmIdent{}, ldsf, tid);
            convert_mats(p.in[I_WA] + (size_t)l * 6 * 128 * 128, (size_t)128 * 128, 6, 128, 128, 128, WaiT + (size_t)l * 6 * 256 * 128, (size_t)256 * 128, RmIdent{}, ldsf, tid, bid, G);
            convert_mats(p.in[I_WI] + (size_t)l * 6 * 128 * 128, (size_t)128 * 128, 6, 128, 128, 128, WaiT + (size_t)l * 6 * 256 * 128, (size_t)256 * 128, RmOff{128}, ldsf, tid, bid, G);
        }
        for (int i = gtid; i < DEPTH * 8 * D; i += gthreads) { const int k = i % D, h = (i / D) % 8, l = i / (8 * D);
            Wfa[i] = (h < 6) ? p.in[I_WIN][(size_t)l * D * N_IN + (size_t)k * N_IN + C_FA + h] : 0.f; }
        for (int i = gtid; i < DEPTH * 48 * D; i += gthreads) { const int k = i % D, o = (i / D) % 48, l = i / (48 * D);
            const float w = (o < 4) ? p.in[I_WGRP][((size_t)l * D + k) * 4 + o] : (o < 36 ? p.in[I_WRT][((size_t)l * D + k) * 32 + (o - 4)] : 0.f);
            const bf16_t hi = f2bf(w);
            W36b[((size_t)l * 2 + 0) * 48 * D + (size_t)o * D + k] = hi; W36b[((size_t)l * 2 + 1) * 48 * D + (size_t)o * D + k] = f2bf(w - bf2f(hi)); }
        for (int i = gtid; i < S * 8; i += gthreads) { const int d = i & 7, t = i >> 3; const float ang = (float)positions[t] * p.inv_freq[d];
            ropecs[t * 16 + d] = cosf(ang); ropecs[t * 16 + 8 + d] = sinf(ang); }
        __syncthreads();
        for (int i = tid; i < 6 * D; i += NTHREADS) { const int k = i % D, h = i / D; ldsf[i] = p.in[I_WIN][(size_t)k * N_IN + C_FA + h]; }
        __syncthreads();
        for (int t0 = gwave * 2; t0 < S; t0 += gwaves * 2) {
            f32x4 v[2][8];
#pragma unroll
            for (int tk = 0; tk < 2; ++tk)
#pragma unroll
                for (int j = 0; j < 8; ++j) v[tk][j] = *(const f32x4*)(p.in[I_X] + (size_t)(t0 + tk) * D + j * 256 + lane * 4);
#pragma unroll
            for (int tk = 0; tk < 2; ++tk) {
                const int t = t0 + tk;
                float fa[6] = {0.f, 0.f, 0.f, 0.f, 0.f, 0.f};
#pragma unroll
                for (int j = 0; j < 8; ++j) {
                    const int c = j * 256 + lane * 4;
                    u32x2 o; o.x = pack2(v[tk][j][0], v[tk][j][1]); o.y = pack2(v[tk][j][2], v[tk][j][3]);
                    *(u32x2*)(xb + (size_t)t * D + c) = o;
#pragma unroll
                    for (int h = 0; h < 6; ++h) { const f32x4 w = *(const f32x4*)(ldsf + h * D + c); fa[h] += v[tk][j][0] * w[0] + v[tk][j][1] * w[1] + v[tk][j][2] * w[2] + v[tk][j][3] * w[3]; }
                    COMPILER_FENCE();
                }
#pragma unroll
                for (int h = 0; h < 6; ++h) { const float sm = wave_sum(fa[h]); if (lane == 0) logf_[h * S + t] = log_sigmoid_f(sm + p.in[I_BF][h]); }
            }
        }
        PH_BAR(0);
    }

    for (int l = 0; l < DEPTH; ++l) {
        const int pb = 1 + l * NPH;
#define hin ((l == 0) ? p.in[I_X] : (const float*)hb)
#define hout ((l == DEPTH - 1) ? p.out : hb)
#define workctr ((int*)(wsl + CTL_WORK_OFF) + l * 64)

        if (PH_SEL(0) && PH_IN(pb + 0)) {
            PHASE_IDS();
            int bz = RFL(bid); OPAQUE_S(bz);
            if (bz == 0) {
                double* part = (double*)lds_raw;
                const int per = S / 64;
                double s = 0.0;
                if (wave < 6) { for (int i = 0; i < per; ++i) s += (double)logf_[wave * S + lane * per + i]; part[wave * 64 + lane] = s; }
                __syncthreads();
                if (wave < 6) {
                    double run = 0.0;
                    for (int j = 0; j < lane; ++j) run += part[wave * 64 + j];
                    for (int i = 0; i < per; ++i) { run += (double)logf_[wave * S + lane * per + i]; cum2[wave * S + lane * per + i] = (float)(run * (double)LOG2E); }
                }
                __syncthreads();
            }
            bool conv_more = (l == 0);
#define CONV_ONE() do { if (conv_more) { __syncthreads(); if (tid == 0) *ubox = (unsigned)atomic_add_int((int*)(wsl + CTL_WORK_OFF) + 62, 1); __syncthreads(); \
                const int cid_ = RFL((int)*ubox); if (cid_ < NCONV) moe_conv_chunk(p, cid_, WguT, WdT, ldsf, tid); else conv_more = false; } } while (0)
            unsigned* cls = (unsigned*)(wsl + CTL_CLS_OFF) + l * 256;
            if (bz == 0) { WAIT_VM0(); __syncthreads(); if (tid == 0) { FENCE_REL_AGENT(); WAIT_VM0(); (void)xb_add(&cls[192], 1u); } }
            const bf16_t* Bt = WinT + (size_t)l * N_INP * D;
            constexpr int ntm = S / 256;
            const unsigned nooff[2][2] = {{0u, 0u}, {0u, 0u}};
            for (int i = 0; i < (bid & 3); ++i) CONV_ONE();
            for (;;) {
                __syncthreads();
                if (tid == 0) *ubox = (unsigned)atomic_add_int(workctr + 9, 1);
                __syncthreads();
                int t = RFL((int)*ubox);
                if (t >= ntm * 21) break;
                int pm, pn, kcls;
                if (t < ntm * 6) { pm = t / 6; pn = 15 + t % 6; kcls = 0; }
                else if (t < ntm * 12) { t -= ntm * 6; pm = t / 6; pn = 9 + t % 6; kcls = 1; }
                else { t -= ntm * 12; pm = t / 9; pn = t % 9; kcls = 2; }
                f32x4 acc[2][2][4][2];
                gemm_tile<false>(xb, pm * 256, nooff, Bt, pn * 256, D, lds_raw, acc, tid);
                int et = tid; OPAQUE(et); const int wr = et >> 8, wc = (et >> 6) & 3, fr = et & 15, fq = (et >> 4) & 3;
                if (pn < 6 || (pn >= 9 && pn < 19)) {
                    bf16_t* dst; float scale = 1.f; bool rope = false;
                    if (pn < 3) { dst = Qa; scale = QSCALE_A; } else if (pn < 6) { dst = Ka; } else if (pn < 12) { dst = Xr; } else if (pn < 15) { dst = Gr; }
                    else if (pn < 17) { dst = Qc; scale = QSCALE_C; rope = true; } else { dst = Kc; rope = true; }
                    const bool headmajor = (pn < 6) || (pn >= 15);
                    const int segpn = (pn < 3) ? pn : (pn < 6) ? pn - 3 : (pn < 12) ? pn - 9 : (pn < 15) ? pn - 12 : (pn < 17) ? pn - 15 : pn - 17;
#pragma unroll
                    for (int ai = 0; ai < 2; ++ai)
#pragma unroll
                        for (int m = 0; m < 4; ++m)
#pragma unroll
                            for (int bj = 0; bj < 2; ++bj)
#pragma unroll
                                for (int n = 0; n < 2; ++n) {
                                    const int dd = wc * 32 + n * 16 + fr;
#pragma unroll
                                    for (int j = 0; j < 4; ++j) {
                                        const int row = pm * 256 + ai * 128 + wr * 64 + m * 16 + fq * 4 + j;
                                        float v = acc[ai][bj][m][n][j];
                                        if (rope && n == 0 && (wc & 1) == 0) {
                                            const float pv = SHX(v, 8);
                                            const float cs = ropecs[row * 16 + (fr & 7)], sn = ropecs[row * 16 + 8 + (fr & 7)];
                                            v = (fr < 8) ? (v * cs - pv * sn) : (v * cs + pv * sn);
                                        }
                                        v *= scale;
                                        *(bf16_t*)(lds_raw + (ai * 128 + wr * 64 + m * 16 + fq * 4 + j) * 528 + (bj * 128 + dd) * 2) = f2bf(v);
                                    }
                                }
                    __syncthreads();
#pragma unroll 4
                    for (int i = 0; i < 16; ++i) {
                        const int idx = et + i * 512, lrow = idx >> 5, ch = idx & 31, row = pm * 256 + lrow;
                        const u32x4 val = *(const u32x4*)(lds_raw + lrow * 528 + ch * 16);
                        size_t gi;
                        if (headmajor) gi = ((size_t)(segpn * 2 + (ch >> 4)) * S + row) * 128 + (ch & 15) * 8;
                        else gi = (size_t)row * LRU_W + segpn * 256 + ch * 8;
                        *(u32x4*)(dst + gi) = val;
                    }
                    __syncthreads();
                    if (pn >= 15) {
                        float* part = ldsf;
#pragma unroll
                        for (int ai = 0; ai < 2; ++ai)
#pragma unroll
                            for (int m = 0; m < 4; ++m)
#pragma unroll
                                for (int bj = 0; bj < 2; ++bj)
#pragma unroll
                                    for (int j = 0; j < 4; ++j) {
                                        float ss = acc[ai][bj][m][0][j] * acc[ai][bj][m][0][j] + acc[ai][bj][m][1][j] * acc[ai][bj][m][1][j];
                                        ss += SHX(ss, 1); ss += SHX(ss, 2); ss += SHX(ss, 4); ss += SHX(ss, 8);
                                        if (fr == 0) part[(wc * 2 + bj) * 256 + ai * 128 + wr * 64 + m * 16 + fq * 4 + j] = ss;
                                    }
                        __syncthreads();
                        {
                            const int bj = et >> 8, row = et & 255;
                            float v0 = part[(0 * 2 + bj) * 256 + row] + part[(1 * 2 + bj) * 256 + row], v1 = part[(2 * 2 + bj) * 256 + row] + part[(3 * 2 + bj) * 256 + row];
                            v0 = fmaxf(v0, SHX(v0, 1)); v0 = fmaxf(v0, SHX(v0, 2)); v0 = fmaxf(v0, SHX(v0, 4)); v0 = fmaxf(v0, SHX(v0, 8)); v0 = xrow16_max(v0);
                            v1 = fmaxf(v1, SHX(v1, 1)); v1 = fmaxf(v1, SHX(v1, 2)); v1 = fmaxf(v1, SHX(v1, 4)); v1 = fmaxf(v1, SHX(v1, 8)); v1 = xrow16_max(v1);
                            if ((et & 63) == 0) {
                                unsigned* q2p = (unsigned*)(wsl + CTL_QK2_OFF) + l * 16 + (pn >= 17 ? 8 : 0) + (segpn * 2 + bj) * 2;
                                atomic_max_u32(q2p, __builtin_bit_cast(unsigned, v0)); atomic_max_u32(q2p + 1, __builtin_bit_cast(unsigned, v1));
                            }
                        }
                        __syncthreads();
                    }
                    if (pn >= 3 && pn < 6) {
                        float* part = ldsf;
#pragma unroll
                        for (int ai = 0; ai < 2; ++ai)
#pragma unroll
                            for (int m = 0; m < 4; ++m)
#pragma unroll
                                for (int bj = 0; bj < 2; ++bj)
#pragma unroll
                                    for (int j = 0; j < 4; ++j) {
                                        float ss = acc[ai][bj][m][0][j] * acc[ai][bj][m][0][j] + acc[ai][bj][m][1][j] * acc[ai][bj][m][1][j];
                                        ss += SHX(ss, 1); ss += SHX(ss, 2); ss += SHX(ss, 4); ss += SHX(ss, 8);
                                        if (fr == 0) part[(wc * 2 + bj) * 256 + ai * 128 + wr * 64 + m * 16 + fq * 4 + j] = ss;
                                    }
                        __syncthreads();
                        {
                            const int bj = et >> 8, row = et & 255;
                            float v = part[(0 * 2 + bj) * 256 + row] + part[(1 * 2 + bj) * 256 + row] + part[(2 * 2 + bj) * 256 + row] + part[(3 * 2 + bj) * 256 + row];
                            v = fmaxf(v, SHX(v, 1)); v = fmaxf(v, SHX(v, 2)); v = fmaxf(v, SHX(v, 4)); v = fmaxf(v, SHX(v, 8)); v = xrow16_max(v);
                            if ((et & 63) == 0) kmax2[((pn - 3) * 2 + bj) * NKT + pm * 4 + ((et >> 6) & 3)] = v;
                        }
                        __syncthreads();
                    }
                } else {
                    bf16_t* dst = (pn < 9) ? VaT : VcT;
                    const int segpn = (pn < 9) ? pn - 6 : pn - 19;
#pragma unroll
                    for (int ai = 0; ai < 2; ++ai)
#pragma unroll
                        for (int m = 0; m < 4; ++m)
#pragma unroll
                            for (int bj = 0; bj < 2; ++bj)
#pragma unroll
                                for (int n = 0; n < 2; ++n) {
                                    const int dd = wc * 32 + n * 16 + fr;
                                    const int row = pm * 256 + ai * 128 + wr * 64 + m * 16 + fq * 4;
                                    const f32x4 a = acc[ai][bj][m][n];
                                    u32x2 o; o.x = pack2(a[0], a[1]); o.y = pack2(a[2], a[3]);
                                    const int s6 = row & 63, pos = (s6 & 32) + ((s6 >> 2) & 3) * 8 + ((s6 >> 4) & 1) * 4;
                                    *(u32x2*)(dst + (((size_t)(segpn * 2 + bj) * NKT + (row >> 6)) * 128 + dd) * 64 + pos) = o;
                                }
                }
                WAIT_VM0();
                __syncthreads();
                if (et == 0) { FENCE_REL_AGENT(); WAIT_VM0(); (void)xb_add(&cls[kcls * 64], 1u); }
                CONV_ONE();
            }
        }

        if (PH_SEL(1) && PH_IN(pb + 1)) {
            PHASE_IDS();
            const float lam_init = (l == 0) ? 0.2f : 0.35550906759f;
            const float s1 = wave_sum(p.in[I_LQ1][l * 64 + lane] * p.in[I_LK1][l * 64 + lane]);
            const float s2 = wave_sum(p.in[I_LQ2][l * 64 + lane] * p.in[I_LK2][l * 64 + lane]);
            const float lam = fexp(s1) - fexp(s2) + lam_init;
            constexpr int NLRU = NKT * 6, NQB = S / 128;
            bool conv_more = (l == 0);
            unsigned* cls = (unsigned*)(wsl + CTL_CLS_OFF) + l * 256;
            unsigned* bw = (unsigned*)wsl;
#define WAIT_CLASS(k, n) do { __syncthreads(); if (tid == 0) { XB_SPIN(xb_ld(&cls[(k) * 64]) < (unsigned)(n), bw); FENCE_ACQ_AGENT(); WAIT_VM0(); } __syncthreads(); } while (0)
#ifndef NO_DIFF
            {
                constexpr int NQB2 = S / 256;
                int total = 0;
                for (int q = 0; q < NQB2; ++q) total += ((4 * q + 4 + DCH - 1) / DCH) * 8;
                WAIT_CLASS(0, (S / 256) * 6);
                for (;;) {
                    __syncthreads();
                    if (tid == 0) *ubox = (unsigned)atomic_add_int(workctr, 1);
                    __syncthreads();
                    int u = RFL((int)*ubox);
                    if (u >= total) break;
                    int qb = NQB2 - 1;
                    for (;; --qb) { const int nu = ((4 * qb + 4 + DCH - 1) / DCH) * 8; if (u < nu) break; u -= nu; }
                    const int c = u >> 3, h = (u >> 1) & 3, mp = u & 1;
                    const int t0 = c * DCH, t1 = (t0 + DCH < 4 * qb + 4) ? t0 + DCH : 4 * qb + 4;
                    const unsigned* q2p = (const unsigned*)(wsl + CTL_QK2_OFF) + l * 16;
                    const float bnd = sqrtf(__builtin_bit_cast(float, q2p[h * 2 + mp]) * __builtin_bit_cast(float, q2p[8 + h * 2 + mp])) * (QSCALE_C * 1.02f) + 0.01f;
                    attn_dmap_unit(Qc + (size_t)h * S * 128, Kc + (size_t)h * S * 128, VcT + (size_t)h * S * 128, mp, qb, t0, t1,
                                   dpo + (size_t)(h * 2 + mp) * DPART_ROWS * 128, dpml + (size_t)(h * 2 + mp) * DPART_ROWS * 2, c, RFL_F(bnd), lds_raw, tid);
                    CONV_ONE();
                }
            }
#endif
#ifndef NO_LRU
            WAIT_CLASS(1, (S / 256) * 6);
            for (;;) {
                __syncthreads();
                if (tid == 0) *ubox = (unsigned)atomic_add_int(workctr + 10, 1);
                __syncthreads();
                const int u = RFL((int)*ubox);
                if (u >= NLRU) break;
                lru_unit_a(u / 6, u % 6, l, p, Xr, WaiT + (size_t)l * 6 * 256 * 128, hloc, ploc, sumA, sumH, lds_raw, tid);
            }
#endif
#ifndef NO_FOX
            WAIT_CLASS(2, (S / 256) * 9);
            WAIT_CLASS(3, 1);
            for (;;) {
                __syncthreads();
                if (tid == 0) *ubox = (unsigned)atomic_add_int(workctr + 1, 1);
                __syncthreads();
                const int u = RFL((int)*ubox);
                if (u >= NQB * FOX_H) break;
                const int qb = NQB - 1 - u / FOX_H, h = u % FOX_H;
                attn_unit<0>(Qa + (size_t)h * S * 128, Ka + (size_t)h * S * 128, VaT + (size_t)h * S * 128, cum2 + (size_t)h * S, kmax2 + h * NKT, qb, concat, h * 128,
                             0.f, 0.f, nullptr, lds_raw, tid);
            }
#endif
            while (conv_more) CONV_ONE();
            PH_BAR(pb + 1);
        }

        if (PH_SEL(2) && PH_IN(pb + 2)) for (int rep = 0; rep < PH_REPS(2); ++rep) {
            PHASE_IDS();
            for (int u = bid; u < NKT * 6; u += G) {
                const int chunk = u / 6, grp = u % 6, c = tid & 127, tq = tid >> 7, ch = grp * 128 + c;
                float cr = 0.f;
                {
                    int j = 0;
                    for (; j + 16 <= chunk; j += 16) {
                        float a8[16], h8[16];
#pragma unroll
                        for (int q = 0; q < 16; ++q) { a8[q] = sumA[(size_t)(j + q) * LRU_W + ch]; h8[q] = sumH[(size_t)(j + q) * LRU_W + ch]; }
#pragma unroll
                        for (int q = 0; q < 16; ++q) cr = a8[q] * cr + h8[q];
                    }
                    for (; j < chunk; ++j) cr = sumA[(size_t)j * LRU_W + ch] * cr + sumH[(size_t)j * LRU_W + ch];
                }
                float hl[16], pl[16]; bf16_t gg[16];
#pragma unroll
                for (int i = 0; i < 16; ++i) { const size_t gi = (size_t)(chunk * 64 + tq * 16 + i) * LRU_W + ch; const unsigned hp = ((const unsigned*)hloc)[gi]; hl[i] = bf2f((bf16_t)(hp & 0xffffu)); pl[i] = bf2f((bf16_t)(hp >> 16)); gg[i] = Gr[gi]; }
#pragma unroll
                for (int i = 0; i < 16; ++i)
                    concat[(size_t)(chunk * 64 + tq * 16 + i) * D + FOX_W + ch] = f2bf(gelu_tanh_f(bf2f(gg[i])) * (hl[i] + pl[i] * cr));
            }
            {
                const float lam_init = (l == 0) ? 0.2f : 0.35550906759f;
                const float s1 = wave_sum(p.in[I_LQ1][l * 64 + lane] * p.in[I_LK1][l * 64 + lane]);
                const float s2 = wave_sum(p.in[I_LQ2][l * 64 + lane] * p.in[I_LK2][l * 64 + lane]);
                const float lam = fexp(s1) - fexp(s2) + lam_init;
                const float* sg = p.in[I_SUBG] + l * 128;
                const float g0 = sg[2 * lane], g1 = sg[2 * lane + 1];
                static_assert(NCH <= 8, "the merge below keeps one (map, chunk) pair per lane: 2 x 8 lanes");
                for (int q = gwave; q < S; q += gwaves) {
                    const int nch = (q >> 6) / DCH + 1;
                    float mv = -INFINITY, lv = 0.f;
                    { const int c = lane & 7, hm = lane >> 3;
                      if (c < nch) { const float* ML = dpml + ((size_t)hm * DPART_ROWS + dpart_row(c, q)) * 2; mv = ML[0]; lv = ML[1]; } }
                    unsigned pk[4][2][NCH];
#pragma unroll
                    for (int h = 0; h < 4; ++h)
#pragma unroll
                        for (int mp = 0; mp < 2; ++mp) {
                            const unsigned* OP = (const unsigned*)(dpo + (size_t)(h * 2 + mp) * DPART_ROWS * 128);
#pragma unroll
                            for (int c = 0; c < NCH; ++c) pk[h][mp][c] = (c < nch) ? OP[(size_t)dpart_row(c, q) * 64 + lane] : 0u;
                        }
                    float Mx = mv; Mx = fmaxf(Mx, DPP_X1(Mx)); Mx = fmaxf(Mx, DPP_X2(Mx)); Mx = fmaxf(Mx, DPP_X7(Mx));
                    const float wv = (mv == -INFINITY) ? 0.f : FAST_EXP2(mv - Mx);
                    float Lp = lv * wv; Lp += DPP_X1(Lp); Lp += DPP_X2(Lp); Lp += DPP_X7(Lp);
#pragma unroll
                    for (int h = 0; h < 4; ++h) {
                        float om[2][2];
#pragma unroll
                        for (int mp = 0; mp < 2; ++mp) {
                            float o0 = 0.f, o1 = 0.f;
#pragma unroll
                            for (int c = 0; c < NCH; ++c) { const float w = RDLANE(wv, (h * 2 + mp) * 8 + c); o0 += bf2f((bf16_t)(pk[h][mp][c] & 0xffffu)) * w; o1 += bf2f((bf16_t)(pk[h][mp][c] >> 16)) * w; }
                            const float il = 1.f / RDLANE(Lp, (h * 2 + mp) * 8);
                            om[mp][0] = o0 * il; om[mp][1] = o1 * il;
                        }
                        const float v0 = om[0][0] - lam * om[1][0], v1 = om[0][1] - lam * om[1][1];
                        const float ss = wave_sum(v0 * v0 + v1 * v1);
                        const float rs = (1.f - lam_init) / sqrtf(ss * (1.f / 128.f) + LN_EPS);
                        *(unsigned*)(concat + (size_t)q * D + 1536 + h * 128 + 2 * lane) = pack2(v0 * rs * g0, v1 * rs * g1);
                    }
                }
            }
            PH_BAR(pb + 2);
        }

        if (PH_SEL(3) && PH_IN(pb + 3)) {
            PHASE_IDS();
            const bf16_t* Bt = WoT + (size_t)l * D * D;
            constexpr int ntn = D / 256, ntm = S / 256;
            static_assert(ntn == 8, "the panel exchange is written for 8 column tiles");
            const unsigned nooff[2][2] = {{0u, 0u}, {0u, 0u}};
            const float* g1 = p.in[I_LN1G] + (size_t)l * D; const float* b1 = p.in[I_LN1B] + (size_t)l * D;
            const float* bg = p.in[I_BGRP] + l * 4; const float* br = p.in[I_BRT] + l * 32;
            const bf16_t* Wb = W36b + (size_t)l * 2 * 48 * D;
            int* lcnt = (int*)(lds_raw + LDS_MISC + M_LCNT);
            const int segcap = ((ntm * ntn + G - 1) / G) * 32;
            unsigned* pcnt = (unsigned*)(wsl + CTL_PAN_OFF) + l * 1024;
            unsigned long long* xbuf = (unsigned long long*)(wsl + A_XBUF);
            unsigned* part = (unsigned*)(wsl + A_PART);
            LAS float* Stab = (LAS float*)(lds_raw + LDS_MISC + M_RTOK);
            float* lgt = (float*)(lds_raw + LDS_MISC + 4096);
            if (tid < 32) lcnt[tid] = 0;
            __syncthreads();
            for (int t0 = bid; t0 < ntm * ntn; t0 += G) {
                int t = t0;
                if (G == 256 && ntm * ntn == 256) { const int x = t0 & 7, j = t0 >> 3; t = (x * 4 + (j >> 3)) * ntn + (j & 7); }
                const int pm = t / ntn, pn = t % ntn;
                f32x4 v[2][16];
                {
                    f32x4 acc[2][2][4][2];
                    gemm_tile<false>(concat, pm * 256, nooff, Bt, pn * 256, D, lds_raw, acc, tid);
                    int et = tid; OPAQUE(et); const int wr = et >> 8, wc = (et >> 6) & 3, fr = et & 15, fq = (et >> 4) & 3;
#pragma unroll
                    for (int ai = 0; ai < 2; ++ai) {
#pragma unroll
                        for (int m = 0; m < 4; ++m)
#pragma unroll
                            for (int bj = 0; bj < 2; ++bj)
#pragma unroll
                                for (int n = 0; n < 2; ++n)
#pragma unroll
                                    for (int j = 0; j < 4; ++j)
                                        *(float*)(lds_raw + (wr * 64 + m * 16 + fq * 4 + j) * 1040 + (bj * 128 + wc * 32 + n * 16 + fr) * 4) = acc[ai][bj][m][n][j];
                        __syncthreads();
#pragma unroll
                        for (int i = 0; i < 16; ++i) {
                            const int lrow = i * 8 + (et >> 6), c4 = et & 63;
                            const size_t gi = (size_t)(pm * 256 + ai * 128 + lrow) * D + pn * 256 + c4 * 4;
                            v[ai][i] = *(const GAS f32x4*)(hin + gi);
                        }
#pragma unroll
                        for (int i = 0; i < 16; ++i) {
                            const int lrow = i * 8 + (et >> 6), c4 = et & 63;
                            v[ai][i] = ALPHA * v[ai][i] + *(const f32x4*)(lds_raw + lrow * 1040 + c4 * 16);
                        }
                        __syncthreads();
                    }
                }
                int et2 = tid; OPAQUE(et2); const int el = et2 & 63, ew = wave_s, er16 = et2 & 15, eq4 = (et2 >> 4) & 3;
#pragma unroll
                for (int q = 0; q < 6; ++q) {
                    const int seg = ew * 6 + q, n2 = seg * 2 + (el >> 5), p5 = el & 31;
                    GLDS16(Wb + (size_t)n2 * D + pn * 256 + ((p5 ^ (n2 & 15)) << 3), lds_raw + 65536 + seg * 1024 + el * 16);
                }
                float my_mt = 0.f, my_m2 = 0.f;
                for (int trep = 0; trep < REP_STATS; ++trep)
#pragma unroll
                for (int ai = 0; ai < 2; ++ai)
#pragma unroll
                    for (int i4 = 0; i4 < 16; i4 += 4) {
                        float mt4[4], m24[4];
#pragma unroll
                        for (int u = 0; u < 4; ++u) { const f32x4 x = v[ai][i4 + u]; mt4[u] = wave_sum((x[0] + x[1]) + (x[2] + x[3])) * (1.f / 256.f); }
#pragma unroll
                        for (int u = 0; u < 4; ++u) { const f32x4 d = v[ai][i4 + u] - mt4[u]; m24[u] = wave_sum((d[0] * d[0] + d[1] * d[1]) + (d[2] * d[2] + d[3] * d[3])); }
#pragma unroll
                        for (int u = 0; u < 4; ++u) if (el == ai * 16 + i4 + u) { my_mt = mt4[u]; my_m2 = m24[u]; }
                        COMPILER_FENCE();
                    }
                unsigned* bw = (unsigned*)wsl;
                if (el < 32) {
                    const int grow = (el >> 4) * 128 + (el & 15) * 8 + ew;
                    xst64(&xbuf[(size_t)(pm * 256 + grow) * 8 + pn], ((unsigned long long)__builtin_bit_cast(unsigned, my_m2) << 32) | __builtin_bit_cast(unsigned, my_mt));
                }
                WAIT_VM0();
                __syncthreads();
                if (et2 == 0) { (void)xb_add(&pcnt[pm * 16], 1u); XB_SPIN(xb_ld(&pcnt[pm * 16]) < 8u, bw); FENCE_ACQ_AGENT(); }
                __syncthreads();
                unsigned long long wk[4];
#pragma unroll
                for (int k = 0; k < 4; ++k) {
                    const int r = k * 8 + (el >> 3), grow = (r >> 4) * 128 + (r & 15) * 8 + ew;
                    wk[k] = xld64(&xbuf[(size_t)(pm * 256 + grow) * 8 + (el & 7)]);
                }
#pragma unroll
                for (int k = 0; k < 4; ++k) {
                    const int r = k * 8 + (el >> 3);
                    const unsigned long long w = wk[k];
                    const float mt = __builtin_bit_cast(float, (unsigned)w), m2 = __builtin_bit_cast(float, (unsigned)(w >> 32));
                    float ms = mt; ms += DPP_X1(ms); ms += DPP_X2(ms); ms += DPP_X7(ms);
                    const float mean = ms * 0.125f, dm = mt - mean;
                    float q = m2 + 256.f * dm * dm; q += DPP_X1(q); q += DPP_X2(q); q += DPP_X7(q);
                    const float rstd = 1.f / sqrtf(q * (1.f / D) + LN_EPS);
                    if ((el & 7) == 0) { Stab[(ew * 32 + r) * 2] = mean; Stab[(ew * 32 + r) * 2 + 1] = rstd; }
                }
                WAVE_SYNC();
                const f32x4 gv = *(const f32x4*)(g1 + pn * 256 + el * 4), bv = *(const f32x4*)(b1 + pn * 256 + el * 4);
                LAS unsigned char* wt = (LAS unsigned char*)lds_raw + ew * 8192;
                const LAS unsigned char* wbl = (const LAS unsigned char*)lds_raw + 65536;
                for (int rrep = 0; rrep < REP_ROUTER; ++rrep)
#pragma unroll
                for (int ai = 0; ai < 2; ++ai) {
                    u32x2 lokeep[16];
#pragma unroll
                    for (int i = 0; i < 16; ++i) {
                        const float mean = Stab[(ew * 32 + ai * 16 + i) * 2], rstd = Stab[(ew * 32 + ai * 16 + i) * 2 + 1];
                        const f32x4 hv = mul_s4(v[ai][i] - mean, rstd) * gv + bv;
                        u32x2 o; o.x = pack2(hv[0], hv[1]); o.y = pack2(hv[2], hv[3]);
                        lokeep[i].x = pack2(hv[0] - bf2f((bf16_t)(o.x & 0xffffu)), hv[1] - bf2f((bf16_t)(o.x >> 16)));
                        lokeep[i].y = pack2(hv[2] - bf2f((bf16_t)(o.y & 0xffffu)), hv[3] - bf2f((bf16_t)(o.y >> 16)));
                        *(LAS u32x2*)(wt + i * 512 + (((el >> 1) ^ i) << 4) + (el & 1) * 8) = o;
                        COMPILER_FENCE();
                    }
                    WAVE_SYNC();
                    f32x4 ac[3];
#pragma unroll
                    for (int nt = 0; nt < 3; ++nt) ac[nt] = (f32x4){0.f, 0.f, 0.f, 0.f};
#pragma unroll 2
                    for (int ks = 0; ks < 8; ++ks) {
                        const int co = ((ks * 4 + eq4) ^ er16) << 4;
                        const bf16x8 ah = *(const LAS bf16x8*)(wt + er16 * 512 + co);
#pragma unroll
                        for (int nt = 0; nt < 3; ++nt) {
                            const bf16x8 bh = *(const LAS bf16x8*)(wbl + (nt * 16 + er16) * 512 + co);
                            const bf16x8 bl = *(const LAS bf16x8*)(wbl + (48 + nt * 16 + er16) * 512 + co);
                            ac[nt] = MFMA16(ah, bh, ac[nt]); ac[nt] = MFMA16(ah, bl, ac[nt]);
                        }
                    }
                    WAVE_SYNC();
#pragma unroll
                    for (int i = 0; i < 16; ++i) *(LAS u32x2*)(wt + i * 512 + (((el >> 1) ^ i) << 4) + (el & 1) * 8) = lokeep[i];
                    WAVE_SYNC();
#pragma unroll 2
                    for (int ks = 0; ks < 8; ++ks) {
                        const int co = ((ks * 4 + eq4) ^ er16) << 4;
                        const bf16x8 al = *(const LAS bf16x8*)(wt + er16 * 512 + co);
#pragma unroll
                        for (int nt = 0; nt < 3; ++nt) {
                            const bf16x8 bh = *(const LAS bf16x8*)(wbl + (nt * 16 + er16) * 512 + co);
                            ac[nt] = MFMA16(al, bh, ac[nt]);
                        }
                    }
#pragma unroll
                    for (int nt = 0; nt < 3; ++nt)
#pragma unroll
                        for (int j = 0; j < 4; ++j) {
                            const float cv = ac[nt][j];
                            xst32(&part[((size_t)pn * S + pm * 256 + ai * 128 + (eq4 * 4 + j) * 8 + ew) * 48 + nt * 16 + er16], __builtin_bit_cast(unsigned, cv));
                        }
                    WAVE_SYNC();
                }
                WAIT_VM0();
                __syncthreads();
                if (et2 == 0) (void)xb_add(&pcnt[512 + pm * 16], 1u);
                for (int srep = 0; srep < REP_STORES; ++srep)
#pragma unroll
                for (int ai = 0; ai < 2; ++ai)
#pragma unroll
                    for (int i = 0; i < 16; ++i) {
                        const float mean = Stab[(ew * 32 + ai * 16 + i) * 2], rstd = Stab[(ew * 32 + ai * 16 + i) * 2 + 1];
                        const f32x4 hv = mul_s4(v[ai][i] - mean, rstd) * gv + bv;
                        const size_t gi = (size_t)(pm * 256 + ai * 128 + i * 8 + ew) * D + pn * 256 + el * 4;
                        u32x2 o; o.x = pack2(hv[0], hv[1]); o.y = pack2(hv[2], hv[3]);
                        *(u32x2*)(h1b + gi) = o;
                        COMPILER_FENCE();
                    }
                if (et2 == 0) { XB_SPIN(xb_ld(&pcnt[512 + pm * 16]) < 8u, bw); FENCE_ACQ_AGENT(); }
                __syncthreads();
                int rt = tid; OPAQUE(rt);
#pragma unroll
                for (int k = 0; k < 3; ++k) {
                    const int idx = rt + k * 512, tk = idx / 48, n = idx - tk * 48;
                    unsigned pq[8];
#pragma unroll
                    for (int q = 0; q < 8; ++q) pq[q] = xb_ld(&part[((size_t)q * S + pm * 256 + pn * 32 + tk) * 48 + n]);
                    float a = 0.f;
#pragma unroll
                    for (int q = 0; q < 8; ++q) a += __builtin_bit_cast(float, pq[q]);
                    lgt[idx] = a;
                }
                __syncthreads();
                if (rt < 32) {
                    const int t = pm * 256 + pn * 32 + rt; const float* L = lgt + rt * 48;
                    float gl[4];
#pragma unroll
                    for (int q = 0; q < 4; ++q) gl[q] = L[q] + bg[q];
                    int gi = 0; float gm = gl[0];
#pragma unroll
                    for (int q = 1; q < 4; ++q) if (gl[q] > gm) { gm = gl[q]; gi = q; }
                    float gs = 0.f;
#pragma unroll
                    for (int q = 0; q < 4; ++q) gs += fexp(gl[q] - gm);
                    const float gweight = 1.f / gs;
                    float E[8];
#pragma unroll
                    for (int e = 0; e < 8; ++e) E[e] = L[4 + gi * 8 + e] + br[gi * 8 + e];
                    int e1 = 0; float m1 = E[0];
#pragma unroll
                    for (int e = 1; e < 8; ++e) if (E[e] > m1) { m1 = E[e]; e1 = e; }
                    int e2 = -1; float m2 = -INFINITY;
#pragma unroll
                    for (int e = 0; e < 8; ++e) if (e != e1 && E[e] > m2) { m2 = E[e]; e2 = e; }
                    const float p2 = fexp(m2 - m1), w1 = 1.f / (1.f + p2), w2 = p2 / (1.f + p2);
                    const int ge1 = gi * 8 + e1, ge2 = gi * 8 + e2;
                    const int i1 = (ge1 * G + bid) * segcap + atomic_add_int(&lcnt[ge1], 1);
                    ltok[i1] = t; lw[i1] = gweight * w1; lslot[i1] = 0;
                    const int i2 = (ge2 * G + bid) * segcap + atomic_add_int(&lcnt[ge2], 1);
                    ltok[i2] = t; lw[i2] = gweight * w2; lslot[i2] = 1;
                }
                __syncthreads();
            }
            { int ft = tid; OPAQUE(ft); if (ft < 32) cntb[bid * 32 + ft] = lcnt[ft]; }
            PH_BAR(pb + 3);
        }

        if (PH_SEL(5) && PH_IN(pb + 5)) {
            PHASE_IDS();
            const unsigned nooff[2][2] = {{0u, 0u}, {0u, 0u}};
            const int segcap = ((S / 256 * (D / 256) + G - 1) / G) * 32;
            moe_prefix(cntb, G, lds_raw, tid);
            const int* ctot = (const int*)(lds_raw + LDS_MISC + M_CTOT); const int* coff = (const int*)(lds_raw + LDS_MISC + M_COFF);
            const int* rtok = (const int*)(lds_raw + LDS_MISC + M_RTOK); const float* rw = (const float*)(lds_raw + LDS_MISC + M_RW);
            const int* rslot = (const int*)(lds_raw + LDS_MISC + M_RSLOT);
            unsigned* done = (unsigned*)(wsl + CTL_DONE_OFF) + l * 1024;
            int* mq = (int*)(wsl + CTL_MQ_OFF) + l * 128;
            const int myx = (int)(xb_xcc_id() & 7u);
            int qi = 0;
            for (;;) {
                __syncthreads();
                if (tid == 0) {
                    unsigned r = 0xffffffffu;
                    while (qi < 8) {
                        const int xx = (myx + qi) & 7;
                        int nm = 0;
#pragma unroll
                        for (int k = 0; k < NEXP / 8; ++k) nm += (ctot[xx + 8 * k] + 255) / 256;
                        const int got = atomic_add_int(mq + xx * 16, 1);
                        if (got < nm * 12) { r = ((unsigned)xx << 24) | (unsigned)got; break; }
                        ++qi;
                    }
                    *ubox = r;
                }
                __syncthreads();
                const unsigned rr = (unsigned)RFL((int)*ubox);
                if (rr == 0xffffffffu) break;
                const int xq = (int)(rr >> 24);
                int u = (int)(rr & 0xffffffu);
                int nmt = 0;
#pragma unroll
                for (int k = 0; k < NEXP / 8; ++k) nmt += (RFL(ctot[xq + 8 * k]) + 255) / 256;
                const bool down = (u >= nmt * 4);
                const int per = down ? 8 : 4;
                if (down) u -= nmt * 4;
                int e = xq;
                for (;; e += 8) { const int nt = ((RFL(ctot[e]) + 255) / 256) * per; if (u < nt) break; u -= nt; }
                const int c = RFL(ctot[e]), off = RFL(coff[e]);
                const int mt = u / per, pn = u % per, m0 = mt * 256;
                moe_rowtable(ltok, lw, lslot, e, m0, c, G, segcap, lds_raw, tid);
                f32x4 acc[2][2][4][2];
                if (!down) {
                    const bf16_t* Bt = WguT + ((size_t)l * NEXP + e) * 1024 * D;
                    unsigned aoff[2][2];
                    int st = tid; OPAQUE(st); int R[2], C[2]; stage_geom(st, R, C);
#pragma unroll
                    for (int h = 0; h < 2; ++h)
#pragma unroll
                        for (int i = 0; i < 2; ++i) aoff[h][i] = (unsigned)(rtok[h * 128 + R[i]] * D + C[i]);
                    gemm_tile<true>(h1b, 0, aoff, Bt, pn * 256, D, lds_raw, acc, tid);
                    int et = tid; OPAQUE(et); const int wr = et >> 8, wc = (et >> 6) & 3, fr = et & 15, fq = (et >> 4) & 3;
#pragma unroll
                    for (int ai = 0; ai < 2; ++ai)
#pragma unroll
                        for (int m = 0; m < 4; ++m)
#pragma unroll
                            for (int j = 0; j < 4; ++j) {
                                const int r = ai * 128 + wr * 64 + m * 16 + fq * 4 + j;
                                const float wgt = rw[r];
#pragma unroll
                                for (int bj = 0; bj < 2; ++bj)
                                    *(bf16_t*)(lds_raw + r * 272 + (bj * 64 + wc * 16 + fr) * 2) = f2bf(silu_f(acc[ai][bj][m][0][j]) * acc[ai][bj][m][1][j] * wgt);
                            }
                    __syncthreads();
#pragma unroll 4
                    for (int i = 0; i < 8; ++i) {
                        const int idx = et + i * 512, r = idx >> 4, ch = idx & 15;
                        if (m0 + r < c) *(u32x4*)(act + (size_t)(off + m0 + r) * DFF + pn * 128 + ch * 8) = *(const u32x4*)(lds_raw + r * 272 + ch * 16);
                    }
                    WAIT_VM0();
                    __syncthreads();
                    if (et == 0) { FENCE_REL_AGENT(); WAIT_VM0(); (void)xb_add(&done[e * 32 + mt], 1u); }
                } else {
                    const bf16_t* Bt = WdT + ((size_t)l * NEXP + e) * D * DFF;
                    if (tid == 0) {
                        unsigned* bw = (unsigned*)wsl;
                        XB_SPIN(xb_ld(&done[e * 32 + mt]) < 4u, bw);
                        FENCE_ACQ_AGENT();
                        WAIT_VM0();
                    }
                    __syncthreads();
                    gemm_tile<false>(act, off + m0, nooff, Bt, pn * 256, DFF, lds_raw, acc, tid);
                    int et = tid; OPAQUE(et); const int wr = et >> 8, wc = (et >> 6) & 3, fr = et & 15, fq = (et >> 4) & 3;
#pragma unroll
                    for (int ai = 0; ai < 2; ++ai)
#pragma unroll
                        for (int m = 0; m < 4; ++m)
#pragma unroll
                            for (int bj = 0; bj < 2; ++bj)
#pragma unroll
                                for (int n = 0; n < 2; ++n)
#pragma unroll
                                    for (int j = 0; j < 4; ++j)
                                        *(bf16_t*)(lds_raw + (ai * 128 + wr * 64 + m * 16 + fq * 4 + j) * 528 + (bj * 128 + wc * 32 + n * 16 + fr) * 2) = f2bf(acc[ai][bj][m][n][j]);
                    __syncthreads();
#pragma unroll 4
                    for (int i = 0; i < 16; ++i) {
                        const int idx = et + i * 512, r = idx >> 5, ch = idx & 31;
                        if (m0 + r < c) *(u32x4*)(contrib + ((size_t)rslot[r] * S + rtok[r]) * D + pn * 256 + ch * 8) = *(const u32x4*)(lds_raw + r * 528 + ch * 16);
                    }
                }
            }
            PH_BAR(pb + 5);
        }

        if (PH_SEL(7) && PH_IN(pb + 7)) for (int rep = 0; rep < PH_REPS(7); ++rep) {
            PHASE_IDS();
            const float* g2 = p.in[I_LN2G] + (size_t)l * D; const float* b2 = p.in[I_LN2B] + (size_t)l * D;
            const bool more = (l + 1 < DEPTH);
            f32x4 gq[8], bq[8];
#pragma unroll
            for (int j = 0; j < 8; ++j) { gq[j] = *(const f32x4*)(g2 + j * 256 + lane * 4); bq[j] = *(const f32x4*)(b2 + j * 256 + lane * 4); }
            if (more) {
                const float* wf = Wfa + (size_t)(l + 1) * 8 * D;
                __syncthreads();
                for (int i = tid; i < 6 * D / 4; i += NTHREADS) *(f32x4*)(ldsf + i * 4) = *(const f32x4*)(wf + i * 4);
                __syncthreads();
            }
            for (int t = gwave; t < S; t += gwaves) {
                f32x4 v[8]; float s = 0.f;
#pragma unroll
                for (int j = 0; j < 8; ++j) {
                    const size_t i = (size_t)t * D + j * 256 + lane * 4;
                    const u32x2 c0 = *(const u32x2*)(contrib + i), c1 = *(const u32x2*)(contrib + (size_t)S * D + i);
                    const f32x4 cs = (f32x4){bf2f((bf16_t)(c0.x & 0xffffu)) + bf2f((bf16_t)(c1.x & 0xffffu)), bf2f((bf16_t)(c0.x >> 16)) + bf2f((bf16_t)(c1.x >> 16)),
                                             bf2f((bf16_t)(c0.y & 0xffffu)) + bf2f((bf16_t)(c1.y & 0xffffu)), bf2f((bf16_t)(c0.y >> 16)) + bf2f((bf16_t)(c1.y >> 16))};
                    const u32x2 hq = *(const u32x2*)(h1b + i);
                    v[j] = ALPHA * (f32x4){bf2f((bf16_t)(hq.x & 0xffffu)), bf2f((bf16_t)(hq.x >> 16)), bf2f((bf16_t)(hq.y & 0xffffu)), bf2f((bf16_t)(hq.y >> 16))} + cs;
                    s += (v[j][0] + v[j][1]) + (v[j][2] + v[j][3]);
                }
                const float mean = wave_sum(s) * (1.f / D);
                float s2 = 0.f;
#pragma unroll
                for (int j = 0; j < 8; ++j) { v[j] -= mean; s2 += (v[j][0] * v[j][0] + v[j][1] * v[j][1]) + (v[j][2] * v[j][2] + v[j][3] * v[j][3]); }
                const float rstd = 1.f / sqrtf(wave_sum(s2) * (1.f / D) + LN_EPS);
                float fa[6] = {0.f, 0.f, 0.f, 0.f, 0.f, 0.f};
#pragma unroll
                for (int j = 0; j < 8; ++j) {
                    const int c = j * 256 + lane * 4;
                    v[j] = v[j] * rstd * gq[j] + bq[j];
                    *(f32x4*)(hout + (size_t)t * D + c) = v[j];
                    COMPILER_FENCE();
                    if (more) {
                        u32x2 o; o.x = pack2(v[j][0], v[j][1]); o.y = pack2(v[j][2], v[j][3]);
                        *(u32x2*)(xb + (size_t)t * D + c) = o;
#pragma unroll
                        for (int h = 0; h < 6; ++h) { const f32x4 w = *(const f32x4*)(ldsf + h * D + c); fa[h] += (v[j][0] * w[0] + v[j][1] * w[1]) + (v[j][2] * w[2] + v[j][3] * w[3]); }
                    }
                }
                if (more) {
#pragma unroll
                    for (int h = 0; h < 6; ++h) { const float sm = wave_sum(fa[h]); if (lane == 0) logf_[h * S + t] = log_sigmoid_f(sm + p.in[I_BF][(l + 1) * 6 + h]); }
                }
            }
            PH_BAR(pb + 7);
        }
    }
#undef PH_IN
#undef PH_BAR
}

constexpr int N_PHASES = 1 + DEPTH * 8;
#ifndef EMU
extern "C" void kernel_launch(void* const* d_in, const int* in_sizes, int n_in, void* d_out, int out_size, void* d_ws, size_t ws_size, hipStream_t stream) {
    static int grid = 0;
    if (grid == 0) {
        if (n_in != N_INPUTS || out_size != S * D || ws_size < WS_END) {
            fprintf(stderr, "kernel_launch: unexpected shapes: n_in %d out %d ws %zu (need %zu)\n", n_in, out_size, ws_size, (size_t)WS_END); grid = -1; return; }
        int dev = 0, cus = 0, per_cu = 0;
        if (hipGetDevice(&dev) != hipSuccess || hipDeviceGetAttribute(&cus, hipDeviceAttributeMultiprocessorCount, dev) != hipSuccess) { grid = -1; return; }
        if (hipFuncSetAttribute((const void*)fwd_kernel, hipFuncAttributeMaxDynamicSharedMemorySize, LDS_BYTES) != hipSuccess) { fprintf(stderr, "kernel_launch: hipFuncSetAttribute failed\n"); grid = -1; return; }
        if (hipOccupancyMaxActiveBlocksPerMultiprocessor(&per_cu, (const void*)fwd_kernel, NTHREADS, LDS_BYTES) != hipSuccess || per_cu < 1) {
            fprintf(stderr, "kernel_launch: occupancy query says %d blocks per CU\n", per_cu); (void)hipGetLastError(); grid = -1; return; }
        grid = cus;
    }
    if (grid < 0) return;
    (void)hipMemsetAsync(d_ws, 0, CTL_BYTES, stream);
    Params p{};
    for (int i = 0; i < N_INPUTS; ++i) p.in[i] = (const float*)d_in[i];
    p.out = (float*)d_out; p.ws = (unsigned char*)d_ws;
    for (int i = 0; i < 8; ++i) p.inv_freq[i] = (float)pow(500000.0, -(double)i * 2.0 / 16.0);
#if N_LAUNCH_SPLIT
    for (int k = 0; k < N_PHASES; ++k) { p.lo = k; p.hi = k + 1; hipLaunchKernelGGL(fwd_kernel, dim3(grid), dim3(NTHREADS), LDS_BYTES, stream, p); }
#else
    p.lo = 0; p.hi = N_PHASES;
    hipLaunchKernelGGL(fwd_kernel, dim3(grid), dim3(NTHREADS), LDS_BYTES, stream, p);
#endif
}
#endif
```

```cpp
#ifndef EMU
#include <hip/hip_runtime.h>
#include <cstdio>
#include <cstdint>
#include <cmath>
#endif

#ifndef SEQ
#define SEQ 8192
#endif
#ifndef N_LAUNCH_SPLIT
#define N_LAUNCH_SPLIT 0
#endif
#ifndef REP_PHASE
#define REP_PHASE -2
#endif
#define PH_REPS(c) ((c) == REP_PHASE ? 2 : 1)
#ifndef REP_SUB
#define REP_SUB 0
#endif

constexpr int S = SEQ, D = 2048, DEPTH = 2;
constexpr int FOX_H = 6, FOX_W = 768;
constexpr int LRU_W = 768;
constexpr int DIFF_H = 4, DIFF_W = 512;
constexpr int N_IN = 5382, N_INP = 5376;
constexpr int C_FA = 2304;
constexpr int NEXP = 32, DFF = 512;
constexpr int NKT = S / 64;
#ifndef REP_ROUTER
#define REP_ROUTER 1
#endif
#ifndef REP_STORES
#define REP_STORES 1
#endif
#ifndef REP_STATS
#define REP_STATS 1
#endif
#ifndef DCH
#define DCH 32
#endif
constexpr int NCH = (NKT + DCH - 1) / DCH;
constexpr size_t DPART_ROWS = (size_t)NCH * S - (size_t)(DCH * 64) * NCH * (NCH - 1) / 2;
constexpr float ALPHA = 1.41421356237309504880f;
constexpr float LN_EPS = 1e-5f;
constexpr float LOG2E = 1.4426950408889634f;
constexpr float QSCALE_A = 0.08838834764831845f * 1.4426950408889634f;
constexpr float QSCALE_C = 0.125f * 1.4426950408889634f;

enum { I_X = 0, I_POS, I_WIN, I_BF, I_CONVW, I_CONVB, I_WA, I_BA, I_WI, I_BI, I_LAM, I_LQ1, I_LK1, I_LQ2, I_LK2, I_SUBG, I_WO, I_LN1G, I_LN1B,
       I_WGRP, I_BGRP, I_WRT, I_BRT, I_WGATE, I_WUP, I_WDOWN, I_LN2G, I_LN2B, N_INPUTS };

typedef unsigned short bf16_t;
typedef short bf16x8 __attribute__((ext_vector_type(8)));
typedef float f32x4 __attribute__((ext_vector_type(4)));
typedef unsigned u32x4 __attribute__((ext_vector_type(4)));
typedef unsigned u32x2 __attribute__((ext_vector_type(2)));

constexpr size_t al256(size_t x) { return (x + 255) & ~(size_t)255; }
constexpr size_t CTL_BYTES = 65536;
constexpr size_t CTL_CNT_OFF = 32768;
constexpr size_t CTL_WORK_OFF = 36864;
constexpr size_t CTL_QK2_OFF = 57344;
constexpr size_t CTL_CLS_OFF = 49152;
constexpr size_t CTL_PAN_OFF = 16384;
constexpr size_t CTL_MQ_OFF = 24576;
constexpr size_t CTL_DONE_OFF = 40960;
constexpr size_t WB_WIN = CTL_BYTES;
constexpr size_t WB_WO = WB_WIN + al256((size_t)DEPTH * N_INP * D * 2);
constexpr size_t WB_WGU = WB_WO + al256((size_t)DEPTH * D * D * 2);
constexpr size_t WB_WD = WB_WGU + al256((size_t)DEPTH * NEXP * 1024 * D * 2);
constexpr size_t WB_WAI = WB_WD + al256((size_t)DEPTH * NEXP * D * DFF * 2);
constexpr size_t WF_FA = WB_WAI + al256((size_t)DEPTH * 6 * 256 * 128 * 2);
constexpr size_t WF_R36 = WF_FA + al256((size_t)DEPTH * 8 * D * 4);
constexpr size_t WF_ROPE = WF_R36 + al256((size_t)DEPTH * 2 * 48 * D * 2);
constexpr size_t A_XB = WF_ROPE + al256((size_t)S * 16 * 4);
constexpr size_t A_HB = A_XB + al256((size_t)S * D * 2);
constexpr size_t A_LOGF = A_HB + al256((size_t)S * D * 4);
constexpr size_t A_CUM = A_LOGF + al256((size_t)6 * S * 4);
constexpr size_t A_KMAX = A_CUM + al256((size_t)6 * S * 4);
constexpr size_t A_CNTB = A_KMAX + al256((size_t)6 * NKT * 4);
constexpr size_t A_QA = A_CNTB + al256((size_t)1024 * 32 * 4);
constexpr size_t A_KA = A_QA + al256((size_t)FOX_H * S * 128 * 2);
constexpr size_t A_VAT = A_KA + al256((size_t)FOX_H * S * 128 * 2);
constexpr size_t A_XR = A_VAT + al256((size_t)FOX_H * S * 128 * 2);
constexpr size_t A_GR = A_XR + al256((size_t)S * LRU_W * 2);
constexpr size_t A_QC = A_GR + al256((size_t)S * LRU_W * 2);
constexpr size_t A_KC = A_QC + al256((size_t)DIFF_H * S * 128 * 2);
constexpr size_t A_VCT = A_KC + al256((size_t)DIFF_H * S * 128 * 2);
constexpr size_t A_HLOC = A_VCT + al256((size_t)DIFF_H * S * 128 * 2);
constexpr size_t A_PLOC = A_HLOC + al256((size_t)S * LRU_W * 4);
constexpr size_t A_SUMA = A_PLOC + al256((size_t)S * LRU_W * 4);
constexpr size_t A_SUMH = A_SUMA + al256((size_t)NKT * LRU_W * 4);
constexpr size_t A_CONCAT = A_SUMH + al256((size_t)NKT * LRU_W * 4);
constexpr size_t A_Y1 = A_CONCAT + al256((size_t)S * D * 2);
constexpr size_t A_H1 = A_Y1 + al256((size_t)S * D * 4);
constexpr size_t A_H1B = A_H1 + al256((size_t)S * D * 4);
constexpr size_t A_LTOK = A_H1B + al256((size_t)S * D * 2);
constexpr size_t A_LW = A_LTOK + al256((size_t)NEXP * S * 4);
constexpr size_t A_LSLOT = A_LW + al256((size_t)NEXP * S * 4);
constexpr size_t A_ACT = A_LSLOT + al256((size_t)NEXP * S * 4);
constexpr size_t A_CONTRIB = A_ACT + al256((size_t)(2 * S + 256) * DFF * 2);
constexpr size_t WS_END = A_CONTRIB + al256((size_t)2 * S * D * 4);
constexpr size_t A_DPO = A_Y1;
constexpr size_t A_DPML = A_DPO + al256((size_t)8 * DPART_ROWS * 128 * 2);
static_assert(A_DPML + (size_t)8 * DPART_ROWS * 2 * 4 <= A_H1B, "differential partials must fit inside the y1 + h1 region");

constexpr size_t A_XBUF = A_H1 + al256((size_t)S * D * 2);
constexpr size_t A_PART = A_XBUF + al256((size_t)S * 8 * 8);
static_assert(A_PART + (size_t)8 * S * 48 * 4 <= A_H1B, "exchange buffers must fit inside the h1 region");
constexpr int NTHREADS = 512;
constexpr int LDS_MAIN = 131072 + 4096;
constexpr int LDS_MISC = LDS_MAIN;
constexpr int LDS_BYTES = LDS_MAIN + 8192 + 16640;
constexpr int M_PRE16 = 8192;
constexpr int M_LCNT = 64, M_CTOT = 256, M_COFF = 384, M_PRE = 512, M_RTOK = 2048, M_RW = 3072, M_RSLOT = 4096;

struct Params {
    const float* in[N_INPUTS];
    float* out;
    unsigned char* ws;
    float inv_freq[8];
    int lo, hi;
};

#ifndef EMU
#define LAS __attribute__((address_space(3)))
#define GAS __attribute__((address_space(1)))
#define DYN_LDS(name) extern __shared__ __attribute__((aligned(16))) unsigned char name[]
#define SLEEP1() __builtin_amdgcn_s_sleep(1)
#define WAVE_SYNC() __builtin_amdgcn_wave_barrier()
#define OPAQUE(x) asm volatile("" : "+v"(x))
#define COMPILER_FENCE() asm volatile("" ::: "memory")
#define RFL(x) __builtin_amdgcn_readfirstlane(x)
#define RFL_F(x) __builtin_bit_cast(float, __builtin_amdgcn_readfirstlane(__builtin_bit_cast(int, x)))
#define ANY_LANE(p) (__builtin_amdgcn_ballot_w64(p) != 0ull)
#define RDLANE(v, l) __builtin_bit_cast(float, __builtin_amdgcn_readlane(__builtin_bit_cast(int, v), l))
__device__ __forceinline__ int lane_id_volatile() { int l; asm volatile("v_mbcnt_lo_u32_b32 %0, -1, 0\n\tv_mbcnt_hi_u32_b32 %0, -1, %0" : "=v"(l)); return l; }
#define LANE_ID() lane_id_volatile()
#define OPAQUE_S(x) asm volatile("" : "+s"(x))
#define WAIT_VM0() asm volatile("s_waitcnt vmcnt(0)" ::: "memory")
#define WAIT_ALL0() __builtin_amdgcn_s_waitcnt(0)
#define FENCE_REL_AGENT() __builtin_amdgcn_fence(__ATOMIC_RELEASE, "agent")
#define FENCE_ACQ_AGENT() __builtin_amdgcn_fence(__ATOMIC_ACQUIRE, "agent")
#define MFMA16(a, b, c) __builtin_amdgcn_mfma_f32_16x16x32_bf16(a, b, c, 0, 0, 0)
#define GLDS16(g, l) __builtin_amdgcn_global_load_lds((const unsigned*)(g), (unsigned*)(l), 16, 0, 0)
#define WAIT_V(n) asm volatile("s_waitcnt vmcnt(" #n ")" ::: "memory")
#define WAIT_L(n) asm volatile("s_waitcnt lgkmcnt(" #n ")" ::: "memory")
#define BAR() __builtin_amdgcn_s_barrier()
#define SCHED() __builtin_amdgcn_sched_barrier(0)
#define SETPRIO(n) __builtin_amdgcn_s_setprio(n)
#define FAST_EXP2(x) __builtin_amdgcn_exp2f(x)
template <int M> __device__ __forceinline__ float shx_impl(float v, int lane) {
    if (M < 32) return __builtin_bit_cast(float, __builtin_amdgcn_ds_swizzle(__builtin_bit_cast(int, v), (M << 10) | 0x1f));
    return __builtin_bit_cast(float, __builtin_amdgcn_ds_bpermute((lane ^ 32) << 2, __builtin_bit_cast(int, v)));
}
#define SHX(v, M) shx_impl<M>(v, lane)
template <int CTRL> __device__ __forceinline__ float dppx(float x) { return __builtin_bit_cast(float, __builtin_amdgcn_mov_dpp(__builtin_bit_cast(int, x), CTRL, 0xf, 0xf, true)); }
#define DPP_X1(x) dppx<0xB1>(x)
#define DPP_X2(x) dppx<0x4E>(x)
#define DPP_X7(x) dppx<0x141>(x)
#define DPP_X8(x) dppx<0x128>(x)
#define xrow16_max(x) xrow16_max_l(x, lane)
#define xrow16_sum(x) xrow16_sum_l(x, lane)
__device__ __forceinline__ float xrow16_max_l(float x, int lane) { x = fmaxf(x, shx_impl<16>(x, lane)); return fmaxf(x, shx_impl<32>(x, lane)); }
__device__ __forceinline__ float xrow16_sum_l(float x, int lane) { x = x + shx_impl<16>(x, lane); return x + shx_impl<32>(x, lane); }
#define FAST_LOG2(x) __builtin_amdgcn_logf(x)
#define FAST_RCP(x) __builtin_amdgcn_rcpf(x)
__device__ __forceinline__ unsigned xb_ld(unsigned* p)              { return __hip_atomic_load(p, __ATOMIC_RELAXED, __HIP_MEMORY_SCOPE_AGENT); }
__device__ __forceinline__ unsigned xb_add(unsigned* p, unsigned v) { return __hip_atomic_fetch_add(p, v, __ATOMIC_RELAXED, __HIP_MEMORY_SCOPE_AGENT); }
__device__ __forceinline__ void xst64(unsigned long long* p, unsigned long long v) { __hip_atomic_store(p, v, __ATOMIC_RELAXED, __HIP_MEMORY_SCOPE_AGENT); }
__device__ __forceinline__ unsigned long long xld64(unsigned long long* p) { return __hip_atomic_load(p, __ATOMIC_RELAXED, __HIP_MEMORY_SCOPE_AGENT); }
__device__ __forceinline__ void xst32(unsigned* p, unsigned v) { __hip_atomic_store(p, v, __ATOMIC_RELAXED, __HIP_MEMORY_SCOPE_AGENT); }
__device__ __forceinline__ unsigned xb_xcc_id() { return (unsigned)__builtin_amdgcn_s_getreg((3 << 11) | 20) & 0xFu; }
__device__ __forceinline__ int atomic_add_int(int* p, int v) { return atomicAdd(p, v); }
__device__ __forceinline__ void atomic_min_int(int* p, int v) { atomicMin(p, v); }
__device__ __forceinline__ void atomic_max_u32(unsigned* p, unsigned v) { atomicMax(p, v); }
__device__ __forceinline__ unsigned pack2(float lo, float hi) { unsigned r; asm volatile("v_cvt_pk_bf16_f32 %0, %1, %2" : "=v"(r) : "v"(lo), "v"(hi)); return r; }
#else
#define MFMA16(a, b, c) emu_mfma_16x16x32_bf16(a, b, c)
#define GLDS16(g, l) emu_glds16((const void*)(g), (void*)(l))
#define WAIT_V(n) ((void)0)
#define WAIT_L(n) ((void)0)
#define BAR() __syncthreads()
#define SCHED() ((void)0)
#define SETPRIO(n) ((void)0)
#define FAST_EXP2(x) exp2f(x)
#define SHX(v, M) __shfl_xor(v, M)
#define DPP_X1(x) __shfl_xor(x, 1)
#define DPP_X2(x) __shfl_xor(x, 2)
#define DPP_X7(x) __shfl_xor(x, 7)
#define DPP_X8(x) __shfl_xor(x, 8)
static inline float xrow16_max(float x) { x = fmaxf(x, __shfl_xor(x, 16)); return fmaxf(x, __shfl_xor(x, 32)); }
static inline float xrow16_sum(float x) { x = x + __shfl_xor(x, 16); return x + __shfl_xor(x, 32); }
#define FAST_LOG2(x) log2f(x)
#define FAST_RCP(x) (1.f / (x))
static inline unsigned pack2(float lo, float hi) {
    unsigned a = __builtin_bit_cast(unsigned, lo), b = __builtin_bit_cast(unsigned, hi);
    a += 0x7fffu + ((a >> 16) & 1u); b += 0x7fffu + ((b >> 16) & 1u);
    return (a >> 16) | (b & 0xffff0000u);
}
#endif
__device__ __forceinline__ bf16_t f2bf(float f) { return (bf16_t)(pack2(f, 0.f) & 0xffffu); }
__device__ __forceinline__ float bf2f(bf16_t h) { return __builtin_bit_cast(float, (unsigned)h << 16); }

#define XB_TMO      128
#define XB_XCNT(j)  (256  + 64 * (j))
#define XB_XSUB(j)  (1280 + 64 * (j))
#define XB_XGEN(j)  (2304 + 64 * (j))
#define XB_TOP      3328
#define XB_TOPGEN   3392
#define XCD_BAR_WORDS 3456
#define XB_SPIN_CAP (1u << 22)
#define XB_SPIN(cond, bar) do { unsigned _sp = 0; while (cond) { SLEEP1(); \
    if ((++_sp & 255u) == 0u) { if (xb_ld(&(bar)[XB_TMO])) break; if (_sp > XB_SPIN_CAP) { xb_add(&(bar)[XB_TMO], 1u); break; } } } } while (0)

#define XB_X2SUB(x, s) (6400 + 16 * ((x) * 4 + (s)))
#define XB_X2CNT(x, s) (7424 + ((x) * 4 + (s)))
struct XcdBarrier { unsigned* bar; unsigned x, s; volatile LAS unsigned* st; };

__device__ __forceinline__ XcdBarrier xcd_barrier_post(unsigned* bar, volatile LAS unsigned* st) {
    XcdBarrier b; b.bar = bar; b.x = xb_xcc_id() & 15u; b.s = (blockIdx.x >> 3) & 3u; b.st = st;
    if (threadIdx.x == 0) {
        unsigned o = xb_add(&bar[XB_X2CNT(b.x, b.s)], 1u);
#ifndef EMU
        asm volatile("" :: "v"(o));
#endif
        (void)o;
        (void)xb_add(&bar[XB_XCNT(b.x)], 1u);
    }
    return b;
}
__device__ __forceinline__ void xcd_barrier_complete(unsigned* bar, unsigned x, unsigned s, unsigned& nsub, unsigned& nx, unsigned& nsubs) {
    const unsigned G = gridDim.x;
    unsigned sum, cnt, sp = 0u;
    for (;;) {
        sum = 0u; cnt = 0u;
#pragma unroll
        for (unsigned j = 0; j < 16; ++j) { const unsigned c = xb_ld(&bar[XB_XCNT(j)]); sum += c; cnt += (c > 0u) ? 1u : 0u; }
        if (sum == G) break;
        SLEEP1();
        if ((++sp & 255u) == 0u) { if (xb_ld(&bar[XB_TMO])) break; if (sp > XB_SPIN_CAP) { xb_add(&bar[XB_TMO], 1u); break; } }
    }
    unsigned mine = 0u, subs = 0u;
#pragma unroll
    for (unsigned q = 0; q < 4; ++q) { const unsigned c = xb_ld(&bar[XB_X2CNT(x, q)]); subs += (c > 0u) ? 1u : 0u; mine = (q == s) ? c : mine; }
    nsub = mine > 0u ? mine : 1u; nx = cnt > 0u ? cnt : 1u; nsubs = subs > 0u ? subs : 1u;
}
__device__ __forceinline__ void xcd_barrier(const XcdBarrier& b, bool leader) {
    WAIT_VM0();
    __syncthreads();
    if (leader) {
        unsigned* bar = b.bar;
        WAIT_ALL0();
        unsigned nsub = b.st[0], nx = b.st[1], nsubs = b.st[2];
        if (nsub == 0u) { xcd_barrier_complete(bar, b.x, b.s, nsub, nx, nsubs); b.st[0] = nsub; b.st[1] = nx; b.st[2] = nsubs; }
        const unsigned old = xb_add(&bar[XB_X2SUB(b.x, b.s)], 1u);
        const unsigned gen = old / nsub;
        bool xcd_last = false;
        if (old + 1u == (gen + 1u) * nsub) {
            const unsigned old2 = xb_add(&bar[XB_XSUB(b.x)], 1u);
            xcd_last = (old2 + 1u == (old2 / nsubs + 1u) * nsubs);
        }
        if (xcd_last) {
            FENCE_REL_AGENT();
            WAIT_VM0();
            const unsigned og = xb_add(&bar[XB_TOP], 1u);
            const unsigned tg = og / nx;
            if (og + 1u == (tg + 1u) * nx) xb_add(&bar[XB_TOPGEN], 1u);
            else XB_SPIN(xb_ld(&bar[XB_TOPGEN]) == tg, bar);
            FENCE_ACQ_AGENT();
            xb_add(&bar[XB_XGEN(b.x)], 1u);
            WAIT_VM0();
        } else {
            XB_SPIN(xb_ld(&bar[XB_XGEN(b.x)]) == gen, bar);
            FENCE_ACQ_AGENT();
            WAIT_VM0();
        }
    }
    __syncthreads();
}

__device__ __forceinline__ f32x4 mul_s4(f32x4 a, float s) {
#ifdef EMU
    return a * s;
#else
    f32x4 o;
#pragma unroll
    for (int c = 0; c < 4; ++c) { float r, x = a[c]; asm volatile("v_mul_f32_e32 %0, %1, %2" : "=v"(r) : "v"(x), "v"(s)); o[c] = r; }
    return o;
#endif
}
__device__ __forceinline__ float wave_sum_l(float v, int lane) {
    (void)lane;
    v += DPP_X1(v); v += DPP_X2(v); v += DPP_X7(v); v += DPP_X8(v);
    return xrow16_sum(v);
}
#define wave_sum(v) wave_sum_l(v, lane)
__device__ __forceinline__ float fexp(float x) { return FAST_EXP2(x * LOG2E); }
__device__ __forceinline__ float sigmoid_f(float x) { return FAST_RCP(1.f + fexp(-x)); }
__device__ __forceinline__ float log_sigmoid_f(float x) { return fminf(x, 0.f) - 0.6931471805599453f * FAST_LOG2(1.f + fexp(-fabsf(x))); }
__device__ __forceinline__ float gelu_tanh_f(float x) { const float u = 0.7978845608028654f * (x + 0.044715f * x * x * x); return x * FAST_RCP(1.f + fexp(-2.f * u)); }
__device__ __forceinline__ float silu_f(float x) { return x * FAST_RCP(1.f + fexp(-x)); }
__device__ __forceinline__ float neg_expm1_f(float x) {
    const float ser = -x * (1.f + x * (0.5f + x * (0.16666667f + x * (0.041666668f + x * (0.008333334f + x * 0.0013888889f)))));
    return (x > -0.35f) ? ser : (1.f - fexp(x));
}

struct RmIdent { __device__ __forceinline__ int operator()(int n) const { return n; } };
struct RmWin { __device__ __forceinline__ int operator()(int n) const { return n < C_FA ? n : (n < C_FA + 6 ? -1 : n - 6); } };
struct RmGu { int kind; __device__ __forceinline__ int operator()(int f) const { return (f >> 7) * 256 + ((f >> 6) & 1) * 128 + ((f >> 4) & 3) * 32 + kind * 16 + (f & 15); } };
struct RmOff { int off; __device__ __forceinline__ int operator()(int n) const { return n + off; } };

template <class RM>
__device__ __forceinline__ void convert_tile(const float* src, int ld, int K, int Nsrc, int k0, int n0, bf16_t* dst, const RM& rm, float* T, int tid) {
    {
        const int nn = tid & 255, kh = (tid >> 8) * 32, n = n0 + nn;
        const float* sp = src + (size_t)(k0 + kh) * ld + n;
        float v[32];
#pragma unroll
        for (int i = 0; i < 32; ++i) v[i] = (n < Nsrc) ? sp[(size_t)i * ld] : 0.f;
#pragma unroll
        for (int i = 0; i < 32; ++i) T[(kh + i) * 257 + nn] = v[i];
    }
    __syncthreads();
#pragma unroll
    for (int q = 0; q < 4; ++q) {
        const int nn = q * 64 + (tid >> 3), kc = (tid & 7) * 8, n = n0 + nn;
        const int row = (n < Nsrc) ? rm(n) : -1;
        if (row >= 0) {
            u32x4 o;
            o.x = pack2(T[(kc + 0) * 257 + nn], T[(kc + 1) * 257 + nn]); o.y = pack2(T[(kc + 2) * 257 + nn], T[(kc + 3) * 257 + nn]);
            o.z = pack2(T[(kc + 4) * 257 + nn], T[(kc + 5) * 257 + nn]); o.w = pack2(T[(kc + 6) * 257 + nn], T[(kc + 7) * 257 + nn]);
            *(u32x4*)(dst + (size_t)row * K + k0 + kc) = o;
        }
    }
    __syncthreads();
}
template <class RM>
__device__ __forceinline__ void convert_tile_v4(const float* src, int ld, int K, int k0, int n0, bf16_t* dst, const RM& rm, float* T, int tid_in) {
    int tid = tid_in; OPAQUE(tid);
    {
        const int w = tid >> 6, l4 = (tid & 63) * 4;
        const float* sp = src + (size_t)(k0 + w * 8) * ld + n0 + l4;
        f32x4 v[8];
#pragma unroll
        for (int i = 0; i < 8; ++i) v[i] = *(const f32x4*)(sp + (size_t)i * ld);
#pragma unroll
        for (int i = 0; i < 8; ++i) { float* tp = T + (w * 8 + i) * 257 + l4; tp[0] = v[i][0]; tp[1] = v[i][1]; tp[2] = v[i][2]; tp[3] = v[i][3]; }
    }
    __syncthreads();
#pragma unroll
    for (int q = 0; q < 4; ++q) {
        const int nn = q * 64 + (tid >> 3), kc = (tid & 7) * 8, n = n0 + nn;
        const int row = rm(n);
        u32x4 o;
        o.x = pack2(T[(kc + 0) * 257 + nn], T[(kc + 1) * 257 + nn]); o.y = pack2(T[(kc + 2) * 257 + nn], T[(kc + 3) * 257 + nn]);
        o.z = pack2(T[(kc + 4) * 257 + nn], T[(kc + 5) * 257 + nn]); o.w = pack2(T[(kc + 6) * 257 + nn], T[(kc + 7) * 257 + nn]);
        *(u32x4*)(dst + (size_t)row * K + k0 + kc) = o;
    }
    __syncthreads();
}
template <class RM>
__device__ __forceinline__ void convert_mats(const float* src, size_t sstride, int nmat, int ld, int K, int Nsrc, bf16_t* dst, size_t dstride, const RM& rm,
                                             float* T, int tid, int bid, int G) {
    const int tk = K / 64, tn = (Nsrc + 255) / 256, per = tk * tn, total = nmat * per;
    for (int t = bid; t < total; t += G) {
        const int mi = t / per, r = t % per;
        convert_tile(src + (size_t)mi * sstride, ld, K, Nsrc, (r / tn) * 64, (r % tn) * 256, dst + (size_t)mi * dstride, rm, T, tid);
    }
}

constexpr int NCONV = DEPTH * 768;
__device__ __forceinline__ void moe_conv_chunk(const Params& p, int cid, bf16_t* WguT_, bf16_t* WdT_, float* T, int tid) {
    const int l = cid / 768, r = cid % 768, kind = r >> 8, t0 = (r & 255) * 8;
    for (int t = t0; t < t0 + 8; ++t) {
        const int mi = t >> 6, rr = t & 63;
        if (kind < 2) {
            const float* src = p.in[kind == 0 ? I_WGATE : I_WUP] + ((size_t)l * NEXP + mi) * D * DFF;
            convert_tile_v4(src, DFF, D, (rr >> 1) * 64, (rr & 1) * 256, WguT_ + ((size_t)l * NEXP + mi) * 1024 * D, RmGu{kind}, T, tid);
        } else {
            const float* src = p.in[I_WDOWN] + ((size_t)l * NEXP + mi) * DFF * D;
            convert_tile_v4(src, D, DFF, (rr >> 3) * 64, (rr & 7) * 256, WdT_ + ((size_t)l * NEXP + mi) * D * DFF, RmIdent{}, T, tid);
        }
    }
}

constexpr int BK = 64, HTB = 128 * 64 * 2;
__device__ __forceinline__ int lds_byte(int r, int c) {
    const int st = (r >> 4) * 2 + (c >> 5), rr = r & 15, cc = c & 31, ob = rr * 64 + cc * 2;
    return st * 1024 + (ob ^ (((ob >> 9) & 1) << 5));
}
__device__ __forceinline__ void stage_rc(int b, int& R, int& C) {
    const int st = b / 1024, sb = b % 1024, swz = sb ^ (((sb >> 9) & 1) << 5);
    R = (st >> 1) * 16 + swz / 64; C = (st & 1) * 32 + (swz % 64) / 2;
}
template <bool GATHER>
__device__ __forceinline__ void gemm_tile(const bf16_t* A, int arow0, const unsigned (&aoff)[2][2], const bf16_t* Bt, int brow0, int K,
                                          unsigned char* shm, f32x4 (&acc)[2][2][4][2], int tid_in) {
    int tid = tid_in; OPAQUE(tid);
    unsigned toff; { int R0, C0; stage_rc(tid * 16, R0, C0); toff = (unsigned)(R0 * K + C0); }
#define SA(b, h) (shm + ((b) * 2 + (h)) * HTB)
#define SB(b, h) (shm + (4 + (b) * 2 + (h)) * HTB)
#define STAGE_B(P, h, kt) do { _Pragma("unroll") for (int _i = 0; _i < 2; ++_i) GLDS16(Bt + ((size_t)(brow0 + (h) * 128 + _i * 64) * K + (size_t)(kt) * BK) + toff, (P) + tid * 16 + _i * 8192); } while (0)
#define STAGE_A(P, h, kt) do { _Pragma("unroll") for (int _i = 0; _i < 2; ++_i) { \
    if (GATHER) GLDS16(A + (size_t)(kt) * BK + aoff[h][_i], (P) + tid * 16 + _i * 8192); \
    else GLDS16(A + ((size_t)(arow0 + (h) * 128 + _i * 64) * K + (size_t)(kt) * BK) + toff, (P) + tid * 16 + _i * 8192); } } while (0)
#define LDA(dst, b, h) _Pragma("unroll") for (int m = 0; m < 4; ++m) _Pragma("unroll") for (int k = 0; k < 2; ++k) \
    dst[m][k] = *reinterpret_cast<const bf16x8*>(SA(b, h) + lds_byte(wr * 64 + m * 16 + fr, k * 32 + fq * 8))
#define LDB(dst, b, h) _Pragma("unroll") for (int n = 0; n < 2; ++n) _Pragma("unroll") for (int k = 0; k < 2; ++k) \
    dst[n][k] = *reinterpret_cast<const bf16x8*>(SB(b, h) + lds_byte(wc * 32 + n * 16 + fr, k * 32 + fq * 8))
#define MMA(ai, bj, At, Bx) do { SETPRIO(1); \
    _Pragma("unroll") for (int m = 0; m < 4; ++m) _Pragma("unroll") for (int n = 0; n < 2; ++n) _Pragma("unroll") for (int k = 0; k < 2; ++k) \
      acc[ai][bj][m][n] = MFMA16(At[m][k], Bx[n][k], acc[ai][bj][m][n]); \
    SETPRIO(0); } while (0)
    int wid = tid >> 6, lane = tid & 63, wr = wid >> 2, wc = wid & 3, fr = lane & 15, fq = lane >> 4;
#pragma unroll
    for (int a = 0; a < 2; ++a)
#pragma unroll
        for (int b = 0; b < 2; ++b)
#pragma unroll
            for (int m = 0; m < 4; ++m)
#pragma unroll
                for (int n = 0; n < 2; ++n) acc[a][b][m][n] = (f32x4){0.f, 0.f, 0.f, 0.f};
    bf16x8 At[4][2], B0[2][2], B1[2][2];
    const int nt = K / BK;
    STAGE_B(SB(0, 0), 0, 0); STAGE_A(SA(0, 0), 0, 0);
    STAGE_B(SB(0, 1), 1, 0); STAGE_A(SA(0, 1), 1, 0);
    if (wr == 1) BAR();
    WAIT_V(4); BAR();
    STAGE_B(SB(1, 0), 0, 1); STAGE_A(SA(1, 0), 0, 1); STAGE_B(SB(1, 1), 1, 1);
    WAIT_V(6); BAR();
    for (int t = 0; t < nt - 2; t += 2) {
        LDB(B0, 0, 0); SCHED(); LDA(At, 0, 0); STAGE_A(SA(1, 1), 1, t + 1);
        WAIT_L(8); BAR(); WAIT_L(0); MMA(0, 0, At, B0); BAR(); SCHED();
        LDB(B1, 0, 1); STAGE_B(SB(0, 0), 0, t + 2);
        BAR(); WAIT_L(0); MMA(0, 1, At, B1); BAR();
        LDA(At, 0, 1); STAGE_A(SA(0, 0), 0, t + 2);
        BAR(); WAIT_L(0); MMA(1, 0, At, B0); BAR(); SCHED();
        STAGE_B(SB(0, 1), 1, t + 2);
        WAIT_V(6); BAR(); MMA(1, 1, At, B1); BAR();
        LDB(B0, 1, 0); SCHED(); LDA(At, 1, 0); STAGE_A(SA(0, 1), 1, t + 2);
        WAIT_L(8); BAR(); WAIT_L(0); MMA(0, 0, At, B0); BAR(); SCHED();
        LDB(B1, 1, 1); STAGE_B(SB(1, 0), 0, t + 3);
        BAR(); WAIT_L(0); MMA(0, 1, At, B1); BAR();
        LDA(At, 1, 1); STAGE_A(SA(1, 0), 0, t + 3);
        BAR(); WAIT_L(0); MMA(1, 0, At, B0); BAR(); SCHED();
        STAGE_B(SB(1, 1), 1, t + 3);
        WAIT_V(6); BAR(); MMA(1, 1, At, B1); BAR();
    }
    OPAQUE(tid); wid = tid >> 6; lane = tid & 63; wr = wid >> 2; wc = wid & 3; fr = lane & 15; fq = lane >> 4;
    { LDB(B0, 0, 0); WAIT_V(0); LDA(At, 0, 0); STAGE_A(SA(1, 1), 1, nt - 1);
      BAR(); WAIT_L(0); MMA(0, 0, At, B0); BAR();
      LDB(B1, 0, 1); BAR(); WAIT_L(0); MMA(0, 1, At, B1); BAR();
      LDA(At, 0, 1); WAIT_V(4); BAR(); WAIT_L(0); MMA(1, 0, At, B0); MMA(1, 1, At, B1); BAR(); }
    { LDB(B0, 1, 0); LDA(At, 1, 0); WAIT_V(2); BAR(); WAIT_L(0); MMA(0, 0, At, B0); BAR();
      LDB(B1, 1, 1); WAIT_V(0); BAR(); WAIT_L(0); MMA(0, 1, At, B1); BAR();
      LDA(At, 1, 1); BAR(); WAIT_L(0); MMA(1, 0, At, B0); MMA(1, 1, At, B1); BAR(); }
    if (wr == 0) BAR();
#undef SA
#undef SB
#undef STAGE_A
#undef STAGE_B
#undef LDA
#undef LDB
#undef MMA
}
__device__ __forceinline__ void stage_geom(int tid, int (&R)[2], int (&C)[2]) {
#pragma unroll
    for (int i = 0; i < 2; ++i) stage_rc(tid * 16 + i * 8192, R[i], C[i]);
}

constexpr int ATT_KBUF = 0, ATT_VBUF = 32768, ATT_CBUF = 65536;
template <int KIND>
__device__ __forceinline__ void attn_unit(const bf16_t* Q, const bf16_t* Kg, const bf16_t* VT, const float* cum2, const float* kmx, int qb, bf16_t* concat, int ccol0,
                                          float lam, float osc, const float* subg, unsigned char* lds, int tid) {
    const int lane = tid & 63, wave = tid >> 6, r16 = lane & 15, q4 = lane >> 4;
    const int q0w = qb * 128 + wave * 16, myq = q0w + r16;
    const int ntiles = 2 * qb + 2;
    const int wlimit = (KIND == 0) ? ((q0w + 15) >> 6) : (q0w >> 6);
    constexpr int NMAP = (KIND == 0) ? 1 : 2, NKS = (KIND == 0) ? 4 : 2;
    bf16x8 qf[NMAP][NKS];
#pragma unroll
    for (int mp = 0; mp < NMAP; ++mp)
#pragma unroll
        for (int ks = 0; ks < NKS; ++ks) qf[mp][ks] = *(const bf16x8*)(Q + (size_t)myq * 128 + mp * 64 + ks * 32 + q4 * 8);
    const float cq = (KIND == 0) ? cum2[myq] : 0.f;
    int kt0 = 0;
    if (KIND == 0) {
        float* wmax = (float*)(lds + ATT_CBUF + 512); int* kst = (int*)(lds + ATT_CBUF + 576);
        float qs = 0.f;
#pragma unroll
        for (int ks = 0; ks < NKS; ++ks)
#pragma unroll
            for (int j = 0; j < 8; ++j) { const float v = bf2f((bf16_t)qf[0][ks][j]); qs += v * v; }
        qs = xrow16_sum(qs);
        qs = fmaxf(qs, SHX(qs, 1)); qs = fmaxf(qs, SHX(qs, 2)); qs = fmaxf(qs, SHX(qs, 4)); qs = fmaxf(qs, SHX(qs, 8));
        if (lane == 0) wmax[wave] = qs;
        if (tid == 0) *kst = 2 * qb;
        __syncthreads();
        float qm = wmax[0];
#pragma unroll
        for (int w = 1; w < 8; ++w) qm = fmaxf(qm, wmax[w]);
        qm = sqrtf(qm) * 1.01f;
        const float kd = sqrtf(fmaxf(kmx[2 * qb], kmx[2 * qb + 1])) * 1.01f;
        if (tid < 2 * qb) {
            const float bias = cum2[qb * 128] - cum2[tid * 64 + 63];
            const bool skip = bias + qm * (sqrtf(kmx[tid]) * 1.01f + kd) < -40.f;
            if (!skip) atomic_min_int(kst, tid);
        }
        __syncthreads();
        kt0 = RFL(*kst);
    }
    f32x4 ot[NMAP][8];
    float mrun[NMAP], lsum[NMAP];
#pragma unroll
    for (int mp = 0; mp < NMAP; ++mp) { mrun[mp] = -INFINITY; lsum[mp] = 0.f;
#pragma unroll
        for (int mo = 0; mo < 8; ++mo) ot[mp][mo] = (f32x4){0.f, 0.f, 0.f, 0.f}; }
    u32x4 sk[2], sv[2]; float sc = 0.f;
    const u32x4* kg = (const u32x4*)Kg; const u32x4* vg = (const u32x4*)VT;
#pragma unroll
    for (int i = 0; i < 2; ++i) { sk[i] = kg[(size_t)kt0 * 1024 + tid + i * 512]; sv[i] = vg[(size_t)kt0 * 1024 + tid + i * 512]; }
    if (KIND == 0 && tid < 64) sc = cum2[kt0 * 64 + tid];
    for (int kt = kt0; kt < ntiles; ++kt) {
        unsigned char* kb = lds + ATT_KBUF + (kt & 1) * 16384;
        unsigned char* vb = lds + ATT_VBUF + (kt & 1) * 16384;
        float* cb = (float*)(lds + ATT_CBUF + (kt & 1) * 256);
#pragma unroll
        for (int i = 0; i < 2; ++i) {
            const int g = tid + i * 512;
            { const int row = g >> 4, c = g & 15; *(u32x4*)(kb + row * 256 + ((c ^ (row & 15)) << 4)) = sk[i]; }
            { const int d = g >> 3, c = g & 7; *(u32x4*)(vb + d * 128 + ((c ^ ((d >> 1) & 7)) << 4)) = sv[i]; }
        }
        if (KIND == 0 && tid < 64) cb[tid] = sc;
        __syncthreads();
        if (kt + 1 < ntiles) {
#pragma unroll
            for (int i = 0; i < 2; ++i) { sk[i] = kg[(size_t)(kt + 1) * 1024 + tid + i * 512]; sv[i] = vg[(size_t)(kt + 1) * 1024 + tid + i * 512]; }
            if (KIND == 0 && tid < 64) sc = cum2[(kt + 1) * 64 + tid];
        }
        if (kt <= wlimit) {
#pragma unroll
            for (int mp = 0; mp < NMAP; ++mp) {
                bf16x8 kf[4][NKS], vfa[8];
#pragma unroll
                for (int m = 0; m < 4; ++m)
#pragma unroll
                    for (int ks = 0; ks < NKS; ++ks) { const int c = (KIND == 0 ? 0 : mp * 8) + ks * 4 + q4; kf[m][ks] = *(const bf16x8*)(kb + (m * 16 + r16) * 256 + ((c ^ r16) << 4)); }
#pragma unroll
                for (int mo = 0; mo < 8; ++mo) { const int d = mo * 16 + r16; vfa[mo] = *(const bf16x8*)(vb + d * 128 + (((0 * 4 + q4) ^ ((d >> 1) & 7)) << 4)); }
                SCHED();
                f32x4 st[4];
#pragma unroll
                for (int m = 0; m < 4; ++m) st[m] = (f32x4){0.f, 0.f, 0.f, 0.f};
#pragma unroll
                for (int ks = 0; ks < NKS; ++ks)
#pragma unroll
                    for (int m = 0; m < 4; ++m) st[m] = MFMA16(kf[m][ks], qf[mp][ks], st[m]);
                SCHED();
                float mx = -INFINITY;
#pragma unroll
                for (int m = 0; m < 4; ++m) {
                    if (KIND == 0) {
                        const f32x4 ck = *(const f32x4*)(cb + m * 16 + 4 * q4);
#pragma unroll
                        for (int j = 0; j < 4; ++j) {
                            float y = st[m][j] + (cq - ck[j]);
                            if (kt * 64 + m * 16 + 4 * q4 + j > myq) y = -INFINITY;
                            st[m][j] = y;
                        }
                    }
#pragma unroll
                    for (int j = 0; j < 4; ++j) mx = fmaxf(mx, st[m][j]);
                }
                mx = xrow16_max(mx);
                const float mnew = fmaxf(mrun[mp], mx);
                const float alpha = FAST_EXP2(mrun[mp] - mnew);
                mrun[mp] = mnew;
                float ps = 0.f;
#pragma unroll
                for (int m = 0; m < 4; ++m)
#pragma unroll
                    for (int j = 0; j < 4; ++j) { const float pv = FAST_EXP2(st[m][j] - mnew); st[m][j] = pv; ps += pv; }
                lsum[mp] = lsum[mp] * alpha + ps;
#pragma unroll
                for (int mo = 0; mo < 8; ++mo) ot[mp][mo] *= alpha;
                bf16x8 pf[2];
#pragma unroll
                for (int kk = 0; kk < 2; ++kk) {
                    u32x4 pw;
                    pw.x = pack2(st[2 * kk][0], st[2 * kk][1]); pw.y = pack2(st[2 * kk][2], st[2 * kk][3]);
                    pw.z = pack2(st[2 * kk + 1][0], st[2 * kk + 1][1]); pw.w = pack2(st[2 * kk + 1][2], st[2 * kk + 1][3]);
                    pf[kk] = __builtin_bit_cast(bf16x8, pw);
                }
                bf16x8 vfb[8];
#pragma unroll
                for (int mo = 0; mo < 8; ++mo) { const int d = mo * 16 + r16; vfb[mo] = *(const bf16x8*)(vb + d * 128 + (((1 * 4 + q4) ^ ((d >> 1) & 7)) << 4)); }
                SCHED();
#pragma unroll
                for (int mo = 0; mo < 8; ++mo) ot[mp][mo] = MFMA16(vfa[mo], pf[0], ot[mp][mo]);
                SCHED();
#pragma unroll
                for (int mo = 0; mo < 8; ++mo) ot[mp][mo] = MFMA16(vfb[mo], pf[1], ot[mp][mo]);
            }
        }
    }
    float inv[NMAP];
#pragma unroll
    for (int mp = 0; mp < NMAP; ++mp) { float l = lsum[mp]; l = xrow16_sum(l); inv[mp] = 1.f / l; }
    if (KIND == 0) {
#pragma unroll
        for (int mo = 0; mo < 8; ++mo) {
            u32x2 o; o.x = pack2(ot[0][mo][0] * inv[0], ot[0][mo][1] * inv[0]); o.y = pack2(ot[0][mo][2] * inv[0], ot[0][mo][3] * inv[0]);
            *(u32x2*)(concat + (size_t)myq * D + ccol0 + mo * 16 + 4 * q4) = o;
        }
    } else {
        float ss = 0.f;
#pragma unroll
        for (int mo = 0; mo < 8; ++mo)
#pragma unroll
            for (int j = 0; j < 4; ++j) { const float v = ot[0][mo][j] * inv[0] - lam * (ot[NMAP - 1][mo][j] * inv[NMAP - 1]); ot[0][mo][j] = v; ss += v * v; }
        ss = xrow16_sum(ss);
        const float rs = osc / sqrtf(ss * (1.f / 128.f) + LN_EPS);
#pragma unroll
        for (int mo = 0; mo < 8; ++mo) {
            const f32x4 g = *(const f32x4*)(subg + mo * 16 + 4 * q4);
            u32x2 o; o.x = pack2(ot[0][mo][0] * rs * g[0], ot[0][mo][1] * rs * g[1]); o.y = pack2(ot[0][mo][2] * rs * g[2], ot[0][mo][3] * rs * g[3]);
            *(u32x2*)(concat + (size_t)myq * D + ccol0 + mo * 16 + 4 * q4) = o;
        }
    }
    __syncthreads();
}

__device__ __forceinline__ int dpart_row(int c, int q) { return c * (S - DCH * 64) - (DCH * 32) * c * (c - 1) + q; }
__device__ __forceinline__ void attn_dmap_unit(const bf16_t* Qh, const bf16_t* Kh, const bf16_t* VTh, int mp, int qb, int t0, int t1,
                                               bf16_t* Op, float* ML, int c, float bnd, unsigned char* lds, int tid) {
    const bool fixedref = (bnd <= 60.f);
    const int lane = tid & 63, wave = tid >> 6, r16 = lane & 15, q4 = lane >> 4;
    const int q0w = qb * 256 + wave * 32;
    const int wlimit = q0w >> 6;
    bf16x8 qf[2][2];
#pragma unroll
    for (int n = 0; n < 2; ++n)
#pragma unroll
        for (int ks = 0; ks < 2; ++ks) qf[n][ks] = *(const bf16x8*)(Qh + (size_t)(q0w + n * 16 + r16) * 128 + mp * 64 + ks * 32 + q4 * 8);
    f32x4 ot[8][2];
    float mrun[2] = {-INFINITY, -INFINITY}, lsum[2] = {0.f, 0.f};
    if (fixedref) { mrun[0] = bnd; mrun[1] = bnd; }
    const float stinit = fixedref ? -bnd : 0.f;
#pragma unroll
    for (int mo = 0; mo < 8; ++mo) { ot[mo][0] = (f32x4){0.f, 0.f, 0.f, 0.f}; ot[mo][1] = (f32x4){0.f, 0.f, 0.f, 0.f}; }
    u32x4 sk, sv[2];
    const u32x4* kg = (const u32x4*)Kh; const u32x4* vg = (const u32x4*)VTh;
    const int krow = tid >> 3, kc8 = tid & 7;
    sk = kg[(size_t)t0 * 1024 + krow * 16 + mp * 8 + kc8];
#pragma unroll
    for (int i = 0; i < 2; ++i) sv[i] = vg[(size_t)t0 * 1024 + tid + i * 512];
    for (int kt = t0; kt < t1; ++kt) {
        unsigned char* kb = lds + (kt & 1) * 8192;
        unsigned char* vb = lds + 16384 + (kt & 1) * 16384;
        *(u32x4*)(kb + krow * 128 + ((kc8 ^ ((krow >> 1) & 7)) << 4)) = sk;
#pragma unroll
        for (int i = 0; i < 2; ++i) { const int g = tid + i * 512, d = g >> 3, cc = g & 7; *(u32x4*)(vb + d * 128 + ((cc ^ ((d >> 1) & 7)) << 4)) = sv[i]; }
        __syncthreads();
        if (kt + 1 < t1) {
            sk = kg[(size_t)(kt + 1) * 1024 + krow * 16 + mp * 8 + kc8];
#pragma unroll
            for (int i = 0; i < 2; ++i) sv[i] = vg[(size_t)(kt + 1) * 1024 + tid + i * 512];
        }
        if (kt <= wlimit) {
            bf16x8 kf[4][2], vfa[8];
#pragma unroll
            for (int m = 0; m < 4; ++m)
#pragma unroll
                for (int ks = 0; ks < 2; ++ks) kf[m][ks] = *(const bf16x8*)(kb + (m * 16 + r16) * 128 + (((ks * 4 + q4) ^ ((r16 >> 1) & 7)) << 4));
#pragma unroll
            for (int mo = 0; mo < 8; ++mo) { const int d = mo * 16 + r16; vfa[mo] = *(const bf16x8*)(vb + d * 128 + (((0 * 4 + q4) ^ ((d >> 1) & 7)) << 4)); }
            SCHED();
            f32x4 st[4][2];
#pragma unroll
            for (int m = 0; m < 4; ++m) { st[m][0] = (f32x4){stinit, stinit, stinit, stinit}; st[m][1] = (f32x4){stinit, stinit, stinit, stinit}; }
            SETPRIO(1);
#pragma unroll
            for (int ks = 0; ks < 2; ++ks)
#pragma unroll
                for (int m = 0; m < 4; ++m) { st[m][0] = MFMA16(kf[m][ks], qf[0][ks], st[m][0]); st[m][1] = MFMA16(kf[m][ks], qf[1][ks], st[m][1]); }
            SETPRIO(0);
            SCHED();
            float alpha[2] = {1.f, 1.f};
            if (fixedref) {
#pragma unroll
                for (int n = 0; n < 2; ++n) {
                    float ps = 0.f;
#pragma unroll
                    for (int m = 0; m < 4; ++m)
#pragma unroll
                        for (int j = 0; j < 4; ++j) { const float pv = FAST_EXP2(st[m][n][j]); st[m][n][j] = pv; ps += pv; }
                    lsum[n] += ps;
                }
            } else
#pragma unroll
            for (int n = 0; n < 2; ++n) {
                float mx = -INFINITY;
#pragma unroll
                for (int m = 0; m < 4; ++m)
#pragma unroll
                    for (int j = 0; j < 4; ++j) mx = fmaxf(mx, st[m][n][j]);
                mx = xrow16_max(mx);
                const float mnew = fmaxf(mrun[n], mx);
                alpha[n] = FAST_EXP2(mrun[n] - mnew);
                mrun[n] = mnew;
                float ps = 0.f;
#pragma unroll
                for (int m = 0; m < 4; ++m)
#pragma unroll
                    for (int j = 0; j < 4; ++j) { const float pv = FAST_EXP2(st[m][n][j] - mnew); st[m][n][j] = pv; ps += pv; }
                lsum[n] = lsum[n] * alpha[n] + ps;
            }
            if (ANY_LANE(alpha[0] != 1.f)) {
#pragma unroll
                for (int mo = 0; mo < 8; ++mo) ot[mo][0] *= alpha[0];
            }
            if (ANY_LANE(alpha[1] != 1.f)) {
#pragma unroll
                for (int mo = 0; mo < 8; ++mo) ot[mo][1] *= alpha[1];
            }
            bf16x8 pf[2][2];
#pragma unroll
            for (int kk = 0; kk < 2; ++kk)
#pragma unroll
                for (int n = 0; n < 2; ++n) {
                    u32x4 pw;
                    pw.x = pack2(st[2 * kk][n][0], st[2 * kk][n][1]); pw.y = pack2(st[2 * kk][n][2], st[2 * kk][n][3]);
                    pw.z = pack2(st[2 * kk + 1][n][0], st[2 * kk + 1][n][1]); pw.w = pack2(st[2 * kk + 1][n][2], st[2 * kk + 1][n][3]);
                    pf[kk][n] = __builtin_bit_cast(bf16x8, pw);
                }
            bf16x8 vfb[8];
#pragma unroll
            for (int mo = 0; mo < 8; ++mo) { const int d = mo * 16 + r16; vfb[mo] = *(const bf16x8*)(vb + d * 128 + (((1 * 4 + q4) ^ ((d >> 1) & 7)) << 4)); }
            SCHED();
            SETPRIO(1);
#pragma unroll
            for (int mo = 0; mo < 8; ++mo) { ot[mo][0] = MFMA16(vfa[mo], pf[0][0], ot[mo][0]); ot[mo][1] = MFMA16(vfa[mo], pf[0][1], ot[mo][1]); }
            SCHED();
#pragma unroll
            for (int mo = 0; mo < 8; ++mo) { ot[mo][0] = MFMA16(vfb[mo], pf[1][0], ot[mo][0]); ot[mo][1] = MFMA16(vfb[mo], pf[1][1], ot[mo][1]); }
            SETPRIO(0);
        }
    }
    if (q0w >= DCH * 64 * c)
#pragma unroll
    for (int n = 0; n < 2; ++n) {
        float l = lsum[n]; l = xrow16_sum(l);
        const int row = dpart_row(c, q0w + n * 16 + r16);
#pragma unroll
        for (int mo = 0; mo < 8; ++mo) {
            u32x2 o; o.x = pack2(ot[mo][n][0], ot[mo][n][1]); o.y = pack2(ot[mo][n][2], ot[mo][n][3]);
            *(u32x2*)(Op + (size_t)(row * 128 + mo * 16 + 4 * q4)) = o;
        }
        if (q4 == 0) { ML[row * 2] = mrun[n]; ML[row * 2 + 1] = l; }
    }
    __syncthreads();
}

__device__ __forceinline__ void lru_unit_a(int chunk, int grp, int l, const Params& p, const bf16_t* Xr, const bf16_t* WaiT, float* hloc, float* ploc, float* sumA, float* sumH,
                                           unsigned char* lds, int tid) {
    const int lane = tid & 63, wave = tid >> 6, r16 = lane & 15, q4 = lane >> 4;
    unsigned char* XCB = lds; float* XU = (float*)(lds + 16384); float* LA = (float*)(lds + 49152); float* ENDS = (float*)(lds + 81920);
    const int t0 = chunk * 64, ch0 = grp * 128;
    bf16x8 bfr[2][4];
#pragma unroll
    for (int g = 0; g < 2; ++g)
#pragma unroll
        for (int ks = 0; ks < 4; ++ks) bfr[g][ks] = *(const bf16x8*)(WaiT + ((size_t)grp * 256 + g * 128 + wave * 16 + r16) * 128 + ks * 32 + q4 * 8);
    const int chg = ch0 + wave * 16 + r16;
    const float ba = p.in[I_BA][(size_t)l * LRU_W + chg], bi = p.in[I_BI][(size_t)l * LRU_W + chg];
    const float lam_raw = p.in[I_LAM][(size_t)l * LRU_W + chg];
    {
        const int c = tid & 127, tq = tid >> 7, ch = ch0 + c;
        const float* cw = p.in[I_CONVW] + (size_t)l * 4 * LRU_W + ch; const float cb = p.in[I_CONVB][(size_t)l * LRU_W + ch];
        const float w0 = cw[0], w1 = cw[LRU_W], w2 = cw[2 * LRU_W], w3 = cw[3 * LRU_W];
        const int ts = t0 + tq * 16;
        float x0 = (ts - 3 >= 0) ? bf2f(Xr[(size_t)(ts - 3) * LRU_W + ch]) : 0.f;
        float x1 = (ts - 2 >= 0) ? bf2f(Xr[(size_t)(ts - 2) * LRU_W + ch]) : 0.f;
        float x2 = (ts - 1 >= 0) ? bf2f(Xr[(size_t)(ts - 1) * LRU_W + ch]) : 0.f;
#pragma unroll
        for (int i = 0; i < 16; ++i) {
            const float x3 = bf2f(Xr[(size_t)(ts + i) * LRU_W + ch]);
            const float v = cb + w0 * x0 + w1 * x1 + w2 * x2 + w3 * x3;
            const int row = tq * 16 + i;
            XU[row * 128 + c] = v;
            *(bf16_t*)(XCB + row * 256 + (((c >> 3) ^ (row & 15)) << 4) + (c & 7) * 2) = f2bf(v);
            x0 = x1; x1 = x2; x2 = x3;
        }
    }
    __syncthreads();
    {
        const float lsl = 8.0f * log_sigmoid_f(lam_raw);
#pragma unroll
        for (int mt = 0; mt < 4; ++mt) {
            f32x4 ga = (f32x4){0.f, 0.f, 0.f, 0.f}, gi = (f32x4){0.f, 0.f, 0.f, 0.f};
#pragma unroll
            for (int ks = 0; ks < 4; ++ks) {
                const bf16x8 af = *(const bf16x8*)(XCB + (mt * 16 + r16) * 256 + (((ks * 4 + q4) ^ r16) << 4));
                ga = MFMA16(af, bfr[0][ks], ga); gi = MFMA16(af, bfr[1][ks], gi);
            }
#pragma unroll
            for (int j = 0; j < 4; ++j) {
                const int row = mt * 16 + 4 * q4 + j, idx = row * 128 + wave * 16 + r16;
                const float r = sigmoid_f(ga[j] + ba), ig = sigmoid_f(gi[j] + bi);
                const float log_a = lsl * r;
                LA[idx] = fexp(log_a);
                XU[idx] = sqrtf(neg_expm1_f(2.f * log_a)) * (ig * XU[idx]);
            }
        }
    }
    __syncthreads();
    {
        const int c = tid & 127, tq = tid >> 7, ch = ch0 + c;
        float h = 0.f, P = 1.f;
#pragma unroll
        for (int i = 0; i < 16; ++i) { const int idx = (tq * 16 + i) * 128 + c; const float a = LA[idx]; h = a * h + XU[idx]; P *= a; XU[idx] = h; LA[idx] = P; }
        ENDS[tq * 128 + c] = P; ENDS[512 + tq * 128 + c] = h;
        __syncthreads();
        float cin = 0.f, pin = 1.f;
        for (int s = 0; s < tq; ++s) { const float Ps = ENDS[s * 128 + c], hs = ENDS[512 + s * 128 + c]; cin = Ps * cin + hs; pin *= Ps; }
#pragma unroll
        for (int i = 0; i < 16; ++i) {
            const int idx = (tq * 16 + i) * 128 + c; const size_t gi = (size_t)(t0 + tq * 16 + i) * LRU_W + ch;
            const float Pl = LA[idx], hl = XU[idx];
            ((unsigned*)hloc)[gi] = pack2(hl + Pl * cin, Pl * pin);
        }
        if (tq == 3) { const float Pl = LA[63 * 128 + c], hl = XU[63 * 128 + c]; sumA[(size_t)chunk * LRU_W + ch] = Pl * pin; sumH[(size_t)chunk * LRU_W + ch] = hl + Pl * cin; }
    }
    __syncthreads();
}

__device__ __forceinline__ void moe_prefix(const int* cntb_, int G, unsigned char* lds, int tid) {
    int* tmp = (int*)lds; int* ctot = (int*)(lds + LDS_MISC + M_CTOT); int* coff = (int*)(lds + LDS_MISC + M_COFF);
    unsigned short* pre16 = (unsigned short*)(lds + LDS_MISC + M_PRE16);
    const int e = tid & 31, part = tid >> 5, PB = (G + 15) / 16;
    int sm = 0;
    for (int i = 0; i < PB; ++i) { const int b = part * PB + i; if (b < G) sm += cntb_[b * 32 + e]; }
    tmp[part * 32 + e] = sm;
    __syncthreads();
    int run = 0;
    for (int q = 0; q < part; ++q) run += tmp[q * 32 + e];
    for (int i = 0; i < PB; ++i) { const int b = part * PB + i; if (b < G) { pre16[e * 257 + b] = (unsigned short)run; run += cntb_[b * 32 + e]; } }
    if (part == 15) { ctot[e] = run; pre16[e * 257 + G] = (unsigned short)run; }
    __syncthreads();
    if (tid == 0) { int o = 0; for (int q = 0; q < 32; ++q) { coff[q] = o; o += ctot[q]; } coff[32] = o; }
    __syncthreads();
}
__device__ __forceinline__ void moe_rowtable(const int* ltok_, const float* lw_, const int* lslot_, int e, int m0, int c_e, int G, int segcap, unsigned char* lds, int tid_in) {
    int tid = tid_in; OPAQUE(tid);
    const unsigned short* pre = (const unsigned short*)(lds + LDS_MISC + M_PRE16) + e * 257;
    int* rtok = (int*)(lds + LDS_MISC + M_RTOK); float* rw = (float*)(lds + LDS_MISC + M_RW); int* rslot = (int*)(lds + LDS_MISC + M_RSLOT);
    if (tid < 256) {
        const int g = m0 + tid;
        int tk = 0, sl = 0; float w = 0.f;
        if (g < c_e) {
            int lo = 0, hi = G;
            while (hi - lo > 1) { const int mid = (lo + hi) >> 1; if ((int)pre[mid] <= g) lo = mid; else hi = mid; }
            const int idx = (e * G + lo) * segcap + (g - (int)pre[lo]);
            tk = ltok_[idx]; w = lw_[idx]; sl = lslot_[idx];
        }
        rtok[tid] = tk; rw[tid] = w; rslot[tid] = sl;
    }
    __syncthreads();
}
#define kmax2 ((float*)(wsl + A_KMAX))
#define dpo ((bf16_t*)(wsl + A_DPO))
#define dpml ((float*)(wsl + A_DPML))
#define cntb ((int*)(wsl + A_CNTB))
#define WinT ((bf16_t*)(wsl + WB_WIN))
#define WoT ((bf16_t*)(wsl + WB_WO))
#define WguT ((bf16_t*)(wsl + WB_WGU))
#define WdT ((bf16_t*)(wsl + WB_WD))
#define WaiT ((bf16_t*)(wsl + WB_WAI))
#define Wfa ((float*)(wsl + WF_FA))
#define W36b ((bf16_t*)(wsl + WF_R36))
#define ropecs ((float*)(wsl + WF_ROPE))
#define xb ((bf16_t*)(wsl + A_XB))
#define hb ((float*)(wsl + A_HB))
#define logf_ ((float*)(wsl + A_LOGF))
#define cum2 ((float*)(wsl + A_CUM))
#define Qa ((bf16_t*)(wsl + A_QA))
#define Ka ((bf16_t*)(wsl + A_KA))
#define VaT ((bf16_t*)(wsl + A_VAT))
#define Xr ((bf16_t*)(wsl + A_XR))
#define Gr ((bf16_t*)(wsl + A_GR))
#define Qc ((bf16_t*)(wsl + A_QC))
#define Kc ((bf16_t*)(wsl + A_KC))
#define VcT ((bf16_t*)(wsl + A_VCT))
#define hloc ((float*)(wsl + A_HLOC))
#define ploc ((float*)(wsl + A_PLOC))
#define sumA ((float*)(wsl + A_SUMA))
#define sumH ((float*)(wsl + A_SUMH))
#define concat ((bf16_t*)(wsl + A_CONCAT))
#define y1 ((float*)(wsl + A_Y1))
#define h1 ((float*)(wsl + A_H1))
#define h1b ((bf16_t*)(wsl + A_H1B))
#define ltok ((int*)(wsl + A_LTOK))
#define lw ((float*)(wsl + A_LW))
#define lslot ((int*)(wsl + A_LSLOT))
#define act ((bf16_t*)(wsl + A_ACT))
#define contrib ((bf16_t*)(wsl + A_CONTRIB))
#ifndef EMU
__global__ void __launch_bounds__(NTHREADS, 2)
#else
void
#endif
fwd_kernel(Params p) {
    DYN_LDS(lds_raw);
    float* ldsf = (float*)lds_raw;
    const int bid = blockIdx.x, G = gridDim.x;
    const int gthreads = G * NTHREADS, gwaves = G * (NTHREADS / 64);
    const int wave_s = RFL((int)threadIdx.x >> 6);
#define PHASE_IDS() unsigned char* wsl = ws; OPAQUE_S(wsl); int tid = wave_s * 64 + LANE_ID(); OPAQUE(tid); const int lane = tid & 63, wave = tid >> 6, gtid = bid * NTHREADS + tid, gwave = bid * (NTHREADS / 64) + wave; (void)lane; (void)wave; (void)gtid; (void)gwave

    unsigned char* ws = p.ws;
    volatile LAS unsigned* bst = (volatile LAS unsigned*)(lds_raw + LDS_MISC);
    unsigned* ubox = (unsigned*)(lds_raw + LDS_MISC + 16);
    if (threadIdx.x == 0) { bst[0] = 0u; bst[1] = 0u; bst[2] = 0u; bst[3] = 0u; }
    __syncthreads();
    XcdBarrier bar = xcd_barrier_post((unsigned*)ws, bst);

    const int* positions = (const int*)p.in[I_POS];

    constexpr int NPH = 8;
    const int lo = p.lo, hi = p.hi;
#ifdef ONLY_PHASE
#define PH_SEL(c) ((c) == ONLY_PHASE)
#else
#define PH_SEL(c) 1
#endif
#define PH_IN(k) (lo <= (k) && (k) < hi)
#define PH_BAR(k) do { if ((k) + 1 < hi) xcd_barrier(bar, wave_s == 0 && LANE_ID() == 0); } while (0)

    if (PH_SEL(-1) && PH_IN(0)) for (int rep = 0; rep < PH_REPS(-1); ++rep) {
        PHASE_IDS();
        for (int l = 0; l < DEPTH; ++l) {
            convert_mats(p.in[I_WIN] + (size_t)l * D * N_IN, 0, 1, N_IN, D, N_IN, WinT + (size_t)l * N_INP * D, 0, RmWin{}, ldsf, tid, bid, G);
            for (int t = bid; t < (D / 64) * (D / 256); t += G)
                convert_tile_v4(p.in[I_WO] + (size_t)l * D * D, D, D, (t / (D / 256)) * 64, (t % (D / 256)) * 256, WoT + (size_t)l * D * D, RmIdent{}, ldsf, tid);
            convert_mats(p.in[I_WA] + (size_t)l * 6 * 128 * 128, (size_t)128 * 128, 6, 128, 128, 128, WaiT + (size_t)l * 6 * 256 * 128, (size_t)256 * 128, RmIdent{}, ldsf, tid, bid, G);
            convert_mats(p.in[I_WI] + (size_t)l * 6 * 128 * 128, (size_t)128 * 128, 6, 128, 128, 128, WaiT + (size_t)l * 6 * 256 * 128, (size_t)256 * 128, RmOff{128}, ldsf, tid, bid, G);
        }
        for (int i = gtid; i < DEPTH * 8 * D; i += gthreads) { const int k = i % D, h = (i / D) % 8, l = i / (8 * D);
            Wfa[i] = (h < 6) ? p.in[I_WIN][(size_t)l * D * N_IN + (size_t)k * N_IN + C_FA + h] : 0.f; }
        for (int i = gtid; i < DEPTH * 48 * D; i += gthreads) { const int k = i % D, o = (i / D) % 48, l = i / (48 * D);
            const float w = (o < 4) ? p.in[I_WGRP][((size_t)l * D + k) * 4 + o] : (o < 36 ? p.in[I_WRT][((size_t)l * D + k) * 32 + (o - 4)] : 0.f);
            const bf16_t hi = f2bf(w);
            W36b[((size_t)l * 2 + 0) * 48 * D + (size_t)o * D + k] = hi; W36b[((size_t)l * 2 + 1) * 48 * D + (size_t)o * D + k] = f2bf(w - bf2f(hi)); }
        for (int i = gtid; i < S * 8; i += gthreads) { const int d = i & 7, t = i >> 3; const float ang = (float)positions[t] * p.inv_freq[d];
            ropecs[t * 16 + d] = cosf(ang); ropecs[t * 16 + 8 + d] = sinf(ang); }
        __syncthreads();
        for (int i = tid; i < 6 * D; i += NTHREADS) { const int k = i % D, h = i / D; ldsf[i] = p.in[I_WIN][(size_t)k * N_IN + C_FA + h]; }
        __syncthreads();
        for (int t0 = gwave * 2; t0 < S; t0 += gwaves * 2) {
            f32x4 v[2][8];
#pragma unroll
            for (int tk = 0; tk < 2; ++tk)
#pragma unroll
                for (int j = 0; j < 8; ++j) v[tk][j] = *(const f32x4*)(p.in[I_X] + (size_t)(t0 + tk) * D + j * 256 + lane * 4);
#pragma unroll
            for (int tk = 0; tk < 2; ++tk) {
                const int t = t0 + tk;
                float fa[6] = {0.f, 0.f, 0.f, 0.f, 0.f, 0.f};
#pragma unroll
                for (int j = 0; j < 8; ++j) {
                    const int c = j * 256 + lane * 4;
                    u32x2 o; o.x = pack2(v[tk][j][0], v[tk][j][1]); o.y = pack2(v[tk][j][2], v[tk][j][3]);
                    *(u32x2*)(xb + (size_t)t * D + c) = o;
#pragma unroll
                    for (int h = 0; h < 6; ++h) { const f32x4 w = *(const f32x4*)(ldsf + h * D + c); fa[h] += v[tk][j][0] * w[0] + v[tk][j][1] * w[1] + v[tk][j][2] * w[2] + v[tk][j][3] * w[3]; }
                    COMPILER_FENCE();
                }
#pragma unroll
                for (int h = 0; h < 6; ++h) { const float sm = wave_sum(fa[h]); if (lane == 0) logf_[h * S + t] = log_sigmoid_f(sm + p.in[I_BF][h]); }
            }
        }
        PH_BAR(0);
    }

    for (int l = 0; l < DEPTH; ++l) {
        const int pb = 1 + l * NPH;
#define hin ((l == 0) ? p.in[I_X] : (const float*)hb)
#define hout ((l == DEPTH - 1) ? p.out : hb)
#define workctr ((int*)(wsl + CTL_WORK_OFF) + l * 64)

        if (PH_SEL(0) && PH_IN(pb + 0)) {
            PHASE_IDS();
            int bz = RFL(bid); OPAQUE_S(bz);
            if (bz == 0) {
                double* part = (double*)lds_raw;
                const int per = S / 64;
                double s = 0.0;
                if (wave < 6) { for (int i = 0; i < per; ++i) s += (double)logf_[wave * S + lane * per + i]; part[wave * 64 + lane] = s; }
                __syncthreads();
                if (wave < 6) {
                    double run = 0.0;
                    for (int j = 0; j < lane; ++j) run += part[wave * 64 + j];
                    for (int i = 0; i < per; ++i) { run += (double)logf_[wave * S + lane * per + i]; cum2[wave * S + lane * per + i] = (float)(run * (double)LOG2E); }
                }
                __syncthreads();
            }
            bool conv_more = (l == 0);
#define CONV_ONE() do { if (conv_more) { __syncthreads(); if (tid == 0) *ubox = (unsigned)atomic_add_int((int*)(wsl + CTL_WORK_OFF) + 62, 1); __syncthreads(); \
                const int cid_ = RFL((int)*ubox); if (cid_ < NCONV) moe_conv_chunk(p, cid_, WguT, WdT, ldsf, tid); else conv_more = false; } } while (0)
            unsigned* cls = (unsigned*)(wsl + CTL_CLS_OFF) + l * 256;
            if (bz == 0) { WAIT_VM0(); __syncthreads(); if (tid == 0) { FENCE_REL_AGENT(); WAIT_VM0(); (void)xb_add(&cls[192], 1u); } }
            const bf16_t* Bt = WinT + (size_t)l * N_INP * D;
            constexpr int ntm = S / 256;
            const unsigned nooff[2][2] = {{0u, 0u}, {0u, 0u}};
            for (int i = 0; i < (bid & 3); ++i) CONV_ONE();
            for (;;) {
                __syncthreads();
                if (tid == 0) *ubox = (unsigned)atomic_add_int(workctr + 9, 1);
                __syncthreads();
                int t = RFL((int)*ubox);
                if (t >= ntm * 21) break;
                int pm, pn, kcls;
                if (t < ntm * 6) { pm = t / 6; pn = 15 + t % 6; kcls = 0; }
                else if (t < ntm * 12) { t -= ntm * 6; pm = t / 6; pn = 9 + t % 6; kcls = 1; }
                else { t -= ntm * 12; pm = t / 9; pn = t % 9; kcls = 2; }
                f32x4 acc[2][2][4][2];
                gemm_tile<false>(xb, pm * 256, nooff, Bt, pn * 256, D, lds_raw, acc, tid);
                int et = tid; OPAQUE(et); const int wr = et >> 8, wc = (et >> 6) & 3, fr = et & 15, fq = (et >> 4) & 3;
                if (pn < 6 || (pn >= 9 && pn < 19)) {
                    bf16_t* dst; float scale = 1.f; bool rope = false;
                    if (pn < 3) { dst = Qa; scale = QSCALE_A; } else if (pn < 6) { dst = Ka; } else if (pn < 12) { dst = Xr; } else if (pn < 15) { dst = Gr; }
                    else if (pn < 17) { dst = Qc; scale = QSCALE_C; rope = true; } else { dst = Kc; rope = true; }
                    const bool headmajor = (pn < 6) || (pn >= 15);
                    const int segpn = (pn < 3) ? pn : (pn < 6) ? pn - 3 : (pn < 12) ? pn - 9 : (pn < 15) ? pn - 12 : (pn < 17) ? pn - 15 : pn - 17;
#pragma unroll
                    for (int ai = 0; ai < 2; ++ai)
#pragma unroll
                        for (int m = 0; m < 4; ++m)
#pragma unroll
                            for (int bj = 0; bj < 2; ++bj)
#pragma unroll
                                for (int n = 0; n < 2; ++n) {
                                    const int dd = wc * 32 + n * 16 + fr;
#pragma unroll
                                    for (int j = 0; j < 4; ++j) {
                                        const int row = pm * 256 + ai * 128 + wr * 64 + m * 16 + fq * 4 + j;
                                        float v = acc[ai][bj][m][n][j];
                                        if (rope && n == 0 && (wc & 1) == 0) {
                                            const float pv = SHX(v, 8);
                                            const float cs = ropecs[row * 16 + (fr & 7)], sn = ropecs[row * 16 + 8 + (fr & 7)];
                                            v = (fr < 8) ? (v * cs - pv * sn) : (v * cs + pv * sn);
                                        }
                                        v *= scale;
                                        *(bf16_t*)(lds_raw + (ai * 128 + wr * 64 + m * 16 + fq * 4 + j) * 528 + (bj * 128 + dd) * 2) = f2bf(v);
                                    }
                                }
                    __syncthreads();
#pragma unroll 4
                    for (int i = 0; i < 16; ++i) {
                        const int idx = et + i * 512, lrow = idx >> 5, ch = idx & 31, row = pm * 256 + lrow;
                        const u32x4 val = *(const u32x4*)(lds_raw + lrow * 528 + ch * 16);
                        size_t gi;
                        if (headmajor) gi = ((size_t)(segpn * 2 + (ch >> 4)) * S + row) * 128 + (ch & 15) * 8;
                        else gi = (size_t)row * LRU_W + segpn * 256 + ch * 8;
                        *(u32x4*)(dst + gi) = val;
                    }
                    __syncthreads();
                    if (pn >= 15) {
                        float* part = ldsf;
#pragma unroll
                        for (int ai = 0; ai < 2; ++ai)
#pragma unroll
                            for (int m = 0; m < 4; ++m)
#pragma unroll
                                for (int bj = 0; bj < 2; ++bj)
#pragma unroll
                                    for (int j = 0; j < 4; ++j) {
                                        float ss = acc[ai][bj][m][0][j] * acc[ai][bj][m][0][j] + acc[ai][bj][m][1][j] * acc[ai][bj][m][1][j];
                                        ss += SHX(ss, 1); ss += SHX(ss, 2); ss += SHX(ss, 4); ss += SHX(ss, 8);
                                        if (fr == 0) part[(wc * 2 + bj) * 256 + ai * 128 + wr * 64 + m * 16 + fq * 4 + j] = ss;
                                    }
                        __syncthreads();
                        {
                            const int bj = et >> 8, row = et & 255;
                            float v0 = part[(0 * 2 + bj) * 256 + row] + part[(1 * 2 + bj) * 256 + row], v1 = part[(2 * 2 + bj) * 256 + row] + part[(3 * 2 + bj) * 256 + row];
                            v0 = fmaxf(v0, SHX(v0, 1)); v0 = fmaxf(v0, SHX(v0, 2)); v0 = fmaxf(v0, SHX(v0, 4)); v0 = fmaxf(v0, SHX(v0, 8)); v0 = xrow16_max(v0);
                            v1 = fmaxf(v1, SHX(v1, 1)); v1 = fmaxf(v1, SHX(v1, 2)); v1 = fmaxf(v1, SHX(v1, 4)); v1 = fmaxf(v1, SHX(v1, 8)); v1 = xrow16_max(v1);
                            if ((et & 63) == 0) {
                                unsigned* q2p = (unsigned*)(wsl + CTL_QK2_OFF) + l * 16 + (pn >= 17 ? 8 : 0) + (segpn * 2 + bj) * 2;
                                atomic_max_u32(q2p, __builtin_bit_cast(unsigned, v0)); atomic_max_u32(q2p + 1, __builtin_bit_cast(unsigned, v1));
                            }
                        }
                        __syncthreads();
                    }
                    if (pn >= 3 && pn < 6) {
                        float* part = ldsf;
#pragma unroll
                        for (int ai = 0; ai < 2; ++ai)
#pragma unroll
                            for (int m = 0; m < 4; ++m)
#pragma unroll
                                for (int bj = 0; bj < 2; ++bj)
#pragma unroll
                                    for (int j = 0; j < 4; ++j) {
                                        float ss = acc[ai][bj][m][0][j] * acc[ai][bj][m][0][j] + acc[ai][bj][m][1][j] * acc[ai][bj][m][1][j];
                                        ss += SHX(ss, 1); ss += SHX(ss, 2); ss += SHX(ss, 4); ss += SHX(ss, 8);
                                        if (fr == 0) part[(wc * 2 + bj) * 256 + ai * 128 + wr * 64 + m * 16 + fq * 4 + j] = ss;
                                    }
                        __syncthreads();
                        {
                            const int bj = et >> 8, row = et & 255;
                            float v = part[(0 * 2 + bj) * 256 + row] + part[(1 * 2 + bj) * 256 + row] + part[(2 * 2 + bj) * 256 + row] + part[(3 * 2 + bj) * 256 + row];
                            v = fmaxf(v, SHX(v, 1)); v = fmaxf(v, SHX(v, 2)); v = fmaxf(v, SHX(v, 4)); v = fmaxf(v, SHX(v, 8)); v = xrow16_max(v);
                            if ((et & 63) == 0) kmax2[((pn - 3) * 2 + bj) * NKT + pm * 4 + ((et >> 6) & 3)] = v;
                        }
                        __syncthreads();
                    }
                } else {
                    bf16_t* dst = (pn < 9) ? VaT : VcT;
                    const int segpn = (pn < 9) ? pn - 6 : pn - 19;
#pragma unroll
                    for (int ai = 0; ai < 2; ++ai)
#pragma unroll
                        for (int m = 0; m < 4; ++m)
#pragma unroll
                            for (int bj = 0; bj < 2; ++bj)
#pragma unroll
                                for (int n = 0; n < 2; ++n) {
                                    const int dd = wc * 32 + n * 16 + fr;
                                    const int row = pm * 256 + ai * 128 + wr * 64 + m * 16 + fq * 4;
                                    const f32x4 a = acc[ai][bj][m][n];
                                    u32x2 o; o.x = pack2(a[0], a[1]); o.y = pack2(a[2], a[3]);
                                    const int s6 = row & 63, pos = (s6 & 32) + ((s6 >> 2) & 3) * 8 + ((s6 >> 4) & 1) * 4;
                                    *(u32x2*)(dst + (((size_t)(segpn * 2 + bj) * NKT + (row >> 6)) * 128 + dd) * 64 + pos) = o;
                                }
                }
                WAIT_VM0();
                __syncthreads();
                if (et == 0) { FENCE_REL_AGENT(); WAIT_VM0(); (void)xb_add(&cls[kcls * 64], 1u); }
                CONV_ONE();
            }
        }

        if (PH_SEL(1) && PH_IN(pb + 1)) {
            PHASE_IDS();
            const float lam_init = (l == 0) ? 0.2f : 0.35550906759f;
            const float s1 = wave_sum(p.in[I_LQ1][l * 64 + lane] * p.in[I_LK1][l * 64 + lane]);
            const float s2 = wave_sum(p.in[I_LQ2][l * 64 + lane] * p.in[I_LK2][l * 64 + lane]);
            const float lam = fexp(s1) - fexp(s2) + lam_init;
            constexpr int NLRU = NKT * 6, NQB = S / 128;
            bool conv_more = (l == 0);
            unsigned* cls = (unsigned*)(wsl + CTL_CLS_OFF) + l * 256;
            unsigned* bw = (unsigned*)wsl;
#define WAIT_CLASS(k, n) do { __syncthreads(); if (tid == 0) { XB_SPIN(xb_ld(&cls[(k) * 64]) < (unsigned)(n), bw); FENCE_ACQ_AGENT(); WAIT_VM0(); } __syncthreads(); } while (0)
#ifndef NO_DIFF
            {
                constexpr int NQB2 = S / 256;
                int total = 0;
                for (int q = 0; q < NQB2; ++q) total += ((4 * q + 4 + DCH - 1) / DCH) * 8;
                WAIT_CLASS(0, (S / 256) * 6);
                for (;;) {
                    __syncthreads();
                    if (tid == 0) *ubox = (unsigned)atomic_add_int(workctr, 1);
                    __syncthreads();
                    int u = RFL((int)*ubox);
                    if (u >= total) break;
                    int qb = NQB2 - 1;
                    for (;; --qb) { const int nu = ((4 * qb + 4 + DCH - 1) / DCH) * 8; if (u < nu) break; u -= nu; }
                    const int c = u >> 3, h = (u >> 1) & 3, mp = u & 1;
                    const int t0 = c * DCH, t1 = (t0 + DCH < 4 * qb + 4) ? t0 + DCH : 4 * qb + 4;
                    const unsigned* q2p = (const unsigned*)(wsl + CTL_QK2_OFF) + l * 16;
                    const float bnd = sqrtf(__builtin_bit_cast(float, q2p[h * 2 + mp]) * __builtin_bit_cast(float, q2p[8 + h * 2 + mp])) * (QSCALE_C * 1.02f) + 0.01f;
                    attn_dmap_unit(Qc + (size_t)h * S * 128, Kc + (size_t)h * S * 128, VcT + (size_t)h * S * 128, mp, qb, t0, t1,
                                   dpo + (size_t)(h * 2 + mp) * DPART_ROWS * 128, dpml + (size_t)(h * 2 + mp) * DPART_ROWS * 2, c, RFL_F(bnd), lds_raw, tid);
                    CONV_ONE();
                }
            }
#endif
#ifndef NO_LRU
            WAIT_CLASS(1, (S / 256) * 6);
            for (;;) {
                __syncthreads();
                if (tid == 0) *ubox = (unsigned)atomic_add_int(workctr + 10, 1);
                __syncthreads();
                const int u = RFL((int)*ubox);
                if (u >= NLRU) break;
                lru_unit_a(u / 6, u % 6, l, p, Xr, WaiT + (size_t)l * 6 * 256 * 128, hloc, ploc, sumA, sumH, lds_raw, tid);
            }
#endif
#ifndef NO_FOX
            WAIT_CLASS(2, (S / 256) * 9);
            WAIT_CLASS(3, 1);
            for (;;) {
                __syncthreads();
                if (tid == 0) *ubox = (unsigned)atomic_add_int(workctr + 1, 1);
                __syncthreads();
                const int u = RFL((int)*ubox);
                if (u >= NQB * FOX_H) break;
                const int qb = NQB - 1 - u / FOX_H, h = u % FOX_H;
                attn_unit<0>(Qa + (size_t)h * S * 128, Ka + (size_t)h * S * 128, VaT + (size_t)h * S * 128, cum2 + (size_t)h * S, kmax2 + h * NKT, qb, concat, h * 128,
                             0.f, 0.f, nullptr, lds_raw, tid);
            }
#endif
            while (conv_more) CONV_ONE();
            PH_BAR(pb + 1);
        }

        if (PH_SEL(2) && PH_IN(pb + 2)) for (int rep = 0; rep < PH_REPS(2); ++rep) {
            PHASE_IDS();
            for (int u = bid; u < NKT * 6; u += G) {
                const int chunk = u / 6, grp = u % 6, c = tid & 127, tq = tid >> 7, ch = grp * 128 + c;
                float cr = 0.f;
                {
                    int j = 0;
                    for (; j + 16 <= chunk; j += 16) {
                        float a8[16], h8[16];
#pragma unroll
                        for (int q = 0; q < 16; ++q) { a8[q] = sumA[(size_t)(j + q) * LRU_W + ch]; h8[q] = sumH[(size_t)(j + q) * LRU_W + ch]; }
#pragma unroll
                        for (int q = 0; q < 16; ++q) cr = a8[q] * cr + h8[q];
                    }
                    for (; j < chunk; ++j) cr = sumA[(size_t)j * LRU_W + ch] * cr + sumH[(size_t)j * LRU_W + ch];
                }
                float hl[16], pl[16]; bf16_t gg[16];
#pragma unroll
                for (int i = 0; i < 16; ++i) { const size_t gi = (size_t)(chunk * 64 + tq * 16 + i) * LRU_W + ch; const unsigned hp = ((const unsigned*)hloc)[gi]; hl[i] = bf2f((bf16_t)(hp & 0xffffu)); pl[i] = bf2f((bf16_t)(hp >> 16)); gg[i] = Gr[gi]; }
#pragma unroll
                for (int i = 0; i < 16; ++i)
                    concat[(size_t)(chunk * 64 + tq * 16 + i) * D + FOX_W + ch] = f2bf(gelu_tanh_f(bf2f(gg[i])) * (hl[i] + pl[i] * cr));
            }
            {
                const float lam_init = (l == 0) ? 0.2f : 0.35550906759f;
                const float s1 = wave_sum(p.in[I_LQ1][l * 64 + lane] * p.in[I_LK1][l * 64 + lane]);
                const float s2 = wave_sum(p.in[I_LQ2][l * 64 + lane] * p.in[I_LK2][l * 64 + lane]);
                const float lam = fexp(s1) - fexp(s2) + lam_init;
                const float* sg = p.in[I_SUBG] + l * 128;
                const float g0 = sg[2 * lane], g1 = sg[2 * lane + 1];
                static_assert(NCH <= 8, "the merge below keeps one (map, chunk) pair per lane: 2 x 8 lanes");
                for (int q = gwave; q < S; q += gwaves) {
                    const int nch = (q >> 6) / DCH + 1;
                    float mv = -INFINITY, lv = 0.f;
                    { const int c = lane & 7, hm = lane >> 3;
                      if (c < nch) { const float* ML = dpml + ((size_t)hm * DPART_ROWS + dpart_row(c, q)) * 2; mv = ML[0]; lv = ML[1]; } }
                    unsigned pk[4][2][NCH];
#pragma unroll
                    for (int h = 0; h < 4; ++h)
#pragma unroll
                        for (int mp = 0; mp < 2; ++mp) {
                            const unsigned* OP = (const unsigned*)(dpo + (size_t)(h * 2 + mp) * DPART_ROWS * 128);
#pragma unroll
                            for (int c = 0; c < NCH; ++c) pk[h][mp][c] = (c < nch) ? OP[(size_t)dpart_row(c, q) * 64 + lane] : 0u;
                        }
                    float Mx = mv; Mx = fmaxf(Mx, DPP_X1(Mx)); Mx = fmaxf(Mx, DPP_X2(Mx)); Mx = fmaxf(Mx, DPP_X7(Mx));
                    const float wv = (mv == -INFINITY) ? 0.f : FAST_EXP2(mv - Mx);
                    float Lp = lv * wv; Lp += DPP_X1(Lp); Lp += DPP_X2(Lp); Lp += DPP_X7(Lp);
#pragma unroll
                    for (int h = 0; h < 4; ++h) {
                        float om[2][2];
#pragma unroll
                        for (int mp = 0; mp < 2; ++mp) {
                            float o0 = 0.f, o1 = 0.f;
#pragma unroll
                            for (int c = 0; c < NCH; ++c) { const float w = RDLANE(wv, (h * 2 + mp) * 8 + c); o0 += bf2f((bf16_t)(pk[h][mp][c] & 0xffffu)) * w; o1 += bf2f((bf16_t)(pk[h][mp][c] >> 16)) * w; }
                            const float il = 1.f / RDLANE(Lp, (h * 2 + mp) * 8);
                            om[mp][0] = o0 * il; om[mp][1] = o1 * il;
                        }
                        const float v0 = om[0][0] - lam * om[1][0], v1 = om[0][1] - lam * om[1][1];
                        const float ss = wave_sum(v0 * v0 + v1 * v1);
                        const float rs = (1.f - lam_init) / sqrtf(ss * (1.f / 128.f) + LN_EPS);
                        *(unsigned*)(concat + (size_t)q * D + 1536 + h * 128 + 2 * lane) = pack2(v0 * rs * g0, v1 * rs * g1);
                    }
                }
            }
            PH_BAR(pb + 2);
        }

        if (PH_SEL(3) && PH_IN(pb + 3)) {
            PHASE_IDS();
            const bf16_t* Bt = WoT + (size_t)l * D * D;
            constexpr int ntn = D / 256, ntm = S / 256;
            static_assert(ntn == 8, "the panel exchange is written for 8 column tiles");
            const unsigned nooff[2][2] = {{0u, 0u}, {0u, 0u}};
            const float* g1 = p.in[I_LN1G] + (size_t)l * D; const float* b1 = p.in[I_LN1B] + (size_t)l * D;
            const float* bg = p.in[I_BGRP] + l * 4; const float* br = p.in[I_BRT] + l * 32;
            const bf16_t* Wb = W36b + (size_t)l * 2 * 48 * D;
            int* lcnt = (int*)(lds_raw + LDS_MISC + M_LCNT);
            const int segcap = ((ntm * ntn + G - 1) / G) * 32;
            unsigned* pcnt = (unsigned*)(wsl + CTL_PAN_OFF) + l * 1024;
            unsigned long long* xbuf = (unsigned long long*)(wsl + A_XBUF);
            unsigned* part = (unsigned*)(wsl + A_PART);
            LAS float* Stab = (LAS float*)(lds_raw + LDS_MISC + M_RTOK);
            float* lgt = (float*)(lds_raw + LDS_MISC + 4096);
            if (tid < 32) lcnt[tid] = 0;
            __syncthreads();
            for (int t0 = bid; t0 < ntm * ntn; t0 += G) {
                int t = t0;
                if (G == 256 && ntm * ntn == 256) { const int x = t0 & 7, j = t0 >> 3; t = (x * 4 + (j >> 3)) * ntn + (j & 7); }
                const int pm = t / ntn, pn = t % ntn;
                f32x4 v[2][16];
                {
                    f32x4 acc[2][2][4][2];
                    gemm_tile<false>(concat, pm * 256, nooff, Bt, pn * 256, D, lds_raw, acc, tid);
                    int et = tid; OPAQUE(et); const int wr = et >> 8, wc = (et >> 6) & 3, fr = et & 15, fq = (et >> 4) & 3;
#pragma unroll
                    for (int ai = 0; ai < 2; ++ai) {
#pragma unroll
                        for (int m = 0; m < 4; ++m)
#pragma unroll
                            for (int bj = 0; bj < 2; ++bj)
#pragma unroll
                                for (int n = 0; n < 2; ++n)
#pragma unroll
                                    for (int j = 0; j < 4; ++j)
                                        *(float*)(lds_raw + (wr * 64 + m * 16 + fq * 4 + j) * 1040 + (bj * 128 + wc * 32 + n * 16 + fr) * 4) = acc[ai][bj][m][n][j];
                        __syncthreads();
#pragma unroll
                        for (int i = 0; i < 16; ++i) {
                            const int lrow = i * 8 + (et >> 6), c4 = et & 63;
                            const size_t gi = (size_t)(pm * 256 + ai * 128 + lrow) * D + pn * 256 + c4 * 4;
                            v[ai][i] = *(const GAS f32x4*)(hin + gi);
                        }
#pragma unroll
                        for (int i = 0; i < 16; ++i) {
                            const int lrow = i * 8 + (et >> 6), c4 = et & 63;
                            v[ai][i] = ALPHA * v[ai][i] + *(const f32x4*)(lds_raw + lrow * 1040 + c4 * 16);
                        }
                        __syncthreads();
                    }
                }
                int et2 = tid; OPAQUE(et2); const int el = et2 & 63, ew = wave_s, er16 = et2 & 15, eq4 = (et2 >> 4) & 3;
#pragma unroll
                for (int q = 0; q < 6; ++q) {
                    const int seg = ew * 6 + q, n2 = seg * 2 + (el >> 5), p5 = el & 31;
                    GLDS16(Wb + (size_t)n2 * D + pn * 256 + ((p5 ^ (n2 & 15)) << 3), lds_raw + 65536 + seg * 1024 + el * 16);
                }
                float my_mt = 0.f, my_m2 = 0.f;
                for (int trep = 0; trep < REP_STATS; ++trep)
#pragma unroll
                for (int ai = 0; ai < 2; ++ai)
#pragma unroll
                    for (int i4 = 0; i4 < 16; i4 += 4) {
                        float mt4[4], m24[4];
#pragma unroll
                        for (int u = 0; u < 4; ++u) { const f32x4 x = v[ai][i4 + u]; mt4[u] = wave_sum((x[0] + x[1]) + (x[2] + x[3])) * (1.f / 256.f); }
#pragma unroll
                        for (int u = 0; u < 4; ++u) { const f32x4 d = v[ai][i4 + u] - mt4[u]; m24[u] = wave_sum((d[0] * d[0] + d[1] * d[1]) + (d[2] * d[2] + d[3] * d[3])); }
#pragma unroll
                        for (int u = 0; u < 4; ++u) if (el == ai * 16 + i4 + u) { my_mt = mt4[u]; my_m2 = m24[u]; }
                        COMPILER_FENCE();
                    }
                unsigned* bw = (unsigned*)wsl;
                if (el < 32) {
                    const int grow = (el >> 4) * 128 + (el & 15) * 8 + ew;
                    xst64(&xbuf[(size_t)(pm * 256 + grow) * 8 + pn], ((unsigned long long)__builtin_bit_cast(unsigned, my_m2) << 32) | __builtin_bit_cast(unsigned, my_mt));
                }
                WAIT_VM0();
                __syncthreads();
                if (et2 == 0) { (void)xb_add(&pcnt[pm * 16], 1u); XB_SPIN(xb_ld(&pcnt[pm * 16]) < 8u, bw); FENCE_ACQ_AGENT(); }
                __syncthreads();
                unsigned long long wk[4];
#pragma unroll
                for (int k = 0; k < 4; ++k) {
                    const int r = k * 8 + (el >> 3), grow = (r >> 4) * 128 + (r & 15) * 8 + ew;
                    wk[k] = xld64(&xbuf[(size_t)(pm * 256 + grow) * 8 + (el & 7)]);
                }
#pragma unroll
                for (int k = 0; k < 4; ++k) {
                    const int r = k * 8 + (el >> 3);
                    const unsigned long long w = wk[k];
                    const float mt = __builtin_bit_cast(float, (unsigned)w), m2 = __builtin_bit_cast(float, (unsigned)(w >> 32));
                    float ms = mt; ms += DPP_X1(ms); ms += DPP_X2(ms); ms += DPP_X7(ms);
                    const float mean = ms * 0.125f, dm = mt - mean;
                    float q = m2 + 256.f * dm * dm; q += DPP_X1(q); q += DPP_X2(q); q += DPP_X7(q);
                    const float rstd = 1.f / sqrtf(q * (1.f / D) + LN_EPS);
                    if ((el & 7) == 0) { Stab[(ew * 32 + r) * 2] = mean; Stab[(ew * 32 + r) * 2 + 1] = rstd; }
                }
                WAVE_SYNC();
                const f32x4 gv = *(const f32x4*)(g1 + pn * 256 + el * 4), bv = *(const f32x4*)(b1 + pn * 256 + el * 4);
                LAS unsigned char* wt = (LAS unsigned char*)lds_raw + ew * 8192;
                const LAS unsigned char* wbl = (const LAS unsigned char*)lds_raw + 65536;
                for (int rrep = 0; rrep < REP_ROUTER; ++rrep)
#pragma unroll
                for (int ai = 0; ai < 2; ++ai) {
                    u32x2 lokeep[16];
#pragma unroll
                    for (int i = 0; i < 16; ++i) {
                        const float mean = Stab[(ew * 32 + ai * 16 + i) * 2], rstd = Stab[(ew * 32 + ai * 16 + i) * 2 + 1];
                        const f32x4 hv = mul_s4(v[ai][i] - mean, rstd) * gv + bv;
                        u32x2 o; o.x = pack2(hv[0], hv[1]); o.y = pack2(hv[2], hv[3]);
                        lokeep[i].x = pack2(hv[0] - bf2f((bf16_t)(o.x & 0xffffu)), hv[1] - bf2f((bf16_t)(o.x >> 16)));
                        lokeep[i].y = pack2(hv[2] - bf2f((bf16_t)(o.y & 0xffffu)), hv[3] - bf2f((bf16_t)(o.y >> 16)));
                        *(LAS u32x2*)(wt + i * 512 + (((el >> 1) ^ i) << 4) + (el & 1) * 8) = o;
                        COMPILER_FENCE();
                    }
                    WAVE_SYNC();
                    f32x4 ac[3];
#pragma unroll
                    for (int nt = 0; nt < 3; ++nt) ac[nt] = (f32x4){0.f, 0.f, 0.f, 0.f};
#pragma unroll 2
                    for (int ks = 0; ks < 8; ++ks) {
                        const int co = ((ks * 4 + eq4) ^ er16) << 4;
                        const bf16x8 ah = *(const LAS bf16x8*)(wt + er16 * 512 + co);
#pragma unroll
                        for (int nt = 0; nt < 3; ++nt) {
                            const bf16x8 bh = *(const LAS bf16x8*)(wbl + (nt * 16 + er16) * 512 + co);
                            const bf16x8 bl = *(const LAS bf16x8*)(wbl + (48 + nt * 16 + er16) * 512 + co);
                            ac[nt] = MFMA16(ah, bh, ac[nt]); ac[nt] = MFMA16(ah, bl, ac[nt]);
                        }
                    }
                    WAVE_SYNC();
#pragma unroll
                    for (int i = 0; i < 16; ++i) *(LAS u32x2*)(wt + i * 512 + (((el >> 1) ^ i) << 4) + (el & 1) * 8) = lokeep[i];
                    WAVE_SYNC();
#pragma unroll 2
                    for (int ks = 0; ks < 8; ++ks) {
                        const int co = ((ks * 4 + eq4) ^ er16) << 4;
                        const bf16x8 al = *(const LAS bf16x8*)(wt + er16 * 512 + co);
#pragma unroll
                        for (int nt = 0; nt < 3; ++nt) {
                            const bf16x8 bh = *(const LAS bf16x8*)(wbl + (nt * 16 + er16) * 512 + co);
                            ac[nt] = MFMA16(al, bh, ac[nt]);
                        }
                    }
#pragma unroll
                    for (int nt = 0; nt < 3; ++nt)
#pragma unroll
                        for (int j = 0; j < 4; ++j) {
                            const float cv = ac[nt][j];
                            xst32(&part[((size_t)pn * S + pm * 256 + ai * 128 + (eq4 * 4 + j) * 8 + ew) * 48 + nt * 16 + er16], __builtin_bit_cast(unsigned, cv));
                        }
                    WAVE_SYNC();
                }
                WAIT_VM0();
                __syncthreads();
                if (et2 == 0) (void)xb_add(&pcnt[512 + pm * 16], 1u);
                for (int srep = 0; srep < REP_STORES; ++srep)
#pragma unroll
                for (int ai = 0; ai < 2; ++ai)
#pragma unroll
                    for (int i = 0; i < 16; ++i) {
                        const float mean = Stab[(ew * 32 + ai * 16 + i) * 2], rstd = Stab[(ew * 32 + ai * 16 + i) * 2 + 1];
                        const f32x4 hv = mul_s4(v[ai][i] - mean, rstd) * gv + bv;
                        const size_t gi = (size_t)(pm * 256 + ai * 128 + i * 8 + ew) * D + pn * 256 + el * 4;
                        u32x2 o; o.x = pack2(hv[0], hv[1]); o.y = pack2(hv[2], hv[3]);
                        *(u32x2*)(h1b + gi) = o;
                        COMPILER_FENCE();
                    }
                if (et2 == 0) { XB_SPIN(xb_ld(&pcnt[512 + pm * 16]) < 8u, bw); FENCE_ACQ_AGENT(); }
                __syncthreads();
                int rt = tid; OPAQUE(rt);
#pragma unroll
                for (int k = 0; k < 3; ++k) {
                    const int idx = rt + k * 512, tk = idx / 48, n = idx - tk * 48;
                    unsigned pq[8];
#pragma unroll
                    for (int q = 0; q < 8; ++q) pq[q] = xb_ld(&part[((size_t)q * S + pm * 256 + pn * 32 + tk) * 48 + n]);
                    float a = 0.f;
#pragma unroll
                    for (int q = 0; q < 8; ++q) a += __builtin_bit_cast(float, pq[q]);
                    lgt[idx] = a;
                }
                __syncthreads();
                if (rt < 32) {
                    const int t = pm * 256 + pn * 32 + rt; const float* L = lgt + rt * 48;
                    float gl[4];
#pragma unroll
                    for (int q = 0; q < 4; ++q) gl[q] = L[q] + bg[q];
                    int gi = 0; float gm = gl[0];
#pragma unroll
                    for (int q = 1; q < 4; ++q) if (gl[q] > gm) { gm = gl[q]; gi = q; }
                    float gs = 0.f;
#pragma unroll
                    for (int q = 0; q < 4; ++q) gs += fexp(gl[q] - gm);
                    const float gweight = 1.f / gs;
                    float E[8];
#pragma unroll
                    for (int e = 0; e < 8; ++e) E[e] = L[4 + gi * 8 + e] + br[gi * 8 + e];
                    int e1 = 0; float m1 = E[0];
#pragma unroll
                    for (int e = 1; e < 8; ++e) if (E[e] > m1) { m1 = E[e]; e1 = e; }
                    int e2 = -1; float m2 = -INFINITY;
#pragma unroll
                    for (int e = 0; e < 8; ++e) if (e != e1 && E[e] > m2) { m2 = E[e]; e2 = e; }
                    const float p2 = fexp(m2 - m1), w1 = 1.f / (1.f + p2), w2 = p2 / (1.f + p2);
                    const int ge1 = gi * 8 + e1, ge2 = gi * 8 + e2;
                    const int i1 = (ge1 * G + bid) * segcap + atomic_add_int(&lcnt[ge1], 1);
                    ltok[i1] = t; lw[i1] = gweight * w1; lslot[i1] = 0;
                    const int i2 = (ge2 * G + bid) * segcap + atomic_add_int(&lcnt[ge2], 1);
                    ltok[i2] = t; lw[i2] = gweight * w2; lslot[i2] = 1;
                }
                __syncthreads();
            }
            { int ft = tid; OPAQUE(ft); if (ft < 32) cntb[bid * 32 + ft] = lcnt[ft]; }
            PH_BAR(pb + 3);
        }

        if (PH_SEL(5) && PH_IN(pb + 5)) {
            PHASE_IDS();
            const unsigned nooff[2][2] = {{0u, 0u}, {0u, 0u}};
            const int segcap = ((S / 256 * (D / 256) + G - 1) / G) * 32;
            moe_prefix(cntb, G, lds_raw, tid);
            const int* ctot = (const int*)(lds_raw + LDS_MISC + M_CTOT); const int* coff = (const int*)(lds_raw + LDS_MISC + M_COFF);
            const int* rtok = (const int*)(lds_raw + LDS_MISC + M_RTOK); const float* rw = (const float*)(lds_raw + LDS_MISC + M_RW);
            const int* rslot = (const int*)(lds_raw + LDS_MISC + M_RSLOT);
            unsigned* done = (unsigned*)(wsl + CTL_DONE_OFF) + l * 1024;
            int* mq = (int*)(wsl + CTL_MQ_OFF) + l * 128;
            const int myx = (int)(xb_xcc_id() & 7u);
            int qi = 0;
            for (;;) {
                __syncthreads();
                if (tid == 0) {
                    unsigned r = 0xffffffffu;
                    while (qi < 8) {
                        const int xx = (myx + qi) & 7;
                        int nm = 0;
#pragma unroll
                        for (int k = 0; k < NEXP / 8; ++k) nm += (ctot[xx + 8 * k] + 255) / 256;
                        const int got = atomic_add_int(mq + xx * 16, 1);
                        if (got < nm * 12) { r = ((unsigned)xx << 24) | (unsigned)got; break; }
                        ++qi;
                    }
                    *ubox = r;
                }
                __syncthreads();
                const unsigned rr = (unsigned)RFL((int)*ubox);
                if (rr == 0xffffffffu) break;
                const int xq = (int)(rr >> 24);
                int u = (int)(rr & 0xffffffu);
                int nmt = 0;
#pragma unroll
                for (int k = 0; k < NEXP / 8; ++k) nmt += (RFL(ctot[xq + 8 * k]) + 255) / 256;
                const bool down = (u >= nmt * 4);
                const int per = down ? 8 : 4;
                if (down) u -= nmt * 4;
                int e = xq;
                for (;; e += 8) { const int nt = ((RFL(ctot[e]) + 255) / 256) * per; if (u < nt) break; u -= nt; }
                const int c = RFL(ctot[e]), off = RFL(coff[e]);
                const int mt = u / per, pn = u % per, m0 = mt * 256;
                moe_rowtable(ltok, lw, lslot, e, m0, c, G, segcap, lds_raw, tid);
                f32x4 acc[2][2][4][2];
                if (!down) {
                    const bf16_t* Bt = WguT + ((size_t)l * NEXP + e) * 1024 * D;
                    unsigned aoff[2][2];
                    int st = tid; OPAQUE(st); int R[2], C[2]; stage_geom(st, R, C);
#pragma unroll
                    for (int h = 0; h < 2; ++h)
#pragma unroll
                        for (int i = 0; i < 2; ++i) aoff[h][i] = (unsigned)(rtok[h * 128 + R[i]] * D + C[i]);
                    gemm_tile<true>(h1b, 0, aoff, Bt, pn * 256, D, lds_raw, acc, tid);
                    int et = tid; OPAQUE(et); const int wr = et >> 8, wc = (et >> 6) & 3, fr = et & 15, fq = (et >> 4) & 3;
#pragma unroll
                    for (int ai = 0; ai < 2; ++ai)
#pragma unroll
                        for (int m = 0; m < 4; ++m)
#pragma unroll
                            for (int j = 0; j < 4; ++j) {
                                const int r = ai * 128 + wr * 64 + m * 16 + fq * 4 + j;
                                const float wgt = rw[r];
#pragma unroll
                                for (int bj = 0; bj < 2; ++bj)
                                    *(bf16_t*)(lds_raw + r * 272 + (bj * 64 + wc * 16 + fr) * 2) = f2bf(silu_f(acc[ai][bj][m][0][j]) * acc[ai][bj][m][1][j] * wgt);
                            }
                    __syncthreads();
#pragma unroll 4
                    for (int i = 0; i < 8; ++i) {
                        const int idx = et + i * 512, r = idx >> 4, ch = idx & 15;
                        if (m0 + r < c) *(u32x4*)(act + (size_t)(off + m0 + r) * DFF + pn * 128 + ch * 8) = *(const u32x4*)(lds_raw + r * 272 + ch * 16);
                    }
                    WAIT_VM0();
                    __syncthreads();
                    if (et == 0) { FENCE_REL_AGENT(); WAIT_VM0(); (void)xb_add(&done[e * 32 + mt], 1u); }
                } else {
                    const bf16_t* Bt = WdT + ((size_t)l * NEXP + e) * D * DFF;
                    if (tid == 0) {
                        unsigned* bw = (unsigned*)wsl;
                        XB_SPIN(xb_ld(&done[e * 32 + mt]) < 4u, bw);
                        FENCE_ACQ_AGENT();
                        WAIT_VM0();
                    }
                    __syncthreads();
                    gemm_tile<false>(act, off + m0, nooff, Bt, pn * 256, DFF, lds_raw, acc, tid);
                    int et = tid; OPAQUE(et); const int wr = et >> 8, wc = (et >> 6) & 3, fr = et & 15, fq = (et >> 4) & 3;
#pragma unroll
                    for (int ai = 0; ai < 2; ++ai)
#pragma unroll
                        for (int m = 0; m < 4; ++m)
#pragma unroll
                            for (int bj = 0; bj < 2; ++bj)
#pragma unroll
                                for (int n = 0; n < 2; ++n)
#pragma unroll
                                    for (int j = 0; j < 4; ++j)
                                        *(bf16_t*)(lds_raw + (ai * 128 + wr * 64 + m * 16 + fq * 4 + j) * 528 + (bj * 128 + wc * 32 + n * 16 + fr) * 2) = f2bf(acc[ai][bj][m][n][j]);
                    __syncthreads();
#pragma unroll 4
                    for (int i = 0; i < 16; ++i) {
                        const int idx = et + i * 512, r = idx >> 5, ch = idx & 31;
                        if (m0 + r < c) *(u32x4*)(contrib + ((size_t)rslot[r] * S + rtok[r]) * D + pn * 256 + ch * 8) = *(const u32x4*)(lds_raw + r * 528 + ch * 16);
                    }
                }
            }
            PH_BAR(pb + 5);
        }

        if (PH_SEL(7) && PH_IN(pb + 7)) for (int rep = 0; rep < PH_REPS(7); ++rep) {
            PHASE_IDS();
            const float* g2 = p.in[I_LN2G] + (size_t)l * D; const float* b2 = p.in[I_LN2B] + (size_t)l * D;
            const bool more = (l + 1 < DEPTH);
            f32x4 gq[8], bq[8];
#pragma unroll
            for (int j = 0; j < 8; ++j) { gq[j] = *(const f32x4*)(g2 + j * 256 + lane * 4); bq[j] = *(const f32x4*)(b2 + j * 256 + lane * 4); }
            if (more) {
                const float* wf = Wfa + (size_t)(l + 1) * 8 * D;
                __syncthreads();
                for (int i = tid; i < 6 * D / 4; i += NTHREADS) *(f32x4*)(ldsf + i * 4) = *(const f32x4*)(wf + i * 4);
                __syncthreads();
            }
            for (int t = gwave; t < S; t += gwaves) {
                f32x4 v[8]; float s = 0.f;
#pragma unroll
                for (int j = 0; j < 8; ++j) {
                    const size_t i = (size_t)t * D + j * 256 + lane * 4;
                    const u32x2 c0 = *(const u32x2*)(contrib + i), c1 = *(const u32x2*)(contrib + (size_t)S * D + i);
                    const f32x4 cs = (f32x4){bf2f((bf16_t)(c0.x & 0xffffu)) + bf2f((bf16_t)(c1.x & 0xffffu)), bf2f((bf16_t)(c0.x >> 16)) + bf2f((bf16_t)(c1.x >> 16)),
                                             bf2f((bf16_t)(c0.y & 0xffffu)) + bf2f((bf16_t)(c1.y & 0xffffu)), bf2f((bf16_t)(c0.y >> 16)) + bf2f((bf16_t)(c1.y >> 16))};
                    const u32x2 hq = *(const u32x2*)(h1b + i);
                    v[j] = ALPHA * (f32x4){bf2f((bf16_t)(hq.x & 0xffffu)), bf2f((bf16_t)(hq.x >> 16)), bf2f((bf16_t)(hq.y & 0xffffu)), bf2f((bf16_t)(hq.y >> 16))} + cs;
                    s += (v[j][0] + v[j][1]) + (v[j][2] + v[j][3]);
                }
                const float mean = wave_sum(s) * (1.f / D);
                float s2 = 0.f;
#pragma unroll
                for (int j = 0; j < 8; ++j) { v[j] -= mean; s2 += (v[j][0] * v[j][0] + v[j][1] * v[j][1]) + (v[j][2] * v[j][2] + v[j][3] * v[j][3]); }
                const float rstd = 1.f / sqrtf(wave_sum(s2) * (1.f / D) + LN_EPS);
                float fa[6] = {0.f, 0.f, 0.f, 0.f, 0.f, 0.f};
#pragma unroll
                for (int j = 0; j < 8; ++j) {
                    const int c = j * 256 + lane * 4;
                    v[j] = v[j] * rstd * gq[j] + bq[j];
                    *(f32x4*)(hout + (size_t)t * D + c) = v[j];
                    COMPILER_FENCE();
                    if (more) {
                        u32x2 o; o.x = pack2(v[j][0], v[j][1]); o.y = pack2(v[j][2], v[j][3]);
                        *(u32x2*)(xb + (size_t)t * D + c) = o;
#pragma unroll
                        for (int h = 0; h < 6; ++h) { const f32x4 w = *(const f32x4*)(ldsf + h * D + c); fa[h] += (v[j][0] * w[0] + v[j][1] * w[1]) + (v[j][2] * w[2] + v[j][3] * w[3]); }
                    }
                }
                if (more) {
#pragma unroll
                    for (int h = 0; h < 6; ++h) { const float sm = wave_sum(fa[h]); if (lane == 0) logf_[h * S + t] = log_sigmoid_f(sm + p.in[I_BF][(l + 1) * 6 + h]); }
                }
            }
            PH_BAR(pb + 7);
        }
    }
#undef PH_IN
#undef PH_BAR
}

constexpr int N_PHASES = 1 + DEPTH * 8;
#ifndef EMU
extern "C" void kernel_launch(void* const* d_in, const int* in_sizes, int n_in, void* d_out, int out_size, void* d_ws, size_t ws_size, hipStream_t stream) {
    static int grid = 0;
    if (grid == 0) {
        if (n_in != N_INPUTS || out_size != S * D || ws_size < WS_END) {
            fprintf(stderr, "kernel_launch: unexpected shapes: n_in %d out %d ws %zu (need %zu)\n", n_in, out_size, ws_size, (size_t)WS_END); grid = -1; return; }
        int dev = 0, cus = 0, per_cu = 0;
        if (hipGetDevice(&dev) != hipSuccess || hipDeviceGetAttribute(&cus, hipDeviceAttributeMultiprocessorCount, dev) != hipSuccess) { grid = -1; return; }
        if (hipFuncSetAttribute((const void*)fwd_kernel, hipFuncAttributeMaxDynamicSharedMemorySize, LDS_BYTES) != hipSuccess) { fprintf(stderr, "kernel_launch: hipFuncSetAttribute failed\n"); grid = -1; return; }
        if (hipOccupancyMaxActiveBlocksPerMultiprocessor(&per_cu, (const void*)fwd_kernel, NTHREADS, LDS_BYTES) != hipSuccess || per_cu < 1) {
            fprintf(stderr, "kernel_launch: occupancy query says %d blocks per CU\n", per_cu); (void)hipGetLastError(); grid = -1; return; }
        grid = cus;
    }
    if (grid < 0) return;
    (void)hipMemsetAsync(d_ws, 0, CTL_BYTES, stream);
    Params p{};
    for (int i = 0; i < N_INPUTS; ++i) p.in[i] = (const float*)d_in[i];
    p.out = (float*)d_out; p.ws = (unsigned char*)d_ws;
    for (int i = 0; i < 8; ++i) p.inv_freq[i] = (float)pow(500000.0, -(double)i * 2.0 / 16.0);
#if N_LAUNCH_SPLIT
    for (int k = 0; k < N_PHASES; ++k) { p.lo = k; p.hi = k + 1; hipLaunchKernelGGL(fwd_kernel, dim3(grid), dim3(NTHREADS), LDS_BYTES, stream, p); }
#else
    p.lo = 0; p.hi = N_PHASES;
    hipLaunchKernelGGL(fwd_kernel, dim3(grid), dim3(NTHREADS), LDS_BYTES, stream, p);
#endif
}
#endif
```

```cpp
#ifndef EMU
#include <hip/hip_runtime.h>
#include <cstdio>
#include <cstdint>
#include <cmath>
#endif

#ifndef SEQ
#define SEQ 8192
#endif
#ifndef N_LAUNCH_SPLIT
#define N_LAUNCH_SPLIT 0
#endif
#ifndef REP_PHASE
#define REP_PHASE -2
#endif
#define PH_REPS(c) ((c) == REP_PHASE ? 2 : 1)
#ifndef REP_SUB
#define REP_SUB 0
#endif

constexpr int S = SEQ, D = 2048, DEPTH = 2;
constexpr int FOX_H = 6, FOX_W = 768;
constexpr int LRU_W = 768;
constexpr int DIFF_H = 4, DIFF_W = 512;
constexpr int N_IN = 5382, N_INP = 5376;
constexpr int C_FA = 2304;
constexpr int NEXP = 32, DFF = 512;
constexpr int NKT = S / 64;
#ifndef REP_ROUTER
#define REP_ROUTER 1
#endif
#ifndef REP_STORES
#define REP_STORES 1
#endif
#ifndef REP_STATS
#define REP_STATS 1
#endif
#ifndef DCH
#define DCH 32
#endif
constexpr int NCH = (NKT + DCH - 1) / DCH;
constexpr size_t DPART_ROWS = (size_t)NCH * S - (size_t)(DCH * 64) * NCH * (NCH - 1) / 2;
constexpr float ALPHA = 1.41421356237309504880f;
constexpr float LN_EPS = 1e-5f;
constexpr float LOG2E = 1.4426950408889634f;
constexpr float QSCALE_A = 0.08838834764831845f * 1.4426950408889634f;
constexpr float QSCALE_C = 0.125f * 1.4426950408889634f;

enum { I_X = 0, I_POS, I_WIN, I_BF, I_CONVW, I_CONVB, I_WA, I_BA, I_WI, I_BI, I_LAM, I_LQ1, I_LK1, I_LQ2, I_LK2, I_SUBG, I_WO, I_LN1G, I_LN1B,
       I_WGRP, I_BGRP, I_WRT, I_BRT, I_WGATE, I_WUP, I_WDOWN, I_LN2G, I_LN2B, N_INPUTS };

typedef unsigned short bf16_t;
typedef short bf16x8 __attribute__((ext_vector_type(8)));
typedef float f32x4 __attribute__((ext_vector_type(4)));
typedef unsigned u32x4 __attribute__((ext_vector_type(4)));
typedef unsigned u32x2 __attribute__((ext_vector_type(2)));

constexpr size_t al256(size_t x) { return (x + 255) & ~(size_t)255; }
constexpr size_t CTL_BYTES = 65536;
constexpr size_t CTL_CNT_OFF = 32768;
constexpr size_t CTL_WORK_OFF = 36864;
constexpr size_t CTL_QK2_OFF = 57344;
constexpr size_t CTL_CLS_OFF = 49152;
constexpr size_t CTL_PAN_OFF = 16384;
constexpr size_t CTL_MQ_OFF = 24576;
constexpr size_t CTL_DONE_OFF = 40960;
constexpr size_t WB_WIN = CTL_BYTES;
constexpr size_t WB_WO = WB_WIN + al256((size_t)DEPTH * N_INP * D * 2);
constexpr size_t WB_WGU = WB_WO + al256((size_t)DEPTH * D * D * 2);
constexpr size_t WB_WD = WB_WGU + al256((size_t)DEPTH * NEXP * 1024 * D * 2);
constexpr size_t WB_WAI = WB_WD + al256((size_t)DEPTH * NEXP * D * DFF * 2);
constexpr size_t WF_FA = WB_WAI + al256((size_t)DEPTH * 6 * 256 * 128 * 2);
constexpr size_t WF_R36 = WF_FA + al256((size_t)DEPTH * 8 * D * 4);
constexpr size_t WF_ROPE = WF_R36 + al256((size_t)DEPTH * 2 * 48 * D * 2);
constexpr size_t A_XB = WF_ROPE + al256((size_t)S * 16 * 4);
constexpr size_t A_HB = A_XB + al256((size_t)S * D * 2);
constexpr size_t A_LOGF = A_HB + al256((size_t)S * D * 4);
constexpr size_t A_CUM = A_LOGF + al256((size_t)6 * S * 4);
constexpr size_t A_KMAX = A_CUM + al256((size_t)6 * S * 4);
constexpr size_t A_CNTB = A_KMAX + al256((size_t)6 * NKT * 4);
constexpr size_t A_QA = A_CNTB + al256((size_t)1024 * 32 * 4);
constexpr size_t A_KA = A_QA + al256((size_t)FOX_H * S * 128 * 2);
constexpr size_t A_VAT = A_KA + al256((size_t)FOX_H * S * 128 * 2);
constexpr size_t A_XR = A_VAT + al256((size_t)FOX_H * S * 128 * 2);
constexpr size_t A_GR = A_XR + al256((size_t)S * LRU_W * 2);
constexpr size_t A_QC = A_GR + al256((size_t)S * LRU_W * 2);
constexpr size_t A_KC = A_QC + al256((size_t)DIFF_H * S * 128 * 2);
constexpr size_t A_VCT = A_KC + al256((size_t)DIFF_H * S * 128 * 2);
constexpr size_t A_HLOC = A_VCT + al256((size_t)DIFF_H * S * 128 * 2);
constexpr size_t A_PLOC = A_HLOC + al256((size_t)S * LRU_W * 4);
constexpr size_t A_SUMA = A_PLOC + al256((size_t)S * LRU_W * 4);
constexpr size_t A_SUMH = A_SUMA + al256((size_t)NKT * LRU_W * 4);
constexpr size_t A_CONCAT = A_SUMH + al256((size_t)NKT * LRU_W * 4);
constexpr size_t A_Y1 = A_CONCAT + al256((size_t)S * D * 2);
constexpr size_t A_H1 = A_Y1 + al256((size_t)S * D * 4);
constexpr size_t A_H1B = A_H1 + al256((size_t)S * D * 4);
constexpr size_t A_LTOK = A_H1B + al256((size_t)S * D * 2);
constexpr size_t A_LW = A_LTOK + al256((size_t)NEXP * S * 4);
constexpr size_t A_LSLOT = A_LW + al256((size_t)NEXP * S * 4);
constexpr size_t A_ACT = A_LSLOT + al256((size_t)NEXP * S * 4);
constexpr size_t A_CONTRIB = A_ACT + al256((size_t)(2 * S + 256) * DFF * 2);
constexpr size_t WS_END = A_CONTRIB + al256((size_t)2 * S * D * 4);
constexpr size_t A_DPO = A_Y1;
constexpr size_t A_DPML = A_DPO + al256((size_t)8 * DPART_ROWS * 128 * 2);
static_assert(A_DPML + (size_t)8 * DPART_ROWS * 2 * 4 <= A_H1B, "differential partials must fit inside the y1 + h1 region");

constexpr size_t A_XBUF = A_H1 + al256((size_t)S * D * 2);
constexpr size_t A_PART = A_XBUF + al256((size_t)S * 8 * 8);
static_assert(A_PART + (size_t)8 * S * 48 * 4 <= A_H1B, "exchange buffers must fit inside the h1 region");
constexpr int NTHREADS = 512;
constexpr int LDS_MAIN = 131072 + 4096;
constexpr int LDS_MISC = LDS_MAIN;
constexpr int LDS_BYTES = LDS_MAIN + 8192 + 16640;
constexpr int M_PRE16 = 8192;
constexpr int M_LCNT = 64, M_CTOT = 256, M_COFF = 384, M_PRE = 512, M_RTOK = 2048, M_RW = 3072, M_RSLOT = 4096;

struct Params {
    const float* in[N_INPUTS];
    float* out;
    unsigned char* ws;
    float inv_freq[8];
    int lo, hi;
};

#ifndef EMU
#define LAS __attribute__((address_space(3)))
#define GAS __attribute__((address_space(1)))
#define DYN_LDS(name) extern __shared__ __attribute__((aligned(16))) unsigned char name[]
#define SLEEP1() __builtin_amdgcn_s_sleep(1)
#define WAVE_SYNC() __builtin_amdgcn_wave_barrier()
#define OPAQUE(x) asm volatile("" : "+v"(x))
#define COMPILER_FENCE() asm volatile("" ::: "memory")
#define RFL(x) __builtin_amdgcn_readfirstlane(x)
#define RFL_F(x) __builtin_bit_cast(float, __builtin_amdgcn_readfirstlane(__builtin_bit_cast(int, x)))
#define ANY_LANE(p) (__builtin_amdgcn_ballot_w64(p) != 0ull)
#define RDLANE(v, l) __builtin_bit_cast(float, __builtin_amdgcn_readlane(__builtin_bit_cast(int, v), l))
__device__ __forceinline__ int lane_id_volatile() { int l; asm volatile("v_mbcnt_lo_u32_b32 %0, -1, 0\n\tv_mbcnt_hi_u32_b32 %0, -1, %0" : "=v"(l)); return l; }
#define LANE_ID() lane_id_volatile()
#define OPAQUE_S(x) asm volatile("" : "+s"(x))
#define WAIT_VM0() asm volatile("s_waitcnt vmcnt(0)" ::: "memory")
#define WAIT_ALL0() __builtin_amdgcn_s_waitcnt(0)
#define FENCE_REL_AGENT() __builtin_amdgcn_fence(__ATOMIC_RELEASE, "agent")
#define FENCE_ACQ_AGENT() __builtin_amdgcn_fence(__ATOMIC_ACQUIRE, "agent")
#define MFMA16(a, b, c) __builtin_amdgcn_mfma_f32_16x16x32_bf16(a, b, c, 0, 0, 0)
#define GLDS16(g, l) __builtin_amdgcn_global_load_lds((const unsigned*)(g), (unsigned*)(l), 16, 0, 0)
#define WAIT_V(n) asm volatile("s_waitcnt vmcnt(" #n ")" ::: "memory")
#define WAIT_L(n) asm volatile("s_waitcnt lgkmcnt(" #n ")" ::: "memory")
#define BAR() __builtin_amdgcn_s_barrier()
#define SCHED() __builtin_amdgcn_sched_barrier(0)
#define SETPRIO(n) __builtin_amdgcn_s_setprio(n)
#define FAST_EXP2(x) __builtin_amdgcn_exp2f(x)
template <int M> __device__ __forceinline__ float shx_impl(float v, int lane) {
    if (M < 32) return __builtin_bit_cast(float, __builtin_amdgcn_ds_swizzle(__builtin_bit_cast(int, v), (M << 10) | 0x1f));
    return __builtin_bit_cast(float, __builtin_amdgcn_ds_bpermute((lane ^ 32) << 2, __builtin_bit_cast(int, v)));
}
#define SHX(v, M) shx_impl<M>(v, lane)
template <int CTRL> __device__ __forceinline__ float dppx(float x) { return __builtin_bit_cast(float, __builtin_amdgcn_mov_dpp(__builtin_bit_cast(int, x), CTRL, 0xf, 0xf, true)); }
#define DPP_X1(x) dppx<0xB1>(x)
#define DPP_X2(x) dppx<0x4E>(x)
#define DPP_X7(x) dppx<0x141>(x)
#define DPP_X8(x) dppx<0x128>(x)
#define xrow16_max(x) xrow16_max_l(x, lane)
#define xrow16_sum(x) xrow16_sum_l(x, lane)
__device__ __forceinline__ float xrow16_max_l(float x, int lane) { x = fmaxf(x, shx_impl<16>(x, lane)); return fmaxf(x, shx_impl<32>(x, lane)); }
__device__ __forceinline__ float xrow16_sum_l(float x, int lane) { x = x + shx_impl<16>(x, lane); return x + shx_impl<32>(x, lane); }
#define FAST_LOG2(x) __builtin_amdgcn_logf(x)
#define FAST_RCP(x) __builtin_amdgcn_rcpf(x)
__device__ __forceinline__ unsigned xb_ld(unsigned* p)              { return __hip_atomic_load(p, __ATOMIC_RELAXED, __HIP_MEMORY_SCOPE_AGENT); }
__device__ __forceinline__ unsigned xb_add(unsigned* p, unsigned v) { return __hip_atomic_fetch_add(p, v, __ATOMIC_RELAXED, __HIP_MEMORY_SCOPE_AGENT); }
__device__ __forceinline__ void xst64(unsigned long long* p, unsigned long long v) { __hip_atomic_store(p, v, __ATOMIC_RELAXED, __HIP_MEMORY_SCOPE_AGENT); }
__device__ __forceinline__ unsigned long long xld64(unsigned long long* p) { return __hip_atomic_load(p, __ATOMIC_RELAXED, __HIP_MEMORY_SCOPE_AGENT); }
__device__ __forceinline__ void xst32(unsigned* p, unsigned v) { __hip_atomic_store(p, v, __ATOMIC_RELAXED, __HIP_MEMORY_SCOPE_AGENT); }
__device__ __forceinline__ unsigned xb_xcc_id() { return (unsigned)__builtin_amdgcn_s_getreg((3 << 11) | 20) & 0xFu; }
__device__ __forceinline__ int atomic_add_int(int* p, int v) { return atomicAdd(p, v); }
__device__ __forceinline__ void atomic_min_int(int* p, int v) { atomicMin(p, v); }
__device__ __forceinline__ void atomic_max_u32(unsigned* p, unsigned v) { atomicMax(p, v); }
__device__ __forceinline__ unsigned pack2(float lo, float hi) { unsigned r; asm volatile("v_cvt_pk_bf16_f32 %0, %1, %2" : "=v"(r) : "v"(lo), "v"(hi)); return r; }
#else
#define MFMA16(a, b, c) emu_mfma_16x16x32_bf16(a, b, c)
#define GLDS16(g, l) emu_glds16((const void*)(g), (void*)(l))
#define WAIT_V(n) ((void)0)
#define WAIT_L(n) ((void)0)
#define BAR() __syncthreads()
#define SCHED() ((void)0)
#define SETPRIO(n) ((void)0)
#define FAST_EXP2(x) exp2f(x)
#define SHX(v, M) __shfl_xor(v, M)
#define DPP_X1(x) __shfl_xor(x, 1)
#define DPP_X2(x) __shfl_xor(x, 2)
#define DPP_X7(x) __shfl_xor(x, 7)
#define DPP_X8(x) __shfl_xor(x, 8)
static inline float xrow16_max(float x) { x = fmaxf(x, __shfl_xor(x, 16)); return fmaxf(x, __shfl_xor(x, 32)); }
static inline float xrow16_sum(float x) { x = x + __shfl_xor(x, 16); return x + __shfl_xor(x, 32); }
#define FAST_LOG2(x) log2f(x)
#define FAST_RCP(x) (1.f / (x))
static inline unsigned pack2(float lo, float hi) {
    unsigned a = __builtin_bit_cast(unsigned, lo), b = __builtin_bit_cast(unsigned, hi);
    a += 0x7fffu + ((a >> 16) & 1u); b += 0x7fffu + ((b >> 16) & 1u);
    return (a >> 16) | (b & 0xffff0000u);
}
#endif
__device__ __forceinline__ bf16_t f2bf(float f) { return (bf16_t)(pack2(f, 0.f) & 0xffffu); }
__device__ __forceinline__ float bf2f(bf16_t h) { return __builtin_bit_cast(float, (unsigned)h << 16); }

#define XB_TMO      128
#define XB_XCNT(j)  (256  + 64 * (j))
#define XB_XSUB(j)  (1280 + 64 * (j))
#define XB_XGEN(j)  (2304 + 64 * (j))
#define XB_TOP      3328
#define XB_TOPGEN   3392
#define XCD_BAR_WORDS 3456
#define XB_SPIN_CAP (1u << 22)
#define XB_SPIN(cond, bar) do { unsigned _sp = 0; while (cond) { SLEEP1(); \
    if ((++_sp & 255u) == 0u) { if (xb_ld(&(bar)[XB_TMO])) break; if (_sp > XB_SPIN_CAP) { xb_add(&(bar)[XB_TMO], 1u); break; } } } } while (0)

#define XB_X2SUB(x, s) (6400 + 16 * ((x) * 4 + (s)))
#define XB_X2CNT(x, s) (7424 + ((x) * 4 + (s)))
struct XcdBarrier { unsigned* bar; unsigned x, s; volatile LAS unsigned* st; };

__device__ __forceinline__ XcdBarrier xcd_barrier_post(unsigned* bar, volatile LAS unsigned* st) {
    XcdBarrier b; b.bar = bar; b.x = xb_xcc_id() & 15u; b.s = (blockIdx.x >> 3) & 3u; b.st = st;
    if (threadIdx.x == 0) {
        unsigned o = xb_add(&bar[XB_X2CNT(b.x, b.s)], 1u);
#ifndef EMU
        asm volatile("" :: "v"(o));
#endif
        (void)o;
        (void)xb_add(&bar[XB_XCNT(b.x)], 1u);
    }
    return b;
}
__device__ __forceinline__ void xcd_barrier_complete(unsigned* bar, unsigned x, unsigned s, unsigned& nsub, unsigned& nx, unsigned& nsubs) {
    const unsigned G = gridDim.x;
    unsigned sum, cnt, sp = 0u;
    for (;;) {
        sum = 0u; cnt = 0u;
#pragma unroll
        for (unsigned j = 0; j < 16; ++j) { const unsigned c = xb_ld(&bar[XB_XCNT(j)]); sum += c; cnt += (c > 0u) ? 1u : 0u; }
        if (sum == G) break;
        SLEEP1();
        if ((++sp & 255u) == 0u) { if (xb_ld(&bar[XB_TMO])) break; if (sp > XB_SPIN_CAP) { xb_add(&bar[XB_TMO], 1u); break; } }
    }
    unsigned mine = 0u, subs = 0u;
#pragma unroll
    for (unsigned q = 0; q < 4; ++q) { const unsigned c = xb_ld(&bar[XB_X2CNT(x, q)]); subs += (c > 0u) ? 1u : 0u; mine = (q == s) ? c : mine; }
    nsub = mine > 0u ? mine : 1u; nx = cnt > 0u ? cnt : 1u; nsubs = subs > 0u ? subs : 1u;
}
__device__ __forceinline__ void xcd_barrier(const XcdBarrier& b, bool leader) {
    WAIT_VM0();
    __syncthreads();
    if (leader) {
        unsigned* bar = b.bar;
        WAIT_ALL0();
        unsigned nsub = b.st[0], nx = b.st[1], nsubs = b.st[2];
        if (nsub == 0u) { xcd_barrier_complete(bar, b.x, b.s, nsub, nx, nsubs); b.st[0] = nsub; b.st[1] = nx; b.st[2] = nsubs; }
        const unsigned old = xb_add(&bar[XB_X2SUB(b.x, b.s)], 1u);
        const unsigned gen = old / nsub;
        bool xcd_last = false;
        if (old + 1u == (gen + 1u) * nsub) {
            const unsigned old2 = xb_add(&bar[XB_XSUB(b.x)], 1u);
            xcd_last = (old2 + 1u == (old2 / nsubs + 1u) * nsubs);
        }
        if (xcd_last) {
            FENCE_REL_AGENT();
            WAIT_VM0();
            const unsigned og = xb_add(&bar[XB_TOP], 1u);
            const unsigned tg = og / nx;
            if (og + 1u == (tg + 1u) * nx) xb_add(&bar[XB_TOPGEN], 1u);
            else XB_SPIN(xb_ld(&bar[XB_TOPGEN]) == tg, bar);
            FENCE_ACQ_AGENT();
            xb_add(&bar[XB_XGEN(b.x)], 1u);
            WAIT_VM0();
        } else {
            XB_SPIN(xb_ld(&bar[XB_XGEN(b.x)]) == gen, bar);
            FENCE_ACQ_AGENT();
            WAIT_VM0();
        }
    }
    __syncthreads();
}

__device__ __forceinline__ f32x4 mul_s4(f32x4 a, float s) {
#ifdef EMU
    return a * s;
#else
    f32x4 o;
#pragma unroll
    for (int c = 0; c < 4; ++c) { float r, x = a[c]; asm volatile("v_mul_f32_e32 %0, %1, %2" : "=v"(r) : "v"(x), "v"(s)); o[c] = r; }
    return o;
#endif
}
__device__ __forceinline__ float wave_sum_l(float v, int lane) {
    (void)lane;
    v += DPP_X1(v); v += DPP_X2(v); v += DPP_X7(v); v += DPP_X8(v);
    return xrow16_sum(v);
}
#define wave_sum(v) wave_sum_l(v, lane)
__device__ __forceinline__ float fexp(float x) { return FAST_EXP2(x * LOG2E); }
__device__ __forceinline__ float sigmoid_f(float x) { return FAST_RCP(1.f + fexp(-x)); }
__device__ __forceinline__ float log_sigmoid_f(float x) { return fminf(x, 0.f) - 0.6931471805599453f * FAST_LOG2(1.f + fexp(-fabsf(x))); }
__device__ __forceinline__ float gelu_tanh_f(float x) { const float u = 0.7978845608028654f * (x + 0.044715f * x * x * x); return x * FAST_RCP(1.f + fexp(-2.f * u)); }
__device__ __forceinline__ float silu_f(float x) { return x * FAST_RCP(1.f + fexp(-x)); }
__device__ __forceinline__ float neg_expm1_f(float x) {
    const float ser = -x * (1.f + x * (0.5f + x * (0.16666667f + x * (0.041666668f + x * (0.008333334f + x * 0.0013888889f)))));
    return (x > -0.35f) ? ser : (1.f - fexp(x));
}

struct RmIdent { __device__ __forceinline__ int operator()(int n) const { return n; } };
struct RmWin { __device__ __forceinline__ int operator()(int n) const { return n < C_FA ? n : (n < C_FA + 6 ? -1 : n - 6); } };
struct RmGu { int kind; __device__ __forceinline__ int operator()(int f) const { return (f >> 7) * 256 + ((f >> 6) & 1) * 128 + ((f >> 4) & 3) * 32 + kind * 16 + (f & 15); } };
struct RmOff { int off; __device__ __forceinline__ int operator()(int n) const { return n + off; } };

template <class RM>
__device__ __forceinline__ void convert_tile(const float* src, int ld, int K, int Nsrc, int k0, int n0, bf16_t* dst, const RM& rm, float* T, int tid) {
    {
        const int nn = tid & 255, kh = (tid >> 8) * 32, n = n0 + nn;
        const float* sp = src + (size_t)(k0 + kh) * ld + n;
        float v[32];
#pragma unroll
        for (int i = 0; i < 32; ++i) v[i] = (n < Nsrc) ? sp[(size_t)i * ld] : 0.f;
#pragma unroll
        for (int i = 0; i < 32; ++i) T[(kh + i) * 257 + nn] = v[i];
    }
    __syncthreads();
#pragma unroll
    for (int q = 0; q < 4; ++q) {
        const int nn = q * 64 + (tid >> 3), kc = (tid & 7) * 8, n = n0 + nn;
        const int row = (n < Nsrc) ? rm(n) : -1;
        if (row >= 0) {
            u32x4 o;
            o.x = pack2(T[(kc + 0) * 257 + nn], T[(kc + 1) * 257 + nn]); o.y = pack2(T[(kc + 2) * 257 + nn], T[(kc + 3) * 257 + nn]);
            o.z = pack2(T[(kc + 4) * 257 + nn], T[(kc + 5) * 257 + nn]); o.w = pack2(T[(kc + 6) * 257 + nn], T[(kc + 7) * 257 + nn]);
            *(u32x4*)(dst + (size_t)row * K + k0 + kc) = o;
        }
    }
    __syncthreads();
}
template <class RM>
__device__ __forceinline__ void convert_tile_v4(const float* src, int ld, int K, int k0, int n0, bf16_t* dst, const RM& rm, float* T, int tid_in) {
    int tid = tid_in; OPAQUE(tid);
    {
        const int w = tid >> 6, l4 = (tid & 63) * 4;
        const float* sp = src + (size_t)(k0 + w * 8) * ld + n0 + l4;
        f32x4 v[8];
#pragma unroll
        for (int i = 0; i < 8; ++i) v[i] = *(const f32x4*)(sp + (size_t)i * ld);
#pragma unroll
        for (int i = 0; i < 8; ++i) { float* tp = T + (w * 8 + i) * 257 + l4; tp[0] = v[i][0]; tp[1] = v[i][1]; tp[2] = v[i][2]; tp[3] = v[i][3]; }
    }
    __syncthreads();
#pragma unroll
    for (int q = 0; q < 4; ++q) {
        const int nn = q * 64 + (tid >> 3), kc = (tid & 7) * 8, n = n0 + nn;
        const int row = rm(n);
        u32x4 o;
        o.x = pack2(T[(kc + 0) * 257 + nn], T[(kc + 1) * 257 + nn]); o.y = pack2(T[(kc + 2) * 257 + nn], T[(kc + 3) * 257 + nn]);
        o.z = pack2(T[(kc + 4) * 257 + nn], T[(kc + 5) * 257 + nn]); o.w = pack2(T[(kc + 6) * 257 + nn], T[(kc + 7) * 257 + nn]);
        *(u32x4*)(dst + (size_t)row * K + k0 + kc) = o;
    }
    __syncthreads();
}
template <class RM>
__device__ __forceinline__ void convert_mats(const float* src, size_t sstride, int nmat, int ld, int K, int Nsrc, bf16_t* dst, size_t dstride, const RM& rm,
                                             float* T, int tid, int bid, int G) {
    const int tk = K / 64, tn = (Nsrc + 255) / 256, per = tk * tn, total = nmat * per;
    for (int t = bid; t < total; t += G) {
        const int mi = t / per, r = t % per;
        convert_tile(src + (size_t)mi * sstride, ld, K, Nsrc, (r / tn) * 64, (r % tn) * 256, dst + (size_t)mi * dstride, rm, T, tid);
    }
}

constexpr int NCONV = DEPTH * 768;
__device__ __forceinline__ void moe_conv_chunk(const Params& p, int cid, bf16_t* WguT_, bf16_t* WdT_, float* T, int tid) {
    const int l = cid / 768, r = cid % 768, kind = r >> 8, t0 = (r & 255) * 8;
    for (int t = t0; t < t0 + 8; ++t) {
        const int mi = t >> 6, rr = t & 63;
        if (kind < 2) {
            const float* src = p.in[kind == 0 ? I_WGATE : I_WUP] + ((size_t)l * NEXP + mi) * D * DFF;
            convert_tile_v4(src, DFF, D, (rr >> 1) * 64, (rr & 1) * 256, WguT_ + ((size_t)l * NEXP + mi) * 1024 * D, RmGu{kind}, T, tid);
        } else {
            const float* src = p.in[I_WDOWN] + ((size_t)l * NEXP + mi) * DFF * D;
            convert_tile_v4(src, D, DFF, (rr >> 3) * 64, (rr & 7) * 256, WdT_ + ((size_t)l * NEXP + mi) * D * DFF, RmIdent{}, T, tid);
        }
    }
}

constexpr int BK = 64, HTB = 128 * 64 * 2;
__device__ __forceinline__ int lds_byte(int r, int c) {
    const int st = (r >> 4) * 2 + (c >> 5), rr = r & 15, cc = c & 31, ob = rr * 64 + cc * 2;
    return st * 1024 + (ob ^ (((ob >> 9) & 1) << 5));
}
__device__ __forceinline__ void stage_rc(int b, int& R, int& C) {
    const int st = b / 1024, sb = b % 1024, swz = sb ^ (((sb >> 9) & 1) << 5);
    R = (st >> 1) * 16 + swz / 64; C = (st & 1) * 32 + (swz % 64) / 2;
}
template <bool GATHER>
__device__ __forceinline__ void gemm_tile(const bf16_t* A, int arow0, const unsigned (&aoff)[2][2], const bf16_t* Bt, int brow0, int K,
                                          unsigned char* shm, f32x4 (&acc)[2][2][4][2], int tid_in) {
    int tid = tid_in; OPAQUE(tid);
    unsigned toff; { int R0, C0; stage_rc(tid * 16, R0, C0); toff = (unsigned)(R0 * K + C0); }
#define SA(b, h) (shm + ((b) * 2 + (h)) * HTB)
#define SB(b, h) (shm + (4 + (b) * 2 + (h)) * HTB)
#define STAGE_B(P, h, kt) do { _Pragma("unroll") for (int _i = 0; _i < 2; ++_i) GLDS16(Bt + ((size_t)(brow0 + (h) * 128 + _i * 64) * K + (size_t)(kt) * BK) + toff, (P) + tid * 16 + _i * 8192); } while (0)
#define STAGE_A(P, h, kt) do { _Pragma("unroll") for (int _i = 0; _i < 2; ++_i) { \
    if (GATHER) GLDS16(A + (size_t)(kt) * BK + aoff[h][_i], (P) + tid * 16 + _i * 8192); \
    else GLDS16(A + ((size_t)(arow0 + (h) * 128 + _i * 64) * K + (size_t)(kt) * BK) + toff, (P) + tid * 16 + _i * 8192); } } while (0)
#define LDA(dst, b, h) _Pragma("unroll") for (int m = 0; m < 4; ++m) _Pragma("unroll") for (int k = 0; k < 2; ++k) \
    dst[m][k] = *reinterpret_cast<const bf16x8*>(SA(b, h) + lds_byte(wr * 64 + m * 16 + fr, k * 32 + fq * 8))
#define LDB(dst, b, h) _Pragma("unroll") for (int n = 0; n < 2; ++n) _Pragma("unroll") for (int k = 0; k < 2; ++k) \
    dst[n][k] = *reinterpret_cast<const bf16x8*>(SB(b, h) + lds_byte(wc * 32 + n * 16 + fr, k * 32 + fq * 8))
#define MMA(ai, bj, At, Bx) do { SETPRIO(1); \
    _Pragma("unroll") for (int m = 0; m < 4; ++m) _Pragma("unroll") for (int n = 0; n < 2; ++n) _Pragma("unroll") for (int k = 0; k < 2; ++k) \
      acc[ai][bj][m][n] = MFMA16(At[m][k], Bx[n][k], acc[ai][bj][m][n]); \
    SETPRIO(0); } while (0)
    int wid = tid >> 6, lane = tid & 63, wr = wid >> 2, wc = wid & 3, fr = lane & 15, fq = lane >> 4;
#pragma unroll
    for (int a = 0; a < 2; ++a)
#pragma unroll
        for (int b = 0; b < 2; ++b)
#pragma unroll
            for (int m = 0; m < 4; ++m)
#pragma unroll
                for (int n = 0; n < 2; ++n) acc[a][b][m][n] = (f32x4){0.f, 0.f, 0.f, 0.f};
    bf16x8 At[4][2], B0[2][2], B1[2][2];
    const int nt = K / BK;
    STAGE_B(SB(0, 0), 0, 0); STAGE_A(SA(0, 0), 0, 0);
    STAGE_B(SB(0, 1), 1, 0); STAGE_A(SA(0, 1), 1, 0);
    if (wr == 1) BAR();
    WAIT_V(4); BAR();
    STAGE_B(SB(1, 0), 0, 1); STAGE_A(SA(1, 0), 0, 1); STAGE_B(SB(1, 1), 1, 1);
    WAIT_V(6); BAR();
    for (int t = 0; t < nt - 2; t += 2) {
        LDB(B0, 0, 0); SCHED(); LDA(At, 0, 0); STAGE_A(SA(1, 1), 1, t + 1);
        WAIT_L(8); BAR(); WAIT_L(0); MMA(0, 0, At, B0); BAR(); SCHED();
        LDB(B1, 0, 1); STAGE_B(SB(0, 0), 0, t + 2);
        BAR(); WAIT_L(0); MMA(0, 1, At, B1); BAR();
        LDA(At, 0, 1); STAGE_A(SA(0, 0), 0, t + 2);
        BAR(); WAIT_L(0); MMA(1, 0, At, B0); BAR(); SCHED();
        STAGE_B(SB(0, 1), 1, t + 2);
        WAIT_V(6); BAR(); MMA(1, 1, At, B1); BAR();
        LDB(B0, 1, 0); SCHED(); LDA(At, 1, 0); STAGE_A(SA(0, 1), 1, t + 2);
        WAIT_L(8); BAR(); WAIT_L(0); MMA(0, 0, At, B0); BAR(); SCHED();
        LDB(B1, 1, 1); STAGE_B(SB(1, 0), 0, t + 3);
        BAR(); WAIT_L(0); MMA(0, 1, At, B1); BAR();
        LDA(At, 1, 1); STAGE_A(SA(1, 0), 0, t + 3);
        BAR(); WAIT_L(0); MMA(1, 0, At, B0); BAR(); SCHED();
        STAGE_B(SB(1, 1), 1, t + 3);
        WAIT_V(6); BAR(); MMA(1, 1, At, B1); BAR();
    }
    OPAQUE(tid); wid = tid >> 6; lane = tid & 63; wr = wid >> 2; wc = wid & 3; fr = lane & 15; fq = lane >> 4;
    { LDB(B0, 0, 0); WAIT_V(0); LDA(At, 0, 0); STAGE_A(SA(1, 1), 1, nt - 1);
      BAR(); WAIT_L(0); MMA(0, 0, At, B0); BAR();
      LDB(B1, 0, 1); BAR(); WAIT_L(0); MMA(0, 1, At, B1); BAR();
      LDA(At, 0, 1); WAIT_V(4); BAR(); WAIT_L(0); MMA(1, 0, At, B0); MMA(1, 1, At, B1); BAR(); }
    { LDB(B0, 1, 0); LDA(At, 1, 0); WAIT_V(2); BAR(); WAIT_L(0); MMA(0, 0, At, B0); BAR();
      LDB(B1, 1, 1); WAIT_V(0); BAR(); WAIT_L(0); MMA(0, 1, At, B1); BAR();
      LDA(At, 1, 1); BAR(); WAIT_L(0); MMA(1, 0, At, B0); MMA(1, 1, At, B1); BAR(); }
    if (wr == 0) BAR();
#undef SA
#undef SB
#undef STAGE_A
#undef STAGE_B
#undef LDA
#undef LDB
#undef MMA
}
__device__ __forceinline__ void stage_geom(int tid, int (&R)[2], int (&C)[2]) {
#pragma unroll
    for (int i = 0; i < 2; ++i) stage_rc(tid * 16 + i * 8192, R[i], C[i]);
}

constexpr int ATT_KBUF = 0, ATT_VBUF = 32768, ATT_CBUF = 65536;
template <int KIND>
__device__ __forceinline__ void attn_unit(const bf16_t* Q, const bf16_t* Kg, const bf16_t* VT, const float* cum2, const float* kmx, int qb, bf16_t* concat, int ccol0,
                                          float lam, float osc, const float* subg, unsigned char* lds, int tid) {
    const int lane = tid & 63, wave = tid >> 6, r16 = lane & 15, q4 = lane >> 4;
    const int q0w = qb * 128 + wave * 16, myq = q0w + r16;
    const int ntiles = 2 * qb + 2;
    const int wlimit = (KIND == 0) ? ((q0w + 15) >> 6) : (q0w >> 6);
    constexpr int NMAP = (KIND == 0) ? 1 : 2, NKS = (KIND == 0) ? 4 : 2;
    bf16x8 qf[NMAP][NKS];
#pragma unroll
    for (int mp = 0; mp < NMAP; ++mp)
#pragma unroll
        for (int ks = 0; ks < NKS; ++ks) qf[mp][ks] = *(const bf16x8*)(Q + (size_t)myq * 128 + mp * 64 + ks * 32 + q4 * 8);
    const float cq = (KIND == 0) ? cum2[myq] : 0.f;
    int kt0 = 0;
    if (KIND == 0) {
        float* wmax = (float*)(lds + ATT_CBUF + 512); int* kst = (int*)(lds + ATT_CBUF + 576);
        float qs = 0.f;
#pragma unroll
        for (int ks = 0; ks < NKS; ++ks)
#pragma unroll
            for (int j = 0; j < 8; ++j) { const float v = bf2f((bf16_t)qf[0][ks][j]); qs += v * v; }
        qs = xrow16_sum(qs);
        qs = fmaxf(qs, SHX(qs, 1)); qs = fmaxf(qs, SHX(qs, 2)); qs = fmaxf(qs, SHX(qs, 4)); qs = fmaxf(qs, SHX(qs, 8));
        if (lane == 0) wmax[wave] = qs;
        if (tid == 0) *kst = 2 * qb;
        __syncthreads();
        float qm = wmax[0];
#pragma unroll
        for (int w = 1; w < 8; ++w) qm = fmaxf(qm, wmax[w]);
        qm = sqrtf(qm) * 1.01f;
        const float kd = sqrtf(fmaxf(kmx[2 * qb], kmx[2 * qb + 1])) * 1.01f;
        if (tid < 2 * qb) {
            const float bias = cum2[qb * 128] - cum2[tid * 64 + 63];
            const bool skip = bias + qm * (sqrtf(kmx[tid]) * 1.01f + kd) < -40.f;
            if (!skip) atomic_min_int(kst, tid);
        }
        __syncthreads();
        kt0 = RFL(*kst);
    }
    f32x4 ot[NMAP][8];
    float mrun[NMAP], lsum[NMAP];
#pragma unroll
    for (int mp = 0; mp < NMAP; ++mp) { mrun[mp] = -INFINITY; lsum[mp] = 0.f;
#pragma unroll
        for (int mo = 0; mo < 8; ++mo) ot[mp][mo] = (f32x4){0.f, 0.f, 0.f, 0.f}; }
    u32x4 sk[2], sv[2]; float sc = 0.f;
    const u32x4* kg = (const u32x4*)Kg; const u32x4* vg = (const u32x4*)VT;
#pragma unroll
    for (int i = 0; i < 2; ++i) { sk[i] = kg[(size_t)kt0 * 1024 + tid + i * 512]; sv[i] = vg[(size_t)kt0 * 1024 + tid + i * 512]; }
    if (KIND == 0 && tid < 64) sc = cum2[kt0 * 64 + tid];
    for (int kt = kt0; kt < ntiles; ++kt) {
        unsigned char* kb = lds + ATT_KBUF + (kt & 1) * 16384;
        unsigned char* vb = lds + ATT_VBUF + (kt & 1) * 16384;
        float* cb = (float*)(lds + ATT_CBUF + (kt & 1) * 256);
#pragma unroll
        for (int i = 0; i < 2; ++i) {
            const int g = tid + i * 512;
            { const int row = g >> 4, c = g & 15; *(u32x4*)(kb + row * 256 + ((c ^ (row & 15)) << 4)) = sk[i]; }
            { const int d = g >> 3, c = g & 7; *(u32x4*)(vb + d * 128 + ((c ^ ((d >> 1) & 7)) << 4)) = sv[i]; }
        }
        if (KIND == 0 && tid < 64) cb[tid] = sc;
        __syncthreads();
        if (kt + 1 < ntiles) {
#pragma unroll
            for (int i = 0; i < 2; ++i) { sk[i] = kg[(size_t)(kt + 1) * 1024 + tid + i * 512]; sv[i] = vg[(size_t)(kt + 1) * 1024 + tid + i * 512]; }
            if (KIND == 0 && tid < 64) sc = cum2[(kt + 1) * 64 + tid];
        }
        if (kt <= wlimit) {
#pragma unroll
            for (int mp = 0; mp < NMAP; ++mp) {
                bf16x8 kf[4][NKS], vfa[8];
#pragma unroll
                for (int m = 0; m < 4; ++m)
#pragma unroll
                    for (int ks = 0; ks < NKS; ++ks) { const int c = (KIND == 0 ? 0 : mp * 8) + ks * 4 + q4; kf[m][ks] = *(const bf16x8*)(kb + (m * 16 + r16) * 256 + ((c ^ r16) << 4)); }
#pragma unroll
                for (int mo = 0; mo < 8; ++mo) { const int d = mo * 16 + r16; vfa[mo] = *(const bf16x8*)(vb + d * 128 + (((0 * 4 + q4) ^ ((d >> 1) & 7)) << 4)); }
                SCHED();
                f32x4 st[4];
#pragma unroll
                for (int m = 0; m < 4; ++m) st[m] = (f32x4){0.f, 0.f, 0.f, 0.f};
#pragma unroll
                for (int ks = 0; ks < NKS; ++ks)
#pragma unroll
                    for (int m = 0; m < 4; ++m) st[m] = MFMA16(kf[m][ks], qf[mp][ks], st[m]);
                SCHED();
                float mx = -INFINITY;
#pragma unroll
                for (int m = 0; m < 4; ++m) {
                    if (KIND == 0) {
                        const f32x4 ck = *(const f32x4*)(cb + m * 16 + 4 * q4);
#pragma unroll
                        for (int j = 0; j < 4; ++j) {
                            float y = st[m][j] + (cq - ck[j]);
                            if (kt * 64 + m * 16 + 4 * q4 + j > myq) y = -INFINITY;
                            st[m][j] = y;
                        }
                    }
#pragma unroll
                    for (int j = 0; j < 4; ++j) mx = fmaxf(mx, st[m][j]);
                }
                mx = xrow16_max(mx);
                const float mnew = fmaxf(mrun[mp], mx);
                const float alpha = FAST_EXP2(mrun[mp] - mnew);
                mrun[mp] = mnew;
                float ps = 0.f;
#pragma unroll
                for (int m = 0; m < 4; ++m)
#pragma unroll
                    for (int j = 0; j < 4; ++j) { const float pv = FAST_EXP2(st[m][j] - mnew); st[m][j] = pv; ps += pv; }
                lsum[mp] = lsum[mp] * alpha + ps;
#pragma unroll
                for (int mo = 0; mo < 8; ++mo) ot[mp][mo] *= alpha;
                bf16x8 pf[2];
#pragma unroll
                for (int kk = 0; kk < 2; ++kk) {
                    u32x4 pw;
                    pw.x = pack2(st[2 * kk][0], st[2 * kk][1]); pw.y = pack2(st[2 * kk][2], st[2 * kk][3]);
                    pw.z = pack2(st[2 * kk + 1][0], st[2 * kk + 1][1]); pw.w = pack2(st[2 * kk + 1][2], st[2 * kk + 1][3]);
                    pf[kk] = __builtin_bit_cast(bf16x8, pw);
                }
                bf16x8 vfb[8];
#pragma unroll
                for (int mo = 0; mo < 8; ++mo) { const int d = mo * 16 + r16; vfb[mo] = *(const bf16x8*)(vb + d * 128 + (((1 * 4 + q4) ^ ((d >> 1) & 7)) << 4)); }
                SCHED();
#pragma unroll
                for (int mo = 0; mo < 8; ++mo) ot[mp][mo] = MFMA16(vfa[mo], pf[0], ot[mp][mo]);
                SCHED();
#pragma unroll
                for (int mo = 0; mo < 8; ++mo) ot[mp][mo] = MFMA16(vfb[mo], pf[1], ot[mp][mo]);
            }
        }
    }
    float inv[NMAP];
#pragma unroll
    for (int mp = 0; mp < NMAP; ++mp) { float l = lsum[mp]; l = xrow16_sum(l); inv[mp] = 1.f / l; }
    if (KIND == 0) {
#pragma unroll
        for (int mo = 0; mo < 8; ++mo) {
            u32x2 o; o.x = pack2(ot[0][mo][0] * inv[0], ot[0][mo][1] * inv[0]); o.y = pack2(ot[0][mo][2] * inv[0], ot[0][mo][3] * inv[0]);
            *(u32x2*)(concat + (size_t)myq * D + ccol0 + mo * 16 + 4 * q4) = o;
        }
    } else {
        float ss = 0.f;
#pragma unroll
        for (int mo = 0; mo < 8; ++mo)
#pragma unroll
            for (int j = 0; j < 4; ++j) { const float v = ot[0][mo][j] * inv[0] - lam * (ot[NMAP - 1][mo][j] * inv[NMAP - 1]); ot[0][mo][j] = v; ss += v * v; }
        ss = xrow16_sum(ss);
        const float rs = osc / sqrtf(ss * (1.f / 128.f) + LN_EPS);
#pragma unroll
        for (int mo = 0; mo < 8; ++mo) {
            const f32x4 g = *(const f32x4*)(subg + mo * 16 + 4 * q4);
            u32x2 o; o.x = pack2(ot[0][mo][0] * rs * g[0], ot[0][mo][1] * rs * g[1]); o.y = pack2(ot[0][mo][2] * rs * g[2], ot[0][mo][3] * rs * g[3]);
            *(u32x2*)(concat + (size_t)myq * D + ccol0 + mo * 16 + 4 * q4) = o;
        }
    }
    __syncthreads();
}

__device__ __forceinline__ int dpart_row(int c, int q) { return c * (S - DCH * 64) - (DCH * 32) * c * (c - 1) + q; }
__device__ __forceinline__ void attn_dmap_unit(const bf16_t* Qh, const bf16_t* Kh, const bf16_t* VTh, int mp, int qb, int t0, int t1,
                                               bf16_t* Op, float* ML, int c, float bnd, unsigned char* lds, int tid) {
    const bool fixedref = (bnd <= 60.f);
    const int lane = tid & 63, wave = tid >> 6, r16 = lane & 15, q4 = lane >> 4;
    const int q0w = qb * 256 + wave * 32;
    const int wlimit = q0w >> 6;
    bf16x8 qf[2][2];
#pragma unroll
    for (int n = 0; n < 2; ++n)
#pragma unroll
        for (int ks = 0; ks < 2; ++ks) qf[n][ks] = *(const bf16x8*)(Qh + (size_t)(q0w + n * 16 + r16) * 128 + mp * 64 + ks * 32 + q4 * 8);
    f32x4 ot[8][2];
    float mrun[2] = {-INFINITY, -INFINITY}, lsum[2] = {0.f, 0.f};
    if (fixedref) { mrun[0] = bnd; mrun[1] = bnd; }
    const float stinit = fixedref ? -bnd : 0.f;
#pragma unroll
    for (int mo = 0; mo < 8; ++mo) { ot[mo][0] = (f32x4){0.f, 0.f, 0.f, 0.f}; ot[mo][1] = (f32x4){0.f, 0.f, 0.f, 0.f}; }
    u32x4 sk, sv[2];
    const u32x4* kg = (const u32x4*)Kh; const u32x4* vg = (const u32x4*)VTh;
    const int krow = tid >> 3, kc8 = tid & 7;
    sk = kg[(size_t)t0 * 1024 + krow * 16 + mp * 8 + kc8];
#pragma unroll
    for (int i = 0; i < 2; ++i) sv[i] = vg[(size_t)t0 * 1024 + tid + i * 512];
    for (int kt = t0; kt < t1; ++kt) {
        unsigned char* kb = lds + (kt & 1) * 8192;
        unsigned char* vb = lds + 16384 + (kt & 1) * 16384;
        *(u32x4*)(kb + krow * 128 + ((kc8 ^ ((krow >> 1) & 7)) << 4)) = sk;
#pragma unroll
        for (int i = 0; i < 2; ++i) { const int g = tid + i * 512, d = g >> 3, cc = g & 7; *(u32x4*)(vb + d * 128 + ((cc ^ ((d >> 1) & 7)) << 4)) = sv[i]; }
        __syncthreads();
        if (kt + 1 < t1) {
            sk = kg[(size_t)(kt + 1) * 1024 + krow * 16 + mp * 8 + kc8];
#pragma unroll
            for (int i = 0; i < 2; ++i) sv[i] = vg[(size_t)(kt + 1) * 1024 + tid + i * 512];
        }
        if (kt <= wlimit) {
            bf16x8 kf[4][2], vfa[8];
#pragma unroll
            for (int m = 0; m < 4; ++m)
#pragma unroll
                for (int ks = 0; ks < 2; ++ks) kf[m][ks] = *(const bf16x8*)(kb + (m * 16 + r16) * 128 + (((ks * 4 + q4) ^ ((r16 >> 1) & 7)) << 4));
#pragma unroll
            for (int mo = 0; mo < 8; ++mo) { const int d = mo * 16 + r16; vfa[mo] = *(const bf16x8*)(vb + d * 128 + (((0 * 4 + q4) ^ ((d >> 1) & 7)) << 4)); }
            SCHED();
            f32x4 st[4][2];
#pragma unroll
            for (int m = 0; m < 4; ++m) { st[m][0] = (f32x4){stinit, stinit, stinit, stinit}; st[m][1] = (f32x4){stinit, stinit, stinit, stinit}; }
            SETPRIO(1);
#pragma unroll
            for (int ks = 0; ks < 2; ++ks)
#pragma unroll
                for (int m = 0; m < 4; ++m) { st[m][0] = MFMA16(kf[m][ks], qf[0][ks], st[m][0]); st[m][1] = MFMA16(kf[m][ks], qf[1][ks], st[m][1]); }
            SETPRIO(0);
            SCHED();
            float alpha[2] = {1.f, 1.f};
            if (fixedref) {
#pragma unroll
                for (int n = 0; n < 2; ++n) {
                    float ps = 0.f;
#pragma unroll
                    for (int m = 0; m < 4; ++m)
#pragma unroll
                        for (int j = 0; j < 4; ++j) { const float pv = FAST_EXP2(st[m][n][j]); st[m][n][j] = pv; ps += pv; }
                    lsum[n] += ps;
                }
            } else
#pragma unroll
            for (int n = 0; n < 2; ++n) {
                float mx = -INFINITY;
#pragma unroll
                for (int m = 0; m < 4; ++m)
#pragma unroll
                    for (int j = 0; j < 4; ++j) mx = fmaxf(mx, st[m][n][j]);
                mx = xrow16_max(mx);
                const float mnew = fmaxf(mrun[n], mx);
                alpha[n] = FAST_EXP2(mrun[n] - mnew);
                mrun[n] = mnew;
                float ps = 0.f;
#pragma unroll
                for (int m = 0; m < 4; ++m)
#pragma unroll
                    for (int j = 0; j < 4; ++j) { const float pv = FAST_EXP2(st[m][n][j] - mnew); st[m][n][j] = pv; ps += pv; }
                lsum[n] = lsum[n] * alpha[n] + ps;
            }
            if (ANY_LANE(alpha[0] != 1.f)) {
#pragma unroll
                for (int mo = 0; mo < 8; ++mo) ot[mo][0] *= alpha[0];
            }
            if (ANY_LANE(alpha[1] != 1.f)) {
#pragma unroll
                for (int mo = 0; mo < 8; ++mo) ot[mo][1] *= alpha[1];
            }
            bf16x8 pf[2][2];
#pragma unroll
            for (int kk = 0; kk < 2; ++kk)
#pragma unroll
                for (int n = 0; n < 2; ++n) {
                    u32x4 pw;
                    pw.x = pack2(st[2 * kk][n][0], st[2 * kk][n][1]); pw.y = pack2(st[2 * kk][n][2], st[2 * kk][n][3]);
                    pw.z = pack2(st[2 * kk + 1][n][0], st[2 * kk + 1][n][1]); pw.w = pack2(st[2 * kk + 1][n][2], st[2 * kk + 1][n][3]);
                    pf[kk][n] = __builtin_bit_cast(bf16x8, pw);
                }
            bf16x8 vfb[8];
#pragma unroll
            for (int mo = 0; mo < 8; ++mo) { const int d = mo * 16 + r16; vfb[mo] = *(const bf16x8*)(vb + d * 128 + (((1 * 4 + q4) ^ ((d >> 1) & 7)) << 4)); }
            SCHED();
            SETPRIO(1);
#pragma unroll
            for (int mo = 0; mo < 8; ++mo) { ot[mo][0] = MFMA16(vfa[mo], pf[0][0], ot[mo][0]); ot[mo][1] = MFMA16(vfa[mo], pf[0][1], ot[mo][1]); }
            SCHED();
#pragma unroll
            for (int mo = 0; mo < 8; ++mo) { ot[mo][0] = MFMA16(vfb[mo], pf[1][0], ot[mo][0]); ot[mo][1] = MFMA16(vfb[mo], pf[1][1], ot[mo][1]); }
            SETPRIO(0);
        }
    }
    if (q0w >= DCH * 64 * c)
#pragma unroll
    for (int n = 0; n < 2; ++n) {
        float l = lsum[n]; l = xrow16_sum(l);
        const int row = dpart_row(c, q0w + n * 16 + r16);
#pragma unroll
        for (int mo = 0; mo < 8; ++mo) {
            u32x2 o; o.x = pack2(ot[mo][n][0], ot[mo][n][1]); o.y = pack2(ot[mo][n][2], ot[mo][n][3]);
            *(u32x2*)(Op + (size_t)(row * 128 + mo * 16 + 4 * q4)) = o;
        }
        if (q4 == 0) { ML[row * 2] = mrun[n]; ML[row * 2 + 1] = l; }
    }
    __syncthreads();
}

__device__ __forceinline__ void lru_unit_a(int chunk, int grp, int l, const Params& p, const bf16_t* Xr, const bf16_t* WaiT, float* hloc, float* ploc, float* sumA, float* sumH,
                                           unsigned char* lds, int tid) {
    const int lane = tid & 63, wave = tid >> 6, r16 = lane & 15, q4 = lane >> 4;
    unsigned char* XCB = lds; float* XU = (float*)(lds + 16384); float* LA = (float*)(lds + 49152); float* ENDS = (float*)(lds + 81920);
    const int t0 = chunk * 64, ch0 = grp * 128;
    bf16x8 bfr[2][4];
#pragma unroll
    for (int g = 0; g < 2; ++g)
#pragma unroll
        for (int ks = 0; ks < 4; ++ks) bfr[g][ks] = *(const bf16x8*)(WaiT + ((size_t)grp * 256 + g * 128 + wave * 16 + r16) * 128 + ks * 32 + q4 * 8);
    const int chg = ch0 + wave * 16 + r16;
    const float ba = p.in[I_BA][(size_t)l * LRU_W + chg], bi = p.in[I_BI][(size_t)l * LRU_W + chg];
    const float lam_raw = p.in[I_LAM][(size_t)l * LRU_W + chg];
    {
        const int c = tid & 127, tq = tid >> 7, ch = ch0 + c;
        const float* cw = p.in[I_CONVW] + (size_t)l * 4 * LRU_W + ch; const float cb = p.in[I_CONVB][(size_t)l * LRU_W + ch];
        const float w0 = cw[0], w1 = cw[LRU_W], w2 = cw[2 * LRU_W], w3 = cw[3 * LRU_W];
        const int ts = t0 + tq * 16;
        float x0 = (ts - 3 >= 0) ? bf2f(Xr[(size_t)(ts - 3) * LRU_W + ch]) : 0.f;
        float x1 = (ts - 2 >= 0) ? bf2f(Xr[(size_t)(ts - 2) * LRU_W + ch]) : 0.f;
        float x2 = (ts - 1 >= 0) ? bf2f(Xr[(size_t)(ts - 1) * LRU_W + ch]) : 0.f;
#pragma unroll
        for (int i = 0; i < 16; ++i) {
            const float x3 = bf2f(Xr[(size_t)(ts + i) * LRU_W + ch]);
            const float v = cb + w0 * x0 + w1 * x1 + w2 * x2 + w3 * x3;
            const int row = tq * 16 + i;
            XU[row * 128 + c] = v;
            *(bf16_t*)(XCB + row * 256 + (((c >> 3) ^ (row & 15)) << 4) + (c & 7) * 2) = f2bf(v);
            x0 = x1; x1 = x2; x2 = x3;
        }
    }
    __syncthreads();
    {
        const float lsl = 8.0f * log_sigmoid_f(lam_raw);
#pragma unroll
        for (int mt = 0; mt < 4; ++mt) {
            f32x4 ga = (f32x4){0.f, 0.f, 0.f, 0.f}, gi = (f32x4){0.f, 0.f, 0.f, 0.f};
#pragma unroll
            for (int ks = 0; ks < 4; ++ks) {
                const bf16x8 af = *(const bf16x8*)(XCB + (mt * 16 + r16) * 256 + (((ks * 4 + q4) ^ r16) << 4));
                ga = MFMA16(af, bfr[0][ks], ga); gi = MFMA16(af, bfr[1][ks], gi);
            }
#pragma unroll
            for (int j = 0; j < 4; ++j) {
                const int row = mt * 16 + 4 * q4 + j, idx = row * 128 + wave * 16 + r16;
                const float r = sigmoid_f(ga[j] + ba), ig = sigmoid_f(gi[j] + bi);
                const float log_a = lsl * r;
                LA[idx] = fexp(log_a);
                XU[idx] = sqrtf(neg_expm1_f(2.f * log_a)) * (ig * XU[idx]);
            }
        }
    }
    __syncthreads();
    {
        const int c = tid & 127, tq = tid >> 7, ch = ch0 + c;
        float h = 0.f, P = 1.f;
#pragma unroll
        for (int i = 0; i < 16; ++i) { const int idx = (tq * 16 + i) * 128 + c; const float a = LA[idx]; h = a * h + XU[idx]; P *= a; XU[idx] = h; LA[idx] = P; }
        ENDS[tq * 128 + c] = P; ENDS[512 + tq * 128 + c] = h;
        __syncthreads();
        float cin = 0.f, pin = 1.f;
        for (int s = 0; s < tq; ++s) { const float Ps = ENDS[s * 128 + c], hs = ENDS[512 + s * 128 + c]; cin = Ps * cin + hs; pin *= Ps; }
#pragma unroll
        for (int i = 0; i < 16; ++i) {
            const int idx = (tq * 16 + i) * 128 + c; const size_t gi = (size_t)(t0 + tq * 16 + i) * LRU_W + ch;
            const float Pl = LA[idx], hl = XU[idx];
            ((unsigned*)hloc)[gi] = pack2(hl + Pl * cin, Pl * pin);
        }
        if (tq == 3) { const float Pl = LA[63 * 128 + c], hl = XU[63 * 128 + c]; sumA[(size_t)chunk * LRU_W + ch] = Pl * pin; sumH[(size_t)chunk * LRU_W + ch] = hl + Pl * cin; }
    }
    __syncthreads();
}

__device__ __forceinline__ void moe_prefix(const int* cntb_, int G, unsigned char* lds, int tid) {
    int* tmp = (int*)lds; int* ctot = (int*)(lds + LDS_MISC + M_CTOT); int* coff = (int*)(lds + LDS_MISC + M_COFF);
    unsigned short* pre16 = (unsigned short*)(lds + LDS_MISC + M_PRE16);
    const int e = tid & 31, part = tid >> 5, PB = (G + 15) / 16;
    int sm = 0;
    for (int i = 0; i < PB; ++i) { const int b = part * PB + i; if (b < G) sm += cntb_[b * 32 + e]; }
    tmp[part * 32 + e] = sm;
    __syncthreads();
    int run = 0;
    for (int q = 0; q < part; ++q) run += tmp[q * 32 + e];
    for (int i = 0; i < PB; ++i) { const int b = part * PB + i; if (b < G) { pre16[e * 257 + b] = (unsigned short)run; run += cntb_[b * 32 + e]; } }
    if (part == 15) { ctot[e] = run; pre16[e * 257 + G] = (unsigned short)run; }
    __syncthreads();
    if (tid == 0) { int o = 0; for (int q = 0; q < 32; ++q) { coff[q] = o; o += ctot[q]; } coff[32] = o; }
    __syncthreads();
}
__device__ __forceinline__ void moe_rowtable(const int* ltok_, const float* lw_, const int* lslot_, int e, int m0, int c_e, int G, int segcap, unsigned char* lds, int tid_in) {
    int tid = tid_in; OPAQUE(tid);
    const unsigned short* pre = (const unsigned short*)(lds + LDS_MISC + M_PRE16) + e * 257;
    int* rtok = (int*)(lds + LDS_MISC + M_RTOK); float* rw = (float*)(lds + LDS_MISC + M_RW); int* rslot = (int*)(lds + LDS_MISC + M_RSLOT);
    if (tid < 256) {
        const int g = m0 + tid;
        int tk = 0, sl = 0; float w = 0.f;
        if (g < c_e) {
            int lo = 0, hi = G;
            while (hi - lo > 1) { const int mid = (lo + hi) >> 1; if ((int)pre[mid] <= g) lo = mid; else hi = mid; }
            const int idx = (e * G + lo) * segcap + (g - (int)pre[lo]);
            tk = ltok_[idx]; w = lw_[idx]; sl = lslot_[idx];
        }
        rtok[tid] = tk; rw[tid] = w; rslot[tid] = sl;
    }
    __syncthreads();
}
#define kmax2 ((float*)(wsl + A_KMAX))
#define dpo ((bf16_t*)(wsl + A_DPO))
#define dpml ((float*)(wsl + A_DPML))
#define cntb ((int*)(wsl + A_CNTB))
#define WinT ((bf16_t*)(wsl + WB_WIN))
#define WoT ((bf16_t*)(wsl + WB_WO))
#define WguT ((bf16_t*)(wsl + WB_WGU))
#define WdT ((bf16_t*)(wsl + WB_WD))
#define WaiT ((bf16_t*)(wsl + WB_WAI))
#define Wfa ((float*)(wsl + WF_FA))
#define W36b ((bf16_t*)(wsl + WF_R36))
#define ropecs ((float*)(wsl + WF_ROPE))
#define xb ((bf16_t*)(wsl + A_XB))
#define hb ((float*)(wsl + A_HB))
#define logf_ ((float*)(wsl + A_LOGF))
#define cum2 ((float*)(wsl + A_CUM))
#define Qa ((bf16_t*)(wsl + A_QA))
#define Ka ((bf16_t*)(wsl + A_KA))
#define VaT ((bf16_t*)(wsl + A_VAT))
#define Xr ((bf16_t*)(wsl + A_XR))
#define Gr ((bf16_t*)(wsl + A_GR))
#define Qc ((bf16_t*)(wsl + A_QC))
#define Kc ((bf16_t*)(wsl + A_KC))
#define VcT ((bf16_t*)(wsl + A_VCT))
#define hloc ((float*)(wsl + A_HLOC))
#define ploc ((float*)(wsl + A_PLOC))
#define sumA ((float*)(wsl + A_SUMA))
#define sumH ((float*)(wsl + A_SUMH))
#define concat ((bf16_t*)(wsl + A_CONCAT))
#define y1 ((float*)(wsl + A_Y1))
#define h1 ((float*)(wsl + A_H1))
#define h1b ((bf16_t*)(wsl + A_H1B))
#define ltok ((int*)(wsl + A_LTOK))
#define lw ((float*)(wsl + A_LW))
#define lslot ((int*)(wsl + A_LSLOT))
#define act ((bf16_t*)(wsl + A_ACT))
#define contrib ((bf16_t*)(wsl + A_CONTRIB))
#ifndef EMU
__global__ void __launch_bounds__(NTHREADS, 2)
#else
void
#endif
fwd_kernel(Params p) {
    DYN_LDS(lds_raw);
    float* ldsf = (float*)lds_raw;
    const int bid = blockIdx.x, G = gridDim.x;
    const int gthreads = G * NTHREADS, gwaves = G * (NTHREADS / 64);
    const int wave_s = RFL((int)threadIdx.x >> 6);
#define PHASE_IDS() unsigned char* wsl = ws; OPAQUE_S(wsl); int tid = wave_s * 64 + LANE_ID(); OPAQUE(tid); const int lane = tid & 63, wave = tid >> 6, gtid = bid * NTHREADS + tid, gwave = bid * (NTHREADS / 64) + wave; (void)lane; (void)wave; (void)gtid; (void)gwave

    unsigned char* ws = p.ws;
    volatile LAS unsigned* bst = (volatile LAS unsigned*)(lds_raw + LDS_MISC);
    unsigned* ubox = (unsigned*)(lds_raw + LDS_MISC + 16);
    if (threadIdx.x == 0) { bst[0] = 0u; bst[1] = 0u; bst[2] = 0u; bst[3] = 0u; }
    __syncthreads();
    XcdBarrier bar = xcd_barrier_post((unsigned*)ws, bst);

    const int* positions = (const int*)p.in[I_POS];

    constexpr int NPH = 8;
    const int lo = p.lo, hi = p.hi;
#ifdef ONLY_PHASE
#define PH_SEL(c) ((c) == ONLY_PHASE)
#else
#define PH_SEL(c) 1
#endif
#define PH_IN(k) (lo <= (k) && (k) < hi)
#define PH_BAR(k) do { if ((k) + 1 < hi) xcd_barrier(bar, wave_s == 0 && LANE_ID() == 0); } while (0)

    if (PH_SEL(-1) && PH_IN(0)) for (int rep = 0; rep < PH_REPS(-1); ++rep) {
        PHASE_IDS();
        for (int l = 0; l < DEPTH; ++l) {
            convert_mats(p.in[I_WIN] + (size_t)l * D * N_IN, 0, 1, N_IN, D, N_IN, WinT + (size_t)l * N_INP * D, 0, RmWin{}, ldsf, tid, bid, G);
            for (int t = bid; t < (D / 64) * (D / 256); t += G)
                convert_tile_v4(p.in[I_WO] + (size_t)l * D * D, D, D, (t / (D / 256)) * 64, (t % (D / 256)) * 256, WoT + (size_t)l * D * D, RmIdent{}, ldsf, tid);
            convert_mats(p.in[I_WA] + (size_t)l * 6 * 128 * 128, (size_t)128 * 128, 6, 128, 128, 128, WaiT + (size_t)l * 6 * 256 * 128, (size_t)256 * 128, RmIdent{}, ldsf, tid, bid, G);
            convert_mats(p.in[I_WI] + (size_t)l * 6 * 128 * 128, (size_t)128 * 128, 6, 128, 128, 128, WaiT + (size_t)l * 6 * 256 * 128, (size_t)256 * 128, RmOff{128}, ldsf, tid, bid, G);
        }
        for (int i = gtid; i < DEPTH * 8 * D; i += gthreads) { const int k = i % D, h = (i / D) % 8, l = i / (8 * D);
            Wfa[i] = (h < 6) ? p.in[I_WIN][(size_t)l * D * N_IN + (size_t)k * N_IN + C_FA + h] : 0.f; }
        for (int i = gtid; i < DEPTH * 48 * D; i += gthreads) { const int k = i % D, o = (i / D) % 48, l = i / (48 * D);
            const float w = (o < 4) ? p.in[I_WGRP][((size_t)l * D + k) * 4 + o] : (o < 36 ? p.in[I_WRT][((size_t)l * D + k) * 32 + (o - 4)] : 0.f);
            const bf16_t hi = f2bf(w);
            W36b[((size_t)l * 2 + 0) * 48 * D + (size_t)o * D + k] = hi; W36b[((size_t)l * 2 + 1) * 48 * D + (size_t)o * D + k] = f2bf(w - bf2f(hi)); }
        for (int i = gtid; i < S * 8; i += gthreads) { const int d = i & 7, t = i >> 3; const float ang = (float)positions[t] * p.inv_freq[d];
            ropecs[t * 16 + d] = cosf(ang); ropecs[t * 16 + 8 + d] = sinf(ang); }
        __syncthreads();
        for (int i = tid; i < 6 * D; i += NTHREADS) { const int k = i % D, h = i / D; ldsf[i] = p.in[I_WIN][(size_t)k * N_IN + C_FA + h]; }
        __syncthreads();
        for (int t0 = gwave * 2; t0 < S; t0 += gwaves * 2) {
            f32x4 v[2][8];
#pragma unroll
            for (int tk = 0; tk < 2; ++tk)
#pragma unroll
                for (int j = 0; j < 8; ++j) v[tk][j] = *(const f32x4*)(p.in[I_X] + (size_t)(t0 + tk) * D + j * 256 + lane * 4);
#pragma unroll
            for (int tk = 0; tk < 2; ++tk) {
                const int t = t0 + tk;
                float fa[6] = {0.f, 0.f, 0.f, 0.f, 0.f, 0.f};
#pragma unroll
                for (int j = 0; j < 8; ++j) {
                    const int c = j * 256 + lane * 4;
                    u32x2 o; o.x = pack2(v[tk][j][0], v[tk][j][1]); o.y = pack2(v[tk][j][2], v[tk][j][3]);
                    *(u32x2*)(xb + (size_t)t * D + c) = o;
#pragma unroll
                    for (int h = 0; h < 6; ++h) { const f32x4 w = *(const f32x4*)(ldsf + h * D + c); fa[h] += v[tk][j][0] * w[0] + v[tk][j][1] * w[1] + v[tk][j][2] * w[2] + v[tk][j][3] * w[3]; }
                    COMPILER_FENCE();
                }
#pragma unroll
                for (int h = 0; h < 6; ++h) { const float sm = wave_sum(fa[h]); if (lane == 0) logf_[h * S + t] = log_sigmoid_f(sm + p.in[I_BF][h]); }
            }
        }
        PH_BAR(0);
    }

    for (int l = 0; l < DEPTH; ++l) {
        const int pb = 1 + l * NPH;
#define hin ((l == 0) ? p.in[I_X] : (const float*)hb)
#define hout ((l == DEPTH - 1) ? p.out : hb)
#define workctr ((int*)(wsl + CTL_WORK_OFF) + l * 64)

        if (PH_SEL(0) && PH_IN(pb + 0)) {
            PHASE_IDS();
            int bz = RFL(bid); OPAQUE_S(bz);
            if (bz == 0) {
                double* part = (double*)lds_raw;
                const int per = S / 64;
                double s = 0.0;
                if (wave < 6) { for (int i = 0; i < per; ++i) s += (double)logf_[wave * S + lane * per + i]; part[wave * 64 + lane] = s; }
                __syncthreads();
                if (wave < 6) {
                    double run = 0.0;
                    for (int j = 0; j < lane; ++j) run += part[wave * 64 + j];
                    for (int i = 0; i < per; ++i) { run += (double)logf_[wave * S + lane * per + i]; cum2[wave * S + lane * per + i] = (float)(run * (double)LOG2E); }
                }
                __syncthreads();
            }
            bool conv_more = (l == 0);
#define CONV_ONE() do { if (conv_more) { __syncthreads(); if (tid == 0) *ubox = (unsigned)atomic_add_int((int*)(wsl + CTL_WORK_OFF) + 62, 1); __syncthreads(); \
                const int cid_ = RFL((int)*ubox); if (cid_ < NCONV) moe_conv_chunk(p, cid_, WguT, WdT, ldsf, tid); else conv_more = false; } } while (0)
            unsigned* cls = (unsigned*)(wsl + CTL_CLS_OFF) + l * 256;
            if (bz == 0) { WAIT_VM0(); __syncthreads(); if (tid == 0) { FENCE_REL_AGENT(); WAIT_VM0(); (void)xb_add(&cls[192], 1u); } }
            const bf16_t* Bt = WinT + (size_t)l * N_INP * D;
            constexpr int ntm = S / 256;
            const unsigned nooff[2][2] = {{0u, 0u}, {0u, 0u}};
            for (int i = 0; i < (bid & 3); ++i) CONV_ONE();
            for (;;) {
                __syncthreads();
                if (tid == 0) *ubox = (unsigned)atomic_add_int(workctr + 9, 1);
                __syncthreads();
                int t = RFL((int)*ubox);
                if (t >= ntm * 21) break;
                int pm, pn, kcls;
                if (t < ntm * 6) { pm = t / 6; pn = 15 + t % 6; kcls = 0; }
                else if (t < ntm * 12) { t -= ntm * 6; pm = t / 6; pn = 9 + t % 6; kcls = 1; }
                else { t -= ntm * 12; pm = t / 9; pn = t % 9; kcls = 2; }
                f32x4 acc[2][2][4][2];
                gemm_tile<false>(xb, pm * 256, nooff, Bt, pn * 256, D, lds_raw, acc, tid);
                int et = tid; OPAQUE(et); const int wr = et >> 8, wc = (et >> 6) & 3, fr = et & 15, fq = (et >> 4) & 3;
                if (pn < 6 || (pn >= 9 && pn < 19)) {
                    bf16_t* dst; float scale = 1.f; bool rope = false;
                    if (pn < 3) { dst = Qa; scale = QSCALE_A; } else if (pn < 6) { dst = Ka; } else if (pn < 12) { dst = Xr; } else if (pn < 15) { dst = Gr; }
                    else if (pn < 17) { dst = Qc; scale = QSCALE_C; rope = true; } else { dst = Kc; rope = true; }
                    const bool headmajor = (pn < 6) || (pn >= 15);
                    const int segpn = (pn < 3) ? pn : (pn < 6) ? pn - 3 : (pn < 12) ? pn - 9 : (pn < 15) ? pn - 12 : (pn < 17) ? pn - 15 : pn - 17;
#pragma unroll
                    for (int ai = 0; ai < 2; ++ai)
#pragma unroll
                        for (int m = 0; m < 4; ++m)
#pragma unroll
                            for (int bj = 0; bj < 2; ++bj)
#pragma unroll
                                for (int n = 0; n < 2; ++n) {
                                    const int dd = wc * 32 + n * 16 + fr;
#pragma unroll
                                    for (int j = 0; j < 4; ++j) {
                                        const int row = pm * 256 + ai * 128 + wr * 64 + m * 16 + fq * 4 + j;
                                        float v = acc[ai][bj][m][n][j];
                                        if (rope && n == 0 && (wc & 1) == 0) {
                                            const float pv = SHX(v, 8);
                                            const float cs = ropecs[row * 16 + (fr & 7)], sn = ropecs[row * 16 + 8 + (fr & 7)];
                                            v = (fr < 8) ? (v * cs - pv * sn) : (v * cs + pv * sn);
                                        }
                                        v *= scale;
                                        *(bf16_t*)(lds_raw + (ai * 128 + wr * 64 + m * 16 + fq * 4 + j) * 528 + (bj * 128 + dd) * 2) = f2bf(v);
                                    }
                                }
                    __syncthreads();
#pragma unroll 4
                    for (int i = 0; i < 16; ++i) {
                        const int idx = et + i * 512, lrow = idx >> 5, ch = idx & 31, row = pm * 256 + lrow;
                        const u32x4 val = *(const u32x4*)(lds_raw + lrow * 528 + ch * 16);
                        size_t gi;
                        if (headmajor) gi = ((size_t)(segpn * 2 + (ch >> 4)) * S + row) * 128 + (ch & 15) * 8;
                        else gi = (size_t)row * LRU_W + segpn * 256 + ch * 8;
                        *(u32x4*)(dst + gi) = val;
                    }
                    __syncthreads();
                    if (pn >= 15) {
                        float* part = ldsf;
#pragma unroll
                        for (int ai = 0; ai < 2; ++ai)
#pragma unroll
                            for (int m = 0; m < 4; ++m)
#pragma unroll
                                for (int bj = 0; bj < 2; ++bj)
#pragma unroll
                                    for (int j = 0; j < 4; ++j) {
                                        float ss = acc[ai][bj][m][0][j] * acc[ai][bj][m][0][j] + acc[ai][bj][m][1][j] * acc[ai][bj][m][1][j];
                                        ss += SHX(ss, 1); ss += SHX(ss, 2); ss += SHX(ss, 4); ss += SHX(ss, 8);
                                        if (fr == 0) part[(wc * 2 + bj) * 256 + ai * 128 + wr * 64 + m * 16 + fq * 4 + j] = ss;
                                    }
                        __syncthreads();
                        {
                            const int bj = et >> 8, row = et & 255;
                            float v0 = part[(0 * 2 + bj) * 256 + row] + part[(1 * 2 + bj) * 256 + row], v1 = part[(2 * 2 + bj) * 256 + row] + part[(3 * 2 + bj) * 256 + row];
                            v0 = fmaxf(v0, SHX(v0, 1)); v0 = fmaxf(v0, SHX(v0, 2)); v0 = fmaxf(v0, SHX(v0, 4)); v0 = fmaxf(v0, SHX(v0, 8)); v0 = xrow16_max(v0);
                            v1 = fmaxf(v1, SHX(v1, 1)); v1 = fmaxf(v1, SHX(v1, 2)); v1 = fmaxf(v1, SHX(v1, 4)); v1 = fmaxf(v1, SHX(v1, 8)); v1 = xrow16_max(v1);
                            if ((et & 63) == 0) {
                                unsigned* q2p = (unsigned*)(wsl + CTL_QK2_OFF) + l * 16 + (pn >= 17 ? 8 : 0) + (segpn * 2 + bj) * 2;
                                atomic_max_u32(q2p, __builtin_bit_cast(unsigned, v0)); atomic_max_u32(q2p + 1, __builtin_bit_cast(unsigned, v1));
                            }
                        }
                        __syncthreads();
                    }
                    if (pn >= 3 && pn < 6) {
                        float* part = ldsf;
#pragma unroll
                        for (int ai = 0; ai < 2; ++ai)
#pragma unroll
                            for (int m = 0; m < 4; ++m)
#pragma unroll
                                for (int bj = 0; bj < 2; ++bj)
#pragma unroll
                                    for (int j = 0; j < 4; ++j) {
                                        float ss = acc[ai][bj][m][0][j] * acc[ai][bj][m][0][j] + acc[ai][bj][m][1][j] * acc[ai][bj][m][1][j];
                                        ss += SHX(ss, 1); ss += SHX(ss, 2); ss += SHX(ss, 4); ss += SHX(ss, 8);
                                        if (fr == 0) part[(wc * 2 + bj) * 256 + ai * 128 + wr * 64 + m * 16 + fq * 4 + j] = ss;
                                    }
                        __syncthreads();
                        {
                            const int bj = et >> 8, row = et & 255;
                            float v = part[(0 * 2 + bj) * 256 + row] + part[(1 * 2 + bj) * 256 + row] + part[(2 * 2 + bj) * 256 + row] + part[(3 * 2 + bj) * 256 + row];
                            v = fmaxf(v, SHX(v, 1)); v = fmaxf(v, SHX(v, 2)); v = fmaxf(v, SHX(v, 4)); v = fmaxf(v, SHX(v, 8)); v = xrow16_max(v);
                            if ((et & 63) == 0) kmax2[((pn - 3) * 2 + bj) * NKT + pm * 4 + ((et >> 6) & 3)] = v;
                        }
                        __syncthreads();
                    }
                } else {
                    bf16_t* dst = (pn < 9) ? VaT : VcT;
                    const int segpn = (pn < 9) ? pn - 6 : pn - 19;
#pragma unroll
                    for (int ai = 0; ai < 2; ++ai)
#pragma unroll
                        for (int m = 0; m < 4; ++m)
#pragma unroll
                            for (int bj = 0; bj < 2; ++bj)
#pragma unroll
                                for (int n = 0; n < 2; ++n) {
                                    const int dd = wc * 32 + n * 16 + fr;
                                    const int row = pm * 256 + ai * 128 + wr * 64 + m * 16 + fq * 4;
                                    const f32x4 a = acc[ai][bj][m][n];
                                    u32x2 o; o.x = pack2(a[0], a[1]); o.y = pack2(a[2], a[3]);
                                    const int s6 = row & 63, pos = (s6 & 32) + ((s6 >> 2) & 3) * 8 + ((s6 >> 4) & 1) * 4;
                                    *(u32x2*)(dst + (((size_t)(segpn * 2 + bj) * NKT + (row >> 6)) * 128 + dd) * 64 + pos) = o;
                                }
                }
                WAIT_VM0();
                __syncthreads();
                if (et == 0) { FENCE_REL_AGENT(); WAIT_VM0(); (void)xb_add(&cls[kcls * 64], 1u); }
                CONV_ONE();
            }
        }

        if (PH_SEL(1) && PH_IN(pb + 1)) {
            PHASE_IDS();
            const float lam_init = (l == 0) ? 0.2f : 0.35550906759f;
            const float s1 = wave_sum(p.in[I_LQ1][l * 64 + lane] * p.in[I_LK1][l * 64 + lane]);
            const float s2 = wave_sum(p.in[I_LQ2][l * 64 + lane] * p.in[I_LK2][l * 64 + lane]);
            const float lam = fexp(s1) - fexp(s2) + lam_init;
            constexpr int NLRU = NKT * 6, NQB = S / 128;
            bool conv_more = (l == 0);
            unsigned* cls = (unsigned*)(wsl + CTL_CLS_OFF) + l * 256;
            unsigned* bw = (unsigned*)wsl;
#define WAIT_CLASS(k, n) do { __syncthreads(); if (tid == 0) { XB_SPIN(xb_ld(&cls[(k) * 64]) < (unsigned)(n), bw); FENCE_ACQ_AGENT(); WAIT_VM0(); } __syncthreads(); } while (0)
#ifndef NO_DIFF
            {
                constexpr int NQB2 = S / 256;
                int total = 0;
                for (int q = 0; q < NQB2; ++q) total += ((4 * q + 4 + DCH - 1) / DCH) * 8;
                WAIT_CLASS(0, (S / 256) * 6);
                for (;;) {
                    __syncthreads();
                    if (tid == 0) *ubox = (unsigned)atomic_add_int(workctr, 1);
                    __syncthreads();
                    int u = RFL((int)*ubox);
                    if (u >= total) break;
                    int qb = NQB2 - 1;
                    for (;; --qb) { const int nu = ((4 * qb + 4 + DCH - 1) / DCH) * 8; if (u < nu) break; u -= nu; }
                    const int c = u >> 3, h = (u >> 1) & 3, mp = u & 1;
                    const int t0 = c * DCH, t1 = (t0 + DCH < 4 * qb + 4) ? t0 + DCH : 4 * qb + 4;
                    const unsigned* q2p = (const unsigned*)(wsl + CTL_QK2_OFF) + l * 16;
                    const float bnd = sqrtf(__builtin_bit_cast(float, q2p[h * 2 + mp]) * __builtin_bit_cast(float, q2p[8 + h * 2 + mp])) * (QSCALE_C * 1.02f) + 0.01f;
                    attn_dmap_unit(Qc + (size_t)h * S * 128, Kc + (size_t)h * S * 128, VcT + (size_t)h * S * 128, mp, qb, t0, t1,
                                   dpo + (size_t)(h * 2 + mp) * DPART_ROWS * 128, dpml + (size_t)(h * 2 + mp) * DPART_ROWS * 2, c, RFL_F(bnd), lds_raw, tid);
                    CONV_ONE();
                }
            }
#endif
#ifndef NO_LRU
            WAIT_CLASS(1, (S / 256) * 6);
            for (;;) {
                __syncthreads();
                if (tid == 0) *ubox = (unsigned)atomic_add_int(workctr + 10, 1);
                __syncthreads();
                const int u = RFL((int)*ubox);
                if (u >= NLRU) break;
                lru_unit_a(u / 6, u % 6, l, p, Xr, WaiT + (size_t)l * 6 * 256 * 128, hloc, ploc, sumA, sumH, lds_raw, tid);
            }
#endif
#ifndef NO_FOX
            WAIT_CLASS(2, (S / 256) * 9);
            WAIT_CLASS(3, 1);
            for (;;) {
                __syncthreads();
                if (tid == 0) *ubox = (unsigned)atomic_add_int(workctr + 1, 1);
                __syncthreads();
                const int u = RFL((int)*ubox);
                if (u >= NQB * FOX_H) break;
                const int qb = NQB - 1 - u / FOX_H, h = u % FOX_H;
                attn_unit<0>(Qa + (size_t)h * S * 128, Ka + (size_t)h * S * 128, VaT + (size_t)h * S * 128, cum2 + (size_t)h * S, kmax2 + h * NKT, qb, concat, h * 128,
                             0.f, 0.f, nullptr, lds_raw, tid);
            }
#endif
            while (conv_more) CONV_ONE();
            PH_BAR(pb + 1);
        }

        if (PH_SEL(2) && PH_IN(pb + 2)) for (int rep = 0; rep < PH_REPS(2); ++rep) {
            PHASE_IDS();
            {
                const int per = (NKT * 6 + G - 1) / G;
                const int c = tid & 127, tq = tid >> 7;
                float cr = 0.f; int pgrp = -1;
                for (int u = bid * per; u < (bid + 1) * per && u < NKT * 6; ++u) {
                    const int grp = u / NKT, chunk = u % NKT, ch = grp * 128 + c;
                    if (grp != pgrp) {
                        pgrp = grp; cr = 0.f;
                        int j = 0;
                        for (; j + 16 <= chunk; j += 16) {
                            float a8[16], h8[16];
#pragma unroll
                            for (int q = 0; q < 16; ++q) { a8[q] = sumA[(size_t)(j + q) * LRU_W + ch]; h8[q] = sumH[(size_t)(j + q) * LRU_W + ch]; }
#pragma unroll
                            for (int q = 0; q < 16; ++q) cr = a8[q] * cr + h8[q];
                        }
                        for (; j < chunk; ++j) cr = sumA[(size_t)j * LRU_W + ch] * cr + sumH[(size_t)j * LRU_W + ch];
                    }
                    float hl[16], pl[16]; bf16_t gg[16];
#pragma unroll
                    for (int i = 0; i < 16; ++i) { const size_t gi = (size_t)(chunk * 64 + tq * 16 + i) * LRU_W + ch; const unsigned hp = ((const unsigned*)hloc)[gi]; hl[i] = bf2f((bf16_t)(hp & 0xffffu)); pl[i] = bf2f((bf16_t)(hp >> 16)); gg[i] = Gr[gi]; }
                    const float an = sumA[(size_t)chunk * LRU_W + ch], hn = sumH[(size_t)chunk * LRU_W + ch];
#pragma unroll
                    for (int i = 0; i < 16; ++i)
                        concat[(size_t)(chunk * 64 + tq * 16 + i) * D + FOX_W + ch] = f2bf(gelu_tanh_f(bf2f(gg[i])) * (hl[i] + pl[i] * cr));
                    cr = an * cr + hn;
                }
            }
            {
                const float lam_init = (l == 0) ? 0.2f : 0.35550906759f;
                const float s1 = wave_sum(p.in[I_LQ1][l * 64 + lane] * p.in[I_LK1][l * 64 + lane]);
                const float s2 = wave_sum(p.in[I_LQ2][l * 64 + lane] * p.in[I_LK2][l * 64 + lane]);
                const float lam = fexp(s1) - fexp(s2) + lam_init;
                const float* sg = p.in[I_SUBG] + l * 128;
                const float g0 = sg[2 * lane], g1 = sg[2 * lane + 1];
                static_assert(NCH <= 8, "the merge below keeps one (map, chunk) pair per lane: 2 x 8 lanes");
                for (int q = gwave; q < S; q += gwaves) {
                    const int nch = (q >> 6) / DCH + 1;
                    float mv = -INFINITY, lv = 0.f;
                    { const int c = lane & 7, hm = lane >> 3;
                      if (c < nch) { const float* ML = dpml + ((size_t)hm * DPART_ROWS + dpart_row(c, q)) * 2; mv = ML[0]; lv = ML[1]; } }
                    unsigned pk[4][2][NCH];
#pragma unroll
                    for (int h = 0; h < 4; ++h)
#pragma unroll
                        for (int mp = 0; mp < 2; ++mp) {
                            const unsigned* OP = (const unsigned*)(dpo + (size_t)(h * 2 + mp) * DPART_ROWS * 128);
#pragma unroll
                            for (int c = 0; c < NCH; ++c) pk[h][mp][c] = (c < nch) ? OP[(size_t)dpart_row(c, q) * 64 + lane] : 0u;
                        }
                    float Mx = mv; Mx = fmaxf(Mx, DPP_X1(Mx)); Mx = fmaxf(Mx, DPP_X2(Mx)); Mx = fmaxf(Mx, DPP_X7(Mx));
                    const float wv = (mv == -INFINITY) ? 0.f : FAST_EXP2(mv - Mx);
                    float Lp = lv * wv; Lp += DPP_X1(Lp); Lp += DPP_X2(Lp); Lp += DPP_X7(Lp);
#pragma unroll
                    for (int h = 0; h < 4; ++h) {
                        float om[2][2];
#pragma unroll
                        for (int mp = 0; mp < 2; ++mp) {
                            float o0 = 0.f, o1 = 0.f;
#pragma unroll
                            for (int c = 0; c < NCH; ++c) { const float w = RDLANE(wv, (h * 2 + mp) * 8 + c); o0 += bf2f((bf16_t)(pk[h][mp][c] & 0xffffu)) * w; o1 += bf2f((bf16_t)(pk[h][mp][c] >> 16)) * w; }
                            const float il = 1.f / RDLANE(Lp, (h * 2 + mp) * 8);
                            om[mp][0] = o0 * il; om[mp][1] = o1 * il;
                        }
                        const float v0 = om[0][0] - lam * om[1][0], v1 = om[0][1] - lam * om[1][1];
                        const float ss = wave_sum(v0 * v0 + v1 * v1);
                        const float rs = (1.f - lam_init) / sqrtf(ss * (1.f / 128.f) + LN_EPS);
                        *(unsigned*)(concat + (size_t)q * D + 1536 + h * 128 + 2 * lane) = pack2(v0 * rs * g0, v1 * rs * g1);
                    }
                }
            }
            PH_BAR(pb + 2);
        }

        if (PH_SEL(3) && PH_IN(pb + 3)) {
            PHASE_IDS();
            const bf16_t* Bt = WoT + (size_t)l * D * D;
            constexpr int ntn = D / 256, ntm = S / 256;
            static_assert(ntn == 8, "the panel exchange is written for 8 column tiles");
            const unsigned nooff[2][2] = {{0u, 0u}, {0u, 0u}};
            const float* g1 = p.in[I_LN1G] + (size_t)l * D; const float* b1 = p.in[I_LN1B] + (size_t)l * D;
            const float* bg = p.in[I_BGRP] + l * 4; const float* br = p.in[I_BRT] + l * 32;
            const bf16_t* Wb = W36b + (size_t)l * 2 * 48 * D;
            int* lcnt = (int*)(lds_raw + LDS_MISC + M_LCNT);
            const int segcap = ((ntm * ntn + G - 1) / G) * 32;
            unsigned* pcnt = (unsigned*)(wsl + CTL_PAN_OFF) + l * 1024;
            unsigned long long* xbuf = (unsigned long long*)(wsl + A_XBUF);
            unsigned* part = (unsigned*)(wsl + A_PART);
            LAS float* Stab = (LAS float*)(lds_raw + LDS_MISC + M_RTOK);
            float* lgt = (float*)(lds_raw + LDS_MISC + 4096);
            if (tid < 32) lcnt[tid] = 0;
            __syncthreads();
            for (int t0 = bid; t0 < ntm * ntn; t0 += G) {
                int t = t0;
                if (G == 256 && ntm * ntn == 256) { const int x = t0 & 7, j = t0 >> 3; t = (x * 4 + (j >> 3)) * ntn + (j & 7); }
                const int pm = t / ntn, pn = t % ntn;
                f32x4 v[2][16];
                {
                    f32x4 acc[2][2][4][2];
                    gemm_tile<false>(concat, pm * 256, nooff, Bt, pn * 256, D, lds_raw, acc, tid);
                    int et = tid; OPAQUE(et); const int wr = et >> 8, wc = (et >> 6) & 3, fr = et & 15, fq = (et >> 4) & 3;
#pragma unroll
                    for (int ai = 0; ai < 2; ++ai) {
#pragma unroll
                        for (int m = 0; m < 4; ++m)
#pragma unroll
                            for (int bj = 0; bj < 2; ++bj)
#pragma unroll
                                for (int n = 0; n < 2; ++n)
#pragma unroll
                                    for (int j = 0; j < 4; ++j)
                                        *(float*)(lds_raw + (wr * 64 + m * 16 + fq * 4 + j) * 1040 + (bj * 128 + wc * 32 + n * 16 + fr) * 4) = acc[ai][bj][m][n][j];
                        __syncthreads();
#pragma unroll
                        for (int i = 0; i < 16; ++i) {
                            const int lrow = i * 8 + (et >> 6), c4 = et & 63;
                            const size_t gi = (size_t)(pm * 256 + ai * 128 + lrow) * D + pn * 256 + c4 * 4;
                            v[ai][i] = *(const GAS f32x4*)(hin + gi);
                        }
#pragma unroll
                        for (int i = 0; i < 16; ++i) {
                            const int lrow = i * 8 + (et >> 6), c4 = et & 63;
                            v[ai][i] = ALPHA * v[ai][i] + *(const f32x4*)(lds_raw + lrow * 1040 + c4 * 16);
                        }
                        __syncthreads();
                    }
                }
                int et2 = tid; OPAQUE(et2); const int el = et2 & 63, ew = wave_s, er16 = et2 & 15, eq4 = (et2 >> 4) & 3;
#pragma unroll
                for (int q = 0; q < 6; ++q) {
                    const int seg = ew * 6 + q, n2 = seg * 2 + (el >> 5), p5 = el & 31;
                    GLDS16(Wb + (size_t)n2 * D + pn * 256 + ((p5 ^ (n2 & 15)) << 3), lds_raw + 65536 + seg * 1024 + el * 16);
                }
                float my_mt = 0.f, my_m2 = 0.f;
                for (int trep = 0; trep < REP_STATS; ++trep)
#pragma unroll
                for (int ai = 0; ai < 2; ++ai)
#pragma unroll
                    for (int i4 = 0; i4 < 16; i4 += 4) {
                        float mt4[4], m24[4];
#pragma unroll
                        for (int u = 0; u < 4; ++u) { const f32x4 x = v[ai][i4 + u]; mt4[u] = wave_sum((x[0] + x[1]) + (x[2] + x[3])) * (1.f / 256.f); }
#pragma unroll
                        for (int u = 0; u < 4; ++u) { const f32x4 d = v[ai][i4 + u] - mt4[u]; m24[u] = wave_sum((d[0] * d[0] + d[1] * d[1]) + (d[2] * d[2] + d[3] * d[3])); }
#pragma unroll
                        for (int u = 0; u < 4; ++u) if (el == ai * 16 + i4 + u) { my_mt = mt4[u]; my_m2 = m24[u]; }
                        COMPILER_FENCE();
                    }
                unsigned* bw = (unsigned*)wsl;
                if (el < 32) {
                    const int grow = (el >> 4) * 128 + (el & 15) * 8 + ew;
                    xst64(&xbuf[(size_t)(pm * 256 + grow) * 8 + pn], ((unsigned long long)__builtin_bit_cast(unsigned, my_m2) << 32) | __builtin_bit_cast(unsigned, my_mt));
                }
                WAIT_VM0();
                __syncthreads();
                if (et2 == 0) { (void)xb_add(&pcnt[pm * 16], 1u); XB_SPIN(xb_ld(&pcnt[pm * 16]) < 8u, bw); FENCE_ACQ_AGENT(); }
                __syncthreads();
                unsigned long long wk[4];
#pragma unroll
                for (int k = 0; k < 4; ++k) {
                    const int r = k * 8 + (el >> 3), grow = (r >> 4) * 128 + (r & 15) * 8 + ew;
                    wk[k] = xld64(&xbuf[(size_t)(pm * 256 + grow) * 8 + (el & 7)]);
                }
#pragma unroll
                for (int k = 0; k < 4; ++k) {
                    const int r = k * 8 + (el >> 3);
                    const unsigned long long w = wk[k];
                    const float mt = __builtin_bit_cast(float, (unsigned)w), m2 = __builtin_bit_cast(float, (unsigned)(w >> 32));
                    float ms = mt; ms += DPP_X1(ms); ms += DPP_X2(ms); ms += DPP_X7(ms);
                    const float mean = ms * 0.125f, dm = mt - mean;
                    float q = m2 + 256.f * dm * dm; q += DPP_X1(q); q += DPP_X2(q); q += DPP_X7(q);
                    const float rstd = 1.f / sqrtf(q * (1.f / D) + LN_EPS);
                    if ((el & 7) == 0) { Stab[(ew * 32 + r) * 2] = mean; Stab[(ew * 32 + r) * 2 + 1] = rstd; }
                }
                WAVE_SYNC();
                const f32x4 gv = *(const f32x4*)(g1 + pn * 256 + el * 4), bv = *(const f32x4*)(b1 + pn * 256 + el * 4);
                LAS unsigned char* wt = (LAS unsigned char*)lds_raw + ew * 8192;
                const LAS unsigned char* wbl = (const LAS unsigned char*)lds_raw + 65536;
                for (int rrep = 0; rrep < REP_ROUTER; ++rrep)
#pragma unroll
                for (int ai = 0; ai < 2; ++ai) {
                    u32x2 lokeep[16];
#pragma unroll
                    for (int i = 0; i < 16; ++i) {
                        const float mean = Stab[(ew * 32 + ai * 16 + i) * 2], rstd = Stab[(ew * 32 + ai * 16 + i) * 2 + 1];
                        const f32x4 hv = mul_s4(v[ai][i] - mean, rstd) * gv + bv;
                        u32x2 o; o.x = pack2(hv[0], hv[1]); o.y = pack2(hv[2], hv[3]);
                        lokeep[i].x = pack2(hv[0] - bf2f((bf16_t)(o.x & 0xffffu)), hv[1] - bf2f((bf16_t)(o.x >> 16)));
                        lokeep[i].y = pack2(hv[2] - bf2f((bf16_t)(o.y & 0xffffu)), hv[3] - bf2f((bf16_t)(o.y >> 16)));
                        *(LAS u32x2*)(wt + i * 512 + (((el >> 1) ^ i) << 4) + (el & 1) * 8) = o;
                        COMPILER_FENCE();
                    }
                    WAVE_SYNC();
                    f32x4 ac[3];
#pragma unroll
                    for (int nt = 0; nt < 3; ++nt) ac[nt] = (f32x4){0.f, 0.f, 0.f, 0.f};
#pragma unroll 2
                    for (int ks = 0; ks < 8; ++ks) {
                        const int co = ((ks * 4 + eq4) ^ er16) << 4;
                        const bf16x8 ah = *(const LAS bf16x8*)(wt + er16 * 512 + co);
#pragma unroll
                        for (int nt = 0; nt < 3; ++nt) {
                            const bf16x8 bh = *(const LAS bf16x8*)(wbl + (nt * 16 + er16) * 512 + co);
                            const bf16x8 bl = *(const LAS bf16x8*)(wbl + (48 + nt * 16 + er16) * 512 + co);
                            ac[nt] = MFMA16(ah, bh, ac[nt]); ac[nt] = MFMA16(ah, bl, ac[nt]);
                        }
                    }
                    WAVE_SYNC();
#pragma unroll
                    for (int i = 0; i < 16; ++i) *(LAS u32x2*)(wt + i * 512 + (((el >> 1) ^ i) << 4) + (el & 1) * 8) = lokeep[i];
                    WAVE_SYNC();
#pragma unroll 2
                    for (int ks = 0; ks < 8; ++ks) {
                        const int co = ((ks * 4 + eq4) ^ er16) << 4;
                        const bf16x8 al = *(const LAS bf16x8*)(wt + er16 * 512 + co);
#pragma unroll
                        for (int nt = 0; nt < 3; ++nt) {
                            const bf16x8 bh = *(const LAS bf16x8*)(wbl + (nt * 16 + er16) * 512 + co);
                            ac[nt] = MFMA16(al, bh, ac[nt]);
                        }
                    }
#pragma unroll
                    for (int nt = 0; nt < 3; ++nt)
#pragma unroll
                        for (int j = 0; j < 4; ++j) {
                            const float cv = ac[nt][j];
                            xst32(&part[((size_t)pn * S + pm * 256 + ai * 128 + (eq4 * 4 + j) * 8 + ew) * 48 + nt * 16 + er16], __builtin_bit_cast(unsigned, cv));
                        }
                    WAVE_SYNC();
                }
                WAIT_VM0();
                __syncthreads();
                if (et2 == 0) (void)xb_add(&pcnt[512 + pm * 16], 1u);
                for (int srep = 0; srep < REP_STORES; ++srep)
#pragma unroll
                for (int ai = 0; ai < 2; ++ai)
#pragma unroll
                    for (int i = 0; i < 16; ++i) {
                        const float mean = Stab[(ew * 32 + ai * 16 + i) * 2], rstd = Stab[(ew * 32 + ai * 16 + i) * 2 + 1];
                        const f32x4 hv = mul_s4(v[ai][i] - mean, rstd) * gv + bv;
                        const size_t gi = (size_t)(pm * 256 + ai * 128 + i * 8 + ew) * D + pn * 256 + el * 4;
                        u32x2 o; o.x = pack2(hv[0], hv[1]); o.y = pack2(hv[2], hv[3]);
                        *(u32x2*)(h1b + gi) = o;
                        COMPILER_FENCE();
                    }
                if (et2 == 0) { XB_SPIN(xb_ld(&pcnt[512 + pm * 16]) < 8u, bw); FENCE_ACQ_AGENT(); }
                __syncthreads();
                int rt = tid; OPAQUE(rt);
#pragma unroll
                for (int k = 0; k < 3; ++k) {
                    const int idx = rt + k * 512, tk = idx / 48, n = idx - tk * 48;
                    unsigned pq[8];
#pragma unroll
                    for (int q = 0; q < 8; ++q) pq[q] = xb_ld(&part[((size_t)q * S + pm * 256 + pn * 32 + tk) * 48 + n]);
                    float a = 0.f;
#pragma unroll
                    for (int q = 0; q < 8; ++q) a += __builtin_bit_cast(float, pq[q]);
                    lgt[idx] = a;
                }
                __syncthreads();
                if (rt < 32) {
                    const int t = pm * 256 + pn * 32 + rt; const float* L = lgt + rt * 48;
                    float gl[4];
#pragma unroll
                    for (int q = 0; q < 4; ++q) gl[q] = L[q] + bg[q];
                    int gi = 0; float gm = gl[0];
#pragma unroll
                    for (int q = 1; q < 4; ++q) if (gl[q] > gm) { gm = gl[q]; gi = q; }
                    float gs = 0.f;
#pragma unroll
                    for (int q = 0; q < 4; ++q) gs += fexp(gl[q] - gm);
                    const float gweight = 1.f / gs;
                    float E[8];
#pragma unroll
                    for (int e = 0; e < 8; ++e) E[e] = L[4 + gi * 8 + e] + br[gi * 8 + e];
                    int e1 = 0; float m1 = E[0];
#pragma unroll
                    for (int e = 1; e < 8; ++e) if (E[e] > m1) { m1 = E[e]; e1 = e; }
                    int e2 = -1; float m2 = -INFINITY;
#pragma unroll
                    for (int e = 0; e < 8; ++e) if (e != e1 && E[e] > m2) { m2 = E[e]; e2 = e; }
                    const float p2 = fexp(m2 - m1), w1 = 1.f / (1.f + p2), w2 = p2 / (1.f + p2);
                    const int ge1 = gi * 8 + e1, ge2 = gi * 8 + e2;
                    const int i1 = (ge1 * G + bid) * segcap + atomic_add_int(&lcnt[ge1], 1);
                    ltok[i1] = t; lw[i1] = gweight * w1; lslot[i1] = 0;
                    const int i2 = (ge2 * G + bid) * segcap + atomic_add_int(&lcnt[ge2], 1);
                    ltok[i2] = t; lw[i2] = gweight * w2; lslot[i2] = 1;
                }
                __syncthreads();
            }
            { int ft = tid; OPAQUE(ft); if (ft < 32) cntb[bid * 32 + ft] = lcnt[ft]; }
            PH_BAR(pb + 3);
        }

        if (PH_SEL(5) && PH_IN(pb + 5)) {
            PHASE_IDS();
            const unsigned nooff[2][2] = {{0u, 0u}, {0u, 0u}};
            const int segcap = ((S / 256 * (D / 256) + G - 1) / G) * 32;
            moe_prefix(cntb, G, lds_raw, tid);
            const int* ctot = (const int*)(lds_raw + LDS_MISC + M_CTOT); const int* coff = (const int*)(lds_raw + LDS_MISC + M_COFF);
            const int* rtok = (const int*)(lds_raw + LDS_MISC + M_RTOK); const float* rw = (const float*)(lds_raw + LDS_MISC + M_RW);
            const int* rslot = (const int*)(lds_raw + LDS_MISC + M_RSLOT);
            unsigned* done = (unsigned*)(wsl + CTL_DONE_OFF) + l * 1024;
            int* mq = (int*)(wsl + CTL_MQ_OFF) + l * 128;
            const int myx = (int)(xb_xcc_id() & 7u);
            int qi = 0;
            for (;;) {
                __syncthreads();
                if (tid == 0) {
                    unsigned r = 0xffffffffu;
                    while (qi < 8) {
                        const int xx = (myx + qi) & 7;
                        int nm = 0;
#pragma unroll
                        for (int k = 0; k < NEXP / 8; ++k) nm += (ctot[xx + 8 * k] + 255) / 256;
                        const int got = atomic_add_int(mq + xx * 16, 1);
                        if (got < nm * 12) { r = ((unsigned)xx << 24) | (unsigned)got; break; }
                        ++qi;
                    }
                    *ubox = r;
                }
                __syncthreads();
                const unsigned rr = (unsigned)RFL((int)*ubox);
                if (rr == 0xffffffffu) break;
                const int xq = (int)(rr >> 24);
                int u = (int)(rr & 0xffffffu);
                int nmt = 0;
#pragma unroll
                for (int k = 0; k < NEXP / 8; ++k) nmt += (RFL(ctot[xq + 8 * k]) + 255) / 256;
                const bool down = (u >= nmt * 4);
                const int per = down ? 8 : 4;
                if (down) u -= nmt * 4;
                int e = xq;
                for (;; e += 8) { const int nt = ((RFL(ctot[e]) + 255) / 256) * per; if (u < nt) break; u -= nt; }
                const int c = RFL(ctot[e]), off = RFL(coff[e]);
                const int mt = u / per, pn = u % per, m0 = mt * 256;
                moe_rowtable(ltok, lw, lslot, e, m0, c, G, segcap, lds_raw, tid);
                f32x4 acc[2][2][4][2];
                if (!down) {
                    const bf16_t* Bt = WguT + ((size_t)l * NEXP + e) * 1024 * D;
                    unsigned aoff[2][2];
                    int st = tid; OPAQUE(st); int R[2], C[2]; stage_geom(st, R, C);
#pragma unroll
                    for (int h = 0; h < 2; ++h)
#pragma unroll
                        for (int i = 0; i < 2; ++i) aoff[h][i] = (unsigned)(rtok[h * 128 + R[i]] * D + C[i]);
                    gemm_tile<true>(h1b, 0, aoff, Bt, pn * 256, D, lds_raw, acc, tid);
                    int et = tid; OPAQUE(et); const int wr = et >> 8, wc = (et >> 6) & 3, fr = et & 15, fq = (et >> 4) & 3;
#pragma unroll
                    for (int ai = 0; ai < 2; ++ai)
#pragma unroll
                        for (int m = 0; m < 4; ++m)
#pragma unroll
                            for (int j = 0; j < 4; ++j) {
                                const int r = ai * 128 + wr * 64 + m * 16 + fq * 4 + j;
                                const float wgt = rw[r];
#pragma unroll
                                for (int bj = 0; bj < 2; ++bj)
                                    *(bf16_t*)(lds_raw + r * 272 + (bj * 64 + wc * 16 + fr) * 2) = f2bf(silu_f(acc[ai][bj][m][0][j]) * acc[ai][bj][m][1][j] * wgt);
                            }
                    __syncthreads();
#pragma unroll 4
                    for (int i = 0; i < 8; ++i) {
                        const int idx = et + i * 512, r = idx >> 4, ch = idx & 15;
                        if (m0 + r < c) *(u32x4*)(act + (size_t)(off + m0 + r) * DFF + pn * 128 + ch * 8) = *(const u32x4*)(lds_raw + r * 272 + ch * 16);
                    }
                    WAIT_VM0();
                    __syncthreads();
                    if (et == 0) { FENCE_REL_AGENT(); WAIT_VM0(); (void)xb_add(&done[e * 32 + mt], 1u); }
                } else {
                    const bf16_t* Bt = WdT + ((size_t)l * NEXP + e) * D * DFF;
                    if (tid == 0) {
                        unsigned* bw = (unsigned*)wsl;
                        XB_SPIN(xb_ld(&done[e * 32 + mt]) < 4u, bw);
                        FENCE_ACQ_AGENT();
                        WAIT_VM0();
                    }
                    __syncthreads();
                    gemm_tile<false>(act, off + m0, nooff, Bt, pn * 256, DFF, lds_raw, acc, tid);
                    int et = tid; OPAQUE(et); const int wr = et >> 8, wc = (et >> 6) & 3, fr = et & 15, fq = (et >> 4) & 3;
#pragma unroll
                    for (int ai = 0; ai < 2; ++ai)
#pragma unroll
                        for (int m = 0; m < 4; ++m)
#pragma unroll
                            for (int bj = 0; bj < 2; ++bj)
#pragma unroll
                                for (int n = 0; n < 2; ++n)
#pragma unroll
                                    for (int j = 0; j < 4; ++j)
                                        *(bf16_t*)(lds_raw + (ai * 128 + wr * 64 + m * 16 + fq * 4 + j) * 528 + (bj * 128 + wc * 32 + n * 16 + fr) * 2) = f2bf(acc[ai][bj][m][n][j]);
                    __syncthreads();
#pragma unroll 4
                    for (int i = 0; i < 16; ++i) {
                        const int idx = et + i * 512, r = idx >> 5, ch = idx & 31;
                        if (m0 + r < c) *(u32x4*)(contrib + ((size_t)rslot[r] * S + rtok[r]) * D + pn * 256 + ch * 8) = *(const u32x4*)(lds_raw + r * 528 + ch * 16);
                    }
                }
            }
            PH_BAR(pb + 5);
        }

        if (PH_SEL(7) && PH_IN(pb + 7)) for (int rep = 0; rep < PH_REPS(7); ++rep) {
            PHASE_IDS();
            const float* g2 = p.in[I_LN2G] + (size_t)l * D; const float* b2 = p.in[I_LN2B] + (size_t)l * D;
            const bool more = (l + 1 < DEPTH);
            f32x4 gq[8], bq[8];
#pragma unroll
            for (int j = 0; j < 8; ++j) { gq[j] = *(const f32x4*)(g2 + j * 256 + lane * 4); bq[j] = *(const f32x4*)(b2 + j * 256 + lane * 4); }
            if (more) {
                const float* wf = Wfa + (size_t)(l + 1) * 8 * D;
                __syncthreads();
                for (int i = tid; i < 6 * D / 4; i += NTHREADS) *(f32x4*)(ldsf + i * 4) = *(const f32x4*)(wf + i * 4);
                __syncthreads();
            }
            for (int t = gwave; t < S; t += gwaves) {
                f32x4 v[8]; float s = 0.f;
#pragma unroll
                for (int j = 0; j < 8; ++j) {
                    const size_t i = (size_t)t * D + j * 256 + lane * 4;
                    const u32x2 c0 = *(const u32x2*)(contrib + i), c1 = *(const u32x2*)(contrib + (size_t)S * D + i);
                    const f32x4 cs = (f32x4){bf2f((bf16_t)(c0.x & 0xffffu)) + bf2f((bf16_t)(c1.x & 0xffffu)), bf2f((bf16_t)(c0.x >> 16)) + bf2f((bf16_t)(c1.x >> 16)),
                                             bf2f((bf16_t)(c0.y & 0xffffu)) + bf2f((bf16_t)(c1.y & 0xffffu)), bf2f((bf16_t)(c0.y >> 16)) + bf2f((bf16_t)(c1.y >> 16))};
                    const u32x2 hq = *(const u32x2*)(h1b + i);
                    v[j] = ALPHA * (f32x4){bf2f((bf16_t)(hq.x & 0xffffu)), bf2f((bf16_t)(hq.x >> 16)), bf2f((bf16_t)(hq.y & 0xffffu)), bf2f((bf16_t)(hq.y >> 16))} + cs;
                    s += (v[j][0] + v[j][1]) + (v[j][2] + v[j][3]);
                }
                const float mean = wave_sum(s) * (1.f / D);
                float s2 = 0.f;
#pragma unroll
                for (int j = 0; j < 8; ++j) { v[j] -= mean; s2 += (v[j][0] * v[j][0] + v[j][1] * v[j][1]) + (v[j][2] * v[j][2] + v[j][3] * v[j][3]); }
                const float rstd = 1.f / sqrtf(wave_sum(s2) * (1.f / D) + LN_EPS);
                float fa[6] = {0.f, 0.f, 0.f, 0.f, 0.f, 0.f};
#pragma unroll
                for (int j = 0; j < 8; ++j) {
                    const int c = j * 256 + lane * 4;
                    v[j] = v[j] * rstd * gq[j] + bq[j];
                    *(f32x4*)(hout + (size_t)t * D + c) = v[j];
                    COMPILER_FENCE();
                    if (more) {
                        u32x2 o; o.x = pack2(v[j][0], v[j][1]); o.y = pack2(v[j][2], v[j][3]);
                        *(u32x2*)(xb + (size_t)t * D + c) = o;
#pragma unroll
                        for (int h = 0; h < 6; ++h) { const f32x4 w = *(const f32x4*)(ldsf + h * D + c); fa[h] += (v[j][0] * w[0] + v[j][1] * w[1]) + (v[j][2] * w[2] + v[j][3] * w[3]); }
                    }
                }
                if (more) {
#pragma unroll
                    for (int h = 0; h < 6; ++h) { const float sm = wave_sum(fa[h]); if (lane == 0) logf_[h * S + t] = log_sigmoid_f(sm + p.in[I_BF][(l + 1) * 6 + h]); }
                }
            }
            PH_BAR(pb + 7);
        }
    }
#undef PH_IN
#undef PH_BAR
}

constexpr int N_PHASES = 1 + DEPTH * 8;
#ifndef EMU
extern "C" void kernel_launch(void* const* d_in, const int* in_sizes, int n_in, void* d_out, int out_size, void* d_ws, size_t ws_size, hipStream_t stream) {
    static int grid = 0;
    if (grid == 0) {
        if (n_in != N_INPUTS || out_size != S * D || ws_size < WS_END) {
            fprintf(stderr, "kernel_launch: unexpected shapes: n_in %d out %d ws %zu (need %zu)\n", n_in, out_size, ws_size, (size_t)WS_END); grid = -1; return; }
        int dev = 0, cus = 0, per_cu = 0;
        if (hipGetDevice(&dev) != hipSuccess || hipDeviceGetAttribute(&cus, hipDeviceAttributeMultiprocessorCount, dev) != hipSuccess) { grid = -1; return; }
        if (hipFuncSetAttribute((const void*)fwd_kernel, hipFuncAttributeMaxDynamicSharedMemorySize, LDS_BYTES) != hipSuccess) { fprintf(stderr, "kernel_launch: hipFuncSetAttribute failed\n"); grid = -1; return; }
        if (hipOccupancyMaxActiveBlocksPerMultiprocessor(&per_cu, (const void*)fwd_kernel, NTHREADS, LDS_BYTES) != hipSuccess || per_cu < 1) {
            fprintf(stderr, "kernel_launch: occupancy query says %d blocks per CU\n", per_cu); (void)hipGetLastError(); grid = -1; return; }
        grid = cus;
    }
    if (grid < 0) return;
    (void)hipMemsetAsync(d_ws, 0, CTL_BYTES, stream);
    Params p{};
    for (int i = 0; i < N_INPUTS; ++i) p.in[i] = (const float*)d_in[i];
    p.out = (float*)d_out; p.ws = (unsigned char*)d_ws;
    for (int i = 0; i < 8; ++i) p.inv_freq[i] = (float)pow(500000.0, -(double)i * 2.0 / 16.0);
#if N_LAUNCH_SPLIT
    for (int k = 0; k < N_PHASES; ++k) { p.lo = k; p.hi = k + 1; hipLaunchKernelGGL(fwd_kernel, dim3(grid), dim3(NTHREADS), LDS_BYTES, stream, p); }
#else
    p.lo = 0; p.hi = N_PHASES;
    hipLaunchKernelGGL(fwd_kernel, dim3(grid), dim3(NTHREADS), LDS_BYTES, stream, p);
#endif
}
#endif
```

```cpp
#ifndef EMU
#include <hip/hip_runtime.h>
#include <cstdio>
#include <cstdint>
#include <cmath>
#endif

#ifndef SEQ
#define SEQ 8192
#endif
#ifndef N_LAUNCH_SPLIT
#define N_LAUNCH_SPLIT 0
#endif
#ifndef REP_PHASE
#define REP_PHASE -2
#endif
#define PH_REPS(c) ((c) == REP_PHASE ? 2 : 1)
#ifndef REP_SUB
#define REP_SUB 0
#endif

constexpr int S = SEQ, D = 2048, DEPTH = 2;
constexpr int FOX_H = 6, FOX_W = 768;
constexpr int LRU_W = 768;
constexpr int DIFF_H = 4, DIFF_W = 512;
constexpr int N_IN = 5382, N_INP = 5376;
constexpr int C_FA = 2304;
constexpr int NEXP = 32, DFF = 512;
constexpr int NKT = S / 64;
#ifndef REP_ROUTER
#define REP_ROUTER 1
#endif
#ifndef REP_STORES
#define REP_STORES 1
#endif
#ifndef REP_STATS
#define REP_STATS 1
#endif
#ifndef DCH
#define DCH 32
#endif
constexpr int NCH = (NKT + DCH - 1) / DCH;
constexpr size_t DPART_ROWS = (size_t)NCH * S - (size_t)(DCH * 64) * NCH * (NCH - 1) / 2;
constexpr float ALPHA = 1.41421356237309504880f;
constexpr float LN_EPS = 1e-5f;
constexpr float LOG2E = 1.4426950408889634f;
constexpr float QSCALE_A = 0.08838834764831845f * 1.4426950408889634f;
constexpr float QSCALE_C = 0.125f * 1.4426950408889634f;

enum { I_X = 0, I_POS, I_WIN, I_BF, I_CONVW, I_CONVB, I_WA, I_BA, I_WI, I_BI, I_LAM, I_LQ1, I_LK1, I_LQ2, I_LK2, I_SUBG, I_WO, I_LN1G, I_LN1B,
       I_WGRP, I_BGRP, I_WRT, I_BRT, I_WGATE, I_WUP, I_WDOWN, I_LN2G, I_LN2B, N_INPUTS };

typedef unsigned short bf16_t;
typedef short bf16x8 __attribute__((ext_vector_type(8)));
typedef float f32x4 __attribute__((ext_vector_type(4)));
typedef unsigned u32x4 __attribute__((ext_vector_type(4)));
typedef unsigned u32x2 __attribute__((ext_vector_type(2)));

constexpr size_t al256(size_t x) { return (x + 255) & ~(size_t)255; }
constexpr size_t CTL_BYTES = 65536;
constexpr size_t CTL_CNT_OFF = 32768;
constexpr size_t CTL_WORK_OFF = 36864;
constexpr size_t CTL_QK2_OFF = 57344;
constexpr size_t CTL_CLS_OFF = 49152;
constexpr size_t CTL_PAN_OFF = 16384;
constexpr size_t CTL_MQ_OFF = 24576;
constexpr size_t CTL_DONE_OFF = 40960;
constexpr size_t WB_WIN = CTL_BYTES;
constexpr size_t WB_WO = WB_WIN + al256((size_t)DEPTH * N_INP * D * 2);
constexpr size_t WB_WGU = WB_WO + al256((size_t)DEPTH * D * D * 2);
constexpr size_t WB_WD = WB_WGU + al256((size_t)DEPTH * NEXP * 1024 * D * 2);
constexpr size_t WB_WAI = WB_WD + al256((size_t)DEPTH * NEXP * D * DFF * 2);
constexpr size_t WF_FA = WB_WAI + al256((size_t)DEPTH * 6 * 256 * 128 * 2);
constexpr size_t WF_R36 = WF_FA + al256((size_t)DEPTH * 8 * D * 4);
constexpr size_t WF_ROPE = WF_R36 + al256((size_t)DEPTH * 2 * 48 * D * 2);
constexpr size_t A_XB = WF_ROPE + al256((size_t)S * 16 * 4);
constexpr size_t A_HB = A_XB + al256((size_t)S * D * 2);
constexpr size_t A_LOGF = A_HB + al256((size_t)S * D * 4);
constexpr size_t A_CUM = A_LOGF + al256((size_t)6 * S * 4);
constexpr size_t A_KMAX = A_CUM + al256((size_t)6 * S * 4);
constexpr size_t A_CNTB = A_KMAX + al256((size_t)6 * NKT * 4);
constexpr size_t A_QA = A_CNTB + al256((size_t)1024 * 32 * 4);
constexpr size_t A_KA = A_QA + al256((size_t)FOX_H * S * 128 * 2);
constexpr size_t A_VAT = A_KA + al256((size_t)FOX_H * S * 128 * 2);
constexpr size_t A_XR = A_VAT + al256((size_t)FOX_H * S * 128 * 2);
constexpr size_t A_GR = A_XR + al256((size_t)S * LRU_W * 2);
constexpr size_t A_QC = A_GR + al256((size_t)S * LRU_W * 2);
constexpr size_t A_KC = A_QC + al256((size_t)DIFF_H * S * 128 * 2);
constexpr size_t A_VCT = A_KC + al256((size_t)DIFF_H * S * 128 * 2);
constexpr size_t A_HLOC = A_VCT + al256((size_t)DIFF_H * S * 128 * 2);
constexpr size_t A_PLOC = A_HLOC + al256((size_t)S * LRU_W * 4);
constexpr size_t A_SUMA = A_PLOC + al256((size_t)S * LRU_W * 4);
constexpr size_t A_SUMH = A_SUMA + al256((size_t)NKT * LRU_W * 4);
constexpr size_t A_CONCAT = A_SUMH + al256((size_t)NKT * LRU_W * 4);
constexpr size_t A_Y1 = A_CONCAT + al256((size_t)S * D * 2);
constexpr size_t A_H1 = A_Y1 + al256((size_t)S * D * 4);
constexpr size_t A_H1B = A_H1 + al256((size_t)S * D * 4);
constexpr size_t A_LTOK = A_H1B + al256((size_t)S * D * 2);
constexpr size_t A_LW = A_LTOK + al256((size_t)NEXP * S * 4);
constexpr size_t A_LSLOT = A_LW + al256((size_t)NEXP * S * 4);
constexpr size_t A_ACT = A_LSLOT + al256((size_t)NEXP * S * 4);
constexpr size_t A_CONTRIB = A_ACT + al256((size_t)(2 * S + 256) * DFF * 2);
constexpr size_t WS_END = A_CONTRIB + al256((size_t)2 * S * D * 4);
constexpr size_t A_DPO = A_Y1;
constexpr size_t A_DPML = A_DPO + al256((size_t)8 * DPART_ROWS * 128 * 2);
static_assert(A_DPML + (size_t)8 * DPART_ROWS * 2 * 4 <= A_H1B, "differential partials must fit inside the y1 + h1 region");

constexpr size_t A_XBUF = A_H1 + al256((size_t)S * D * 2);
constexpr size_t A_PART = A_XBUF + al256((size_t)S * 8 * 8);
static_assert(A_PART + (size_t)8 * S * 48 * 4 <= A_H1B, "exchange buffers must fit inside the h1 region");
constexpr int NTHREADS = 512;
constexpr int LDS_MAIN = 131072 + 4096;
constexpr int LDS_MISC = LDS_MAIN;
constexpr int LDS_BYTES = LDS_MAIN + 8192 + 16640;
constexpr int M_PRE16 = 8192;
constexpr int M_LCNT = 64, M_CTOT = 256, M_COFF = 384, M_PRE = 512, M_RTOK = 2048, M_RW = 3072, M_RSLOT = 4096;

struct Params {
    const float* in[N_INPUTS];
    float* out;
    unsigned char* ws;
    float inv_freq[8];
    int lo, hi;
};

#ifndef EMU
#define LAS __attribute__((address_space(3)))
#define GAS __attribute__((address_space(1)))
#define DYN_LDS(name) extern __shared__ __attribute__((aligned(16))) unsigned char name[]
#define SLEEP1() __builtin_amdgcn_s_sleep(1)
#define WAVE_SYNC() __builtin_amdgcn_wave_barrier()
#define OPAQUE(x) asm volatile("" : "+v"(x))
#define COMPILER_FENCE() asm volatile("" ::: "memory")
#define RFL(x) __builtin_amdgcn_readfirstlane(x)
#define RFL_F(x) __builtin_bit_cast(float, __builtin_amdgcn_readfirstlane(__builtin_bit_cast(int, x)))
#define ANY_LANE(p) (__builtin_amdgcn_ballot_w64(p) != 0ull)
#define RDLANE(v, l) __builtin_bit_cast(float, __builtin_amdgcn_readlane(__builtin_bit_cast(int, v), l))
__device__ __forceinline__ int lane_id_volatile() { int l; asm volatile("v_mbcnt_lo_u32_b32 %0, -1, 0\n\tv_mbcnt_hi_u32_b32 %0, -1, %0" : "=v"(l)); return l; }
#define LANE_ID() lane_id_volatile()
#define OPAQUE_S(x) asm volatile("" : "+s"(x))
#define WAIT_VM0() asm volatile("s_waitcnt vmcnt(0)" ::: "memory")
#define WAIT_ALL0() __builtin_amdgcn_s_waitcnt(0)
#define FENCE_REL_AGENT() __builtin_amdgcn_fence(__ATOMIC_RELEASE, "agent")
#define FENCE_ACQ_AGENT() __builtin_amdgcn_fence(__ATOMIC_ACQUIRE, "agent")
#define MFMA16(a, b, c) __builtin_amdgcn_mfma_f32_16x16x32_bf16(a, b, c, 0, 0, 0)
#define GLDS16(g, l) __builtin_amdgcn_global_load_lds((const unsigned*)(g), (unsigned*)(l), 16, 0, 0)
#define WAIT_V(n) asm volatile("s_waitcnt vmcnt(" #n ")" ::: "memory")
#define WAIT_L(n) asm volatile("s_waitcnt lgkmcnt(" #n ")" ::: "memory")
#define BAR() __builtin_amdgcn_s_barrier()
#define SCHED() __builtin_amdgcn_sched_barrier(0)
#define SETPRIO(n) __builtin_amdgcn_s_setprio(n)
#define FAST_EXP2(x) __builtin_amdgcn_exp2f(x)
template <int M> __device__ __forceinline__ float shx_impl(float v, int lane) {
    if (M < 32) return __builtin_bit_cast(float, __builtin_amdgcn_ds_swizzle(__builtin_bit_cast(int, v), (M << 10) | 0x1f));
    return __builtin_bit_cast(float, __builtin_amdgcn_ds_bpermute((lane ^ 32) << 2, __builtin_bit_cast(int, v)));
}
#define SHX(v, M) shx_impl<M>(v, lane)
template <int CTRL> __device__ __forceinline__ float dppx(float x) { return __builtin_bit_cast(float, __builtin_amdgcn_mov_dpp(__builtin_bit_cast(int, x), CTRL, 0xf, 0xf, true)); }
#define DPP_X1(x) dppx<0xB1>(x)
#define DPP_X2(x) dppx<0x4E>(x)
#define DPP_X7(x) dppx<0x141>(x)
#define DPP_X8(x) dppx<0x128>(x)
#define xrow16_max(x) xrow16_max_l(x, lane)
#define xrow16_sum(x) xrow16_sum_l(x, lane)
__device__ __forceinline__ float xrow16_max_l(float x, int lane) { x = fmaxf(x, shx_impl<16>(x, lane)); return fmaxf(x, shx_impl<32>(x, lane)); }
__device__ __forceinline__ float xrow16_sum_l(float x, int lane) { x = x + shx_impl<16>(x, lane); return x + shx_impl<32>(x, lane); }
#define FAST_LOG2(x) __builtin_amdgcn_logf(x)
#define FAST_RCP(x) __builtin_amdgcn_rcpf(x)
__device__ __forceinline__ unsigned xb_ld(unsigned* p)              { return __hip_atomic_load(p, __ATOMIC_RELAXED, __HIP_MEMORY_SCOPE_AGENT); }
__device__ __forceinline__ unsigned xb_add(unsigned* p, unsigned v) { return __hip_atomic_fetch_add(p, v, __ATOMIC_RELAXED, __HIP_MEMORY_SCOPE_AGENT); }
__device__ __forceinline__ void xst64(unsigned long long* p, unsigned long long v) { __hip_atomic_store(p, v, __ATOMIC_RELAXED, __HIP_MEMORY_SCOPE_AGENT); }
__device__ __forceinline__ unsigned long long xld64(unsigned long long* p) { return __hip_atomic_load(p, __ATOMIC_RELAXED, __HIP_MEMORY_SCOPE_AGENT); }
__device__ __forceinline__ void xst32(unsigned* p, unsigned v) { __hip_atomic_store(p, v, __ATOMIC_RELAXED, __HIP_MEMORY_SCOPE_AGENT); }
__device__ __forceinline__ unsigned xb_xcc_id() { return (unsigned)__builtin_amdgcn_s_getreg((3 << 11) | 20) & 0xFu; }
__device__ __forceinline__ int atomic_add_int(int* p, int v) { return atomicAdd(p, v); }
__device__ __forceinline__ void atomic_min_int(int* p, int v) { atomicMin(p, v); }
__device__ __forceinline__ void atomic_max_u32(unsigned* p, unsigned v) { atomicMax(p, v); }
__device__ __forceinline__ unsigned pack2(float lo, float hi) { unsigned r; asm volatile("v_cvt_pk_bf16_f32 %0, %1, %2" : "=v"(r) : "v"(lo), "v"(hi)); return r; }
#else
#define MFMA16(a, b, c) emu_mfma_16x16x32_bf16(a, b, c)
#define GLDS16(g, l) emu_glds16((const void*)(g), (void*)(l))
#define WAIT_V(n) ((void)0)
#define WAIT_L(n) ((void)0)
#define BAR() __syncthreads()
#define SCHED() ((void)0)
#define SETPRIO(n) ((void)0)
#define FAST_EXP2(x) exp2f(x)
#define SHX(v, M) __shfl_xor(v, M)
#define DPP_X1(x) __shfl_xor(x, 1)
#define DPP_X2(x) __shfl_xor(x, 2)
#define DPP_X7(x) __shfl_xor(x, 7)
#define DPP_X8(x) __shfl_xor(x, 8)
static inline float xrow16_max(float x) { x = fmaxf(x, __shfl_xor(x, 16)); return fmaxf(x, __shfl_xor(x, 32)); }
static inline float xrow16_sum(float x) { x = x + __shfl_xor(x, 16); return x + __shfl_xor(x, 32); }
#define FAST_LOG2(x) log2f(x)
#define FAST_RCP(x) (1.f / (x))
static inline unsigned pack2(float lo, float hi) {
    unsigned a = __builtin_bit_cast(unsigned, lo), b = __builtin_bit_cast(unsigned, hi);
    a += 0x7fffu + ((a >> 16) & 1u); b += 0x7fffu + ((b >> 16) & 1u);
    return (a >> 16) | (b & 0xffff0000u);
}
#endif
__device__ __forceinline__ bf16_t f2bf(float f) { return (bf16_t)(pack2(f, 0.f) & 0xffffu); }
__device__ __forceinline__ float bf2f(bf16_t h) { return __builtin_bit_cast(float, (unsigned)h << 16); }

#define XB_TMO      128
#define XB_XCNT(j)  (256  + 64 * (j))
#define XB_XSUB(j)  (1280 + 64 * (j))
#define XB_XGEN(j)  (2304 + 64 * (j))
#define XB_TOP      3328
#define XB_TOPGEN   3392
#define XCD_BAR_WORDS 3456
#define XB_SPIN_CAP (1u << 22)
#define XB_SPIN(cond, bar) do { unsigned _sp = 0; while (cond) { SLEEP1(); \
    if ((++_sp & 255u) == 0u) { if (xb_ld(&(bar)[XB_TMO])) break; if (_sp > XB_SPIN_CAP) { xb_add(&(bar)[XB_TMO], 1u); break; } } } } while (0)

#define XB_X2SUB(x, s) (6400 + 16 * ((x) * 4 + (s)))
#define XB_X2CNT(x, s) (7424 + ((x) * 4 + (s)))
struct XcdBarrier { unsigned* bar; unsigned x, s; volatile LAS unsigned* st; };

__device__ __forceinline__ XcdBarrier xcd_barrier_post(unsigned* bar, volatile LAS unsigned* st) {
    XcdBarrier b; b.bar = bar; b.x = xb_xcc_id() & 15u; b.s = (blockIdx.x >> 3) & 3u; b.st = st;
    if (threadIdx.x == 0) {
        unsigned o = xb_add(&bar[XB_X2CNT(b.x, b.s)], 1u);
#ifndef EMU
        asm volatile("" :: "v"(o));
#endif
        (void)o;
        (void)xb_add(&bar[XB_XCNT(b.x)], 1u);
    }
    return b;
}
__device__ __forceinline__ void xcd_barrier_complete(unsigned* bar, unsigned x, unsigned s, unsigned& nsub, unsigned& nx, unsigned& nsubs) {
    const unsigned G = gridDim.x;
    unsigned sum, cnt, sp = 0u;
    for (;;) {
        sum = 0u; cnt = 0u;
#pragma unroll
        for (unsigned j = 0; j < 16; ++j) { const unsigned c = xb_ld(&bar[XB_XCNT(j)]); sum += c; cnt += (c > 0u) ? 1u : 0u; }
        if (sum == G) break;
        SLEEP1();
        if ((++sp & 255u) == 0u) { if (xb_ld(&bar[XB_TMO])) break; if (sp > XB_SPIN_CAP) { xb_add(&bar[XB_TMO], 1u); break; } }
    }
    unsigned mine = 0u, subs = 0u;
#pragma unroll
    for (unsigned q = 0; q < 4; ++q) { const unsigned c = xb_ld(&bar[XB_X2CNT(x, q)]); subs += (c > 0u) ? 1u : 0u; mine = (q == s) ? c : mine; }
    nsub = mine > 0u ? mine : 1u; nx = cnt > 0u ? cnt : 1u; nsubs = subs > 0u ? subs : 1u;
}
__device__ __forceinline__ void xcd_barrier(const XcdBarrier& b, bool leader) {
    WAIT_VM0();
    __syncthreads();
    if (leader) {
        unsigned* bar = b.bar;
        WAIT_ALL0();
        unsigned nsub = b.st[0], nx = b.st[1], nsubs = b.st[2];
        if (nsub == 0u) { xcd_barrier_complete(bar, b.x, b.s, nsub, nx, nsubs); b.st[0] = nsub; b.st[1] = nx; b.st[2] = nsubs; }
        const unsigned old = xb_add(&bar[XB_X2SUB(b.x, b.s)], 1u);
        const unsigned gen = old / nsub;
        bool xcd_last = false;
        if (old + 1u == (gen + 1u) * nsub) {
            const unsigned old2 = xb_add(&bar[XB_XSUB(b.x)], 1u);
            xcd_last = (old2 + 1u == (old2 / nsubs + 1u) * nsubs);
        }
        if (xcd_last) {
            FENCE_REL_AGENT();
            WAIT_VM0();
            const unsigned og = xb_add(&bar[XB_TOP], 1u);
            const unsigned tg = og / nx;
            if (og + 1u == (tg + 1u) * nx) xb_add(&bar[XB_TOPGEN], 1u);
            else XB_SPIN(xb_ld(&bar[XB_TOPGEN]) == tg, bar);
            FENCE_ACQ_AGENT();
            xb_add(&bar[XB_XGEN(b.x)], 1u);
            WAIT_VM0();
        } else {
            XB_SPIN(xb_ld(&bar[XB_XGEN(b.x)]) == gen, bar);
            FENCE_ACQ_AGENT();
            WAIT_VM0();
        }
    }
    __syncthreads();
}

__device__ __forceinline__ f32x4 mul_s4(f32x4 a, float s) {
#ifdef EMU
    return a * s;
#else
    f32x4 o;
#pragma unroll
    for (int c = 0; c < 4; ++c) { float r, x = a[c]; asm volatile("v_mul_f32_e32 %0, %1, %2" : "=v"(r) : "v"(x), "v"(s)); o[c] = r; }
    return o;
#endif
}
__device__ __forceinline__ float wave_sum_l(float v, int lane) {
    (void)lane;
    v += DPP_X1(v); v += DPP_X2(v); v += DPP_X7(v); v += DPP_X8(v);
    return xrow16_sum(v);
}
#define wave_sum(v) wave_sum_l(v, lane)
__device__ __forceinline__ float fexp(float x) { return FAST_EXP2(x * LOG2E); }
__device__ __forceinline__ float sigmoid_f(float x) { return FAST_RCP(1.f + fexp(-x)); }
__device__ __forceinline__ float log_sigmoid_f(float x) { return fminf(x, 0.f) - 0.6931471805599453f * FAST_LOG2(1.f + fexp(-fabsf(x))); }
__device__ __forceinline__ float gelu_tanh_f(float x) { const float u = 0.7978845608028654f * (x + 0.044715f * x * x * x); return x * FAST_RCP(1.f + fexp(-2.f * u)); }
__device__ __forceinline__ float silu_f(float x) { return x * FAST_RCP(1.f + fexp(-x)); }
__device__ __forceinline__ float neg_expm1_f(float x) {
    const float ser = -x * (1.f + x * (0.5f + x * (0.16666667f + x * (0.041666668f + x * (0.008333334f + x * 0.0013888889f)))));
    return (x > -0.35f) ? ser : (1.f - fexp(x));
}

struct RmIdent { __device__ __forceinline__ int operator()(int n) const { return n; } };
struct RmWin { __device__ __forceinline__ int operator()(int n) const { return n < C_FA ? n : (n < C_FA + 6 ? -1 : n - 6); } };
struct RmGu { int kind; __device__ __forceinline__ int operator()(int f) const { return (f >> 7) * 256 + ((f >> 6) & 1) * 128 + ((f >> 4) & 3) * 32 + kind * 16 + (f & 15); } };
struct RmOff { int off; __device__ __forceinline__ int operator()(int n) const { return n + off; } };

template <class RM>
__device__ __forceinline__ void convert_tile(const float* src, int ld, int K, int Nsrc, int k0, int n0, bf16_t* dst, const RM& rm, float* T, int tid) {
    {
        const int nn = tid & 255, kh = (tid >> 8) * 32, n = n0 + nn;
        const float* sp = src + (size_t)(k0 + kh) * ld + n;
        float v[32];
#pragma unroll
        for (int i = 0; i < 32; ++i) v[i] = (n < Nsrc) ? sp[(size_t)i * ld] : 0.f;
#pragma unroll
        for (int i = 0; i < 32; ++i) T[(kh + i) * 257 + nn] = v[i];
    }
    __syncthreads();
#pragma unroll
    for (int q = 0; q < 4; ++q) {
        const int nn = q * 64 + (tid >> 3), kc = (tid & 7) * 8, n = n0 + nn;
        const int row = (n < Nsrc) ? rm(n) : -1;
        if (row >= 0) {
            u32x4 o;
            o.x = pack2(T[(kc + 0) * 257 + nn], T[(kc + 1) * 257 + nn]); o.y = pack2(T[(kc + 2) * 257 + nn], T[(kc + 3) * 257 + nn]);
            o.z = pack2(T[(kc + 4) * 257 + nn], T[(kc + 5) * 257 + nn]); o.w = pack2(T[(kc + 6) * 257 + nn], T[(kc + 7) * 257 + nn]);
            *(u32x4*)(dst + (size_t)row * K + k0 + kc) = o;
        }
    }
    __syncthreads();
}
template <class RM>
__device__ __forceinline__ void convert_tile_v4(const float* src, int ld, int K, int k0, int n0, bf16_t* dst, const RM& rm, float* T, int tid_in) {
    int tid = tid_in; OPAQUE(tid);
    {
        const int w = tid >> 6, l4 = (tid & 63) * 4;
        const float* sp = src + (size_t)(k0 + w * 8) * ld + n0 + l4;
        f32x4 v[8];
#pragma unroll
        for (int i = 0; i < 8; ++i) v[i] = *(const f32x4*)(sp + (size_t)i * ld);
#pragma unroll
        for (int i = 0; i < 8; ++i) { float* tp = T + (w * 8 + i) * 257 + l4; tp[0] = v[i][0]; tp[1] = v[i][1]; tp[2] = v[i][2]; tp[3] = v[i][3]; }
    }
    __syncthreads();
#pragma unroll
    for (int q = 0; q < 4; ++q) {
        const int nn = q * 64 + (tid >> 3), kc = (tid & 7) * 8, n = n0 + nn;
        const int row = rm(n);
        u32x4 o;
        o.x = pack2(T[(kc + 0) * 257 + nn], T[(kc + 1) * 257 + nn]); o.y = pack2(T[(kc + 2) * 257 + nn], T[(kc + 3) * 257 + nn]);
        o.z = pack2(T[(kc + 4) * 257 + nn], T[(kc + 5) * 257 + nn]); o.w = pack2(T[(kc + 6) * 257 + nn], T[(kc + 7) * 257 + nn]);
        *(u32x4*)(dst + (size_t)row * K + k0 + kc) = o;
    }
    __syncthreads();
}
template <class RM>
__device__ __forceinline__ void convert_mats(const float* src, size_t sstride, int nmat, int ld, int K, int Nsrc, bf16_t* dst, size_t dstride, const RM& rm,
                                             float* T, int tid, int bid, int G) {
    const int tk = K / 64, tn = (Nsrc + 255) / 256, per = tk * tn, total = nmat * per;
    for (int t = bid; t < total; t += G) {
        const int mi = t / per, r = t % per;
        convert_tile(src + (size_t)mi * sstride, ld, K, Nsrc, (r / tn) * 64, (r % tn) * 256, dst + (size_t)mi * dstride, rm, T, tid);
    }
}

constexpr int NCONV = DEPTH * 768;
__device__ __forceinline__ void moe_conv_chunk(const Params& p, int cid, bf16_t* WguT_, bf16_t* WdT_, float* T, int tid) {
    const int l = cid / 768, r = cid % 768, kind = r >> 8, t0 = (r & 255) * 8;
    for (int t = t0; t < t0 + 8; ++t) {
        const int mi = t >> 6, rr = t & 63;
        if (kind < 2) {
            const float* src = p.in[kind == 0 ? I_WGATE : I_WUP] + ((size_t)l * NEXP + mi) * D * DFF;
            convert_tile_v4(src, DFF, D, (rr >> 1) * 64, (rr & 1) * 256, WguT_ + ((size_t)l * NEXP + mi) * 1024 * D, RmGu{kind}, T, tid);
        } else {
            const float* src = p.in[I_WDOWN] + ((size_t)l * NEXP + mi) * DFF * D;
            convert_tile_v4(src, D, DFF, (rr >> 3) * 64, (rr & 7) * 256, WdT_ + ((size_t)l * NEXP + mi) * D * DFF, RmIdent{}, T, tid);
        }
    }
}

constexpr int BK = 64, HTB = 128 * 64 * 2;
__device__ __forceinline__ int lds_byte(int r, int c) {
    const int st = (r >> 4) * 2 + (c >> 5), rr = r & 15, cc = c & 31, ob = rr * 64 + cc * 2;
    return st * 1024 + (ob ^ (((ob >> 9) & 1) << 5));
}
__device__ __forceinline__ void stage_rc(int b, int& R, int& C) {
    const int st = b / 1024, sb = b % 1024, swz = sb ^ (((sb >> 9) & 1) << 5);
    R = (st >> 1) * 16 + swz / 64; C = (st & 1) * 32 + (swz % 64) / 2;
}
template <bool GATHER>
__device__ __forceinline__ void gemm_tile(const bf16_t* A, int arow0, const unsigned (&aoff)[2][2], const bf16_t* Bt, int brow0, int K,
                                          unsigned char* shm, f32x4 (&acc)[2][2][4][2], int tid_in) {
    int tid = tid_in; OPAQUE(tid);
    unsigned toff; { int R0, C0; stage_rc(tid * 16, R0, C0); toff = (unsigned)(R0 * K + C0); }
#define SA(b, h) (shm + ((b) * 2 + (h)) * HTB)
#define SB(b, h) (shm + (4 + (b) * 2 + (h)) * HTB)
#define STAGE_B(P, h, kt) do { _Pragma("unroll") for (int _i = 0; _i < 2; ++_i) GLDS16(Bt + ((size_t)(brow0 + (h) * 128 + _i * 64) * K + (size_t)(kt) * BK) + toff, (P) + tid * 16 + _i * 8192); } while (0)
#define STAGE_A(P, h, kt) do { _Pragma("unroll") for (int _i = 0; _i < 2; ++_i) { \
    if (GATHER) GLDS16(A + (size_t)(kt) * BK + aoff[h][_i], (P) + tid * 16 + _i * 8192); \
    else GLDS16(A + ((size_t)(arow0 + (h) * 128 + _i * 64) * K + (size_t)(kt) * BK) + toff, (P) + tid * 16 + _i * 8192); } } while (0)
#define LDA(dst, b, h) _Pragma("unroll") for (int m = 0; m < 4; ++m) _Pragma("unroll") for (int k = 0; k < 2; ++k) \
    dst[m][k] = *reinterpret_cast<const bf16x8*>(SA(b, h) + lds_byte(wr * 64 + m * 16 + fr, k * 32 + fq * 8))
#define LDB(dst, b, h) _Pragma("unroll") for (int n = 0; n < 2; ++n) _Pragma("unroll") for (int k = 0; k < 2; ++k) \
    dst[n][k] = *reinterpret_cast<const bf16x8*>(SB(b, h) + lds_byte(wc * 32 + n * 16 + fr, k * 32 + fq * 8))
#define MMA(ai, bj, At, Bx) do { SETPRIO(1); \
    _Pragma("unroll") for (int m = 0; m < 4; ++m) _Pragma("unroll") for (int n = 0; n < 2; ++n) _Pragma("unroll") for (int k = 0; k < 2; ++k) \
      acc[ai][bj][m][n] = MFMA16(At[m][k], Bx[n][k], acc[ai][bj][m][n]); \
    SETPRIO(0); } while (0)
    int wid = tid >> 6, lane = tid & 63, wr = wid >> 2, wc = wid & 3, fr = lane & 15, fq = lane >> 4;
#pragma unroll
    for (int a = 0; a < 2; ++a)
#pragma unroll
        for (int b = 0; b < 2; ++b)
#pragma unroll
            for (int m = 0; m < 4; ++m)
#pragma unroll
                for (int n = 0; n < 2; ++n) acc[a][b][m][n] = (f32x4){0.f, 0.f, 0.f, 0.f};
    bf16x8 At[4][2], B0[2][2], B1[2][2];
    const int nt = K / BK;
    STAGE_B(SB(0, 0), 0, 0); STAGE_A(SA(0, 0), 0, 0);
    STAGE_B(SB(0, 1), 1, 0); STAGE_A(SA(0, 1), 1, 0);
    if (wr == 1) BAR();
    WAIT_V(4); BAR();
    STAGE_B(SB(1, 0), 0, 1); STAGE_A(SA(1, 0), 0, 1); STAGE_B(SB(1, 1), 1, 1);
    WAIT_V(6); BAR();
    for (int t = 0; t < nt - 2; t += 2) {
        LDB(B0, 0, 0); SCHED(); LDA(At, 0, 0); STAGE_A(SA(1, 1), 1, t + 1);
        WAIT_L(8); BAR(); WAIT_L(0); MMA(0, 0, At, B0); BAR(); SCHED();
        LDB(B1, 0, 1); STAGE_B(SB(0, 0), 0, t + 2);
        BAR(); WAIT_L(0); MMA(0, 1, At, B1); BAR();
        LDA(At, 0, 1); STAGE_A(SA(0, 0), 0, t + 2);
        BAR(); WAIT_L(0); MMA(1, 0, At, B0); BAR(); SCHED();
        STAGE_B(SB(0, 1), 1, t + 2);
        WAIT_V(6); BAR(); MMA(1, 1, At, B1); BAR();
        LDB(B0, 1, 0); SCHED(); LDA(At, 1, 0); STAGE_A(SA(0, 1), 1, t + 2);
        WAIT_L(8); BAR(); WAIT_L(0); MMA(0, 0, At, B0); BAR(); SCHED();
        LDB(B1, 1, 1); STAGE_B(SB(1, 0), 0, t + 3);
        BAR(); WAIT_L(0); MMA(0, 1, At, B1); BAR();
        LDA(At, 1, 1); STAGE_A(SA(1, 0), 0, t + 3);
        BAR(); WAIT_L(0); MMA(1, 0, At, B0); BAR(); SCHED();
        STAGE_B(SB(1, 1), 1, t + 3);
        WAIT_V(6); BAR(); MMA(1, 1, At, B1); BAR();
    }
    OPAQUE(tid); wid = tid >> 6; lane = tid & 63; wr = wid >> 2; wc = wid & 3; fr = lane & 15; fq = lane >> 4;
    { LDB(B0, 0, 0); WAIT_V(0); LDA(At, 0, 0); STAGE_A(SA(1, 1), 1, nt - 1);
      BAR(); WAIT_L(0); MMA(0, 0, At, B0); BAR();
      LDB(B1, 0, 1); BAR(); WAIT_L(0); MMA(0, 1, At, B1); BAR();
      LDA(At, 0, 1); WAIT_V(4); BAR(); WAIT_L(0); MMA(1, 0, At, B0); MMA(1, 1, At, B1); BAR(); }
    { LDB(B0, 1, 0); LDA(At, 1, 0); WAIT_V(2); BAR(); WAIT_L(0); MMA(0, 0, At, B0); BAR();
      LDB(B1, 1, 1); WAIT_V(0); BAR(); WAIT_L(0); MMA(0, 1, At, B1); BAR();
      LDA(At, 1, 1); BAR(); WAIT_L(0); MMA(1, 0, At, B0); MMA(1, 1, At, B1); BAR(); }
    if (wr == 0) BAR();
#undef SA
#undef SB
#undef STAGE_A
#undef STAGE_B
#undef LDA
#undef LDB
#undef MMA
}
__device__ __forceinline__ void stage_geom(int tid, int (&R)[2], int (&C)[2]) {
#pragma unroll
    for (int i = 0; i < 2; ++i) stage_rc(tid * 16 + i * 8192, R[i], C[i]);
}

constexpr int ATT_KBUF = 0, ATT_VBUF = 32768, ATT_CBUF = 65536;
template <int KIND>
__device__ __forceinline__ void attn_unit(const bf16_t* Q, const bf16_t* Kg, const bf16_t* VT, const float* cum2, const float* kmx, int qb, bf16_t* concat, int ccol0,
                                          float lam, float osc, const float* subg, unsigned char* lds, int tid) {
    const int lane = tid & 63, wave = tid >> 6, r16 = lane & 15, q4 = lane >> 4;
    const int q0w = qb * 128 + wave * 16, myq = q0w + r16;
    const int ntiles = 2 * qb + 2;
    const int wlimit = (KIND == 0) ? ((q0w + 15) >> 6) : (q0w >> 6);
    constexpr int NMAP = (KIND == 0) ? 1 : 2, NKS = (KIND == 0) ? 4 : 2;
    bf16x8 qf[NMAP][NKS];
#pragma unroll
    for (int mp = 0; mp < NMAP; ++mp)
#pragma unroll
        for (int ks = 0; ks < NKS; ++ks) qf[mp][ks] = *(const bf16x8*)(Q + (size_t)myq * 128 + mp * 64 + ks * 32 + q4 * 8);
    const float cq = (KIND == 0) ? cum2[myq] : 0.f;
    int kt0 = 0;
    if (KIND == 0) {
        float* wmax = (float*)(lds + ATT_CBUF + 512); int* kst = (int*)(lds + ATT_CBUF + 576);
        float qs = 0.f;
#pragma unroll
        for (int ks = 0; ks < NKS; ++ks)
#pragma unroll
            for (int j = 0; j < 8; ++j) { const float v = bf2f((bf16_t)qf[0][ks][j]); qs += v * v; }
        qs = xrow16_sum(qs);
        qs = fmaxf(qs, SHX(qs, 1)); qs = fmaxf(qs, SHX(qs, 2)); qs = fmaxf(qs, SHX(qs, 4)); qs = fmaxf(qs, SHX(qs, 8));
        if (lane == 0) wmax[wave] = qs;
        if (tid == 0) *kst = 2 * qb;
        __syncthreads();
        float qm = wmax[0];
#pragma unroll
        for (int w = 1; w < 8; ++w) qm = fmaxf(qm, wmax[w]);
        qm = sqrtf(qm) * 1.01f;
        const float kd = sqrtf(fmaxf(kmx[2 * qb], kmx[2 * qb + 1])) * 1.01f;
        if (tid < 2 * qb) {
            const float bias = cum2[qb * 128] - cum2[tid * 64 + 63];
            const bool skip = bias + qm * (sqrtf(kmx[tid]) * 1.01f + kd) < -40.f;
            if (!skip) atomic_min_int(kst, tid);
        }
        __syncthreads();
        kt0 = RFL(*kst);
    }
    f32x4 ot[NMAP][8];
    float mrun[NMAP], lsum[NMAP];
#pragma unroll
    for (int mp = 0; mp < NMAP; ++mp) { mrun[mp] = -INFINITY; lsum[mp] = 0.f;
#pragma unroll
        for (int mo = 0; mo < 8; ++mo) ot[mp][mo] = (f32x4){0.f, 0.f, 0.f, 0.f}; }
    u32x4 sk[2], sv[2]; float sc = 0.f;
    const u32x4* kg = (const u32x4*)Kg; const u32x4* vg = (const u32x4*)VT;
#pragma unroll
    for (int i = 0; i < 2; ++i) { sk[i] = kg[(size_t)kt0 * 1024 + tid + i * 512]; sv[i] = vg[(size_t)kt0 * 1024 + tid + i * 512]; }
    if (KIND == 0 && tid < 64) sc = cum2[kt0 * 64 + tid];
    for (int kt = kt0; kt < ntiles; ++kt) {
        unsigned char* kb = lds + ATT_KBUF + (kt & 1) * 16384;
        unsigned char* vb = lds + ATT_VBUF + (kt & 1) * 16384;
        float* cb = (float*)(lds + ATT_CBUF + (kt & 1) * 256);
#pragma unroll
        for (int i = 0; i < 2; ++i) {
            const int g = tid + i * 512;
            { const int row = g >> 4, c = g & 15; *(u32x4*)(kb + row * 256 + ((c ^ (row & 15)) << 4)) = sk[i]; }
            { const int d = g >> 3, c = g & 7; *(u32x4*)(vb + d * 128 + ((c ^ ((d >> 1) & 7)) << 4)) = sv[i]; }
        }
        if (KIND == 0 && tid < 64) cb[tid] = sc;
        __syncthreads();
        if (kt + 1 < ntiles) {
#pragma unroll
            for (int i = 0; i < 2; ++i) { sk[i] = kg[(size_t)(kt + 1) * 1024 + tid + i * 512]; sv[i] = vg[(size_t)(kt + 1) * 1024 + tid + i * 512]; }
            if (KIND == 0 && tid < 64) sc = cum2[(kt + 1) * 64 + tid];
        }
        if (kt <= wlimit) {
#pragma unroll
            for (int mp = 0; mp < NMAP; ++mp) {
                bf16x8 kf[4][NKS], vfa[8];
#pragma unroll
                for (int m = 0; m < 4; ++m)
#pragma unroll
                    for (int ks = 0; ks < NKS; ++ks) { const int c = (KIND == 0 ? 0 : mp * 8) + ks * 4 + q4; kf[m][ks] = *(const bf16x8*)(kb + (m * 16 + r16) * 256 + ((c ^ r16) << 4)); }
#pragma unroll
                for (int mo = 0; mo < 8; ++mo) { const int d = mo * 16 + r16; vfa[mo] = *(const bf16x8*)(vb + d * 128 + (((0 * 4 + q4) ^ ((d >> 1) & 7)) << 4)); }
                SCHED();
                f32x4 st[4];
#pragma unroll
                for (int m = 0; m < 4; ++m) st[m] = (f32x4){0.f, 0.f, 0.f, 0.f};
#pragma unroll
                for (int ks = 0; ks < NKS; ++ks)
#pragma unroll
                    for (int m = 0; m < 4; ++m) st[m] = MFMA16(kf[m][ks], qf[mp][ks], st[m]);
                SCHED();
                float mx = -INFINITY;
#pragma unroll
                for (int m = 0; m < 4; ++m) {
                    if (KIND == 0) {
                        const f32x4 ck = *(const f32x4*)(cb + m * 16 + 4 * q4);
#pragma unroll
                        for (int j = 0; j < 4; ++j) {
                            float y = st[m][j] + (cq - ck[j]);
                            if (kt * 64 + m * 16 + 4 * q4 + j > myq) y = -INFINITY;
                            st[m][j] = y;
                        }
                    }
#pragma unroll
                    for (int j = 0; j < 4; ++j) mx = fmaxf(mx, st[m][j]);
                }
                mx = xrow16_max(mx);
                const float mnew = fmaxf(mrun[mp], mx);
                const float alpha = FAST_EXP2(mrun[mp] - mnew);
                mrun[mp] = mnew;
                float ps = 0.f;
#pragma unroll
                for (int m = 0; m < 4; ++m)
#pragma unroll
                    for (int j = 0; j < 4; ++j) { const float pv = FAST_EXP2(st[m][j] - mnew); st[m][j] = pv; ps += pv; }
                lsum[mp] = lsum[mp] * alpha + ps;
#pragma unroll
                for (int mo = 0; mo < 8; ++mo) ot[mp][mo] *= alpha;
                bf16x8 pf[2];
#pragma unroll
                for (int kk = 0; kk < 2; ++kk) {
                    u32x4 pw;
                    pw.x = pack2(st[2 * kk][0], st[2 * kk][1]); pw.y = pack2(st[2 * kk][2], st[2 * kk][3]);
                    pw.z = pack2(st[2 * kk + 1][0], st[2 * kk + 1][1]); pw.w = pack2(st[2 * kk + 1][2], st[2 * kk + 1][3]);
                    pf[kk] = __builtin_bit_cast(bf16x8, pw);
                }
                bf16x8 vfb[8];
#pragma unroll
                for (int mo = 0; mo < 8; ++mo) { const int d = mo * 16 + r16; vfb[mo] = *(const bf16x8*)(vb + d * 128 + (((1 * 4 + q4) ^ ((d >> 1) & 7)) << 4)); }
                SCHED();
#pragma unroll
                for (int mo = 0; mo < 8; ++mo) ot[mp][mo] = MFMA16(vfa[mo], pf[0], ot[mp][mo]);
                SCHED();
#pragma unroll
                for (int mo = 0; mo < 8; ++mo) ot[mp][mo] = MFMA16(vfb[mo], pf[1], ot[mp][mo]);
            }
        }
    }
    float inv[NMAP];
#pragma unroll
    for (int mp = 0; mp < NMAP; ++mp) { float l = lsum[mp]; l = xrow16_sum(l); inv[mp] = 1.f / l; }
    if (KIND == 0) {
#pragma unroll
        for (int mo = 0; mo < 8; ++mo) {
            u32x2 o; o.x = pack2(ot[0][mo][0] * inv[0], ot[0][mo][1] * inv[0]); o.y = pack2(ot[0][mo][2] * inv[0], ot[0][mo][3] * inv[0]);
            *(u32x2*)(concat + (size_t)myq * D + ccol0 + mo * 16 + 4 * q4) = o;
        }
    } else {
        float ss = 0.f;
#pragma unroll
        for (int mo = 0; mo < 8; ++mo)
#pragma unroll
            for (int j = 0; j < 4; ++j) { const float v = ot[0][mo][j] * inv[0] - lam * (ot[NMAP - 1][mo][j] * inv[NMAP - 1]); ot[0][mo][j] = v; ss += v * v; }
        ss = xrow16_sum(ss);
        const float rs = osc / sqrtf(ss * (1.f / 128.f) + LN_EPS);
#pragma unroll
        for (int mo = 0; mo < 8; ++mo) {
            const f32x4 g = *(const f32x4*)(subg + mo * 16 + 4 * q4);
            u32x2 o; o.x = pack2(ot[0][mo][0] * rs * g[0], ot[0][mo][1] * rs * g[1]); o.y = pack2(ot[0][mo][2] * rs * g[2], ot[0][mo][3] * rs * g[3]);
            *(u32x2*)(concat + (size_t)myq * D + ccol0 + mo * 16 + 4 * q4) = o;
        }
    }
    __syncthreads();
}

__device__ __forceinline__ int dpart_row(int c, int q) { return c * (S - DCH * 64) - (DCH * 32) * c * (c - 1) + q; }
__device__ __forceinline__ void attn_dmap_unit(const bf16_t* Qh, const bf16_t* Kh, const bf16_t* VTh, int mp, int qb, int t0, int t1,
                                               bf16_t* Op, float* ML, int c, float bnd, unsigned char* lds, int tid) {
    const bool fixedref = (bnd <= 60.f);
    const int lane = tid & 63, wave = tid >> 6, r16 = lane & 15, q4 = lane >> 4;
    const int q0w = qb * 256 + wave * 32;
    const int wlimit = q0w >> 6;
    bf16x8 qf[2][2];
#pragma unroll
    for (int n = 0; n < 2; ++n)
#pragma unroll
        for (int ks = 0; ks < 2; ++ks) qf[n][ks] = *(const bf16x8*)(Qh + (size_t)(q0w + n * 16 + r16) * 128 + mp * 64 + ks * 32 + q4 * 8);
    f32x4 ot[8][2];
    float mrun[2] = {-INFINITY, -INFINITY}, lsum[2] = {0.f, 0.f};
    if (fixedref) { mrun[0] = bnd; mrun[1] = bnd; }
    const float stinit = fixedref ? -bnd : 0.f;
#pragma unroll
    for (int mo = 0; mo < 8; ++mo) { ot[mo][0] = (f32x4){0.f, 0.f, 0.f, 0.f}; ot[mo][1] = (f32x4){0.f, 0.f, 0.f, 0.f}; }
    u32x4 sk, sv[2];
    const u32x4* kg = (const u32x4*)Kh; const u32x4* vg = (const u32x4*)VTh;
    const int krow = tid >> 3, kc8 = tid & 7;
    sk = kg[(size_t)t0 * 1024 + krow * 16 + mp * 8 + kc8];
#pragma unroll
    for (int i = 0; i < 2; ++i) sv[i] = vg[(size_t)t0 * 1024 + tid + i * 512];
    for (int kt = t0; kt < t1; ++kt) {
        unsigned char* kb = lds + (kt & 1) * 8192;
        unsigned char* vb = lds + 16384 + (kt & 1) * 16384;
        *(u32x4*)(kb + krow * 128 + ((kc8 ^ ((krow >> 1) & 7)) << 4)) = sk;
#pragma unroll
        for (int i = 0; i < 2; ++i) { const int g = tid + i * 512, d = g >> 3, cc = g & 7; *(u32x4*)(vb + d * 128 + ((cc ^ ((d >> 1) & 7)) << 4)) = sv[i]; }
        __syncthreads();
        if (kt + 1 < t1) {
            sk = kg[(size_t)(kt + 1) * 1024 + krow * 16 + mp * 8 + kc8];
#pragma unroll
            for (int i = 0; i < 2; ++i) sv[i] = vg[(size_t)(kt + 1) * 1024 + tid + i * 512];
        }
        if (kt <= wlimit) {
            bf16x8 kf[4][2], vfa[8];
#pragma unroll
            for (int m = 0; m < 4; ++m)
#pragma unroll
                for (int ks = 0; ks < 2; ++ks) kf[m][ks] = *(const bf16x8*)(kb + (m * 16 + r16) * 128 + (((ks * 4 + q4) ^ ((r16 >> 1) & 7)) << 4));
#pragma unroll
            for (int mo = 0; mo < 8; ++mo) { const int d = mo * 16 + r16; vfa[mo] = *(const bf16x8*)(vb + d * 128 + (((0 * 4 + q4) ^ ((d >> 1) & 7)) << 4)); }
            SCHED();
            f32x4 st[4][2];
#pragma unroll
            for (int m = 0; m < 4; ++m) { st[m][0] = (f32x4){stinit, stinit, stinit, stinit}; st[m][1] = (f32x4){stinit, stinit, stinit, stinit}; }
            SETPRIO(1);
#pragma unroll
            for (int ks = 0; ks < 2; ++ks)
#pragma unroll
                for (int m = 0; m < 4; ++m) { st[m][0] = MFMA16(kf[m][ks], qf[0][ks], st[m][0]); st[m][1] = MFMA16(kf[m][ks], qf[1][ks], st[m][1]); }
            SETPRIO(0);
            SCHED();
            float alpha[2] = {1.f, 1.f};
            if (fixedref) {
#pragma unroll
                for (int n = 0; n < 2; ++n) {
                    float ps = 0.f;
#pragma unroll
                    for (int m = 0; m < 4; ++m)
#pragma unroll
                        for (int j = 0; j < 4; ++j) { const float pv = FAST_EXP2(st[m][n][j]); st[m][n][j] = pv; ps += pv; }
                    lsum[n] += ps;
                }
            } else
#pragma unroll
            for (int n = 0; n < 2; ++n) {
                float mx = -INFINITY;
#pragma unroll
                for (int m = 0; m < 4; ++m)
#pragma unroll
                    for (int j = 0; j < 4; ++j) mx = fmaxf(mx, st[m][n][j]);
                mx = xrow16_max(mx);
                const float mnew = fmaxf(mrun[n], mx);
                alpha[n] = FAST_EXP2(mrun[n] - mnew);
                mrun[n] = mnew;
                float ps = 0.f;
#pragma unroll
                for (int m = 0; m < 4; ++m)
#pragma unroll
                    for (int j = 0; j < 4; ++j) { const float pv = FAST_EXP2(st[m][n][j] - mnew); st[m][n][j] = pv; ps += pv; }
                lsum[n] = lsum[n] * alpha[n] + ps;
            }
            if (ANY_LANE(alpha[0] != 1.f)) {
#pragma unroll
                for (int mo = 0; mo < 8; ++mo) ot[mo][0] *= alpha[0];
            }
            if (ANY_LANE(alpha[1] != 1.f)) {
#pragma unroll
                for (int mo = 0; mo < 8; ++mo) ot[mo][1] *= alpha[1];
            }
            bf16x8 pf[2][2];
#pragma unroll
            for (int kk = 0; kk < 2; ++kk)
#pragma unroll
                for (int n = 0; n < 2; ++n) {
                    u32x4 pw;
                    pw.x = pack2(st[2 * kk][n][0], st[2 * kk][n][1]); pw.y = pack2(st[2 * kk][n][2], st[2 * kk][n][3]);
                    pw.z = pack2(st[2 * kk + 1][n][0], st[2 * kk + 1][n][1]); pw.w = pack2(st[2 * kk + 1][n][2], st[2 * kk + 1][n][3]);
                    pf[kk][n] = __builtin_bit_cast(bf16x8, pw);
                }
            bf16x8 vfb[8];
#pragma unroll
            for (int mo = 0; mo < 8; ++mo) { const int d = mo * 16 + r16; vfb[mo] = *(const bf16x8*)(vb + d * 128 + (((1 * 4 + q4) ^ ((d >> 1) & 7)) << 4)); }
            SCHED();
            SETPRIO(1);
#pragma unroll
            for (int mo = 0; mo < 8; ++mo) { ot[mo][0] = MFMA16(vfa[mo], pf[0][0], ot[mo][0]); ot[mo][1] = MFMA16(vfa[mo], pf[0][1], ot[mo][1]); }
            SCHED();
#pragma unroll
            for (int mo = 0; mo < 8; ++mo) { ot[mo][0] = MFMA16(vfb[mo], pf[1][0], ot[mo][0]); ot[mo][1] = MFMA16(vfb[mo], pf[1][1], ot[mo][1]); }
            SETPRIO(0);
        }
    }
    if (q0w >= DCH * 64 * c)
#pragma unroll
    for (int n = 0; n < 2; ++n) {
        float l = lsum[n]; l = xrow16_sum(l);
        const int row = dpart_row(c, q0w + n * 16 + r16);
#pragma unroll
        for (int mo = 0; mo < 8; ++mo) {
            u32x2 o; o.x = pack2(ot[mo][n][0], ot[mo][n][1]); o.y = pack2(ot[mo][n][2], ot[mo][n][3]);
            *(u32x2*)(Op + (size_t)(row * 128 + mo * 16 + 4 * q4)) = o;
        }
        if (q4 == 0) { ML[row * 2] = mrun[n]; ML[row * 2 + 1] = l; }
    }
    __syncthreads();
}

__device__ __forceinline__ void lru_unit_a(int chunk, int grp, int l, const Params& p, const bf16_t* Xr, const bf16_t* WaiT, float* hloc, float* ploc, float* sumA, float* sumH,
                                           unsigned char* lds, int tid) {
    const int lane = tid & 63, wave = tid >> 6, r16 = lane & 15, q4 = lane >> 4;
    unsigned char* XCB = lds; float* XU = (float*)(lds + 16384); float* LA = (float*)(lds + 49152); float* ENDS = (float*)(lds + 81920);
    const int t0 = chunk * 64, ch0 = grp * 128;
    bf16x8 bfr[2][4];
#pragma unroll
    for (int g = 0; g < 2; ++g)
#pragma unroll
        for (int ks = 0; ks < 4; ++ks) bfr[g][ks] = *(const bf16x8*)(WaiT + ((size_t)grp * 256 + g * 128 + wave * 16 + r16) * 128 + ks * 32 + q4 * 8);
    const int chg = ch0 + wave * 16 + r16;
    const float ba = p.in[I_BA][(size_t)l * LRU_W + chg], bi = p.in[I_BI][(size_t)l * LRU_W + chg];
    const float lam_raw = p.in[I_LAM][(size_t)l * LRU_W + chg];
    {
        const int c = tid & 127, tq = tid >> 7, ch = ch0 + c;
        const float* cw = p.in[I_CONVW] + (size_t)l * 4 * LRU_W + ch; const float cb = p.in[I_CONVB][(size_t)l * LRU_W + ch];
        const float w0 = cw[0], w1 = cw[LRU_W], w2 = cw[2 * LRU_W], w3 = cw[3 * LRU_W];
        const int ts = t0 + tq * 16;
        float x0 = (ts - 3 >= 0) ? bf2f(Xr[(size_t)(ts - 3) * LRU_W + ch]) : 0.f;
        float x1 = (ts - 2 >= 0) ? bf2f(Xr[(size_t)(ts - 2) * LRU_W + ch]) : 0.f;
        float x2 = (ts - 1 >= 0) ? bf2f(Xr[(size_t)(ts - 1) * LRU_W + ch]) : 0.f;
#pragma unroll
        for (int i = 0; i < 16; ++i) {
            const float x3 = bf2f(Xr[(size_t)(ts + i) * LRU_W + ch]);
            const float v = cb + w0 * x0 + w1 * x1 + w2 * x2 + w3 * x3;
            const int row = tq * 16 + i;
            XU[row * 128 + c] = v;
            *(bf16_t*)(XCB + row * 256 + (((c >> 3) ^ (row & 15)) << 4) + (c & 7) * 2) = f2bf(v);
            x0 = x1; x1 = x2; x2 = x3;
        }
    }
    __syncthreads();
    {
        const float lsl = 8.0f * log_sigmoid_f(lam_raw);
#pragma unroll
        for (int mt = 0; mt < 4; ++mt) {
            f32x4 ga = (f32x4){0.f, 0.f, 0.f, 0.f}, gi = (f32x4){0.f, 0.f, 0.f, 0.f};
#pragma unroll
            for (int ks = 0; ks < 4; ++ks) {
                const bf16x8 af = *(const bf16x8*)(XCB + (mt * 16 + r16) * 256 + (((ks * 4 + q4) ^ r16) << 4));
                ga = MFMA16(af, bfr[0][ks], ga); gi = MFMA16(af, bfr[1][ks], gi);
            }
#pragma unroll
            for (int j = 0; j < 4; ++j) {
                const int row = mt * 16 + 4 * q4 + j, idx = row * 128 + wave * 16 + r16;
                const float r = sigmoid_f(ga[j] + ba), ig = sigmoid_f(gi[j] + bi);
                const float log_a = lsl * r;
                LA[idx] = fexp(log_a);
                XU[idx] = sqrtf(neg_expm1_f(2.f * log_a)) * (ig * XU[idx]);
            }
        }
    }
    __syncthreads();
    {
        const int c = tid & 127, tq = tid >> 7, ch = ch0 + c;
        float h = 0.f, P = 1.f;
#pragma unroll
        for (int i = 0; i < 16; ++i) { const int idx = (tq * 16 + i) * 128 + c; const float a = LA[idx]; h = a * h + XU[idx]; P *= a; XU[idx] = h; LA[idx] = P; }
        ENDS[tq * 128 + c] = P; ENDS[512 + tq * 128 + c] = h;
        __syncthreads();
        float cin = 0.f, pin = 1.f;
        for (int s = 0; s < tq; ++s) { const float Ps = ENDS[s * 128 + c], hs = ENDS[512 + s * 128 + c]; cin = Ps * cin + hs; pin *= Ps; }
#pragma unroll
        for (int i = 0; i < 16; ++i) {
            const int idx = (tq * 16 + i) * 128 + c; const size_t gi = (size_t)(t0 + tq * 16 + i) * LRU_W + ch;
            const float Pl = LA[idx], hl = XU[idx];
            ((unsigned*)hloc)[gi] = pack2(hl + Pl * cin, Pl * pin);
        }
        if (tq == 3) { const float Pl = LA[63 * 128 + c], hl = XU[63 * 128 + c]; sumA[(size_t)chunk * LRU_W + ch] = Pl * pin; sumH[(size_t)chunk * LRU_W + ch] = hl + Pl * cin; }
    }
    __syncthreads();
}

__device__ __forceinline__ void moe_prefix(const int* cntb_, int G, unsigned char* lds, int tid) {
    int* tmp = (int*)lds; int* ctot = (int*)(lds + LDS_MISC + M_CTOT); int* coff = (int*)(lds + LDS_MISC + M_COFF);
    unsigned short* pre16 = (unsigned short*)(lds + LDS_MISC + M_PRE16);
    const int e = tid & 31, part = tid >> 5, PB = (G + 15) / 16;
    int sm = 0;
    for (int i = 0; i < PB; ++i) { const int b = part * PB + i; if (b < G) sm += cntb_[b * 32 + e]; }
    tmp[part * 32 + e] = sm;
    __syncthreads();
    int run = 0;
    for (int q = 0; q < part; ++q) run += tmp[q * 32 + e];
    for (int i = 0; i < PB; ++i) { const int b = part * PB + i; if (b < G) { pre16[e * 257 + b] = (unsigned short)run; run += cntb_[b * 32 + e]; } }
    if (part == 15) { ctot[e] = run; pre16[e * 257 + G] = (unsigned short)run; }
    __syncthreads();
    if (tid == 0) { int o = 0; for (int q = 0; q < 32; ++q) { coff[q] = o; o += ctot[q]; } coff[32] = o; }
    __syncthreads();
}
__device__ __forceinline__ void moe_rowtable(const int* ltok_, const float* lw_, const int* lslot_, int e, int m0, int c_e, int G, int segcap, unsigned char* lds, int tid_in) {
    int tid = tid_in; OPAQUE(tid);
    const unsigned short* pre = (const unsigned short*)(lds + LDS_MISC + M_PRE16) + e * 257;
    int* rtok = (int*)(lds + LDS_MISC + M_RTOK); float* rw = (float*)(lds + LDS_MISC + M_RW); int* rslot = (int*)(lds + LDS_MISC + M_RSLOT);
    if (tid < 256) {
        const int g = m0 + tid;
        int tk = 0, sl = 0; float w = 0.f;
        if (g < c_e) {
            int lo = 0, hi = G;
            while (hi - lo > 1) { const int mid = (lo + hi) >> 1; if ((int)pre[mid] <= g) lo = mid; else hi = mid; }
            const int idx = (e * G + lo) * segcap + (g - (int)pre[lo]);
            tk = ltok_[idx]; w = lw_[idx]; sl = lslot_[idx];
        }
        rtok[tid] = tk; rw[tid] = w; rslot[tid] = sl;
    }
    __syncthreads();
}
#define kmax2 ((float*)(wsl + A_KMAX))
#define dpo ((bf16_t*)(wsl + A_DPO))
#define dpml ((float*)(wsl + A_DPML))
#define cntb ((int*)(wsl + A_CNTB))
#define WinT ((bf16_t*)(wsl + WB_WIN))
#define WoT ((bf16_t*)(wsl + WB_WO))
#define WguT ((bf16_t*)(wsl + WB_WGU))
#define WdT ((bf16_t*)(wsl + WB_WD))
#define WaiT ((bf16_t*)(wsl + WB_WAI))
#define Wfa ((float*)(wsl + WF_FA))
#define W36b ((bf16_t*)(wsl + WF_R36))
#define ropecs ((float*)(wsl + WF_ROPE))
#define xb ((bf16_t*)(wsl + A_XB))
#define hb ((float*)(wsl + A_HB))
#define logf_ ((float*)(wsl + A_LOGF))
#define cum2 ((float*)(wsl + A_CUM))
#define Qa ((bf16_t*)(wsl + A_QA))
#define Ka ((bf16_t*)(wsl + A_KA))
#define VaT ((bf16_t*)(wsl + A_VAT))
#define Xr ((bf16_t*)(wsl + A_XR))
#define Gr ((bf16_t*)(wsl + A_GR))
#define Qc ((bf16_t*)(wsl + A_QC))
#define Kc ((bf16_t*)(wsl + A_KC))
#define VcT ((bf16_t*)(wsl + A_VCT))
#define hloc ((float*)(wsl + A_HLOC))
#define ploc ((float*)(wsl + A_PLOC))
#define sumA ((float*)(wsl + A_SUMA))
#define sumH ((float*)(wsl + A_SUMH))
#define concat ((bf16_t*)(wsl + A_CONCAT))
#define y1 ((float*)(wsl + A_Y1))
#define h1 ((float*)(wsl + A_H1))
#define h1b ((bf16_t*)(wsl + A_H1B))
#define ltok ((int*)(wsl + A_LTOK))
#define lw ((float*)(wsl + A_LW))
#define lslot ((int*)(wsl + A_LSLOT))
#define act ((bf16_t*)(wsl + A_ACT))
#define contrib ((bf16_t*)(wsl + A_CONTRIB))
#ifndef EMU
__global__ void __launch_bounds__(NTHREADS, 2)
#else
void
#endif
fwd_kernel(Params p) {
    DYN_LDS(lds_raw);
    float* ldsf = (float*)lds_raw;
    const int bid = blockIdx.x, G = gridDim.x;
    const int gthreads = G * NTHREADS, gwaves = G * (NTHREADS / 64);
    const int wave_s = RFL((int)threadIdx.x >> 6);
#define PHASE_IDS() unsigned char* wsl = ws; OPAQUE_S(wsl); int tid = wave_s * 64 + LANE_ID(); OPAQUE(tid); const int lane = tid & 63, wave = tid >> 6, gtid = bid * NTHREADS + tid, gwave = bid * (NTHREADS / 64) + wave; (void)lane; (void)wave; (void)gtid; (void)gwave

    unsigned char* ws = p.ws;
    volatile LAS unsigned* bst = (volatile LAS unsigned*)(lds_raw + LDS_MISC);
    unsigned* ubox = (unsigned*)(lds_raw + LDS_MISC + 16);
    if (threadIdx.x == 0) { bst[0] = 0u; bst[1] = 0u; bst[2] = 0u; bst[3] = 0u; }
    __syncthreads();
    XcdBarrier bar = xcd_barrier_post((unsigned*)ws, bst);

    const int* positions = (const int*)p.in[I_POS];

    constexpr int NPH = 8;
    const int lo = p.lo, hi = p.hi;
#ifdef ONLY_PHASE
#define PH_SEL(c) ((c) == ONLY_PHASE)
#else
#define PH_SEL(c) 1
#endif
#define PH_IN(k) (lo <= (k) && (k) < hi)
#define PH_BAR(k) do { if ((k) + 1 < hi) xcd_barrier(bar, wave_s == 0 && LANE_ID() == 0); } while (0)

    if (PH_SEL(-1) && PH_IN(0)) for (int rep = 0; rep < PH_REPS(-1); ++rep) {
        PHASE_IDS();
        for (int l = 0; l < DEPTH; ++l) {
            convert_mats(p.in[I_WIN] + (size_t)l * D * N_IN, 0, 1, N_IN, D, N_IN, WinT + (size_t)l * N_INP * D, 0, RmWin{}, ldsf, tid, bid, G);
            for (int t = bid; t < (D / 64) * (D / 256); t += G)
                convert_tile_v4(p.in[I_WO] + (size_t)l * D * D, D, D, (t / (D / 256)) * 64, (t % (D / 256)) * 256, WoT + (size_t)l * D * D, RmIdent{}, ldsf, tid);
            convert_mats(p.in[I_WA] + (size_t)l * 6 * 128 * 128, (size_t)128 * 128, 6, 128, 128, 128, WaiT + (size_t)l * 6 * 256 * 128, (size_t)256 * 128, RmIdent{}, ldsf, tid, bid, G);
            convert_mats(p.in[I_WI] + (size_t)l * 6 * 128 * 128, (size_t)128 * 128, 6, 128, 128, 128, WaiT + (size_t)l * 6 * 256 * 128, (size_t)256 * 128, RmOff{128}, ldsf, tid, bid, G);
        }
        for (int i = gtid; i < DEPTH * 8 * D; i += gthreads) { const int k = i % D, h = (i / D) % 8, l = i / (8 * D);
            Wfa[i] = (h < 6) ? p.in[I_WIN][(size_t)l * D * N_IN + (size_t)k * N_IN + C_FA + h] : 0.f; }
        for (int i = gtid; i < DEPTH * 48 * D; i += gthreads) { const int k = i % D, o = (i / D) % 48, l = i / (48 * D);
            const float w = (o < 4) ? p.in[I_WGRP][((size_t)l * D + k) * 4 + o] : (o < 36 ? p.in[I_WRT][((size_t)l * D + k) * 32 + (o - 4)] : 0.f);
            const bf16_t hi = f2bf(w);
            W36b[((size_t)l * 2 + 0) * 48 * D + (size_t)o * D + k] = hi; W36b[((size_t)l * 2 + 1) * 48 * D + (size_t)o * D + k] = f2bf(w - bf2f(hi)); }
        for (int i = gtid; i < S * 8; i += gthreads) { const int d = i & 7, t = i >> 3; const float ang = (float)positions[t] * p.inv_freq[d];
            ropecs[t * 16 + d] = cosf(ang); ropecs[t * 16 + 8 + d] = sinf(ang); }
        __syncthreads();
        for (int i = tid; i < 6 * D; i += NTHREADS) { const int k = i % D, h = i / D; ldsf[i] = p.in[I_WIN][(size_t)k * N_IN + C_FA + h]; }
        __syncthreads();
        for (int t0 = gwave * 2; t0 < S; t0 += gwaves * 2) {
            f32x4 v[2][8];
#pragma unroll
            for (int tk = 0; tk < 2; ++tk)
#pragma unroll
                for (int j = 0; j < 8; ++j) v[tk][j] = *(const f32x4*)(p.in[I_X] + (size_t)(t0 + tk) * D + j * 256 + lane * 4);
#pragma unroll
            for (int tk = 0; tk < 2; ++tk) {
                const int t = t0 + tk;
                float fa[6] = {0.f, 0.f, 0.f, 0.f, 0.f, 0.f};
#pragma unroll
                for (int j = 0; j < 8; ++j) {
                    const int c = j * 256 + lane * 4;
                    u32x2 o; o.x = pack2(v[tk][j][0], v[tk][j][1]); o.y = pack2(v[tk][j][2], v[tk][j][3]);
                    *(u32x2*)(xb + (size_t)t * D + c) = o;
#pragma unroll
                    for (int h = 0; h < 6; ++h) { const f32x4 w = *(const f32x4*)(ldsf + h * D + c); fa[h] += v[tk][j][0] * w[0] + v[tk][j][1] * w[1] + v[tk][j][2] * w[2] + v[tk][j][3] * w[3]; }
                    COMPILER_FENCE();
                }
#pragma unroll
                for (int h = 0; h < 6; ++h) { const float sm = wave_sum(fa[h]); if (lane == 0) logf_[h * S + t] = log_sigmoid_f(sm + p.in[I_BF][h]); }
            }
        }
        PH_BAR(0);
    }

    for (int l = 0; l < DEPTH; ++l) {
        const int pb = 1 + l * NPH;
#define hin ((l == 0) ? p.in[I_X] : (const float*)hb)
#define hout ((l == DEPTH - 1) ? p.out : hb)
#define workctr ((int*)(wsl + CTL_WORK_OFF) + l * 64)

        if (PH_SEL(0) && PH_IN(pb + 0)) {
            PHASE_IDS();
            int bz = RFL(bid); OPAQUE_S(bz);
            if (bz == 0) {
                double* part = (double*)lds_raw;
                const int per = S / 64;
                double s = 0.0;
                if (wave < 6) { for (int i = 0; i < per; ++i) s += (double)logf_[wave * S + lane * per + i]; part[wave * 64 + lane] = s; }
                __syncthreads();
                if (wave < 6) {
                    double run = 0.0;
                    for (int j = 0; j < lane; ++j) run += part[wave * 64 + j];
                    for (int i = 0; i < per; ++i) { run += (double)logf_[wave * S + lane * per + i]; cum2[wave * S + lane * per + i] = (float)(run * (double)LOG2E); }
                }
                __syncthreads();
            }
            bool conv_more = (l == 0);
#define CONV_ONE() do { if (conv_more) { __syncthreads(); if (tid == 0) *ubox = (unsigned)atomic_add_int((int*)(wsl + CTL_WORK_OFF) + 62, 1); __syncthreads(); \
                const int cid_ = RFL((int)*ubox); if (cid_ < NCONV) moe_conv_chunk(p, cid_, WguT, WdT, ldsf, tid); else conv_more = false; } } while (0)
            unsigned* cls = (unsigned*)(wsl + CTL_CLS_OFF) + l * 256;
            if (bz == 0) { WAIT_VM0(); __syncthreads(); if (tid == 0) { FENCE_REL_AGENT(); WAIT_VM0(); (void)xb_add(&cls[192], 1u); } }
            const bf16_t* Bt = WinT + (size_t)l * N_INP * D;
            constexpr int ntm = S / 256;
            const unsigned nooff[2][2] = {{0u, 0u}, {0u, 0u}};
            for (int i = 0; i < (bid & 3); ++i) CONV_ONE();
            for (;;) {
                __syncthreads();
                if (tid == 0) *ubox = (unsigned)atomic_add_int(workctr + 9, 1);
                __syncthreads();
                int t = RFL((int)*ubox);
                if (t >= ntm * 21) break;
                int pm, pn, kcls;
                if (t < ntm * 6) { pm = t / 6; pn = 15 + t % 6; kcls = 0; }
                else if (t < ntm * 12) { t -= ntm * 6; pm = t / 6; pn = 9 + t % 6; kcls = 1; }
                else { t -= ntm * 12; pm = t / 9; pn = t % 9; kcls = 2; }
                f32x4 acc[2][2][4][2];
                gemm_tile<false>(xb, pm * 256, nooff, Bt, pn * 256, D, lds_raw, acc, tid);
                int et = tid; OPAQUE(et); const int wr = et >> 8, wc = (et >> 6) & 3, fr = et & 15, fq = (et >> 4) & 3;
                if (pn < 6 || (pn >= 9 && pn < 19)) {
                    bf16_t* dst; float scale = 1.f; bool rope = false;
                    if (pn < 3) { dst = Qa; scale = QSCALE_A; } else if (pn < 6) { dst = Ka; } else if (pn < 12) { dst = Xr; } else if (pn < 15) { dst = Gr; }
                    else if (pn < 17) { dst = Qc; scale = QSCALE_C; rope = true; } else { dst = Kc; rope = true; }
                    const bool headmajor = (pn < 6) || (pn >= 15);
                    const int segpn = (pn < 3) ? pn : (pn < 6) ? pn - 3 : (pn < 12) ? pn - 9 : (pn < 15) ? pn - 12 : (pn < 17) ? pn - 15 : pn - 17;
#pragma unroll
                    for (int ai = 0; ai < 2; ++ai)
#pragma unroll
                        for (int m = 0; m < 4; ++m)
#pragma unroll
                            for (int bj = 0; bj < 2; ++bj)
#pragma unroll
                                for (int n = 0; n < 2; ++n) {
                                    const int dd = wc * 32 + n * 16 + fr;
#pragma unroll
                                    for (int j = 0; j < 4; ++j) {
                                        const int row = pm * 256 + ai * 128 + wr * 64 + m * 16 + fq * 4 + j;
                                        float v = acc[ai][bj][m][n][j];
                                        if (rope && n == 0 && (wc & 1) == 0) {
                                            const float pv = SHX(v, 8);
                                            const float cs = ropecs[row * 16 + (fr & 7)], sn = ropecs[row * 16 + 8 + (fr & 7)];
                                            v = (fr < 8) ? (v * cs - pv * sn) : (v * cs + pv * sn);
                                        }
                                        v *= scale;
                                        *(bf16_t*)(lds_raw + (ai * 128 + wr * 64 + m * 16 + fq * 4 + j) * 528 + (bj * 128 + dd) * 2) = f2bf(v);
                                    }
                                }
                    __syncthreads();
#pragma unroll 4
                    for (int i = 0; i < 16; ++i) {
                        const int idx = et + i * 512, lrow = idx >> 5, ch = idx & 31, row = pm * 256 + lrow;
                        const u32x4 val = *(const u32x4*)(lds_raw + lrow * 528 + ch * 16);
                        size_t gi;
                        if (headmajor) gi = ((size_t)(segpn * 2 + (ch >> 4)) * S + row) * 128 + (ch & 15) * 8;
                        else gi = (size_t)row * LRU_W + segpn * 256 + ch * 8;
                        *(u32x4*)(dst + gi) = val;
                    }
                    __syncthreads();
                    if (pn >= 15) {
                        float* part = ldsf;
#pragma unroll
                        for (int ai = 0; ai < 2; ++ai)
#pragma unroll
                            for (int m = 0; m < 4; ++m)
#pragma unroll
                                for (int bj = 0; bj < 2; ++bj)
#pragma unroll
                                    for (int j = 0; j < 4; ++j) {
                                        float ss = acc[ai][bj][m][0][j] * acc[ai][bj][m][0][j] + acc[ai][bj][m][1][j] * acc[ai][bj][m][1][j];
                                        ss += SHX(ss, 1); ss += SHX(ss, 2); ss += SHX(ss, 4); ss += SHX(ss, 8);
                                        if (fr == 0) part[(wc * 2 + bj) * 256 + ai * 128 + wr * 64 + m * 16 + fq * 4 + j] = ss;
                                    }
                        __syncthreads();
                        {
                            const int bj = et >> 8, row = et & 255;
                            float v0 = part[(0 * 2 + bj) * 256 + row] + part[(1 * 2 + bj) * 256 + row], v1 = part[(2 * 2 + bj) * 256 + row] + part[(3 * 2 + bj) * 256 + row];
                            v0 = fmaxf(v0, SHX(v0, 1)); v0 = fmaxf(v0, SHX(v0, 2)); v0 = fmaxf(v0, SHX(v0, 4)); v0 = fmaxf(v0, SHX(v0, 8)); v0 = xrow16_max(v0);
                            v1 = fmaxf(v1, SHX(v1, 1)); v1 = fmaxf(v1, SHX(v1, 2)); v1 = fmaxf(v1, SHX(v1, 4)); v1 = fmaxf(v1, SHX(v1, 8)); v1 = xrow16_max(v1);
                            if ((et & 63) == 0) {
                                unsigned* q2p = (unsigned*)(wsl + CTL_QK2_OFF) + l * 16 + (pn >= 17 ? 8 : 0) + (segpn * 2 + bj) * 2;
                                atomic_max_u32(q2p, __builtin_bit_cast(unsigned, v0)); atomic_max_u32(q2p + 1, __builtin_bit_cast(unsigned, v1));
                            }
                        }
                        __syncthreads();
                    }
                    if (pn >= 3 && pn < 6) {
                        float* part = ldsf;
#pragma unroll
                        for (int ai = 0; ai < 2; ++ai)
#pragma unroll
                            for (int m = 0; m < 4; ++m)
#pragma unroll
                                for (int bj = 0; bj < 2; ++bj)
#pragma unroll
                                    for (int j = 0; j < 4; ++j) {
                                        float ss = acc[ai][bj][m][0][j] * acc[ai][bj][m][0][j] + acc[ai][bj][m][1][j] * acc[ai][bj][m][1][j];
                                        ss += SHX(ss, 1); ss += SHX(ss, 2); ss += SHX(ss, 4); ss += SHX(ss, 8);
                                        if (fr == 0) part[(wc * 2 + bj) * 256 + ai * 128 + wr * 64 + m * 16 + fq * 4 + j] = ss;
                                    }
                        __syncthreads();
                        {
                            const int bj = et >> 8, row = et & 255;
                            float v = part[(0 * 2 + bj) * 256 + row] + part[(1 * 2 + bj) * 256 + row] + part[(2 * 2 + bj) * 256 + row] + part[(3 * 2 + bj) * 256 + row];
                            v = fmaxf(v, SHX(v, 1)); v = fmaxf(v, SHX(v, 2)); v = fmaxf(v, SHX(v, 4)); v = fmaxf(v, SHX(v, 8)); v = xrow16_max(v);
                            if ((et & 63) == 0) kmax2[((pn - 3) * 2 + bj) * NKT + pm * 4 + ((et >> 6) & 3)] = v;
                        }
                        __syncthreads();
                    }
                } else {
                    bf16_t* dst = (pn < 9) ? VaT : VcT;
                    const int segpn = (pn < 9) ? pn - 6 : pn - 19;
#pragma unroll
                    for (int ai = 0; ai < 2; ++ai)
#pragma unroll
                        for (int m = 0; m < 4; ++m)
#pragma unroll
                            for (int bj = 0; bj < 2; ++bj)
#pragma unroll
                                for (int n = 0; n < 2; ++n) {
                                    const int dd = wc * 32 + n * 16 + fr;
                                    const int row = pm * 256 + ai * 128 + wr * 64 + m * 16 + fq * 4;
                                    const f32x4 a = acc[ai][bj][m][n];
                                    u32x2 o; o.x = pack2(a[0], a[1]); o.y = pack2(a[2], a[3]);
                                    const int s6 = row & 63, pos = (s6 & 32) + ((s6 >> 2) & 3) * 8 + ((s6 >> 4) & 1) * 4;
                                    *(u32x2*)(dst + (((size_t)(segpn * 2 + bj) * NKT + (row >> 6)) * 128 + dd) * 64 + pos) = o;
                                }
                }
                WAIT_VM0();
                __syncthreads();
                if (et == 0) { FENCE_REL_AGENT(); WAIT_VM0(); (void)xb_add(&cls[kcls * 64], 1u); }
                CONV_ONE();
            }
        }

        if (PH_SEL(1) && PH_IN(pb + 1)) {
            PHASE_IDS();
            const float lam_init = (l == 0) ? 0.2f : 0.35550906759f;
            const float s1 = wave_sum(p.in[I_LQ1][l * 64 + lane] * p.in[I_LK1][l * 64 + lane]);
            const float s2 = wave_sum(p.in[I_LQ2][l * 64 + lane] * p.in[I_LK2][l * 64 + lane]);
            const float lam = fexp(s1) - fexp(s2) + lam_init;
            constexpr int NLRU = NKT * 6, NQB = S / 128;
            bool conv_more = (l == 0);
            unsigned* cls = (unsigned*)(wsl + CTL_CLS_OFF) + l * 256;
            unsigned* bw = (unsigned*)wsl;
#define WAIT_CLASS(k, n) do { __syncthreads(); if (tid == 0) { XB_SPIN(xb_ld(&cls[(k) * 64]) < (unsigned)(n), bw); FENCE_ACQ_AGENT(); WAIT_VM0(); } __syncthreads(); } while (0)
#ifndef NO_DIFF
            {
                constexpr int NQB2 = S / 256;
                int total = 0;
                for (int q = 0; q < NQB2; ++q) total += ((4 * q + 4 + DCH - 1) / DCH) * 8;
                WAIT_CLASS(0, (S / 256) * 6);
                for (;;) {
                    __syncthreads();
                    if (tid == 0) *ubox = (unsigned)atomic_add_int(workctr, 1);
                    __syncthreads();
                    int u = RFL((int)*ubox);
                    if (u >= total) break;
                    int qb = NQB2 - 1;
                    for (;; --qb) { const int nu = ((4 * qb + 4 + DCH - 1) / DCH) * 8; if (u < nu) break; u -= nu; }
                    const int c = u >> 3, h = (u >> 1) & 3, mp = u & 1;
                    const int t0 = c * DCH, t1 = (t0 + DCH < 4 * qb + 4) ? t0 + DCH : 4 * qb + 4;
                    const unsigned* q2p = (const unsigned*)(wsl + CTL_QK2_OFF) + l * 16;
                    const float bnd = sqrtf(__builtin_bit_cast(float, q2p[h * 2 + mp]) * __builtin_bit_cast(float, q2p[8 + h * 2 + mp])) * (QSCALE_C * 1.02f) + 0.01f;
                    attn_dmap_unit(Qc + (size_t)h * S * 128, Kc + (size_t)h * S * 128, VcT + (size_t)h * S * 128, mp, qb, t0, t1,
                                   dpo + (size_t)(h * 2 + mp) * DPART_ROWS * 128, dpml + (size_t)(h * 2 + mp) * DPART_ROWS * 2, c, RFL_F(bnd), lds_raw, tid);
                    CONV_ONE();
                }
            }
#endif
#ifndef NO_LRU
            WAIT_CLASS(1, (S / 256) * 6);
            for (;;) {
                __syncthreads();
                if (tid == 0) *ubox = (unsigned)atomic_add_int(workctr + 10, 1);
                __syncthreads();
                const int u = RFL((int)*ubox);
                if (u >= NLRU) break;
                lru_unit_a(u / 6, u % 6, l, p, Xr, WaiT + (size_t)l * 6 * 256 * 128, hloc, ploc, sumA, sumH, lds_raw, tid);
            }
#endif
#ifndef NO_FOX
            WAIT_CLASS(2, (S / 256) * 9);
            WAIT_CLASS(3, 1);
            for (;;) {
                __syncthreads();
                if (tid == 0) *ubox = (unsigned)atomic_add_int(workctr + 1, 1);
                __syncthreads();
                const int u = RFL((int)*ubox);
                if (u >= NQB * FOX_H) break;
                const int qb = NQB - 1 - u / FOX_H, h = u % FOX_H;
                attn_unit<0>(Qa + (size_t)h * S * 128, Ka + (size_t)h * S * 128, VaT + (size_t)h * S * 128, cum2 + (size_t)h * S, kmax2 + h * NKT, qb, concat, h * 128,
                             0.f, 0.f, nullptr, lds_raw, tid);
            }
#endif
            while (conv_more) CONV_ONE();
            PH_BAR(pb + 1);
        }

        if (PH_SEL(2) && PH_IN(pb + 2)) for (int rep = 0; rep < PH_REPS(2); ++rep) {
            PHASE_IDS();
            {
                const int per = (NKT * 6 + G - 1) / G;
                const int c = tid & 127, tq = tid >> 7;
                float cr = 0.f; int pgrp = -1;
                for (int u = bid * per; u < (bid + 1) * per && u < NKT * 6; ++u) {
                    const int grp = u / NKT, chunk = u % NKT, ch = grp * 128 + c;
                    if (grp != pgrp) {
                        pgrp = grp;
                        const int seg = (chunk + 3) >> 2, j0 = tq * seg, j1 = (j0 + seg < chunk) ? j0 + seg : chunk;
                        float pa = 1.f, ph = 0.f;
                        int j = j0;
                        for (; j + 16 <= j1; j += 16) {
                            float a8[16], h8[16];
#pragma unroll
                            for (int q = 0; q < 16; ++q) { a8[q] = sumA[(size_t)(j + q) * LRU_W + ch]; h8[q] = sumH[(size_t)(j + q) * LRU_W + ch]; }
#pragma unroll
                            for (int q = 0; q < 16; ++q) { pa *= a8[q]; ph = a8[q] * ph + h8[q]; }
                        }
                        for (; j < j1; ++j) { const float a = sumA[(size_t)j * LRU_W + ch]; pa *= a; ph = a * ph + sumH[(size_t)j * LRU_W + ch]; }
                        __syncthreads();
                        ldsf[(tq * 128 + c) * 2] = pa; ldsf[(tq * 128 + c) * 2 + 1] = ph;
                        __syncthreads();
                        cr = 0.f;
#pragma unroll
                        for (int s = 0; s < 4; ++s) cr = ldsf[(s * 128 + c) * 2] * cr + ldsf[(s * 128 + c) * 2 + 1];
                    }
                    float hl[16], pl[16]; bf16_t gg[16];
#pragma unroll
                    for (int i = 0; i < 16; ++i) { const size_t gi = (size_t)(chunk * 64 + tq * 16 + i) * LRU_W + ch; const unsigned hp = ((const unsigned*)hloc)[gi]; hl[i] = bf2f((bf16_t)(hp & 0xffffu)); pl[i] = bf2f((bf16_t)(hp >> 16)); gg[i] = Gr[gi]; }
                    const float an = sumA[(size_t)chunk * LRU_W + ch], hn = sumH[(size_t)chunk * LRU_W + ch];
#pragma unroll
                    for (int i = 0; i < 16; ++i)
                        concat[(size_t)(chunk * 64 + tq * 16 + i) * D + FOX_W + ch] = f2bf(gelu_tanh_f(bf2f(gg[i])) * (hl[i] + pl[i] * cr));
                    cr = an * cr + hn;
                }
            }
            {
                const float lam_init = (l == 0) ? 0.2f : 0.35550906759f;
                const float s1 = wave_sum(p.in[I_LQ1][l * 64 + lane] * p.in[I_LK1][l * 64 + lane]);
                const float s2 = wave_sum(p.in[I_LQ2][l * 64 + lane] * p.in[I_LK2][l * 64 + lane]);
                const float lam = fexp(s1) - fexp(s2) + lam_init;
                const float* sg = p.in[I_SUBG] + l * 128;
                const float g0 = sg[2 * lane], g1 = sg[2 * lane + 1];
                static_assert(NCH <= 8, "the merge below keeps one (map, chunk) pair per lane: 2 x 8 lanes");
                for (int q = gwave; q < S; q += gwaves) {
                    const int nch = (q >> 6) / DCH + 1;
                    float mv = -INFINITY, lv = 0.f;
                    { const int c = lane & 7, hm = lane >> 3;
                      if (c < nch) { const float* ML = dpml + ((size_t)hm * DPART_ROWS + dpart_row(c, q)) * 2; mv = ML[0]; lv = ML[1]; } }
                    unsigned pk[4][2][NCH];
#pragma unroll
                    for (int h = 0; h < 4; ++h)
#pragma unroll
                        for (int mp = 0; mp < 2; ++mp) {
                            const unsigned* OP = (const unsigned*)(dpo + (size_t)(h * 2 + mp) * DPART_ROWS * 128);
#pragma unroll
                            for (int c = 0; c < NCH; ++c) pk[h][mp][c] = (c < nch) ? OP[(size_t)dpart_row(c, q) * 64 + lane] : 0u;
                        }
                    float Mx = mv; Mx = fmaxf(Mx, DPP_X1(Mx)); Mx = fmaxf(Mx, DPP_X2(Mx)); Mx = fmaxf(Mx, DPP_X7(Mx));
                    const float wv = (mv == -INFINITY) ? 0.f : FAST_EXP2(mv - Mx);
                    float Lp = lv * wv; Lp += DPP_X1(Lp); Lp += DPP_X2(Lp); Lp += DPP_X7(Lp);
#pragma unroll
                    for (int h = 0; h < 4; ++h) {
                        float om[2][2];
#pragma unroll
                        for (int mp = 0; mp < 2; ++mp) {
                            float o0 = 0.f, o1 = 0.f;
#pragma unroll
                            for (int c = 0; c < NCH; ++c) { const float w = RDLANE(wv, (h * 2 + mp) * 8 + c); o0 += bf2f((bf16_t)(pk[h][mp][c] & 0xffffu)) * w; o1 += bf2f((bf16_t)(pk[h][mp][c] >> 16)) * w; }
                            const float il = 1.f / RDLANE(Lp, (h * 2 + mp) * 8);
                            om[mp][0] = o0 * il; om[mp][1] = o1 * il;
                        }
                        const float v0 = om[0][0] - lam * om[1][0], v1 = om[0][1] - lam * om[1][1];
                        const float ss = wave_sum(v0 * v0 + v1 * v1);
                        const float rs = (1.f - lam_init) / sqrtf(ss * (1.f / 128.f) + LN_EPS);
                        *(unsigned*)(concat + (size_t)q * D + 1536 + h * 128 + 2 * lane) = pack2(v0 * rs * g0, v1 * rs * g1);
                    }
                }
            }
            PH_BAR(pb + 2);
        }

        if (PH_SEL(3) && PH_IN(pb + 3)) {
            PHASE_IDS();
            const bf16_t* Bt = WoT + (size_t)l * D * D;
            constexpr int ntn = D / 256, ntm = S / 256;
            static_assert(ntn == 8, "the panel exchange is written for 8 column tiles");
            const unsigned nooff[2][2] = {{0u, 0u}, {0u, 0u}};
            const float* g1 = p.in[I_LN1G] + (size_t)l * D; const float* b1 = p.in[I_LN1B] + (size_t)l * D;
            const float* bg = p.in[I_BGRP] + l * 4; const float* br = p.in[I_BRT] + l * 32;
            const bf16_t* Wb = W36b + (size_t)l * 2 * 48 * D;
            int* lcnt = (int*)(lds_raw + LDS_MISC + M_LCNT);
            const int segcap = ((ntm * ntn + G - 1) / G) * 32;
            unsigned* pcnt = (unsigned*)(wsl + CTL_PAN_OFF) + l * 1024;
            unsigned long long* xbuf = (unsigned long long*)(wsl + A_XBUF);
            unsigned* part = (unsigned*)(wsl + A_PART);
            LAS float* Stab = (LAS float*)(lds_raw + LDS_MISC + M_RTOK);
            float* lgt = (float*)(lds_raw + LDS_MISC + 4096);
            if (tid < 32) lcnt[tid] = 0;
            __syncthreads();
            for (int t0 = bid; t0 < ntm * ntn; t0 += G) {
                int t = t0;
                if (G == 256 && ntm * ntn == 256) { const int x = t0 & 7, j = t0 >> 3; t = (x * 4 + (j >> 3)) * ntn + (j & 7); }
                const int pm = t / ntn, pn = t % ntn;
                f32x4 v[2][16];
                {
                    f32x4 acc[2][2][4][2];
                    gemm_tile<false>(concat, pm * 256, nooff, Bt, pn * 256, D, lds_raw, acc, tid);
                    int et = tid; OPAQUE(et); const int wr = et >> 8, wc = (et >> 6) & 3, fr = et & 15, fq = (et >> 4) & 3;
#pragma unroll
                    for (int ai = 0; ai < 2; ++ai) {
#pragma unroll
                        for (int m = 0; m < 4; ++m)
#pragma unroll
                            for (int bj = 0; bj < 2; ++bj)
#pragma unroll
                                for (int n = 0; n < 2; ++n)
#pragma unroll
                                    for (int j = 0; j < 4; ++j)
                                        *(float*)(lds_raw + (wr * 64 + m * 16 + fq * 4 + j) * 1040 + (bj * 128 + wc * 32 + n * 16 + fr) * 4) = acc[ai][bj][m][n][j];
                        __syncthreads();
#pragma unroll
                        for (int i = 0; i < 16; ++i) {
                            const int lrow = i * 8 + (et >> 6), c4 = et & 63;
                            const size_t gi = (size_t)(pm * 256 + ai * 128 + lrow) * D + pn * 256 + c4 * 4;
                            v[ai][i] = *(const GAS f32x4*)(hin + gi);
                        }
#pragma unroll
                        for (int i = 0; i < 16; ++i) {
                            const int lrow = i * 8 + (et >> 6), c4 = et & 63;
                            v[ai][i] = ALPHA * v[ai][i] + *(const f32x4*)(lds_raw + lrow * 1040 + c4 * 16);
                        }
                        __syncthreads();
                    }
                }
                int et2 = tid; OPAQUE(et2); const int el = et2 & 63, ew = wave_s, er16 = et2 & 15, eq4 = (et2 >> 4) & 3;
#pragma unroll
                for (int q = 0; q < 6; ++q) {
                    const int seg = ew * 6 + q, n2 = seg * 2 + (el >> 5), p5 = el & 31;
                    GLDS16(Wb + (size_t)n2 * D + pn * 256 + ((p5 ^ (n2 & 15)) << 3), lds_raw + 65536 + seg * 1024 + el * 16);
                }
                float my_mt = 0.f, my_m2 = 0.f;
                for (int trep = 0; trep < REP_STATS; ++trep)
#pragma unroll
                for (int ai = 0; ai < 2; ++ai)
#pragma unroll
                    for (int i4 = 0; i4 < 16; i4 += 4) {
                        float mt4[4], m24[4];
#pragma unroll
                        for (int u = 0; u < 4; ++u) { const f32x4 x = v[ai][i4 + u]; mt4[u] = wave_sum((x[0] + x[1]) + (x[2] + x[3])) * (1.f / 256.f); }
#pragma unroll
                        for (int u = 0; u < 4; ++u) { const f32x4 d = v[ai][i4 + u] - mt4[u]; m24[u] = wave_sum((d[0] * d[0] + d[1] * d[1]) + (d[2] * d[2] + d[3] * d[3])); }
#pragma unroll
                        for (int u = 0; u < 4; ++u) if (el == ai * 16 + i4 + u) { my_mt = mt4[u]; my_m2 = m24[u]; }
                        COMPILER_FENCE();
                    }
                unsigned* bw = (unsigned*)wsl;
                if (el < 32) {
                    const int grow = (el >> 4) * 128 + (el & 15) * 8 + ew;
                    xst64(&xbuf[(size_t)(pm * 256 + grow) * 8 + pn], ((unsigned long long)__builtin_bit_cast(unsigned, my_m2) << 32) | __builtin_bit_cast(unsigned, my_mt));
                }
                WAIT_VM0();
                __syncthreads();
                if (et2 == 0) { (void)xb_add(&pcnt[pm * 16], 1u); XB_SPIN(xb_ld(&pcnt[pm * 16]) < 8u, bw); FENCE_ACQ_AGENT(); }
                __syncthreads();
                unsigned long long wk[4];
#pragma unroll
                for (int k = 0; k < 4; ++k) {
                    const int r = k * 8 + (el >> 3), grow = (r >> 4) * 128 + (r & 15) * 8 + ew;
                    wk[k] = xld64(&xbuf[(size_t)(pm * 256 + grow) * 8 + (el & 7)]);
                }
#pragma unroll
                for (int k = 0; k < 4; ++k) {
                    const int r = k * 8 + (el >> 3);
                    const unsigned long long w = wk[k];
                    const float mt = __builtin_bit_cast(float, (unsigned)w), m2 = __builtin_bit_cast(float, (unsigned)(w >> 32));
                    float ms = mt; ms += DPP_X1(ms); ms += DPP_X2(ms); ms += DPP_X7(ms);
                    const float mean = ms * 0.125f, dm = mt - mean;
                    float q = m2 + 256.f * dm * dm; q += DPP_X1(q); q += DPP_X2(q); q += DPP_X7(q);
                    const float rstd = 1.f / sqrtf(q * (1.f / D) + LN_EPS);
                    if ((el & 7) == 0) { Stab[(ew * 32 + r) * 2] = mean; Stab[(ew * 32 + r) * 2 + 1] = rstd; }
                }
                WAVE_SYNC();
                const f32x4 gv = *(const f32x4*)(g1 + pn * 256 + el * 4), bv = *(const f32x4*)(b1 + pn * 256 + el * 4);
                LAS unsigned char* wt = (LAS unsigned char*)lds_raw + ew * 8192;
                const LAS unsigned char* wbl = (const LAS unsigned char*)lds_raw + 65536;
                for (int rrep = 0; rrep < REP_ROUTER; ++rrep)
#pragma unroll
                for (int ai = 0; ai < 2; ++ai) {
                    u32x2 lokeep[16];
#pragma unroll
                    for (int i = 0; i < 16; ++i) {
                        const float mean = Stab[(ew * 32 + ai * 16 + i) * 2], rstd = Stab[(ew * 32 + ai * 16 + i) * 2 + 1];
                        const f32x4 hv = mul_s4(v[ai][i] - mean, rstd) * gv + bv;
                        u32x2 o; o.x = pack2(hv[0], hv[1]); o.y = pack2(hv[2], hv[3]);
                        lokeep[i].x = pack2(hv[0] - bf2f((bf16_t)(o.x & 0xffffu)), hv[1] - bf2f((bf16_t)(o.x >> 16)));
                        lokeep[i].y = pack2(hv[2] - bf2f((bf16_t)(o.y & 0xffffu)), hv[3] - bf2f((bf16_t)(o.y >> 16)));
                        *(LAS u32x2*)(wt + i * 512 + (((el >> 1) ^ i) << 4) + (el & 1) * 8) = o;
                        COMPILER_FENCE();
                    }
                    WAVE_SYNC();
                    f32x4 ac[3];
#pragma unroll
                    for (int nt = 0; nt < 3; ++nt) ac[nt] = (f32x4){0.f, 0.f, 0.f, 0.f};
#pragma unroll 2
                    for (int ks = 0; ks < 8; ++ks) {
                        const int co = ((ks * 4 + eq4) ^ er16) << 4;
                        const bf16x8 ah = *(const LAS bf16x8*)(wt + er16 * 512 + co);
#pragma unroll
                        for (int nt = 0; nt < 3; ++nt) {
                            const bf16x8 bh = *(const LAS bf16x8*)(wbl + (nt * 16 + er16) * 512 + co);
                            const bf16x8 bl = *(const LAS bf16x8*)(wbl + (48 + nt * 16 + er16) * 512 + co);
                            ac[nt] = MFMA16(ah, bh, ac[nt]); ac[nt] = MFMA16(ah, bl, ac[nt]);
                        }
                    }
                    WAVE_SYNC();
#pragma unroll
                    for (int i = 0; i < 16; ++i) *(LAS u32x2*)(wt + i * 512 + (((el >> 1) ^ i) << 4) + (el & 1) * 8) = lokeep[i];
                    WAVE_SYNC();
#pragma unroll 2
                    for (int ks = 0; ks < 8; ++ks) {
                        const int co = ((ks * 4 + eq4) ^ er16) << 4;
                        const bf16x8 al = *(const LAS bf16x8*)(wt + er16 * 512 + co);
#pragma unroll
                        for (int nt = 0; nt < 3; ++nt) {
                            const bf16x8 bh = *(const LAS bf16x8*)(wbl + (nt * 16 + er16) * 512 + co);
                            ac[nt] = MFMA16(al, bh, ac[nt]);
                        }
                    }
#pragma unroll
                    for (int nt = 0; nt < 3; ++nt)
#pragma unroll
                        for (int j = 0; j < 4; ++j) {
                            const float cv = ac[nt][j];
                            xst32(&part[((size_t)pn * S + pm * 256 + ai * 128 + (eq4 * 4 + j) * 8 + ew) * 48 + nt * 16 + er16], __builtin_bit_cast(unsigned, cv));
                        }
                    WAVE_SYNC();
                }
                WAIT_VM0();
                __syncthreads();
                if (et2 == 0) (void)xb_add(&pcnt[512 + pm * 16], 1u);
                for (int srep = 0; srep < REP_STORES; ++srep)
#pragma unroll
                for (int ai = 0; ai < 2; ++ai)
#pragma unroll
                    for (int i = 0; i < 16; ++i) {
                        const float mean = Stab[(ew * 32 + ai * 16 + i) * 2], rstd = Stab[(ew * 32 + ai * 16 + i) * 2 + 1];
                        const f32x4 hv = mul_s4(v[ai][i] - mean, rstd) * gv + bv;
                        const size_t gi = (size_t)(pm * 256 + ai * 128 + i * 8 + ew) * D + pn * 256 + el * 4;
                        u32x2 o; o.x = pack2(hv[0], hv[1]); o.y = pack2(hv[2], hv[3]);
                        *(u32x2*)(h1b + gi) = o;
                        COMPILER_FENCE();
                    }
                if (et2 == 0) { XB_SPIN(xb_ld(&pcnt[512 + pm * 16]) < 8u, bw); FENCE_ACQ_AGENT(); }
                __syncthreads();
                int rt = tid; OPAQUE(rt);
#pragma unroll
                for (int k = 0; k < 3; ++k) {
                    const int idx = rt + k * 512, tk = idx / 48, n = idx - tk * 48;
                    unsigned pq[8];
#pragma unroll
                    for (int q = 0; q < 8; ++q) pq[q] = xb_ld(&part[((size_t)q * S + pm * 256 + pn * 32 + tk) * 48 + n]);
                    float a = 0.f;
#pragma unroll
                    for (int q = 0; q < 8; ++q) a += __builtin_bit_cast(float, pq[q]);
                    lgt[idx] = a;
                }
                __syncthreads();
                if (rt < 32) {
                    const int t = pm * 256 + pn * 32 + rt; const float* L = lgt + rt * 48;
                    float gl[4];
#pragma unroll
                    for (int q = 0; q < 4; ++q) gl[q] = L[q] + bg[q];
                    int gi = 0; float gm = gl[0];
#pragma unroll
                    for (int q = 1; q < 4; ++q) if (gl[q] > gm) { gm = gl[q]; gi = q; }
                    float gs = 0.f;
#pragma unroll
                    for (int q = 0; q < 4; ++q) gs += fexp(gl[q] - gm);
                    const float gweight = 1.f / gs;
                    float E[8];
#pragma unroll
                    for (int e = 0; e < 8; ++e) E[e] = L[4 + gi * 8 + e] + br[gi * 8 + e];
                    int e1 = 0; float m1 = E[0];
#pragma unroll
                    for (int e = 1; e < 8; ++e) if (E[e] > m1) { m1 = E[e]; e1 = e; }
                    int e2 = -1; float m2 = -INFINITY;
#pragma unroll
                    for (int e = 0; e < 8; ++e) if (e != e1 && E[e] > m2) { m2 = E[e]; e2 = e; }
                    const float p2 = fexp(m2 - m1), w1 = 1.f / (1.f + p2), w2 = p2 / (1.f + p2);
                    const int ge1 = gi * 8 + e1, ge2 = gi * 8 + e2;
                    const int i1 = (ge1 * G + bid) * segcap + atomic_add_int(&lcnt[ge1], 1);
                    ltok[i1] = t; lw[i1] = gweight * w1; lslot[i1] = 0;
                    const int i2 = (ge2 * G + bid) * segcap + atomic_add_int(&lcnt[ge2], 1);
                    ltok[i2] = t; lw[i2] = gweight * w2; lslot[i2] = 1;
                }
                __syncthreads();
            }
            { int ft = tid; OPAQUE(ft); if (ft < 32) cntb[bid * 32 + ft] = lcnt[ft]; }
            PH_BAR(pb + 3);
        }

        if (PH_SEL(5) && PH_IN(pb + 5)) {
            PHASE_IDS();
            const unsigned nooff[2][2] = {{0u, 0u}, {0u, 0u}};
            const int segcap = ((S / 256 * (D / 256) + G - 1) / G) * 32;
            moe_prefix(cntb, G, lds_raw, tid);
            const int* ctot = (const int*)(lds_raw + LDS_MISC + M_CTOT); const int* coff = (const int*)(lds_raw + LDS_MISC + M_COFF);
            const int* rtok = (const int*)(lds_raw + LDS_MISC + M_RTOK); const float* rw = (const float*)(lds_raw + LDS_MISC + M_RW);
            const int* rslot = (const int*)(lds_raw + LDS_MISC + M_RSLOT);
            unsigned* done = (unsigned*)(wsl + CTL_DONE_OFF) + l * 1024;
            int* mq = (int*)(wsl + CTL_MQ_OFF) + l * 128;
            const int myx = (int)(xb_xcc_id() & 7u);
            int qi = 0;
            for (;;) {
                __syncthreads();
                if (tid == 0) {
                    unsigned r = 0xffffffffu;
                    while (qi < 8) {
                        const int xx = (myx + qi) & 7;
                        int nm = 0;
#pragma unroll
                        for (int k = 0; k < NEXP / 8; ++k) nm += (ctot[xx + 8 * k] + 255) / 256;
                        const int got = atomic_add_int(mq + xx * 16, 1);
                        if (got < nm * 12) { r = ((unsigned)xx << 24) | (unsigned)got; break; }
                        ++qi;
                    }
                    *ubox = r;
                }
                __syncthreads();
                const unsigned rr = (unsigned)RFL((int)*ubox);
                if (rr == 0xffffffffu) break;
                const int xq = (int)(rr >> 24);
                int u = (int)(rr & 0xffffffu);
                int nmt = 0;
#pragma unroll
                for (int k = 0; k < NEXP / 8; ++k) nmt += (RFL(ctot[xq + 8 * k]) + 255) / 256;
                const bool down = (u >= nmt * 4);
                const int per = down ? 8 : 4;
                if (down) u -= nmt * 4;
                int e = xq;
                for (;; e += 8) { const int nt = ((RFL(ctot[e]) + 255) / 256) * per; if (u < nt) break; u -= nt; }
                const int c = RFL(ctot[e]), off = RFL(coff[e]);
                const int mt = u / per, pn = u % per, m0 = mt * 256;
                moe_rowtable(ltok, lw, lslot, e, m0, c, G, segcap, lds_raw, tid);
                f32x4 acc[2][2][4][2];
                if (!down) {
                    const bf16_t* Bt = WguT + ((size_t)l * NEXP + e) * 1024 * D;
                    unsigned aoff[2][2];
                    int st = tid; OPAQUE(st); int R[2], C[2]; stage_geom(st, R, C);
#pragma unroll
                    for (int h = 0; h < 2; ++h)
#pragma unroll
                        for (int i = 0; i < 2; ++i) aoff[h][i] = (unsigned)(rtok[h * 128 + R[i]] * D + C[i]);
                    gemm_tile<true>(h1b, 0, aoff, Bt, pn * 256, D, lds_raw, acc, tid);
                    int et = tid; OPAQUE(et); const int wr = et >> 8, wc = (et >> 6) & 3, fr = et & 15, fq = (et >> 4) & 3;
#pragma unroll
                    for (int ai = 0; ai < 2; ++ai)
#pragma unroll
                        for (int m = 0; m < 4; ++m)
#pragma unroll
                            for (int j = 0; j < 4; ++j) {
                                const int r = ai * 128 + wr * 64 + m * 16 + fq * 4 + j;
                                const float wgt = rw[r];
#pragma unroll
                                for (int bj = 0; bj < 2; ++bj)
                                    *(bf16_t*)(lds_raw + r * 272 + (bj * 64 + wc * 16 + fr) * 2) = f2bf(silu_f(acc[ai][bj][m][0][j]) * acc[ai][bj][m][1][j] * wgt);
                            }
                    __syncthreads();
#pragma unroll 4
                    for (int i = 0; i < 8; ++i) {
                        const int idx = et + i * 512, r = idx >> 4, ch = idx & 15;
                        if (m0 + r < c) *(u32x4*)(act + (size_t)(off + m0 + r) * DFF + pn * 128 + ch * 8) = *(const u32x4*)(lds_raw + r * 272 + ch * 16);
                    }
                    WAIT_VM0();
                    __syncthreads();
                    if (et == 0) { FENCE_REL_AGENT(); WAIT_VM0(); (void)xb_add(&done[e * 32 + mt], 1u); }
                } else {
                    const bf16_t* Bt = WdT + ((size_t)l * NEXP + e) * D * DFF;
                    if (tid == 0) {
                        unsigned* bw = (unsigned*)wsl;
                        XB_SPIN(xb_ld(&done[e * 32 + mt]) < 4u, bw);
                        FENCE_ACQ_AGENT();
                        WAIT_VM0();
                    }
                    __syncthreads();
                    gemm_tile<false>(act, off + m0, nooff, Bt, pn * 256, DFF, lds_raw, acc, tid);
                    int et = tid; OPAQUE(et); const int wr = et >> 8, wc = (et >> 6) & 3, fr = et & 15, fq = (et >> 4) & 3;
#pragma unroll
                    for (int ai = 0; ai < 2; ++ai)
#pragma unroll
                        for (int m = 0; m < 4; ++m)
#pragma unroll
                            for (int bj = 0; bj < 2; ++bj)
#pragma unroll
                                for (int n = 0; n < 2; ++n)
#pragma unroll
                                    for (int j = 0; j < 4; ++j)
                                        *(bf16_t*)(lds_raw + (ai * 128 + wr * 64 + m * 16 + fq * 4 + j) * 528 + (bj * 128 + wc * 32 + n * 16 + fr) * 2) = f2bf(acc[ai][bj][m][n][j]);
                    __syncthreads();
#pragma unroll 4
                    for (int i = 0; i < 16; ++i) {
                        const int idx = et + i * 512, r = idx >> 5, ch = idx & 31;
                        if (m0 + r < c) *(u32x4*)(contrib + ((size_t)rslot[r] * S + rtok[r]) * D + pn * 256 + ch * 8) = *(const u32x4*)(lds_raw + r * 528 + ch * 16);
                    }
                }
            }
            PH_BAR(pb + 5);
        }

        if (PH_SEL(7) && PH_IN(pb + 7)) for (int rep = 0; rep < PH_REPS(7); ++rep) {
            PHASE_IDS();
            const float* g2 = p.in[I_LN2G] + (size_t)l * D; const float* b2 = p.in[I_LN2B] + (size_t)l * D;
            const bool more = (l + 1 < DEPTH);
            f32x4 gq[8], bq[8];
#pragma unroll
            for (int j = 0; j < 8; ++j) { gq[j] = *(const f32x4*)(g2 + j * 256 + lane * 4); bq[j] = *(const f32x4*)(b2 + j * 256 + lane * 4); }
            if (more) {
                const float* wf = Wfa + (size_t)(l + 1) * 8 * D;
                __syncthreads();
                for (int i = tid; i < 6 * D / 4; i += NTHREADS) *(f32x4*)(ldsf + i * 4) = *(const f32x4*)(wf + i * 4);
                __syncthreads();
            }
            for (int t = gwave; t < S; t += gwaves) {
                f32x4 v[8]; float s = 0.f;
#pragma unroll
                for (int j = 0; j < 8; ++j) {
                    const size_t i = (size_t)t * D + j * 256 + lane * 4;
                    const u32x2 c0 = *(const u32x2*)(contrib + i), c1 = *(const u32x2*)(contrib + (size_t)S * D + i);
                    const f32x4 cs = (f32x4){bf2f((bf16_t)(c0.x & 0xffffu)) + bf2f((bf16_t)(c1.x & 0xffffu)), bf2f((bf16_t)(c0.x >> 16)) + bf2f((bf16_t)(c1.x >> 16)),
                                             bf2f((bf16_t)(c0.y & 0xffffu)) + bf2f((bf16_t)(c1.y & 0xffffu)), bf2f((bf16_t)(c0.y >> 16)) + bf2f((bf16_t)(c1.y >> 16))};
                    const u32x2 hq = *(const u32x2*)(h1b + i);
                    v[j] = ALPHA * (f32x4){bf2f((bf16_t)(hq.x & 0xffffu)), bf2f((bf16_t)(hq.x >> 16)), bf2f((bf16_t)(hq.y & 0xffffu)), bf2f((bf16_t)(hq.y >> 16))} + cs;
                    s += (v[j][0] + v[j][1]) + (v[j][2] + v[j][3]);
                }
                const float mean = wave_sum(s) * (1.f / D);
                float s2 = 0.f;
#pragma unroll
                for (int j = 0; j < 8; ++j) { v[j] -= mean; s2 += (v[j][0] * v[j][0] + v[j][1] * v[j][1]) + (v[j][2] * v[j][2] + v[j][3] * v[j][3]); }
                const float rstd = 1.f / sqrtf(wave_sum(s2) * (1.f / D) + LN_EPS);
                float fa[6] = {0.f, 0.f, 0.f, 0.f, 0.f, 0.f};
#pragma unroll
                for (int j = 0; j < 8; ++j) {
                    const int c = j * 256 + lane * 4;
                    v[j] = v[j] * rstd * gq[j] + bq[j];
                    *(f32x4*)(hout + (size_t)t * D + c) = v[j];
                    COMPILER_FENCE();
                    if (more) {
                        u32x2 o; o.x = pack2(v[j][0], v[j][1]); o.y = pack2(v[j][2], v[j][3]);
                        *(u32x2*)(xb + (size_t)t * D + c) = o;
#pragma unroll
                        for (int h = 0; h < 6; ++h) { const f32x4 w = *(const f32x4*)(ldsf + h * D + c); fa[h] += (v[j][0] * w[0] + v[j][1] * w[1]) + (v[j][2] * w[2] + v[j][3] * w[3]); }
                    }
                }
                if (more) {
#pragma unroll
                    for (int h = 0; h < 6; ++h) { const float sm = wave_sum(fa[h]); if (lane == 0) logf_[h * S + t] = log_sigmoid_f(sm + p.in[I_BF][(l + 1) * 6 + h]); }
                }
            }
            PH_BAR(pb + 7);
        }
    }
#undef PH_IN
#undef PH_BAR
}

constexpr int N_PHASES = 1 + DEPTH * 8;
#ifndef EMU
extern "C" void kernel_launch(void* const* d_in, const int* in_sizes, int n_in, void* d_out, int out_size, void* d_ws, size_t ws_size, hipStream_t stream) {
    static int grid = 0;
    if (grid == 0) {
        if (n_in != N_INPUTS || out_size != S * D || ws_size < WS_END) {
            fprintf(stderr, "kernel_launch: unexpected shapes: n_in %d out %d ws %zu (need %zu)\n", n_in, out_size, ws_size, (size_t)WS_END); grid = -1; return; }
        int dev = 0, cus = 0, per_cu = 0;
        if (hipGetDevice(&dev) != hipSuccess || hipDeviceGetAttribute(&cus, hipDeviceAttributeMultiprocessorCount, dev) != hipSuccess) { grid = -1; return; }
        if (hipFuncSetAttribute((const void*)fwd_kernel, hipFuncAttributeMaxDynamicSharedMemorySize, LDS_BYTES) != hipSuccess) { fprintf(stderr, "kernel_launch: hipFuncSetAttribute failed\n"); grid = -1; return; }
        if (hipOccupancyMaxActiveBlocksPerMultiprocessor(&per_cu, (const void*)fwd_kernel, NTHREADS, LDS_BYTES) != hipSuccess || per_cu < 1) {
            fprintf(stderr, "kernel_launch: occupancy query says %d blocks per CU\n", per_cu); (void)hipGetLastError(); grid = -1; return; }
        grid = cus;
    }
    if (grid < 0) return;
    (void)hipMemsetAsync(d_ws, 0, CTL_BYTES, stream);
    Params p{};
    for (int i = 0; i < N_INPUTS; ++i) p.in[i] = (const float*)d_in[i];
    p.out = (float*)d_out; p.ws = (unsigned char*)d_ws;
    for (int i = 0; i < 8; ++i) p.inv_freq[i] = (float)pow(500000.0, -(double)i * 2.0 / 16.0);
#if N_LAUNCH_SPLIT
    for (int k = 0; k < N_PHASES; ++k) { p.lo = k; p.hi = k + 1; hipLaunchKernelGGL(fwd_kernel, dim3(grid), dim3(NTHREADS), LDS_BYTES, stream, p); }
#else
    p.lo = 0; p.hi = N_PHASES;
    hipLaunchKernelGGL(fwd_kernel, dim3(grid), dim3(NTHREADS), LDS_BYTES, stream, p);
#endif
}
#endif
```

```cpp
#ifndef EMU
#include <hip/hip_runtime.h>
#include <cstdio>
#include <cstdint>
#include <cmath>
#endif

#ifndef SEQ
#define SEQ 8192
#endif
#ifndef N_LAUNCH_SPLIT
#define N_LAUNCH_SPLIT 0
#endif
#ifndef REP_PHASE
#define REP_PHASE -2
#endif
#define PH_REPS(c) ((c) == REP_PHASE ? 2 : 1)
#ifndef REP_SUB
#define REP_SUB 0
#endif

constexpr int S = SEQ, D = 2048, DEPTH = 2;
constexpr int FOX_H = 6, FOX_W = 768;
constexpr int LRU_W = 768;
constexpr int DIFF_H = 4, DIFF_W = 512;
constexpr int N_IN = 5382, N_INP = 5376;
constexpr int C_FA = 2304;
constexpr int NEXP = 32, DFF = 512;
constexpr int NKT = S / 64;
#ifndef REP_ROUTER
#define REP_ROUTER 1
#endif
#ifndef REP_STORES
#define REP_STORES 1
#endif
#ifndef REP_STATS
#define REP_STATS 1
#endif
#ifndef DCH
#define DCH 48
#endif
constexpr int NCH = (NKT + DCH - 1) / DCH;
constexpr size_t DPART_ROWS = (size_t)NCH * S - (size_t)(DCH * 64) * NCH * (NCH - 1) / 2;
constexpr float ALPHA = 1.41421356237309504880f;
constexpr float LN_EPS = 1e-5f;
constexpr float LOG2E = 1.4426950408889634f;
constexpr float QSCALE_A = 0.08838834764831845f * 1.4426950408889634f;
constexpr float QSCALE_C = 0.125f * 1.4426950408889634f;

enum { I_X = 0, I_POS, I_WIN, I_BF, I_CONVW, I_CONVB, I_WA, I_BA, I_WI, I_BI, I_LAM, I_LQ1, I_LK1, I_LQ2, I_LK2, I_SUBG, I_WO, I_LN1G, I_LN1B,
       I_WGRP, I_BGRP, I_WRT, I_BRT, I_WGATE, I_WUP, I_WDOWN, I_LN2G, I_LN2B, N_INPUTS };

typedef unsigned short bf16_t;
typedef short bf16x8 __attribute__((ext_vector_type(8)));
typedef float f32x4 __attribute__((ext_vector_type(4)));
typedef unsigned u32x4 __attribute__((ext_vector_type(4)));
typedef unsigned u32x2 __attribute__((ext_vector_type(2)));

constexpr size_t al256(size_t x) { return (x + 255) & ~(size_t)255; }
constexpr size_t CTL_BYTES = 65536;
constexpr size_t CTL_CNT_OFF = 32768;
constexpr size_t CTL_WORK_OFF = 36864;
constexpr size_t CTL_QK2_OFF = 57344;
constexpr size_t CTL_CLS_OFF = 49152;
constexpr size_t CTL_PAN_OFF = 16384;
constexpr size_t CTL_MQ_OFF = 24576;
constexpr size_t CTL_DONE_OFF = 40960;
constexpr size_t WB_WIN = CTL_BYTES;
constexpr size_t WB_WO = WB_WIN + al256((size_t)DEPTH * N_INP * D * 2);
constexpr size_t WB_WGU = WB_WO + al256((size_t)DEPTH * D * D * 2);
constexpr size_t WB_WD = WB_WGU + al256((size_t)DEPTH * NEXP * 1024 * D * 2);
constexpr size_t WB_WAI = WB_WD + al256((size_t)DEPTH * NEXP * D * DFF * 2);
constexpr size_t WF_FA = WB_WAI + al256((size_t)DEPTH * 6 * 256 * 128 * 2);
constexpr size_t WF_R36 = WF_FA + al256((size_t)DEPTH * 8 * D * 4);
constexpr size_t WF_ROPE = WF_R36 + al256((size_t)DEPTH * 2 * 48 * D * 2);
constexpr size_t A_XB = WF_ROPE + al256((size_t)S * 16 * 4);
constexpr size_t A_HB = A_XB + al256((size_t)S * D * 2);
constexpr size_t A_LOGF = A_HB + al256((size_t)S * D * 4);
constexpr size_t A_CUM = A_LOGF + al256((size_t)6 * S * 4);
constexpr size_t A_KMAX = A_CUM + al256((size_t)6 * S * 4);
constexpr size_t A_CNTB = A_KMAX + al256((size_t)6 * NKT * 4);
constexpr size_t A_QA = A_CNTB + al256((size_t)1024 * 32 * 4);
constexpr size_t A_KA = A_QA + al256((size_t)FOX_H * S * 128 * 2);
constexpr size_t A_VAT = A_KA + al256((size_t)FOX_H * S * 128 * 2);
constexpr size_t A_XR = A_VAT + al256((size_t)FOX_H * S * 128 * 2);
constexpr size_t A_GR = A_XR + al256((size_t)S * LRU_W * 2);
constexpr size_t A_QC = A_GR + al256((size_t)S * LRU_W * 2);
constexpr size_t A_KC = A_QC + al256((size_t)DIFF_H * S * 128 * 2);
constexpr size_t A_VCT = A_KC + al256((size_t)DIFF_H * S * 128 * 2);
constexpr size_t A_HLOC = A_VCT + al256((size_t)DIFF_H * S * 128 * 2);
constexpr size_t A_PLOC = A_HLOC + al256((size_t)S * LRU_W * 4);
constexpr size_t A_SUMA = A_PLOC + al256((size_t)S * LRU_W * 4);
constexpr size_t A_SUMH = A_SUMA + al256((size_t)NKT * LRU_W * 4);
constexpr size_t A_CONCAT = A_SUMH + al256((size_t)NKT * LRU_W * 4);
constexpr size_t A_Y1 = A_CONCAT + al256((size_t)S * D * 2);
constexpr size_t A_H1 = A_Y1 + al256((size_t)S * D * 4);
constexpr size_t A_H1B = A_H1 + al256((size_t)S * D * 4);
constexpr size_t A_LTOK = A_H1B + al256((size_t)S * D * 2);
constexpr size_t A_LW = A_LTOK + al256((size_t)NEXP * S * 4 * 2);
constexpr size_t A_LSLOT = A_LW + al256((size_t)NEXP * S * 4 * 2);
constexpr size_t A_ACT = A_LSLOT + al256((size_t)NEXP * S * 4 * 2);
constexpr size_t A_CONTRIB = A_ACT + al256((size_t)(2 * S + 256) * DFF * 2);
constexpr size_t WS_END = A_CONTRIB + al256((size_t)2 * S * D * 4);
constexpr size_t A_DPO = A_Y1;
constexpr size_t A_DPML = A_DPO + al256((size_t)8 * DPART_ROWS * 128 * 2);
static_assert(A_DPML + (size_t)8 * DPART_ROWS * 2 * 4 <= A_H1B, "differential partials must fit inside the y1 + h1 region");

constexpr size_t A_XBUF = A_H1 + al256((size_t)S * D * 2);
constexpr size_t A_PART = A_XBUF + al256((size_t)S * 8 * 8);
static_assert(A_PART + (size_t)8 * S * 48 * 4 <= A_H1B, "exchange buffers must fit inside the h1 region");
constexpr int NTHREADS = 512;
constexpr int LDS_MAIN = 131072 + 4096;
constexpr int LDS_MISC = LDS_MAIN;
constexpr int LDS_BYTES = LDS_MAIN + 8192 + 16640;
constexpr int M_PRE16 = 8192;
constexpr int M_LCNT = 64, M_CTOT = 256, M_COFF = 384, M_PRE = 512, M_RTOK = 2048, M_RW = 3072, M_RSLOT = 4096;

struct Params {
    const float* in[N_INPUTS];
    float* out;
    unsigned char* ws;
    float inv_freq[8];
    int lo, hi;
};

#ifndef EMU
#define LAS __attribute__((address_space(3)))
#define GAS __attribute__((address_space(1)))
#define DYN_LDS(name) extern __shared__ __attribute__((aligned(16))) unsigned char name[]
#define SLEEP1() __builtin_amdgcn_s_sleep(1)
#define WAVE_SYNC() __builtin_amdgcn_wave_barrier()
#define OPAQUE(x) asm volatile("" : "+v"(x))
#define COMPILER_FENCE() asm volatile("" ::: "memory")
#define RFL(x) __builtin_amdgcn_readfirstlane(x)
#define RFL_F(x) __builtin_bit_cast(float, __builtin_amdgcn_readfirstlane(__builtin_bit_cast(int, x)))
#define ANY_LANE(p) (__builtin_amdgcn_ballot_w64(p) != 0ull)
#define RDLANE(v, l) __builtin_bit_cast(float, __builtin_amdgcn_readlane(__builtin_bit_cast(int, v), l))
__device__ __forceinline__ int lane_id_volatile() { int l; asm volatile("v_mbcnt_lo_u32_b32 %0, -1, 0\n\tv_mbcnt_hi_u32_b32 %0, -1, %0" : "=v"(l)); return l; }
#define LANE_ID() lane_id_volatile()
#define OPAQUE_S(x) asm volatile("" : "+s"(x))
#define WAIT_VM0() asm volatile("s_waitcnt vmcnt(0)" ::: "memory")
#define WAIT_ALL0() __builtin_amdgcn_s_waitcnt(0)
#define FENCE_REL_AGENT() __builtin_amdgcn_fence(__ATOMIC_RELEASE, "agent")
#define FENCE_ACQ_AGENT() __builtin_amdgcn_fence(__ATOMIC_ACQUIRE, "agent")
#define MFMA16(a, b, c) __builtin_amdgcn_mfma_f32_16x16x32_bf16(a, b, c, 0, 0, 0)
#define GLDS16(g, l) __builtin_amdgcn_global_load_lds((const unsigned*)(g), (unsigned*)(l), 16, 0, 0)
#define WAIT_V(n) asm volatile("s_waitcnt vmcnt(" #n ")" ::: "memory")
#define WAIT_L(n) asm volatile("s_waitcnt lgkmcnt(" #n ")" ::: "memory")
#define BAR() __builtin_amdgcn_s_barrier()
#define SCHED() __builtin_amdgcn_sched_barrier(0)
#define SETPRIO(n) __builtin_amdgcn_s_setprio(n)
#define FAST_EXP2(x) __builtin_amdgcn_exp2f(x)
template <int M> __device__ __forceinline__ float shx_impl(float v, int lane) {
    if (M < 32) return __builtin_bit_cast(float, __builtin_amdgcn_ds_swizzle(__builtin_bit_cast(int, v), (M << 10) | 0x1f));
    return __builtin_bit_cast(float, __builtin_amdgcn_ds_bpermute((lane ^ 32) << 2, __builtin_bit_cast(int, v)));
}
#define SHX(v, M) shx_impl<M>(v, lane)
template <int CTRL> __device__ __forceinline__ float dppx(float x) { return __builtin_bit_cast(float, __builtin_amdgcn_mov_dpp(__builtin_bit_cast(int, x), CTRL, 0xf, 0xf, true)); }
#define DPP_X1(x) dppx<0xB1>(x)
#define DPP_X2(x) dppx<0x4E>(x)
#define DPP_X7(x) dppx<0x141>(x)
#define DPP_X8(x) dppx<0x128>(x)
#define xrow16_max(x) xrow16_max_l(x, lane)
#define xrow16_sum(x) xrow16_sum_l(x, lane)
__device__ __forceinline__ float xrow16_max_l(float x, int lane) { x = fmaxf(x, shx_impl<16>(x, lane)); return fmaxf(x, shx_impl<32>(x, lane)); }
__device__ __forceinline__ float xrow16_sum_l(float x, int lane) { x = x + shx_impl<16>(x, lane); return x + shx_impl<32>(x, lane); }
#define FAST_LOG2(x) __builtin_amdgcn_logf(x)
#define FAST_RCP(x) __builtin_amdgcn_rcpf(x)
__device__ __forceinline__ unsigned xb_ld(unsigned* p)              { return __hip_atomic_load(p, __ATOMIC_RELAXED, __HIP_MEMORY_SCOPE_AGENT); }
__device__ __forceinline__ unsigned xb_add(unsigned* p, unsigned v) { return __hip_atomic_fetch_add(p, v, __ATOMIC_RELAXED, __HIP_MEMORY_SCOPE_AGENT); }
__device__ __forceinline__ void xst64(unsigned long long* p, unsigned long long v) { __hip_atomic_store(p, v, __ATOMIC_RELAXED, __HIP_MEMORY_SCOPE_AGENT); }
__device__ __forceinline__ unsigned long long xld64(unsigned long long* p) { return __hip_atomic_load(p, __ATOMIC_RELAXED, __HIP_MEMORY_SCOPE_AGENT); }
__device__ __forceinline__ void xst32(unsigned* p, unsigned v) { __hip_atomic_store(p, v, __ATOMIC_RELAXED, __HIP_MEMORY_SCOPE_AGENT); }
__device__ __forceinline__ unsigned xb_xcc_id() { return (unsigned)__builtin_amdgcn_s_getreg((3 << 11) | 20) & 0xFu; }
__device__ __forceinline__ int atomic_add_int(int* p, int v) { return atomicAdd(p, v); }
__device__ __forceinline__ void atomic_min_int(int* p, int v) { atomicMin(p, v); }
__device__ __forceinline__ void atomic_max_u32(unsigned* p, unsigned v) { atomicMax(p, v); }
__device__ __forceinline__ unsigned pack2(float lo, float hi) { unsigned r; asm volatile("v_cvt_pk_bf16_f32 %0, %1, %2" : "=v"(r) : "v"(lo), "v"(hi)); return r; }
#else
#define MFMA16(a, b, c) emu_mfma_16x16x32_bf16(a, b, c)
#define GLDS16(g, l) emu_glds16((const void*)(g), (void*)(l))
#define WAIT_V(n) ((void)0)
#define WAIT_L(n) ((void)0)
#define BAR() __syncthreads()
#define SCHED() ((void)0)
#define SETPRIO(n) ((void)0)
#define FAST_EXP2(x) exp2f(x)
#define SHX(v, M) __shfl_xor(v, M)
#define DPP_X1(x) __shfl_xor(x, 1)
#define DPP_X2(x) __shfl_xor(x, 2)
#define DPP_X7(x) __shfl_xor(x, 7)
#define DPP_X8(x) __shfl_xor(x, 8)
static inline float xrow16_max(float x) { x = fmaxf(x, __shfl_xor(x, 16)); return fmaxf(x, __shfl_xor(x, 32)); }
static inline float xrow16_sum(float x) { x = x + __shfl_xor(x, 16); return x + __shfl_xor(x, 32); }
#define FAST_LOG2(x) log2f(x)
#define FAST_RCP(x) (1.f / (x))
static inline unsigned pack2(float lo, float hi) {
    unsigned a = __builtin_bit_cast(unsigned, lo), b = __builtin_bit_cast(unsigned, hi);
    a += 0x7fffu + ((a >> 16) & 1u); b += 0x7fffu + ((b >> 16) & 1u);
    return (a >> 16) | (b & 0xffff0000u);
}
#endif
__device__ __forceinline__ bf16_t f2bf(float f) { return (bf16_t)(pack2(f, 0.f) & 0xffffu); }
__device__ __forceinline__ float bf2f(bf16_t h) { return __builtin_bit_cast(float, (unsigned)h << 16); }

#define XB_TMO      128
#define XB_XCNT(j)  (256  + 64 * (j))
#define XB_XSUB(j)  (1280 + 64 * (j))
#define XB_XGEN(j)  (2304 + 64 * (j))
#define XB_TOP      3328
#define XB_TOPGEN   3392
#define XCD_BAR_WORDS 3456
#define XB_SPIN_CAP (1u << 22)
#define XB_SPIN(cond, bar) do { unsigned _sp = 0; while (cond) { SLEEP1(); \
    if ((++_sp & 255u) == 0u) { if (xb_ld(&(bar)[XB_TMO])) break; if (_sp > XB_SPIN_CAP) { xb_add(&(bar)[XB_TMO], 1u); break; } } } } while (0)

#define XB_X2SUB(x, s) (6400 + 16 * ((x) * 4 + (s)))
#define XB_X2CNT(x, s) (7424 + ((x) * 4 + (s)))
struct XcdBarrier { unsigned* bar; unsigned x, s; volatile LAS unsigned* st; };

__device__ __forceinline__ XcdBarrier xcd_barrier_post(unsigned* bar, volatile LAS unsigned* st) {
    XcdBarrier b; b.bar = bar; b.x = xb_xcc_id() & 15u; b.s = (blockIdx.x >> 3) & 3u; b.st = st;
    if (threadIdx.x == 0) {
        unsigned o = xb_add(&bar[XB_X2CNT(b.x, b.s)], 1u);
#ifndef EMU
        asm volatile("" :: "v"(o));
#endif
        (void)o;
        (void)xb_add(&bar[XB_XCNT(b.x)], 1u);
    }
    return b;
}
__device__ __forceinline__ void xcd_barrier_complete(unsigned* bar, unsigned x, unsigned s, unsigned& nsub, unsigned& nx, unsigned& nsubs) {
    const unsigned G = gridDim.x;
    unsigned sum, cnt, sp = 0u;
    for (;;) {
        sum = 0u; cnt = 0u;
#pragma unroll
        for (unsigned j = 0; j < 16; ++j) { const unsigned c = xb_ld(&bar[XB_XCNT(j)]); sum += c; cnt += (c > 0u) ? 1u : 0u; }
        if (sum == G) break;
        SLEEP1();
        if ((++sp & 255u) == 0u) { if (xb_ld(&bar[XB_TMO])) break; if (sp > XB_SPIN_CAP) { xb_add(&bar[XB_TMO], 1u); break; } }
    }
    unsigned mine = 0u, subs = 0u;
#pragma unroll
    for (unsigned q = 0; q < 4; ++q) { const unsigned c = xb_ld(&bar[XB_X2CNT(x, q)]); subs += (c > 0u) ? 1u : 0u; mine = (q == s) ? c : mine; }
    nsub = mine > 0u ? mine : 1u; nx = cnt > 0u ? cnt : 1u; nsubs = subs > 0u ? subs : 1u;
}
__device__ __forceinline__ void xcd_barrier(const XcdBarrier& b, bool leader) {
    WAIT_VM0();
    __syncthreads();
    if (leader) {
        unsigned* bar = b.bar;
        WAIT_ALL0();
        unsigned nsub = b.st[0], nx = b.st[1], nsubs = b.st[2];
        if (nsub == 0u) { xcd_barrier_complete(bar, b.x, b.s, nsub, nx, nsubs); b.st[0] = nsub; b.st[1] = nx; b.st[2] = nsubs; }
        const unsigned old = xb_add(&bar[XB_X2SUB(b.x, b.s)], 1u);
        const unsigned gen = old / nsub;
        bool xcd_last = false;
        if (old + 1u == (gen + 1u) * nsub) {
            const unsigned old2 = xb_add(&bar[XB_XSUB(b.x)], 1u);
            xcd_last = (old2 + 1u == (old2 / nsubs + 1u) * nsubs);
        }
        if (xcd_last) {
            FENCE_REL_AGENT();
            WAIT_VM0();
            const unsigned og = xb_add(&bar[XB_TOP], 1u);
            const unsigned tg = og / nx;
            if (og + 1u == (tg + 1u) * nx) xb_add(&bar[XB_TOPGEN], 1u);
            else XB_SPIN(xb_ld(&bar[XB_TOPGEN]) == tg, bar);
            FENCE_ACQ_AGENT();
            xb_add(&bar[XB_XGEN(b.x)], 1u);
            WAIT_VM0();
        } else {
            XB_SPIN(xb_ld(&bar[XB_XGEN(b.x)]) == gen, bar);
            FENCE_ACQ_AGENT();
            WAIT_VM0();
        }
    }
    __syncthreads();
}

__device__ __forceinline__ void stage4_bf16_pairs(unsigned char* p0, int rs, float v0, float v1, float v2, float v3, int fr) {
    const bool odd = (fr & 1) != 0;
    const float r0 = DPP_X1(odd ? v0 : v2), r1 = DPP_X1(odd ? v1 : v3);
    const unsigned w0 = odd ? pack2(r0, v2) : pack2(v0, r0), w1 = odd ? pack2(r1, v3) : pack2(v1, r1);
    unsigned char* p = p0 + (odd ? 2 * rs - 2 : 0);
    *(unsigned*)p = w0; *(unsigned*)(p + rs) = w1;
}
__device__ __forceinline__ f32x4 mul_s4(f32x4 a, float s) {
#ifdef EMU
    return a * s;
#else
    f32x4 o;
#pragma unroll
    for (int c = 0; c < 4; ++c) { float r, x = a[c]; asm volatile("v_mul_f32_e32 %0, %1, %2" : "=v"(r) : "v"(x), "v"(s)); o[c] = r; }
    return o;
#endif
}
__device__ __forceinline__ float wave_sum_l(float v, int lane) {
    (void)lane;
    v += DPP_X1(v); v += DPP_X2(v); v += DPP_X7(v); v += DPP_X8(v);
    return xrow16_sum(v);
}
#define wave_sum(v) wave_sum_l(v, lane)
__device__ __forceinline__ float fexp(float x) { return FAST_EXP2(x * LOG2E); }
__device__ __forceinline__ float sigmoid_f(float x) { return FAST_RCP(1.f + fexp(-x)); }
__device__ __forceinline__ float log_sigmoid_f(float x) { return fminf(x, 0.f) - 0.6931471805599453f * FAST_LOG2(1.f + fexp(-fabsf(x))); }
__device__ __forceinline__ float gelu_tanh_f(float x) { const float u = 0.7978845608028654f * (x + 0.044715f * x * x * x); return x * FAST_RCP(1.f + fexp(-2.f * u)); }
__device__ __forceinline__ float silu_f(float x) { return x * FAST_RCP(1.f + fexp(-x)); }
__device__ __forceinline__ float neg_expm1_f(float x) {
    const float ser = -x * (1.f + x * (0.5f + x * (0.16666667f + x * (0.041666668f + x * (0.008333334f + x * 0.0013888889f)))));
    return (x > -0.35f) ? ser : (1.f - fexp(x));
}

struct RmIdent { __device__ __forceinline__ int operator()(int n) const { return n; } };
struct RmWin { __device__ __forceinline__ int operator()(int n) const { return n < C_FA ? n : (n < C_FA + 6 ? -1 : n - 6); } };
struct RmGu { int kind; __device__ __forceinline__ int operator()(int f) const { return (f >> 7) * 256 + ((f >> 6) & 1) * 128 + ((f >> 4) & 3) * 32 + kind * 16 + (f & 15); } };
struct RmOff { int off; __device__ __forceinline__ int operator()(int n) const { return n + off; } };

template <class RM>
__device__ __forceinline__ void convert_tile(const float* src, int ld, int K, int Nsrc, int k0, int n0, bf16_t* dst, const RM& rm, float* T, int tid) {
    {
        const int nn = tid & 255, kh = (tid >> 8) * 32, n = n0 + nn;
        const float* sp = src + (size_t)(k0 + kh) * ld + n;
        float v[32];
#pragma unroll
        for (int i = 0; i < 32; ++i) v[i] = (n < Nsrc) ? sp[(size_t)i * ld] : 0.f;
#pragma unroll
        for (int i = 0; i < 32; ++i) T[(kh + i) * 257 + nn] = v[i];
    }
    __syncthreads();
#pragma unroll
    for (int q = 0; q < 4; ++q) {
        const int nn = q * 64 + (tid >> 3), kc = (tid & 7) * 8, n = n0 + nn;
        const int row = (n < Nsrc) ? rm(n) : -1;
        if (row >= 0) {
            u32x4 o;
            o.x = pack2(T[(kc + 0) * 257 + nn], T[(kc + 1) * 257 + nn]); o.y = pack2(T[(kc + 2) * 257 + nn], T[(kc + 3) * 257 + nn]);
            o.z = pack2(T[(kc + 4) * 257 + nn], T[(kc + 5) * 257 + nn]); o.w = pack2(T[(kc + 6) * 257 + nn], T[(kc + 7) * 257 + nn]);
            *(u32x4*)(dst + (size_t)row * K + k0 + kc) = o;
        }
    }
    __syncthreads();
}
template <class RM>
__device__ __forceinline__ void convert_tile_v4(const float* src, int ld, int K, int k0, int n0, bf16_t* dst, const RM& rm, float* T, int tid_in) {
    int tid = tid_in; OPAQUE(tid);
    {
        const int w = tid >> 6, l4 = (tid & 63) * 4;
        const float* sp = src + (size_t)(k0 + w * 8) * ld + n0 + l4;
        f32x4 v[8];
#pragma unroll
        for (int i = 0; i < 8; ++i) v[i] = *(const f32x4*)(sp + (size_t)i * ld);
#pragma unroll
        for (int i = 0; i < 8; ++i) { float* tp = T + (w * 8 + i) * 257 + l4; tp[0] = v[i][0]; tp[1] = v[i][1]; tp[2] = v[i][2]; tp[3] = v[i][3]; }
    }
    __syncthreads();
#pragma unroll
    for (int q = 0; q < 4; ++q) {
        const int nn = q * 64 + (tid >> 3), kc = (tid & 7) * 8, n = n0 + nn;
        const int row = rm(n);
        u32x4 o;
        o.x = pack2(T[(kc + 0) * 257 + nn], T[(kc + 1) * 257 + nn]); o.y = pack2(T[(kc + 2) * 257 + nn], T[(kc + 3) * 257 + nn]);
        o.z = pack2(T[(kc + 4) * 257 + nn], T[(kc + 5) * 257 + nn]); o.w = pack2(T[(kc + 6) * 257 + nn], T[(kc + 7) * 257 + nn]);
        *(u32x4*)(dst + (size_t)row * K + k0 + kc) = o;
    }
    __syncthreads();
}
template <class RM>
__device__ __forceinline__ void convert_mats(const float* src, size_t sstride, int nmat, int ld, int K, int Nsrc, bf16_t* dst, size_t dstride, const RM& rm,
                                             float* T, int tid, int bid, int G) {
    const int tk = K / 64, tn = (Nsrc + 255) / 256, per = tk * tn, total = nmat * per;
    for (int t = bid; t < total; t += G) {
        const int mi = t / per, r = t % per;
        convert_tile(src + (size_t)mi * sstride, ld, K, Nsrc, (r / tn) * 64, (r % tn) * 256, dst + (size_t)mi * dstride, rm, T, tid);
    }
}

constexpr int NCONV = DEPTH * 768;
__device__ __forceinline__ void moe_conv_chunk(const Params& p, int cid, bf16_t* WguT_, bf16_t* WdT_, float* T, int tid) {
    const int l = cid / 768, r = cid % 768, kind = r >> 8, t0 = (r & 255) * 8;
    for (int t = t0; t < t0 + 8; ++t) {
        const int mi = t >> 6, rr = t & 63;
        if (kind < 2) {
            const float* src = p.in[kind == 0 ? I_WGATE : I_WUP] + ((size_t)l * NEXP + mi) * D * DFF;
            convert_tile_v4(src, DFF, D, (rr >> 1) * 64, (rr & 1) * 256, WguT_ + ((size_t)l * NEXP + mi) * 1024 * D, RmGu{kind}, T, tid);
        } else {
            const float* src = p.in[I_WDOWN] + ((size_t)l * NEXP + mi) * DFF * D;
            convert_tile_v4(src, D, DFF, (rr >> 3) * 64, (rr & 7) * 256, WdT_ + ((size_t)l * NEXP + mi) * D * DFF, RmIdent{}, T, tid);
        }
    }
}

constexpr int BK = 64, HTB = 128 * 64 * 2;
__device__ __forceinline__ int lds_byte(int r, int c) {
    const int st = (r >> 4) * 2 + (c >> 5), rr = r & 15, cc = c & 31, ob = rr * 64 + cc * 2;
    return st * 1024 + (ob ^ (((ob >> 9) & 1) << 5));
}
__device__ __forceinline__ void stage_rc(int b, int& R, int& C) {
    const int st = b / 1024, sb = b % 1024, swz = sb ^ (((sb >> 9) & 1) << 5);
    R = (st >> 1) * 16 + swz / 64; C = (st & 1) * 32 + (swz % 64) / 2;
}
template <bool GATHER>
__device__ __forceinline__ void gemm_tile(const bf16_t* A, int arow0, const unsigned (&aoff)[2][2], const bf16_t* Bt, int brow0, int K,
                                          unsigned char* shm, f32x4 (&acc)[2][2][4][2], int tid_in) {
    int tid = tid_in; OPAQUE(tid);
    unsigned toff; { int R0, C0; stage_rc(tid * 16, R0, C0); toff = (unsigned)(R0 * K + C0); }
#define SA(b, h) (shm + ((b) * 2 + (h)) * HTB)
#define SB(b, h) (shm + (4 + (b) * 2 + (h)) * HTB)
#define STAGE_B(P, h, kt) do { _Pragma("unroll") for (int _i = 0; _i < 2; ++_i) GLDS16(Bt + ((size_t)(brow0 + (h) * 128 + _i * 64) * K + (size_t)(kt) * BK) + toff, (P) + tid * 16 + _i * 8192); } while (0)
#define STAGE_A(P, h, kt) do { _Pragma("unroll") for (int _i = 0; _i < 2; ++_i) { \
    if (GATHER) GLDS16(A + (size_t)(kt) * BK + aoff[h][_i], (P) + tid * 16 + _i * 8192); \
    else GLDS16(A + ((size_t)(arow0 + (h) * 128 + _i * 64) * K + (size_t)(kt) * BK) + toff, (P) + tid * 16 + _i * 8192); } } while (0)
#define LDA(dst, b, h) _Pragma("unroll") for (int m = 0; m < 4; ++m) _Pragma("unroll") for (int k = 0; k < 2; ++k) \
    dst[m][k] = *reinterpret_cast<const bf16x8*>(SA(b, h) + lds_byte(wr * 64 + m * 16 + fr, k * 32 + fq * 8))
#define LDB(dst, b, h) _Pragma("unroll") for (int n = 0; n < 2; ++n) _Pragma("unroll") for (int k = 0; k < 2; ++k) \
    dst[n][k] = *reinterpret_cast<const bf16x8*>(SB(b, h) + lds_byte(wc * 32 + n * 16 + fr, k * 32 + fq * 8))
#define MMA(ai, bj, At, Bx) do { SETPRIO(1); \
    _Pragma("unroll") for (int m = 0; m < 4; ++m) _Pragma("unroll") for (int n = 0; n < 2; ++n) _Pragma("unroll") for (int k = 0; k < 2; ++k) \
      acc[ai][bj][m][n] = MFMA16(At[m][k], Bx[n][k], acc[ai][bj][m][n]); \
    SETPRIO(0); } while (0)
    int wid = tid >> 6, lane = tid & 63, wr = wid >> 2, wc = wid & 3, fr = lane & 15, fq = lane >> 4;
#pragma unroll
    for (int a = 0; a < 2; ++a)
#pragma unroll
        for (int b = 0; b < 2; ++b)
#pragma unroll
            for (int m = 0; m < 4; ++m)
#pragma unroll
                for (int n = 0; n < 2; ++n) acc[a][b][m][n] = (f32x4){0.f, 0.f, 0.f, 0.f};
    bf16x8 At[4][2], B0[2][2], B1[2][2];
    const int nt = K / BK;
    STAGE_B(SB(0, 0), 0, 0); STAGE_A(SA(0, 0), 0, 0);
    STAGE_B(SB(0, 1), 1, 0); STAGE_A(SA(0, 1), 1, 0);
    if (wr == 1) BAR();
    WAIT_V(4); BAR();
    STAGE_B(SB(1, 0), 0, 1); STAGE_A(SA(1, 0), 0, 1); STAGE_B(SB(1, 1), 1, 1);
    WAIT_V(6); BAR();
    for (int t = 0; t < nt - 2; t += 2) {
        LDB(B0, 0, 0); SCHED(); LDA(At, 0, 0); STAGE_A(SA(1, 1), 1, t + 1);
        WAIT_L(8); BAR(); WAIT_L(0); MMA(0, 0, At, B0); BAR(); SCHED();
        LDB(B1, 0, 1); STAGE_B(SB(0, 0), 0, t + 2);
        BAR(); WAIT_L(0); MMA(0, 1, At, B1); BAR();
        LDA(At, 0, 1); STAGE_A(SA(0, 0), 0, t + 2);
        BAR(); WAIT_L(0); MMA(1, 0, At, B0); BAR(); SCHED();
        STAGE_B(SB(0, 1), 1, t + 2);
        WAIT_V(6); BAR(); MMA(1, 1, At, B1); BAR();
        LDB(B0, 1, 0); SCHED(); LDA(At, 1, 0); STAGE_A(SA(0, 1), 1, t + 2);
        WAIT_L(8); BAR(); WAIT_L(0); MMA(0, 0, At, B0); BAR(); SCHED();
        LDB(B1, 1, 1); STAGE_B(SB(1, 0), 0, t + 3);
        BAR(); WAIT_L(0); MMA(0, 1, At, B1); BAR();
        LDA(At, 1, 1); STAGE_A(SA(1, 0), 0, t + 3);
        BAR(); WAIT_L(0); MMA(1, 0, At, B0); BAR(); SCHED();
        STAGE_B(SB(1, 1), 1, t + 3);
        WAIT_V(6); BAR(); MMA(1, 1, At, B1); BAR();
    }
    OPAQUE(tid); wid = tid >> 6; lane = tid & 63; wr = wid >> 2; wc = wid & 3; fr = lane & 15; fq = lane >> 4;
    { LDB(B0, 0, 0); WAIT_V(0); LDA(At, 0, 0); STAGE_A(SA(1, 1), 1, nt - 1);
      BAR(); WAIT_L(0); MMA(0, 0, At, B0); BAR();
      LDB(B1, 0, 1); BAR(); WAIT_L(0); MMA(0, 1, At, B1); BAR();
      LDA(At, 0, 1); WAIT_V(4); BAR(); WAIT_L(0); MMA(1, 0, At, B0); MMA(1, 1, At, B1); BAR(); }
    { LDB(B0, 1, 0); LDA(At, 1, 0); WAIT_V(2); BAR(); WAIT_L(0); MMA(0, 0, At, B0); BAR();
      LDB(B1, 1, 1); WAIT_V(0); BAR(); WAIT_L(0); MMA(0, 1, At, B1); BAR();
      LDA(At, 1, 1); BAR(); WAIT_L(0); MMA(1, 0, At, B0); MMA(1, 1, At, B1); BAR(); }
    if (wr == 0) BAR();
#undef SA
#undef SB
#undef STAGE_A
#undef STAGE_B
#undef LDA
#undef LDB
#undef MMA
}
__device__ __forceinline__ void stage_geom(int tid, int (&R)[2], int (&C)[2]) {
#pragma unroll
    for (int i = 0; i < 2; ++i) stage_rc(tid * 16 + i * 8192, R[i], C[i]);
}

constexpr int ATT_STAGE = 69632;
constexpr int ATT_KBUF = 0, ATT_VBUF = 32768, ATT_CBUF = 65536;
template <int KIND>
__device__ __forceinline__ void attn_unit(const bf16_t* Q, const bf16_t* Kg, const bf16_t* VT, const float* cum2, const float* kmx, int qb, bf16_t* concat, int ccol0,
                                          float lam, float osc, const float* subg, unsigned char* lds, int tid) {
    const int lane = tid & 63, wave = tid >> 6, r16 = lane & 15, q4 = lane >> 4;
    const int q0w = qb * 128 + wave * 16, myq = q0w + r16;
    const int ntiles = 2 * qb + 2;
    const int wlimit = (KIND == 0) ? ((q0w + 15) >> 6) : (q0w >> 6);
    constexpr int NMAP = (KIND == 0) ? 1 : 2, NKS = (KIND == 0) ? 4 : 2;
    bf16x8 qf[NMAP][NKS];
#pragma unroll
    for (int mp = 0; mp < NMAP; ++mp)
#pragma unroll
        for (int ks = 0; ks < NKS; ++ks) qf[mp][ks] = *(const bf16x8*)(Q + (size_t)myq * 128 + mp * 64 + ks * 32 + q4 * 8);
    const float cq = (KIND == 0) ? cum2[myq] : 0.f;
    int kt0 = 0;
    if (KIND == 0) {
        float* wmax = (float*)(lds + ATT_CBUF + 512); int* kst = (int*)(lds + ATT_CBUF + 576);
        float qs = 0.f;
#pragma unroll
        for (int ks = 0; ks < NKS; ++ks)
#pragma unroll
            for (int j = 0; j < 8; ++j) { const float v = bf2f((bf16_t)qf[0][ks][j]); qs += v * v; }
        qs = xrow16_sum(qs);
        qs = fmaxf(qs, SHX(qs, 1)); qs = fmaxf(qs, SHX(qs, 2)); qs = fmaxf(qs, SHX(qs, 4)); qs = fmaxf(qs, SHX(qs, 8));
        if (lane == 0) wmax[wave] = qs;
        if (tid == 0) *kst = 2 * qb;
        __syncthreads();
        float qm = wmax[0];
#pragma unroll
        for (int w = 1; w < 8; ++w) qm = fmaxf(qm, wmax[w]);
        qm = sqrtf(qm) * 1.01f;
        const float kd = sqrtf(fmaxf(kmx[2 * qb], kmx[2 * qb + 1])) * 1.01f;
        if (tid < 2 * qb) {
            const float bias = cum2[qb * 128] - cum2[tid * 64 + 63];
            const bool skip = bias + qm * (sqrtf(kmx[tid]) * 1.01f + kd) < -40.f;
            if (!skip) atomic_min_int(kst, tid);
        }
        __syncthreads();
        kt0 = RFL(*kst);
    }
    f32x4 ot[NMAP][8];
    float mrun[NMAP], lsum[NMAP];
#pragma unroll
    for (int mp = 0; mp < NMAP; ++mp) { mrun[mp] = -INFINITY; lsum[mp] = 0.f;
#pragma unroll
        for (int mo = 0; mo < 8; ++mo) ot[mp][mo] = (f32x4){0.f, 0.f, 0.f, 0.f}; }
    u32x4 sk[2], sv[2]; float sc = 0.f;
    const u32x4* kg = (const u32x4*)Kg; const u32x4* vg = (const u32x4*)VT;
#pragma unroll
    for (int i = 0; i < 2; ++i) { sk[i] = kg[(size_t)kt0 * 1024 + tid + i * 512]; sv[i] = vg[(size_t)kt0 * 1024 + tid + i * 512]; }
    if (KIND == 0 && tid < 64) sc = cum2[kt0 * 64 + tid];
    for (int kt = kt0; kt < ntiles; ++kt) {
        unsigned char* kb = lds + ATT_KBUF + (kt & 1) * 16384;
        unsigned char* vb = lds + ATT_VBUF + (kt & 1) * 16384;
        float* cb = (float*)(lds + ATT_CBUF + (kt & 1) * 256);
#pragma unroll
        for (int i = 0; i < 2; ++i) {
            const int g = tid + i * 512;
            { const int row = g >> 4, c = g & 15; *(u32x4*)(kb + row * 256 + ((c ^ (row & 15)) << 4)) = sk[i]; }
            { const int d = g >> 3, c = g & 7; *(u32x4*)(vb + d * 128 + ((c ^ ((d >> 1) & 7)) << 4)) = sv[i]; }
        }
        if (KIND == 0 && tid < 64) cb[tid] = sc;
        __syncthreads();
        if (kt + 1 < ntiles) {
#pragma unroll
            for (int i = 0; i < 2; ++i) { sk[i] = kg[(size_t)(kt + 1) * 1024 + tid + i * 512]; sv[i] = vg[(size_t)(kt + 1) * 1024 + tid + i * 512]; }
            if (KIND == 0 && tid < 64) sc = cum2[(kt + 1) * 64 + tid];
        }
        if (kt <= wlimit) {
#pragma unroll
            for (int mp = 0; mp < NMAP; ++mp) {
                bf16x8 kf[4][NKS], vfa[8];
#pragma unroll
                for (int m = 0; m < 4; ++m)
#pragma unroll
                    for (int ks = 0; ks < NKS; ++ks) { const int c = (KIND == 0 ? 0 : mp * 8) + ks * 4 + q4; kf[m][ks] = *(const bf16x8*)(kb + (m * 16 + r16) * 256 + ((c ^ r16) << 4)); }
#pragma unroll
                for (int mo = 0; mo < 8; ++mo) { const int d = mo * 16 + r16; vfa[mo] = *(const bf16x8*)(vb + d * 128 + (((0 * 4 + q4) ^ ((d >> 1) & 7)) << 4)); }
                SCHED();
                f32x4 st[4];
#pragma unroll
                for (int m = 0; m < 4; ++m) st[m] = (f32x4){0.f, 0.f, 0.f, 0.f};
#pragma unroll
                for (int ks = 0; ks < NKS; ++ks)
#pragma unroll
                    for (int m = 0; m < 4; ++m) st[m] = MFMA16(kf[m][ks], qf[mp][ks], st[m]);
                SCHED();
                float mx = -INFINITY;
#pragma unroll
                for (int m = 0; m < 4; ++m) {
                    if (KIND == 0) {
                        const f32x4 ck = *(const f32x4*)(cb + m * 16 + 4 * q4);
#pragma unroll
                        for (int j = 0; j < 4; ++j) {
                            float y = st[m][j] + (cq - ck[j]);
                            if (kt * 64 + m * 16 + 4 * q4 + j > myq) y = -INFINITY;
                            st[m][j] = y;
                        }
                    }
#pragma unroll
                    for (int j = 0; j < 4; ++j) mx = fmaxf(mx, st[m][j]);
                }
                mx = xrow16_max(mx);
                const float mnew = fmaxf(mrun[mp], mx);
                const float alpha = FAST_EXP2(mrun[mp] - mnew);
                mrun[mp] = mnew;
                float ps = 0.f;
#pragma unroll
                for (int m = 0; m < 4; ++m)
#pragma unroll
                    for (int j = 0; j < 4; ++j) { const float pv = FAST_EXP2(st[m][j] - mnew); st[m][j] = pv; ps += pv; }
                lsum[mp] = lsum[mp] * alpha + ps;
#pragma unroll
                for (int mo = 0; mo < 8; ++mo) ot[mp][mo] *= alpha;
                bf16x8 pf[2];
#pragma unroll
                for (int kk = 0; kk < 2; ++kk) {
                    u32x4 pw;
                    pw.x = pack2(st[2 * kk][0], st[2 * kk][1]); pw.y = pack2(st[2 * kk][2], st[2 * kk][3]);
                    pw.z = pack2(st[2 * kk + 1][0], st[2 * kk + 1][1]); pw.w = pack2(st[2 * kk + 1][2], st[2 * kk + 1][3]);
                    pf[kk] = __builtin_bit_cast(bf16x8, pw);
                }
                bf16x8 vfb[8];
#pragma unroll
                for (int mo = 0; mo < 8; ++mo) { const int d = mo * 16 + r16; vfb[mo] = *(const bf16x8*)(vb + d * 128 + (((1 * 4 + q4) ^ ((d >> 1) & 7)) << 4)); }
                SCHED();
#pragma unroll
                for (int mo = 0; mo < 8; ++mo) ot[mp][mo] = MFMA16(vfa[mo], pf[0], ot[mp][mo]);
                SCHED();
#pragma unroll
                for (int mo = 0; mo < 8; ++mo) ot[mp][mo] = MFMA16(vfb[mo], pf[1], ot[mp][mo]);
            }
        }
    }
    float inv[NMAP];
#pragma unroll
    for (int mp = 0; mp < NMAP; ++mp) { float l = lsum[mp]; l = xrow16_sum(l); inv[mp] = 1.f / l; }
    if (KIND == 0) {
        int te = tid; OPAQUE(te);
        const int er = te & 15, eq = (te >> 4) & 3, eqw = qb * 128 + (te >> 6) * 16;
        unsigned char* stg = lds + ATT_STAGE + (te >> 6) * 8192;
#pragma unroll
        for (int mo = 0; mo < 8; ++mo) {
            u32x2 o; o.x = pack2(ot[0][mo][0] * inv[0], ot[0][mo][1] * inv[0]); o.y = pack2(ot[0][mo][2] * inv[0], ot[0][mo][3] * inv[0]);
            *(u32x2*)(stg + er * 256 + (((mo * 2 + (eq >> 1)) ^ er) << 4) + (eq & 1) * 8) = o;
        }
        WAVE_SYNC();
#pragma unroll
        for (int k = 0; k < 4; ++k) {
            const int rl = k * 4 + eq, cch = er;
            const u32x4 val = *(const u32x4*)(stg + rl * 256 + ((cch ^ rl) << 4));
            *(u32x4*)(concat + (size_t)(eqw + rl) * D + ccol0 + cch * 8) = val;
        }
    } else {
        float ss = 0.f;
#pragma unroll
        for (int mo = 0; mo < 8; ++mo)
#pragma unroll
            for (int j = 0; j < 4; ++j) { const float v = ot[0][mo][j] * inv[0] - lam * (ot[NMAP - 1][mo][j] * inv[NMAP - 1]); ot[0][mo][j] = v; ss += v * v; }
        ss = xrow16_sum(ss);
        const float rs = osc / sqrtf(ss * (1.f / 128.f) + LN_EPS);
#pragma unroll
        for (int mo = 0; mo < 8; ++mo) {
            const f32x4 g = *(const f32x4*)(subg + mo * 16 + 4 * q4);
            u32x2 o; o.x = pack2(ot[0][mo][0] * rs * g[0], ot[0][mo][1] * rs * g[1]); o.y = pack2(ot[0][mo][2] * rs * g[2], ot[0][mo][3] * rs * g[3]);
            *(u32x2*)(concat + (size_t)myq * D + ccol0 + mo * 16 + 4 * q4) = o;
        }
    }
    __syncthreads();
}

__device__ __forceinline__ int dpart_row(int c, int q) { return c * (S - DCH * 64) - (DCH * 32) * c * (c - 1) + q; }
__device__ __forceinline__ void attn_dmap_unit(const bf16_t* Qh, const bf16_t* Kh, const bf16_t* VTh, int mp, int qb, int t0, int t1,
                                               bf16_t* Op, float* ML, int c, float bnd, unsigned char* lds, int tid) {
    const bool fixedref = (bnd <= 60.f);
    const int lane = tid & 63, wave = tid >> 6, r16 = lane & 15, q4 = lane >> 4;
    const int q0w = qb * 256 + wave * 32;
    const int wlimit = q0w >> 6;
    bf16x8 qf[2][2];
#pragma unroll
    for (int n = 0; n < 2; ++n)
#pragma unroll
        for (int ks = 0; ks < 2; ++ks) qf[n][ks] = *(const bf16x8*)(Qh + (size_t)(q0w + n * 16 + r16) * 128 + mp * 64 + ks * 32 + q4 * 8);
    f32x4 ot[8][2];
    float mrun[2] = {-INFINITY, -INFINITY}, lsum[2] = {0.f, 0.f};
    if (fixedref) { mrun[0] = bnd; mrun[1] = bnd; }
    const float stinit = fixedref ? -bnd : 0.f;
#pragma unroll
    for (int mo = 0; mo < 8; ++mo) { ot[mo][0] = (f32x4){0.f, 0.f, 0.f, 0.f}; ot[mo][1] = (f32x4){0.f, 0.f, 0.f, 0.f}; }
    u32x4 sk, sv[2];
    const u32x4* kg = (const u32x4*)Kh; const u32x4* vg = (const u32x4*)VTh;
    const int krow = tid >> 3, kc8 = tid & 7;
    sk = kg[(size_t)t0 * 1024 + krow * 16 + mp * 8 + kc8];
#pragma unroll
    for (int i = 0; i < 2; ++i) sv[i] = vg[(size_t)t0 * 1024 + tid + i * 512];
    for (int kt = t0; kt < t1; ++kt) {
        unsigned char* kb = lds + (kt & 1) * 8192;
        unsigned char* vb = lds + 16384 + (kt & 1) * 16384;
        *(u32x4*)(kb + krow * 128 + ((kc8 ^ ((krow >> 1) & 7)) << 4)) = sk;
#pragma unroll
        for (int i = 0; i < 2; ++i) { const int g = tid + i * 512, d = g >> 3, cc = g & 7; *(u32x4*)(vb + d * 128 + ((cc ^ ((d >> 1) & 7)) << 4)) = sv[i]; }
        __syncthreads();
        if (kt + 1 < t1) {
            sk = kg[(size_t)(kt + 1) * 1024 + krow * 16 + mp * 8 + kc8];
#pragma unroll
            for (int i = 0; i < 2; ++i) sv[i] = vg[(size_t)(kt + 1) * 1024 + tid + i * 512];
        }
        if (kt <= wlimit) {
            bf16x8 kf[4][2], vfa[8];
#pragma unroll
            for (int m = 0; m < 4; ++m)
#pragma unroll
                for (int ks = 0; ks < 2; ++ks) kf[m][ks] = *(const bf16x8*)(kb + (m * 16 + r16) * 128 + (((ks * 4 + q4) ^ ((r16 >> 1) & 7)) << 4));
#pragma unroll
            for (int mo = 0; mo < 8; ++mo) { const int d = mo * 16 + r16; vfa[mo] = *(const bf16x8*)(vb + d * 128 + (((0 * 4 + q4) ^ ((d >> 1) & 7)) << 4)); }
            SCHED();
            f32x4 st[4][2];
#pragma unroll
            for (int m = 0; m < 4; ++m) { st[m][0] = (f32x4){stinit, stinit, stinit, stinit}; st[m][1] = (f32x4){stinit, stinit, stinit, stinit}; }
            SETPRIO(1);
#pragma unroll
            for (int ks = 0; ks < 2; ++ks)
#pragma unroll
                for (int m = 0; m < 4; ++m) { st[m][0] = MFMA16(kf[m][ks], qf[0][ks], st[m][0]); st[m][1] = MFMA16(kf[m][ks], qf[1][ks], st[m][1]); }
            SETPRIO(0);
            SCHED();
            float alpha[2] = {1.f, 1.f};
            if (fixedref) {
#pragma unroll
                for (int n = 0; n < 2; ++n) {
                    float ps = 0.f;
#pragma unroll
                    for (int m = 0; m < 4; ++m)
#pragma unroll
                        for (int j = 0; j < 4; ++j) { const float pv = FAST_EXP2(st[m][n][j]); st[m][n][j] = pv; ps += pv; }
                    lsum[n] += ps;
                }
            } else
#pragma unroll
            for (int n = 0; n < 2; ++n) {
                float mx = -INFINITY;
#pragma unroll
                for (int m = 0; m < 4; ++m)
#pragma unroll
                    for (int j = 0; j < 4; ++j) mx = fmaxf(mx, st[m][n][j]);
                mx = xrow16_max(mx);
                const float mnew = fmaxf(mrun[n], mx);
                alpha[n] = FAST_EXP2(mrun[n] - mnew);
                mrun[n] = mnew;
                float ps = 0.f;
#pragma unroll
                for (int m = 0; m < 4; ++m)
#pragma unroll
                    for (int j = 0; j < 4; ++j) { const float pv = FAST_EXP2(st[m][n][j] - mnew); st[m][n][j] = pv; ps += pv; }
                lsum[n] = lsum[n] * alpha[n] + ps;
            }
            if (ANY_LANE(alpha[0] != 1.f)) {
#pragma unroll
                for (int mo = 0; mo < 8; ++mo) ot[mo][0] *= alpha[0];
            }
            if (ANY_LANE(alpha[1] != 1.f)) {
#pragma unroll
                for (int mo = 0; mo < 8; ++mo) ot[mo][1] *= alpha[1];
            }
            bf16x8 pf[2][2];
#pragma unroll
            for (int kk = 0; kk < 2; ++kk)
#pragma unroll
                for (int n = 0; n < 2; ++n) {
                    u32x4 pw;
                    pw.x = pack2(st[2 * kk][n][0], st[2 * kk][n][1]); pw.y = pack2(st[2 * kk][n][2], st[2 * kk][n][3]);
                    pw.z = pack2(st[2 * kk + 1][n][0], st[2 * kk + 1][n][1]); pw.w = pack2(st[2 * kk + 1][n][2], st[2 * kk + 1][n][3]);
                    pf[kk][n] = __builtin_bit_cast(bf16x8, pw);
                }
            bf16x8 vfb[8];
#pragma unroll
            for (int mo = 0; mo < 8; ++mo) { const int d = mo * 16 + r16; vfb[mo] = *(const bf16x8*)(vb + d * 128 + (((1 * 4 + q4) ^ ((d >> 1) & 7)) << 4)); }
            SCHED();
            SETPRIO(1);
#pragma unroll
            for (int mo = 0; mo < 8; ++mo) { ot[mo][0] = MFMA16(vfa[mo], pf[0][0], ot[mo][0]); ot[mo][1] = MFMA16(vfa[mo], pf[0][1], ot[mo][1]); }
            SCHED();
#pragma unroll
            for (int mo = 0; mo < 8; ++mo) { ot[mo][0] = MFMA16(vfb[mo], pf[1][0], ot[mo][0]); ot[mo][1] = MFMA16(vfb[mo], pf[1][1], ot[mo][1]); }
            SETPRIO(0);
        }
    }
    if (q0w >= DCH * 64 * c)
#pragma unroll
    for (int n = 0; n < 2; ++n) {
        float l = lsum[n]; l = xrow16_sum(l);
        const int row = dpart_row(c, q0w + n * 16 + r16);
        if (q4 == 0) { ML[row * 2] = mrun[n]; ML[row * 2 + 1] = l; }
    }
    {
        int te = tid; OPAQUE(te);
        const int er = te & 15, eq = (te >> 4) & 3, eqw = qb * 256 + (te >> 6) * 32;
        unsigned char* stg = lds + ATT_STAGE + (te >> 6) * 8192;
#pragma unroll
        for (int n = 0; n < 2; ++n)
#pragma unroll
            for (int mo = 0; mo < 8; ++mo) {
                u32x2 o; o.x = pack2(ot[mo][n][0], ot[mo][n][1]); o.y = pack2(ot[mo][n][2], ot[mo][n][3]);
                *(u32x2*)(stg + (n * 16 + er) * 256 + (((mo * 2 + (eq >> 1)) ^ er) << 4) + (eq & 1) * 8) = o;
            }
        WAVE_SYNC();
        if (eqw >= DCH * 64 * c) {
            const int row0 = dpart_row(c, eqw);
#pragma unroll
            for (int k = 0; k < 8; ++k) {
                const int rl = k * 4 + eq, cch = er;
                const u32x4 val = *(const u32x4*)(stg + rl * 256 + ((cch ^ (rl & 15)) << 4));
                *(u32x4*)(Op + (size_t)(row0 + rl) * 128 + cch * 8) = val;
            }
        }
    }
    __syncthreads();
}

__device__ __forceinline__ void lru_unit_a(int chunk, int grp, int l, const Params& p, const bf16_t* Xr, const bf16_t* WaiT, float* hloc, float* ploc, float* sumA, float* sumH,
                                           unsigned char* lds, int tid) {
    const int lane = tid & 63, wave = tid >> 6, r16 = lane & 15, q4 = lane >> 4;
    unsigned char* XCB = lds; float* XU = (float*)(lds + 16384); float* LA = (float*)(lds + 49152); float* ENDS = (float*)(lds + 81920);
    const int t0 = chunk * 64, ch0 = grp * 128;
    bf16x8 bfr[2][4];
#pragma unroll
    for (int g = 0; g < 2; ++g)
#pragma unroll
        for (int ks = 0; ks < 4; ++ks) bfr[g][ks] = *(const bf16x8*)(WaiT + ((size_t)grp * 256 + g * 128 + wave * 16 + r16) * 128 + ks * 32 + q4 * 8);
    const int chg = ch0 + wave * 16 + r16;
    const float ba = p.in[I_BA][(size_t)l * LRU_W + chg], bi = p.in[I_BI][(size_t)l * LRU_W + chg];
    const float lam_raw = p.in[I_LAM][(size_t)l * LRU_W + chg];
    {
        const int c = tid & 127, tq = tid >> 7, ch = ch0 + c;
        const float* cw = p.in[I_CONVW] + (size_t)l * 4 * LRU_W + ch; const float cb = p.in[I_CONVB][(size_t)l * LRU_W + ch];
        const float w0 = cw[0], w1 = cw[LRU_W], w2 = cw[2 * LRU_W], w3 = cw[3 * LRU_W];
        const int ts = t0 + tq * 16;
        float x0 = (ts - 3 >= 0) ? bf2f(Xr[(size_t)(ts - 3) * LRU_W + ch]) : 0.f;
        float x1 = (ts - 2 >= 0) ? bf2f(Xr[(size_t)(ts - 2) * LRU_W + ch]) : 0.f;
        float x2 = (ts - 1 >= 0) ? bf2f(Xr[(size_t)(ts - 1) * LRU_W + ch]) : 0.f;
#pragma unroll
        for (int i = 0; i < 16; ++i) {
            const float x3 = bf2f(Xr[(size_t)(ts + i) * LRU_W + ch]);
            const float v = cb + w0 * x0 + w1 * x1 + w2 * x2 + w3 * x3;
            const int row = tq * 16 + i;
            XU[row * 128 + c] = v;
            *(bf16_t*)(XCB + row * 256 + (((c >> 3) ^ (row & 15)) << 4) + (c & 7) * 2) = f2bf(v);
            x0 = x1; x1 = x2; x2 = x3;
        }
    }
    __syncthreads();
    {
        const float lsl = 8.0f * log_sigmoid_f(lam_raw);
#pragma unroll
        for (int mt = 0; mt < 4; ++mt) {
            f32x4 ga = (f32x4){0.f, 0.f, 0.f, 0.f}, gi = (f32x4){0.f, 0.f, 0.f, 0.f};
#pragma unroll
            for (int ks = 0; ks < 4; ++ks) {
                const bf16x8 af = *(const bf16x8*)(XCB + (mt * 16 + r16) * 256 + (((ks * 4 + q4) ^ r16) << 4));
                ga = MFMA16(af, bfr[0][ks], ga); gi = MFMA16(af, bfr[1][ks], gi);
            }
#pragma unroll
            for (int j = 0; j < 4; ++j) {
                const int row = mt * 16 + 4 * q4 + j, idx = row * 128 + wave * 16 + r16;
                const float r = sigmoid_f(ga[j] + ba), ig = sigmoid_f(gi[j] + bi);
                const float log_a = lsl * r;
                LA[idx] = fexp(log_a);
                XU[idx] = sqrtf(neg_expm1_f(2.f * log_a)) * (ig * XU[idx]);
            }
        }
    }
    __syncthreads();
    {
        const int c = tid & 127, tq = tid >> 7, ch = ch0 + c;
        float h = 0.f, P = 1.f;
#pragma unroll
        for (int i = 0; i < 16; ++i) { const int idx = (tq * 16 + i) * 128 + c; const float a = LA[idx]; h = a * h + XU[idx]; P *= a; XU[idx] = h; LA[idx] = P; }
        ENDS[tq * 128 + c] = P; ENDS[512 + tq * 128 + c] = h;
        __syncthreads();
        float cin = 0.f, pin = 1.f;
        for (int s = 0; s < tq; ++s) { const float Ps = ENDS[s * 128 + c], hs = ENDS[512 + s * 128 + c]; cin = Ps * cin + hs; pin *= Ps; }
#pragma unroll
        for (int i = 0; i < 16; ++i) {
            const int idx = (tq * 16 + i) * 128 + c; const size_t gi = (size_t)(t0 + tq * 16 + i) * LRU_W + ch;
            const float Pl = LA[idx], hl = XU[idx];
            ((unsigned*)hloc)[gi] = pack2(hl + Pl * cin, Pl * pin);
        }
        if (tq == 3) { const float Pl = LA[63 * 128 + c], hl = XU[63 * 128 + c]; sumA[(size_t)chunk * LRU_W + ch] = Pl * pin; sumH[(size_t)chunk * LRU_W + ch] = hl + Pl * cin; }
    }
    __syncthreads();
}

__device__ __forceinline__ void moe_prefix(const int* cntb_, int G, unsigned char* lds, int tid) {
    int* tmp = (int*)lds; int* ctot = (int*)(lds + LDS_MISC + M_CTOT); int* coff = (int*)(lds + LDS_MISC + M_COFF);
    unsigned short* pre16 = (unsigned short*)(lds + LDS_MISC + M_PRE16);
    const int e = tid & 31, part = tid >> 5, PB = (G + 15) / 16;
    int sm = 0;
    for (int i = 0; i < PB; ++i) { const int b = part * PB + i; if (b < G) sm += cntb_[b * 32 + e]; }
    tmp[part * 32 + e] = sm;
    __syncthreads();
    int run = 0;
    for (int q = 0; q < part; ++q) run += tmp[q * 32 + e];
    for (int i = 0; i < PB; ++i) { const int b = part * PB + i; if (b < G) { pre16[e * 257 + b] = (unsigned short)run; run += cntb_[b * 32 + e]; } }
    if (part == 15) { ctot[e] = run; pre16[e * 257 + G] = (unsigned short)run; }
    __syncthreads();
    if (tid == 0) { int o = 0; for (int q = 0; q < 32; ++q) { coff[q] = o; o += ctot[q]; } coff[32] = o; }
    __syncthreads();
}
__device__ __forceinline__ void moe_rowtable(const int* ltok_, const float* lw_, const int* lslot_, int e, int m0, int c_e, int G, int segcap, unsigned char* lds, int tid_in) {
    int tid = tid_in; OPAQUE(tid);
    const unsigned short* pre = (const unsigned short*)(lds + LDS_MISC + M_PRE16) + e * 257;
    int* rtok = (int*)(lds + LDS_MISC + M_RTOK); float* rw = (float*)(lds + LDS_MISC + M_RW); int* rslot = (int*)(lds + LDS_MISC + M_RSLOT);
    if (tid < 256) {
        const int g = m0 + tid;
        int tk = 0, sl = 0; float w = 0.f;
        if (g < c_e) {
            int lo = 0, hi = G;
            while (hi - lo > 1) { const int mid = (lo + hi) >> 1; if ((int)pre[mid] <= g) lo = mid; else hi = mid; }
            const int idx = (e * G + lo) * segcap + (g - (int)pre[lo]);
            tk = ltok_[idx]; w = lw_[idx]; sl = lslot_[idx];
        }
        rtok[tid] = tk; rw[tid] = w; rslot[tid] = sl;
    }
    __syncthreads();
}
#define kmax2 ((float*)(wsl + A_KMAX))
#define dpo ((bf16_t*)(wsl + A_DPO))
#define dpml ((float*)(wsl + A_DPML))
#define cntb ((int*)(wsl + A_CNTB))
#define WinT ((bf16_t*)(wsl + WB_WIN))
#define WoT ((bf16_t*)(wsl + WB_WO))
#define WguT ((bf16_t*)(wsl + WB_WGU))
#define WdT ((bf16_t*)(wsl + WB_WD))
#define WaiT ((bf16_t*)(wsl + WB_WAI))
#define Wfa ((float*)(wsl + WF_FA))
#define W36b ((bf16_t*)(wsl + WF_R36))
#define ropecs ((float*)(wsl + WF_ROPE))
#define xb ((bf16_t*)(wsl + A_XB))
#define hb ((float*)(wsl + A_HB))
#define logf_ ((float*)(wsl + A_LOGF))
#define cum2 ((float*)(wsl + A_CUM))
#define Qa ((bf16_t*)(wsl + A_QA))
#define Ka ((bf16_t*)(wsl + A_KA))
#define VaT ((bf16_t*)(wsl + A_VAT))
#define Xr ((bf16_t*)(wsl + A_XR))
#define Gr ((bf16_t*)(wsl + A_GR))
#define Qc ((bf16_t*)(wsl + A_QC))
#define Kc ((bf16_t*)(wsl + A_KC))
#define VcT ((bf16_t*)(wsl + A_VCT))
#define hloc ((float*)(wsl + A_HLOC))
#define ploc ((float*)(wsl + A_PLOC))
#define sumA ((float*)(wsl + A_SUMA))
#define sumH ((float*)(wsl + A_SUMH))
#define concat ((bf16_t*)(wsl + A_CONCAT))
#define y1 ((float*)(wsl + A_Y1))
#define h1 ((float*)(wsl + A_H1))
#define h1b ((bf16_t*)(wsl + A_H1B))
#define ltok ((int*)(wsl + A_LTOK))
#define lw ((float*)(wsl + A_LW))
#define lslot ((int*)(wsl + A_LSLOT))
#define act ((bf16_t*)(wsl + A_ACT))
#define contrib ((bf16_t*)(wsl + A_CONTRIB))
#ifndef EMU
__global__ void __launch_bounds__(NTHREADS, 2)
#else
void
#endif
fwd_kernel(Params p) {
    DYN_LDS(lds_raw);
    float* ldsf = (float*)lds_raw;
    const int bid = blockIdx.x, G = gridDim.x;
    const int gthreads = G * NTHREADS, gwaves = G * (NTHREADS / 64);
    const int wave_s = RFL((int)threadIdx.x >> 6);
#define PHASE_IDS() unsigned char* wsl = ws; OPAQUE_S(wsl); int tid = wave_s * 64 + LANE_ID(); OPAQUE(tid); const int lane = tid & 63, wave = tid >> 6, gtid = bid * NTHREADS + tid, gwave = bid * (NTHREADS / 64) + wave; (void)lane; (void)wave; (void)gtid; (void)gwave

    unsigned char* ws = p.ws;
    volatile LAS unsigned* bst = (volatile LAS unsigned*)(lds_raw + LDS_MISC);
    unsigned* ubox = (unsigned*)(lds_raw + LDS_MISC + 16);
    if (threadIdx.x == 0) { bst[0] = 0u; bst[1] = 0u; bst[2] = 0u; bst[3] = 0u; }
    __syncthreads();
    XcdBarrier bar = xcd_barrier_post((unsigned*)ws, bst);

    const int* positions = (const int*)p.in[I_POS];

    constexpr int NPH = 8;
    const int lo = p.lo, hi = p.hi;
#ifdef ONLY_PHASE
#define PH_SEL(c) ((c) == ONLY_PHASE)
#else
#define PH_SEL(c) 1
#endif
#define PH_IN(k) (lo <= (k) && (k) < hi)
#define PH_BAR(k) do { if ((k) + 1 < hi) xcd_barrier(bar, wave_s == 0 && LANE_ID() == 0); } while (0)

    if (PH_SEL(-1) && PH_IN(0)) for (int rep = 0; rep < PH_REPS(-1); ++rep) {
        PHASE_IDS();
        for (int l = 0; l < DEPTH; ++l) {
            convert_mats(p.in[I_WIN] + (size_t)l * D * N_IN, 0, 1, N_IN, D, N_IN, WinT + (size_t)l * N_INP * D, 0, RmWin{}, ldsf, tid, bid, G);
            for (int t = bid; t < (D / 64) * (D / 256); t += G)
                convert_tile_v4(p.in[I_WO] + (size_t)l * D * D, D, D, (t / (D / 256)) * 64, (t % (D / 256)) * 256, WoT + (size_t)l * D * D, RmIdent{}, ldsf, tid);
            convert_mats(p.in[I_WA] + (size_t)l * 6 * 128 * 128, (size_t)128 * 128, 6, 128, 128, 128, WaiT + (size_t)l * 6 * 256 * 128, (size_t)256 * 128, RmIdent{}, ldsf, tid, bid, G);
            convert_mats(p.in[I_WI] + (size_t)l * 6 * 128 * 128, (size_t)128 * 128, 6, 128, 128, 128, WaiT + (size_t)l * 6 * 256 * 128, (size_t)256 * 128, RmOff{128}, ldsf, tid, bid, G);
        }
        for (int i = gtid; i < DEPTH * 8 * D; i += gthreads) { const int k = i % D, h = (i / D) % 8, l = i / (8 * D);
            Wfa[i] = (h < 6) ? p.in[I_WIN][(size_t)l * D * N_IN + (size_t)k * N_IN + C_FA + h] : 0.f; }
        for (int i = gtid; i < DEPTH * 48 * D; i += gthreads) { const int k = i % D, o = (i / D) % 48, l = i / (48 * D);
            const float w = (o < 4) ? p.in[I_WGRP][((size_t)l * D + k) * 4 + o] : (o < 36 ? p.in[I_WRT][((size_t)l * D + k) * 32 + (o - 4)] : 0.f);
            const bf16_t hi = f2bf(w);
            W36b[((size_t)l * 2 + 0) * 48 * D + (size_t)o * D + k] = hi; W36b[((size_t)l * 2 + 1) * 48 * D + (size_t)o * D + k] = f2bf(w - bf2f(hi)); }
        for (int i = gtid; i < S * 8; i += gthreads) { const int d = i & 7, t = i >> 3; const float ang = (float)positions[t] * p.inv_freq[d];
            ropecs[t * 16 + d] = cosf(ang); ropecs[t * 16 + 8 + d] = sinf(ang); }
        __syncthreads();
        for (int i = tid; i < 6 * D; i += NTHREADS) { const int k = i % D, h = i / D; ldsf[i] = p.in[I_WIN][(size_t)k * N_IN + C_FA + h]; }
        __syncthreads();
        for (int t0 = gwave * 2; t0 < S; t0 += gwaves * 2) {
            f32x4 v[2][8];
#pragma unroll
            for (int tk = 0; tk < 2; ++tk)
#pragma unroll
                for (int j = 0; j < 8; ++j) v[tk][j] = *(const f32x4*)(p.in[I_X] + (size_t)(t0 + tk) * D + j * 256 + lane * 4);
#pragma unroll
            for (int tk = 0; tk < 2; ++tk) {
                const int t = t0 + tk;
                float fa[6] = {0.f, 0.f, 0.f, 0.f, 0.f, 0.f};
#pragma unroll
                for (int j = 0; j < 8; ++j) {
                    const int c = j * 256 + lane * 4;
                    u32x2 o; o.x = pack2(v[tk][j][0], v[tk][j][1]); o.y = pack2(v[tk][j][2], v[tk][j][3]);
                    *(u32x2*)(xb + (size_t)t * D + c) = o;
#pragma unroll
                    for (int h = 0; h < 6; ++h) { const f32x4 w = *(const f32x4*)(ldsf + h * D + c); fa[h] += v[tk][j][0] * w[0] + v[tk][j][1] * w[1] + v[tk][j][2] * w[2] + v[tk][j][3] * w[3]; }
                    COMPILER_FENCE();
                }
#pragma unroll
                for (int h = 0; h < 6; ++h) { const float sm = wave_sum(fa[h]); if (lane == 0) logf_[h * S + t] = log_sigmoid_f(sm + p.in[I_BF][h]); }
            }
        }
        PH_BAR(0);
    }

    for (int l = 0; l < DEPTH; ++l) {
        const int pb = 1 + l * NPH;
#define hin ((l == 0) ? p.in[I_X] : (const float*)hb)
#define hout ((l == DEPTH - 1) ? p.out : hb)
#define workctr ((int*)(wsl + CTL_WORK_OFF) + l * 64)

        if (PH_SEL(0) && PH_IN(pb + 0)) {
            PHASE_IDS();
            int bz = RFL(bid); OPAQUE_S(bz);
            if (bz == 0) {
                double* part = (double*)lds_raw;
                const int per = S / 64;
                double s = 0.0;
                if (wave < 6) { for (int i = 0; i < per; ++i) s += (double)logf_[wave * S + lane * per + i]; part[wave * 64 + lane] = s; }
                __syncthreads();
                if (wave < 6) {
                    double run = 0.0;
                    for (int j = 0; j < lane; ++j) run += part[wave * 64 + j];
                    for (int i = 0; i < per; ++i) { run += (double)logf_[wave * S + lane * per + i]; cum2[wave * S + lane * per + i] = (float)(run * (double)LOG2E); }
                }
                __syncthreads();
            }
            bool conv_more = (l == 0);
#define CONV_ONE() do { if (conv_more) { __syncthreads(); if (tid == 0) *ubox = (unsigned)atomic_add_int((int*)(wsl + CTL_WORK_OFF) + 62, 1); __syncthreads(); \
                const int cid_ = RFL((int)*ubox); if (cid_ < NCONV) moe_conv_chunk(p, cid_, WguT, WdT, ldsf, tid); else conv_more = false; } } while (0)
            unsigned* cls = (unsigned*)(wsl + CTL_CLS_OFF) + l * 256;
            if (bz == 0) { WAIT_VM0(); __syncthreads(); if (tid == 0) { FENCE_REL_AGENT(); WAIT_VM0(); (void)xb_add(&cls[192], 1u); } }
            const bf16_t* Bt = WinT + (size_t)l * N_INP * D;
            constexpr int ntm = S / 256;
            const unsigned nooff[2][2] = {{0u, 0u}, {0u, 0u}};
            for (int i = 0; i < (bid & 3); ++i) CONV_ONE();
            for (;;) {
                __syncthreads();
                if (tid == 0) *ubox = (unsigned)atomic_add_int(workctr + 9, 1);
                __syncthreads();
                int t = RFL((int)*ubox);
                if (t >= ntm * 21) break;
                int pm, pn, kcls;
                if (t < ntm * 6) { pm = t / 6; pn = 15 + t % 6; kcls = 0; }
                else if (t < ntm * 12) { t -= ntm * 6; pm = t / 6; pn = 9 + t % 6; kcls = 1; }
                else { t -= ntm * 12; pm = t / 9; pn = t % 9; kcls = 2; }
                f32x4 acc[2][2][4][2];
                gemm_tile<false>(xb, pm * 256, nooff, Bt, pn * 256, D, lds_raw, acc, tid);
                int et = tid; OPAQUE(et); const int wr = et >> 8, wc = (et >> 6) & 3, fr = et & 15, fq = (et >> 4) & 3;
                if (pn < 6 || (pn >= 9 && pn < 19)) {
                    bf16_t* dst; float scale = 1.f; bool rope = false;
                    if (pn < 3) { dst = Qa; scale = QSCALE_A; } else if (pn < 6) { dst = Ka; } else if (pn < 12) { dst = Xr; } else if (pn < 15) { dst = Gr; }
                    else if (pn < 17) { dst = Qc; scale = QSCALE_C; rope = true; } else { dst = Kc; rope = true; }
                    const bool headmajor = (pn < 6) || (pn >= 15);
                    const int segpn = (pn < 3) ? pn : (pn < 6) ? pn - 3 : (pn < 12) ? pn - 9 : (pn < 15) ? pn - 12 : (pn < 17) ? pn - 15 : pn - 17;
#pragma unroll
                    for (int ai = 0; ai < 2; ++ai)
#pragma unroll
                        for (int m = 0; m < 4; ++m)
#pragma unroll
                            for (int bj = 0; bj < 2; ++bj)
#pragma unroll
                                for (int n = 0; n < 2; ++n) {
                                    const int dd = wc * 32 + n * 16 + fr;
                                    float vv[4];
#pragma unroll
                                    for (int j = 0; j < 4; ++j) {
                                        const int row = pm * 256 + ai * 128 + wr * 64 + m * 16 + fq * 4 + j;
                                        float v = acc[ai][bj][m][n][j];
                                        if (rope && n == 0 && (wc & 1) == 0) {
                                            const float pv = SHX(v, 8);
                                            const float cs = ropecs[row * 16 + (fr & 7)], sn = ropecs[row * 16 + 8 + (fr & 7)];
                                            v = (fr < 8) ? (v * cs - pv * sn) : (v * cs + pv * sn);
                                        }
                                        vv[j] = v * scale;
                                    }
                                    stage4_bf16_pairs(lds_raw + (ai * 128 + wr * 64 + m * 16 + fq * 4) * 528 + (bj * 128 + dd) * 2, 528, vv[0], vv[1], vv[2], vv[3], fr);
                                }
                    __syncthreads();
#pragma unroll 4
                    for (int i = 0; i < 16; ++i) {
                        const int idx = et + i * 512, lrow = idx >> 5, ch = idx & 31, row = pm * 256 + lrow;
                        const u32x4 val = *(const u32x4*)(lds_raw + lrow * 528 + ch * 16);
                        size_t gi;
                        if (headmajor) gi = ((size_t)(segpn * 2 + (ch >> 4)) * S + row) * 128 + (ch & 15) * 8;
                        else gi = (size_t)row * LRU_W + segpn * 256 + ch * 8;
                        *(u32x4*)(dst + gi) = val;
                    }
                    __syncthreads();
                    if (pn >= 15) {
                        float* part = ldsf;
#pragma unroll
                        for (int ai = 0; ai < 2; ++ai)
#pragma unroll
                            for (int m = 0; m < 4; ++m)
#pragma unroll
                                for (int bj = 0; bj < 2; ++bj)
#pragma unroll
                                    for (int j = 0; j < 4; ++j) {
                                        float ss = acc[ai][bj][m][0][j] * acc[ai][bj][m][0][j] + acc[ai][bj][m][1][j] * acc[ai][bj][m][1][j];
                                        ss += SHX(ss, 1); ss += SHX(ss, 2); ss += SHX(ss, 4); ss += SHX(ss, 8);
                                        if (fr == 0) part[(wc * 2 + bj) * 256 + ai * 128 + wr * 64 + m * 16 + fq * 4 + j] = ss;
                                    }
                        __syncthreads();
                        {
                            const int bj = et >> 8, row = et & 255;
                            float v0 = part[(0 * 2 + bj) * 256 + row] + part[(1 * 2 + bj) * 256 + row], v1 = part[(2 * 2 + bj) * 256 + row] + part[(3 * 2 + bj) * 256 + row];
                            v0 = fmaxf(v0, SHX(v0, 1)); v0 = fmaxf(v0, SHX(v0, 2)); v0 = fmaxf(v0, SHX(v0, 4)); v0 = fmaxf(v0, SHX(v0, 8)); v0 = xrow16_max(v0);
                            v1 = fmaxf(v1, SHX(v1, 1)); v1 = fmaxf(v1, SHX(v1, 2)); v1 = fmaxf(v1, SHX(v1, 4)); v1 = fmaxf(v1, SHX(v1, 8)); v1 = xrow16_max(v1);
                            if ((et & 63) == 0) {
                                unsigned* q2p = (unsigned*)(wsl + CTL_QK2_OFF) + l * 16 + (pn >= 17 ? 8 : 0) + (segpn * 2 + bj) * 2;
                                atomic_max_u32(q2p, __builtin_bit_cast(unsigned, v0)); atomic_max_u32(q2p + 1, __builtin_bit_cast(unsigned, v1));
                            }
                        }
                        __syncthreads();
                    }
                    if (pn >= 3 && pn < 6) {
                        float* part = ldsf;
#pragma unroll
                        for (int ai = 0; ai < 2; ++ai)
#pragma unroll
                            for (int m = 0; m < 4; ++m)
#pragma unroll
                                for (int bj = 0; bj < 2; ++bj)
#pragma unroll
                                    for (int j = 0; j < 4; ++j) {
                                        float ss = acc[ai][bj][m][0][j] * acc[ai][bj][m][0][j] + acc[ai][bj][m][1][j] * acc[ai][bj][m][1][j];
                                        ss += SHX(ss, 1); ss += SHX(ss, 2); ss += SHX(ss, 4); ss += SHX(ss, 8);
                                        if (fr == 0) part[(wc * 2 + bj) * 256 + ai * 128 + wr * 64 + m * 16 + fq * 4 + j] = ss;
                                    }
                        __syncthreads();
                        {
                            const int bj = et >> 8, row = et & 255;
                            float v = part[(0 * 2 + bj) * 256 + row] + part[(1 * 2 + bj) * 256 + row] + part[(2 * 2 + bj) * 256 + row] + part[(3 * 2 + bj) * 256 + row];
                            v = fmaxf(v, SHX(v, 1)); v = fmaxf(v, SHX(v, 2)); v = fmaxf(v, SHX(v, 4)); v = fmaxf(v, SHX(v, 8)); v = xrow16_max(v);
                            if ((et & 63) == 0) kmax2[((pn - 3) * 2 + bj) * NKT + pm * 4 + ((et >> 6) & 3)] = v;
                        }
                        __syncthreads();
                    }
                } else {
                    bf16_t* dst = (pn < 9) ? VaT : VcT;
                    const int segpn = (pn < 9) ? pn - 6 : pn - 19;
#pragma unroll
                    for (int ai = 0; ai < 2; ++ai)
#pragma unroll
                        for (int m = 0; m < 4; ++m)
#pragma unroll
                            for (int bj = 0; bj < 2; ++bj)
#pragma unroll
                                for (int n = 0; n < 2; ++n) {
                                    const int dd = wc * 32 + n * 16 + fr;
                                    const f32x4 a = acc[ai][bj][m][n];
                                    u32x2 o; o.x = pack2(a[0], a[1]); o.y = pack2(a[2], a[3]);
                                    const int s6 = m * 16 + fq * 4, pos = (s6 & 32) + ((s6 >> 2) & 3) * 8 + ((s6 >> 4) & 1) * 4;
                                    *(u32x2*)(lds_raw + ((bj * 4 + ai * 2 + wr) * 128 + dd) * 128 + ((((pos >> 3) ^ (dd & 7))) << 4) + (pos & 7) * 2) = o;
                                }
                    __syncthreads();
#pragma unroll 4
                    for (int i = 0; i < 16; ++i) {
                        const int idx = et + i * 512, blk = idx >> 10, dd = (idx >> 3) & 127, c = idx & 7;
                        const u32x4 val = *(const u32x4*)(lds_raw + (blk * 128 + dd) * 128 + ((c ^ (dd & 7)) << 4));
                        *(u32x4*)(dst + (((size_t)(segpn * 2 + (blk >> 2)) * NKT + (pm * 4 + (blk & 3))) * 128 + dd) * 64 + c * 8) = val;
                    }
                    __syncthreads();
                }
                WAIT_VM0();
                __syncthreads();
                if (et == 0) { FENCE_REL_AGENT(); WAIT_VM0(); (void)xb_add(&cls[kcls * 64], 1u); }
                CONV_ONE();
            }
        }

        if (PH_SEL(1) && PH_IN(pb + 1)) {
            PHASE_IDS();
            const float lam_init = (l == 0) ? 0.2f : 0.35550906759f;
            const float s1 = wave_sum(p.in[I_LQ1][l * 64 + lane] * p.in[I_LK1][l * 64 + lane]);
            const float s2 = wave_sum(p.in[I_LQ2][l * 64 + lane] * p.in[I_LK2][l * 64 + lane]);
            const float lam = fexp(s1) - fexp(s2) + lam_init;
            constexpr int NLRU = NKT * 6, NQB = S / 128;
            bool conv_more = (l == 0);
            unsigned* cls = (unsigned*)(wsl + CTL_CLS_OFF) + l * 256;
            unsigned* bw = (unsigned*)wsl;
#define WAIT_CLASS(k, n) do { __syncthreads(); if (tid == 0) { XB_SPIN(xb_ld(&cls[(k) * 64]) < (unsigned)(n), bw); FENCE_ACQ_AGENT(); WAIT_VM0(); } __syncthreads(); } while (0)
#ifndef NO_DIFF
            {
                constexpr int NQB2 = S / 256;
                int total = 0;
                for (int q = 0; q < NQB2; ++q) total += ((4 * q + 4 + DCH - 1) / DCH) * 8;
                WAIT_CLASS(0, (S / 256) * 6);
                for (;;) {
                    __syncthreads();
                    if (tid == 0) *ubox = (unsigned)atomic_add_int(workctr, 1);
                    __syncthreads();
                    int u = RFL((int)*ubox);
                    if (u >= total) break;
                    int qb = NQB2 - 1;
                    for (;; --qb) { const int nu = ((4 * qb + 4 + DCH - 1) / DCH) * 8; if (u < nu) break; u -= nu; }
                    const int c = u >> 3, h = (u >> 1) & 3, mp = u & 1;
                    const int t0 = c * DCH, t1 = (t0 + DCH < 4 * qb + 4) ? t0 + DCH : 4 * qb + 4;
                    const unsigned* q2p = (const unsigned*)(wsl + CTL_QK2_OFF) + l * 16;
                    const float bnd = sqrtf(__builtin_bit_cast(float, q2p[h * 2 + mp]) * __builtin_bit_cast(float, q2p[8 + h * 2 + mp])) * (QSCALE_C * 1.02f) + 0.01f;
                    attn_dmap_unit(Qc + (size_t)h * S * 128, Kc + (size_t)h * S * 128, VcT + (size_t)h * S * 128, mp, qb, t0, t1,
                                   dpo + (size_t)(h * 2 + mp) * DPART_ROWS * 128, dpml + (size_t)(h * 2 + mp) * DPART_ROWS * 2, c, RFL_F(bnd), lds_raw, tid);
                    CONV_ONE();
                }
            }
#endif
#ifndef NO_LRU
            WAIT_CLASS(1, (S / 256) * 6);
            for (;;) {
                __syncthreads();
                if (tid == 0) *ubox = (unsigned)atomic_add_int(workctr + 10, 1);
                __syncthreads();
                const int u = RFL((int)*ubox);
                if (u >= NLRU) break;
                lru_unit_a(u / 6, u % 6, l, p, Xr, WaiT + (size_t)l * 6 * 256 * 128, hloc, ploc, sumA, sumH, lds_raw, tid);
            }
#endif
#ifndef NO_FOX
            WAIT_CLASS(2, (S / 256) * 9);
            WAIT_CLASS(3, 1);
            for (;;) {
                __syncthreads();
                if (tid == 0) *ubox = (unsigned)atomic_add_int(workctr + 1, 1);
                __syncthreads();
                const int u = RFL((int)*ubox);
                if (u >= NQB * FOX_H) break;
                const int qb = NQB - 1 - u / FOX_H, h = u % FOX_H;
                attn_unit<0>(Qa + (size_t)h * S * 128, Ka + (size_t)h * S * 128, VaT + (size_t)h * S * 128, cum2 + (size_t)h * S, kmax2 + h * NKT, qb, concat, h * 128,
                             0.f, 0.f, nullptr, lds_raw, tid);
            }
#endif
            while (conv_more) CONV_ONE();
            PH_BAR(pb + 1);
        }

        if (PH_SEL(2) && PH_IN(pb + 2)) for (int rep = 0; rep < PH_REPS(2); ++rep) {
            PHASE_IDS();
            {
                const int per = (NKT * 6 + G - 1) / G;
                const int c = tid & 127, tq = tid >> 7;
                float cr = 0.f; int pgrp = -1;
                for (int u = bid * per; u < (bid + 1) * per && u < NKT * 6; ++u) {
                    const int grp = u / NKT, chunk = u % NKT, ch = grp * 128 + c;
                    if (grp != pgrp) {
                        pgrp = grp;
                        const int seg = (chunk + 3) >> 2, j0 = tq * seg, j1 = (j0 + seg < chunk) ? j0 + seg : chunk;
                        float pa = 1.f, ph = 0.f;
                        int j = j0;
                        for (; j + 16 <= j1; j += 16) {
                            float a8[16], h8[16];
#pragma unroll
                            for (int q = 0; q < 16; ++q) { a8[q] = sumA[(size_t)(j + q) * LRU_W + ch]; h8[q] = sumH[(size_t)(j + q) * LRU_W + ch]; }
#pragma unroll
                            for (int q = 0; q < 16; ++q) { pa *= a8[q]; ph = a8[q] * ph + h8[q]; }
                        }
                        for (; j < j1; ++j) { const float a = sumA[(size_t)j * LRU_W + ch]; pa *= a; ph = a * ph + sumH[(size_t)j * LRU_W + ch]; }
                        __syncthreads();
                        ldsf[(tq * 128 + c) * 2] = pa; ldsf[(tq * 128 + c) * 2 + 1] = ph;
                        __syncthreads();
                        cr = 0.f;
#pragma unroll
                        for (int s = 0; s < 4; ++s) cr = ldsf[(s * 128 + c) * 2] * cr + ldsf[(s * 128 + c) * 2 + 1];
                    }
                    float hl[16], pl[16]; bf16_t gg[16];
#pragma unroll
                    for (int i = 0; i < 16; ++i) { const size_t gi = (size_t)(chunk * 64 + tq * 16 + i) * LRU_W + ch; const unsigned hp = ((const unsigned*)hloc)[gi]; hl[i] = bf2f((bf16_t)(hp & 0xffffu)); pl[i] = bf2f((bf16_t)(hp >> 16)); gg[i] = Gr[gi]; }
                    const float an = sumA[(size_t)chunk * LRU_W + ch], hn = sumH[(size_t)chunk * LRU_W + ch];
#pragma unroll
                    for (int i = 0; i < 16; ++i)
                        concat[(size_t)(chunk * 64 + tq * 16 + i) * D + FOX_W + ch] = f2bf(gelu_tanh_f(bf2f(gg[i])) * (hl[i] + pl[i] * cr));
                    cr = an * cr + hn;
                }
            }
            {
                const float lam_init = (l == 0) ? 0.2f : 0.35550906759f;
                const float s1 = wave_sum(p.in[I_LQ1][l * 64 + lane] * p.in[I_LK1][l * 64 + lane]);
                const float s2 = wave_sum(p.in[I_LQ2][l * 64 + lane] * p.in[I_LK2][l * 64 + lane]);
                const float lam = fexp(s1) - fexp(s2) + lam_init;
                const float* sg = p.in[I_SUBG] + l * 128;
                const float g0 = sg[2 * lane], g1 = sg[2 * lane + 1];
                static_assert(NCH <= 8, "the merge below keeps one (map, chunk) pair per lane: 2 x 8 lanes");
                for (int q = gwave; q < S; q += gwaves) {
                    const int nch = (q >> 6) / DCH + 1;
                    float mv = -INFINITY, lv = 0.f;
                    { const int c = lane & 7, hm = lane >> 3;
                      if (c < nch) { const float* ML = dpml + ((size_t)hm * DPART_ROWS + dpart_row(c, q)) * 2; mv = ML[0]; lv = ML[1]; } }
                    unsigned pk[4][2][NCH];
#pragma unroll
                    for (int h = 0; h < 4; ++h)
#pragma unroll
                        for (int mp = 0; mp < 2; ++mp) {
                            const unsigned* OP = (const unsigned*)(dpo + (size_t)(h * 2 + mp) * DPART_ROWS * 128);
#pragma unroll
                            for (int c = 0; c < NCH; ++c) pk[h][mp][c] = (c < nch) ? OP[(size_t)dpart_row(c, q) * 64 + lane] : 0u;
                        }
                    float Mx = mv; Mx = fmaxf(Mx, DPP_X1(Mx)); Mx = fmaxf(Mx, DPP_X2(Mx)); Mx = fmaxf(Mx, DPP_X7(Mx));
                    const float wv = (mv == -INFINITY) ? 0.f : FAST_EXP2(mv - Mx);
                    float Lp = lv * wv; Lp += DPP_X1(Lp); Lp += DPP_X2(Lp); Lp += DPP_X7(Lp);
#pragma unroll
                    for (int h = 0; h < 4; ++h) {
                        float om[2][2];
#pragma unroll
                        for (int mp = 0; mp < 2; ++mp) {
                            float o0 = 0.f, o1 = 0.f;
#pragma unroll
                            for (int c = 0; c < NCH; ++c) { const float w = RDLANE(wv, (h * 2 + mp) * 8 + c); o0 += bf2f((bf16_t)(pk[h][mp][c] & 0xffffu)) * w; o1 += bf2f((bf16_t)(pk[h][mp][c] >> 16)) * w; }
                            const float il = 1.f / RDLANE(Lp, (h * 2 + mp) * 8);
                            om[mp][0] = o0 * il; om[mp][1] = o1 * il;
                        }
                        const float v0 = om[0][0] - lam * om[1][0], v1 = om[0][1] - lam * om[1][1];
                        const float ss = wave_sum(v0 * v0 + v1 * v1);
                        const float rs = (1.f - lam_init) / sqrtf(ss * (1.f / 128.f) + LN_EPS);
                        *(unsigned*)(concat + (size_t)q * D + 1536 + h * 128 + 2 * lane) = pack2(v0 * rs * g0, v1 * rs * g1);
                    }
                }
            }
            PH_BAR(pb + 2);
        }

        if (PH_SEL(3) && PH_IN(pb + 3)) {
            PHASE_IDS();
            const bf16_t* Bt = WoT + (size_t)l * D * D;
            constexpr int ntn = D / 256, ntm = S / 256;
            static_assert(ntn == 8, "the panel exchange is written for 8 column tiles");
            const unsigned nooff[2][2] = {{0u, 0u}, {0u, 0u}};
            const float* g1 = p.in[I_LN1G] + (size_t)l * D; const float* b1 = p.in[I_LN1B] + (size_t)l * D;
            const float* bg = p.in[I_BGRP] + l * 4; const float* br = p.in[I_BRT] + l * 32;
            const bf16_t* Wb = W36b + (size_t)l * 2 * 48 * D;
            int* lcnt = (int*)(lds_raw + LDS_MISC + M_LCNT);
            const int segcap = ((ntm * ntn + G - 1) / G) * 32;
            unsigned* pcnt = (unsigned*)(wsl + CTL_PAN_OFF) + l * 1024;
            unsigned long long* xbuf = (unsigned long long*)(wsl + A_XBUF);
            unsigned* part = (unsigned*)(wsl + A_PART);
            LAS float* Stab = (LAS float*)(lds_raw + LDS_MISC + M_RTOK);
            float* lgt = (float*)(lds_raw + LDS_MISC + 4096);
            if (tid < 32) lcnt[tid] = 0;
            __syncthreads();
            for (int t0 = bid; t0 < ntm * ntn; t0 += G) {
                int t = t0;
                if (G == 256 && ntm * ntn == 256) { const int x = t0 & 7, j = t0 >> 3; t = (x * 4 + (j >> 3)) * ntn + (j & 7); }
                const int pm = t / ntn, pn = t % ntn;
                f32x4 v[2][16];
                {
                    f32x4 acc[2][2][4][2];
                    gemm_tile<false>(concat, pm * 256, nooff, Bt, pn * 256, D, lds_raw, acc, tid);
                    int et = tid; OPAQUE(et); const int wr = et >> 8, wc = (et >> 6) & 3, fr = et & 15, fq = (et >> 4) & 3;
#pragma unroll
                    for (int ai = 0; ai < 2; ++ai) {
#pragma unroll
                        for (int m = 0; m < 4; ++m)
#pragma unroll
                            for (int bj = 0; bj < 2; ++bj)
#pragma unroll
                                for (int n = 0; n < 2; ++n)
#pragma unroll
                                    for (int j = 0; j < 4; ++j)
                                        *(float*)(lds_raw + (wr * 64 + m * 16 + fq * 4 + j) * 1040 + (bj * 128 + wc * 32 + n * 16 + fr) * 4) = acc[ai][bj][m][n][j];
                        __syncthreads();
#pragma unroll
                        for (int i = 0; i < 16; ++i) {
                            const int lrow = i * 8 + (et >> 6), c4 = et & 63;
                            const size_t gi = (size_t)(pm * 256 + ai * 128 + lrow) * D + pn * 256 + c4 * 4;
                            v[ai][i] = *(const GAS f32x4*)(hin + gi);
                        }
#pragma unroll
                        for (int i = 0; i < 16; ++i) {
                            const int lrow = i * 8 + (et >> 6), c4 = et & 63;
                            v[ai][i] = ALPHA * v[ai][i] + *(const f32x4*)(lds_raw + lrow * 1040 + c4 * 16);
                        }
                        __syncthreads();
                    }
                }
                int et2 = tid; OPAQUE(et2); const int el = et2 & 63, ew = wave_s, er16 = et2 & 15, eq4 = (et2 >> 4) & 3;
#pragma unroll
                for (int q = 0; q < 6; ++q) {
                    const int seg = ew * 6 + q, n2 = seg * 2 + (el >> 5), p5 = el & 31;
                    GLDS16(Wb + (size_t)n2 * D + pn * 256 + ((p5 ^ (n2 & 15)) << 3), lds_raw + 65536 + seg * 1024 + el * 16);
                }
                float my_mt = 0.f, my_m2 = 0.f;
                for (int trep = 0; trep < REP_STATS; ++trep)
#pragma unroll
                for (int ai = 0; ai < 2; ++ai)
#pragma unroll
                    for (int i4 = 0; i4 < 16; i4 += 4) {
                        float mt4[4], m24[4];
#pragma unroll
                        for (int u = 0; u < 4; ++u) { const f32x4 x = v[ai][i4 + u]; mt4[u] = wave_sum((x[0] + x[1]) + (x[2] + x[3])) * (1.f / 256.f); }
#pragma unroll
                        for (int u = 0; u < 4; ++u) { const f32x4 d = v[ai][i4 + u] - mt4[u]; m24[u] = wave_sum((d[0] * d[0] + d[1] * d[1]) + (d[2] * d[2] + d[3] * d[3])); }
#pragma unroll
                        for (int u = 0; u < 4; ++u) if (el == ai * 16 + i4 + u) { my_mt = mt4[u]; my_m2 = m24[u]; }
                        COMPILER_FENCE();
                    }
                unsigned* bw = (unsigned*)wsl;
                if (el < 32) {
                    const int grow = (el >> 4) * 128 + (el & 15) * 8 + ew;
                    xst64(&xbuf[(size_t)(pm * 256 + grow) * 8 + pn], ((unsigned long long)__builtin_bit_cast(unsigned, my_m2) << 32) | __builtin_bit_cast(unsigned, my_mt));
                }
                WAIT_VM0();
                __syncthreads();
                if (et2 == 0) { (void)xb_add(&pcnt[pm * 16], 1u); XB_SPIN(xb_ld(&pcnt[pm * 16]) < 8u, bw); FENCE_ACQ_AGENT(); }
                __syncthreads();
                unsigned long long wk[4];
#pragma unroll
                for (int k = 0; k < 4; ++k) {
                    const int r = k * 8 + (el >> 3), grow = (r >> 4) * 128 + (r & 15) * 8 + ew;
                    wk[k] = xld64(&xbuf[(size_t)(pm * 256 + grow) * 8 + (el & 7)]);
                }
#pragma unroll
                for (int k = 0; k < 4; ++k) {
                    const int r = k * 8 + (el >> 3);
                    const unsigned long long w = wk[k];
                    const float mt = __builtin_bit_cast(float, (unsigned)w), m2 = __builtin_bit_cast(float, (unsigned)(w >> 32));
                    float ms = mt; ms += DPP_X1(ms); ms += DPP_X2(ms); ms += DPP_X7(ms);
                    const float mean = ms * 0.125f, dm = mt - mean;
                    float q = m2 + 256.f * dm * dm; q += DPP_X1(q); q += DPP_X2(q); q += DPP_X7(q);
                    const float rstd = 1.f / sqrtf(q * (1.f / D) + LN_EPS);
                    if ((el & 7) == 0) { Stab[(ew * 32 + r) * 2] = mean; Stab[(ew * 32 + r) * 2 + 1] = rstd; }
                }
                WAVE_SYNC();
                const f32x4 gv = *(const f32x4*)(g1 + pn * 256 + el * 4), bv = *(const f32x4*)(b1 + pn * 256 + el * 4);
                LAS unsigned char* wt = (LAS unsigned char*)lds_raw + ew * 8192;
                const LAS unsigned char* wbl = (const LAS unsigned char*)lds_raw + 65536;
                for (int rrep = 0; rrep < REP_ROUTER; ++rrep)
#pragma unroll
                for (int ai = 0; ai < 2; ++ai) {
                    u32x2 lokeep[16];
#pragma unroll
                    for (int i = 0; i < 16; ++i) {
                        const float mean = Stab[(ew * 32 + ai * 16 + i) * 2], rstd = Stab[(ew * 32 + ai * 16 + i) * 2 + 1];
                        const f32x4 hv = mul_s4(v[ai][i] - mean, rstd) * gv + bv;
                        u32x2 o; o.x = pack2(hv[0], hv[1]); o.y = pack2(hv[2], hv[3]);
                        lokeep[i].x = pack2(hv[0] - bf2f((bf16_t)(o.x & 0xffffu)), hv[1] - bf2f((bf16_t)(o.x >> 16)));
                        lokeep[i].y = pack2(hv[2] - bf2f((bf16_t)(o.y & 0xffffu)), hv[3] - bf2f((bf16_t)(o.y >> 16)));
                        *(LAS u32x2*)(wt + i * 512 + (((el >> 1) ^ i) << 4) + (el & 1) * 8) = o;
                        COMPILER_FENCE();
                    }
                    WAVE_SYNC();
                    f32x4 ac[3];
#pragma unroll
                    for (int nt = 0; nt < 3; ++nt) ac[nt] = (f32x4){0.f, 0.f, 0.f, 0.f};
#pragma unroll 2
                    for (int ks = 0; ks < 8; ++ks) {
                        const int co = ((ks * 4 + eq4) ^ er16) << 4;
                        const bf16x8 ah = *(const LAS bf16x8*)(wt + er16 * 512 + co);
#pragma unroll
                        for (int nt = 0; nt < 3; ++nt) {
                            const bf16x8 bh = *(const LAS bf16x8*)(wbl + (nt * 16 + er16) * 512 + co);
                            const bf16x8 bl = *(const LAS bf16x8*)(wbl + (48 + nt * 16 + er16) * 512 + co);
                            ac[nt] = MFMA16(ah, bh, ac[nt]); ac[nt] = MFMA16(ah, bl, ac[nt]);
                        }
                    }
                    WAVE_SYNC();
#pragma unroll
                    for (int i = 0; i < 16; ++i) *(LAS u32x2*)(wt + i * 512 + (((el >> 1) ^ i) << 4) + (el & 1) * 8) = lokeep[i];
                    WAVE_SYNC();
#pragma unroll 2
                    for (int ks = 0; ks < 8; ++ks) {
                        const int co = ((ks * 4 + eq4) ^ er16) << 4;
                        const bf16x8 al = *(const LAS bf16x8*)(wt + er16 * 512 + co);
#pragma unroll
                        for (int nt = 0; nt < 3; ++nt) {
                            const bf16x8 bh = *(const LAS bf16x8*)(wbl + (nt * 16 + er16) * 512 + co);
                            ac[nt] = MFMA16(al, bh, ac[nt]);
                        }
                    }
#pragma unroll
                    for (int nt = 0; nt < 3; ++nt)
#pragma unroll
                        for (int j = 0; j < 4; ++j) {
                            const float cv = ac[nt][j];
                            xst32(&part[((size_t)pn * S + pm * 256 + ai * 128 + (eq4 * 4 + j) * 8 + ew) * 48 + nt * 16 + er16], __builtin_bit_cast(unsigned, cv));
                        }
                    WAVE_SYNC();
                }
                WAIT_VM0();
                __syncthreads();
                if (et2 == 0) (void)xb_add(&pcnt[512 + pm * 16], 1u);
                for (int srep = 0; srep < REP_STORES; ++srep)
#pragma unroll
                for (int ai = 0; ai < 2; ++ai)
#pragma unroll
                    for (int i = 0; i < 16; ++i) {
                        const float mean = Stab[(ew * 32 + ai * 16 + i) * 2], rstd = Stab[(ew * 32 + ai * 16 + i) * 2 + 1];
                        const f32x4 hv = mul_s4(v[ai][i] - mean, rstd) * gv + bv;
                        const size_t gi = (size_t)(pm * 256 + ai * 128 + i * 8 + ew) * D + pn * 256 + el * 4;
                        u32x2 o; o.x = pack2(hv[0], hv[1]); o.y = pack2(hv[2], hv[3]);
                        *(u32x2*)(h1b + gi) = o;
                        COMPILER_FENCE();
                    }
                if (et2 == 0) { XB_SPIN(xb_ld(&pcnt[512 + pm * 16]) < 8u, bw); FENCE_ACQ_AGENT(); }
                __syncthreads();
                int rt = tid; OPAQUE(rt);
#pragma unroll
                for (int k = 0; k < 3; ++k) {
                    const int idx = rt + k * 512, tk = idx / 48, n = idx - tk * 48;
                    unsigned pq[8];
#pragma unroll
                    for (int q = 0; q < 8; ++q) pq[q] = xb_ld(&part[((size_t)q * S + pm * 256 + pn * 32 + tk) * 48 + n]);
                    float a = 0.f;
#pragma unroll
                    for (int q = 0; q < 8; ++q) a += __builtin_bit_cast(float, pq[q]);
                    lgt[idx] = a;
                }
                __syncthreads();
                if (rt < 32) {
                    const int t = pm * 256 + pn * 32 + rt; const float* L = lgt + rt * 48;
                    float gl[4];
#pragma unroll
                    for (int q = 0; q < 4; ++q) gl[q] = L[q] + bg[q];
                    int gi = 0; float gm = gl[0];
#pragma unroll
                    for (int q = 1; q < 4; ++q) if (gl[q] > gm) { gm = gl[q]; gi = q; }
                    float gs = 0.f;
#pragma unroll
                    for (int q = 0; q < 4; ++q) gs += fexp(gl[q] - gm);
                    const float gweight = 1.f / gs;
                    float E[8];
#pragma unroll
                    for (int e = 0; e < 8; ++e) E[e] = L[4 + gi * 8 + e] + br[gi * 8 + e];
                    int e1 = 0; float m1 = E[0];
#pragma unroll
                    for (int e = 1; e < 8; ++e) if (E[e] > m1) { m1 = E[e]; e1 = e; }
                    int e2 = -1; float m2 = -INFINITY;
#pragma unroll
                    for (int e = 0; e < 8; ++e) if (e != e1 && E[e] > m2) { m2 = E[e]; e2 = e; }
                    const float p2 = fexp(m2 - m1), w1 = 1.f / (1.f + p2), w2 = p2 / (1.f + p2);
                    const int ge1 = gi * 8 + e1, ge2 = gi * 8 + e2;
                    const int i1 = (ge1 * G + bid) * segcap + atomic_add_int(&lcnt[ge1], 1);
                    ltok[i1] = t; lw[i1] = gweight * w1; lslot[i1] = 0;
                    const int i2 = (ge2 * G + bid) * segcap + atomic_add_int(&lcnt[ge2], 1);
                    ltok[i2] = t; lw[i2] = gweight * w2; lslot[i2] = 1;
                }
                __syncthreads();
            }
            { int ft = tid; OPAQUE(ft); if (ft < 32) cntb[bid * 32 + ft] = lcnt[ft]; }
            PH_BAR(pb + 3);
        }

        if (PH_SEL(5) && PH_IN(pb + 5)) {
            PHASE_IDS();
            const unsigned nooff[2][2] = {{0u, 0u}, {0u, 0u}};
            const int segcap = ((S / 256 * (D / 256) + G - 1) / G) * 32;
            moe_prefix(cntb, G, lds_raw, tid);
            const int* ctot = (const int*)(lds_raw + LDS_MISC + M_CTOT); const int* coff = (const int*)(lds_raw + LDS_MISC + M_COFF);
            const int* rtok = (const int*)(lds_raw + LDS_MISC + M_RTOK); const float* rw = (const float*)(lds_raw + LDS_MISC + M_RW);
            const int* rslot = (const int*)(lds_raw + LDS_MISC + M_RSLOT);
            unsigned* done = (unsigned*)(wsl + CTL_DONE_OFF) + l * 1024;
            int* mq = (int*)(wsl + CTL_MQ_OFF) + l * 128;
            const int myx = (int)(xb_xcc_id() & 7u);
            int qi = 0;
            for (;;) {
                __syncthreads();
                if (tid == 0) {
                    unsigned r = 0xffffffffu;
                    while (qi < 8) {
                        const int xx = (myx + qi) & 7;
                        int nm = 0;
#pragma unroll
                        for (int k = 0; k < NEXP / 8; ++k) nm += (ctot[xx + 8 * k] + 255) / 256;
                        const int got = atomic_add_int(mq + xx * 16, 1);
                        if (got < nm * 12) { r = ((unsigned)xx << 24) | (unsigned)got; break; }
                        ++qi;
                    }
                    *ubox = r;
                }
                __syncthreads();
                const unsigned rr = (unsigned)RFL((int)*ubox);
                if (rr == 0xffffffffu) break;
                const int xq = (int)(rr >> 24);
                int u = (int)(rr & 0xffffffu);
                int nmt = 0;
#pragma unroll
                for (int k = 0; k < NEXP / 8; ++k) nmt += (RFL(ctot[xq + 8 * k]) + 255) / 256;
                const bool down = (u >= nmt * 4);
                const int per = down ? 8 : 4;
                if (down) u -= nmt * 4;
                int e = xq;
                for (;; e += 8) { const int nt = ((RFL(ctot[e]) + 255) / 256) * per; if (u < nt) break; u -= nt; }
                const int c = RFL(ctot[e]), off = RFL(coff[e]);
                const int mt = u / per, pn = u % per, m0 = mt * 256;
                moe_rowtable(ltok, lw, lslot, e, m0, c, G, segcap, lds_raw, tid);
                f32x4 acc[2][2][4][2];
                if (!down) {
                    const bf16_t* Bt = WguT + ((size_t)l * NEXP + e) * 1024 * D;
                    unsigned aoff[2][2];
                    int st = tid; OPAQUE(st); int R[2], C[2]; stage_geom(st, R, C);
#pragma unroll
                    for (int h = 0; h < 2; ++h)
#pragma unroll
                        for (int i = 0; i < 2; ++i) aoff[h][i] = (unsigned)(rtok[h * 128 + R[i]] * D + C[i]);
                    gemm_tile<true>(h1b, 0, aoff, Bt, pn * 256, D, lds_raw, acc, tid);
                    int et = tid; OPAQUE(et); const int wr = et >> 8, wc = (et >> 6) & 3, fr = et & 15, fq = (et >> 4) & 3;
#pragma unroll
                    for (int ai = 0; ai < 2; ++ai)
#pragma unroll
                        for (int m = 0; m < 4; ++m)
#pragma unroll
                            for (int bj = 0; bj < 2; ++bj) {
                                const int r0 = ai * 128 + wr * 64 + m * 16 + fq * 4;
                                float vv[4];
#pragma unroll
                                for (int j = 0; j < 4; ++j) vv[j] = silu_f(acc[ai][bj][m][0][j]) * acc[ai][bj][m][1][j] * rw[r0 + j];
                                stage4_bf16_pairs(lds_raw + r0 * 272 + (bj * 64 + wc * 16 + fr) * 2, 272, vv[0], vv[1], vv[2], vv[3], fr);
                            }
                    __syncthreads();
#pragma unroll 4
                    for (int i = 0; i < 8; ++i) {
                        const int idx = et + i * 512, r = idx >> 4, ch = idx & 15;
                        if (m0 + r < c) *(u32x4*)(act + (size_t)(off + m0 + r) * DFF + pn * 128 + ch * 8) = *(const u32x4*)(lds_raw + r * 272 + ch * 16);
                    }
                    WAIT_VM0();
                    __syncthreads();
                    if (et == 0) { FENCE_REL_AGENT(); WAIT_VM0(); (void)xb_add(&done[e * 32 + mt], 1u); }
                } else {
                    const bf16_t* Bt = WdT + ((size_t)l * NEXP + e) * D * DFF;
                    if (tid == 0) {
                        unsigned* bw = (unsigned*)wsl;
                        XB_SPIN(xb_ld(&done[e * 32 + mt]) < 4u, bw);
                        FENCE_ACQ_AGENT();
                        WAIT_VM0();
                    }
                    __syncthreads();
                    gemm_tile<false>(act, off + m0, nooff, Bt, pn * 256, DFF, lds_raw, acc, tid);
                    int et = tid; OPAQUE(et); const int wr = et >> 8, wc = (et >> 6) & 3, fr = et & 15, fq = (et >> 4) & 3;
#pragma unroll
                    for (int ai = 0; ai < 2; ++ai)
#pragma unroll
                        for (int m = 0; m < 4; ++m)
#pragma unroll
                            for (int bj = 0; bj < 2; ++bj)
#pragma unroll
                                for (int n = 0; n < 2; ++n)
                                    stage4_bf16_pairs(lds_raw + (ai * 128 + wr * 64 + m * 16 + fq * 4) * 528 + (bj * 128 + wc * 32 + n * 16 + fr) * 2, 528,
                                                      acc[ai][bj][m][n][0], acc[ai][bj][m][n][1], acc[ai][bj][m][n][2], acc[ai][bj][m][n][3], fr);
                    __syncthreads();
#pragma unroll 4
                    for (int i = 0; i < 16; ++i) {
                        const int idx = et + i * 512, r = idx >> 5, ch = idx & 31;
                        if (m0 + r < c) *(u32x4*)(contrib + ((size_t)rslot[r] * S + rtok[r]) * D + pn * 256 + ch * 8) = *(const u32x4*)(lds_raw + r * 528 + ch * 16);
                    }
                }
            }
            PH_BAR(pb + 5);
        }

        if (PH_SEL(7) && PH_IN(pb + 7)) for (int rep = 0; rep < PH_REPS(7); ++rep) {
            PHASE_IDS();
            const float* g2 = p.in[I_LN2G] + (size_t)l * D; const float* b2 = p.in[I_LN2B] + (size_t)l * D;
            const bool more = (l + 1 < DEPTH);
            f32x4 gq[8], bq[8];
#pragma unroll
            for (int j = 0; j < 8; ++j) { gq[j] = *(const f32x4*)(g2 + j * 256 + lane * 4); bq[j] = *(const f32x4*)(b2 + j * 256 + lane * 4); }
            if (more) {
                const float* wf = Wfa + (size_t)(l + 1) * 8 * D;
                __syncthreads();
                for (int i = tid; i < 6 * D / 4; i += NTHREADS) *(f32x4*)(ldsf + i * 4) = *(const f32x4*)(wf + i * 4);
                __syncthreads();
            }
            for (int t = gwave; t < S; t += gwaves) {
                f32x4 v[8]; float s = 0.f;
#pragma unroll
                for (int j = 0; j < 8; ++j) {
                    const size_t i = (size_t)t * D + j * 256 + lane * 4;
                    const u32x2 c0 = *(const u32x2*)(contrib + i), c1 = *(const u32x2*)(contrib + (size_t)S * D + i);
                    const f32x4 cs = (f32x4){bf2f((bf16_t)(c0.x & 0xffffu)) + bf2f((bf16_t)(c1.x & 0xffffu)), bf2f((bf16_t)(c0.x >> 16)) + bf2f((bf16_t)(c1.x >> 16)),
                                             bf2f((bf16_t)(c0.y & 0xffffu)) + bf2f((bf16_t)(c1.y & 0xffffu)), bf2f((bf16_t)(c0.y >> 16)) + bf2f((bf16_t)(c1.y >> 16))};
                    const u32x2 hq = *(const u32x2*)(h1b + i);
                    v[j] = ALPHA * (f32x4){bf2f((bf16_t)(hq.x & 0xffffu)), bf2f((bf16_t)(hq.x >> 16)), bf2f((bf16_t)(hq.y & 0xffffu)), bf2f((bf16_t)(hq.y >> 16))} + cs;
                    s += (v[j][0] + v[j][1]) + (v[j][2] + v[j][3]);
                }
                const float mean = wave_sum(s) * (1.f / D);
                float s2 = 0.f;
#pragma unroll
                for (int j = 0; j < 8; ++j) { v[j] -= mean; s2 += (v[j][0] * v[j][0] + v[j][1] * v[j][1]) + (v[j][2] * v[j][2] + v[j][3] * v[j][3]); }
                const float rstd = 1.f / sqrtf(wave_sum(s2) * (1.f / D) + LN_EPS);
                float fa[6] = {0.f, 0.f, 0.f, 0.f, 0.f, 0.f};
#pragma unroll
                for (int j = 0; j < 8; ++j) {
                    const int c = j * 256 + lane * 4;
                    v[j] = v[j] * rstd * gq[j] + bq[j];
                    *(f32x4*)(hout + (size_t)t * D + c) = v[j];
                    COMPILER_FENCE();
                    if (more) {
                        u32x2 o; o.x = pack2(v[j][0], v[j][1]); o.y = pack2(v[j][2], v[j][3]);
                        *(u32x2*)(xb + (size_t)t * D + c) = o;
#pragma unroll
                        for (int h = 0; h < 6; ++h) { const f32x4 w = *(const f32x4*)(ldsf + h * D + c); fa[h] += (v[j][0] * w[0] + v[j][1] * w[1]) + (v[j][2] * w[2] + v[j][3] * w[3]); }
                    }
                }
                if (more) {
#pragma unroll
                    for (int h = 0; h < 6; ++h) { const float sm = wave_sum(fa[h]); if (lane == 0) logf_[h * S + t] = log_sigmoid_f(sm + p.in[I_BF][(l + 1) * 6 + h]); }
                }
            }
            PH_BAR(pb + 7);
        }
    }
#undef PH_IN
#undef PH_BAR
}

constexpr int N_PHASES = 1 + DEPTH * 8;
#ifndef EMU
extern "C" void kernel_launch(void* const* d_in, const int* in_sizes, int n_in, void* d_out, int out_size, void* d_ws, size_t ws_size, hipStream_t stream) {
    static int grid = 0;
    if (grid == 0) {
        if (n_in != N_INPUTS || out_size != S * D || ws_size < WS_END) {
            fprintf(stderr, "kernel_launch: unexpected shapes: n_in %d out %d ws %zu (need %zu)\n", n_in, out_size, ws_size, (size_t)WS_END); grid = -1; return; }
        int dev = 0, cus = 0, per_cu = 0;
        if (hipGetDevice(&dev) != hipSuccess || hipDeviceGetAttribute(&cus, hipDeviceAttributeMultiprocessorCount, dev) != hipSuccess) { grid = -1; return; }
        if (hipFuncSetAttribute((const void*)fwd_kernel, hipFuncAttributeMaxDynamicSharedMemorySize, LDS_BYTES) != hipSuccess) { fprintf(stderr, "kernel_launch: hipFuncSetAttribute failed\n"); grid = -1; return; }
        if (hipOccupancyMaxActiveBlocksPerMultiprocessor(&per_cu, (const void*)fwd_kernel, NTHREADS, LDS_BYTES) != hipSuccess || per_cu < 1) {
            fprintf(stderr, "kernel_launch: occupancy query says %d blocks per CU\n", per_cu); (void)hipGetLastError(); grid = -1; return; }
        grid = cus;
    }
    if (grid < 0) return;
    (void)hipMemsetAsync(d_ws, 0, CTL_BYTES, stream);
    Params p{};
    for (int i = 0; i < N_INPUTS; ++i) p.in[i] = (const float*)d_in[i];
    p.out = (float*)d_out; p.ws = (unsigned char*)d_ws;
    for (int i = 0; i < 8; ++i) p.inv_freq[i] = (float)pow(500000.0, -(double)i * 2.0 / 16.0);
#if N_LAUNCH_SPLIT
    for (int k = 0; k < N_PHASES; ++k) { p.lo = k; p.hi = k + 1; hipLaunchKernelGGL(fwd_kernel, dim3(grid), dim3(NTHREADS), LDS_BYTES, stream, p); }
#else
    p.lo = 0; p.hi = N_PHASES;
    hipLaunchKernelGGL(fwd_kernel, dim3(grid), dim3(NTHREADS), LDS_BYTES, stream, p);
#endif
}
#endif
```

```cpp
#ifndef EMU
#include <hip/hip_runtime.h>
#include <cstdio>
#include <cstdint>
#include <cmath>
#endif

#ifndef SEQ
#define SEQ 8192
#endif
#ifndef N_LAUNCH_SPLIT
#define N_LAUNCH_SPLIT 0
#endif
#ifndef REP_PHASE
#define REP_PHASE -2
#endif
#define PH_REPS(c) ((c) == REP_PHASE ? 2 : 1)
#ifndef REP_SUB
#define REP_SUB 0
#endif

constexpr int S = SEQ, D = 2048, DEPTH = 2;
constexpr int FOX_H = 6, FOX_W = 768;
constexpr int LRU_W = 768;
constexpr int DIFF_H = 4, DIFF_W = 512;
constexpr int N_IN = 5382, N_INP = 5376;
constexpr int C_FA = 2304;
constexpr int NEXP = 32, DFF = 512;
constexpr int NKT = S / 64;
#ifndef REP_ROUTER
#define REP_ROUTER 1
#endif
#ifndef REP_STORES
#define REP_STORES 1
#endif
#ifndef REP_STATS
#define REP_STATS 1
#endif
#ifndef DCH
#define DCH 48
#endif
constexpr int NCH = (NKT + DCH - 1) / DCH;
constexpr size_t DPART_ROWS = (size_t)NCH * S - (size_t)(DCH * 64) * NCH * (NCH - 1) / 2;
constexpr float ALPHA = 1.41421356237309504880f;
constexpr float LN_EPS = 1e-5f;
constexpr float LOG2E = 1.4426950408889634f;
constexpr float QSCALE_A = 0.08838834764831845f * 1.4426950408889634f;
constexpr float QSCALE_C = 0.125f * 1.4426950408889634f;

enum { I_X = 0, I_POS, I_WIN, I_BF, I_CONVW, I_CONVB, I_WA, I_BA, I_WI, I_BI, I_LAM, I_LQ1, I_LK1, I_LQ2, I_LK2, I_SUBG, I_WO, I_LN1G, I_LN1B,
       I_WGRP, I_BGRP, I_WRT, I_BRT, I_WGATE, I_WUP, I_WDOWN, I_LN2G, I_LN2B, N_INPUTS };

typedef unsigned short bf16_t;
typedef short bf16x8 __attribute__((ext_vector_type(8)));
typedef float f32x4 __attribute__((ext_vector_type(4)));
typedef unsigned u32x4 __attribute__((ext_vector_type(4)));
typedef unsigned u32x2 __attribute__((ext_vector_type(2)));

constexpr size_t al256(size_t x) { return (x + 255) & ~(size_t)255; }
constexpr size_t CTL_BYTES = 65536;
constexpr size_t CTL_CNT_OFF = 32768;
constexpr size_t CTL_WORK_OFF = 36864;
constexpr size_t CTL_QK2_OFF = 57344;
constexpr size_t CTL_CLS_OFF = 49152;
constexpr size_t CTL_PAN_OFF = 16384;
constexpr size_t CTL_MQ_OFF = 24576;
constexpr size_t CTL_DONE_OFF = 40960;
constexpr size_t WB_WIN = CTL_BYTES;
constexpr size_t WB_WO = WB_WIN + al256((size_t)DEPTH * N_INP * D * 2);
constexpr size_t WB_WGU = WB_WO + al256((size_t)DEPTH * D * D * 2);
constexpr size_t WB_WD = WB_WGU + al256((size_t)DEPTH * NEXP * 1024 * D * 2);
constexpr size_t WB_WAI = WB_WD + al256((size_t)DEPTH * NEXP * D * DFF * 2);
constexpr size_t WF_FA = WB_WAI + al256((size_t)DEPTH * 6 * 256 * 128 * 2);
constexpr size_t WF_R36 = WF_FA + al256((size_t)DEPTH * 8 * D * 4);
constexpr size_t WF_ROPE = WF_R36 + al256((size_t)DEPTH * 2 * 48 * D * 2);
constexpr size_t A_XB = WF_ROPE + al256((size_t)S * 16 * 4);
constexpr size_t A_HB = A_XB + al256((size_t)S * D * 2);
constexpr size_t A_LOGF = A_HB + al256((size_t)S * D * 4);
constexpr size_t A_CUM = A_LOGF + al256((size_t)6 * S * 4);
constexpr size_t A_KMAX = A_CUM + al256((size_t)6 * S * 4);
constexpr size_t A_CNTB = A_KMAX + al256((size_t)6 * NKT * 4);
constexpr size_t A_QA = A_CNTB + al256((size_t)1024 * 32 * 4);
constexpr size_t A_KA = A_QA + al256((size_t)FOX_H * S * 128 * 2);
constexpr size_t A_VAT = A_KA + al256((size_t)FOX_H * S * 128 * 2);
constexpr size_t A_XR = A_VAT + al256((size_t)FOX_H * S * 128 * 2);
constexpr size_t A_GR = A_XR + al256((size_t)S * LRU_W * 2);
constexpr size_t A_QC = A_GR + al256((size_t)S * LRU_W * 2);
constexpr size_t A_KC = A_QC + al256((size_t)DIFF_H * S * 128 * 2);
constexpr size_t A_VCT = A_KC + al256((size_t)DIFF_H * S * 128 * 2);
constexpr size_t A_HLOC = A_VCT + al256((size_t)DIFF_H * S * 128 * 2);
constexpr size_t A_PLOC = A_HLOC + al256((size_t)S * LRU_W * 4);
constexpr size_t A_SUMA = A_PLOC + al256((size_t)S * LRU_W * 4);
constexpr size_t A_SUMH = A_SUMA + al256((size_t)NKT * LRU_W * 4);
constexpr size_t A_CONCAT = A_SUMH + al256((size_t)NKT * LRU_W * 4);
constexpr size_t A_Y1 = A_CONCAT + al256((size_t)S * D * 2);
constexpr size_t A_H1 = A_Y1 + al256((size_t)S * D * 4);
constexpr size_t A_H1B = A_H1 + al256((size_t)S * D * 4);
constexpr size_t A_LTOK = A_H1B + al256((size_t)S * D * 2);
constexpr size_t A_LW = A_LTOK + al256((size_t)NEXP * S * 4 * 2);
constexpr size_t A_LSLOT = A_LW + al256((size_t)NEXP * S * 4 * 2);
constexpr size_t A_ACT = A_LSLOT + al256((size_t)NEXP * S * 4 * 2);
constexpr size_t A_CONTRIB = A_ACT + al256((size_t)(2 * S + 256) * DFF * 2);
constexpr size_t WS_END = A_CONTRIB + al256((size_t)2 * S * D * 4);
constexpr size_t A_DPO = A_Y1;
constexpr size_t A_DPML = A_DPO + al256((size_t)8 * DPART_ROWS * 128 * 2);
static_assert(A_DPML + (size_t)8 * DPART_ROWS * 2 * 4 <= A_H1B, "differential partials must fit inside the y1 + h1 region");

constexpr size_t A_XBUF = A_H1 + al256((size_t)S * D * 2);
constexpr size_t A_PART = A_XBUF + al256((size_t)S * 8 * 8);
static_assert(A_PART + (size_t)8 * S * 48 * 4 <= A_H1B, "exchange buffers must fit inside the h1 region");
constexpr int NTHREADS = 512;
constexpr int LDS_MAIN = 131072 + 4096;
constexpr int LDS_MISC = LDS_MAIN;
constexpr int LDS_BYTES = LDS_MAIN + 8192 + 16640;
constexpr int M_PRE16 = 8192;
constexpr int M_LCNT = 64, M_CTOT = 256, M_COFF = 384, M_PRE = 512, M_RTOK = 2048, M_RW = 3072, M_RSLOT = 4096;

struct Params {
    const float* in[N_INPUTS];
    float* out;
    unsigned char* ws;
    float inv_freq[8];
    int lo, hi;
};

#ifndef EMU
#define LAS __attribute__((address_space(3)))
#define GAS __attribute__((address_space(1)))
#define DYN_LDS(name) extern __shared__ __attribute__((aligned(16))) unsigned char name[]
#define SLEEP1() __builtin_amdgcn_s_sleep(1)
#define WAVE_SYNC() __builtin_amdgcn_wave_barrier()
#define OPAQUE(x) asm volatile("" : "+v"(x))
#define COMPILER_FENCE() asm volatile("" ::: "memory")
#define RFL(x) __builtin_amdgcn_readfirstlane(x)
#define RFL_F(x) __builtin_bit_cast(float, __builtin_amdgcn_readfirstlane(__builtin_bit_cast(int, x)))
#define ANY_LANE(p) (__builtin_amdgcn_ballot_w64(p) != 0ull)
#define RDLANE(v, l) __builtin_bit_cast(float, __builtin_amdgcn_readlane(__builtin_bit_cast(int, v), l))
__device__ __forceinline__ int lane_id_volatile() { int l; asm volatile("v_mbcnt_lo_u32_b32 %0, -1, 0\n\tv_mbcnt_hi_u32_b32 %0, -1, %0" : "=v"(l)); return l; }
#define LANE_ID() lane_id_volatile()
#define OPAQUE_S(x) asm volatile("" : "+s"(x))
#define WAIT_VM0() asm volatile("s_waitcnt vmcnt(0)" ::: "memory")
#define WAIT_ALL0() __builtin_amdgcn_s_waitcnt(0)
#define FENCE_REL_AGENT() __builtin_amdgcn_fence(__ATOMIC_RELEASE, "agent")
#define FENCE_ACQ_AGENT() __builtin_amdgcn_fence(__ATOMIC_ACQUIRE, "agent")
#define MFMA16(a, b, c) __builtin_amdgcn_mfma_f32_16x16x32_bf16(a, b, c, 0, 0, 0)
#define GLDS16(g, l) __builtin_amdgcn_global_load_lds((const unsigned*)(g), (unsigned*)(l), 16, 0, 0)
#define WAIT_V(n) asm volatile("s_waitcnt vmcnt(" #n ")" ::: "memory")
#define WAIT_L(n) asm volatile("s_waitcnt lgkmcnt(" #n ")" ::: "memory")
#define BAR() __builtin_amdgcn_s_barrier()
#define SCHED() __builtin_amdgcn_sched_barrier(0)
#define SETPRIO(n) __builtin_amdgcn_s_setprio(n)
#define FAST_EXP2(x) __builtin_amdgcn_exp2f(x)
template <int M> __device__ __forceinline__ float shx_impl(float v, int lane) {
    if (M < 32) return __builtin_bit_cast(float, __builtin_amdgcn_ds_swizzle(__builtin_bit_cast(int, v), (M << 10) | 0x1f));
    return __builtin_bit_cast(float, __builtin_amdgcn_ds_bpermute((lane ^ 32) << 2, __builtin_bit_cast(int, v)));
}
#define SHX(v, M) shx_impl<M>(v, lane)
template <int CTRL> __device__ __forceinline__ float dppx(float x) { return __builtin_bit_cast(float, __builtin_amdgcn_mov_dpp(__builtin_bit_cast(int, x), CTRL, 0xf, 0xf, true)); }
#define DPP_X1(x) dppx<0xB1>(x)
#define DPP_X2(x) dppx<0x4E>(x)
#define DPP_X7(x) dppx<0x141>(x)
#define DPP_X8(x) dppx<0x128>(x)
#define xrow16_max(x) xrow16_max_l(x, lane)
#define xrow16_sum(x) xrow16_sum_l(x, lane)
__device__ __forceinline__ float xrow16_max_l(float x, int lane) { x = fmaxf(x, shx_impl<16>(x, lane)); return fmaxf(x, shx_impl<32>(x, lane)); }
__device__ __forceinline__ float xrow16_sum_l(float x, int lane) { x = x + shx_impl<16>(x, lane); return x + shx_impl<32>(x, lane); }
#define FAST_LOG2(x) __builtin_amdgcn_logf(x)
#define FAST_RCP(x) __builtin_amdgcn_rcpf(x)
__device__ __forceinline__ unsigned xb_ld(unsigned* p)              { return __hip_atomic_load(p, __ATOMIC_RELAXED, __HIP_MEMORY_SCOPE_AGENT); }
__device__ __forceinline__ unsigned xb_add(unsigned* p, unsigned v) { return __hip_atomic_fetch_add(p, v, __ATOMIC_RELAXED, __HIP_MEMORY_SCOPE_AGENT); }
__device__ __forceinline__ void xst64(unsigned long long* p, unsigned long long v) { __hip_atomic_store(p, v, __ATOMIC_RELAXED, __HIP_MEMORY_SCOPE_AGENT); }
__device__ __forceinline__ unsigned long long xld64(unsigned long long* p) { return __hip_atomic_load(p, __ATOMIC_RELAXED, __HIP_MEMORY_SCOPE_AGENT); }
__device__ __forceinline__ void xst32(unsigned* p, unsigned v) { __hip_atomic_store(p, v, __ATOMIC_RELAXED, __HIP_MEMORY_SCOPE_AGENT); }
__device__ __forceinline__ unsigned xb_xcc_id() { return (unsigned)__builtin_amdgcn_s_getreg((3 << 11) | 20) & 0xFu; }
__device__ __forceinline__ int atomic_add_int(int* p, int v) { return atomicAdd(p, v); }
__device__ __forceinline__ void atomic_min_int(int* p, int v) { atomicMin(p, v); }
__device__ __forceinline__ void atomic_max_u32(unsigned* p, unsigned v) { atomicMax(p, v); }
__device__ __forceinline__ unsigned pack2(float lo, float hi) { unsigned r; asm volatile("v_cvt_pk_bf16_f32 %0, %1, %2" : "=v"(r) : "v"(lo), "v"(hi)); return r; }
#else
#define MFMA16(a, b, c) emu_mfma_16x16x32_bf16(a, b, c)
#define GLDS16(g, l) emu_glds16((const void*)(g), (void*)(l))
#define WAIT_V(n) ((void)0)
#define WAIT_L(n) ((void)0)
#define BAR() __syncthreads()
#define SCHED() ((void)0)
#define SETPRIO(n) ((void)0)
#define FAST_EXP2(x) exp2f(x)
#define SHX(v, M) __shfl_xor(v, M)
#define DPP_X1(x) __shfl_xor(x, 1)
#define DPP_X2(x) __shfl_xor(x, 2)
#define DPP_X7(x) __shfl_xor(x, 7)
#define DPP_X8(x) __shfl_xor(x, 8)
static inline float xrow16_max(float x) { x = fmaxf(x, __shfl_xor(x, 16)); return fmaxf(x, __shfl_xor(x, 32)); }
static inline float xrow16_sum(float x) { x = x + __shfl_xor(x, 16); return x + __shfl_xor(x, 32); }
#define FAST_LOG2(x) log2f(x)
#define FAST_RCP(x) (1.f / (x))
static inline unsigned pack2(float lo, float hi) {
    unsigned a = __builtin_bit_cast(unsigned, lo), b = __builtin_bit_cast(unsigned, hi);
    a += 0x7fffu + ((a >> 16) & 1u); b += 0x7fffu + ((b >> 16) & 1u);
    return (a >> 16) | (b & 0xffff0000u);
}
#endif
__device__ __forceinline__ bf16_t f2bf(float f) { return (bf16_t)(pack2(f, 0.f) & 0xffffu); }
__device__ __forceinline__ float bf2f(bf16_t h) { return __builtin_bit_cast(float, (unsigned)h << 16); }

#define XB_TMO      128
#define XB_XCNT(j)  (256  + 64 * (j))
#define XB_XSUB(j)  (1280 + 64 * (j))
#define XB_XGEN(j)  (2304 + 64 * (j))
#define XB_TOP      3328
#define XB_TOPGEN   3392
#define XCD_BAR_WORDS 3456
#define XB_SPIN_CAP (1u << 22)
#define XB_SPIN(cond, bar) do { unsigned _sp = 0; while (cond) { SLEEP1(); \
    if ((++_sp & 255u) == 0u) { if (xb_ld(&(bar)[XB_TMO])) break; if (_sp > XB_SPIN_CAP) { xb_add(&(bar)[XB_TMO], 1u); break; } } } } while (0)

#define XB_X2SUB(x, s) (6400 + 16 * ((x) * 4 + (s)))
#define XB_X2CNT(x, s) (7424 + ((x) * 4 + (s)))
struct XcdBarrier { unsigned* bar; unsigned x, s; volatile LAS unsigned* st; };

__device__ __forceinline__ XcdBarrier xcd_barrier_post(unsigned* bar, volatile LAS unsigned* st) {
    XcdBarrier b; b.bar = bar; b.x = xb_xcc_id() & 15u; b.s = (blockIdx.x >> 3) & 3u; b.st = st;
    if (threadIdx.x == 0) {
        unsigned o = xb_add(&bar[XB_X2CNT(b.x, b.s)], 1u);
#ifndef EMU
        asm volatile("" :: "v"(o));
#endif
        (void)o;
        (void)xb_add(&bar[XB_XCNT(b.x)], 1u);
    }
    return b;
}
__device__ __forceinline__ void xcd_barrier_complete(unsigned* bar, unsigned x, unsigned s, unsigned& nsub, unsigned& nx, unsigned& nsubs) {
    const unsigned G = gridDim.x;
    unsigned sum, cnt, sp = 0u;
    for (;;) {
        sum = 0u; cnt = 0u;
#pragma unroll
        for (unsigned j = 0; j < 16; ++j) { const unsigned c = xb_ld(&bar[XB_XCNT(j)]); sum += c; cnt += (c > 0u) ? 1u : 0u; }
        if (sum == G) break;
        SLEEP1();
        if ((++sp & 255u) == 0u) { if (xb_ld(&bar[XB_TMO])) break; if (sp > XB_SPIN_CAP) { xb_add(&bar[XB_TMO], 1u); break; } }
    }
    unsigned mine = 0u, subs = 0u;
#pragma unroll
    for (unsigned q = 0; q < 4; ++q) { const unsigned c = xb_ld(&bar[XB_X2CNT(x, q)]); subs += (c > 0u) ? 1u : 0u; mine = (q == s) ? c : mine; }
    nsub = mine > 0u ? mine : 1u; nx = cnt > 0u ? cnt : 1u; nsubs = subs > 0u ? subs : 1u;
}
__device__ __forceinline__ void xcd_barrier(const XcdBarrier& b, bool leader) {
    WAIT_VM0();
    __syncthreads();
    if (leader) {
        unsigned* bar = b.bar;
        WAIT_ALL0();
        unsigned nsub = b.st[0], nx = b.st[1], nsubs = b.st[2];
        if (nsub == 0u) { xcd_barrier_complete(bar, b.x, b.s, nsub, nx, nsubs); b.st[0] = nsub; b.st[1] = nx; b.st[2] = nsubs; }
        const unsigned old = xb_add(&bar[XB_X2SUB(b.x, b.s)], 1u);
        const unsigned gen = old / nsub;
        bool xcd_last = false;
        if (old + 1u == (gen + 1u) * nsub) {
            const unsigned old2 = xb_add(&bar[XB_XSUB(b.x)], 1u);
            xcd_last = (old2 + 1u == (old2 / nsubs + 1u) * nsubs);
        }
        if (xcd_last) {
            FENCE_REL_AGENT();
            WAIT_VM0();
            const unsigned og = xb_add(&bar[XB_TOP], 1u);
            const unsigned tg = og / nx;
            if (og + 1u == (tg + 1u) * nx) xb_add(&bar[XB_TOPGEN], 1u);
            else XB_SPIN(xb_ld(&bar[XB_TOPGEN]) == tg, bar);
            FENCE_ACQ_AGENT();
            xb_add(&bar[XB_XGEN(b.x)], 1u);
            WAIT_VM0();
        } else {
            XB_SPIN(xb_ld(&bar[XB_XGEN(b.x)]) == gen, bar);
            FENCE_ACQ_AGENT();
            WAIT_VM0();
        }
    }
    __syncthreads();
}

__device__ __forceinline__ f32x4 mul_s4(f32x4 a, float s) {
#ifdef EMU
    return a * s;
#else
    f32x4 o;
#pragma unroll
    for (int c = 0; c < 4; ++c) { float r, x = a[c]; asm volatile("v_mul_f32_e32 %0, %1, %2" : "=v"(r) : "v"(x), "v"(s)); o[c] = r; }
    return o;
#endif
}
__device__ __forceinline__ float wave_sum_l(float v, int lane) {
    (void)lane;
    v += DPP_X1(v); v += DPP_X2(v); v += DPP_X7(v); v += DPP_X8(v);
    return xrow16_sum(v);
}
#define wave_sum(v) wave_sum_l(v, lane)
__device__ __forceinline__ float fexp(float x) { return FAST_EXP2(x * LOG2E); }
__device__ __forceinline__ float sigmoid_f(float x) { return FAST_RCP(1.f + fexp(-x)); }
__device__ __forceinline__ float log_sigmoid_f(float x) { return fminf(x, 0.f) - 0.6931471805599453f * FAST_LOG2(1.f + fexp(-fabsf(x))); }
__device__ __forceinline__ float gelu_tanh_f(float x) { const float u = 0.7978845608028654f * (x + 0.044715f * x * x * x); return x * FAST_RCP(1.f + fexp(-2.f * u)); }
__device__ __forceinline__ float silu_f(float x) { return x * FAST_RCP(1.f + fexp(-x)); }
__device__ __forceinline__ float neg_expm1_f(float x) {
    const float ser = -x * (1.f + x * (0.5f + x * (0.16666667f + x * (0.041666668f + x * (0.008333334f + x * 0.0013888889f)))));
    return (x > -0.35f) ? ser : (1.f - fexp(x));
}

struct RmIdent { __device__ __forceinline__ int operator()(int n) const { return n; } };
struct RmWin { __device__ __forceinline__ int operator()(int n) const { return n < C_FA ? n : (n < C_FA + 6 ? -1 : n - 6); } };
struct RmGu { int kind; __device__ __forceinline__ int operator()(int f) const { return (f >> 7) * 256 + ((f >> 6) & 1) * 128 + ((f >> 4) & 3) * 32 + kind * 16 + (f & 15); } };
struct RmOff { int off; __device__ __forceinline__ int operator()(int n) const { return n + off; } };

template <class RM>
__device__ __forceinline__ void convert_tile(const float* src, int ld, int K, int Nsrc, int k0, int n0, bf16_t* dst, const RM& rm, float* T, int tid) {
    {
        const int nn = tid & 255, kh = (tid >> 8) * 32, n = n0 + nn;
        const float* sp = src + (size_t)(k0 + kh) * ld + n;
        float v[32];
#pragma unroll
        for (int i = 0; i < 32; ++i) v[i] = (n < Nsrc) ? sp[(size_t)i * ld] : 0.f;
#pragma unroll
        for (int i = 0; i < 32; ++i) T[(kh + i) * 257 + nn] = v[i];
    }
    __syncthreads();
#pragma unroll
    for (int q = 0; q < 4; ++q) {
        const int nn = q * 64 + (tid >> 3), kc = (tid & 7) * 8, n = n0 + nn;
        const int row = (n < Nsrc) ? rm(n) : -1;
        if (row >= 0) {
            u32x4 o;
            o.x = pack2(T[(kc + 0) * 257 + nn], T[(kc + 1) * 257 + nn]); o.y = pack2(T[(kc + 2) * 257 + nn], T[(kc + 3) * 257 + nn]);
            o.z = pack2(T[(kc + 4) * 257 + nn], T[(kc + 5) * 257 + nn]); o.w = pack2(T[(kc + 6) * 257 + nn], T[(kc + 7) * 257 + nn]);
            *(u32x4*)(dst + (size_t)row * K + k0 + kc) = o;
        }
    }
    __syncthreads();
}
template <class RM>
__device__ __forceinline__ void convert_tile_v4(const float* src, int ld, int K, int k0, int n0, bf16_t* dst, const RM& rm, float* T, int tid_in) {
    int tid = tid_in; OPAQUE(tid);
    {
        const int w = tid >> 6, l4 = (tid & 63) * 4;
        const float* sp = src + (size_t)(k0 + w * 8) * ld + n0 + l4;
        f32x4 v[8];
#pragma unroll
        for (int i = 0; i < 8; ++i) v[i] = *(const f32x4*)(sp + (size_t)i * ld);
#pragma unroll
        for (int i = 0; i < 8; ++i) { float* tp = T + (w * 8 + i) * 257 + l4; tp[0] = v[i][0]; tp[1] = v[i][1]; tp[2] = v[i][2]; tp[3] = v[i][3]; }
    }
    __syncthreads();
#pragma unroll
    for (int q = 0; q < 4; ++q) {
        const int nn = q * 64 + (tid >> 3), kc = (tid & 7) * 8, n = n0 + nn;
        const int row = rm(n);
        u32x4 o;
        o.x = pack2(T[(kc + 0) * 257 + nn], T[(kc + 1) * 257 + nn]); o.y = pack2(T[(kc + 2) * 257 + nn], T[(kc + 3) * 257 + nn]);
        o.z = pack2(T[(kc + 4) * 257 + nn], T[(kc + 5) * 257 + nn]); o.w = pack2(T[(kc + 6) * 257 + nn], T[(kc + 7) * 257 + nn]);
        *(u32x4*)(dst + (size_t)row * K + k0 + kc) = o;
    }
    __syncthreads();
}
template <class RM>
__device__ __forceinline__ void convert_mats(const float* src, size_t sstride, int nmat, int ld, int K, int Nsrc, bf16_t* dst, size_t dstride, const RM& rm,
                                             float* T, int tid, int bid, int G) {
    const int tk = K / 64, tn = (Nsrc + 255) / 256, per = tk * tn, total = nmat * per;
    for (int t = bid; t < total; t += G) {
        const int mi = t / per, r = t % per;
        convert_tile(src + (size_t)mi * sstride, ld, K, Nsrc, (r / tn) * 64, (r % tn) * 256, dst + (size_t)mi * dstride, rm, T, tid);
    }
}

constexpr int NCONV = DEPTH * 768;
__device__ __forceinline__ void moe_conv_chunk(const Params& p, int cid, bf16_t* WguT_, bf16_t* WdT_, float* T, int tid) {
    const int l = cid / 768, r = cid % 768, kind = r >> 8, t0 = (r & 255) * 8;
    for (int t = t0; t < t0 + 8; ++t) {
        const int mi = t >> 6, rr = t & 63;
        if (kind < 2) {
            const float* src = p.in[kind == 0 ? I_WGATE : I_WUP] + ((size_t)l * NEXP + mi) * D * DFF;
            convert_tile_v4(src, DFF, D, (rr >> 1) * 64, (rr & 1) * 256, WguT_ + ((size_t)l * NEXP + mi) * 1024 * D, RmGu{kind}, T, tid);
        } else {
            const float* src = p.in[I_WDOWN] + ((size_t)l * NEXP + mi) * DFF * D;
            convert_tile_v4(src, D, DFF, (rr >> 3) * 64, (rr & 7) * 256, WdT_ + ((size_t)l * NEXP + mi) * D * DFF, RmIdent{}, T, tid);
        }
    }
}

constexpr int BK = 64, HTB = 128 * 64 * 2;
__device__ __forceinline__ int lds_byte(int r, int c) {
    const int st = (r >> 4) * 2 + (c >> 5), rr = r & 15, cc = c & 31, ob = rr * 64 + cc * 2;
    return st * 1024 + (ob ^ (((ob >> 9) & 1) << 5));
}
__device__ __forceinline__ void stage_rc(int b, int& R, int& C) {
    const int st = b / 1024, sb = b % 1024, swz = sb ^ (((sb >> 9) & 1) << 5);
    R = (st >> 1) * 16 + swz / 64; C = (st & 1) * 32 + (swz % 64) / 2;
}
template <bool GATHER>
__device__ __forceinline__ void gemm_tile(const bf16_t* A, int arow0, const unsigned (&aoff)[2][2], const bf16_t* Bt, int brow0, int K,
                                          unsigned char* shm, f32x4 (&acc)[2][2][4][2], int tid_in) {
    int tid = tid_in; OPAQUE(tid);
    unsigned toff; { int R0, C0; stage_rc(tid * 16, R0, C0); toff = (unsigned)(R0 * K + C0); }
#define SA(b, h) (shm + ((b) * 2 + (h)) * HTB)
#define SB(b, h) (shm + (4 + (b) * 2 + (h)) * HTB)
#define STAGE_B(P, h, kt) do { _Pragma("unroll") for (int _i = 0; _i < 2; ++_i) GLDS16(Bt + ((size_t)(brow0 + (h) * 128 + _i * 64) * K + (size_t)(kt) * BK) + toff, (P) + tid * 16 + _i * 8192); } while (0)
#define STAGE_A(P, h, kt) do { _Pragma("unroll") for (int _i = 0; _i < 2; ++_i) { \
    if (GATHER) GLDS16(A + (size_t)(kt) * BK + aoff[h][_i], (P) + tid * 16 + _i * 8192); \
    else GLDS16(A + ((size_t)(arow0 + (h) * 128 + _i * 64) * K + (size_t)(kt) * BK) + toff, (P) + tid * 16 + _i * 8192); } } while (0)
#define LDA(dst, b, h) _Pragma("unroll") for (int m = 0; m < 4; ++m) _Pragma("unroll") for (int k = 0; k < 2; ++k) \
    dst[m][k] = *reinterpret_cast<const bf16x8*>(SA(b, h) + lds_byte(wr * 64 + m * 16 + fr, k * 32 + fq * 8))
#define LDB(dst, b, h) _Pragma("unroll") for (int n = 0; n < 2; ++n) _Pragma("unroll") for (int k = 0; k < 2; ++k) \
    dst[n][k] = *reinterpret_cast<const bf16x8*>(SB(b, h) + lds_byte(wc * 32 + n * 16 + fr, k * 32 + fq * 8))
#define MMA(ai, bj, At, Bx) do { SETPRIO(1); \
    _Pragma("unroll") for (int m = 0; m < 4; ++m) _Pragma("unroll") for (int n = 0; n < 2; ++n) _Pragma("unroll") for (int k = 0; k < 2; ++k) \
      acc[ai][bj][m][n] = MFMA16(At[m][k], Bx[n][k], acc[ai][bj][m][n]); \
    SETPRIO(0); } while (0)
    int wid = tid >> 6, lane = tid & 63, wr = wid >> 2, wc = wid & 3, fr = lane & 15, fq = lane >> 4;
#pragma unroll
    for (int a = 0; a < 2; ++a)
#pragma unroll
        for (int b = 0; b < 2; ++b)
#pragma unroll
            for (int m = 0; m < 4; ++m)
#pragma unroll
                for (int n = 0; n < 2; ++n) acc[a][b][m][n] = (f32x4){0.f, 0.f, 0.f, 0.f};
    bf16x8 At[4][2], B0[2][2], B1[2][2];
    const int nt = K / BK;
    STAGE_B(SB(0, 0), 0, 0); STAGE_A(SA(0, 0), 0, 0);
    STAGE_B(SB(0, 1), 1, 0); STAGE_A(SA(0, 1), 1, 0);
    if (wr == 1) BAR();
    WAIT_V(4); BAR();
    STAGE_B(SB(1, 0), 0, 1); STAGE_A(SA(1, 0), 0, 1); STAGE_B(SB(1, 1), 1, 1);
    WAIT_V(6); BAR();
    for (int t = 0; t < nt - 2; t += 2) {
        LDB(B0, 0, 0); SCHED(); LDA(At, 0, 0); STAGE_A(SA(1, 1), 1, t + 1);
        WAIT_L(8); BAR(); WAIT_L(0); MMA(0, 0, At, B0); BAR(); SCHED();
        LDB(B1, 0, 1); STAGE_B(SB(0, 0), 0, t + 2);
        BAR(); WAIT_L(0); MMA(0, 1, At, B1); BAR();
        LDA(At, 0, 1); STAGE_A(SA(0, 0), 0, t + 2);
        BAR(); WAIT_L(0); MMA(1, 0, At, B0); BAR(); SCHED();
        STAGE_B(SB(0, 1), 1, t + 2);
        WAIT_V(6); BAR(); MMA(1, 1, At, B1); BAR();
        LDB(B0, 1, 0); SCHED(); LDA(At, 1, 0); STAGE_A(SA(0, 1), 1, t + 2);
        WAIT_L(8); BAR(); WAIT_L(0); MMA(0, 0, At, B0); BAR(); SCHED();
        LDB(B1, 1, 1); STAGE_B(SB(1, 0), 0, t + 3);
        BAR(); WAIT_L(0); MMA(0, 1, At, B1); BAR();
        LDA(At, 1, 1); STAGE_A(SA(1, 0), 0, t + 3);
        BAR(); WAIT_L(0); MMA(1, 0, At, B0); BAR(); SCHED();
        STAGE_B(SB(1, 1), 1, t + 3);
        WAIT_V(6); BAR(); MMA(1, 1, At, B1); BAR();
    }
    OPAQUE(tid); wid = tid >> 6; lane = tid & 63; wr = wid >> 2; wc = wid & 3; fr = lane & 15; fq = lane >> 4;
    { LDB(B0, 0, 0); WAIT_V(0); LDA(At, 0, 0); STAGE_A(SA(1, 1), 1, nt - 1);
      BAR(); WAIT_L(0); MMA(0, 0, At, B0); BAR();
      LDB(B1, 0, 1); BAR(); WAIT_L(0); MMA(0, 1, At, B1); BAR();
      LDA(At, 0, 1); WAIT_V(4); BAR(); WAIT_L(0); MMA(1, 0, At, B0); MMA(1, 1, At, B1); BAR(); }
    { LDB(B0, 1, 0); LDA(At, 1, 0); WAIT_V(2); BAR(); WAIT_L(0); MMA(0, 0, At, B0); BAR();
      LDB(B1, 1, 1); WAIT_V(0); BAR(); WAIT_L(0); MMA(0, 1, At, B1); BAR();
      LDA(At, 1, 1); BAR(); WAIT_L(0); MMA(1, 0, At, B0); MMA(1, 1, At, B1); BAR(); }
    if (wr == 0) BAR();
#undef SA
#undef SB
#undef STAGE_A
#undef STAGE_B
#undef LDA
#undef LDB
#undef MMA
}
__device__ __forceinline__ void stage_geom(int tid, int (&R)[2], int (&C)[2]) {
#pragma unroll
    for (int i = 0; i < 2; ++i) stage_rc(tid * 16 + i * 8192, R[i], C[i]);
}

constexpr int ATT_STAGE = 69632;
constexpr int ATT_KBUF = 0, ATT_VBUF = 32768, ATT_CBUF = 65536;
template <int KIND>
__device__ __forceinline__ void attn_unit(const bf16_t* Q, const bf16_t* Kg, const bf16_t* VT, const float* cum2, const float* kmx, int qb, bf16_t* concat, int ccol0,
                                          float lam, float osc, const float* subg, unsigned char* lds, int tid) {
    const int lane = tid & 63, wave = tid >> 6, r16 = lane & 15, q4 = lane >> 4;
    const int q0w = qb * 128 + wave * 16, myq = q0w + r16;
    const int ntiles = 2 * qb + 2;
    const int wlimit = (KIND == 0) ? ((q0w + 15) >> 6) : (q0w >> 6);
    constexpr int NMAP = (KIND == 0) ? 1 : 2, NKS = (KIND == 0) ? 4 : 2;
    bf16x8 qf[NMAP][NKS];
#pragma unroll
    for (int mp = 0; mp < NMAP; ++mp)
#pragma unroll
        for (int ks = 0; ks < NKS; ++ks) qf[mp][ks] = *(const bf16x8*)(Q + (size_t)myq * 128 + mp * 64 + ks * 32 + q4 * 8);
    const float cq = (KIND == 0) ? cum2[myq] : 0.f;
    int kt0 = 0;
    if (KIND == 0) {
        float* wmax = (float*)(lds + ATT_CBUF + 512); int* kst = (int*)(lds + ATT_CBUF + 576);
        float qs = 0.f;
#pragma unroll
        for (int ks = 0; ks < NKS; ++ks)
#pragma unroll
            for (int j = 0; j < 8; ++j) { const float v = bf2f((bf16_t)qf[0][ks][j]); qs += v * v; }
        qs = xrow16_sum(qs);
        qs = fmaxf(qs, SHX(qs, 1)); qs = fmaxf(qs, SHX(qs, 2)); qs = fmaxf(qs, SHX(qs, 4)); qs = fmaxf(qs, SHX(qs, 8));
        if (lane == 0) wmax[wave] = qs;
        if (tid == 0) *kst = 2 * qb;
        __syncthreads();
        float qm = wmax[0];
#pragma unroll
        for (int w = 1; w < 8; ++w) qm = fmaxf(qm, wmax[w]);
        qm = sqrtf(qm) * 1.01f;
        const float kd = sqrtf(fmaxf(kmx[2 * qb], kmx[2 * qb + 1])) * 1.01f;
        if (tid < 2 * qb) {
            const float bias = cum2[qb * 128] - cum2[tid * 64 + 63];
            const bool skip = bias + qm * (sqrtf(kmx[tid]) * 1.01f + kd) < -40.f;
            if (!skip) atomic_min_int(kst, tid);
        }
        __syncthreads();
        kt0 = RFL(*kst);
    }
    f32x4 ot[NMAP][8];
    float mrun[NMAP], lsum[NMAP];
#pragma unroll
    for (int mp = 0; mp < NMAP; ++mp) { mrun[mp] = -INFINITY; lsum[mp] = 0.f;
#pragma unroll
        for (int mo = 0; mo < 8; ++mo) ot[mp][mo] = (f32x4){0.f, 0.f, 0.f, 0.f}; }
    u32x4 sk[2], sv[2]; float sc = 0.f;
    const u32x4* kg = (const u32x4*)Kg; const u32x4* vg = (const u32x4*)VT;
#pragma unroll
    for (int i = 0; i < 2; ++i) { sk[i] = kg[(size_t)kt0 * 1024 + tid + i * 512]; sv[i] = vg[(size_t)kt0 * 1024 + tid + i * 512]; }
    if (KIND == 0 && tid < 64) sc = cum2[kt0 * 64 + tid];
    for (int kt = kt0; kt < ntiles; ++kt) {
        unsigned char* kb = lds + ATT_KBUF + (kt & 1) * 16384;
        unsigned char* vb = lds + ATT_VBUF + (kt & 1) * 16384;
        float* cb = (float*)(lds + ATT_CBUF + (kt & 1) * 256);
#pragma unroll
        for (int i = 0; i < 2; ++i) {
            const int g = tid + i * 512;
            { const int row = g >> 4, c = g & 15; *(u32x4*)(kb + row * 256 + ((c ^ (row & 15)) << 4)) = sk[i]; }
            { const int d = g >> 3, c = g & 7; *(u32x4*)(vb + d * 128 + ((c ^ ((d >> 1) & 7)) << 4)) = sv[i]; }
        }
        if (KIND == 0 && tid < 64) cb[tid] = sc;
        __syncthreads();
        if (kt + 1 < ntiles) {
#pragma unroll
            for (int i = 0; i < 2; ++i) { sk[i] = kg[(size_t)(kt + 1) * 1024 + tid + i * 512]; sv[i] = vg[(size_t)(kt + 1) * 1024 + tid + i * 512]; }
            if (KIND == 0 && tid < 64) sc = cum2[(kt + 1) * 64 + tid];
        }
        if (kt <= wlimit) {
#pragma unroll
            for (int mp = 0; mp < NMAP; ++mp) {
                bf16x8 kf[4][NKS], vfa[8];
#pragma unroll
                for (int m = 0; m < 4; ++m)
#pragma unroll
                    for (int ks = 0; ks < NKS; ++ks) { const int c = (KIND == 0 ? 0 : mp * 8) + ks * 4 + q4; kf[m][ks] = *(const bf16x8*)(kb + (m * 16 + r16) * 256 + ((c ^ r16) << 4)); }
#pragma unroll
                for (int mo = 0; mo < 8; ++mo) { const int d = mo * 16 + r16; vfa[mo] = *(const bf16x8*)(vb + d * 128 + (((0 * 4 + q4) ^ ((d >> 1) & 7)) << 4)); }
                SCHED();
                f32x4 st[4];
#pragma unroll
                for (int m = 0; m < 4; ++m) st[m] = (f32x4){0.f, 0.f, 0.f, 0.f};
#pragma unroll
                for (int ks = 0; ks < NKS; ++ks)
#pragma unroll
                    for (int m = 0; m < 4; ++m) st[m] = MFMA16(kf[m][ks], qf[mp][ks], st[m]);
                SCHED();
                float mx = -INFINITY;
#pragma unroll
                for (int m = 0; m < 4; ++m) {
                    if (KIND == 0) {
                        const f32x4 ck = *(const f32x4*)(cb + m * 16 + 4 * q4);
#pragma unroll
                        for (int j = 0; j < 4; ++j) {
                            float y = st[m][j] + (cq - ck[j]);
                            if (kt * 64 + m * 16 + 4 * q4 + j > myq) y = -INFINITY;
                            st[m][j] = y;
                        }
                    }
#pragma unroll
                    for (int j = 0; j < 4; ++j) mx = fmaxf(mx, st[m][j]);
                }
                mx = xrow16_max(mx);
                const float mnew = fmaxf(mrun[mp], mx);
                const float alpha = FAST_EXP2(mrun[mp] - mnew);
                mrun[mp] = mnew;
                float ps = 0.f;
#pragma unroll
                for (int m = 0; m < 4; ++m)
#pragma unroll
                    for (int j = 0; j < 4; ++j) { const float pv = FAST_EXP2(st[m][j] - mnew); st[m][j] = pv; ps += pv; }
                lsum[mp] = lsum[mp] * alpha + ps;
#pragma unroll
                for (int mo = 0; mo < 8; ++mo) ot[mp][mo] *= alpha;
                bf16x8 pf[2];
#pragma unroll
                for (int kk = 0; kk < 2; ++kk) {
                    u32x4 pw;
                    pw.x = pack2(st[2 * kk][0], st[2 * kk][1]); pw.y = pack2(st[2 * kk][2], st[2 * kk][3]);
                    pw.z = pack2(st[2 * kk + 1][0], st[2 * kk + 1][1]); pw.w = pack2(st[2 * kk + 1][2], st[2 * kk + 1][3]);
                    pf[kk] = __builtin_bit_cast(bf16x8, pw);
                }
                bf16x8 vfb[8];
#pragma unroll
                for (int mo = 0; mo < 8; ++mo) { const int d = mo * 16 + r16; vfb[mo] = *(const bf16x8*)(vb + d * 128 + (((1 * 4 + q4) ^ ((d >> 1) & 7)) << 4)); }
                SCHED();
#pragma unroll
                for (int mo = 0; mo < 8; ++mo) ot[mp][mo] = MFMA16(vfa[mo], pf[0], ot[mp][mo]);
                SCHED();
#pragma unroll
                for (int mo = 0; mo < 8; ++mo) ot[mp][mo] = MFMA16(vfb[mo], pf[1], ot[mp][mo]);
            }
        }
    }
    float inv[NMAP];
#pragma unroll
    for (int mp = 0; mp < NMAP; ++mp) { float l = lsum[mp]; l = xrow16_sum(l); inv[mp] = 1.f / l; }
    if (KIND == 0) {
        int te = tid; OPAQUE(te);
        const int er = te & 15, eq = (te >> 4) & 3, eqw = qb * 128 + (te >> 6) * 16;
        unsigned char* stg = lds + ATT_STAGE + (te >> 6) * 8192;
#pragma unroll
        for (int mo = 0; mo < 8; ++mo) {
            u32x2 o; o.x = pack2(ot[0][mo][0] * inv[0], ot[0][mo][1] * inv[0]); o.y = pack2(ot[0][mo][2] * inv[0], ot[0][mo][3] * inv[0]);
            *(u32x2*)(stg + er * 256 + (((mo * 2 + (eq >> 1)) ^ er) << 4) + (eq & 1) * 8) = o;
        }
        WAVE_SYNC();
#pragma unroll
        for (int k = 0; k < 4; ++k) {
            const int rl = k * 4 + eq, cch = er;
            const u32x4 val = *(const u32x4*)(stg + rl * 256 + ((cch ^ rl) << 4));
            *(u32x4*)(concat + (size_t)(eqw + rl) * D + ccol0 + cch * 8) = val;
        }
    } else {
        float ss = 0.f;
#pragma unroll
        for (int mo = 0; mo < 8; ++mo)
#pragma unroll
            for (int j = 0; j < 4; ++j) { const float v = ot[0][mo][j] * inv[0] - lam * (ot[NMAP - 1][mo][j] * inv[NMAP - 1]); ot[0][mo][j] = v; ss += v * v; }
        ss = xrow16_sum(ss);
        const float rs = osc / sqrtf(ss * (1.f / 128.f) + LN_EPS);
#pragma unroll
        for (int mo = 0; mo < 8; ++mo) {
            const f32x4 g = *(const f32x4*)(subg + mo * 16 + 4 * q4);
            u32x2 o; o.x = pack2(ot[0][mo][0] * rs * g[0], ot[0][mo][1] * rs * g[1]); o.y = pack2(ot[0][mo][2] * rs * g[2], ot[0][mo][3] * rs * g[3]);
            *(u32x2*)(concat + (size_t)myq * D + ccol0 + mo * 16 + 4 * q4) = o;
        }
    }
    __syncthreads();
}

__device__ __forceinline__ int dpart_row(int c, int q) { return c * (S - DCH * 64) - (DCH * 32) * c * (c - 1) + q; }
__device__ __forceinline__ void attn_dmap_unit(const bf16_t* Qh, const bf16_t* Kh, const bf16_t* VTh, int mp, int qb, int t0, int t1,
                                               bf16_t* Op, float* ML, int c, float bnd, unsigned char* lds, int tid) {
    const bool fixedref = (bnd <= 60.f);
    const int lane = tid & 63, wave = tid >> 6, r16 = lane & 15, q4 = lane >> 4;
    const int q0w = qb * 256 + wave * 32;
    const int wlimit = q0w >> 6;
    bf16x8 qf[2][2];
#pragma unroll
    for (int n = 0; n < 2; ++n)
#pragma unroll
        for (int ks = 0; ks < 2; ++ks) qf[n][ks] = *(const bf16x8*)(Qh + (size_t)(q0w + n * 16 + r16) * 128 + mp * 64 + ks * 32 + q4 * 8);
    f32x4 ot[8][2];
    float mrun[2] = {-INFINITY, -INFINITY}, lsum[2] = {0.f, 0.f};
    if (fixedref) { mrun[0] = bnd; mrun[1] = bnd; }
    const float stinit = fixedref ? -bnd : 0.f;
#pragma unroll
    for (int mo = 0; mo < 8; ++mo) { ot[mo][0] = (f32x4){0.f, 0.f, 0.f, 0.f}; ot[mo][1] = (f32x4){0.f, 0.f, 0.f, 0.f}; }
    u32x4 sk, sv[2];
    const u32x4* kg = (const u32x4*)Kh; const u32x4* vg = (const u32x4*)VTh;
    const int krow = tid >> 3, kc8 = tid & 7;
    sk = kg[(size_t)t0 * 1024 + krow * 16 + mp * 8 + kc8];
#pragma unroll
    for (int i = 0; i < 2; ++i) sv[i] = vg[(size_t)t0 * 1024 + tid + i * 512];
    for (int kt = t0; kt < t1; ++kt) {
        unsigned char* kb = lds + (kt & 1) * 8192;
        unsigned char* vb = lds + 16384 + (kt & 1) * 16384;
        *(u32x4*)(kb + krow * 128 + ((kc8 ^ ((krow >> 1) & 7)) << 4)) = sk;
#pragma unroll
        for (int i = 0; i < 2; ++i) { const int g = tid + i * 512, d = g >> 3, cc = g & 7; *(u32x4*)(vb + d * 128 + ((cc ^ ((d >> 1) & 7)) << 4)) = sv[i]; }
        __syncthreads();
        if (kt + 1 < t1) {
            sk = kg[(size_t)(kt + 1) * 1024 + krow * 16 + mp * 8 + kc8];
#pragma unroll
            for (int i = 0; i < 2; ++i) sv[i] = vg[(size_t)(kt + 1) * 1024 + tid + i * 512];
        }
        if (kt <= wlimit) {
            bf16x8 kf[4][2], vfa[8];
#pragma unroll
            for (int m = 0; m < 4; ++m)
#pragma unroll
                for (int ks = 0; ks < 2; ++ks) kf[m][ks] = *(const bf16x8*)(kb + (m * 16 + r16) * 128 + (((ks * 4 + q4) ^ ((r16 >> 1) & 7)) << 4));
#pragma unroll
            for (int mo = 0; mo < 8; ++mo) { const int d = mo * 16 + r16; vfa[mo] = *(const bf16x8*)(vb + d * 128 + (((0 * 4 + q4) ^ ((d >> 1) & 7)) << 4)); }
            SCHED();
            f32x4 st[4][2];
#pragma unroll
            for (int m = 0; m < 4; ++m) { st[m][0] = (f32x4){stinit, stinit, stinit, stinit}; st[m][1] = (f32x4){stinit, stinit, stinit, stinit}; }
            SETPRIO(1);
#pragma unroll
            for (int ks = 0; ks < 2; ++ks)
#pragma unroll
                for (int m = 0; m < 4; ++m) { st[m][0] = MFMA16(kf[m][ks], qf[0][ks], st[m][0]); st[m][1] = MFMA16(kf[m][ks], qf[1][ks], st[m][1]); }
            SETPRIO(0);
            SCHED();
            float alpha[2] = {1.f, 1.f};
            if (fixedref) {
#pragma unroll
                for (int n = 0; n < 2; ++n) {
                    float ps = 0.f;
#pragma unroll
                    for (int m = 0; m < 4; ++m)
#pragma unroll
                        for (int j = 0; j < 4; ++j) { const float pv = FAST_EXP2(st[m][n][j]); st[m][n][j] = pv; ps += pv; }
                    lsum[n] += ps;
                }
            } else
#pragma unroll
            for (int n = 0; n < 2; ++n) {
                float mx = -INFINITY;
#pragma unroll
                for (int m = 0; m < 4; ++m)
#pragma unroll
                    for (int j = 0; j < 4; ++j) mx = fmaxf(mx, st[m][n][j]);
                mx = xrow16_max(mx);
                const float mnew = fmaxf(mrun[n], mx);
                alpha[n] = FAST_EXP2(mrun[n] - mnew);
                mrun[n] = mnew;
                float ps = 0.f;
#pragma unroll
                for (int m = 0; m < 4; ++m)
#pragma unroll
                    for (int j = 0; j < 4; ++j) { const float pv = FAST_EXP2(st[m][n][j] - mnew); st[m][n][j] = pv; ps += pv; }
                lsum[n] = lsum[n] * alpha[n] + ps;
            }
            if (ANY_LANE(alpha[0] != 1.f)) {
#pragma unroll
                for (int mo = 0; mo < 8; ++mo) ot[mo][0] *= alpha[0];
            }
            if (ANY_LANE(alpha[1] != 1.f)) {
#pragma unroll
                for (int mo = 0; mo < 8; ++mo) ot[mo][1] *= alpha[1];
            }
            bf16x8 pf[2][2];
#pragma unroll
            for (int kk = 0; kk < 2; ++kk)
#pragma unroll
                for (int n = 0; n < 2; ++n) {
                    u32x4 pw;
                    pw.x = pack2(st[2 * kk][n][0], st[2 * kk][n][1]); pw.y = pack2(st[2 * kk][n][2], st[2 * kk][n][3]);
                    pw.z = pack2(st[2 * kk + 1][n][0], st[2 * kk + 1][n][1]); pw.w = pack2(st[2 * kk + 1][n][2], st[2 * kk + 1][n][3]);
                    pf[kk][n] = __builtin_bit_cast(bf16x8, pw);
                }
            bf16x8 vfb[8];
#pragma unroll
            for (int mo = 0; mo < 8; ++mo) { const int d = mo * 16 + r16; vfb[mo] = *(const bf16x8*)(vb + d * 128 + (((1 * 4 + q4) ^ ((d >> 1) & 7)) << 4)); }
            SCHED();
            SETPRIO(1);
#pragma unroll
            for (int mo = 0; mo < 8; ++mo) { ot[mo][0] = MFMA16(vfa[mo], pf[0][0], ot[mo][0]); ot[mo][1] = MFMA16(vfa[mo], pf[0][1], ot[mo][1]); }
            SCHED();
#pragma unroll
            for (int mo = 0; mo < 8; ++mo) { ot[mo][0] = MFMA16(vfb[mo], pf[1][0], ot[mo][0]); ot[mo][1] = MFMA16(vfb[mo], pf[1][1], ot[mo][1]); }
            SETPRIO(0);
        }
    }
    if (q0w >= DCH * 64 * c)
#pragma unroll
    for (int n = 0; n < 2; ++n) {
        float l = lsum[n]; l = xrow16_sum(l);
        const int row = dpart_row(c, q0w + n * 16 + r16);
        if (q4 == 0) { ML[row * 2] = mrun[n]; ML[row * 2 + 1] = l; }
    }
    {
        int te = tid; OPAQUE(te);
        const int er = te & 15, eq = (te >> 4) & 3, eqw = qb * 256 + (te >> 6) * 32;
        unsigned char* stg = lds + ATT_STAGE + (te >> 6) * 8192;
#pragma unroll
        for (int n = 0; n < 2; ++n)
#pragma unroll
            for (int mo = 0; mo < 8; ++mo) {
                u32x2 o; o.x = pack2(ot[mo][n][0], ot[mo][n][1]); o.y = pack2(ot[mo][n][2], ot[mo][n][3]);
                *(u32x2*)(stg + (n * 16 + er) * 256 + (((mo * 2 + (eq >> 1)) ^ er) << 4) + (eq & 1) * 8) = o;
            }
        WAVE_SYNC();
        if (eqw >= DCH * 64 * c) {
            const int row0 = dpart_row(c, eqw);
#pragma unroll
            for (int k = 0; k < 8; ++k) {
                const int rl = k * 4 + eq, cch = er;
                const u32x4 val = *(const u32x4*)(stg + rl * 256 + ((cch ^ (rl & 15)) << 4));
                *(u32x4*)(Op + (size_t)(row0 + rl) * 128 + cch * 8) = val;
            }
        }
    }
    __syncthreads();
}

__device__ __forceinline__ void lru_unit_a(int chunk, int grp, int l, const Params& p, const bf16_t* Xr, const bf16_t* WaiT, float* hloc, float* ploc, float* sumA, float* sumH,
                                           unsigned char* lds, int tid) {
    const int lane = tid & 63, wave = tid >> 6, r16 = lane & 15, q4 = lane >> 4;
    unsigned char* XCB = lds; float* XU = (float*)(lds + 16384); float* LA = (float*)(lds + 49152); float* ENDS = (float*)(lds + 81920);
    const int t0 = chunk * 64, ch0 = grp * 128;
    bf16x8 bfr[2][4];
#pragma unroll
    for (int g = 0; g < 2; ++g)
#pragma unroll
        for (int ks = 0; ks < 4; ++ks) bfr[g][ks] = *(const bf16x8*)(WaiT + ((size_t)grp * 256 + g * 128 + wave * 16 + r16) * 128 + ks * 32 + q4 * 8);
    const int chg = ch0 + wave * 16 + r16;
    const float ba = p.in[I_BA][(size_t)l * LRU_W + chg], bi = p.in[I_BI][(size_t)l * LRU_W + chg];
    const float lam_raw = p.in[I_LAM][(size_t)l * LRU_W + chg];
    {
        const int c = tid & 127, tq = tid >> 7, ch = ch0 + c;
        const float* cw = p.in[I_CONVW] + (size_t)l * 4 * LRU_W + ch; const float cb = p.in[I_CONVB][(size_t)l * LRU_W + ch];
        const float w0 = cw[0], w1 = cw[LRU_W], w2 = cw[2 * LRU_W], w3 = cw[3 * LRU_W];
        const int ts = t0 + tq * 16;
        float x0 = (ts - 3 >= 0) ? bf2f(Xr[(size_t)(ts - 3) * LRU_W + ch]) : 0.f;
        float x1 = (ts - 2 >= 0) ? bf2f(Xr[(size_t)(ts - 2) * LRU_W + ch]) : 0.f;
        float x2 = (ts - 1 >= 0) ? bf2f(Xr[(size_t)(ts - 1) * LRU_W + ch]) : 0.f;
#pragma unroll
        for (int i = 0; i < 16; ++i) {
            const float x3 = bf2f(Xr[(size_t)(ts + i) * LRU_W + ch]);
            const float v = cb + w0 * x0 + w1 * x1 + w2 * x2 + w3 * x3;
            const int row = tq * 16 + i;
            XU[row * 128 + c] = v;
            *(bf16_t*)(XCB + row * 256 + (((c >> 3) ^ (row & 15)) << 4) + (c & 7) * 2) = f2bf(v);
            x0 = x1; x1 = x2; x2 = x3;
        }
    }
    __syncthreads();
    {
        const float lsl = 8.0f * log_sigmoid_f(lam_raw);
#pragma unroll
        for (int mt = 0; mt < 4; ++mt) {
            f32x4 ga = (f32x4){0.f, 0.f, 0.f, 0.f}, gi = (f32x4){0.f, 0.f, 0.f, 0.f};
#pragma unroll
            for (int ks = 0; ks < 4; ++ks) {
                const bf16x8 af = *(const bf16x8*)(XCB + (mt * 16 + r16) * 256 + (((ks * 4 + q4) ^ r16) << 4));
                ga = MFMA16(af, bfr[0][ks], ga); gi = MFMA16(af, bfr[1][ks], gi);
            }
#pragma unroll
            for (int j = 0; j < 4; ++j) {
                const int row = mt * 16 + 4 * q4 + j, idx = row * 128 + wave * 16 + r16;
                const float r = sigmoid_f(ga[j] + ba), ig = sigmoid_f(gi[j] + bi);
                const float log_a = lsl * r;
                LA[idx] = fexp(log_a);
                XU[idx] = sqrtf(neg_expm1_f(2.f * log_a)) * (ig * XU[idx]);
            }
        }
    }
    __syncthreads();
    {
        const int c = tid & 127, tq = tid >> 7, ch = ch0 + c;
        float h = 0.f, P = 1.f;
#pragma unroll
        for (int i = 0; i < 16; ++i) { const int idx = (tq * 16 + i) * 128 + c; const float a = LA[idx]; h = a * h + XU[idx]; P *= a; XU[idx] = h; LA[idx] = P; }
        ENDS[tq * 128 + c] = P; ENDS[512 + tq * 128 + c] = h;
        __syncthreads();
        float cin = 0.f, pin = 1.f;
        for (int s = 0; s < tq; ++s) { const float Ps = ENDS[s * 128 + c], hs = ENDS[512 + s * 128 + c]; cin = Ps * cin + hs; pin *= Ps; }
#pragma unroll
        for (int i = 0; i < 16; ++i) {
            const int idx = (tq * 16 + i) * 128 + c; const size_t gi = (size_t)(t0 + tq * 16 + i) * LRU_W + ch;
            const float Pl = LA[idx], hl = XU[idx];
            ((unsigned*)hloc)[gi] = pack2(hl + Pl * cin, Pl * pin);
        }
        if (tq == 3) { const float Pl = LA[63 * 128 + c], hl = XU[63 * 128 + c]; sumA[(size_t)chunk * LRU_W + ch] = Pl * pin; sumH[(size_t)chunk * LRU_W + ch] = hl + Pl * cin; }
    }
    __syncthreads();
}

__device__ __forceinline__ void moe_prefix(const int* cntb_, int G, unsigned char* lds, int tid) {
    int* tmp = (int*)lds; int* ctot = (int*)(lds + LDS_MISC + M_CTOT); int* coff = (int*)(lds + LDS_MISC + M_COFF);
    unsigned short* pre16 = (unsigned short*)(lds + LDS_MISC + M_PRE16);
    const int e = tid & 31, part = tid >> 5, PB = (G + 15) / 16;
    int sm = 0;
    for (int i = 0; i < PB; ++i) { const int b = part * PB + i; if (b < G) sm += cntb_[b * 32 + e]; }
    tmp[part * 32 + e] = sm;
    __syncthreads();
    int run = 0;
    for (int q = 0; q < part; ++q) run += tmp[q * 32 + e];
    for (int i = 0; i < PB; ++i) { const int b = part * PB + i; if (b < G) { pre16[e * 257 + b] = (unsigned short)run; run += cntb_[b * 32 + e]; } }
    if (part == 15) { ctot[e] = run; pre16[e * 257 + G] = (unsigned short)run; }
    __syncthreads();
    if (tid == 0) { int o = 0; for (int q = 0; q < 32; ++q) { coff[q] = o; o += ctot[q]; } coff[32] = o; }
    __syncthreads();
}
__device__ __forceinline__ void moe_rowtable(const int* ltok_, const float* lw_, const int* lslot_, int e, int m0, int c_e, int G, int segcap, unsigned char* lds, int tid_in) {
    int tid = tid_in; OPAQUE(tid);
    const unsigned short* pre = (const unsigned short*)(lds + LDS_MISC + M_PRE16) + e * 257;
    int* rtok = (int*)(lds + LDS_MISC + M_RTOK); float* rw = (float*)(lds + LDS_MISC + M_RW); int* rslot = (int*)(lds + LDS_MISC + M_RSLOT);
    if (tid < 256) {
        const int g = m0 + tid;
        int tk = 0, sl = 0; float w = 0.f;
        if (g < c_e) {
            int lo = 0, hi = G;
            while (hi - lo > 1) { const int mid = (lo + hi) >> 1; if ((int)pre[mid] <= g) lo = mid; else hi = mid; }
            const int idx = (e * G + lo) * segcap + (g - (int)pre[lo]);
            tk = ltok_[idx]; w = lw_[idx]; sl = lslot_[idx];
        }
        rtok[tid] = tk; rw[tid] = w; rslot[tid] = sl;
    }
    __syncthreads();
}
#define kmax2 ((float*)(wsl + A_KMAX))
#define dpo ((bf16_t*)(wsl + A_DPO))
#define dpml ((float*)(wsl + A_DPML))
#define cntb ((int*)(wsl + A_CNTB))
#define WinT ((bf16_t*)(wsl + WB_WIN))
#define WoT ((bf16_t*)(wsl + WB_WO))
#define WguT ((bf16_t*)(wsl + WB_WGU))
#define WdT ((bf16_t*)(wsl + WB_WD))
#define WaiT ((bf16_t*)(wsl + WB_WAI))
#define Wfa ((float*)(wsl + WF_FA))
#define W36b ((bf16_t*)(wsl + WF_R36))
#define ropecs ((float*)(wsl + WF_ROPE))
#define xb ((bf16_t*)(wsl + A_XB))
#define hb ((float*)(wsl + A_HB))
#define logf_ ((float*)(wsl + A_LOGF))
#define cum2 ((float*)(wsl + A_CUM))
#define Qa ((bf16_t*)(wsl + A_QA))
#define Ka ((bf16_t*)(wsl + A_KA))
#define VaT ((bf16_t*)(wsl + A_VAT))
#define Xr ((bf16_t*)(wsl + A_XR))
#define Gr ((bf16_t*)(wsl + A_GR))
#define Qc ((bf16_t*)(wsl + A_QC))
#define Kc ((bf16_t*)(wsl + A_KC))
#define VcT ((bf16_t*)(wsl + A_VCT))
#define hloc ((float*)(wsl + A_HLOC))
#define ploc ((float*)(wsl + A_PLOC))
#define sumA ((float*)(wsl + A_SUMA))
#define sumH ((float*)(wsl + A_SUMH))
#define concat ((bf16_t*)(wsl + A_CONCAT))
#define y1 ((float*)(wsl + A_Y1))
#define h1 ((float*)(wsl + A_H1))
#define h1b ((bf16_t*)(wsl + A_H1B))
#define ltok ((int*)(wsl + A_LTOK))
#define lw ((float*)(wsl + A_LW))
#define lslot ((int*)(wsl + A_LSLOT))
#define act ((bf16_t*)(wsl + A_ACT))
#define contrib ((bf16_t*)(wsl + A_CONTRIB))
#ifndef EMU
__global__ void __launch_bounds__(NTHREADS, 2)
#else
void
#endif
fwd_kernel(Params p) {
    DYN_LDS(lds_raw);
    float* ldsf = (float*)lds_raw;
    const int bid = blockIdx.x, G = gridDim.x;
    const int gthreads = G * NTHREADS, gwaves = G * (NTHREADS / 64);
    const int wave_s = RFL((int)threadIdx.x >> 6);
#define PHASE_IDS() unsigned char* wsl = ws; OPAQUE_S(wsl); int tid = wave_s * 64 + LANE_ID(); OPAQUE(tid); const int lane = tid & 63, wave = tid >> 6, gtid = bid * NTHREADS + tid, gwave = bid * (NTHREADS / 64) + wave; (void)lane; (void)wave; (void)gtid; (void)gwave

    unsigned char* ws = p.ws;
    volatile LAS unsigned* bst = (volatile LAS unsigned*)(lds_raw + LDS_MISC);
    unsigned* ubox = (unsigned*)(lds_raw + LDS_MISC + 16);
    if (threadIdx.x == 0) { bst[0] = 0u; bst[1] = 0u; bst[2] = 0u; bst[3] = 0u; }
    __syncthreads();
    XcdBarrier bar = xcd_barrier_post((unsigned*)ws, bst);

    const int* positions = (const int*)p.in[I_POS];

    constexpr int NPH = 8;
    const int lo = p.lo, hi = p.hi;
#ifdef ONLY_PHASE
#define PH_SEL(c) ((c) == ONLY_PHASE)
#else
#define PH_SEL(c) 1
#endif
#define PH_IN(k) (lo <= (k) && (k) < hi)
#define PH_BAR(k) do { if ((k) + 1 < hi) xcd_barrier(bar, wave_s == 0 && LANE_ID() == 0); } while (0)

    if (PH_SEL(-1) && PH_IN(0)) for (int rep = 0; rep < PH_REPS(-1); ++rep) {
        PHASE_IDS();
        for (int l = 0; l < DEPTH; ++l) {
            convert_mats(p.in[I_WIN] + (size_t)l * D * N_IN, 0, 1, N_IN, D, N_IN, WinT + (size_t)l * N_INP * D, 0, RmWin{}, ldsf, tid, bid, G);
            for (int t = bid; t < (D / 64) * (D / 256); t += G)
                convert_tile_v4(p.in[I_WO] + (size_t)l * D * D, D, D, (t / (D / 256)) * 64, (t % (D / 256)) * 256, WoT + (size_t)l * D * D, RmIdent{}, ldsf, tid);
            convert_mats(p.in[I_WA] + (size_t)l * 6 * 128 * 128, (size_t)128 * 128, 6, 128, 128, 128, WaiT + (size_t)l * 6 * 256 * 128, (size_t)256 * 128, RmIdent{}, ldsf, tid, bid, G);
            convert_mats(p.in[I_WI] + (size_t)l * 6 * 128 * 128, (size_t)128 * 128, 6, 128, 128, 128, WaiT + (size_t)l * 6 * 256 * 128, (size_t)256 * 128, RmOff{128}, ldsf, tid, bid, G);
        }
        for (int i = gtid; i < DEPTH * 8 * D; i += gthreads) { const int h = i % 8, k = (i / 8) % D, l = i / (8 * D);
            Wfa[((size_t)l * 8 + h) * D + k] = (h < 6) ? p.in[I_WIN][(size_t)l * D * N_IN + (size_t)k * N_IN + C_FA + h] : 0.f; }
        for (int i = gtid; i < DEPTH * 48 * D; i += gthreads) { const int k = i % D, o = (i / D) % 48, l = i / (48 * D);
            const float w = (o < 4) ? p.in[I_WGRP][((size_t)l * D + k) * 4 + o] : (o < 36 ? p.in[I_WRT][((size_t)l * D + k) * 32 + (o - 4)] : 0.f);
            const bf16_t hi = f2bf(w);
            W36b[((size_t)l * 2 + 0) * 48 * D + (size_t)o * D + k] = hi; W36b[((size_t)l * 2 + 1) * 48 * D + (size_t)o * D + k] = f2bf(w - bf2f(hi)); }
        for (int i = gtid; i < S * 8; i += gthreads) { const int d = i & 7, t = i >> 3; const float ang = (float)positions[t] * p.inv_freq[d];
            ropecs[t * 16 + d] = cosf(ang); ropecs[t * 16 + 8 + d] = sinf(ang); }
        __syncthreads();
        for (int i = tid; i < 6 * D; i += NTHREADS) { const int k = i / 6, h = i % 6; ldsf[h * D + k] = p.in[I_WIN][(size_t)k * N_IN + C_FA + h]; }
        __syncthreads();
        for (int t0 = gwave * 2; t0 < S; t0 += gwaves * 2) {
            f32x4 v[2][8];
#pragma unroll
            for (int tk = 0; tk < 2; ++tk)
#pragma unroll
                for (int j = 0; j < 8; ++j) v[tk][j] = *(const f32x4*)(p.in[I_X] + (size_t)(t0 + tk) * D + j * 256 + lane * 4);
#pragma unroll
            for (int tk = 0; tk < 2; ++tk) {
                const int t = t0 + tk;
                float fa[6] = {0.f, 0.f, 0.f, 0.f, 0.f, 0.f};
#pragma unroll
                for (int j = 0; j < 8; ++j) {
                    const int c = j * 256 + lane * 4;
                    u32x2 o; o.x = pack2(v[tk][j][0], v[tk][j][1]); o.y = pack2(v[tk][j][2], v[tk][j][3]);
                    *(u32x2*)(xb + (size_t)t * D + c) = o;
#pragma unroll
                    for (int h = 0; h < 6; ++h) { const f32x4 w = *(const f32x4*)(ldsf + h * D + c); fa[h] += v[tk][j][0] * w[0] + v[tk][j][1] * w[1] + v[tk][j][2] * w[2] + v[tk][j][3] * w[3]; }
                    COMPILER_FENCE();
                }
#pragma unroll
                for (int h = 0; h < 6; ++h) { const float sm = wave_sum(fa[h]); if (lane == 0) logf_[h * S + t] = log_sigmoid_f(sm + p.in[I_BF][h]); }
            }
        }
        PH_BAR(0);
    }

    for (int l = 0; l < DEPTH; ++l) {
        const int pb = 1 + l * NPH;
#define hin ((l == 0) ? p.in[I_X] : (const float*)hb)
#define hout ((l == DEPTH - 1) ? p.out : hb)
#define workctr ((int*)(wsl + CTL_WORK_OFF) + l * 64)

        if (PH_SEL(0) && PH_IN(pb + 0)) {
            PHASE_IDS();
            int bz = RFL(bid); OPAQUE_S(bz);
            if (bz == 0) {
                double* part = (double*)lds_raw;
                const int per = S / 64;
                double s = 0.0;
                if (wave < 6) { for (int i = 0; i < per; ++i) s += (double)logf_[wave * S + lane * per + i]; part[wave * 64 + lane] = s; }
                __syncthreads();
                if (wave < 6) {
                    double run = 0.0;
                    for (int j = 0; j < lane; ++j) run += part[wave * 64 + j];
                    for (int i = 0; i < per; ++i) { run += (double)logf_[wave * S + lane * per + i]; cum2[wave * S + lane * per + i] = (float)(run * (double)LOG2E); }
                }
                __syncthreads();
            }
            bool conv_more = (l == 0);
#define CONV_ONE() do { if (conv_more) { __syncthreads(); if (tid == 0) *ubox = (unsigned)atomic_add_int((int*)(wsl + CTL_WORK_OFF) + 62, 1); __syncthreads(); \
                const int cid_ = RFL((int)*ubox); if (cid_ < NCONV) moe_conv_chunk(p, cid_, WguT, WdT, ldsf, tid); else conv_more = false; } } while (0)
            unsigned* cls = (unsigned*)(wsl + CTL_CLS_OFF) + l * 256;
            if (bz == 0) { WAIT_VM0(); __syncthreads(); if (tid == 0) { FENCE_REL_AGENT(); WAIT_VM0(); (void)xb_add(&cls[192], 1u); } }
            const bf16_t* Bt = WinT + (size_t)l * N_INP * D;
            constexpr int ntm = S / 256;
            const unsigned nooff[2][2] = {{0u, 0u}, {0u, 0u}};
            for (int i = 0; i < (bid & 3); ++i) CONV_ONE();
            for (;;) {
                __syncthreads();
                if (tid == 0) *ubox = (unsigned)atomic_add_int(workctr + 9, 1);
                __syncthreads();
                int t = RFL((int)*ubox);
                if (t >= ntm * 21) break;
                int pm, pn, kcls;
                if (t < ntm * 6) { pm = t / 6; pn = 15 + t % 6; kcls = 0; }
                else if (t < ntm * 12) { t -= ntm * 6; pm = t / 6; pn = 9 + t % 6; kcls = 1; }
                else { t -= ntm * 12; pm = t / 9; pn = t % 9; kcls = 2; }
                f32x4 acc[2][2][4][2];
                gemm_tile<false>(xb, pm * 256, nooff, Bt, pn * 256, D, lds_raw, acc, tid);
                int et = tid; OPAQUE(et); const int wr = et >> 8, wc = (et >> 6) & 3, fr = et & 15, fq = (et >> 4) & 3;
                if (pn < 6 || (pn >= 9 && pn < 19)) {
                    bf16_t* dst; float scale = 1.f; bool rope = false;
                    if (pn < 3) { dst = Qa; scale = QSCALE_A; } else if (pn < 6) { dst = Ka; } else if (pn < 12) { dst = Xr; } else if (pn < 15) { dst = Gr; }
                    else if (pn < 17) { dst = Qc; scale = QSCALE_C; rope = true; } else { dst = Kc; rope = true; }
                    const bool headmajor = (pn < 6) || (pn >= 15);
                    const int segpn = (pn < 3) ? pn : (pn < 6) ? pn - 3 : (pn < 12) ? pn - 9 : (pn < 15) ? pn - 12 : (pn < 17) ? pn - 15 : pn - 17;
#pragma unroll
                    for (int ai = 0; ai < 2; ++ai)
#pragma unroll
                        for (int m = 0; m < 4; ++m)
#pragma unroll
                            for (int bj = 0; bj < 2; ++bj)
#pragma unroll
                                for (int n = 0; n < 2; ++n) {
                                    const int dd = wc * 32 + n * 16 + fr;
#pragma unroll
                                    for (int j = 0; j < 4; ++j) {
                                        const int row = pm * 256 + ai * 128 + wr * 64 + m * 16 + fq * 4 + j;
                                        float v = acc[ai][bj][m][n][j];
                                        if (rope && n == 0 && (wc & 1) == 0) {
                                            const float pv = SHX(v, 8);
                                            const float cs = ropecs[row * 16 + (fr & 7)], sn = ropecs[row * 16 + 8 + (fr & 7)];
                                            v = (fr < 8) ? (v * cs - pv * sn) : (v * cs + pv * sn);
                                        }
                                        v *= scale;
                                        *(bf16_t*)(lds_raw + (ai * 128 + wr * 64 + m * 16 + fq * 4 + j) * 528 + (bj * 128 + dd) * 2) = f2bf(v);
                                    }
                                }
                    __syncthreads();
#pragma unroll 4
                    for (int i = 0; i < 16; ++i) {
                        const int idx = et + i * 512, lrow = idx >> 5, ch = idx & 31, row = pm * 256 + lrow;
                        const u32x4 val = *(const u32x4*)(lds_raw + lrow * 528 + ch * 16);
                        size_t gi;
                        if (headmajor) gi = ((size_t)(segpn * 2 + (ch >> 4)) * S + row) * 128 + (ch & 15) * 8;
                        else gi = (size_t)row * LRU_W + segpn * 256 + ch * 8;
                        *(u32x4*)(dst + gi) = val;
                    }
                    __syncthreads();
                    if (pn >= 15) {
                        float* part = ldsf;
#pragma unroll
                        for (int ai = 0; ai < 2; ++ai)
#pragma unroll
                            for (int m = 0; m < 4; ++m)
#pragma unroll
                                for (int bj = 0; bj < 2; ++bj)
#pragma unroll
                                    for (int j = 0; j < 4; ++j) {
                                        float ss = acc[ai][bj][m][0][j] * acc[ai][bj][m][0][j] + acc[ai][bj][m][1][j] * acc[ai][bj][m][1][j];
                                        ss += SHX(ss, 1); ss += SHX(ss, 2); ss += SHX(ss, 4); ss += SHX(ss, 8);
                                        if (fr == 0) part[(wc * 2 + bj) * 256 + ai * 128 + wr * 64 + m * 16 + fq * 4 + j] = ss;
                                    }
                        __syncthreads();
                        {
                            const int bj = et >> 8, row = et & 255;
                            float v0 = part[(0 * 2 + bj) * 256 + row] + part[(1 * 2 + bj) * 256 + row], v1 = part[(2 * 2 + bj) * 256 + row] + part[(3 * 2 + bj) * 256 + row];
                            v0 = fmaxf(v0, SHX(v0, 1)); v0 = fmaxf(v0, SHX(v0, 2)); v0 = fmaxf(v0, SHX(v0, 4)); v0 = fmaxf(v0, SHX(v0, 8)); v0 = xrow16_max(v0);
                            v1 = fmaxf(v1, SHX(v1, 1)); v1 = fmaxf(v1, SHX(v1, 2)); v1 = fmaxf(v1, SHX(v1, 4)); v1 = fmaxf(v1, SHX(v1, 8)); v1 = xrow16_max(v1);
                            if ((et & 63) == 0) {
                                unsigned* q2p = (unsigned*)(wsl + CTL_QK2_OFF) + l * 16 + (pn >= 17 ? 8 : 0) + (segpn * 2 + bj) * 2;
                                atomic_max_u32(q2p, __builtin_bit_cast(unsigned, v0)); atomic_max_u32(q2p + 1, __builtin_bit_cast(unsigned, v1));
                            }
                        }
                        __syncthreads();
                    }
                    if (pn >= 3 && pn < 6) {
                        float* part = ldsf;
#pragma unroll
                        for (int ai = 0; ai < 2; ++ai)
#pragma unroll
                            for (int m = 0; m < 4; ++m)
#pragma unroll
                                for (int bj = 0; bj < 2; ++bj)
#pragma unroll
                                    for (int j = 0; j < 4; ++j) {
                                        float ss = acc[ai][bj][m][0][j] * acc[ai][bj][m][0][j] + acc[ai][bj][m][1][j] * acc[ai][bj][m][1][j];
                                        ss += SHX(ss, 1); ss += SHX(ss, 2); ss += SHX(ss, 4); ss += SHX(ss, 8);
                                        if (fr == 0) part[(wc * 2 + bj) * 256 + ai * 128 + wr * 64 + m * 16 + fq * 4 + j] = ss;
                                    }
                        __syncthreads();
                        {
                            const int bj = et >> 8, row = et & 255;
                            float v = part[(0 * 2 + bj) * 256 + row] + part[(1 * 2 + bj) * 256 + row] + part[(2 * 2 + bj) * 256 + row] + part[(3 * 2 + bj) * 256 + row];
                            v = fmaxf(v, SHX(v, 1)); v = fmaxf(v, SHX(v, 2)); v = fmaxf(v, SHX(v, 4)); v = fmaxf(v, SHX(v, 8)); v = xrow16_max(v);
                            if ((et & 63) == 0) kmax2[((pn - 3) * 2 + bj) * NKT + pm * 4 + ((et >> 6) & 3)] = v;
                        }
                        __syncthreads();
                    }
                } else {
                    bf16_t* dst = (pn < 9) ? VaT : VcT;
                    const int segpn = (pn < 9) ? pn - 6 : pn - 19;
#pragma unroll
                    for (int ai = 0; ai < 2; ++ai)
#pragma unroll
                        for (int m = 0; m < 4; ++m)
#pragma unroll
                            for (int bj = 0; bj < 2; ++bj)
#pragma unroll
                                for (int n = 0; n < 2; ++n) {
                                    const int dd = wc * 32 + n * 16 + fr;
                                    const f32x4 a = acc[ai][bj][m][n];
                                    u32x2 o; o.x = pack2(a[0], a[1]); o.y = pack2(a[2], a[3]);
                                    const int s6 = m * 16 + fq * 4, pos = (s6 & 32) + ((s6 >> 2) & 3) * 8 + ((s6 >> 4) & 1) * 4;
                                    *(u32x2*)(lds_raw + ((bj * 4 + ai * 2 + wr) * 128 + dd) * 128 + ((((pos >> 3) ^ (dd & 7))) << 4) + (pos & 7) * 2) = o;
                                }
                    __syncthreads();
#pragma unroll 4
                    for (int i = 0; i < 16; ++i) {
                        const int idx = et + i * 512, blk = idx >> 10, dd = (idx >> 3) & 127, c = idx & 7;
                        const u32x4 val = *(const u32x4*)(lds_raw + (blk * 128 + dd) * 128 + ((c ^ (dd & 7)) << 4));
                        *(u32x4*)(dst + (((size_t)(segpn * 2 + (blk >> 2)) * NKT + (pm * 4 + (blk & 3))) * 128 + dd) * 64 + c * 8) = val;
                    }
                    __syncthreads();
                }
                WAIT_VM0();
                __syncthreads();
                if (et == 0) { FENCE_REL_AGENT(); WAIT_VM0(); (void)xb_add(&cls[kcls * 64], 1u); }
                CONV_ONE();
            }
        }

        if (PH_SEL(1) && PH_IN(pb + 1)) {
            PHASE_IDS();
            const float lam_init = (l == 0) ? 0.2f : 0.35550906759f;
            const float s1 = wave_sum(p.in[I_LQ1][l * 64 + lane] * p.in[I_LK1][l * 64 + lane]);
            const float s2 = wave_sum(p.in[I_LQ2][l * 64 + lane] * p.in[I_LK2][l * 64 + lane]);
            const float lam = fexp(s1) - fexp(s2) + lam_init;
            constexpr int NLRU = NKT * 6, NQB = S / 128;
            bool conv_more = (l == 0);
            unsigned* cls = (unsigned*)(wsl + CTL_CLS_OFF) + l * 256;
            unsigned* bw = (unsigned*)wsl;
#define WAIT_CLASS(k, n) do { __syncthreads(); if (tid == 0) { XB_SPIN(xb_ld(&cls[(k) * 64]) < (unsigned)(n), bw); FENCE_ACQ_AGENT(); WAIT_VM0(); } __syncthreads(); } while (0)
#ifndef NO_DIFF
            {
                constexpr int NQB2 = S / 256;
                int total = 0;
                for (int q = 0; q < NQB2; ++q) total += ((4 * q + 4 + DCH - 1) / DCH) * 8;
                WAIT_CLASS(0, (S / 256) * 6);
                for (;;) {
                    __syncthreads();
                    if (tid == 0) *ubox = (unsigned)atomic_add_int(workctr, 1);
                    __syncthreads();
                    int u = RFL((int)*ubox);
                    if (u >= total) break;
                    int qb = NQB2 - 1;
                    for (;; --qb) { const int nu = ((4 * qb + 4 + DCH - 1) / DCH) * 8; if (u < nu) break; u -= nu; }
                    const int c = u >> 3, h = (u >> 1) & 3, mp = u & 1;
                    const int t0 = c * DCH, t1 = (t0 + DCH < 4 * qb + 4) ? t0 + DCH : 4 * qb + 4;
                    const unsigned* q2p = (const unsigned*)(wsl + CTL_QK2_OFF) + l * 16;
                    const float bnd = sqrtf(__builtin_bit_cast(float, q2p[h * 2 + mp]) * __builtin_bit_cast(float, q2p[8 + h * 2 + mp])) * (QSCALE_C * 1.02f) + 0.01f;
                    attn_dmap_unit(Qc + (size_t)h * S * 128, Kc + (size_t)h * S * 128, VcT + (size_t)h * S * 128, mp, qb, t0, t1,
                                   dpo + (size_t)(h * 2 + mp) * DPART_ROWS * 128, dpml + (size_t)(h * 2 + mp) * DPART_ROWS * 2, c, RFL_F(bnd), lds_raw, tid);
                    CONV_ONE();
                }
            }
#endif
#ifndef NO_LRU
            WAIT_CLASS(1, (S / 256) * 6);
            for (;;) {
                __syncthreads();
                if (tid == 0) *ubox = (unsigned)atomic_add_int(workctr + 10, 1);
                __syncthreads();
                const int u = RFL((int)*ubox);
                if (u >= NLRU) break;
                lru_unit_a(u / 6, u % 6, l, p, Xr, WaiT + (size_t)l * 6 * 256 * 128, hloc, ploc, sumA, sumH, lds_raw, tid);
            }
#endif
#ifndef NO_FOX
            WAIT_CLASS(2, (S / 256) * 9);
            WAIT_CLASS(3, 1);
            for (;;) {
                __syncthreads();
                if (tid == 0) *ubox = (unsigned)atomic_add_int(workctr + 1, 1);
                __syncthreads();
                const int u = RFL((int)*ubox);
                if (u >= NQB * FOX_H) break;
                const int qb = NQB - 1 - u / FOX_H, h = u % FOX_H;
                attn_unit<0>(Qa + (size_t)h * S * 128, Ka + (size_t)h * S * 128, VaT + (size_t)h * S * 128, cum2 + (size_t)h * S, kmax2 + h * NKT, qb, concat, h * 128,
                             0.f, 0.f, nullptr, lds_raw, tid);
            }
#endif
            while (conv_more) CONV_ONE();
            PH_BAR(pb + 1);
        }

        if (PH_SEL(2) && PH_IN(pb + 2)) for (int rep = 0; rep < PH_REPS(2); ++rep) {
            PHASE_IDS();
            {
                const int per = (NKT * 6 + G - 1) / G;
                const int c = tid & 127, tq = tid >> 7;
                float cr = 0.f; int pgrp = -1;
                for (int u = bid * per; u < (bid + 1) * per && u < NKT * 6; ++u) {
                    const int grp = u / NKT, chunk = u % NKT, ch = grp * 128 + c;
                    if (grp != pgrp) {
                        pgrp = grp;
                        const int seg = (chunk + 3) >> 2, j0 = tq * seg, j1 = (j0 + seg < chunk) ? j0 + seg : chunk;
                        float pa = 1.f, ph = 0.f;
                        int j = j0;
                        for (; j + 16 <= j1; j += 16) {
                            float a8[16], h8[16];
#pragma unroll
                            for (int q = 0; q < 16; ++q) { a8[q] = sumA[(size_t)(j + q) * LRU_W + ch]; h8[q] = sumH[(size_t)(j + q) * LRU_W + ch]; }
#pragma unroll
                            for (int q = 0; q < 16; ++q) { pa *= a8[q]; ph = a8[q] * ph + h8[q]; }
                        }
                        for (; j < j1; ++j) { const float a = sumA[(size_t)j * LRU_W + ch]; pa *= a; ph = a * ph + sumH[(size_t)j * LRU_W + ch]; }
                        __syncthreads();
                        ldsf[(tq * 128 + c) * 2] = pa; ldsf[(tq * 128 + c) * 2 + 1] = ph;
                        __syncthreads();
                        cr = 0.f;
#pragma unroll
                        for (int s = 0; s < 4; ++s) cr = ldsf[(s * 128 + c) * 2] * cr + ldsf[(s * 128 + c) * 2 + 1];
                    }
                    float hl[16], pl[16]; bf16_t gg[16];
#pragma unroll
                    for (int i = 0; i < 16; ++i) { const size_t gi = (size_t)(chunk * 64 + tq * 16 + i) * LRU_W + ch; const unsigned hp = ((const unsigned*)hloc)[gi]; hl[i] = bf2f((bf16_t)(hp & 0xffffu)); pl[i] = bf2f((bf16_t)(hp >> 16)); gg[i] = Gr[gi]; }
                    const float an = sumA[(size_t)chunk * LRU_W + ch], hn = sumH[(size_t)chunk * LRU_W + ch];
#pragma unroll
                    for (int i = 0; i < 16; ++i)
                        concat[(size_t)(chunk * 64 + tq * 16 + i) * D + FOX_W + ch] = f2bf(gelu_tanh_f(bf2f(gg[i])) * (hl[i] + pl[i] * cr));
                    cr = an * cr + hn;
                }
            }
            {
                const float lam_init = (l == 0) ? 0.2f : 0.35550906759f;
                const float s1 = wave_sum(p.in[I_LQ1][l * 64 + lane] * p.in[I_LK1][l * 64 + lane]);
                const float s2 = wave_sum(p.in[I_LQ2][l * 64 + lane] * p.in[I_LK2][l * 64 + lane]);
                const float lam = fexp(s1) - fexp(s2) + lam_init;
                const float* sg = p.in[I_SUBG] + l * 128;
                const float g0 = sg[2 * lane], g1 = sg[2 * lane + 1];
                static_assert(NCH <= 8, "the merge below keeps one (map, chunk) pair per lane: 2 x 8 lanes");
                for (int q = gwave; q < S; q += gwaves) {
                    const int nch = (q >> 6) / DCH + 1;
                    float mv = -INFINITY, lv = 0.f;
                    { const int c = lane & 7, hm = lane >> 3;
                      if (c < nch) { const float* ML = dpml + ((size_t)hm * DPART_ROWS + dpart_row(c, q)) * 2; mv = ML[0]; lv = ML[1]; } }
                    unsigned pk[4][2][NCH];
#pragma unroll
                    for (int h = 0; h < 4; ++h)
#pragma unroll
                        for (int mp = 0; mp < 2; ++mp) {
                            const unsigned* OP = (const unsigned*)(dpo + (size_t)(h * 2 + mp) * DPART_ROWS * 128);
#pragma unroll
                            for (int c = 0; c < NCH; ++c) pk[h][mp][c] = (c < nch) ? OP[(size_t)dpart_row(c, q) * 64 + lane] : 0u;
                        }
                    float Mx = mv; Mx = fmaxf(Mx, DPP_X1(Mx)); Mx = fmaxf(Mx, DPP_X2(Mx)); Mx = fmaxf(Mx, DPP_X7(Mx));
                    const float wv = (mv == -INFINITY) ? 0.f : FAST_EXP2(mv - Mx);
                    float Lp = lv * wv; Lp += DPP_X1(Lp); Lp += DPP_X2(Lp); Lp += DPP_X7(Lp);
#pragma unroll
                    for (int h = 0; h < 4; ++h) {
                        float om[2][2];
#pragma unroll
                        for (int mp = 0; mp < 2; ++mp) {
                            float o0 = 0.f, o1 = 0.f;
#pragma unroll
                            for (int c = 0; c < NCH; ++c) { const float w = RDLANE(wv, (h * 2 + mp) * 8 + c); o0 += bf2f((bf16_t)(pk[h][mp][c] & 0xffffu)) * w; o1 += bf2f((bf16_t)(pk[h][mp][c] >> 16)) * w; }
                            const float il = 1.f / RDLANE(Lp, (h * 2 + mp) * 8);
                            om[mp][0] = o0 * il; om[mp][1] = o1 * il;
                        }
                        const float v0 = om[0][0] - lam * om[1][0], v1 = om[0][1] - lam * om[1][1];
                        const float ss = wave_sum(v0 * v0 + v1 * v1);
                        const float rs = (1.f - lam_init) / sqrtf(ss * (1.f / 128.f) + LN_EPS);
                        *(unsigned*)(concat + (size_t)q * D + 1536 + h * 128 + 2 * lane) = pack2(v0 * rs * g0, v1 * rs * g1);
                    }
                }
            }
            PH_BAR(pb + 2);
        }

        if (PH_SEL(3) && PH_IN(pb + 3)) {
            PHASE_IDS();
            const bf16_t* Bt = WoT + (size_t)l * D * D;
            constexpr int ntn = D / 256, ntm = S / 256;
            static_assert(ntn == 8, "the panel exchange is written for 8 column tiles");
            const unsigned nooff[2][2] = {{0u, 0u}, {0u, 0u}};
            const float* g1 = p.in[I_LN1G] + (size_t)l * D; const float* b1 = p.in[I_LN1B] + (size_t)l * D;
            const float* bg = p.in[I_BGRP] + l * 4; const float* br = p.in[I_BRT] + l * 32;
            const bf16_t* Wb = W36b + (size_t)l * 2 * 48 * D;
            int* lcnt = (int*)(lds_raw + LDS_MISC + M_LCNT);
            const int segcap = ((ntm * ntn + G - 1) / G) * 32;
            unsigned* pcnt = (unsigned*)(wsl + CTL_PAN_OFF) + l * 1024;
            unsigned long long* xbuf = (unsigned long long*)(wsl + A_XBUF);
            unsigned* part = (unsigned*)(wsl + A_PART);
            LAS float* Stab = (LAS float*)(lds_raw + LDS_MISC + M_RTOK);
            float* lgt = (float*)(lds_raw + LDS_MISC + 4096);
            if (tid < 32) lcnt[tid] = 0;
            __syncthreads();
            for (int t0 = bid; t0 < ntm * ntn; t0 += G) {
                int t = t0;
                if (G == 256 && ntm * ntn == 256) { const int x = t0 & 7, j = t0 >> 3; t = (x * 4 + (j >> 3)) * ntn + (j & 7); }
                const int pm = t / ntn, pn = t % ntn;
                f32x4 v[2][16];
                {
                    f32x4 acc[2][2][4][2];
                    gemm_tile<false>(concat, pm * 256, nooff, Bt, pn * 256, D, lds_raw, acc, tid);
                    int et = tid; OPAQUE(et); const int wr = et >> 8, wc = (et >> 6) & 3, fr = et & 15, fq = (et >> 4) & 3;
#pragma unroll
                    for (int ai = 0; ai < 2; ++ai) {
#pragma unroll
                        for (int m = 0; m < 4; ++m)
#pragma unroll
                            for (int bj = 0; bj < 2; ++bj)
#pragma unroll
                                for (int n = 0; n < 2; ++n)
#pragma unroll
                                    for (int j = 0; j < 4; ++j)
                                        *(float*)(lds_raw + (wr * 64 + m * 16 + fq * 4 + j) * 1040 + (bj * 128 + wc * 32 + n * 16 + fr) * 4) = acc[ai][bj][m][n][j];
                        __syncthreads();
#pragma unroll
                        for (int i = 0; i < 16; ++i) {
                            const int lrow = i * 8 + (et >> 6), c4 = et & 63;
                            const size_t gi = (size_t)(pm * 256 + ai * 128 + lrow) * D + pn * 256 + c4 * 4;
                            v[ai][i] = *(const GAS f32x4*)(hin + gi);
                        }
#pragma unroll
                        for (int i = 0; i < 16; ++i) {
                            const int lrow = i * 8 + (et >> 6), c4 = et & 63;
                            v[ai][i] = ALPHA * v[ai][i] + *(const f32x4*)(lds_raw + lrow * 1040 + c4 * 16);
                        }
                        __syncthreads();
                    }
                }
                int et2 = tid; OPAQUE(et2); const int el = et2 & 63, ew = wave_s, er16 = et2 & 15, eq4 = (et2 >> 4) & 3;
#pragma unroll
                for (int q = 0; q < 6; ++q) {
                    const int seg = ew * 6 + q, n2 = seg * 2 + (el >> 5), p5 = el & 31;
                    GLDS16(Wb + (size_t)n2 * D + pn * 256 + ((p5 ^ (n2 & 15)) << 3), lds_raw + 65536 + seg * 1024 + el * 16);
                }
                float my_mt = 0.f, my_m2 = 0.f;
                for (int trep = 0; trep < REP_STATS; ++trep)
#pragma unroll
                for (int ai = 0; ai < 2; ++ai)
#pragma unroll
                    for (int i4 = 0; i4 < 16; i4 += 4) {
                        float mt4[4], m24[4];
#pragma unroll
                        for (int u = 0; u < 4; ++u) { const f32x4 x = v[ai][i4 + u]; mt4[u] = wave_sum((x[0] + x[1]) + (x[2] + x[3])) * (1.f / 256.f); }
#pragma unroll
                        for (int u = 0; u < 4; ++u) { const f32x4 d = v[ai][i4 + u] - mt4[u]; m24[u] = wave_sum((d[0] * d[0] + d[1] * d[1]) + (d[2] * d[2] + d[3] * d[3])); }
#pragma unroll
                        for (int u = 0; u < 4; ++u) if (el == ai * 16 + i4 + u) { my_mt = mt4[u]; my_m2 = m24[u]; }
                        COMPILER_FENCE();
                    }
                unsigned* bw = (unsigned*)wsl;
                if (el < 32) {
                    const int grow = (el >> 4) * 128 + (el & 15) * 8 + ew;
                    xst64(&xbuf[(size_t)(pm * 256 + grow) * 8 + pn], ((unsigned long long)__builtin_bit_cast(unsigned, my_m2) << 32) | __builtin_bit_cast(unsigned, my_mt));
                }
                WAIT_VM0();
                __syncthreads();
                if (et2 == 0) { (void)xb_add(&pcnt[pm * 16], 1u); XB_SPIN(xb_ld(&pcnt[pm * 16]) < 8u, bw); FENCE_ACQ_AGENT(); }
                __syncthreads();
                unsigned long long wk[4];
#pragma unroll
                for (int k = 0; k < 4; ++k) {
                    const int r = k * 8 + (el >> 3), grow = (r >> 4) * 128 + (r & 15) * 8 + ew;
                    wk[k] = xld64(&xbuf[(size_t)(pm * 256 + grow) * 8 + (el & 7)]);
                }
#pragma unroll
                for (int k = 0; k < 4; ++k) {
                    const int r = k * 8 + (el >> 3);
                    const unsigned long long w = wk[k];
                    const float mt = __builtin_bit_cast(float, (unsigned)w), m2 = __builtin_bit_cast(float, (unsigned)(w >> 32));
                    float ms = mt; ms += DPP_X1(ms); ms += DPP_X2(ms); ms += DPP_X7(ms);
                    const float mean = ms * 0.125f, dm = mt - mean;
                    float q = m2 + 256.f * dm * dm; q += DPP_X1(q); q += DPP_X2(q); q += DPP_X7(q);
                    const float rstd = 1.f / sqrtf(q * (1.f / D) + LN_EPS);
                    if ((el & 7) == 0) { Stab[(ew * 32 + r) * 2] = mean; Stab[(ew * 32 + r) * 2 + 1] = rstd; }
                }
                WAVE_SYNC();
                const f32x4 gv = *(const f32x4*)(g1 + pn * 256 + el * 4), bv = *(const f32x4*)(b1 + pn * 256 + el * 4);
                LAS unsigned char* wt = (LAS unsigned char*)lds_raw + ew * 8192;
                const LAS unsigned char* wbl = (const LAS unsigned char*)lds_raw + 65536;
                for (int rrep = 0; rrep < REP_ROUTER; ++rrep)
#pragma unroll
                for (int ai = 0; ai < 2; ++ai) {
                    u32x2 lokeep[16];
#pragma unroll
                    for (int i = 0; i < 16; ++i) {
                        const float mean = Stab[(ew * 32 + ai * 16 + i) * 2], rstd = Stab[(ew * 32 + ai * 16 + i) * 2 + 1];
                        const f32x4 hv = mul_s4(v[ai][i] - mean, rstd) * gv + bv;
                        u32x2 o; o.x = pack2(hv[0], hv[1]); o.y = pack2(hv[2], hv[3]);
                        lokeep[i].x = pack2(hv[0] - bf2f((bf16_t)(o.x & 0xffffu)), hv[1] - bf2f((bf16_t)(o.x >> 16)));
                        lokeep[i].y = pack2(hv[2] - bf2f((bf16_t)(o.y & 0xffffu)), hv[3] - bf2f((bf16_t)(o.y >> 16)));
                        *(LAS u32x2*)(wt + i * 512 + (((el >> 1) ^ i) << 4) + (el & 1) * 8) = o;
                        COMPILER_FENCE();
                    }
                    WAVE_SYNC();
                    f32x4 ac[3];
#pragma unroll
                    for (int nt = 0; nt < 3; ++nt) ac[nt] = (f32x4){0.f, 0.f, 0.f, 0.f};
#pragma unroll 2
                    for (int ks = 0; ks < 8; ++ks) {
                        const int co = ((ks * 4 + eq4) ^ er16) << 4;
                        const bf16x8 ah = *(const LAS bf16x8*)(wt + er16 * 512 + co);
#pragma unroll
                        for (int nt = 0; nt < 3; ++nt) {
                            const bf16x8 bh = *(const LAS bf16x8*)(wbl + (nt * 16 + er16) * 512 + co);
                            const bf16x8 bl = *(const LAS bf16x8*)(wbl + (48 + nt * 16 + er16) * 512 + co);
                            ac[nt] = MFMA16(ah, bh, ac[nt]); ac[nt] = MFMA16(ah, bl, ac[nt]);
                        }
                    }
                    WAVE_SYNC();
#pragma unroll
                    for (int i = 0; i < 16; ++i) *(LAS u32x2*)(wt + i * 512 + (((el >> 1) ^ i) << 4) + (el & 1) * 8) = lokeep[i];
                    WAVE_SYNC();
#pragma unroll 2
                    for (int ks = 0; ks < 8; ++ks) {
                        const int co = ((ks * 4 + eq4) ^ er16) << 4;
                        const bf16x8 al = *(const LAS bf16x8*)(wt + er16 * 512 + co);
#pragma unroll
                        for (int nt = 0; nt < 3; ++nt) {
                            const bf16x8 bh = *(const LAS bf16x8*)(wbl + (nt * 16 + er16) * 512 + co);
                            ac[nt] = MFMA16(al, bh, ac[nt]);
                        }
                    }
#pragma unroll
                    for (int nt = 0; nt < 3; ++nt)
#pragma unroll
                        for (int j = 0; j < 4; ++j) {
                            const float cv = ac[nt][j];
                            xst32(&part[((size_t)pn * S + pm * 256 + ai * 128 + (eq4 * 4 + j) * 8 + ew) * 48 + nt * 16 + er16], __builtin_bit_cast(unsigned, cv));
                        }
                    WAVE_SYNC();
                }
                WAIT_VM0();
                __syncthreads();
                if (et2 == 0) (void)xb_add(&pcnt[512 + pm * 16], 1u);
                for (int srep = 0; srep < REP_STORES; ++srep)
#pragma unroll
                for (int ai = 0; ai < 2; ++ai)
#pragma unroll
                    for (int i = 0; i < 16; ++i) {
                        const float mean = Stab[(ew * 32 + ai * 16 + i) * 2], rstd = Stab[(ew * 32 + ai * 16 + i) * 2 + 1];
                        const f32x4 hv = mul_s4(v[ai][i] - mean, rstd) * gv + bv;
                        const size_t gi = (size_t)(pm * 256 + ai * 128 + i * 8 + ew) * D + pn * 256 + el * 4;
                        u32x2 o; o.x = pack2(hv[0], hv[1]); o.y = pack2(hv[2], hv[3]);
                        *(u32x2*)(h1b + gi) = o;
                        COMPILER_FENCE();
                    }
                if (et2 == 0) { XB_SPIN(xb_ld(&pcnt[512 + pm * 16]) < 8u, bw); FENCE_ACQ_AGENT(); }
                __syncthreads();
                int rt = tid; OPAQUE(rt);
#pragma unroll
                for (int k = 0; k < 3; ++k) {
                    const int idx = rt + k * 512, tk = idx / 48, n = idx - tk * 48;
                    unsigned pq[8];
#pragma unroll
                    for (int q = 0; q < 8; ++q) pq[q] = xb_ld(&part[((size_t)q * S + pm * 256 + pn * 32 + tk) * 48 + n]);
                    float a = 0.f;
#pragma unroll
                    for (int q = 0; q < 8; ++q) a += __builtin_bit_cast(float, pq[q]);
                    lgt[idx] = a;
                }
                __syncthreads();
                if (rt < 32) {
                    const int t = pm * 256 + pn * 32 + rt; const float* L = lgt + rt * 48;
                    float gl[4];
#pragma unroll
                    for (int q = 0; q < 4; ++q) gl[q] = L[q] + bg[q];
                    int gi = 0; float gm = gl[0];
#pragma unroll
                    for (int q = 1; q < 4; ++q) if (gl[q] > gm) { gm = gl[q]; gi = q; }
                    float gs = 0.f;
#pragma unroll
                    for (int q = 0; q < 4; ++q) gs += fexp(gl[q] - gm);
                    const float gweight = 1.f / gs;
                    float E[8];
#pragma unroll
                    for (int e = 0; e < 8; ++e) E[e] = L[4 + gi * 8 + e] + br[gi * 8 + e];
                    int e1 = 0; float m1 = E[0];
#pragma unroll
                    for (int e = 1; e < 8; ++e) if (E[e] > m1) { m1 = E[e]; e1 = e; }
                    int e2 = -1; float m2 = -INFINITY;
#pragma unroll
                    for (int e = 0; e < 8; ++e) if (e != e1 && E[e] > m2) { m2 = E[e]; e2 = e; }
                    const float p2 = fexp(m2 - m1), w1 = 1.f / (1.f + p2), w2 = p2 / (1.f + p2);
                    const int ge1 = gi * 8 + e1, ge2 = gi * 8 + e2;
                    const int i1 = (ge1 * G + bid) * segcap + atomic_add_int(&lcnt[ge1], 1);
                    ltok[i1] = t; lw[i1] = gweight * w1; lslot[i1] = 0;
                    const int i2 = (ge2 * G + bid) * segcap + atomic_add_int(&lcnt[ge2], 1);
                    ltok[i2] = t; lw[i2] = gweight * w2; lslot[i2] = 1;
                }
                __syncthreads();
            }
            { int ft = tid; OPAQUE(ft); if (ft < 32) cntb[bid * 32 + ft] = lcnt[ft]; }
            PH_BAR(pb + 3);
        }

        if (PH_SEL(5) && PH_IN(pb + 5)) {
            PHASE_IDS();
            const unsigned nooff[2][2] = {{0u, 0u}, {0u, 0u}};
            const int segcap = ((S / 256 * (D / 256) + G - 1) / G) * 32;
            moe_prefix(cntb, G, lds_raw, tid);
            const int* ctot = (const int*)(lds_raw + LDS_MISC + M_CTOT); const int* coff = (const int*)(lds_raw + LDS_MISC + M_COFF);
            const int* rtok = (const int*)(lds_raw + LDS_MISC + M_RTOK); const float* rw = (const float*)(lds_raw + LDS_MISC + M_RW);
            const int* rslot = (const int*)(lds_raw + LDS_MISC + M_RSLOT);
            unsigned* done = (unsigned*)(wsl + CTL_DONE_OFF) + l * 1024;
            int* mq = (int*)(wsl + CTL_MQ_OFF) + l * 128;
            const int myx = (int)(xb_xcc_id() & 7u);
            int qi = 0;
            for (;;) {
                __syncthreads();
                if (tid == 0) {
                    unsigned r = 0xffffffffu;
                    while (qi < 8) {
                        const int xx = (myx + qi) & 7;
                        int nm = 0;
#pragma unroll
                        for (int k = 0; k < NEXP / 8; ++k) nm += (ctot[xx + 8 * k] + 255) / 256;
                        const int got = atomic_add_int(mq + xx * 16, 1);
                        if (got < nm * 12) { r = ((unsigned)xx << 24) | (unsigned)got; break; }
                        ++qi;
                    }
                    *ubox = r;
                }
                __syncthreads();
                const unsigned rr = (unsigned)RFL((int)*ubox);
                if (rr == 0xffffffffu) break;
                const int xq = (int)(rr >> 24);
                int u = (int)(rr & 0xffffffu);
                int nmt = 0;
#pragma unroll
                for (int k = 0; k < NEXP / 8; ++k) nmt += (RFL(ctot[xq + 8 * k]) + 255) / 256;
                const bool down = (u >= nmt * 4);
                const int per = down ? 8 : 4;
                if (down) u -= nmt * 4;
                int e = xq;
                for (;; e += 8) { const int nt = ((RFL(ctot[e]) + 255) / 256) * per; if (u < nt) break; u -= nt; }
                const int c = RFL(ctot[e]), off = RFL(coff[e]);
                const int mt = u / per, pn = u % per, m0 = mt * 256;
                moe_rowtable(ltok, lw, lslot, e, m0, c, G, segcap, lds_raw, tid);
                f32x4 acc[2][2][4][2];
                if (!down) {
                    const bf16_t* Bt = WguT + ((size_t)l * NEXP + e) * 1024 * D;
                    unsigned aoff[2][2];
                    int st = tid; OPAQUE(st); int R[2], C[2]; stage_geom(st, R, C);
#pragma unroll
                    for (int h = 0; h < 2; ++h)
#pragma unroll
                        for (int i = 0; i < 2; ++i) aoff[h][i] = (unsigned)(rtok[h * 128 + R[i]] * D + C[i]);
                    gemm_tile<true>(h1b, 0, aoff, Bt, pn * 256, D, lds_raw, acc, tid);
                    int et = tid; OPAQUE(et); const int wr = et >> 8, wc = (et >> 6) & 3, fr = et & 15, fq = (et >> 4) & 3;
#pragma unroll
                    for (int ai = 0; ai < 2; ++ai)
#pragma unroll
                        for (int m = 0; m < 4; ++m)
#pragma unroll
                            for (int j = 0; j < 4; ++j) {
                                const int r = ai * 128 + wr * 64 + m * 16 + fq * 4 + j;
                                const float wgt = rw[r];
#pragma unroll
                                for (int bj = 0; bj < 2; ++bj)
                                    *(bf16_t*)(lds_raw + r * 272 + (bj * 64 + wc * 16 + fr) * 2) = f2bf(silu_f(acc[ai][bj][m][0][j]) * acc[ai][bj][m][1][j] * wgt);
                            }
                    __syncthreads();
#pragma unroll 4
                    for (int i = 0; i < 8; ++i) {
                        const int idx = et + i * 512, r = idx >> 4, ch = idx & 15;
                        if (m0 + r < c) *(u32x4*)(act + (size_t)(off + m0 + r) * DFF + pn * 128 + ch * 8) = *(const u32x4*)(lds_raw + r * 272 + ch * 16);
                    }
                    WAIT_VM0();
                    __syncthreads();
                    if (et == 0) { FENCE_REL_AGENT(); WAIT_VM0(); (void)xb_add(&done[e * 32 + mt], 1u); }
                } else {
                    const bf16_t* Bt = WdT + ((size_t)l * NEXP + e) * D * DFF;
                    if (tid == 0) {
                        unsigned* bw = (unsigned*)wsl;
                        XB_SPIN(xb_ld(&done[e * 32 + mt]) < 4u, bw);
                        FENCE_ACQ_AGENT();
                        WAIT_VM0();
                    }
                    __syncthreads();
                    gemm_tile<false>(act, off + m0, nooff, Bt, pn * 256, DFF, lds_raw, acc, tid);
                    int et = tid; OPAQUE(et); const int wr = et >> 8, wc = (et >> 6) & 3, fr = et & 15, fq = (et >> 4) & 3;
#pragma unroll
                    for (int ai = 0; ai < 2; ++ai)
#pragma unroll
                        for (int m = 0; m < 4; ++m)
#pragma unroll
                            for (int bj = 0; bj < 2; ++bj)
#pragma unroll
                                for (int n = 0; n < 2; ++n)
#pragma unroll
                                    for (int j = 0; j < 4; ++j)
                                        *(bf16_t*)(lds_raw + (ai * 128 + wr * 64 + m * 16 + fq * 4 + j) * 528 + (bj * 128 + wc * 32 + n * 16 + fr) * 2) = f2bf(acc[ai][bj][m][n][j]);
                    __syncthreads();
#pragma unroll 4
                    for (int i = 0; i < 16; ++i) {
                        const int idx = et + i * 512, r = idx >> 5, ch = idx & 31;
                        if (m0 + r < c) *(u32x4*)(contrib + ((size_t)rslot[r] * S + rtok[r]) * D + pn * 256 + ch * 8) = *(const u32x4*)(lds_raw + r * 528 + ch * 16);
                    }
                }
            }
            PH_BAR(pb + 5);
        }

        if (PH_SEL(7) && PH_IN(pb + 7)) for (int rep = 0; rep < PH_REPS(7); ++rep) {
            PHASE_IDS();
            const float* g2 = p.in[I_LN2G] + (size_t)l * D; const float* b2 = p.in[I_LN2B] + (size_t)l * D;
            const bool more = (l + 1 < DEPTH);
            f32x4 gq[8], bq[8];
#pragma unroll
            for (int j = 0; j < 8; ++j) { gq[j] = *(const f32x4*)(g2 + j * 256 + lane * 4); bq[j] = *(const f32x4*)(b2 + j * 256 + lane * 4); }
            if (more) {
                const float* wf = Wfa + (size_t)(l + 1) * 8 * D;
                __syncthreads();
                for (int i = tid; i < 6 * D / 4; i += NTHREADS) *(f32x4*)(ldsf + i * 4) = *(const f32x4*)(wf + i * 4);
                __syncthreads();
            }
            for (int t = gwave; t < S; t += gwaves) {
                f32x4 v[8]; float s = 0.f;
#pragma unroll
                for (int j = 0; j < 8; ++j) {
                    const size_t i = (size_t)t * D + j * 256 + lane * 4;
                    const u32x2 c0 = *(const u32x2*)(contrib + i), c1 = *(const u32x2*)(contrib + (size_t)S * D + i);
                    const f32x4 cs = (f32x4){bf2f((bf16_t)(c0.x & 0xffffu)) + bf2f((bf16_t)(c1.x & 0xffffu)), bf2f((bf16_t)(c0.x >> 16)) + bf2f((bf16_t)(c1.x >> 16)),
                                             bf2f((bf16_t)(c0.y & 0xffffu)) + bf2f((bf16_t)(c1.y & 0xffffu)), bf2f((bf16_t)(c0.y >> 16)) + bf2f((bf16_t)(c1.y >> 16))};
                    const u32x2 hq = *(const u32x2*)(h1b + i);
                    v[j] = ALPHA * (f32x4){bf2f((bf16_t)(hq.x & 0xffffu)), bf2f((bf16_t)(hq.x >> 16)), bf2f((bf16_t)(hq.y & 0xffffu)), bf2f((bf16_t)(hq.y >> 16))} + cs;
                    s += (v[j][0] + v[j][1]) + (v[j][2] + v[j][3]);
                }
                const float mean = wave_sum(s) * (1.f / D);
                float s2 = 0.f;
#pragma unroll
                for (int j = 0; j < 8; ++j) { v[j] -= mean; s2 += (v[j][0] * v[j][0] + v[j][1] * v[j][1]) + (v[j][2] * v[j][2] + v[j][3] * v[j][3]); }
                const float rstd = 1.f / sqrtf(wave_sum(s2) * (1.f / D) + LN_EPS);
                float fa[6] = {0.f, 0.f, 0.f, 0.f, 0.f, 0.f};
#pragma unroll
                for (int j = 0; j < 8; ++j) {
                    const int c = j * 256 + lane * 4;
                    v[j] = v[j] * rstd * gq[j] + bq[j];
                    *(f32x4*)(hout + (size_t)t * D + c) = v[j];
                    COMPILER_FENCE();
                    if (more) {
                        u32x2 o; o.x = pack2(v[j][0], v[j][1]); o.y = pack2(v[j][2], v[j][3]);
                        *(u32x2*)(xb + (size_t)t * D + c) = o;
#pragma unroll
                        for (int h = 0; h < 6; ++h) { const f32x4 w = *(const f32x4*)(ldsf + h * D + c); fa[h] += (v[j][0] * w[0] + v[j][1] * w[1]) + (v[j][2] * w[2] + v[j][3] * w[3]); }
                    }
                }
                if (more) {
#pragma unroll
                    for (int h = 0; h < 6; ++h) { const float sm = wave_sum(fa[h]); if (lane == 0) logf_[h * S + t] = log_sigmoid_f(sm + p.in[I_BF][(l + 1) * 6 + h]); }
                }
            }
            PH_BAR(pb + 7);
        }
    }
#undef PH_IN
#undef PH_BAR
}

constexpr int N_PHASES = 1 + DEPTH * 8;
#ifndef EMU
extern "C" void kernel_launch(void* const* d_in, const int* in_sizes, int n_in, void* d_out, int out_size, void* d_ws, size_t ws_size, hipStream_t stream) {
    static int grid = 0;
    if (grid == 0) {
        if (n_in != N_INPUTS || out_size != S * D || ws_size < WS_END) {
            fprintf(stderr, "kernel_launch: unexpected shapes: n_in %d out %d ws %zu (need %zu)\n", n_in, out_size, ws_size, (size_t)WS_END); grid = -1; return; }
        int dev = 0, cus = 0, per_cu = 0;
        if (hipGetDevice(&dev) != hipSuccess || hipDeviceGetAttribute(&cus, hipDeviceAttributeMultiprocessorCount, dev) != hipSuccess) { grid = -1; return; }
        if (hipFuncSetAttribute((const void*)fwd_kernel, hipFuncAttributeMaxDynamicSharedMemorySize, LDS_BYTES) != hipSuccess) { fprintf(stderr, "kernel_launch: hipFuncSetAttribute failed\n"); grid = -1; return; }
        if (hipOccupancyMaxActiveBlocksPerMultiprocessor(&per_cu, (const void*)fwd_kernel, NTHREADS, LDS_BYTES) != hipSuccess || per_cu < 1) {
            fprintf(stderr, "kernel_launch: occupancy query says %d blocks per CU\n", per_cu); (void)hipGetLastError(); grid = -1; return; }
        grid = cus;
    }
    if (grid < 0) return;
    (void)hipMemsetAsync(d_ws, 0, CTL_BYTES, stream);
    Params p{};
    for (int i = 0; i < N_INPUTS; ++i) p.in[i] = (const float*)d_in[i];
    p.out = (float*)d_out; p.ws = (unsigned char*)d_ws;
    for (int i = 0; i < 8; ++i) p.inv_freq[i] = (float)pow(500000.0, -(double)i * 2.0 / 16.0);
#if N_LAUNCH_SPLIT
    for (int k = 0; k < N_PHASES; ++k) { p.lo = k; p.hi = k + 1; hipLaunchKernelGGL(fwd_kernel, dim3(grid), dim3(NTHREADS), LDS_BYTES, stream, p); }
#else
    p.lo = 0; p.hi = N_PHASES;
    hipLaunchKernelGGL(fwd_kernel, dim3(grid), dim3(NTHREADS), LDS_BYTES, stream, p);
#endif
}
#endif
```

```cpp
#ifndef EMU
#include <hip/hip_runtime.h>
#include <cstdio>
#include <cstdint>
#include <cmath>
#endif

#ifndef SEQ
#define SEQ 8192
#endif
#ifndef N_LAUNCH_SPLIT
#define N_LAUNCH_SPLIT 0
#endif
#ifndef REP_PHASE
#define REP_PHASE -2
#endif
#define PH_REPS(c) ((c) == REP_PHASE ? 2 : 1)
#ifndef REP_SUB
#define REP_SUB 0
#endif

constexpr int S = SEQ, D = 2048, DEPTH = 2;
constexpr int FOX_H = 6, FOX_W = 768;
constexpr int LRU_W = 768;
constexpr int DIFF_H = 4, DIFF_W = 512;
constexpr int N_IN = 5382, N_INP = 5376;
constexpr int C_FA = 2304;
constexpr int NEXP = 32, DFF = 512;
constexpr int NKT = S / 64;
#ifndef REP_ROUTER
#define REP_ROUTER 1
#endif
#ifndef REP_STORES
#define REP_STORES 1
#endif
#ifndef REP_STATS
#define REP_STATS 1
#endif
#ifndef DCH
#define DCH 48
#endif
constexpr int NCH = (NKT + DCH - 1) / DCH;
constexpr size_t DPART_ROWS = (size_t)NCH * S - (size_t)(DCH * 64) * NCH * (NCH - 1) / 2;
constexpr float ALPHA = 1.41421356237309504880f;
constexpr float LN_EPS = 1e-5f;
constexpr float LOG2E = 1.4426950408889634f;
constexpr float QSCALE_A = 0.08838834764831845f * 1.4426950408889634f;
constexpr float QSCALE_C = 0.125f * 1.4426950408889634f;

enum { I_X = 0, I_POS, I_WIN, I_BF, I_CONVW, I_CONVB, I_WA, I_BA, I_WI, I_BI, I_LAM, I_LQ1, I_LK1, I_LQ2, I_LK2, I_SUBG, I_WO, I_LN1G, I_LN1B,
       I_WGRP, I_BGRP, I_WRT, I_BRT, I_WGATE, I_WUP, I_WDOWN, I_LN2G, I_LN2B, N_INPUTS };

typedef unsigned short bf16_t;
typedef short bf16x8 __attribute__((ext_vector_type(8)));
typedef float f32x4 __attribute__((ext_vector_type(4)));
typedef unsigned u32x4 __attribute__((ext_vector_type(4)));
typedef unsigned u32x2 __attribute__((ext_vector_type(2)));

constexpr size_t al256(size_t x) { return (x + 255) & ~(size_t)255; }
constexpr size_t CTL_BYTES = 65536;
constexpr size_t CTL_CNT_OFF = 32768;
constexpr size_t CTL_WORK_OFF = 36864;
constexpr size_t CTL_QK2_OFF = 57344;
constexpr size_t CTL_CLS_OFF = 49152;
constexpr size_t CTL_PAN_OFF = 16384;
constexpr size_t CTL_MQ_OFF = 24576;
constexpr size_t CTL_DONE_OFF = 40960;
constexpr size_t WB_WIN = CTL_BYTES;
constexpr size_t WB_WO = WB_WIN + al256((size_t)DEPTH * N_INP * D * 2);
constexpr size_t WB_WGU = WB_WO + al256((size_t)DEPTH * D * D * 2);
constexpr size_t WB_WD = WB_WGU + al256((size_t)DEPTH * NEXP * 1024 * D * 2);
constexpr size_t WB_WAI = WB_WD + al256((size_t)DEPTH * NEXP * D * DFF * 2);
constexpr size_t WF_FA = WB_WAI + al256((size_t)DEPTH * 6 * 256 * 128 * 2);
constexpr size_t WF_R36 = WF_FA + al256((size_t)DEPTH * 8 * D * 4);
constexpr size_t WF_ROPE = WF_R36 + al256((size_t)DEPTH * 2 * 48 * D * 2);
constexpr size_t A_XB = WF_ROPE + al256((size_t)S * 16 * 4);
constexpr size_t A_HB = A_XB + al256((size_t)S * D * 2);
constexpr size_t A_LOGF = A_HB + al256((size_t)S * D * 4);
constexpr size_t A_CUM = A_LOGF + al256((size_t)6 * S * 4);
constexpr size_t A_KMAX = A_CUM + al256((size_t)6 * S * 4);
constexpr size_t A_CNTB = A_KMAX + al256((size_t)6 * NKT * 4);
constexpr size_t A_QA = A_CNTB + al256((size_t)1024 * 32 * 4);
constexpr size_t A_KA = A_QA + al256((size_t)FOX_H * S * 128 * 2);
constexpr size_t A_VAT = A_KA + al256((size_t)FOX_H * S * 128 * 2);
constexpr size_t A_XR = A_VAT + al256((size_t)FOX_H * S * 128 * 2);
constexpr size_t A_GR = A_XR + al256((size_t)S * LRU_W * 2);
constexpr size_t A_QC = A_GR + al256((size_t)S * LRU_W * 2);
constexpr size_t A_KC = A_QC + al256((size_t)DIFF_H * S * 128 * 2);
constexpr size_t A_VCT = A_KC + al256((size_t)DIFF_H * S * 128 * 2);
constexpr size_t A_HLOC = A_VCT + al256((size_t)DIFF_H * S * 128 * 2);
constexpr size_t A_PLOC = A_HLOC + al256((size_t)S * LRU_W * 4);
constexpr size_t A_SUMA = A_PLOC + al256((size_t)S * LRU_W * 4);
constexpr size_t A_SUMH = A_SUMA + al256((size_t)NKT * LRU_W * 4);
constexpr size_t A_CONCAT = A_SUMH + al256((size_t)NKT * LRU_W * 4);
constexpr size_t A_Y1 = A_CONCAT + al256((size_t)S * D * 2);
constexpr size_t A_H1 = A_Y1 + al256((size_t)S * D * 4);
constexpr size_t A_H1B = A_H1 + al256((size_t)S * D * 4);
constexpr size_t A_LTOK = A_H1B + al256((size_t)S * D * 2);
constexpr size_t A_LW = A_LTOK + al256((size_t)NEXP * S * 4 * 2);
constexpr size_t A_LSLOT = A_LW + al256((size_t)NEXP * S * 4 * 2);
constexpr size_t A_ACT = A_LSLOT + al256((size_t)NEXP * S * 4 * 2);
constexpr size_t A_CONTRIB = A_ACT + al256((size_t)(2 * S + 256) * DFF * 2);
constexpr size_t WS_END = A_CONTRIB + al256((size_t)2 * S * D * 4);
constexpr size_t A_DPO = A_Y1;
constexpr size_t A_DPML = A_DPO + al256((size_t)8 * DPART_ROWS * 128 * 2);
static_assert(A_DPML + (size_t)8 * DPART_ROWS * 2 * 4 <= A_H1B, "differential partials must fit inside the y1 + h1 region");

constexpr size_t A_XBUF = A_H1 + al256((size_t)S * D * 2);
constexpr size_t A_PART = A_XBUF + al256((size_t)S * 8 * 8);
static_assert(A_PART + (size_t)8 * S * 48 * 4 <= A_H1B, "exchange buffers must fit inside the h1 region");
constexpr int NTHREADS = 512;
constexpr int LDS_MAIN = 131072 + 4096;
constexpr int LDS_MISC = LDS_MAIN;
constexpr int LDS_BYTES = LDS_MAIN + 8192 + 16640;
constexpr int M_PRE16 = 8192;
constexpr int M_LCNT = 64, M_CTOT = 256, M_COFF = 384, M_PRE = 512, M_RTOK = 2048, M_RW = 3072, M_RSLOT = 4096;

struct Params {
    const float* in[N_INPUTS];
    float* out;
    unsigned char* ws;
    float inv_freq[8];
    int lo, hi;
};

#ifndef EMU
#define LAS __attribute__((address_space(3)))
#define GAS __attribute__((address_space(1)))
#define DYN_LDS(name) extern __shared__ __attribute__((aligned(16))) unsigned char name[]
#define SLEEP1() __builtin_amdgcn_s_sleep(1)
#define WAVE_SYNC() __builtin_amdgcn_wave_barrier()
#define OPAQUE(x) asm volatile("" : "+v"(x))
#define COMPILER_FENCE() asm volatile("" ::: "memory")
#define RFL(x) __builtin_amdgcn_readfirstlane(x)
#define RFL_F(x) __builtin_bit_cast(float, __builtin_amdgcn_readfirstlane(__builtin_bit_cast(int, x)))
#define ANY_LANE(p) (__builtin_amdgcn_ballot_w64(p) != 0ull)
#define RDLANE(v, l) __builtin_bit_cast(float, __builtin_amdgcn_readlane(__builtin_bit_cast(int, v), l))
__device__ __forceinline__ int lane_id_volatile() { int l; asm volatile("v_mbcnt_lo_u32_b32 %0, -1, 0\n\tv_mbcnt_hi_u32_b32 %0, -1, %0" : "=v"(l)); return l; }
#define LANE_ID() lane_id_volatile()
#define OPAQUE_S(x) asm volatile("" : "+s"(x))
#define WAIT_VM0() asm volatile("s_waitcnt vmcnt(0)" ::: "memory")
#define WAIT_ALL0() __builtin_amdgcn_s_waitcnt(0)
#define FENCE_REL_AGENT() __builtin_amdgcn_fence(__ATOMIC_RELEASE, "agent")
#define FENCE_ACQ_AGENT() __builtin_amdgcn_fence(__ATOMIC_ACQUIRE, "agent")
#define MFMA16(a, b, c) __builtin_amdgcn_mfma_f32_16x16x32_bf16(a, b, c, 0, 0, 0)
#define GLDS16(g, l) __builtin_amdgcn_global_load_lds((const unsigned*)(g), (unsigned*)(l), 16, 0, 0)
#define WAIT_V(n) asm volatile("s_waitcnt vmcnt(" #n ")" ::: "memory")
#define WAIT_L(n) asm volatile("s_waitcnt lgkmcnt(" #n ")" ::: "memory")
#define BAR() __builtin_amdgcn_s_barrier()
#define SCHED() __builtin_amdgcn_sched_barrier(0)
#define SETPRIO(n) __builtin_amdgcn_s_setprio(n)
#define FAST_EXP2(x) __builtin_amdgcn_exp2f(x)
template <int M> __device__ __forceinline__ float shx_impl(float v, int lane) {
    if (M < 32) return __builtin_bit_cast(float, __builtin_amdgcn_ds_swizzle(__builtin_bit_cast(int, v), (M << 10) | 0x1f));
    return __builtin_bit_cast(float, __builtin_amdgcn_ds_bpermute((lane ^ 32) << 2, __builtin_bit_cast(int, v)));
}
#define SHX(v, M) shx_impl<M>(v, lane)
template <int CTRL> __device__ __forceinline__ float dppx(float x) { return __builtin_bit_cast(float, __builtin_amdgcn_mov_dpp(__builtin_bit_cast(int, x), CTRL, 0xf, 0xf, true)); }
#define DPP_X1(x) dppx<0xB1>(x)
#define DPP_X2(x) dppx<0x4E>(x)
#define DPP_X7(x) dppx<0x141>(x)
#define DPP_X8(x) dppx<0x128>(x)
#define xrow16_max(x) xrow16_max_l(x, lane)
#define xrow16_sum(x) xrow16_sum_l(x, lane)
__device__ __forceinline__ float xrow16_max_l(float x, int lane) { x = fmaxf(x, shx_impl<16>(x, lane)); return fmaxf(x, shx_impl<32>(x, lane)); }
__device__ __forceinline__ float xrow16_sum_l(float x, int lane) { x = x + shx_impl<16>(x, lane); return x + shx_impl<32>(x, lane); }
#define FAST_LOG2(x) __builtin_amdgcn_logf(x)
#define FAST_RCP(x) __builtin_amdgcn_rcpf(x)
__device__ __forceinline__ unsigned xb_ld(unsigned* p)              { return __hip_atomic_load(p, __ATOMIC_RELAXED, __HIP_MEMORY_SCOPE_AGENT); }
__device__ __forceinline__ unsigned xb_add(unsigned* p, unsigned v) { return __hip_atomic_fetch_add(p, v, __ATOMIC_RELAXED, __HIP_MEMORY_SCOPE_AGENT); }
__device__ __forceinline__ void xst64(unsigned long long* p, unsigned long long v) { __hip_atomic_store(p, v, __ATOMIC_RELAXED, __HIP_MEMORY_SCOPE_AGENT); }
__device__ __forceinline__ unsigned long long xld64(unsigned long long* p) { return __hip_atomic_load(p, __ATOMIC_RELAXED, __HIP_MEMORY_SCOPE_AGENT); }
__device__ __forceinline__ void xst32(unsigned* p, unsigned v) { __hip_atomic_store(p, v, __ATOMIC_RELAXED, __HIP_MEMORY_SCOPE_AGENT); }
__device__ __forceinline__ unsigned xb_xcc_id() { return (unsigned)__builtin_amdgcn_s_getreg((3 << 11) | 20) & 0xFu; }
__device__ __forceinline__ int atomic_add_int(int* p, int v) { return atomicAdd(p, v); }
__device__ __forceinline__ void atomic_min_int(int* p, int v) { atomicMin(p, v); }
__device__ __forceinline__ void atomic_max_u32(unsigned* p, unsigned v) { atomicMax(p, v); }
__device__ __forceinline__ unsigned pack2(float lo, float hi) { unsigned r; asm volatile("v_cvt_pk_bf16_f32 %0, %1, %2" : "=v"(r) : "v"(lo), "v"(hi)); return r; }
#else
#define MFMA16(a, b, c) emu_mfma_16x16x32_bf16(a, b, c)
#define GLDS16(g, l) emu_glds16((const void*)(g), (void*)(l))
#define WAIT_V(n) ((void)0)
#define WAIT_L(n) ((void)0)
#define BAR() __syncthreads()
#define SCHED() ((void)0)
#define SETPRIO(n) ((void)0)
#define FAST_EXP2(x) exp2f(x)
#define SHX(v, M) __shfl_xor(v, M)
#define DPP_X1(x) __shfl_xor(x, 1)
#define DPP_X2(x) __shfl_xor(x, 2)
#define DPP_X7(x) __shfl_xor(x, 7)
#define DPP_X8(x) __shfl_xor(x, 8)
static inline float xrow16_max(float x) { x = fmaxf(x, __shfl_xor(x, 16)); return fmaxf(x, __shfl_xor(x, 32)); }
static inline float xrow16_sum(float x) { x = x + __shfl_xor(x, 16); return x + __shfl_xor(x, 32); }
#define FAST_LOG2(x) log2f(x)
#define FAST_RCP(x) (1.f / (x))
static inline unsigned pack2(float lo, float hi) {
    unsigned a = __builtin_bit_cast(unsigned, lo), b = __builtin_bit_cast(unsigned, hi);
    a += 0x7fffu + ((a >> 16) & 1u); b += 0x7fffu + ((b >> 16) & 1u);
    return (a >> 16) | (b & 0xffff0000u);
}
#endif
__device__ __forceinline__ bf16_t f2bf(float f) { return (bf16_t)(pack2(f, 0.f) & 0xffffu); }
__device__ __forceinline__ float bf2f(bf16_t h) { return __builtin_bit_cast(float, (unsigned)h << 16); }

#define XB_TMO      128
#define XB_XCNT(j)  (256  + 64 * (j))
#define XB_XSUB(j)  (1280 + 64 * (j))
#define XB_XGEN(j)  (2304 + 64 * (j))
#define XB_TOP      3328
#define XB_TOPGEN   3392
#define XCD_BAR_WORDS 3456
#define XB_SPIN_CAP (1u << 22)
#define XB_SPIN(cond, bar) do { unsigned _sp = 0; while (cond) { SLEEP1(); \
    if ((++_sp & 255u) == 0u) { if (xb_ld(&(bar)[XB_TMO])) break; if (_sp > XB_SPIN_CAP) { xb_add(&(bar)[XB_TMO], 1u); break; } } } } while (0)

#define XB_X2SUB(x, s) (6400 + 16 * ((x) * 4 + (s)))
#define XB_X2CNT(x, s) (7424 + ((x) * 4 + (s)))
struct XcdBarrier { unsigned* bar; unsigned x, s; volatile LAS unsigned* st; };

__device__ __forceinline__ XcdBarrier xcd_barrier_post(unsigned* bar, volatile LAS unsigned* st) {
    XcdBarrier b; b.bar = bar; b.x = xb_xcc_id() & 15u; b.s = (blockIdx.x >> 3) & 3u; b.st = st;
    if (threadIdx.x == 0) {
        unsigned o = xb_add(&bar[XB_X2CNT(b.x, b.s)], 1u);
#ifndef EMU
        asm volatile("" :: "v"(o));
#endif
        (void)o;
        (void)xb_add(&bar[XB_XCNT(b.x)], 1u);
    }
    return b;
}
__device__ __forceinline__ void xcd_barrier_complete(unsigned* bar, unsigned x, unsigned s, unsigned& nsub, unsigned& nx, unsigned& nsubs) {
    const unsigned G = gridDim.x;
    unsigned sum, cnt, sp = 0u;
    for (;;) {
        sum = 0u; cnt = 0u;
#pragma unroll
        for (unsigned j = 0; j < 16; ++j) { const unsigned c = xb_ld(&bar[XB_XCNT(j)]); sum += c; cnt += (c > 0u) ? 1u : 0u; }
        if (sum == G) break;
        SLEEP1();
        if ((++sp & 255u) == 0u) { if (xb_ld(&bar[XB_TMO])) break; if (sp > XB_SPIN_CAP) { xb_add(&bar[XB_TMO], 1u); break; } }
    }
    unsigned mine = 0u, subs = 0u;
#pragma unroll
    for (unsigned q = 0; q < 4; ++q) { const unsigned c = xb_ld(&bar[XB_X2CNT(x, q)]); subs += (c > 0u) ? 1u : 0u; mine = (q == s) ? c : mine; }
    nsub = mine > 0u ? mine : 1u; nx = cnt > 0u ? cnt : 1u; nsubs = subs > 0u ? subs : 1u;
}
__device__ __forceinline__ void xcd_barrier(const XcdBarrier& b, bool leader) {
    WAIT_VM0();
    __syncthreads();
    if (leader) {
        unsigned* bar = b.bar;
        WAIT_ALL0();
        unsigned nsub = b.st[0], nx = b.st[1], nsubs = b.st[2];
        if (nsub == 0u) { xcd_barrier_complete(bar, b.x, b.s, nsub, nx, nsubs); b.st[0] = nsub; b.st[1] = nx; b.st[2] = nsubs; }
        const unsigned old = xb_add(&bar[XB_X2SUB(b.x, b.s)], 1u);
        const unsigned gen = old / nsub;
        bool xcd_last = false;
        if (old + 1u == (gen + 1u) * nsub) {
            const unsigned old2 = xb_add(&bar[XB_XSUB(b.x)], 1u);
            xcd_last = (old2 + 1u == (old2 / nsubs + 1u) * nsubs);
        }
        if (xcd_last) {
            FENCE_REL_AGENT();
            WAIT_VM0();
            const unsigned og = xb_add(&bar[XB_TOP], 1u);
            const unsigned tg = og / nx;
            if (og + 1u == (tg + 1u) * nx) xb_add(&bar[XB_TOPGEN], 1u);
            else XB_SPIN(xb_ld(&bar[XB_TOPGEN]) == tg, bar);
            FENCE_ACQ_AGENT();
            xb_add(&bar[XB_XGEN(b.x)], 1u);
            WAIT_VM0();
        } else {
            XB_SPIN(xb_ld(&bar[XB_XGEN(b.x)]) == gen, bar);
            FENCE_ACQ_AGENT();
            WAIT_VM0();
        }
    }
    __syncthreads();
}

__device__ __forceinline__ f32x4 mul_s4(f32x4 a, float s) {
#ifdef EMU
    return a * s;
#else
    f32x4 o;
#pragma unroll
    for (int c = 0; c < 4; ++c) { float r, x = a[c]; asm volatile("v_mul_f32_e32 %0, %1, %2" : "=v"(r) : "v"(x), "v"(s)); o[c] = r; }
    return o;
#endif
}
__device__ __forceinline__ float wave_sum_l(float v, int lane) {
    (void)lane;
    v += DPP_X1(v); v += DPP_X2(v); v += DPP_X7(v); v += DPP_X8(v);
    return xrow16_sum(v);
}
#define wave_sum(v) wave_sum_l(v, lane)
__device__ __forceinline__ float fexp(float x) { return FAST_EXP2(x * LOG2E); }
__device__ __forceinline__ float sigmoid_f(float x) { return FAST_RCP(1.f + fexp(-x)); }
__device__ __forceinline__ float log_sigmoid_f(float x) { return fminf(x, 0.f) - 0.6931471805599453f * FAST_LOG2(1.f + fexp(-fabsf(x))); }
__device__ __forceinline__ float gelu_tanh_f(float x) { const float u = 0.7978845608028654f * (x + 0.044715f * x * x * x); return x * FAST_RCP(1.f + fexp(-2.f * u)); }
__device__ __forceinline__ float silu_f(float x) { return x * FAST_RCP(1.f + fexp(-x)); }
__device__ __forceinline__ float neg_expm1_f(float x) {
    const float ser = -x * (1.f + x * (0.5f + x * (0.16666667f + x * (0.041666668f + x * (0.008333334f + x * 0.0013888889f)))));
    return (x > -0.35f) ? ser : (1.f - fexp(x));
}

struct RmIdent { __device__ __forceinline__ int operator()(int n) const { return n; } };
struct RmWin { __device__ __forceinline__ int operator()(int n) const { return n < C_FA ? n : (n < C_FA + 6 ? -1 : n - 6); } };
struct RmGu { int kind; __device__ __forceinline__ int operator()(int f) const { return (f >> 7) * 256 + ((f >> 6) & 1) * 128 + ((f >> 4) & 3) * 32 + kind * 16 + (f & 15); } };
struct RmOff { int off; __device__ __forceinline__ int operator()(int n) const { return n + off; } };

template <class RM>
__device__ __forceinline__ void convert_tile(const float* src, int ld, int K, int Nsrc, int k0, int n0, bf16_t* dst, const RM& rm, float* T, int tid) {
    {
        const int nn = tid & 255, kh = (tid >> 8) * 32, n = n0 + nn;
        const float* sp = src + (size_t)(k0 + kh) * ld + n;
        float v[32];
#pragma unroll
        for (int i = 0; i < 32; ++i) v[i] = (n < Nsrc) ? sp[(size_t)i * ld] : 0.f;
#pragma unroll
        for (int i = 0; i < 32; ++i) T[(kh + i) * 257 + nn] = v[i];
    }
    __syncthreads();
#pragma unroll
    for (int q = 0; q < 4; ++q) {
        const int nn = q * 64 + (tid >> 3), kc = (tid & 7) * 8, n = n0 + nn;
        const int row = (n < Nsrc) ? rm(n) : -1;
        if (row >= 0) {
            u32x4 o;
            o.x = pack2(T[(kc + 0) * 257 + nn], T[(kc + 1) * 257 + nn]); o.y = pack2(T[(kc + 2) * 257 + nn], T[(kc + 3) * 257 + nn]);
            o.z = pack2(T[(kc + 4) * 257 + nn], T[(kc + 5) * 257 + nn]); o.w = pack2(T[(kc + 6) * 257 + nn], T[(kc + 7) * 257 + nn]);
            *(u32x4*)(dst + (size_t)row * K + k0 + kc) = o;
        }
    }
    __syncthreads();
}
template <class RM>
__device__ __forceinline__ void convert_tile_v4(const float* src, int ld, int K, int k0, int n0, bf16_t* dst, const RM& rm, float* T, int tid_in) {
    int tid = tid_in; OPAQUE(tid);
    {
        const int w = tid >> 6, l4 = (tid & 63) * 4;
        const float* sp = src + (size_t)(k0 + w * 8) * ld + n0 + l4;
        f32x4 v[8];
#pragma unroll
        for (int i = 0; i < 8; ++i) v[i] = *(const f32x4*)(sp + (size_t)i * ld);
#pragma unroll
        for (int i = 0; i < 8; ++i) { float* tp = T + (w * 8 + i) * 257 + l4; tp[0] = v[i][0]; tp[1] = v[i][1]; tp[2] = v[i][2]; tp[3] = v[i][3]; }
    }
    __syncthreads();
#pragma unroll
    for (int q = 0; q < 4; ++q) {
        const int nn = q * 64 + (tid >> 3), kc = (tid & 7) * 8, n = n0 + nn;
        const int row = rm(n);
        u32x4 o;
        o.x = pack2(T[(kc + 0) * 257 + nn], T[(kc + 1) * 257 + nn]); o.y = pack2(T[(kc + 2) * 257 + nn], T[(kc + 3) * 257 + nn]);
        o.z = pack2(T[(kc + 4) * 257 + nn], T[(kc + 5) * 257 + nn]); o.w = pack2(T[(kc + 6) * 257 + nn], T[(kc + 7) * 257 + nn]);
        *(u32x4*)(dst + (size_t)row * K + k0 + kc) = o;
    }
    __syncthreads();
}
template <class RM>
__device__ __forceinline__ void convert_mats(const float* src, size_t sstride, int nmat, int ld, int K, int Nsrc, bf16_t* dst, size_t dstride, const RM& rm,
                                             float* T, int tid, int bid, int G) {
    const int tk = K / 64, tn = (Nsrc + 255) / 256, per = tk * tn, total = nmat * per;
    for (int t = bid; t < total; t += G) {
        const int mi = t / per, r = t % per;
        convert_tile(src + (size_t)mi * sstride, ld, K, Nsrc, (r / tn) * 64, (r % tn) * 256, dst + (size_t)mi * dstride, rm, T, tid);
    }
}

constexpr int NCONV = DEPTH * 768;
__device__ __forceinline__ void moe_conv_chunk(const Params& p, int cid, bf16_t* WguT_, bf16_t* WdT_, float* T, int tid) {
    const int l = cid / 768, r = cid % 768, kind = r >> 8, t0 = (r & 255) * 8;
    for (int t = t0; t < t0 + 8; ++t) {
        const int mi = t >> 6, rr = t & 63;
        if (kind < 2) {
            const float* src = p.in[kind == 0 ? I_WGATE : I_WUP] + ((size_t)l * NEXP + mi) * D * DFF;
            convert_tile_v4(src, DFF, D, (rr >> 1) * 64, (rr & 1) * 256, WguT_ + ((size_t)l * NEXP + mi) * 1024 * D, RmGu{kind}, T, tid);
        } else {
            const float* src = p.in[I_WDOWN] + ((size_t)l * NEXP + mi) * DFF * D;
            convert_tile_v4(src, D, DFF, (rr >> 3) * 64, (rr & 7) * 256, WdT_ + ((size_t)l * NEXP + mi) * D * DFF, RmIdent{}, T, tid);
        }
    }
}

constexpr int BK = 64, HTB = 128 * 64 * 2;
__device__ __forceinline__ int lds_byte(int r, int c) {
    const int st = (r >> 4) * 2 + (c >> 5), rr = r & 15, cc = c & 31, ob = rr * 64 + cc * 2;
    return st * 1024 + (ob ^ (((ob >> 9) & 1) << 5));
}
__device__ __forceinline__ void stage_rc(int b, int& R, int& C) {
    const int st = b / 1024, sb = b % 1024, swz = sb ^ (((sb >> 9) & 1) << 5);
    R = (st >> 1) * 16 + swz / 64; C = (st & 1) * 32 + (swz % 64) / 2;
}
template <bool GATHER>
__device__ __forceinline__ void gemm_tile(const bf16_t* A, int arow0, const unsigned (&aoff)[2][2], const bf16_t* Bt, int brow0, int K,
                                          unsigned char* shm, f32x4 (&acc)[2][2][4][2], int tid_in) {
    int tid = tid_in; OPAQUE(tid);
    unsigned toff; { int R0, C0; stage_rc(tid * 16, R0, C0); toff = (unsigned)(R0 * K + C0); }
#define SA(b, h) (shm + ((b) * 2 + (h)) * HTB)
#define SB(b, h) (shm + (4 + (b) * 2 + (h)) * HTB)
#define STAGE_B(P, h, kt) do { _Pragma("unroll") for (int _i = 0; _i < 2; ++_i) GLDS16(Bt + ((size_t)(brow0 + (h) * 128 + _i * 64) * K + (size_t)(kt) * BK) + toff, (P) + tid * 16 + _i * 8192); } while (0)
#define STAGE_A(P, h, kt) do { _Pragma("unroll") for (int _i = 0; _i < 2; ++_i) { \
    if (GATHER) GLDS16(A + (size_t)(kt) * BK + aoff[h][_i], (P) + tid * 16 + _i * 8192); \
    else GLDS16(A + ((size_t)(arow0 + (h) * 128 + _i * 64) * K + (size_t)(kt) * BK) + toff, (P) + tid * 16 + _i * 8192); } } while (0)
#define LDA(dst, b, h) _Pragma("unroll") for (int m = 0; m < 4; ++m) _Pragma("unroll") for (int k = 0; k < 2; ++k) \
    dst[m][k] = *reinterpret_cast<const bf16x8*>(SA(b, h) + lds_byte(wr * 64 + m * 16 + fr, k * 32 + fq * 8))
#define LDB(dst, b, h) _Pragma("unroll") for (int n = 0; n < 2; ++n) _Pragma("unroll") for (int k = 0; k < 2; ++k) \
    dst[n][k] = *reinterpret_cast<const bf16x8*>(SB(b, h) + lds_byte(wc * 32 + n * 16 + fr, k * 32 + fq * 8))
#define MMA(ai, bj, At, Bx) do { SETPRIO(1); \
    _Pragma("unroll") for (int m = 0; m < 4; ++m) _Pragma("unroll") for (int n = 0; n < 2; ++n) _Pragma("unroll") for (int k = 0; k < 2; ++k) \
      acc[ai][bj][m][n] = MFMA16(At[m][k], Bx[n][k], acc[ai][bj][m][n]); \
    SETPRIO(0); } while (0)
    int wid = tid >> 6, lane = tid & 63, wr = wid >> 2, wc = wid & 3, fr = lane & 15, fq = lane >> 4;
#pragma unroll
    for (int a = 0; a < 2; ++a)
#pragma unroll
        for (int b = 0; b < 2; ++b)
#pragma unroll
            for (int m = 0; m < 4; ++m)
#pragma unroll
                for (int n = 0; n < 2; ++n) acc[a][b][m][n] = (f32x4){0.f, 0.f, 0.f, 0.f};
    bf16x8 At[4][2], B0[2][2], B1[2][2];
    const int nt = K / BK;
    STAGE_B(SB(0, 0), 0, 0); STAGE_A(SA(0, 0), 0, 0);
    STAGE_B(SB(0, 1), 1, 0); STAGE_A(SA(0, 1), 1, 0);
    if (wr == 1) BAR();
    WAIT_V(4); BAR();
    STAGE_B(SB(1, 0), 0, 1); STAGE_A(SA(1, 0), 0, 1); STAGE_B(SB(1, 1), 1, 1);
    WAIT_V(6); BAR();
    for (int t = 0; t < nt - 2; t += 2) {
        LDB(B0, 0, 0); SCHED(); LDA(At, 0, 0); STAGE_A(SA(1, 1), 1, t + 1);
        WAIT_L(8); BAR(); WAIT_L(0); MMA(0, 0, At, B0); BAR(); SCHED();
        LDB(B1, 0, 1); STAGE_B(SB(0, 0), 0, t + 2);
        BAR(); WAIT_L(0); MMA(0, 1, At, B1); BAR();
        LDA(At, 0, 1); STAGE_A(SA(0, 0), 0, t + 2);
        BAR(); WAIT_L(0); MMA(1, 0, At, B0); BAR(); SCHED();
        STAGE_B(SB(0, 1), 1, t + 2);
        WAIT_V(6); BAR(); MMA(1, 1, At, B1); BAR();
        LDB(B0, 1, 0); SCHED(); LDA(At, 1, 0); STAGE_A(SA(0, 1), 1, t + 2);
        WAIT_L(8); BAR(); WAIT_L(0); MMA(0, 0, At, B0); BAR(); SCHED();
        LDB(B1, 1, 1); STAGE_B(SB(1, 0), 0, t + 3);
        BAR(); WAIT_L(0); MMA(0, 1, At, B1); BAR();
        LDA(At, 1, 1); STAGE_A(SA(1, 0), 0, t + 3);
        BAR(); WAIT_L(0); MMA(1, 0, At, B0); BAR(); SCHED();
        STAGE_B(SB(1, 1), 1, t + 3);
        WAIT_V(6); BAR(); MMA(1, 1, At, B1); BAR();
    }
    OPAQUE(tid); wid = tid >> 6; lane = tid & 63; wr = wid >> 2; wc = wid & 3; fr = lane & 15; fq = lane >> 4;
    { LDB(B0, 0, 0); WAIT_V(0); LDA(At, 0, 0); STAGE_A(SA(1, 1), 1, nt - 1);
      BAR(); WAIT_L(0); MMA(0, 0, At, B0); BAR();
      LDB(B1, 0, 1); BAR(); WAIT_L(0); MMA(0, 1, At, B1); BAR();
      LDA(At, 0, 1); WAIT_V(4); BAR(); WAIT_L(0); MMA(1, 0, At, B0); MMA(1, 1, At, B1); BAR(); }
    { LDB(B0, 1, 0); LDA(At, 1, 0); WAIT_V(2); BAR(); WAIT_L(0); MMA(0, 0, At, B0); BAR();
      LDB(B1, 1, 1); WAIT_V(0); BAR(); WAIT_L(0); MMA(0, 1, At, B1); BAR();
      LDA(At, 1, 1); BAR(); WAIT_L(0); MMA(1, 0, At, B0); MMA(1, 1, At, B1); BAR(); }
    if (wr == 0) BAR();
#undef SA
#undef SB
#undef STAGE_A
#undef STAGE_B
#undef LDA
#undef LDB
#undef MMA
}
__device__ __forceinline__ void stage_geom(int tid, int (&R)[2], int (&C)[2]) {
#pragma unroll
    for (int i = 0; i < 2; ++i) stage_rc(tid * 16 + i * 8192, R[i], C[i]);
}

constexpr int ATT_STAGE = 69632;
constexpr int ATT_KBUF = 0, ATT_VBUF = 32768, ATT_CBUF = 65536;
template <int KIND>
__device__ __forceinline__ void attn_unit(const bf16_t* Q, const bf16_t* Kg, const bf16_t* VT, const float* cum2, const float* kmx, int qb, bf16_t* concat, int ccol0,
                                          float lam, float osc, const float* subg, unsigned char* lds, int tid) {
    const int lane = tid & 63, wave = tid >> 6, r16 = lane & 15, q4 = lane >> 4;
    const int q0w = qb * 128 + wave * 16, myq = q0w + r16;
    const int ntiles = 2 * qb + 2;
    const int wlimit = (KIND == 0) ? ((q0w + 15) >> 6) : (q0w >> 6);
    constexpr int NMAP = (KIND == 0) ? 1 : 2, NKS = (KIND == 0) ? 4 : 2;
    bf16x8 qf[NMAP][NKS];
#pragma unroll
    for (int mp = 0; mp < NMAP; ++mp)
#pragma unroll
        for (int ks = 0; ks < NKS; ++ks) qf[mp][ks] = *(const bf16x8*)(Q + (size_t)myq * 128 + mp * 64 + ks * 32 + q4 * 8);
    const float cq = (KIND == 0) ? cum2[myq] : 0.f;
    int kt0 = 0;
    if (KIND == 0) {
        float* wmax = (float*)(lds + ATT_CBUF + 512); int* kst = (int*)(lds + ATT_CBUF + 576);
        float qs = 0.f;
#pragma unroll
        for (int ks = 0; ks < NKS; ++ks)
#pragma unroll
            for (int j = 0; j < 8; ++j) { const float v = bf2f((bf16_t)qf[0][ks][j]); qs += v * v; }
        qs = xrow16_sum(qs);
        qs = fmaxf(qs, SHX(qs, 1)); qs = fmaxf(qs, SHX(qs, 2)); qs = fmaxf(qs, SHX(qs, 4)); qs = fmaxf(qs, SHX(qs, 8));
        if (lane == 0) wmax[wave] = qs;
        if (tid == 0) *kst = 2 * qb;
        __syncthreads();
        float qm = wmax[0];
#pragma unroll
        for (int w = 1; w < 8; ++w) qm = fmaxf(qm, wmax[w]);
        qm = sqrtf(qm) * 1.01f;
        const float kd = sqrtf(fmaxf(kmx[2 * qb], kmx[2 * qb + 1])) * 1.01f;
        if (tid < 2 * qb) {
            const float bias = cum2[qb * 128] - cum2[tid * 64 + 63];
            const bool skip = bias + qm * (sqrtf(kmx[tid]) * 1.01f + kd) < -40.f;
            if (!skip) atomic_min_int(kst, tid);
        }
        __syncthreads();
        kt0 = RFL(*kst);
    }
    f32x4 ot[NMAP][8];
    float mrun[NMAP], lsum[NMAP];
#pragma unroll
    for (int mp = 0; mp < NMAP; ++mp) { mrun[mp] = -INFINITY; lsum[mp] = 0.f;
#pragma unroll
        for (int mo = 0; mo < 8; ++mo) ot[mp][mo] = (f32x4){0.f, 0.f, 0.f, 0.f}; }
    u32x4 sk[2], sv[2]; float sc = 0.f;
    const u32x4* kg = (const u32x4*)Kg; const u32x4* vg = (const u32x4*)VT;
#pragma unroll
    for (int i = 0; i < 2; ++i) { sk[i] = kg[(size_t)kt0 * 1024 + tid + i * 512]; sv[i] = vg[(size_t)kt0 * 1024 + tid + i * 512]; }
    if (KIND == 0 && tid < 64) sc = cum2[kt0 * 64 + tid];
    for (int kt = kt0; kt < ntiles; ++kt) {
        unsigned char* kb = lds + ATT_KBUF + (kt & 1) * 16384;
        unsigned char* vb = lds + ATT_VBUF + (kt & 1) * 16384;
        float* cb = (float*)(lds + ATT_CBUF + (kt & 1) * 256);
#pragma unroll
        for (int i = 0; i < 2; ++i) {
            const int g = tid + i * 512;
            { const int row = g >> 4, c = g & 15; *(u32x4*)(kb + row * 256 + ((c ^ (row & 15)) << 4)) = sk[i]; }
            { const int d = g >> 3, c = g & 7; *(u32x4*)(vb + d * 128 + ((c ^ ((d >> 1) & 7)) << 4)) = sv[i]; }
        }
        if (KIND == 0 && tid < 64) cb[tid] = sc;
        __syncthreads();
        if (kt + 1 < ntiles) {
#pragma unroll
            for (int i = 0; i < 2; ++i) { sk[i] = kg[(size_t)(kt + 1) * 1024 + tid + i * 512]; sv[i] = vg[(size_t)(kt + 1) * 1024 + tid + i * 512]; }
            if (KIND == 0 && tid < 64) sc = cum2[(kt + 1) * 64 + tid];
        }
        if (kt <= wlimit) {
#pragma unroll
            for (int mp = 0; mp < NMAP; ++mp) {
                bf16x8 kf[4][NKS], vfa[8];
#pragma unroll
                for (int m = 0; m < 4; ++m)
#pragma unroll
                    for (int ks = 0; ks < NKS; ++ks) { const int c = (KIND == 0 ? 0 : mp * 8) + ks * 4 + q4; kf[m][ks] = *(const bf16x8*)(kb + (m * 16 + r16) * 256 + ((c ^ r16) << 4)); }
#pragma unroll
                for (int mo = 0; mo < 8; ++mo) { const int d = mo * 16 + r16; vfa[mo] = *(const bf16x8*)(vb + d * 128 + (((0 * 4 + q4) ^ ((d >> 1) & 7)) << 4)); }
                SCHED();
                f32x4 st[4];
#pragma unroll
                for (int m = 0; m < 4; ++m) st[m] = (f32x4){0.f, 0.f, 0.f, 0.f};
#pragma unroll
                for (int ks = 0; ks < NKS; ++ks)
#pragma unroll
                    for (int m = 0; m < 4; ++m) st[m] = MFMA16(kf[m][ks], qf[mp][ks], st[m]);
                SCHED();
                float mx = -INFINITY;
#pragma unroll
                for (int m = 0; m < 4; ++m) {
                    if (KIND == 0) {
                        const f32x4 ck = *(const f32x4*)(cb + m * 16 + 4 * q4);
#pragma unroll
                        for (int j = 0; j < 4; ++j) {
                            float y = st[m][j] + (cq - ck[j]);
                            if (kt * 64 + m * 16 + 4 * q4 + j > myq) y = -INFINITY;
                            st[m][j] = y;
                        }
                    }
#pragma unroll
                    for (int j = 0; j < 4; ++j) mx = fmaxf(mx, st[m][j]);
                }
                mx = xrow16_max(mx);
                const float mnew = fmaxf(mrun[mp], mx);
                const float alpha = FAST_EXP2(mrun[mp] - mnew);
                mrun[mp] = mnew;
                float ps = 0.f;
#pragma unroll
                for (int m = 0; m < 4; ++m)
#pragma unroll
                    for (int j = 0; j < 4; ++j) { const float pv = FAST_EXP2(st[m][j] - mnew); st[m][j] = pv; ps += pv; }
                lsum[mp] = lsum[mp] * alpha + ps;
#pragma unroll
                for (int mo = 0; mo < 8; ++mo) ot[mp][mo] *= alpha;
                bf16x8 pf[2];
#pragma unroll
                for (int kk = 0; kk < 2; ++kk) {
                    u32x4 pw;
                    pw.x = pack2(st[2 * kk][0], st[2 * kk][1]); pw.y = pack2(st[2 * kk][2], st[2 * kk][3]);
                    pw.z = pack2(st[2 * kk + 1][0], st[2 * kk + 1][1]); pw.w = pack2(st[2 * kk + 1][2], st[2 * kk + 1][3]);
                    pf[kk] = __builtin_bit_cast(bf16x8, pw);
                }
                bf16x8 vfb[8];
#pragma unroll
                for (int mo = 0; mo < 8; ++mo) { const int d = mo * 16 + r16; vfb[mo] = *(const bf16x8*)(vb + d * 128 + (((1 * 4 + q4) ^ ((d >> 1) & 7)) << 4)); }
                SCHED();
#pragma unroll
                for (int mo = 0; mo < 8; ++mo) ot[mp][mo] = MFMA16(vfa[mo], pf[0], ot[mp][mo]);
                SCHED();
#pragma unroll
                for (int mo = 0; mo < 8; ++mo) ot[mp][mo] = MFMA16(vfb[mo], pf[1], ot[mp][mo]);
            }
        }
    }
    float inv[NMAP];
#pragma unroll
    for (int mp = 0; mp < NMAP; ++mp) { float l = lsum[mp]; l = xrow16_sum(l); inv[mp] = 1.f / l; }
    if (KIND == 0) {
        int te = tid; OPAQUE(te);
        const int er = te & 15, eq = (te >> 4) & 3, eqw = qb * 128 + (te >> 6) * 16;
        unsigned char* stg = lds + ATT_STAGE + (te >> 6) * 8192;
#pragma unroll
        for (int mo = 0; mo < 8; ++mo) {
            u32x2 o; o.x = pack2(ot[0][mo][0] * inv[0], ot[0][mo][1] * inv[0]); o.y = pack2(ot[0][mo][2] * inv[0], ot[0][mo][3] * inv[0]);
            *(u32x2*)(stg + er * 256 + (((mo * 2 + (eq >> 1)) ^ er) << 4) + (eq & 1) * 8) = o;
        }
        WAVE_SYNC();
#pragma unroll
        for (int k = 0; k < 4; ++k) {
            const int rl = k * 4 + eq, cch = er;
            const u32x4 val = *(const u32x4*)(stg + rl * 256 + ((cch ^ rl) << 4));
            *(u32x4*)(concat + (size_t)(eqw + rl) * D + ccol0 + cch * 8) = val;
        }
    } else {
        float ss = 0.f;
#pragma unroll
        for (int mo = 0; mo < 8; ++mo)
#pragma unroll
            for (int j = 0; j < 4; ++j) { const float v = ot[0][mo][j] * inv[0] - lam * (ot[NMAP - 1][mo][j] * inv[NMAP - 1]); ot[0][mo][j] = v; ss += v * v; }
        ss = xrow16_sum(ss);
        const float rs = osc / sqrtf(ss * (1.f / 128.f) + LN_EPS);
#pragma unroll
        for (int mo = 0; mo < 8; ++mo) {
            const f32x4 g = *(const f32x4*)(subg + mo * 16 + 4 * q4);
            u32x2 o; o.x = pack2(ot[0][mo][0] * rs * g[0], ot[0][mo][1] * rs * g[1]); o.y = pack2(ot[0][mo][2] * rs * g[2], ot[0][mo][3] * rs * g[3]);
            *(u32x2*)(concat + (size_t)myq * D + ccol0 + mo * 16 + 4 * q4) = o;
        }
    }
    __syncthreads();
}

__device__ __forceinline__ int dpart_row(int c, int q) { return c * (S - DCH * 64) - (DCH * 32) * c * (c - 1) + q; }
__device__ __forceinline__ void attn_dmap_unit(const bf16_t* Qh, const bf16_t* Kh, const bf16_t* VTh, int mp, int qb, int t0, int t1,
                                               bf16_t* Op, float* ML, int c, float bnd, unsigned char* lds, int tid) {
    const bool fixedref = (bnd <= 60.f);
    const int lane = tid & 63, wave = tid >> 6, r16 = lane & 15, q4 = lane >> 4;
    const int q0w = qb * 256 + wave * 32;
    const int wlimit = q0w >> 6;
    bf16x8 qf[2][2];
#pragma unroll
    for (int n = 0; n < 2; ++n)
#pragma unroll
        for (int ks = 0; ks < 2; ++ks) qf[n][ks] = *(const bf16x8*)(Qh + (size_t)(q0w + n * 16 + r16) * 128 + mp * 64 + ks * 32 + q4 * 8);
    f32x4 ot[8][2];
    float mrun[2] = {-INFINITY, -INFINITY}, lsum[2] = {0.f, 0.f};
    if (fixedref) { mrun[0] = bnd; mrun[1] = bnd; }
    const float stinit = fixedref ? -bnd : 0.f;
#pragma unroll
    for (int mo = 0; mo < 8; ++mo) { ot[mo][0] = (f32x4){0.f, 0.f, 0.f, 0.f}; ot[mo][1] = (f32x4){0.f, 0.f, 0.f, 0.f}; }
    const u32x4* kg = (const u32x4*)Kh; const u32x4* vg = (const u32x4*)VTh;
    const int krow = tid >> 3, kc8 = tid & 7;
#define DM_STAGE(kt_) do { unsigned char* kb_ = lds + ((kt_) & 1) * 8192; unsigned char* vb_ = lds + 16384 + ((kt_) & 1) * 16384; \
        GLDS16(kg + (size_t)(kt_) * 1024 + krow * 16 + mp * 8 + (kc8 ^ ((krow >> 1) & 7)), kb_ + tid * 16); \
        _Pragma("unroll") for (int i_ = 0; i_ < 2; ++i_) { const int g_ = tid + i_ * 512, d_ = g_ >> 3, p_ = g_ & 7; \
            GLDS16(vg + (size_t)(kt_) * 1024 + d_ * 8 + (p_ ^ ((d_ >> 1) & 7)), vb_ + g_ * 16); } } while (0)
    DM_STAGE(t0);
    for (int kt = t0; kt < t1; ++kt) {
        unsigned char* kb = lds + (kt & 1) * 8192;
        unsigned char* vb = lds + 16384 + (kt & 1) * 16384;
        WAIT_VM0();
        __syncthreads();
        if (kt + 1 < t1) DM_STAGE(kt + 1);
        if (kt <= wlimit) {
            bf16x8 kf[4][2], vfa[8];
#pragma unroll
            for (int m = 0; m < 4; ++m)
#pragma unroll
                for (int ks = 0; ks < 2; ++ks) kf[m][ks] = *(const bf16x8*)(kb + (m * 16 + r16) * 128 + (((ks * 4 + q4) ^ ((r16 >> 1) & 7)) << 4));
#pragma unroll
            for (int mo = 0; mo < 8; ++mo) { const int d = mo * 16 + r16; vfa[mo] = *(const bf16x8*)(vb + d * 128 + (((0 * 4 + q4) ^ ((d >> 1) & 7)) << 4)); }
            SCHED();
            f32x4 st[4][2];
#pragma unroll
            for (int m = 0; m < 4; ++m) { st[m][0] = (f32x4){stinit, stinit, stinit, stinit}; st[m][1] = (f32x4){stinit, stinit, stinit, stinit}; }
            SETPRIO(1);
#pragma unroll
            for (int ks = 0; ks < 2; ++ks)
#pragma unroll
                for (int m = 0; m < 4; ++m) { st[m][0] = MFMA16(kf[m][ks], qf[0][ks], st[m][0]); st[m][1] = MFMA16(kf[m][ks], qf[1][ks], st[m][1]); }
            SETPRIO(0);
            SCHED();
            float alpha[2] = {1.f, 1.f};
            if (fixedref) {
#pragma unroll
                for (int n = 0; n < 2; ++n) {
                    float ps = 0.f;
#pragma unroll
                    for (int m = 0; m < 4; ++m)
#pragma unroll
                        for (int j = 0; j < 4; ++j) { const float pv = FAST_EXP2(st[m][n][j]); st[m][n][j] = pv; ps += pv; }
                    lsum[n] += ps;
                }
            } else
#pragma unroll
            for (int n = 0; n < 2; ++n) {
                float mx = -INFINITY;
#pragma unroll
                for (int m = 0; m < 4; ++m)
#pragma unroll
                    for (int j = 0; j < 4; ++j) mx = fmaxf(mx, st[m][n][j]);
                mx = xrow16_max(mx);
                const float mnew = fmaxf(mrun[n], mx);
                alpha[n] = FAST_EXP2(mrun[n] - mnew);
                mrun[n] = mnew;
                float ps = 0.f;
#pragma unroll
                for (int m = 0; m < 4; ++m)
#pragma unroll
                    for (int j = 0; j < 4; ++j) { const float pv = FAST_EXP2(st[m][n][j] - mnew); st[m][n][j] = pv; ps += pv; }
                lsum[n] = lsum[n] * alpha[n] + ps;
            }
            if (ANY_LANE(alpha[0] != 1.f)) {
#pragma unroll
                for (int mo = 0; mo < 8; ++mo) ot[mo][0] *= alpha[0];
            }
            if (ANY_LANE(alpha[1] != 1.f)) {
#pragma unroll
                for (int mo = 0; mo < 8; ++mo) ot[mo][1] *= alpha[1];
            }
            bf16x8 pf[2][2];
#pragma unroll
            for (int kk = 0; kk < 2; ++kk)
#pragma unroll
                for (int n = 0; n < 2; ++n) {
                    u32x4 pw;
                    pw.x = pack2(st[2 * kk][n][0], st[2 * kk][n][1]); pw.y = pack2(st[2 * kk][n][2], st[2 * kk][n][3]);
                    pw.z = pack2(st[2 * kk + 1][n][0], st[2 * kk + 1][n][1]); pw.w = pack2(st[2 * kk + 1][n][2], st[2 * kk + 1][n][3]);
                    pf[kk][n] = __builtin_bit_cast(bf16x8, pw);
                }
            bf16x8 vfb[8];
#pragma unroll
            for (int mo = 0; mo < 8; ++mo) { const int d = mo * 16 + r16; vfb[mo] = *(const bf16x8*)(vb + d * 128 + (((1 * 4 + q4) ^ ((d >> 1) & 7)) << 4)); }
            SCHED();
            SETPRIO(1);
#pragma unroll
            for (int mo = 0; mo < 8; ++mo) { ot[mo][0] = MFMA16(vfa[mo], pf[0][0], ot[mo][0]); ot[mo][1] = MFMA16(vfa[mo], pf[0][1], ot[mo][1]); }
            SCHED();
#pragma unroll
            for (int mo = 0; mo < 8; ++mo) { ot[mo][0] = MFMA16(vfb[mo], pf[1][0], ot[mo][0]); ot[mo][1] = MFMA16(vfb[mo], pf[1][1], ot[mo][1]); }
            SETPRIO(0);
        }
    }
    if (q0w >= DCH * 64 * c)
#pragma unroll
    for (int n = 0; n < 2; ++n) {
        float l = lsum[n]; l = xrow16_sum(l);
        const int row = dpart_row(c, q0w + n * 16 + r16);
        if (q4 == 0) { ML[row * 2] = mrun[n]; ML[row * 2 + 1] = l; }
    }
    {
        int te = tid; OPAQUE(te);
        const int er = te & 15, eq = (te >> 4) & 3, eqw = qb * 256 + (te >> 6) * 32;
        unsigned char* stg = lds + ATT_STAGE + (te >> 6) * 8192;
#pragma unroll
        for (int n = 0; n < 2; ++n)
#pragma unroll
            for (int mo = 0; mo < 8; ++mo) {
                u32x2 o; o.x = pack2(ot[mo][n][0], ot[mo][n][1]); o.y = pack2(ot[mo][n][2], ot[mo][n][3]);
                *(u32x2*)(stg + (n * 16 + er) * 256 + (((mo * 2 + (eq >> 1)) ^ er) << 4) + (eq & 1) * 8) = o;
            }
        WAVE_SYNC();
        if (eqw >= DCH * 64 * c) {
            const int row0 = dpart_row(c, eqw);
#pragma unroll
            for (int k = 0; k < 8; ++k) {
                const int rl = k * 4 + eq, cch = er;
                const u32x4 val = *(const u32x4*)(stg + rl * 256 + ((cch ^ (rl & 15)) << 4));
                *(u32x4*)(Op + (size_t)(row0 + rl) * 128 + cch * 8) = val;
            }
        }
    }
    __syncthreads();
}

__device__ __forceinline__ void lru_unit_a(int chunk, int grp, int l, const Params& p, const bf16_t* Xr, const bf16_t* WaiT, float* hloc, float* ploc, float* sumA, float* sumH,
                                           unsigned char* lds, int tid) {
    const int lane = tid & 63, wave = tid >> 6, r16 = lane & 15, q4 = lane >> 4;
    unsigned char* XCB = lds; float* XU = (float*)(lds + 16384); float* LA = (float*)(lds + 49152); float* ENDS = (float*)(lds + 81920);
    const int t0 = chunk * 64, ch0 = grp * 128;
    bf16x8 bfr[2][4];
#pragma unroll
    for (int g = 0; g < 2; ++g)
#pragma unroll
        for (int ks = 0; ks < 4; ++ks) bfr[g][ks] = *(const bf16x8*)(WaiT + ((size_t)grp * 256 + g * 128 + wave * 16 + r16) * 128 + ks * 32 + q4 * 8);
    const int chg = ch0 + wave * 16 + r16;
    const float ba = p.in[I_BA][(size_t)l * LRU_W + chg], bi = p.in[I_BI][(size_t)l * LRU_W + chg];
    const float lam_raw = p.in[I_LAM][(size_t)l * LRU_W + chg];
    {
        const int c = tid & 127, tq = tid >> 7, ch = ch0 + c;
        const float* cw = p.in[I_CONVW] + (size_t)l * 4 * LRU_W + ch; const float cb = p.in[I_CONVB][(size_t)l * LRU_W + ch];
        const float w0 = cw[0], w1 = cw[LRU_W], w2 = cw[2 * LRU_W], w3 = cw[3 * LRU_W];
        const int ts = t0 + tq * 16;
        float x0 = (ts - 3 >= 0) ? bf2f(Xr[(size_t)(ts - 3) * LRU_W + ch]) : 0.f;
        float x1 = (ts - 2 >= 0) ? bf2f(Xr[(size_t)(ts - 2) * LRU_W + ch]) : 0.f;
        float x2 = (ts - 1 >= 0) ? bf2f(Xr[(size_t)(ts - 1) * LRU_W + ch]) : 0.f;
#pragma unroll
        for (int i = 0; i < 16; ++i) {
            const float x3 = bf2f(Xr[(size_t)(ts + i) * LRU_W + ch]);
            const float v = cb + w0 * x0 + w1 * x1 + w2 * x2 + w3 * x3;
            const int row = tq * 16 + i;
            XU[row * 128 + c] = v;
            *(bf16_t*)(XCB + row * 256 + (((c >> 3) ^ (row & 15)) << 4) + (c & 7) * 2) = f2bf(v);
            x0 = x1; x1 = x2; x2 = x3;
        }
    }
    __syncthreads();
    {
        const float lsl = 8.0f * log_sigmoid_f(lam_raw);
#pragma unroll
        for (int mt = 0; mt < 4; ++mt) {
            f32x4 ga = (f32x4){0.f, 0.f, 0.f, 0.f}, gi = (f32x4){0.f, 0.f, 0.f, 0.f};
#pragma unroll
            for (int ks = 0; ks < 4; ++ks) {
                const bf16x8 af = *(const bf16x8*)(XCB + (mt * 16 + r16) * 256 + (((ks * 4 + q4) ^ r16) << 4));
                ga = MFMA16(af, bfr[0][ks], ga); gi = MFMA16(af, bfr[1][ks], gi);
            }
#pragma unroll
            for (int j = 0; j < 4; ++j) {
                const int row = mt * 16 + 4 * q4 + j, idx = row * 128 + wave * 16 + r16;
                const float r = sigmoid_f(ga[j] + ba), ig = sigmoid_f(gi[j] + bi);
                const float log_a = lsl * r;
                LA[idx] = fexp(log_a);
                XU[idx] = sqrtf(neg_expm1_f(2.f * log_a)) * (ig * XU[idx]);
            }
        }
    }
    __syncthreads();
    {
        const int c = tid & 127, tq = tid >> 7, ch = ch0 + c;
        float h = 0.f, P = 1.f;
#pragma unroll
        for (int i = 0; i < 16; ++i) { const int idx = (tq * 16 + i) * 128 + c; const float a = LA[idx]; h = a * h + XU[idx]; P *= a; XU[idx] = h; LA[idx] = P; }
        ENDS[tq * 128 + c] = P; ENDS[512 + tq * 128 + c] = h;
        __syncthreads();
        float cin = 0.f, pin = 1.f;
        for (int s = 0; s < tq; ++s) { const float Ps = ENDS[s * 128 + c], hs = ENDS[512 + s * 128 + c]; cin = Ps * cin + hs; pin *= Ps; }
#pragma unroll
        for (int i = 0; i < 16; ++i) {
            const int idx = (tq * 16 + i) * 128 + c; const size_t gi = (size_t)(t0 + tq * 16 + i) * LRU_W + ch;
            const float Pl = LA[idx], hl = XU[idx];
            ((unsigned*)hloc)[gi] = pack2(hl + Pl * cin, Pl * pin);
        }
        if (tq == 3) { const float Pl = LA[63 * 128 + c], hl = XU[63 * 128 + c]; sumA[(size_t)chunk * LRU_W + ch] = Pl * pin; sumH[(size_t)chunk * LRU_W + ch] = hl + Pl * cin; }
    }
    __syncthreads();
}

__device__ __forceinline__ void moe_prefix(const int* cntb_, int G, unsigned char* lds, int tid) {
    int* tmp = (int*)lds; int* ctot = (int*)(lds + LDS_MISC + M_CTOT); int* coff = (int*)(lds + LDS_MISC + M_COFF);
    unsigned short* pre16 = (unsigned short*)(lds + LDS_MISC + M_PRE16);
    const int e = tid & 31, part = tid >> 5, PB = (G + 15) / 16;
    int sm = 0;
    for (int i = 0; i < PB; ++i) { const int b = part * PB + i; if (b < G) sm += cntb_[b * 32 + e]; }
    tmp[part * 32 + e] = sm;
    __syncthreads();
    int run = 0;
    for (int q = 0; q < part; ++q) run += tmp[q * 32 + e];
    for (int i = 0; i < PB; ++i) { const int b = part * PB + i; if (b < G) { pre16[e * 257 + b] = (unsigned short)run; run += cntb_[b * 32 + e]; } }
    if (part == 15) { ctot[e] = run; pre16[e * 257 + G] = (unsigned short)run; }
    __syncthreads();
    if (tid == 0) { int o = 0; for (int q = 0; q < 32; ++q) { coff[q] = o; o += ctot[q]; } coff[32] = o; }
    __syncthreads();
}
__device__ __forceinline__ void moe_rowtable(const int* ltok_, const float* lw_, const int* lslot_, int e, int m0, int c_e, int G, int segcap, unsigned char* lds, int tid_in) {
    int tid = tid_in; OPAQUE(tid);
    const unsigned short* pre = (const unsigned short*)(lds + LDS_MISC + M_PRE16) + e * 257;
    int* rtok = (int*)(lds + LDS_MISC + M_RTOK); float* rw = (float*)(lds + LDS_MISC + M_RW); int* rslot = (int*)(lds + LDS_MISC + M_RSLOT);
    if (tid < 256) {
        const int g = m0 + tid;
        int tk = 0, sl = 0; float w = 0.f;
        if (g < c_e) {
            int lo = 0, hi = G;
            while (hi - lo > 1) { const int mid = (lo + hi) >> 1; if ((int)pre[mid] <= g) lo = mid; else hi = mid; }
            const int idx = (e * G + lo) * segcap + (g - (int)pre[lo]);
            tk = ltok_[idx]; w = lw_[idx]; sl = lslot_[idx];
        }
        rtok[tid] = tk; rw[tid] = w; rslot[tid] = sl;
    }
    __syncthreads();
}
#define kmax2 ((float*)(wsl + A_KMAX))
#define dpo ((bf16_t*)(wsl + A_DPO))
#define dpml ((float*)(wsl + A_DPML))
#define cntb ((int*)(wsl + A_CNTB))
#define WinT ((bf16_t*)(wsl + WB_WIN))
#define WoT ((bf16_t*)(wsl + WB_WO))
#define WguT ((bf16_t*)(wsl + WB_WGU))
#define WdT ((bf16_t*)(wsl + WB_WD))
#define WaiT ((bf16_t*)(wsl + WB_WAI))
#define Wfa ((float*)(wsl + WF_FA))
#define W36b ((bf16_t*)(wsl + WF_R36))
#define ropecs ((float*)(wsl + WF_ROPE))
#define xb ((bf16_t*)(wsl + A_XB))
#define hb ((float*)(wsl + A_HB))
#define logf_ ((float*)(wsl + A_LOGF))
#define cum2 ((float*)(wsl + A_CUM))
#define Qa ((bf16_t*)(wsl + A_QA))
#define Ka ((bf16_t*)(wsl + A_KA))
#define VaT ((bf16_t*)(wsl + A_VAT))
#define Xr ((bf16_t*)(wsl + A_XR))
#define Gr ((bf16_t*)(wsl + A_GR))
#define Qc ((bf16_t*)(wsl + A_QC))
#define Kc ((bf16_t*)(wsl + A_KC))
#define VcT ((bf16_t*)(wsl + A_VCT))
#define hloc ((float*)(wsl + A_HLOC))
#define ploc ((float*)(wsl + A_PLOC))
#define sumA ((float*)(wsl + A_SUMA))
#define sumH ((float*)(wsl + A_SUMH))
#define concat ((bf16_t*)(wsl + A_CONCAT))
#define y1 ((float*)(wsl + A_Y1))
#define h1 ((float*)(wsl + A_H1))
#define h1b ((bf16_t*)(wsl + A_H1B))
#define ltok ((int*)(wsl + A_LTOK))
#define lw ((float*)(wsl + A_LW))
#define lslot ((int*)(wsl + A_LSLOT))
#define act ((bf16_t*)(wsl + A_ACT))
#define contrib ((bf16_t*)(wsl + A_CONTRIB))
#ifndef EMU
__global__ void __launch_bounds__(NTHREADS, 2)
#else
void
#endif
fwd_kernel(Params p) {
    DYN_LDS(lds_raw);
    float* ldsf = (float*)lds_raw;
    const int bid = blockIdx.x, G = gridDim.x;
    const int gthreads = G * NTHREADS, gwaves = G * (NTHREADS / 64);
    const int wave_s = RFL((int)threadIdx.x >> 6);
#define PHASE_IDS() unsigned char* wsl = ws; OPAQUE_S(wsl); int tid = wave_s * 64 + LANE_ID(); OPAQUE(tid); const int lane = tid & 63, wave = tid >> 6, gtid = bid * NTHREADS + tid, gwave = bid * (NTHREADS / 64) + wave; (void)lane; (void)wave; (void)gtid; (void)gwave

    unsigned char* ws = p.ws;
    volatile LAS unsigned* bst = (volatile LAS unsigned*)(lds_raw + LDS_MISC);
    unsigned* ubox = (unsigned*)(lds_raw + LDS_MISC + 16);
    if (threadIdx.x == 0) { bst[0] = 0u; bst[1] = 0u; bst[2] = 0u; bst[3] = 0u; }
    __syncthreads();
    XcdBarrier bar = xcd_barrier_post((unsigned*)ws, bst);

    const int* positions = (const int*)p.in[I_POS];

    constexpr int NPH = 8;
    const int lo = p.lo, hi = p.hi;
#ifdef ONLY_PHASE
#define PH_SEL(c) ((c) == ONLY_PHASE)
#else
#define PH_SEL(c) 1
#endif
#define PH_IN(k) (lo <= (k) && (k) < hi)
#define PH_BAR(k) do { if ((k) + 1 < hi) xcd_barrier(bar, wave_s == 0 && LANE_ID() == 0); } while (0)

    if (PH_SEL(-1) && PH_IN(0)) for (int rep = 0; rep < PH_REPS(-1); ++rep) {
        PHASE_IDS();
        for (int l = 0; l < DEPTH; ++l) {
            convert_mats(p.in[I_WIN] + (size_t)l * D * N_IN, 0, 1, N_IN, D, N_IN, WinT + (size_t)l * N_INP * D, 0, RmWin{}, ldsf, tid, bid, G);
            for (int t = bid; t < (D / 64) * (D / 256); t += G)
                convert_tile_v4(p.in[I_WO] + (size_t)l * D * D, D, D, (t / (D / 256)) * 64, (t % (D / 256)) * 256, WoT + (size_t)l * D * D, RmIdent{}, ldsf, tid);
            convert_mats(p.in[I_WA] + (size_t)l * 6 * 128 * 128, (size_t)128 * 128, 6, 128, 128, 128, WaiT + (size_t)l * 6 * 256 * 128, (size_t)256 * 128, RmIdent{}, ldsf, tid, bid, G);
            convert_mats(p.in[I_WI] + (size_t)l * 6 * 128 * 128, (size_t)128 * 128, 6, 128, 128, 128, WaiT + (size_t)l * 6 * 256 * 128, (size_t)256 * 128, RmOff{128}, ldsf, tid, bid, G);
        }
        for (int i = gtid; i < DEPTH * 8 * D; i += gthreads) { const int h = i % 8, k = (i / 8) % D, l = i / (8 * D);
            Wfa[((size_t)l * 8 + h) * D + k] = (h < 6) ? p.in[I_WIN][(size_t)l * D * N_IN + (size_t)k * N_IN + C_FA + h] : 0.f; }
        for (int i = gtid; i < DEPTH * 48 * D; i += gthreads) { const int k = i % D, o = (i / D) % 48, l = i / (48 * D);
            const float w = (o < 4) ? p.in[I_WGRP][((size_t)l * D + k) * 4 + o] : (o < 36 ? p.in[I_WRT][((size_t)l * D + k) * 32 + (o - 4)] : 0.f);
            const bf16_t hi = f2bf(w);
            W36b[((size_t)l * 2 + 0) * 48 * D + (size_t)o * D + k] = hi; W36b[((size_t)l * 2 + 1) * 48 * D + (size_t)o * D + k] = f2bf(w - bf2f(hi)); }
        for (int i = gtid; i < S * 8; i += gthreads) { const int d = i & 7, t = i >> 3; const float ang = (float)positions[t] * p.inv_freq[d];
            ropecs[t * 16 + d] = cosf(ang); ropecs[t * 16 + 8 + d] = sinf(ang); }
        __syncthreads();
        for (int i = tid; i < 6 * D; i += NTHREADS) { const int k = i / 6, h = i % 6; ldsf[h * D + k] = p.in[I_WIN][(size_t)k * N_IN + C_FA + h]; }
        __syncthreads();
        for (int t0 = gwave * 2; t0 < S; t0 += gwaves * 2) {
            f32x4 v[2][8];
#pragma unroll
            for (int tk = 0; tk < 2; ++tk)
#pragma unroll
                for (int j = 0; j < 8; ++j) v[tk][j] = *(const f32x4*)(p.in[I_X] + (size_t)(t0 + tk) * D + j * 256 + lane * 4);
#pragma unroll
            for (int tk = 0; tk < 2; ++tk) {
                const int t = t0 + tk;
                float fa[6] = {0.f, 0.f, 0.f, 0.f, 0.f, 0.f};
#pragma unroll
                for (int j = 0; j < 8; ++j) {
                    const int c = j * 256 + lane * 4;
                    u32x2 o; o.x = pack2(v[tk][j][0], v[tk][j][1]); o.y = pack2(v[tk][j][2], v[tk][j][3]);
                    *(u32x2*)(xb + (size_t)t * D + c) = o;
#pragma unroll
                    for (int h = 0; h < 6; ++h) { const f32x4 w = *(const f32x4*)(ldsf + h * D + c); fa[h] += v[tk][j][0] * w[0] + v[tk][j][1] * w[1] + v[tk][j][2] * w[2] + v[tk][j][3] * w[3]; }
                    COMPILER_FENCE();
                }
#pragma unroll
                for (int h = 0; h < 6; ++h) { const float sm = wave_sum(fa[h]); if (lane == 0) logf_[h * S + t] = log_sigmoid_f(sm + p.in[I_BF][h]); }
            }
        }
        PH_BAR(0);
    }

    for (int l = 0; l < DEPTH; ++l) {
        const int pb = 1 + l * NPH;
#define hin ((l == 0) ? p.in[I_X] : (const float*)hb)
#define hout ((l == DEPTH - 1) ? p.out : hb)
#define workctr ((int*)(wsl + CTL_WORK_OFF) + l * 64)

        if (PH_SEL(0) && PH_IN(pb + 0)) {
            PHASE_IDS();
            int bz = RFL(bid); OPAQUE_S(bz);
            if (bz == 0) {
                double* part = (double*)lds_raw;
                const int per = S / 64;
                double s = 0.0;
                if (wave < 6) { for (int i = 0; i < per; ++i) s += (double)logf_[wave * S + lane * per + i]; part[wave * 64 + lane] = s; }
                __syncthreads();
                if (wave < 6) {
                    double run = 0.0;
                    for (int j = 0; j < lane; ++j) run += part[wave * 64 + j];
                    for (int i = 0; i < per; ++i) { run += (double)logf_[wave * S + lane * per + i]; cum2[wave * S + lane * per + i] = (float)(run * (double)LOG2E); }
                }
                __syncthreads();
            }
            bool conv_more = (l == 0);
#define CONV_ONE() do { if (conv_more) { __syncthreads(); if (tid == 0) *ubox = (unsigned)atomic_add_int((int*)(wsl + CTL_WORK_OFF) + 62, 1); __syncthreads(); \
                const int cid_ = RFL((int)*ubox); if (cid_ < NCONV) moe_conv_chunk(p, cid_, WguT, WdT, ldsf, tid); else conv_more = false; } } while (0)
            unsigned* cls = (unsigned*)(wsl + CTL_CLS_OFF) + l * 256;
            if (bz == 0) { WAIT_VM0(); __syncthreads(); if (tid == 0) { FENCE_REL_AGENT(); WAIT_VM0(); (void)xb_add(&cls[192], 1u); } }
            const bf16_t* Bt = WinT + (size_t)l * N_INP * D;
            constexpr int ntm = S / 256;
            const unsigned nooff[2][2] = {{0u, 0u}, {0u, 0u}};
            for (int i = 0; i < (bid & 3); ++i) CONV_ONE();
            for (;;) {
                __syncthreads();
                if (tid == 0) *ubox = (unsigned)atomic_add_int(workctr + 9, 1);
                __syncthreads();
                int t = RFL((int)*ubox);
                if (t >= ntm * 21) break;
                int pm, pn, kcls;
                if (t < ntm * 6) { pm = t / 6; pn = 15 + t % 6; kcls = 0; }
                else if (t < ntm * 12) { t -= ntm * 6; pm = t / 6; pn = 9 + t % 6; kcls = 1; }
                else { t -= ntm * 12; pm = t / 9; pn = t % 9; kcls = 2; }
                f32x4 acc[2][2][4][2];
                gemm_tile<false>(xb, pm * 256, nooff, Bt, pn * 256, D, lds_raw, acc, tid);
                int et = tid; OPAQUE(et); const int wr = et >> 8, wc = (et >> 6) & 3, fr = et & 15, fq = (et >> 4) & 3;
                if (pn < 6 || (pn >= 9 && pn < 19)) {
                    bf16_t* dst; float scale = 1.f; bool rope = false;
                    if (pn < 3) { dst = Qa; scale = QSCALE_A; } else if (pn < 6) { dst = Ka; } else if (pn < 12) { dst = Xr; } else if (pn < 15) { dst = Gr; }
                    else if (pn < 17) { dst = Qc; scale = QSCALE_C; rope = true; } else { dst = Kc; rope = true; }
                    const bool headmajor = (pn < 6) || (pn >= 15);
                    const int segpn = (pn < 3) ? pn : (pn < 6) ? pn - 3 : (pn < 12) ? pn - 9 : (pn < 15) ? pn - 12 : (pn < 17) ? pn - 15 : pn - 17;
#pragma unroll
                    for (int ai = 0; ai < 2; ++ai)
#pragma unroll
                        for (int m = 0; m < 4; ++m)
#pragma unroll
                            for (int bj = 0; bj < 2; ++bj)
#pragma unroll
                                for (int n = 0; n < 2; ++n) {
                                    const int dd = wc * 32 + n * 16 + fr;
#pragma unroll
                                    for (int j = 0; j < 4; ++j) {
                                        const int row = pm * 256 + ai * 128 + wr * 64 + m * 16 + fq * 4 + j;
                                        float v = acc[ai][bj][m][n][j];
                                        if (rope && n == 0 && (wc & 1) == 0) {
                                            const float pv = SHX(v, 8);
                                            const float cs = ropecs[row * 16 + (fr & 7)], sn = ropecs[row * 16 + 8 + (fr & 7)];
                                            v = (fr < 8) ? (v * cs - pv * sn) : (v * cs + pv * sn);
                                        }
                                        v *= scale;
                                        *(bf16_t*)(lds_raw + (ai * 128 + wr * 64 + m * 16 + fq * 4 + j) * 528 + (bj * 128 + dd) * 2) = f2bf(v);
                                    }
                                }
                    __syncthreads();
#pragma unroll 4
                    for (int i = 0; i < 16; ++i) {
                        const int idx = et + i * 512, lrow = idx >> 5, ch = idx & 31, row = pm * 256 + lrow;
                        const u32x4 val = *(const u32x4*)(lds_raw + lrow * 528 + ch * 16);
                        size_t gi;
                        if (headmajor) gi = ((size_t)(segpn * 2 + (ch >> 4)) * S + row) * 128 + (ch & 15) * 8;
                        else gi = (size_t)row * LRU_W + segpn * 256 + ch * 8;
                        *(u32x4*)(dst + gi) = val;
                    }
                    __syncthreads();
                    if (pn >= 15) {
                        float* part = ldsf;
#pragma unroll
                        for (int ai = 0; ai < 2; ++ai)
#pragma unroll
                            for (int m = 0; m < 4; ++m)
#pragma unroll
                                for (int bj = 0; bj < 2; ++bj)
#pragma unroll
                                    for (int j = 0; j < 4; ++j) {
                                        float ss = acc[ai][bj][m][0][j] * acc[ai][bj][m][0][j] + acc[ai][bj][m][1][j] * acc[ai][bj][m][1][j];
                                        ss += SHX(ss, 1); ss += SHX(ss, 2); ss += SHX(ss, 4); ss += SHX(ss, 8);
                                        if (fr == 0) part[(wc * 2 + bj) * 256 + ai * 128 + wr * 64 + m * 16 + fq * 4 + j] = ss;
                                    }
                        __syncthreads();
                        {
                            const int bj = et >> 8, row = et & 255;
                            float v0 = part[(0 * 2 + bj) * 256 + row] + part[(1 * 2 + bj) * 256 + row], v1 = part[(2 * 2 + bj) * 256 + row] + part[(3 * 2 + bj) * 256 + row];
                            v0 = fmaxf(v0, SHX(v0, 1)); v0 = fmaxf(v0, SHX(v0, 2)); v0 = fmaxf(v0, SHX(v0, 4)); v0 = fmaxf(v0, SHX(v0, 8)); v0 = xrow16_max(v0);
                            v1 = fmaxf(v1, SHX(v1, 1)); v1 = fmaxf(v1, SHX(v1, 2)); v1 = fmaxf(v1, SHX(v1, 4)); v1 = fmaxf(v1, SHX(v1, 8)); v1 = xrow16_max(v1);
                            if ((et & 63) == 0) {
                                unsigned* q2p = (unsigned*)(wsl + CTL_QK2_OFF) + l * 16 + (pn >= 17 ? 8 : 0) + (segpn * 2 + bj) * 2;
                                atomic_max_u32(q2p, __builtin_bit_cast(unsigned, v0)); atomic_max_u32(q2p + 1, __builtin_bit_cast(unsigned, v1));
                            }
                        }
                        __syncthreads();
                    }
                    if (pn >= 3 && pn < 6) {
                        float* part = ldsf;
#pragma unroll
                        for (int ai = 0; ai < 2; ++ai)
#pragma unroll
                            for (int m = 0; m < 4; ++m)
#pragma unroll
                                for (int bj = 0; bj < 2; ++bj)
#pragma unroll
                                    for (int j = 0; j < 4; ++j) {
                                        float ss = acc[ai][bj][m][0][j] * acc[ai][bj][m][0][j] + acc[ai][bj][m][1][j] * acc[ai][bj][m][1][j];
                                        ss += SHX(ss, 1); ss += SHX(ss, 2); ss += SHX(ss, 4); ss += SHX(ss, 8);
                                        if (fr == 0) part[(wc * 2 + bj) * 256 + ai * 128 + wr * 64 + m * 16 + fq * 4 + j] = ss;
                                    }
                        __syncthreads();
                        {
                            const int bj = et >> 8, row = et & 255;
                            float v = part[(0 * 2 + bj) * 256 + row] + part[(1 * 2 + bj) * 256 + row] + part[(2 * 2 + bj) * 256 + row] + part[(3 * 2 + bj) * 256 + row];
                            v = fmaxf(v, SHX(v, 1)); v = fmaxf(v, SHX(v, 2)); v = fmaxf(v, SHX(v, 4)); v = fmaxf(v, SHX(v, 8)); v = xrow16_max(v);
                            if ((et & 63) == 0) kmax2[((pn - 3) * 2 + bj) * NKT + pm * 4 + ((et >> 6) & 3)] = v;
                        }
                        __syncthreads();
                    }
                } else {
                    bf16_t* dst = (pn < 9) ? VaT : VcT;
                    const int segpn = (pn < 9) ? pn - 6 : pn - 19;
#pragma unroll
                    for (int ai = 0; ai < 2; ++ai)
#pragma unroll
                        for (int m = 0; m < 4; ++m)
#pragma unroll
                            for (int bj = 0; bj < 2; ++bj)
#pragma unroll
                                for (int n = 0; n < 2; ++n) {
                                    const int dd = wc * 32 + n * 16 + fr;
                                    const f32x4 a = acc[ai][bj][m][n];
                                    u32x2 o; o.x = pack2(a[0], a[1]); o.y = pack2(a[2], a[3]);
                                    const int s6 = m * 16 + fq * 4, pos = (s6 & 32) + ((s6 >> 2) & 3) * 8 + ((s6 >> 4) & 1) * 4;
                                    *(u32x2*)(lds_raw + ((bj * 4 + ai * 2 + wr) * 128 + dd) * 128 + ((((pos >> 3) ^ (dd & 7))) << 4) + (pos & 7) * 2) = o;
                                }
                    __syncthreads();
#pragma unroll 4
                    for (int i = 0; i < 16; ++i) {
                        const int idx = et + i * 512, blk = idx >> 10, dd = (idx >> 3) & 127, c = idx & 7;
                        const u32x4 val = *(const u32x4*)(lds_raw + (blk * 128 + dd) * 128 + ((c ^ (dd & 7)) << 4));
                        *(u32x4*)(dst + (((size_t)(segpn * 2 + (blk >> 2)) * NKT + (pm * 4 + (blk & 3))) * 128 + dd) * 64 + c * 8) = val;
                    }
                    __syncthreads();
                }
                WAIT_VM0();
                __syncthreads();
                if (et == 0) { FENCE_REL_AGENT(); WAIT_VM0(); (void)xb_add(&cls[kcls * 64], 1u); }
                CONV_ONE();
            }
        }

        if (PH_SEL(1) && PH_IN(pb + 1)) {
            PHASE_IDS();
            const float lam_init = (l == 0) ? 0.2f : 0.35550906759f;
            const float s1 = wave_sum(p.in[I_LQ1][l * 64 + lane] * p.in[I_LK1][l * 64 + lane]);
            const float s2 = wave_sum(p.in[I_LQ2][l * 64 + lane] * p.in[I_LK2][l * 64 + lane]);
            const float lam = fexp(s1) - fexp(s2) + lam_init;
            constexpr int NLRU = NKT * 6, NQB = S / 128;
            bool conv_more = (l == 0);
            unsigned* cls = (unsigned*)(wsl + CTL_CLS_OFF) + l * 256;
            unsigned* bw = (unsigned*)wsl;
#define WAIT_CLASS(k, n) do { __syncthreads(); if (tid == 0) { XB_SPIN(xb_ld(&cls[(k) * 64]) < (unsigned)(n), bw); FENCE_ACQ_AGENT(); WAIT_VM0(); } __syncthreads(); } while (0)
#ifndef NO_DIFF
            {
                constexpr int NQB2 = S / 256;
                int total = 0;
                for (int q = 0; q < NQB2; ++q) total += ((4 * q + 4 + DCH - 1) / DCH) * 8;
                WAIT_CLASS(0, (S / 256) * 6);
                for (;;) {
                    __syncthreads();
                    if (tid == 0) *ubox = (unsigned)atomic_add_int(workctr, 1);
                    __syncthreads();
                    int u = RFL((int)*ubox);
                    if (u >= total) break;
                    int qb = NQB2 - 1;
                    for (;; --qb) { const int nu = ((4 * qb + 4 + DCH - 1) / DCH) * 8; if (u < nu) break; u -= nu; }
                    const int c = u >> 3, h = (u >> 1) & 3, mp = u & 1;
                    const int t0 = c * DCH, t1 = (t0 + DCH < 4 * qb + 4) ? t0 + DCH : 4 * qb + 4;
                    const unsigned* q2p = (const unsigned*)(wsl + CTL_QK2_OFF) + l * 16;
                    const float bnd = sqrtf(__builtin_bit_cast(float, q2p[h * 2 + mp]) * __builtin_bit_cast(float, q2p[8 + h * 2 + mp])) * (QSCALE_C * 1.02f) + 0.01f;
                    attn_dmap_unit(Qc + (size_t)h * S * 128, Kc + (size_t)h * S * 128, VcT + (size_t)h * S * 128, mp, qb, t0, t1,
                                   dpo + (size_t)(h * 2 + mp) * DPART_ROWS * 128, dpml + (size_t)(h * 2 + mp) * DPART_ROWS * 2, c, RFL_F(bnd), lds_raw, tid);
                    CONV_ONE();
                }
            }
#endif
#ifndef NO_LRU
            WAIT_CLASS(1, (S / 256) * 6);
            for (;;) {
                __syncthreads();
                if (tid == 0) *ubox = (unsigned)atomic_add_int(workctr + 10, 1);
                __syncthreads();
                const int u = RFL((int)*ubox);
                if (u >= NLRU) break;
                lru_unit_a(u / 6, u % 6, l, p, Xr, WaiT + (size_t)l * 6 * 256 * 128, hloc, ploc, sumA, sumH, lds_raw, tid);
            }
#endif
#ifndef NO_FOX
            WAIT_CLASS(2, (S / 256) * 9);
            WAIT_CLASS(3, 1);
            for (;;) {
                __syncthreads();
                if (tid == 0) *ubox = (unsigned)atomic_add_int(workctr + 1, 1);
                __syncthreads();
                const int u = RFL((int)*ubox);
                if (u >= NQB * FOX_H) break;
                const int qb = NQB - 1 - u / FOX_H, h = u % FOX_H;
                attn_unit<0>(Qa + (size_t)h * S * 128, Ka + (size_t)h * S * 128, VaT + (size_t)h * S * 128, cum2 + (size_t)h * S, kmax2 + h * NKT, qb, concat, h * 128,
                             0.f, 0.f, nullptr, lds_raw, tid);
            }
#endif
            while (conv_more) CONV_ONE();
            PH_BAR(pb + 1);
        }

        if (PH_SEL(2) && PH_IN(pb + 2)) for (int rep = 0; rep < PH_REPS(2); ++rep) {
            PHASE_IDS();
            {
                const int per = (NKT * 6 + G - 1) / G;
                const int c = tid & 127, tq = tid >> 7;
                float cr = 0.f; int pgrp = -1;
                for (int u = bid * per; u < (bid + 1) * per && u < NKT * 6; ++u) {
                    const int grp = u / NKT, chunk = u % NKT, ch = grp * 128 + c;
                    if (grp != pgrp) {
                        pgrp = grp;
                        const int seg = (chunk + 3) >> 2, j0 = tq * seg, j1 = (j0 + seg < chunk) ? j0 + seg : chunk;
                        float pa = 1.f, ph = 0.f;
                        int j = j0;
                        for (; j + 16 <= j1; j += 16) {
                            float a8[16], h8[16];
#pragma unroll
                            for (int q = 0; q < 16; ++q) { a8[q] = sumA[(size_t)(j + q) * LRU_W + ch]; h8[q] = sumH[(size_t)(j + q) * LRU_W + ch]; }
#pragma unroll
                            for (int q = 0; q < 16; ++q) { pa *= a8[q]; ph = a8[q] * ph + h8[q]; }
                        }
                        for (; j < j1; ++j) { const float a = sumA[(size_t)j * LRU_W + ch]; pa *= a; ph = a * ph + sumH[(size_t)j * LRU_W + ch]; }
                        __syncthreads();
                        ldsf[(tq * 128 + c) * 2] = pa; ldsf[(tq * 128 + c) * 2 + 1] = ph;
                        __syncthreads();
                        cr = 0.f;
#pragma unroll
                        for (int s = 0; s < 4; ++s) cr = ldsf[(s * 128 + c) * 2] * cr + ldsf[(s * 128 + c) * 2 + 1];
                    }
                    float hl[16], pl[16]; bf16_t gg[16];
#pragma unroll
                    for (int i = 0; i < 16; ++i) { const size_t gi = (size_t)(chunk * 64 + tq * 16 + i) * LRU_W + ch; const unsigned hp = ((const unsigned*)hloc)[gi]; hl[i] = bf2f((bf16_t)(hp & 0xffffu)); pl[i] = bf2f((bf16_t)(hp >> 16)); gg[i] = Gr[gi]; }
                    const float an = sumA[(size_t)chunk * LRU_W + ch], hn = sumH[(size_t)chunk * LRU_W + ch];
#pragma unroll
                    for (int i = 0; i < 16; ++i)
                        concat[(size_t)(chunk * 64 + tq * 16 + i) * D + FOX_W + ch] = f2bf(gelu_tanh_f(bf2f(gg[i])) * (hl[i] + pl[i] * cr));
                    cr = an * cr + hn;
                }
            }
            {
                const float lam_init = (l == 0) ? 0.2f : 0.35550906759f;
                const float s1 = wave_sum(p.in[I_LQ1][l * 64 + lane] * p.in[I_LK1][l * 64 + lane]);
                const float s2 = wave_sum(p.in[I_LQ2][l * 64 + lane] * p.in[I_LK2][l * 64 + lane]);
                const float lam = fexp(s1) - fexp(s2) + lam_init;
                const float* sg = p.in[I_SUBG] + l * 128;
                const float g0 = sg[2 * lane], g1 = sg[2 * lane + 1];
                static_assert(NCH <= 8, "the merge below keeps one (map, chunk) pair per lane: 2 x 8 lanes");
                for (int q = gwave; q < S; q += gwaves) {
                    const int nch = (q >> 6) / DCH + 1;
                    float mv = -INFINITY, lv = 0.f;
                    { const int c = lane & 7, hm = lane >> 3;
                      if (c < nch) { const float* ML = dpml + ((size_t)hm * DPART_ROWS + dpart_row(c, q)) * 2; mv = ML[0]; lv = ML[1]; } }
                    unsigned pk[4][2][NCH];
#pragma unroll
                    for (int h = 0; h < 4; ++h)
#pragma unroll
                        for (int mp = 0; mp < 2; ++mp) {
                            const unsigned* OP = (const unsigned*)(dpo + (size_t)(h * 2 + mp) * DPART_ROWS * 128);
#pragma unroll
                            for (int c = 0; c < NCH; ++c) pk[h][mp][c] = (c < nch) ? OP[(size_t)dpart_row(c, q) * 64 + lane] : 0u;
                        }
                    float Mx = mv; Mx = fmaxf(Mx, DPP_X1(Mx)); Mx = fmaxf(Mx, DPP_X2(Mx)); Mx = fmaxf(Mx, DPP_X7(Mx));
                    const float wv = (mv == -INFINITY) ? 0.f : FAST_EXP2(mv - Mx);
                    float Lp = lv * wv; Lp += DPP_X1(Lp); Lp += DPP_X2(Lp); Lp += DPP_X7(Lp);
#pragma unroll
                    for (int h = 0; h < 4; ++h) {
                        float om[2][2];
#pragma unroll
                        for (int mp = 0; mp < 2; ++mp) {
                            float o0 = 0.f, o1 = 0.f;
#pragma unroll
                            for (int c = 0; c < NCH; ++c) { const float w = RDLANE(wv, (h * 2 + mp) * 8 + c); o0 += bf2f((bf16_t)(pk[h][mp][c] & 0xffffu)) * w; o1 += bf2f((bf16_t)(pk[h][mp][c] >> 16)) * w; }
                            const float il = 1.f / RDLANE(Lp, (h * 2 + mp) * 8);
                            om[mp][0] = o0 * il; om[mp][1] = o1 * il;
                        }
                        const float v0 = om[0][0] - lam * om[1][0], v1 = om[0][1] - lam * om[1][1];
                        const float ss = wave_sum(v0 * v0 + v1 * v1);
                        const float rs = (1.f - lam_init) / sqrtf(ss * (1.f / 128.f) + LN_EPS);
                        *(unsigned*)(concat + (size_t)q * D + 1536 + h * 128 + 2 * lane) = pack2(v0 * rs * g0, v1 * rs * g1);
                    }
                }
            }
            PH_BAR(pb + 2);
        }

        if (PH_SEL(3) && PH_IN(pb + 3)) {
            PHASE_IDS();
            const bf16_t* Bt = WoT + (size_t)l * D * D;
            constexpr int ntn = D / 256, ntm = S / 256;
            static_assert(ntn == 8, "the panel exchange is written for 8 column tiles");
            const unsigned nooff[2][2] = {{0u, 0u}, {0u, 0u}};
            const float* g1 = p.in[I_LN1G] + (size_t)l * D; const float* b1 = p.in[I_LN1B] + (size_t)l * D;
            const float* bg = p.in[I_BGRP] + l * 4; const float* br = p.in[I_BRT] + l * 32;
            const bf16_t* Wb = W36b + (size_t)l * 2 * 48 * D;
            int* lcnt = (int*)(lds_raw + LDS_MISC + M_LCNT);
            const int segcap = ((ntm * ntn + G - 1) / G) * 32;
            unsigned* pcnt = (unsigned*)(wsl + CTL_PAN_OFF) + l * 1024;
            unsigned long long* xbuf = (unsigned long long*)(wsl + A_XBUF);
            unsigned* part = (unsigned*)(wsl + A_PART);
            LAS float* Stab = (LAS float*)(lds_raw + LDS_MISC + M_RTOK);
            float* lgt = (float*)(lds_raw + LDS_MISC + 4096);
            if (tid < 32) lcnt[tid] = 0;
            __syncthreads();
            for (int t0 = bid; t0 < ntm * ntn; t0 += G) {
                int t = t0;
                if (G == 256 && ntm * ntn == 256) { const int x = t0 & 7, j = t0 >> 3; t = (x * 4 + (j >> 3)) * ntn + (j & 7); }
                const int pm = t / ntn, pn = t % ntn;
                f32x4 v[2][16];
                {
                    f32x4 acc[2][2][4][2];
                    gemm_tile<false>(concat, pm * 256, nooff, Bt, pn * 256, D, lds_raw, acc, tid);
                    int et = tid; OPAQUE(et); const int wr = et >> 8, wc = (et >> 6) & 3, fr = et & 15, fq = (et >> 4) & 3;
#pragma unroll
                    for (int ai = 0; ai < 2; ++ai) {
#pragma unroll
                        for (int m = 0; m < 4; ++m)
#pragma unroll
                            for (int bj = 0; bj < 2; ++bj)
#pragma unroll
                                for (int n = 0; n < 2; ++n)
#pragma unroll
                                    for (int j = 0; j < 4; ++j)
                                        *(float*)(lds_raw + (wr * 64 + m * 16 + fq * 4 + j) * 1040 + (bj * 128 + wc * 32 + n * 16 + fr) * 4) = acc[ai][bj][m][n][j];
                        __syncthreads();
#pragma unroll
                        for (int i = 0; i < 16; ++i) {
                            const int lrow = i * 8 + (et >> 6), c4 = et & 63;
                            const size_t gi = (size_t)(pm * 256 + ai * 128 + lrow) * D + pn * 256 + c4 * 4;
                            v[ai][i] = *(const GAS f32x4*)(hin + gi);
                        }
#pragma unroll
                        for (int i = 0; i < 16; ++i) {
                            const int lrow = i * 8 + (et >> 6), c4 = et & 63;
                            v[ai][i] = ALPHA * v[ai][i] + *(const f32x4*)(lds_raw + lrow * 1040 + c4 * 16);
                        }
                        __syncthreads();
                    }
                }
                int et2 = tid; OPAQUE(et2); const int el = et2 & 63, ew = wave_s, er16 = et2 & 15, eq4 = (et2 >> 4) & 3;
#pragma unroll
                for (int q = 0; q < 6; ++q) {
                    const int seg = ew * 6 + q, n2 = seg * 2 + (el >> 5), p5 = el & 31;
                    GLDS16(Wb + (size_t)n2 * D + pn * 256 + ((p5 ^ (n2 & 15)) << 3), lds_raw + 65536 + seg * 1024 + el * 16);
                }
                float my_mt = 0.f, my_m2 = 0.f;
                for (int trep = 0; trep < REP_STATS; ++trep)
#pragma unroll
                for (int ai = 0; ai < 2; ++ai)
#pragma unroll
                    for (int i4 = 0; i4 < 16; i4 += 4) {
                        float mt4[4], m24[4];
#pragma unroll
                        for (int u = 0; u < 4; ++u) { const f32x4 x = v[ai][i4 + u]; mt4[u] = wave_sum((x[0] + x[1]) + (x[2] + x[3])) * (1.f / 256.f); }
#pragma unroll
                        for (int u = 0; u < 4; ++u) { const f32x4 d = v[ai][i4 + u] - mt4[u]; m24[u] = wave_sum((d[0] * d[0] + d[1] * d[1]) + (d[2] * d[2] + d[3] * d[3])); }
#pragma unroll
                        for (int u = 0; u < 4; ++u) if (el == ai * 16 + i4 + u) { my_mt = mt4[u]; my_m2 = m24[u]; }
                        COMPILER_FENCE();
                    }
                unsigned* bw = (unsigned*)wsl;
                if (el < 32) {
                    const int grow = (el >> 4) * 128 + (el & 15) * 8 + ew;
                    xst64(&xbuf[(size_t)(pm * 256 + grow) * 8 + pn], ((unsigned long long)__builtin_bit_cast(unsigned, my_m2) << 32) | __builtin_bit_cast(unsigned, my_mt));
                }
                WAIT_VM0();
                __syncthreads();
                if (et2 == 0) { (void)xb_add(&pcnt[pm * 16], 1u); XB_SPIN(xb_ld(&pcnt[pm * 16]) < 8u, bw); FENCE_ACQ_AGENT(); }
                __syncthreads();
                unsigned long long wk[4];
#pragma unroll
                for (int k = 0; k < 4; ++k) {
                    const int r = k * 8 + (el >> 3), grow = (r >> 4) * 128 + (r & 15) * 8 + ew;
                    wk[k] = xld64(&xbuf[(size_t)(pm * 256 + grow) * 8 + (el & 7)]);
                }
#pragma unroll
                for (int k = 0; k < 4; ++k) {
                    const int r = k * 8 + (el >> 3);
                    const unsigned long long w = wk[k];
                    const float mt = __builtin_bit_cast(float, (unsigned)w), m2 = __builtin_bit_cast(float, (unsigned)(w >> 32));
                    float ms = mt; ms += DPP_X1(ms); ms += DPP_X2(ms); ms += DPP_X7(ms);
                    const float mean = ms * 0.125f, dm = mt - mean;
                    float q = m2 + 256.f * dm * dm; q += DPP_X1(q); q += DPP_X2(q); q += DPP_X7(q);
                    const float rstd = 1.f / sqrtf(q * (1.f / D) + LN_EPS);
                    if ((el & 7) == 0) { Stab[(ew * 32 + r) * 2] = mean; Stab[(ew * 32 + r) * 2 + 1] = rstd; }
                }
                WAVE_SYNC();
                const f32x4 gv = *(const f32x4*)(g1 + pn * 256 + el * 4), bv = *(const f32x4*)(b1 + pn * 256 + el * 4);
                LAS unsigned char* wt = (LAS unsigned char*)lds_raw + ew * 8192;
                const LAS unsigned char* wbl = (const LAS unsigned char*)lds_raw + 65536;
                for (int rrep = 0; rrep < REP_ROUTER; ++rrep)
#pragma unroll
                for (int ai = 0; ai < 2; ++ai) {
                    u32x2 lokeep[16];
#pragma unroll
                    for (int i = 0; i < 16; ++i) {
                        const float mean = Stab[(ew * 32 + ai * 16 + i) * 2], rstd = Stab[(ew * 32 + ai * 16 + i) * 2 + 1];
                        const f32x4 hv = mul_s4(v[ai][i] - mean, rstd) * gv + bv;
                        u32x2 o; o.x = pack2(hv[0], hv[1]); o.y = pack2(hv[2], hv[3]);
                        lokeep[i].x = pack2(hv[0] - bf2f((bf16_t)(o.x & 0xffffu)), hv[1] - bf2f((bf16_t)(o.x >> 16)));
                        lokeep[i].y = pack2(hv[2] - bf2f((bf16_t)(o.y & 0xffffu)), hv[3] - bf2f((bf16_t)(o.y >> 16)));
                        *(LAS u32x2*)(wt + i * 512 + (((el >> 1) ^ i) << 4) + (el & 1) * 8) = o;
                        COMPILER_FENCE();
                    }
                    WAVE_SYNC();
                    f32x4 ac[3];
#pragma unroll
                    for (int nt = 0; nt < 3; ++nt) ac[nt] = (f32x4){0.f, 0.f, 0.f, 0.f};
#pragma unroll 2
                    for (int ks = 0; ks < 8; ++ks) {
                        const int co = ((ks * 4 + eq4) ^ er16) << 4;
                        const bf16x8 ah = *(const LAS bf16x8*)(wt + er16 * 512 + co);
#pragma unroll
                        for (int nt = 0; nt < 3; ++nt) {
                            const bf16x8 bh = *(const LAS bf16x8*)(wbl + (nt * 16 + er16) * 512 + co);
                            const bf16x8 bl = *(const LAS bf16x8*)(wbl + (48 + nt * 16 + er16) * 512 + co);
                            ac[nt] = MFMA16(ah, bh, ac[nt]); ac[nt] = MFMA16(ah, bl, ac[nt]);
                        }
                    }
                    WAVE_SYNC();
#pragma unroll
                    for (int i = 0; i < 16; ++i) *(LAS u32x2*)(wt + i * 512 + (((el >> 1) ^ i) << 4) + (el & 1) * 8) = lokeep[i];
                    WAVE_SYNC();
#pragma unroll 2
                    for (int ks = 0; ks < 8; ++ks) {
                        const int co = ((ks * 4 + eq4) ^ er16) << 4;
                        const bf16x8 al = *(const LAS bf16x8*)(wt + er16 * 512 + co);
#pragma unroll
                        for (int nt = 0; nt < 3; ++nt) {
                            const bf16x8 bh = *(const LAS bf16x8*)(wbl + (nt * 16 + er16) * 512 + co);
                            ac[nt] = MFMA16(al, bh, ac[nt]);
                        }
                    }
#pragma unroll
                    for (int nt = 0; nt < 3; ++nt)
#pragma unroll
                        for (int j = 0; j < 4; ++j) {
                            const float cv = ac[nt][j];
                            xst32(&part[((size_t)pn * S + pm * 256 + ai * 128 + (eq4 * 4 + j) * 8 + ew) * 48 + nt * 16 + er16], __builtin_bit_cast(unsigned, cv));
                        }
                    WAVE_SYNC();
                }
                WAIT_VM0();
                __syncthreads();
                if (et2 == 0) (void)xb_add(&pcnt[512 + pm * 16], 1u);
                for (int srep = 0; srep < REP_STORES; ++srep)
#pragma unroll
                for (int ai = 0; ai < 2; ++ai)
#pragma unroll
                    for (int i = 0; i < 16; ++i) {
                        const float mean = Stab[(ew * 32 + ai * 16 + i) * 2], rstd = Stab[(ew * 32 + ai * 16 + i) * 2 + 1];
                        const f32x4 hv = mul_s4(v[ai][i] - mean, rstd) * gv + bv;
                        const size_t gi = (size_t)(pm * 256 + ai * 128 + i * 8 + ew) * D + pn * 256 + el * 4;
                        u32x2 o; o.x = pack2(hv[0], hv[1]); o.y = pack2(hv[2], hv[3]);
                        *(u32x2*)(h1b + gi) = o;
                        COMPILER_FENCE();
                    }
                if (et2 == 0) { XB_SPIN(xb_ld(&pcnt[512 + pm * 16]) < 8u, bw); FENCE_ACQ_AGENT(); }
                __syncthreads();
                int rt = tid; OPAQUE(rt);
#pragma unroll
                for (int k = 0; k < 3; ++k) {
                    const int idx = rt + k * 512, tk = idx / 48, n = idx - tk * 48;
                    unsigned pq[8];
#pragma unroll
                    for (int q = 0; q < 8; ++q) pq[q] = xb_ld(&part[((size_t)q * S + pm * 256 + pn * 32 + tk) * 48 + n]);
                    float a = 0.f;
#pragma unroll
                    for (int q = 0; q < 8; ++q) a += __builtin_bit_cast(float, pq[q]);
                    lgt[idx] = a;
                }
                __syncthreads();
                if (rt < 32) {
                    const int t = pm * 256 + pn * 32 + rt; const float* L = lgt + rt * 48;
                    float gl[4];
#pragma unroll
                    for (int q = 0; q < 4; ++q) gl[q] = L[q] + bg[q];
                    int gi = 0; float gm = gl[0];
#pragma unroll
                    for (int q = 1; q < 4; ++q) if (gl[q] > gm) { gm = gl[q]; gi = q; }
                    float gs = 0.f;
#pragma unroll
                    for (int q = 0; q < 4; ++q) gs += fexp(gl[q] - gm);
                    const float gweight = 1.f / gs;
                    float E[8];
#pragma unroll
                    for (int e = 0; e < 8; ++e) E[e] = L[4 + gi * 8 + e] + br[gi * 8 + e];
                    int e1 = 0; float m1 = E[0];
#pragma unroll
                    for (int e = 1; e < 8; ++e) if (E[e] > m1) { m1 = E[e]; e1 = e; }
                    int e2 = -1; float m2 = -INFINITY;
#pragma unroll
                    for (int e = 0; e < 8; ++e) if (e != e1 && E[e] > m2) { m2 = E[e]; e2 = e; }
                    const float p2 = fexp(m2 - m1), w1 = 1.f / (1.f + p2), w2 = p2 / (1.f + p2);
                    const int ge1 = gi * 8 + e1, ge2 = gi * 8 + e2;
                    const int i1 = (ge1 * G + bid) * segcap + atomic_add_int(&lcnt[ge1], 1);
                    ltok[i1] = t; lw[i1] = gweight * w1; lslot[i1] = 0;
                    const int i2 = (ge2 * G + bid) * segcap + atomic_add_int(&lcnt[ge2], 1);
                    ltok[i2] = t; lw[i2] = gweight * w2; lslot[i2] = 1;
                }
                __syncthreads();
            }
            { int ft = tid; OPAQUE(ft); if (ft < 32) cntb[bid * 32 + ft] = lcnt[ft]; }
            PH_BAR(pb + 3);
        }

        if (PH_SEL(5) && PH_IN(pb + 5)) {
            PHASE_IDS();
            const unsigned nooff[2][2] = {{0u, 0u}, {0u, 0u}};
            const int segcap = ((S / 256 * (D / 256) + G - 1) / G) * 32;
            moe_prefix(cntb, G, lds_raw, tid);
            const int* ctot = (const int*)(lds_raw + LDS_MISC + M_CTOT); const int* coff = (const int*)(lds_raw + LDS_MISC + M_COFF);
            const int* rtok = (const int*)(lds_raw + LDS_MISC + M_RTOK); const float* rw = (const float*)(lds_raw + LDS_MISC + M_RW);
            const int* rslot = (const int*)(lds_raw + LDS_MISC + M_RSLOT);
            unsigned* done = (unsigned*)(wsl + CTL_DONE_OFF) + l * 1024;
            int* mq = (int*)(wsl + CTL_MQ_OFF) + l * 128;
            const int myx = (int)(xb_xcc_id() & 7u);
            int qi = 0;
            for (;;) {
                __syncthreads();
                if (tid == 0) {
                    unsigned r = 0xffffffffu;
                    while (qi < 8) {
                        const int xx = (myx + qi) & 7;
                        int nm = 0;
#pragma unroll
                        for (int k = 0; k < NEXP / 8; ++k) nm += (ctot[xx + 8 * k] + 255) / 256;
                        const int got = atomic_add_int(mq + xx * 16, 1);
                        if (got < nm * 12) { r = ((unsigned)xx << 24) | (unsigned)got; break; }
                        ++qi;
                    }
                    *ubox = r;
                }
                __syncthreads();
                const unsigned rr = (unsigned)RFL((int)*ubox);
                if (rr == 0xffffffffu) break;
                const int xq = (int)(rr >> 24);
                int u = (int)(rr & 0xffffffu);
                int nmt = 0;
#pragma unroll
                for (int k = 0; k < NEXP / 8; ++k) nmt += (RFL(ctot[xq + 8 * k]) + 255) / 256;
                const bool down = (u >= nmt * 4);
                const int per = down ? 8 : 4;
                if (down) u -= nmt * 4;
                int e = xq;
                for (;; e += 8) { const int nt = ((RFL(ctot[e]) + 255) / 256) * per; if (u < nt) break; u -= nt; }
                const int c = RFL(ctot[e]), off = RFL(coff[e]);
                const int mt = u / per, pn = u % per, m0 = mt * 256;
                moe_rowtable(ltok, lw, lslot, e, m0, c, G, segcap, lds_raw, tid);
                f32x4 acc[2][2][4][2];
                if (!down) {
                    const bf16_t* Bt = WguT + ((size_t)l * NEXP + e) * 1024 * D;
                    unsigned aoff[2][2];
                    int st = tid; OPAQUE(st); int R[2], C[2]; stage_geom(st, R, C);
#pragma unroll
                    for (int h = 0; h < 2; ++h)
#pragma unroll
                        for (int i = 0; i < 2; ++i) aoff[h][i] = (unsigned)(rtok[h * 128 + R[i]] * D + C[i]);
                    gemm_tile<true>(h1b, 0, aoff, Bt, pn * 256, D, lds_raw, acc, tid);
                    int et = tid; OPAQUE(et); const int wr = et >> 8, wc = (et >> 6) & 3, fr = et & 15, fq = (et >> 4) & 3;
#pragma unroll
                    for (int ai = 0; ai < 2; ++ai)
#pragma unroll
                        for (int m = 0; m < 4; ++m)
#pragma unroll
                            for (int j = 0; j < 4; ++j) {
                                const int r = ai * 128 + wr * 64 + m * 16 + fq * 4 + j;
                                const float wgt = rw[r];
#pragma unroll
                                for (int bj = 0; bj < 2; ++bj)
                                    *(bf16_t*)(lds_raw + r * 272 + (bj * 64 + wc * 16 + fr) * 2) = f2bf(silu_f(acc[ai][bj][m][0][j]) * acc[ai][bj][m][1][j] * wgt);
                            }
                    __syncthreads();
#pragma unroll 4
                    for (int i = 0; i < 8; ++i) {
                        const int idx = et + i * 512, r = idx >> 4, ch = idx & 15;
                        if (m0 + r < c) *(u32x4*)(act + (size_t)(off + m0 + r) * DFF + pn * 128 + ch * 8) = *(const u32x4*)(lds_raw + r * 272 + ch * 16);
                    }
                    WAIT_VM0();
                    __syncthreads();
                    if (et == 0) { FENCE_REL_AGENT(); WAIT_VM0(); (void)xb_add(&done[e * 32 + mt], 1u); }
                } else {
                    const bf16_t* Bt = WdT + ((size_t)l * NEXP + e) * D * DFF;
                    if (tid == 0) {
                        unsigned* bw = (unsigned*)wsl;
                        XB_SPIN(xb_ld(&done[e * 32 + mt]) < 4u, bw);
                        FENCE_ACQ_AGENT();
                        WAIT_VM0();
                    }
                    __syncthreads();
                    gemm_tile<false>(act, off + m0, nooff, Bt, pn * 256, DFF, lds_raw, acc, tid);
                    int et = tid; OPAQUE(et); const int wr = et >> 8, wc = (et >> 6) & 3, fr = et & 15, fq = (et >> 4) & 3;
#pragma unroll
                    for (int ai = 0; ai < 2; ++ai)
#pragma unroll
                        for (int m = 0; m < 4; ++m)
#pragma unroll
                            for (int bj = 0; bj < 2; ++bj)
#pragma unroll
                                for (int n = 0; n < 2; ++n)
#pragma unroll
                                    for (int j = 0; j < 4; ++j)
                                        *(bf16_t*)(lds_raw + (ai * 128 + wr * 64 + m * 16 + fq * 4 + j) * 528 + (bj * 128 + wc * 32 + n * 16 + fr) * 2) = f2bf(acc[ai][bj][m][n][j]);
                    __syncthreads();
#pragma unroll 4
                    for (int i = 0; i < 16; ++i) {
                        const int idx = et + i * 512, r = idx >> 5, ch = idx & 31;
                        if (m0 + r < c) *(u32x4*)(contrib + ((size_t)rslot[r] * S + rtok[r]) * D + pn * 256 + ch * 8) = *(const u32x4*)(lds_raw + r * 528 + ch * 16);
                    }
                }
            }
            PH_BAR(pb + 5);
        }

        if (PH_SEL(7) && PH_IN(pb + 7)) for (int rep = 0; rep < PH_REPS(7); ++rep) {
            PHASE_IDS();
            const float* g2 = p.in[I_LN2G] + (size_t)l * D; const float* b2 = p.in[I_LN2B] + (size_t)l * D;
            const bool more = (l + 1 < DEPTH);
            f32x4 gq[8], bq[8];
#pragma unroll
            for (int j = 0; j < 8; ++j) { gq[j] = *(const f32x4*)(g2 + j * 256 + lane * 4); bq[j] = *(const f32x4*)(b2 + j * 256 + lane * 4); }
            if (more) {
                const float* wf = Wfa + (size_t)(l + 1) * 8 * D;
                __syncthreads();
                for (int i = tid; i < 6 * D / 4; i += NTHREADS) *(f32x4*)(ldsf + i * 4) = *(const f32x4*)(wf + i * 4);
                __syncthreads();
            }
            for (int t = gwave; t < S; t += gwaves) {
                f32x4 v[8]; float s = 0.f;
#pragma unroll
                for (int j = 0; j < 8; ++j) {
                    const size_t i = (size_t)t * D + j * 256 + lane * 4;
                    const u32x2 c0 = *(const u32x2*)(contrib + i), c1 = *(const u32x2*)(contrib + (size_t)S * D + i);
                    const f32x4 cs = (f32x4){bf2f((bf16_t)(c0.x & 0xffffu)) + bf2f((bf16_t)(c1.x & 0xffffu)), bf2f((bf16_t)(c0.x >> 16)) + bf2f((bf16_t)(c1.x >> 16)),
                                             bf2f((bf16_t)(c0.y & 0xffffu)) + bf2f((bf16_t)(c1.y & 0xffffu)), bf2f((bf16_t)(c0.y >> 16)) + bf2f((bf16_t)(c1.y >> 16))};
                    const u32x2 hq = *(const u32x2*)(h1b + i);
                    v[j] = ALPHA * (f32x4){bf2f((bf16_t)(hq.x & 0xffffu)), bf2f((bf16_t)(hq.x >> 16)), bf2f((bf16_t)(hq.y & 0xffffu)), bf2f((bf16_t)(hq.y >> 16))} + cs;
                    s += (v[j][0] + v[j][1]) + (v[j][2] + v[j][3]);
                }
                const float mean = wave_sum(s) * (1.f / D);
                float s2 = 0.f;
#pragma unroll
                for (int j = 0; j < 8; ++j) { v[j] -= mean; s2 += (v[j][0] * v[j][0] + v[j][1] * v[j][1]) + (v[j][2] * v[j][2] + v[j][3] * v[j][3]); }
                const float rstd = 1.f / sqrtf(wave_sum(s2) * (1.f / D) + LN_EPS);
                float fa[6] = {0.f, 0.f, 0.f, 0.f, 0.f, 0.f};
#pragma unroll
                for (int j = 0; j < 8; ++j) {
                    const int c = j * 256 + lane * 4;
                    v[j] = v[j] * rstd * gq[j] + bq[j];
                    *(f32x4*)(hout + (size_t)t * D + c) = v[j];
                    COMPILER_FENCE();
                    if (more) {
                        u32x2 o; o.x = pack2(v[j][0], v[j][1]); o.y = pack2(v[j][2], v[j][3]);
                        *(u32x2*)(xb + (size_t)t * D + c) = o;
#pragma unroll
                        for (int h = 0; h < 6; ++h) { const f32x4 w = *(const f32x4*)(ldsf + h * D + c); fa[h] += (v[j][0] * w[0] + v[j][1] * w[1]) + (v[j][2] * w[2] + v[j][3] * w[3]); }
                    }
                }
                if (more) {
#pragma unroll
                    for (int h = 0; h < 6; ++h) { const float sm = wave_sum(fa[h]); if (lane == 0) logf_[h * S + t] = log_sigmoid_f(sm + p.in[I_BF][(l + 1) * 6 + h]); }
                }
            }
            PH_BAR(pb + 7);
        }
    }
#undef PH_IN
#undef PH_BAR
}

constexpr int N_PHASES = 1 + DEPTH * 8;
#ifndef EMU
extern "C" void kernel_launch(void* const* d_in, const int* in_sizes, int n_in, void* d_out, int out_size, void* d_ws, size_t ws_size, hipStream_t stream) {
    static int grid = 0;
    if (grid == 0) {
        if (n_in != N_INPUTS || out_size != S * D || ws_size < WS_END) {
            fprintf(stderr, "kernel_launch: unexpected shapes: n_in %d out %d ws %zu (need %zu)\n", n_in, out_size, ws_size, (size_t)WS_END); grid = -1; return; }
        int dev = 0, cus = 0, per_cu = 0;
        if (hipGetDevice(&dev) != hipSuccess || hipDeviceGetAttribute(&cus, hipDeviceAttributeMultiprocessorCount, dev) != hipSuccess) { grid = -1; return; }
        if (hipFuncSetAttribute((const void*)fwd_kernel, hipFuncAttributeMaxDynamicSharedMemorySize, LDS_BYTES) != hipSuccess) { fprintf(stderr, "kernel_launch: hipFuncSetAttribute failed\n"); grid = -1; return; }
        if (hipOccupancyMaxActiveBlocksPerMultiprocessor(&per_cu, (const void*)fwd_kernel, NTHREADS, LDS_BYTES) != hipSuccess || per_cu < 1) {
            fprintf(stderr, "kernel_launch: occupancy query says %d blocks per CU\n", per_cu); (void)hipGetLastError(); grid = -1; return; }
        grid = cus;
    }
    if (grid < 0) return;
    (void)hipMemsetAsync(d_ws, 0, CTL_BYTES, stream);
    Params p{};
    for (int i = 0; i < N_INPUTS; ++i) p.in[i] = (const float*)d_in[i];
    p.out = (float*)d_out; p.ws = (unsigned char*)d_ws;
    for (int i = 0; i < 8; ++i) p.inv_freq[i] = (float)pow(500000.0, -(double)i * 2.0 / 16.0);
#if N_LAUNCH_SPLIT
    for (int k = 0; k < N_PHASES; ++k) { p.lo = k; p.hi = k + 1; hipLaunchKernelGGL(fwd_kernel, dim3(grid), dim3(NTHREADS), LDS_BYTES, stream, p); }
#else
    p.lo = 0; p.hi = N_PHASES;
    hipLaunchKernelGGL(fwd_kernel, dim3(grid), dim3(NTHREADS), LDS_BYTES, stream, p);
#endif
}
#endif
```

```cpp
#ifndef EMU
#include <hip/hip_runtime.h>
#include <cstdio>
#include <cstdint>
#include <cmath>
#endif

#ifndef SEQ
#define SEQ 8192
#endif
#ifndef N_LAUNCH_SPLIT
#define N_LAUNCH_SPLIT 0
#endif
#ifndef REP_PHASE
#define REP_PHASE -2
#endif
#define PH_REPS(c) ((c) == REP_PHASE ? 2 : 1)
#ifndef REP_SUB
#define REP_SUB 0
#endif

constexpr int S = SEQ, D = 2048, DEPTH = 2;
constexpr int FOX_H = 6, FOX_W = 768;
constexpr int LRU_W = 768;
constexpr int DIFF_H = 4, DIFF_W = 512;
constexpr int N_IN = 5382, N_INP = 5376;
constexpr int C_FA = 2304;
constexpr int NEXP = 32, DFF = 512;
constexpr int NKT = S / 64;
#ifndef REP_ROUTER
#define REP_ROUTER 1
#endif
#ifndef REP_STORES
#define REP_STORES 1
#endif
#ifndef REP_STATS
#define REP_STATS 1
#endif
#ifndef DCH
#define DCH 48
#endif
constexpr int NCH = (NKT + DCH - 1) / DCH;
constexpr size_t DPART_ROWS = (size_t)NCH * S - (size_t)(DCH * 64) * NCH * (NCH - 1) / 2;
constexpr float ALPHA = 1.41421356237309504880f;
constexpr float LN_EPS = 1e-5f;
constexpr float LOG2E = 1.4426950408889634f;
constexpr float QSCALE_A = 0.08838834764831845f * 1.4426950408889634f;
constexpr float QSCALE_C = 0.125f * 1.4426950408889634f;

enum { I_X = 0, I_POS, I_WIN, I_BF, I_CONVW, I_CONVB, I_WA, I_BA, I_WI, I_BI, I_LAM, I_LQ1, I_LK1, I_LQ2, I_LK2, I_SUBG, I_WO, I_LN1G, I_LN1B,
       I_WGRP, I_BGRP, I_WRT, I_BRT, I_WGATE, I_WUP, I_WDOWN, I_LN2G, I_LN2B, N_INPUTS };

typedef unsigned short bf16_t;
typedef short bf16x8 __attribute__((ext_vector_type(8)));
typedef float f32x4 __attribute__((ext_vector_type(4)));
typedef unsigned u32x4 __attribute__((ext_vector_type(4)));
typedef unsigned u32x2 __attribute__((ext_vector_type(2)));
#ifdef EMU
static inline void st_wt16(void* p, u32x4 v) { *(u32x4*)p = v; }
#endif

constexpr size_t al256(size_t x) { return (x + 255) & ~(size_t)255; }
constexpr size_t CTL_BYTES = 65536;
constexpr size_t CTL_CNT_OFF = 32768;
constexpr size_t CTL_WORK_OFF = 36864;
constexpr size_t CTL_QK2_OFF = 57344;
constexpr size_t CTL_CLS_OFF = 49152;
constexpr size_t CTL_PAN_OFF = 16384;
constexpr size_t CTL_MQ_OFF = 24576;
constexpr size_t CTL_DONE_OFF = 40960;
constexpr size_t WB_WIN = CTL_BYTES;
constexpr size_t WB_WO = WB_WIN + al256((size_t)DEPTH * N_INP * D * 2);
constexpr size_t WB_WGU = WB_WO + al256((size_t)DEPTH * D * D * 2);
constexpr size_t WB_WD = WB_WGU + al256((size_t)DEPTH * NEXP * 1024 * D * 2);
constexpr size_t WB_WAI = WB_WD + al256((size_t)DEPTH * NEXP * D * DFF * 2);
constexpr size_t WF_FA = WB_WAI + al256((size_t)DEPTH * 6 * 256 * 128 * 2);
constexpr size_t WF_R36 = WF_FA + al256((size_t)DEPTH * 8 * D * 4);
constexpr size_t WF_ROPE = WF_R36 + al256((size_t)DEPTH * 2 * 48 * D * 2);
constexpr size_t A_XB = WF_ROPE + al256((size_t)S * 16 * 4);
constexpr size_t A_HB = A_XB + al256((size_t)S * D * 2);
constexpr size_t A_LOGF = A_HB + al256((size_t)S * D * 4);
constexpr size_t A_CUM = A_LOGF + al256((size_t)6 * S * 4);
constexpr size_t A_KMAX = A_CUM + al256((size_t)6 * S * 4);
constexpr size_t A_CNTB = A_KMAX + al256((size_t)6 * NKT * 4);
constexpr size_t A_QA = A_CNTB + al256((size_t)1024 * 32 * 4);
constexpr size_t A_KA = A_QA + al256((size_t)FOX_H * S * 128 * 2);
constexpr size_t A_VAT = A_KA + al256((size_t)FOX_H * S * 128 * 2);
constexpr size_t A_XR = A_VAT + al256((size_t)FOX_H * S * 128 * 2);
constexpr size_t A_GR = A_XR + al256((size_t)S * LRU_W * 2);
constexpr size_t A_QC = A_GR + al256((size_t)S * LRU_W * 2);
constexpr size_t A_KC = A_QC + al256((size_t)DIFF_H * S * 128 * 2);
constexpr size_t A_VCT = A_KC + al256((size_t)DIFF_H * S * 128 * 2);
constexpr size_t A_HLOC = A_VCT + al256((size_t)DIFF_H * S * 128 * 2);
constexpr size_t A_PLOC = A_HLOC + al256((size_t)S * LRU_W * 4);
constexpr size_t A_SUMA = A_PLOC + al256((size_t)S * LRU_W * 4);
constexpr size_t A_SUMH = A_SUMA + al256((size_t)NKT * LRU_W * 4);
constexpr size_t A_CONCAT = A_SUMH + al256((size_t)NKT * LRU_W * 4);
constexpr size_t A_Y1 = A_CONCAT + al256((size_t)S * D * 2);
constexpr size_t A_H1 = A_Y1 + al256((size_t)S * D * 4);
constexpr size_t A_H1B = A_H1 + al256((size_t)S * D * 4);
constexpr size_t A_LTOK = A_H1B + al256((size_t)S * D * 2);
constexpr size_t A_LW = A_LTOK + al256((size_t)NEXP * S * 4 * 2);
constexpr size_t A_LSLOT = A_LW + al256((size_t)NEXP * S * 4 * 2);
constexpr size_t A_ACT = A_LSLOT + al256((size_t)NEXP * S * 4 * 2);
constexpr size_t A_CONTRIB = A_ACT + al256((size_t)(2 * S + 256) * DFF * 2);
constexpr size_t WS_END = A_CONTRIB + al256((size_t)2 * S * D * 4);
constexpr size_t A_DPO = A_Y1;
constexpr size_t A_DPML = A_DPO + al256((size_t)8 * DPART_ROWS * 128 * 2);
static_assert(A_DPML + (size_t)8 * DPART_ROWS * 2 * 4 <= A_H1B, "differential partials must fit inside the y1 + h1 region");

constexpr size_t A_XBUF = A_H1 + al256((size_t)S * D * 2);
constexpr size_t A_PART = A_XBUF + al256((size_t)S * 8 * 8);
static_assert(A_PART + (size_t)8 * S * 48 * 4 <= A_H1B, "exchange buffers must fit inside the h1 region");
constexpr int NTHREADS = 512;
constexpr int LDS_MAIN = 131072 + 4096;
constexpr int LDS_MISC = LDS_MAIN;
constexpr int LDS_BYTES = LDS_MAIN + 8192 + 16640;
constexpr int M_PRE16 = 8192;
constexpr int M_LCNT = 64, M_CTOT = 256, M_COFF = 384, M_PRE = 512, M_RTOK = 2048, M_RW = 3072, M_RSLOT = 4096;

struct Params {
    const float* in[N_INPUTS];
    float* out;
    unsigned char* ws;
    float inv_freq[8];
    int lo, hi;
};

#ifndef EMU
#define LAS __attribute__((address_space(3)))
#define GAS __attribute__((address_space(1)))
#define DYN_LDS(name) extern __shared__ __attribute__((aligned(16))) unsigned char name[]
#define SLEEP1() __builtin_amdgcn_s_sleep(1)
#define WAVE_SYNC() __builtin_amdgcn_wave_barrier()
#define OPAQUE(x) asm volatile("" : "+v"(x))
#define COMPILER_FENCE() asm volatile("" ::: "memory")
#define RFL(x) __builtin_amdgcn_readfirstlane(x)
#define RFL_F(x) __builtin_bit_cast(float, __builtin_amdgcn_readfirstlane(__builtin_bit_cast(int, x)))
#define ANY_LANE(p) (__builtin_amdgcn_ballot_w64(p) != 0ull)
#define RDLANE(v, l) __builtin_bit_cast(float, __builtin_amdgcn_readlane(__builtin_bit_cast(int, v), l))
__device__ __forceinline__ int lane_id_volatile() { int l; asm volatile("v_mbcnt_lo_u32_b32 %0, -1, 0\n\tv_mbcnt_hi_u32_b32 %0, -1, %0" : "=v"(l)); return l; }
#define LANE_ID() lane_id_volatile()
#define OPAQUE_S(x) asm volatile("" : "+s"(x))
#define WAIT_VM0() asm volatile("s_waitcnt vmcnt(0)" ::: "memory")
#define WAIT_ALL0() __builtin_amdgcn_s_waitcnt(0)
#define FENCE_REL_AGENT() __builtin_amdgcn_fence(__ATOMIC_RELEASE, "agent")
#define FENCE_ACQ_AGENT() __builtin_amdgcn_fence(__ATOMIC_ACQUIRE, "agent")
#define MFMA16(a, b, c) __builtin_amdgcn_mfma_f32_16x16x32_bf16(a, b, c, 0, 0, 0)
#define GLDS16(g, l) __builtin_amdgcn_global_load_lds((const unsigned*)(g), (unsigned*)(l), 16, 0, 0)
#define GLDS16X(g, l, aux) __builtin_amdgcn_global_load_lds((const unsigned*)(g), (unsigned*)(l), 16, 0, aux)
#define WAIT_V(n) asm volatile("s_waitcnt vmcnt(" #n ")" ::: "memory")
#define WAIT_L(n) asm volatile("s_waitcnt lgkmcnt(" #n ")" ::: "memory")
#define BAR() __builtin_amdgcn_s_barrier()
#define SCHED() __builtin_amdgcn_sched_barrier(0)
#define SETPRIO(n) __builtin_amdgcn_s_setprio(n)
#define FAST_EXP2(x) __builtin_amdgcn_exp2f(x)
template <int M> __device__ __forceinline__ float shx_impl(float v, int lane) {
    if (M < 32) return __builtin_bit_cast(float, __builtin_amdgcn_ds_swizzle(__builtin_bit_cast(int, v), (M << 10) | 0x1f));
    return __builtin_bit_cast(float, __builtin_amdgcn_ds_bpermute((lane ^ 32) << 2, __builtin_bit_cast(int, v)));
}
#define SHX(v, M) shx_impl<M>(v, lane)
template <int CTRL> __device__ __forceinline__ float dppx(float x) { return __builtin_bit_cast(float, __builtin_amdgcn_mov_dpp(__builtin_bit_cast(int, x), CTRL, 0xf, 0xf, true)); }
#define DPP_X1(x) dppx<0xB1>(x)
#define DPP_X2(x) dppx<0x4E>(x)
#define DPP_X7(x) dppx<0x141>(x)
#define DPP_X8(x) dppx<0x128>(x)
#define xrow16_max(x) xrow16_max_l(x, lane)
#define xrow16_sum(x) xrow16_sum_l(x, lane)
__device__ __forceinline__ float xrow16_max_l(float x, int lane) { x = fmaxf(x, shx_impl<16>(x, lane)); return fmaxf(x, shx_impl<32>(x, lane)); }
__device__ __forceinline__ float xrow16_sum_l(float x, int lane) { x = x + shx_impl<16>(x, lane); return x + shx_impl<32>(x, lane); }
#define FAST_LOG2(x) __builtin_amdgcn_logf(x)
#define FAST_RCP(x) __builtin_amdgcn_rcpf(x)
__device__ __forceinline__ unsigned xb_ld(unsigned* p)              { return __hip_atomic_load(p, __ATOMIC_RELAXED, __HIP_MEMORY_SCOPE_AGENT); }
__device__ __forceinline__ unsigned xb_add(unsigned* p, unsigned v) { return __hip_atomic_fetch_add(p, v, __ATOMIC_RELAXED, __HIP_MEMORY_SCOPE_AGENT); }
__device__ __forceinline__ void st_wt16(void* p, u32x4 v) { asm volatile("global_store_dwordx4 %0, %1, off sc1" :: "v"(p), "v"(v) : "memory"); }
__device__ __forceinline__ void xst64(unsigned long long* p, unsigned long long v) { __hip_atomic_store(p, v, __ATOMIC_RELAXED, __HIP_MEMORY_SCOPE_AGENT); }
__device__ __forceinline__ unsigned long long xld64(unsigned long long* p) { return __hip_atomic_load(p, __ATOMIC_RELAXED, __HIP_MEMORY_SCOPE_AGENT); }
__device__ __forceinline__ void xst32(unsigned* p, unsigned v) { __hip_atomic_store(p, v, __ATOMIC_RELAXED, __HIP_MEMORY_SCOPE_AGENT); }
__device__ __forceinline__ unsigned xb_xcc_id() { return (unsigned)__builtin_amdgcn_s_getreg((3 << 11) | 20) & 0xFu; }
__device__ __forceinline__ int atomic_add_int(int* p, int v) { return atomicAdd(p, v); }
__device__ __forceinline__ void atomic_min_int(int* p, int v) { atomicMin(p, v); }
__device__ __forceinline__ void atomic_max_u32(unsigned* p, unsigned v) { atomicMax(p, v); }
__device__ __forceinline__ unsigned pack2(float lo, float hi) { unsigned r; asm volatile("v_cvt_pk_bf16_f32 %0, %1, %2" : "=v"(r) : "v"(lo), "v"(hi)); return r; }
#else
#define MFMA16(a, b, c) emu_mfma_16x16x32_bf16(a, b, c)
#define GLDS16(g, l) emu_glds16((const void*)(g), (void*)(l))
#define GLDS16X(g, l, aux) emu_glds16((const void*)(g), (void*)(l))
#define WAIT_V(n) ((void)0)
#define WAIT_L(n) ((void)0)
#define BAR() __syncthreads()
#define SCHED() ((void)0)
#define SETPRIO(n) ((void)0)
#define FAST_EXP2(x) exp2f(x)
#define SHX(v, M) __shfl_xor(v, M)
#define DPP_X1(x) __shfl_xor(x, 1)
#define DPP_X2(x) __shfl_xor(x, 2)
#define DPP_X7(x) __shfl_xor(x, 7)
#define DPP_X8(x) __shfl_xor(x, 8)
static inline float xrow16_max(float x) { x = fmaxf(x, __shfl_xor(x, 16)); return fmaxf(x, __shfl_xor(x, 32)); }
static inline float xrow16_sum(float x) { x = x + __shfl_xor(x, 16); return x + __shfl_xor(x, 32); }
#define FAST_LOG2(x) log2f(x)
#define FAST_RCP(x) (1.f / (x))
static inline unsigned pack2(float lo, float hi) {
    unsigned a = __builtin_bit_cast(unsigned, lo), b = __builtin_bit_cast(unsigned, hi);
    a += 0x7fffu + ((a >> 16) & 1u); b += 0x7fffu + ((b >> 16) & 1u);
    return (a >> 16) | (b & 0xffff0000u);
}
#endif
__device__ __forceinline__ bf16_t f2bf(float f) { return (bf16_t)(pack2(f, 0.f) & 0xffffu); }
__device__ __forceinline__ float bf2f(bf16_t h) { return __builtin_bit_cast(float, (unsigned)h << 16); }

#define XB_TMO      128
#define XB_XCNT(j)  (256  + 64 * (j))
#define XB_XSUB(j)  (1280 + 64 * (j))
#define XB_XGEN(j)  (2304 + 64 * (j))
#define XB_TOP      3328
#define XB_TOPGEN   3392
#define XCD_BAR_WORDS 3456
#define XB_SPIN_CAP (1u << 22)
#define XB_SPIN(cond, bar) do { unsigned _sp = 0; while (cond) { SLEEP1(); \
    if ((++_sp & 255u) == 0u) { if (xb_ld(&(bar)[XB_TMO])) break; if (_sp > XB_SPIN_CAP) { xb_add(&(bar)[XB_TMO], 1u); break; } } } } while (0)

#define XB_X2SUB(x, s) (6400 + 16 * ((x) * 4 + (s)))
#define XB_X2CNT(x, s) (7424 + ((x) * 4 + (s)))
struct XcdBarrier { unsigned* bar; unsigned x, s; volatile LAS unsigned* st; };

__device__ __forceinline__ XcdBarrier xcd_barrier_post(unsigned* bar, volatile LAS unsigned* st) {
    XcdBarrier b; b.bar = bar; b.x = xb_xcc_id() & 15u; b.s = (blockIdx.x >> 3) & 3u; b.st = st;
    if (threadIdx.x == 0) {
        unsigned o = xb_add(&bar[XB_X2CNT(b.x, b.s)], 1u);
#ifndef EMU
        asm volatile("" :: "v"(o));
#endif
        (void)o;
        (void)xb_add(&bar[XB_XCNT(b.x)], 1u);
    }
    return b;
}
__device__ __forceinline__ void xcd_barrier_complete(unsigned* bar, unsigned x, unsigned s, unsigned& nsub, unsigned& nx, unsigned& nsubs) {
    const unsigned G = gridDim.x;
    unsigned sum, cnt, sp = 0u;
    for (;;) {
        sum = 0u; cnt = 0u;
#pragma unroll
        for (unsigned j = 0; j < 16; ++j) { const unsigned c = xb_ld(&bar[XB_XCNT(j)]); sum += c; cnt += (c > 0u) ? 1u : 0u; }
        if (sum == G) break;
        SLEEP1();
        if ((++sp & 255u) == 0u) { if (xb_ld(&bar[XB_TMO])) break; if (sp > XB_SPIN_CAP) { xb_add(&bar[XB_TMO], 1u); break; } }
    }
    unsigned mine = 0u, subs = 0u;
#pragma unroll
    for (unsigned q = 0; q < 4; ++q) { const unsigned c = xb_ld(&bar[XB_X2CNT(x, q)]); subs += (c > 0u) ? 1u : 0u; mine = (q == s) ? c : mine; }
    nsub = mine > 0u ? mine : 1u; nx = cnt > 0u ? cnt : 1u; nsubs = subs > 0u ? subs : 1u;
}
__device__ __forceinline__ void xcd_barrier(const XcdBarrier& b, bool leader) {
    WAIT_VM0();
    __syncthreads();
    if (leader) {
        unsigned* bar = b.bar;
        WAIT_ALL0();
        unsigned nsub = b.st[0], nx = b.st[1], nsubs = b.st[2];
        if (nsub == 0u) { xcd_barrier_complete(bar, b.x, b.s, nsub, nx, nsubs); b.st[0] = nsub; b.st[1] = nx; b.st[2] = nsubs; }
        const unsigned old = xb_add(&bar[XB_X2SUB(b.x, b.s)], 1u);
        const unsigned gen = old / nsub;
        bool xcd_last = false;
        if (old + 1u == (gen + 1u) * nsub) {
            const unsigned old2 = xb_add(&bar[XB_XSUB(b.x)], 1u);
            xcd_last = (old2 + 1u == (old2 / nsubs + 1u) * nsubs);
        }
        if (xcd_last) {
            FENCE_REL_AGENT();
            WAIT_VM0();
            const unsigned og = xb_add(&bar[XB_TOP], 1u);
            const unsigned tg = og / nx;
            if (og + 1u == (tg + 1u) * nx) xb_add(&bar[XB_TOPGEN], 1u);
            else XB_SPIN(xb_ld(&bar[XB_TOPGEN]) == tg, bar);
            FENCE_ACQ_AGENT();
            xb_add(&bar[XB_XGEN(b.x)], 1u);
            WAIT_VM0();
        } else {
            XB_SPIN(xb_ld(&bar[XB_XGEN(b.x)]) == gen, bar);
            FENCE_ACQ_AGENT();
            WAIT_VM0();
        }
    }
    __syncthreads();
}

__device__ __forceinline__ f32x4 mul_s4(f32x4 a, float s) {
#ifdef EMU
    return a * s;
#else
    f32x4 o;
#pragma unroll
    for (int c = 0; c < 4; ++c) { float r, x = a[c]; asm volatile("v_mul_f32_e32 %0, %1, %2" : "=v"(r) : "v"(x), "v"(s)); o[c] = r; }
    return o;
#endif
}
__device__ __forceinline__ float wave_sum_l(float v, int lane) {
    (void)lane;
    v += DPP_X1(v); v += DPP_X2(v); v += DPP_X7(v); v += DPP_X8(v);
    return xrow16_sum(v);
}
#define wave_sum(v) wave_sum_l(v, lane)
__device__ __forceinline__ float fexp(float x) { return FAST_EXP2(x * LOG2E); }
__device__ __forceinline__ float sigmoid_f(float x) { return FAST_RCP(1.f + fexp(-x)); }
__device__ __forceinline__ float log_sigmoid_f(float x) { return fminf(x, 0.f) - 0.6931471805599453f * FAST_LOG2(1.f + fexp(-fabsf(x))); }
__device__ __forceinline__ float gelu_tanh_f(float x) { const float u = 0.7978845608028654f * (x + 0.044715f * x * x * x); return x * FAST_RCP(1.f + fexp(-2.f * u)); }
__device__ __forceinline__ float silu_f(float x) { return x * FAST_RCP(1.f + fexp(-x)); }
__device__ __forceinline__ float neg_expm1_f(float x) {
    const float ser = -x * (1.f + x * (0.5f + x * (0.16666667f + x * (0.041666668f + x * (0.008333334f + x * 0.0013888889f)))));
    return (x > -0.35f) ? ser : (1.f - fexp(x));
}

struct RmIdent { __device__ __forceinline__ int operator()(int n) const { return n; } };
struct RmWin { __device__ __forceinline__ int operator()(int n) const { return n < C_FA ? n : (n < C_FA + 6 ? -1 : n - 6); } };
struct RmGu { int kind; __device__ __forceinline__ int operator()(int f) const { return (f >> 7) * 256 + ((f >> 6) & 1) * 128 + ((f >> 4) & 3) * 32 + kind * 16 + (f & 15); } };
struct RmOff { int off; __device__ __forceinline__ int operator()(int n) const { return n + off; } };

template <class RM>
__device__ __forceinline__ void convert_tile(const float* src, int ld, int K, int Nsrc, int k0, int n0, bf16_t* dst, const RM& rm, float* T, int tid) {
    {
        const int nn = tid & 255, kh = (tid >> 8) * 32, n = n0 + nn;
        const float* sp = src + (size_t)(k0 + kh) * ld + n;
        float v[32];
#pragma unroll
        for (int i = 0; i < 32; ++i) v[i] = (n < Nsrc) ? sp[(size_t)i * ld] : 0.f;
#pragma unroll
        for (int i = 0; i < 32; ++i) T[(kh + i) * 257 + nn] = v[i];
    }
    __syncthreads();
#pragma unroll
    for (int q = 0; q < 4; ++q) {
        const int nn = q * 64 + (tid >> 3), kc = (tid & 7) * 8, n = n0 + nn;
        const int row = (n < Nsrc) ? rm(n) : -1;
        if (row >= 0) {
            u32x4 o;
            o.x = pack2(T[(kc + 0) * 257 + nn], T[(kc + 1) * 257 + nn]); o.y = pack2(T[(kc + 2) * 257 + nn], T[(kc + 3) * 257 + nn]);
            o.z = pack2(T[(kc + 4) * 257 + nn], T[(kc + 5) * 257 + nn]); o.w = pack2(T[(kc + 6) * 257 + nn], T[(kc + 7) * 257 + nn]);
            *(u32x4*)(dst + (size_t)row * K + k0 + kc) = o;
        }
    }
    __syncthreads();
}
template <class RM>
__device__ __forceinline__ void convert_tile_v4(const float* src, int ld, int K, int k0, int n0, bf16_t* dst, const RM& rm, float* T, int tid_in) {
    int tid = tid_in; OPAQUE(tid);
    {
        const int w = tid >> 6, l4 = (tid & 63) * 4;
        const float* sp = src + (size_t)(k0 + w * 8) * ld + n0 + l4;
        f32x4 v[8];
#pragma unroll
        for (int i = 0; i < 8; ++i) v[i] = *(const f32x4*)(sp + (size_t)i * ld);
#pragma unroll
        for (int i = 0; i < 8; ++i) { float* tp = T + (w * 8 + i) * 257 + l4; tp[0] = v[i][0]; tp[1] = v[i][1]; tp[2] = v[i][2]; tp[3] = v[i][3]; }
    }
    __syncthreads();
#pragma unroll
    for (int q = 0; q < 4; ++q) {
        const int nn = q * 64 + (tid >> 3), kc = (tid & 7) * 8, n = n0 + nn;
        const int row = rm(n);
        u32x4 o;
        o.x = pack2(T[(kc + 0) * 257 + nn], T[(kc + 1) * 257 + nn]); o.y = pack2(T[(kc + 2) * 257 + nn], T[(kc + 3) * 257 + nn]);
        o.z = pack2(T[(kc + 4) * 257 + nn], T[(kc + 5) * 257 + nn]); o.w = pack2(T[(kc + 6) * 257 + nn], T[(kc + 7) * 257 + nn]);
        *(u32x4*)(dst + (size_t)row * K + k0 + kc) = o;
    }
    __syncthreads();
}
template <class RM>
__device__ __forceinline__ void convert_mats(const float* src, size_t sstride, int nmat, int ld, int K, int Nsrc, bf16_t* dst, size_t dstride, const RM& rm,
                                             float* T, int tid, int bid, int G) {
    const int tk = K / 64, tn = (Nsrc + 255) / 256, per = tk * tn, total = nmat * per;
    for (int t = bid; t < total; t += G) {
        const int mi = t / per, r = t % per;
        convert_tile(src + (size_t)mi * sstride, ld, K, Nsrc, (r / tn) * 64, (r % tn) * 256, dst + (size_t)mi * dstride, rm, T, tid);
    }
}

constexpr int NCONV = DEPTH * 768;
__device__ __forceinline__ void moe_conv_chunk(const Params& p, int cid, bf16_t* WguT_, bf16_t* WdT_, float* T, int tid) {
    const int l = cid / 768, r = cid % 768, kind = r >> 8, t0 = (r & 255) * 8;
    for (int t = t0; t < t0 + 8; ++t) {
        const int mi = t >> 6, rr = t & 63;
        if (kind < 2) {
            const float* src = p.in[kind == 0 ? I_WGATE : I_WUP] + ((size_t)l * NEXP + mi) * D * DFF;
            convert_tile_v4(src, DFF, D, (rr >> 1) * 64, (rr & 1) * 256, WguT_ + ((size_t)l * NEXP + mi) * 1024 * D, RmGu{kind}, T, tid);
        } else {
            const float* src = p.in[I_WDOWN] + ((size_t)l * NEXP + mi) * DFF * D;
            convert_tile_v4(src, D, DFF, (rr >> 3) * 64, (rr & 7) * 256, WdT_ + ((size_t)l * NEXP + mi) * D * DFF, RmIdent{}, T, tid);
        }
    }
}

constexpr int BK = 64, HTB = 128 * 64 * 2;
__device__ __forceinline__ int lds_byte(int r, int c) {
    const int st = (r >> 4) * 2 + (c >> 5), rr = r & 15, cc = c & 31, ob = rr * 64 + cc * 2;
    return st * 1024 + (ob ^ (((ob >> 9) & 1) << 5));
}
__device__ __forceinline__ void stage_rc(int b, int& R, int& C) {
    const int st = b / 1024, sb = b % 1024, swz = sb ^ (((sb >> 9) & 1) << 5);
    R = (st >> 1) * 16 + swz / 64; C = (st & 1) * 32 + (swz % 64) / 2;
}
template <bool GATHER, int AAUX = 0>
__device__ __forceinline__ void gemm_tile(const bf16_t* A, int arow0, const unsigned (&aoff)[2][2], const bf16_t* Bt, int brow0, int K,
                                          unsigned char* shm, f32x4 (&acc)[2][2][4][2], int tid_in) {
    int tid = tid_in; OPAQUE(tid);
    unsigned toff; { int R0, C0; stage_rc(tid * 16, R0, C0); toff = (unsigned)(R0 * K + C0); }
#define SA(b, h) (shm + ((b) * 2 + (h)) * HTB)
#define SB(b, h) (shm + (4 + (b) * 2 + (h)) * HTB)
#define STAGE_B(P, h, kt) do { _Pragma("unroll") for (int _i = 0; _i < 2; ++_i) GLDS16(Bt + ((size_t)(brow0 + (h) * 128 + _i * 64) * K + (size_t)(kt) * BK) + toff, (P) + tid * 16 + _i * 8192); } while (0)
#define STAGE_A(P, h, kt) do { _Pragma("unroll") for (int _i = 0; _i < 2; ++_i) { \
    if (GATHER) GLDS16(A + (size_t)(kt) * BK + aoff[h][_i], (P) + tid * 16 + _i * 8192); \
    else GLDS16X(A + ((size_t)(arow0 + (h) * 128 + _i * 64) * K + (size_t)(kt) * BK) + toff, (P) + tid * 16 + _i * 8192, AAUX); } } while (0)
#define LDA(dst, b, h) _Pragma("unroll") for (int m = 0; m < 4; ++m) _Pragma("unroll") for (int k = 0; k < 2; ++k) \
    dst[m][k] = *reinterpret_cast<const bf16x8*>(SA(b, h) + lds_byte(wr * 64 + m * 16 + fr, k * 32 + fq * 8))
#define LDB(dst, b, h) _Pragma("unroll") for (int n = 0; n < 2; ++n) _Pragma("unroll") for (int k = 0; k < 2; ++k) \
    dst[n][k] = *reinterpret_cast<const bf16x8*>(SB(b, h) + lds_byte(wc * 32 + n * 16 + fr, k * 32 + fq * 8))
#define MMA(ai, bj, At, Bx) do { SETPRIO(1); \
    _Pragma("unroll") for (int m = 0; m < 4; ++m) _Pragma("unroll") for (int n = 0; n < 2; ++n) _Pragma("unroll") for (int k = 0; k < 2; ++k) \
      acc[ai][bj][m][n] = MFMA16(At[m][k], Bx[n][k], acc[ai][bj][m][n]); \
    SETPRIO(0); } while (0)
    int wid = tid >> 6, lane = tid & 63, wr = wid >> 2, wc = wid & 3, fr = lane & 15, fq = lane >> 4;
#pragma unroll
    for (int a = 0; a < 2; ++a)
#pragma unroll
        for (int b = 0; b < 2; ++b)
#pragma unroll
            for (int m = 0; m < 4; ++m)
#pragma unroll
                for (int n = 0; n < 2; ++n) acc[a][b][m][n] = (f32x4){0.f, 0.f, 0.f, 0.f};
    bf16x8 At[4][2], B0[2][2], B1[2][2];
    const int nt = K / BK;
    STAGE_B(SB(0, 0), 0, 0); STAGE_A(SA(0, 0), 0, 0);
    STAGE_B(SB(0, 1), 1, 0); STAGE_A(SA(0, 1), 1, 0);
    if (wr == 1) BAR();
    WAIT_V(4); BAR();
    STAGE_B(SB(1, 0), 0, 1); STAGE_A(SA(1, 0), 0, 1); STAGE_B(SB(1, 1), 1, 1);
    WAIT_V(6); BAR();
    for (int t = 0; t < nt - 2; t += 2) {
        LDB(B0, 0, 0); SCHED(); LDA(At, 0, 0); STAGE_A(SA(1, 1), 1, t + 1);
        WAIT_L(8); BAR(); WAIT_L(0); MMA(0, 0, At, B0); BAR(); SCHED();
        LDB(B1, 0, 1); STAGE_B(SB(0, 0), 0, t + 2);
        BAR(); WAIT_L(0); MMA(0, 1, At, B1); BAR();
        LDA(At, 0, 1); STAGE_A(SA(0, 0), 0, t + 2);
        BAR(); WAIT_L(0); MMA(1, 0, At, B0); BAR(); SCHED();
        STAGE_B(SB(0, 1), 1, t + 2);
        WAIT_V(6); BAR(); MMA(1, 1, At, B1); BAR();
        LDB(B0, 1, 0); SCHED(); LDA(At, 1, 0); STAGE_A(SA(0, 1), 1, t + 2);
        WAIT_L(8); BAR(); WAIT_L(0); MMA(0, 0, At, B0); BAR(); SCHED();
        LDB(B1, 1, 1); STAGE_B(SB(1, 0), 0, t + 3);
        BAR(); WAIT_L(0); MMA(0, 1, At, B1); BAR();
        LDA(At, 1, 1); STAGE_A(SA(1, 0), 0, t + 3);
        BAR(); WAIT_L(0); MMA(1, 0, At, B0); BAR(); SCHED();
        STAGE_B(SB(1, 1), 1, t + 3);
        WAIT_V(6); BAR(); MMA(1, 1, At, B1); BAR();
    }
    OPAQUE(tid); wid = tid >> 6; lane = tid & 63; wr = wid >> 2; wc = wid & 3; fr = lane & 15; fq = lane >> 4;
    { LDB(B0, 0, 0); WAIT_V(0); LDA(At, 0, 0); STAGE_A(SA(1, 1), 1, nt - 1);
      BAR(); WAIT_L(0); MMA(0, 0, At, B0); BAR();
      LDB(B1, 0, 1); BAR(); WAIT_L(0); MMA(0, 1, At, B1); BAR();
      LDA(At, 0, 1); WAIT_V(4); BAR(); WAIT_L(0); MMA(1, 0, At, B0); MMA(1, 1, At, B1); BAR(); }
    { LDB(B0, 1, 0); LDA(At, 1, 0); WAIT_V(2); BAR(); WAIT_L(0); MMA(0, 0, At, B0); BAR();
      LDB(B1, 1, 1); WAIT_V(0); BAR(); WAIT_L(0); MMA(0, 1, At, B1); BAR();
      LDA(At, 1, 1); BAR(); WAIT_L(0); MMA(1, 0, At, B0); MMA(1, 1, At, B1); BAR(); }
    if (wr == 0) BAR();
#undef SA
#undef SB
#undef STAGE_A
#undef STAGE_B
#undef LDA
#undef LDB
#undef MMA
}
__device__ __forceinline__ void stage_geom(int tid, int (&R)[2], int (&C)[2]) {
#pragma unroll
    for (int i = 0; i < 2; ++i) stage_rc(tid * 16 + i * 8192, R[i], C[i]);
}

constexpr int ATT_STAGE = 69632;
constexpr int ATT_KBUF = 0, ATT_VBUF = 32768, ATT_CBUF = 65536;
template <int KIND>
__device__ __forceinline__ void attn_unit(const bf16_t* Q, const bf16_t* Kg, const bf16_t* VT, const float* cum2, const float* kmx, int qb, bf16_t* concat, int ccol0,
                                          float lam, float osc, const float* subg, unsigned char* lds, int tid) {
    const int lane = tid & 63, wave = tid >> 6, r16 = lane & 15, q4 = lane >> 4;
    const int q0w = qb * 128 + wave * 16, myq = q0w + r16;
    const int ntiles = 2 * qb + 2;
    const int wlimit = (KIND == 0) ? ((q0w + 15) >> 6) : (q0w >> 6);
    constexpr int NMAP = (KIND == 0) ? 1 : 2, NKS = (KIND == 0) ? 4 : 2;
    bf16x8 qf[NMAP][NKS];
#pragma unroll
    for (int mp = 0; mp < NMAP; ++mp)
#pragma unroll
        for (int ks = 0; ks < NKS; ++ks) qf[mp][ks] = *(const bf16x8*)(Q + (size_t)myq * 128 + mp * 64 + ks * 32 + q4 * 8);
    const float cq = (KIND == 0) ? cum2[myq] : 0.f;
    int kt0 = 0;
    if (KIND == 0) {
        float* wmax = (float*)(lds + ATT_CBUF + 512); int* kst = (int*)(lds + ATT_CBUF + 576);
        float qs = 0.f;
#pragma unroll
        for (int ks = 0; ks < NKS; ++ks)
#pragma unroll
            for (int j = 0; j < 8; ++j) { const float v = bf2f((bf16_t)qf[0][ks][j]); qs += v * v; }
        qs = xrow16_sum(qs);
        qs = fmaxf(qs, SHX(qs, 1)); qs = fmaxf(qs, SHX(qs, 2)); qs = fmaxf(qs, SHX(qs, 4)); qs = fmaxf(qs, SHX(qs, 8));
        if (lane == 0) wmax[wave] = qs;
        if (tid == 0) *kst = 2 * qb;
        __syncthreads();
        float qm = wmax[0];
#pragma unroll
        for (int w = 1; w < 8; ++w) qm = fmaxf(qm, wmax[w]);
        qm = sqrtf(qm) * 1.01f;
        const float kd = sqrtf(fmaxf(kmx[2 * qb], kmx[2 * qb + 1])) * 1.01f;
        if (tid < 2 * qb) {
            const float bias = cum2[qb * 128] - cum2[tid * 64 + 63];
            const bool skip = bias + qm * (sqrtf(kmx[tid]) * 1.01f + kd) < -40.f;
            if (!skip) atomic_min_int(kst, tid);
        }
        __syncthreads();
        kt0 = RFL(*kst);
    }
    f32x4 ot[NMAP][8];
    float mrun[NMAP], lsum[NMAP];
#pragma unroll
    for (int mp = 0; mp < NMAP; ++mp) { mrun[mp] = -INFINITY; lsum[mp] = 0.f;
#pragma unroll
        for (int mo = 0; mo < 8; ++mo) ot[mp][mo] = (f32x4){0.f, 0.f, 0.f, 0.f}; }
    u32x4 sk[2], sv[2]; float sc = 0.f;
    const u32x4* kg = (const u32x4*)Kg; const u32x4* vg = (const u32x4*)VT;
#pragma unroll
    for (int i = 0; i < 2; ++i) { sk[i] = kg[(size_t)kt0 * 1024 + tid + i * 512]; sv[i] = vg[(size_t)kt0 * 1024 + tid + i * 512]; }
    if (KIND == 0 && tid < 64) sc = cum2[kt0 * 64 + tid];
    for (int kt = kt0; kt < ntiles; ++kt) {
        unsigned char* kb = lds + ATT_KBUF + (kt & 1) * 16384;
        unsigned char* vb = lds + ATT_VBUF + (kt & 1) * 16384;
        float* cb = (float*)(lds + ATT_CBUF + (kt & 1) * 256);
#pragma unroll
        for (int i = 0; i < 2; ++i) {
            const int g = tid + i * 512;
            { const int row = g >> 4, c = g & 15; *(u32x4*)(kb + row * 256 + ((c ^ (row & 15)) << 4)) = sk[i]; }
            { const int d = g >> 3, c = g & 7; *(u32x4*)(vb + d * 128 + ((c ^ ((d >> 1) & 7)) << 4)) = sv[i]; }
        }
        if (KIND == 0 && tid < 64) cb[tid] = sc;
        __syncthreads();
        if (kt + 1 < ntiles) {
#pragma unroll
            for (int i = 0; i < 2; ++i) { sk[i] = kg[(size_t)(kt + 1) * 1024 + tid + i * 512]; sv[i] = vg[(size_t)(kt + 1) * 1024 + tid + i * 512]; }
            if (KIND == 0 && tid < 64) sc = cum2[(kt + 1) * 64 + tid];
        }
        if (kt <= wlimit) {
#pragma unroll
            for (int mp = 0; mp < NMAP; ++mp) {
                bf16x8 kf[4][NKS], vfa[8];
#pragma unroll
                for (int m = 0; m < 4; ++m)
#pragma unroll
                    for (int ks = 0; ks < NKS; ++ks) { const int c = (KIND == 0 ? 0 : mp * 8) + ks * 4 + q4; kf[m][ks] = *(const bf16x8*)(kb + (m * 16 + r16) * 256 + ((c ^ r16) << 4)); }
#pragma unroll
                for (int mo = 0; mo < 8; ++mo) { const int d = mo * 16 + r16; vfa[mo] = *(const bf16x8*)(vb + d * 128 + (((0 * 4 + q4) ^ ((d >> 1) & 7)) << 4)); }
                SCHED();
                f32x4 st[4];
#pragma unroll
                for (int m = 0; m < 4; ++m) st[m] = (f32x4){0.f, 0.f, 0.f, 0.f};
#pragma unroll
                for (int ks = 0; ks < NKS; ++ks)
#pragma unroll
                    for (int m = 0; m < 4; ++m) st[m] = MFMA16(kf[m][ks], qf[mp][ks], st[m]);
                SCHED();
                float mx = -INFINITY;
#pragma unroll
                for (int m = 0; m < 4; ++m) {
                    if (KIND == 0) {
                        const f32x4 ck = *(const f32x4*)(cb + m * 16 + 4 * q4);
#pragma unroll
                        for (int j = 0; j < 4; ++j) {
                            float y = st[m][j] + (cq - ck[j]);
                            if (kt * 64 + m * 16 + 4 * q4 + j > myq) y = -INFINITY;
                            st[m][j] = y;
                        }
                    }
#pragma unroll
                    for (int j = 0; j < 4; ++j) mx = fmaxf(mx, st[m][j]);
                }
                mx = xrow16_max(mx);
                const float mnew = fmaxf(mrun[mp], mx);
                const float alpha = FAST_EXP2(mrun[mp] - mnew);
                mrun[mp] = mnew;
                float ps = 0.f;
#pragma unroll
                for (int m = 0; m < 4; ++m)
#pragma unroll
                    for (int j = 0; j < 4; ++j) { const float pv = FAST_EXP2(st[m][j] - mnew); st[m][j] = pv; ps += pv; }
                lsum[mp] = lsum[mp] * alpha + ps;
#pragma unroll
                for (int mo = 0; mo < 8; ++mo) ot[mp][mo] *= alpha;
                bf16x8 pf[2];
#pragma unroll
                for (int kk = 0; kk < 2; ++kk) {
                    u32x4 pw;
                    pw.x = pack2(st[2 * kk][0], st[2 * kk][1]); pw.y = pack2(st[2 * kk][2], st[2 * kk][3]);
                    pw.z = pack2(st[2 * kk + 1][0], st[2 * kk + 1][1]); pw.w = pack2(st[2 * kk + 1][2], st[2 * kk + 1][3]);
                    pf[kk] = __builtin_bit_cast(bf16x8, pw);
                }
                bf16x8 vfb[8];
#pragma unroll
                for (int mo = 0; mo < 8; ++mo) { const int d = mo * 16 + r16; vfb[mo] = *(const bf16x8*)(vb + d * 128 + (((1 * 4 + q4) ^ ((d >> 1) & 7)) << 4)); }
                SCHED();
#pragma unroll
                for (int mo = 0; mo < 8; ++mo) ot[mp][mo] = MFMA16(vfa[mo], pf[0], ot[mp][mo]);
                SCHED();
#pragma unroll
                for (int mo = 0; mo < 8; ++mo) ot[mp][mo] = MFMA16(vfb[mo], pf[1], ot[mp][mo]);
            }
        }
    }
    float inv[NMAP];
#pragma unroll
    for (int mp = 0; mp < NMAP; ++mp) { float l = lsum[mp]; l = xrow16_sum(l); inv[mp] = 1.f / l; }
    if (KIND == 0) {
        int te = tid; OPAQUE(te);
        const int er = te & 15, eq = (te >> 4) & 3, eqw = qb * 128 + (te >> 6) * 16;
        unsigned char* stg = lds + ATT_STAGE + (te >> 6) * 8192;
#pragma unroll
        for (int mo = 0; mo < 8; ++mo) {
            u32x2 o; o.x = pack2(ot[0][mo][0] * inv[0], ot[0][mo][1] * inv[0]); o.y = pack2(ot[0][mo][2] * inv[0], ot[0][mo][3] * inv[0]);
            *(u32x2*)(stg + er * 256 + (((mo * 2 + (eq >> 1)) ^ er) << 4) + (eq & 1) * 8) = o;
        }
        WAVE_SYNC();
#pragma unroll
        for (int k = 0; k < 4; ++k) {
            const int rl = k * 4 + eq, cch = er;
            const u32x4 val = *(const u32x4*)(stg + rl * 256 + ((cch ^ rl) << 4));
            *(u32x4*)(concat + (size_t)(eqw + rl) * D + ccol0 + cch * 8) = val;
        }
    } else {
        float ss = 0.f;
#pragma unroll
        for (int mo = 0; mo < 8; ++mo)
#pragma unroll
            for (int j = 0; j < 4; ++j) { const float v = ot[0][mo][j] * inv[0] - lam * (ot[NMAP - 1][mo][j] * inv[NMAP - 1]); ot[0][mo][j] = v; ss += v * v; }
        ss = xrow16_sum(ss);
        const float rs = osc / sqrtf(ss * (1.f / 128.f) + LN_EPS);
#pragma unroll
        for (int mo = 0; mo < 8; ++mo) {
            const f32x4 g = *(const f32x4*)(subg + mo * 16 + 4 * q4);
            u32x2 o; o.x = pack2(ot[0][mo][0] * rs * g[0], ot[0][mo][1] * rs * g[1]); o.y = pack2(ot[0][mo][2] * rs * g[2], ot[0][mo][3] * rs * g[3]);
            *(u32x2*)(concat + (size_t)myq * D + ccol0 + mo * 16 + 4 * q4) = o;
        }
    }
    __syncthreads();
}

__device__ __forceinline__ int dpart_row(int c, int q) { return c * (S - DCH * 64) - (DCH * 32) * c * (c - 1) + q; }
__device__ __forceinline__ void attn_dmap_unit(const bf16_t* Qh, const bf16_t* Kh, const bf16_t* VTh, int mp, int qb, int t0, int t1,
                                               bf16_t* Op, float* ML, int c, float bnd, unsigned char* lds, int tid) {
    const bool fixedref = (bnd <= 60.f);
    const int lane = tid & 63, wave = tid >> 6, r16 = lane & 15, q4 = lane >> 4;
    const int q0w = qb * 256 + wave * 32;
    const int wlimit = q0w >> 6;
    bf16x8 qf[2][2];
#pragma unroll
    for (int n = 0; n < 2; ++n)
#pragma unroll
        for (int ks = 0; ks < 2; ++ks) qf[n][ks] = *(const bf16x8*)(Qh + (size_t)(q0w + n * 16 + r16) * 128 + mp * 64 + ks * 32 + q4 * 8);
    f32x4 ot[8][2];
    float mrun[2] = {-INFINITY, -INFINITY}, lsum[2] = {0.f, 0.f};
    if (fixedref) { mrun[0] = bnd; mrun[1] = bnd; }
    const float stinit = fixedref ? -bnd : 0.f;
#pragma unroll
    for (int mo = 0; mo < 8; ++mo) { ot[mo][0] = (f32x4){0.f, 0.f, 0.f, 0.f}; ot[mo][1] = (f32x4){0.f, 0.f, 0.f, 0.f}; }
    u32x4 sk, sv[2];
    const u32x4* kg = (const u32x4*)Kh; const u32x4* vg = (const u32x4*)VTh;
    const int krow = tid >> 3, kc8 = tid & 7;
    sk = kg[(size_t)t0 * 1024 + krow * 16 + mp * 8 + kc8];
#pragma unroll
    for (int i = 0; i < 2; ++i) sv[i] = vg[(size_t)t0 * 1024 + tid + i * 512];
    for (int kt = t0; kt < t1; ++kt) {
        unsigned char* kb = lds + (kt & 1) * 8192;
        unsigned char* vb = lds + 16384 + (kt & 1) * 16384;
        *(u32x4*)(kb + krow * 128 + ((kc8 ^ ((krow >> 1) & 7)) << 4)) = sk;
#pragma unroll
        for (int i = 0; i < 2; ++i) { const int g = tid + i * 512, d = g >> 3, cc = g & 7; *(u32x4*)(vb + d * 128 + ((cc ^ ((d >> 1) & 7)) << 4)) = sv[i]; }
        __syncthreads();
        if (kt + 1 < t1) {
            sk = kg[(size_t)(kt + 1) * 1024 + krow * 16 + mp * 8 + kc8];
#pragma unroll
            for (int i = 0; i < 2; ++i) sv[i] = vg[(size_t)(kt + 1) * 1024 + tid + i * 512];
        }
        if (kt <= wlimit) {
            bf16x8 kf[4][2], vfa[8];
#pragma unroll
            for (int m = 0; m < 4; ++m)
#pragma unroll
                for (int ks = 0; ks < 2; ++ks) kf[m][ks] = *(const bf16x8*)(kb + (m * 16 + r16) * 128 + (((ks * 4 + q4) ^ ((r16 >> 1) & 7)) << 4));
#pragma unroll
            for (int mo = 0; mo < 8; ++mo) { const int d = mo * 16 + r16; vfa[mo] = *(const bf16x8*)(vb + d * 128 + (((0 * 4 + q4) ^ ((d >> 1) & 7)) << 4)); }
            SCHED();
            f32x4 st[4][2];
#pragma unroll
            for (int m = 0; m < 4; ++m) { st[m][0] = (f32x4){stinit, stinit, stinit, stinit}; st[m][1] = (f32x4){stinit, stinit, stinit, stinit}; }
            SETPRIO(1);
#pragma unroll
            for (int ks = 0; ks < 2; ++ks)
#pragma unroll
                for (int m = 0; m < 4; ++m) { st[m][0] = MFMA16(kf[m][ks], qf[0][ks], st[m][0]); st[m][1] = MFMA16(kf[m][ks], qf[1][ks], st[m][1]); }
            SETPRIO(0);
            SCHED();
            float alpha[2] = {1.f, 1.f};
            if (fixedref) {
#pragma unroll
                for (int n = 0; n < 2; ++n) {
                    float ps = 0.f;
#pragma unroll
                    for (int m = 0; m < 4; ++m)
#pragma unroll
                        for (int j = 0; j < 4; ++j) { const float pv = FAST_EXP2(st[m][n][j]); st[m][n][j] = pv; ps += pv; }
                    lsum[n] += ps;
                }
            } else
#pragma unroll
            for (int n = 0; n < 2; ++n) {
                float mx = -INFINITY;
#pragma unroll
                for (int m = 0; m < 4; ++m)
#pragma unroll
                    for (int j = 0; j < 4; ++j) mx = fmaxf(mx, st[m][n][j]);
                mx = xrow16_max(mx);
                const float mnew = fmaxf(mrun[n], mx);
                alpha[n] = FAST_EXP2(mrun[n] - mnew);
                mrun[n] = mnew;
                float ps = 0.f;
#pragma unroll
                for (int m = 0; m < 4; ++m)
#pragma unroll
                    for (int j = 0; j < 4; ++j) { const float pv = FAST_EXP2(st[m][n][j] - mnew); st[m][n][j] = pv; ps += pv; }
                lsum[n] = lsum[n] * alpha[n] + ps;
            }
            if (ANY_LANE(alpha[0] != 1.f)) {
#pragma unroll
                for (int mo = 0; mo < 8; ++mo) ot[mo][0] *= alpha[0];
            }
            if (ANY_LANE(alpha[1] != 1.f)) {
#pragma unroll
                for (int mo = 0; mo < 8; ++mo) ot[mo][1] *= alpha[1];
            }
            bf16x8 pf[2][2];
#pragma unroll
            for (int kk = 0; kk < 2; ++kk)
#pragma unroll
                for (int n = 0; n < 2; ++n) {
                    u32x4 pw;
                    pw.x = pack2(st[2 * kk][n][0], st[2 * kk][n][1]); pw.y = pack2(st[2 * kk][n][2], st[2 * kk][n][3]);
                    pw.z = pack2(st[2 * kk + 1][n][0], st[2 * kk + 1][n][1]); pw.w = pack2(st[2 * kk + 1][n][2], st[2 * kk + 1][n][3]);
                    pf[kk][n] = __builtin_bit_cast(bf16x8, pw);
                }
            bf16x8 vfb[8];
#pragma unroll
            for (int mo = 0; mo < 8; ++mo) { const int d = mo * 16 + r16; vfb[mo] = *(const bf16x8*)(vb + d * 128 + (((1 * 4 + q4) ^ ((d >> 1) & 7)) << 4)); }
            SCHED();
            SETPRIO(1);
#pragma unroll
            for (int mo = 0; mo < 8; ++mo) { ot[mo][0] = MFMA16(vfa[mo], pf[0][0], ot[mo][0]); ot[mo][1] = MFMA16(vfa[mo], pf[0][1], ot[mo][1]); }
            SCHED();
#pragma unroll
            for (int mo = 0; mo < 8; ++mo) { ot[mo][0] = MFMA16(vfb[mo], pf[1][0], ot[mo][0]); ot[mo][1] = MFMA16(vfb[mo], pf[1][1], ot[mo][1]); }
            SETPRIO(0);
        }
    }
    if (q0w >= DCH * 64 * c)
#pragma unroll
    for (int n = 0; n < 2; ++n) {
        float l = lsum[n]; l = xrow16_sum(l);
        const int row = dpart_row(c, q0w + n * 16 + r16);
        if (q4 == 0) { ML[row * 2] = mrun[n]; ML[row * 2 + 1] = l; }
    }
    {
        int te = tid; OPAQUE(te);
        const int er = te & 15, eq = (te >> 4) & 3, eqw = qb * 256 + (te >> 6) * 32;
        unsigned char* stg = lds + ATT_STAGE + (te >> 6) * 8192;
#pragma unroll
        for (int n = 0; n < 2; ++n)
#pragma unroll
            for (int mo = 0; mo < 8; ++mo) {
                u32x2 o; o.x = pack2(ot[mo][n][0], ot[mo][n][1]); o.y = pack2(ot[mo][n][2], ot[mo][n][3]);
                *(u32x2*)(stg + (n * 16 + er) * 256 + (((mo * 2 + (eq >> 1)) ^ er) << 4) + (eq & 1) * 8) = o;
            }
        WAVE_SYNC();
        if (eqw >= DCH * 64 * c) {
            const int row0 = dpart_row(c, eqw);
#pragma unroll
            for (int k = 0; k < 8; ++k) {
                const int rl = k * 4 + eq, cch = er;
                const u32x4 val = *(const u32x4*)(stg + rl * 256 + ((cch ^ (rl & 15)) << 4));
                *(u32x4*)(Op + (size_t)(row0 + rl) * 128 + cch * 8) = val;
            }
        }
    }
    __syncthreads();
}

__device__ __forceinline__ void lru_unit_a(int chunk, int grp, int l, const Params& p, const bf16_t* Xr, const bf16_t* WaiT, float* hloc, float* ploc, float* sumA, float* sumH,
                                           unsigned char* lds, int tid) {
    const int lane = tid & 63, wave = tid >> 6, r16 = lane & 15, q4 = lane >> 4;
    unsigned char* XCB = lds; float* XU = (float*)(lds + 16384); float* LA = (float*)(lds + 49152); float* ENDS = (float*)(lds + 81920);
    const int t0 = chunk * 64, ch0 = grp * 128;
    bf16x8 bfr[2][4];
#pragma unroll
    for (int g = 0; g < 2; ++g)
#pragma unroll
        for (int ks = 0; ks < 4; ++ks) bfr[g][ks] = *(const bf16x8*)(WaiT + ((size_t)grp * 256 + g * 128 + wave * 16 + r16) * 128 + ks * 32 + q4 * 8);
    const int chg = ch0 + wave * 16 + r16;
    const float ba = p.in[I_BA][(size_t)l * LRU_W + chg], bi = p.in[I_BI][(size_t)l * LRU_W + chg];
    const float lam_raw = p.in[I_LAM][(size_t)l * LRU_W + chg];
    {
        const int c = tid & 127, tq = tid >> 7, ch = ch0 + c;
        const float* cw = p.in[I_CONVW] + (size_t)l * 4 * LRU_W + ch; const float cb = p.in[I_CONVB][(size_t)l * LRU_W + ch];
        const float w0 = cw[0], w1 = cw[LRU_W], w2 = cw[2 * LRU_W], w3 = cw[3 * LRU_W];
        const int ts = t0 + tq * 16;
        float x0 = (ts - 3 >= 0) ? bf2f(Xr[(size_t)(ts - 3) * LRU_W + ch]) : 0.f;
        float x1 = (ts - 2 >= 0) ? bf2f(Xr[(size_t)(ts - 2) * LRU_W + ch]) : 0.f;
        float x2 = (ts - 1 >= 0) ? bf2f(Xr[(size_t)(ts - 1) * LRU_W + ch]) : 0.f;
#pragma unroll
        for (int i = 0; i < 16; ++i) {
            const float x3 = bf2f(Xr[(size_t)(ts + i) * LRU_W + ch]);
            const float v = cb + w0 * x0 + w1 * x1 + w2 * x2 + w3 * x3;
            const int row = tq * 16 + i;
            XU[row * 128 + c] = v;
            *(bf16_t*)(XCB + row * 256 + (((c >> 3) ^ (row & 15)) << 4) + (c & 7) * 2) = f2bf(v);
            x0 = x1; x1 = x2; x2 = x3;
        }
    }
    __syncthreads();
    {
        const float lsl = 8.0f * log_sigmoid_f(lam_raw);
#pragma unroll
        for (int mt = 0; mt < 4; ++mt) {
            f32x4 ga = (f32x4){0.f, 0.f, 0.f, 0.f}, gi = (f32x4){0.f, 0.f, 0.f, 0.f};
#pragma unroll
            for (int ks = 0; ks < 4; ++ks) {
                const bf16x8 af = *(const bf16x8*)(XCB + (mt * 16 + r16) * 256 + (((ks * 4 + q4) ^ r16) << 4));
                ga = MFMA16(af, bfr[0][ks], ga); gi = MFMA16(af, bfr[1][ks], gi);
            }
#pragma unroll
            for (int j = 0; j < 4; ++j) {
                const int row = mt * 16 + 4 * q4 + j, idx = row * 128 + wave * 16 + r16;
                const float r = sigmoid_f(ga[j] + ba), ig = sigmoid_f(gi[j] + bi);
                const float log_a = lsl * r;
                LA[idx] = fexp(log_a);
                XU[idx] = sqrtf(neg_expm1_f(2.f * log_a)) * (ig * XU[idx]);
            }
        }
    }
    __syncthreads();
    {
        const int c = tid & 127, tq = tid >> 7, ch = ch0 + c;
        float h = 0.f, P = 1.f;
#pragma unroll
        for (int i = 0; i < 16; ++i) { const int idx = (tq * 16 + i) * 128 + c; const float a = LA[idx]; h = a * h + XU[idx]; P *= a; XU[idx] = h; LA[idx] = P; }
        ENDS[tq * 128 + c] = P; ENDS[512 + tq * 128 + c] = h;
        __syncthreads();
        float cin = 0.f, pin = 1.f;
        for (int s = 0; s < tq; ++s) { const float Ps = ENDS[s * 128 + c], hs = ENDS[512 + s * 128 + c]; cin = Ps * cin + hs; pin *= Ps; }
#pragma unroll
        for (int i = 0; i < 16; ++i) {
            const int idx = (tq * 16 + i) * 128 + c; const size_t gi = (size_t)(t0 + tq * 16 + i) * LRU_W + ch;
            const float Pl = LA[idx], hl = XU[idx];
            ((unsigned*)hloc)[gi] = pack2(hl + Pl * cin, Pl * pin);
        }
        if (tq == 3) { const float Pl = LA[63 * 128 + c], hl = XU[63 * 128 + c]; sumA[(size_t)chunk * LRU_W + ch] = Pl * pin; sumH[(size_t)chunk * LRU_W + ch] = hl + Pl * cin; }
    }
    __syncthreads();
}

__device__ __forceinline__ void moe_prefix(const int* cntb_, int G, unsigned char* lds, int tid) {
    int* tmp = (int*)lds; int* ctot = (int*)(lds + LDS_MISC + M_CTOT); int* coff = (int*)(lds + LDS_MISC + M_COFF);
    unsigned short* pre16 = (unsigned short*)(lds + LDS_MISC + M_PRE16);
    const int e = tid & 31, part = tid >> 5, PB = (G + 15) / 16;
    int sm = 0;
    for (int i = 0; i < PB; ++i) { const int b = part * PB + i; if (b < G) sm += cntb_[b * 32 + e]; }
    tmp[part * 32 + e] = sm;
    __syncthreads();
    int run = 0;
    for (int q = 0; q < part; ++q) run += tmp[q * 32 + e];
    for (int i = 0; i < PB; ++i) { const int b = part * PB + i; if (b < G) { pre16[e * 257 + b] = (unsigned short)run; run += cntb_[b * 32 + e]; } }
    if (part == 15) { ctot[e] = run; pre16[e * 257 + G] = (unsigned short)run; }
    __syncthreads();
    if (tid == 0) { int o = 0; for (int q = 0; q < 32; ++q) { coff[q] = o; o += ctot[q]; } coff[32] = o; }
    __syncthreads();
}
__device__ __forceinline__ void moe_rowtable(const int* ltok_, const float* lw_, const int* lslot_, int e, int m0, int c_e, int G, int segcap, unsigned char* lds, int tid_in) {
    int tid = tid_in; OPAQUE(tid);
    const unsigned short* pre = (const unsigned short*)(lds + LDS_MISC + M_PRE16) + e * 257;
    int* rtok = (int*)(lds + LDS_MISC + M_RTOK); float* rw = (float*)(lds + LDS_MISC + M_RW); int* rslot = (int*)(lds + LDS_MISC + M_RSLOT);
    if (tid < 256) {
        const int g = m0 + tid;
        int tk = 0, sl = 0; float w = 0.f;
        if (g < c_e) {
            int lo = 0, hi = G;
            while (hi - lo > 1) { const int mid = (lo + hi) >> 1; if ((int)pre[mid] <= g) lo = mid; else hi = mid; }
            const int idx = (e * G + lo) * segcap + (g - (int)pre[lo]);
            tk = ltok_[idx]; w = lw_[idx]; sl = lslot_[idx];
        }
        rtok[tid] = tk; rw[tid] = w; rslot[tid] = sl;
    }
    __syncthreads();
}
#define kmax2 ((float*)(wsl + A_KMAX))
#define dpo ((bf16_t*)(wsl + A_DPO))
#define dpml ((float*)(wsl + A_DPML))
#define cntb ((int*)(wsl + A_CNTB))
#define WinT ((bf16_t*)(wsl + WB_WIN))
#define WoT ((bf16_t*)(wsl + WB_WO))
#define WguT ((bf16_t*)(wsl + WB_WGU))
#define WdT ((bf16_t*)(wsl + WB_WD))
#define WaiT ((bf16_t*)(wsl + WB_WAI))
#define Wfa ((float*)(wsl + WF_FA))
#define W36b ((bf16_t*)(wsl + WF_R36))
#define ropecs ((float*)(wsl + WF_ROPE))
#define xb ((bf16_t*)(wsl + A_XB))
#define hb ((float*)(wsl + A_HB))
#define logf_ ((float*)(wsl + A_LOGF))
#define cum2 ((float*)(wsl + A_CUM))
#define Qa ((bf16_t*)(wsl + A_QA))
#define Ka ((bf16_t*)(wsl + A_KA))
#define VaT ((bf16_t*)(wsl + A_VAT))
#define Xr ((bf16_t*)(wsl + A_XR))
#define Gr ((bf16_t*)(wsl + A_GR))
#define Qc ((bf16_t*)(wsl + A_QC))
#define Kc ((bf16_t*)(wsl + A_KC))
#define VcT ((bf16_t*)(wsl + A_VCT))
#define hloc ((float*)(wsl + A_HLOC))
#define ploc ((float*)(wsl + A_PLOC))
#define sumA ((float*)(wsl + A_SUMA))
#define sumH ((float*)(wsl + A_SUMH))
#define concat ((bf16_t*)(wsl + A_CONCAT))
#define y1 ((float*)(wsl + A_Y1))
#define h1 ((float*)(wsl + A_H1))
#define h1b ((bf16_t*)(wsl + A_H1B))
#define ltok ((int*)(wsl + A_LTOK))
#define lw ((float*)(wsl + A_LW))
#define lslot ((int*)(wsl + A_LSLOT))
#define act ((bf16_t*)(wsl + A_ACT))
#define contrib ((bf16_t*)(wsl + A_CONTRIB))
#ifndef EMU
__global__ void __launch_bounds__(NTHREADS, 2)
#else
void
#endif
fwd_kernel(Params p) {
    DYN_LDS(lds_raw);
    float* ldsf = (float*)lds_raw;
    const int bid = blockIdx.x, G = gridDim.x;
    const int gthreads = G * NTHREADS, gwaves = G * (NTHREADS / 64);
    const int wave_s = RFL((int)threadIdx.x >> 6);
#define PHASE_IDS() unsigned char* wsl = ws; OPAQUE_S(wsl); int tid = wave_s * 64 + LANE_ID(); OPAQUE(tid); const int lane = tid & 63, wave = tid >> 6, gtid = bid * NTHREADS + tid, gwave = bid * (NTHREADS / 64) + wave; (void)lane; (void)wave; (void)gtid; (void)gwave

    unsigned char* ws = p.ws;
    volatile LAS unsigned* bst = (volatile LAS unsigned*)(lds_raw + LDS_MISC);
    unsigned* ubox = (unsigned*)(lds_raw + LDS_MISC + 16);
    if (threadIdx.x == 0) { bst[0] = 0u; bst[1] = 0u; bst[2] = 0u; bst[3] = 0u; }
    __syncthreads();
    XcdBarrier bar = xcd_barrier_post((unsigned*)ws, bst);

    const int* positions = (const int*)p.in[I_POS];

    constexpr int NPH = 8;
    const int lo = p.lo, hi = p.hi;
#ifdef ONLY_PHASE
#define PH_SEL(c) ((c) == ONLY_PHASE)
#else
#define PH_SEL(c) 1
#endif
#define PH_IN(k) (lo <= (k) && (k) < hi)
#define PH_BAR(k) do { if ((k) + 1 < hi) xcd_barrier(bar, wave_s == 0 && LANE_ID() == 0); } while (0)

    if (PH_SEL(-1) && PH_IN(0)) for (int rep = 0; rep < PH_REPS(-1); ++rep) {
        PHASE_IDS();
        for (int l = 0; l < DEPTH; ++l) {
            convert_mats(p.in[I_WIN] + (size_t)l * D * N_IN, 0, 1, N_IN, D, N_IN, WinT + (size_t)l * N_INP * D, 0, RmWin{}, ldsf, tid, bid, G);
            for (int t = bid; t < (D / 64) * (D / 256); t += G)
                convert_tile_v4(p.in[I_WO] + (size_t)l * D * D, D, D, (t / (D / 256)) * 64, (t % (D / 256)) * 256, WoT + (size_t)l * D * D, RmIdent{}, ldsf, tid);
            convert_mats(p.in[I_WA] + (size_t)l * 6 * 128 * 128, (size_t)128 * 128, 6, 128, 128, 128, WaiT + (size_t)l * 6 * 256 * 128, (size_t)256 * 128, RmIdent{}, ldsf, tid, bid, G);
            convert_mats(p.in[I_WI] + (size_t)l * 6 * 128 * 128, (size_t)128 * 128, 6, 128, 128, 128, WaiT + (size_t)l * 6 * 256 * 128, (size_t)256 * 128, RmOff{128}, ldsf, tid, bid, G);
        }
        for (int i = gtid; i < DEPTH * 8 * D; i += gthreads) { const int k = i % D, h = (i / D) % 8, l = i / (8 * D);
            Wfa[i] = (h < 6) ? p.in[I_WIN][(size_t)l * D * N_IN + (size_t)k * N_IN + C_FA + h] : 0.f; }
        for (int i = gtid; i < DEPTH * 48 * D; i += gthreads) { const int k = i % D, o = (i / D) % 48, l = i / (48 * D);
            const float w = (o < 4) ? p.in[I_WGRP][((size_t)l * D + k) * 4 + o] : (o < 36 ? p.in[I_WRT][((size_t)l * D + k) * 32 + (o - 4)] : 0.f);
            const bf16_t hi = f2bf(w);
            W36b[((size_t)l * 2 + 0) * 48 * D + (size_t)o * D + k] = hi; W36b[((size_t)l * 2 + 1) * 48 * D + (size_t)o * D + k] = f2bf(w - bf2f(hi)); }
        for (int i = gtid; i < S * 8; i += gthreads) { const int d = i & 7, t = i >> 3; const float ang = (float)positions[t] * p.inv_freq[d];
            ropecs[t * 16 + d] = cosf(ang); ropecs[t * 16 + 8 + d] = sinf(ang); }
        __syncthreads();
        for (int i = tid; i < 6 * D; i += NTHREADS) { const int k = i % D, h = i / D; ldsf[i] = p.in[I_WIN][(size_t)k * N_IN + C_FA + h]; }
        __syncthreads();
        for (int t0 = gwave * 2; t0 < S; t0 += gwaves * 2) {
            f32x4 v[2][8];
#pragma unroll
            for (int tk = 0; tk < 2; ++tk)
#pragma unroll
                for (int j = 0; j < 8; ++j) v[tk][j] = *(const f32x4*)(p.in[I_X] + (size_t)(t0 + tk) * D + j * 256 + lane * 4);
#pragma unroll
            for (int tk = 0; tk < 2; ++tk) {
                const int t = t0 + tk;
                float fa[6] = {0.f, 0.f, 0.f, 0.f, 0.f, 0.f};
#pragma unroll
                for (int j = 0; j < 8; ++j) {
                    const int c = j * 256 + lane * 4;
                    u32x2 o; o.x = pack2(v[tk][j][0], v[tk][j][1]); o.y = pack2(v[tk][j][2], v[tk][j][3]);
                    *(u32x2*)(xb + (size_t)t * D + c) = o;
#pragma unroll
                    for (int h = 0; h < 6; ++h) { const f32x4 w = *(const f32x4*)(ldsf + h * D + c); fa[h] += v[tk][j][0] * w[0] + v[tk][j][1] * w[1] + v[tk][j][2] * w[2] + v[tk][j][3] * w[3]; }
                    COMPILER_FENCE();
                }
#pragma unroll
                for (int h = 0; h < 6; ++h) { const float sm = wave_sum(fa[h]); if (lane == 0) logf_[h * S + t] = log_sigmoid_f(sm + p.in[I_BF][h]); }
            }
        }
        PH_BAR(0);
    }

    for (int l = 0; l < DEPTH; ++l) {
        const int pb = 1 + l * NPH;
#define hin ((l == 0) ? p.in[I_X] : (const float*)hb)
#define hout ((l == DEPTH - 1) ? p.out : hb)
#define workctr ((int*)(wsl + CTL_WORK_OFF) + l * 64)

        if (PH_SEL(0) && PH_IN(pb + 0)) {
            PHASE_IDS();
            int bz = RFL(bid); OPAQUE_S(bz);
            if (bz == 0) {
                double* part = (double*)lds_raw;
                const int per = S / 64;
                double s = 0.0;
                if (wave < 6) { for (int i = 0; i < per; ++i) s += (double)logf_[wave * S + lane * per + i]; part[wave * 64 + lane] = s; }
                __syncthreads();
                if (wave < 6) {
                    double run = 0.0;
                    for (int j = 0; j < lane; ++j) run += part[wave * 64 + j];
                    for (int i = 0; i < per; ++i) { run += (double)logf_[wave * S + lane * per + i]; cum2[wave * S + lane * per + i] = (float)(run * (double)LOG2E); }
                }
                __syncthreads();
            }
            bool conv_more = (l == 0);
#define CONV_ONE() do { if (conv_more) { __syncthreads(); if (tid == 0) *ubox = (unsigned)atomic_add_int((int*)(wsl + CTL_WORK_OFF) + 62, 1); __syncthreads(); \
                const int cid_ = RFL((int)*ubox); if (cid_ < NCONV) moe_conv_chunk(p, cid_, WguT, WdT, ldsf, tid); else conv_more = false; } } while (0)
            unsigned* cls = (unsigned*)(wsl + CTL_CLS_OFF) + l * 256;
            if (bz == 0) { WAIT_VM0(); __syncthreads(); if (tid == 0) { FENCE_REL_AGENT(); WAIT_VM0(); (void)xb_add(&cls[192], 1u); } }
            const bf16_t* Bt = WinT + (size_t)l * N_INP * D;
            constexpr int ntm = S / 256;
            const unsigned nooff[2][2] = {{0u, 0u}, {0u, 0u}};
            for (int i = 0; i < (bid & 3); ++i) CONV_ONE();
            for (;;) {
                __syncthreads();
                if (tid == 0) *ubox = (unsigned)atomic_add_int(workctr + 9, 1);
                __syncthreads();
                int t = RFL((int)*ubox);
                if (t >= ntm * 21) break;
                int pm, pn, kcls;
                if (t < ntm * 6) { pm = t / 6; pn = 15 + t % 6; kcls = 0; }
                else if (t < ntm * 12) { t -= ntm * 6; pm = t / 6; pn = 9 + t % 6; kcls = 1; }
                else { t -= ntm * 12; pm = t / 9; pn = t % 9; kcls = 2; }
                f32x4 acc[2][2][4][2];
                gemm_tile<false>(xb, pm * 256, nooff, Bt, pn * 256, D, lds_raw, acc, tid);
                int et = tid; OPAQUE(et); const int wr = et >> 8, wc = (et >> 6) & 3, fr = et & 15, fq = (et >> 4) & 3;
                if (pn < 6 || (pn >= 9 && pn < 19)) {
                    bf16_t* dst; float scale = 1.f; bool rope = false;
                    if (pn < 3) { dst = Qa; scale = QSCALE_A; } else if (pn < 6) { dst = Ka; } else if (pn < 12) { dst = Xr; } else if (pn < 15) { dst = Gr; }
                    else if (pn < 17) { dst = Qc; scale = QSCALE_C; rope = true; } else { dst = Kc; rope = true; }
                    const bool headmajor = (pn < 6) || (pn >= 15);
                    const int segpn = (pn < 3) ? pn : (pn < 6) ? pn - 3 : (pn < 12) ? pn - 9 : (pn < 15) ? pn - 12 : (pn < 17) ? pn - 15 : pn - 17;
#pragma unroll
                    for (int ai = 0; ai < 2; ++ai)
#pragma unroll
                        for (int m = 0; m < 4; ++m)
#pragma unroll
                            for (int bj = 0; bj < 2; ++bj)
#pragma unroll
                                for (int n = 0; n < 2; ++n) {
                                    const int dd = wc * 32 + n * 16 + fr;
#pragma unroll
                                    for (int j = 0; j < 4; ++j) {
                                        const int row = pm * 256 + ai * 128 + wr * 64 + m * 16 + fq * 4 + j;
                                        float v = acc[ai][bj][m][n][j];
                                        if (rope && n == 0 && (wc & 1) == 0) {
                                            const float pv = SHX(v, 8);
                                            const float cs = ropecs[row * 16 + (fr & 7)], sn = ropecs[row * 16 + 8 + (fr & 7)];
                                            v = (fr < 8) ? (v * cs - pv * sn) : (v * cs + pv * sn);
                                        }
                                        v *= scale;
                                        *(bf16_t*)(lds_raw + (ai * 128 + wr * 64 + m * 16 + fq * 4 + j) * 528 + (bj * 128 + dd) * 2) = f2bf(v);
                                    }
                                }
                    __syncthreads();
#pragma unroll 4
                    for (int i = 0; i < 16; ++i) {
                        const int idx = et + i * 512, lrow = idx >> 5, ch = idx & 31, row = pm * 256 + lrow;
                        const u32x4 val = *(const u32x4*)(lds_raw + lrow * 528 + ch * 16);
                        size_t gi;
                        if (headmajor) gi = ((size_t)(segpn * 2 + (ch >> 4)) * S + row) * 128 + (ch & 15) * 8;
                        else gi = (size_t)row * LRU_W + segpn * 256 + ch * 8;
                        *(u32x4*)(dst + gi) = val;
                    }
                    __syncthreads();
                    if (pn >= 15) {
                        float* part = ldsf;
#pragma unroll
                        for (int ai = 0; ai < 2; ++ai)
#pragma unroll
                            for (int m = 0; m < 4; ++m)
#pragma unroll
                                for (int bj = 0; bj < 2; ++bj)
#pragma unroll
                                    for (int j = 0; j < 4; ++j) {
                                        float ss = acc[ai][bj][m][0][j] * acc[ai][bj][m][0][j] + acc[ai][bj][m][1][j] * acc[ai][bj][m][1][j];
                                        ss += SHX(ss, 1); ss += SHX(ss, 2); ss += SHX(ss, 4); ss += SHX(ss, 8);
                                        if (fr == 0) part[(wc * 2 + bj) * 256 + ai * 128 + wr * 64 + m * 16 + fq * 4 + j] = ss;
                                    }
                        __syncthreads();
                        {
                            const int bj = et >> 8, row = et & 255;
                            float v0 = part[(0 * 2 + bj) * 256 + row] + part[(1 * 2 + bj) * 256 + row], v1 = part[(2 * 2 + bj) * 256 + row] + part[(3 * 2 + bj) * 256 + row];
                            v0 = fmaxf(v0, SHX(v0, 1)); v0 = fmaxf(v0, SHX(v0, 2)); v0 = fmaxf(v0, SHX(v0, 4)); v0 = fmaxf(v0, SHX(v0, 8)); v0 = xrow16_max(v0);
                            v1 = fmaxf(v1, SHX(v1, 1)); v1 = fmaxf(v1, SHX(v1, 2)); v1 = fmaxf(v1, SHX(v1, 4)); v1 = fmaxf(v1, SHX(v1, 8)); v1 = xrow16_max(v1);
                            if ((et & 63) == 0) {
                                unsigned* q2p = (unsigned*)(wsl + CTL_QK2_OFF) + l * 16 + (pn >= 17 ? 8 : 0) + (segpn * 2 + bj) * 2;
                                atomic_max_u32(q2p, __builtin_bit_cast(unsigned, v0)); atomic_max_u32(q2p + 1, __builtin_bit_cast(unsigned, v1));
                            }
                        }
                        __syncthreads();
                    }
                    if (pn >= 3 && pn < 6) {
                        float* part = ldsf;
#pragma unroll
                        for (int ai = 0; ai < 2; ++ai)
#pragma unroll
                            for (int m = 0; m < 4; ++m)
#pragma unroll
                                for (int bj = 0; bj < 2; ++bj)
#pragma unroll
                                    for (int j = 0; j < 4; ++j) {
                                        float ss = acc[ai][bj][m][0][j] * acc[ai][bj][m][0][j] + acc[ai][bj][m][1][j] * acc[ai][bj][m][1][j];
                                        ss += SHX(ss, 1); ss += SHX(ss, 2); ss += SHX(ss, 4); ss += SHX(ss, 8);
                                        if (fr == 0) part[(wc * 2 + bj) * 256 + ai * 128 + wr * 64 + m * 16 + fq * 4 + j] = ss;
                                    }
                        __syncthreads();
                        {
                            const int bj = et >> 8, row = et & 255;
                            float v = part[(0 * 2 + bj) * 256 + row] + part[(1 * 2 + bj) * 256 + row] + part[(2 * 2 + bj) * 256 + row] + part[(3 * 2 + bj) * 256 + row];
                            v = fmaxf(v, SHX(v, 1)); v = fmaxf(v, SHX(v, 2)); v = fmaxf(v, SHX(v, 4)); v = fmaxf(v, SHX(v, 8)); v = xrow16_max(v);
                            if ((et & 63) == 0) kmax2[((pn - 3) * 2 + bj) * NKT + pm * 4 + ((et >> 6) & 3)] = v;
                        }
                        __syncthreads();
                    }
                } else {
                    bf16_t* dst = (pn < 9) ? VaT : VcT;
                    const int segpn = (pn < 9) ? pn - 6 : pn - 19;
#pragma unroll
                    for (int ai = 0; ai < 2; ++ai)
#pragma unroll
                        for (int m = 0; m < 4; ++m)
#pragma unroll
                            for (int bj = 0; bj < 2; ++bj)
#pragma unroll
                                for (int n = 0; n < 2; ++n) {
                                    const int dd = wc * 32 + n * 16 + fr;
                                    const f32x4 a = acc[ai][bj][m][n];
                                    u32x2 o; o.x = pack2(a[0], a[1]); o.y = pack2(a[2], a[3]);
                                    const int s6 = m * 16 + fq * 4, pos = (s6 & 32) + ((s6 >> 2) & 3) * 8 + ((s6 >> 4) & 1) * 4;
                                    *(u32x2*)(lds_raw + ((bj * 4 + ai * 2 + wr) * 128 + dd) * 128 + ((((pos >> 3) ^ (dd & 7))) << 4) + (pos & 7) * 2) = o;
                                }
                    __syncthreads();
#pragma unroll 4
                    for (int i = 0; i < 16; ++i) {
                        const int idx = et + i * 512, blk = idx >> 10, dd = (idx >> 3) & 127, c = idx & 7;
                        const u32x4 val = *(const u32x4*)(lds_raw + (blk * 128 + dd) * 128 + ((c ^ (dd & 7)) << 4));
                        *(u32x4*)(dst + (((size_t)(segpn * 2 + (blk >> 2)) * NKT + (pm * 4 + (blk & 3))) * 128 + dd) * 64 + c * 8) = val;
                    }
                    __syncthreads();
                }
                WAIT_VM0();
                __syncthreads();
                if (et == 0) { FENCE_REL_AGENT(); WAIT_VM0(); (void)xb_add(&cls[kcls * 64], 1u); }
                CONV_ONE();
            }
        }

        if (PH_SEL(1) && PH_IN(pb + 1)) {
            PHASE_IDS();
            const float lam_init = (l == 0) ? 0.2f : 0.35550906759f;
            const float s1 = wave_sum(p.in[I_LQ1][l * 64 + lane] * p.in[I_LK1][l * 64 + lane]);
            const float s2 = wave_sum(p.in[I_LQ2][l * 64 + lane] * p.in[I_LK2][l * 64 + lane]);
            const float lam = fexp(s1) - fexp(s2) + lam_init;
            constexpr int NLRU = NKT * 6, NQB = S / 128;
            bool conv_more = (l == 0);
            unsigned* cls = (unsigned*)(wsl + CTL_CLS_OFF) + l * 256;
            unsigned* bw = (unsigned*)wsl;
#define WAIT_CLASS(k, n) do { __syncthreads(); if (tid == 0) { XB_SPIN(xb_ld(&cls[(k) * 64]) < (unsigned)(n), bw); FENCE_ACQ_AGENT(); WAIT_VM0(); } __syncthreads(); } while (0)
#ifndef NO_DIFF
            {
                constexpr int NQB2 = S / 256;
                int total = 0;
                for (int q = 0; q < NQB2; ++q) total += ((4 * q + 4 + DCH - 1) / DCH) * 8;
                WAIT_CLASS(0, (S / 256) * 6);
                for (;;) {
                    __syncthreads();
                    if (tid == 0) *ubox = (unsigned)atomic_add_int(workctr, 1);
                    __syncthreads();
                    int u = RFL((int)*ubox);
                    if (u >= total) break;
                    int qb = NQB2 - 1;
                    for (;; --qb) { const int nu = ((4 * qb + 4 + DCH - 1) / DCH) * 8; if (u < nu) break; u -= nu; }
                    const int c = u >> 3, h = (u >> 1) & 3, mp = u & 1;
                    const int t0 = c * DCH, t1 = (t0 + DCH < 4 * qb + 4) ? t0 + DCH : 4 * qb + 4;
                    const unsigned* q2p = (const unsigned*)(wsl + CTL_QK2_OFF) + l * 16;
                    const float bnd = sqrtf(__builtin_bit_cast(float, q2p[h * 2 + mp]) * __builtin_bit_cast(float, q2p[8 + h * 2 + mp])) * (QSCALE_C * 1.02f) + 0.01f;
                    attn_dmap_unit(Qc + (size_t)h * S * 128, Kc + (size_t)h * S * 128, VcT + (size_t)h * S * 128, mp, qb, t0, t1,
                                   dpo + (size_t)(h * 2 + mp) * DPART_ROWS * 128, dpml + (size_t)(h * 2 + mp) * DPART_ROWS * 2, c, RFL_F(bnd), lds_raw, tid);
                    CONV_ONE();
                }
            }
#endif
#ifndef NO_LRU
            WAIT_CLASS(1, (S / 256) * 6);
            for (;;) {
                __syncthreads();
                if (tid == 0) *ubox = (unsigned)atomic_add_int(workctr + 10, 1);
                __syncthreads();
                const int u = RFL((int)*ubox);
                if (u >= NLRU) break;
                lru_unit_a(u / 6, u % 6, l, p, Xr, WaiT + (size_t)l * 6 * 256 * 128, hloc, ploc, sumA, sumH, lds_raw, tid);
            }
#endif
#ifndef NO_FOX
            WAIT_CLASS(2, (S / 256) * 9);
            WAIT_CLASS(3, 1);
            for (;;) {
                __syncthreads();
                if (tid == 0) *ubox = (unsigned)atomic_add_int(workctr + 1, 1);
                __syncthreads();
                const int u = RFL((int)*ubox);
                if (u >= NQB * FOX_H) break;
                const int qb = NQB - 1 - u / FOX_H, h = u % FOX_H;
                attn_unit<0>(Qa + (size_t)h * S * 128, Ka + (size_t)h * S * 128, VaT + (size_t)h * S * 128, cum2 + (size_t)h * S, kmax2 + h * NKT, qb, concat, h * 128,
                             0.f, 0.f, nullptr, lds_raw, tid);
            }
#endif
            while (conv_more) CONV_ONE();
            PH_BAR(pb + 1);
        }

        if (PH_SEL(2) && PH_IN(pb + 2)) for (int rep = 0; rep < PH_REPS(2); ++rep) {
            PHASE_IDS();
            {
                const int per = (NKT * 6 + G - 1) / G;
                const int c = tid & 127, tq = tid >> 7;
                float cr = 0.f; int pgrp = -1;
                for (int u = bid * per; u < (bid + 1) * per && u < NKT * 6; ++u) {
                    const int grp = u / NKT, chunk = u % NKT, ch = grp * 128 + c;
                    if (grp != pgrp) {
                        pgrp = grp;
                        const int seg = (chunk + 3) >> 2, j0 = tq * seg, j1 = (j0 + seg < chunk) ? j0 + seg : chunk;
                        float pa = 1.f, ph = 0.f;
                        int j = j0;
                        for (; j + 16 <= j1; j += 16) {
                            float a8[16], h8[16];
#pragma unroll
                            for (int q = 0; q < 16; ++q) { a8[q] = sumA[(size_t)(j + q) * LRU_W + ch]; h8[q] = sumH[(size_t)(j + q) * LRU_W + ch]; }
#pragma unroll
                            for (int q = 0; q < 16; ++q) { pa *= a8[q]; ph = a8[q] * ph + h8[q]; }
                        }
                        for (; j < j1; ++j) { const float a = sumA[(size_t)j * LRU_W + ch]; pa *= a; ph = a * ph + sumH[(size_t)j * LRU_W + ch]; }
                        __syncthreads();
                        ldsf[(tq * 128 + c) * 2] = pa; ldsf[(tq * 128 + c) * 2 + 1] = ph;
                        __syncthreads();
                        cr = 0.f;
#pragma unroll
                        for (int s = 0; s < 4; ++s) cr = ldsf[(s * 128 + c) * 2] * cr + ldsf[(s * 128 + c) * 2 + 1];
                    }
                    float hl[16], pl[16]; bf16_t gg[16];
#pragma unroll
                    for (int i = 0; i < 16; ++i) { const size_t gi = (size_t)(chunk * 64 + tq * 16 + i) * LRU_W + ch; const unsigned hp = ((const unsigned*)hloc)[gi]; hl[i] = bf2f((bf16_t)(hp & 0xffffu)); pl[i] = bf2f((bf16_t)(hp >> 16)); gg[i] = Gr[gi]; }
                    const float an = sumA[(size_t)chunk * LRU_W + ch], hn = sumH[(size_t)chunk * LRU_W + ch];
#pragma unroll
                    for (int i = 0; i < 16; ++i)
                        concat[(size_t)(chunk * 64 + tq * 16 + i) * D + FOX_W + ch] = f2bf(gelu_tanh_f(bf2f(gg[i])) * (hl[i] + pl[i] * cr));
                    cr = an * cr + hn;
                }
            }
            {
                const float lam_init = (l == 0) ? 0.2f : 0.35550906759f;
                const float s1 = wave_sum(p.in[I_LQ1][l * 64 + lane] * p.in[I_LK1][l * 64 + lane]);
                const float s2 = wave_sum(p.in[I_LQ2][l * 64 + lane] * p.in[I_LK2][l * 64 + lane]);
                const float lam = fexp(s1) - fexp(s2) + lam_init;
                const float* sg = p.in[I_SUBG] + l * 128;
                const float g0 = sg[2 * lane], g1 = sg[2 * lane + 1];
                static_assert(NCH <= 8, "the merge below keeps one (map, chunk) pair per lane: 2 x 8 lanes");
                for (int q = gwave; q < S; q += gwaves) {
                    const int nch = (q >> 6) / DCH + 1;
                    float mv = -INFINITY, lv = 0.f;
                    { const int c = lane & 7, hm = lane >> 3;
                      if (c < nch) { const float* ML = dpml + ((size_t)hm * DPART_ROWS + dpart_row(c, q)) * 2; mv = ML[0]; lv = ML[1]; } }
                    unsigned pk[4][2][NCH];
#pragma unroll
                    for (int h = 0; h < 4; ++h)
#pragma unroll
                        for (int mp = 0; mp < 2; ++mp) {
                            const unsigned* OP = (const unsigned*)(dpo + (size_t)(h * 2 + mp) * DPART_ROWS * 128);
#pragma unroll
                            for (int c = 0; c < NCH; ++c) pk[h][mp][c] = (c < nch) ? OP[(size_t)dpart_row(c, q) * 64 + lane] : 0u;
                        }
                    float Mx = mv; Mx = fmaxf(Mx, DPP_X1(Mx)); Mx = fmaxf(Mx, DPP_X2(Mx)); Mx = fmaxf(Mx, DPP_X7(Mx));
                    const float wv = (mv == -INFINITY) ? 0.f : FAST_EXP2(mv - Mx);
                    float Lp = lv * wv; Lp += DPP_X1(Lp); Lp += DPP_X2(Lp); Lp += DPP_X7(Lp);
#pragma unroll
                    for (int h = 0; h < 4; ++h) {
                        float om[2][2];
#pragma unroll
                        for (int mp = 0; mp < 2; ++mp) {
                            float o0 = 0.f, o1 = 0.f;
#pragma unroll
                            for (int c = 0; c < NCH; ++c) { const float w = RDLANE(wv, (h * 2 + mp) * 8 + c); o0 += bf2f((bf16_t)(pk[h][mp][c] & 0xffffu)) * w; o1 += bf2f((bf16_t)(pk[h][mp][c] >> 16)) * w; }
                            const float il = 1.f / RDLANE(Lp, (h * 2 + mp) * 8);
                            om[mp][0] = o0 * il; om[mp][1] = o1 * il;
                        }
                        const float v0 = om[0][0] - lam * om[1][0], v1 = om[0][1] - lam * om[1][1];
                        const float ss = wave_sum(v0 * v0 + v1 * v1);
                        const float rs = (1.f - lam_init) / sqrtf(ss * (1.f / 128.f) + LN_EPS);
                        *(unsigned*)(concat + (size_t)q * D + 1536 + h * 128 + 2 * lane) = pack2(v0 * rs * g0, v1 * rs * g1);
                    }
                }
            }
            PH_BAR(pb + 2);
        }

        if (PH_SEL(3) && PH_IN(pb + 3)) {
            PHASE_IDS();
            const bf16_t* Bt = WoT + (size_t)l * D * D;
            constexpr int ntn = D / 256, ntm = S / 256;
            static_assert(ntn == 8, "the panel exchange is written for 8 column tiles");
            const unsigned nooff[2][2] = {{0u, 0u}, {0u, 0u}};
            const float* g1 = p.in[I_LN1G] + (size_t)l * D; const float* b1 = p.in[I_LN1B] + (size_t)l * D;
            const float* bg = p.in[I_BGRP] + l * 4; const float* br = p.in[I_BRT] + l * 32;
            const bf16_t* Wb = W36b + (size_t)l * 2 * 48 * D;
            int* lcnt = (int*)(lds_raw + LDS_MISC + M_LCNT);
            const int segcap = ((ntm * ntn + G - 1) / G) * 32;
            unsigned* pcnt = (unsigned*)(wsl + CTL_PAN_OFF) + l * 1024;
            unsigned long long* xbuf = (unsigned long long*)(wsl + A_XBUF);
            unsigned* part = (unsigned*)(wsl + A_PART);
            LAS float* Stab = (LAS float*)(lds_raw + LDS_MISC + M_RTOK);
            float* lgt = (float*)(lds_raw + LDS_MISC + 4096);
            if (tid < 32) lcnt[tid] = 0;
            __syncthreads();
            for (int t0 = bid; t0 < ntm * ntn; t0 += G) {
                int t = t0;
                if (G == 256 && ntm * ntn == 256) { const int x = t0 & 7, j = t0 >> 3; t = (x * 4 + (j >> 3)) * ntn + (j & 7); }
                const int pm = t / ntn, pn = t % ntn;
                f32x4 v[2][16];
                {
                    f32x4 acc[2][2][4][2];
                    gemm_tile<false>(concat, pm * 256, nooff, Bt, pn * 256, D, lds_raw, acc, tid);
                    int et = tid; OPAQUE(et); const int wr = et >> 8, wc = (et >> 6) & 3, fr = et & 15, fq = (et >> 4) & 3;
#pragma unroll
                    for (int ai = 0; ai < 2; ++ai) {
#pragma unroll
                        for (int m = 0; m < 4; ++m)
#pragma unroll
                            for (int bj = 0; bj < 2; ++bj)
#pragma unroll
                                for (int n = 0; n < 2; ++n)
#pragma unroll
                                    for (int j = 0; j < 4; ++j)
                                        *(float*)(lds_raw + (wr * 64 + m * 16 + fq * 4 + j) * 1040 + (bj * 128 + wc * 32 + n * 16 + fr) * 4) = acc[ai][bj][m][n][j];
                        __syncthreads();
#pragma unroll
                        for (int i = 0; i < 16; ++i) {
                            const int lrow = i * 8 + (et >> 6), c4 = et & 63;
                            const size_t gi = (size_t)(pm * 256 + ai * 128 + lrow) * D + pn * 256 + c4 * 4;
                            v[ai][i] = *(const GAS f32x4*)(hin + gi);
                        }
#pragma unroll
                        for (int i = 0; i < 16; ++i) {
                            const int lrow = i * 8 + (et >> 6), c4 = et & 63;
                            v[ai][i] = ALPHA * v[ai][i] + *(const f32x4*)(lds_raw + lrow * 1040 + c4 * 16);
                        }
                        __syncthreads();
                    }
                }
                int et2 = tid; OPAQUE(et2); const int el = et2 & 63, ew = wave_s, er16 = et2 & 15, eq4 = (et2 >> 4) & 3;
#pragma unroll
                for (int q = 0; q < 6; ++q) {
                    const int seg = ew * 6 + q, n2 = seg * 2 + (el >> 5), p5 = el & 31;
                    GLDS16(Wb + (size_t)n2 * D + pn * 256 + ((p5 ^ (n2 & 15)) << 3), lds_raw + 65536 + seg * 1024 + el * 16);
                }
                float my_mt = 0.f, my_m2 = 0.f;
                for (int trep = 0; trep < REP_STATS; ++trep)
#pragma unroll
                for (int ai = 0; ai < 2; ++ai)
#pragma unroll
                    for (int i4 = 0; i4 < 16; i4 += 4) {
                        float mt4[4], m24[4];
#pragma unroll
                        for (int u = 0; u < 4; ++u) { const f32x4 x = v[ai][i4 + u]; mt4[u] = wave_sum((x[0] + x[1]) + (x[2] + x[3])) * (1.f / 256.f); }
#pragma unroll
                        for (int u = 0; u < 4; ++u) { const f32x4 d = v[ai][i4 + u] - mt4[u]; m24[u] = wave_sum((d[0] * d[0] + d[1] * d[1]) + (d[2] * d[2] + d[3] * d[3])); }
#pragma unroll
                        for (int u = 0; u < 4; ++u) if (el == ai * 16 + i4 + u) { my_mt = mt4[u]; my_m2 = m24[u]; }
                        COMPILER_FENCE();
                    }
                unsigned* bw = (unsigned*)wsl;
                if (el < 32) {
                    const int grow = (el >> 4) * 128 + (el & 15) * 8 + ew;
                    xst64(&xbuf[(size_t)(pm * 256 + grow) * 8 + pn], ((unsigned long long)__builtin_bit_cast(unsigned, my_m2) << 32) | __builtin_bit_cast(unsigned, my_mt));
                }
                WAIT_VM0();
                __syncthreads();
                if (et2 == 0) { (void)xb_add(&pcnt[pm * 16], 1u); XB_SPIN(xb_ld(&pcnt[pm * 16]) < 8u, bw); FENCE_ACQ_AGENT(); }
                __syncthreads();
                unsigned long long wk[4];
#pragma unroll
                for (int k = 0; k < 4; ++k) {
                    const int r = k * 8 + (el >> 3), grow = (r >> 4) * 128 + (r & 15) * 8 + ew;
                    wk[k] = xld64(&xbuf[(size_t)(pm * 256 + grow) * 8 + (el & 7)]);
                }
#pragma unroll
                for (int k = 0; k < 4; ++k) {
                    const int r = k * 8 + (el >> 3);
                    const unsigned long long w = wk[k];
                    const float mt = __builtin_bit_cast(float, (unsigned)w), m2 = __builtin_bit_cast(float, (unsigned)(w >> 32));
                    float ms = mt; ms += DPP_X1(ms); ms += DPP_X2(ms); ms += DPP_X7(ms);
                    const float mean = ms * 0.125f, dm = mt - mean;
                    float q = m2 + 256.f * dm * dm; q += DPP_X1(q); q += DPP_X2(q); q += DPP_X7(q);
                    const float rstd = 1.f / sqrtf(q * (1.f / D) + LN_EPS);
                    if ((el & 7) == 0) { Stab[(ew * 32 + r) * 2] = mean; Stab[(ew * 32 + r) * 2 + 1] = rstd; }
                }
                WAVE_SYNC();
                const f32x4 gv = *(const f32x4*)(g1 + pn * 256 + el * 4), bv = *(const f32x4*)(b1 + pn * 256 + el * 4);
                LAS unsigned char* wt = (LAS unsigned char*)lds_raw + ew * 8192;
                const LAS unsigned char* wbl = (const LAS unsigned char*)lds_raw + 65536;
                for (int rrep = 0; rrep < REP_ROUTER; ++rrep)
#pragma unroll
                for (int ai = 0; ai < 2; ++ai) {
                    u32x2 lokeep[16];
#pragma unroll
                    for (int i = 0; i < 16; ++i) {
                        const float mean = Stab[(ew * 32 + ai * 16 + i) * 2], rstd = Stab[(ew * 32 + ai * 16 + i) * 2 + 1];
                        const f32x4 hv = mul_s4(v[ai][i] - mean, rstd) * gv + bv;
                        u32x2 o; o.x = pack2(hv[0], hv[1]); o.y = pack2(hv[2], hv[3]);
                        lokeep[i].x = pack2(hv[0] - bf2f((bf16_t)(o.x & 0xffffu)), hv[1] - bf2f((bf16_t)(o.x >> 16)));
                        lokeep[i].y = pack2(hv[2] - bf2f((bf16_t)(o.y & 0xffffu)), hv[3] - bf2f((bf16_t)(o.y >> 16)));
                        *(LAS u32x2*)(wt + i * 512 + (((el >> 1) ^ i) << 4) + (el & 1) * 8) = o;
                        COMPILER_FENCE();
                    }
                    WAVE_SYNC();
                    f32x4 ac[3];
#pragma unroll
                    for (int nt = 0; nt < 3; ++nt) ac[nt] = (f32x4){0.f, 0.f, 0.f, 0.f};
#pragma unroll 2
                    for (int ks = 0; ks < 8; ++ks) {
                        const int co = ((ks * 4 + eq4) ^ er16) << 4;
                        const bf16x8 ah = *(const LAS bf16x8*)(wt + er16 * 512 + co);
#pragma unroll
                        for (int nt = 0; nt < 3; ++nt) {
                            const bf16x8 bh = *(const LAS bf16x8*)(wbl + (nt * 16 + er16) * 512 + co);
                            const bf16x8 bl = *(const LAS bf16x8*)(wbl + (48 + nt * 16 + er16) * 512 + co);
                            ac[nt] = MFMA16(ah, bh, ac[nt]); ac[nt] = MFMA16(ah, bl, ac[nt]);
                        }
                    }
                    WAVE_SYNC();
#pragma unroll
                    for (int i = 0; i < 16; ++i) *(LAS u32x2*)(wt + i * 512 + (((el >> 1) ^ i) << 4) + (el & 1) * 8) = lokeep[i];
                    WAVE_SYNC();
#pragma unroll 2
                    for (int ks = 0; ks < 8; ++ks) {
                        const int co = ((ks * 4 + eq4) ^ er16) << 4;
                        const bf16x8 al = *(const LAS bf16x8*)(wt + er16 * 512 + co);
#pragma unroll
                        for (int nt = 0; nt < 3; ++nt) {
                            const bf16x8 bh = *(const LAS bf16x8*)(wbl + (nt * 16 + er16) * 512 + co);
                            ac[nt] = MFMA16(al, bh, ac[nt]);
                        }
                    }
#pragma unroll
                    for (int nt = 0; nt < 3; ++nt)
#pragma unroll
                        for (int j = 0; j < 4; ++j) {
                            const float cv = ac[nt][j];
                            xst32(&part[((size_t)pn * S + pm * 256 + ai * 128 + (eq4 * 4 + j) * 8 + ew) * 48 + nt * 16 + er16], __builtin_bit_cast(unsigned, cv));
                        }
                    WAVE_SYNC();
                }
                WAIT_VM0();
                __syncthreads();
                if (et2 == 0) (void)xb_add(&pcnt[512 + pm * 16], 1u);
                for (int srep = 0; srep < REP_STORES; ++srep)
#pragma unroll
                for (int ai = 0; ai < 2; ++ai)
#pragma unroll
                    for (int i = 0; i < 16; ++i) {
                        const float mean = Stab[(ew * 32 + ai * 16 + i) * 2], rstd = Stab[(ew * 32 + ai * 16 + i) * 2 + 1];
                        const f32x4 hv = mul_s4(v[ai][i] - mean, rstd) * gv + bv;
                        const size_t gi = (size_t)(pm * 256 + ai * 128 + i * 8 + ew) * D + pn * 256 + el * 4;
                        u32x2 o; o.x = pack2(hv[0], hv[1]); o.y = pack2(hv[2], hv[3]);
                        *(u32x2*)(h1b + gi) = o;
                        COMPILER_FENCE();
                    }
                if (et2 == 0) { XB_SPIN(xb_ld(&pcnt[512 + pm * 16]) < 8u, bw); FENCE_ACQ_AGENT(); }
                __syncthreads();
                int rt = tid; OPAQUE(rt);
#pragma unroll
                for (int k = 0; k < 3; ++k) {
                    const int idx = rt + k * 512, tk = idx / 48, n = idx - tk * 48;
                    unsigned pq[8];
#pragma unroll
                    for (int q = 0; q < 8; ++q) pq[q] = xb_ld(&part[((size_t)q * S + pm * 256 + pn * 32 + tk) * 48 + n]);
                    float a = 0.f;
#pragma unroll
                    for (int q = 0; q < 8; ++q) a += __builtin_bit_cast(float, pq[q]);
                    lgt[idx] = a;
                }
                __syncthreads();
                if (rt < 32) {
                    const int t = pm * 256 + pn * 32 + rt; const float* L = lgt + rt * 48;
                    float gl[4];
#pragma unroll
                    for (int q = 0; q < 4; ++q) gl[q] = L[q] + bg[q];
                    int gi = 0; float gm = gl[0];
#pragma unroll
                    for (int q = 1; q < 4; ++q) if (gl[q] > gm) { gm = gl[q]; gi = q; }
                    float gs = 0.f;
#pragma unroll
                    for (int q = 0; q < 4; ++q) gs += fexp(gl[q] - gm);
                    const float gweight = 1.f / gs;
                    float E[8];
#pragma unroll
                    for (int e = 0; e < 8; ++e) E[e] = L[4 + gi * 8 + e] + br[gi * 8 + e];
                    int e1 = 0; float m1 = E[0];
#pragma unroll
                    for (int e = 1; e < 8; ++e) if (E[e] > m1) { m1 = E[e]; e1 = e; }
                    int e2 = -1; float m2 = -INFINITY;
#pragma unroll
                    for (int e = 0; e < 8; ++e) if (e != e1 && E[e] > m2) { m2 = E[e]; e2 = e; }
                    const float p2 = fexp(m2 - m1), w1 = 1.f / (1.f + p2), w2 = p2 / (1.f + p2);
                    const int ge1 = gi * 8 + e1, ge2 = gi * 8 + e2;
                    const int i1 = (ge1 * G + bid) * segcap + atomic_add_int(&lcnt[ge1], 1);
                    ltok[i1] = t; lw[i1] = gweight * w1; lslot[i1] = 0;
                    const int i2 = (ge2 * G + bid) * segcap + atomic_add_int(&lcnt[ge2], 1);
                    ltok[i2] = t; lw[i2] = gweight * w2; lslot[i2] = 1;
                }
                __syncthreads();
            }
            { int ft = tid; OPAQUE(ft); if (ft < 32) cntb[bid * 32 + ft] = lcnt[ft]; }
            PH_BAR(pb + 3);
        }

        if (PH_SEL(5) && PH_IN(pb + 5)) {
            PHASE_IDS();
            const unsigned nooff[2][2] = {{0u, 0u}, {0u, 0u}};
            const int segcap = ((S / 256 * (D / 256) + G - 1) / G) * 32;
            moe_prefix(cntb, G, lds_raw, tid);
            const int* ctot = (const int*)(lds_raw + LDS_MISC + M_CTOT); const int* coff = (const int*)(lds_raw + LDS_MISC + M_COFF);
            const int* rtok = (const int*)(lds_raw + LDS_MISC + M_RTOK); const float* rw = (const float*)(lds_raw + LDS_MISC + M_RW);
            const int* rslot = (const int*)(lds_raw + LDS_MISC + M_RSLOT);
            unsigned* done = (unsigned*)(wsl + CTL_DONE_OFF) + l * 1024;
            int* mq = (int*)(wsl + CTL_MQ_OFF) + l * 128;
            const int myx = (int)(xb_xcc_id() & 7u);
            int qi = 0;
            for (;;) {
                __syncthreads();
                if (tid == 0) {
                    unsigned r = 0xffffffffu;
                    while (qi < 8) {
                        const int xx = (myx + qi) & 7;
                        int nm = 0;
#pragma unroll
                        for (int k = 0; k < NEXP / 8; ++k) nm += (ctot[xx + 8 * k] + 255) / 256;
                        const int got = atomic_add_int(mq + xx * 16, 1);
                        if (got < nm * 12) { r = ((unsigned)xx << 24) | (unsigned)got; break; }
                        ++qi;
                    }
                    *ubox = r;
                }
                __syncthreads();
                const unsigned rr = (unsigned)RFL((int)*ubox);
                if (rr == 0xffffffffu) break;
                const int xq = (int)(rr >> 24);
                int u = (int)(rr & 0xffffffu);
                int nmt = 0;
#pragma unroll
                for (int k = 0; k < NEXP / 8; ++k) nmt += (RFL(ctot[xq + 8 * k]) + 255) / 256;
                const bool down = (u >= nmt * 4);
                const int per = down ? 8 : 4;
                if (down) u -= nmt * 4;
                int e = xq;
                for (;; e += 8) { const int nt = ((RFL(ctot[e]) + 255) / 256) * per; if (u < nt) break; u -= nt; }
                const int c = RFL(ctot[e]), off = RFL(coff[e]);
                const int mt = u / per, pn = u % per, m0 = mt * 256;
                moe_rowtable(ltok, lw, lslot, e, m0, c, G, segcap, lds_raw, tid);
                f32x4 acc[2][2][4][2];
                if (!down) {
                    const bf16_t* Bt = WguT + ((size_t)l * NEXP + e) * 1024 * D;
                    unsigned aoff[2][2];
                    int st = tid; OPAQUE(st); int R[2], C[2]; stage_geom(st, R, C);
#pragma unroll
                    for (int h = 0; h < 2; ++h)
#pragma unroll
                        for (int i = 0; i < 2; ++i) aoff[h][i] = (unsigned)(rtok[h * 128 + R[i]] * D + C[i]);
                    gemm_tile<true>(h1b, 0, aoff, Bt, pn * 256, D, lds_raw, acc, tid);
                    int et = tid; OPAQUE(et); const int wr = et >> 8, wc = (et >> 6) & 3, fr = et & 15, fq = (et >> 4) & 3;
#pragma unroll
                    for (int ai = 0; ai < 2; ++ai)
#pragma unroll
                        for (int m = 0; m < 4; ++m)
#pragma unroll
                            for (int j = 0; j < 4; ++j) {
                                const int r = ai * 128 + wr * 64 + m * 16 + fq * 4 + j;
                                const float wgt = rw[r];
#pragma unroll
                                for (int bj = 0; bj < 2; ++bj)
                                    *(bf16_t*)(lds_raw + r * 272 + (bj * 64 + wc * 16 + fr) * 2) = f2bf(silu_f(acc[ai][bj][m][0][j]) * acc[ai][bj][m][1][j] * wgt);
                            }
                    __syncthreads();
#pragma unroll 4
                    for (int i = 0; i < 8; ++i) {
                        const int idx = et + i * 512, r = idx >> 4, ch = idx & 15;
                        if (m0 + r < c) st_wt16(act + (size_t)(off + m0 + r) * DFF + pn * 128 + ch * 8, *(const u32x4*)(lds_raw + r * 272 + ch * 16));
                    }
                    WAIT_VM0();
                    __syncthreads();
                    if (et == 0) (void)xb_add(&done[e * 32 + mt], 1u);
                } else {
                    const bf16_t* Bt = WdT + ((size_t)l * NEXP + e) * D * DFF;
                    if (tid == 0) {
                        unsigned* bw = (unsigned*)wsl;
                        XB_SPIN(xb_ld(&done[e * 32 + mt]) < 4u, bw);
                        FENCE_ACQ_AGENT();
                        WAIT_VM0();
                    }
                    __syncthreads();
                    gemm_tile<false, 16>(act, off + m0, nooff, Bt, pn * 256, DFF, lds_raw, acc, tid);
                    int et = tid; OPAQUE(et); const int wr = et >> 8, wc = (et >> 6) & 3, fr = et & 15, fq = (et >> 4) & 3;
#pragma unroll
                    for (int ai = 0; ai < 2; ++ai)
#pragma unroll
                        for (int m = 0; m < 4; ++m)
#pragma unroll
                            for (int bj = 0; bj < 2; ++bj)
#pragma unroll
                                for (int n = 0; n < 2; ++n)
#pragma unroll
                                    for (int j = 0; j < 4; ++j)
                                        *(bf16_t*)(lds_raw + (ai * 128 + wr * 64 + m * 16 + fq * 4 + j) * 528 + (bj * 128 + wc * 32 + n * 16 + fr) * 2) = f2bf(acc[ai][bj][m][n][j]);
                    __syncthreads();
#pragma unroll 4
                    for (int i = 0; i < 16; ++i) {
                        const int idx = et + i * 512, r = idx >> 5, ch = idx & 31;
                        if (m0 + r < c) *(u32x4*)(contrib + ((size_t)rslot[r] * S + rtok[r]) * D + pn * 256 + ch * 8) = *(const u32x4*)(lds_raw + r * 528 + ch * 16);
                    }
                }
            }
            PH_BAR(pb + 5);
        }

        if (PH_SEL(7) && PH_IN(pb + 7)) for (int rep = 0; rep < PH_REPS(7); ++rep) {
            PHASE_IDS();
            const float* g2 = p.in[I_LN2G] + (size_t)l * D; const float* b2 = p.in[I_LN2B] + (size_t)l * D;
            const bool more = (l + 1 < DEPTH);
            f32x4 gq[8], bq[8];
#pragma unroll
            for (int j = 0; j < 8; ++j) { gq[j] = *(const f32x4*)(g2 + j * 256 + lane * 4); bq[j] = *(const f32x4*)(b2 + j * 256 + lane * 4); }
            if (more) {
                const float* wf = Wfa + (size_t)(l + 1) * 8 * D;
                __syncthreads();
                for (int i = tid; i < 6 * D / 4; i += NTHREADS) *(f32x4*)(ldsf + i * 4) = *(const f32x4*)(wf + i * 4);
                __syncthreads();
            }
            for (int t = gwave; t < S; t += gwaves) {
                f32x4 v[8]; float s = 0.f;
#pragma unroll
                for (int j = 0; j < 8; ++j) {
                    const size_t i = (size_t)t * D + j * 256 + lane * 4;
                    const u32x2 c0 = *(const u32x2*)(contrib + i), c1 = *(const u32x2*)(contrib + (size_t)S * D + i);
                    const f32x4 cs = (f32x4){bf2f((bf16_t)(c0.x & 0xffffu)) + bf2f((bf16_t)(c1.x & 0xffffu)), bf2f((bf16_t)(c0.x >> 16)) + bf2f((bf16_t)(c1.x >> 16)),
                                             bf2f((bf16_t)(c0.y & 0xffffu)) + bf2f((bf16_t)(c1.y & 0xffffu)), bf2f((bf16_t)(c0.y >> 16)) + bf2f((bf16_t)(c1.y >> 16))};
                    const u32x2 hq = *(const u32x2*)(h1b + i);
                    v[j] = ALPHA * (f32x4){bf2f((bf16_t)(hq.x & 0xffffu)), bf2f((bf16_t)(hq.x >> 16)), bf2f((bf16_t)(hq.y & 0xffffu)), bf2f((bf16_t)(hq.y >> 16))} + cs;
                    s += (v[j][0] + v[j][1]) + (v[j][2] + v[j][3]);
                }
                const float mean = wave_sum(s) * (1.f / D);
                float s2 = 0.f;
#pragma unroll
                for (int j = 0; j < 8; ++j) { v[j] -= mean; s2 += (v[j][0] * v[j][0] + v[j][1] * v[j][1]) + (v[j][2] * v[j][2] + v[j][3] * v[j][3]); }
                const float rstd = 1.f / sqrtf(wave_sum(s2) * (1.f / D) + LN_EPS);
                float fa[6] = {0.f, 0.f, 0.f, 0.f, 0.f, 0.f};
#pragma unroll
                for (int j = 0; j < 8; ++j) {
                    const int c = j * 256 + lane * 4;
                    v[j] = v[j] * rstd * gq[j] + bq[j];
                    *(f32x4*)(hout + (size_t)t * D + c) = v[j];
                    COMPILER_FENCE();
                    if (more) {
                        u32x2 o; o.x = pack2(v[j][0], v[j][1]); o.y = pack2(v[j][2], v[j][3]);
                        *(u32x2*)(xb + (size_t)t * D + c) = o;
#pragma unroll
                        for (int h = 0; h < 6; ++h) { const f32x4 w = *(const f32x4*)(ldsf + h * D + c); fa[h] += (v[j][0] * w[0] + v[j][1] * w[1]) + (v[j][2] * w[2] + v[j][3] * w[3]); }
                    }
                }
                if (more) {
#pragma unroll
                    for (int h = 0; h < 6; ++h) { const float sm = wave_sum(fa[h]); if (lane == 0) logf_[h * S + t] = log_sigmoid_f(sm + p.in[I_BF][(l + 1) * 6 + h]); }
                }
            }
            PH_BAR(pb + 7);
        }
    }
#undef PH_IN
#undef PH_BAR
}

constexpr int N_PHASES = 1 + DEPTH * 8;
#ifndef EMU
extern "C" void kernel_launch(void* const* d_in, const int* in_sizes, int n_in, void* d_out, int out_size, void* d_ws, size_t ws_size, hipStream_t stream) {
    static int grid = 0;
    if (grid == 0) {
        if (n_in != N_INPUTS || out_size != S * D || ws_size < WS_END) {
            fprintf(stderr, "kernel_launch: unexpected shapes: n_in %d out %d ws %zu (need %zu)\n", n_in, out_size, ws_size, (size_t)WS_END); grid = -1; return; }
        int dev = 0, cus = 0, per_cu = 0;
        if (hipGetDevice(&dev) != hipSuccess || hipDeviceGetAttribute(&cus, hipDeviceAttributeMultiprocessorCount, dev) != hipSuccess) { grid = -1; return; }
        if (hipFuncSetAttribute((const void*)fwd_kernel, hipFuncAttributeMaxDynamicSharedMemorySize, LDS_BYTES) != hipSuccess) { fprintf(stderr, "kernel_launch: hipFuncSetAttribute failed\n"); grid = -1; return; }
        if (hipOccupancyMaxActiveBlocksPerMultiprocessor(&per_cu, (const void*)fwd_kernel, NTHREADS, LDS_BYTES) != hipSuccess || per_cu < 1) {
            fprintf(stderr, "kernel_launch: occupancy query says %d blocks per CU\n", per_cu); (void)hipGetLastError(); grid = -1; return; }
        grid = cus;
    }
    if (grid < 0) return;
    (void)hipMemsetAsync(d_ws, 0, CTL_BYTES, stream);
    Params p{};
    for (int i = 0; i < N_INPUTS; ++i) p.in[i] = (const float*)d_in[i];
    p.out = (float*)d_out; p.ws = (unsigned char*)d_ws;
    for (int i = 0; i < 8; ++i) p.inv_freq[i] = (float)pow(500000.0, -(double)i * 2.0 / 16.0);
#if N_LAUNCH_SPLIT
    for (int k = 0; k < N_PHASES; ++k) { p.lo = k; p.hi = k + 1; hipLaunchKernelGGL(fwd_kernel, dim3(grid), dim3(NTHREADS), LDS_BYTES, stream, p); }
#else
    p.lo = 0; p.hi = N_PHASES;
    hipLaunchKernelGGL(fwd_kernel, dim3(grid), dim3(NTHREADS), LDS_BYTES, stream, p);
#endif
}
#endif
```

```cpp
#ifndef EMU
#include <hip/hip_runtime.h>
#include <cstdio>
#include <cstdint>
#include <cmath>
#endif

#ifndef SEQ
#define SEQ 8192
#endif
#ifndef N_LAUNCH_SPLIT
#define N_LAUNCH_SPLIT 0
#endif
#ifndef REP_PHASE
#define REP_PHASE -2
#endif
#define PH_REPS(c) ((c) == REP_PHASE ? 2 : 1)
#ifndef REP_SUB
#define REP_SUB 0
#endif

constexpr int S = SEQ, D = 2048, DEPTH = 2;
constexpr int FOX_H = 6, FOX_W = 768;
constexpr int LRU_W = 768;
constexpr int DIFF_H = 4, DIFF_W = 512;
constexpr int N_IN = 5382, N_INP = 5376;
constexpr int C_FA = 2304;
constexpr int NEXP = 32, DFF = 512;
constexpr int NKT = S / 64;
#ifndef REP_ROUTER
#define REP_ROUTER 1
#endif
#ifndef REP_STORES
#define REP_STORES 1
#endif
#ifndef REP_STATS
#define REP_STATS 1
#endif
#ifndef DCH
#define DCH 48
#endif
constexpr int NCH = (NKT + DCH - 1) / DCH;
constexpr size_t DPART_ROWS = (size_t)NCH * S - (size_t)(DCH * 64) * NCH * (NCH - 1) / 2;
constexpr float ALPHA = 1.41421356237309504880f;
constexpr float LN_EPS = 1e-5f;
constexpr float LOG2E = 1.4426950408889634f;
constexpr float QSCALE_A = 0.08838834764831845f * 1.4426950408889634f;
constexpr float QSCALE_C = 0.125f * 1.4426950408889634f;

enum { I_X = 0, I_POS, I_WIN, I_BF, I_CONVW, I_CONVB, I_WA, I_BA, I_WI, I_BI, I_LAM, I_LQ1, I_LK1, I_LQ2, I_LK2, I_SUBG, I_WO, I_LN1G, I_LN1B,
       I_WGRP, I_BGRP, I_WRT, I_BRT, I_WGATE, I_WUP, I_WDOWN, I_LN2G, I_LN2B, N_INPUTS };

typedef unsigned short bf16_t;
typedef short bf16x8 __attribute__((ext_vector_type(8)));
typedef float f32x4 __attribute__((ext_vector_type(4)));
typedef unsigned u32x4 __attribute__((ext_vector_type(4)));
typedef unsigned u32x2 __attribute__((ext_vector_type(2)));
#ifdef EMU
static inline void st_wt16(void* p, u32x4 v) { *(u32x4*)p = v; }
#endif

constexpr size_t al256(size_t x) { return (x + 255) & ~(size_t)255; }
constexpr size_t CTL_BYTES = 65536;
constexpr size_t CTL_CNT_OFF = 32768;
constexpr size_t CTL_WORK_OFF = 36864;
constexpr size_t CTL_QK2_OFF = 57344;
constexpr size_t CTL_CLS_OFF = 49152;
constexpr size_t CTL_PAN_OFF = 16384;
constexpr size_t CTL_MQ_OFF = 24576;
constexpr size_t CTL_DONE_OFF = 40960;
constexpr size_t WB_WIN = CTL_BYTES;
constexpr size_t WB_WO = WB_WIN + al256((size_t)DEPTH * N_INP * D * 2);
constexpr size_t WB_WGU = WB_WO + al256((size_t)DEPTH * D * D * 2);
constexpr size_t WB_WD = WB_WGU + al256((size_t)DEPTH * NEXP * 1024 * D * 2);
constexpr size_t WB_WAI = WB_WD + al256((size_t)DEPTH * NEXP * D * DFF * 2);
constexpr size_t WF_FA = WB_WAI + al256((size_t)DEPTH * 6 * 256 * 128 * 2);
constexpr size_t WF_R36 = WF_FA + al256((size_t)DEPTH * 8 * D * 4);
constexpr size_t WF_ROPE = WF_R36 + al256((size_t)DEPTH * 2 * 48 * D * 2);
constexpr size_t A_XB = WF_ROPE + al256((size_t)S * 16 * 4);
constexpr size_t A_HB = A_XB + al256((size_t)S * D * 2);
constexpr size_t A_LOGF = A_HB + al256((size_t)S * D * 4);
constexpr size_t A_CUM = A_LOGF + al256((size_t)6 * S * 4);
constexpr size_t A_KMAX = A_CUM + al256((size_t)6 * S * 4);
constexpr size_t A_CNTB = A_KMAX + al256((size_t)6 * NKT * 4);
constexpr size_t A_QA = A_CNTB + al256((size_t)1024 * 32 * 4);
constexpr size_t A_KA = A_QA + al256((size_t)FOX_H * S * 128 * 2);
constexpr size_t A_VAT = A_KA + al256((size_t)FOX_H * S * 128 * 2);
constexpr size_t A_XR = A_VAT + al256((size_t)FOX_H * S * 128 * 2);
constexpr size_t A_GR = A_XR + al256((size_t)S * LRU_W * 2);
constexpr size_t A_QC = A_GR + al256((size_t)S * LRU_W * 2);
constexpr size_t A_KC = A_QC + al256((size_t)DIFF_H * S * 128 * 2);
constexpr size_t A_VCT = A_KC + al256((size_t)DIFF_H * S * 128 * 2);
constexpr size_t A_HLOC = A_VCT + al256((size_t)DIFF_H * S * 128 * 2);
constexpr size_t A_PLOC = A_HLOC + al256((size_t)S * LRU_W * 4);
constexpr size_t A_SUMA = A_PLOC + al256((size_t)S * LRU_W * 4);
constexpr size_t A_SUMH = A_SUMA + al256((size_t)NKT * LRU_W * 4);
constexpr size_t A_CONCAT = A_SUMH + al256((size_t)NKT * LRU_W * 4);
constexpr size_t A_Y1 = A_CONCAT + al256((size_t)S * D * 2);
constexpr size_t A_H1 = A_Y1 + al256((size_t)S * D * 4);
constexpr size_t A_H1B = A_H1 + al256((size_t)S * D * 4);
constexpr size_t A_LTOK = A_H1B + al256((size_t)S * D * 2);
constexpr size_t A_LW = A_LTOK + al256((size_t)NEXP * S * 4 * 2);
constexpr size_t A_LSLOT = A_LW + al256((size_t)NEXP * S * 4 * 2);
constexpr size_t A_ACT = A_LSLOT + al256((size_t)NEXP * S * 4 * 2);
constexpr size_t A_CONTRIB = A_ACT + al256((size_t)(2 * S + 256) * DFF * 2);
constexpr size_t WS_END = A_CONTRIB + al256((size_t)2 * S * D * 4);
constexpr size_t A_DPO = A_Y1;
constexpr size_t A_DPML = A_DPO + al256((size_t)8 * DPART_ROWS * 128 * 2);
static_assert(A_DPML + (size_t)8 * DPART_ROWS * 2 * 4 <= A_H1B, "differential partials must fit inside the y1 + h1 region");

constexpr size_t A_XBUF = A_H1 + al256((size_t)S * D * 2);
constexpr size_t A_PART = A_XBUF + al256((size_t)S * 8 * 8);
static_assert(A_PART + (size_t)8 * S * 48 * 4 <= A_H1B, "exchange buffers must fit inside the h1 region");
constexpr int NTHREADS = 512;
constexpr int LDS_MAIN = 131072 + 4096;
constexpr int LDS_MISC = LDS_MAIN;
constexpr int LDS_BYTES = LDS_MAIN + 8192 + 16640;
constexpr int M_PRE16 = 8192;
constexpr int M_LCNT = 64, M_CTOT = 256, M_COFF = 384, M_PRE = 512, M_RTOK = 2048, M_RW = 3072, M_RSLOT = 4096;

struct Params {
    const float* in[N_INPUTS];
    float* out;
    unsigned char* ws;
    float inv_freq[8];
    int lo, hi;
};

#ifndef EMU
#define LAS __attribute__((address_space(3)))
#define GAS __attribute__((address_space(1)))
#define DYN_LDS(name) extern __shared__ __attribute__((aligned(16))) unsigned char name[]
#define SLEEP1() __builtin_amdgcn_s_sleep(1)
#define WAVE_SYNC() __builtin_amdgcn_wave_barrier()
#define OPAQUE(x) asm volatile("" : "+v"(x))
#define COMPILER_FENCE() asm volatile("" ::: "memory")
#define RFL(x) __builtin_amdgcn_readfirstlane(x)
#define RFL_F(x) __builtin_bit_cast(float, __builtin_amdgcn_readfirstlane(__builtin_bit_cast(int, x)))
#define ANY_LANE(p) (__builtin_amdgcn_ballot_w64(p) != 0ull)
#define RDLANE(v, l) __builtin_bit_cast(float, __builtin_amdgcn_readlane(__builtin_bit_cast(int, v), l))
__device__ __forceinline__ int lane_id_volatile() { int l; asm volatile("v_mbcnt_lo_u32_b32 %0, -1, 0\n\tv_mbcnt_hi_u32_b32 %0, -1, %0" : "=v"(l)); return l; }
#define LANE_ID() lane_id_volatile()
#define OPAQUE_S(x) asm volatile("" : "+s"(x))
#define WAIT_VM0() asm volatile("s_waitcnt vmcnt(0)" ::: "memory")
#define WAIT_ALL0() __builtin_amdgcn_s_waitcnt(0)
#define FENCE_REL_AGENT() __builtin_amdgcn_fence(__ATOMIC_RELEASE, "agent")
#define FENCE_ACQ_AGENT() __builtin_amdgcn_fence(__ATOMIC_ACQUIRE, "agent")
#define MFMA16(a, b, c) __builtin_amdgcn_mfma_f32_16x16x32_bf16(a, b, c, 0, 0, 0)
#define GLDS16(g, l) __builtin_amdgcn_global_load_lds((const unsigned*)(g), (unsigned*)(l), 16, 0, 0)
#define GLDS16X(g, l, aux) __builtin_amdgcn_global_load_lds((const unsigned*)(g), (unsigned*)(l), 16, 0, aux)
#define WAIT_V(n) asm volatile("s_waitcnt vmcnt(" #n ")" ::: "memory")
#define WAIT_L(n) asm volatile("s_waitcnt lgkmcnt(" #n ")" ::: "memory")
#define BAR() __builtin_amdgcn_s_barrier()
#define SCHED() __builtin_amdgcn_sched_barrier(0)
#define SETPRIO(n) __builtin_amdgcn_s_setprio(n)
#define FAST_EXP2(x) __builtin_amdgcn_exp2f(x)
template <int M> __device__ __forceinline__ float shx_impl(float v, int lane) {
    if (M < 32) return __builtin_bit_cast(float, __builtin_amdgcn_ds_swizzle(__builtin_bit_cast(int, v), (M << 10) | 0x1f));
    return __builtin_bit_cast(float, __builtin_amdgcn_ds_bpermute((lane ^ 32) << 2, __builtin_bit_cast(int, v)));
}
#define SHX(v, M) shx_impl<M>(v, lane)
template <int CTRL> __device__ __forceinline__ float dppx(float x) { return __builtin_bit_cast(float, __builtin_amdgcn_mov_dpp(__builtin_bit_cast(int, x), CTRL, 0xf, 0xf, true)); }
#define DPP_X1(x) dppx<0xB1>(x)
#define DPP_X2(x) dppx<0x4E>(x)
#define DPP_X7(x) dppx<0x141>(x)
#define DPP_X8(x) dppx<0x128>(x)
#define xrow16_max(x) xrow16_max_l(x, lane)
#define xrow16_sum(x) xrow16_sum_l(x, lane)
__device__ __forceinline__ float xrow16_max_l(float x, int lane) { x = fmaxf(x, shx_impl<16>(x, lane)); return fmaxf(x, shx_impl<32>(x, lane)); }
__device__ __forceinline__ float xrow16_sum_l(float x, int lane) { x = x + shx_impl<16>(x, lane); return x + shx_impl<32>(x, lane); }
#define FAST_LOG2(x) __builtin_amdgcn_logf(x)
#define FAST_RCP(x) __builtin_amdgcn_rcpf(x)
__device__ __forceinline__ unsigned xb_ld(unsigned* p)              { return __hip_atomic_load(p, __ATOMIC_RELAXED, __HIP_MEMORY_SCOPE_AGENT); }
__device__ __forceinline__ unsigned xb_add(unsigned* p, unsigned v) { return __hip_atomic_fetch_add(p, v, __ATOMIC_RELAXED, __HIP_MEMORY_SCOPE_AGENT); }
__device__ __forceinline__ void st_wt16(void* p, u32x4 v) { asm volatile("global_store_dwordx4 %0, %1, off sc1" :: "v"(p), "v"(v) : "memory"); }
__device__ __forceinline__ void xst64(unsigned long long* p, unsigned long long v) { __hip_atomic_store(p, v, __ATOMIC_RELAXED, __HIP_MEMORY_SCOPE_AGENT); }
__device__ __forceinline__ unsigned long long xld64(unsigned long long* p) { return __hip_atomic_load(p, __ATOMIC_RELAXED, __HIP_MEMORY_SCOPE_AGENT); }
__device__ __forceinline__ void xst32(unsigned* p, unsigned v) { __hip_atomic_store(p, v, __ATOMIC_RELAXED, __HIP_MEMORY_SCOPE_AGENT); }
__device__ __forceinline__ unsigned xb_xcc_id() { return (unsigned)__builtin_amdgcn_s_getreg((3 << 11) | 20) & 0xFu; }
__device__ __forceinline__ int atomic_add_int(int* p, int v) { return atomicAdd(p, v); }
__device__ __forceinline__ void atomic_min_int(int* p, int v) { atomicMin(p, v); }
__device__ __forceinline__ void atomic_max_u32(unsigned* p, unsigned v) { atomicMax(p, v); }
__device__ __forceinline__ unsigned pack2(float lo, float hi) { unsigned r; asm volatile("v_cvt_pk_bf16_f32 %0, %1, %2" : "=v"(r) : "v"(lo), "v"(hi)); return r; }
#else
#define MFMA16(a, b, c) emu_mfma_16x16x32_bf16(a, b, c)
#define GLDS16(g, l) emu_glds16((const void*)(g), (void*)(l))
#define GLDS16X(g, l, aux) emu_glds16((const void*)(g), (void*)(l))
#define WAIT_V(n) ((void)0)
#define WAIT_L(n) ((void)0)
#define BAR() __syncthreads()
#define SCHED() ((void)0)
#define SETPRIO(n) ((void)0)
#define FAST_EXP2(x) exp2f(x)
#define SHX(v, M) __shfl_xor(v, M)
#define DPP_X1(x) __shfl_xor(x, 1)
#define DPP_X2(x) __shfl_xor(x, 2)
#define DPP_X7(x) __shfl_xor(x, 7)
#define DPP_X8(x) __shfl_xor(x, 8)
static inline float xrow16_max(float x) { x = fmaxf(x, __shfl_xor(x, 16)); return fmaxf(x, __shfl_xor(x, 32)); }
static inline float xrow16_sum(float x) { x = x + __shfl_xor(x, 16); return x + __shfl_xor(x, 32); }
#define FAST_LOG2(x) log2f(x)
#define FAST_RCP(x) (1.f / (x))
static inline unsigned pack2(float lo, float hi) {
    unsigned a = __builtin_bit_cast(unsigned, lo), b = __builtin_bit_cast(unsigned, hi);
    a += 0x7fffu + ((a >> 16) & 1u); b += 0x7fffu + ((b >> 16) & 1u);
    return (a >> 16) | (b & 0xffff0000u);
}
#endif
__device__ __forceinline__ bf16_t f2bf(float f) { return (bf16_t)(pack2(f, 0.f) & 0xffffu); }
__device__ __forceinline__ float bf2f(bf16_t h) { return __builtin_bit_cast(float, (unsigned)h << 16); }

#define XB_TMO      128
#define XB_XCNT(j)  (256  + 64 * (j))
#define XB_XSUB(j)  (1280 + 64 * (j))
#define XB_XGEN(j)  (2304 + 64 * (j))
#define XB_TOP      3328
#define XB_TOPGEN   3392
#define XCD_BAR_WORDS 3456
#define XB_SPIN_CAP (1u << 22)
#define XB_SPIN(cond, bar) do { unsigned _sp = 0; while (cond) { SLEEP1(); \
    if ((++_sp & 255u) == 0u) { if (xb_ld(&(bar)[XB_TMO])) break; if (_sp > XB_SPIN_CAP) { xb_add(&(bar)[XB_TMO], 1u); break; } } } } while (0)

#define XB_X2SUB(x, s) (6400 + 16 * ((x) * 4 + (s)))
#define XB_X2CNT(x, s) (7424 + ((x) * 4 + (s)))
struct XcdBarrier { unsigned* bar; unsigned x, s; volatile LAS unsigned* st; };

__device__ __forceinline__ XcdBarrier xcd_barrier_post(unsigned* bar, volatile LAS unsigned* st) {
    XcdBarrier b; b.bar = bar; b.x = xb_xcc_id() & 15u; b.s = (blockIdx.x >> 3) & 3u; b.st = st;
    if (threadIdx.x == 0) {
        unsigned o = xb_add(&bar[XB_X2CNT(b.x, b.s)], 1u);
#ifndef EMU
        asm volatile("" :: "v"(o));
#endif
        (void)o;
        (void)xb_add(&bar[XB_XCNT(b.x)], 1u);
    }
    return b;
}
__device__ __forceinline__ void xcd_barrier_complete(unsigned* bar, unsigned x, unsigned s, unsigned& nsub, unsigned& nx, unsigned& nsubs) {
    const unsigned G = gridDim.x;
    unsigned sum, cnt, sp = 0u;
    for (;;) {
        sum = 0u; cnt = 0u;
#pragma unroll
        for (unsigned j = 0; j < 16; ++j) { const unsigned c = xb_ld(&bar[XB_XCNT(j)]); sum += c; cnt += (c > 0u) ? 1u : 0u; }
        if (sum == G) break;
        SLEEP1();
        if ((++sp & 255u) == 0u) { if (xb_ld(&bar[XB_TMO])) break; if (sp > XB_SPIN_CAP) { xb_add(&bar[XB_TMO], 1u); break; } }
    }
    unsigned mine = 0u, subs = 0u;
#pragma unroll
    for (unsigned q = 0; q < 4; ++q) { const unsigned c = xb_ld(&bar[XB_X2CNT(x, q)]); subs += (c > 0u) ? 1u : 0u; mine = (q == s) ? c : mine; }
    nsub = mine > 0u ? mine : 1u; nx = cnt > 0u ? cnt : 1u; nsubs = subs > 0u ? subs : 1u;
}
__device__ __forceinline__ void xcd_barrier(const XcdBarrier& b, bool leader) {
    WAIT_VM0();
    __syncthreads();
    if (leader) {
        unsigned* bar = b.bar;
        WAIT_ALL0();
        unsigned nsub = b.st[0], nx = b.st[1], nsubs = b.st[2];
        if (nsub == 0u) { xcd_barrier_complete(bar, b.x, b.s, nsub, nx, nsubs); b.st[0] = nsub; b.st[1] = nx; b.st[2] = nsubs; }
        const unsigned old = xb_add(&bar[XB_X2SUB(b.x, b.s)], 1u);
        const unsigned gen = old / nsub;
        bool xcd_last = false;
        if (old + 1u == (gen + 1u) * nsub) {
            const unsigned old2 = xb_add(&bar[XB_XSUB(b.x)], 1u);
            xcd_last = (old2 + 1u == (old2 / nsubs + 1u) * nsubs);
        }
        if (xcd_last) {
            FENCE_REL_AGENT();
            WAIT_VM0();
            const unsigned og = xb_add(&bar[XB_TOP], 1u);
            const unsigned tg = og / nx;
            if (og + 1u == (tg + 1u) * nx) xb_add(&bar[XB_TOPGEN], 1u);
            else XB_SPIN(xb_ld(&bar[XB_TOPGEN]) == tg, bar);
            FENCE_ACQ_AGENT();
            xb_add(&bar[XB_XGEN(b.x)], 1u);
            WAIT_VM0();
        } else {
            XB_SPIN(xb_ld(&bar[XB_XGEN(b.x)]) == gen, bar);
            FENCE_ACQ_AGENT();
            WAIT_VM0();
        }
    }
    __syncthreads();
}

__device__ __forceinline__ f32x4 mul_s4(f32x4 a, float s) {
#ifdef EMU
    return a * s;
#else
    f32x4 o;
#pragma unroll
    for (int c = 0; c < 4; ++c) { float r, x = a[c]; asm volatile("v_mul_f32_e32 %0, %1, %2" : "=v"(r) : "v"(x), "v"(s)); o[c] = r; }
    return o;
#endif
}
__device__ __forceinline__ float wave_sum_l(float v, int lane) {
    (void)lane;
    v += DPP_X1(v); v += DPP_X2(v); v += DPP_X7(v); v += DPP_X8(v);
    return xrow16_sum(v);
}
#define wave_sum(v) wave_sum_l(v, lane)
__device__ __forceinline__ float fexp(float x) { return FAST_EXP2(x * LOG2E); }
__device__ __forceinline__ float sigmoid_f(float x) { return FAST_RCP(1.f + fexp(-x)); }
__device__ __forceinline__ float log_sigmoid_f(float x) { return fminf(x, 0.f) - 0.6931471805599453f * FAST_LOG2(1.f + fexp(-fabsf(x))); }
__device__ __forceinline__ float gelu_tanh_f(float x) { const float u = 0.7978845608028654f * (x + 0.044715f * x * x * x); return x * FAST_RCP(1.f + fexp(-2.f * u)); }
__device__ __forceinline__ float silu_f(float x) { return x * FAST_RCP(1.f + fexp(-x)); }
__device__ __forceinline__ float neg_expm1_f(float x) {
    const float ser = -x * (1.f + x * (0.5f + x * (0.16666667f + x * (0.041666668f + x * (0.008333334f + x * 0.0013888889f)))));
    return (x > -0.35f) ? ser : (1.f - fexp(x));
}

struct RmIdent { __device__ __forceinline__ int operator()(int n) const { return n; } };
struct RmWin { __device__ __forceinline__ int operator()(int n) const { return n < C_FA ? n : (n < C_FA + 6 ? -1 : n - 6); } };
struct RmGu { int kind; __device__ __forceinline__ int operator()(int f) const { return (f >> 7) * 256 + ((f >> 6) & 1) * 128 + ((f >> 4) & 3) * 32 + kind * 16 + (f & 15); } };
struct RmOff { int off; __device__ __forceinline__ int operator()(int n) const { return n + off; } };

template <class RM>
__device__ __forceinline__ void convert_tile(const float* src, int ld, int K, int Nsrc, int k0, int n0, bf16_t* dst, const RM& rm, float* T, int tid) {
    {
        const int nn = tid & 255, kh = (tid >> 8) * 32, n = n0 + nn;
        const float* sp = src + (size_t)(k0 + kh) * ld + n;
        float v[32];
#pragma unroll
        for (int i = 0; i < 32; ++i) v[i] = (n < Nsrc) ? sp[(size_t)i * ld] : 0.f;
#pragma unroll
        for (int i = 0; i < 32; ++i) T[(kh + i) * 257 + nn] = v[i];
    }
    __syncthreads();
#pragma unroll
    for (int q = 0; q < 4; ++q) {
        const int nn = q * 64 + (tid >> 3), kc = (tid & 7) * 8, n = n0 + nn;
        const int row = (n < Nsrc) ? rm(n) : -1;
        if (row >= 0) {
            u32x4 o;
            o.x = pack2(T[(kc + 0) * 257 + nn], T[(kc + 1) * 257 + nn]); o.y = pack2(T[(kc + 2) * 257 + nn], T[(kc + 3) * 257 + nn]);
            o.z = pack2(T[(kc + 4) * 257 + nn], T[(kc + 5) * 257 + nn]); o.w = pack2(T[(kc + 6) * 257 + nn], T[(kc + 7) * 257 + nn]);
            *(u32x4*)(dst + (size_t)row * K + k0 + kc) = o;
        }
    }
    __syncthreads();
}
template <class RM>
__device__ __forceinline__ void convert_tile_v4(const float* src, int ld, int K, int k0, int n0, bf16_t* dst, const RM& rm, float* T, int tid_in) {
    int tid = tid_in; OPAQUE(tid);
    {
        const int w = tid >> 6, l4 = (tid & 63) * 4;
        const float* sp = src + (size_t)(k0 + w * 8) * ld + n0 + l4;
        f32x4 v[8];
#pragma unroll
        for (int i = 0; i < 8; ++i) v[i] = *(const f32x4*)(sp + (size_t)i * ld);
#pragma unroll
        for (int i = 0; i < 8; ++i) { float* tp = T + (w * 8 + i) * 257 + l4; tp[0] = v[i][0]; tp[1] = v[i][1]; tp[2] = v[i][2]; tp[3] = v[i][3]; }
    }
    __syncthreads();
#pragma unroll
    for (int q = 0; q < 4; ++q) {
        const int nn = q * 64 + (tid >> 3), kc = (tid & 7) * 8, n = n0 + nn;
        const int row = rm(n);
        u32x4 o;
        o.x = pack2(T[(kc + 0) * 257 + nn], T[(kc + 1) * 257 + nn]); o.y = pack2(T[(kc + 2) * 257 + nn], T[(kc + 3) * 257 + nn]);
        o.z = pack2(T[(kc + 4) * 257 + nn], T[(kc + 5) * 257 + nn]); o.w = pack2(T[(kc + 6) * 257 + nn], T[(kc + 7) * 257 + nn]);
        *(u32x4*)(dst + (size_t)row * K + k0 + kc) = o;
    }
    __syncthreads();
}
template <class RM>
__device__ __forceinline__ void convert_mats(const float* src, size_t sstride, int nmat, int ld, int K, int Nsrc, bf16_t* dst, size_t dstride, const RM& rm,
                                             float* T, int tid, int bid, int G) {
    const int tk = K / 64, tn = (Nsrc + 255) / 256, per = tk * tn, total = nmat * per;
    for (int t = bid; t < total; t += G) {
        const int mi = t / per, r = t % per;
        convert_tile(src + (size_t)mi * sstride, ld, K, Nsrc, (r / tn) * 64, (r % tn) * 256, dst + (size_t)mi * dstride, rm, T, tid);
    }
}

template <class RM>
__device__ __forceinline__ void convert_mat_pipe(const float* src, int ld, int K, int Nsrc, bf16_t* dst, const RM& rm, float* T, int tid_in, int bid, int G) {
    int tid = tid_in; OPAQUE(tid);
    const int tn = (Nsrc + 255) / 256, total = (K / 64) * tn;
    const int nn = tid & 255, kh = (tid >> 8) * 32;
    float v[32];
    int t = bid;
    if (t < total) {
        const int n = (t % tn) * 256 + nn;
        const float* sp = src + (size_t)((t / tn) * 64 + kh) * ld + n;
#pragma unroll
        for (int i = 0; i < 32; ++i) v[i] = (n < Nsrc) ? sp[(size_t)i * ld] : 0.f;
    }
#pragma unroll 1
    for (; t < total; t += G) {
        const int k0 = (t / tn) * 64, n0 = (t % tn) * 256;
#pragma unroll
        for (int i = 0; i < 32; ++i) T[(kh + i) * 257 + nn] = v[i];
        __syncthreads();
        const int t2 = t + G;
        if (t2 < total) {
            const int n = (t2 % tn) * 256 + nn;
            const float* sp = src + (size_t)((t2 / tn) * 64 + kh) * ld + n;
#pragma unroll
            for (int i = 0; i < 32; ++i) v[i] = (n < Nsrc) ? sp[(size_t)i * ld] : 0.f;
        }
#pragma unroll
        for (int q = 0; q < 4; ++q) {
            const int n2 = q * 64 + (tid >> 3), kc = (tid & 7) * 8, n = n0 + n2;
            const int row = (n < Nsrc) ? rm(n) : -1;
            if (row >= 0) {
                u32x4 o;
                o.x = pack2(T[(kc + 0) * 257 + n2], T[(kc + 1) * 257 + n2]); o.y = pack2(T[(kc + 2) * 257 + n2], T[(kc + 3) * 257 + n2]);
                o.z = pack2(T[(kc + 4) * 257 + n2], T[(kc + 5) * 257 + n2]); o.w = pack2(T[(kc + 6) * 257 + n2], T[(kc + 7) * 257 + n2]);
                *(u32x4*)(dst + (size_t)row * K + k0 + kc) = o;
            }
        }
        __syncthreads();
    }
}

constexpr int NCONV = DEPTH * 768;
__device__ __forceinline__ void moe_conv_chunk(const Params& p, int cid, bf16_t* WguT_, bf16_t* WdT_, float* T, int tid_in) {
    int tid = tid_in; OPAQUE(tid);
    const int l = cid / 768, r = cid % 768, kind = r >> 8, t0 = (r & 255) * 8, mi = t0 >> 6;
    const float* src; bf16_t* dst; int ld, K;
    if (kind < 2) { src = p.in[kind == 0 ? I_WGATE : I_WUP] + ((size_t)l * NEXP + mi) * D * DFF; dst = WguT_ + ((size_t)l * NEXP + mi) * 1024 * D; ld = DFF; K = D; }
    else { src = p.in[I_WDOWN] + ((size_t)l * NEXP + mi) * DFF * D; dst = WdT_ + ((size_t)l * NEXP + mi) * D * DFF; ld = D; K = DFF; }
    const int w = tid >> 6, l4 = (tid & 63) * 4;
    f32x4 v[8];
    {
        const int rr = t0 & 63, k0 = (kind < 2) ? (rr >> 1) * 64 : (rr >> 3) * 64, n0 = (kind < 2) ? (rr & 1) * 256 : (rr & 7) * 256;
        const float* sp = src + (size_t)(k0 + w * 8) * ld + n0 + l4;
#pragma unroll
        for (int i = 0; i < 8; ++i) v[i] = *(const f32x4*)(sp + (size_t)i * ld);
    }
#pragma unroll 1
    for (int j = 0; j < 8; ++j) {
        const int rr = (t0 + j) & 63, k0 = (kind < 2) ? (rr >> 1) * 64 : (rr >> 3) * 64, n0 = (kind < 2) ? (rr & 1) * 256 : (rr & 7) * 256;
#pragma unroll
        for (int i = 0; i < 8; ++i) { float* tp = T + (w * 8 + i) * 257 + l4; tp[0] = v[i][0]; tp[1] = v[i][1]; tp[2] = v[i][2]; tp[3] = v[i][3]; }
        __syncthreads();
        if (j + 1 < 8) {
            const int r2 = (t0 + j + 1) & 63, k2 = (kind < 2) ? (r2 >> 1) * 64 : (r2 >> 3) * 64, n2 = (kind < 2) ? (r2 & 1) * 256 : (r2 & 7) * 256;
            const float* sp = src + (size_t)(k2 + w * 8) * ld + n2 + l4;
#pragma unroll
            for (int i = 0; i < 8; ++i) v[i] = *(const f32x4*)(sp + (size_t)i * ld);
        }
#pragma unroll
        for (int q = 0; q < 4; ++q) {
            const int nn = q * 64 + (tid >> 3), kc = (tid & 7) * 8, n = n0 + nn;
            const int row = (kind < 2) ? RmGu{kind}(n) : n;
            u32x4 o;
            o.x = pack2(T[(kc + 0) * 257 + nn], T[(kc + 1) * 257 + nn]); o.y = pack2(T[(kc + 2) * 257 + nn], T[(kc + 3) * 257 + nn]);
            o.z = pack2(T[(kc + 4) * 257 + nn], T[(kc + 5) * 257 + nn]); o.w = pack2(T[(kc + 6) * 257 + nn], T[(kc + 7) * 257 + nn]);
            *(u32x4*)(dst + (size_t)row * K + k0 + kc) = o;
        }
        __syncthreads();
    }
}

constexpr int BK = 64, HTB = 128 * 64 * 2;
__device__ __forceinline__ int lds_byte(int r, int c) {
    const int st = (r >> 4) * 2 + (c >> 5), rr = r & 15, cc = c & 31, ob = rr * 64 + cc * 2;
    return st * 1024 + (ob ^ (((ob >> 9) & 1) << 5));
}
__device__ __forceinline__ void stage_rc(int b, int& R, int& C) {
    const int st = b / 1024, sb = b % 1024, swz = sb ^ (((sb >> 9) & 1) << 5);
    R = (st >> 1) * 16 + swz / 64; C = (st & 1) * 32 + (swz % 64) / 2;
}
template <bool GATHER, int AAUX = 0, bool HALF = false>
__device__ __forceinline__ void gemm_tile(const bf16_t* A, int arow0, const unsigned (&aoff)[2][2], const bf16_t* Bt, int brow0, int K,
                                          unsigned char* shm, f32x4 (&acc)[2][2][4][2], int tid_in) {
    int tid = tid_in; OPAQUE(tid);
    unsigned toff; { int R0, C0; stage_rc(tid * 16, R0, C0); toff = (unsigned)(R0 * K + C0); }
#define SA(b, h) (shm + ((b) * 2 + (h)) * HTB)
#define SB(b, h) (shm + (4 + (b) * 2 + (h)) * HTB)
#define STAGE_B(P, h, kt) do { _Pragma("unroll") for (int _i = 0; _i < 2; ++_i) GLDS16(Bt + ((size_t)(brow0 + (h) * 128 + _i * 64) * K + (size_t)(kt) * BK) + toff, (P) + tid * 16 + _i * 8192); } while (0)
#define STAGE_A(P, h, kt) do { _Pragma("unroll") for (int _i = 0; _i < 2; ++_i) { \
    if (GATHER) GLDS16(A + (size_t)(kt) * BK + aoff[h][_i], (P) + tid * 16 + _i * 8192); \
    else GLDS16X(A + ((size_t)(arow0 + (h) * 128 + _i * 64) * K + (size_t)(kt) * BK) + toff, (P) + tid * 16 + _i * 8192, AAUX); } } while (0)
#define LDA(dst, b, h) _Pragma("unroll") for (int m = 0; m < 4; ++m) _Pragma("unroll") for (int k = 0; k < 2; ++k) \
    dst[m][k] = *reinterpret_cast<const bf16x8*>(SA(b, h) + lds_byte(wr * 64 + m * 16 + fr, k * 32 + fq * 8))
#define LDB(dst, b, h) _Pragma("unroll") for (int n = 0; n < 2; ++n) _Pragma("unroll") for (int k = 0; k < 2; ++k) \
    dst[n][k] = *reinterpret_cast<const bf16x8*>(SB(b, h) + lds_byte(wc * 32 + n * 16 + fr, k * 32 + fq * 8))
#define MMA(ai, bj, At, Bx) do { if (HALF && (ai) == 1) break; SETPRIO(1); \
    _Pragma("unroll") for (int m = 0; m < 4; ++m) _Pragma("unroll") for (int n = 0; n < 2; ++n) _Pragma("unroll") for (int k = 0; k < 2; ++k) \
      acc[ai][bj][m][n] = MFMA16(At[m][k], Bx[n][k], acc[ai][bj][m][n]); \
    SETPRIO(0); } while (0)
    int wid = tid >> 6, lane = tid & 63, wr = wid >> 2, wc = wid & 3, fr = lane & 15, fq = lane >> 4;
#pragma unroll
    for (int a = 0; a < 2; ++a)
#pragma unroll
        for (int b = 0; b < 2; ++b)
#pragma unroll
            for (int m = 0; m < 4; ++m)
#pragma unroll
                for (int n = 0; n < 2; ++n) acc[a][b][m][n] = (f32x4){0.f, 0.f, 0.f, 0.f};
    bf16x8 At[4][2], B0[2][2], B1[2][2];
    const int nt = K / BK;
    STAGE_B(SB(0, 0), 0, 0); STAGE_A(SA(0, 0), 0, 0);
    STAGE_B(SB(0, 1), 1, 0); STAGE_A(SA(0, 1), 1, 0);
    if (wr == 1) BAR();
    WAIT_V(4); BAR();
    STAGE_B(SB(1, 0), 0, 1); STAGE_A(SA(1, 0), 0, 1); STAGE_B(SB(1, 1), 1, 1);
    WAIT_V(6); BAR();
    for (int t = 0; t < nt - 2; t += 2) {
        LDB(B0, 0, 0); SCHED(); LDA(At, 0, 0); STAGE_A(SA(1, 1), 1, t + 1);
        WAIT_L(8); BAR(); WAIT_L(0); MMA(0, 0, At, B0); BAR(); SCHED();
        LDB(B1, 0, 1); STAGE_B(SB(0, 0), 0, t + 2);
        BAR(); WAIT_L(0); MMA(0, 1, At, B1); BAR();
        LDA(At, 0, 1); STAGE_A(SA(0, 0), 0, t + 2);
        BAR(); WAIT_L(0); MMA(1, 0, At, B0); BAR(); SCHED();
        STAGE_B(SB(0, 1), 1, t + 2);
        WAIT_V(6); BAR(); MMA(1, 1, At, B1); BAR();
        LDB(B0, 1, 0); SCHED(); LDA(At, 1, 0); STAGE_A(SA(0, 1), 1, t + 2);
        WAIT_L(8); BAR(); WAIT_L(0); MMA(0, 0, At, B0); BAR(); SCHED();
        LDB(B1, 1, 1); STAGE_B(SB(1, 0), 0, t + 3);
        BAR(); WAIT_L(0); MMA(0, 1, At, B1); BAR();
        LDA(At, 1, 1); STAGE_A(SA(1, 0), 0, t + 3);
        BAR(); WAIT_L(0); MMA(1, 0, At, B0); BAR(); SCHED();
        STAGE_B(SB(1, 1), 1, t + 3);
        WAIT_V(6); BAR(); MMA(1, 1, At, B1); BAR();
    }
    OPAQUE(tid); wid = tid >> 6; lane = tid & 63; wr = wid >> 2; wc = wid & 3; fr = lane & 15; fq = lane >> 4;
    { LDB(B0, 0, 0); WAIT_V(0); LDA(At, 0, 0); STAGE_A(SA(1, 1), 1, nt - 1);
      BAR(); WAIT_L(0); MMA(0, 0, At, B0); BAR();
      LDB(B1, 0, 1); BAR(); WAIT_L(0); MMA(0, 1, At, B1); BAR();
      LDA(At, 0, 1); WAIT_V(4); BAR(); WAIT_L(0); MMA(1, 0, At, B0); MMA(1, 1, At, B1); BAR(); }
    { LDB(B0, 1, 0); LDA(At, 1, 0); WAIT_V(2); BAR(); WAIT_L(0); MMA(0, 0, At, B0); BAR();
      LDB(B1, 1, 1); WAIT_V(0); BAR(); WAIT_L(0); MMA(0, 1, At, B1); BAR();
      LDA(At, 1, 1); BAR(); WAIT_L(0); MMA(1, 0, At, B0); MMA(1, 1, At, B1); BAR(); }
    if (wr == 0) BAR();
#undef SA
#undef SB
#undef STAGE_A
#undef STAGE_B
#undef LDA
#undef LDB
#undef MMA
}
__device__ __forceinline__ void stage_geom(int tid, int (&R)[2], int (&C)[2]) {
#pragma unroll
    for (int i = 0; i < 2; ++i) stage_rc(tid * 16 + i * 8192, R[i], C[i]);
}

constexpr int ATT_STAGE = 69632;
constexpr int ATT_KBUF = 0, ATT_VBUF = 32768, ATT_CBUF = 65536;
template <int KIND>
__device__ __forceinline__ void attn_unit(const bf16_t* Q, const bf16_t* Kg, const bf16_t* VT, const float* cum2, const float* kmx, int qb, bf16_t* concat, int ccol0,
                                          float lam, float osc, const float* subg, unsigned char* lds, int tid) {
    const int lane = tid & 63, wave = tid >> 6, r16 = lane & 15, q4 = lane >> 4;
    const int q0w = qb * 128 + wave * 16, myq = q0w + r16;
    const int ntiles = 2 * qb + 2;
    const int wlimit = (KIND == 0) ? ((q0w + 15) >> 6) : (q0w >> 6);
    constexpr int NMAP = (KIND == 0) ? 1 : 2, NKS = (KIND == 0) ? 4 : 2;
    bf16x8 qf[NMAP][NKS];
#pragma unroll
    for (int mp = 0; mp < NMAP; ++mp)
#pragma unroll
        for (int ks = 0; ks < NKS; ++ks) qf[mp][ks] = *(const bf16x8*)(Q + (size_t)myq * 128 + mp * 64 + ks * 32 + q4 * 8);
    const float cq = (KIND == 0) ? cum2[myq] : 0.f;
    int kt0 = 0;
    if (KIND == 0) {
        float* wmax = (float*)(lds + ATT_CBUF + 512); int* kst = (int*)(lds + ATT_CBUF + 576);
        float qs = 0.f;
#pragma unroll
        for (int ks = 0; ks < NKS; ++ks)
#pragma unroll
            for (int j = 0; j < 8; ++j) { const float v = bf2f((bf16_t)qf[0][ks][j]); qs += v * v; }
        qs = xrow16_sum(qs);
        qs = fmaxf(qs, SHX(qs, 1)); qs = fmaxf(qs, SHX(qs, 2)); qs = fmaxf(qs, SHX(qs, 4)); qs = fmaxf(qs, SHX(qs, 8));
        if (lane == 0) wmax[wave] = qs;
        if (tid == 0) *kst = 2 * qb;
        __syncthreads();
        float qm = wmax[0];
#pragma unroll
        for (int w = 1; w < 8; ++w) qm = fmaxf(qm, wmax[w]);
        qm = sqrtf(qm) * 1.01f;
        const float kd = sqrtf(fmaxf(kmx[2 * qb], kmx[2 * qb + 1])) * 1.01f;
        if (tid < 2 * qb) {
            const float bias = cum2[qb * 128] - cum2[tid * 64 + 63];
            const bool skip = bias + qm * (sqrtf(kmx[tid]) * 1.01f + kd) < -40.f;
            if (!skip) atomic_min_int(kst, tid);
        }
        __syncthreads();
        kt0 = RFL(*kst);
    }
    f32x4 ot[NMAP][8];
    float mrun[NMAP], lsum[NMAP];
#pragma unroll
    for (int mp = 0; mp < NMAP; ++mp) { mrun[mp] = -INFINITY; lsum[mp] = 0.f;
#pragma unroll
        for (int mo = 0; mo < 8; ++mo) ot[mp][mo] = (f32x4){0.f, 0.f, 0.f, 0.f}; }
    u32x4 sk[2], sv[2]; float sc = 0.f;
    const u32x4* kg = (const u32x4*)Kg; const u32x4* vg = (const u32x4*)VT;
#pragma unroll
    for (int i = 0; i < 2; ++i) { sk[i] = kg[(size_t)kt0 * 1024 + tid + i * 512]; sv[i] = vg[(size_t)kt0 * 1024 + tid + i * 512]; }
    if (KIND == 0 && tid < 64) sc = cum2[kt0 * 64 + tid];
    for (int kt = kt0; kt < ntiles; ++kt) {
        unsigned char* kb = lds + ATT_KBUF + (kt & 1) * 16384;
        unsigned char* vb = lds + ATT_VBUF + (kt & 1) * 16384;
        float* cb = (float*)(lds + ATT_CBUF + (kt & 1) * 256);
#pragma unroll
        for (int i = 0; i < 2; ++i) {
            const int g = tid + i * 512;
            { const int row = g >> 4, c = g & 15; *(u32x4*)(kb + row * 256 + ((c ^ (row & 15)) << 4)) = sk[i]; }
            { const int d = g >> 3, c = g & 7; *(u32x4*)(vb + d * 128 + ((c ^ ((d >> 1) & 7)) << 4)) = sv[i]; }
        }
        if (KIND == 0 && tid < 64) cb[tid] = sc;
        __syncthreads();
        if (kt + 1 < ntiles) {
#pragma unroll
            for (int i = 0; i < 2; ++i) { sk[i] = kg[(size_t)(kt + 1) * 1024 + tid + i * 512]; sv[i] = vg[(size_t)(kt + 1) * 1024 + tid + i * 512]; }
            if (KIND == 0 && tid < 64) sc = cum2[(kt + 1) * 64 + tid];
        }
        if (kt <= wlimit) {
#pragma unroll
            for (int mp = 0; mp < NMAP; ++mp) {
                bf16x8 kf[4][NKS], vfa[8];
#pragma unroll
                for (int m = 0; m < 4; ++m)
#pragma unroll
                    for (int ks = 0; ks < NKS; ++ks) { const int c = (KIND == 0 ? 0 : mp * 8) + ks * 4 + q4; kf[m][ks] = *(const bf16x8*)(kb + (m * 16 + r16) * 256 + ((c ^ r16) << 4)); }
#pragma unroll
                for (int mo = 0; mo < 8; ++mo) { const int d = mo * 16 + r16; vfa[mo] = *(const bf16x8*)(vb + d * 128 + (((0 * 4 + q4) ^ ((d >> 1) & 7)) << 4)); }
                SCHED();
                f32x4 st[4];
#pragma unroll
                for (int m = 0; m < 4; ++m) st[m] = (f32x4){0.f, 0.f, 0.f, 0.f};
#pragma unroll
                for (int ks = 0; ks < NKS; ++ks)
#pragma unroll
                    for (int m = 0; m < 4; ++m) st[m] = MFMA16(kf[m][ks], qf[mp][ks], st[m]);
                SCHED();
                float mx = -INFINITY;
#pragma unroll
                for (int m = 0; m < 4; ++m) {
                    if (KIND == 0) {
                        const f32x4 ck = *(const f32x4*)(cb + m * 16 + 4 * q4);
#pragma unroll
                        for (int j = 0; j < 4; ++j) {
                            float y = st[m][j] + (cq - ck[j]);
                            if (kt * 64 + m * 16 + 4 * q4 + j > myq) y = -INFINITY;
                            st[m][j] = y;
                        }
                    }
#pragma unroll
                    for (int j = 0; j < 4; ++j) mx = fmaxf(mx, st[m][j]);
                }
                mx = xrow16_max(mx);
                const float mnew = fmaxf(mrun[mp], mx);
                const float alpha = FAST_EXP2(mrun[mp] - mnew);
                mrun[mp] = mnew;
                float ps = 0.f;
#pragma unroll
                for (int m = 0; m < 4; ++m)
#pragma unroll
                    for (int j = 0; j < 4; ++j) { const float pv = FAST_EXP2(st[m][j] - mnew); st[m][j] = pv; ps += pv; }
                lsum[mp] = lsum[mp] * alpha + ps;
#pragma unroll
                for (int mo = 0; mo < 8; ++mo) ot[mp][mo] *= alpha;
                bf16x8 pf[2];
#pragma unroll
                for (int kk = 0; kk < 2; ++kk) {
                    u32x4 pw;
                    pw.x = pack2(st[2 * kk][0], st[2 * kk][1]); pw.y = pack2(st[2 * kk][2], st[2 * kk][3]);
                    pw.z = pack2(st[2 * kk + 1][0], st[2 * kk + 1][1]); pw.w = pack2(st[2 * kk + 1][2], st[2 * kk + 1][3]);
                    pf[kk] = __builtin_bit_cast(bf16x8, pw);
                }
                bf16x8 vfb[8];
#pragma unroll
                for (int mo = 0; mo < 8; ++mo) { const int d = mo * 16 + r16; vfb[mo] = *(const bf16x8*)(vb + d * 128 + (((1 * 4 + q4) ^ ((d >> 1) & 7)) << 4)); }
                SCHED();
#pragma unroll
                for (int mo = 0; mo < 8; ++mo) ot[mp][mo] = MFMA16(vfa[mo], pf[0], ot[mp][mo]);
                SCHED();
#pragma unroll
                for (int mo = 0; mo < 8; ++mo) ot[mp][mo] = MFMA16(vfb[mo], pf[1], ot[mp][mo]);
            }
        }
    }
    float inv[NMAP];
#pragma unroll
    for (int mp = 0; mp < NMAP; ++mp) { float l = lsum[mp]; l = xrow16_sum(l); inv[mp] = 1.f / l; }
    if (KIND == 0) {
        int te = tid; OPAQUE(te);
        const int er = te & 15, eq = (te >> 4) & 3, eqw = qb * 128 + (te >> 6) * 16;
        unsigned char* stg = lds + ATT_STAGE + (te >> 6) * 8192;
#pragma unroll
        for (int mo = 0; mo < 8; ++mo) {
            u32x2 o; o.x = pack2(ot[0][mo][0] * inv[0], ot[0][mo][1] * inv[0]); o.y = pack2(ot[0][mo][2] * inv[0], ot[0][mo][3] * inv[0]);
            *(u32x2*)(stg + er * 256 + (((mo * 2 + (eq >> 1)) ^ er) << 4) + (eq & 1) * 8) = o;
        }
        WAVE_SYNC();
#pragma unroll
        for (int k = 0; k < 4; ++k) {
            const int rl = k * 4 + eq, cch = er;
            const u32x4 val = *(const u32x4*)(stg + rl * 256 + ((cch ^ rl) << 4));
            *(u32x4*)(concat + (size_t)(eqw + rl) * D + ccol0 + cch * 8) = val;
        }
    } else {
        float ss = 0.f;
#pragma unroll
        for (int mo = 0; mo < 8; ++mo)
#pragma unroll
            for (int j = 0; j < 4; ++j) { const float v = ot[0][mo][j] * inv[0] - lam * (ot[NMAP - 1][mo][j] * inv[NMAP - 1]); ot[0][mo][j] = v; ss += v * v; }
        ss = xrow16_sum(ss);
        const float rs = osc / sqrtf(ss * (1.f / 128.f) + LN_EPS);
#pragma unroll
        for (int mo = 0; mo < 8; ++mo) {
            const f32x4 g = *(const f32x4*)(subg + mo * 16 + 4 * q4);
            u32x2 o; o.x = pack2(ot[0][mo][0] * rs * g[0], ot[0][mo][1] * rs * g[1]); o.y = pack2(ot[0][mo][2] * rs * g[2], ot[0][mo][3] * rs * g[3]);
            *(u32x2*)(concat + (size_t)myq * D + ccol0 + mo * 16 + 4 * q4) = o;
        }
    }
    __syncthreads();
}

__device__ __forceinline__ int dpart_row(int c, int q) { return c * (S - DCH * 64) - (DCH * 32) * c * (c - 1) + q; }
__device__ __forceinline__ void attn_dmap_unit(const bf16_t* Qh, const bf16_t* Kh, const bf16_t* VTh, int mp, int qb, int t0, int t1,
                                               bf16_t* Op, float* ML, int c, float bnd, unsigned char* lds, int tid) {
    const bool fixedref = (bnd <= 60.f);
    const int lane = tid & 63, wave = tid >> 6, r16 = lane & 15, q4 = lane >> 4;
    const int q0w = qb * 256 + wave * 32;
    const int wlimit = q0w >> 6;
    bf16x8 qf[2][2];
#pragma unroll
    for (int n = 0; n < 2; ++n)
#pragma unroll
        for (int ks = 0; ks < 2; ++ks) qf[n][ks] = *(const bf16x8*)(Qh + (size_t)(q0w + n * 16 + r16) * 128 + mp * 64 + ks * 32 + q4 * 8);
    f32x4 ot[8][2];
    float mrun[2] = {-INFINITY, -INFINITY}, lsum[2] = {0.f, 0.f};
    if (fixedref) { mrun[0] = bnd; mrun[1] = bnd; }
    const float stinit = fixedref ? -bnd : 0.f;
#pragma unroll
    for (int mo = 0; mo < 8; ++mo) { ot[mo][0] = (f32x4){0.f, 0.f, 0.f, 0.f}; ot[mo][1] = (f32x4){0.f, 0.f, 0.f, 0.f}; }
    u32x4 sk, sv[2];
    const u32x4* kg = (const u32x4*)Kh; const u32x4* vg = (const u32x4*)VTh;
    const int krow = tid >> 3, kc8 = tid & 7;
    sk = kg[(size_t)t0 * 1024 + krow * 16 + mp * 8 + kc8];
#pragma unroll
    for (int i = 0; i < 2; ++i) sv[i] = vg[(size_t)t0 * 1024 + tid + i * 512];
    for (int kt = t0; kt < t1; ++kt) {
        unsigned char* kb = lds + (kt & 1) * 8192;
        unsigned char* vb = lds + 16384 + (kt & 1) * 16384;
        *(u32x4*)(kb + krow * 128 + ((kc8 ^ ((krow >> 1) & 7)) << 4)) = sk;
#pragma unroll
        for (int i = 0; i < 2; ++i) { const int g = tid + i * 512, d = g >> 3, cc = g & 7; *(u32x4*)(vb + d * 128 + ((cc ^ ((d >> 1) & 7)) << 4)) = sv[i]; }
        __syncthreads();
        if (kt + 1 < t1) {
            sk = kg[(size_t)(kt + 1) * 1024 + krow * 16 + mp * 8 + kc8];
#pragma unroll
            for (int i = 0; i < 2; ++i) sv[i] = vg[(size_t)(kt + 1) * 1024 + tid + i * 512];
        }
        if (kt <= wlimit) {
            bf16x8 kf[4][2], vfa[8];
#pragma unroll
            for (int m = 0; m < 4; ++m)
#pragma unroll
                for (int ks = 0; ks < 2; ++ks) kf[m][ks] = *(const bf16x8*)(kb + (m * 16 + r16) * 128 + (((ks * 4 + q4) ^ ((r16 >> 1) & 7)) << 4));
#pragma unroll
            for (int mo = 0; mo < 8; ++mo) { const int d = mo * 16 + r16; vfa[mo] = *(const bf16x8*)(vb + d * 128 + (((0 * 4 + q4) ^ ((d >> 1) & 7)) << 4)); }
            SCHED();
            f32x4 st[4][2];
#pragma unroll
            for (int m = 0; m < 4; ++m) { st[m][0] = (f32x4){stinit, stinit, stinit, stinit}; st[m][1] = (f32x4){stinit, stinit, stinit, stinit}; }
            SETPRIO(1);
#pragma unroll
            for (int ks = 0; ks < 2; ++ks)
#pragma unroll
                for (int m = 0; m < 4; ++m) { st[m][0] = MFMA16(kf[m][ks], qf[0][ks], st[m][0]); st[m][1] = MFMA16(kf[m][ks], qf[1][ks], st[m][1]); }
            SETPRIO(0);
            SCHED();
            float alpha[2] = {1.f, 1.f};
            if (fixedref) {
#pragma unroll
                for (int n = 0; n < 2; ++n) {
                    float ps = 0.f;
#pragma unroll
                    for (int m = 0; m < 4; ++m)
#pragma unroll
                        for (int j = 0; j < 4; ++j) { const float pv = FAST_EXP2(st[m][n][j]); st[m][n][j] = pv; ps += pv; }
                    lsum[n] += ps;
                }
            } else
#pragma unroll
            for (int n = 0; n < 2; ++n) {
                float mx = -INFINITY;
#pragma unroll
                for (int m = 0; m < 4; ++m)
#pragma unroll
                    for (int j = 0; j < 4; ++j) mx = fmaxf(mx, st[m][n][j]);
                mx = xrow16_max(mx);
                const float mnew = fmaxf(mrun[n], mx);
                alpha[n] = FAST_EXP2(mrun[n] - mnew);
                mrun[n] = mnew;
                float ps = 0.f;
#pragma unroll
                for (int m = 0; m < 4; ++m)
#pragma unroll
                    for (int j = 0; j < 4; ++j) { const float pv = FAST_EXP2(st[m][n][j] - mnew); st[m][n][j] = pv; ps += pv; }
                lsum[n] = lsum[n] * alpha[n] + ps;
            }
            if (ANY_LANE(alpha[0] != 1.f)) {
#pragma unroll
                for (int mo = 0; mo < 8; ++mo) ot[mo][0] *= alpha[0];
            }
            if (ANY_LANE(alpha[1] != 1.f)) {
#pragma unroll
                for (int mo = 0; mo < 8; ++mo) ot[mo][1] *= alpha[1];
            }
            bf16x8 pf[2][2];
#pragma unroll
            for (int kk = 0; kk < 2; ++kk)
#pragma unroll
                for (int n = 0; n < 2; ++n) {
                    u32x4 pw;
                    pw.x = pack2(st[2 * kk][n][0], st[2 * kk][n][1]); pw.y = pack2(st[2 * kk][n][2], st[2 * kk][n][3]);
                    pw.z = pack2(st[2 * kk + 1][n][0], st[2 * kk + 1][n][1]); pw.w = pack2(st[2 * kk + 1][n][2], st[2 * kk + 1][n][3]);
                    pf[kk][n] = __builtin_bit_cast(bf16x8, pw);
                }
            bf16x8 vfb[8];
#pragma unroll
            for (int mo = 0; mo < 8; ++mo) { const int d = mo * 16 + r16; vfb[mo] = *(const bf16x8*)(vb + d * 128 + (((1 * 4 + q4) ^ ((d >> 1) & 7)) << 4)); }
            SCHED();
            SETPRIO(1);
#pragma unroll
            for (int mo = 0; mo < 8; ++mo) { ot[mo][0] = MFMA16(vfa[mo], pf[0][0], ot[mo][0]); ot[mo][1] = MFMA16(vfa[mo], pf[0][1], ot[mo][1]); }
            SCHED();
#pragma unroll
            for (int mo = 0; mo < 8; ++mo) { ot[mo][0] = MFMA16(vfb[mo], pf[1][0], ot[mo][0]); ot[mo][1] = MFMA16(vfb[mo], pf[1][1], ot[mo][1]); }
            SETPRIO(0);
        }
    }
    if (q0w >= DCH * 64 * c)
#pragma unroll
    for (int n = 0; n < 2; ++n) {
        float l = lsum[n]; l = xrow16_sum(l);
        const int row = dpart_row(c, q0w + n * 16 + r16);
        if (q4 == 0) { ML[row * 2] = mrun[n]; ML[row * 2 + 1] = l; }
    }
    {
        int te = tid; OPAQUE(te);
        const int er = te & 15, eq = (te >> 4) & 3, eqw = qb * 256 + (te >> 6) * 32;
        unsigned char* stg = lds + ATT_STAGE + (te >> 6) * 8192;
#pragma unroll
        for (int n = 0; n < 2; ++n)
#pragma unroll
            for (int mo = 0; mo < 8; ++mo) {
                u32x2 o; o.x = pack2(ot[mo][n][0], ot[mo][n][1]); o.y = pack2(ot[mo][n][2], ot[mo][n][3]);
                *(u32x2*)(stg + (n * 16 + er) * 256 + (((mo * 2 + (eq >> 1)) ^ er) << 4) + (eq & 1) * 8) = o;
            }
        WAVE_SYNC();
        if (eqw >= DCH * 64 * c) {
            const int row0 = dpart_row(c, eqw);
#pragma unroll
            for (int k = 0; k < 8; ++k) {
                const int rl = k * 4 + eq, cch = er;
                const u32x4 val = *(const u32x4*)(stg + rl * 256 + ((cch ^ (rl & 15)) << 4));
                *(u32x4*)(Op + (size_t)(row0 + rl) * 128 + cch * 8) = val;
            }
        }
    }
    __syncthreads();
}

__device__ __forceinline__ void lru_unit_a(int chunk, int grp, int l, const Params& p, const bf16_t* Xr, const bf16_t* WaiT, float* hloc, float* ploc, float* sumA, float* sumH,
                                           unsigned char* lds, int tid) {
    const int lane = tid & 63, wave = tid >> 6, r16 = lane & 15, q4 = lane >> 4;
    unsigned char* XCB = lds; float* XU = (float*)(lds + 16384); float* LA = (float*)(lds + 49152); float* ENDS = (float*)(lds + 81920);
    const int t0 = chunk * 64, ch0 = grp * 128;
    bf16x8 bfr[2][4];
#pragma unroll
    for (int g = 0; g < 2; ++g)
#pragma unroll
        for (int ks = 0; ks < 4; ++ks) bfr[g][ks] = *(const bf16x8*)(WaiT + ((size_t)grp * 256 + g * 128 + wave * 16 + r16) * 128 + ks * 32 + q4 * 8);
    const int chg = ch0 + wave * 16 + r16;
    const float ba = p.in[I_BA][(size_t)l * LRU_W + chg], bi = p.in[I_BI][(size_t)l * LRU_W + chg];
    const float lam_raw = p.in[I_LAM][(size_t)l * LRU_W + chg];
    {
        const int c = tid & 127, tq = tid >> 7, ch = ch0 + c;
        const float* cw = p.in[I_CONVW] + (size_t)l * 4 * LRU_W + ch; const float cb = p.in[I_CONVB][(size_t)l * LRU_W + ch];
        const float w0 = cw[0], w1 = cw[LRU_W], w2 = cw[2 * LRU_W], w3 = cw[3 * LRU_W];
        const int ts = t0 + tq * 16;
        float x0 = (ts - 3 >= 0) ? bf2f(Xr[(size_t)(ts - 3) * LRU_W + ch]) : 0.f;
        float x1 = (ts - 2 >= 0) ? bf2f(Xr[(size_t)(ts - 2) * LRU_W + ch]) : 0.f;
        float x2 = (ts - 1 >= 0) ? bf2f(Xr[(size_t)(ts - 1) * LRU_W + ch]) : 0.f;
#pragma unroll
        for (int i = 0; i < 16; ++i) {
            const float x3 = bf2f(Xr[(size_t)(ts + i) * LRU_W + ch]);
            const float v = cb + w0 * x0 + w1 * x1 + w2 * x2 + w3 * x3;
            const int row = tq * 16 + i;
            XU[row * 128 + c] = v;
            *(bf16_t*)(XCB + row * 256 + (((c >> 3) ^ (row & 15)) << 4) + (c & 7) * 2) = f2bf(v);
            x0 = x1; x1 = x2; x2 = x3;
        }
    }
    __syncthreads();
    {
        const float lsl = 8.0f * log_sigmoid_f(lam_raw);
#pragma unroll
        for (int mt = 0; mt < 4; ++mt) {
            f32x4 ga = (f32x4){0.f, 0.f, 0.f, 0.f}, gi = (f32x4){0.f, 0.f, 0.f, 0.f};
#pragma unroll
            for (int ks = 0; ks < 4; ++ks) {
                const bf16x8 af = *(const bf16x8*)(XCB + (mt * 16 + r16) * 256 + (((ks * 4 + q4) ^ r16) << 4));
                ga = MFMA16(af, bfr[0][ks], ga); gi = MFMA16(af, bfr[1][ks], gi);
            }
#pragma unroll
            for (int j = 0; j < 4; ++j) {
                const int row = mt * 16 + 4 * q4 + j, idx = row * 128 + wave * 16 + r16;
                const float r = sigmoid_f(ga[j] + ba), ig = sigmoid_f(gi[j] + bi);
                const float log_a = lsl * r;
                LA[idx] = fexp(log_a);
                XU[idx] = sqrtf(neg_expm1_f(2.f * log_a)) * (ig * XU[idx]);
            }
        }
    }
    __syncthreads();
    {
        const int c = tid & 127, tq = tid >> 7, ch = ch0 + c;
        float h = 0.f, P = 1.f;
#pragma unroll
        for (int i = 0; i < 16; ++i) { const int idx = (tq * 16 + i) * 128 + c; const float a = LA[idx]; h = a * h + XU[idx]; P *= a; XU[idx] = h; LA[idx] = P; }
        ENDS[tq * 128 + c] = P; ENDS[512 + tq * 128 + c] = h;
        __syncthreads();
        float cin = 0.f, pin = 1.f;
        for (int s = 0; s < tq; ++s) { const float Ps = ENDS[s * 128 + c], hs = ENDS[512 + s * 128 + c]; cin = Ps * cin + hs; pin *= Ps; }
#pragma unroll
        for (int i = 0; i < 16; ++i) {
            const int idx = (tq * 16 + i) * 128 + c; const size_t gi = (size_t)(t0 + tq * 16 + i) * LRU_W + ch;
            const float Pl = LA[idx], hl = XU[idx];
            ((unsigned*)hloc)[gi] = pack2(hl + Pl * cin, Pl * pin);
        }
        if (tq == 3) { const float Pl = LA[63 * 128 + c], hl = XU[63 * 128 + c]; sumA[(size_t)chunk * LRU_W + ch] = Pl * pin; sumH[(size_t)chunk * LRU_W + ch] = hl + Pl * cin; }
    }
    __syncthreads();
}

__device__ __forceinline__ void moe_prefix(const int* cntb_, int G, unsigned char* lds, int tid) {
    int* tmp = (int*)lds; int* ctot = (int*)(lds + LDS_MISC + M_CTOT); int* coff = (int*)(lds + LDS_MISC + M_COFF);
    unsigned short* pre16 = (unsigned short*)(lds + LDS_MISC + M_PRE16);
    const int e = tid & 31, part = tid >> 5, PB = (G + 15) / 16;
    int sm = 0;
    for (int i = 0; i < PB; ++i) { const int b = part * PB + i; if (b < G) sm += cntb_[b * 32 + e]; }
    tmp[part * 32 + e] = sm;
    __syncthreads();
    int run = 0;
    for (int q = 0; q < part; ++q) run += tmp[q * 32 + e];
    for (int i = 0; i < PB; ++i) { const int b = part * PB + i; if (b < G) { pre16[e * 257 + b] = (unsigned short)run; run += cntb_[b * 32 + e]; } }
    if (part == 15) { ctot[e] = run; pre16[e * 257 + G] = (unsigned short)run; }
    __syncthreads();
    if (tid == 0) { int o = 0; for (int q = 0; q < 32; ++q) { coff[q] = o; o += ctot[q]; } coff[32] = o; }
    __syncthreads();
}
__device__ __forceinline__ void moe_rowtable(const int* ltok_, const float* lw_, const int* lslot_, int e, int m0, int c_e, int G, int segcap, unsigned char* lds, int tid_in) {
    int tid = tid_in; OPAQUE(tid);
    const unsigned short* pre = (const unsigned short*)(lds + LDS_MISC + M_PRE16) + e * 257;
    int* rtok = (int*)(lds + LDS_MISC + M_RTOK); float* rw = (float*)(lds + LDS_MISC + M_RW); int* rslot = (int*)(lds + LDS_MISC + M_RSLOT);
    if (tid < 256) {
        const int g = m0 + tid;
        int tk = 0, sl = 0; float w = 0.f;
        if (g < c_e) {
            int lo = 0, hi = G;
            while (hi - lo > 1) { const int mid = (lo + hi) >> 1; if ((int)pre[mid] <= g) lo = mid; else hi = mid; }
            const int idx = (e * G + lo) * segcap + (g - (int)pre[lo]);
            tk = ltok_[idx]; w = lw_[idx]; sl = lslot_[idx];
        }
        rtok[tid] = tk; rw[tid] = w; rslot[tid] = sl;
    }
    __syncthreads();
}
#define kmax2 ((float*)(wsl + A_KMAX))
#define dpo ((bf16_t*)(wsl + A_DPO))
#define dpml ((float*)(wsl + A_DPML))
#define cntb ((int*)(wsl + A_CNTB))
#define WinT ((bf16_t*)(wsl + WB_WIN))
#define WoT ((bf16_t*)(wsl + WB_WO))
#define WguT ((bf16_t*)(wsl + WB_WGU))
#define WdT ((bf16_t*)(wsl + WB_WD))
#define WaiT ((bf16_t*)(wsl + WB_WAI))
#define Wfa ((float*)(wsl + WF_FA))
#define W36b ((bf16_t*)(wsl + WF_R36))
#define ropecs ((float*)(wsl + WF_ROPE))
#define xb ((bf16_t*)(wsl + A_XB))
#define hb ((float*)(wsl + A_HB))
#define logf_ ((float*)(wsl + A_LOGF))
#define cum2 ((float*)(wsl + A_CUM))
#define Qa ((bf16_t*)(wsl + A_QA))
#define Ka ((bf16_t*)(wsl + A_KA))
#define VaT ((bf16_t*)(wsl + A_VAT))
#define Xr ((bf16_t*)(wsl + A_XR))
#define Gr ((bf16_t*)(wsl + A_GR))
#define Qc ((bf16_t*)(wsl + A_QC))
#define Kc ((bf16_t*)(wsl + A_KC))
#define VcT ((bf16_t*)(wsl + A_VCT))
#define hloc ((float*)(wsl + A_HLOC))
#define ploc ((float*)(wsl + A_PLOC))
#define sumA ((float*)(wsl + A_SUMA))
#define sumH ((float*)(wsl + A_SUMH))
#define concat ((bf16_t*)(wsl + A_CONCAT))
#define y1 ((float*)(wsl + A_Y1))
#define h1 ((float*)(wsl + A_H1))
#define h1b ((bf16_t*)(wsl + A_H1B))
#define ltok ((int*)(wsl + A_LTOK))
#define lw ((float*)(wsl + A_LW))
#define lslot ((int*)(wsl + A_LSLOT))
#define act ((bf16_t*)(wsl + A_ACT))
#define contrib ((bf16_t*)(wsl + A_CONTRIB))
#ifndef EMU
__global__ void __launch_bounds__(NTHREADS, 2)
#else
void
#endif
fwd_kernel(Params p) {
    DYN_LDS(lds_raw);
    float* ldsf = (float*)lds_raw;
    const int bid = blockIdx.x, G = gridDim.x;
    const int gthreads = G * NTHREADS, gwaves = G * (NTHREADS / 64);
    const int wave_s = RFL((int)threadIdx.x >> 6);
#define PHASE_IDS() unsigned char* wsl = ws; OPAQUE_S(wsl); int tid = wave_s * 64 + LANE_ID(); OPAQUE(tid); const int lane = tid & 63, wave = tid >> 6, gtid = bid * NTHREADS + tid, gwave = bid * (NTHREADS / 64) + wave; (void)lane; (void)wave; (void)gtid; (void)gwave

    unsigned char* ws = p.ws;
    volatile LAS unsigned* bst = (volatile LAS unsigned*)(lds_raw + LDS_MISC);
    unsigned* ubox = (unsigned*)(lds_raw + LDS_MISC + 16);
    if (threadIdx.x == 0) { bst[0] = 0u; bst[1] = 0u; bst[2] = 0u; bst[3] = 0u; }
    __syncthreads();
    XcdBarrier bar = xcd_barrier_post((unsigned*)ws, bst);

    const int* positions = (const int*)p.in[I_POS];

    constexpr int NPH = 8;
    const int lo = p.lo, hi = p.hi;
#ifdef ONLY_PHASE
#define PH_SEL(c) ((c) == ONLY_PHASE)
#else
#define PH_SEL(c) 1
#endif
#define PH_IN(k) (lo <= (k) && (k) < hi)
#define PH_BAR(k) do { if ((k) + 1 < hi) xcd_barrier(bar, wave_s == 0 && LANE_ID() == 0); } while (0)

    if (PH_SEL(-1) && PH_IN(0)) for (int rep = 0; rep < PH_REPS(-1); ++rep) {
        PHASE_IDS();
        for (int l = 0; l < DEPTH; ++l) {
            convert_mat_pipe(p.in[I_WIN] + (size_t)l * D * N_IN, N_IN, D, N_IN, WinT + (size_t)l * N_INP * D, RmWin{}, ldsf, tid, bid, G);
            convert_mat_pipe(p.in[I_WO] + (size_t)l * D * D, D, D, D, WoT + (size_t)l * D * D, RmIdent{}, ldsf, tid, bid, G);
            convert_mats(p.in[I_WA] + (size_t)l * 6 * 128 * 128, (size_t)128 * 128, 6, 128, 128, 128, WaiT + (size_t)l * 6 * 256 * 128, (size_t)256 * 128, RmIdent{}, ldsf, tid, bid, G);
            convert_mats(p.in[I_WI] + (size_t)l * 6 * 128 * 128, (size_t)128 * 128, 6, 128, 128, 128, WaiT + (size_t)l * 6 * 256 * 128, (size_t)256 * 128, RmOff{128}, ldsf, tid, bid, G);
        }
        for (int i = gtid; i < DEPTH * 8 * D; i += gthreads) { const int k = i % D, h = (i / D) % 8, l = i / (8 * D);
            Wfa[i] = (h < 6) ? p.in[I_WIN][(size_t)l * D * N_IN + (size_t)k * N_IN + C_FA + h] : 0.f; }
        for (int i = gtid; i < DEPTH * 48 * D; i += gthreads) { const int k = i % D, o = (i / D) % 48, l = i / (48 * D);
            const float w = (o < 4) ? p.in[I_WGRP][((size_t)l * D + k) * 4 + o] : (o < 36 ? p.in[I_WRT][((size_t)l * D + k) * 32 + (o - 4)] : 0.f);
            const bf16_t hi = f2bf(w);
            W36b[((size_t)l * 2 + 0) * 48 * D + (size_t)o * D + k] = hi; W36b[((size_t)l * 2 + 1) * 48 * D + (size_t)o * D + k] = f2bf(w - bf2f(hi)); }
        for (int i = gtid; i < S * 8; i += gthreads) { const int d = i & 7, t = i >> 3; const float ang = (float)positions[t] * p.inv_freq[d];
            ropecs[t * 16 + d] = cosf(ang); ropecs[t * 16 + 8 + d] = sinf(ang); }
        __syncthreads();
        for (int i = tid; i < 6 * D; i += NTHREADS) { const int k = i % D, h = i / D; ldsf[i] = p.in[I_WIN][(size_t)k * N_IN + C_FA + h]; }
        __syncthreads();
        for (int t0 = gwave * 2; t0 < S; t0 += gwaves * 2) {
            f32x4 v[2][8];
#pragma unroll
            for (int tk = 0; tk < 2; ++tk)
#pragma unroll
                for (int j = 0; j < 8; ++j) v[tk][j] = *(const f32x4*)(p.in[I_X] + (size_t)(t0 + tk) * D + j * 256 + lane * 4);
#pragma unroll
            for (int tk = 0; tk < 2; ++tk) {
                const int t = t0 + tk;
                float fa[6] = {0.f, 0.f, 0.f, 0.f, 0.f, 0.f};
#pragma unroll
                for (int j = 0; j < 8; ++j) {
                    const int c = j * 256 + lane * 4;
                    u32x2 o; o.x = pack2(v[tk][j][0], v[tk][j][1]); o.y = pack2(v[tk][j][2], v[tk][j][3]);
                    *(u32x2*)(xb + (size_t)t * D + c) = o;
#pragma unroll
                    for (int h = 0; h < 6; ++h) { const f32x4 w = *(const f32x4*)(ldsf + h * D + c); fa[h] += v[tk][j][0] * w[0] + v[tk][j][1] * w[1] + v[tk][j][2] * w[2] + v[tk][j][3] * w[3]; }
                    COMPILER_FENCE();
                }
#pragma unroll
                for (int h = 0; h < 6; ++h) { const float sm = wave_sum(fa[h]); if (lane == 0) logf_[h * S + t] = log_sigmoid_f(sm + p.in[I_BF][h]); }
            }
        }
        PH_BAR(0);
    }

    for (int l = 0; l < DEPTH; ++l) {
        const int pb = 1 + l * NPH;
#define hin ((l == 0) ? p.in[I_X] : (const float*)hb)
#define hout ((l == DEPTH - 1) ? p.out : hb)
#define workctr ((int*)(wsl + CTL_WORK_OFF) + l * 64)

        if (PH_SEL(0) && PH_IN(pb + 0)) {
            PHASE_IDS();
            int bz = RFL(bid); OPAQUE_S(bz);
            if (bz == 0) {
                double* part = (double*)lds_raw;
                const int per = S / 64;
                double s = 0.0;
                if (wave < 6) { for (int i = 0; i < per; ++i) s += (double)logf_[wave * S + lane * per + i]; part[wave * 64 + lane] = s; }
                __syncthreads();
                if (wave < 6) {
                    double run = 0.0;
                    for (int j = 0; j < lane; ++j) run += part[wave * 64 + j];
                    for (int i = 0; i < per; ++i) { run += (double)logf_[wave * S + lane * per + i]; cum2[wave * S + lane * per + i] = (float)(run * (double)LOG2E); }
                }
                __syncthreads();
            }
            bool conv_more = true;
#define CONV_ONE() do { if (conv_more) { __syncthreads(); if (tid == 0) *ubox = (unsigned)atomic_add_int(workctr + 62, 1); __syncthreads(); \
                const int cid_ = RFL((int)*ubox); if (cid_ < 768) moe_conv_chunk(p, l * 768 + cid_, WguT, WdT, ldsf, tid); else conv_more = false; } } while (0)
            unsigned* cls = (unsigned*)(wsl + CTL_CLS_OFF) + l * 256;
            if (bz == 0) { WAIT_VM0(); __syncthreads(); if (tid == 0) { FENCE_REL_AGENT(); WAIT_VM0(); (void)xb_add(&cls[192], 1u); } }
            const bf16_t* Bt = WinT + (size_t)l * N_INP * D;
            constexpr int ntm = S / 256;
            const unsigned nooff[2][2] = {{0u, 0u}, {0u, 0u}};
            for (int i = 0; i < (bid & 7); ++i) CONV_ONE();
            for (;;) {
                __syncthreads();
                if (tid == 0) *ubox = (unsigned)atomic_add_int(workctr + 9, 1);
                __syncthreads();
                int t = RFL((int)*ubox);
                if (t >= ntm * 21) break;
                int pm, pn, kcls;
                if (t < ntm * 6) { pm = t / 6; pn = 15 + t % 6; kcls = 0; }
                else if (t < ntm * 12) { t -= ntm * 6; pm = t / 6; pn = 9 + t % 6; kcls = 1; }
                else { t -= ntm * 12; pm = t / 9; pn = t % 9; kcls = 2; }
                f32x4 acc[2][2][4][2];
                gemm_tile<false>(xb, pm * 256, nooff, Bt, pn * 256, D, lds_raw, acc, tid);
                int et = tid; OPAQUE(et); const int wr = et >> 8, wc = (et >> 6) & 3, fr = et & 15, fq = (et >> 4) & 3;
                if (pn < 6 || (pn >= 9 && pn < 19)) {
                    bf16_t* dst; float scale = 1.f; bool rope = false;
                    if (pn < 3) { dst = Qa; scale = QSCALE_A; } else if (pn < 6) { dst = Ka; } else if (pn < 12) { dst = Xr; } else if (pn < 15) { dst = Gr; }
                    else if (pn < 17) { dst = Qc; scale = QSCALE_C; rope = true; } else { dst = Kc; rope = true; }
                    const bool headmajor = (pn < 6) || (pn >= 15);
                    const int segpn = (pn < 3) ? pn : (pn < 6) ? pn - 3 : (pn < 12) ? pn - 9 : (pn < 15) ? pn - 12 : (pn < 17) ? pn - 15 : pn - 17;
#pragma unroll
                    for (int ai = 0; ai < 2; ++ai)
#pragma unroll
                        for (int m = 0; m < 4; ++m)
#pragma unroll
                            for (int bj = 0; bj < 2; ++bj)
#pragma unroll
                                for (int n = 0; n < 2; ++n) {
                                    const int dd = wc * 32 + n * 16 + fr;
#pragma unroll
                                    for (int j = 0; j < 4; ++j) {
                                        const int row = pm * 256 + ai * 128 + wr * 64 + m * 16 + fq * 4 + j;
                                        float v = acc[ai][bj][m][n][j];
                                        if (rope && n == 0 && (wc & 1) == 0) {
                                            const float pv = SHX(v, 8);
                                            const float cs = ropecs[row * 16 + (fr & 7)], sn = ropecs[row * 16 + 8 + (fr & 7)];
                                            v = (fr < 8) ? (v * cs - pv * sn) : (v * cs + pv * sn);
                                        }
                                        v *= scale;
                                        *(bf16_t*)(lds_raw + (ai * 128 + wr * 64 + m * 16 + fq * 4 + j) * 528 + (bj * 128 + dd) * 2) = f2bf(v);
                                    }
                                }
                    __syncthreads();
#pragma unroll 4
                    for (int i = 0; i < 16; ++i) {
                        const int idx = et + i * 512, lrow = idx >> 5, ch = idx & 31, row = pm * 256 + lrow;
                        const u32x4 val = *(const u32x4*)(lds_raw + lrow * 528 + ch * 16);
                        size_t gi;
                        if (headmajor) gi = ((size_t)(segpn * 2 + (ch >> 4)) * S + row) * 128 + (ch & 15) * 8;
                        else gi = (size_t)row * LRU_W + segpn * 256 + ch * 8;
                        *(u32x4*)(dst + gi) = val;
                    }
                    __syncthreads();
                    if (pn >= 15) {
                        float* part = ldsf;
#pragma unroll
                        for (int ai = 0; ai < 2; ++ai)
#pragma unroll
                            for (int m = 0; m < 4; ++m)
#pragma unroll
                                for (int bj = 0; bj < 2; ++bj)
#pragma unroll
                                    for (int j = 0; j < 4; ++j) {
                                        float ss = acc[ai][bj][m][0][j] * acc[ai][bj][m][0][j] + acc[ai][bj][m][1][j] * acc[ai][bj][m][1][j];
                                        ss += SHX(ss, 1); ss += SHX(ss, 2); ss += SHX(ss, 4); ss += SHX(ss, 8);
                                        if (fr == 0) part[(wc * 2 + bj) * 256 + ai * 128 + wr * 64 + m * 16 + fq * 4 + j] = ss;
                                    }
                        __syncthreads();
                        {
                            const int bj = et >> 8, row = et & 255;
                            float v0 = part[(0 * 2 + bj) * 256 + row] + part[(1 * 2 + bj) * 256 + row], v1 = part[(2 * 2 + bj) * 256 + row] + part[(3 * 2 + bj) * 256 + row];
                            v0 = fmaxf(v0, SHX(v0, 1)); v0 = fmaxf(v0, SHX(v0, 2)); v0 = fmaxf(v0, SHX(v0, 4)); v0 = fmaxf(v0, SHX(v0, 8)); v0 = xrow16_max(v0);
                            v1 = fmaxf(v1, SHX(v1, 1)); v1 = fmaxf(v1, SHX(v1, 2)); v1 = fmaxf(v1, SHX(v1, 4)); v1 = fmaxf(v1, SHX(v1, 8)); v1 = xrow16_max(v1);
                            if ((et & 63) == 0) {
                                unsigned* q2p = (unsigned*)(wsl + CTL_QK2_OFF) + l * 16 + (pn >= 17 ? 8 : 0) + (segpn * 2 + bj) * 2;
                                atomic_max_u32(q2p, __builtin_bit_cast(unsigned, v0)); atomic_max_u32(q2p + 1, __builtin_bit_cast(unsigned, v1));
                            }
                        }
                        __syncthreads();
                    }
                    if (pn >= 3 && pn < 6) {
                        float* part = ldsf;
#pragma unroll
                        for (int ai = 0; ai < 2; ++ai)
#pragma unroll
                            for (int m = 0; m < 4; ++m)
#pragma unroll
                                for (int bj = 0; bj < 2; ++bj)
#pragma unroll
                                    for (int j = 0; j < 4; ++j) {
                                        float ss = acc[ai][bj][m][0][j] * acc[ai][bj][m][0][j] + acc[ai][bj][m][1][j] * acc[ai][bj][m][1][j];
                                        ss += SHX(ss, 1); ss += SHX(ss, 2); ss += SHX(ss, 4); ss += SHX(ss, 8);
                                        if (fr == 0) part[(wc * 2 + bj) * 256 + ai * 128 + wr * 64 + m * 16 + fq * 4 + j] = ss;
                                    }
                        __syncthreads();
                        {
                            const int bj = et >> 8, row = et & 255;
                            float v = part[(0 * 2 + bj) * 256 + row] + part[(1 * 2 + bj) * 256 + row] + part[(2 * 2 + bj) * 256 + row] + part[(3 * 2 + bj) * 256 + row];
                            v = fmaxf(v, SHX(v, 1)); v = fmaxf(v, SHX(v, 2)); v = fmaxf(v, SHX(v, 4)); v = fmaxf(v, SHX(v, 8)); v = xrow16_max(v);
                            if ((et & 63) == 0) kmax2[((pn - 3) * 2 + bj) * NKT + pm * 4 + ((et >> 6) & 3)] = v;
                        }
                        __syncthreads();
                    }
                } else {
                    bf16_t* dst = (pn < 9) ? VaT : VcT;
                    const int segpn = (pn < 9) ? pn - 6 : pn - 19;
#pragma unroll
                    for (int ai = 0; ai < 2; ++ai)
#pragma unroll
                        for (int m = 0; m < 4; ++m)
#pragma unroll
                            for (int bj = 0; bj < 2; ++bj)
#pragma unroll
                                for (int n = 0; n < 2; ++n) {
                                    const int dd = wc * 32 + n * 16 + fr;
                                    const f32x4 a = acc[ai][bj][m][n];
                                    u32x2 o; o.x = pack2(a[0], a[1]); o.y = pack2(a[2], a[3]);
                                    const int s6 = m * 16 + fq * 4, pos = (s6 & 32) + ((s6 >> 2) & 3) * 8 + ((s6 >> 4) & 1) * 4;
                                    *(u32x2*)(lds_raw + ((bj * 4 + ai * 2 + wr) * 128 + dd) * 128 + ((((pos >> 3) ^ (dd & 7))) << 4) + (pos & 7) * 2) = o;
                                }
                    __syncthreads();
#pragma unroll 4
                    for (int i = 0; i < 16; ++i) {
                        const int idx = et + i * 512, blk = idx >> 10, dd = (idx >> 3) & 127, c = idx & 7;
                        const u32x4 val = *(const u32x4*)(lds_raw + (blk * 128 + dd) * 128 + ((c ^ (dd & 7)) << 4));
                        *(u32x4*)(dst + (((size_t)(segpn * 2 + (blk >> 2)) * NKT + (pm * 4 + (blk & 3))) * 128 + dd) * 64 + c * 8) = val;
                    }
                    __syncthreads();
                }
                WAIT_VM0();
                __syncthreads();
                if (et == 0) { FENCE_REL_AGENT(); WAIT_VM0(); (void)xb_add(&cls[kcls * 64], 1u); }
                CONV_ONE();
            }
        }

        if (PH_SEL(1) && PH_IN(pb + 1)) {
            PHASE_IDS();
            const float lam_init = (l == 0) ? 0.2f : 0.35550906759f;
            const float s1 = wave_sum(p.in[I_LQ1][l * 64 + lane] * p.in[I_LK1][l * 64 + lane]);
            const float s2 = wave_sum(p.in[I_LQ2][l * 64 + lane] * p.in[I_LK2][l * 64 + lane]);
            const float lam = fexp(s1) - fexp(s2) + lam_init;
            constexpr int NLRU = NKT * 6, NQB = S / 128;
            bool conv_more = true;
            unsigned* cls = (unsigned*)(wsl + CTL_CLS_OFF) + l * 256;
            unsigned* bw = (unsigned*)wsl;
#define WAIT_CLASS(k, n) do { __syncthreads(); if (tid == 0) { XB_SPIN(xb_ld(&cls[(k) * 64]) < (unsigned)(n), bw); FENCE_ACQ_AGENT(); WAIT_VM0(); } __syncthreads(); } while (0)
#ifndef NO_DIFF
            {
                constexpr int NQB2 = S / 256;
                int total = 0;
                for (int q = 0; q < NQB2; ++q) total += ((4 * q + 4 + DCH - 1) / DCH) * 8;
                WAIT_CLASS(0, (S / 256) * 6);
                for (;;) {
                    __syncthreads();
                    if (tid == 0) *ubox = (unsigned)atomic_add_int(workctr, 1);
                    __syncthreads();
                    int u = RFL((int)*ubox);
                    if (u >= total) break;
                    int qb = NQB2 - 1;
                    for (;; --qb) { const int nu = ((4 * qb + 4 + DCH - 1) / DCH) * 8; if (u < nu) break; u -= nu; }
                    const int c = u >> 3, h = (u >> 1) & 3, mp = u & 1;
                    const int t0 = c * DCH, t1 = (t0 + DCH < 4 * qb + 4) ? t0 + DCH : 4 * qb + 4;
                    const unsigned* q2p = (const unsigned*)(wsl + CTL_QK2_OFF) + l * 16;
                    const float bnd = sqrtf(__builtin_bit_cast(float, q2p[h * 2 + mp]) * __builtin_bit_cast(float, q2p[8 + h * 2 + mp])) * (QSCALE_C * 1.02f) + 0.01f;
                    attn_dmap_unit(Qc + (size_t)h * S * 128, Kc + (size_t)h * S * 128, VcT + (size_t)h * S * 128, mp, qb, t0, t1,
                                   dpo + (size_t)(h * 2 + mp) * DPART_ROWS * 128, dpml + (size_t)(h * 2 + mp) * DPART_ROWS * 2, c, RFL_F(bnd), lds_raw, tid);
                    CONV_ONE();
                }
            }
#endif
#ifndef NO_LRU
            WAIT_CLASS(1, (S / 256) * 6);
            for (;;) {
                __syncthreads();
                if (tid == 0) *ubox = (unsigned)atomic_add_int(workctr + 10, 1);
                __syncthreads();
                const int u = RFL((int)*ubox);
                if (u >= NLRU) break;
                lru_unit_a(u / 6, u % 6, l, p, Xr, WaiT + (size_t)l * 6 * 256 * 128, hloc, ploc, sumA, sumH, lds_raw, tid);
            }
#endif
#ifndef NO_FOX
            WAIT_CLASS(2, (S / 256) * 9);
            WAIT_CLASS(3, 1);
            for (;;) {
                __syncthreads();
                if (tid == 0) *ubox = (unsigned)atomic_add_int(workctr + 1, 1);
                __syncthreads();
                const int u = RFL((int)*ubox);
                if (u >= NQB * FOX_H) break;
                const int qb = NQB - 1 - u / FOX_H, h = u % FOX_H;
                attn_unit<0>(Qa + (size_t)h * S * 128, Ka + (size_t)h * S * 128, VaT + (size_t)h * S * 128, cum2 + (size_t)h * S, kmax2 + h * NKT, qb, concat, h * 128,
                             0.f, 0.f, nullptr, lds_raw, tid);
            }
#endif
            while (conv_more) CONV_ONE();
            PH_BAR(pb + 1);
        }

        if (PH_SEL(2) && PH_IN(pb + 2)) for (int rep = 0; rep < PH_REPS(2); ++rep) {
            PHASE_IDS();
            {
                const int per = (NKT * 6 + G - 1) / G;
                const int c = tid & 127, tq = tid >> 7;
                float cr = 0.f; int pgrp = -1;
                for (int u = bid * per; u < (bid + 1) * per && u < NKT * 6; ++u) {
                    const int grp = u / NKT, chunk = u % NKT, ch = grp * 128 + c;
                    if (grp != pgrp) {
                        pgrp = grp;
                        const int seg = (chunk + 3) >> 2, j0 = tq * seg, j1 = (j0 + seg < chunk) ? j0 + seg : chunk;
                        float pa = 1.f, ph = 0.f;
                        int j = j0;
                        for (; j + 16 <= j1; j += 16) {
                            float a8[16], h8[16];
#pragma unroll
                            for (int q = 0; q < 16; ++q) { a8[q] = sumA[(size_t)(j + q) * LRU_W + ch]; h8[q] = sumH[(size_t)(j + q) * LRU_W + ch]; }
#pragma unroll
                            for (int q = 0; q < 16; ++q) { pa *= a8[q]; ph = a8[q] * ph + h8[q]; }
                        }
                        for (; j < j1; ++j) { const float a = sumA[(size_t)j * LRU_W + ch]; pa *= a; ph = a * ph + sumH[(size_t)j * LRU_W + ch]; }
                        __syncthreads();
                        ldsf[(tq * 128 + c) * 2] = pa; ldsf[(tq * 128 + c) * 2 + 1] = ph;
                        __syncthreads();
                        cr = 0.f;
#pragma unroll
                        for (int s = 0; s < 4; ++s) cr = ldsf[(s * 128 + c) * 2] * cr + ldsf[(s * 128 + c) * 2 + 1];
                    }
                    float hl[16], pl[16]; bf16_t gg[16];
#pragma unroll
                    for (int i = 0; i < 16; ++i) { const size_t gi = (size_t)(chunk * 64 + tq * 16 + i) * LRU_W + ch; const unsigned hp = ((const unsigned*)hloc)[gi]; hl[i] = bf2f((bf16_t)(hp & 0xffffu)); pl[i] = bf2f((bf16_t)(hp >> 16)); gg[i] = Gr[gi]; }
                    const float an = sumA[(size_t)chunk * LRU_W + ch], hn = sumH[(size_t)chunk * LRU_W + ch];
#pragma unroll
                    for (int i = 0; i < 16; ++i)
                        concat[(size_t)(chunk * 64 + tq * 16 + i) * D + FOX_W + ch] = f2bf(gelu_tanh_f(bf2f(gg[i])) * (hl[i] + pl[i] * cr));
                    cr = an * cr + hn;
                }
            }
            {
                const float lam_init = (l == 0) ? 0.2f : 0.35550906759f;
                const float s1 = wave_sum(p.in[I_LQ1][l * 64 + lane] * p.in[I_LK1][l * 64 + lane]);
                const float s2 = wave_sum(p.in[I_LQ2][l * 64 + lane] * p.in[I_LK2][l * 64 + lane]);
                const float lam = fexp(s1) - fexp(s2) + lam_init;
                const float* sg = p.in[I_SUBG] + l * 128;
                const float g0 = sg[2 * lane], g1 = sg[2 * lane + 1];
                static_assert(NCH <= 8, "the merge below keeps one (map, chunk) pair per lane: 2 x 8 lanes");
                for (int q = gwave; q < S; q += gwaves) {
                    const int nch = (q >> 6) / DCH + 1;
                    float mv = -INFINITY, lv = 0.f;
                    { const int c = lane & 7, hm = lane >> 3;
                      if (c < nch) { const float* ML = dpml + ((size_t)hm * DPART_ROWS + dpart_row(c, q)) * 2; mv = ML[0]; lv = ML[1]; } }
                    unsigned pk[4][2][NCH];
#pragma unroll
                    for (int h = 0; h < 4; ++h)
#pragma unroll
                        for (int mp = 0; mp < 2; ++mp) {
                            const unsigned* OP = (const unsigned*)(dpo + (size_t)(h * 2 + mp) * DPART_ROWS * 128);
#pragma unroll
                            for (int c = 0; c < NCH; ++c) pk[h][mp][c] = (c < nch) ? OP[(size_t)dpart_row(c, q) * 64 + lane] : 0u;
                        }
                    float Mx = mv; Mx = fmaxf(Mx, DPP_X1(Mx)); Mx = fmaxf(Mx, DPP_X2(Mx)); Mx = fmaxf(Mx, DPP_X7(Mx));
                    const float wv = (mv == -INFINITY) ? 0.f : FAST_EXP2(mv - Mx);
                    float Lp = lv * wv; Lp += DPP_X1(Lp); Lp += DPP_X2(Lp); Lp += DPP_X7(Lp);
#pragma unroll
                    for (int h = 0; h < 4; ++h) {
                        float om[2][2];
#pragma unroll
                        for (int mp = 0; mp < 2; ++mp) {
                            float o0 = 0.f, o1 = 0.f;
#pragma unroll
                            for (int c = 0; c < NCH; ++c) { const float w = RDLANE(wv, (h * 2 + mp) * 8 + c); o0 += bf2f((bf16_t)(pk[h][mp][c] & 0xffffu)) * w; o1 += bf2f((bf16_t)(pk[h][mp][c] >> 16)) * w; }
                            const float il = 1.f / RDLANE(Lp, (h * 2 + mp) * 8);
                            om[mp][0] = o0 * il; om[mp][1] = o1 * il;
                        }
                        const float v0 = om[0][0] - lam * om[1][0], v1 = om[0][1] - lam * om[1][1];
                        const float ss = wave_sum(v0 * v0 + v1 * v1);
                        const float rs = (1.f - lam_init) / sqrtf(ss * (1.f / 128.f) + LN_EPS);
                        *(unsigned*)(concat + (size_t)q * D + 1536 + h * 128 + 2 * lane) = pack2(v0 * rs * g0, v1 * rs * g1);
                    }
                }
            }
            PH_BAR(pb + 2);
        }

        if (PH_SEL(3) && PH_IN(pb + 3)) {
            PHASE_IDS();
            const bf16_t* Bt = WoT + (size_t)l * D * D;
            constexpr int ntn = D / 256, ntm = S / 256;
            static_assert(ntn == 8, "the panel exchange is written for 8 column tiles");
            const unsigned nooff[2][2] = {{0u, 0u}, {0u, 0u}};
            const float* g1 = p.in[I_LN1G] + (size_t)l * D; const float* b1 = p.in[I_LN1B] + (size_t)l * D;
            const float* bg = p.in[I_BGRP] + l * 4; const float* br = p.in[I_BRT] + l * 32;
            const bf16_t* Wb = W36b + (size_t)l * 2 * 48 * D;
            int* lcnt = (int*)(lds_raw + LDS_MISC + M_LCNT);
            const int segcap = ((ntm * ntn + G - 1) / G) * 32;
            unsigned* pcnt = (unsigned*)(wsl + CTL_PAN_OFF) + l * 1024;
            unsigned long long* xbuf = (unsigned long long*)(wsl + A_XBUF);
            unsigned* part = (unsigned*)(wsl + A_PART);
            LAS float* Stab = (LAS float*)(lds_raw + LDS_MISC + M_RTOK);
            float* lgt = (float*)(lds_raw + LDS_MISC + 4096);
            if (tid < 32) lcnt[tid] = 0;
            __syncthreads();
            for (int t0 = bid; t0 < ntm * ntn; t0 += G) {
                int t = t0;
                if (G == 256 && ntm * ntn == 256) { const int x = t0 & 7, j = t0 >> 3; t = (x * 4 + (j >> 3)) * ntn + (j & 7); }
                const int pm = t / ntn, pn = t % ntn;
                f32x4 v[2][16];
                {
                    f32x4 acc[2][2][4][2];
                    gemm_tile<false>(concat, pm * 256, nooff, Bt, pn * 256, D, lds_raw, acc, tid);
                    int et = tid; OPAQUE(et); const int wr = et >> 8, wc = (et >> 6) & 3, fr = et & 15, fq = (et >> 4) & 3;
#pragma unroll
                    for (int ai = 0; ai < 2; ++ai) {
#pragma unroll
                        for (int m = 0; m < 4; ++m)
#pragma unroll
                            for (int bj = 0; bj < 2; ++bj)
#pragma unroll
                                for (int n = 0; n < 2; ++n)
#pragma unroll
                                    for (int j = 0; j < 4; ++j)
                                        *(float*)(lds_raw + (wr * 64 + m * 16 + fq * 4 + j) * 1040 + (bj * 128 + wc * 32 + n * 16 + fr) * 4) = acc[ai][bj][m][n][j];
                        __syncthreads();
#pragma unroll
                        for (int i = 0; i < 16; ++i) {
                            const int lrow = i * 8 + (et >> 6), c4 = et & 63;
                            const size_t gi = (size_t)(pm * 256 + ai * 128 + lrow) * D + pn * 256 + c4 * 4;
                            v[ai][i] = *(const GAS f32x4*)(hin + gi);
                        }
#pragma unroll
                        for (int i = 0; i < 16; ++i) {
                            const int lrow = i * 8 + (et >> 6), c4 = et & 63;
                            v[ai][i] = ALPHA * v[ai][i] + *(const f32x4*)(lds_raw + lrow * 1040 + c4 * 16);
                        }
                        __syncthreads();
                    }
                }
                int et2 = tid; OPAQUE(et2); const int el = et2 & 63, ew = wave_s, er16 = et2 & 15, eq4 = (et2 >> 4) & 3;
#pragma unroll
                for (int q = 0; q < 6; ++q) {
                    const int seg = ew * 6 + q, n2 = seg * 2 + (el >> 5), p5 = el & 31;
                    GLDS16(Wb + (size_t)n2 * D + pn * 256 + ((p5 ^ (n2 & 15)) << 3), lds_raw + 65536 + seg * 1024 + el * 16);
                }
                float my_mt = 0.f, my_m2 = 0.f;
                for (int trep = 0; trep < REP_STATS; ++trep)
#pragma unroll
                for (int ai = 0; ai < 2; ++ai)
#pragma unroll
                    for (int i4 = 0; i4 < 16; i4 += 4) {
                        float mt4[4], m24[4];
#pragma unroll
                        for (int u = 0; u < 4; ++u) { const f32x4 x = v[ai][i4 + u]; mt4[u] = wave_sum((x[0] + x[1]) + (x[2] + x[3])) * (1.f / 256.f); }
#pragma unroll
                        for (int u = 0; u < 4; ++u) { const f32x4 d = v[ai][i4 + u] - mt4[u]; m24[u] = wave_sum((d[0] * d[0] + d[1] * d[1]) + (d[2] * d[2] + d[3] * d[3])); }
#pragma unroll
                        for (int u = 0; u < 4; ++u) if (el == ai * 16 + i4 + u) { my_mt = mt4[u]; my_m2 = m24[u]; }
                        COMPILER_FENCE();
                    }
                unsigned* bw = (unsigned*)wsl;
                if (el < 32) {
                    const int grow = (el >> 4) * 128 + (el & 15) * 8 + ew;
                    xst64(&xbuf[(size_t)(pm * 256 + grow) * 8 + pn], ((unsigned long long)__builtin_bit_cast(unsigned, my_m2) << 32) | __builtin_bit_cast(unsigned, my_mt));
                }
                WAIT_VM0();
                __syncthreads();
                if (et2 == 0) { (void)xb_add(&pcnt[pm * 16], 1u); XB_SPIN(xb_ld(&pcnt[pm * 16]) < 8u, bw); FENCE_ACQ_AGENT(); }
                __syncthreads();
                unsigned long long wk[4];
#pragma unroll
                for (int k = 0; k < 4; ++k) {
                    const int r = k * 8 + (el >> 3), grow = (r >> 4) * 128 + (r & 15) * 8 + ew;
                    wk[k] = xld64(&xbuf[(size_t)(pm * 256 + grow) * 8 + (el & 7)]);
                }
#pragma unroll
                for (int k = 0; k < 4; ++k) {
                    const int r = k * 8 + (el >> 3);
                    const unsigned long long w = wk[k];
                    const float mt = __builtin_bit_cast(float, (unsigned)w), m2 = __builtin_bit_cast(float, (unsigned)(w >> 32));
                    float ms = mt; ms += DPP_X1(ms); ms += DPP_X2(ms); ms += DPP_X7(ms);
                    const float mean = ms * 0.125f, dm = mt - mean;
                    float q = m2 + 256.f * dm * dm; q += DPP_X1(q); q += DPP_X2(q); q += DPP_X7(q);
                    const float rstd = 1.f / sqrtf(q * (1.f / D) + LN_EPS);
                    if ((el & 7) == 0) { Stab[(ew * 32 + r) * 2] = mean; Stab[(ew * 32 + r) * 2 + 1] = rstd; }
                }
                WAVE_SYNC();
                const f32x4 gv = *(const f32x4*)(g1 + pn * 256 + el * 4), bv = *(const f32x4*)(b1 + pn * 256 + el * 4);
                LAS unsigned char* wt = (LAS unsigned char*)lds_raw + ew * 8192;
                const LAS unsigned char* wbl = (const LAS unsigned char*)lds_raw + 65536;
                for (int rrep = 0; rrep < REP_ROUTER; ++rrep)
#pragma unroll
                for (int ai = 0; ai < 2; ++ai) {
                    u32x2 lokeep[16];
#pragma unroll
                    for (int i = 0; i < 16; ++i) {
                        const float mean = Stab[(ew * 32 + ai * 16 + i) * 2], rstd = Stab[(ew * 32 + ai * 16 + i) * 2 + 1];
                        const f32x4 hv = mul_s4(v[ai][i] - mean, rstd) * gv + bv;
                        u32x2 o; o.x = pack2(hv[0], hv[1]); o.y = pack2(hv[2], hv[3]);
                        lokeep[i].x = pack2(hv[0] - bf2f((bf16_t)(o.x & 0xffffu)), hv[1] - bf2f((bf16_t)(o.x >> 16)));
                        lokeep[i].y = pack2(hv[2] - bf2f((bf16_t)(o.y & 0xffffu)), hv[3] - bf2f((bf16_t)(o.y >> 16)));
                        *(LAS u32x2*)(wt + i * 512 + (((el >> 1) ^ i) << 4) + (el & 1) * 8) = o;
                        COMPILER_FENCE();
                    }
                    WAVE_SYNC();
                    f32x4 ac[3];
#pragma unroll
                    for (int nt = 0; nt < 3; ++nt) ac[nt] = (f32x4){0.f, 0.f, 0.f, 0.f};
#pragma unroll 2
                    for (int ks = 0; ks < 8; ++ks) {
                        const int co = ((ks * 4 + eq4) ^ er16) << 4;
                        const bf16x8 ah = *(const LAS bf16x8*)(wt + er16 * 512 + co);
#pragma unroll
                        for (int nt = 0; nt < 3; ++nt) {
                            const bf16x8 bh = *(const LAS bf16x8*)(wbl + (nt * 16 + er16) * 512 + co);
                            const bf16x8 bl = *(const LAS bf16x8*)(wbl + (48 + nt * 16 + er16) * 512 + co);
                            ac[nt] = MFMA16(ah, bh, ac[nt]); ac[nt] = MFMA16(ah, bl, ac[nt]);
                        }
                    }
                    WAVE_SYNC();
#pragma unroll
                    for (int i = 0; i < 16; ++i) *(LAS u32x2*)(wt + i * 512 + (((el >> 1) ^ i) << 4) + (el & 1) * 8) = lokeep[i];
                    WAVE_SYNC();
#pragma unroll 2
                    for (int ks = 0; ks < 8; ++ks) {
                        const int co = ((ks * 4 + eq4) ^ er16) << 4;
                        const bf16x8 al = *(const LAS bf16x8*)(wt + er16 * 512 + co);
#pragma unroll
                        for (int nt = 0; nt < 3; ++nt) {
                            const bf16x8 bh = *(const LAS bf16x8*)(wbl + (nt * 16 + er16) * 512 + co);
                            ac[nt] = MFMA16(al, bh, ac[nt]);
                        }
                    }
#pragma unroll
                    for (int nt = 0; nt < 3; ++nt)
#pragma unroll
                        for (int j = 0; j < 4; ++j) {
                            const float cv = ac[nt][j];
                            xst32(&part[((size_t)pn * S + pm * 256 + ai * 128 + (eq4 * 4 + j) * 8 + ew) * 48 + nt * 16 + er16], __builtin_bit_cast(unsigned, cv));
                        }
                    WAVE_SYNC();
                }
                WAIT_VM0();
                __syncthreads();
                if (et2 == 0) (void)xb_add(&pcnt[512 + pm * 16], 1u);
                for (int srep = 0; srep < REP_STORES; ++srep)
#pragma unroll
                for (int ai = 0; ai < 2; ++ai)
#pragma unroll
                    for (int i = 0; i < 16; ++i) {
                        const float mean = Stab[(ew * 32 + ai * 16 + i) * 2], rstd = Stab[(ew * 32 + ai * 16 + i) * 2 + 1];
                        const f32x4 hv = mul_s4(v[ai][i] - mean, rstd) * gv + bv;
                        const size_t gi = (size_t)(pm * 256 + ai * 128 + i * 8 + ew) * D + pn * 256 + el * 4;
                        u32x2 o; o.x = pack2(hv[0], hv[1]); o.y = pack2(hv[2], hv[3]);
                        *(u32x2*)(h1b + gi) = o;
                        COMPILER_FENCE();
                    }
                if (et2 == 0) { XB_SPIN(xb_ld(&pcnt[512 + pm * 16]) < 8u, bw); FENCE_ACQ_AGENT(); }
                __syncthreads();
                int rt = tid; OPAQUE(rt);
#pragma unroll
                for (int k = 0; k < 3; ++k) {
                    const int idx = rt + k * 512, tk = idx / 48, n = idx - tk * 48;
                    unsigned pq[8];
#pragma unroll
                    for (int q = 0; q < 8; ++q) pq[q] = xb_ld(&part[((size_t)q * S + pm * 256 + pn * 32 + tk) * 48 + n]);
                    float a = 0.f;
#pragma unroll
                    for (int q = 0; q < 8; ++q) a += __builtin_bit_cast(float, pq[q]);
                    lgt[idx] = a;
                }
                __syncthreads();
                if (rt < 32) {
                    const int t = pm * 256 + pn * 32 + rt; const float* L = lgt + rt * 48;
                    float gl[4];
#pragma unroll
                    for (int q = 0; q < 4; ++q) gl[q] = L[q] + bg[q];
                    int gi = 0; float gm = gl[0];
#pragma unroll
                    for (int q = 1; q < 4; ++q) if (gl[q] > gm) { gm = gl[q]; gi = q; }
                    float gs = 0.f;
#pragma unroll
                    for (int q = 0; q < 4; ++q) gs += fexp(gl[q] - gm);
                    const float gweight = 1.f / gs;
                    float E[8];
#pragma unroll
                    for (int e = 0; e < 8; ++e) E[e] = L[4 + gi * 8 + e] + br[gi * 8 + e];
                    int e1 = 0; float m1 = E[0];
#pragma unroll
                    for (int e = 1; e < 8; ++e) if (E[e] > m1) { m1 = E[e]; e1 = e; }
                    int e2 = -1; float m2 = -INFINITY;
#pragma unroll
                    for (int e = 0; e < 8; ++e) if (e != e1 && E[e] > m2) { m2 = E[e]; e2 = e; }
                    const float p2 = fexp(m2 - m1), w1 = 1.f / (1.f + p2), w2 = p2 / (1.f + p2);
                    const int ge1 = gi * 8 + e1, ge2 = gi * 8 + e2;
                    const int i1 = (ge1 * G + bid) * segcap + atomic_add_int(&lcnt[ge1], 1);
                    ltok[i1] = t; lw[i1] = gweight * w1; lslot[i1] = 0;
                    const int i2 = (ge2 * G + bid) * segcap + atomic_add_int(&lcnt[ge2], 1);
                    ltok[i2] = t; lw[i2] = gweight * w2; lslot[i2] = 1;
                }
                __syncthreads();
            }
            { int ft = tid; OPAQUE(ft); if (ft < 32) cntb[bid * 32 + ft] = lcnt[ft]; }
            PH_BAR(pb + 3);
        }

        if (PH_SEL(5) && PH_IN(pb + 5)) {
            PHASE_IDS();
            const unsigned nooff[2][2] = {{0u, 0u}, {0u, 0u}};
            const int segcap = ((S / 256 * (D / 256) + G - 1) / G) * 32;
            moe_prefix(cntb, G, lds_raw, tid);
            const int* ctot = (const int*)(lds_raw + LDS_MISC + M_CTOT); const int* coff = (const int*)(lds_raw + LDS_MISC + M_COFF);
            const int* rtok = (const int*)(lds_raw + LDS_MISC + M_RTOK); const float* rw = (const float*)(lds_raw + LDS_MISC + M_RW);
            const int* rslot = (const int*)(lds_raw + LDS_MISC + M_RSLOT);
            unsigned* done = (unsigned*)(wsl + CTL_DONE_OFF) + l * 1024;
            int* mq = (int*)(wsl + CTL_MQ_OFF) + l * 128;
            const int myx = (int)(xb_xcc_id() & 7u);
            int qi = 0;
            for (;;) {
                __syncthreads();
                if (tid == 0) {
                    unsigned r = 0xffffffffu;
                    while (qi < 8) {
                        const int xx = (myx + qi) & 7;
                        int nm = 0;
#pragma unroll
                        for (int k = 0; k < NEXP / 8; ++k) nm += (ctot[xx + 8 * k] + 255) / 256;
                        const int got = atomic_add_int(mq + xx * 16, 1);
                        if (got < nm * 12) { r = ((unsigned)xx << 24) | (unsigned)got; break; }
                        ++qi;
                    }
                    *ubox = r;
                }
                __syncthreads();
                const unsigned rr = (unsigned)RFL((int)*ubox);
                if (rr == 0xffffffffu) break;
                const int xq = (int)(rr >> 24);
                int u = (int)(rr & 0xffffffu);
                int nmt = 0;
#pragma unroll
                for (int k = 0; k < NEXP / 8; ++k) nmt += (RFL(ctot[xq + 8 * k]) + 255) / 256;
                const bool down = (u >= nmt * 4);
                const int per = down ? 8 : 4;
                if (down) u -= nmt * 4;
                int e = xq;
                for (;; e += 8) { const int nt = ((RFL(ctot[e]) + 255) / 256) * per; if (u < nt) break; u -= nt; }
                const int c = RFL(ctot[e]), off = RFL(coff[e]);
                const int mt = u / per, pn = u % per, m0 = mt * 256;
                moe_rowtable(ltok, lw, lslot, e, m0, c, G, segcap, lds_raw, tid);
                f32x4 acc[2][2][4][2];
                if (!down) {
                    const bf16_t* Bt = WguT + ((size_t)l * NEXP + e) * 1024 * D;
                    unsigned aoff[2][2];
                    int st = tid; OPAQUE(st); int R[2], C[2]; stage_geom(st, R, C);
#pragma unroll
                    for (int h = 0; h < 2; ++h)
#pragma unroll
                        for (int i = 0; i < 2; ++i) aoff[h][i] = (unsigned)(rtok[h * 128 + R[i]] * D + C[i]);
                    if (c - m0 <= 128) gemm_tile<true, 0, true>(h1b, 0, aoff, Bt, pn * 256, D, lds_raw, acc, tid);
                    else gemm_tile<true>(h1b, 0, aoff, Bt, pn * 256, D, lds_raw, acc, tid);
                    int et = tid; OPAQUE(et); const int wr = et >> 8, wc = (et >> 6) & 3, fr = et & 15, fq = (et >> 4) & 3;
#pragma unroll
                    for (int ai = 0; ai < 2; ++ai)
#pragma unroll
                        for (int m = 0; m < 4; ++m)
#pragma unroll
                            for (int j = 0; j < 4; ++j) {
                                const int r = ai * 128 + wr * 64 + m * 16 + fq * 4 + j;
                                const float wgt = rw[r];
#pragma unroll
                                for (int bj = 0; bj < 2; ++bj)
                                    *(bf16_t*)(lds_raw + r * 272 + (bj * 64 + wc * 16 + fr) * 2) = f2bf(silu_f(acc[ai][bj][m][0][j]) * acc[ai][bj][m][1][j] * wgt);
                            }
                    __syncthreads();
#pragma unroll 4
                    for (int i = 0; i < 8; ++i) {
                        const int idx = et + i * 512, r = idx >> 4, ch = idx & 15;
                        if (m0 + r < c) st_wt16(act + (size_t)(off + m0 + r) * DFF + pn * 128 + ch * 8, *(const u32x4*)(lds_raw + r * 272 + ch * 16));
                    }
                    WAIT_VM0();
                    __syncthreads();
                    if (et == 0) (void)xb_add(&done[e * 32 + mt], 1u);
                } else {
                    const bf16_t* Bt = WdT + ((size_t)l * NEXP + e) * D * DFF;
                    if (tid == 0) {
                        unsigned* bw = (unsigned*)wsl;
                        XB_SPIN(xb_ld(&done[e * 32 + mt]) < 4u, bw);
                        FENCE_ACQ_AGENT();
                        WAIT_VM0();
                    }
                    __syncthreads();
                    if (c - m0 <= 128) gemm_tile<false, 16, true>(act, off + m0, nooff, Bt, pn * 256, DFF, lds_raw, acc, tid);
                    else gemm_tile<false, 16>(act, off + m0, nooff, Bt, pn * 256, DFF, lds_raw, acc, tid);
                    int et = tid; OPAQUE(et); const int wr = et >> 8, wc = (et >> 6) & 3, fr = et & 15, fq = (et >> 4) & 3;
#pragma unroll
                    for (int ai = 0; ai < 2; ++ai)
#pragma unroll
                        for (int m = 0; m < 4; ++m)
#pragma unroll
                            for (int bj = 0; bj < 2; ++bj)
#pragma unroll
                                for (int n = 0; n < 2; ++n)
#pragma unroll
                                    for (int j = 0; j < 4; ++j)
                                        *(bf16_t*)(lds_raw + (ai * 128 + wr * 64 + m * 16 + fq * 4 + j) * 528 + (bj * 128 + wc * 32 + n * 16 + fr) * 2) = f2bf(acc[ai][bj][m][n][j]);
                    __syncthreads();
#pragma unroll 4
                    for (int i = 0; i < 16; ++i) {
                        const int idx = et + i * 512, r = idx >> 5, ch = idx & 31;
                        if (m0 + r < c) *(u32x4*)(contrib + ((size_t)rslot[r] * S + rtok[r]) * D + pn * 256 + ch * 8) = *(const u32x4*)(lds_raw + r * 528 + ch * 16);
                    }
                }
            }
            PH_BAR(pb + 5);
        }

        if (PH_SEL(7) && PH_IN(pb + 7)) for (int rep = 0; rep < PH_REPS(7); ++rep) {
            PHASE_IDS();
            const float* g2 = p.in[I_LN2G] + (size_t)l * D; const float* b2 = p.in[I_LN2B] + (size_t)l * D;
            const bool more = (l + 1 < DEPTH);
            f32x4 gq[8], bq[8];
#pragma unroll
            for (int j = 0; j < 8; ++j) { gq[j] = *(const f32x4*)(g2 + j * 256 + lane * 4); bq[j] = *(const f32x4*)(b2 + j * 256 + lane * 4); }
            if (more) {
                const float* wf = Wfa + (size_t)(l + 1) * 8 * D;
                __syncthreads();
                for (int i = tid; i < 6 * D / 4; i += NTHREADS) *(f32x4*)(ldsf + i * 4) = *(const f32x4*)(wf + i * 4);
                __syncthreads();
            }
            for (int t = gwave; t < S; t += gwaves) {
                f32x4 v[8]; float s = 0.f;
#pragma unroll
                for (int j = 0; j < 8; ++j) {
                    const size_t i = (size_t)t * D + j * 256 + lane * 4;
                    const u32x2 c0 = *(const u32x2*)(contrib + i), c1 = *(const u32x2*)(contrib + (size_t)S * D + i);
                    const f32x4 cs = (f32x4){bf2f((bf16_t)(c0.x & 0xffffu)) + bf2f((bf16_t)(c1.x & 0xffffu)), bf2f((bf16_t)(c0.x >> 16)) + bf2f((bf16_t)(c1.x >> 16)),
                                             bf2f((bf16_t)(c0.y & 0xffffu)) + bf2f((bf16_t)(c1.y & 0xffffu)), bf2f((bf16_t)(c0.y >> 16)) + bf2f((bf16_t)(c1.y >> 16))};
                    const u32x2 hq = *(const u32x2*)(h1b + i);
                    v[j] = ALPHA * (f32x4){bf2f((bf16_t)(hq.x & 0xffffu)), bf2f((bf16_t)(hq.x >> 16)), bf2f((bf16_t)(hq.y & 0xffffu)), bf2f((bf16_t)(hq.y >> 16))} + cs;
                    s += (v[j][0] + v[j][1]) + (v[j][2] + v[j][3]);
                }
                const float mean = wave_sum(s) * (1.f / D);
                float s2 = 0.f;
#pragma unroll
                for (int j = 0; j < 8; ++j) { v[j] -= mean; s2 += (v[j][0] * v[j][0] + v[j][1] * v[j][1]) + (v[j][2] * v[j][2] + v[j][3] * v[j][3]); }
                const float rstd = 1.f / sqrtf(wave_sum(s2) * (1.f / D) + LN_EPS);
                float fa[6] = {0.f, 0.f, 0.f, 0.f, 0.f, 0.f};
#pragma unroll
                for (int j = 0; j < 8; ++j) {
                    const int c = j * 256 + lane * 4;
                    v[j] = v[j] * rstd * gq[j] + bq[j];
                    *(f32x4*)(hout + (size_t)t * D + c) = v[j];
                    COMPILER_FENCE();
                    if (more) {
                        u32x2 o; o.x = pack2(v[j][0], v[j][1]); o.y = pack2(v[j][2], v[j][3]);
                        *(u32x2*)(xb + (size_t)t * D + c) = o;
#pragma unroll
                        for (int h = 0; h < 6; ++h) { const f32x4 w = *(const f32x4*)(ldsf + h * D + c); fa[h] += (v[j][0] * w[0] + v[j][1] * w[1]) + (v[j][2] * w[2] + v[j][3] * w[3]); }
                    }
                }
                if (more) {
#pragma unroll
                    for (int h = 0; h < 6; ++h) { const float sm = wave_sum(fa[h]); if (lane == 0) logf_[h * S + t] = log_sigmoid_f(sm + p.in[I_BF][(l + 1) * 6 + h]); }
                }
            }
            PH_BAR(pb + 7);
        }
    }
#undef PH_IN
#undef PH_BAR
}

constexpr int N_PHASES = 1 + DEPTH * 8;
#ifndef EMU
extern "C" void kernel_launch(void* const* d_in, const int* in_sizes, int n_in, void* d_out, int out_size, void* d_ws, size_t ws_size, hipStream_t stream) {
    static int grid = 0;
    if (grid == 0) {
        if (n_in != N_INPUTS || out_size != S * D || ws_size < WS_END) {
            fprintf(stderr, "kernel_launch: unexpected shapes: n_in %d out %d ws %zu (need %zu)\n", n_in, out_size, ws_size, (size_t)WS_END); grid = -1; return; }
        int dev = 0, cus = 0, per_cu = 0;
        if (hipGetDevice(&dev) != hipSuccess || hipDeviceGetAttribute(&cus, hipDeviceAttributeMultiprocessorCount, dev) != hipSuccess) { grid = -1; return; }
        if (hipFuncSetAttribute((const void*)fwd_kernel, hipFuncAttributeMaxDynamicSharedMemorySize, LDS_BYTES) != hipSuccess) { fprintf(stderr, "kernel_launch: hipFuncSetAttribute failed\n"); grid = -1; return; }
        if (hipOccupancyMaxActiveBlocksPerMultiprocessor(&per_cu, (const void*)fwd_kernel, NTHREADS, LDS_BYTES) != hipSuccess || per_cu < 1) {
            fprintf(stderr, "kernel_launch: occupancy query says %d blocks per CU\n", per_cu); (void)hipGetLastError(); grid = -1; return; }
        grid = cus;
    }
    if (grid < 0) return;
    (void)hipMemsetAsync(d_ws, 0, CTL_BYTES, stream);
    Params p{};
    for (int i = 0; i < N_INPUTS; ++i) p.in[i] = (const float*)d_in[i];
    p.out = (float*)d_out; p.ws = (unsigned char*)d_ws;
    for (int i = 0; i < 8; ++i) p.inv_freq[i] = (float)pow(500000.0, -(double)i * 2.0 / 16.0);
#if N_LAUNCH_SPLIT
    for (int k = 0; k < N_PHASES; ++k) { p.lo = k; p.hi = k + 1; hipLaunchKernelGGL(fwd_kernel, dim3(grid), dim3(NTHREADS), LDS_BYTES, stream, p); }
#else
    p.lo = 0; p.hi = N_PHASES;
    hipLaunchKernelGGL(fwd_kernel, dim3(grid), dim3(NTHREADS), LDS_BYTES, stream, p);
#endif
}
#endif
```
